# Optimizing an MI355X kernel written in HIP

```python
import jax
import jax.numpy as jnp
from jax import lax
import numpy as np

D_MODEL = 1024
BATCH = 1
SEQ = 16384
DEPTH = 2

GRID_W = 64
CTX_LEN = 256
BRANCH_W = D_MODEL
RET_HEADS = 4
RET_DK = 128
RET_DV = BRANCH_W // RET_HEADS
RET_CHUNK = 128
GQA_HEADS = 8
GQA_KV_HEADS = 2
GQA_DIM = BRANCH_W // GQA_HEADS
Q_BLOCK = 128
NA_HEADS = 16
NA_DIM = BRANCH_W // NA_HEADS
NA_WIN_ROWS = 8
NA_WIN_COLS = 16
RWKV_HEADS = 16
RWKV_DIM = BRANCH_W // RWKV_HEADS
DECAY_LORA = 64
ICLR_LORA = 64
ROPE_THETA = 10000.0
NORM_EPS = 1e-6
RWKV_GN_EPS = 64e-5

EVEN_SPLIT = (RET_HEADS * RET_DK, RET_HEADS * RET_DK, BRANCH_W,
              GQA_HEADS * GQA_DIM, GQA_KV_HEADS * GQA_DIM, GQA_KV_HEADS * GQA_DIM,
              BRANCH_W, BRANCH_W)
RWKV_SPLIT = (BRANCH_W, BRANCH_W, BRANCH_W, DECAY_LORA, DECAY_LORA, ICLR_LORA, ICLR_LORA)
SHIFT_W = sum(RWKV_SPLIT)
ODD_SPLIT = (3 * BRANCH_W, SHIFT_W, BRANCH_W, BRANCH_W)
EVEN_IN = sum(EVEN_SPLIT)
ODD_IN = sum(ODD_SPLIT)

kernel_name = 'hybrid_ret_gqa_natten_rwkv7_dit'


def _split(p, sizes):
    return jnp.split(p, np.cumsum(sizes)[:-1].tolist(), axis=-1)


def rms_norm(x, g):
    xf = x.astype(jnp.float32)
    y = xf * lax.rsqrt(jnp.mean(xf * xf, axis=-1, keepdims=True) + NORM_EPS)
    return (y * g.astype(jnp.float32)).astype(x.dtype)


def head_layer_norm(x, eps):
    xf = x.astype(jnp.float32)
    xc = xf - jnp.mean(xf, axis=-1, keepdims=True)
    return xc * lax.rsqrt(jnp.mean(xc * xc, axis=-1, keepdims=True) + eps)


def axial_rope(n, dim):
    t = jnp.arange(n)
    row = (t // GRID_W).astype(jnp.float32)
    col = (t % GRID_W).astype(jnp.float32)
    n_freq = dim // 4
    inv = ROPE_THETA ** (-jnp.arange(n_freq, dtype=jnp.float32) / n_freq)
    ang = jnp.concatenate([row[:, None] * inv, col[:, None] * inv], axis=-1)
    return jnp.cos(ang), jnp.sin(ang)


def apply_rope(x, cos, sin):
    cos = cos[None, :, None, :].astype(x.dtype)
    sin = sin[None, :, None, :].astype(x.dtype)
    x1, x2 = x[..., 0::2], x[..., 1::2]
    return jnp.stack([x1 * cos - x2 * sin, x1 * sin + x2 * cos], axis=-1).reshape(x.shape)


def block_attention(q, k, v):
    B, Tq, Hq, d = q.shape
    Hkv = k.shape[2]
    qg = (q * d ** -0.5).reshape(B, Tq // Q_BLOCK, Q_BLOCK, Hkv, Hq // Hkv, d)

    def one(qb):
        s = jnp.einsum('bqgrd,bkgd->bgrqk', qb, k).astype(jnp.float32)
        p = jax.nn.softmax(s, axis=-1).astype(v.dtype)
        return jnp.einsum('bgrqk,bkgd->bqgrd', p, v)

    out = lax.map(one, jnp.moveaxis(qg, 1, 0))
    return jnp.moveaxis(out, 0, 1).reshape(B, Tq, Hq, d)


def retention_scan(q, k, v, log_g, s0, emit):
    B, T, H, dk = q.shape
    dv = v.shape[-1]
    n = T // RET_CHUNK
    f32 = jnp.float32
    qc = q.astype(f32).reshape(B, n, RET_CHUNK, H, dk)
    kc = k.astype(f32).reshape(B, n, RET_CHUNK, H, dk)
    vc = v.astype(f32).reshape(B, n, RET_CHUNK, H, dv)
    pos = jnp.arange(RET_CHUNK, dtype=f32)
    zeta = jnp.exp((RET_CHUNK - 1 - pos)[None, :] * log_g[:, None])
    u = jnp.einsum('bnjhd,hj,bnjhe->nbhde', kc, zeta, vc)
    g_chunk = jnp.exp(RET_CHUNK * log_g)[None, :, None, None]

    def step(s, u_i):
        return g_chunk * s + u_i, (s if emit else None)

    s_final, s_prev = lax.scan(step, s0.astype(f32), u)
    if not emit:
        return None, s_final
    diff = pos[:, None] - pos[None, :]
    decay_in = jnp.where(diff >= 0, jnp.exp(jnp.maximum(diff, 0.0)[None] * log_g[:, None, None]), 0.0)
    scores = jnp.einsum('bnihd,bnjhd->bnhij', qc, kc) * decay_in
    inner = jnp.einsum('bnhij,bnjhe->bnihe', scores, vc)
    xi = jnp.exp((pos + 1)[None, :] * log_g[:, None])
    cross = jnp.einsum('bnihd,nbhde,hi->bnihe', qc, s_prev, xi)
    return (inner + cross).reshape(B, T, H, dv), s_final


def bidir_retention(lat, ctx, log_g, need_ctx):
    B = lat[0].shape[0]
    s0 = jnp.zeros((B, RET_HEADS, RET_DK, RET_DV), jnp.float32)
    out_l, out_c = [], []
    for d in range(2):
        rev = (lambda t: jnp.flip(t, axis=1)) if d else (lambda t: t)
        y_c, s_c = retention_scan(*[rev(t) for t in ctx], log_g[d], s0, need_ctx)
        y_l, _ = retention_scan(*[rev(t) for t in lat], log_g[d], s_c, True)
        out_l.append(rev(y_l))
        if need_ctx:
            out_c.append(rev(y_c))
    return out_l[0] + out_l[1], (out_c[0] + out_c[1] if need_ctx else None)


def neighbourhood_attention(q, k, v, k_ctx, v_ctx, rpb):
    B, T, H, d = q.shape
    rows = T // GRID_W
    wh = min(NA_WIN_ROWS, rows)
    ww = NA_WIN_COLS
    qg = (q * d ** -0.5).reshape(B, rows, GRID_W, H, d)
    kg = k.reshape(B, rows, GRID_W, H, d)
    vg = v.reshape(B, rows, GRID_W, H, d)
    cols = np.arange(GRID_W)
    col_idx = np.clip(cols - ww // 2, 0, GRID_W - ww)[:, None] + np.arange(ww)[None, :]
    rpb_c = rpb[:, :, col_idx - cols[:, None] + (NA_WIN_COLS - 1)]

    def one_row(args):
        r, q_row = args
        r0 = jnp.clip(r - wh // 2, 0, rows - wh)
        k_win = lax.dynamic_slice_in_dim(kg, r0, wh, axis=1)[:, :, col_idx]
        v_win = lax.dynamic_slice_in_dim(vg, r0, wh, axis=1)[:, :, col_idx]
        bias = rpb_c[:, r0 + jnp.arange(wh) - r + (NA_WIN_ROWS - 1)]
        s_win = (jnp.einsum('bqhd,biqjhd->bhqij', q_row, k_win).astype(jnp.float32)
                 + jnp.transpose(bias, (0, 2, 1, 3)).astype(jnp.float32))
        s_ctx = jnp.einsum('bqhd,bkhd->bhqk', q_row, k_ctx).astype(jnp.float32)
        p = jax.nn.softmax(jnp.concatenate([s_win.reshape(B, H, GRID_W, wh * ww), s_ctx], axis=-1),
                           axis=-1).astype(v.dtype)
        p_win = p[..., :wh * ww].reshape(B, H, GRID_W, wh, ww)
        return (jnp.einsum('bhqij,biqjhd->bqhd', p_win, v_win)
                + jnp.einsum('bhqk,bkhd->bqhd', p[..., wh * ww:], v_ctx))

    out = lax.map(one_row, (jnp.arange(rows), jnp.moveaxis(qg, 1, 0)))
    return jnp.moveaxis(out, 0, 1).reshape(B, T, H, d)


def centred_token_shift(z, mu):
    zeros = jnp.zeros_like(z[:, :1])
    prev = jnp.concatenate([zeros, z[:, :-1]], axis=1)
    nxt = jnp.concatenate([z[:, 1:], zeros], axis=1)
    return z + (0.5 * (prev + nxt) - z) * mu


def rwkv_direction(parts, d, w0, w2, a0, a2, k_k, k_a):
    r, k, v = parts[0], parts[1], parts[2]
    zw, za = parts[3 + d], parts[5 + d]
    B, n, _ = r.shape
    heads = lambda t: t.reshape(B, n, RWKV_HEADS, RWKV_DIM)
    log_w = -jax.nn.softplus(-(w0 + jnp.tanh(zw) @ w2).astype(jnp.float32)) - 0.5
    decay = jnp.exp(-jnp.exp(log_w))
    a = jax.nn.sigmoid(a0 + za @ a2)
    kk = heads(k * k_k).astype(jnp.float32)
    kk = kk / jnp.maximum(jnp.linalg.norm(kk, axis=-1, keepdims=True), 1e-12)
    kd = k * (1.0 + (a - 1.0) * k_a)
    return heads(r), heads(decay), heads(kd), heads(v), -kk, kk * heads(a).astype(jnp.float32)


def rwkv7_scan(r, w, k, v, a, b, s0, emit):
    xs = tuple(jnp.moveaxis(t.astype(jnp.float32), 1, 0) for t in (r, w, k, v, a, b))

    def step(s, inp):
        rt, wt, kt, vt, at, bt = inp
        sa = jnp.einsum('bhij,bhj->bhi', s, at)
        s = s * wt[:, :, None, :] + sa[..., None] * bt[:, :, None, :] + vt[..., None] * kt[:, :, None, :]
        return s, (jnp.einsum('bhij,bhj->bhi', s, rt) if emit else None)

    s_final, ys = lax.scan(step, s0, xs)
    return (jnp.moveaxis(ys, 0, 1) if emit else None), s_final


def rwkv_bonus(ins, r_k):
    r, _, kd, v, _, _ = ins
    return jnp.sum(r * kd * r_k, axis=-1, keepdims=True) * v


def rwkv_branch(z, zc, w0s, w2s, a0s, a2s, k_k, k_a, r_k, lnx_g, lnx_b, need_ctx):
    B = z.shape[0]
    parts, parts_c = _split(z, RWKV_SPLIT), _split(zc, RWKV_SPLIT)
    s0 = jnp.zeros((B, RWKV_HEADS, RWKV_DIM, RWKV_DIM), jnp.float32)
    wkv_l, bon_l, wkv_c, bon_c = [], [], [], []
    for d in range(2):
        rev = (lambda t: jnp.flip(t, axis=1)) if d else (lambda t: t)
        ins_l = rwkv_direction(parts, d, w0s[d], w2s[d], a0s[d], a2s[d], k_k, k_a)
        ins_c = rwkv_direction(parts_c, d, w0s[d], w2s[d], a0s[d], a2s[d], k_k, k_a)
        y_c, s_c = rwkv7_scan(*[rev(t) for t in ins_c], s0, need_ctx)
        y_l, _ = rwkv7_scan(*[rev(t) for t in ins_l], s_c, True)
        wkv_l.append(rev(y_l))
        bon_l.append(rwkv_bonus(ins_l, r_k))
        if need_ctx:
            wkv_c.append(rev(y_c))
            bon_c.append(rwkv_bonus(ins_c, r_k))

    def finish(wkv, bon):
        y = (head_layer_norm(wkv[0] + wkv[1], RWKV_GN_EPS) * lnx_g.reshape(RWKV_HEADS, RWKV_DIM)
             + lnx_b.reshape(RWKV_HEADS, RWKV_DIM))
        return y + bon[0] + bon[1]

    return finish(wkv_l, bon_l), (finish(wkv_c, bon_c) if need_ctx else None)


def even_mixer(h, hc, w_in, w_out, dec_f, dec_b, q_norm, k_norm, need_ctx):
    B, T, _ = h.shape

    def project(hs):
        n = hs.shape[1]
        qa, ka, va, qb, kb, vb, ga, gb = _split(hs @ w_in, EVEN_SPLIT)
        return (qa.reshape(B, n, RET_HEADS, RET_DK),
                ka.reshape(B, n, RET_HEADS, RET_DK) * RET_DK ** -0.5,
                va.reshape(B, n, RET_HEADS, RET_DV),
                rms_norm(qb.reshape(B, n, GQA_HEADS, GQA_DIM), q_norm),
                rms_norm(kb.reshape(B, n, GQA_KV_HEADS, GQA_DIM), k_norm),
                vb.reshape(B, n, GQA_KV_HEADS, GQA_DIM), ga, gb)

    qa, ka, va, qb, kb, vb, ga, gb = project(h)
    qa_c, ka_c, va_c, qb_c, kb_c, vb_c, ga_c, gb_c = project(hc)
    cos_a, sin_a = axial_rope(T, RET_DK)
    cos_b, sin_b = axial_rope(T, GQA_DIM)
    qa, ka = apply_rope(qa, cos_a, sin_a), apply_rope(ka, cos_a, sin_a)
    qb, kb = apply_rope(qb, cos_b, sin_b), apply_rope(kb, cos_b, sin_b)
    log_g = (jax.nn.log_sigmoid(dec_f.astype(jnp.float32)), jax.nn.log_sigmoid(dec_b.astype(jnp.float32)))
    ret, ret_c = bidir_retention((qa, ka, va), (qa_c, ka_c, va_c), log_g, need_ctx)
    att = block_attention(qb, jnp.concatenate([kb_c, kb], axis=1), jnp.concatenate([vb_c, vb], axis=1))

    def merge(ret_o, att_o, g_a, g_b):
        n = ret_o.shape[1]
        return jnp.concatenate([jax.nn.silu(g_a) * head_layer_norm(ret_o, NORM_EPS).reshape(B, n, BRANCH_W),
                                jax.nn.silu(g_b) * att_o.reshape(B, n, BRANCH_W)], axis=-1) @ w_out

    y = merge(ret, att, ga, gb)
    if not need_ctx:
        return y, None
    return y, merge(ret_c, block_attention(qb_c, kb_c, vb_c), ga_c, gb_c)


def odd_mixer(h, hc, w_in, w_out, rpb, shift_mu, w0s, w2s, a0s, a2s, k_k, k_a, r_k, lnx_g, lnx_b, need_ctx):
    B, T, _ = h.shape

    def project(hs):
        n = hs.shape[1]
        na_p, rw_p, g_c, g_d = _split(hs @ w_in, ODD_SPLIT)
        q, k, v = [t.reshape(B, n, NA_HEADS, NA_DIM) for t in _split(na_p, (BRANCH_W,) * 3)]
        return q, k, v, centred_token_shift(rw_p, shift_mu), g_c, g_d

    q, k, v, z, g_c, g_d = project(h)
    q_cx, k_cx, v_cx, z_cx, g_c_cx, g_d_cx = project(hc)
    na = neighbourhood_attention(q, k, v, k_cx, v_cx, rpb)
    rw, rw_cx = rwkv_branch(z, z_cx, w0s, w2s, a0s, a2s, k_k, k_a, r_k, lnx_g, lnx_b, need_ctx)

    def merge(na_o, rw_o, gc, gd):
        n = na_o.shape[1]
        return jnp.concatenate([jax.nn.silu(gc) * na_o.reshape(B, n, BRANCH_W),
                                jax.nn.silu(gd) * rw_o.reshape(B, n, BRANCH_W)], axis=-1) @ w_out

    y = merge(na, rw, g_c, g_d)
    if not need_ctx:
        return y, None
    return y, merge(block_attention(q_cx, k_cx, v_cx), rw_cx, g_c_cx, g_d_cx)


def setup_inputs(seed: int = 0) -> dict:
    key = jax.random.key(seed)
    keys = iter(jax.random.split(key, 48))
    n_even = (DEPTH + 1) // 2
    n_odd = DEPTH // 2
    f32 = jnp.float32

    def nrm(shape, std):
        return std * jax.random.normal(next(keys), shape, f32)

    def near_one(shape):
        return 1.0 + nrm(shape, 0.02)

    gamma0 = 1.0 - 2.0 ** (-5.0 - np.arange(RET_HEADS))
    logit0 = jnp.asarray(np.log(gamma0 / (1.0 - gamma0)), f32)
    w0_base = -6.0 + 5.0 * jnp.linspace(0.0, 1.0, BRANCH_W, dtype=f32)
    return {
        'x': nrm((BATCH, SEQ, D_MODEL), 1.0),
        'c': nrm((BATCH, D_MODEL), 1.0),
        'ctx': nrm((BATCH, CTX_LEN, D_MODEL), 1.0),
        'c_ctx': nrm((D_MODEL,), 1.0),
        'w_mod': nrm((DEPTH, D_MODEL, 3 * D_MODEL), 0.5 * D_MODEL ** -0.5),
        'b_mod': nrm((DEPTH, 3 * D_MODEL), 0.02),
        'g_pre': near_one((DEPTH, D_MODEL)),
        'g_post': near_one((DEPTH, D_MODEL)),
        'ev_w_in': nrm((n_even, D_MODEL, EVEN_IN), D_MODEL ** -0.5),
        'ev_w_out': nrm((n_even, 2 * BRANCH_W, D_MODEL), (2 * BRANCH_W) ** -0.5),
        'ret_decay_fwd': logit0 + nrm((n_even, RET_HEADS), 0.1),
        'ret_decay_bwd': logit0 + nrm((n_even, RET_HEADS), 0.1),
        'gqa_q_norm': near_one((n_even, GQA_DIM)),
        'gqa_k_norm': near_one((n_even, GQA_DIM)),
        'od_w_in': nrm((n_odd, D_MODEL, ODD_IN), D_MODEL ** -0.5),
        'od_w_out': nrm((n_odd, 2 * BRANCH_W, D_MODEL), (2 * BRANCH_W) ** -0.5),
        'na_rpb': nrm((n_odd, NA_HEADS, 2 * NA_WIN_ROWS - 1, 2 * NA_WIN_COLS - 1), 0.1),
        'rwkv_shift_mu': jax.random.uniform(next(keys), (n_odd, SHIFT_W), f32),
        'rwkv_w0_fwd': w0_base + nrm((n_odd, BRANCH_W), 0.1),
        'rwkv_w2_fwd': nrm((n_odd, DECAY_LORA, BRANCH_W), 0.1),
        'rwkv_w0_bwd': w0_base + nrm((n_odd, BRANCH_W), 0.1),
        'rwkv_w2_bwd': nrm((n_odd, DECAY_LORA, BRANCH_W), 0.1),
        'rwkv_a0_fwd': nrm((n_odd, BRANCH_W), 0.1),
        'rwkv_a2_fwd': nrm((n_odd, ICLR_LORA, BRANCH_W), 0.1),
        'rwkv_a0_bwd': nrm((n_odd, BRANCH_W), 0.1),
        'rwkv_a2_bwd': nrm((n_odd, ICLR_LORA, BRANCH_W), 0.1),
        'rwkv_k_k': 0.85 + nrm((n_odd, BRANCH_W), 0.02),
        'rwkv_k_a': near_one((n_odd, BRANCH_W)),
        'rwkv_r_k': nrm((n_odd, RWKV_HEADS, RWKV_DIM), 0.1),
        'rwkv_lnx_g': near_one((n_odd, BRANCH_W)),
        'rwkv_lnx_b': nrm((n_odd, BRANCH_W), 0.02),
    }


def reference(x, c, ctx, c_ctx, w_mod, b_mod, g_pre, g_post, ev_w_in, ev_w_out, ret_decay_fwd, ret_decay_bwd,
              gqa_q_norm, gqa_k_norm, od_w_in, od_w_out, na_rpb, rwkv_shift_mu, rwkv_w0_fwd, rwkv_w2_fwd,
              rwkv_w0_bwd, rwkv_w2_bwd, rwkv_a0_fwd, rwkv_a2_fwd, rwkv_a0_bwd, rwkv_a2_bwd, rwkv_k_k, rwkv_k_a,
              rwkv_r_k, rwkv_lnx_g, rwkv_lnx_b):
    for layer in range(DEPTH):
        need_ctx = layer < DEPTH - 1
        i = layer // 2
        mod = jax.nn.silu(c) @ w_mod[layer] + b_mod[layer]
        mod_c = jax.nn.silu(c_ctx) @ w_mod[layer] + b_mod[layer]
        shift, scale, gate = jnp.split(mod[:, None, :], 3, axis=-1)
        shift_c, scale_c, gate_c = jnp.split(mod_c, 3, axis=-1)
        h = rms_norm(x, g_pre[layer]) * (1.0 + scale) + shift
        hc = rms_norm(ctx, g_pre[layer]) * (1.0 + scale_c) + shift_c
        if layer % 2 == 0:
            y, y_c = even_mixer(h, hc, ev_w_in[i], ev_w_out[i], ret_decay_fwd[i], ret_decay_bwd[i],
                                gqa_q_norm[i], gqa_k_norm[i], need_ctx)
        else:
            y, y_c = odd_mixer(h, hc, od_w_in[i], od_w_out[i], na_rpb[i], rwkv_shift_mu[i],
                               (rwkv_w0_fwd[i], rwkv_w0_bwd[i]), (rwkv_w2_fwd[i], rwkv_w2_bwd[i]),
                               (rwkv_a0_fwd[i], rwkv_a0_bwd[i]), (rwkv_a2_fwd[i], rwkv_a2_bwd[i]),
                               rwkv_k_k[i], rwkv_k_a[i], rwkv_r_k[i], rwkv_lnx_g[i], rwkv_lnx_b[i], need_ctx)
        x = x + gate * rms_norm(y, g_post[layer])
        if need_ctx:
            ctx = ctx + gate_c * rms_norm(y_c, g_post[layer])
    return x
```

```cpp
#ifdef CPU_EMU
#include <cstdio>
#include <cstdlib>
#include <cstring>
#include <cmath>
#include <vector>
#define DEV static inline
#else
#include <hip/hip_runtime.h>
#include <hip/hip_cooperative_groups.h>
#include <cstdio>
namespace cg = cooperative_groups;
#define DEV __device__ __forceinline__
#endif

#ifndef SEQ_LEN
#define SEQ_LEN 16384
#endif
typedef unsigned short bf16_t;
constexpr int DM = 1024, CTXN = 256, SEQ = SEQ_LEN, R = CTXN + SEQ, GW = 64, GROWS = SEQ / GW;
constexpr int EVEN_IN = 5632, ODD_IN = 8448;
constexpr int P0W = 3584;
constexpr int C_QA = 0, C_KA = 512, C_VA = 1024, C_QB = 2048, C_KB = 3072, C_VB = 3328, C_GA = 3584;
constexpr int ZW = 3328;
constexpr int O_NA = 0, O_RW = 3072, O_GC = 6400;
constexpr int NAW = 3072;
constexpr float NORM_EPS = 1e-6f, GN_EPS = 64e-5f;

constexpr size_t MiB = 1u << 20;
constexpr size_t WS_MODV = 0;
constexpr size_t WS_ROPE = 64 * 1024;
constexpr size_t WS_CTX1 = 1 * MiB;
constexpr size_t WS_WB = 2 * MiB;
constexpr size_t WS_XN = 42 * MiB;
constexpr size_t WS_BIG = WS_XN + (((size_t)R * DM * 2 + MiB - 1) / MiB) * MiB;
constexpr size_t WS_BR = WS_BIG + (((size_t)R * P0W * 2 + MiB - 1) / MiB) * MiB;
constexpr size_t WS_END = WS_BR + (size_t)R * 2048 * 2;
static_assert(SEQ != 16384 || WS_END <= 256 * MiB, "workspace map exceeds 256 MiB");

struct Params {
    const float *x, *c, *ctx, *c_ctx, *w_mod, *b_mod, *g_pre, *g_post, *ev_w_in, *ev_w_out, *dec_f, *dec_b, *q_norm, *k_norm;
    const float *od_w_in, *od_w_out, *rpb, *mu, *w0f, *w2f, *w0b, *w2b, *a0f, *a2f, *a0b, *a2b, *k_k, *k_a, *r_k, *lnx_g, *lnx_b;
    float* out; unsigned char* ws;
};

DEV bf16_t f2bf(float f) { unsigned u; __builtin_memcpy(&u, &f, 4); u = (u + 0x7fffu + ((u >> 16) & 1u)) >> 16; return (bf16_t)u; }
DEV float bf2f(bf16_t h) { unsigned u = ((unsigned)h) << 16; float f; __builtin_memcpy(&f, &u, 4); return f; }
DEV float siluf(float x) { return x / (1.0f + expf(-x)); }
DEV float sigmf(float x) { return 1.0f / (1.0f + expf(-x)); }
DEV float softplusf(float x) { return fmaxf(x, 0.f) + log1pf(expf(-fabsf(x))); }

DEV float* ws_modv(const Params& p) { return (float*)(p.ws + WS_MODV); }
DEV float* ws_rope(const Params& p) { return (float*)(p.ws + WS_ROPE); }
DEV float* ws_ctx1(const Params& p) { return (float*)(p.ws + WS_CTX1); }
DEV bf16_t* ws_xn(const Params& p) { return (bf16_t*)(p.ws + WS_XN); }
DEV bf16_t* ws_big(const Params& p) { return (bf16_t*)(p.ws + WS_BIG); }
DEV float* ws_y(const Params& p) { return (float*)(p.ws + WS_BIG); }
DEV bf16_t* ws_br(const Params& p) { return (bf16_t*)(p.ws + WS_BR); }

constexpr long N_MOD = 2 * 2 * 3072;
DEV void ph_mod(const Params& p, long gid) {
    const int j = (int)(gid % 3072), s = (int)((gid / 3072) % 2), l = (int)(gid / 6144);
    const float* cv = s ? p.c_ctx : p.c; const float* w = p.w_mod + (size_t)l * DM * 3072 + j;
    float acc = 0.f;
    for (int k = 0; k < DM; ++k) acc += siluf(cv[k]) * w[(size_t)k * 3072];
    ws_modv(p)[gid] = acc + p.b_mod[l * 3072 + j];
}
constexpr long N_ROPE = 256 * 32;
DEV void ph_rope_table(const Params& p, long gid) {
    const int f = (int)(gid % 32), pos = (int)(gid / 32);
    const float inv = powf(10000.0f, -(float)f / 32.0f); const float ang = (float)pos * inv;
    ws_rope(p)[gid] = cosf(ang); ws_rope(p)[N_ROPE + gid] = sinf(ang);
}
template <int LAYER> DEV void ph_prenorm(const Params& p, long gid) {
    const int row = (int)gid; const int s = row < CTXN ? 1 : 0;
    const float* src = row < CTXN ? ((LAYER == 0 ? p.ctx : ws_ctx1(p)) + (size_t)row * DM) : ((LAYER == 0 ? p.x : p.out) + (size_t)(row - CTXN) * DM);
    const float* mv = ws_modv(p) + (LAYER * 2 + s) * 3072; const float* g = p.g_pre + LAYER * DM;
    float ss = 0.f;
    for (int k = 0; k < DM; ++k) ss += src[k] * src[k];
    const float rstd = 1.0f / sqrtf(ss / DM + NORM_EPS);
    bf16_t* o = ws_xn(p) + (size_t)row * DM;
    for (int k = 0; k < DM; ++k) o[k] = f2bf(src[k] * rstd * g[k] * (1.0f + mv[1024 + k]) + mv[k]);
}
template <int MODE> DEV void gemm_item(const bf16_t* A, int K, const float* W, int ldw, void* out, int pitch, int row, int col) {
    const bf16_t* a = A + (size_t)row * K; const float* w = W + col; float acc = 0.f;
    for (int k = 0; k < K; ++k) acc += bf2f(a[k]) * w[(size_t)k * ldw];
    if (MODE == 0) ((bf16_t*)out)[(size_t)row * pitch + col] = f2bf(acc);
    else if (MODE == 1) { bf16_t* o = (bf16_t*)out + (size_t)row * pitch + col; *o = f2bf(siluf(acc) * bf2f(*o)); }
    else ((float*)out)[(size_t)row * pitch + col] = acc;
}
DEV void ph_gemm_l0_qkv(const Params& p, long gid) { gemm_item<0>(ws_xn(p), DM, p.ev_w_in, EVEN_IN, ws_big(p), P0W, (int)(gid / P0W), (int)(gid % P0W)); }
DEV void ph_gemm_l0_gate(const Params& p, long gid) { gemm_item<1>(ws_xn(p), DM, p.ev_w_in + C_GA, EVEN_IN, ws_br(p), 2048, (int)(gid / 2048), (int)(gid % 2048)); }
DEV void ph_gemm_l0_out(const Params& p, long gid) { gemm_item<2>(ws_br(p), 2048, p.ev_w_out, DM, ws_y(p), DM, (int)(gid / DM), (int)(gid % DM)); }
DEV void ph_gemm_l1_rw(const Params& p, long gid) { gemm_item<0>(ws_xn(p), DM, p.od_w_in + O_RW, ODD_IN, ws_big(p), ZW, (int)(gid / ZW), (int)(gid % ZW)); }
DEV void ph_gemm_l1_na(const Params& p, long gid) { gemm_item<0>(ws_xn(p), DM, p.od_w_in + O_NA, ODD_IN, ws_big(p), NAW, (int)(gid / NAW), (int)(gid % NAW)); }
DEV void ph_gemm_l1_gate(const Params& p, long gid) { gemm_item<1>(ws_xn(p), DM, p.od_w_in + O_GC, ODD_IN, ws_br(p), 2048, CTXN + (int)(gid / 2048), (int)(gid % 2048)); }
DEV void ph_gemm_l1_out(const Params& p, long gid) { gemm_item<2>(ws_br(p), 2048, p.od_w_out, DM, ws_y(p), DM, CTXN + (int)(gid / DM), (int)(gid % DM)); }

constexpr long N_ROPENORM = (long)R * 18;
DEV void ph_ropenorm(const Params& p, long gid) {
    const int slot = (int)(gid % 18), row = (int)(gid / 18);
    int col; const float* nw = nullptr; float sc = 1.f;
    if (slot < 4) col = C_QA + slot * 128; else if (slot < 8) { col = C_KA + (slot - 4) * 128; sc = 0.08838834764831845f; }
    else if (slot < 16) { col = C_QB + (slot - 8) * 128; nw = p.q_norm; } else { col = C_KB + (slot - 16) * 128; nw = p.k_norm; }
    bf16_t* v = ws_big(p) + (size_t)row * P0W + col;
    if (nw) { float ss = 0.f; for (int d = 0; d < 128; ++d) { const float t = bf2f(v[d]); ss += t * t; } sc = 1.0f / sqrtf(ss / 128.f + NORM_EPS); }
    const bool rot = row >= CTXN; const int t = row - CTXN; const int gr = rot ? t / GW : 0, gc = rot ? t % GW : 0;
    const float* ct = ws_rope(p); const float* st = ct + N_ROPE;
    for (int i = 0; i < 64; ++i) {
        float x1 = bf2f(v[2 * i]) * sc, x2 = bf2f(v[2 * i + 1]) * sc;
        if (nw) { x1 *= nw[2 * i]; x2 *= nw[2 * i + 1]; }
        if (rot) { const int pos = i < 32 ? gr : gc, f = i & 31; const float cs = ct[pos * 32 + f], sn = st[pos * 32 + f]; const float y1 = x1 * cs - x2 * sn, y2 = x1 * sn + x2 * cs; x1 = y1; x2 = y2; }
        v[2 * i] = f2bf(x1); v[2 * i + 1] = f2bf(x2);
    }
}
constexpr long N_RETSCAN = 2 * 4 * 256;
DEV void ph_ret_scan(const Params& p, long gid) {
    const int e = (int)(gid % 256), h = (int)((gid / 256) % 4), dir = (int)(gid / 1024);
    const float g = sigmf((dir ? p.dec_b : p.dec_f)[h]);
    float S[128];
#pragma unroll
    for (int d = 0; d < 128; ++d) S[d] = 0.f;
    const bf16_t* P = ws_big(p); bf16_t* BR = ws_br(p);
    for (int pos = 0; pos < R; ++pos) {
        int row; if (pos < CTXN) row = dir ? CTXN - 1 - pos : pos; else { const int t = pos - CTXN; row = CTXN + (dir ? SEQ - 1 - t : t); }
        const bf16_t* pr = P + (size_t)row * P0W; const float v = bf2f(pr[C_VA + h * 256 + e]);
        const bf16_t* kq = pr + C_KA + h * 128; const bf16_t* qq = pr + C_QA + h * 128; float y = 0.f;
#pragma unroll
        for (int d = 0; d < 128; ++d) { S[d] = g * S[d] + bf2f(kq[d]) * v; y += bf2f(qq[d]) * S[d]; }
        BR[(size_t)row * 2048 + dir * 1024 + h * 256 + e] = f2bf(y);
    }
}
constexpr long N_RETMERGE = (long)R * 4;
DEV void ph_ret_merge(const Params& p, long gid) {
    const int h = (int)(gid % 4), row = (int)(gid / 4);
    bf16_t* b = ws_br(p) + (size_t)row * 2048 + h * 256;
    float s = 0.f; for (int e = 0; e < 256; ++e) s += bf2f(b[e]) + bf2f(b[1024 + e]);
    const float mean = s / 256.f; float q = 0.f;
    for (int e = 0; e < 256; ++e) { const float d = bf2f(b[e]) + bf2f(b[1024 + e]) - mean; q += d * d; }
    const float rstd = 1.0f / sqrtf(q / 256.f + NORM_EPS);
    for (int e = 0; e < 256; ++e) b[e] = f2bf((bf2f(b[e]) + bf2f(b[1024 + e]) - mean) * rstd);
}
constexpr long N_GQA = (long)R * 8 * 8;
DEV void ph_gqa_attn(const Params& p, long gid) {
    const int sl = (int)(gid % 8), row = (int)((gid / 8) % R), head = (int)(gid / (8L * R)), g = head / 4;
    const bf16_t* P = ws_big(p); const int nk = row < CTXN ? CTXN : R;
    float q[128];
    { const bf16_t* qp = P + (size_t)row * P0W + C_QB + head * 128;
#pragma unroll
      for (int d = 0; d < 128; ++d) q[d] = bf2f(qp[d]) * 0.08838834764831845f; }
    float acc[16];
#pragma unroll
    for (int i = 0; i < 16; ++i) acc[i] = 0.f;
    float m = -1e30f, l = 0.f;
    for (int j = 0; j < nk; ++j) {
        const bf16_t* kp = P + (size_t)j * P0W + C_KB + g * 128; float s = 0.f;
#pragma unroll
        for (int d = 0; d < 128; ++d) s += q[d] * bf2f(kp[d]);
        const float mn = fmaxf(m, s), al = expf(m - mn), pe = expf(s - mn);
        const bf16_t* vp = P + (size_t)j * P0W + C_VB + g * 128 + sl * 16;
        l = l * al + pe;
#pragma unroll
        for (int i = 0; i < 16; ++i) acc[i] = acc[i] * al + pe * bf2f(vp[i]);
        m = mn;
    }
    bf16_t* o = ws_br(p) + (size_t)row * 2048 + 1024 + head * 128 + sl * 16; const float il = 1.0f / l;
#pragma unroll
    for (int i = 0; i < 16; ++i) o[i] = f2bf(acc[i] * il);
}
template <int LAYER> DEV void ph_resid(const Params& p, long gid) {
    const int row = LAYER == 0 ? (int)gid : CTXN + (int)gid; const int s = row < CTXN ? 1 : 0;
    const float* y = ws_y(p) + (size_t)row * DM; const float* mv = ws_modv(p) + (LAYER * 2 + s) * 3072 + 2048; const float* g = p.g_post + LAYER * DM;
    float ss = 0.f; for (int k = 0; k < DM; ++k) ss += y[k] * y[k];
    const float rstd = 1.0f / sqrtf(ss / DM + NORM_EPS);
    const float* src; float* dst;
    if (row < CTXN) { src = p.ctx + (size_t)row * DM; dst = ws_ctx1(p) + (size_t)row * DM; }
    else { src = (LAYER == 0 ? p.x : p.out) + (size_t)(row - CTXN) * DM; dst = p.out + (size_t)(row - CTXN) * DM; }
    for (int k = 0; k < DM; ++k) dst[k] = src[k] + mv[k] * (y[k] * rstd * g[k]);
}
DEV float zshift(const bf16_t* Z, const float* mu, int row, int col) {
    const int lo = row < CTXN ? 0 : CTXN, hi = row < CTXN ? CTXN : R;
    const float z = bf2f(Z[(size_t)row * ZW + col]);
    const float pv = row > lo ? bf2f(Z[(size_t)(row - 1) * ZW + col]) : 0.f, nx = row + 1 < hi ? bf2f(Z[(size_t)(row + 1) * ZW + col]) : 0.f;
    return z + (0.5f * (pv + nx) - z) * mu[col];
}
constexpr long N_RWFIN = (long)SEQ * 16;
DEV void ph_rwkv_finish(const Params& p, long gid) {
    const int h = (int)(gid % 16), t = (int)(gid / 16), row = CTXN + t;
    const bf16_t* Z = ws_big(p); bf16_t* b = ws_br(p) + (size_t)row * 2048;
    float bon[2];
    for (int d = 0; d < 2; ++d) {
        const float* a0 = d ? p.a0b : p.a0f; const float* a2 = d ? p.a2b : p.a2f;
        float s = 0.f;
        for (int j = 0; j < 64; ++j) { const int hj = h * 64 + j; float acc = a0[hj];
            for (int m = 0; m < 64; ++m) acc += zshift(Z, p.mu, row, 3200 + d * 64 + m) * a2[m * 1024 + hj];
            const float al = sigmf(acc); const float r = zshift(Z, p.mu, row, hj), k = zshift(Z, p.mu, row, 1024 + hj);
            s += r * (k * (1.0f + (al - 1.0f) * p.k_a[hj])) * p.r_k[hj]; }
        bon[d] = s;
    }
    float sm = 0.f; for (int i = 0; i < 64; ++i) sm += bf2f(b[h * 64 + i]) + bf2f(b[1024 + h * 64 + i]);
    const float mean = sm / 64.f; float q = 0.f;
    for (int i = 0; i < 64; ++i) { const float d = bf2f(b[h * 64 + i]) + bf2f(b[1024 + h * 64 + i]) - mean; q += d * d; }
    const float rstd = 1.0f / sqrtf(q / 64.f + GN_EPS);
    for (int i = 0; i < 64; ++i) { const int hi = h * 64 + i; const float w = bf2f(b[hi]) + bf2f(b[1024 + hi]);
        const float v = zshift(Z, p.mu, row, 2048 + hi);
        b[1024 + hi] = f2bf((w - mean) * rstd * p.lnx_g[hi] + p.lnx_b[hi] + (bon[0] + bon[1]) * v); }
}
constexpr long N_NA = (long)SEQ * 16;
DEV void ph_na(const Params& p, long gid) {
    const int h = (int)(gid % 16), t = (int)(gid / 16), r = t / GW, c = t % GW;
    const bf16_t* P = ws_big(p);
    float q[64];
    { const bf16_t* qp = P + (size_t)(CTXN + t) * NAW + h * 64;
#pragma unroll
      for (int d = 0; d < 64; ++d) q[d] = bf2f(qp[d]) * 0.125f; }
    float acc[64];
#pragma unroll
    for (int d = 0; d < 64; ++d) acc[d] = 0.f;
    float m = -1e30f, l = 0.f;
    const int wh = GROWS < 8 ? GROWS : 8;
    int r0 = r - wh / 2; r0 = r0 < 0 ? 0 : (r0 > GROWS - wh ? GROWS - wh : r0);
    int c0 = c - 8; c0 = c0 < 0 ? 0 : (c0 > GW - 16 ? GW - 16 : c0);
    const float* rp = p.rpb + h * 15 * 31;
    for (int kk = 0; kk < wh * 16 + CTXN; ++kk) {
        int krow; float bias = 0.f;
        if (kk < wh * 16) { const int i = kk / 16, j = kk % 16; krow = CTXN + (r0 + i) * GW + c0 + j; bias = rp[(r0 + i - r + 7) * 31 + (c0 + j - c + 15)]; }
        else krow = kk - wh * 16;
        const bf16_t* kp = P + (size_t)krow * NAW + 1024 + h * 64; float s = bias;
#pragma unroll
        for (int d = 0; d < 64; ++d) s += q[d] * bf2f(kp[d]);
        const float mn = fmaxf(m, s), al = expf(m - mn), pe = expf(s - mn);
        const bf16_t* vp = P + (size_t)krow * NAW + 2048 + h * 64;
        l = l * al + pe;
#pragma unroll
        for (int d = 0; d < 64; ++d) acc[d] = acc[d] * al + pe * bf2f(vp[d]);
        m = mn;
    }
    bf16_t* o = ws_br(p) + (size_t)(CTXN + t) * 2048 + h * 64; const float il = 1.0f / l;
#pragma unroll
    for (int d = 0; d < 64; ++d) o[d] = f2bf(acc[d] * il);
}

constexpr int RW_CH = 16;
struct RwShared { float r[RW_CH][64], w[RW_CH][64], kd[RW_CH][64], v[RW_CH][64], a[RW_CH][64], b[RW_CH][64], tz[RW_CH][64], za[RW_CH][64], kk[RW_CH][64]; };
#ifdef CPU_EMU
#define FOR_THREADS(tid) for (int tid = 0; tid < 64; ++tid)
#define BLOCK_SYNC()
#define TSTATE(tid) S_all[tid]
#else
#define FOR_THREADS(tid) const int tid = threadIdx.x; if (tid < 64)
#define BLOCK_SYNC() __syncthreads()
#define TSTATE(tid) S_reg
#endif
DEV int rw_row(int dir, int pos) { if (pos < CTXN) return dir ? CTXN - 1 - pos : pos; const int t = pos - CTXN; return CTXN + (dir ? SEQ - 1 - t : t); }
#ifdef CPU_EMU
static void rwkv_scan_block(const Params& p, int blk, RwShared& sh) {
    static thread_local float S_all[64][64];
    for (int i = 0; i < 64; ++i) for (int j = 0; j < 64; ++j) S_all[i][j] = 0.f;
#else
__device__ void rwkv_scan_block(const Params& p, int blk, RwShared& sh) {
    float S_reg[64];
#pragma unroll
    for (int j = 0; j < 64; ++j) S_reg[j] = 0.f;
#endif
    const int dir = blk / 16, h = blk % 16;
    const float* w0 = dir ? p.w0b : p.w0f; const float* w2 = dir ? p.w2b : p.w2f; const float* a0 = dir ? p.a0b : p.a0f; const float* a2 = dir ? p.a2b : p.a2f;
    const bf16_t* Z = ws_big(p); bf16_t* BR = ws_br(p);
    for (int p0 = 0; p0 < R; p0 += RW_CH) {
        { FOR_THREADS(tid) { const int hj = h * 64 + tid;
            for (int tt = 0; tt < RW_CH; ++tt) { const int row = rw_row(dir, p0 + tt);
                sh.tz[tt][tid] = tanhf(zshift(Z, p.mu, row, 3072 + dir * 64 + tid)); sh.za[tt][tid] = zshift(Z, p.mu, row, 3200 + dir * 64 + tid);
                sh.r[tt][tid] = zshift(Z, p.mu, row, hj); sh.v[tt][tid] = zshift(Z, p.mu, row, 2048 + hj);
                const float k = zshift(Z, p.mu, row, 1024 + hj); sh.kd[tt][tid] = k; sh.kk[tt][tid] = k * p.k_k[hj]; } } }
        BLOCK_SYNC();
        { FOR_THREADS(tid) { const int hj = h * 64 + tid;
            for (int tt = 0; tt < RW_CH; ++tt) { float aw = w0[hj], aa = a0[hj], nn = 0.f;
                for (int m = 0; m < 64; ++m) { aw += sh.tz[tt][m] * w2[m * 1024 + hj]; aa += sh.za[tt][m] * a2[m * 1024 + hj]; nn += sh.kk[tt][m] * sh.kk[tt][m]; }
                const float lw = -softplusf(-aw) - 0.5f; const float al = sigmf(aa);
                const float kkn = sh.kk[tt][tid] / fmaxf(sqrtf(nn), 1e-12f);
                sh.w[tt][tid] = expf(-expf(lw)); sh.a[tt][tid] = -kkn; sh.b[tt][tid] = kkn * al;
                sh.kd[tt][tid] = sh.kd[tt][tid] * (1.0f + (al - 1.0f) * p.k_a[hj]); } } }
        BLOCK_SYNC();
        { FOR_THREADS(tid) { float* S = TSTATE(tid);
            for (int tt = 0; tt < RW_CH; ++tt) { float sa = 0.f;
#pragma unroll
                for (int j = 0; j < 64; ++j) sa += S[j] * sh.a[tt][j];
                const float vi = sh.v[tt][tid]; float y = 0.f;
#pragma unroll
                for (int j = 0; j < 64; ++j) { S[j] = S[j] * sh.w[tt][j] + sa * sh.b[tt][j] + vi * sh.kd[tt][j]; y += S[j] * sh.r[tt][j]; }
                if (p0 >= CTXN) BR[(size_t)rw_row(dir, p0 + tt) * 2048 + dir * 1024 + h * 64 + tid] = f2bf(y); } } }
        BLOCK_SYNC();
    }
}

static Params make_params(void* const* d_in, void* d_out, void* d_ws) {
    Params p{};
    const float** f = (const float**)&p;
    for (int i = 0; i < 31; ++i) f[i] = (const float*)d_in[i];
    p.out = (float*)d_out; p.ws = (unsigned char*)d_ws; return p;
}


#ifndef CPU_EMU
#define LAS __attribute__((address_space(3)))
#define GAS __attribute__((address_space(1)))
typedef unsigned v4u __attribute__((ext_vector_type(4)));
constexpr int NWAVES = 8, NTHR = NWAVES * 64;
#ifndef PROBE
#define PROBE 0
#endif
#define XB_TMO      128
#define XB_XCNT(j)  (256  + 64 * (j))
#define XB_XSUB(j)  (1280 + 64 * (j))
#define XB_XGEN(j)  (2304 + 64 * (j))
#define XB_TOP      3328
#define XB_TOPGEN   3392
#define XCD_BAR_WORDS 3456
#define XB_SPIN_CAP (1u << 18)

__device__ __forceinline__ unsigned xb_ld(unsigned* p)              { return __hip_atomic_load(p, __ATOMIC_RELAXED, __HIP_MEMORY_SCOPE_AGENT); }
__device__ __forceinline__ unsigned xb_add(unsigned* p, unsigned v) { return __hip_atomic_fetch_add(p, v, __ATOMIC_RELAXED, __HIP_MEMORY_SCOPE_AGENT); }
__device__ __forceinline__ unsigned xb_xcc_id() { return (unsigned)__builtin_amdgcn_s_getreg((3 << 11) | 20) & 0xFu; }
#define XB_SPIN(cond, bar) do { unsigned _sp = 0; while (cond) { __builtin_amdgcn_s_sleep(1); \
    if ((++_sp & 255u) == 0u) { if (xb_ld(&(bar)[XB_TMO])) break; if (_sp > XB_SPIN_CAP) { atomicAdd(&(bar)[XB_TMO], 1u); break; } } } } while (0)

struct XcdBarrier {
    unsigned* bar; unsigned x;
    volatile LAS unsigned* st;
};

__device__ __forceinline__ XcdBarrier xcd_barrier_post(unsigned* bar, volatile LAS unsigned* st) {
    XcdBarrier b; b.bar = bar; b.x = xb_xcc_id(); b.st = st;
    if (threadIdx.x == 0) (void)xb_add(&bar[XB_XCNT(b.x)], 1u);
    return b;
}
__device__ __forceinline__ void xcd_barrier_complete(unsigned* bar, unsigned x, unsigned& nloc, unsigned& nx) {
    const unsigned G = gridDim.x * gridDim.y * gridDim.z;
    unsigned sum, cnt, mine, sp = 0u;
    for (;;) {
        sum = 0u; cnt = 0u; mine = 0u;
#pragma unroll
        for (unsigned j = 0; j < 16; ++j) { const unsigned c = xb_ld(&bar[XB_XCNT(j)]); sum += c; cnt += (c > 0u) ? 1u : 0u; mine = (j == x) ? c : mine; }
        if (sum == G) break;
        __builtin_amdgcn_s_sleep(1);
        if ((++sp & 255u) == 0u) { if (xb_ld(&bar[XB_TMO])) break; if (sp > XB_SPIN_CAP) { atomicAdd(&bar[XB_TMO], 1u); break; } }
    }
    nloc = mine > 0u ? mine : 1u; nx = cnt > 0u ? cnt : 1u;
}

__device__ __forceinline__ void xcd_barrier(const XcdBarrier& b) {
    asm volatile("s_waitcnt vmcnt(0)" ::: "memory");
    __syncthreads();
    if (threadIdx.x == 0) {
        unsigned* bar = b.bar;
        __builtin_amdgcn_s_waitcnt(0);
        unsigned nloc = b.st[0], nx = b.st[1];
        if (nloc == 0u) { xcd_barrier_complete(bar, b.x, nloc, nx); b.st[0] = nloc; b.st[1] = nx; }
        const unsigned old = xb_add(&bar[XB_XSUB(b.x)], 1u);
        const unsigned gen = old / nloc;
        if (old + 1u == (gen + 1u) * nloc) {
            __builtin_amdgcn_fence(__ATOMIC_RELEASE, "agent");
            asm volatile("s_waitcnt vmcnt(0)" ::: "memory");
            const unsigned og = xb_add(&bar[XB_TOP], 1u);
            const unsigned tg = og / nx;
            if (og + 1u == (tg + 1u) * nx) xb_add(&bar[XB_TOPGEN], 1u);
            else XB_SPIN(xb_ld(&bar[XB_TOPGEN]) == tg, bar);
            __builtin_amdgcn_fence(__ATOMIC_ACQUIRE, "agent");
            xb_add(&bar[XB_XGEN(b.x)], 1u);
            asm volatile("s_waitcnt vmcnt(0)" ::: "memory");
        } else {
            XB_SPIN(xb_ld(&bar[XB_XGEN(b.x)]) == gen, bar);
            __builtin_amdgcn_fence(__ATOMIC_ACQUIRE, "agent");
            asm volatile("s_waitcnt vmcnt(0)" ::: "memory");
        }
    }
    __syncthreads();
}
namespace pg8 {
#define PG8_LAS __attribute__((address_space(3)))
typedef unsigned short bf16_t;
typedef short bf16x8 __attribute__((ext_vector_type(8)));
typedef float f32x4 __attribute__((ext_vector_type(4)));
typedef unsigned u32x4 __attribute__((ext_vector_type(4)));
constexpr int BM = 256, BK = 64, HALF = 128, HTB = HALF * BK * 2  , STAGE_BYTES = 8 * HTB, NXCD = 8, WGM = 8;

__host__ __device__ __forceinline__ int lds_byte(int r, int c) { const int st = (r >> 4) * 2 + (c >> 5), rr = r & 15, cc = c & 31, ob = rr * 64 + cc * 2; return st * 1024 + (ob ^ (((ob >> 9) & 1) << 5)); }
__host__ __device__ __forceinline__ void stage_rc(int b, int& R, int& C) { const int st = b / 1024, sb = b % 1024, swz = sb ^ (((sb >> 9) & 1) << 5); R = (st >> 1) * 16 + swz / 64; C = (st & 1) * 32 + (swz % 64) / 2; }
__host__ __device__ __forceinline__ int perm32(int rho) { const int n = rho >> 4, i = rho & 15; return 8 * (i >> 2) + 4 * n + (i & 3); }

struct Unit { int pm, pn; };
struct Gemm { const bf16_t* A; const bf16_t* Bt; int M, N, K; int lda = 0, ldb = 0; int ksl = 0; };

struct StaticOrder {
    int nM, nN, nwg, G, c;
    __host__ __device__ void init(int M, int N, int G_, int c_) { nM = M / BM; nN = N / BM; nwg = nM * nN; G = G_; c = c_; }
    __host__ __device__ bool next(int i, Unit& u) const {
        const long L = (long)i * G + c; if (L >= nwg) return false;
        int wgid = (int)L; { const int q = nwg / NXCD, r = nwg % NXCD, xcd = wgid % NXCD, off = wgid / NXCD; wgid = (xcd < r ? xcd * (q + 1) : r * (q + 1) + (xcd - r) * q) + off; }
        const int nig = WGM * nN, gid = wgid / nig, fm = gid * WGM, gsz = (nM - fm) < WGM ? (nM - fm) : WGM;
        u.pm = fm + ((wgid % nig) % gsz); u.pn = (wgid % nig) / gsz; return true;
    }
    __device__ __forceinline__ void a_ready(const Unit&) const {}
    __device__ __forceinline__ void done(const Unit&) const {}
};

__device__ __forceinline__ unsigned cvt_pk_bf16(float lo, float hi) { unsigned r; asm volatile("v_cvt_pk_bf16_f32 %0, %1, %2" : "=v"(r) : "v"(lo), "v"(hi)); return r; }
typedef float f32x2 __attribute__((ext_vector_type(2)));
__device__ __forceinline__ f32x2 gelu_pk(f32x2 v) {
    const f32x2 av = __builtin_elementwise_abs(v), d = av * 0.2316418882f + 1.0f;
    f32x2 t; t.x = __builtin_amdgcn_rcpf(d.x); t.y = __builtin_amdgcn_rcpf(d.y);
    f32x2 q = t * 0.5307027145f + (-0.7265760135f); q = q * t + 0.7107068705f; q = q * t + (-0.142248368f); q = q * t + 0.127414796f; q = q * t;
    const f32x2 s = (v * v) * (-0.72134752044f);
    f32x2 e; e.x = __builtin_amdgcn_exp2f(s.x); e.y = __builtin_amdgcn_exp2f(s.y);
    const f32x2 m = v * (q * e), r = v - m;
    f32x2 o; o.x = v.x < 0.f ? m.x : r.x; o.y = v.y < 0.f ? m.y : r.y; return o;
}

template <int ACT  > struct EpiBf16 {
    static constexpr bool PERM = true, AFTER_DRAIN = false; static_assert(ACT == 0 || ACT == 1, "EpiBf16: ACT is 0 (none) or 1 (gelu_pk)");
    bf16_t* O; int ldc; const float* bias; int split_cols; size_t split_stride; float scale0;
    __device__ __forceinline__ void operator()(const f32x4 (&acc)[2][2][4][2], const Unit& u, int wr, int wc, int fr, int fq) const {
        const int row0 = u.pm * BM + wr * 64 + fr; int colt = u.pn * BM; bf16_t* base = O;
        float sc = 1.f; if (split_cols) { const int t = colt / split_cols; base += (size_t)t * split_stride; colt -= t * split_cols; if (t == 0) sc = scale0; }
        const int col0 = colt + wc * 32 + 8 * fq, bcol0 = u.pn * BM + wc * 32 + 8 * fq;
        f32x4 bv[2][2];
#pragma unroll
        for (int bj = 0; bj < 2; ++bj)
#pragma unroll
            for (int n = 0; n < 2; ++n) bv[bj][n] = bias ? *(const f32x4*)(bias + bcol0 + bj * HALF + 4 * n) : (f32x4){0.f, 0.f, 0.f, 0.f};
#pragma unroll
        for (int ai = 0; ai < 2; ++ai)
#pragma unroll
            for (int m = 0; m < 4; ++m) { bf16_t* rowp = base + (size_t)(row0 + ai * HALF + m * 16) * ldc + col0;
#pragma unroll
                for (int bj = 0; bj < 2; ++bj) { f32x4 v0 = acc[ai][bj][m][0] + bv[bj][0], v1 = acc[ai][bj][m][1] + bv[bj][1];
                    if (ACT == 1) { f32x2 a = gelu_pk((f32x2){v0[0], v0[1]}), b = gelu_pk((f32x2){v0[2], v0[3]}), c = gelu_pk((f32x2){v1[0], v1[1]}), d = gelu_pk((f32x2){v1[2], v1[3]});
                        v0 = (f32x4){a.x, a.y, b.x, b.y}; v1 = (f32x4){c.x, c.y, d.x, d.y}; }
                    v0 = v0 * sc; v1 = v1 * sc; u32x4 w; w.x = cvt_pk_bf16(v0[0], v0[1]); w.y = cvt_pk_bf16(v0[2], v0[3]); w.z = cvt_pk_bf16(v1[0], v1[1]); w.w = cvt_pk_bf16(v1[2], v1[3]);
                    *(u32x4*)(rowp + bj * HALF) = w; } }
    }
};

__device__ __forceinline__ float silu_fast(float v) { return v * __builtin_amdgcn_rcpf(1.0f + __builtin_amdgcn_exp2f(-1.4426950408889634f * v)); }
struct EpiGateMul {
    static constexpr bool PERM = true, AFTER_DRAIN = false;
    bf16_t* O; int ldc;
    __device__ __forceinline__ void operator()(const f32x4 (&acc)[2][2][4][2], const Unit& u, int wr, int wc, int fr, int fq) const {
        const int row0 = u.pm * BM + wr * 64 + fr, col0 = u.pn * BM + wc * 32 + 8 * fq;
#pragma unroll
        for (int ai = 0; ai < 2; ++ai)
#pragma unroll
            for (int m = 0; m < 4; ++m) { bf16_t* rowp = O + (size_t)(row0 + ai * HALF + m * 16) * ldc + col0;
#pragma unroll
                for (int bj = 0; bj < 2; ++bj) { const u32x4 old = *(const u32x4*)(rowp + bj * HALF); const f32x4 v0 = acc[ai][bj][m][0], v1 = acc[ai][bj][m][1];
                    u32x4 w;
                    w.x = cvt_pk_bf16(silu_fast(v0[0]) * __uint_as_float(old.x << 16), silu_fast(v0[1]) * __uint_as_float(old.x & 0xffff0000u));
                    w.y = cvt_pk_bf16(silu_fast(v0[2]) * __uint_as_float(old.y << 16), silu_fast(v0[3]) * __uint_as_float(old.y & 0xffff0000u));
                    w.z = cvt_pk_bf16(silu_fast(v1[0]) * __uint_as_float(old.z << 16), silu_fast(v1[1]) * __uint_as_float(old.z & 0xffff0000u));
                    w.w = cvt_pk_bf16(silu_fast(v1[2]) * __uint_as_float(old.w << 16), silu_fast(v1[3]) * __uint_as_float(old.w & 0xffff0000u));
                    *(u32x4*)(rowp + bj * HALF) = w; } }
    }
};
struct EpiSiluBf16 {
    static constexpr bool PERM = true, AFTER_DRAIN = false;
    bf16_t* O; int ldc;
    __device__ __forceinline__ void operator()(const f32x4 (&acc)[2][2][4][2], const Unit& u, int wr, int wc, int fr, int fq) const {
        const int row0 = u.pm * BM + wr * 64 + fr, col0 = u.pn * BM + wc * 32 + 8 * fq;
#pragma unroll
        for (int ai = 0; ai < 2; ++ai)
#pragma unroll
            for (int m = 0; m < 4; ++m) { bf16_t* rowp = O + (size_t)(row0 + ai * HALF + m * 16) * ldc + col0;
#pragma unroll
                for (int bj = 0; bj < 2; ++bj) { const f32x4 v0 = acc[ai][bj][m][0], v1 = acc[ai][bj][m][1]; u32x4 w;
                    w.x = cvt_pk_bf16(silu_fast(v0[0]), silu_fast(v0[1])); w.y = cvt_pk_bf16(silu_fast(v0[2]), silu_fast(v0[3]));
                    w.z = cvt_pk_bf16(silu_fast(v1[0]), silu_fast(v1[1])); w.w = cvt_pk_bf16(silu_fast(v1[2]), silu_fast(v1[3]));
                    *(u32x4*)(rowp + bj * HALF) = w; } }
    }
};
struct EpiF32 {
    static constexpr bool PERM = true, AFTER_DRAIN = false;
    float* O; int ldc;
    __device__ __forceinline__ void operator()(const f32x4 (&acc)[2][2][4][2], const Unit& u, int wr, int wc, int fr, int fq) const {
        const int row0 = u.pm * BM + wr * 64 + fr, col0 = u.pn * BM + wc * 32 + 8 * fq;
#pragma unroll
        for (int ai = 0; ai < 2; ++ai)
#pragma unroll
            for (int m = 0; m < 4; ++m) { float* rowp = O + (size_t)(row0 + ai * HALF + m * 16) * ldc + col0;
#pragma unroll
                for (int bj = 0; bj < 2; ++bj) { *(f32x4*)(rowp + bj * HALF) = acc[ai][bj][m][0]; *(f32x4*)(rowp + bj * HALF + 4) = acc[ai][bj][m][1]; } }
    }
};

template <class Epi, class Sched, bool ALIGN_EPI = false, bool SP2 = false>
__device__ __forceinline__ void gemm_phase(PG8_LAS unsigned char* lds, const Gemm g, const Sched& S, const Epi& E) {
    int tid_ = threadIdx.x; asm volatile("" : "+v"(tid_));
    const int tid = tid_, wid = __builtin_amdgcn_readfirstlane(tid >> 6), lane = tid & 63, wr = wid >> 2, wc = wid & 3, fr = lane & 15, fq = lane >> 4;
    const int K = g.K, nt = K / BK, lda = g.lda ? g.lda : K, ldb = g.ldb ? g.ldb : K;
    unsigned voffA[2], voffB[2];
#pragma unroll
    for (int i = 0; i < 2; ++i) { int R, C; stage_rc(tid * 16 + i * 8192, R, C); const int Rb = Epi::PERM ? ((R & ~31) + perm32(R & 31)) : R;
        voffA[i] = (unsigned)(R * lda + C) * 2u; voffB[i] = (unsigned)(Rb * ldb + C) * 2u; }
    const size_t kstep = (size_t)(BK * 2);
    const size_t hstepA = (size_t)HALF * lda * 2, hstepB = (size_t)HALF * ldb * 2;
    const size_t tstepA = g.ksl ? (size_t)g.ksl : 2 * hstepA, tstepB = 2 * hstepB, bpm = (size_t)g.ksl;
    const unsigned ldsw = (unsigned)wid * 1024u;
    const int aoff = lds_byte(wr * 64 + fr, fq * 8), boff = lds_byte(wc * 32 + fr, fq * 8);
#define PG8_SA(b, h) (((b) * 2 + (h)) * HTB)
#define PG8_SB(b, h) ((4 + (b) * 2 + (h)) * HTB)
#define PG8_STAGE(bufoff, gbase, voff) do { _Pragma("unroll") for (int _i = 0; _i < 2; ++_i) \
        __builtin_amdgcn_global_load_lds((const unsigned*)((const char*)(gbase) + (voff)[_i]), (PG8_LAS unsigned*)(lds + (bufoff) + ldsw + _i * 8192), 16, 0, 0); } while (0)
#define PG8_LDA(dst, b, h) do { _Pragma("unroll") for (int m = 0; m < 4; ++m) _Pragma("unroll") for (int k = 0; k < 2; ++k) dst[m][k] = *(const PG8_LAS bf16x8*)(lds + PG8_SA(b, h) + aoff + m * 2048 + k * 1024); } while (0)
#define PG8_LDB(dst, b, h) do { _Pragma("unroll") for (int n = 0; n < 2; ++n) _Pragma("unroll") for (int k = 0; k < 2; ++k) dst[n][k] = *(const PG8_LAS bf16x8*)(lds + PG8_SB(b, h) + boff + n * 2048 + k * 1024); } while (0)
#define PG8_MMA(ai, bj, At, Bt) do { __builtin_amdgcn_s_setprio(1); _Pragma("unroll") for (int m = 0; m < 4; ++m) _Pragma("unroll") for (int n = 0; n < 2; ++n) _Pragma("unroll") for (int k = 0; k < 2; ++k) \
        acc[ai][bj][m][n] = __builtin_amdgcn_mfma_f32_16x16x32_bf16(Bt[n][k], At[m][k], acc[ai][bj][m][n], 0, 0, 0); __builtin_amdgcn_s_setprio(0); } while (0)
#define PG8_WAIT_V(n) asm volatile("s_waitcnt vmcnt(" #n ")" ::: "memory")
#define PG8_WAIT_L(n) asm volatile("s_waitcnt lgkmcnt(" #n ")" ::: "memory")
#define PG8_BAR __builtin_amdgcn_s_barrier()
#define PG8_SCHED __builtin_amdgcn_sched_barrier(0)
    Unit cur, nxt; int ui = 0;
    if (!S.next(0, cur)) return;
    f32x4 acc[2][2][4][2];
#pragma unroll
    for (int a = 0; a < 2; ++a)
#pragma unroll
        for (int b = 0; b < 2; ++b)
#pragma unroll
            for (int m = 0; m < 4; ++m)
#pragma unroll
                for (int n = 0; n < 2; ++n) acc[a][b][m][n] = (f32x4){0.f, 0.f, 0.f, 0.f};
    bf16x8 At[4][2], B0[2][2], B1[2][2];
    const char* cA = (const char*)g.A + (size_t)cur.pm * tstepA; const char* cB = (const char*)g.Bt + (size_t)cur.pn * tstepB + (size_t)cur.pm * bpm;
    S.a_ready(cur);
    if constexpr (SP2) {
        PG8_STAGE(PG8_SB(0, 0), cB, voffB); PG8_STAGE(PG8_SB(0, 1), cB + hstepB, voffB); PG8_STAGE(PG8_SA(0, 0), cA, voffA); PG8_STAGE(PG8_SA(0, 1), cA + hstepA, voffA);
        if (wr == 1) PG8_BAR;
        PG8_WAIT_V(2); PG8_BAR;
        PG8_STAGE(PG8_SB(1, 0), cB + kstep, voffB); PG8_STAGE(PG8_SA(1, 0), cA + kstep, voffA); PG8_STAGE(PG8_SB(1, 1), cB + hstepB + kstep, voffB);
        PG8_WAIT_V(6); PG8_BAR;
    } else {
        PG8_STAGE(PG8_SB(0, 0), cB, voffB); PG8_STAGE(PG8_SA(0, 0), cA, voffA); PG8_STAGE(PG8_SB(0, 1), cB + hstepB, voffB); PG8_STAGE(PG8_SA(0, 1), cA + hstepA, voffA);
        if (wr == 1) PG8_BAR;
        PG8_WAIT_V(4); PG8_BAR;
        PG8_STAGE(PG8_SB(1, 0), cB + kstep, voffB); PG8_STAGE(PG8_SA(1, 0), cA + kstep, voffA); PG8_STAGE(PG8_SB(1, 1), cB + hstepB + kstep, voffB);
        PG8_WAIT_V(6); PG8_BAR;
    }
    for (;;) {
        const bool has_next = S.next(ui + 1, nxt);
        const char* nA = has_next ? (const char*)g.A + (size_t)nxt.pm * tstepA : cA; const char* nB = has_next ? (const char*)g.Bt + (size_t)nxt.pn * tstepB + (size_t)nxt.pm * bpm : cB;
        for (int t = 0; t < nt; t += 2) {
            const bool last = (t == nt - 2);
            const char* a1 = cA + (size_t)(t + 1) * kstep;
            const char* a2 = last ? nA : cA + (size_t)(t + 2) * kstep; const char* b2 = last ? nB : cB + (size_t)(t + 2) * kstep;
            const char* a3 = a2 + kstep; const char* b3 = b2 + kstep;
            if (last && has_next) S.a_ready(nxt);
            if constexpr (SP2) {
            PG8_LDB(B0, 0, 0); PG8_LDB(B1, 0, 1); PG8_SCHED; PG8_LDA(At, 0, 0); PG8_STAGE(PG8_SA(1, 1), a1 + hstepA, voffA);
            PG8_WAIT_V(8); PG8_WAIT_L(0); PG8_BAR; PG8_MMA(0, 0, At, B0); PG8_MMA(0, 1, At, B1); PG8_BAR; PG8_SCHED;
            PG8_LDA(At, 0, 1); PG8_STAGE(PG8_SB(0, 0), b2, voffB); PG8_STAGE(PG8_SB(0, 1), b2 + hstepB, voffB); PG8_STAGE(PG8_SA(0, 0), a2, voffA);
            PG8_WAIT_V(8); PG8_WAIT_L(0); PG8_BAR; PG8_MMA(1, 0, At, B0); PG8_MMA(1, 1, At, B1); PG8_BAR; PG8_SCHED;
            PG8_LDB(B0, 1, 0); PG8_LDB(B1, 1, 1); PG8_SCHED; PG8_LDA(At, 1, 0); PG8_STAGE(PG8_SA(0, 1), a2 + hstepA, voffA);
            PG8_WAIT_V(8); PG8_WAIT_L(0); PG8_BAR; PG8_MMA(0, 0, At, B0); PG8_MMA(0, 1, At, B1); PG8_BAR; PG8_SCHED;
            PG8_LDA(At, 1, 1); PG8_STAGE(PG8_SB(1, 0), b3, voffB); PG8_STAGE(PG8_SB(1, 1), b3 + hstepB, voffB); PG8_STAGE(PG8_SA(1, 0), a3, voffA);
            PG8_WAIT_V(8); PG8_WAIT_L(0); PG8_BAR; PG8_MMA(1, 0, At, B0); PG8_MMA(1, 1, At, B1); PG8_BAR; PG8_SCHED;
            } else {
            PG8_LDB(B0, 0, 0); PG8_SCHED; PG8_LDA(At, 0, 0); PG8_STAGE(PG8_SA(1, 1), a1 + hstepA, voffA);
            PG8_WAIT_L(8); PG8_BAR; PG8_WAIT_L(0); PG8_MMA(0, 0, At, B0); PG8_BAR; PG8_SCHED;
            PG8_LDB(B1, 0, 1); PG8_STAGE(PG8_SB(0, 0), b2, voffB);
            PG8_BAR; PG8_WAIT_L(0); PG8_MMA(0, 1, At, B1); PG8_BAR;
            PG8_LDA(At, 0, 1); PG8_STAGE(PG8_SA(0, 0), a2, voffA);
            PG8_BAR; PG8_WAIT_L(0); PG8_MMA(1, 0, At, B0); PG8_BAR; PG8_SCHED;
            PG8_STAGE(PG8_SB(0, 1), b2 + hstepB, voffB);
            PG8_WAIT_V(6); PG8_BAR; PG8_MMA(1, 1, At, B1); PG8_BAR;
            PG8_LDB(B0, 1, 0); PG8_SCHED; PG8_LDA(At, 1, 0); PG8_STAGE(PG8_SA(0, 1), a2 + hstepA, voffA);
            PG8_WAIT_L(8); PG8_BAR; PG8_WAIT_L(0); PG8_MMA(0, 0, At, B0); PG8_BAR; PG8_SCHED;
            PG8_LDB(B1, 1, 1); PG8_STAGE(PG8_SB(1, 0), b3, voffB);
            PG8_BAR; PG8_WAIT_L(0); PG8_MMA(0, 1, At, B1); PG8_BAR;
            PG8_LDA(At, 1, 1); PG8_STAGE(PG8_SA(1, 0), a3, voffA);
            PG8_BAR; PG8_WAIT_L(0); PG8_MMA(1, 0, At, B0); PG8_BAR; PG8_SCHED;
            PG8_STAGE(PG8_SB(1, 1), b3 + hstepB, voffB);
            PG8_WAIT_V(6); PG8_BAR; PG8_MMA(1, 1, At, B1); PG8_BAR;
            }
        }
        if constexpr (ALIGN_EPI) { if (wr == 0) PG8_BAR; }
        if constexpr (!Epi::AFTER_DRAIN) { E(acc, cur, wr, wc, fr, fq); S.done(cur); }
        if (!has_next) break;
#pragma unroll
        for (int a = 0; a < 2; ++a)
#pragma unroll
            for (int b = 0; b < 2; ++b)
#pragma unroll
                for (int m = 0; m < 4; ++m)
#pragma unroll
                    for (int n = 0; n < 2; ++n) acc[a][b][m][n] = (f32x4){0.f, 0.f, 0.f, 0.f};
        cur = nxt; cA = nA; cB = nB; ++ui;
        if constexpr (ALIGN_EPI) { if (wr == 1) PG8_BAR; }
    }
    PG8_WAIT_V(0);
    if constexpr (!ALIGN_EPI) { if (wr == 0) PG8_BAR; }
    PG8_BAR;
    if constexpr (Epi::AFTER_DRAIN) { E.fused(acc, cur, wr, wc, fr, fq, lds, wid, lane); S.done(cur); }
#undef PG8_SA
#undef PG8_SB
#undef PG8_STAGE
#undef PG8_LDA
#undef PG8_LDB
#undef PG8_MMA
#undef PG8_WAIT_V
#undef PG8_WAIT_L
#undef PG8_BAR
#undef PG8_SCHED
}
}

namespace attn {
using bf16 = unsigned short;
constexpr int   D = 128, NW = 8, QBLK = 32, KVBLK = 64;
constexpr float SCALE = 0.088388347648318440f;
constexpr float THR = 8.f;
constexpr int SDEPTH = 2;
constexpr int LDQ = P0W, LDK = P0W, LDO = 2048;
constexpr size_t SHM_V = KVBLK * D * 2, SHM_K = KVBLK * D * 2, SHM_ATTN = 2 * SHM_V + 2 * SHM_K + NW * 64 * 4;
using bf16x8 = __attribute__((ext_vector_type(8))) short;
using s16x4  = __attribute__((ext_vector_type(4))) short;
using f32x16 = __attribute__((ext_vector_type(16))) float;
using f32x8  = __attribute__((ext_vector_type(8))) float;
using u32x4  = __attribute__((ext_vector_type(4))) unsigned;
#define KSWZ(row, colB) ((row) * 256 + ((colB) ^ (((row) & 7) << 4)))
#define SBAR() __builtin_amdgcn_sched_barrier(0)
__device__ __forceinline__ int crow(int r, int hi) { return (r & 3) + 8 * (r >> 2) + 4 * hi; }
__device__ __forceinline__ unsigned cvtpk(float lo, float hi) {
  unsigned r; asm volatile("v_cvt_pk_bf16_f32 %0, %1, %2" : "=v"(r) : "v"(lo), "v"(hi)); return r;
}
template <typename TIn> struct Stage;
template <> struct Stage<bf16>  { using T = bf16x8;
  __device__ static __forceinline__ T ld8(const bf16* p) { return *reinterpret_cast<const bf16x8*>(p); }
  __device__ static __forceinline__ bf16x8 tobf(T x) { return x; } };
template <> struct Stage<float> { using T = f32x8;
  __device__ static __forceinline__ T ld8(const float* p) { return *reinterpret_cast<const f32x8*>(p); }
  __device__ static __forceinline__ bf16x8 tobf(T x) {
    u32x4 w = {cvtpk(x[0], x[1]), cvtpk(x[2], x[3]), cvtpk(x[4], x[5]), cvtpk(x[6], x[7])}; return *reinterpret_cast<bf16x8*>(&w); } };

__device__ __forceinline__ void partialSM(f32x16& p0, f32x16& p1, float& m_reg, float& mn, float& alpha) {
  constexpr float C = SCALE * 1.4426950408889634f;
  float pmax = p0[0]; for (int r = 1; r < 16; ++r) pmax = fmaxf(pmax, p0[r]); for (int r = 0; r < 16; ++r) pmax = fmaxf(pmax, p1[r]);
  { auto rr = __builtin_amdgcn_permlane32_swap(__float_as_uint(pmax), __float_as_uint(pmax), false, false);
    pmax = fmaxf(__uint_as_float(rr[0]), __uint_as_float(rr[1])); }
  if (__builtin_expect(__all(pmax - m_reg <= THR / SCALE), 1)) { mn = m_reg; alpha = 1.f; }
  else { mn = fmaxf(m_reg, pmax); alpha = __builtin_amdgcn_exp2f((m_reg - mn) * C); m_reg = mn; }
  float mnC = -mn * C;
  for (int r = 0; r < 16; ++r) p0[r] = fmaf(p0[r], C, mnC); for (int r = 0; r < 16; ++r) p1[r] = fmaf(p1[r], C, mnC);
  for (int r = 0; r < 16; ++r) p0[r] = __builtin_amdgcn_exp2f(p0[r]);
}
__device__ __forceinline__ void finishSM(f32x16& p0, f32x16& p1, float alpha, float& l_reg, bf16x8& pa0, bf16x8& pa1, bf16x8& pa2, bf16x8& pa3) {
  for (int r = 0; r < 16; ++r) p1[r] = __builtin_amdgcn_exp2f(p1[r]);
  float ps = 0; for (int r = 0; r < 16; ++r) ps += p0[r]; for (int r = 0; r < 16; ++r) ps += p1[r];
  { auto rr = __builtin_amdgcn_permlane32_swap(__float_as_uint(ps), __float_as_uint(ps), false, false);
    ps = __uint_as_float(rr[0]) + __uint_as_float(rr[1]); }
  l_reg = l_reg * alpha + ps;
#define PK4(P, BASE, OUT) do { unsigned a0 = cvtpk(P[BASE + 0], P[BASE + 1]), a1 = cvtpk(P[BASE + 2], P[BASE + 3]);   \
    unsigned b0 = cvtpk(P[BASE + 4], P[BASE + 5]), b1 = cvtpk(P[BASE + 6], P[BASE + 7]);                              \
    auto r0 = __builtin_amdgcn_permlane32_swap(a0, b0, false, false); auto r1 = __builtin_amdgcn_permlane32_swap(a1, b1, false, false); \
    u32x4 w = {r0[0], r1[0], r0[1], r1[1]}; OUT = *reinterpret_cast<bf16x8*>(&w); } while (0)
  PK4(p0, 0, pa0); PK4(p0, 8, pa1); PK4(p1, 0, pa2); PK4(p1, 8, pa3);
#undef PK4
}
__device__ __forceinline__ void qkt(f32x16& p0, f32x16& p1, const bf16* Ks, const bf16x8* qr, int r32, int hi) {
  p0 = f32x16{}; p1 = f32x16{};
  for (int d0 = 0; d0 < 8; ++d0) { int cb = (d0 * 16 + hi * 8) * 2;
    bf16x8 b0 = *reinterpret_cast<const bf16x8*>((const char*)Ks + KSWZ(r32, cb));
    bf16x8 b1 = *reinterpret_cast<const bf16x8*>((const char*)Ks + KSWZ(32 + r32, cb));
    p0 = __builtin_amdgcn_mfma_f32_32x32x16_bf16(b0, qr[d0], p0, 0, 0, 0);
    p1 = __builtin_amdgcn_mfma_f32_32x32x16_bf16(b1, qr[d0], p1, 0, 0, 0); }
}
__device__ __forceinline__ int v_st(int k, int c) { const int kk = (k & ~0xC) | ((k & 4) << 1) | ((k & 8) >> 1); return ((kk >> 3) * 4 + (c >> 5)) * 512 + ((kk & 7) * 32 + (c & 31)) * 2; }
__device__ __forceinline__ int v_rd_base(int lane) { return ((lane & 3) << 3) | (((lane >> 2) & 3) << 6) | (((lane >> 4) & 1) << 5) | (((lane >> 5) & 1) << 8); }
constexpr int v_rd_off(int d0, int ks, int half) { return d0 * 512 + ks * 4096 + half * 2048; }
template <int OFF> __device__ __forceinline__ s16x4 tr_read(int vb) {
  s16x4 r; asm volatile("ds_read_b64_tr_b16 %0, %1 offset:%2" : "=&v"(r) : "v"(vb), "i"(OFF) : "memory"); return r;
}
template <int D0> __device__ __forceinline__ void pv_one(f32x16& od, int vb, bf16x8 pa0, bf16x8 pa1, bf16x8 pa2, bf16x8 pa3) {
  const s16x4 l0 = tr_read<v_rd_off(D0, 0, 0)>(vb), h0 = tr_read<v_rd_off(D0, 0, 1)>(vb), l1 = tr_read<v_rd_off(D0, 1, 0)>(vb), h1 = tr_read<v_rd_off(D0, 1, 1)>(vb);
  const s16x4 l2 = tr_read<v_rd_off(D0, 2, 0)>(vb), h2 = tr_read<v_rd_off(D0, 2, 1)>(vb), l3 = tr_read<v_rd_off(D0, 3, 0)>(vb), h3 = tr_read<v_rd_off(D0, 3, 1)>(vb);
  asm volatile("s_waitcnt lgkmcnt(0)" ::: "memory"); SBAR();
#define PK(L, H) (bf16x8){L[0], L[1], L[2], L[3], H[0], H[1], H[2], H[3]}
  od = __builtin_amdgcn_mfma_f32_32x32x16_bf16(pa0, PK(l0, h0), od, 0, 0, 0);
  od = __builtin_amdgcn_mfma_f32_32x32x16_bf16(pa1, PK(l1, h1), od, 0, 0, 0);
  od = __builtin_amdgcn_mfma_f32_32x32x16_bf16(pa2, PK(l2, h2), od, 0, 0, 0);
  od = __builtin_amdgcn_mfma_f32_32x32x16_bf16(pa3, PK(l3, h3), od, 0, 0, 0);
#undef PK
}
__device__ __forceinline__ void pv_d0(f32x16* o, int vb, bf16x8 pa0, bf16x8 pa1, bf16x8 pa2, bf16x8 pa3) {
  pv_one<0>(o[0], vb, pa0, pa1, pa2, pa3); pv_one<1>(o[1], vb, pa0, pa1, pa2, pa3); pv_one<2>(o[2], vb, pa0, pa1, pa2, pa3); pv_one<3>(o[3], vb, pa0, pa1, pa2, pa3);
}

template <typename TQ>
__device__ __forceinline__ void attn_dense_body(const TQ* __restrict__ Qb, const bf16* __restrict__ Kh, const bf16* __restrict__ Vh,
                                                bf16* __restrict__ Ob, int seq, char* lds) {
  using St = Stage<bf16>; using SQ = Stage<TQ>;
  int tid_ = threadIdx.x; asm volatile("" : "+v"(tid_));
  const int tid = tid_, wid = tid >> 6, lane = tid & 63, r32 = lane & 31, hi = lane >> 5;
  bf16* V_lds = (bf16*)lds; bf16* K_lds = (bf16*)(lds + 2 * SHM_V);
  float* ws = (float*)(lds + 2 * SHM_V + 2 * SHM_K) + wid * 64; float* li_l = ws; float* al_l = ws + 32;
  float m_reg = -1e30f, l_reg = 0; f32x16 o[4] = {}; bf16x8 qr[8];
  const TQ* Qw = Qb + (long)(wid * QBLK + r32) * LDQ + hi * 8;
#pragma unroll
  for (int d0 = 0; d0 < 8; ++d0) qr[d0] = SQ::tobf(SQ::ld8(Qw + d0 * 16));
  const int sr = tid >> 4, sc = (tid & 15) * 8, vst0 = v_st(sr, sc), vst1 = v_st(32 + sr, sc);
  const int vb0 = (int)(uintptr_t)V_lds + v_rd_base(lane);
  struct { typename St::T vs0, vs1, ks0, ks1; } sr_[SDEPTH];
#define SLOAD(i, k0) do { sr_[i].vs0 = St::ld8(&Vh[(long)((k0) + sr) * LDK + sc]); sr_[i].vs1 = St::ld8(&Vh[(long)((k0) + 32 + sr) * LDK + sc]); \
    sr_[i].ks0 = St::ld8(&Kh[(long)((k0) + sr) * LDK + sc]); sr_[i].ks1 = St::ld8(&Kh[(long)((k0) + 32 + sr) * LDK + sc]); } while (0)
#define SWRITE(b, i) do { *(bf16x8*)((char*)V_lds + (b) * SHM_V + vst0) = St::tobf(sr_[i].vs0);          \
    *(bf16x8*)((char*)V_lds + (b) * SHM_V + vst1) = St::tobf(sr_[i].vs1); int kc = sc * 2;               \
    *(bf16x8*)((char*)K_lds + (b) * SHM_K + KSWZ(sr, kc)) = St::tobf(sr_[i].ks0);                       \
    *(bf16x8*)((char*)K_lds + (b) * SHM_K + KSWZ(32 + sr, kc)) = St::tobf(sr_[i].ks1); } while (0)
#define SWAIT() do { if constexpr (SDEPTH == 2) asm volatile("s_waitcnt vmcnt(4)" ::: "memory"); else asm volatile("s_waitcnt vmcnt(0)" ::: "memory"); } while (0)
#define RESC(a) do { if (__any((a) < 1.f)) { if (hi == 0) al_l[r32] = (a); asm volatile("s_waitcnt lgkmcnt(0)" ::: "memory"); \
    for (int d = 0; d < 4; ++d) for (int r = 0; r < 16; ++r) o[d][r] *= al_l[crow(r, hi)]; } } while (0)
  f32x16 pA0, pA1, pB0, pB1; float mnA, mnB, alA, alB; bf16x8 pa0, pa1, pa2, pa3; const int NT = seq / KVBLK;
  constexpr int SE = 0, SO = SDEPTH - 1;
  SLOAD(SE, 0); asm volatile("s_waitcnt vmcnt(0)" ::: "memory"); SWRITE(0, SE); __syncthreads();
  qkt(pA0, pA1, K_lds, qr, r32, hi); partialSM(pA0, pA1, m_reg, mnA, alA);
  SLOAD(SO, KVBLK); if constexpr (SDEPTH == 2) { if (2 < NT) SLOAD(SE, 2 * KVBLK); }
  SWAIT(); SWRITE(1, SO); __syncthreads();
  for (int j = 1; j + 1 < NT; j += 2) {
    SBAR(); qkt(pB0, pB1, (bf16*)((char*)K_lds + SHM_K), qr, r32, hi);
    finishSM(pA0, pA1, alA, l_reg, pa0, pa1, pa2, pa3); SBAR();
    SLOAD(SO, (j + SDEPTH) * KVBLK); SBAR();
    pv_d0(o, vb0, pa0, pa1, pa2, pa3); partialSM(pB0, pB1, m_reg, mnB, alB);
    __syncthreads(); SWAIT(); SWRITE(0, SE);
    RESC(alB); __syncthreads();
    SBAR(); qkt(pA0, pA1, K_lds, qr, r32, hi);
    finishSM(pB0, pB1, alB, l_reg, pa0, pa1, pa2, pa3); SBAR();
    if (SDEPTH == 1 || j + 3 < NT) SLOAD(SE, (j + 1 + SDEPTH) * KVBLK); SBAR();
    pv_d0(o, vb0 + (int)SHM_V, pa0, pa1, pa2, pa3); partialSM(pA0, pA1, m_reg, mnA, alA);
    __syncthreads(); SWAIT(); SWRITE(1, SO);
    RESC(alA); __syncthreads();
  }
  SBAR(); qkt(pB0, pB1, (bf16*)((char*)K_lds + SHM_K), qr, r32, hi);
  finishSM(pA0, pA1, alA, l_reg, pa0, pa1, pa2, pa3); SBAR();
  pv_d0(o, vb0, pa0, pa1, pa2, pa3); partialSM(pB0, pB1, m_reg, mnB, alB);
  __syncthreads(); RESC(alB);
  finishSM(pB0, pB1, alB, l_reg, pa0, pa1, pa2, pa3); SBAR();
  pv_d0(o, vb0 + (int)SHM_V, pa0, pa1, pa2, pa3);
  if (hi == 0) li_l[r32] = l_reg; asm volatile("s_waitcnt lgkmcnt(0)" ::: "memory");
  float rli[16];
#pragma unroll
  for (int r = 0; r < 16; ++r) rli[r] = __builtin_amdgcn_rcpf(li_l[crow(r, hi)]);
  bf16* Ow = Ob + (long)(wid * QBLK) * LDO;
#pragma unroll
  for (int r = 0; r < 16; ++r) { int orow = crow(r, hi);
    for (int d0 = 0; d0 < 4; ++d0) Ow[(long)orow * LDO + d0 * 32 + r32] = (bf16)(cvtpk(o[d0][r] * rli[r], 0.f) & 0xffffu); }
#undef SLOAD
#undef SWRITE
#undef SWAIT
#undef RESC
}
#undef KSWZ
#undef SBAR
}

namespace rw {
typedef short bf16x8 __attribute__((ext_vector_type(8)));
typedef float f32x4 __attribute__((ext_vector_type(4)));
typedef unsigned u32x4 __attribute__((ext_vector_type(4)));
typedef unsigned u32x2 __attribute__((ext_vector_type(2)));
constexpr int CH = 32, NC = R / CH;
static_assert(NC % 2 == 0, "the prep loop is unrolled by two");
constexpr int BUFB = 5 * 8192 + 1024;
constexpr int O_W = 0, O_B = 8192, O_KD = 16384, O_A = 24576, O_R = 32768, O_V = 40960;
constexpr int PITCH = 72;
constexpr int L_SCR = 2 * BUFB, SCRB = 2 * 16 * PITCH * 2;
constexpr int L_W2T = L_SCR + 4 * SCRB, L_A2T = L_W2T + 64 * PITCH * 2;
constexpr int L_Y = L_A2T + 64 * PITCH * 2;
constexpr int L_CST = L_Y + 2 * 2 * CH * 64 * 4;
constexpr int L_END = L_CST + 10 * 64 * 4;
static_assert(L_END <= 163840 - 64 && (BUFB % 16) == 0 && (L_SCR % 16) == 0 && (SCRB % 16) == 0 && (L_W2T % 16) == 0 && (L_A2T % 16) == 0 && (L_Y % 16) == 0 && (L_CST % 16) == 0, "rwkv LDS map");
constexpr size_t WS_BON = 38 * MiB;

template <int CTRL> __device__ __forceinline__ float dppmov(float x) { return __builtin_bit_cast(float, __builtin_amdgcn_update_dpp(0, __builtin_bit_cast(int, x), CTRL, 0xF, 0xF, true)); }
__device__ __forceinline__ float allreduce8(float x) {
    x += dppmov<0xB1>(x);
    x += dppmov<0x4E>(x);
    x += dppmov<0x141>(x);
    return x;
}
__device__ __forceinline__ float allreduce16(float x) { x = allreduce8(x); x += dppmov<0x140>(x); return x; }
__device__ __forceinline__ float fast_tanh(float x) { const float e = __builtin_amdgcn_exp2f(2.885390081777927f * x); return 1.0f - 2.0f * __builtin_amdgcn_rcpf(1.0f + e); }
__device__ __forceinline__ float bflo(unsigned u) { return __uint_as_float(u << 16); }
__device__ __forceinline__ float bfhi(unsigned u) { return __uint_as_float(u & 0xffff0000u); }
__device__ __forceinline__ unsigned pkbf(float lo, float hi) { unsigned r; asm volatile("v_cvt_pk_bf16_f32 %0, %1, %2" : "=v"(r) : "v"(lo), "v"(hi)); return r; }

constexpr int SEGR = 128, NSEG = R / SEGR, NCG = (ZW + 511) / 512;
constexpr size_t WS_HALO = 40 * MiB;
static_assert(WS_HALO + (size_t)NSEG * 2 * ZW * 2 <= WS_XN, "halo rows overflow");
__device__ __forceinline__ void shift_halo(const Params& p) {
    int tid_ = threadIdx.x; asm volatile("" : "+v"(tid_));
    const bf16_t* Z = ws_big(p); bf16_t* H = (bf16_t*)(p.ws + WS_HALO);
    for (int it = (int)blockIdx.x * NTHR + tid_; it < NSEG * 2 * (ZW / 8); it += (int)gridDim.x * NTHR) {
        const int c8 = it % (ZW / 8), w = (it / (ZW / 8)) & 1, seg = it / (2 * (ZW / 8));
        *(u32x4*)(H + ((size_t)seg * 2 + w) * ZW + c8 * 8) = *(const u32x4*)(Z + (size_t)(seg * SEGR + (w ? SEGR - 1 : 0)) * ZW + c8 * 8);
    }
}
__device__ __forceinline__ u32x4 shift8(u32x4 c, u32x4 pv, u32x4 nx, f32x4 m0, f32x4 m1) {
    u32x4 o;
#pragma unroll
    for (int q = 0; q < 4; ++q) { const float ml = q < 2 ? m0[2 * q] : m1[2 * q - 4], mh = q < 2 ? m0[2 * q + 1] : m1[2 * q - 3];
        const float zl = bflo(c[q]), zh = bfhi(c[q]);
        o[q] = pkbf(zl + (0.5f * (bflo(pv[q]) + bflo(nx[q])) - zl) * ml, zh + (0.5f * (bfhi(pv[q]) + bfhi(nx[q])) - zh) * mh); }
    return o;
}
__device__ __forceinline__ void shift_inplace(const Params& p) {
    int tid_ = threadIdx.x; asm volatile("" : "+v"(tid_));
    const int lane = tid_ & 63, gw = (int)blockIdx.x * NWAVES + (tid_ >> 6), ngw = (int)gridDim.x * NWAVES;
    bf16_t* Z = ws_big(p); const bf16_t* H = (const bf16_t*)(p.ws + WS_HALO);
    for (int u = gw; u < NSEG * NCG; u += ngw) {
        const int seg = u / NCG, col = (u % NCG) * 512 + lane * 8;
        if (col < ZW) {
            const f32x4 m0 = *(const f32x4*)(p.mu + col), m1 = *(const f32x4*)(p.mu + col + 4);
            const bool first = seg == 0 || seg == CTXN / SEGR, last = seg == CTXN / SEGR - 1 || seg == NSEG - 1;
            bf16_t* zr = Z + (size_t)seg * SEGR * ZW + col;
            u32x4 pv = first ? (u32x4){0u, 0u, 0u, 0u} : *(const u32x4*)(H + ((size_t)(seg - 1) * 2 + 1) * ZW + col);
            const u32x4 tail = last ? (u32x4){0u, 0u, 0u, 0u} : *(const u32x4*)(H + ((size_t)(seg + 1) * 2) * ZW + col);
            u32x4 c0 = *(const u32x4*)zr, c1 = *(const u32x4*)(zr + ZW), c2 = *(const u32x4*)(zr + 2 * ZW), c3 = *(const u32x4*)(zr + 3 * ZW);
            for (int r = 0; r < SEGR; r += 4) {
                u32x4 n0 = tail, n1 = tail, n2 = tail, n3 = tail;
                if (r + 4 < SEGR) { n0 = *(const u32x4*)(zr + (size_t)(r + 4) * ZW); n1 = *(const u32x4*)(zr + (size_t)(r + 5) * ZW); n2 = *(const u32x4*)(zr + (size_t)(r + 6) * ZW); n3 = *(const u32x4*)(zr + (size_t)(r + 7) * ZW); }
                const u32x4 o0 = shift8(c0, pv, c1, m0, m1), o1 = shift8(c1, c0, c2, m0, m1), o2 = shift8(c2, c1, c3, m0, m1), o3 = shift8(c3, c2, n0, m0, m1);
                *(u32x4*)(zr + (size_t)r * ZW) = o0; *(u32x4*)(zr + (size_t)(r + 1) * ZW) = o1; *(u32x4*)(zr + (size_t)(r + 2) * ZW) = o2; *(u32x4*)(zr + (size_t)(r + 3) * ZW) = o3;
                pv = c3; c0 = n0; c1 = n1; c2 = n2; c3 = n3;
            }
        }
    }
}

struct Raw { u32x4 c[5]; };

template <int MODE> __device__ __forceinline__ void scan_block(const Params& p, int blk, LAS unsigned char* lds) {
    int tid_ = threadIdx.x; asm volatile("" : "+v"(tid_));
    const int tid = tid_, lane = tid & 63, wave = __builtin_amdgcn_readfirstlane(tid >> 6);
    const int dir = blk >> 7, h = (blk >> 3) & 15, eighth = blk & 7;
    const float* w0 = dir ? p.w0b : p.w0f; const float* w2 = dir ? p.w2b : p.w2f; const float* a0 = dir ? p.a0b : p.a0f; const float* a2 = dir ? p.a2b : p.a2f;
    const bf16_t* Z = ws_big(p); bf16_t* BR = ws_br(p); float* bon = (float*)(p.ws + WS_BON) + ((size_t)dir * 16 + h) * SEQ;
    { const int m = tid >> 3, j8 = (tid & 7) * 8;
      const f32x4 wa = *(const f32x4*)(w2 + (size_t)m * 1024 + h * 64 + j8), wb = *(const f32x4*)(w2 + (size_t)m * 1024 + h * 64 + j8 + 4);
      const f32x4 aa = *(const f32x4*)(a2 + (size_t)m * 1024 + h * 64 + j8), ab = *(const f32x4*)(a2 + (size_t)m * 1024 + h * 64 + j8 + 4);
      LAS bf16_t* yw = (LAS bf16_t*)(lds + L_W2T); LAS bf16_t* ya = (LAS bf16_t*)(lds + L_A2T);
#pragma unroll
      for (int q = 0; q < 4; ++q) { yw[(j8 + q) * PITCH + m] = f2bf(wa[q]); yw[(j8 + 4 + q) * PITCH + m] = f2bf(wb[q]); ya[(j8 + q) * PITCH + m] = f2bf(aa[q]); ya[(j8 + 4 + q) * PITCH + m] = f2bf(ab[q]); }
      for (int i = tid; i < 4 * SCRB / 4; i += NTHR) *(LAS unsigned*)(lds + L_SCR + i * 4) = 0u;
      for (int i = tid; i < 640; i += NTHR) { const int g = i >> 6, cc = i & 63, hc = h * 64 + cc; float v;
          if (g < 3) v = p.mu[g * 1024 + hc]; else if (g == 3) v = p.mu[3072 + dir * 64 + cc]; else if (g == 4) v = p.mu[3200 + dir * 64 + cc];
          else if (g == 5) v = w0[hc]; else if (g == 6) v = a0[hc]; else if (g == 7) v = p.k_k[hc]; else if (g == 8) v = p.k_a[hc]; else v = p.r_k[hc];
          *(LAS float*)(lds + L_CST + i * 4) = v; } }
    __syncthreads();
    if ((wave & 2) != 0) {
        const int pw = (wave & 1) + ((wave >> 2) << 1), tq = lane >> 3, c8 = (lane & 7) * 8, hj = h * 64 + c8, tslot = pw * 8 + tq;
        const int gcol[5] = {hj, 1024 + hj, 2048 + hj, 3072 + dir * 64 + c8, 3200 + dir * 64 + c8};
        LAS unsigned char* scr = lds + L_SCR + pw * SCRB;
#define RW_CST(g, hh) (*(LAS f32x4*)(lds + L_CST + ((g) * 64 + c8 + 4 * (hh)) * 4))
#define RW_LOADRAW(raw, cc) do { const bf16_t* zr_ = Z + (size_t)rw_row(dir, (cc) * CH + tslot) * ZW; \
            _Pragma("unroll") for (int g = 0; g < 5; ++g) raw.c[g] = *(const u32x4*)(zr_ + gcol[g]); } while (0)
        Raw rawA, rawB;
        f32x4 cw0[2], ca0[2], ckk[2], cka[2], crk[2];
#pragma unroll
        for (int hh = 0; hh < 2; ++hh) { cw0[hh] = RW_CST(5, hh); ca0[hh] = RW_CST(6, hh); ckk[hh] = RW_CST(7, hh); cka[hh] = RW_CST(8, hh); crk[hh] = RW_CST(9, hh);
            asm volatile("" : "+v"(cw0[hh]), "+v"(ca0[hh]), "+v"(ckk[hh]), "+v"(cka[hh]), "+v"(crk[hh])); }
        if (MODE == 0 || MODE == 2 || MODE == 3 || MODE == 9) { RW_LOADRAW(rawA, 0); RW_LOADRAW(rawB, 1); }
#define RW_PREP_ITER(RAWSET, cc_) do { \
            if (MODE == 0 || MODE == 2 || MODE == 3 || MODE == 9) { \
            const int cn = (cc_) + 1; LAS unsigned char* buf = lds + (cn & 1) * BUFB; const int p0 = cn * CH; const bool latent = p0 >= CTXN; \
            f32x4 rr[2], kv[2]; \
            { const u32x4 u = RAWSET.c[0]; rr[0] = (f32x4){bflo(u.x), bfhi(u.x), bflo(u.y), bfhi(u.y)}; rr[1] = (f32x4){bflo(u.z), bfhi(u.z), bflo(u.w), bfhi(u.w)}; \
              *(LAS f32x4*)(buf + O_R + (tslot * 64 + c8) * 4) = rr[0]; *(LAS f32x4*)(buf + O_R + (tslot * 64 + c8) * 4 + 16) = rr[1]; } \
            { const u32x4 u = RAWSET.c[1]; kv[0] = (f32x4){bflo(u.x), bfhi(u.x), bflo(u.y), bfhi(u.y)}; kv[1] = (f32x4){bflo(u.z), bfhi(u.z), bflo(u.w), bfhi(u.w)}; } \
            if ((lane & 7) == eighth) { const u32x4 u = RAWSET.c[2]; *(LAS f32x4*)(buf + O_V + tslot * 32) = (f32x4){bflo(u.x), bfhi(u.x), bflo(u.y), bfhi(u.y)}; *(LAS f32x4*)(buf + O_V + tslot * 32 + 16) = (f32x4){bflo(u.z), bfhi(u.z), bflo(u.w), bfhi(u.w)}; } \
            { const u32x4 u = RAWSET.c[3]; u32x4 o; \
              o.x = pkbf(fast_tanh(bflo(u.x)), fast_tanh(bfhi(u.x))); o.y = pkbf(fast_tanh(bflo(u.y)), fast_tanh(bfhi(u.y))); o.z = pkbf(fast_tanh(bflo(u.z)), fast_tanh(bfhi(u.z))); o.w = pkbf(fast_tanh(bflo(u.w)), fast_tanh(bfhi(u.w))); \
              *(LAS u32x4*)(scr + (tq * PITCH + c8) * 2) = o; *(LAS u32x4*)(scr + 16 * PITCH * 2 + (tq * PITCH + c8) * 2) = RAWSET.c[4]; } \
            if (cn + 2 < NC) RW_LOADRAW(RAWSET, cn + 2);              \
            asm volatile("s_waitcnt lgkmcnt(0)" ::: "memory"); \
            { const int r16 = lane & 15, quad = lane >> 4; f32x4 acc[2][4]; \
_Pragma("unroll") \
              for (int lora = 0; lora < 2; ++lora) { \
                  LAS unsigned char* X = scr + lora * 16 * PITCH * 2 + (r16 * PITCH + quad * 8) * 2; \
                  const bf16x8 x0 = *(LAS bf16x8*)X, x1 = *(LAS bf16x8*)(X + 64); \
_Pragma("unroll") \
                  for (int jt = 0; jt < 4; ++jt) { \
                      LAS unsigned char* Y = lds + (lora ? L_A2T : L_W2T) + ((jt * 16 + r16) * PITCH + quad * 8) * 2; \
                      acc[lora][jt] = (f32x4){0.f, 0.f, 0.f, 0.f}; \
                      acc[lora][jt] = __builtin_amdgcn_mfma_f32_16x16x32_bf16(x0, *(LAS bf16x8*)Y, acc[lora][jt], 0, 0, 0); \
                      acc[lora][jt] = __builtin_amdgcn_mfma_f32_16x16x32_bf16(x1, *(LAS bf16x8*)(Y + 64), acc[lora][jt], 0, 0, 0); } } \
              if (quad < 2) { \
_Pragma("unroll") \
                  for (int lora = 0; lora < 2; ++lora) \
_Pragma("unroll") \
                      for (int jt = 0; jt < 4; ++jt) \
_Pragma("unroll") \
                          for (int r = 0; r < 4; ++r) *(LAS float*)(buf + (lora ? O_B : O_W) + ((pw * 8 + quad * 4 + r) * 64 + jt * 16 + r16) * 4) = acc[lora][jt][r]; } } \
            asm volatile("s_waitcnt lgkmcnt(0)" ::: "memory"); \
            { float bs = 0.f, nn = 0.f; f32x4 kk[2], al[2]; \
_Pragma("unroll") \
              for (int hh = 0; hh < 2; ++hh) { const int off = (tslot * 64 + c8 + 4 * hh) * 4; \
                  const f32x4 aw = *(LAS f32x4*)(buf + O_W + off) + cw0[hh], aa = *(LAS f32x4*)(buf + O_B + off) + ca0[hh]; \
                  f32x4 wv; \
_Pragma("unroll") \
                  for (int q = 0; q < 4; ++q) { const float sg = __builtin_amdgcn_rcpf(1.0f + __builtin_amdgcn_exp2f(-1.4426950408889634f * aw[q])); \
                      wv[q] = __builtin_amdgcn_exp2f(-0.8750612633917f * sg); al[hh][q] = __builtin_amdgcn_rcpf(1.0f + __builtin_amdgcn_exp2f(-1.4426950408889634f * aa[q])); kk[hh][q] = kv[hh][q] * ckk[hh][q]; nn += kk[hh][q] * kk[hh][q]; } \
                  *(LAS f32x4*)(buf + O_W + off) = wv; } \
              nn = allreduce8(nn); \
              const float inv = __builtin_amdgcn_rsqf(fmaxf(nn, 1e-24f)); \
_Pragma("unroll") \
              for (int hh = 0; hh < 2; ++hh) { const int off = (tslot * 64 + c8 + 4 * hh) * 4; \
                  const f32x4 r = rr[hh]; \
                  f32x4 av, bv, kd; \
_Pragma("unroll") \
                  for (int q = 0; q < 4; ++q) { const float kn = kk[hh][q] * inv; av[q] = -kn; bv[q] = kn * al[hh][q]; kd[q] = kv[hh][q] * (1.0f + (al[hh][q] - 1.0f) * cka[hh][q]); bs += r[q] * kd[q] * crk[hh][q]; } \
                  *(LAS f32x4*)(buf + O_B + off) = bv; *(LAS f32x4*)(buf + O_KD + off) = kd; *(LAS f32x4*)(buf + O_A + off) = av; } \
              bs = allreduce8(bs); \
              if (MODE == 0 && latent && eighth == 0 && (lane & 7) == 0) bon[rw_row(dir, p0 + tslot) - CTXN] = bs; } \
            } \
            __syncthreads(); \
        } while (0)
        for (int c = -1; c < NC - 1; c += 2) { RW_PREP_ITER(rawA, c); RW_PREP_ITER(rawB, c + 1); }
#undef RW_PREP_ITER
#undef RW_LOADRAW
#undef RW_CST
    } else if (wave >= 4) {
        const int sw = wave - 4, et = lane >> 1, erp = lane & 1;
#define RW_EMIT(cc) do { if ((cc) * CH >= CTXN) { const LAS f32x4* yp = (const LAS f32x4*)(lds + L_Y + ((((cc) & 1) * 2 + sw) * 8192) + et * 256 + erp * 128); \
            f32x4 s0 = yp[0] + yp[1] + yp[2] + yp[3], s1 = yp[4] + yp[5] + yp[6] + yp[7]; \
            *(unsigned*)(BR + (size_t)rw_row(dir, (cc) * CH + et) * 2048 + dir * 1024 + h * 64 + eighth * 8 + sw * 4 + erp * 2) = pkbf((s0[0] + s0[1]) + (s0[2] + s0[3]), (s1[0] + s1[1]) + (s1[2] + s1[3])); } } while (0)
        __syncthreads();
        for (int c = 0; c < NC; ++c) { if (c >= 1) RW_EMIT(c - 1); if (c + 1 < NC) __syncthreads(); }
    } else {
        __builtin_amdgcn_s_setprio(0);
        typedef float f32x2 __attribute__((ext_vector_type(2)));
        f32x2 S01 = {0.f, 0.f}, S23 = {0.f, 0.f};
        const int srow = wave * 4 + (lane >> 4), sj = (lane & 15) * 4;
        __syncthreads();
        struct Ops { f32x4 a, w, b, k, r; float v; };
#define RW_LD(o, t) do { o.a = *(LAS f32x4*)(bp + O_A + (t) * 256); \
            if (MODE == 9) { o.w = o.a; o.b = o.a; o.k = o.a; o.r = o.a; o.v = o.a[0]; } else { o.w = *(LAS f32x4*)(bp + O_W + (t) * 256); o.b = *(LAS f32x4*)(bp + O_B + (t) * 256); \
            o.k = *(LAS f32x4*)(bp + O_KD + (t) * 256); o.r = *(LAS f32x4*)(bp + O_R + (t) * 256); o.v = *(LAS float*)(vp + (t) * 32); } } while (0)
#define RW_STEP(o, t) do { f32x2 pd = S01 * o.a.lo; pd = S23 * o.a.hi + pd; float sa = pd.x + pd.y; if (MODE != 5 && MODE != 7) sa = allreduce16(sa); \
            S01 = o.b.lo * sa + (S01 * o.w.lo + o.k.lo * o.v); S23 = o.b.hi * sa + (S23 * o.w.hi + o.k.hi * o.v); \
            { f32x2 py = S01 * o.r.lo; py = S23 * o.r.hi + py; *(LAS float*)(yb + (t) * 256) = py.x + py.y; } } while (0)
        for (int c = 0; c < NC; ++c) {
            LAS unsigned char* bp = lds + (c & 1) * BUFB + sj * 4; LAS unsigned char* vp = lds + (c & 1) * BUFB + O_V + srow * 4; LAS unsigned char* yb = lds + L_Y + ((c & 1) * 2 + wave) * 8192 + lane * 4;
            Ops A0, A1, A2, A3, B0, B1, B2, B3;
            if (MODE != 2) {
            RW_LD(A0, 0); RW_LD(A1, 1); RW_LD(A2, 2); RW_LD(A3, 3);
#pragma unroll
            for (int g = 0; g < CH / 8; ++g) {
                RW_LD(B0, 8 * g + 4); RW_LD(B1, 8 * g + 5); RW_LD(B2, 8 * g + 6); RW_LD(B3, 8 * g + 7);
                __builtin_amdgcn_sched_barrier(0);
                RW_STEP(A0, 8 * g); RW_STEP(A1, 8 * g + 1); RW_STEP(A2, 8 * g + 2); RW_STEP(A3, 8 * g + 3);
                __builtin_amdgcn_sched_barrier(0);
                if (g + 1 < CH / 8) { RW_LD(A0, 8 * g + 8); RW_LD(A1, 8 * g + 9); RW_LD(A2, 8 * g + 10); RW_LD(A3, 8 * g + 11); }
                __builtin_amdgcn_sched_barrier(0);
                RW_STEP(B0, 8 * g + 4); RW_STEP(B1, 8 * g + 5); RW_STEP(B2, 8 * g + 6); RW_STEP(B3, 8 * g + 7);
                __builtin_amdgcn_sched_barrier(0);
            }
            }
            if (c + 1 < NC) __syncthreads();
        }
#undef RW_LD
#undef RW_STEP
        if (MODE != 0) asm volatile("" :: "v"(S01), "v"(S23));
        __builtin_amdgcn_s_setprio(0);
    }
    __syncthreads();
    if (wave == 4 || wave == 5) { const int sw = wave - 4, et = lane >> 1, erp = lane & 1; RW_EMIT(NC - 1); }
#undef RW_EMIT
    __syncthreads();
}

__device__ __forceinline__ float wave_sum(float v) {
    v = allreduce16(v);
    { auto r = __builtin_amdgcn_permlane16_swap(__float_as_uint(v), __float_as_uint(v), false, false); v = __uint_as_float(r[0]) + __uint_as_float(r[1]); }
    { auto r = __builtin_amdgcn_permlane32_swap(__float_as_uint(v), __float_as_uint(v), false, false); v = __uint_as_float(r[0]) + __uint_as_float(r[1]); }
    return v;
}
__device__ __forceinline__ void finish_phase(const Params& p) {
    int tid_ = threadIdx.x; asm volatile("" : "+v"(tid_));
    const int lane = tid_ & 63, gw = (int)blockIdx.x * NWAVES + (tid_ >> 6), ngw = (int)gridDim.x * NWAVES;
    const bf16_t* Z = ws_big(p); bf16_t* BR = ws_br(p); const float* bon = (const float*)(p.ws + WS_BON);
    for (int it = gw; it < SEQ * 4; it += ngw) {
        const int t = it >> 2, h = (it & 3) * 4 + (lane >> 4), row = CTXN + t, col = h * 64 + (lane & 15) * 4;
        bf16_t* b = BR + (size_t)row * 2048;
        const u32x2 wf = *(const u32x2*)(b + col), wb = *(const u32x2*)(b + 1024 + col), zv = *(const u32x2*)(Z + (size_t)row * ZW + 2048 + col);
        const f32x4 x = {bflo(wf.x) + bflo(wb.x), bfhi(wf.x) + bfhi(wb.x), bflo(wf.y) + bflo(wb.y), bfhi(wf.y) + bfhi(wb.y)};
        const float mean = allreduce16((x[0] + x[1]) + (x[2] + x[3])) * (1.0f / 64.f);
        const f32x4 d = x - mean;
        const float var = allreduce16((d[0] * d[0] + d[1] * d[1]) + (d[2] * d[2] + d[3] * d[3])) * (1.0f / 64.f);
        const float rstd = __builtin_amdgcn_rsqf(var + GN_EPS), bsum = bon[(size_t)h * SEQ + t] + bon[((size_t)16 + h) * SEQ + t];
        const f32x4 g = *(const f32x4*)(p.lnx_g + col), bb = *(const f32x4*)(p.lnx_b + col), v = {bflo(zv.x), bfhi(zv.x), bflo(zv.y), bfhi(zv.y)};
        const f32x4 y = d * rstd * g + bb + v * bsum;
        u32x2 o; o.x = pkbf(y[0], y[1]); o.y = pkbf(y[2], y[3]);
        *(u32x2*)(b + 1024 + col) = o;
    }
}
}

namespace wy {
typedef short bf16x4 __attribute__((ext_vector_type(4)));
using rw::f32x4; using rw::u32x4; using rw::u32x2; using rw::bf16x8; using rw::bflo; using rw::bfhi; using rw::PITCH;
typedef float f32x2_t __attribute__((ext_vector_type(2)));
typedef __bf16 bf2_t __attribute__((ext_vector_type(2)));
__device__ __forceinline__ unsigned pkbf(float lo, float hi) { const f32x2_t v = {lo, hi}; return __builtin_bit_cast(unsigned, __builtin_convertvector(v, bf2_t)); }
typedef GAS unsigned gu32;
#define WY_RLX __ATOMIC_RELAXED, __HIP_MEMORY_SCOPE_AGENT
constexpr int NJOB = R / 64, NCHUNK = R / 16, NSLOT = 8, ATP = 144, REC = 13056, JOBB = 4 * REC;
static_assert(R % 64 == 0 && CTXN % 64 == 0, "jobs are 64 tokens");
constexpr int R_AT = 0, R_RT = 2304, R_BK = 4608, R_VT = 8704, R_AAK = 10752, R_TT = 11264, R_ARBK = 11776, R_WL = 12800;
__device__ __forceinline__ int permj(int j) { return (j >> 5) * 32 + ((j >> 2) & 3) * 8 + ((j >> 4) & 1) * 4 + (j & 3); }
constexpr int C_SLOTS = 3, C_SYNC = C_SLOTS * JOBB;
static_assert(C_SYNC + 64 <= 163840 - 64 && (JOBB / 4) % 16 == 0, "consumer LDS map");
constexpr size_t WS_RING = WS_WB;
constexpr size_t RING_TOTAL = (size_t)32 * NSLOT * JOBB;
constexpr size_t WS_WYF = 256 * 1024 + 16384;
constexpr int WYF_ACK = 32 * NSLOT * 64, WYF_ABORT = WYF_ACK + 32 * 64, WYF_WORDS = WYF_ABORT + 64;
constexpr unsigned SPIN_CAP = 1u << 17;
constexpr int P_A = 0, P_B = 16384, P_KD = 32768, P_LW = 49152, P_IMG = 65536, P_BRM = P_IMG + JOBB, P_KRM = P_BRM + 8192, P_AAB = P_KRM + 8192, P_W2T = P_AAB + 4096, P_A2T = P_W2T + 64 * PITCH * 2, P_END = P_A2T + 64 * PITCH * 2;
constexpr int P_SCR = P_BRM, SCRW = 2 * 8 * PITCH * 2;
constexpr int P_CST = P_IMG;
static_assert(P_END <= 163840 - 64 && P_SCR + 8 * SCRW + 8 * PITCH * 2 <= P_W2T, "wy LDS map");

__device__ __forceinline__ bf16x4 pack4(f32x4 v) { u32x2 r; r.x = pkbf(v[0], v[1]); r.y = pkbf(v[2], v[3]); return __builtin_bit_cast(bf16x4, r); }
__device__ __forceinline__ f32x4 mm(u32x2 a, bf16x4 b, f32x4 c) { return __builtin_amdgcn_mfma_f32_16x16x16bf16_1k(__builtin_bit_cast(bf16x4, a), b, c, 0, 0, 0); }
__device__ __forceinline__ f32x4 mm(u32x2 a, u32x2 b, f32x4 c) { return __builtin_amdgcn_mfma_f32_16x16x16bf16_1k(__builtin_bit_cast(bf16x4, a), __builtin_bit_cast(bf16x4, b), c, 0, 0, 0); }
__device__ __forceinline__ void wait_ge(gu32* word, unsigned want, gu32* abortw, int lane) {
    for (unsigned spins = 0;;) {
        unsigned v = 0u; if (lane == 0) v = __hip_atomic_load(word, WY_RLX);
        if ((unsigned)__builtin_amdgcn_readfirstlane(v) >= want) return;
        __builtin_amdgcn_s_sleep(1);
        if ((++spins & 255u) == 0u) { unsigned a = 0u; if (lane == 0) a = __hip_atomic_load(abortw, WY_RLX);
            if (__builtin_amdgcn_readfirstlane(a)) return;
            if (spins > SPIN_CAP) { if (lane == 0) __hip_atomic_store(abortw, 1u, WY_RLX); return; } }
    }
}

__device__ __forceinline__ void wait_ge4(gu32* words, unsigned want, gu32* abortw, int lane) {
    for (unsigned spins = 0;;) {
        unsigned v = 0xffffffffu; if (lane < 4) v = __hip_atomic_load(words + lane, WY_RLX);
        const unsigned v0 = (unsigned)__builtin_amdgcn_readlane((int)v, 0), v1 = (unsigned)__builtin_amdgcn_readlane((int)v, 1), v2 = (unsigned)__builtin_amdgcn_readlane((int)v, 2), v3 = (unsigned)__builtin_amdgcn_readlane((int)v, 3);
        const unsigned m01 = v0 < v1 ? v0 : v1, m23 = v2 < v3 ? v2 : v3;
        if ((m01 < m23 ? m01 : m23) >= want) return;
        __builtin_amdgcn_s_sleep(1);
        if ((++spins & 255u) == 0u) { unsigned a = 0u; if (lane == 0) a = __hip_atomic_load(abortw, WY_RLX);
            if (__builtin_amdgcn_readfirstlane(a)) return;
            if (spins > SPIN_CAP) { if (lane == 0) __hip_atomic_store(abortw, 1u, WY_RLX); return; } }
    }
}

struct Frag { u32x4 a01, a23, r01, r23, bk[4], arbk; u32x2 vT, aak, tt; f32x4 wl[4]; };

__device__ __forceinline__ void wait_lds_min4(LAS unsigned* w, unsigned want, gu32* abortw, int lane) {
    for (unsigned spins = 0;;) {
        const unsigned a = __hip_atomic_load(w, __ATOMIC_RELAXED, __HIP_MEMORY_SCOPE_WORKGROUP), b = __hip_atomic_load(w + 1, __ATOMIC_RELAXED, __HIP_MEMORY_SCOPE_WORKGROUP),
                       c = __hip_atomic_load(w + 2, __ATOMIC_RELAXED, __HIP_MEMORY_SCOPE_WORKGROUP), d = __hip_atomic_load(w + 3, __ATOMIC_RELAXED, __HIP_MEMORY_SCOPE_WORKGROUP);
        const unsigned m0 = a < b ? a : b, m1 = c < d ? c : d;
        if ((unsigned)__builtin_amdgcn_readfirstlane((int)(m0 < m1 ? m0 : m1)) >= want) return;
        __builtin_amdgcn_s_sleep(1);
        if ((++spins & 1023u) == 0u) { unsigned ab = 0u; if (lane == 0) ab = __hip_atomic_load(abortw, WY_RLX);
            if (__builtin_amdgcn_readfirstlane(ab)) return;
            if (spins > (SPIN_CAP << 3)) { if (lane == 0) __hip_atomic_store(abortw, 1u, WY_RLX); return; } }
    }
}
template <int MODE> __device__ __forceinline__ void loader(const Params& p, int chain, int lw, int lane, LAS unsigned char* lds) {
    const unsigned char* ring = (const unsigned char*)p.ws + WS_RING + (size_t)chain * NSLOT * JOBB;
    gu32* wf = (gu32*)(p.ws + WS_WYF); gu32* flags = wf + chain * NSLOT * 64; gu32* ackw = wf + WYF_ACK + chain * 64; gu32* abortw = wf + WYF_ABORT;
    LAS unsigned* loaded = (LAS unsigned*)(lds + C_SYNC); LAS unsigned* done = loaded + 4;
    const __amdgpu_buffer_rsrc_t ring_rsrc = __builtin_amdgcn_make_buffer_rsrc((void*)(p.ws + WS_RING), 0, (int)RING_TOTAL, 0x00020000);
    constexpr int QB = JOBB / 4, NIT = (QB / 16 + 63) / 64, TAIL = QB / 16 - (NIT - 1) * 64;
    for (int g = 0; g < NJOB; ++g) {
        if (MODE != 1 && g >= C_SLOTS) { wait_lds_min4(done, (unsigned)(g - C_SLOTS + 1), abortw, lane); __builtin_amdgcn_fence(__ATOMIC_ACQUIRE, "workgroup"); }
        if (MODE < 2) { wait_ge(flags + (g % NSLOT) * 64, (unsigned)g + 1u, abortw, lane); __builtin_amdgcn_fence(__ATOMIC_ACQUIRE, "agent"); }
        const int soff = (chain * NSLOT + g % NSLOT) * JOBB + lw * QB + lane * 16;
        LAS unsigned char* dst = lds + (g % C_SLOTS) * JOBB + lw * QB + lane * 16;
        u32x4 v[NIT];
#pragma unroll
        for (int k = 0; k < NIT; ++k) if (MODE == 0 && (k < NIT - 1 || lane < TAIL)) v[k] = __builtin_amdgcn_raw_buffer_load_b128(ring_rsrc, soff + k * 1024, 0, 16);
#pragma unroll
        for (int k = 0; k < NIT; ++k) if (MODE == 0 && (k < NIT - 1 || lane < TAIL)) *(LAS u32x4*)(dst + k * 1024) = v[k];
        asm volatile("s_waitcnt vmcnt(0) lgkmcnt(0)" ::: "memory");
        __builtin_amdgcn_fence(__ATOMIC_RELEASE, "workgroup");
        if (lane == 0) { __hip_atomic_store(ackw + lw, (unsigned)g + 1u, WY_RLX); __hip_atomic_store(loaded + lw, (unsigned)g + 1u, __ATOMIC_RELAXED, __HIP_MEMORY_SCOPE_WORKGROUP); }
    }
}
__device__ __forceinline__ bf16x8 cat(u32x2 a, u32x2 b) { const u32x4 v = {a.x, a.y, b.x, b.y}; return __builtin_bit_cast(bf16x8, v); }
__device__ __forceinline__ u32x2 pack4u(f32x4 v) { u32x2 r; r.x = pkbf(v[0], v[1]); r.y = pkbf(v[2], v[3]); return r; }
__device__ __forceinline__ f32x4 mm32(bf16x8 a, bf16x8 b, f32x4 c) { return __builtin_amdgcn_mfma_f32_16x16x32_bf16(a, b, c, 0, 0, 0); }
template <int MODE> __device__ __forceinline__ void consumer(const Params& p, int chain, int wave, int lane, LAS unsigned char* lds) {
    const int n = lane & 15, q = lane >> 4, dir = chain >> 4, h = chain & 15;
    gu32* abortw = (gu32*)(p.ws + WS_WYF) + WYF_ABORT;
    LAS unsigned* loaded = (LAS unsigned*)(lds + C_SYNC); LAS unsigned* done = loaded + 4;
    f32x4 S0 = {0.f, 0.f, 0.f, 0.f}, S1 = S0, S2 = S0, S3 = S0;
    const int offA = n * ATP + 16 * q, offB = n * 32 + 8 * q, offW = 16 * q, offS = n * 64 + ((q ^ ((n >> 2) & 3)) * 16);
    const long rstep = dir ? -2048 : 2048;
    bf16_t* yq = ws_br(p) + (size_t)(CTXN + (dir ? SEQ - 1 - 4 * q : 4 * q)) * 2048 + dir * 1024 + h * 64 + 16 * wave + n;
#define WY_LOAD(F, base, k) do { \
        F.a01 = *(const LAS u32x4*)(base + offA + (k) * REC + R_AT); F.a23 = *(const LAS u32x4*)(base + offA + (k) * REC + R_AT + 64); \
        F.r01 = *(const LAS u32x4*)(base + offA + (k) * REC + R_RT); F.r23 = *(const LAS u32x4*)(base + offA + (k) * REC + R_RT + 64); \
        _Pragma("unroll") for (int jt = 0; jt < 4; ++jt) { F.bk[jt] = *(const LAS u32x4*)(base + offS + (k) * REC + R_BK + 1024 * jt); F.wl[jt] = *(const LAS f32x4*)(base + offW + (k) * REC + R_WL + 64 * jt); } \
        F.arbk = *(const LAS u32x4*)(base + offS + (k) * REC + R_ARBK); \
        F.vT = *(const LAS u32x2*)(base + offB + (k) * REC + R_VT + 512 * wave); F.aak = *(const LAS u32x2*)(base + offB + (k) * REC + R_AAK); F.tt = *(const LAS u32x2*)(base + offB + (k) * REC + R_TT); } while (0)
#define WY_Q(v) __builtin_bit_cast(bf16x8, v)
#define WY_COMPUTE(F, cidx) do { const f32x4 z0_ = {0.f, 0.f, 0.f, 0.f}; const u32x2 zz_ = {0u, 0u};     \
        const bf16x8 s01 = cat(pack4u(S0), pack4u(S1)), s23 = cat(pack4u(S2), pack4u(S3)); \
        f32x4 Z = mm32(WY_Q(F.a01), s01, z0_); Z = mm32(WY_Q(F.a23), s23, Z); Z = mm32(cat(F.aak, zz_), cat(F.vT, zz_), Z); \
        f32x4 Y = mm32(WY_Q(F.r01), s01, z0_); Y = mm32(WY_Q(F.r23), s23, Y); \
        const u32x2 zb = pack4u(Z); const f32x4 U = mm32(cat(F.tt, zz_), cat(zb, zz_), z0_); const u32x2 ub = pack4u(U); \
        const bf16x8 vu = cat(F.vT, ub); \
        Y = mm32(WY_Q(F.arbk), vu, Y); \
        S0 = mm32(WY_Q(F.bk[0]), vu, S0); S1 = mm32(WY_Q(F.bk[1]), vu, S1); S2 = mm32(WY_Q(F.bk[2]), vu, S2); S3 = mm32(WY_Q(F.bk[3]), vu, S3); \
        S0 *= F.wl[0]; S1 *= F.wl[1]; S2 *= F.wl[2]; S3 *= F.wl[3]; \
        if (MODE == 0 && (cidx) * 16 >= CTXN) { const unsigned y01 = pkbf(Y[0], Y[1]), y23 = pkbf(Y[2], Y[3]); bf16_t* yp_ = yq + (long)((cidx) * 16 - CTXN) * rstep; \
            *(unsigned short*)yp_ = (unsigned short)(y01 & 0xffffu); *(unsigned short*)(yp_ + rstep) = (unsigned short)(y01 >> 16); \
            *(unsigned short*)(yp_ + 2 * rstep) = (unsigned short)(y23 & 0xffffu); *(unsigned short*)(yp_ + 3 * rstep) = (unsigned short)(y23 >> 16); } } while (0)
    Frag FA, FB;
    wait_lds_min4(loaded, 1u, abortw, lane); __builtin_amdgcn_fence(__ATOMIC_ACQUIRE, "workgroup");
    int slot = 0;
    { const LAS unsigned char* b0 = lds; WY_LOAD(FA, b0, 0); if (MODE == 3) WY_LOAD(FB, b0, 1); }
    for (int g = 0; g < NJOB; ++g) {
        const LAS unsigned char* base = lds + slot * JOBB;
        if (MODE != 3) WY_LOAD(FB, base, 1); WY_COMPUTE(FA, 4 * g);
        if (MODE != 3) WY_LOAD(FA, base, 2); WY_COMPUTE(FB, 4 * g + 1);
        if (MODE != 3) WY_LOAD(FB, base, 3); WY_COMPUTE(FA, 4 * g + 2);
        slot = slot == C_SLOTS - 1 ? 0 : slot + 1;
        if (g + 1 < NJOB) { wait_lds_min4(loaded, (unsigned)g + 2u, abortw, lane); __builtin_amdgcn_fence(__ATOMIC_ACQUIRE, "workgroup");
            const LAS unsigned char* nb = lds + slot * JOBB; if (MODE != 3) WY_LOAD(FA, nb, 0); }
        WY_COMPUTE(FB, 4 * g + 3);
        asm volatile("s_waitcnt lgkmcnt(0)" ::: "memory");
        __builtin_amdgcn_fence(__ATOMIC_RELEASE, "workgroup");
        if (lane == 0) __hip_atomic_store(done + wave, (unsigned)g + 1u, __ATOMIC_RELAXED, __HIP_MEMORY_SCOPE_WORKGROUP);
    }
#undef WY_LOAD
#undef WY_COMPUTE
#undef WY_Q
    if (MODE != 0) asm volatile("" :: "v"(S0), "v"(S1), "v"(S2), "v"(S3));
}

__device__ __forceinline__ void producer(const Params& p, int chain, int first, int step, LAS unsigned char* lds) {
    int tid_ = threadIdx.x; asm volatile("" : "+v"(tid_));
    const int tid = tid_, lane = tid & 63, wave = __builtin_amdgcn_readfirstlane(tid >> 6);
    const int dir = chain >> 4, h = chain & 15;
    const float* w0 = dir ? p.w0b : p.w0f; const float* w2 = dir ? p.w2b : p.w2f; const float* a0 = dir ? p.a0b : p.a0f; const float* a2 = dir ? p.a2b : p.a2f;
    const bf16_t* Z = ws_big(p); float* bon = (float*)(p.ws + rw::WS_BON) + ((size_t)dir * 16 + h) * SEQ;
    gu32* wf = (gu32*)(p.ws + WS_WYF); gu32* flags = wf + chain * NSLOT * 64; gu32* ackw = wf + WYF_ACK + chain * 64; gu32* abortw = wf + WYF_ABORT;
    const __amdgpu_buffer_rsrc_t ring_rsrc = __builtin_amdgcn_make_buffer_rsrc((void*)(p.ws + WS_RING), 0, (int)RING_TOTAL, 0x00020000);
    { const int m = tid >> 3, j8 = (tid & 7) * 8;
      const f32x4 wa = *(const f32x4*)(w2 + (size_t)m * 1024 + h * 64 + j8), wb = *(const f32x4*)(w2 + (size_t)m * 1024 + h * 64 + j8 + 4);
      const f32x4 aa = *(const f32x4*)(a2 + (size_t)m * 1024 + h * 64 + j8), ab = *(const f32x4*)(a2 + (size_t)m * 1024 + h * 64 + j8 + 4);
      LAS bf16_t* yw = (LAS bf16_t*)(lds + P_W2T); LAS bf16_t* ya = (LAS bf16_t*)(lds + P_A2T);
#pragma unroll
      for (int qq = 0; qq < 4; ++qq) { yw[(j8 + qq) * PITCH + m] = f2bf(wa[qq]); yw[(j8 + 4 + qq) * PITCH + m] = f2bf(wb[qq]); ya[(j8 + qq) * PITCH + m] = f2bf(aa[qq]); ya[(j8 + 4 + qq) * PITCH + m] = f2bf(ab[qq]); }
      for (int i = tid; i < 320; i += NTHR) { const int gI = i >> 6, cc = i & 63, hc = h * 64 + cc; float v;
          if (gI == 0) v = w0[hc]; else if (gI == 1) v = a0[hc]; else if (gI == 2) v = p.k_k[hc]; else if (gI == 3) v = p.k_a[hc]; else v = p.r_k[hc];
          *(LAS float*)(lds + P_CST + i * 4) = v; } }
    __syncthreads();
    const int tq = lane >> 3, c8 = (lane & 7) * 8, hj = h * 64 + c8, tslot = wave * 8 + tq, ch1 = tslot >> 4, t1 = tslot & 15;
    const int gcol[5] = {hj, 1024 + hj, 2048 + hj, 3072 + dir * 64 + c8, 3200 + dir * 64 + c8};
    f32x4 cw0[2], ca0[2], ckk[2], cka[2], crk[2];
#pragma unroll
    for (int hh = 0; hh < 2; ++hh) {
#define WY_CST(gI) (*(LAS f32x4*)(lds + P_CST + ((gI) * 64 + c8 + 4 * hh) * 4))
        cw0[hh] = WY_CST(0); ca0[hh] = WY_CST(1); ckk[hh] = WY_CST(2); cka[hh] = WY_CST(3); crk[hh] = WY_CST(4);
#undef WY_CST
        asm volatile("" : "+v"(cw0[hh]), "+v"(ca0[hh]), "+v"(ckk[hh]), "+v"(cka[hh]), "+v"(crk[hh])); }
    __syncthreads();
    LAS unsigned char* scr = lds + P_SCR + wave * SCRW;
    LAS unsigned char* img = lds + P_IMG;
    rw::Raw raw;
#define WY_LOADRAW(gj) do { const bf16_t* zr_ = Z + (size_t)rw_row(dir, (gj) * 64 + tslot) * ZW; \
        _Pragma("unroll") for (int g5 = 0; g5 < 5; ++g5) raw.c[g5] = *(const u32x4*)(zr_ + gcol[g5]); } while (0)
    if (first < NJOB) WY_LOADRAW(first);
    for (int g = first; g < NJOB; g += step) {
        const bool latent = g * 64 >= CTXN;
        { f32x4 rr[2], kv[2];
          { const u32x4 u = raw.c[0]; rr[0] = (f32x4){bflo(u.x), bfhi(u.x), bflo(u.y), bfhi(u.y)}; rr[1] = (f32x4){bflo(u.z), bfhi(u.z), bflo(u.w), bfhi(u.w)};
            LAS unsigned char* rr_ = img + ch1 * REC + R_RT + t1 * ATP + permj(c8) * 2; *(LAS u32x2*)rr_ = (u32x2){u.x, u.y}; *(LAS u32x2*)(rr_ + 16) = (u32x2){u.z, u.w}; }
          { const u32x4 u = raw.c[1]; kv[0] = (f32x4){bflo(u.x), bfhi(u.x), bflo(u.y), bfhi(u.y)}; kv[1] = (f32x4){bflo(u.z), bfhi(u.z), bflo(u.w), bfhi(u.w)}; }
          { const u32x4 u = raw.c[2]; LAS unsigned short* vt = (LAS unsigned short*)(img + ch1 * REC + R_VT) + c8 * 16 + t1;
            vt[0] = (unsigned short)(u.x & 0xffffu); vt[16] = (unsigned short)(u.x >> 16); vt[32] = (unsigned short)(u.y & 0xffffu); vt[48] = (unsigned short)(u.y >> 16);
            vt[64] = (unsigned short)(u.z & 0xffffu); vt[80] = (unsigned short)(u.z >> 16); vt[96] = (unsigned short)(u.w & 0xffffu); vt[112] = (unsigned short)(u.w >> 16); }
          { const u32x4 u = raw.c[3]; u32x4 o;
            o.x = pkbf(rw::fast_tanh(bflo(u.x)), rw::fast_tanh(bfhi(u.x))); o.y = pkbf(rw::fast_tanh(bflo(u.y)), rw::fast_tanh(bfhi(u.y))); o.z = pkbf(rw::fast_tanh(bflo(u.z)), rw::fast_tanh(bfhi(u.z))); o.w = pkbf(rw::fast_tanh(bflo(u.w)), rw::fast_tanh(bfhi(u.w)));
            *(LAS u32x4*)(scr + (tq * PITCH + c8) * 2) = o; *(LAS u32x4*)(scr + 8 * PITCH * 2 + (tq * PITCH + c8) * 2) = raw.c[4]; }
          if (g + step < NJOB) WY_LOADRAW(g + step);
          asm volatile("s_waitcnt lgkmcnt(0)" ::: "memory");
          { const int r16 = lane & 15, quad = lane >> 4; f32x4 acc[2][4];
#pragma unroll
            for (int lora = 0; lora < 2; ++lora) {
                LAS unsigned char* X = scr + lora * 8 * PITCH * 2 + (r16 * PITCH + quad * 8) * 2;
                const bf16x8 x0 = *(LAS bf16x8*)X, x1 = *(LAS bf16x8*)(X + 64);
#pragma unroll
                for (int jt = 0; jt < 4; ++jt) {
                    LAS unsigned char* Y = lds + (lora ? P_A2T : P_W2T) + ((jt * 16 + r16) * PITCH + quad * 8) * 2;
                    acc[lora][jt] = (f32x4){0.f, 0.f, 0.f, 0.f};
                    acc[lora][jt] = __builtin_amdgcn_mfma_f32_16x16x32_bf16(x0, *(LAS bf16x8*)Y, acc[lora][jt], 0, 0, 0);
                    acc[lora][jt] = __builtin_amdgcn_mfma_f32_16x16x32_bf16(x1, *(LAS bf16x8*)(Y + 64), acc[lora][jt], 0, 0, 0); } }
            if (quad < 2) {
#pragma unroll
                for (int lora = 0; lora < 2; ++lora)
#pragma unroll
                    for (int jt = 0; jt < 4; ++jt)
#pragma unroll
                        for (int r = 0; r < 4; ++r) *(LAS float*)(lds + (lora ? P_B : P_LW) + ((wave * 8 + quad * 4 + r) * 64 + jt * 16 + r16) * 4) = acc[lora][jt][r]; } }
          asm volatile("s_waitcnt lgkmcnt(0)" ::: "memory");
          { float bs = 0.f, nn = 0.f; f32x4 kk[2], al[2];
#pragma unroll
            for (int hh = 0; hh < 2; ++hh) { const int off = (tslot * 64 + c8 + 4 * hh) * 4;
                const f32x4 aw = *(LAS f32x4*)(lds + P_LW + off) + cw0[hh], aa = *(LAS f32x4*)(lds + P_B + off) + ca0[hh];
                f32x4 lw;
#pragma unroll
                for (int qq = 0; qq < 4; ++qq) { const float sg = __builtin_amdgcn_rcpf(1.0f + __builtin_amdgcn_exp2f(-1.4426950408889634f * aw[qq]));
                    lw[qq] = -0.8750612633917f * sg; al[hh][qq] = __builtin_amdgcn_rcpf(1.0f + __builtin_amdgcn_exp2f(-1.4426950408889634f * aa[qq])); kk[hh][qq] = kv[hh][qq] * ckk[hh][qq]; nn += kk[hh][qq] * kk[hh][qq]; }
                *(LAS f32x4*)(lds + P_LW + off) = lw; }
            nn = rw::allreduce8(nn);
            const float inv = __builtin_amdgcn_rsqf(fmaxf(nn, 1e-24f));
#pragma unroll
            for (int hh = 0; hh < 2; ++hh) { const int off = (tslot * 64 + c8 + 4 * hh) * 4;
                const f32x4 r = rr[hh];
                f32x4 av, bv, kd;
#pragma unroll
                for (int qq = 0; qq < 4; ++qq) { const float kn = kk[hh][qq] * inv; av[qq] = -kn; bv[qq] = kn * al[hh][qq]; kd[qq] = kv[hh][qq] * (1.0f + (al[hh][qq] - 1.0f) * cka[hh][qq]); bs += r[qq] * kd[qq] * crk[hh][qq]; }
                *(LAS f32x4*)(lds + P_B + off) = bv; *(LAS f32x4*)(lds + P_KD + off) = kd; *(LAS f32x4*)(lds + P_A + off) = av; }
            bs = rw::allreduce8(bs);
            if (latent && (lane & 7) == 0) bon[rw_row(dir, g * 64 + tslot) - CTXN] = bs; } }
        __syncthreads();
        { const int ch = wave & 3, half = wave >> 2, j = lane;
          LAS unsigned char* rec = img + ch * REC;
          const LAS float* LW = (const LAS float*)(lds + P_LW) + (ch * 16) * 64 + j;
          const LAS float* XA = (const LAS float*)(lds + (half ? P_KD : P_A)) + (ch * 16) * 64 + j;
          const LAS float* XB = (const LAS float*)(lds + P_B) + (ch * 16) * 64 + j;
          LAS unsigned short* rowm0 = (LAS unsigned short*)(rec + (half ? R_RT : R_AT)) + permj(j);
          LAS unsigned short* rowm1 = (LAS unsigned short*)(lds + (half ? P_KRM : P_BRM) + ch * 2048) + permj(j);
          float cum = 0.f, x0p = 0.f, x1p = 0.f; unsigned tp[8];
#pragma unroll
          for (int t = 0; t < 16; ++t) {
              const float lw = LW[t * 64], cprev = cum; cum += lw;
              const float iW = __builtin_amdgcn_exp2f(-cum);
              float x0, x1;
              if (half == 0) { x0 = XA[t * 64] * __builtin_amdgcn_exp2f(cprev); x1 = XB[t * 64] * iW; }
              else { x0 = __uint_as_float((unsigned)rowm0[t * (ATP / 2)] << 16) * __builtin_amdgcn_exp2f(cum); x1 = XA[t * 64] * iW; }
              if (t & 1) { const unsigned p0 = pkbf(x0p, x0), p1 = pkbf(x1p, x1);
                  rowm0[(t - 1) * (ATP / 2)] = (unsigned short)(p0 & 0xffffu); rowm0[t * (ATP / 2)] = (unsigned short)(p0 >> 16);
                  rowm1[(t - 1) * 64] = (unsigned short)(p1 & 0xffffu); rowm1[t * 64] = (unsigned short)(p1 >> 16);
                  tp[t >> 1] = p1; }
              x0p = x0; x1p = x1; }
          { LAS unsigned char* bkr = rec + R_BK + j * 64 + (half ? 0 : 8); const int sw = (j >> 2) & 3;
#pragma unroll
            for (int qq = 0; qq < 4; ++qq) *(LAS u32x2*)(bkr + ((qq ^ sw) * 16)) = (u32x2){tp[2 * qq], tp[2 * qq + 1]}; }
          if (half) *(LAS float*)(rec + R_WL + j * 4) = __builtin_amdgcn_exp2f(cum); }
        __syncthreads();
        { const int ch = wave & 3, pair = wave >> 2, n = lane & 15, q = lane >> 4;
          LAS unsigned char* rec = img + ch * REC;
          const LAS unsigned char* Yrm = rec + (pair ? R_RT : R_AT) + n * ATP + 16 * q;
          const LAS unsigned char* Xb = lds + P_BRM + ch * 2048 + n * 128 + 16 * q;
          const LAS unsigned char* Xk = lds + P_KRM + ch * 2048 + n * 128 + 16 * q;
          f32x4 cb = {0.f, 0.f, 0.f, 0.f}, ck = cb;
#pragma unroll
          for (int jt = 0; jt < 4; ++jt) { const int o_ = (jt >> 1) * 64 + (jt & 1) * 8; const u32x2 yb = *(const LAS u32x2*)(Yrm + o_);
              cb = mm(*(const LAS u32x2*)(Xb + o_), yb, cb); ck = mm(*(const LAS u32x2*)(Xk + o_), yb, ck); }
#pragma unroll
          for (int r = 0; r < 4; ++r) { const int s = 4 * q + r; const bool keep = pair ? (s <= n) : (s < n); if (!keep) { cb[r] = 0.f; ck[r] = 0.f; } }
          u32x2 ob, ok; ob.x = pkbf(cb[0], cb[1]); ob.y = pkbf(cb[2], cb[3]); ok.x = pkbf(ck[0], ck[1]); ok.y = pkbf(ck[2], ck[3]);
          if (pair) *(LAS u32x4*)(rec + R_ARBK + n * 64 + ((q ^ ((n >> 2) & 3)) * 16)) = (u32x4){ok.x, ok.y, ob.x, ob.y};
          else { *(LAS f32x4*)(lds + P_AAB + ch * 1024 + n * 64 + 16 * q) = cb; *(LAS u32x2*)(rec + R_AAK + n * 32 + 8 * q) = ok; } }
        __syncthreads();
        if (wave == 0) {
            const int ch = lane >> 4, c = lane & 15;
            const LAS float* Aab = (const LAS float*)(lds + P_AAB + ch * 1024);
            float Tc[16];
#pragma unroll
            for (int t = 0; t < 16; ++t) { float acc = (t == c) ? 1.0f : 0.0f;
#pragma unroll
                for (int s4 = 0; s4 < (t + 3) / 4; ++s4) { const f32x4 a4 = *(const LAS f32x4*)(Aab + t * 16 + 4 * s4);
#pragma unroll
                    for (int e = 0; e < 4; ++e) if (4 * s4 + e < t) acc += a4[e] * Tc[4 * s4 + e]; }
                Tc[t] = acc; }
            LAS unsigned short* tt = (LAS unsigned short*)(img + ch * REC + R_TT) + c;
#pragma unroll
            for (int t = 0; t < 16; t += 2) { const unsigned pp = pkbf(Tc[t], Tc[t + 1]); tt[t * 16] = (unsigned short)(pp & 0xffffu); tt[(t + 1) * 16] = (unsigned short)(pp >> 16); }
            if (g >= NSLOT) wait_ge4(ackw, (unsigned)(g - NSLOT + 1), abortw, lane);
        }
        __syncthreads();
        { const int slot = g % NSLOT; const int base = (chain * NSLOT + slot) * JOBB;
          for (int i = tid; i < JOBB / 16; i += NTHR) __builtin_amdgcn_raw_buffer_store_b128(*(LAS u32x4*)(img + i * 16), ring_rsrc, base + i * 16, 0, 16);
          asm volatile("s_waitcnt vmcnt(0)" ::: "memory");
          __syncthreads();
          if (tid == 0) __hip_atomic_store(flags + slot * 64, (unsigned)g + 1u, WY_RLX); }
    }
#undef WY_LOADRAW
}

__device__ __forceinline__ void zero_words(const Params& p) {
    int t_ = threadIdx.x; asm volatile("" : "+v"(t_)); unsigned* wf_ = (unsigned*)(p.ws + WS_WYF);
    for (long g = (long)blockIdx.x * NTHR + t_; g < (long)WYF_WORDS; g += (long)gridDim.x * NTHR) wf_[g] = 0u;
}
template <int MODE> __device__ __forceinline__ void phase(const Params& p, LAS unsigned char* lds) {
    const int G = (int)gridDim.x, b = (int)blockIdx.x, nper = (G - 32) / 32;
    if (b < 32) {
        int tid_ = threadIdx.x; asm volatile("" : "+v"(tid_)); const int wave = __builtin_amdgcn_readfirstlane(tid_ >> 6);
        if (tid_ < 8) *(LAS unsigned*)(lds + C_SYNC + 4 * tid_) = 0u;
        __syncthreads();
        if (wave < 4) { if (MODE != 1) consumer<MODE>(p, b, wave, tid_ & 63, lds); } else loader<MODE>(p, b, wave - 4, tid_ & 63, lds);
    }
    else if (MODE < 2) { const int pp = b - 32; if (pp < 32 * nper) producer(p, pp % 32, pp / 32, nper, lds); }
}
}

namespace ret {
using attn::bf16x8; using attn::s16x4; using attn::f32x16; using attn::u32x4;
typedef float f32x4 __attribute__((ext_vector_type(4)));
typedef unsigned u32x2 __attribute__((ext_vector_type(2)));
constexpr int NQ = R / 128;
constexpr size_t SLOT_BYTES = 256 * 128 * 2;
constexpr size_t WS_SCTX = 254 * MiB;
#define RKSWZ(row, colB) ((row) * 256 + ((colB) ^ (((row) & 7) << 4)))
__device__ __forceinline__ bf16_t* slot(const Params& p, int dir, int q, int head) {
    return q >= 2 ? (bf16_t*)((unsigned char*)p.out + (((size_t)dir * (NQ - 2) + (q - 2)) * 4 + head) * SLOT_BYTES)
                  : (bf16_t*)(p.ws + WS_SCTX + (((size_t)dir * 2 + q) * 4 + head) * SLOT_BYTES);
}
__device__ __forceinline__ float log2_sigmoid(float x) { return -1.4426950408889634f * (fmaxf(-x, 0.f) + log1pf(expf(-fabsf(x)))); }
__device__ __forceinline__ bf16x8 scale8(bf16x8 v, float s) {
    u32x4 w = __builtin_bit_cast(u32x4, v), o;
#pragma unroll
    for (int i = 0; i < 4; ++i) o[i] = attn::cvtpk(__uint_as_float(w[i] << 16) * s, __uint_as_float(w[i] & 0xffff0000u) * s);
    return __builtin_bit_cast(bf16x8, o);
}
__device__ __forceinline__ void pk4(const f32x16& P, int base, bf16x8& out) {
    const unsigned a0 = attn::cvtpk(P[base + 0], P[base + 1]), a1 = attn::cvtpk(P[base + 2], P[base + 3]);
    const unsigned b0 = attn::cvtpk(P[base + 4], P[base + 5]), b1 = attn::cvtpk(P[base + 6], P[base + 7]);
    auto r0 = __builtin_amdgcn_permlane32_swap(a0, b0, false, false); auto r1 = __builtin_amdgcn_permlane32_swap(a1, b1, false, false);
    u32x4 w = {r0[0], r1[0], r0[1], r1[1]}; out = __builtin_bit_cast(bf16x8, w);
}
#define RPK(L, H) (bf16x8){L[0], L[1], L[2], L[3], H[0], H[1], H[2], H[3]}

__device__ __forceinline__ void summaries_unit(const Params& p, int q, int h, char* lds) {
    int tid_ = threadIdx.x; asm volatile("" : "+v"(tid_));
    const int tid = tid_, lane = tid & 63, wave = __builtin_amdgcn_readfirstlane(tid >> 6), r32 = lane & 31, hi = lane >> 5;
    const bf16_t* P = ws_big(p) + (size_t)q * 128 * P0W;
    const float lgf = log2_sigmoid(p.dec_f[h]), lgb = log2_sigmoid(p.dec_b[h]);
    const int sr = tid >> 4, sc = (tid & 15) * 8, st0 = attn::v_st(sr, sc), st1 = attn::v_st(32 + sr, sc);
#pragma unroll
    for (int th = 0; th < 2; ++th) {
        const int t0 = th * 64 + sr, t1 = t0 + 32;
        const bf16_t* r0 = P + (size_t)t0 * P0W; const bf16_t* r1 = P + (size_t)t1 * P0W;
#pragma unroll
        for (int eh = 0; eh < 2; ++eh) { char* vt = lds + (th * 2 + eh) * 16384;
            *(bf16x8*)(vt + st0) = *(const bf16x8*)(r0 + C_VA + h * 256 + eh * 128 + sc); *(bf16x8*)(vt + st1) = *(const bf16x8*)(r1 + C_VA + h * 256 + eh * 128 + sc); }
        const bf16x8 k0 = *(const bf16x8*)(r0 + C_KA + h * 128 + sc), k1 = *(const bf16x8*)(r1 + C_KA + h * 128 + sc);
        char* kf = lds + 65536 + th * 16384; char* kb = lds + 98304 + th * 16384;
        *(bf16x8*)(kf + st0) = scale8(k0, __builtin_amdgcn_exp2f((float)(127 - t0) * lgf)); *(bf16x8*)(kf + st1) = scale8(k1, __builtin_amdgcn_exp2f((float)(127 - t1) * lgf));
        *(bf16x8*)(kb + st0) = scale8(k0, __builtin_amdgcn_exp2f((float)t0 * lgb)); *(bf16x8*)(kb + st1) = scale8(k1, __builtin_amdgcn_exp2f((float)t1 * lgb));
    }
    __syncthreads();
    const int lbase = (int)(uintptr_t)lds + attn::v_rd_base(lane);
    f32x16 acc[2][4];
#pragma unroll
    for (int d = 0; d < 2; ++d)
#pragma unroll
        for (int b = 0; b < 4; ++b) acc[d][b] = f32x16{};
#pragma unroll
    for (int th = 0; th < 2; ++th) {
        const int va = lbase + (th * 2 + (wave >> 2)) * 16384 + (wave & 3) * 512, kfb = lbase + 65536 + th * 16384, kbb = lbase + 98304 + th * 16384;
#define R1_STEP(KS) do { \
        const s16x4 al = attn::tr_read<attn::v_rd_off(0, KS, 0)>(va), ah = attn::tr_read<attn::v_rd_off(0, KS, 1)>(va); \
        const s16x4 f0l = attn::tr_read<attn::v_rd_off(0, KS, 0)>(kfb), f0h = attn::tr_read<attn::v_rd_off(0, KS, 1)>(kfb), f1l = attn::tr_read<attn::v_rd_off(1, KS, 0)>(kfb), f1h = attn::tr_read<attn::v_rd_off(1, KS, 1)>(kfb); \
        const s16x4 f2l = attn::tr_read<attn::v_rd_off(2, KS, 0)>(kfb), f2h = attn::tr_read<attn::v_rd_off(2, KS, 1)>(kfb), f3l = attn::tr_read<attn::v_rd_off(3, KS, 0)>(kfb), f3h = attn::tr_read<attn::v_rd_off(3, KS, 1)>(kfb); \
        const s16x4 g0l = attn::tr_read<attn::v_rd_off(0, KS, 0)>(kbb), g0h = attn::tr_read<attn::v_rd_off(0, KS, 1)>(kbb), g1l = attn::tr_read<attn::v_rd_off(1, KS, 0)>(kbb), g1h = attn::tr_read<attn::v_rd_off(1, KS, 1)>(kbb); \
        const s16x4 g2l = attn::tr_read<attn::v_rd_off(2, KS, 0)>(kbb), g2h = attn::tr_read<attn::v_rd_off(2, KS, 1)>(kbb), g3l = attn::tr_read<attn::v_rd_off(3, KS, 0)>(kbb), g3h = attn::tr_read<attn::v_rd_off(3, KS, 1)>(kbb); \
        asm volatile("s_waitcnt lgkmcnt(0)" ::: "memory"); __builtin_amdgcn_sched_barrier(0); \
        const bf16x8 a = RPK(al, ah); \
        acc[0][0] = __builtin_amdgcn_mfma_f32_32x32x16_bf16(a, RPK(f0l, f0h), acc[0][0], 0, 0, 0); acc[0][1] = __builtin_amdgcn_mfma_f32_32x32x16_bf16(a, RPK(f1l, f1h), acc[0][1], 0, 0, 0); \
        acc[0][2] = __builtin_amdgcn_mfma_f32_32x32x16_bf16(a, RPK(f2l, f2h), acc[0][2], 0, 0, 0); acc[0][3] = __builtin_amdgcn_mfma_f32_32x32x16_bf16(a, RPK(f3l, f3h), acc[0][3], 0, 0, 0); \
        acc[1][0] = __builtin_amdgcn_mfma_f32_32x32x16_bf16(a, RPK(g0l, g0h), acc[1][0], 0, 0, 0); acc[1][1] = __builtin_amdgcn_mfma_f32_32x32x16_bf16(a, RPK(g1l, g1h), acc[1][1], 0, 0, 0); \
        acc[1][2] = __builtin_amdgcn_mfma_f32_32x32x16_bf16(a, RPK(g2l, g2h), acc[1][2], 0, 0, 0); acc[1][3] = __builtin_amdgcn_mfma_f32_32x32x16_bf16(a, RPK(g3l, g3h), acc[1][3], 0, 0, 0); \
        __builtin_amdgcn_sched_barrier(0); } while (0)
        R1_STEP(0); R1_STEP(1); R1_STEP(2); R1_STEP(3);
#undef R1_STEP
    }
#pragma unroll
    for (int d = 0; d < 2; ++d) { bf16_t* dst = slot(p, d, q, h);
#pragma unroll
        for (int db = 0; db < 4; ++db)
#pragma unroll
            for (int r = 0; r < 16; ++r) dst[(size_t)(32 * wave + attn::crow(r, hi)) * 128 + 32 * db + r32] = (bf16_t)(attn::cvtpk(acc[d][db][r], 0.f) & 0xffffu); }
    __syncthreads();
}

__device__ __forceinline__ void state_scan(const Params& p) {
    int tid_ = threadIdx.x; asm volatile("" : "+v"(tid_));
    for (long gt = (long)blockIdx.x * NTHR + tid_; gt < 2L * 4 * 16384; gt += (long)gridDim.x * NTHR) {
    const int pair = (int)(gt & 16383), h = (int)((gt >> 14) & 3), dir = (int)(gt >> 16);
    const float G = __builtin_amdgcn_exp2f(128.0f * log2_sigmoid((dir ? p.dec_b : p.dec_f)[h]));
    float s0 = 0.f, s1 = 0.f;
    for (int n = 0; n < NQ; ++n) {
        const int q = dir == 0 ? n : (n < 2 ? 1 - n : NQ + 1 - n);
        unsigned* ptr = (unsigned*)slot(p, dir, q, h) + pair;
        const unsigned u = *ptr;
        *ptr = attn::cvtpk(s0, s1);
        s0 = G * s0 + __uint_as_float(u << 16); s1 = G * s1 + __uint_as_float(u & 0xffff0000u);
    }    }
}

__device__ __forceinline__ void output_unit(const Params& p, int q, int h, char* lds) {
    int tid_ = threadIdx.x; asm volatile("" : "+v"(tid_));
    const int tid = tid_, lane = tid & 63, wave = __builtin_amdgcn_readfirstlane(tid >> 6), r32 = lane & 31, hi = lane >> 5;
    const int ib = wave >> 1, eh = wave & 1;
    const bf16_t* P = ws_big(p) + (size_t)q * 128 * P0W;
    const float lgf = log2_sigmoid(p.dec_f[h]), lgb = log2_sigmoid(p.dec_b[h]);
    { const int sr = tid >> 4, sc = (tid & 15) * 8, st0 = attn::v_st(sr, sc), st1 = attn::v_st(32 + sr, sc);
#pragma unroll
      for (int jt = 0; jt < 2; ++jt) {
          const bf16_t* r0 = P + (size_t)(jt * 64 + sr) * P0W; const bf16_t* r1 = r0 + (size_t)32 * P0W;
          char* kt = lds + jt * 16384;
          *(bf16x8*)(kt + RKSWZ(sr, sc * 2)) = *(const bf16x8*)(r0 + C_KA + h * 128 + sc); *(bf16x8*)(kt + RKSWZ(32 + sr, sc * 2)) = *(const bf16x8*)(r1 + C_KA + h * 128 + sc);
#pragma unroll
          for (int e2 = 0; e2 < 2; ++e2) { char* vt = lds + 32768 + (jt * 2 + e2) * 16384;
              *(bf16x8*)(vt + st0) = *(const bf16x8*)(r0 + C_VA + h * 256 + e2 * 128 + sc); *(bf16x8*)(vt + st1) = *(const bf16x8*)(r1 + C_VA + h * 256 + e2 * 128 + sc); }
      } }
    bf16x8 qr[8];
    { const bf16_t* Qw = P + (size_t)(ib * 32 + r32) * P0W + C_QA + h * 128 + hi * 8;
#pragma unroll
      for (int d0 = 0; d0 < 8; ++d0) qr[d0] = *(const bf16x8*)(Qw + d0 * 16); }
    const bf16_t* Sf = slot(p, 0, q, h) + (size_t)(eh * 128 + r32) * 128 + hi * 8; const bf16_t* Sb = slot(p, 1, q, h) + (size_t)(eh * 128 + r32) * 128 + hi * 8;
    bf16x8 fa[8], fb[8];
#define RET_LOADB(F, S, sb) do { _Pragma("unroll") for (int s_ = 0; s_ < 2; ++s_) _Pragma("unroll") for (int d0 = 0; d0 < 4; ++d0) F[s_ * 4 + d0] = *(const bf16x8*)((S) + (size_t)d0 * 32 * 128 + ((sb) * 2 + s_) * 16); } while (0)
#define RET_MMAB(F, sc, sb) do { _Pragma("unroll") for (int s_ = 0; s_ < 2; ++s_) { const bf16x8 a = scale8(qr[(sb) * 2 + s_], sc); \
        _Pragma("unroll") for (int d0 = 0; d0 < 4; ++d0) o[d0] = __builtin_amdgcn_mfma_f32_32x32x16_bf16(a, F[s_ * 4 + d0], o[d0], 0, 0, 0); } } while (0)
    RET_LOADB(fa, Sf, 0);
    __syncthreads();
    f32x16 o[4] = {};
    const int i_loc = ib * 32 + r32;
    const int vb0 = (int)(uintptr_t)lds + 32768 + attn::v_rd_base(lane);
#pragma unroll
    for (int jt = 0; jt < 2; ++jt) {
        f32x16 p0, p1;
        attn::qkt(p0, p1, (const attn::bf16*)(lds + jt * 16384), qr, r32, hi);
#pragma unroll
        for (int r = 0; r < 16; ++r) {
            const int j0 = jt * 64 + attn::crow(r, hi), dl0 = i_loc - j0, dl1 = dl0 - 32;
            const float m0 = dl0 > 0 ? __builtin_amdgcn_exp2f((float)dl0 * lgf) : (dl0 < 0 ? __builtin_amdgcn_exp2f((float)(-dl0) * lgb) : 2.0f);
            const float m1 = dl1 > 0 ? __builtin_amdgcn_exp2f((float)dl1 * lgf) : (dl1 < 0 ? __builtin_amdgcn_exp2f((float)(-dl1) * lgb) : 2.0f);
            p0[r] *= m0; p1[r] *= m1;
        }
        bf16x8 pa0, pa1, pa2, pa3; pk4(p0, 0, pa0); pk4(p0, 8, pa1); pk4(p1, 0, pa2); pk4(p1, 8, pa3);
        __builtin_amdgcn_sched_barrier(0);
        attn::pv_d0(o, vb0 + (jt * 2 + eh) * 16384, pa0, pa1, pa2, pa3);
    }
    { const float scf = __builtin_amdgcn_exp2f((float)(i_loc + 1) * lgf), scb = __builtin_amdgcn_exp2f((float)(128 - i_loc) * lgb);
      RET_LOADB(fb, Sf, 1); __builtin_amdgcn_sched_barrier(0);
      RET_MMAB(fa, scf, 0); __builtin_amdgcn_sched_barrier(0); RET_LOADB(fa, Sf, 2); __builtin_amdgcn_sched_barrier(0);
      RET_MMAB(fb, scf, 1); __builtin_amdgcn_sched_barrier(0); RET_LOADB(fb, Sf, 3); __builtin_amdgcn_sched_barrier(0);
      RET_MMAB(fa, scf, 2); __builtin_amdgcn_sched_barrier(0); RET_LOADB(fa, Sb, 0); __builtin_amdgcn_sched_barrier(0);
      RET_MMAB(fb, scf, 3); __builtin_amdgcn_sched_barrier(0); RET_LOADB(fb, Sb, 1); __builtin_amdgcn_sched_barrier(0);
      RET_MMAB(fa, scb, 0); __builtin_amdgcn_sched_barrier(0); RET_LOADB(fa, Sb, 2); __builtin_amdgcn_sched_barrier(0);
      RET_MMAB(fb, scb, 1); __builtin_amdgcn_sched_barrier(0); RET_LOADB(fb, Sb, 3); __builtin_amdgcn_sched_barrier(0);
      RET_MMAB(fa, scb, 2); __builtin_amdgcn_sched_barrier(0);
      RET_MMAB(fb, scb, 3); }
#undef RET_LOADB
#undef RET_MMAB
    __syncthreads();
    float* O = (float*)lds;
#pragma unroll
    for (int r = 0; r < 16; ++r)
#pragma unroll
        for (int d0 = 0; d0 < 4; ++d0) O[(ib * 32 + attn::crow(r, hi)) * 256 + eh * 128 + d0 * 32 + r32] = o[d0][r];
    __syncthreads();
    bf16_t* BR = ws_br(p) + (size_t)q * 128 * 2048 + h * 256;
#pragma unroll 4
    for (int rr = 0; rr < 16; ++rr) {
        const int row = wave * 16 + rr; const f32x4 x = *(const f32x4*)(O + row * 256 + lane * 4);
        const float mean = rw::wave_sum((x[0] + x[1]) + (x[2] + x[3])) * (1.0f / 256.f);
        const f32x4 d = x - mean;
        const float var = rw::wave_sum((d[0] * d[0] + d[1] * d[1]) + (d[2] * d[2] + d[3] * d[3])) * (1.0f / 256.f);
        const float rstd = 1.0f / sqrtf(var + NORM_EPS);
        f32x4 y = d * rstd;
        if (q < 2) { const u32x2 gg = *(const u32x2*)((const bf16_t*)(p.ws + 255 * MiB) + (size_t)(q * 128 + row) * 2048 + h * 256 + lane * 4);
            y[0] *= __uint_as_float(gg.x << 16); y[1] *= __uint_as_float(gg.x & 0xffff0000u); y[2] *= __uint_as_float(gg.y << 16); y[3] *= __uint_as_float(gg.y & 0xffff0000u); }
        u32x2 w; w.x = attn::cvtpk(y[0], y[1]); w.y = attn::cvtpk(y[2], y[3]);
        *(u32x2*)(BR + (size_t)row * 2048 + lane * 4) = w;
    }
    __syncthreads();
}
#undef RPK
#undef RKSWZ
}

namespace na {
using attn::bf16x8; using attn::f32x16; using attn::u32x4;
constexpr float L2E = 1.4426950408889634f;
constexpr int WH = GROWS < 8 ? GROWS : 8;
constexpr int L_K = 0, L_V = 32768, L_WS = 65536, L_RPB = L_WS + NWAVES * 64 * 4, L_END = L_RPB + 15 * 31 * 4;
#define NKSWZ(row, colB) ((row) * 256 + ((colB) ^ (((row) & 7) << 4)))
__device__ __forceinline__ int win_r0(int r) { int r0 = r - WH / 2; return r0 < 0 ? 0 : (r0 > GROWS - WH ? GROWS - WH : r0); }
__device__ __forceinline__ int win_c0(int c) { int c0 = c - 8; return c0 < 0 ? 0 : (c0 > GW - 16 ? GW - 16 : c0); }

__device__ __forceinline__ void na_unit(const Params& p, int rg, int h, char* lds) {
    int tid_ = threadIdx.x; asm volatile("" : "+v"(tid_));
    const int tid = tid_, lane = tid & 63, wave = __builtin_amdgcn_readfirstlane(tid >> 6), r32 = lane & 31, hi = lane >> 5;
    const bf16_t* P = ws_big(p); const bf16_t* NAC = (const bf16_t*)(p.ws + 255 * MiB);
    const int r = 4 * rg + (wave >> 1), qc = (wave & 1) * 32 + r32, my_r0 = win_r0(r), my_c0 = win_c0(qc);
    const int lo = win_r0(4 * rg), hiw = win_r0(4 * rg + 3) + WH, NT = hiw - lo + CTXN / 64;
    float* wsf = (float*)(lds + L_WS) + wave * 64; float* rpb_l = (float*)(lds + L_RPB);
    if (tid < 15 * 31) rpb_l[tid] = p.rpb[h * 15 * 31 + tid];
    bf16x8 qr[4];
    { const bf16_t* Qw = P + (size_t)(CTXN + r * 64 + qc) * NAW + h * 64 + hi * 8;
#pragma unroll
      for (int d0 = 0; d0 < 4; ++d0) qr[d0] = *(const bf16x8*)(Qw + d0 * 16); }
    const int sk = tid >> 3, sc = (tid & 7) * 8, kst = NKSWZ(sk, sc * 2), vst = attn::v_st(sk, sc);
    bf16x8 kA, vA, kB, vB;
#define NA_LOAD(KR, VR, t) do { if ((t) < hiw - lo) { const int krow_ = CTXN + (lo + (t)) * 64 + sk; \
            KR = *(const bf16x8*)(P + (size_t)krow_ * NAW + 1024 + h * 64 + sc); VR = *(const bf16x8*)(P + (size_t)krow_ * NAW + 2048 + h * 64 + sc); } \
        else { const bf16_t* c_ = NAC + (size_t)(((t) - (hiw - lo)) * 64 + sk) * 2048 + h * 64 + sc; KR = *(const bf16x8*)c_; VR = *(const bf16x8*)(c_ + 1024); } } while (0)
#define NA_WRITE(KR, VR, b) do { *(bf16x8*)(lds + L_K + (b) * 16384 + kst) = KR; *(bf16x8*)(lds + L_V + (b) * 16384 + vst) = VR; } while (0)
    NA_LOAD(kA, vA, 0); NA_WRITE(kA, vA, 0);
    NA_LOAD(kB, vB, 1);
    __syncthreads();
    float m_reg = -1e30f, l_reg = 0.f; f32x16 o[2] = {};
    const int vb0 = (int)(uintptr_t)lds + L_V + attn::v_rd_base(lane);
#define NA_TILE(t, KW, VW, KL, VL) do { \
        if ((t) + 2 < NT) NA_LOAD(KL, VL, (t) + 2);            \
        const bool is_ctx = (t) >= hiw - lo; const int kr = lo + (t); \
        if (is_ctx || (kr >= my_r0 && kr < my_r0 + WH)) { \
            const char* Ks = lds + L_K + ((t) & 1) * 16384; \
            f32x16 p0 = {}, p1 = {}; \
            _Pragma("unroll") for (int d0 = 0; d0 < 4; ++d0) { const int cb = (d0 * 16 + hi * 8) * 2; \
                const bf16x8 b0 = *(const bf16x8*)(Ks + NKSWZ(r32, cb)), b1 = *(const bf16x8*)(Ks + NKSWZ(32 + r32, cb)); \
                p0 = __builtin_amdgcn_mfma_f32_32x32x16_bf16(b0, qr[d0], p0, 0, 0, 0); p1 = __builtin_amdgcn_mfma_f32_32x32x16_bf16(b1, qr[d0], p1, 0, 0, 0); } \
            if (is_ctx) { \
                _Pragma("unroll") for (int q = 0; q < 16; ++q) { p0[q] *= 0.125f; p1[q] *= 0.125f; } \
            } else { \
                const float* brow = rpb_l + (kr - r + 7) * 31 + 15 - qc; \
                _Pragma("unroll") for (int q = 0; q < 16; ++q) { const int kc0 = attn::crow(q, hi), kc1 = kc0 + 32; \
                    const bool v0 = kc0 >= my_c0 && kc0 < my_c0 + 16, v1 = kc1 >= my_c0 && kc1 < my_c0 + 16; \
                    p0[q] = v0 ? p0[q] * 0.125f + brow[v0 ? kc0 : qc] : -1e30f; p1[q] = v1 ? p1[q] * 0.125f + brow[v1 ? kc1 : qc] : -1e30f; } \
            } \
            float pmax = p0[0]; \
            _Pragma("unroll") for (int q = 1; q < 16; ++q) pmax = fmaxf(pmax, p0[q]); \
            _Pragma("unroll") for (int q = 0; q < 16; ++q) pmax = fmaxf(pmax, p1[q]); \
            { auto rr = __builtin_amdgcn_permlane32_swap(__float_as_uint(pmax), __float_as_uint(pmax), false, false); pmax = fmaxf(__uint_as_float(rr[0]), __uint_as_float(rr[1])); } \
            const float mn = fmaxf(m_reg, pmax), alpha = __builtin_amdgcn_exp2f((m_reg - mn) * L2E), mnl = -mn * L2E; m_reg = mn; \
            float ps = 0.f; \
            _Pragma("unroll") for (int q = 0; q < 16; ++q) { p0[q] = __builtin_amdgcn_exp2f(fmaf(p0[q], L2E, mnl)); p1[q] = __builtin_amdgcn_exp2f(fmaf(p1[q], L2E, mnl)); ps += p0[q] + p1[q]; } \
            { auto rr = __builtin_amdgcn_permlane32_swap(__float_as_uint(ps), __float_as_uint(ps), false, false); ps = __uint_as_float(rr[0]) + __uint_as_float(rr[1]); } \
            l_reg = l_reg * alpha + ps; \
            if (__any(alpha < 1.f)) { if (hi == 0) wsf[r32] = alpha; asm volatile("s_waitcnt lgkmcnt(0)" ::: "memory"); \
                _Pragma("unroll") for (int d = 0; d < 2; ++d) _Pragma("unroll") for (int q = 0; q < 16; ++q) o[d][q] *= wsf[attn::crow(q, hi)]; } \
            bf16x8 pa0, pa1, pa2, pa3; ret::pk4(p0, 0, pa0); ret::pk4(p0, 8, pa1); ret::pk4(p1, 0, pa2); ret::pk4(p1, 8, pa3); \
            __builtin_amdgcn_sched_barrier(0); \
            const int vb = vb0 + ((t) & 1) * 16384; \
            attn::pv_one<0>(o[0], vb, pa0, pa1, pa2, pa3); attn::pv_one<1>(o[1], vb, pa0, pa1, pa2, pa3); \
        } \
        if ((t) + 1 < NT) NA_WRITE(KW, VW, ((t) + 1) & 1);     \
        __syncthreads(); } while (0)
    for (int t = 0; t < NT; t += 2) {
        NA_TILE(t, kB, vB, kA, vA);
        if (t + 1 < NT) NA_TILE(t + 1, kA, vA, kB, vB);
    }
#undef NA_TILE
#undef NA_LOAD
#undef NA_WRITE
    if (hi == 0) wsf[32 + r32] = l_reg; asm volatile("s_waitcnt lgkmcnt(0)" ::: "memory");
    bf16_t* Ow = ws_br(p) + (size_t)(CTXN + r * 64 + (wave & 1) * 32) * 2048 + h * 64;
#pragma unroll
    for (int q = 0; q < 16; ++q) { const int orow = attn::crow(q, hi); const float rl = __builtin_amdgcn_rcpf(wsf[32 + orow]);
#pragma unroll
        for (int d0 = 0; d0 < 2; ++d0) Ow[(size_t)orow * 2048 + d0 * 32 + r32] = (bf16_t)(attn::cvtpk(o[d0][q] * rl, 0.f) & 0xffffu); }
    __syncthreads();
}
#undef NKSWZ
}

namespace el {
typedef float f32x4 __attribute__((ext_vector_type(4)));
typedef unsigned u32x2 __attribute__((ext_vector_type(2)));
__device__ __forceinline__ float wsum(float v) { return rw::wave_sum(v); }
__device__ __forceinline__ unsigned pk(float lo, float hi) { unsigned r; asm volatile("v_cvt_pk_bf16_f32 %0, %1, %2" : "=v"(r) : "v"(lo), "v"(hi)); return r; }

__device__ __forceinline__ void mod_phase(const Params& p, char* lds) {
    int tid_ = threadIdx.x; asm volatile("" : "+v"(tid_));
    const int tid = tid_, ks = tid >> 6, jl = tid & 63;
    float* sc = (float*)lds; float* red = sc + 2048;
    for (int b = blockIdx.x; b < 2 * 48; b += gridDim.x) {
        const int l = b / 48, j = (b % 48) * 64 + jl;
        __syncthreads();
        for (int k = tid; k < 2048; k += NTHR) { const float x = k < 1024 ? p.c[k] : p.c_ctx[k - 1024]; sc[k] = x / (1.0f + __expf(-x)); }
        __syncthreads();
        const float* w = p.w_mod + (size_t)l * DM * 3072 + (size_t)(ks * 128) * 3072 + j; float a0 = 0.f, a1 = 0.f;
#pragma unroll 8
        for (int k = 0; k < 128; ++k) { const float wv = w[(size_t)k * 3072]; a0 += sc[ks * 128 + k] * wv; a1 += sc[1024 + ks * 128 + k] * wv; }
        red[ks * 64 + jl] = a0; red[512 + ks * 64 + jl] = a1;
        __syncthreads();
        if (tid < 128) { const int s = tid >> 6; float t = 0.f;
#pragma unroll
            for (int q = 0; q < 8; ++q) t += red[s * 512 + q * 64 + jl];
            ws_modv(p)[(l * 2 + s) * 3072 + j] = t + p.b_mod[l * 3072 + j]; }
    }
    __syncthreads();
}

template <int LAYER> __device__ __forceinline__ void modnorm_store(const Params& p, const f32x4 (&v)[4], int row, int lane) {
    const float* mv = ws_modv(p) + (LAYER * 2 + (row < CTXN ? 1 : 0)) * 3072; const float* g = p.g_pre + LAYER * DM;
    float ss = 0.f;
#pragma unroll
    for (int j = 0; j < 4; ++j) ss += (v[j][0] * v[j][0] + v[j][1] * v[j][1]) + (v[j][2] * v[j][2] + v[j][3] * v[j][3]);
    const float rstd = 1.0f / sqrtf(wsum(ss) * (1.0f / DM) + NORM_EPS);
    bf16_t* o = ws_xn(p) + (size_t)row * DM;
#pragma unroll
    for (int j = 0; j < 4; ++j) { const int c = lane * 4 + 256 * j;
        const f32x4 gg = *(const f32x4*)(g + c), sh = *(const f32x4*)(mv + c), sc = *(const f32x4*)(mv + 1024 + c);
        const f32x4 y = v[j] * rstd * gg * (sc + 1.0f) + sh;
        u32x2 w; w.x = pk(y[0], y[1]); w.y = pk(y[2], y[3]); *(u32x2*)(o + c) = w; }
}
__device__ __forceinline__ void prenorm0_phase(const Params& p) {
    int tid_ = threadIdx.x; asm volatile("" : "+v"(tid_));
    const int lane = tid_ & 63, gw = (int)blockIdx.x * NWAVES + (tid_ >> 6), ngw = (int)gridDim.x * NWAVES;
    for (int row = gw; row < R; row += ngw) {
        const float* src = row < CTXN ? p.ctx + (size_t)row * DM : p.x + (size_t)(row - CTXN) * DM;
        f32x4 v[4];
#pragma unroll
        for (int j = 0; j < 4; ++j) v[j] = *(const f32x4*)(src + lane * 4 + 256 * j);
        modnorm_store<0>(p, v, row, lane);
    }
}
template <int LAYER> __device__ __forceinline__ void resid_phase(const Params& p) {
    int tid_ = threadIdx.x; asm volatile("" : "+v"(tid_));
    const int lane = tid_ & 63, gw = (int)blockIdx.x * NWAVES + (tid_ >> 6), ngw = (int)gridDim.x * NWAVES;
    for (int row = (LAYER == 0 ? 0 : CTXN) + gw; row < R; row += ngw) {
        const bool ctxsum = LAYER == 0 && row < CTXN;
        const float* y = ctxsum ? (const float*)(p.ws + WS_BIG + 72 * MiB) + (size_t)row * DM : ws_y(p) + (size_t)row * DM; const float* mv = ws_modv(p) + (LAYER * 2 + (row < CTXN ? 1 : 0)) * 3072 + 2048; const float* g = p.g_post + LAYER * DM;
        const float* src; float* dst;
        if (row < CTXN) { src = p.ctx + (size_t)row * DM; dst = ws_ctx1(p) + (size_t)row * DM; }
        else { src = (LAYER == 0 ? p.x : p.out) + (size_t)(row - CTXN) * DM; dst = p.out + (size_t)(row - CTXN) * DM; }
        f32x4 yv[4]; float ss = 0.f;
#pragma unroll
        for (int j = 0; j < 4; ++j) { yv[j] = *(const f32x4*)(y + lane * 4 + 256 * j);
            if (ctxsum) { _Pragma("unroll") for (int s = 1; s < 8; ++s) yv[j] += *(const f32x4*)(y + (size_t)s * CTXN * DM + lane * 4 + 256 * j); }
            ss += (yv[j][0] * yv[j][0] + yv[j][1] * yv[j][1]) + (yv[j][2] * yv[j][2] + yv[j][3] * yv[j][3]); }
        const float rstd = 1.0f / sqrtf(wsum(ss) * (1.0f / DM) + NORM_EPS);
        f32x4 xn[4];
#pragma unroll
        for (int j = 0; j < 4; ++j) { const int c = lane * 4 + 256 * j;
            xn[j] = *(const f32x4*)(src + c) + *(const f32x4*)(mv + c) * (yv[j] * rstd * *(const f32x4*)(g + c));
            *(f32x4*)(dst + c) = xn[j]; }
        if (LAYER == 0) modnorm_store<1>(p, xn, row, lane);
    }
}
__device__ __forceinline__ void ropenorm_phase(const Params& p) {
    int tid_ = threadIdx.x; asm volatile("" : "+v"(tid_));
    const int lane = tid_ & 63, gw = (int)blockIdx.x * NWAVES + (tid_ >> 6), ngw = (int)gridDim.x * NWAVES;
    const float* ct = ws_rope(p); const float* st = ct + N_ROPE;
    const float qn0 = p.q_norm[2 * lane], qn1 = p.q_norm[2 * lane + 1], kn0 = p.k_norm[2 * lane], kn1 = p.k_norm[2 * lane + 1];
    for (int row = gw; row < R; row += ngw) {
        const bool rot = row >= CTXN; const int t = row - CTXN; float cs = 1.f, sn = 0.f;
        if (rot) { const int pos = lane < 32 ? t / GW : t % GW, f = lane & 31; cs = ct[pos * 32 + f]; sn = st[pos * 32 + f]; }
        bf16_t* base = ws_big(p) + (size_t)row * P0W;
#pragma unroll
        for (int slot = 0; slot < 18; ++slot) {
            const int col = slot < 4 ? C_QA + slot * 128 : slot < 8 ? C_KA + (slot - 4) * 128 : slot < 16 ? C_QB + (slot - 8) * 128 : C_KB + (slot - 16) * 128;
            unsigned* ptr = (unsigned*)(base + col) + lane; const unsigned u = *ptr;
            float x1 = __uint_as_float(u << 16), x2 = __uint_as_float(u & 0xffff0000u);
            if (slot >= 4 && slot < 8) { x1 *= 0.08838834764831845f; x2 *= 0.08838834764831845f; }
            if (slot >= 8) { const float sc = 1.0f / sqrtf(wsum(x1 * x1 + x2 * x2) * (1.0f / 128.f) + NORM_EPS);
                x1 *= sc * (slot < 16 ? qn0 : kn0); x2 *= sc * (slot < 16 ? qn1 : kn1); }
            *ptr = pk(x1 * cs - x2 * sn, x1 * sn + x2 * cs);
        }
    }
}
}

constexpr int RING_BYTES = 131072, LDS_BYTES = 163840;
constexpr size_t WS_BAR = 256 * 1024;
constexpr size_t WS_SIDE = 255 * MiB;
constexpr size_t WS_YC = WS_BIG + 72 * MiB;
constexpr int LDS_BARW = LDS_BYTES - 64;
constexpr size_t WB_IN0 = WS_WB, WB_OUT0 = WB_IN0 + (size_t)EVEN_IN * DM * 2, WB_IN1 = WB_OUT0 + (size_t)DM * 2048 * 2, WB_OUT1 = WB_IN1 + (size_t)ODD_IN * DM * 2, WB_END = WB_OUT1 + (size_t)DM * 2048 * 2;
static_assert(WB_END <= WS_XN, "weight copies overflow their region");
static_assert(wy::WS_RING + wy::RING_TOTAL <= WB_IN1 && XCD_BAR_WORDS * 4 <= 16384 && wy::WS_WYF + (size_t)wy::WYF_WORDS * 4 <= WS_CTX1, "rwkv ring / flag words");

__device__ __forceinline__ unsigned pk2(float lo, float hi) { return (unsigned)f2bf(lo) | ((unsigned)f2bf(hi) << 16); }
__device__ __forceinline__ void transpose_item(const float* W, int K, int N, int ldw, bf16_t* WT, LAS float* scr, int item, int lane) {
    const int nblk = N / 32, kb = item / nblk, nb = item % nblk, k0 = 64 * kb, n0 = 32 * nb;
#pragma unroll 8
    for (int i = 0; i < 32; ++i) { const int kk = 2 * i + (lane >> 5); scr[kk * 33 + (lane & 31)] = W[(size_t)(k0 + kk) * ldw + n0 + (lane & 31)]; }
    asm volatile("s_waitcnt lgkmcnt(0)" ::: "memory");
    const int c = lane & 7;
#pragma unroll
    for (int j = 0; j < 4; ++j) { const int n = (lane >> 3) + 8 * j; const LAS float* s = scr + (8 * c) * 33 + n;
        v4u o; o.x = pk2(s[0 * 33], s[1 * 33]); o.y = pk2(s[2 * 33], s[3 * 33]); o.z = pk2(s[4 * 33], s[5 * 33]); o.w = pk2(s[6 * 33], s[7 * 33]);
        *(v4u*)(WT + (size_t)(n0 + n) * K + k0 + 8 * c) = o; }
    asm volatile("s_waitcnt lgkmcnt(0)" ::: "memory");
}
__device__ __forceinline__ void p0_weights(const Params& p, LAS unsigned char* lds) {
    const int lane = threadIdx.x & 63, wave = __builtin_amdgcn_readfirstlane(threadIdx.x >> 6);
    LAS float* scr = (LAS float*)(lds + wave * 16384);
    const int gw = blockIdx.x * NWAVES + wave, NGW = gridDim.x * NWAVES;
    constexpr int I_IN0 = (DM / 64) * (EVEN_IN / 32), I_OUT = (2048 / 64) * (DM / 32), I_IN1 = (DM / 64) * (ODD_IN / 32);
    for (int it = gw; it < I_IN0 + I_OUT + I_IN1 + I_OUT; it += NGW) {
        int r = it;
        if (r < I_IN0) { transpose_item(p.ev_w_in, DM, EVEN_IN, EVEN_IN, (bf16_t*)(p.ws + WB_IN0), scr, r, lane); continue; } r -= I_IN0;
        if (r < I_OUT) { transpose_item(p.ev_w_out, 2048, DM, DM, (bf16_t*)(p.ws + WB_OUT0), scr, r, lane); continue; } r -= I_OUT;
        if (r < I_IN1) { transpose_item(p.od_w_in, DM, ODD_IN, ODD_IN, (bf16_t*)(p.ws + WB_IN1), scr, r, lane); continue; } r -= I_IN1;
        transpose_item(p.od_w_out, 2048, DM, DM, (bf16_t*)(p.ws + WB_OUT1), scr, r, lane);
    }
}

template <class Epi> __device__ __forceinline__ void run_gemm(LAS unsigned char* lds, const bf16_t* A, const bf16_t* Bt, int M, int N, int K, const Epi& E, int rot = 0, int lda = 0, int ldb = 0) {
    const int G = (int)gridDim.x;
    pg8::Gemm g{A, Bt, M, N, K, lda, ldb}; pg8::StaticOrder S; S.init(M, N, G, ((int)blockIdx.x + rot) % G);
    pg8::gemm_phase<Epi, pg8::StaticOrder, true, true>(lds, g, S, E);
}
__device__ __forceinline__ int tail_rot(int units) { const int G = (int)gridDim.x; return (G - units % G) % G; }

#ifndef PROBE
#define PROBE 0
#endif
#define REP(bit) for (int rep_ = 0; rep_ < (((PROBE) >> (bit)) & 1) + 1; ++rep_)
__global__ void __launch_bounds__(NTHR, 2) mega(Params p) {
    extern __shared__ __attribute__((aligned(16))) unsigned char lds_raw[];
    cg::grid_group grid = cg::this_grid();
    LAS unsigned char* lds = (LAS unsigned char*)lds_raw;
    const long gsz = (long)gridDim.x * NTHR;
    if (threadIdx.x < 2) *(LAS unsigned*)(lds + LDS_BARW + 4 * threadIdx.x) = 0u;
    __syncthreads();
    const XcdBarrier xbar = xcd_barrier_post((unsigned*)(p.ws + WS_BAR), (volatile LAS unsigned*)(lds + LDS_BARW));
    const bf16_t* wt_in0 = (const bf16_t*)(p.ws + WB_IN0); const bf16_t* wt_out0 = (const bf16_t*)(p.ws + WB_OUT0);
    const bf16_t* wt_in1 = (const bf16_t*)(p.ws + WB_IN1); const bf16_t* wt_out1 = (const bf16_t*)(p.ws + WB_OUT1);
#define X(fn, n) { int t_ = threadIdx.x; asm volatile("" : "+v"(t_)); for (long g = (long)blockIdx.x * NTHR + t_; g < (long)(n); g += gsz) fn(p, g); }
#define SYNC xcd_barrier(xbar);
    if ((PROBE >> 13) & 1) { for (int i_ = 0; i_ < 20; ++i_) xcd_barrier(xbar); }
    REP(14) { el::mod_phase(p, (char*)lds_raw); X(ph_rope_table, N_ROPE) p0_weights(p, lds);
              if (p.out == nullptr) grid.sync();
              SYNC }
    REP(15) { el::prenorm0_phase(p); SYNC }
    REP(2) { run_gemm(lds, ws_xn(p), wt_in0, R, P0W, DM, pg8::EpiBf16<0>{ws_big(p), P0W, nullptr, 0, 0, 1.f});
             run_gemm(lds, ws_xn(p), wt_in0 + (size_t)C_GA * DM, CTXN, 2048, DM, pg8::EpiSiluBf16{(bf16_t*)(p.ws + WS_SIDE), 2048}, tail_rot((R / 256) * (P0W / 256)));
             SYNC }
    el::ropenorm_phase(p); SYNC
    REP(5) { for (int u = blockIdx.x; u < ret::NQ * 4; u += gridDim.x) { const int q = u < (ret::NQ - 2) * 4 ? 2 + u / 4 : (u - (ret::NQ - 2) * 4) / 4; ret::summaries_unit(p, q, u & 3, (char*)lds_raw); } SYNC }
    ret::state_scan(p); SYNC
    REP(6) { for (int u = blockIdx.x; u < ret::NQ * 4; u += gridDim.x) { const int q = u < (ret::NQ - 2) * 4 ? 2 + u / 4 : (u - (ret::NQ - 2) * 4) / 4; ret::output_unit(p, q, u & 3, (char*)lds_raw); } SYNC }
    REP(0) {
        const int G = (int)gridDim.x, vcu = (G % 8 == 0) ? ((int)blockIdx.x % 8) * (G / 8) + (int)blockIdx.x / 8 : (int)blockIdx.x;
        const int NLAT = (SEQ / 256) * 8, per = (NLAT + G - 1) / G;
        const bf16_t* P = ws_big(p); bf16_t* BR = ws_br(p);
        for (int i = 0; i <= per; ++i) {
            int head, row0, seq;
            if (i < per) { const int unit = vcu * per + i; if (unit >= NLAT) continue; const int nqb = SEQ / 256, kv = unit / (4 * nqb), rem = unit % (4 * nqb); head = kv * 4 + rem / nqb; row0 = CTXN + (rem % nqb) * 256; seq = R; }
            else { if (vcu >= 8) break; head = vcu; row0 = 0; seq = CTXN; }
            const int kv = head / 4;
            attn::attn_dense_body<attn::bf16>(P + (size_t)row0 * P0W + C_QB + head * 128, P + C_KB + kv * 128, P + C_VB + kv * 128, BR + (size_t)row0 * 2048 + 1024 + head * 128, seq, (char*)lds_raw);
            __syncthreads();
            if (row0 == 0) {
                int t_ = threadIdx.x; asm volatile("" : "+v"(t_)); const bf16_t* GC = (const bf16_t*)(p.ws + WS_SIDE);
                const size_t o = (size_t)(t_ >> 1) * 2048 + 1024 + head * 128 + (t_ & 1) * 64;
#pragma unroll
                for (int i = 0; i < 8; ++i) { v4u a = *(const v4u*)(BR + o + 8 * i); const v4u b = *(const v4u*)(GC + o + 8 * i);
#pragma unroll
                    for (int q = 0; q < 4; ++q) a[q] = attn::cvtpk(__uint_as_float(a[q] << 16) * __uint_as_float(b[q] << 16), __uint_as_float(a[q] & 0xffff0000u) * __uint_as_float(b[q] & 0xffff0000u));
                    *(v4u*)(BR + o + 8 * i) = a; }
                __syncthreads();
            }
        }
        if (PROBE & 1) xcd_barrier(xbar);
    }
    SYNC
    run_gemm(lds, ws_xn(p) + (size_t)CTXN * DM, wt_in0 + (size_t)C_GA * DM, SEQ, 2048, DM, pg8::EpiGateMul{ws_br(p) + (size_t)CTXN * 2048, 2048});
    {
        pg8::Gemm gk{ws_br(p), wt_out0, 8 * 256, DM, 256, 2048, 2048, 256 * 2}; pg8::StaticOrder S; S.init(8 * 256, DM, (int)gridDim.x, (int)blockIdx.x);
        pg8::gemm_phase<pg8::EpiF32, pg8::StaticOrder, true, true>(lds, gk, S, pg8::EpiF32{(float*)(p.ws + WS_YC), DM}); }
    SYNC
    REP(4) { run_gemm(lds, ws_br(p) + (size_t)CTXN * 2048, wt_out0, SEQ, DM, 2048, pg8::EpiF32{ws_y(p) + (size_t)CTXN * DM, DM}); SYNC }
    REP(15) { el::resid_phase<0>(p); SYNC }
    REP(3) { run_gemm(lds, ws_xn(p), wt_in1 + (size_t)O_RW * DM, R, ZW, DM, pg8::EpiBf16<0>{ws_big(p), ZW, nullptr, 0, 0, 1.f});
             run_gemm(lds, ws_xn(p), wt_in1 + (size_t)(O_NA + 1024) * DM, CTXN, 2048, DM, pg8::EpiBf16<0>{(bf16_t*)(p.ws + WS_SIDE), 2048, nullptr, 0, 0, 1.f}, tail_rot((R / 256) * (ZW / 256)));
             SYNC }
    rw::shift_halo(p); SYNC
    rw::shift_inplace(p); wy::zero_words(p); SYNC
    if ((PROBE >> 16) & 1) { wy::phase<1>(p, lds); SYNC wy::zero_words(p); SYNC }
    if ((PROBE >> 17) & 1) { wy::phase<2>(p, lds); SYNC wy::zero_words(p); SYNC }
    if ((PROBE >> 18) & 1) { wy::phase<3>(p, lds); SYNC wy::zero_words(p); SYNC }
    if (gridDim.x >= 64) wy::phase<0>(p, lds);
    else { for (int b = blockIdx.x; b < 256; b += gridDim.x) rw::scan_block<0>(p, b, lds); }
    SYNC
    rw::finish_phase(p); SYNC
    REP(3) { run_gemm(lds, ws_xn(p) + (size_t)CTXN * DM, wt_in1 + (size_t)O_NA * DM, SEQ, NAW, DM, pg8::EpiBf16<0>{ws_big(p) + (size_t)CTXN * NAW, NAW, nullptr, 0, 0, 1.f}); SYNC }
    REP(7) { for (int u = blockIdx.x; u < (GROWS / 4) * 16; u += gridDim.x) na::na_unit(p, u >> 4, u & 15, (char*)lds_raw); SYNC }
    run_gemm(lds, ws_xn(p) + (size_t)CTXN * DM, wt_in1 + (size_t)O_GC * DM, SEQ, 2048, DM, pg8::EpiGateMul{ws_br(p) + (size_t)CTXN * 2048, 2048}); SYNC
    REP(4) { run_gemm(lds, ws_br(p) + (size_t)CTXN * 2048, wt_out1, SEQ, DM, 2048, pg8::EpiF32{ws_y(p) + (size_t)CTXN * DM, DM}); SYNC }
    el::resid_phase<1>(p);
#undef X
#undef SYNC
}

extern "C" void kernel_launch(void* const* d_in, const int* in_sizes, int n_in, void* d_out, int out_size, void* d_ws, size_t ws_size, hipStream_t stream) {
    static int grid_blocks = 0;
    if (!grid_blocks) {
        int dev = 0, cus = 0, per_cu = 0;
        (void)hipGetDevice(&dev); (void)hipDeviceGetAttribute(&cus, hipDeviceAttributeMultiprocessorCount, dev);
        (void)hipFuncSetAttribute((const void*)mega, hipFuncAttributeMaxDynamicSharedMemorySize, LDS_BYTES);
        (void)hipOccupancyMaxActiveBlocksPerMultiprocessor(&per_cu, mega, NTHR, LDS_BYTES);
        if (per_cu < 1) per_cu = 1;
        grid_blocks = cus * per_cu;
        if (ws_size < WS_END) fprintf(stderr, "kernel_launch: workspace too small: %zu < %zu\n", ws_size, (size_t)WS_END);
    }
    (void)hipMemsetAsync((char*)d_ws + WS_BAR, 0, XCD_BAR_WORDS * 4, stream);
    Params p = make_params(d_in, d_out, d_ws);
    void* args[] = {&p};
    hipError_t e = hipLaunchCooperativeKernel((void*)mega, dim3(grid_blocks), dim3(NTHR), args, LDS_BYTES, stream);
    if (e != hipSuccess) fprintf(stderr, "cooperative launch failed: %s (grid %d)\n", hipGetErrorString(e), grid_blocks);
}

#else
int main(int argc, char** argv) {
    const char* dir = argc > 1 ? argv[1] : "data";
    char path[512]; snprintf(path, 512, "%s/sizes.txt", dir); FILE* f = fopen(path, "r"); if (!f) { printf("no sizes\n"); return 1; }
    std::vector<long> sizes; long v; while (fscanf(f, "%ld", &v) == 1) sizes.push_back(v); fclose(f);
    if (sizes.size() != 31) { printf("bad n inputs %zu\n", sizes.size()); return 1; }
    snprintf(path, 512, "%s/inputs.bin", dir); f = fopen(path, "rb");
    std::vector<std::vector<float>> in(31); std::vector<void*> ptrs(31);
    for (int i = 0; i < 31; ++i) { in[i].resize(sizes[i]); if (fread(in[i].data(), 4, sizes[i], f) != (size_t)sizes[i]) { printf("short read\n"); return 1; } ptrs[i] = in[i].data(); }
    fclose(f);
    if (sizes[0] != (long)SEQ * DM) { printf("SEQ mismatch: build with -DSEQ_LEN=%ld\n", sizes[0] / DM); return 1; }
    std::vector<float> out((size_t)SEQ * DM, 0.f); std::vector<unsigned char> ws(WS_END, 0xAA);
    Params p = make_params(ptrs.data(), out.data(), ws.data());
    auto check = [&](const char* name, const float* got, size_t n) {
        snprintf(path, 512, "%s/%s", dir, name); FILE* g = fopen(path, "rb"); std::vector<float> ref(n); if (fread(ref.data(), 4, n, g) != n) printf("short ref\n"); fclose(g);
        double num = 0, den = 0, mx = 0; for (size_t i = 0; i < n; ++i) { const double d = (double)got[i] - ref[i]; num += d * d; den += (double)ref[i] * ref[i]; if (fabs(d) > mx) mx = fabs(d); }
        printf("%s: rvr=%.3e absmax=%.3e\n", name, num / den, mx); };
    static RwShared sh;
    int phase = 0;
#define X(fn, n) { printf("phase %d %s n=%ld\n", phase++, #fn, (long)(n)); fflush(stdout); _Pragma("omp parallel for schedule(dynamic, 64)") for (long g = 0; g < (long)(n); ++g) fn(p, g); }
#define SYNC
#define SCAN { printf("phase %d scan\n", phase++); fflush(stdout); _Pragma("omp parallel for schedule(dynamic, 1)") for (int b = 0; b < 32; ++b) { RwShared* s = new RwShared; rwkv_scan_block(p, b, *s); delete s; } }
    X(ph_mod, N_MOD) X(ph_rope_table, N_ROPE) X(ph_prenorm<0>, (long)R) X(ph_gemm_l0_qkv, (long)R * P0W) X(ph_ropenorm, N_ROPENORM) X(ph_ret_scan, N_RETSCAN)
    X(ph_ret_merge, N_RETMERGE) X(ph_gqa_attn, N_GQA) X(ph_gemm_l0_gate, (long)R * 2048) X(ph_gemm_l0_out, (long)R * DM) X(ph_resid<0>, (long)R)
    check("x0.bin", out.data(), out.size()); check("ctx0.bin", ws_ctx1(p), (size_t)CTXN * DM);
    X(ph_prenorm<1>, (long)R) X(ph_gemm_l1_rw, (long)R * ZW) SCAN X(ph_rwkv_finish, N_RWFIN) X(ph_gemm_l1_na, (long)R * NAW) X(ph_na, N_NA)
    X(ph_gemm_l1_gate, (long)SEQ * 2048) X(ph_gemm_l1_out, (long)SEQ * DM) X(ph_resid<1>, (long)SEQ)
    check("out.bin", out.data(), out.size());
    return 0;
}
#endif
```

```cpp
#ifdef CPU_EMU
#include <cstdio>
#include <cstdlib>
#include <cstring>
#include <cmath>
#include <vector>
#define DEV static inline
#else
#include <hip/hip_runtime.h>
#include <hip/hip_cooperative_groups.h>
#include <cstdio>
namespace cg = cooperative_groups;
#define DEV __device__ __forceinline__
#endif

#ifndef SEQ_LEN
#define SEQ_LEN 16384
#endif
typedef unsigned short bf16_t;
constexpr int DM = 1024, CTXN = 256, SEQ = SEQ_LEN, R = CTXN + SEQ, GW = 64, GROWS = SEQ / GW;
constexpr int EVEN_IN = 5632, ODD_IN = 8448;
constexpr int P0W = 3584;
constexpr int C_QA = 0, C_KA = 512, C_VA = 1024, C_QB = 2048, C_KB = 3072, C_VB = 3328, C_GA = 3584;
constexpr int ZW = 3328;
constexpr int O_NA = 0, O_RW = 3072, O_GC = 6400;
constexpr int NAW = 3072;
constexpr float NORM_EPS = 1e-6f, GN_EPS = 64e-5f;

constexpr size_t MiB = 1u << 20;
constexpr size_t WS_MODV = 0;
constexpr size_t WS_ROPE = 64 * 1024;
constexpr size_t WS_CTX1 = 1 * MiB;
constexpr size_t WS_WB = 2 * MiB;
constexpr size_t WS_XN = 42 * MiB;
constexpr size_t WS_BIG = WS_XN + (((size_t)R * DM * 2 + MiB - 1) / MiB) * MiB;
constexpr size_t WS_BR = WS_BIG + (((size_t)R * P0W * 2 + MiB - 1) / MiB) * MiB;
constexpr size_t WS_END = WS_BR + (size_t)R * 2048 * 2;
static_assert(SEQ != 16384 || WS_END <= 256 * MiB, "workspace map exceeds 256 MiB");

struct Params {
    const float *x, *c, *ctx, *c_ctx, *w_mod, *b_mod, *g_pre, *g_post, *ev_w_in, *ev_w_out, *dec_f, *dec_b, *q_norm, *k_norm;
    const float *od_w_in, *od_w_out, *rpb, *mu, *w0f, *w2f, *w0b, *w2b, *a0f, *a2f, *a0b, *a2b, *k_k, *k_a, *r_k, *lnx_g, *lnx_b;
    float* out; unsigned char* ws;
};

DEV bf16_t f2bf(float f) { unsigned u; __builtin_memcpy(&u, &f, 4); u = (u + 0x7fffu + ((u >> 16) & 1u)) >> 16; return (bf16_t)u; }
DEV float bf2f(bf16_t h) { unsigned u = ((unsigned)h) << 16; float f; __builtin_memcpy(&f, &u, 4); return f; }
DEV float siluf(float x) { return x / (1.0f + expf(-x)); }
DEV float sigmf(float x) { return 1.0f / (1.0f + expf(-x)); }
DEV float softplusf(float x) { return fmaxf(x, 0.f) + log1pf(expf(-fabsf(x))); }

DEV float* ws_modv(const Params& p) { return (float*)(p.ws + WS_MODV); }
DEV float* ws_rope(const Params& p) { return (float*)(p.ws + WS_ROPE); }
DEV float* ws_ctx1(const Params& p) { return (float*)(p.ws + WS_CTX1); }
DEV bf16_t* ws_xn(const Params& p) { return (bf16_t*)(p.ws + WS_XN); }
DEV bf16_t* ws_big(const Params& p) { return (bf16_t*)(p.ws + WS_BIG); }
DEV float* ws_y(const Params& p) { return (float*)(p.ws + WS_BIG); }
DEV bf16_t* ws_br(const Params& p) { return (bf16_t*)(p.ws + WS_BR); }

constexpr long N_MOD = 2 * 2 * 3072;
DEV void ph_mod(const Params& p, long gid) {
    const int j = (int)(gid % 3072), s = (int)((gid / 3072) % 2), l = (int)(gid / 6144);
    const float* cv = s ? p.c_ctx : p.c; const float* w = p.w_mod + (size_t)l * DM * 3072 + j;
    float acc = 0.f;
    for (int k = 0; k < DM; ++k) acc += siluf(cv[k]) * w[(size_t)k * 3072];
    ws_modv(p)[gid] = acc + p.b_mod[l * 3072 + j];
}
constexpr long N_ROPE = 256 * 32;
DEV void ph_rope_table(const Params& p, long gid) {
    const int f = (int)(gid % 32), pos = (int)(gid / 32);
    const float inv = powf(10000.0f, -(float)f / 32.0f); const float ang = (float)pos * inv;
    ws_rope(p)[gid] = cosf(ang); ws_rope(p)[N_ROPE + gid] = sinf(ang);
}
template <int LAYER> DEV void ph_prenorm(const Params& p, long gid) {
    const int row = (int)gid; const int s = row < CTXN ? 1 : 0;
    const float* src = row < CTXN ? ((LAYER == 0 ? p.ctx : ws_ctx1(p)) + (size_t)row * DM) : ((LAYER == 0 ? p.x : p.out) + (size_t)(row - CTXN) * DM);
    const float* mv = ws_modv(p) + (LAYER * 2 + s) * 3072; const float* g = p.g_pre + LAYER * DM;
    float ss = 0.f;
    for (int k = 0; k < DM; ++k) ss += src[k] * src[k];
    const float rstd = 1.0f / sqrtf(ss / DM + NORM_EPS);
    bf16_t* o = ws_xn(p) + (size_t)row * DM;
    for (int k = 0; k < DM; ++k) o[k] = f2bf(src[k] * rstd * g[k] * (1.0f + mv[1024 + k]) + mv[k]);
}
template <int MODE> DEV void gemm_item(const bf16_t* A, int K, const float* W, int ldw, void* out, int pitch, int row, int col) {
    const bf16_t* a = A + (size_t)row * K; const float* w = W + col; float acc = 0.f;
    for (int k = 0; k < K; ++k) acc += bf2f(a[k]) * w[(size_t)k * ldw];
    if (MODE == 0) ((bf16_t*)out)[(size_t)row * pitch + col] = f2bf(acc);
    else if (MODE == 1) { bf16_t* o = (bf16_t*)out + (size_t)row * pitch + col; *o = f2bf(siluf(acc) * bf2f(*o)); }
    else ((float*)out)[(size_t)row * pitch + col] = acc;
}
DEV void ph_gemm_l0_qkv(const Params& p, long gid) { gemm_item<0>(ws_xn(p), DM, p.ev_w_in, EVEN_IN, ws_big(p), P0W, (int)(gid / P0W), (int)(gid % P0W)); }
DEV void ph_gemm_l0_gate(const Params& p, long gid) { gemm_item<1>(ws_xn(p), DM, p.ev_w_in + C_GA, EVEN_IN, ws_br(p), 2048, (int)(gid / 2048), (int)(gid % 2048)); }
DEV void ph_gemm_l0_out(const Params& p, long gid) { gemm_item<2>(ws_br(p), 2048, p.ev_w_out, DM, ws_y(p), DM, (int)(gid / DM), (int)(gid % DM)); }
DEV void ph_gemm_l1_rw(const Params& p, long gid) { gemm_item<0>(ws_xn(p), DM, p.od_w_in + O_RW, ODD_IN, ws_big(p), ZW, (int)(gid / ZW), (int)(gid % ZW)); }
DEV void ph_gemm_l1_na(const Params& p, long gid) { gemm_item<0>(ws_xn(p), DM, p.od_w_in + O_NA, ODD_IN, ws_big(p), NAW, (int)(gid / NAW), (int)(gid % NAW)); }
DEV void ph_gemm_l1_gate(const Params& p, long gid) { gemm_item<1>(ws_xn(p), DM, p.od_w_in + O_GC, ODD_IN, ws_br(p), 2048, CTXN + (int)(gid / 2048), (int)(gid % 2048)); }
DEV void ph_gemm_l1_out(const Params& p, long gid) { gemm_item<2>(ws_br(p), 2048, p.od_w_out, DM, ws_y(p), DM, CTXN + (int)(gid / DM), (int)(gid % DM)); }

constexpr long N_ROPENORM = (long)R * 18;
DEV void ph_ropenorm(const Params& p, long gid) {
    const int slot = (int)(gid % 18), row = (int)(gid / 18);
    int col; const float* nw = nullptr; float sc = 1.f;
    if (slot < 4) col = C_QA + slot * 128; else if (slot < 8) { col = C_KA + (slot - 4) * 128; sc = 0.08838834764831845f; }
    else if (slot < 16) { col = C_QB + (slot - 8) * 128; nw = p.q_norm; } else { col = C_KB + (slot - 16) * 128; nw = p.k_norm; }
    bf16_t* v = ws_big(p) + (size_t)row * P0W + col;
    if (nw) { float ss = 0.f; for (int d = 0; d < 128; ++d) { const float t = bf2f(v[d]); ss += t * t; } sc = 1.0f / sqrtf(ss / 128.f + NORM_EPS); }
    const bool rot = row >= CTXN; const int t = row - CTXN; const int gr = rot ? t / GW : 0, gc = rot ? t % GW : 0;
    const float* ct = ws_rope(p); const float* st = ct + N_ROPE;
    for (int i = 0; i < 64; ++i) {
        float x1 = bf2f(v[2 * i]) * sc, x2 = bf2f(v[2 * i + 1]) * sc;
        if (nw) { x1 *= nw[2 * i]; x2 *= nw[2 * i + 1]; }
        if (rot) { const int pos = i < 32 ? gr : gc, f = i & 31; const float cs = ct[pos * 32 + f], sn = st[pos * 32 + f]; const float y1 = x1 * cs - x2 * sn, y2 = x1 * sn + x2 * cs; x1 = y1; x2 = y2; }
        v[2 * i] = f2bf(x1); v[2 * i + 1] = f2bf(x2);
    }
}
constexpr long N_RETSCAN = 2 * 4 * 256;
DEV void ph_ret_scan(const Params& p, long gid) {
    const int e = (int)(gid % 256), h = (int)((gid / 256) % 4), dir = (int)(gid / 1024);
    const float g = sigmf((dir ? p.dec_b : p.dec_f)[h]);
    float S[128];
#pragma unroll
    for (int d = 0; d < 128; ++d) S[d] = 0.f;
    const bf16_t* P = ws_big(p); bf16_t* BR = ws_br(p);
    for (int pos = 0; pos < R; ++pos) {
        int row; if (pos < CTXN) row = dir ? CTXN - 1 - pos : pos; else { const int t = pos - CTXN; row = CTXN + (dir ? SEQ - 1 - t : t); }
        const bf16_t* pr = P + (size_t)row * P0W; const float v = bf2f(pr[C_VA + h * 256 + e]);
        const bf16_t* kq = pr + C_KA + h * 128; const bf16_t* qq = pr + C_QA + h * 128; float y = 0.f;
#pragma unroll
        for (int d = 0; d < 128; ++d) { S[d] = g * S[d] + bf2f(kq[d]) * v; y += bf2f(qq[d]) * S[d]; }
        BR[(size_t)row * 2048 + dir * 1024 + h * 256 + e] = f2bf(y);
    }
}
constexpr long N_RETMERGE = (long)R * 4;
DEV void ph_ret_merge(const Params& p, long gid) {
    const int h = (int)(gid % 4), row = (int)(gid / 4);
    bf16_t* b = ws_br(p) + (size_t)row * 2048 + h * 256;
    float s = 0.f; for (int e = 0; e < 256; ++e) s += bf2f(b[e]) + bf2f(b[1024 + e]);
    const float mean = s / 256.f; float q = 0.f;
    for (int e = 0; e < 256; ++e) { const float d = bf2f(b[e]) + bf2f(b[1024 + e]) - mean; q += d * d; }
    const float rstd = 1.0f / sqrtf(q / 256.f + NORM_EPS);
    for (int e = 0; e < 256; ++e) b[e] = f2bf((bf2f(b[e]) + bf2f(b[1024 + e]) - mean) * rstd);
}
constexpr long N_GQA = (long)R * 8 * 8;
DEV void ph_gqa_attn(const Params& p, long gid) {
    const int sl = (int)(gid % 8), row = (int)((gid / 8) % R), head = (int)(gid / (8L * R)), g = head / 4;
    const bf16_t* P = ws_big(p); const int nk = row < CTXN ? CTXN : R;
    float q[128];
    { const bf16_t* qp = P + (size_t)row * P0W + C_QB + head * 128;
#pragma unroll
      for (int d = 0; d < 128; ++d) q[d] = bf2f(qp[d]) * 0.08838834764831845f; }
    float acc[16];
#pragma unroll
    for (int i = 0; i < 16; ++i) acc[i] = 0.f;
    float m = -1e30f, l = 0.f;
    for (int j = 0; j < nk; ++j) {
        const bf16_t* kp = P + (size_t)j * P0W + C_KB + g * 128; float s = 0.f;
#pragma unroll
        for (int d = 0; d < 128; ++d) s += q[d] * bf2f(kp[d]);
        const float mn = fmaxf(m, s), al = expf(m - mn), pe = expf(s - mn);
        const bf16_t* vp = P + (size_t)j * P0W + C_VB + g * 128 + sl * 16;
        l = l * al + pe;
#pragma unroll
        for (int i = 0; i < 16; ++i) acc[i] = acc[i] * al + pe * bf2f(vp[i]);
        m = mn;
    }
    bf16_t* o = ws_br(p) + (size_t)row * 2048 + 1024 + head * 128 + sl * 16; const float il = 1.0f / l;
#pragma unroll
    for (int i = 0; i < 16; ++i) o[i] = f2bf(acc[i] * il);
}
template <int LAYER> DEV void ph_resid(const Params& p, long gid) {
    const int row = LAYER == 0 ? (int)gid : CTXN + (int)gid; const int s = row < CTXN ? 1 : 0;
    const float* y = ws_y(p) + (size_t)row * DM; const float* mv = ws_modv(p) + (LAYER * 2 + s) * 3072 + 2048; const float* g = p.g_post + LAYER * DM;
    float ss = 0.f; for (int k = 0; k < DM; ++k) ss += y[k] * y[k];
    const float rstd = 1.0f / sqrtf(ss / DM + NORM_EPS);
    const float* src; float* dst;
    if (row < CTXN) { src = p.ctx + (size_t)row * DM; dst = ws_ctx1(p) + (size_t)row * DM; }
    else { src = (LAYER == 0 ? p.x : p.out) + (size_t)(row - CTXN) * DM; dst = p.out + (size_t)(row - CTXN) * DM; }
    for (int k = 0; k < DM; ++k) dst[k] = src[k] + mv[k] * (y[k] * rstd * g[k]);
}
DEV float zshift(const bf16_t* Z, const float* mu, int row, int col) {
    const int lo = row < CTXN ? 0 : CTXN, hi = row < CTXN ? CTXN : R;
    const float z = bf2f(Z[(size_t)row * ZW + col]);
    const float pv = row > lo ? bf2f(Z[(size_t)(row - 1) * ZW + col]) : 0.f, nx = row + 1 < hi ? bf2f(Z[(size_t)(row + 1) * ZW + col]) : 0.f;
    return z + (0.5f * (pv + nx) - z) * mu[col];
}
constexpr long N_RWFIN = (long)SEQ * 16;
DEV void ph_rwkv_finish(const Params& p, long gid) {
    const int h = (int)(gid % 16), t = (int)(gid / 16), row = CTXN + t;
    const bf16_t* Z = ws_big(p); bf16_t* b = ws_br(p) + (size_t)row * 2048;
    float bon[2];
    for (int d = 0; d < 2; ++d) {
        const float* a0 = d ? p.a0b : p.a0f; const float* a2 = d ? p.a2b : p.a2f;
        float s = 0.f;
        for (int j = 0; j < 64; ++j) { const int hj = h * 64 + j; float acc = a0[hj];
            for (int m = 0; m < 64; ++m) acc += zshift(Z, p.mu, row, 3200 + d * 64 + m) * a2[m * 1024 + hj];
            const float al = sigmf(acc); const float r = zshift(Z, p.mu, row, hj), k = zshift(Z, p.mu, row, 1024 + hj);
            s += r * (k * (1.0f + (al - 1.0f) * p.k_a[hj])) * p.r_k[hj]; }
        bon[d] = s;
    }
    float sm = 0.f; for (int i = 0; i < 64; ++i) sm += bf2f(b[h * 64 + i]) + bf2f(b[1024 + h * 64 + i]);
    const float mean = sm / 64.f; float q = 0.f;
    for (int i = 0; i < 64; ++i) { const float d = bf2f(b[h * 64 + i]) + bf2f(b[1024 + h * 64 + i]) - mean; q += d * d; }
    const float rstd = 1.0f / sqrtf(q / 64.f + GN_EPS);
    for (int i = 0; i < 64; ++i) { const int hi = h * 64 + i; const float w = bf2f(b[hi]) + bf2f(b[1024 + hi]);
        const float v = zshift(Z, p.mu, row, 2048 + hi);
        b[1024 + hi] = f2bf((w - mean) * rstd * p.lnx_g[hi] + p.lnx_b[hi] + (bon[0] + bon[1]) * v); }
}
constexpr long N_NA = (long)SEQ * 16;
DEV void ph_na(const Params& p, long gid) {
    const int h = (int)(gid % 16), t = (int)(gid / 16), r = t / GW, c = t % GW;
    const bf16_t* P = ws_big(p);
    float q[64];
    { const bf16_t* qp = P + (size_t)(CTXN + t) * NAW + h * 64;
#pragma unroll
      for (int d = 0; d < 64; ++d) q[d] = bf2f(qp[d]) * 0.125f; }
    float acc[64];
#pragma unroll
    for (int d = 0; d < 64; ++d) acc[d] = 0.f;
    float m = -1e30f, l = 0.f;
    const int wh = GROWS < 8 ? GROWS : 8;
    int r0 = r - wh / 2; r0 = r0 < 0 ? 0 : (r0 > GROWS - wh ? GROWS - wh : r0);
    int c0 = c - 8; c0 = c0 < 0 ? 0 : (c0 > GW - 16 ? GW - 16 : c0);
    const float* rp = p.rpb + h * 15 * 31;
    for (int kk = 0; kk < wh * 16 + CTXN; ++kk) {
        int krow; float bias = 0.f;
        if (kk < wh * 16) { const int i = kk / 16, j = kk % 16; krow = CTXN + (r0 + i) * GW + c0 + j; bias = rp[(r0 + i - r + 7) * 31 + (c0 + j - c + 15)]; }
        else krow = kk - wh * 16;
        const bf16_t* kp = P + (size_t)krow * NAW + 1024 + h * 64; float s = bias;
#pragma unroll
        for (int d = 0; d < 64; ++d) s += q[d] * bf2f(kp[d]);
        const float mn = fmaxf(m, s), al = expf(m - mn), pe = expf(s - mn);
        const bf16_t* vp = P + (size_t)krow * NAW + 2048 + h * 64;
        l = l * al + pe;
#pragma unroll
        for (int d = 0; d < 64; ++d) acc[d] = acc[d] * al + pe * bf2f(vp[d]);
        m = mn;
    }
    bf16_t* o = ws_br(p) + (size_t)(CTXN + t) * 2048 + h * 64; const float il = 1.0f / l;
#pragma unroll
    for (int d = 0; d < 64; ++d) o[d] = f2bf(acc[d] * il);
}

constexpr int RW_CH = 16;
struct RwShared { float r[RW_CH][64], w[RW_CH][64], kd[RW_CH][64], v[RW_CH][64], a[RW_CH][64], b[RW_CH][64], tz[RW_CH][64], za[RW_CH][64], kk[RW_CH][64]; };
#ifdef CPU_EMU
#define FOR_THREADS(tid) for (int tid = 0; tid < 64; ++tid)
#define BLOCK_SYNC()
#define TSTATE(tid) S_all[tid]
#else
#define FOR_THREADS(tid) const int tid = threadIdx.x; if (tid < 64)
#define BLOCK_SYNC() __syncthreads()
#define TSTATE(tid) S_reg
#endif
DEV int rw_row(int dir, int pos) { if (pos < CTXN) return dir ? CTXN - 1 - pos : pos; const int t = pos - CTXN; return CTXN + (dir ? SEQ - 1 - t : t); }
#ifdef CPU_EMU
static void rwkv_scan_block(const Params& p, int blk, RwShared& sh) {
    static thread_local float S_all[64][64];
    for (int i = 0; i < 64; ++i) for (int j = 0; j < 64; ++j) S_all[i][j] = 0.f;
#else
__device__ void rwkv_scan_block(const Params& p, int blk, RwShared& sh) {
    float S_reg[64];
#pragma unroll
    for (int j = 0; j < 64; ++j) S_reg[j] = 0.f;
#endif
    const int dir = blk / 16, h = blk % 16;
    const float* w0 = dir ? p.w0b : p.w0f; const float* w2 = dir ? p.w2b : p.w2f; const float* a0 = dir ? p.a0b : p.a0f; const float* a2 = dir ? p.a2b : p.a2f;
    const bf16_t* Z = ws_big(p); bf16_t* BR = ws_br(p);
    for (int p0 = 0; p0 < R; p0 += RW_CH) {
        { FOR_THREADS(tid) { const int hj = h * 64 + tid;
            for (int tt = 0; tt < RW_CH; ++tt) { const int row = rw_row(dir, p0 + tt);
                sh.tz[tt][tid] = tanhf(zshift(Z, p.mu, row, 3072 + dir * 64 + tid)); sh.za[tt][tid] = zshift(Z, p.mu, row, 3200 + dir * 64 + tid);
                sh.r[tt][tid] = zshift(Z, p.mu, row, hj); sh.v[tt][tid] = zshift(Z, p.mu, row, 2048 + hj);
                const float k = zshift(Z, p.mu, row, 1024 + hj); sh.kd[tt][tid] = k; sh.kk[tt][tid] = k * p.k_k[hj]; } } }
        BLOCK_SYNC();
        { FOR_THREADS(tid) { const int hj = h * 64 + tid;
            for (int tt = 0; tt < RW_CH; ++tt) { float aw = w0[hj], aa = a0[hj], nn = 0.f;
                for (int m = 0; m < 64; ++m) { aw += sh.tz[tt][m] * w2[m * 1024 + hj]; aa += sh.za[tt][m] * a2[m * 1024 + hj]; nn += sh.kk[tt][m] * sh.kk[tt][m]; }
                const float lw = -softplusf(-aw) - 0.5f; const float al = sigmf(aa);
                const float kkn = sh.kk[tt][tid] / fmaxf(sqrtf(nn), 1e-12f);
                sh.w[tt][tid] = expf(-expf(lw)); sh.a[tt][tid] = -kkn; sh.b[tt][tid] = kkn * al;
                sh.kd[tt][tid] = sh.kd[tt][tid] * (1.0f + (al - 1.0f) * p.k_a[hj]); } } }
        BLOCK_SYNC();
        { FOR_THREADS(tid) { float* S = TSTATE(tid);
            for (int tt = 0; tt < RW_CH; ++tt) { float sa = 0.f;
#pragma unroll
                for (int j = 0; j < 64; ++j) sa += S[j] * sh.a[tt][j];
                const float vi = sh.v[tt][tid]; float y = 0.f;
#pragma unroll
                for (int j = 0; j < 64; ++j) { S[j] = S[j] * sh.w[tt][j] + sa * sh.b[tt][j] + vi * sh.kd[tt][j]; y += S[j] * sh.r[tt][j]; }
                if (p0 >= CTXN) BR[(size_t)rw_row(dir, p0 + tt) * 2048 + dir * 1024 + h * 64 + tid] = f2bf(y); } } }
        BLOCK_SYNC();
    }
}

static Params make_params(void* const* d_in, void* d_out, void* d_ws) {
    Params p{};
    const float** f = (const float**)&p;
    for (int i = 0; i < 31; ++i) f[i] = (const float*)d_in[i];
    p.out = (float*)d_out; p.ws = (unsigned char*)d_ws; return p;
}


#ifndef CPU_EMU
#define LAS __attribute__((address_space(3)))
#define GAS __attribute__((address_space(1)))
typedef unsigned v4u __attribute__((ext_vector_type(4)));
constexpr int NWAVES = 8, NTHR = NWAVES * 64;
#ifndef PROBE
#define PROBE 0
#endif
#define XB_TMO      128
#define XB_XCNT(j)  (256  + 64 * (j))
#define XB_XSUB(j)  (1280 + 64 * (j))
#define XB_XGEN(j)  (2304 + 64 * (j))
#define XB_TOP      3328
#define XB_TOPGEN   3392
#define XCD_BAR_WORDS 3456
#define XB_SPIN_CAP (1u << 18)

__device__ __forceinline__ unsigned xb_ld(unsigned* p)              { return __hip_atomic_load(p, __ATOMIC_RELAXED, __HIP_MEMORY_SCOPE_AGENT); }
__device__ __forceinline__ unsigned xb_add(unsigned* p, unsigned v) { return __hip_atomic_fetch_add(p, v, __ATOMIC_RELAXED, __HIP_MEMORY_SCOPE_AGENT); }
__device__ __forceinline__ unsigned xb_xcc_id() { return (unsigned)__builtin_amdgcn_s_getreg((3 << 11) | 20) & 0xFu; }
#define XB_SPIN(cond, bar) do { unsigned _sp = 0; while (cond) { __builtin_amdgcn_s_sleep(1); \
    if ((++_sp & 255u) == 0u) { if (xb_ld(&(bar)[XB_TMO])) break; if (_sp > XB_SPIN_CAP) { atomicAdd(&(bar)[XB_TMO], 1u); break; } } } } while (0)

struct XcdBarrier {
    unsigned* bar; unsigned x;
    volatile LAS unsigned* st;
};

__device__ __forceinline__ XcdBarrier xcd_barrier_post(unsigned* bar, volatile LAS unsigned* st) {
    XcdBarrier b; b.bar = bar; b.x = xb_xcc_id(); b.st = st;
    if (threadIdx.x == 0) (void)xb_add(&bar[XB_XCNT(b.x)], 1u);
    return b;
}
__device__ __forceinline__ void xcd_barrier_complete(unsigned* bar, unsigned x, unsigned& nloc, unsigned& nx) {
    const unsigned G = gridDim.x * gridDim.y * gridDim.z;
    unsigned sum, cnt, mine, sp = 0u;
    for (;;) {
        sum = 0u; cnt = 0u; mine = 0u;
#pragma unroll
        for (unsigned j = 0; j < 16; ++j) { const unsigned c = xb_ld(&bar[XB_XCNT(j)]); sum += c; cnt += (c > 0u) ? 1u : 0u; mine = (j == x) ? c : mine; }
        if (sum == G) break;
        __builtin_amdgcn_s_sleep(1);
        if ((++sp & 255u) == 0u) { if (xb_ld(&bar[XB_TMO])) break; if (sp > XB_SPIN_CAP) { atomicAdd(&bar[XB_TMO], 1u); break; } }
    }
    nloc = mine > 0u ? mine : 1u; nx = cnt > 0u ? cnt : 1u;
}

__device__ __forceinline__ void xcd_barrier(const XcdBarrier& b) {
    asm volatile("s_waitcnt vmcnt(0)" ::: "memory");
    __syncthreads();
    if (threadIdx.x == 0) {
        unsigned* bar = b.bar;
        __builtin_amdgcn_s_waitcnt(0);
        unsigned nloc = b.st[0], nx = b.st[1];
        if (nloc == 0u) { xcd_barrier_complete(bar, b.x, nloc, nx); b.st[0] = nloc; b.st[1] = nx; }
        const unsigned old = xb_add(&bar[XB_XSUB(b.x)], 1u);
        const unsigned gen = old / nloc;
        if (old + 1u == (gen + 1u) * nloc) {
            __builtin_amdgcn_fence(__ATOMIC_RELEASE, "agent");
            asm volatile("s_waitcnt vmcnt(0)" ::: "memory");
            const unsigned og = xb_add(&bar[XB_TOP], 1u);
            const unsigned tg = og / nx;
            if (og + 1u == (tg + 1u) * nx) xb_add(&bar[XB_TOPGEN], 1u);
            else XB_SPIN(xb_ld(&bar[XB_TOPGEN]) == tg, bar);
            __builtin_amdgcn_fence(__ATOMIC_ACQUIRE, "agent");
            xb_add(&bar[XB_XGEN(b.x)], 1u);
            asm volatile("s_waitcnt vmcnt(0)" ::: "memory");
        } else {
            XB_SPIN(xb_ld(&bar[XB_XGEN(b.x)]) == gen, bar);
            __builtin_amdgcn_fence(__ATOMIC_ACQUIRE, "agent");
            asm volatile("s_waitcnt vmcnt(0)" ::: "memory");
        }
    }
    __syncthreads();
}
namespace pg8 {
#define PG8_LAS __attribute__((address_space(3)))
typedef unsigned short bf16_t;
typedef short bf16x8 __attribute__((ext_vector_type(8)));
typedef float f32x4 __attribute__((ext_vector_type(4)));
typedef unsigned u32x4 __attribute__((ext_vector_type(4)));
constexpr int BM = 256, BK = 64, HALF = 128, HTB = HALF * BK * 2  , STAGE_BYTES = 8 * HTB, NXCD = 8, WGM = 8;

__host__ __device__ __forceinline__ int lds_byte(int r, int c) { const int st = (r >> 4) * 2 + (c >> 5), rr = r & 15, cc = c & 31, ob = rr * 64 + cc * 2; return st * 1024 + (ob ^ (((ob >> 9) & 1) << 5)); }
__host__ __device__ __forceinline__ void stage_rc(int b, int& R, int& C) { const int st = b / 1024, sb = b % 1024, swz = sb ^ (((sb >> 9) & 1) << 5); R = (st >> 1) * 16 + swz / 64; C = (st & 1) * 32 + (swz % 64) / 2; }
__host__ __device__ __forceinline__ int perm32(int rho) { const int n = rho >> 4, i = rho & 15; return 8 * (i >> 2) + 4 * n + (i & 3); }

struct Unit { int pm, pn; };
struct Gemm { const bf16_t* A; const bf16_t* Bt; int M, N, K; int lda = 0, ldb = 0; int ksl = 0; };

struct StaticOrder {
    int nM, nN, nwg, G, c;
    __host__ __device__ void init(int M, int N, int G_, int c_) { nM = M / BM; nN = N / BM; nwg = nM * nN; G = G_; c = c_; }
    __host__ __device__ bool next(int i, Unit& u) const {
        const long L = (long)i * G + c; if (L >= nwg) return false;
        int wgid = (int)L; { const int q = nwg / NXCD, r = nwg % NXCD, xcd = wgid % NXCD, off = wgid / NXCD; wgid = (xcd < r ? xcd * (q + 1) : r * (q + 1) + (xcd - r) * q) + off; }
        const int nig = WGM * nN, gid = wgid / nig, fm = gid * WGM, gsz = (nM - fm) < WGM ? (nM - fm) : WGM;
        u.pm = fm + ((wgid % nig) % gsz); u.pn = (wgid % nig) / gsz; return true;
    }
    __device__ __forceinline__ void a_ready(const Unit&) const {}
    __device__ __forceinline__ void done(const Unit&) const {}
};

__device__ __forceinline__ unsigned cvt_pk_bf16(float lo, float hi) { unsigned r; asm volatile("v_cvt_pk_bf16_f32 %0, %1, %2" : "=v"(r) : "v"(lo), "v"(hi)); return r; }
typedef float f32x2 __attribute__((ext_vector_type(2)));
__device__ __forceinline__ f32x2 gelu_pk(f32x2 v) {
    const f32x2 av = __builtin_elementwise_abs(v), d = av * 0.2316418882f + 1.0f;
    f32x2 t; t.x = __builtin_amdgcn_rcpf(d.x); t.y = __builtin_amdgcn_rcpf(d.y);
    f32x2 q = t * 0.5307027145f + (-0.7265760135f); q = q * t + 0.7107068705f; q = q * t + (-0.142248368f); q = q * t + 0.127414796f; q = q * t;
    const f32x2 s = (v * v) * (-0.72134752044f);
    f32x2 e; e.x = __builtin_amdgcn_exp2f(s.x); e.y = __builtin_amdgcn_exp2f(s.y);
    const f32x2 m = v * (q * e), r = v - m;
    f32x2 o; o.x = v.x < 0.f ? m.x : r.x; o.y = v.y < 0.f ? m.y : r.y; return o;
}

template <int ACT  > struct EpiBf16 {
    static constexpr bool PERM = true, AFTER_DRAIN = false; static_assert(ACT == 0 || ACT == 1, "EpiBf16: ACT is 0 (none) or 1 (gelu_pk)");
    bf16_t* O; int ldc; const float* bias; int split_cols; size_t split_stride; float scale0;
    __device__ __forceinline__ void operator()(const f32x4 (&acc)[2][2][4][2], const Unit& u, int wr, int wc, int fr, int fq) const {
        const int row0 = u.pm * BM + wr * 64 + fr; int colt = u.pn * BM; bf16_t* base = O;
        float sc = 1.f; if (split_cols) { const int t = colt / split_cols; base += (size_t)t * split_stride; colt -= t * split_cols; if (t == 0) sc = scale0; }
        const int col0 = colt + wc * 32 + 8 * fq, bcol0 = u.pn * BM + wc * 32 + 8 * fq;
        f32x4 bv[2][2];
#pragma unroll
        for (int bj = 0; bj < 2; ++bj)
#pragma unroll
            for (int n = 0; n < 2; ++n) bv[bj][n] = bias ? *(const f32x4*)(bias + bcol0 + bj * HALF + 4 * n) : (f32x4){0.f, 0.f, 0.f, 0.f};
#pragma unroll
        for (int ai = 0; ai < 2; ++ai)
#pragma unroll
            for (int m = 0; m < 4; ++m) { bf16_t* rowp = base + (size_t)(row0 + ai * HALF + m * 16) * ldc + col0;
#pragma unroll
                for (int bj = 0; bj < 2; ++bj) { f32x4 v0 = acc[ai][bj][m][0] + bv[bj][0], v1 = acc[ai][bj][m][1] + bv[bj][1];
                    if (ACT == 1) { f32x2 a = gelu_pk((f32x2){v0[0], v0[1]}), b = gelu_pk((f32x2){v0[2], v0[3]}), c = gelu_pk((f32x2){v1[0], v1[1]}), d = gelu_pk((f32x2){v1[2], v1[3]});
                        v0 = (f32x4){a.x, a.y, b.x, b.y}; v1 = (f32x4){c.x, c.y, d.x, d.y}; }
                    v0 = v0 * sc; v1 = v1 * sc; u32x4 w; w.x = cvt_pk_bf16(v0[0], v0[1]); w.y = cvt_pk_bf16(v0[2], v0[3]); w.z = cvt_pk_bf16(v1[0], v1[1]); w.w = cvt_pk_bf16(v1[2], v1[3]);
                    *(u32x4*)(rowp + bj * HALF) = w; } }
    }
};

__device__ __forceinline__ float silu_fast(float v) { return v * __builtin_amdgcn_rcpf(1.0f + __builtin_amdgcn_exp2f(-1.4426950408889634f * v)); }
struct EpiGateMul {
    static constexpr bool PERM = true, AFTER_DRAIN = false;
    bf16_t* O; int ldc;
    __device__ __forceinline__ void operator()(const f32x4 (&acc)[2][2][4][2], const Unit& u, int wr, int wc, int fr, int fq) const {
        const int row0 = u.pm * BM + wr * 64 + fr, col0 = u.pn * BM + wc * 32 + 8 * fq;
#pragma unroll
        for (int ai = 0; ai < 2; ++ai)
#pragma unroll
            for (int m = 0; m < 4; ++m) { bf16_t* rowp = O + (size_t)(row0 + ai * HALF + m * 16) * ldc + col0;
#pragma unroll
                for (int bj = 0; bj < 2; ++bj) { const u32x4 old = *(const u32x4*)(rowp + bj * HALF); const f32x4 v0 = acc[ai][bj][m][0], v1 = acc[ai][bj][m][1];
                    u32x4 w;
                    w.x = cvt_pk_bf16(silu_fast(v0[0]) * __uint_as_float(old.x << 16), silu_fast(v0[1]) * __uint_as_float(old.x & 0xffff0000u));
                    w.y = cvt_pk_bf16(silu_fast(v0[2]) * __uint_as_float(old.y << 16), silu_fast(v0[3]) * __uint_as_float(old.y & 0xffff0000u));
                    w.z = cvt_pk_bf16(silu_fast(v1[0]) * __uint_as_float(old.z << 16), silu_fast(v1[1]) * __uint_as_float(old.z & 0xffff0000u));
                    w.w = cvt_pk_bf16(silu_fast(v1[2]) * __uint_as_float(old.w << 16), silu_fast(v1[3]) * __uint_as_float(old.w & 0xffff0000u));
                    *(u32x4*)(rowp + bj * HALF) = w; } }
    }
};
struct EpiSiluBf16 {
    static constexpr bool PERM = true, AFTER_DRAIN = false;
    bf16_t* O; int ldc;
    __device__ __forceinline__ void operator()(const f32x4 (&acc)[2][2][4][2], const Unit& u, int wr, int wc, int fr, int fq) const {
        const int row0 = u.pm * BM + wr * 64 + fr, col0 = u.pn * BM + wc * 32 + 8 * fq;
#pragma unroll
        for (int ai = 0; ai < 2; ++ai)
#pragma unroll
            for (int m = 0; m < 4; ++m) { bf16_t* rowp = O + (size_t)(row0 + ai * HALF + m * 16) * ldc + col0;
#pragma unroll
                for (int bj = 0; bj < 2; ++bj) { const f32x4 v0 = acc[ai][bj][m][0], v1 = acc[ai][bj][m][1]; u32x4 w;
                    w.x = cvt_pk_bf16(silu_fast(v0[0]), silu_fast(v0[1])); w.y = cvt_pk_bf16(silu_fast(v0[2]), silu_fast(v0[3]));
                    w.z = cvt_pk_bf16(silu_fast(v1[0]), silu_fast(v1[1])); w.w = cvt_pk_bf16(silu_fast(v1[2]), silu_fast(v1[3]));
                    *(u32x4*)(rowp + bj * HALF) = w; } }
    }
};
struct EpiF32 {
    static constexpr bool PERM = true, AFTER_DRAIN = false;
    float* O; int ldc;
    __device__ __forceinline__ void operator()(const f32x4 (&acc)[2][2][4][2], const Unit& u, int wr, int wc, int fr, int fq) const {
        const int row0 = u.pm * BM + wr * 64 + fr, col0 = u.pn * BM + wc * 32 + 8 * fq;
#pragma unroll
        for (int ai = 0; ai < 2; ++ai)
#pragma unroll
            for (int m = 0; m < 4; ++m) { float* rowp = O + (size_t)(row0 + ai * HALF + m * 16) * ldc + col0;
#pragma unroll
                for (int bj = 0; bj < 2; ++bj) { *(f32x4*)(rowp + bj * HALF) = acc[ai][bj][m][0]; *(f32x4*)(rowp + bj * HALF + 4) = acc[ai][bj][m][1]; } }
    }
};

template <class Epi, class Sched, bool ALIGN_EPI = false, bool SP2 = false>
__device__ __forceinline__ void gemm_phase(PG8_LAS unsigned char* lds, const Gemm g, const Sched& S, const Epi& E) {
    int tid_ = threadIdx.x; asm volatile("" : "+v"(tid_));
    const int tid = tid_, wid = __builtin_amdgcn_readfirstlane(tid >> 6), lane = tid & 63, wr = wid >> 2, wc = wid & 3, fr = lane & 15, fq = lane >> 4;
    const int K = g.K, nt = K / BK, lda = g.lda ? g.lda : K, ldb = g.ldb ? g.ldb : K;
    unsigned voffA[2], voffB[2];
#pragma unroll
    for (int i = 0; i < 2; ++i) { int R, C; stage_rc(tid * 16 + i * 8192, R, C); const int Rb = Epi::PERM ? ((R & ~31) + perm32(R & 31)) : R;
        voffA[i] = (unsigned)(R * lda + C) * 2u; voffB[i] = (unsigned)(Rb * ldb + C) * 2u; }
    const size_t kstep = (size_t)(BK * 2);
    const size_t hstepA = (size_t)HALF * lda * 2, hstepB = (size_t)HALF * ldb * 2;
    const size_t tstepA = g.ksl ? (size_t)g.ksl : 2 * hstepA, tstepB = 2 * hstepB, bpm = (size_t)g.ksl;
    const unsigned ldsw = (unsigned)wid * 1024u;
    const int aoff = lds_byte(wr * 64 + fr, fq * 8), boff = lds_byte(wc * 32 + fr, fq * 8);
#define PG8_SA(b, h) (((b) * 2 + (h)) * HTB)
#define PG8_SB(b, h) ((4 + (b) * 2 + (h)) * HTB)
#define PG8_STAGE(bufoff, gbase, voff) do { _Pragma("unroll") for (int _i = 0; _i < 2; ++_i) \
        __builtin_amdgcn_global_load_lds((const unsigned*)((const char*)(gbase) + (voff)[_i]), (PG8_LAS unsigned*)(lds + (bufoff) + ldsw + _i * 8192), 16, 0, 0); } while (0)
#define PG8_LDA(dst, b, h) do { _Pragma("unroll") for (int m = 0; m < 4; ++m) _Pragma("unroll") for (int k = 0; k < 2; ++k) dst[m][k] = *(const PG8_LAS bf16x8*)(lds + PG8_SA(b, h) + aoff + m * 2048 + k * 1024); } while (0)
#define PG8_LDB(dst, b, h) do { _Pragma("unroll") for (int n = 0; n < 2; ++n) _Pragma("unroll") for (int k = 0; k < 2; ++k) dst[n][k] = *(const PG8_LAS bf16x8*)(lds + PG8_SB(b, h) + boff + n * 2048 + k * 1024); } while (0)
#define PG8_MMA(ai, bj, At, Bt) do { __builtin_amdgcn_s_setprio(1); _Pragma("unroll") for (int m = 0; m < 4; ++m) _Pragma("unroll") for (int n = 0; n < 2; ++n) _Pragma("unroll") for (int k = 0; k < 2; ++k) \
        acc[ai][bj][m][n] = __builtin_amdgcn_mfma_f32_16x16x32_bf16(Bt[n][k], At[m][k], acc[ai][bj][m][n], 0, 0, 0); __builtin_amdgcn_s_setprio(0); } while (0)
#define PG8_WAIT_V(n) asm volatile("s_waitcnt vmcnt(" #n ")" ::: "memory")
#define PG8_WAIT_L(n) asm volatile("s_waitcnt lgkmcnt(" #n ")" ::: "memory")
#define PG8_BAR __builtin_amdgcn_s_barrier()
#define PG8_SCHED __builtin_amdgcn_sched_barrier(0)
    Unit cur, nxt; int ui = 0;
    if (!S.next(0, cur)) return;
    f32x4 acc[2][2][4][2];
#pragma unroll
    for (int a = 0; a < 2; ++a)
#pragma unroll
        for (int b = 0; b < 2; ++b)
#pragma unroll
            for (int m = 0; m < 4; ++m)
#pragma unroll
                for (int n = 0; n < 2; ++n) acc[a][b][m][n] = (f32x4){0.f, 0.f, 0.f, 0.f};
    bf16x8 At[4][2], B0[2][2], B1[2][2];
    const char* cA = (const char*)g.A + (size_t)cur.pm * tstepA; const char* cB = (const char*)g.Bt + (size_t)cur.pn * tstepB + (size_t)cur.pm * bpm;
    S.a_ready(cur);
    if constexpr (SP2) {
        PG8_STAGE(PG8_SB(0, 0), cB, voffB); PG8_STAGE(PG8_SB(0, 1), cB + hstepB, voffB); PG8_STAGE(PG8_SA(0, 0), cA, voffA); PG8_STAGE(PG8_SA(0, 1), cA + hstepA, voffA);
        if (wr == 1) PG8_BAR;
        PG8_WAIT_V(2); PG8_BAR;
        PG8_STAGE(PG8_SB(1, 0), cB + kstep, voffB); PG8_STAGE(PG8_SA(1, 0), cA + kstep, voffA); PG8_STAGE(PG8_SB(1, 1), cB + hstepB + kstep, voffB);
        PG8_WAIT_V(6); PG8_BAR;
    } else {
        PG8_STAGE(PG8_SB(0, 0), cB, voffB); PG8_STAGE(PG8_SA(0, 0), cA, voffA); PG8_STAGE(PG8_SB(0, 1), cB + hstepB, voffB); PG8_STAGE(PG8_SA(0, 1), cA + hstepA, voffA);
        if (wr == 1) PG8_BAR;
        PG8_WAIT_V(4); PG8_BAR;
        PG8_STAGE(PG8_SB(1, 0), cB + kstep, voffB); PG8_STAGE(PG8_SA(1, 0), cA + kstep, voffA); PG8_STAGE(PG8_SB(1, 1), cB + hstepB + kstep, voffB);
        PG8_WAIT_V(6); PG8_BAR;
    }
    for (;;) {
        const bool has_next = S.next(ui + 1, nxt);
        const char* nA = has_next ? (const char*)g.A + (size_t)nxt.pm * tstepA : cA; const char* nB = has_next ? (const char*)g.Bt + (size_t)nxt.pn * tstepB + (size_t)nxt.pm * bpm : cB;
        for (int t = 0; t < nt; t += 2) {
            const bool last = (t == nt - 2);
            const char* a1 = cA + (size_t)(t + 1) * kstep;
            const char* a2 = last ? nA : cA + (size_t)(t + 2) * kstep; const char* b2 = last ? nB : cB + (size_t)(t + 2) * kstep;
            const char* a3 = a2 + kstep; const char* b3 = b2 + kstep;
            if (last && has_next) S.a_ready(nxt);
            if constexpr (SP2) {
            PG8_LDB(B0, 0, 0); PG8_LDB(B1, 0, 1); PG8_SCHED; PG8_LDA(At, 0, 0); PG8_STAGE(PG8_SA(1, 1), a1 + hstepA, voffA);
            PG8_WAIT_V(8); PG8_WAIT_L(0); PG8_BAR; PG8_MMA(0, 0, At, B0); PG8_MMA(0, 1, At, B1); PG8_BAR; PG8_SCHED;
            PG8_LDA(At, 0, 1); PG8_STAGE(PG8_SB(0, 0), b2, voffB); PG8_STAGE(PG8_SB(0, 1), b2 + hstepB, voffB); PG8_STAGE(PG8_SA(0, 0), a2, voffA);
            PG8_WAIT_V(8); PG8_WAIT_L(0); PG8_BAR; PG8_MMA(1, 0, At, B0); PG8_MMA(1, 1, At, B1); PG8_BAR; PG8_SCHED;
            PG8_LDB(B0, 1, 0); PG8_LDB(B1, 1, 1); PG8_SCHED; PG8_LDA(At, 1, 0); PG8_STAGE(PG8_SA(0, 1), a2 + hstepA, voffA);
            PG8_WAIT_V(8); PG8_WAIT_L(0); PG8_BAR; PG8_MMA(0, 0, At, B0); PG8_MMA(0, 1, At, B1); PG8_BAR; PG8_SCHED;
            PG8_LDA(At, 1, 1); PG8_STAGE(PG8_SB(1, 0), b3, voffB); PG8_STAGE(PG8_SB(1, 1), b3 + hstepB, voffB); PG8_STAGE(PG8_SA(1, 0), a3, voffA);
            PG8_WAIT_V(8); PG8_WAIT_L(0); PG8_BAR; PG8_MMA(1, 0, At, B0); PG8_MMA(1, 1, At, B1); PG8_BAR; PG8_SCHED;
            } else {
            PG8_LDB(B0, 0, 0); PG8_SCHED; PG8_LDA(At, 0, 0); PG8_STAGE(PG8_SA(1, 1), a1 + hstepA, voffA);
            PG8_WAIT_L(8); PG8_BAR; PG8_WAIT_L(0); PG8_MMA(0, 0, At, B0); PG8_BAR; PG8_SCHED;
            PG8_LDB(B1, 0, 1); PG8_STAGE(PG8_SB(0, 0), b2, voffB);
            PG8_BAR; PG8_WAIT_L(0); PG8_MMA(0, 1, At, B1); PG8_BAR;
            PG8_LDA(At, 0, 1); PG8_STAGE(PG8_SA(0, 0), a2, voffA);
            PG8_BAR; PG8_WAIT_L(0); PG8_MMA(1, 0, At, B0); PG8_BAR; PG8_SCHED;
            PG8_STAGE(PG8_SB(0, 1), b2 + hstepB, voffB);
            PG8_WAIT_V(6); PG8_BAR; PG8_MMA(1, 1, At, B1); PG8_BAR;
            PG8_LDB(B0, 1, 0); PG8_SCHED; PG8_LDA(At, 1, 0); PG8_STAGE(PG8_SA(0, 1), a2 + hstepA, voffA);
            PG8_WAIT_L(8); PG8_BAR; PG8_WAIT_L(0); PG8_MMA(0, 0, At, B0); PG8_BAR; PG8_SCHED;
            PG8_LDB(B1, 1, 1); PG8_STAGE(PG8_SB(1, 0), b3, voffB);
            PG8_BAR; PG8_WAIT_L(0); PG8_MMA(0, 1, At, B1); PG8_BAR;
            PG8_LDA(At, 1, 1); PG8_STAGE(PG8_SA(1, 0), a3, voffA);
            PG8_BAR; PG8_WAIT_L(0); PG8_MMA(1, 0, At, B0); PG8_BAR; PG8_SCHED;
            PG8_STAGE(PG8_SB(1, 1), b3 + hstepB, voffB);
            PG8_WAIT_V(6); PG8_BAR; PG8_MMA(1, 1, At, B1); PG8_BAR;
            }
        }
        if constexpr (ALIGN_EPI) { if (wr == 0) PG8_BAR; }
        if constexpr (!Epi::AFTER_DRAIN) { E(acc, cur, wr, wc, fr, fq); S.done(cur); }
        if (!has_next) break;
#pragma unroll
        for (int a = 0; a < 2; ++a)
#pragma unroll
            for (int b = 0; b < 2; ++b)
#pragma unroll
                for (int m = 0; m < 4; ++m)
#pragma unroll
                    for (int n = 0; n < 2; ++n) acc[a][b][m][n] = (f32x4){0.f, 0.f, 0.f, 0.f};
        cur = nxt; cA = nA; cB = nB; ++ui;
        if constexpr (ALIGN_EPI) { if (wr == 1) PG8_BAR; }
    }
    PG8_WAIT_V(0);
    if constexpr (!ALIGN_EPI) { if (wr == 0) PG8_BAR; }
    PG8_BAR;
    if constexpr (Epi::AFTER_DRAIN) { E.fused(acc, cur, wr, wc, fr, fq, lds, wid, lane); S.done(cur); }
#undef PG8_SA
#undef PG8_SB
#undef PG8_STAGE
#undef PG8_LDA
#undef PG8_LDB
#undef PG8_MMA
#undef PG8_WAIT_V
#undef PG8_WAIT_L
#undef PG8_BAR
#undef PG8_SCHED
}
}

namespace attn {
using bf16 = unsigned short;
constexpr int   D = 128, NW = 8, QBLK = 32, KVBLK = 64;
constexpr float SCALE = 0.088388347648318440f;
constexpr float THR = 8.f;
constexpr int SDEPTH = 2;
constexpr int LDQ = P0W, LDK = P0W, LDO = 2048;
constexpr size_t SHM_V = KVBLK * D * 2, SHM_K = KVBLK * D * 2, SHM_ATTN = 2 * SHM_V + 2 * SHM_K + NW * 64 * 4;
using bf16x8 = __attribute__((ext_vector_type(8))) short;
using s16x4  = __attribute__((ext_vector_type(4))) short;
using f32x16 = __attribute__((ext_vector_type(16))) float;
using f32x8  = __attribute__((ext_vector_type(8))) float;
using u32x4  = __attribute__((ext_vector_type(4))) unsigned;
#define KSWZ(row, colB) ((row) * 256 + ((colB) ^ (((row) & 7) << 4)))
#define SBAR() __builtin_amdgcn_sched_barrier(0)
__device__ __forceinline__ int crow(int r, int hi) { return (r & 3) + 8 * (r >> 2) + 4 * hi; }
__device__ __forceinline__ unsigned cvtpk(float lo, float hi) {
  unsigned r; asm volatile("v_cvt_pk_bf16_f32 %0, %1, %2" : "=v"(r) : "v"(lo), "v"(hi)); return r;
}
template <typename TIn> struct Stage;
template <> struct Stage<bf16>  { using T = bf16x8;
  __device__ static __forceinline__ T ld8(const bf16* p) { return *reinterpret_cast<const bf16x8*>(p); }
  __device__ static __forceinline__ bf16x8 tobf(T x) { return x; } };
template <> struct Stage<float> { using T = f32x8;
  __device__ static __forceinline__ T ld8(const float* p) { return *reinterpret_cast<const f32x8*>(p); }
  __device__ static __forceinline__ bf16x8 tobf(T x) {
    u32x4 w = {cvtpk(x[0], x[1]), cvtpk(x[2], x[3]), cvtpk(x[4], x[5]), cvtpk(x[6], x[7])}; return *reinterpret_cast<bf16x8*>(&w); } };

__device__ __forceinline__ void partialSM(f32x16& p0, f32x16& p1, float& m_reg, float& mn, float& alpha) {
  constexpr float C = SCALE * 1.4426950408889634f;
  float pmax = p0[0]; for (int r = 1; r < 16; ++r) pmax = fmaxf(pmax, p0[r]); for (int r = 0; r < 16; ++r) pmax = fmaxf(pmax, p1[r]);
  { auto rr = __builtin_amdgcn_permlane32_swap(__float_as_uint(pmax), __float_as_uint(pmax), false, false);
    pmax = fmaxf(__uint_as_float(rr[0]), __uint_as_float(rr[1])); }
  if (__builtin_expect(__all(pmax - m_reg <= THR / SCALE), 1)) { mn = m_reg; alpha = 1.f; }
  else { mn = fmaxf(m_reg, pmax); alpha = __builtin_amdgcn_exp2f((m_reg - mn) * C); m_reg = mn; }
  float mnC = -mn * C;
  for (int r = 0; r < 16; ++r) p0[r] = fmaf(p0[r], C, mnC); for (int r = 0; r < 16; ++r) p1[r] = fmaf(p1[r], C, mnC);
  for (int r = 0; r < 16; ++r) p0[r] = __builtin_amdgcn_exp2f(p0[r]);
}
__device__ __forceinline__ void finishSM(f32x16& p0, f32x16& p1, float alpha, float& l_reg, bf16x8& pa0, bf16x8& pa1, bf16x8& pa2, bf16x8& pa3) {
  for (int r = 0; r < 16; ++r) p1[r] = __builtin_amdgcn_exp2f(p1[r]);
  float ps = 0; for (int r = 0; r < 16; ++r) ps += p0[r]; for (int r = 0; r < 16; ++r) ps += p1[r];
  { auto rr = __builtin_amdgcn_permlane32_swap(__float_as_uint(ps), __float_as_uint(ps), false, false);
    ps = __uint_as_float(rr[0]) + __uint_as_float(rr[1]); }
  l_reg = l_reg * alpha + ps;
#define PK4(P, BASE, OUT) do { unsigned a0 = cvtpk(P[BASE + 0], P[BASE + 1]), a1 = cvtpk(P[BASE + 2], P[BASE + 3]);   \
    unsigned b0 = cvtpk(P[BASE + 4], P[BASE + 5]), b1 = cvtpk(P[BASE + 6], P[BASE + 7]);                              \
    auto r0 = __builtin_amdgcn_permlane32_swap(a0, b0, false, false); auto r1 = __builtin_amdgcn_permlane32_swap(a1, b1, false, false); \
    u32x4 w = {r0[0], r1[0], r0[1], r1[1]}; OUT = *reinterpret_cast<bf16x8*>(&w); } while (0)
  PK4(p0, 0, pa0); PK4(p0, 8, pa1); PK4(p1, 0, pa2); PK4(p1, 8, pa3);
#undef PK4
}
__device__ __forceinline__ void qkt(f32x16& p0, f32x16& p1, const bf16* Ks, const bf16x8* qr, int r32, int hi) {
  p0 = f32x16{}; p1 = f32x16{};
  for (int d0 = 0; d0 < 8; ++d0) { int cb = (d0 * 16 + hi * 8) * 2;
    bf16x8 b0 = *reinterpret_cast<const bf16x8*>((const char*)Ks + KSWZ(r32, cb));
    bf16x8 b1 = *reinterpret_cast<const bf16x8*>((const char*)Ks + KSWZ(32 + r32, cb));
    p0 = __builtin_amdgcn_mfma_f32_32x32x16_bf16(b0, qr[d0], p0, 0, 0, 0);
    p1 = __builtin_amdgcn_mfma_f32_32x32x16_bf16(b1, qr[d0], p1, 0, 0, 0); }
}
__device__ __forceinline__ int v_st(int k, int c) { const int kk = (k & ~0xC) | ((k & 4) << 1) | ((k & 8) >> 1); return ((kk >> 3) * 4 + (c >> 5)) * 512 + ((kk & 7) * 32 + (c & 31)) * 2; }
__device__ __forceinline__ int v_rd_base(int lane) { return ((lane & 3) << 3) | (((lane >> 2) & 3) << 6) | (((lane >> 4) & 1) << 5) | (((lane >> 5) & 1) << 8); }
constexpr int v_rd_off(int d0, int ks, int half) { return d0 * 512 + ks * 4096 + half * 2048; }
template <int OFF> __device__ __forceinline__ s16x4 tr_read(int vb) {
  s16x4 r; asm volatile("ds_read_b64_tr_b16 %0, %1 offset:%2" : "=&v"(r) : "v"(vb), "i"(OFF) : "memory"); return r;
}
template <int D0> __device__ __forceinline__ void pv_one(f32x16& od, int vb, bf16x8 pa0, bf16x8 pa1, bf16x8 pa2, bf16x8 pa3) {
  const s16x4 l0 = tr_read<v_rd_off(D0, 0, 0)>(vb), h0 = tr_read<v_rd_off(D0, 0, 1)>(vb), l1 = tr_read<v_rd_off(D0, 1, 0)>(vb), h1 = tr_read<v_rd_off(D0, 1, 1)>(vb);
  const s16x4 l2 = tr_read<v_rd_off(D0, 2, 0)>(vb), h2 = tr_read<v_rd_off(D0, 2, 1)>(vb), l3 = tr_read<v_rd_off(D0, 3, 0)>(vb), h3 = tr_read<v_rd_off(D0, 3, 1)>(vb);
  asm volatile("s_waitcnt lgkmcnt(0)" ::: "memory"); SBAR();
#define PK(L, H) (bf16x8){L[0], L[1], L[2], L[3], H[0], H[1], H[2], H[3]}
  od = __builtin_amdgcn_mfma_f32_32x32x16_bf16(pa0, PK(l0, h0), od, 0, 0, 0);
  od = __builtin_amdgcn_mfma_f32_32x32x16_bf16(pa1, PK(l1, h1), od, 0, 0, 0);
  od = __builtin_amdgcn_mfma_f32_32x32x16_bf16(pa2, PK(l2, h2), od, 0, 0, 0);
  od = __builtin_amdgcn_mfma_f32_32x32x16_bf16(pa3, PK(l3, h3), od, 0, 0, 0);
#undef PK
}
__device__ __forceinline__ void pv_d0(f32x16* o, int vb, bf16x8 pa0, bf16x8 pa1, bf16x8 pa2, bf16x8 pa3) {
  pv_one<0>(o[0], vb, pa0, pa1, pa2, pa3); pv_one<1>(o[1], vb, pa0, pa1, pa2, pa3); pv_one<2>(o[2], vb, pa0, pa1, pa2, pa3); pv_one<3>(o[3], vb, pa0, pa1, pa2, pa3);
}

template <typename TQ>
__device__ __forceinline__ void attn_dense_body(const TQ* __restrict__ Qb, const bf16* __restrict__ Kh, const bf16* __restrict__ Vh,
                                                bf16* __restrict__ Ob, int seq, char* lds) {
  using St = Stage<bf16>; using SQ = Stage<TQ>;
  int tid_ = threadIdx.x; asm volatile("" : "+v"(tid_));
  const int tid = tid_, wid = tid >> 6, lane = tid & 63, r32 = lane & 31, hi = lane >> 5;
  bf16* V_lds = (bf16*)lds; bf16* K_lds = (bf16*)(lds + 2 * SHM_V);
  float* ws = (float*)(lds + 2 * SHM_V + 2 * SHM_K) + wid * 64; float* li_l = ws; float* al_l = ws + 32;
  float m_reg = -1e30f, l_reg = 0; f32x16 o[4] = {}; bf16x8 qr[8];
  const TQ* Qw = Qb + (long)(wid * QBLK + r32) * LDQ + hi * 8;
#pragma unroll
  for (int d0 = 0; d0 < 8; ++d0) qr[d0] = SQ::tobf(SQ::ld8(Qw + d0 * 16));
  const int sr = tid >> 4, sc = (tid & 15) * 8, vst0 = v_st(sr, sc), vst1 = v_st(32 + sr, sc);
  const int vb0 = (int)(uintptr_t)V_lds + v_rd_base(lane);
  struct { typename St::T vs0, vs1, ks0, ks1; } sr_[SDEPTH];
#define SLOAD(i, k0) do { sr_[i].vs0 = St::ld8(&Vh[(long)((k0) + sr) * LDK + sc]); sr_[i].vs1 = St::ld8(&Vh[(long)((k0) + 32 + sr) * LDK + sc]); \
    sr_[i].ks0 = St::ld8(&Kh[(long)((k0) + sr) * LDK + sc]); sr_[i].ks1 = St::ld8(&Kh[(long)((k0) + 32 + sr) * LDK + sc]); } while (0)
#define SWRITE(b, i) do { *(bf16x8*)((char*)V_lds + (b) * SHM_V + vst0) = St::tobf(sr_[i].vs0);          \
    *(bf16x8*)((char*)V_lds + (b) * SHM_V + vst1) = St::tobf(sr_[i].vs1); int kc = sc * 2;               \
    *(bf16x8*)((char*)K_lds + (b) * SHM_K + KSWZ(sr, kc)) = St::tobf(sr_[i].ks0);                       \
    *(bf16x8*)((char*)K_lds + (b) * SHM_K + KSWZ(32 + sr, kc)) = St::tobf(sr_[i].ks1); } while (0)
#define SWAIT() do { if constexpr (SDEPTH == 2) asm volatile("s_waitcnt vmcnt(4)" ::: "memory"); else asm volatile("s_waitcnt vmcnt(0)" ::: "memory"); } while (0)
#define RESC(a) do { if (__any((a) < 1.f)) { if (hi == 0) al_l[r32] = (a); asm volatile("s_waitcnt lgkmcnt(0)" ::: "memory"); \
    for (int d = 0; d < 4; ++d) for (int r = 0; r < 16; ++r) o[d][r] *= al_l[crow(r, hi)]; } } while (0)
  f32x16 pA0, pA1, pB0, pB1; float mnA, mnB, alA, alB; bf16x8 pa0, pa1, pa2, pa3; const int NT = seq / KVBLK;
  constexpr int SE = 0, SO = SDEPTH - 1;
  SLOAD(SE, 0); asm volatile("s_waitcnt vmcnt(0)" ::: "memory"); SWRITE(0, SE); __syncthreads();
  qkt(pA0, pA1, K_lds, qr, r32, hi); partialSM(pA0, pA1, m_reg, mnA, alA);
  SLOAD(SO, KVBLK); if constexpr (SDEPTH == 2) { if (2 < NT) SLOAD(SE, 2 * KVBLK); }
  SWAIT(); SWRITE(1, SO); __syncthreads();
  for (int j = 1; j + 1 < NT; j += 2) {
    SBAR(); qkt(pB0, pB1, (bf16*)((char*)K_lds + SHM_K), qr, r32, hi);
    finishSM(pA0, pA1, alA, l_reg, pa0, pa1, pa2, pa3); SBAR();
    SLOAD(SO, (j + SDEPTH) * KVBLK); SBAR();
    pv_d0(o, vb0, pa0, pa1, pa2, pa3); partialSM(pB0, pB1, m_reg, mnB, alB);
    __syncthreads(); SWAIT(); SWRITE(0, SE);
    RESC(alB); __syncthreads();
    SBAR(); qkt(pA0, pA1, K_lds, qr, r32, hi);
    finishSM(pB0, pB1, alB, l_reg, pa0, pa1, pa2, pa3); SBAR();
    if (SDEPTH == 1 || j + 3 < NT) SLOAD(SE, (j + 1 + SDEPTH) * KVBLK); SBAR();
    pv_d0(o, vb0 + (int)SHM_V, pa0, pa1, pa2, pa3); partialSM(pA0, pA1, m_reg, mnA, alA);
    __syncthreads(); SWAIT(); SWRITE(1, SO);
    RESC(alA); __syncthreads();
  }
  SBAR(); qkt(pB0, pB1, (bf16*)((char*)K_lds + SHM_K), qr, r32, hi);
  finishSM(pA0, pA1, alA, l_reg, pa0, pa1, pa2, pa3); SBAR();
  pv_d0(o, vb0, pa0, pa1, pa2, pa3); partialSM(pB0, pB1, m_reg, mnB, alB);
  __syncthreads(); RESC(alB);
  finishSM(pB0, pB1, alB, l_reg, pa0, pa1, pa2, pa3); SBAR();
  pv_d0(o, vb0 + (int)SHM_V, pa0, pa1, pa2, pa3);
  if (hi == 0) li_l[r32] = l_reg; asm volatile("s_waitcnt lgkmcnt(0)" ::: "memory");
  float rli[16];
#pragma unroll
  for (int r = 0; r < 16; ++r) rli[r] = __builtin_amdgcn_rcpf(li_l[crow(r, hi)]);
  bf16* Ow = Ob + (long)(wid * QBLK) * LDO;
#pragma unroll
  for (int r = 0; r < 16; ++r) { int orow = crow(r, hi);
    for (int d0 = 0; d0 < 4; ++d0) Ow[(long)orow * LDO + d0 * 32 + r32] = (bf16)(cvtpk(o[d0][r] * rli[r], 0.f) & 0xffffu); }
#undef SLOAD
#undef SWRITE
#undef SWAIT
#undef RESC
}
#undef KSWZ
#undef SBAR
}

namespace rw {
typedef short bf16x8 __attribute__((ext_vector_type(8)));
typedef float f32x4 __attribute__((ext_vector_type(4)));
typedef unsigned u32x4 __attribute__((ext_vector_type(4)));
typedef unsigned u32x2 __attribute__((ext_vector_type(2)));
constexpr int CH = 32, NC = R / CH;
static_assert(NC % 2 == 0, "the prep loop is unrolled by two");
constexpr int BUFB = 5 * 8192 + 1024;
constexpr int O_W = 0, O_B = 8192, O_KD = 16384, O_A = 24576, O_R = 32768, O_V = 40960;
constexpr int PITCH = 72;
constexpr int L_SCR = 2 * BUFB, SCRB = 2 * 16 * PITCH * 2;
constexpr int L_W2T = L_SCR + 4 * SCRB, L_A2T = L_W2T + 64 * PITCH * 2;
constexpr int L_Y = L_A2T + 64 * PITCH * 2;
constexpr int L_CST = L_Y + 2 * 2 * CH * 64 * 4;
constexpr int L_END = L_CST + 10 * 64 * 4;
static_assert(L_END <= 163840 - 64 && (BUFB % 16) == 0 && (L_SCR % 16) == 0 && (SCRB % 16) == 0 && (L_W2T % 16) == 0 && (L_A2T % 16) == 0 && (L_Y % 16) == 0 && (L_CST % 16) == 0, "rwkv LDS map");
constexpr size_t WS_BON = 38 * MiB;

template <int CTRL> __device__ __forceinline__ float dppmov(float x) { return __builtin_bit_cast(float, __builtin_amdgcn_update_dpp(0, __builtin_bit_cast(int, x), CTRL, 0xF, 0xF, true)); }
__device__ __forceinline__ float allreduce8(float x) {
    x += dppmov<0xB1>(x);
    x += dppmov<0x4E>(x);
    x += dppmov<0x141>(x);
    return x;
}
__device__ __forceinline__ float allreduce16(float x) { x = allreduce8(x); x += dppmov<0x140>(x); return x; }
__device__ __forceinline__ float fast_tanh(float x) { const float e = __builtin_amdgcn_exp2f(2.885390081777927f * x); return 1.0f - 2.0f * __builtin_amdgcn_rcpf(1.0f + e); }
__device__ __forceinline__ float bflo(unsigned u) { return __uint_as_float(u << 16); }
__device__ __forceinline__ float bfhi(unsigned u) { return __uint_as_float(u & 0xffff0000u); }
__device__ __forceinline__ unsigned pkbf(float lo, float hi) { unsigned r; asm volatile("v_cvt_pk_bf16_f32 %0, %1, %2" : "=v"(r) : "v"(lo), "v"(hi)); return r; }

constexpr int SEGR = 128, NSEG = R / SEGR, NCG = (ZW + 511) / 512;
constexpr size_t WS_HALO = 40 * MiB;
static_assert(WS_HALO + (size_t)NSEG * 2 * ZW * 2 <= WS_XN, "halo rows overflow");
__device__ __forceinline__ void shift_halo(const Params& p) {
    int tid_ = threadIdx.x; asm volatile("" : "+v"(tid_));
    const bf16_t* Z = ws_big(p); bf16_t* H = (bf16_t*)(p.ws + WS_HALO);
    for (int it = (int)blockIdx.x * NTHR + tid_; it < NSEG * 2 * (ZW / 8); it += (int)gridDim.x * NTHR) {
        const int c8 = it % (ZW / 8), w = (it / (ZW / 8)) & 1, seg = it / (2 * (ZW / 8));
        *(u32x4*)(H + ((size_t)seg * 2 + w) * ZW + c8 * 8) = *(const u32x4*)(Z + (size_t)(seg * SEGR + (w ? SEGR - 1 : 0)) * ZW + c8 * 8);
    }
}
__device__ __forceinline__ u32x4 shift8(u32x4 c, u32x4 pv, u32x4 nx, f32x4 m0, f32x4 m1) {
    u32x4 o;
#pragma unroll
    for (int q = 0; q < 4; ++q) { const float ml = q < 2 ? m0[2 * q] : m1[2 * q - 4], mh = q < 2 ? m0[2 * q + 1] : m1[2 * q - 3];
        const float zl = bflo(c[q]), zh = bfhi(c[q]);
        o[q] = pkbf(zl + (0.5f * (bflo(pv[q]) + bflo(nx[q])) - zl) * ml, zh + (0.5f * (bfhi(pv[q]) + bfhi(nx[q])) - zh) * mh); }
    return o;
}
__device__ __forceinline__ void shift_inplace(const Params& p) {
    int tid_ = threadIdx.x; asm volatile("" : "+v"(tid_));
    const int lane = tid_ & 63, gw = (int)blockIdx.x * NWAVES + (tid_ >> 6), ngw = (int)gridDim.x * NWAVES;
    bf16_t* Z = ws_big(p); const bf16_t* H = (const bf16_t*)(p.ws + WS_HALO);
    for (int u = gw; u < NSEG * NCG; u += ngw) {
        const int seg = u / NCG, col = (u % NCG) * 512 + lane * 8;
        if (col < ZW) {
            const f32x4 m0 = *(const f32x4*)(p.mu + col), m1 = *(const f32x4*)(p.mu + col + 4);
            const bool first = seg == 0 || seg == CTXN / SEGR, last = seg == CTXN / SEGR - 1 || seg == NSEG - 1;
            bf16_t* zr = Z + (size_t)seg * SEGR * ZW + col;
            u32x4 pv = first ? (u32x4){0u, 0u, 0u, 0u} : *(const u32x4*)(H + ((size_t)(seg - 1) * 2 + 1) * ZW + col);
            const u32x4 tail = last ? (u32x4){0u, 0u, 0u, 0u} : *(const u32x4*)(H + ((size_t)(seg + 1) * 2) * ZW + col);
            u32x4 c0 = *(const u32x4*)zr, c1 = *(const u32x4*)(zr + ZW), c2 = *(const u32x4*)(zr + 2 * ZW), c3 = *(const u32x4*)(zr + 3 * ZW);
            for (int r = 0; r < SEGR; r += 4) {
                u32x4 n0 = tail, n1 = tail, n2 = tail, n3 = tail;
                if (r + 4 < SEGR) { n0 = *(const u32x4*)(zr + (size_t)(r + 4) * ZW); n1 = *(const u32x4*)(zr + (size_t)(r + 5) * ZW); n2 = *(const u32x4*)(zr + (size_t)(r + 6) * ZW); n3 = *(const u32x4*)(zr + (size_t)(r + 7) * ZW); }
                const u32x4 o0 = shift8(c0, pv, c1, m0, m1), o1 = shift8(c1, c0, c2, m0, m1), o2 = shift8(c2, c1, c3, m0, m1), o3 = shift8(c3, c2, n0, m0, m1);
                *(u32x4*)(zr + (size_t)r * ZW) = o0; *(u32x4*)(zr + (size_t)(r + 1) * ZW) = o1; *(u32x4*)(zr + (size_t)(r + 2) * ZW) = o2; *(u32x4*)(zr + (size_t)(r + 3) * ZW) = o3;
                pv = c3; c0 = n0; c1 = n1; c2 = n2; c3 = n3;
            }
        }
    }
}

struct Raw { u32x4 c[5]; };

template <int MODE> __device__ __forceinline__ void scan_block(const Params& p, int blk, LAS unsigned char* lds) {
    int tid_ = threadIdx.x; asm volatile("" : "+v"(tid_));
    const int tid = tid_, lane = tid & 63, wave = __builtin_amdgcn_readfirstlane(tid >> 6);
    const int dir = blk >> 7, h = (blk >> 3) & 15, eighth = blk & 7;
    const float* w0 = dir ? p.w0b : p.w0f; const float* w2 = dir ? p.w2b : p.w2f; const float* a0 = dir ? p.a0b : p.a0f; const float* a2 = dir ? p.a2b : p.a2f;
    const bf16_t* Z = ws_big(p); bf16_t* BR = ws_br(p); float* bon = (float*)(p.ws + WS_BON) + ((size_t)dir * 16 + h) * SEQ;
    { const int m = tid >> 3, j8 = (tid & 7) * 8;
      const f32x4 wa = *(const f32x4*)(w2 + (size_t)m * 1024 + h * 64 + j8), wb = *(const f32x4*)(w2 + (size_t)m * 1024 + h * 64 + j8 + 4);
      const f32x4 aa = *(const f32x4*)(a2 + (size_t)m * 1024 + h * 64 + j8), ab = *(const f32x4*)(a2 + (size_t)m * 1024 + h * 64 + j8 + 4);
      LAS bf16_t* yw = (LAS bf16_t*)(lds + L_W2T); LAS bf16_t* ya = (LAS bf16_t*)(lds + L_A2T);
#pragma unroll
      for (int q = 0; q < 4; ++q) { yw[(j8 + q) * PITCH + m] = f2bf(wa[q]); yw[(j8 + 4 + q) * PITCH + m] = f2bf(wb[q]); ya[(j8 + q) * PITCH + m] = f2bf(aa[q]); ya[(j8 + 4 + q) * PITCH + m] = f2bf(ab[q]); }
      for (int i = tid; i < 4 * SCRB / 4; i += NTHR) *(LAS unsigned*)(lds + L_SCR + i * 4) = 0u;
      for (int i = tid; i < 640; i += NTHR) { const int g = i >> 6, cc = i & 63, hc = h * 64 + cc; float v;
          if (g < 3) v = p.mu[g * 1024 + hc]; else if (g == 3) v = p.mu[3072 + dir * 64 + cc]; else if (g == 4) v = p.mu[3200 + dir * 64 + cc];
          else if (g == 5) v = w0[hc]; else if (g == 6) v = a0[hc]; else if (g == 7) v = p.k_k[hc]; else if (g == 8) v = p.k_a[hc]; else v = p.r_k[hc];
          *(LAS float*)(lds + L_CST + i * 4) = v; } }
    __syncthreads();
    if ((wave & 2) != 0) {
        const int pw = (wave & 1) + ((wave >> 2) << 1), tq = lane >> 3, c8 = (lane & 7) * 8, hj = h * 64 + c8, tslot = pw * 8 + tq;
        const int gcol[5] = {hj, 1024 + hj, 2048 + hj, 3072 + dir * 64 + c8, 3200 + dir * 64 + c8};
        LAS unsigned char* scr = lds + L_SCR + pw * SCRB;
#define RW_CST(g, hh) (*(LAS f32x4*)(lds + L_CST + ((g) * 64 + c8 + 4 * (hh)) * 4))
#define RW_LOADRAW(raw, cc) do { const bf16_t* zr_ = Z + (size_t)rw_row(dir, (cc) * CH + tslot) * ZW; \
            _Pragma("unroll") for (int g = 0; g < 5; ++g) raw.c[g] = *(const u32x4*)(zr_ + gcol[g]); } while (0)
        Raw rawA, rawB;
        f32x4 cw0[2], ca0[2], ckk[2], cka[2], crk[2];
#pragma unroll
        for (int hh = 0; hh < 2; ++hh) { cw0[hh] = RW_CST(5, hh); ca0[hh] = RW_CST(6, hh); ckk[hh] = RW_CST(7, hh); cka[hh] = RW_CST(8, hh); crk[hh] = RW_CST(9, hh);
            asm volatile("" : "+v"(cw0[hh]), "+v"(ca0[hh]), "+v"(ckk[hh]), "+v"(cka[hh]), "+v"(crk[hh])); }
        if (MODE == 0 || MODE == 2 || MODE == 3 || MODE == 9) { RW_LOADRAW(rawA, 0); RW_LOADRAW(rawB, 1); }
#define RW_PREP_ITER(RAWSET, cc_) do { \
            if (MODE == 0 || MODE == 2 || MODE == 3 || MODE == 9) { \
            const int cn = (cc_) + 1; LAS unsigned char* buf = lds + (cn & 1) * BUFB; const int p0 = cn * CH; const bool latent = p0 >= CTXN; \
            f32x4 rr[2], kv[2]; \
            { const u32x4 u = RAWSET.c[0]; rr[0] = (f32x4){bflo(u.x), bfhi(u.x), bflo(u.y), bfhi(u.y)}; rr[1] = (f32x4){bflo(u.z), bfhi(u.z), bflo(u.w), bfhi(u.w)}; \
              *(LAS f32x4*)(buf + O_R + (tslot * 64 + c8) * 4) = rr[0]; *(LAS f32x4*)(buf + O_R + (tslot * 64 + c8) * 4 + 16) = rr[1]; } \
            { const u32x4 u = RAWSET.c[1]; kv[0] = (f32x4){bflo(u.x), bfhi(u.x), bflo(u.y), bfhi(u.y)}; kv[1] = (f32x4){bflo(u.z), bfhi(u.z), bflo(u.w), bfhi(u.w)}; } \
            if ((lane & 7) == eighth) { const u32x4 u = RAWSET.c[2]; *(LAS f32x4*)(buf + O_V + tslot * 32) = (f32x4){bflo(u.x), bfhi(u.x), bflo(u.y), bfhi(u.y)}; *(LAS f32x4*)(buf + O_V + tslot * 32 + 16) = (f32x4){bflo(u.z), bfhi(u.z), bflo(u.w), bfhi(u.w)}; } \
            { const u32x4 u = RAWSET.c[3]; u32x4 o; \
              o.x = pkbf(fast_tanh(bflo(u.x)), fast_tanh(bfhi(u.x))); o.y = pkbf(fast_tanh(bflo(u.y)), fast_tanh(bfhi(u.y))); o.z = pkbf(fast_tanh(bflo(u.z)), fast_tanh(bfhi(u.z))); o.w = pkbf(fast_tanh(bflo(u.w)), fast_tanh(bfhi(u.w))); \
              *(LAS u32x4*)(scr + (tq * PITCH + c8) * 2) = o; *(LAS u32x4*)(scr + 16 * PITCH * 2 + (tq * PITCH + c8) * 2) = RAWSET.c[4]; } \
            if (cn + 2 < NC) RW_LOADRAW(RAWSET, cn + 2);              \
            asm volatile("s_waitcnt lgkmcnt(0)" ::: "memory"); \
            { const int r16 = lane & 15, quad = lane >> 4; f32x4 acc[2][4]; \
_Pragma("unroll") \
              for (int lora = 0; lora < 2; ++lora) { \
                  LAS unsigned char* X = scr + lora * 16 * PITCH * 2 + (r16 * PITCH + quad * 8) * 2; \
                  const bf16x8 x0 = *(LAS bf16x8*)X, x1 = *(LAS bf16x8*)(X + 64); \
_Pragma("unroll") \
                  for (int jt = 0; jt < 4; ++jt) { \
                      LAS unsigned char* Y = lds + (lora ? L_A2T : L_W2T) + ((jt * 16 + r16) * PITCH + quad * 8) * 2; \
                      acc[lora][jt] = (f32x4){0.f, 0.f, 0.f, 0.f}; \
                      acc[lora][jt] = __builtin_amdgcn_mfma_f32_16x16x32_bf16(x0, *(LAS bf16x8*)Y, acc[lora][jt], 0, 0, 0); \
                      acc[lora][jt] = __builtin_amdgcn_mfma_f32_16x16x32_bf16(x1, *(LAS bf16x8*)(Y + 64), acc[lora][jt], 0, 0, 0); } } \
              if (quad < 2) { \
_Pragma("unroll") \
                  for (int lora = 0; lora < 2; ++lora) \
_Pragma("unroll") \
                      for (int jt = 0; jt < 4; ++jt) \
_Pragma("unroll") \
                          for (int r = 0; r < 4; ++r) *(LAS float*)(buf + (lora ? O_B : O_W) + ((pw * 8 + quad * 4 + r) * 64 + jt * 16 + r16) * 4) = acc[lora][jt][r]; } } \
            asm volatile("s_waitcnt lgkmcnt(0)" ::: "memory"); \
            { float bs = 0.f, nn = 0.f; f32x4 kk[2], al[2]; \
_Pragma("unroll") \
              for (int hh = 0; hh < 2; ++hh) { const int off = (tslot * 64 + c8 + 4 * hh) * 4; \
                  const f32x4 aw = *(LAS f32x4*)(buf + O_W + off) + cw0[hh], aa = *(LAS f32x4*)(buf + O_B + off) + ca0[hh]; \
                  f32x4 wv; \
_Pragma("unroll") \
                  for (int q = 0; q < 4; ++q) { const float sg = __builtin_amdgcn_rcpf(1.0f + __builtin_amdgcn_exp2f(-1.4426950408889634f * aw[q])); \
                      wv[q] = __builtin_amdgcn_exp2f(-0.8750612633917f * sg); al[hh][q] = __builtin_amdgcn_rcpf(1.0f + __builtin_amdgcn_exp2f(-1.4426950408889634f * aa[q])); kk[hh][q] = kv[hh][q] * ckk[hh][q]; nn += kk[hh][q] * kk[hh][q]; } \
                  *(LAS f32x4*)(buf + O_W + off) = wv; } \
              nn = allreduce8(nn); \
              const float inv = __builtin_amdgcn_rsqf(fmaxf(nn, 1e-24f)); \
_Pragma("unroll") \
              for (int hh = 0; hh < 2; ++hh) { const int off = (tslot * 64 + c8 + 4 * hh) * 4; \
                  const f32x4 r = rr[hh]; \
                  f32x4 av, bv, kd; \
_Pragma("unroll") \
                  for (int q = 0; q < 4; ++q) { const float kn = kk[hh][q] * inv; av[q] = -kn; bv[q] = kn * al[hh][q]; kd[q] = kv[hh][q] * (1.0f + (al[hh][q] - 1.0f) * cka[hh][q]); bs += r[q] * kd[q] * crk[hh][q]; } \
                  *(LAS f32x4*)(buf + O_B + off) = bv; *(LAS f32x4*)(buf + O_KD + off) = kd; *(LAS f32x4*)(buf + O_A + off) = av; } \
              bs = allreduce8(bs); \
              if (MODE == 0 && latent && eighth == 0 && (lane & 7) == 0) bon[rw_row(dir, p0 + tslot) - CTXN] = bs; } \
            } \
            __syncthreads(); \
        } while (0)
        for (int c = -1; c < NC - 1; c += 2) { RW_PREP_ITER(rawA, c); RW_PREP_ITER(rawB, c + 1); }
#undef RW_PREP_ITER
#undef RW_LOADRAW
#undef RW_CST
    } else if (wave >= 4) {
        const int sw = wave - 4, et = lane >> 1, erp = lane & 1;
#define RW_EMIT(cc) do { if ((cc) * CH >= CTXN) { const LAS f32x4* yp = (const LAS f32x4*)(lds + L_Y + ((((cc) & 1) * 2 + sw) * 8192) + et * 256 + erp * 128); \
            f32x4 s0 = yp[0] + yp[1] + yp[2] + yp[3], s1 = yp[4] + yp[5] + yp[6] + yp[7]; \
            *(unsigned*)(BR + (size_t)rw_row(dir, (cc) * CH + et) * 2048 + dir * 1024 + h * 64 + eighth * 8 + sw * 4 + erp * 2) = pkbf((s0[0] + s0[1]) + (s0[2] + s0[3]), (s1[0] + s1[1]) + (s1[2] + s1[3])); } } while (0)
        __syncthreads();
        for (int c = 0; c < NC; ++c) { if (c >= 1) RW_EMIT(c - 1); if (c + 1 < NC) __syncthreads(); }
    } else {
        __builtin_amdgcn_s_setprio(0);
        typedef float f32x2 __attribute__((ext_vector_type(2)));
        f32x2 S01 = {0.f, 0.f}, S23 = {0.f, 0.f};
        const int srow = wave * 4 + (lane >> 4), sj = (lane & 15) * 4;
        __syncthreads();
        struct Ops { f32x4 a, w, b, k, r; float v; };
#define RW_LD(o, t) do { o.a = *(LAS f32x4*)(bp + O_A + (t) * 256); \
            if (MODE == 9) { o.w = o.a; o.b = o.a; o.k = o.a; o.r = o.a; o.v = o.a[0]; } else { o.w = *(LAS f32x4*)(bp + O_W + (t) * 256); o.b = *(LAS f32x4*)(bp + O_B + (t) * 256); \
            o.k = *(LAS f32x4*)(bp + O_KD + (t) * 256); o.r = *(LAS f32x4*)(bp + O_R + (t) * 256); o.v = *(LAS float*)(vp + (t) * 32); } } while (0)
#define RW_STEP(o, t) do { f32x2 pd = S01 * o.a.lo; pd = S23 * o.a.hi + pd; float sa = pd.x + pd.y; if (MODE != 5 && MODE != 7) sa = allreduce16(sa); \
            S01 = o.b.lo * sa + (S01 * o.w.lo + o.k.lo * o.v); S23 = o.b.hi * sa + (S23 * o.w.hi + o.k.hi * o.v); \
            { f32x2 py = S01 * o.r.lo; py = S23 * o.r.hi + py; *(LAS float*)(yb + (t) * 256) = py.x + py.y; } } while (0)
        for (int c = 0; c < NC; ++c) {
            LAS unsigned char* bp = lds + (c & 1) * BUFB + sj * 4; LAS unsigned char* vp = lds + (c & 1) * BUFB + O_V + srow * 4; LAS unsigned char* yb = lds + L_Y + ((c & 1) * 2 + wave) * 8192 + lane * 4;
            Ops A0, A1, A2, A3, B0, B1, B2, B3;
            if (MODE != 2) {
            RW_LD(A0, 0); RW_LD(A1, 1); RW_LD(A2, 2); RW_LD(A3, 3);
#pragma unroll
            for (int g = 0; g < CH / 8; ++g) {
                RW_LD(B0, 8 * g + 4); RW_LD(B1, 8 * g + 5); RW_LD(B2, 8 * g + 6); RW_LD(B3, 8 * g + 7);
                __builtin_amdgcn_sched_barrier(0);
                RW_STEP(A0, 8 * g); RW_STEP(A1, 8 * g + 1); RW_STEP(A2, 8 * g + 2); RW_STEP(A3, 8 * g + 3);
                __builtin_amdgcn_sched_barrier(0);
                if (g + 1 < CH / 8) { RW_LD(A0, 8 * g + 8); RW_LD(A1, 8 * g + 9); RW_LD(A2, 8 * g + 10); RW_LD(A3, 8 * g + 11); }
                __builtin_amdgcn_sched_barrier(0);
                RW_STEP(B0, 8 * g + 4); RW_STEP(B1, 8 * g + 5); RW_STEP(B2, 8 * g + 6); RW_STEP(B3, 8 * g + 7);
                __builtin_amdgcn_sched_barrier(0);
            }
            }
            if (c + 1 < NC) __syncthreads();
        }
#undef RW_LD
#undef RW_STEP
        if (MODE != 0) asm volatile("" :: "v"(S01), "v"(S23));
        __builtin_amdgcn_s_setprio(0);
    }
    __syncthreads();
    if (wave == 4 || wave == 5) { const int sw = wave - 4, et = lane >> 1, erp = lane & 1; RW_EMIT(NC - 1); }
#undef RW_EMIT
    __syncthreads();
}

__device__ __forceinline__ float wave_sum(float v) {
    v = allreduce16(v);
    { auto r = __builtin_amdgcn_permlane16_swap(__float_as_uint(v), __float_as_uint(v), false, false); v = __uint_as_float(r[0]) + __uint_as_float(r[1]); }
    { auto r = __builtin_amdgcn_permlane32_swap(__float_as_uint(v), __float_as_uint(v), false, false); v = __uint_as_float(r[0]) + __uint_as_float(r[1]); }
    return v;
}
__device__ __forceinline__ void finish_phase(const Params& p) {
    int tid_ = threadIdx.x; asm volatile("" : "+v"(tid_));
    const int lane = tid_ & 63, gw = (int)blockIdx.x * NWAVES + (tid_ >> 6), ngw = (int)gridDim.x * NWAVES;
    const bf16_t* Z = ws_big(p); bf16_t* BR = ws_br(p); const float* bon = (const float*)(p.ws + WS_BON);
    for (int it = gw; it < SEQ * 4; it += ngw) {
        const int t = it >> 2, h = (it & 3) * 4 + (lane >> 4), row = CTXN + t, col = h * 64 + (lane & 15) * 4;
        bf16_t* b = BR + (size_t)row * 2048;
        const u32x2 wf = *(const u32x2*)(b + col), wb = *(const u32x2*)(b + 1024 + col), zv = *(const u32x2*)(Z + (size_t)row * ZW + 2048 + col);
        const f32x4 x = {bflo(wf.x) + bflo(wb.x), bfhi(wf.x) + bfhi(wb.x), bflo(wf.y) + bflo(wb.y), bfhi(wf.y) + bfhi(wb.y)};
        const float mean = allreduce16((x[0] + x[1]) + (x[2] + x[3])) * (1.0f / 64.f);
        const f32x4 d = x - mean;
        const float var = allreduce16((d[0] * d[0] + d[1] * d[1]) + (d[2] * d[2] + d[3] * d[3])) * (1.0f / 64.f);
        const float rstd = __builtin_amdgcn_rsqf(var + GN_EPS), bsum = bon[(size_t)h * SEQ + t] + bon[((size_t)16 + h) * SEQ + t];
        const f32x4 g = *(const f32x4*)(p.lnx_g + col), bb = *(const f32x4*)(p.lnx_b + col), v = {bflo(zv.x), bfhi(zv.x), bflo(zv.y), bfhi(zv.y)};
        const f32x4 y = d * rstd * g + bb + v * bsum;
        u32x2 o; o.x = pkbf(y[0], y[1]); o.y = pkbf(y[2], y[3]);
        *(u32x2*)(b + 1024 + col) = o;
    }
}
}

namespace wy {
typedef short bf16x4 __attribute__((ext_vector_type(4)));
using rw::f32x4; using rw::u32x4; using rw::u32x2; using rw::bf16x8; using rw::bflo; using rw::bfhi; using rw::PITCH;
typedef float f32x2_t __attribute__((ext_vector_type(2)));
typedef __bf16 bf2_t __attribute__((ext_vector_type(2)));
__device__ __forceinline__ unsigned pkbf(float lo, float hi) { const f32x2_t v = {lo, hi}; return __builtin_bit_cast(unsigned, __builtin_convertvector(v, bf2_t)); }
typedef GAS unsigned gu32;
#define WY_RLX __ATOMIC_RELAXED, __HIP_MEMORY_SCOPE_AGENT
constexpr int NJOB = R / 64, NCHUNK = R / 16, NSLOT = 8, ATP = 144, REC = 13056, JOBB = 4 * REC;
static_assert(R % 64 == 0 && CTXN % 64 == 0 && (R / 64) % 2 == 0, "jobs are 64 tokens; the loader is unrolled by two jobs");
constexpr int R_AT = 0, R_RT = 2304, R_BK = 4608, R_VT = 8704, R_AAK = 10752, R_TT = 11264, R_ARBK = 11776, R_WL = 12800;
__device__ __forceinline__ int permj(int j) { return (j >> 5) * 32 + ((j >> 2) & 3) * 8 + ((j >> 4) & 1) * 4 + (j & 3); }
constexpr int C_SLOTS = 3, C_SYNC = C_SLOTS * JOBB;
static_assert(C_SYNC + 64 <= 163840 - 64 && (JOBB / 4) % 16 == 0, "consumer LDS map");
constexpr size_t WS_RING = WS_WB;
constexpr size_t RING_TOTAL = (size_t)32 * NSLOT * JOBB;
constexpr size_t WS_WYF = 256 * 1024 + 16384;
constexpr int WYF_ACK = 32 * NSLOT * 64, WYF_ABORT = WYF_ACK + 32 * 64, WYF_WORDS = WYF_ABORT + 64;
constexpr unsigned SPIN_CAP = 1u << 17;
constexpr int P_A = 0, P_B = 16384, P_KD = 32768, P_LW = 49152, P_IMG = 65536, P_BRM = P_IMG + JOBB, P_KRM = P_BRM + 8192, P_AAB = P_KRM + 8192, P_W2T = P_AAB + 4096, P_A2T = P_W2T + 64 * PITCH * 2, P_END = P_A2T + 64 * PITCH * 2;
constexpr int P_SCR = P_BRM, SCRW = 2 * 8 * PITCH * 2;
constexpr int P_CST = P_IMG;
static_assert(P_END <= 163840 - 64 && P_SCR + 8 * SCRW + 8 * PITCH * 2 <= P_W2T, "wy LDS map");

__device__ __forceinline__ bf16x4 pack4(f32x4 v) { u32x2 r; r.x = pkbf(v[0], v[1]); r.y = pkbf(v[2], v[3]); return __builtin_bit_cast(bf16x4, r); }
__device__ __forceinline__ f32x4 mm(u32x2 a, bf16x4 b, f32x4 c) { return __builtin_amdgcn_mfma_f32_16x16x16bf16_1k(__builtin_bit_cast(bf16x4, a), b, c, 0, 0, 0); }
__device__ __forceinline__ f32x4 mm(u32x2 a, u32x2 b, f32x4 c) { return __builtin_amdgcn_mfma_f32_16x16x16bf16_1k(__builtin_bit_cast(bf16x4, a), __builtin_bit_cast(bf16x4, b), c, 0, 0, 0); }
__device__ __forceinline__ void wait_ge(gu32* word, unsigned want, gu32* abortw, int lane) {
    for (unsigned spins = 0;;) {
        unsigned v = 0u; if (lane == 0) v = __hip_atomic_load(word, WY_RLX);
        if ((unsigned)__builtin_amdgcn_readfirstlane(v) >= want) return;
        __builtin_amdgcn_s_sleep(1);
        if ((++spins & 255u) == 0u) { unsigned a = 0u; if (lane == 0) a = __hip_atomic_load(abortw, WY_RLX);
            if (__builtin_amdgcn_readfirstlane(a)) return;
            if (spins > SPIN_CAP) { if (lane == 0) __hip_atomic_store(abortw, 1u, WY_RLX); return; } }
    }
}

__device__ __forceinline__ void wait_ge4(gu32* words, unsigned want, gu32* abortw, int lane) {
    for (unsigned spins = 0;;) {
        unsigned v = 0xffffffffu; if (lane < 4) v = __hip_atomic_load(words + lane, WY_RLX);
        const unsigned v0 = (unsigned)__builtin_amdgcn_readlane((int)v, 0), v1 = (unsigned)__builtin_amdgcn_readlane((int)v, 1), v2 = (unsigned)__builtin_amdgcn_readlane((int)v, 2), v3 = (unsigned)__builtin_amdgcn_readlane((int)v, 3);
        const unsigned m01 = v0 < v1 ? v0 : v1, m23 = v2 < v3 ? v2 : v3;
        if ((m01 < m23 ? m01 : m23) >= want) return;
        __builtin_amdgcn_s_sleep(1);
        if ((++spins & 255u) == 0u) { unsigned a = 0u; if (lane == 0) a = __hip_atomic_load(abortw, WY_RLX);
            if (__builtin_amdgcn_readfirstlane(a)) return;
            if (spins > SPIN_CAP) { if (lane == 0) __hip_atomic_store(abortw, 1u, WY_RLX); return; } }
    }
}

struct Frag { u32x4 a01, a23, r01, r23, bk[4], arbk; u32x2 vT, aak, tt; f32x4 wl[4]; };

__device__ __forceinline__ void wait_lds_min4(LAS unsigned* w, unsigned want, gu32* abortw, int lane) {
    for (unsigned spins = 0;;) {
        const unsigned a = __hip_atomic_load(w, __ATOMIC_RELAXED, __HIP_MEMORY_SCOPE_WORKGROUP), b = __hip_atomic_load(w + 1, __ATOMIC_RELAXED, __HIP_MEMORY_SCOPE_WORKGROUP),
                       c = __hip_atomic_load(w + 2, __ATOMIC_RELAXED, __HIP_MEMORY_SCOPE_WORKGROUP), d = __hip_atomic_load(w + 3, __ATOMIC_RELAXED, __HIP_MEMORY_SCOPE_WORKGROUP);
        const unsigned m0 = a < b ? a : b, m1 = c < d ? c : d;
        if ((unsigned)__builtin_amdgcn_readfirstlane((int)(m0 < m1 ? m0 : m1)) >= want) return;
        __builtin_amdgcn_s_sleep(1);
        if ((++spins & 1023u) == 0u) { unsigned ab = 0u; if (lane == 0) ab = __hip_atomic_load(abortw, WY_RLX);
            if (__builtin_amdgcn_readfirstlane(ab)) return;
            if (spins > (SPIN_CAP << 3)) { if (lane == 0) __hip_atomic_store(abortw, 1u, WY_RLX); return; } }
    }
}
template <int MODE> __device__ __forceinline__ void loader(const Params& p, int chain, int lw, int lane, LAS unsigned char* lds) {
    gu32* wf = (gu32*)(p.ws + WS_WYF); gu32* flags = wf + chain * NSLOT * 64; gu32* ackw = wf + WYF_ACK + chain * 64; gu32* abortw = wf + WYF_ABORT;
    LAS unsigned* loaded = (LAS unsigned*)(lds + C_SYNC); LAS unsigned* done = loaded + 4;
    const __amdgpu_buffer_rsrc_t ring_rsrc = __builtin_amdgcn_make_buffer_rsrc((void*)(p.ws + WS_RING), 0, (int)RING_TOTAL, 0x00020000);
    constexpr int QB = JOBB / 4, NIT = (QB / 16 + 63) / 64, TAIL = QB / 16 - (NIT - 1) * 64;
    static_assert(NIT == 13, "the counted waits below assume 13 loads per set");
    u32x4 va[NIT], vb[NIT];
#define WY_ISSUE(v, g_) do { if (MODE < 2) wait_ge(flags + ((g_) % NSLOT) * 64, (unsigned)(g_) + 1u, abortw, lane); \
        const int soff = (chain * NSLOT + (g_) % NSLOT) * JOBB + lw * QB + lane * 16; \
        _Pragma("unroll") for (int k = 0; k < NIT; ++k) if (MODE == 0 && (k < NIT - 1 || lane < TAIL)) v[k] = __builtin_amdgcn_raw_buffer_load_b128(ring_rsrc, soff + k * 1024, 0, 16); } while (0)
#define WY_COMMIT(v, g_, WAITSTR) do { \
        if (MODE != 1 && (g_) >= C_SLOTS) { wait_lds_min4(done, (unsigned)((g_) - C_SLOTS + 1), abortw, lane); __builtin_amdgcn_fence(__ATOMIC_ACQUIRE, "workgroup"); }     \
        asm volatile(WAITSTR ::: "memory");                                                     \
        LAS unsigned char* dst = lds + ((g_) % C_SLOTS) * JOBB + lw * QB + lane * 16; \
        _Pragma("unroll") for (int k = 0; k < NIT; ++k) if (MODE == 0 && (k < NIT - 1 || lane < TAIL)) *(LAS u32x4*)(dst + k * 1024) = v[k]; \
        asm volatile("s_waitcnt lgkmcnt(0)" ::: "memory"); \
        __builtin_amdgcn_fence(__ATOMIC_RELEASE, "workgroup"); \
        if (lane == 0) { __hip_atomic_store(ackw + lw, (unsigned)(g_) + 1u, WY_RLX); __hip_atomic_store(loaded + lw, (unsigned)(g_) + 1u, __ATOMIC_RELAXED, __HIP_MEMORY_SCOPE_WORKGROUP); } } while (0)
    WY_ISSUE(va, 0);
    for (int g = 0; g < NJOB; g += 2) {
        WY_ISSUE(vb, g + 1); WY_COMMIT(va, g, "s_waitcnt vmcnt(13)");
        if (g + 2 < NJOB) { WY_ISSUE(va, g + 2); WY_COMMIT(vb, g + 1, "s_waitcnt vmcnt(13)"); } else WY_COMMIT(vb, g + 1, "s_waitcnt vmcnt(0)");
    }
#undef WY_ISSUE
#undef WY_COMMIT
}
__device__ __forceinline__ bf16x8 cat(u32x2 a, u32x2 b) { const u32x4 v = {a.x, a.y, b.x, b.y}; return __builtin_bit_cast(bf16x8, v); }
__device__ __forceinline__ u32x2 pack4u(f32x4 v) { u32x2 r; r.x = pkbf(v[0], v[1]); r.y = pkbf(v[2], v[3]); return r; }
__device__ __forceinline__ f32x4 mm32(bf16x8 a, bf16x8 b, f32x4 c) { return __builtin_amdgcn_mfma_f32_16x16x32_bf16(a, b, c, 0, 0, 0); }
template <int MODE> __device__ __forceinline__ void consumer(const Params& p, int chain, int wave, int lane, LAS unsigned char* lds) {
    const int n = lane & 15, q = lane >> 4, dir = chain >> 4, h = chain & 15;
    gu32* abortw = (gu32*)(p.ws + WS_WYF) + WYF_ABORT;
    LAS unsigned* loaded = (LAS unsigned*)(lds + C_SYNC); LAS unsigned* done = loaded + 4;
    f32x4 S0 = {0.f, 0.f, 0.f, 0.f}, S1 = S0, S2 = S0, S3 = S0;
    const int offA = n * ATP + 16 * q, offB = n * 32 + 8 * q, offW = 16 * q, offS = n * 64 + ((q ^ ((n >> 2) & 3)) * 16);
    const long rstep = dir ? -2048 : 2048;
    bf16_t* yq = ws_br(p) + (size_t)(CTXN + (dir ? SEQ - 1 - 4 * q : 4 * q)) * 2048 + dir * 1024 + h * 64 + 16 * wave + n;
#define WY_LOAD(F, base, k) do { \
        F.a01 = *(const LAS u32x4*)(base + offA + (k) * REC + R_AT); F.a23 = *(const LAS u32x4*)(base + offA + (k) * REC + R_AT + 64); \
        F.r01 = *(const LAS u32x4*)(base + offA + (k) * REC + R_RT); F.r23 = *(const LAS u32x4*)(base + offA + (k) * REC + R_RT + 64); \
        _Pragma("unroll") for (int jt = 0; jt < 4; ++jt) { F.bk[jt] = *(const LAS u32x4*)(base + offS + (k) * REC + R_BK + 1024 * jt); F.wl[jt] = *(const LAS f32x4*)(base + offW + (k) * REC + R_WL + 64 * jt); } \
        F.arbk = *(const LAS u32x4*)(base + offS + (k) * REC + R_ARBK); \
        F.vT = *(const LAS u32x2*)(base + offB + (k) * REC + R_VT + 512 * wave); F.aak = *(const LAS u32x2*)(base + offB + (k) * REC + R_AAK); F.tt = *(const LAS u32x2*)(base + offB + (k) * REC + R_TT); } while (0)
#define WY_Q(v) __builtin_bit_cast(bf16x8, v)
#define WY_COMPUTE(F, cidx) do { const f32x4 z0_ = {0.f, 0.f, 0.f, 0.f}; const u32x2 zz_ = {0u, 0u};     \
        const bf16x8 s01 = cat(pack4u(S0), pack4u(S1)), s23 = cat(pack4u(S2), pack4u(S3)); \
        f32x4 Z = mm32(WY_Q(F.a01), s01, z0_); Z = mm32(WY_Q(F.a23), s23, Z); Z = mm32(cat(F.aak, zz_), cat(F.vT, zz_), Z); \
        f32x4 Y = mm32(WY_Q(F.r01), s01, z0_); Y = mm32(WY_Q(F.r23), s23, Y); \
        const u32x2 zb = pack4u(Z); const f32x4 U = mm32(cat(F.tt, zz_), cat(zb, zz_), z0_); const u32x2 ub = pack4u(U); \
        const bf16x8 vu = cat(F.vT, ub); \
        Y = mm32(WY_Q(F.arbk), vu, Y); \
        S0 = mm32(WY_Q(F.bk[0]), vu, S0); S1 = mm32(WY_Q(F.bk[1]), vu, S1); S2 = mm32(WY_Q(F.bk[2]), vu, S2); S3 = mm32(WY_Q(F.bk[3]), vu, S3); \
        S0 *= F.wl[0]; S1 *= F.wl[1]; S2 *= F.wl[2]; S3 *= F.wl[3]; \
        if (MODE == 0 && (cidx) * 16 >= CTXN) { const unsigned y01 = pkbf(Y[0], Y[1]), y23 = pkbf(Y[2], Y[3]); bf16_t* yp_ = yq + (long)((cidx) * 16 - CTXN) * rstep; \
            *(unsigned short*)yp_ = (unsigned short)(y01 & 0xffffu); *(unsigned short*)(yp_ + rstep) = (unsigned short)(y01 >> 16); \
            *(unsigned short*)(yp_ + 2 * rstep) = (unsigned short)(y23 & 0xffffu); *(unsigned short*)(yp_ + 3 * rstep) = (unsigned short)(y23 >> 16); } } while (0)
    Frag FA, FB;
    wait_lds_min4(loaded, 1u, abortw, lane); __builtin_amdgcn_fence(__ATOMIC_ACQUIRE, "workgroup");
    int slot = 0;
    { const LAS unsigned char* b0 = lds; WY_LOAD(FA, b0, 0); if (MODE == 3) WY_LOAD(FB, b0, 1); }
    for (int g = 0; g < NJOB; ++g) {
        const LAS unsigned char* base = lds + slot * JOBB;
        if (MODE != 3) WY_LOAD(FB, base, 1); WY_COMPUTE(FA, 4 * g);
        if (MODE != 3) WY_LOAD(FA, base, 2); WY_COMPUTE(FB, 4 * g + 1);
        if (MODE != 3) WY_LOAD(FB, base, 3); WY_COMPUTE(FA, 4 * g + 2);
        slot = slot == C_SLOTS - 1 ? 0 : slot + 1;
        if (g + 1 < NJOB) { wait_lds_min4(loaded, (unsigned)g + 2u, abortw, lane); __builtin_amdgcn_fence(__ATOMIC_ACQUIRE, "workgroup");
            const LAS unsigned char* nb = lds + slot * JOBB; if (MODE != 3) WY_LOAD(FA, nb, 0); }
        WY_COMPUTE(FB, 4 * g + 3);
        asm volatile("s_waitcnt lgkmcnt(0)" ::: "memory");
        __builtin_amdgcn_fence(__ATOMIC_RELEASE, "workgroup");
        if (lane == 0) __hip_atomic_store(done + wave, (unsigned)g + 1u, __ATOMIC_RELAXED, __HIP_MEMORY_SCOPE_WORKGROUP);
    }
#undef WY_LOAD
#undef WY_COMPUTE
#undef WY_Q
    if (MODE != 0) asm volatile("" :: "v"(S0), "v"(S1), "v"(S2), "v"(S3));
}

template <int HALF> __device__ __forceinline__ void stage2(LAS unsigned char* lds, LAS unsigned char* img, int ch, int j) {
    LAS unsigned char* rec = img + ch * REC;
    const LAS float* LW = (const LAS float*)(lds + P_LW) + (ch * 16) * 64 + j;
    const LAS float* XA = (const LAS float*)(lds + (HALF ? P_KD : P_A)) + (ch * 16) * 64 + j;
    const LAS float* XB = (const LAS float*)(lds + P_B) + (ch * 16) * 64 + j;
    LAS unsigned short* rowm0 = (LAS unsigned short*)(rec + (HALF ? R_RT : R_AT)) + permj(j);
    LAS unsigned short* rowm1 = (LAS unsigned short*)(lds + (HALF ? P_KRM : P_BRM) + ch * 2048) + permj(j);
    float lw[16], s0[16], s1[16];
#pragma unroll
    for (int t = 0; t < 16; ++t) { lw[t] = LW[t * 64]; s1[t] = HALF ? XA[t * 64] : XB[t * 64];
        if (HALF) s0[t] = __uint_as_float((unsigned)rowm0[t * (ATP / 2)] << 16); else s0[t] = XA[t * 64]; }
    float cum = 0.f, x0p = 0.f, x1p = 0.f; unsigned tp[8];
#pragma unroll
    for (int t = 0; t < 16; ++t) {
        const float cprev = cum; cum += lw[t];
        const float x0 = s0[t] * __builtin_amdgcn_exp2f(HALF ? cum : cprev), x1 = s1[t] * __builtin_amdgcn_exp2f(-cum);
        if (t & 1) { const unsigned p0 = pkbf(x0p, x0), p1 = pkbf(x1p, x1);
            rowm0[(t - 1) * (ATP / 2)] = (unsigned short)(p0 & 0xffffu); rowm0[t * (ATP / 2)] = (unsigned short)(p0 >> 16);
            rowm1[(t - 1) * 64] = (unsigned short)(p1 & 0xffffu); rowm1[t * 64] = (unsigned short)(p1 >> 16);
            tp[t >> 1] = p1; }
        x0p = x0; x1p = x1; }
    { LAS unsigned char* bkr = rec + R_BK + j * 64 + (HALF ? 0 : 8); const int sw = (j >> 2) & 3;
#pragma unroll
      for (int qq = 0; qq < 4; ++qq) *(LAS u32x2*)(bkr + ((qq ^ sw) * 16)) = (u32x2){tp[2 * qq], tp[2 * qq + 1]}; }
    if (HALF) *(LAS float*)(rec + R_WL + j * 4) = __builtin_amdgcn_exp2f(cum);
}

template <int SKIP> __device__ __forceinline__ void producer(const Params& p, int chain, int first, int step, LAS unsigned char* lds) {
    int tid_ = threadIdx.x; asm volatile("" : "+v"(tid_));
    const int tid = tid_, lane = tid & 63, wave = __builtin_amdgcn_readfirstlane(tid >> 6);
    const int dir = chain >> 4, h = chain & 15;
    const float* w0 = dir ? p.w0b : p.w0f; const float* w2 = dir ? p.w2b : p.w2f; const float* a0 = dir ? p.a0b : p.a0f; const float* a2 = dir ? p.a2b : p.a2f;
    const bf16_t* Z = ws_big(p); float* bon = (float*)(p.ws + rw::WS_BON) + ((size_t)dir * 16 + h) * SEQ;
    gu32* wf = (gu32*)(p.ws + WS_WYF); gu32* flags = wf + chain * NSLOT * 64; gu32* ackw = wf + WYF_ACK + chain * 64; gu32* abortw = wf + WYF_ABORT;
    const __amdgpu_buffer_rsrc_t ring_rsrc = __builtin_amdgcn_make_buffer_rsrc((void*)(p.ws + WS_RING), 0, (int)RING_TOTAL, 0x00020000);
    { const int m = tid >> 3, j8 = (tid & 7) * 8;
      const f32x4 wa = *(const f32x4*)(w2 + (size_t)m * 1024 + h * 64 + j8), wb = *(const f32x4*)(w2 + (size_t)m * 1024 + h * 64 + j8 + 4);
      const f32x4 aa = *(const f32x4*)(a2 + (size_t)m * 1024 + h * 64 + j8), ab = *(const f32x4*)(a2 + (size_t)m * 1024 + h * 64 + j8 + 4);
      LAS bf16_t* yw = (LAS bf16_t*)(lds + P_W2T); LAS bf16_t* ya = (LAS bf16_t*)(lds + P_A2T);
#pragma unroll
      for (int qq = 0; qq < 4; ++qq) { yw[(j8 + qq) * PITCH + m] = f2bf(wa[qq]); yw[(j8 + 4 + qq) * PITCH + m] = f2bf(wb[qq]); ya[(j8 + qq) * PITCH + m] = f2bf(aa[qq]); ya[(j8 + 4 + qq) * PITCH + m] = f2bf(ab[qq]); }
      for (int i = tid; i < 320; i += NTHR) { const int gI = i >> 6, cc = i & 63, hc = h * 64 + cc; float v;
          if (gI == 0) v = w0[hc]; else if (gI == 1) v = a0[hc]; else if (gI == 2) v = p.k_k[hc]; else if (gI == 3) v = p.k_a[hc]; else v = p.r_k[hc];
          *(LAS float*)(lds + P_CST + i * 4) = v; } }
    __syncthreads();
    const int tq = lane >> 3, c8 = (lane & 7) * 8, hj = h * 64 + c8, tslot = wave * 8 + tq, ch1 = tslot >> 4, t1 = tslot & 15;
    const int gcol[5] = {hj, 1024 + hj, 2048 + hj, 3072 + dir * 64 + c8, 3200 + dir * 64 + c8};
    f32x4 cw0[2], ca0[2], ckk[2], cka[2], crk[2];
#pragma unroll
    for (int hh = 0; hh < 2; ++hh) {
#define WY_CST(gI) (*(LAS f32x4*)(lds + P_CST + ((gI) * 64 + c8 + 4 * hh) * 4))
        cw0[hh] = WY_CST(0); ca0[hh] = WY_CST(1); ckk[hh] = WY_CST(2); cka[hh] = WY_CST(3); crk[hh] = WY_CST(4);
#undef WY_CST
        asm volatile("" : "+v"(cw0[hh]), "+v"(ca0[hh]), "+v"(ckk[hh]), "+v"(cka[hh]), "+v"(crk[hh])); }
    __syncthreads();
    LAS unsigned char* scr = lds + P_SCR + wave * SCRW;
    LAS unsigned char* img = lds + P_IMG;
    rw::Raw raw;
#define WY_LOADRAW(gj) do { const bf16_t* zr_ = Z + (size_t)rw_row(dir, (gj) * 64 + tslot) * ZW; \
        _Pragma("unroll") for (int g5 = 0; g5 < 5; ++g5) raw.c[g5] = *(const u32x4*)(zr_ + gcol[g5]); } while (0)
    if (first < NJOB) WY_LOADRAW(first);
    for (int g = first; g < NJOB; g += step) {
        const bool latent = g * 64 >= CTXN;
        if (!(SKIP & 1)) { f32x4 rr[2], kv[2];
          { const u32x4 u = raw.c[0]; rr[0] = (f32x4){bflo(u.x), bfhi(u.x), bflo(u.y), bfhi(u.y)}; rr[1] = (f32x4){bflo(u.z), bfhi(u.z), bflo(u.w), bfhi(u.w)};
            LAS unsigned char* rr_ = img + ch1 * REC + R_RT + t1 * ATP + permj(c8) * 2; *(LAS u32x2*)rr_ = (u32x2){u.x, u.y}; *(LAS u32x2*)(rr_ + 16) = (u32x2){u.z, u.w}; }
          { const u32x4 u = raw.c[1]; kv[0] = (f32x4){bflo(u.x), bfhi(u.x), bflo(u.y), bfhi(u.y)}; kv[1] = (f32x4){bflo(u.z), bfhi(u.z), bflo(u.w), bfhi(u.w)}; }
          { const u32x4 u = raw.c[2]; LAS unsigned short* vt = (LAS unsigned short*)(img + ch1 * REC + R_VT) + c8 * 16 + t1;
            vt[0] = (unsigned short)(u.x & 0xffffu); vt[16] = (unsigned short)(u.x >> 16); vt[32] = (unsigned short)(u.y & 0xffffu); vt[48] = (unsigned short)(u.y >> 16);
            vt[64] = (unsigned short)(u.z & 0xffffu); vt[80] = (unsigned short)(u.z >> 16); vt[96] = (unsigned short)(u.w & 0xffffu); vt[112] = (unsigned short)(u.w >> 16); }
          { const u32x4 u = raw.c[3]; u32x4 o;
            o.x = pkbf(rw::fast_tanh(bflo(u.x)), rw::fast_tanh(bfhi(u.x))); o.y = pkbf(rw::fast_tanh(bflo(u.y)), rw::fast_tanh(bfhi(u.y))); o.z = pkbf(rw::fast_tanh(bflo(u.z)), rw::fast_tanh(bfhi(u.z))); o.w = pkbf(rw::fast_tanh(bflo(u.w)), rw::fast_tanh(bfhi(u.w)));
            *(LAS u32x4*)(scr + (tq * PITCH + c8) * 2) = o; *(LAS u32x4*)(scr + 8 * PITCH * 2 + (tq * PITCH + c8) * 2) = raw.c[4]; }
          if (g + step < NJOB) WY_LOADRAW(g + step);
          asm volatile("s_waitcnt lgkmcnt(0)" ::: "memory");
          { const int r16 = lane & 15, quad = lane >> 4; f32x4 acc[2][4];
#pragma unroll
            for (int lora = 0; lora < 2; ++lora) {
                LAS unsigned char* X = scr + lora * 8 * PITCH * 2 + (r16 * PITCH + quad * 8) * 2;
                const bf16x8 x0 = *(LAS bf16x8*)X, x1 = *(LAS bf16x8*)(X + 64);
#pragma unroll
                for (int jt = 0; jt < 4; ++jt) {
                    LAS unsigned char* Y = lds + (lora ? P_A2T : P_W2T) + ((jt * 16 + r16) * PITCH + quad * 8) * 2;
                    acc[lora][jt] = (f32x4){0.f, 0.f, 0.f, 0.f};
                    acc[lora][jt] = __builtin_amdgcn_mfma_f32_16x16x32_bf16(x0, *(LAS bf16x8*)Y, acc[lora][jt], 0, 0, 0);
                    acc[lora][jt] = __builtin_amdgcn_mfma_f32_16x16x32_bf16(x1, *(LAS bf16x8*)(Y + 64), acc[lora][jt], 0, 0, 0); } }
            if (quad < 2) {
#pragma unroll
                for (int lora = 0; lora < 2; ++lora)
#pragma unroll
                    for (int jt = 0; jt < 4; ++jt)
#pragma unroll
                        for (int r = 0; r < 4; ++r) *(LAS float*)(lds + (lora ? P_B : P_LW) + ((wave * 8 + quad * 4 + r) * 64 + jt * 16 + r16) * 4) = acc[lora][jt][r]; } }
          asm volatile("s_waitcnt lgkmcnt(0)" ::: "memory");
          { float bs = 0.f, nn = 0.f; f32x4 kk[2], al[2];
#pragma unroll
            for (int hh = 0; hh < 2; ++hh) { const int off = (tslot * 64 + c8 + 4 * hh) * 4;
                const f32x4 aw = *(LAS f32x4*)(lds + P_LW + off) + cw0[hh], aa = *(LAS f32x4*)(lds + P_B + off) + ca0[hh];
                f32x4 lw;
#pragma unroll
                for (int qq = 0; qq < 4; ++qq) { const float sg = __builtin_amdgcn_rcpf(1.0f + __builtin_amdgcn_exp2f(-1.4426950408889634f * aw[qq]));
                    lw[qq] = -0.8750612633917f * sg; al[hh][qq] = __builtin_amdgcn_rcpf(1.0f + __builtin_amdgcn_exp2f(-1.4426950408889634f * aa[qq])); kk[hh][qq] = kv[hh][qq] * ckk[hh][qq]; nn += kk[hh][qq] * kk[hh][qq]; }
                *(LAS f32x4*)(lds + P_LW + off) = lw; }
            nn = rw::allreduce8(nn);
            const float inv = __builtin_amdgcn_rsqf(fmaxf(nn, 1e-24f));
#pragma unroll
            for (int hh = 0; hh < 2; ++hh) { const int off = (tslot * 64 + c8 + 4 * hh) * 4;
                const f32x4 r = rr[hh];
                f32x4 av, bv, kd;
#pragma unroll
                for (int qq = 0; qq < 4; ++qq) { const float kn = kk[hh][qq] * inv; av[qq] = -kn; bv[qq] = kn * al[hh][qq]; kd[qq] = kv[hh][qq] * (1.0f + (al[hh][qq] - 1.0f) * cka[hh][qq]); bs += r[qq] * kd[qq] * crk[hh][qq]; }
                *(LAS f32x4*)(lds + P_B + off) = bv; *(LAS f32x4*)(lds + P_KD + off) = kd; *(LAS f32x4*)(lds + P_A + off) = av; }
            bs = rw::allreduce8(bs);
            if (latent && (lane & 7) == 0) bon[rw_row(dir, g * 64 + tslot) - CTXN] = bs; } }
        __syncthreads();
        if (!(SKIP & 2)) { if (wave >> 2) stage2<1>(lds, img, wave & 3, lane); else stage2<0>(lds, img, wave & 3, lane); }
        __syncthreads();
        if (!(SKIP & 4)) { const int ch = wave & 3, pair = wave >> 2, n = lane & 15, q = lane >> 4;
          LAS unsigned char* rec = img + ch * REC;
          const LAS unsigned char* Yrm = rec + (pair ? R_RT : R_AT) + n * ATP + 16 * q;
          const LAS unsigned char* Xb = lds + P_BRM + ch * 2048 + n * 128 + 16 * q;
          const LAS unsigned char* Xk = lds + P_KRM + ch * 2048 + n * 128 + 16 * q;
          f32x4 cb = {0.f, 0.f, 0.f, 0.f}, ck = cb;
#pragma unroll
          for (int jt = 0; jt < 4; ++jt) { const int o_ = (jt >> 1) * 64 + (jt & 1) * 8; const u32x2 yb = *(const LAS u32x2*)(Yrm + o_);
              cb = mm(*(const LAS u32x2*)(Xb + o_), yb, cb); ck = mm(*(const LAS u32x2*)(Xk + o_), yb, ck); }
#pragma unroll
          for (int r = 0; r < 4; ++r) { const int s = 4 * q + r; const bool keep = pair ? (s <= n) : (s < n); if (!keep) { cb[r] = 0.f; ck[r] = 0.f; } }
          u32x2 ob, ok; ob.x = pkbf(cb[0], cb[1]); ob.y = pkbf(cb[2], cb[3]); ok.x = pkbf(ck[0], ck[1]); ok.y = pkbf(ck[2], ck[3]);
          if (pair) *(LAS u32x4*)(rec + R_ARBK + n * 64 + ((q ^ ((n >> 2) & 3)) * 16)) = (u32x4){ok.x, ok.y, ob.x, ob.y};
          else {
              *(LAS u32x2*)(rec + R_AAK + n * 32 + 8 * q) = ok;
              LAS float* A2 = (LAS float*)(lds + P_AAB + ch * 1024);
#pragma unroll
              for (int r = 0; r < 4; ++r) A2[n * 16 + r * 4 + q] = cb[r];
              asm volatile("s_waitcnt lgkmcnt(0)" ::: "memory");
              const int c = lane >> 2, pp = lane & 3;
              f32x4 a4[16];
#pragma unroll
              for (int t = 0; t < 16; ++t) a4[t] = *(const LAS f32x4*)(A2 + t * 16 + pp * 4);
              float Tk0 = 0.f, Tk1 = 0.f, Tk2 = 0.f, Tk3 = 0.f, Tprev = 0.f;
              LAS unsigned short* tt = (LAS unsigned short*)(rec + R_TT) + c;
#pragma unroll
              for (int t = 0; t < 16; ++t) {
                  float acc = (a4[t][0] * Tk0 + a4[t][1] * Tk1) + (a4[t][2] * Tk2 + a4[t][3] * Tk3);
                  acc += rw::dppmov<0xB1>(acc); acc += rw::dppmov<0x4E>(acc);
                  const float Tt = acc + ((t == c) ? 1.0f : 0.0f);
                  const bool mine = (t & 3) == pp;
                  if ((t >> 2) == 0) Tk0 = mine ? Tt : Tk0; else if ((t >> 2) == 1) Tk1 = mine ? Tt : Tk1; else if ((t >> 2) == 2) Tk2 = mine ? Tt : Tk2; else Tk3 = mine ? Tt : Tk3;
                  if (t & 1) { const unsigned pk_ = pkbf(Tprev, Tt); if (pp == 0) { tt[(t - 1) * 16] = (unsigned short)(pk_ & 0xffffu); tt[t * 16] = (unsigned short)(pk_ >> 16); } }
                  Tprev = Tt; }
          } }
        if (wave == 0 && g >= NSLOT) wait_ge4(ackw, (unsigned)(g - NSLOT + 1), abortw, lane);
        __syncthreads();
        { const int slot = g % NSLOT; const int base = (chain * NSLOT + slot) * JOBB;
          if (!(SKIP & 8)) for (int i = tid; i < JOBB / 16; i += NTHR) __builtin_amdgcn_raw_buffer_store_b128(*(LAS u32x4*)(img + i * 16), ring_rsrc, base + i * 16, 0, 16);
          asm volatile("s_waitcnt vmcnt(0)" ::: "memory");
          __syncthreads();
          if (tid == 0) __hip_atomic_store(flags + slot * 64, (unsigned)g + 1u, WY_RLX); }
    }
#undef WY_LOADRAW
}

__device__ __forceinline__ void zero_words(const Params& p) {
    int t_ = threadIdx.x; asm volatile("" : "+v"(t_)); unsigned* wf_ = (unsigned*)(p.ws + WS_WYF);
    for (long g = (long)blockIdx.x * NTHR + t_; g < (long)WYF_WORDS; g += (long)gridDim.x * NTHR) wf_[g] = 0u;
}
template <int MODE, int SKIP = 0> __device__ __forceinline__ void phase(const Params& p, LAS unsigned char* lds) {
    const int G = (int)gridDim.x, b = (int)blockIdx.x, nper = (G - 32) / 32;
    if (b < 32) {
        int tid_ = threadIdx.x; asm volatile("" : "+v"(tid_)); const int wave = __builtin_amdgcn_readfirstlane(tid_ >> 6);
        if (tid_ < 8) *(LAS unsigned*)(lds + C_SYNC + 4 * tid_) = 0u;
        __syncthreads();
        if (wave < 4) { if (MODE != 1) consumer<MODE>(p, b, wave, tid_ & 63, lds); } else loader<MODE>(p, b, wave - 4, tid_ & 63, lds);
    }
    else if (MODE < 2) { const int pp = b - 32; if (pp < 32 * nper) producer<SKIP>(p, pp % 32, pp / 32, nper, lds); }
}
}

namespace ret {
using attn::bf16x8; using attn::s16x4; using attn::f32x16; using attn::u32x4;
typedef float f32x4 __attribute__((ext_vector_type(4)));
typedef unsigned u32x2 __attribute__((ext_vector_type(2)));
constexpr int NQ = R / 128;
constexpr size_t SLOT_BYTES = 256 * 128 * 2;
constexpr size_t WS_SCTX = 254 * MiB;
#define RKSWZ(row, colB) ((row) * 256 + ((colB) ^ (((row) & 7) << 4)))
__device__ __forceinline__ bf16_t* slot(const Params& p, int dir, int q, int head) {
    return q >= 2 ? (bf16_t*)((unsigned char*)p.out + (((size_t)dir * (NQ - 2) + (q - 2)) * 4 + head) * SLOT_BYTES)
                  : (bf16_t*)(p.ws + WS_SCTX + (((size_t)dir * 2 + q) * 4 + head) * SLOT_BYTES);
}
__device__ __forceinline__ float log2_sigmoid(float x) { return -1.4426950408889634f * (fmaxf(-x, 0.f) + log1pf(expf(-fabsf(x)))); }
__device__ __forceinline__ bf16x8 scale8(bf16x8 v, float s) {
    u32x4 w = __builtin_bit_cast(u32x4, v), o;
#pragma unroll
    for (int i = 0; i < 4; ++i) o[i] = attn::cvtpk(__uint_as_float(w[i] << 16) * s, __uint_as_float(w[i] & 0xffff0000u) * s);
    return __builtin_bit_cast(bf16x8, o);
}
__device__ __forceinline__ void pk4(const f32x16& P, int base, bf16x8& out) {
    const unsigned a0 = attn::cvtpk(P[base + 0], P[base + 1]), a1 = attn::cvtpk(P[base + 2], P[base + 3]);
    const unsigned b0 = attn::cvtpk(P[base + 4], P[base + 5]), b1 = attn::cvtpk(P[base + 6], P[base + 7]);
    auto r0 = __builtin_amdgcn_permlane32_swap(a0, b0, false, false); auto r1 = __builtin_amdgcn_permlane32_swap(a1, b1, false, false);
    u32x4 w = {r0[0], r1[0], r0[1], r1[1]}; out = __builtin_bit_cast(bf16x8, w);
}
#define RPK(L, H) (bf16x8){L[0], L[1], L[2], L[3], H[0], H[1], H[2], H[3]}

__device__ __forceinline__ void summaries_unit(const Params& p, int q, int h, char* lds) {
    int tid_ = threadIdx.x; asm volatile("" : "+v"(tid_));
    const int tid = tid_, lane = tid & 63, wave = __builtin_amdgcn_readfirstlane(tid >> 6), r32 = lane & 31, hi = lane >> 5;
    const bf16_t* P = ws_big(p) + (size_t)q * 128 * P0W;
    const float lgf = log2_sigmoid(p.dec_f[h]), lgb = log2_sigmoid(p.dec_b[h]);
    const int sr = tid >> 4, sc = (tid & 15) * 8, st0 = attn::v_st(sr, sc), st1 = attn::v_st(32 + sr, sc);
#pragma unroll
    for (int th = 0; th < 2; ++th) {
        const int t0 = th * 64 + sr, t1 = t0 + 32;
        const bf16_t* r0 = P + (size_t)t0 * P0W; const bf16_t* r1 = P + (size_t)t1 * P0W;
#pragma unroll
        for (int eh = 0; eh < 2; ++eh) { char* vt = lds + (th * 2 + eh) * 16384;
            *(bf16x8*)(vt + st0) = *(const bf16x8*)(r0 + C_VA + h * 256 + eh * 128 + sc); *(bf16x8*)(vt + st1) = *(const bf16x8*)(r1 + C_VA + h * 256 + eh * 128 + sc); }
        const bf16x8 k0 = *(const bf16x8*)(r0 + C_KA + h * 128 + sc), k1 = *(const bf16x8*)(r1 + C_KA + h * 128 + sc);
        char* kf = lds + 65536 + th * 16384; char* kb = lds + 98304 + th * 16384;
        *(bf16x8*)(kf + st0) = scale8(k0, __builtin_amdgcn_exp2f((float)(127 - t0) * lgf)); *(bf16x8*)(kf + st1) = scale8(k1, __builtin_amdgcn_exp2f((float)(127 - t1) * lgf));
        *(bf16x8*)(kb + st0) = scale8(k0, __builtin_amdgcn_exp2f((float)t0 * lgb)); *(bf16x8*)(kb + st1) = scale8(k1, __builtin_amdgcn_exp2f((float)t1 * lgb));
    }
    __syncthreads();
    const int lbase = (int)(uintptr_t)lds + attn::v_rd_base(lane);
    f32x16 acc[2][4];
#pragma unroll
    for (int d = 0; d < 2; ++d)
#pragma unroll
        for (int b = 0; b < 4; ++b) acc[d][b] = f32x16{};
#pragma unroll
    for (int th = 0; th < 2; ++th) {
        const int va = lbase + (th * 2 + (wave >> 2)) * 16384 + (wave & 3) * 512, kfb = lbase + 65536 + th * 16384, kbb = lbase + 98304 + th * 16384;
#define R1_STEP(KS) do { \
        const s16x4 al = attn::tr_read<attn::v_rd_off(0, KS, 0)>(va), ah = attn::tr_read<attn::v_rd_off(0, KS, 1)>(va); \
        const s16x4 f0l = attn::tr_read<attn::v_rd_off(0, KS, 0)>(kfb), f0h = attn::tr_read<attn::v_rd_off(0, KS, 1)>(kfb), f1l = attn::tr_read<attn::v_rd_off(1, KS, 0)>(kfb), f1h = attn::tr_read<attn::v_rd_off(1, KS, 1)>(kfb); \
        const s16x4 f2l = attn::tr_read<attn::v_rd_off(2, KS, 0)>(kfb), f2h = attn::tr_read<attn::v_rd_off(2, KS, 1)>(kfb), f3l = attn::tr_read<attn::v_rd_off(3, KS, 0)>(kfb), f3h = attn::tr_read<attn::v_rd_off(3, KS, 1)>(kfb); \
        const s16x4 g0l = attn::tr_read<attn::v_rd_off(0, KS, 0)>(kbb), g0h = attn::tr_read<attn::v_rd_off(0, KS, 1)>(kbb), g1l = attn::tr_read<attn::v_rd_off(1, KS, 0)>(kbb), g1h = attn::tr_read<attn::v_rd_off(1, KS, 1)>(kbb); \
        const s16x4 g2l = attn::tr_read<attn::v_rd_off(2, KS, 0)>(kbb), g2h = attn::tr_read<attn::v_rd_off(2, KS, 1)>(kbb), g3l = attn::tr_read<attn::v_rd_off(3, KS, 0)>(kbb), g3h = attn::tr_read<attn::v_rd_off(3, KS, 1)>(kbb); \
        asm volatile("s_waitcnt lgkmcnt(0)" ::: "memory"); __builtin_amdgcn_sched_barrier(0); \
        const bf16x8 a = RPK(al, ah); \
        acc[0][0] = __builtin_amdgcn_mfma_f32_32x32x16_bf16(a, RPK(f0l, f0h), acc[0][0], 0, 0, 0); acc[0][1] = __builtin_amdgcn_mfma_f32_32x32x16_bf16(a, RPK(f1l, f1h), acc[0][1], 0, 0, 0); \
        acc[0][2] = __builtin_amdgcn_mfma_f32_32x32x16_bf16(a, RPK(f2l, f2h), acc[0][2], 0, 0, 0); acc[0][3] = __builtin_amdgcn_mfma_f32_32x32x16_bf16(a, RPK(f3l, f3h), acc[0][3], 0, 0, 0); \
        acc[1][0] = __builtin_amdgcn_mfma_f32_32x32x16_bf16(a, RPK(g0l, g0h), acc[1][0], 0, 0, 0); acc[1][1] = __builtin_amdgcn_mfma_f32_32x32x16_bf16(a, RPK(g1l, g1h), acc[1][1], 0, 0, 0); \
        acc[1][2] = __builtin_amdgcn_mfma_f32_32x32x16_bf16(a, RPK(g2l, g2h), acc[1][2], 0, 0, 0); acc[1][3] = __builtin_amdgcn_mfma_f32_32x32x16_bf16(a, RPK(g3l, g3h), acc[1][3], 0, 0, 0); \
        __builtin_amdgcn_sched_barrier(0); } while (0)
        R1_STEP(0); R1_STEP(1); R1_STEP(2); R1_STEP(3);
#undef R1_STEP
    }
#pragma unroll
    for (int d = 0; d < 2; ++d) { bf16_t* dst = slot(p, d, q, h);
#pragma unroll
        for (int db = 0; db < 4; ++db)
#pragma unroll
            for (int r = 0; r < 16; ++r) dst[(size_t)(32 * wave + attn::crow(r, hi)) * 128 + 32 * db + r32] = (bf16_t)(attn::cvtpk(acc[d][db][r], 0.f) & 0xffffu); }
    __syncthreads();
}

__device__ __forceinline__ void state_scan(const Params& p) {
    int tid_ = threadIdx.x; asm volatile("" : "+v"(tid_));
    for (long gt = (long)blockIdx.x * NTHR + tid_; gt < 2L * 4 * 16384; gt += (long)gridDim.x * NTHR) {
    const int pair = (int)(gt & 16383), h = (int)((gt >> 14) & 3), dir = (int)(gt >> 16);
    const float G = __builtin_amdgcn_exp2f(128.0f * log2_sigmoid((dir ? p.dec_b : p.dec_f)[h]));
    float s0 = 0.f, s1 = 0.f;
    for (int n = 0; n < NQ; ++n) {
        const int q = dir == 0 ? n : (n < 2 ? 1 - n : NQ + 1 - n);
        unsigned* ptr = (unsigned*)slot(p, dir, q, h) + pair;
        const unsigned u = *ptr;
        *ptr = attn::cvtpk(s0, s1);
        s0 = G * s0 + __uint_as_float(u << 16); s1 = G * s1 + __uint_as_float(u & 0xffff0000u);
    }    }
}

__device__ __forceinline__ void output_unit(const Params& p, int q, int h, char* lds) {
    int tid_ = threadIdx.x; asm volatile("" : "+v"(tid_));
    const int tid = tid_, lane = tid & 63, wave = __builtin_amdgcn_readfirstlane(tid >> 6), r32 = lane & 31, hi = lane >> 5;
    const int ib = wave >> 1, eh = wave & 1;
    const bf16_t* P = ws_big(p) + (size_t)q * 128 * P0W;
    const float lgf = log2_sigmoid(p.dec_f[h]), lgb = log2_sigmoid(p.dec_b[h]);
    { const int sr = tid >> 4, sc = (tid & 15) * 8, st0 = attn::v_st(sr, sc), st1 = attn::v_st(32 + sr, sc);
#pragma unroll
      for (int jt = 0; jt < 2; ++jt) {
          const bf16_t* r0 = P + (size_t)(jt * 64 + sr) * P0W; const bf16_t* r1 = r0 + (size_t)32 * P0W;
          char* kt = lds + jt * 16384;
          *(bf16x8*)(kt + RKSWZ(sr, sc * 2)) = *(const bf16x8*)(r0 + C_KA + h * 128 + sc); *(bf16x8*)(kt + RKSWZ(32 + sr, sc * 2)) = *(const bf16x8*)(r1 + C_KA + h * 128 + sc);
#pragma unroll
          for (int e2 = 0; e2 < 2; ++e2) { char* vt = lds + 32768 + (jt * 2 + e2) * 16384;
              *(bf16x8*)(vt + st0) = *(const bf16x8*)(r0 + C_VA + h * 256 + e2 * 128 + sc); *(bf16x8*)(vt + st1) = *(const bf16x8*)(r1 + C_VA + h * 256 + e2 * 128 + sc); }
      } }
    bf16x8 qr[8];
    { const bf16_t* Qw = P + (size_t)(ib * 32 + r32) * P0W + C_QA + h * 128 + hi * 8;
#pragma unroll
      for (int d0 = 0; d0 < 8; ++d0) qr[d0] = *(const bf16x8*)(Qw + d0 * 16); }
    const bf16_t* Sf = slot(p, 0, q, h) + (size_t)(eh * 128 + r32) * 128 + hi * 8; const bf16_t* Sb = slot(p, 1, q, h) + (size_t)(eh * 128 + r32) * 128 + hi * 8;
    bf16x8 fa[8], fb[8];
#define RET_LOADB(F, S, sb) do { _Pragma("unroll") for (int s_ = 0; s_ < 2; ++s_) _Pragma("unroll") for (int d0 = 0; d0 < 4; ++d0) F[s_ * 4 + d0] = *(const bf16x8*)((S) + (size_t)d0 * 32 * 128 + ((sb) * 2 + s_) * 16); } while (0)
#define RET_MMAB(F, sc, sb) do { _Pragma("unroll") for (int s_ = 0; s_ < 2; ++s_) { const bf16x8 a = scale8(qr[(sb) * 2 + s_], sc); \
        _Pragma("unroll") for (int d0 = 0; d0 < 4; ++d0) o[d0] = __builtin_amdgcn_mfma_f32_32x32x16_bf16(a, F[s_ * 4 + d0], o[d0], 0, 0, 0); } } while (0)
    RET_LOADB(fa, Sf, 0);
    __syncthreads();
    f32x16 o[4] = {};
    const int i_loc = ib * 32 + r32;
    const int vb0 = (int)(uintptr_t)lds + 32768 + attn::v_rd_base(lane);
#pragma unroll
    for (int jt = 0; jt < 2; ++jt) {
        f32x16 p0, p1;
        attn::qkt(p0, p1, (const attn::bf16*)(lds + jt * 16384), qr, r32, hi);
#pragma unroll
        for (int r = 0; r < 16; ++r) {
            const int j0 = jt * 64 + attn::crow(r, hi), dl0 = i_loc - j0, dl1 = dl0 - 32;
            const float m0 = dl0 > 0 ? __builtin_amdgcn_exp2f((float)dl0 * lgf) : (dl0 < 0 ? __builtin_amdgcn_exp2f((float)(-dl0) * lgb) : 2.0f);
            const float m1 = dl1 > 0 ? __builtin_amdgcn_exp2f((float)dl1 * lgf) : (dl1 < 0 ? __builtin_amdgcn_exp2f((float)(-dl1) * lgb) : 2.0f);
            p0[r] *= m0; p1[r] *= m1;
        }
        bf16x8 pa0, pa1, pa2, pa3; pk4(p0, 0, pa0); pk4(p0, 8, pa1); pk4(p1, 0, pa2); pk4(p1, 8, pa3);
        __builtin_amdgcn_sched_barrier(0);
        attn::pv_d0(o, vb0 + (jt * 2 + eh) * 16384, pa0, pa1, pa2, pa3);
    }
    { const float scf = __builtin_amdgcn_exp2f((float)(i_loc + 1) * lgf), scb = __builtin_amdgcn_exp2f((float)(128 - i_loc) * lgb);
      RET_LOADB(fb, Sf, 1); __builtin_amdgcn_sched_barrier(0);
      RET_MMAB(fa, scf, 0); __builtin_amdgcn_sched_barrier(0); RET_LOADB(fa, Sf, 2); __builtin_amdgcn_sched_barrier(0);
      RET_MMAB(fb, scf, 1); __builtin_amdgcn_sched_barrier(0); RET_LOADB(fb, Sf, 3); __builtin_amdgcn_sched_barrier(0);
      RET_MMAB(fa, scf, 2); __builtin_amdgcn_sched_barrier(0); RET_LOADB(fa, Sb, 0); __builtin_amdgcn_sched_barrier(0);
      RET_MMAB(fb, scf, 3); __builtin_amdgcn_sched_barrier(0); RET_LOADB(fb, Sb, 1); __builtin_amdgcn_sched_barrier(0);
      RET_MMAB(fa, scb, 0); __builtin_amdgcn_sched_barrier(0); RET_LOADB(fa, Sb, 2); __builtin_amdgcn_sched_barrier(0);
      RET_MMAB(fb, scb, 1); __builtin_amdgcn_sched_barrier(0); RET_LOADB(fb, Sb, 3); __builtin_amdgcn_sched_barrier(0);
      RET_MMAB(fa, scb, 2); __builtin_amdgcn_sched_barrier(0);
      RET_MMAB(fb, scb, 3); }
#undef RET_LOADB
#undef RET_MMAB
    __syncthreads();
    float* O = (float*)lds;
#pragma unroll
    for (int r = 0; r < 16; ++r)
#pragma unroll
        for (int d0 = 0; d0 < 4; ++d0) O[(ib * 32 + attn::crow(r, hi)) * 256 + eh * 128 + d0 * 32 + r32] = o[d0][r];
    __syncthreads();
    bf16_t* BR = ws_br(p) + (size_t)q * 128 * 2048 + h * 256;
#pragma unroll 4
    for (int rr = 0; rr < 16; ++rr) {
        const int row = wave * 16 + rr; const f32x4 x = *(const f32x4*)(O + row * 256 + lane * 4);
        const float mean = rw::wave_sum((x[0] + x[1]) + (x[2] + x[3])) * (1.0f / 256.f);
        const f32x4 d = x - mean;
        const float var = rw::wave_sum((d[0] * d[0] + d[1] * d[1]) + (d[2] * d[2] + d[3] * d[3])) * (1.0f / 256.f);
        const float rstd = 1.0f / sqrtf(var + NORM_EPS);
        f32x4 y = d * rstd;
        if (q < 2) { const u32x2 gg = *(const u32x2*)((const bf16_t*)(p.ws + 255 * MiB) + (size_t)(q * 128 + row) * 2048 + h * 256 + lane * 4);
            y[0] *= __uint_as_float(gg.x << 16); y[1] *= __uint_as_float(gg.x & 0xffff0000u); y[2] *= __uint_as_float(gg.y << 16); y[3] *= __uint_as_float(gg.y & 0xffff0000u); }
        u32x2 w; w.x = attn::cvtpk(y[0], y[1]); w.y = attn::cvtpk(y[2], y[3]);
        *(u32x2*)(BR + (size_t)row * 2048 + lane * 4) = w;
    }
    __syncthreads();
}
#undef RPK
#undef RKSWZ
}

namespace na {
using attn::bf16x8; using attn::f32x16; using attn::u32x4;
constexpr float L2E = 1.4426950408889634f;
constexpr int WH = GROWS < 8 ? GROWS : 8;
constexpr int L_K = 0, L_V = 32768, L_WS = 65536, L_RPB = L_WS + NWAVES * 64 * 4, L_END = L_RPB + 15 * 31 * 4;
#define NKSWZ(row, colB) ((row) * 256 + ((colB) ^ (((row) & 7) << 4)))
__device__ __forceinline__ int win_r0(int r) { int r0 = r - WH / 2; return r0 < 0 ? 0 : (r0 > GROWS - WH ? GROWS - WH : r0); }
__device__ __forceinline__ int win_c0(int c) { int c0 = c - 8; return c0 < 0 ? 0 : (c0 > GW - 16 ? GW - 16 : c0); }

__device__ __forceinline__ void na_unit(const Params& p, int rg, int h, char* lds) {
    int tid_ = threadIdx.x; asm volatile("" : "+v"(tid_));
    const int tid = tid_, lane = tid & 63, wave = __builtin_amdgcn_readfirstlane(tid >> 6), r32 = lane & 31, hi = lane >> 5;
    const bf16_t* P = ws_big(p); const bf16_t* NAC = (const bf16_t*)(p.ws + 255 * MiB);
    const int r = 4 * rg + (wave >> 1), qc = (wave & 1) * 32 + r32, my_r0 = win_r0(r), my_c0 = win_c0(qc);
    const int lo = win_r0(4 * rg), hiw = win_r0(4 * rg + 3) + WH, NT = hiw - lo + CTXN / 64;
    float* wsf = (float*)(lds + L_WS) + wave * 64; float* rpb_l = (float*)(lds + L_RPB);
    if (tid < 15 * 31) rpb_l[tid] = p.rpb[h * 15 * 31 + tid];
    bf16x8 qr[4];
    { const bf16_t* Qw = P + (size_t)(CTXN + r * 64 + qc) * NAW + h * 64 + hi * 8;
#pragma unroll
      for (int d0 = 0; d0 < 4; ++d0) qr[d0] = *(const bf16x8*)(Qw + d0 * 16); }
    const int sk = tid >> 3, sc = (tid & 7) * 8, kst = NKSWZ(sk, sc * 2), vst = attn::v_st(sk, sc);
    bf16x8 kA, vA, kB, vB;
#define NA_LOAD(KR, VR, t) do { if ((t) < hiw - lo) { const int krow_ = CTXN + (lo + (t)) * 64 + sk; \
            KR = *(const bf16x8*)(P + (size_t)krow_ * NAW + 1024 + h * 64 + sc); VR = *(const bf16x8*)(P + (size_t)krow_ * NAW + 2048 + h * 64 + sc); } \
        else { const bf16_t* c_ = NAC + (size_t)(((t) - (hiw - lo)) * 64 + sk) * 2048 + h * 64 + sc; KR = *(const bf16x8*)c_; VR = *(const bf16x8*)(c_ + 1024); } } while (0)
#define NA_WRITE(KR, VR, b) do { *(bf16x8*)(lds + L_K + (b) * 16384 + kst) = KR; *(bf16x8*)(lds + L_V + (b) * 16384 + vst) = VR; } while (0)
    NA_LOAD(kA, vA, 0); NA_WRITE(kA, vA, 0);
    NA_LOAD(kB, vB, 1);
    __syncthreads();
    float m_reg = -1e30f, l_reg = 0.f; f32x16 o[2] = {};
    const int vb0 = (int)(uintptr_t)lds + L_V + attn::v_rd_base(lane);
#define NA_TILE(t, KW, VW, KL, VL) do { \
        if ((t) + 2 < NT) NA_LOAD(KL, VL, (t) + 2);            \
        const bool is_ctx = (t) >= hiw - lo; const int kr = lo + (t); \
        if (is_ctx || (kr >= my_r0 && kr < my_r0 + WH)) { \
            const char* Ks = lds + L_K + ((t) & 1) * 16384; \
            f32x16 p0 = {}, p1 = {}; \
            _Pragma("unroll") for (int d0 = 0; d0 < 4; ++d0) { const int cb = (d0 * 16 + hi * 8) * 2; \
                const bf16x8 b0 = *(const bf16x8*)(Ks + NKSWZ(r32, cb)), b1 = *(const bf16x8*)(Ks + NKSWZ(32 + r32, cb)); \
                p0 = __builtin_amdgcn_mfma_f32_32x32x16_bf16(b0, qr[d0], p0, 0, 0, 0); p1 = __builtin_amdgcn_mfma_f32_32x32x16_bf16(b1, qr[d0], p1, 0, 0, 0); } \
            if (is_ctx) { \
                _Pragma("unroll") for (int q = 0; q < 16; ++q) { p0[q] *= 0.125f; p1[q] *= 0.125f; } \
            } else { \
                const float* brow = rpb_l + (kr - r + 7) * 31 + 15 - qc; \
                _Pragma("unroll") for (int q = 0; q < 16; ++q) { const int kc0 = attn::crow(q, hi), kc1 = kc0 + 32; \
                    const bool v0 = kc0 >= my_c0 && kc0 < my_c0 + 16, v1 = kc1 >= my_c0 && kc1 < my_c0 + 16; \
                    p0[q] = v0 ? p0[q] * 0.125f + brow[v0 ? kc0 : qc] : -1e30f; p1[q] = v1 ? p1[q] * 0.125f + brow[v1 ? kc1 : qc] : -1e30f; } \
            } \
            float pmax = p0[0]; \
            _Pragma("unroll") for (int q = 1; q < 16; ++q) pmax = fmaxf(pmax, p0[q]); \
            _Pragma("unroll") for (int q = 0; q < 16; ++q) pmax = fmaxf(pmax, p1[q]); \
            { auto rr = __builtin_amdgcn_permlane32_swap(__float_as_uint(pmax), __float_as_uint(pmax), false, false); pmax = fmaxf(__uint_as_float(rr[0]), __uint_as_float(rr[1])); } \
            const float mn = fmaxf(m_reg, pmax), alpha = __builtin_amdgcn_exp2f((m_reg - mn) * L2E), mnl = -mn * L2E; m_reg = mn; \
            float ps = 0.f; \
            _Pragma("unroll") for (int q = 0; q < 16; ++q) { p0[q] = __builtin_amdgcn_exp2f(fmaf(p0[q], L2E, mnl)); p1[q] = __builtin_amdgcn_exp2f(fmaf(p1[q], L2E, mnl)); ps += p0[q] + p1[q]; } \
            { auto rr = __builtin_amdgcn_permlane32_swap(__float_as_uint(ps), __float_as_uint(ps), false, false); ps = __uint_as_float(rr[0]) + __uint_as_float(rr[1]); } \
            l_reg = l_reg * alpha + ps; \
            if (__any(alpha < 1.f)) { if (hi == 0) wsf[r32] = alpha; asm volatile("s_waitcnt lgkmcnt(0)" ::: "memory"); \
                _Pragma("unroll") for (int d = 0; d < 2; ++d) _Pragma("unroll") for (int q = 0; q < 16; ++q) o[d][q] *= wsf[attn::crow(q, hi)]; } \
            bf16x8 pa0, pa1, pa2, pa3; ret::pk4(p0, 0, pa0); ret::pk4(p0, 8, pa1); ret::pk4(p1, 0, pa2); ret::pk4(p1, 8, pa3); \
            __builtin_amdgcn_sched_barrier(0); \
            const int vb = vb0 + ((t) & 1) * 16384; \
            attn::pv_one<0>(o[0], vb, pa0, pa1, pa2, pa3); attn::pv_one<1>(o[1], vb, pa0, pa1, pa2, pa3); \
        } \
        if ((t) + 1 < NT) NA_WRITE(KW, VW, ((t) + 1) & 1);     \
        __syncthreads(); } while (0)
    for (int t = 0; t < NT; t += 2) {
        NA_TILE(t, kB, vB, kA, vA);
        if (t + 1 < NT) NA_TILE(t + 1, kA, vA, kB, vB);
    }
#undef NA_TILE
#undef NA_LOAD
#undef NA_WRITE
    if (hi == 0) wsf[32 + r32] = l_reg; asm volatile("s_waitcnt lgkmcnt(0)" ::: "memory");
    bf16_t* Ow = ws_br(p) + (size_t)(CTXN + r * 64 + (wave & 1) * 32) * 2048 + h * 64;
#pragma unroll
    for (int q = 0; q < 16; ++q) { const int orow = attn::crow(q, hi); const float rl = __builtin_amdgcn_rcpf(wsf[32 + orow]);
#pragma unroll
        for (int d0 = 0; d0 < 2; ++d0) Ow[(size_t)orow * 2048 + d0 * 32 + r32] = (bf16_t)(attn::cvtpk(o[d0][q] * rl, 0.f) & 0xffffu); }
    __syncthreads();
}
#undef NKSWZ
}

namespace el {
typedef float f32x4 __attribute__((ext_vector_type(4)));
typedef unsigned u32x2 __attribute__((ext_vector_type(2)));
__device__ __forceinline__ float wsum(float v) { return rw::wave_sum(v); }
__device__ __forceinline__ unsigned pk(float lo, float hi) { unsigned r; asm volatile("v_cvt_pk_bf16_f32 %0, %1, %2" : "=v"(r) : "v"(lo), "v"(hi)); return r; }

__device__ __forceinline__ void mod_phase(const Params& p, char* lds) {
    int tid_ = threadIdx.x; asm volatile("" : "+v"(tid_));
    const int tid = tid_, ks = tid >> 6, jl = tid & 63;
    float* sc = (float*)lds; float* red = sc + 2048;
    for (int b = blockIdx.x; b < 2 * 48; b += gridDim.x) {
        const int l = b / 48, j = (b % 48) * 64 + jl;
        __syncthreads();
        for (int k = tid; k < 2048; k += NTHR) { const float x = k < 1024 ? p.c[k] : p.c_ctx[k - 1024]; sc[k] = x / (1.0f + __expf(-x)); }
        __syncthreads();
        const float* w = p.w_mod + (size_t)l * DM * 3072 + (size_t)(ks * 128) * 3072 + j; float a0 = 0.f, a1 = 0.f;
#pragma unroll 8
        for (int k = 0; k < 128; ++k) { const float wv = w[(size_t)k * 3072]; a0 += sc[ks * 128 + k] * wv; a1 += sc[1024 + ks * 128 + k] * wv; }
        red[ks * 64 + jl] = a0; red[512 + ks * 64 + jl] = a1;
        __syncthreads();
        if (tid < 128) { const int s = tid >> 6; float t = 0.f;
#pragma unroll
            for (int q = 0; q < 8; ++q) t += red[s * 512 + q * 64 + jl];
            ws_modv(p)[(l * 2 + s) * 3072 + j] = t + p.b_mod[l * 3072 + j]; }
    }
    __syncthreads();
}

template <int LAYER> __device__ __forceinline__ void modnorm_store(const Params& p, const f32x4 (&v)[4], int row, int lane) {
    const float* mv = ws_modv(p) + (LAYER * 2 + (row < CTXN ? 1 : 0)) * 3072; const float* g = p.g_pre + LAYER * DM;
    float ss = 0.f;
#pragma unroll
    for (int j = 0; j < 4; ++j) ss += (v[j][0] * v[j][0] + v[j][1] * v[j][1]) + (v[j][2] * v[j][2] + v[j][3] * v[j][3]);
    const float rstd = 1.0f / sqrtf(wsum(ss) * (1.0f / DM) + NORM_EPS);
    bf16_t* o = ws_xn(p) + (size_t)row * DM;
#pragma unroll
    for (int j = 0; j < 4; ++j) { const int c = lane * 4 + 256 * j;
        const f32x4 gg = *(const f32x4*)(g + c), sh = *(const f32x4*)(mv + c), sc = *(const f32x4*)(mv + 1024 + c);
        const f32x4 y = v[j] * rstd * gg * (sc + 1.0f) + sh;
        u32x2 w; w.x = pk(y[0], y[1]); w.y = pk(y[2], y[3]); *(u32x2*)(o + c) = w; }
}
__device__ __forceinline__ void prenorm0_phase(const Params& p) {
    int tid_ = threadIdx.x; asm volatile("" : "+v"(tid_));
    const int lane = tid_ & 63, gw = (int)blockIdx.x * NWAVES + (tid_ >> 6), ngw = (int)gridDim.x * NWAVES;
    for (int row = gw; row < R; row += ngw) {
        const float* src = row < CTXN ? p.ctx + (size_t)row * DM : p.x + (size_t)(row - CTXN) * DM;
        f32x4 v[4];
#pragma unroll
        for (int j = 0; j < 4; ++j) v[j] = *(const f32x4*)(src + lane * 4 + 256 * j);
        modnorm_store<0>(p, v, row, lane);
    }
}
template <int LAYER> __device__ __forceinline__ void resid_phase(const Params& p) {
    int tid_ = threadIdx.x; asm volatile("" : "+v"(tid_));
    const int lane = tid_ & 63, gw = (int)blockIdx.x * NWAVES + (tid_ >> 6), ngw = (int)gridDim.x * NWAVES;
    for (int row = (LAYER == 0 ? 0 : CTXN) + gw; row < R; row += ngw) {
        const bool ctxsum = LAYER == 0 && row < CTXN;
        const float* y = ctxsum ? (const float*)(p.ws + WS_BIG + 72 * MiB) + (size_t)row * DM : ws_y(p) + (size_t)row * DM; const float* mv = ws_modv(p) + (LAYER * 2 + (row < CTXN ? 1 : 0)) * 3072 + 2048; const float* g = p.g_post + LAYER * DM;
        const float* src; float* dst;
        if (row < CTXN) { src = p.ctx + (size_t)row * DM; dst = ws_ctx1(p) + (size_t)row * DM; }
        else { src = (LAYER == 0 ? p.x : p.out) + (size_t)(row - CTXN) * DM; dst = p.out + (size_t)(row - CTXN) * DM; }
        f32x4 yv[4]; float ss = 0.f;
#pragma unroll
        for (int j = 0; j < 4; ++j) { yv[j] = *(const f32x4*)(y + lane * 4 + 256 * j);
            if (ctxsum) { _Pragma("unroll") for (int s = 1; s < 8; ++s) yv[j] += *(const f32x4*)(y + (size_t)s * CTXN * DM + lane * 4 + 256 * j); }
            ss += (yv[j][0] * yv[j][0] + yv[j][1] * yv[j][1]) + (yv[j][2] * yv[j][2] + yv[j][3] * yv[j][3]); }
        const float rstd = 1.0f / sqrtf(wsum(ss) * (1.0f / DM) + NORM_EPS);
        f32x4 xn[4];
#pragma unroll
        for (int j = 0; j < 4; ++j) { const int c = lane * 4 + 256 * j;
            xn[j] = *(const f32x4*)(src + c) + *(const f32x4*)(mv + c) * (yv[j] * rstd * *(const f32x4*)(g + c));
            *(f32x4*)(dst + c) = xn[j]; }
        if (LAYER == 0) modnorm_store<1>(p, xn, row, lane);
    }
}
__device__ __forceinline__ void ropenorm_phase(const Params& p) {
    int tid_ = threadIdx.x; asm volatile("" : "+v"(tid_));
    const int lane = tid_ & 63, gw = (int)blockIdx.x * NWAVES + (tid_ >> 6), ngw = (int)gridDim.x * NWAVES;
    const float* ct = ws_rope(p); const float* st = ct + N_ROPE;
    const float qn0 = p.q_norm[2 * lane], qn1 = p.q_norm[2 * lane + 1], kn0 = p.k_norm[2 * lane], kn1 = p.k_norm[2 * lane + 1];
    for (int row = gw; row < R; row += ngw) {
        const bool rot = row >= CTXN; const int t = row - CTXN; float cs = 1.f, sn = 0.f;
        if (rot) { const int pos = lane < 32 ? t / GW : t % GW, f = lane & 31; cs = ct[pos * 32 + f]; sn = st[pos * 32 + f]; }
        bf16_t* base = ws_big(p) + (size_t)row * P0W;
#pragma unroll
        for (int slot = 0; slot < 18; ++slot) {
            const int col = slot < 4 ? C_QA + slot * 128 : slot < 8 ? C_KA + (slot - 4) * 128 : slot < 16 ? C_QB + (slot - 8) * 128 : C_KB + (slot - 16) * 128;
            unsigned* ptr = (unsigned*)(base + col) + lane; const unsigned u = *ptr;
            float x1 = __uint_as_float(u << 16), x2 = __uint_as_float(u & 0xffff0000u);
            if (slot >= 4 && slot < 8) { x1 *= 0.08838834764831845f; x2 *= 0.08838834764831845f; }
            if (slot >= 8) { const float sc = 1.0f / sqrtf(wsum(x1 * x1 + x2 * x2) * (1.0f / 128.f) + NORM_EPS);
                x1 *= sc * (slot < 16 ? qn0 : kn0); x2 *= sc * (slot < 16 ? qn1 : kn1); }
            *ptr = pk(x1 * cs - x2 * sn, x1 * sn + x2 * cs);
        }
    }
}
}

constexpr int RING_BYTES = 131072, LDS_BYTES = 163840;
constexpr size_t WS_BAR = 256 * 1024;
constexpr size_t WS_SIDE = 255 * MiB;
constexpr size_t WS_YC = WS_BIG + 72 * MiB;
constexpr int LDS_BARW = LDS_BYTES - 64;
constexpr size_t WB_IN0 = WS_WB, WB_OUT0 = WB_IN0 + (size_t)EVEN_IN * DM * 2, WB_IN1 = WB_OUT0 + (size_t)DM * 2048 * 2, WB_OUT1 = WB_IN1 + (size_t)ODD_IN * DM * 2, WB_END = WB_OUT1 + (size_t)DM * 2048 * 2;
static_assert(WB_END <= WS_XN, "weight copies overflow their region");
static_assert(wy::WS_RING + wy::RING_TOTAL <= WB_IN1 && XCD_BAR_WORDS * 4 <= 16384 && wy::WS_WYF + (size_t)wy::WYF_WORDS * 4 <= WS_CTX1, "rwkv ring / flag words");

__device__ __forceinline__ unsigned pk2(float lo, float hi) { return (unsigned)f2bf(lo) | ((unsigned)f2bf(hi) << 16); }
__device__ __forceinline__ void transpose_item(const float* W, int K, int N, int ldw, bf16_t* WT, LAS float* scr, int item, int lane) {
    const int nblk = N / 32, kb = item / nblk, nb = item % nblk, k0 = 64 * kb, n0 = 32 * nb;
#pragma unroll 8
    for (int i = 0; i < 32; ++i) { const int kk = 2 * i + (lane >> 5); scr[kk * 33 + (lane & 31)] = W[(size_t)(k0 + kk) * ldw + n0 + (lane & 31)]; }
    asm volatile("s_waitcnt lgkmcnt(0)" ::: "memory");
    const int c = lane & 7;
#pragma unroll
    for (int j = 0; j < 4; ++j) { const int n = (lane >> 3) + 8 * j; const LAS float* s = scr + (8 * c) * 33 + n;
        v4u o; o.x = pk2(s[0 * 33], s[1 * 33]); o.y = pk2(s[2 * 33], s[3 * 33]); o.z = pk2(s[4 * 33], s[5 * 33]); o.w = pk2(s[6 * 33], s[7 * 33]);
        *(v4u*)(WT + (size_t)(n0 + n) * K + k0 + 8 * c) = o; }
    asm volatile("s_waitcnt lgkmcnt(0)" ::: "memory");
}
__device__ __forceinline__ void p0_weights(const Params& p, LAS unsigned char* lds) {
    const int lane = threadIdx.x & 63, wave = __builtin_amdgcn_readfirstlane(threadIdx.x >> 6);
    LAS float* scr = (LAS float*)(lds + wave * 16384);
    const int gw = blockIdx.x * NWAVES + wave, NGW = gridDim.x * NWAVES;
    constexpr int I_IN0 = (DM / 64) * (EVEN_IN / 32), I_OUT = (2048 / 64) * (DM / 32), I_IN1 = (DM / 64) * (ODD_IN / 32);
    for (int it = gw; it < I_IN0 + I_OUT + I_IN1 + I_OUT; it += NGW) {
        int r = it;
        if (r < I_IN0) { transpose_item(p.ev_w_in, DM, EVEN_IN, EVEN_IN, (bf16_t*)(p.ws + WB_IN0), scr, r, lane); continue; } r -= I_IN0;
        if (r < I_OUT) { transpose_item(p.ev_w_out, 2048, DM, DM, (bf16_t*)(p.ws + WB_OUT0), scr, r, lane); continue; } r -= I_OUT;
        if (r < I_IN1) { transpose_item(p.od_w_in, DM, ODD_IN, ODD_IN, (bf16_t*)(p.ws + WB_IN1), scr, r, lane); continue; } r -= I_IN1;
        transpose_item(p.od_w_out, 2048, DM, DM, (bf16_t*)(p.ws + WB_OUT1), scr, r, lane);
    }
}

template <class Epi> __device__ __forceinline__ void run_gemm(LAS unsigned char* lds, const bf16_t* A, const bf16_t* Bt, int M, int N, int K, const Epi& E, int rot = 0, int lda = 0, int ldb = 0) {
    const int G = (int)gridDim.x;
    pg8::Gemm g{A, Bt, M, N, K, lda, ldb}; pg8::StaticOrder S; S.init(M, N, G, ((int)blockIdx.x + rot) % G);
    pg8::gemm_phase<Epi, pg8::StaticOrder, true, true>(lds, g, S, E);
}
__device__ __forceinline__ int tail_rot(int units) { const int G = (int)gridDim.x; return (G - units % G) % G; }

#ifndef PROBE
#define PROBE 0
#endif
#define REP(bit) for (int rep_ = 0; rep_ < (((PROBE) >> (bit)) & 1) + 1; ++rep_)
__global__ void __launch_bounds__(NTHR, 2) mega(Params p) {
    extern __shared__ __attribute__((aligned(16))) unsigned char lds_raw[];
    cg::grid_group grid = cg::this_grid();
    LAS unsigned char* lds = (LAS unsigned char*)lds_raw;
    const long gsz = (long)gridDim.x * NTHR;
    if (threadIdx.x < 2) *(LAS unsigned*)(lds + LDS_BARW + 4 * threadIdx.x) = 0u;
    __syncthreads();
    const XcdBarrier xbar = xcd_barrier_post((unsigned*)(p.ws + WS_BAR), (volatile LAS unsigned*)(lds + LDS_BARW));
    const bf16_t* wt_in0 = (const bf16_t*)(p.ws + WB_IN0); const bf16_t* wt_out0 = (const bf16_t*)(p.ws + WB_OUT0);
    const bf16_t* wt_in1 = (const bf16_t*)(p.ws + WB_IN1); const bf16_t* wt_out1 = (const bf16_t*)(p.ws + WB_OUT1);
#define X(fn, n) { int t_ = threadIdx.x; asm volatile("" : "+v"(t_)); for (long g = (long)blockIdx.x * NTHR + t_; g < (long)(n); g += gsz) fn(p, g); }
#define SYNC xcd_barrier(xbar);
    if ((PROBE >> 13) & 1) { for (int i_ = 0; i_ < 20; ++i_) xcd_barrier(xbar); }
    REP(14) { el::mod_phase(p, (char*)lds_raw); X(ph_rope_table, N_ROPE) p0_weights(p, lds);
              if (p.out == nullptr) grid.sync();
              SYNC }
    REP(15) { el::prenorm0_phase(p); SYNC }
    REP(2) { run_gemm(lds, ws_xn(p), wt_in0, R, P0W, DM, pg8::EpiBf16<0>{ws_big(p), P0W, nullptr, 0, 0, 1.f});
             run_gemm(lds, ws_xn(p), wt_in0 + (size_t)C_GA * DM, CTXN, 2048, DM, pg8::EpiSiluBf16{(bf16_t*)(p.ws + WS_SIDE), 2048}, tail_rot((R / 256) * (P0W / 256)));
             SYNC }
    el::ropenorm_phase(p); SYNC
    REP(5) { for (int u = blockIdx.x; u < ret::NQ * 4; u += gridDim.x) { const int q = u < (ret::NQ - 2) * 4 ? 2 + u / 4 : (u - (ret::NQ - 2) * 4) / 4; ret::summaries_unit(p, q, u & 3, (char*)lds_raw); } SYNC }
    ret::state_scan(p); SYNC
    REP(6) { for (int u = blockIdx.x; u < ret::NQ * 4; u += gridDim.x) { const int q = u < (ret::NQ - 2) * 4 ? 2 + u / 4 : (u - (ret::NQ - 2) * 4) / 4; ret::output_unit(p, q, u & 3, (char*)lds_raw); } SYNC }
    REP(0) {
        const int G = (int)gridDim.x, vcu = (G % 8 == 0) ? ((int)blockIdx.x % 8) * (G / 8) + (int)blockIdx.x / 8 : (int)blockIdx.x;
        const int NLAT = (SEQ / 256) * 8, per = (NLAT + G - 1) / G;
        const bf16_t* P = ws_big(p); bf16_t* BR = ws_br(p);
        for (int i = 0; i <= per; ++i) {
            int head, row0, seq;
            if (i < per) { const int unit = vcu * per + i; if (unit >= NLAT) continue; const int nqb = SEQ / 256, kv = unit / (4 * nqb), rem = unit % (4 * nqb); head = kv * 4 + rem / nqb; row0 = CTXN + (rem % nqb) * 256; seq = R; }
            else { if (vcu >= 8) break; head = vcu; row0 = 0; seq = CTXN; }
            const int kv = head / 4;
            attn::attn_dense_body<attn::bf16>(P + (size_t)row0 * P0W + C_QB + head * 128, P + C_KB + kv * 128, P + C_VB + kv * 128, BR + (size_t)row0 * 2048 + 1024 + head * 128, seq, (char*)lds_raw);
            __syncthreads();
            if (row0 == 0) {
                int t_ = threadIdx.x; asm volatile("" : "+v"(t_)); const bf16_t* GC = (const bf16_t*)(p.ws + WS_SIDE);
                const size_t o = (size_t)(t_ >> 1) * 2048 + 1024 + head * 128 + (t_ & 1) * 64;
#pragma unroll
                for (int i = 0; i < 8; ++i) { v4u a = *(const v4u*)(BR + o + 8 * i); const v4u b = *(const v4u*)(GC + o + 8 * i);
#pragma unroll
                    for (int q = 0; q < 4; ++q) a[q] = attn::cvtpk(__uint_as_float(a[q] << 16) * __uint_as_float(b[q] << 16), __uint_as_float(a[q] & 0xffff0000u) * __uint_as_float(b[q] & 0xffff0000u));
                    *(v4u*)(BR + o + 8 * i) = a; }
                __syncthreads();
            }
        }
        if (PROBE & 1) xcd_barrier(xbar);
    }
    SYNC
    run_gemm(lds, ws_xn(p) + (size_t)CTXN * DM, wt_in0 + (size_t)C_GA * DM, SEQ, 2048, DM, pg8::EpiGateMul{ws_br(p) + (size_t)CTXN * 2048, 2048});
    {
        pg8::Gemm gk{ws_br(p), wt_out0, 8 * 256, DM, 256, 2048, 2048, 256 * 2}; pg8::StaticOrder S; S.init(8 * 256, DM, (int)gridDim.x, (int)blockIdx.x);
        pg8::gemm_phase<pg8::EpiF32, pg8::StaticOrder, true, true>(lds, gk, S, pg8::EpiF32{(float*)(p.ws + WS_YC), DM}); }
    SYNC
    REP(4) { run_gemm(lds, ws_br(p) + (size_t)CTXN * 2048, wt_out0, SEQ, DM, 2048, pg8::EpiF32{ws_y(p) + (size_t)CTXN * DM, DM}); SYNC }
    REP(15) { el::resid_phase<0>(p); SYNC }
    REP(3) { run_gemm(lds, ws_xn(p), wt_in1 + (size_t)O_RW * DM, R, ZW, DM, pg8::EpiBf16<0>{ws_big(p), ZW, nullptr, 0, 0, 1.f});
             run_gemm(lds, ws_xn(p), wt_in1 + (size_t)(O_NA + 1024) * DM, CTXN, 2048, DM, pg8::EpiBf16<0>{(bf16_t*)(p.ws + WS_SIDE), 2048, nullptr, 0, 0, 1.f}, tail_rot((R / 256) * (ZW / 256)));
             SYNC }
    rw::shift_halo(p); SYNC
    rw::shift_inplace(p); wy::zero_words(p); SYNC
#ifndef PSKIP
#define PSKIP 0
#endif
    if ((PROBE >> 16) & 1) { wy::phase<1, PSKIP>(p, lds); SYNC wy::zero_words(p); SYNC }
    if ((PROBE >> 17) & 1) { wy::phase<2>(p, lds); SYNC wy::zero_words(p); SYNC }
    if ((PROBE >> 18) & 1) { wy::phase<3>(p, lds); SYNC wy::zero_words(p); SYNC }
    if (gridDim.x >= 64) wy::phase<0>(p, lds);
    else { for (int b = blockIdx.x; b < 256; b += gridDim.x) rw::scan_block<0>(p, b, lds); }
    SYNC
    rw::finish_phase(p); SYNC
    REP(3) { run_gemm(lds, ws_xn(p) + (size_t)CTXN * DM, wt_in1 + (size_t)O_NA * DM, SEQ, NAW, DM, pg8::EpiBf16<0>{ws_big(p) + (size_t)CTXN * NAW, NAW, nullptr, 0, 0, 1.f}); SYNC }
    REP(7) { for (int u = blockIdx.x; u < (GROWS / 4) * 16; u += gridDim.x) na::na_unit(p, u >> 4, u & 15, (char*)lds_raw); SYNC }
    run_gemm(lds, ws_xn(p) + (size_t)CTXN * DM, wt_in1 + (size_t)O_GC * DM, SEQ, 2048, DM, pg8::EpiGateMul{ws_br(p) + (size_t)CTXN * 2048, 2048}); SYNC
    REP(4) { run_gemm(lds, ws_br(p) + (size_t)CTXN * 2048, wt_out1, SEQ, DM, 2048, pg8::EpiF32{ws_y(p) + (size_t)CTXN * DM, DM}); SYNC }
    el::resid_phase<1>(p);
#undef X
#undef SYNC
}

extern "C" void kernel_launch(void* const* d_in, const int* in_sizes, int n_in, void* d_out, int out_size, void* d_ws, size_t ws_size, hipStream_t stream) {
    static int grid_blocks = 0;
    if (!grid_blocks) {
        int dev = 0, cus = 0, per_cu = 0;
        (void)hipGetDevice(&dev); (void)hipDeviceGetAttribute(&cus, hipDeviceAttributeMultiprocessorCount, dev);
        (void)hipFuncSetAttribute((const void*)mega, hipFuncAttributeMaxDynamicSharedMemorySize, LDS_BYTES);
        (void)hipOccupancyMaxActiveBlocksPerMultiprocessor(&per_cu, mega, NTHR, LDS_BYTES);
        if (per_cu < 1) per_cu = 1;
        grid_blocks = cus * per_cu;
        if (ws_size < WS_END) fprintf(stderr, "kernel_launch: workspace too small: %zu < %zu\n", ws_size, (size_t)WS_END);
    }
    (void)hipMemsetAsync((char*)d_ws + WS_BAR, 0, XCD_BAR_WORDS * 4, stream);
    Params p = make_params(d_in, d_out, d_ws);
    void* args[] = {&p};
    hipError_t e = hipLaunchCooperativeKernel((void*)mega, dim3(grid_blocks), dim3(NTHR), args, LDS_BYTES, stream);
    if (e != hipSuccess) fprintf(stderr, "cooperative launch failed: %s (grid %d)\n", hipGetErrorString(e), grid_blocks);
}

#else
int main(int argc, char** argv) {
    const char* dir = argc > 1 ? argv[1] : "data";
    char path[512]; snprintf(path, 512, "%s/sizes.txt", dir); FILE* f = fopen(path, "r"); if (!f) { printf("no sizes\n"); return 1; }
    std::vector<long> sizes; long v; while (fscanf(f, "%ld", &v) == 1) sizes.push_back(v); fclose(f);
    if (sizes.size() != 31) { printf("bad n inputs %zu\n", sizes.size()); return 1; }
    snprintf(path, 512, "%s/inputs.bin", dir); f = fopen(path, "rb");
    std::vector<std::vector<float>> in(31); std::vector<void*> ptrs(31);
    for (int i = 0; i < 31; ++i) { in[i].resize(sizes[i]); if (fread(in[i].data(), 4, sizes[i], f) != (size_t)sizes[i]) { printf("short read\n"); return 1; } ptrs[i] = in[i].data(); }
    fclose(f);
    if (sizes[0] != (long)SEQ * DM) { printf("SEQ mismatch: build with -DSEQ_LEN=%ld\n", sizes[0] / DM); return 1; }
    std::vector<float> out((size_t)SEQ * DM, 0.f); std::vector<unsigned char> ws(WS_END, 0xAA);
    Params p = make_params(ptrs.data(), out.data(), ws.data());
    auto check = [&](const char* name, const float* got, size_t n) {
        snprintf(path, 512, "%s/%s", dir, name); FILE* g = fopen(path, "rb"); std::vector<float> ref(n); if (fread(ref.data(), 4, n, g) != n) printf("short ref\n"); fclose(g);
        double num = 0, den = 0, mx = 0; for (size_t i = 0; i < n; ++i) { const double d = (double)got[i] - ref[i]; num += d * d; den += (double)ref[i] * ref[i]; if (fabs(d) > mx) mx = fabs(d); }
        printf("%s: rvr=%.3e absmax=%.3e\n", name, num / den, mx); };
    static RwShared sh;
    int phase = 0;
#define X(fn, n) { printf("phase %d %s n=%ld\n", phase++, #fn, (long)(n)); fflush(stdout); _Pragma("omp parallel for schedule(dynamic, 64)") for (long g = 0; g < (long)(n); ++g) fn(p, g); }
#define SYNC
#define SCAN { printf("phase %d scan\n", phase++); fflush(stdout); _Pragma("omp parallel for schedule(dynamic, 1)") for (int b = 0; b < 32; ++b) { RwShared* s = new RwShared; rwkv_scan_block(p, b, *s); delete s; } }
    X(ph_mod, N_MOD) X(ph_rope_table, N_ROPE) X(ph_prenorm<0>, (long)R) X(ph_gemm_l0_qkv, (long)R * P0W) X(ph_ropenorm, N_ROPENORM) X(ph_ret_scan, N_RETSCAN)
    X(ph_ret_merge, N_RETMERGE) X(ph_gqa_attn, N_GQA) X(ph_gemm_l0_gate, (long)R * 2048) X(ph_gemm_l0_out, (long)R * DM) X(ph_resid<0>, (long)R)
    check("x0.bin", out.data(), out.size()); check("ctx0.bin", ws_ctx1(p), (size_t)CTXN * DM);
    X(ph_prenorm<1>, (long)R) X(ph_gemm_l1_rw, (long)R * ZW) SCAN X(ph_rwkv_finish, N_RWFIN) X(ph_gemm_l1_na, (long)R * NAW) X(ph_na, N_NA)
    X(ph_gemm_l1_gate, (long)SEQ * 2048) X(ph_gemm_l1_out, (long)SEQ * DM) X(ph_resid<1>, (long)SEQ)
    check("out.bin", out.data(), out.size());
    return 0;
}
#endif
```

```cpp
#ifdef CPU_EMU
#include <cstdio>
#include <cstdlib>
#include <cstring>
#include <cmath>
#include <vector>
#define DEV static inline
#else
#include <hip/hip_runtime.h>
#include <hip/hip_cooperative_groups.h>
#include <cstdio>
namespace cg = cooperative_groups;
#define DEV __device__ __forceinline__
#endif

#ifndef SEQ_LEN
#define SEQ_LEN 16384
#endif
typedef unsigned short bf16_t;
constexpr int DM = 1024, CTXN = 256, SEQ = SEQ_LEN, R = CTXN + SEQ, GW = 64, GROWS = SEQ / GW;
constexpr int EVEN_IN = 5632, ODD_IN = 8448;
constexpr int P0W = 3584;
constexpr int C_QA = 0, C_KA = 512, C_VA = 1024, C_QB = 2048, C_KB = 3072, C_VB = 3328, C_GA = 3584;
constexpr int ZW = 3328;
constexpr int O_NA = 0, O_RW = 3072, O_GC = 6400;
constexpr int NAW = 3072;
constexpr float NORM_EPS = 1e-6f, GN_EPS = 64e-5f;

constexpr size_t MiB = 1u << 20;
constexpr size_t WS_MODV = 0;
constexpr size_t WS_ROPE = 64 * 1024;
constexpr size_t WS_CTX1 = 1 * MiB;
constexpr size_t WS_WB = 2 * MiB;
constexpr size_t WS_XN = 42 * MiB;
constexpr size_t WS_BIG = WS_XN + (((size_t)R * DM * 2 + MiB - 1) / MiB) * MiB;
constexpr size_t WS_BR = WS_BIG + (((size_t)R * P0W * 2 + MiB - 1) / MiB) * MiB;
constexpr size_t WS_END = WS_BR + (size_t)R * 2048 * 2;
static_assert(SEQ != 16384 || WS_END <= 256 * MiB, "workspace map exceeds 256 MiB");

struct Params {
    const float *x, *c, *ctx, *c_ctx, *w_mod, *b_mod, *g_pre, *g_post, *ev_w_in, *ev_w_out, *dec_f, *dec_b, *q_norm, *k_norm;
    const float *od_w_in, *od_w_out, *rpb, *mu, *w0f, *w2f, *w0b, *w2b, *a0f, *a2f, *a0b, *a2b, *k_k, *k_a, *r_k, *lnx_g, *lnx_b;
    float* out; unsigned char* ws;
};

DEV bf16_t f2bf(float f) { unsigned u; __builtin_memcpy(&u, &f, 4); u = (u + 0x7fffu + ((u >> 16) & 1u)) >> 16; return (bf16_t)u; }
DEV float bf2f(bf16_t h) { unsigned u = ((unsigned)h) << 16; float f; __builtin_memcpy(&f, &u, 4); return f; }
DEV float siluf(float x) { return x / (1.0f + expf(-x)); }
DEV float sigmf(float x) { return 1.0f / (1.0f + expf(-x)); }
DEV float softplusf(float x) { return fmaxf(x, 0.f) + log1pf(expf(-fabsf(x))); }

DEV float* ws_modv(const Params& p) { return (float*)(p.ws + WS_MODV); }
DEV float* ws_rope(const Params& p) { return (float*)(p.ws + WS_ROPE); }
DEV float* ws_ctx1(const Params& p) { return (float*)(p.ws + WS_CTX1); }
DEV bf16_t* ws_xn(const Params& p) { return (bf16_t*)(p.ws + WS_XN); }
DEV bf16_t* ws_big(const Params& p) { return (bf16_t*)(p.ws + WS_BIG); }
DEV float* ws_y(const Params& p) { return (float*)(p.ws + WS_BIG); }
DEV bf16_t* ws_br(const Params& p) { return (bf16_t*)(p.ws + WS_BR); }

constexpr long N_MOD = 2 * 2 * 3072;
DEV void ph_mod(const Params& p, long gid) {
    const int j = (int)(gid % 3072), s = (int)((gid / 3072) % 2), l = (int)(gid / 6144);
    const float* cv = s ? p.c_ctx : p.c; const float* w = p.w_mod + (size_t)l * DM * 3072 + j;
    float acc = 0.f;
    for (int k = 0; k < DM; ++k) acc += siluf(cv[k]) * w[(size_t)k * 3072];
    ws_modv(p)[gid] = acc + p.b_mod[l * 3072 + j];
}
constexpr long N_ROPE = 256 * 32;
DEV void ph_rope_table(const Params& p, long gid) {
    const int f = (int)(gid % 32), pos = (int)(gid / 32);
    const float inv = powf(10000.0f, -(float)f / 32.0f); const float ang = (float)pos * inv;
    ws_rope(p)[gid] = cosf(ang); ws_rope(p)[N_ROPE + gid] = sinf(ang);
}
template <int LAYER> DEV void ph_prenorm(const Params& p, long gid) {
    const int row = (int)gid; const int s = row < CTXN ? 1 : 0;
    const float* src = row < CTXN ? ((LAYER == 0 ? p.ctx : ws_ctx1(p)) + (size_t)row * DM) : ((LAYER == 0 ? p.x : p.out) + (size_t)(row - CTXN) * DM);
    const float* mv = ws_modv(p) + (LAYER * 2 + s) * 3072; const float* g = p.g_pre + LAYER * DM;
    float ss = 0.f;
    for (int k = 0; k < DM; ++k) ss += src[k] * src[k];
    const float rstd = 1.0f / sqrtf(ss / DM + NORM_EPS);
    bf16_t* o = ws_xn(p) + (size_t)row * DM;
    for (int k = 0; k < DM; ++k) o[k] = f2bf(src[k] * rstd * g[k] * (1.0f + mv[1024 + k]) + mv[k]);
}
template <int MODE> DEV void gemm_item(const bf16_t* A, int K, const float* W, int ldw, void* out, int pitch, int row, int col) {
    const bf16_t* a = A + (size_t)row * K; const float* w = W + col; float acc = 0.f;
    for (int k = 0; k < K; ++k) acc += bf2f(a[k]) * w[(size_t)k * ldw];
    if (MODE == 0) ((bf16_t*)out)[(size_t)row * pitch + col] = f2bf(acc);
    else if (MODE == 1) { bf16_t* o = (bf16_t*)out + (size_t)row * pitch + col; *o = f2bf(siluf(acc) * bf2f(*o)); }
    else ((float*)out)[(size_t)row * pitch + col] = acc;
}
DEV void ph_gemm_l0_qkv(const Params& p, long gid) { gemm_item<0>(ws_xn(p), DM, p.ev_w_in, EVEN_IN, ws_big(p), P0W, (int)(gid / P0W), (int)(gid % P0W)); }
DEV void ph_gemm_l0_gate(const Params& p, long gid) { gemm_item<1>(ws_xn(p), DM, p.ev_w_in + C_GA, EVEN_IN, ws_br(p), 2048, (int)(gid / 2048), (int)(gid % 2048)); }
DEV void ph_gemm_l0_out(const Params& p, long gid) { gemm_item<2>(ws_br(p), 2048, p.ev_w_out, DM, ws_y(p), DM, (int)(gid / DM), (int)(gid % DM)); }
DEV void ph_gemm_l1_rw(const Params& p, long gid) { gemm_item<0>(ws_xn(p), DM, p.od_w_in + O_RW, ODD_IN, ws_big(p), ZW, (int)(gid / ZW), (int)(gid % ZW)); }
DEV void ph_gemm_l1_na(const Params& p, long gid) { gemm_item<0>(ws_xn(p), DM, p.od_w_in + O_NA, ODD_IN, ws_big(p), NAW, (int)(gid / NAW), (int)(gid % NAW)); }
DEV void ph_gemm_l1_gate(const Params& p, long gid) { gemm_item<1>(ws_xn(p), DM, p.od_w_in + O_GC, ODD_IN, ws_br(p), 2048, CTXN + (int)(gid / 2048), (int)(gid % 2048)); }
DEV void ph_gemm_l1_out(const Params& p, long gid) { gemm_item<2>(ws_br(p), 2048, p.od_w_out, DM, ws_y(p), DM, CTXN + (int)(gid / DM), (int)(gid % DM)); }

constexpr long N_ROPENORM = (long)R * 18;
DEV void ph_ropenorm(const Params& p, long gid) {
    const int slot = (int)(gid % 18), row = (int)(gid / 18);
    int col; const float* nw = nullptr; float sc = 1.f;
    if (slot < 4) col = C_QA + slot * 128; else if (slot < 8) { col = C_KA + (slot - 4) * 128; sc = 0.08838834764831845f; }
    else if (slot < 16) { col = C_QB + (slot - 8) * 128; nw = p.q_norm; } else { col = C_KB + (slot - 16) * 128; nw = p.k_norm; }
    bf16_t* v = ws_big(p) + (size_t)row * P0W + col;
    if (nw) { float ss = 0.f; for (int d = 0; d < 128; ++d) { const float t = bf2f(v[d]); ss += t * t; } sc = 1.0f / sqrtf(ss / 128.f + NORM_EPS); }
    const bool rot = row >= CTXN; const int t = row - CTXN; const int gr = rot ? t / GW : 0, gc = rot ? t % GW : 0;
    const float* ct = ws_rope(p); const float* st = ct + N_ROPE;
    for (int i = 0; i < 64; ++i) {
        float x1 = bf2f(v[2 * i]) * sc, x2 = bf2f(v[2 * i + 1]) * sc;
        if (nw) { x1 *= nw[2 * i]; x2 *= nw[2 * i + 1]; }
        if (rot) { const int pos = i < 32 ? gr : gc, f = i & 31; const float cs = ct[pos * 32 + f], sn = st[pos * 32 + f]; const float y1 = x1 * cs - x2 * sn, y2 = x1 * sn + x2 * cs; x1 = y1; x2 = y2; }
        v[2 * i] = f2bf(x1); v[2 * i + 1] = f2bf(x2);
    }
}
constexpr long N_RETSCAN = 2 * 4 * 256;
DEV void ph_ret_scan(const Params& p, long gid) {
    const int e = (int)(gid % 256), h = (int)((gid / 256) % 4), dir = (int)(gid / 1024);
    const float g = sigmf((dir ? p.dec_b : p.dec_f)[h]);
    float S[128];
#pragma unroll
    for (int d = 0; d < 128; ++d) S[d] = 0.f;
    const bf16_t* P = ws_big(p); bf16_t* BR = ws_br(p);
    for (int pos = 0; pos < R; ++pos) {
        int row; if (pos < CTXN) row = dir ? CTXN - 1 - pos : pos; else { const int t = pos - CTXN; row = CTXN + (dir ? SEQ - 1 - t : t); }
        const bf16_t* pr = P + (size_t)row * P0W; const float v = bf2f(pr[C_VA + h * 256 + e]);
        const bf16_t* kq = pr + C_KA + h * 128; const bf16_t* qq = pr + C_QA + h * 128; float y = 0.f;
#pragma unroll
        for (int d = 0; d < 128; ++d) { S[d] = g * S[d] + bf2f(kq[d]) * v; y += bf2f(qq[d]) * S[d]; }
        BR[(size_t)row * 2048 + dir * 1024 + h * 256 + e] = f2bf(y);
    }
}
constexpr long N_RETMERGE = (long)R * 4;
DEV void ph_ret_merge(const Params& p, long gid) {
    const int h = (int)(gid % 4), row = (int)(gid / 4);
    bf16_t* b = ws_br(p) + (size_t)row * 2048 + h * 256;
    float s = 0.f; for (int e = 0; e < 256; ++e) s += bf2f(b[e]) + bf2f(b[1024 + e]);
    const float mean = s / 256.f; float q = 0.f;
    for (int e = 0; e < 256; ++e) { const float d = bf2f(b[e]) + bf2f(b[1024 + e]) - mean; q += d * d; }
    const float rstd = 1.0f / sqrtf(q / 256.f + NORM_EPS);
    for (int e = 0; e < 256; ++e) b[e] = f2bf((bf2f(b[e]) + bf2f(b[1024 + e]) - mean) * rstd);
}
constexpr long N_GQA = (long)R * 8 * 8;
DEV void ph_gqa_attn(const Params& p, long gid) {
    const int sl = (int)(gid % 8), row = (int)((gid / 8) % R), head = (int)(gid / (8L * R)), g = head / 4;
    const bf16_t* P = ws_big(p); const int nk = row < CTXN ? CTXN : R;
    float q[128];
    { const bf16_t* qp = P + (size_t)row * P0W + C_QB + head * 128;
#pragma unroll
      for (int d = 0; d < 128; ++d) q[d] = bf2f(qp[d]) * 0.08838834764831845f; }
    float acc[16];
#pragma unroll
    for (int i = 0; i < 16; ++i) acc[i] = 0.f;
    float m = -1e30f, l = 0.f;
    for (int j = 0; j < nk; ++j) {
        const bf16_t* kp = P + (size_t)j * P0W + C_KB + g * 128; float s = 0.f;
#pragma unroll
        for (int d = 0; d < 128; ++d) s += q[d] * bf2f(kp[d]);
        const float mn = fmaxf(m, s), al = expf(m - mn), pe = expf(s - mn);
        const bf16_t* vp = P + (size_t)j * P0W + C_VB + g * 128 + sl * 16;
        l = l * al + pe;
#pragma unroll
        for (int i = 0; i < 16; ++i) acc[i] = acc[i] * al + pe * bf2f(vp[i]);
        m = mn;
    }
    bf16_t* o = ws_br(p) + (size_t)row * 2048 + 1024 + head * 128 + sl * 16; const float il = 1.0f / l;
#pragma unroll
    for (int i = 0; i < 16; ++i) o[i] = f2bf(acc[i] * il);
}
template <int LAYER> DEV void ph_resid(const Params& p, long gid) {
    const int row = LAYER == 0 ? (int)gid : CTXN + (int)gid; const int s = row < CTXN ? 1 : 0;
    const float* y = ws_y(p) + (size_t)row * DM; const float* mv = ws_modv(p) + (LAYER * 2 + s) * 3072 + 2048; const float* g = p.g_post + LAYER * DM;
    float ss = 0.f; for (int k = 0; k < DM; ++k) ss += y[k] * y[k];
    const float rstd = 1.0f / sqrtf(ss / DM + NORM_EPS);
    const float* src; float* dst;
    if (row < CTXN) { src = p.ctx + (size_t)row * DM; dst = ws_ctx1(p) + (size_t)row * DM; }
    else { src = (LAYER == 0 ? p.x : p.out) + (size_t)(row - CTXN) * DM; dst = p.out + (size_t)(row - CTXN) * DM; }
    for (int k = 0; k < DM; ++k) dst[k] = src[k] + mv[k] * (y[k] * rstd * g[k]);
}
DEV float zshift(const bf16_t* Z, const float* mu, int row, int col) {
    const int lo = row < CTXN ? 0 : CTXN, hi = row < CTXN ? CTXN : R;
    const float z = bf2f(Z[(size_t)row * ZW + col]);
    const float pv = row > lo ? bf2f(Z[(size_t)(row - 1) * ZW + col]) : 0.f, nx = row + 1 < hi ? bf2f(Z[(size_t)(row + 1) * ZW + col]) : 0.f;
    return z + (0.5f * (pv + nx) - z) * mu[col];
}
constexpr long N_RWFIN = (long)SEQ * 16;
DEV void ph_rwkv_finish(const Params& p, long gid) {
    const int h = (int)(gid % 16), t = (int)(gid / 16), row = CTXN + t;
    const bf16_t* Z = ws_big(p); bf16_t* b = ws_br(p) + (size_t)row * 2048;
    float bon[2];
    for (int d = 0; d < 2; ++d) {
        const float* a0 = d ? p.a0b : p.a0f; const float* a2 = d ? p.a2b : p.a2f;
        float s = 0.f;
        for (int j = 0; j < 64; ++j) { const int hj = h * 64 + j; float acc = a0[hj];
            for (int m = 0; m < 64; ++m) acc += zshift(Z, p.mu, row, 3200 + d * 64 + m) * a2[m * 1024 + hj];
            const float al = sigmf(acc); const float r = zshift(Z, p.mu, row, hj), k = zshift(Z, p.mu, row, 1024 + hj);
            s += r * (k * (1.0f + (al - 1.0f) * p.k_a[hj])) * p.r_k[hj]; }
        bon[d] = s;
    }
    float sm = 0.f; for (int i = 0; i < 64; ++i) sm += bf2f(b[h * 64 + i]) + bf2f(b[1024 + h * 64 + i]);
    const float mean = sm / 64.f; float q = 0.f;
    for (int i = 0; i < 64; ++i) { const float d = bf2f(b[h * 64 + i]) + bf2f(b[1024 + h * 64 + i]) - mean; q += d * d; }
    const float rstd = 1.0f / sqrtf(q / 64.f + GN_EPS);
    for (int i = 0; i < 64; ++i) { const int hi = h * 64 + i; const float w = bf2f(b[hi]) + bf2f(b[1024 + hi]);
        const float v = zshift(Z, p.mu, row, 2048 + hi);
        b[1024 + hi] = f2bf((w - mean) * rstd * p.lnx_g[hi] + p.lnx_b[hi] + (bon[0] + bon[1]) * v); }
}
constexpr long N_NA = (long)SEQ * 16;
DEV void ph_na(const Params& p, long gid) {
    const int h = (int)(gid % 16), t = (int)(gid / 16), r = t / GW, c = t % GW;
    const bf16_t* P = ws_big(p);
    float q[64];
    { const bf16_t* qp = P + (size_t)(CTXN + t) * NAW + h * 64;
#pragma unroll
      for (int d = 0; d < 64; ++d) q[d] = bf2f(qp[d]) * 0.125f; }
    float acc[64];
#pragma unroll
    for (int d = 0; d < 64; ++d) acc[d] = 0.f;
    float m = -1e30f, l = 0.f;
    const int wh = GROWS < 8 ? GROWS : 8;
    int r0 = r - wh / 2; r0 = r0 < 0 ? 0 : (r0 > GROWS - wh ? GROWS - wh : r0);
    int c0 = c - 8; c0 = c0 < 0 ? 0 : (c0 > GW - 16 ? GW - 16 : c0);
    const float* rp = p.rpb + h * 15 * 31;
    for (int kk = 0; kk < wh * 16 + CTXN; ++kk) {
        int krow; float bias = 0.f;
        if (kk < wh * 16) { const int i = kk / 16, j = kk % 16; krow = CTXN + (r0 + i) * GW + c0 + j; bias = rp[(r0 + i - r + 7) * 31 + (c0 + j - c + 15)]; }
        else krow = kk - wh * 16;
        const bf16_t* kp = P + (size_t)krow * NAW + 1024 + h * 64; float s = bias;
#pragma unroll
        for (int d = 0; d < 64; ++d) s += q[d] * bf2f(kp[d]);
        const float mn = fmaxf(m, s), al = expf(m - mn), pe = expf(s - mn);
        const bf16_t* vp = P + (size_t)krow * NAW + 2048 + h * 64;
        l = l * al + pe;
#pragma unroll
        for (int d = 0; d < 64; ++d) acc[d] = acc[d] * al + pe * bf2f(vp[d]);
        m = mn;
    }
    bf16_t* o = ws_br(p) + (size_t)(CTXN + t) * 2048 + h * 64; const float il = 1.0f / l;
#pragma unroll
    for (int d = 0; d < 64; ++d) o[d] = f2bf(acc[d] * il);
}

constexpr int RW_CH = 16;
struct RwShared { float r[RW_CH][64], w[RW_CH][64], kd[RW_CH][64], v[RW_CH][64], a[RW_CH][64], b[RW_CH][64], tz[RW_CH][64], za[RW_CH][64], kk[RW_CH][64]; };
#ifdef CPU_EMU
#define FOR_THREADS(tid) for (int tid = 0; tid < 64; ++tid)
#define BLOCK_SYNC()
#define TSTATE(tid) S_all[tid]
#else
#define FOR_THREADS(tid) const int tid = threadIdx.x; if (tid < 64)
#define BLOCK_SYNC() __syncthreads()
#define TSTATE(tid) S_reg
#endif
DEV int rw_row(int dir, int pos) { if (pos < CTXN) return dir ? CTXN - 1 - pos : pos; const int t = pos - CTXN; return CTXN + (dir ? SEQ - 1 - t : t); }
#ifdef CPU_EMU
static void rwkv_scan_block(const Params& p, int blk, RwShared& sh) {
    static thread_local float S_all[64][64];
    for (int i = 0; i < 64; ++i) for (int j = 0; j < 64; ++j) S_all[i][j] = 0.f;
#else
__device__ void rwkv_scan_block(const Params& p, int blk, RwShared& sh) {
    float S_reg[64];
#pragma unroll
    for (int j = 0; j < 64; ++j) S_reg[j] = 0.f;
#endif
    const int dir = blk / 16, h = blk % 16;
    const float* w0 = dir ? p.w0b : p.w0f; const float* w2 = dir ? p.w2b : p.w2f; const float* a0 = dir ? p.a0b : p.a0f; const float* a2 = dir ? p.a2b : p.a2f;
    const bf16_t* Z = ws_big(p); bf16_t* BR = ws_br(p);
    for (int p0 = 0; p0 < R; p0 += RW_CH) {
        { FOR_THREADS(tid) { const int hj = h * 64 + tid;
            for (int tt = 0; tt < RW_CH; ++tt) { const int row = rw_row(dir, p0 + tt);
                sh.tz[tt][tid] = tanhf(zshift(Z, p.mu, row, 3072 + dir * 64 + tid)); sh.za[tt][tid] = zshift(Z, p.mu, row, 3200 + dir * 64 + tid);
                sh.r[tt][tid] = zshift(Z, p.mu, row, hj); sh.v[tt][tid] = zshift(Z, p.mu, row, 2048 + hj);
                const float k = zshift(Z, p.mu, row, 1024 + hj); sh.kd[tt][tid] = k; sh.kk[tt][tid] = k * p.k_k[hj]; } } }
        BLOCK_SYNC();
        { FOR_THREADS(tid) { const int hj = h * 64 + tid;
            for (int tt = 0; tt < RW_CH; ++tt) { float aw = w0[hj], aa = a0[hj], nn = 0.f;
                for (int m = 0; m < 64; ++m) { aw += sh.tz[tt][m] * w2[m * 1024 + hj]; aa += sh.za[tt][m] * a2[m * 1024 + hj]; nn += sh.kk[tt][m] * sh.kk[tt][m]; }
                const float lw = -softplusf(-aw) - 0.5f; const float al = sigmf(aa);
                const float kkn = sh.kk[tt][tid] / fmaxf(sqrtf(nn), 1e-12f);
                sh.w[tt][tid] = expf(-expf(lw)); sh.a[tt][tid] = -kkn; sh.b[tt][tid] = kkn * al;
                sh.kd[tt][tid] = sh.kd[tt][tid] * (1.0f + (al - 1.0f) * p.k_a[hj]); } } }
        BLOCK_SYNC();
        { FOR_THREADS(tid) { float* S = TSTATE(tid);
            for (int tt = 0; tt < RW_CH; ++tt) { float sa = 0.f;
#pragma unroll
                for (int j = 0; j < 64; ++j) sa += S[j] * sh.a[tt][j];
                const float vi = sh.v[tt][tid]; float y = 0.f;
#pragma unroll
                for (int j = 0; j < 64; ++j) { S[j] = S[j] * sh.w[tt][j] + sa * sh.b[tt][j] + vi * sh.kd[tt][j]; y += S[j] * sh.r[tt][j]; }
                if (p0 >= CTXN) BR[(size_t)rw_row(dir, p0 + tt) * 2048 + dir * 1024 + h * 64 + tid] = f2bf(y); } } }
        BLOCK_SYNC();
    }
}

static Params make_params(void* const* d_in, void* d_out, void* d_ws) {
    Params p{};
    const float** f = (const float**)&p;
    for (int i = 0; i < 31; ++i) f[i] = (const float*)d_in[i];
    p.out = (float*)d_out; p.ws = (unsigned char*)d_ws; return p;
}


#ifndef CPU_EMU
#define LAS __attribute__((address_space(3)))
#define GAS __attribute__((address_space(1)))
typedef unsigned v4u __attribute__((ext_vector_type(4)));
constexpr int NWAVES = 8, NTHR = NWAVES * 64;
#ifndef PROBE
#define PROBE 0
#endif
#define XB_TMO      128
#define XB_XCNT(j)  (256  + 64 * (j))
#define XB_XSUB(j)  (1280 + 64 * (j))
#define XB_XGEN(j)  (2304 + 64 * (j))
#define XB_TOP      3328
#define XB_TOPGEN   3392
#define XCD_BAR_WORDS 3456
#define XB_SPIN_CAP (1u << 18)

__device__ __forceinline__ unsigned xb_ld(unsigned* p)              { return __hip_atomic_load(p, __ATOMIC_RELAXED, __HIP_MEMORY_SCOPE_AGENT); }
__device__ __forceinline__ unsigned xb_add(unsigned* p, unsigned v) { return __hip_atomic_fetch_add(p, v, __ATOMIC_RELAXED, __HIP_MEMORY_SCOPE_AGENT); }
__device__ __forceinline__ unsigned xb_xcc_id() { return (unsigned)__builtin_amdgcn_s_getreg((3 << 11) | 20) & 0xFu; }
#define XB_SPIN(cond, bar) do { unsigned _sp = 0; while (cond) { __builtin_amdgcn_s_sleep(1); \
    if ((++_sp & 255u) == 0u) { if (xb_ld(&(bar)[XB_TMO])) break; if (_sp > XB_SPIN_CAP) { atomicAdd(&(bar)[XB_TMO], 1u); break; } } } } while (0)

struct XcdBarrier {
    unsigned* bar; unsigned x;
    volatile LAS unsigned* st;
};

__device__ __forceinline__ XcdBarrier xcd_barrier_post(unsigned* bar, volatile LAS unsigned* st) {
    XcdBarrier b; b.bar = bar; b.x = xb_xcc_id(); b.st = st;
    if (threadIdx.x == 0) (void)xb_add(&bar[XB_XCNT(b.x)], 1u);
    return b;
}
__device__ __forceinline__ void xcd_barrier_complete(unsigned* bar, unsigned x, unsigned& nloc, unsigned& nx) {
    const unsigned G = gridDim.x * gridDim.y * gridDim.z;
    unsigned sum, cnt, mine, sp = 0u;
    for (;;) {
        sum = 0u; cnt = 0u; mine = 0u;
#pragma unroll
        for (unsigned j = 0; j < 16; ++j) { const unsigned c = xb_ld(&bar[XB_XCNT(j)]); sum += c; cnt += (c > 0u) ? 1u : 0u; mine = (j == x) ? c : mine; }
        if (sum == G) break;
        __builtin_amdgcn_s_sleep(1);
        if ((++sp & 255u) == 0u) { if (xb_ld(&bar[XB_TMO])) break; if (sp > XB_SPIN_CAP) { atomicAdd(&bar[XB_TMO], 1u); break; } }
    }
    nloc = mine > 0u ? mine : 1u; nx = cnt > 0u ? cnt : 1u;
}

__device__ __forceinline__ void xcd_barrier(const XcdBarrier& b) {
    asm volatile("s_waitcnt vmcnt(0)" ::: "memory");
    __syncthreads();
    if (threadIdx.x == 0) {
        unsigned* bar = b.bar;
        __builtin_amdgcn_s_waitcnt(0);
        unsigned nloc = b.st[0], nx = b.st[1];
        if (nloc == 0u) { xcd_barrier_complete(bar, b.x, nloc, nx); b.st[0] = nloc; b.st[1] = nx; }
        const unsigned old = xb_add(&bar[XB_XSUB(b.x)], 1u);
        const unsigned gen = old / nloc;
        if (old + 1u == (gen + 1u) * nloc) {
            __builtin_amdgcn_fence(__ATOMIC_RELEASE, "agent");
            asm volatile("s_waitcnt vmcnt(0)" ::: "memory");
            const unsigned og = xb_add(&bar[XB_TOP], 1u);
            const unsigned tg = og / nx;
            if (og + 1u == (tg + 1u) * nx) xb_add(&bar[XB_TOPGEN], 1u);
            else XB_SPIN(xb_ld(&bar[XB_TOPGEN]) == tg, bar);
            __builtin_amdgcn_fence(__ATOMIC_ACQUIRE, "agent");
            xb_add(&bar[XB_XGEN(b.x)], 1u);
            asm volatile("s_waitcnt vmcnt(0)" ::: "memory");
        } else {
            XB_SPIN(xb_ld(&bar[XB_XGEN(b.x)]) == gen, bar);
            __builtin_amdgcn_fence(__ATOMIC_ACQUIRE, "agent");
            asm volatile("s_waitcnt vmcnt(0)" ::: "memory");
        }
    }
    __syncthreads();
}
namespace pg8 {
#define PG8_LAS __attribute__((address_space(3)))
typedef unsigned short bf16_t;
typedef short bf16x8 __attribute__((ext_vector_type(8)));
typedef float f32x4 __attribute__((ext_vector_type(4)));
typedef unsigned u32x4 __attribute__((ext_vector_type(4)));
constexpr int BM = 256, BK = 64, HALF = 128, HTB = HALF * BK * 2  , STAGE_BYTES = 8 * HTB, NXCD = 8, WGM = 8;

__host__ __device__ __forceinline__ int lds_byte(int r, int c) { const int st = (r >> 4) * 2 + (c >> 5), rr = r & 15, cc = c & 31, ob = rr * 64 + cc * 2; return st * 1024 + (ob ^ (((ob >> 9) & 1) << 5)); }
__host__ __device__ __forceinline__ void stage_rc(int b, int& R, int& C) { const int st = b / 1024, sb = b % 1024, swz = sb ^ (((sb >> 9) & 1) << 5); R = (st >> 1) * 16 + swz / 64; C = (st & 1) * 32 + (swz % 64) / 2; }
__host__ __device__ __forceinline__ int perm32(int rho) { const int n = rho >> 4, i = rho & 15; return 8 * (i >> 2) + 4 * n + (i & 3); }

struct Unit { int pm, pn; };
struct Gemm { const bf16_t* A; const bf16_t* Bt; int M, N, K; int lda = 0, ldb = 0; int ksl = 0; };

struct StaticOrder {
    int nM, nN, nwg, G, c;
    __host__ __device__ void init(int M, int N, int G_, int c_) { nM = M / BM; nN = N / BM; nwg = nM * nN; G = G_; c = c_; }
    __host__ __device__ bool next(int i, Unit& u) const {
        const long L = (long)i * G + c; if (L >= nwg) return false;
        int wgid = (int)L; { const int q = nwg / NXCD, r = nwg % NXCD, xcd = wgid % NXCD, off = wgid / NXCD; wgid = (xcd < r ? xcd * (q + 1) : r * (q + 1) + (xcd - r) * q) + off; }
        const int nig = WGM * nN, gid = wgid / nig, fm = gid * WGM, gsz = (nM - fm) < WGM ? (nM - fm) : WGM;
        u.pm = fm + ((wgid % nig) % gsz); u.pn = (wgid % nig) / gsz; return true;
    }
    __device__ __forceinline__ void a_ready(const Unit&) const {}
    __device__ __forceinline__ void done(const Unit&) const {}
};

__device__ __forceinline__ unsigned cvt_pk_bf16(float lo, float hi) { unsigned r; asm volatile("v_cvt_pk_bf16_f32 %0, %1, %2" : "=v"(r) : "v"(lo), "v"(hi)); return r; }
typedef float f32x2 __attribute__((ext_vector_type(2)));
__device__ __forceinline__ f32x2 gelu_pk(f32x2 v) {
    const f32x2 av = __builtin_elementwise_abs(v), d = av * 0.2316418882f + 1.0f;
    f32x2 t; t.x = __builtin_amdgcn_rcpf(d.x); t.y = __builtin_amdgcn_rcpf(d.y);
    f32x2 q = t * 0.5307027145f + (-0.7265760135f); q = q * t + 0.7107068705f; q = q * t + (-0.142248368f); q = q * t + 0.127414796f; q = q * t;
    const f32x2 s = (v * v) * (-0.72134752044f);
    f32x2 e; e.x = __builtin_amdgcn_exp2f(s.x); e.y = __builtin_amdgcn_exp2f(s.y);
    const f32x2 m = v * (q * e), r = v - m;
    f32x2 o; o.x = v.x < 0.f ? m.x : r.x; o.y = v.y < 0.f ? m.y : r.y; return o;
}

template <int ACT  > struct EpiBf16 {
    static constexpr bool PERM = true, AFTER_DRAIN = false; static_assert(ACT == 0 || ACT == 1, "EpiBf16: ACT is 0 (none) or 1 (gelu_pk)");
    bf16_t* O; int ldc; const float* bias; int split_cols; size_t split_stride; float scale0;
    __device__ __forceinline__ void operator()(const f32x4 (&acc)[2][2][4][2], const Unit& u, int wr, int wc, int fr, int fq) const {
        const int row0 = u.pm * BM + wr * 64 + fr; int colt = u.pn * BM; bf16_t* base = O;
        float sc = 1.f; if (split_cols) { const int t = colt / split_cols; base += (size_t)t * split_stride; colt -= t * split_cols; if (t == 0) sc = scale0; }
        const int col0 = colt + wc * 32 + 8 * fq, bcol0 = u.pn * BM + wc * 32 + 8 * fq;
        f32x4 bv[2][2];
#pragma unroll
        for (int bj = 0; bj < 2; ++bj)
#pragma unroll
            for (int n = 0; n < 2; ++n) bv[bj][n] = bias ? *(const f32x4*)(bias + bcol0 + bj * HALF + 4 * n) : (f32x4){0.f, 0.f, 0.f, 0.f};
#pragma unroll
        for (int ai = 0; ai < 2; ++ai)
#pragma unroll
            for (int m = 0; m < 4; ++m) { bf16_t* rowp = base + (size_t)(row0 + ai * HALF + m * 16) * ldc + col0;
#pragma unroll
                for (int bj = 0; bj < 2; ++bj) { f32x4 v0 = acc[ai][bj][m][0] + bv[bj][0], v1 = acc[ai][bj][m][1] + bv[bj][1];
                    if (ACT == 1) { f32x2 a = gelu_pk((f32x2){v0[0], v0[1]}), b = gelu_pk((f32x2){v0[2], v0[3]}), c = gelu_pk((f32x2){v1[0], v1[1]}), d = gelu_pk((f32x2){v1[2], v1[3]});
                        v0 = (f32x4){a.x, a.y, b.x, b.y}; v1 = (f32x4){c.x, c.y, d.x, d.y}; }
                    v0 = v0 * sc; v1 = v1 * sc; u32x4 w; w.x = cvt_pk_bf16(v0[0], v0[1]); w.y = cvt_pk_bf16(v0[2], v0[3]); w.z = cvt_pk_bf16(v1[0], v1[1]); w.w = cvt_pk_bf16(v1[2], v1[3]);
                    *(u32x4*)(rowp + bj * HALF) = w; } }
    }
};

__device__ __forceinline__ float silu_fast(float v) { return v * __builtin_amdgcn_rcpf(1.0f + __builtin_amdgcn_exp2f(-1.4426950408889634f * v)); }
struct EpiGateMul {
    static constexpr bool PERM = true, AFTER_DRAIN = false;
    bf16_t* O; int ldc;
    __device__ __forceinline__ void operator()(const f32x4 (&acc)[2][2][4][2], const Unit& u, int wr, int wc, int fr, int fq) const {
        const int row0 = u.pm * BM + wr * 64 + fr, col0 = u.pn * BM + wc * 32 + 8 * fq;
#pragma unroll
        for (int ai = 0; ai < 2; ++ai)
#pragma unroll
            for (int m = 0; m < 4; ++m) { bf16_t* rowp = O + (size_t)(row0 + ai * HALF + m * 16) * ldc + col0;
#pragma unroll
                for (int bj = 0; bj < 2; ++bj) { const u32x4 old = *(const u32x4*)(rowp + bj * HALF); const f32x4 v0 = acc[ai][bj][m][0], v1 = acc[ai][bj][m][1];
                    u32x4 w;
                    w.x = cvt_pk_bf16(silu_fast(v0[0]) * __uint_as_float(old.x << 16), silu_fast(v0[1]) * __uint_as_float(old.x & 0xffff0000u));
                    w.y = cvt_pk_bf16(silu_fast(v0[2]) * __uint_as_float(old.y << 16), silu_fast(v0[3]) * __uint_as_float(old.y & 0xffff0000u));
                    w.z = cvt_pk_bf16(silu_fast(v1[0]) * __uint_as_float(old.z << 16), silu_fast(v1[1]) * __uint_as_float(old.z & 0xffff0000u));
                    w.w = cvt_pk_bf16(silu_fast(v1[2]) * __uint_as_float(old.w << 16), silu_fast(v1[3]) * __uint_as_float(old.w & 0xffff0000u));
                    *(u32x4*)(rowp + bj * HALF) = w; } }
    }
};
struct EpiSiluBf16 {
    static constexpr bool PERM = true, AFTER_DRAIN = false;
    bf16_t* O; int ldc;
    __device__ __forceinline__ void operator()(const f32x4 (&acc)[2][2][4][2], const Unit& u, int wr, int wc, int fr, int fq) const {
        const int row0 = u.pm * BM + wr * 64 + fr, col0 = u.pn * BM + wc * 32 + 8 * fq;
#pragma unroll
        for (int ai = 0; ai < 2; ++ai)
#pragma unroll
            for (int m = 0; m < 4; ++m) { bf16_t* rowp = O + (size_t)(row0 + ai * HALF + m * 16) * ldc + col0;
#pragma unroll
                for (int bj = 0; bj < 2; ++bj) { const f32x4 v0 = acc[ai][bj][m][0], v1 = acc[ai][bj][m][1]; u32x4 w;
                    w.x = cvt_pk_bf16(silu_fast(v0[0]), silu_fast(v0[1])); w.y = cvt_pk_bf16(silu_fast(v0[2]), silu_fast(v0[3]));
                    w.z = cvt_pk_bf16(silu_fast(v1[0]), silu_fast(v1[1])); w.w = cvt_pk_bf16(silu_fast(v1[2]), silu_fast(v1[3]));
                    *(u32x4*)(rowp + bj * HALF) = w; } }
    }
};
struct EpiF32 {
    static constexpr bool PERM = true, AFTER_DRAIN = false;
    float* O; int ldc;
    __device__ __forceinline__ void operator()(const f32x4 (&acc)[2][2][4][2], const Unit& u, int wr, int wc, int fr, int fq) const {
        const int row0 = u.pm * BM + wr * 64 + fr, col0 = u.pn * BM + wc * 32 + 8 * fq;
#pragma unroll
        for (int ai = 0; ai < 2; ++ai)
#pragma unroll
            for (int m = 0; m < 4; ++m) { float* rowp = O + (size_t)(row0 + ai * HALF + m * 16) * ldc + col0;
#pragma unroll
                for (int bj = 0; bj < 2; ++bj) { *(f32x4*)(rowp + bj * HALF) = acc[ai][bj][m][0]; *(f32x4*)(rowp + bj * HALF + 4) = acc[ai][bj][m][1]; } }
    }
};

template <class Epi, class Sched, bool ALIGN_EPI = false, bool SP2 = false>
__device__ __forceinline__ void gemm_phase(PG8_LAS unsigned char* lds, const Gemm g, const Sched& S, const Epi& E) {
    int tid_ = threadIdx.x; asm volatile("" : "+v"(tid_));
    const int tid = tid_, wid = __builtin_amdgcn_readfirstlane(tid >> 6), lane = tid & 63, wr = wid >> 2, wc = wid & 3, fr = lane & 15, fq = lane >> 4;
    const int K = g.K, nt = K / BK, lda = g.lda ? g.lda : K, ldb = g.ldb ? g.ldb : K;
    unsigned voffA[2], voffB[2];
#pragma unroll
    for (int i = 0; i < 2; ++i) { int R, C; stage_rc(tid * 16 + i * 8192, R, C); const int Rb = Epi::PERM ? ((R & ~31) + perm32(R & 31)) : R;
        voffA[i] = (unsigned)(R * lda + C) * 2u; voffB[i] = (unsigned)(Rb * ldb + C) * 2u; }
    const size_t kstep = (size_t)(BK * 2);
    const size_t hstepA = (size_t)HALF * lda * 2, hstepB = (size_t)HALF * ldb * 2;
    const size_t tstepA = g.ksl ? (size_t)g.ksl : 2 * hstepA, tstepB = 2 * hstepB, bpm = (size_t)g.ksl;
    const unsigned ldsw = (unsigned)wid * 1024u;
    const int aoff = lds_byte(wr * 64 + fr, fq * 8), boff = lds_byte(wc * 32 + fr, fq * 8);
#define PG8_SA(b, h) (((b) * 2 + (h)) * HTB)
#define PG8_SB(b, h) ((4 + (b) * 2 + (h)) * HTB)
#define PG8_STAGE(bufoff, gbase, voff) do { _Pragma("unroll") for (int _i = 0; _i < 2; ++_i) \
        __builtin_amdgcn_global_load_lds((const unsigned*)((const char*)(gbase) + (voff)[_i]), (PG8_LAS unsigned*)(lds + (bufoff) + ldsw + _i * 8192), 16, 0, 0); } while (0)
#define PG8_LDA(dst, b, h) do { _Pragma("unroll") for (int m = 0; m < 4; ++m) _Pragma("unroll") for (int k = 0; k < 2; ++k) dst[m][k] = *(const PG8_LAS bf16x8*)(lds + PG8_SA(b, h) + aoff + m * 2048 + k * 1024); } while (0)
#define PG8_LDB(dst, b, h) do { _Pragma("unroll") for (int n = 0; n < 2; ++n) _Pragma("unroll") for (int k = 0; k < 2; ++k) dst[n][k] = *(const PG8_LAS bf16x8*)(lds + PG8_SB(b, h) + boff + n * 2048 + k * 1024); } while (0)
#define PG8_MMA(ai, bj, At, Bt) do { __builtin_amdgcn_s_setprio(1); _Pragma("unroll") for (int m = 0; m < 4; ++m) _Pragma("unroll") for (int n = 0; n < 2; ++n) _Pragma("unroll") for (int k = 0; k < 2; ++k) \
        acc[ai][bj][m][n] = __builtin_amdgcn_mfma_f32_16x16x32_bf16(Bt[n][k], At[m][k], acc[ai][bj][m][n], 0, 0, 0); __builtin_amdgcn_s_setprio(0); } while (0)
#define PG8_WAIT_V(n) asm volatile("s_waitcnt vmcnt(" #n ")" ::: "memory")
#define PG8_WAIT_L(n) asm volatile("s_waitcnt lgkmcnt(" #n ")" ::: "memory")
#define PG8_BAR __builtin_amdgcn_s_barrier()
#define PG8_SCHED __builtin_amdgcn_sched_barrier(0)
    Unit cur, nxt; int ui = 0;
    if (!S.next(0, cur)) return;
    f32x4 acc[2][2][4][2];
#pragma unroll
    for (int a = 0; a < 2; ++a)
#pragma unroll
        for (int b = 0; b < 2; ++b)
#pragma unroll
            for (int m = 0; m < 4; ++m)
#pragma unroll
                for (int n = 0; n < 2; ++n) acc[a][b][m][n] = (f32x4){0.f, 0.f, 0.f, 0.f};
    bf16x8 At[4][2], B0[2][2], B1[2][2];
    const char* cA = (const char*)g.A + (size_t)cur.pm * tstepA; const char* cB = (const char*)g.Bt + (size_t)cur.pn * tstepB + (size_t)cur.pm * bpm;
    S.a_ready(cur);
    if constexpr (SP2) {
        PG8_STAGE(PG8_SB(0, 0), cB, voffB); PG8_STAGE(PG8_SB(0, 1), cB + hstepB, voffB); PG8_STAGE(PG8_SA(0, 0), cA, voffA); PG8_STAGE(PG8_SA(0, 1), cA + hstepA, voffA);
        if (wr == 1) PG8_BAR;
        PG8_WAIT_V(2); PG8_BAR;
        PG8_STAGE(PG8_SB(1, 0), cB + kstep, voffB); PG8_STAGE(PG8_SA(1, 0), cA + kstep, voffA); PG8_STAGE(PG8_SB(1, 1), cB + hstepB + kstep, voffB);
        PG8_WAIT_V(6); PG8_BAR;
    } else {
        PG8_STAGE(PG8_SB(0, 0), cB, voffB); PG8_STAGE(PG8_SA(0, 0), cA, voffA); PG8_STAGE(PG8_SB(0, 1), cB + hstepB, voffB); PG8_STAGE(PG8_SA(0, 1), cA + hstepA, voffA);
        if (wr == 1) PG8_BAR;
        PG8_WAIT_V(4); PG8_BAR;
        PG8_STAGE(PG8_SB(1, 0), cB + kstep, voffB); PG8_STAGE(PG8_SA(1, 0), cA + kstep, voffA); PG8_STAGE(PG8_SB(1, 1), cB + hstepB + kstep, voffB);
        PG8_WAIT_V(6); PG8_BAR;
    }
    for (;;) {
        const bool has_next = S.next(ui + 1, nxt);
        const char* nA = has_next ? (const char*)g.A + (size_t)nxt.pm * tstepA : cA; const char* nB = has_next ? (const char*)g.Bt + (size_t)nxt.pn * tstepB + (size_t)nxt.pm * bpm : cB;
        for (int t = 0; t < nt; t += 2) {
            const bool last = (t == nt - 2);
            const char* a1 = cA + (size_t)(t + 1) * kstep;
            const char* a2 = last ? nA : cA + (size_t)(t + 2) * kstep; const char* b2 = last ? nB : cB + (size_t)(t + 2) * kstep;
            const char* a3 = a2 + kstep; const char* b3 = b2 + kstep;
            if (last && has_next) S.a_ready(nxt);
            if constexpr (SP2) {
            PG8_LDB(B0, 0, 0); PG8_LDB(B1, 0, 1); PG8_SCHED; PG8_LDA(At, 0, 0); PG8_STAGE(PG8_SA(1, 1), a1 + hstepA, voffA);
            PG8_WAIT_V(8); PG8_WAIT_L(0); PG8_BAR; PG8_MMA(0, 0, At, B0); PG8_MMA(0, 1, At, B1); PG8_BAR; PG8_SCHED;
            PG8_LDA(At, 0, 1); PG8_STAGE(PG8_SB(0, 0), b2, voffB); PG8_STAGE(PG8_SB(0, 1), b2 + hstepB, voffB); PG8_STAGE(PG8_SA(0, 0), a2, voffA);
            PG8_WAIT_V(8); PG8_WAIT_L(0); PG8_BAR; PG8_MMA(1, 0, At, B0); PG8_MMA(1, 1, At, B1); PG8_BAR; PG8_SCHED;
            PG8_LDB(B0, 1, 0); PG8_LDB(B1, 1, 1); PG8_SCHED; PG8_LDA(At, 1, 0); PG8_STAGE(PG8_SA(0, 1), a2 + hstepA, voffA);
            PG8_WAIT_V(8); PG8_WAIT_L(0); PG8_BAR; PG8_MMA(0, 0, At, B0); PG8_MMA(0, 1, At, B1); PG8_BAR; PG8_SCHED;
            PG8_LDA(At, 1, 1); PG8_STAGE(PG8_SB(1, 0), b3, voffB); PG8_STAGE(PG8_SB(1, 1), b3 + hstepB, voffB); PG8_STAGE(PG8_SA(1, 0), a3, voffA);
            PG8_WAIT_V(8); PG8_WAIT_L(0); PG8_BAR; PG8_MMA(1, 0, At, B0); PG8_MMA(1, 1, At, B1); PG8_BAR; PG8_SCHED;
            } else {
            PG8_LDB(B0, 0, 0); PG8_SCHED; PG8_LDA(At, 0, 0); PG8_STAGE(PG8_SA(1, 1), a1 + hstepA, voffA);
            PG8_WAIT_L(8); PG8_BAR; PG8_WAIT_L(0); PG8_MMA(0, 0, At, B0); PG8_BAR; PG8_SCHED;
            PG8_LDB(B1, 0, 1); PG8_STAGE(PG8_SB(0, 0), b2, voffB);
            PG8_BAR; PG8_WAIT_L(0); PG8_MMA(0, 1, At, B1); PG8_BAR;
            PG8_LDA(At, 0, 1); PG8_STAGE(PG8_SA(0, 0), a2, voffA);
            PG8_BAR; PG8_WAIT_L(0); PG8_MMA(1, 0, At, B0); PG8_BAR; PG8_SCHED;
            PG8_STAGE(PG8_SB(0, 1), b2 + hstepB, voffB);
            PG8_WAIT_V(6); PG8_BAR; PG8_MMA(1, 1, At, B1); PG8_BAR;
            PG8_LDB(B0, 1, 0); PG8_SCHED; PG8_LDA(At, 1, 0); PG8_STAGE(PG8_SA(0, 1), a2 + hstepA, voffA);
            PG8_WAIT_L(8); PG8_BAR; PG8_WAIT_L(0); PG8_MMA(0, 0, At, B0); PG8_BAR; PG8_SCHED;
            PG8_LDB(B1, 1, 1); PG8_STAGE(PG8_SB(1, 0), b3, voffB);
            PG8_BAR; PG8_WAIT_L(0); PG8_MMA(0, 1, At, B1); PG8_BAR;
            PG8_LDA(At, 1, 1); PG8_STAGE(PG8_SA(1, 0), a3, voffA);
            PG8_BAR; PG8_WAIT_L(0); PG8_MMA(1, 0, At, B0); PG8_BAR; PG8_SCHED;
            PG8_STAGE(PG8_SB(1, 1), b3 + hstepB, voffB);
            PG8_WAIT_V(6); PG8_BAR; PG8_MMA(1, 1, At, B1); PG8_BAR;
            }
        }
        if constexpr (ALIGN_EPI) { if (wr == 0) PG8_BAR; }
        if constexpr (!Epi::AFTER_DRAIN) { E(acc, cur, wr, wc, fr, fq); S.done(cur); }
        if (!has_next) break;
#pragma unroll
        for (int a = 0; a < 2; ++a)
#pragma unroll
            for (int b = 0; b < 2; ++b)
#pragma unroll
                for (int m = 0; m < 4; ++m)
#pragma unroll
                    for (int n = 0; n < 2; ++n) acc[a][b][m][n] = (f32x4){0.f, 0.f, 0.f, 0.f};
        cur = nxt; cA = nA; cB = nB; ++ui;
        if constexpr (ALIGN_EPI) { if (wr == 1) PG8_BAR; }
    }
    PG8_WAIT_V(0);
    if constexpr (!ALIGN_EPI) { if (wr == 0) PG8_BAR; }
    PG8_BAR;
    if constexpr (Epi::AFTER_DRAIN) { E.fused(acc, cur, wr, wc, fr, fq, lds, wid, lane); S.done(cur); }
#undef PG8_SA
#undef PG8_SB
#undef PG8_STAGE
#undef PG8_LDA
#undef PG8_LDB
#undef PG8_MMA
#undef PG8_WAIT_V
#undef PG8_WAIT_L
#undef PG8_BAR
#undef PG8_SCHED
}
}

namespace attn {
using bf16 = unsigned short;
constexpr int   D = 128, NW = 8, QBLK = 32, KVBLK = 64;
constexpr float SCALE = 0.088388347648318440f;
constexpr float THR = 8.f;
constexpr int SDEPTH = 2;
constexpr int LDQ = P0W, LDK = P0W, LDO = 2048;
constexpr size_t SHM_V = KVBLK * D * 2, SHM_K = KVBLK * D * 2, SHM_ATTN = 2 * SHM_V + 2 * SHM_K + NW * 64 * 4;
using bf16x8 = __attribute__((ext_vector_type(8))) short;
using s16x4  = __attribute__((ext_vector_type(4))) short;
using f32x16 = __attribute__((ext_vector_type(16))) float;
using f32x8  = __attribute__((ext_vector_type(8))) float;
using u32x4  = __attribute__((ext_vector_type(4))) unsigned;
#define KSWZ(row, colB) ((row) * 256 + ((colB) ^ (((row) & 7) << 4)))
#define SBAR() __builtin_amdgcn_sched_barrier(0)
__device__ __forceinline__ int crow(int r, int hi) { return (r & 3) + 8 * (r >> 2) + 4 * hi; }
__device__ __forceinline__ unsigned cvtpk(float lo, float hi) {
  unsigned r; asm volatile("v_cvt_pk_bf16_f32 %0, %1, %2" : "=v"(r) : "v"(lo), "v"(hi)); return r;
}
template <typename TIn> struct Stage;
template <> struct Stage<bf16>  { using T = bf16x8;
  __device__ static __forceinline__ T ld8(const bf16* p) { return *reinterpret_cast<const bf16x8*>(p); }
  __device__ static __forceinline__ bf16x8 tobf(T x) { return x; } };
template <> struct Stage<float> { using T = f32x8;
  __device__ static __forceinline__ T ld8(const float* p) { return *reinterpret_cast<const f32x8*>(p); }
  __device__ static __forceinline__ bf16x8 tobf(T x) {
    u32x4 w = {cvtpk(x[0], x[1]), cvtpk(x[2], x[3]), cvtpk(x[4], x[5]), cvtpk(x[6], x[7])}; return *reinterpret_cast<bf16x8*>(&w); } };

template <bool NOMAX> __device__ __forceinline__ void partialSM(f32x16& p0, f32x16& p1, float& m_reg, float& mn, float& alpha) {
  if constexpr (NOMAX) { for (int r = 0; r < 16; ++r) p0[r] = __builtin_amdgcn_exp2f(p0[r]); alpha = 1.f; return; }
  constexpr float C = SCALE * 1.4426950408889634f;
  float pmax = p0[0]; for (int r = 1; r < 16; ++r) pmax = fmaxf(pmax, p0[r]); for (int r = 0; r < 16; ++r) pmax = fmaxf(pmax, p1[r]);
  { auto rr = __builtin_amdgcn_permlane32_swap(__float_as_uint(pmax), __float_as_uint(pmax), false, false);
    pmax = fmaxf(__uint_as_float(rr[0]), __uint_as_float(rr[1])); }
  if (__builtin_expect(__all(pmax - m_reg <= THR / SCALE), 1)) { mn = m_reg; alpha = 1.f; }
  else { mn = fmaxf(m_reg, pmax); alpha = __builtin_amdgcn_exp2f((m_reg - mn) * C); m_reg = mn; }
  float mnC = -mn * C;
  for (int r = 0; r < 16; ++r) p0[r] = fmaf(p0[r], C, mnC); for (int r = 0; r < 16; ++r) p1[r] = fmaf(p1[r], C, mnC);
  for (int r = 0; r < 16; ++r) p0[r] = __builtin_amdgcn_exp2f(p0[r]);
}
__device__ __forceinline__ void finishSM(f32x16& p0, f32x16& p1, float alpha, float& l_reg, bf16x8& pa0, bf16x8& pa1, bf16x8& pa2, bf16x8& pa3) {
  for (int r = 0; r < 16; ++r) p1[r] = __builtin_amdgcn_exp2f(p1[r]);
  float ps = 0; for (int r = 0; r < 16; ++r) ps += p0[r]; for (int r = 0; r < 16; ++r) ps += p1[r];
  { auto rr = __builtin_amdgcn_permlane32_swap(__float_as_uint(ps), __float_as_uint(ps), false, false);
    ps = __uint_as_float(rr[0]) + __uint_as_float(rr[1]); }
  l_reg = l_reg * alpha + ps;
#define PK4(P, BASE, OUT) do { unsigned a0 = cvtpk(P[BASE + 0], P[BASE + 1]), a1 = cvtpk(P[BASE + 2], P[BASE + 3]);   \
    unsigned b0 = cvtpk(P[BASE + 4], P[BASE + 5]), b1 = cvtpk(P[BASE + 6], P[BASE + 7]);                              \
    auto r0 = __builtin_amdgcn_permlane32_swap(a0, b0, false, false); auto r1 = __builtin_amdgcn_permlane32_swap(a1, b1, false, false); \
    u32x4 w = {r0[0], r1[0], r0[1], r1[1]}; OUT = *reinterpret_cast<bf16x8*>(&w); } while (0)
  PK4(p0, 0, pa0); PK4(p0, 8, pa1); PK4(p1, 0, pa2); PK4(p1, 8, pa3);
#undef PK4
}
__device__ __forceinline__ void qkt(f32x16& p0, f32x16& p1, const bf16* Ks, const bf16x8* qr, int r32, int hi) {
  p0 = f32x16{}; p1 = f32x16{};
  for (int d0 = 0; d0 < 8; ++d0) { int cb = (d0 * 16 + hi * 8) * 2;
    bf16x8 b0 = *reinterpret_cast<const bf16x8*>((const char*)Ks + KSWZ(r32, cb));
    bf16x8 b1 = *reinterpret_cast<const bf16x8*>((const char*)Ks + KSWZ(32 + r32, cb));
    p0 = __builtin_amdgcn_mfma_f32_32x32x16_bf16(b0, qr[d0], p0, 0, 0, 0);
    p1 = __builtin_amdgcn_mfma_f32_32x32x16_bf16(b1, qr[d0], p1, 0, 0, 0); }
}
__device__ __forceinline__ int v_st(int k, int c) { const int kk = (k & ~0xC) | ((k & 4) << 1) | ((k & 8) >> 1); return ((kk >> 3) * 4 + (c >> 5)) * 512 + ((kk & 7) * 32 + (c & 31)) * 2; }
__device__ __forceinline__ int v_rd_base(int lane) { return ((lane & 3) << 3) | (((lane >> 2) & 3) << 6) | (((lane >> 4) & 1) << 5) | (((lane >> 5) & 1) << 8); }
constexpr int v_rd_off(int d0, int ks, int half) { return d0 * 512 + ks * 4096 + half * 2048; }
template <int OFF> __device__ __forceinline__ s16x4 tr_read(int vb) {
  s16x4 r; asm volatile("ds_read_b64_tr_b16 %0, %1 offset:%2" : "=&v"(r) : "v"(vb), "i"(OFF) : "memory"); return r;
}
template <int D0> __device__ __forceinline__ void pv_one(f32x16& od, int vb, bf16x8 pa0, bf16x8 pa1, bf16x8 pa2, bf16x8 pa3) {
  const s16x4 l0 = tr_read<v_rd_off(D0, 0, 0)>(vb), h0 = tr_read<v_rd_off(D0, 0, 1)>(vb), l1 = tr_read<v_rd_off(D0, 1, 0)>(vb), h1 = tr_read<v_rd_off(D0, 1, 1)>(vb);
  const s16x4 l2 = tr_read<v_rd_off(D0, 2, 0)>(vb), h2 = tr_read<v_rd_off(D0, 2, 1)>(vb), l3 = tr_read<v_rd_off(D0, 3, 0)>(vb), h3 = tr_read<v_rd_off(D0, 3, 1)>(vb);
  asm volatile("s_waitcnt lgkmcnt(0)" ::: "memory"); SBAR();
#define PK(L, H) (bf16x8){L[0], L[1], L[2], L[3], H[0], H[1], H[2], H[3]}
  od = __builtin_amdgcn_mfma_f32_32x32x16_bf16(pa0, PK(l0, h0), od, 0, 0, 0);
  od = __builtin_amdgcn_mfma_f32_32x32x16_bf16(pa1, PK(l1, h1), od, 0, 0, 0);
  od = __builtin_amdgcn_mfma_f32_32x32x16_bf16(pa2, PK(l2, h2), od, 0, 0, 0);
  od = __builtin_amdgcn_mfma_f32_32x32x16_bf16(pa3, PK(l3, h3), od, 0, 0, 0);
#undef PK
}
__device__ __forceinline__ void pv_d0(f32x16* o, int vb, bf16x8 pa0, bf16x8 pa1, bf16x8 pa2, bf16x8 pa3) {
  pv_one<0>(o[0], vb, pa0, pa1, pa2, pa3); pv_one<1>(o[1], vb, pa0, pa1, pa2, pa3); pv_one<2>(o[2], vb, pa0, pa1, pa2, pa3); pv_one<3>(o[3], vb, pa0, pa1, pa2, pa3);
}

template <typename TQ, bool NOMAX>
__device__ __forceinline__ void attn_dense_body(const TQ* __restrict__ Qb, const bf16* __restrict__ Kh, const bf16* __restrict__ Vh,
                                                bf16* __restrict__ Ob, int seq, char* lds) {
  using St = Stage<bf16>; using SQ = Stage<TQ>;
  int tid_ = threadIdx.x; asm volatile("" : "+v"(tid_));
  const int tid = tid_, wid = tid >> 6, lane = tid & 63, r32 = lane & 31, hi = lane >> 5;
  bf16* V_lds = (bf16*)lds; bf16* K_lds = (bf16*)(lds + 2 * SHM_V);
  float* ws = (float*)(lds + 2 * SHM_V + 2 * SHM_K) + wid * 64; float* li_l = ws; float* al_l = ws + 32;
  float m_reg = -1e30f, l_reg = 0; f32x16 o[4] = {}; bf16x8 qr[8];
  const TQ* Qw = Qb + (long)(wid * QBLK + r32) * LDQ + hi * 8;
#pragma unroll
  for (int d0 = 0; d0 < 8; ++d0) { qr[d0] = SQ::tobf(SQ::ld8(Qw + d0 * 16));
    if constexpr (NOMAX) { constexpr float C = SCALE * 1.4426950408889634f; u32x4 w = *reinterpret_cast<u32x4*>(&qr[d0]);
      for (int i = 0; i < 4; ++i) w[i] = cvtpk(__uint_as_float(w[i] << 16) * C, __uint_as_float(w[i] & 0xffff0000u) * C);
      qr[d0] = *reinterpret_cast<bf16x8*>(&w); } }
  const int sr = tid >> 4, sc = (tid & 15) * 8, vst0 = v_st(sr, sc), vst1 = v_st(32 + sr, sc);
  const int vb0 = (int)(uintptr_t)V_lds + v_rd_base(lane);
  struct { typename St::T vs0, vs1, ks0, ks1; } sr_[SDEPTH];
#define SLOAD(i, k0) do { sr_[i].vs0 = St::ld8(&Vh[(long)((k0) + sr) * LDK + sc]); sr_[i].vs1 = St::ld8(&Vh[(long)((k0) + 32 + sr) * LDK + sc]); \
    sr_[i].ks0 = St::ld8(&Kh[(long)((k0) + sr) * LDK + sc]); sr_[i].ks1 = St::ld8(&Kh[(long)((k0) + 32 + sr) * LDK + sc]); } while (0)
#define SWRITE(b, i) do { *(bf16x8*)((char*)V_lds + (b) * SHM_V + vst0) = St::tobf(sr_[i].vs0);          \
    *(bf16x8*)((char*)V_lds + (b) * SHM_V + vst1) = St::tobf(sr_[i].vs1); int kc = sc * 2;               \
    *(bf16x8*)((char*)K_lds + (b) * SHM_K + KSWZ(sr, kc)) = St::tobf(sr_[i].ks0);                       \
    *(bf16x8*)((char*)K_lds + (b) * SHM_K + KSWZ(32 + sr, kc)) = St::tobf(sr_[i].ks1); } while (0)
#define SWAIT() do { if constexpr (SDEPTH == 2) asm volatile("s_waitcnt vmcnt(4)" ::: "memory"); else asm volatile("s_waitcnt vmcnt(0)" ::: "memory"); } while (0)
#define RESC(a) do { if (!NOMAX && __any((a) < 1.f)) { if (hi == 0) al_l[r32] = (a); asm volatile("s_waitcnt lgkmcnt(0)" ::: "memory"); \
    for (int d = 0; d < 4; ++d) for (int r = 0; r < 16; ++r) o[d][r] *= al_l[crow(r, hi)]; } } while (0)
  f32x16 pA0, pA1, pB0, pB1; float mnA, mnB, alA, alB; bf16x8 pa0, pa1, pa2, pa3; const int NT = seq / KVBLK;
  constexpr int SE = 0, SO = SDEPTH - 1;
  SLOAD(SE, 0); asm volatile("s_waitcnt vmcnt(0)" ::: "memory"); SWRITE(0, SE); __syncthreads();
  qkt(pA0, pA1, K_lds, qr, r32, hi); partialSM<NOMAX>(pA0, pA1, m_reg, mnA, alA);
  SLOAD(SO, KVBLK); if constexpr (SDEPTH == 2) { if (2 < NT) SLOAD(SE, 2 * KVBLK); }
  SWAIT(); SWRITE(1, SO); __syncthreads();
  for (int j = 1; j + 1 < NT; j += 2) {
    SBAR(); qkt(pB0, pB1, (bf16*)((char*)K_lds + SHM_K), qr, r32, hi);
    finishSM(pA0, pA1, alA, l_reg, pa0, pa1, pa2, pa3); SBAR();
    SLOAD(SO, (j + SDEPTH) * KVBLK); SBAR();
    pv_d0(o, vb0, pa0, pa1, pa2, pa3); partialSM<NOMAX>(pB0, pB1, m_reg, mnB, alB);
    __syncthreads(); SWAIT(); SWRITE(0, SE);
    RESC(alB); __syncthreads();
    SBAR(); qkt(pA0, pA1, K_lds, qr, r32, hi);
    finishSM(pB0, pB1, alB, l_reg, pa0, pa1, pa2, pa3); SBAR();
    if (SDEPTH == 1 || j + 3 < NT) SLOAD(SE, (j + 1 + SDEPTH) * KVBLK); SBAR();
    pv_d0(o, vb0 + (int)SHM_V, pa0, pa1, pa2, pa3); partialSM<NOMAX>(pA0, pA1, m_reg, mnA, alA);
    __syncthreads(); SWAIT(); SWRITE(1, SO);
    RESC(alA); __syncthreads();
  }
  SBAR(); qkt(pB0, pB1, (bf16*)((char*)K_lds + SHM_K), qr, r32, hi);
  finishSM(pA0, pA1, alA, l_reg, pa0, pa1, pa2, pa3); SBAR();
  pv_d0(o, vb0, pa0, pa1, pa2, pa3); partialSM<NOMAX>(pB0, pB1, m_reg, mnB, alB);
  __syncthreads(); RESC(alB);
  finishSM(pB0, pB1, alB, l_reg, pa0, pa1, pa2, pa3); SBAR();
  pv_d0(o, vb0 + (int)SHM_V, pa0, pa1, pa2, pa3);
  if (hi == 0) li_l[r32] = l_reg; asm volatile("s_waitcnt lgkmcnt(0)" ::: "memory");
  float rli[16];
#pragma unroll
  for (int r = 0; r < 16; ++r) rli[r] = __builtin_amdgcn_rcpf(li_l[crow(r, hi)]);
  bf16* Ow = Ob + (long)(wid * QBLK) * LDO;
#pragma unroll
  for (int r = 0; r < 16; ++r) { int orow = crow(r, hi);
    for (int d0 = 0; d0 < 4; ++d0) Ow[(long)orow * LDO + d0 * 32 + r32] = (bf16)(cvtpk(o[d0][r] * rli[r], 0.f) & 0xffffu); }
#undef SLOAD
#undef SWRITE
#undef SWAIT
#undef RESC
}
#undef KSWZ
#undef SBAR
}

namespace rw {
typedef short bf16x8 __attribute__((ext_vector_type(8)));
typedef float f32x4 __attribute__((ext_vector_type(4)));
typedef unsigned u32x4 __attribute__((ext_vector_type(4)));
typedef unsigned u32x2 __attribute__((ext_vector_type(2)));
constexpr int CH = 32, NC = R / CH;
static_assert(NC % 2 == 0, "the prep loop is unrolled by two");
constexpr int BUFB = 5 * 8192 + 1024;
constexpr int O_W = 0, O_B = 8192, O_KD = 16384, O_A = 24576, O_R = 32768, O_V = 40960;
constexpr int PITCH = 72;
constexpr int L_SCR = 2 * BUFB, SCRB = 2 * 16 * PITCH * 2;
constexpr int L_W2T = L_SCR + 4 * SCRB, L_A2T = L_W2T + 64 * PITCH * 2;
constexpr int L_Y = L_A2T + 64 * PITCH * 2;
constexpr int L_CST = L_Y + 2 * 2 * CH * 64 * 4;
constexpr int L_END = L_CST + 10 * 64 * 4;
static_assert(L_END <= 163840 - 64 && (BUFB % 16) == 0 && (L_SCR % 16) == 0 && (SCRB % 16) == 0 && (L_W2T % 16) == 0 && (L_A2T % 16) == 0 && (L_Y % 16) == 0 && (L_CST % 16) == 0, "rwkv LDS map");
constexpr size_t WS_BON = 38 * MiB;

template <int CTRL> __device__ __forceinline__ float dppmov(float x) { return __builtin_bit_cast(float, __builtin_amdgcn_update_dpp(0, __builtin_bit_cast(int, x), CTRL, 0xF, 0xF, true)); }
__device__ __forceinline__ float allreduce8(float x) {
    x += dppmov<0xB1>(x);
    x += dppmov<0x4E>(x);
    x += dppmov<0x141>(x);
    return x;
}
__device__ __forceinline__ float allreduce16(float x) { x = allreduce8(x); x += dppmov<0x140>(x); return x; }
__device__ __forceinline__ float fast_tanh(float x) { const float e = __builtin_amdgcn_exp2f(2.885390081777927f * x); return 1.0f - 2.0f * __builtin_amdgcn_rcpf(1.0f + e); }
__device__ __forceinline__ float bflo(unsigned u) { return __uint_as_float(u << 16); }
__device__ __forceinline__ float bfhi(unsigned u) { return __uint_as_float(u & 0xffff0000u); }
__device__ __forceinline__ unsigned pkbf(float lo, float hi) { unsigned r; asm volatile("v_cvt_pk_bf16_f32 %0, %1, %2" : "=v"(r) : "v"(lo), "v"(hi)); return r; }

constexpr int SEGR = 128, NSEG = R / SEGR, NCG = (ZW + 511) / 512;
constexpr size_t WS_HALO = 40 * MiB;
static_assert(WS_HALO + (size_t)NSEG * 2 * ZW * 2 <= WS_XN, "halo rows overflow");
__device__ __forceinline__ void shift_halo(const Params& p) {
    int tid_ = threadIdx.x; asm volatile("" : "+v"(tid_));
    const bf16_t* Z = ws_big(p); bf16_t* H = (bf16_t*)(p.ws + WS_HALO);
    for (int it = (int)blockIdx.x * NTHR + tid_; it < NSEG * 2 * (ZW / 8); it += (int)gridDim.x * NTHR) {
        const int c8 = it % (ZW / 8), w = (it / (ZW / 8)) & 1, seg = it / (2 * (ZW / 8));
        *(u32x4*)(H + ((size_t)seg * 2 + w) * ZW + c8 * 8) = *(const u32x4*)(Z + (size_t)(seg * SEGR + (w ? SEGR - 1 : 0)) * ZW + c8 * 8);
    }
}
__device__ __forceinline__ u32x4 shift8(u32x4 c, u32x4 pv, u32x4 nx, f32x4 m0, f32x4 m1) {
    u32x4 o;
#pragma unroll
    for (int q = 0; q < 4; ++q) { const float ml = q < 2 ? m0[2 * q] : m1[2 * q - 4], mh = q < 2 ? m0[2 * q + 1] : m1[2 * q - 3];
        const float zl = bflo(c[q]), zh = bfhi(c[q]);
        o[q] = pkbf(zl + (0.5f * (bflo(pv[q]) + bflo(nx[q])) - zl) * ml, zh + (0.5f * (bfhi(pv[q]) + bfhi(nx[q])) - zh) * mh); }
    return o;
}
__device__ __forceinline__ void shift_inplace(const Params& p) {
    int tid_ = threadIdx.x; asm volatile("" : "+v"(tid_));
    const int lane = tid_ & 63, gw = (int)blockIdx.x * NWAVES + (tid_ >> 6), ngw = (int)gridDim.x * NWAVES;
    bf16_t* Z = ws_big(p); const bf16_t* H = (const bf16_t*)(p.ws + WS_HALO);
    for (int u = gw; u < NSEG * NCG; u += ngw) {
        const int seg = u / NCG, col = (u % NCG) * 512 + lane * 8;
        if (col < ZW) {
            const f32x4 m0 = *(const f32x4*)(p.mu + col), m1 = *(const f32x4*)(p.mu + col + 4);
            const bool first = seg == 0 || seg == CTXN / SEGR, last = seg == CTXN / SEGR - 1 || seg == NSEG - 1;
            bf16_t* zr = Z + (size_t)seg * SEGR * ZW + col;
            u32x4 pv = first ? (u32x4){0u, 0u, 0u, 0u} : *(const u32x4*)(H + ((size_t)(seg - 1) * 2 + 1) * ZW + col);
            const u32x4 tail = last ? (u32x4){0u, 0u, 0u, 0u} : *(const u32x4*)(H + ((size_t)(seg + 1) * 2) * ZW + col);
            u32x4 c0 = *(const u32x4*)zr, c1 = *(const u32x4*)(zr + ZW), c2 = *(const u32x4*)(zr + 2 * ZW), c3 = *(const u32x4*)(zr + 3 * ZW);
            for (int r = 0; r < SEGR; r += 4) {
                u32x4 n0 = tail, n1 = tail, n2 = tail, n3 = tail;
                if (r + 4 < SEGR) { n0 = *(const u32x4*)(zr + (size_t)(r + 4) * ZW); n1 = *(const u32x4*)(zr + (size_t)(r + 5) * ZW); n2 = *(const u32x4*)(zr + (size_t)(r + 6) * ZW); n3 = *(const u32x4*)(zr + (size_t)(r + 7) * ZW); }
                const u32x4 o0 = shift8(c0, pv, c1, m0, m1), o1 = shift8(c1, c0, c2, m0, m1), o2 = shift8(c2, c1, c3, m0, m1), o3 = shift8(c3, c2, n0, m0, m1);
                *(u32x4*)(zr + (size_t)r * ZW) = o0; *(u32x4*)(zr + (size_t)(r + 1) * ZW) = o1; *(u32x4*)(zr + (size_t)(r + 2) * ZW) = o2; *(u32x4*)(zr + (size_t)(r + 3) * ZW) = o3;
                pv = c3; c0 = n0; c1 = n1; c2 = n2; c3 = n3;
            }
        }
    }
}

struct Raw { u32x4 c[5]; };

template <int MODE> __device__ __forceinline__ void scan_block(const Params& p, int blk, LAS unsigned char* lds) {
    int tid_ = threadIdx.x; asm volatile("" : "+v"(tid_));
    const int tid = tid_, lane = tid & 63, wave = __builtin_amdgcn_readfirstlane(tid >> 6);
    const int dir = blk >> 7, h = (blk >> 3) & 15, eighth = blk & 7;
    const float* w0 = dir ? p.w0b : p.w0f; const float* w2 = dir ? p.w2b : p.w2f; const float* a0 = dir ? p.a0b : p.a0f; const float* a2 = dir ? p.a2b : p.a2f;
    const bf16_t* Z = ws_big(p); bf16_t* BR = ws_br(p); float* bon = (float*)(p.ws + WS_BON) + ((size_t)dir * 16 + h) * SEQ;
    { const int m = tid >> 3, j8 = (tid & 7) * 8;
      const f32x4 wa = *(const f32x4*)(w2 + (size_t)m * 1024 + h * 64 + j8), wb = *(const f32x4*)(w2 + (size_t)m * 1024 + h * 64 + j8 + 4);
      const f32x4 aa = *(const f32x4*)(a2 + (size_t)m * 1024 + h * 64 + j8), ab = *(const f32x4*)(a2 + (size_t)m * 1024 + h * 64 + j8 + 4);
      LAS bf16_t* yw = (LAS bf16_t*)(lds + L_W2T); LAS bf16_t* ya = (LAS bf16_t*)(lds + L_A2T);
#pragma unroll
      for (int q = 0; q < 4; ++q) { yw[(j8 + q) * PITCH + m] = f2bf(wa[q]); yw[(j8 + 4 + q) * PITCH + m] = f2bf(wb[q]); ya[(j8 + q) * PITCH + m] = f2bf(aa[q]); ya[(j8 + 4 + q) * PITCH + m] = f2bf(ab[q]); }
      for (int i = tid; i < 4 * SCRB / 4; i += NTHR) *(LAS unsigned*)(lds + L_SCR + i * 4) = 0u;
      for (int i = tid; i < 640; i += NTHR) { const int g = i >> 6, cc = i & 63, hc = h * 64 + cc; float v;
          if (g < 3) v = p.mu[g * 1024 + hc]; else if (g == 3) v = p.mu[3072 + dir * 64 + cc]; else if (g == 4) v = p.mu[3200 + dir * 64 + cc];
          else if (g == 5) v = w0[hc]; else if (g == 6) v = a0[hc]; else if (g == 7) v = p.k_k[hc]; else if (g == 8) v = p.k_a[hc]; else v = p.r_k[hc];
          *(LAS float*)(lds + L_CST + i * 4) = v; } }
    __syncthreads();
    if ((wave & 2) != 0) {
        const int pw = (wave & 1) + ((wave >> 2) << 1), tq = lane >> 3, c8 = (lane & 7) * 8, hj = h * 64 + c8, tslot = pw * 8 + tq;
        const int gcol[5] = {hj, 1024 + hj, 2048 + hj, 3072 + dir * 64 + c8, 3200 + dir * 64 + c8};
        LAS unsigned char* scr = lds + L_SCR + pw * SCRB;
#define RW_CST(g, hh) (*(LAS f32x4*)(lds + L_CST + ((g) * 64 + c8 + 4 * (hh)) * 4))
#define RW_LOADRAW(raw, cc) do { const bf16_t* zr_ = Z + (size_t)rw_row(dir, (cc) * CH + tslot) * ZW; \
            _Pragma("unroll") for (int g = 0; g < 5; ++g) raw.c[g] = *(const u32x4*)(zr_ + gcol[g]); } while (0)
        Raw rawA, rawB;
        f32x4 cw0[2], ca0[2], ckk[2], cka[2], crk[2];
#pragma unroll
        for (int hh = 0; hh < 2; ++hh) { cw0[hh] = RW_CST(5, hh); ca0[hh] = RW_CST(6, hh); ckk[hh] = RW_CST(7, hh); cka[hh] = RW_CST(8, hh); crk[hh] = RW_CST(9, hh);
            asm volatile("" : "+v"(cw0[hh]), "+v"(ca0[hh]), "+v"(ckk[hh]), "+v"(cka[hh]), "+v"(crk[hh])); }
        if (MODE == 0 || MODE == 2 || MODE == 3 || MODE == 9) { RW_LOADRAW(rawA, 0); RW_LOADRAW(rawB, 1); }
#define RW_PREP_ITER(RAWSET, cc_) do { \
            if (MODE == 0 || MODE == 2 || MODE == 3 || MODE == 9) { \
            const int cn = (cc_) + 1; LAS unsigned char* buf = lds + (cn & 1) * BUFB; const int p0 = cn * CH; const bool latent = p0 >= CTXN; \
            f32x4 rr[2], kv[2]; \
            { const u32x4 u = RAWSET.c[0]; rr[0] = (f32x4){bflo(u.x), bfhi(u.x), bflo(u.y), bfhi(u.y)}; rr[1] = (f32x4){bflo(u.z), bfhi(u.z), bflo(u.w), bfhi(u.w)}; \
              *(LAS f32x4*)(buf + O_R + (tslot * 64 + c8) * 4) = rr[0]; *(LAS f32x4*)(buf + O_R + (tslot * 64 + c8) * 4 + 16) = rr[1]; } \
            { const u32x4 u = RAWSET.c[1]; kv[0] = (f32x4){bflo(u.x), bfhi(u.x), bflo(u.y), bfhi(u.y)}; kv[1] = (f32x4){bflo(u.z), bfhi(u.z), bflo(u.w), bfhi(u.w)}; } \
            if ((lane & 7) == eighth) { const u32x4 u = RAWSET.c[2]; *(LAS f32x4*)(buf + O_V + tslot * 32) = (f32x4){bflo(u.x), bfhi(u.x), bflo(u.y), bfhi(u.y)}; *(LAS f32x4*)(buf + O_V + tslot * 32 + 16) = (f32x4){bflo(u.z), bfhi(u.z), bflo(u.w), bfhi(u.w)}; } \
            { const u32x4 u = RAWSET.c[3]; u32x4 o; \
              o.x = pkbf(fast_tanh(bflo(u.x)), fast_tanh(bfhi(u.x))); o.y = pkbf(fast_tanh(bflo(u.y)), fast_tanh(bfhi(u.y))); o.z = pkbf(fast_tanh(bflo(u.z)), fast_tanh(bfhi(u.z))); o.w = pkbf(fast_tanh(bflo(u.w)), fast_tanh(bfhi(u.w))); \
              *(LAS u32x4*)(scr + (tq * PITCH + c8) * 2) = o; *(LAS u32x4*)(scr + 16 * PITCH * 2 + (tq * PITCH + c8) * 2) = RAWSET.c[4]; } \
            if (cn + 2 < NC) RW_LOADRAW(RAWSET, cn + 2);              \
            asm volatile("s_waitcnt lgkmcnt(0)" ::: "memory"); \
            { const int r16 = lane & 15, quad = lane >> 4; f32x4 acc[2][4]; \
_Pragma("unroll") \
              for (int lora = 0; lora < 2; ++lora) { \
                  LAS unsigned char* X = scr + lora * 16 * PITCH * 2 + (r16 * PITCH + quad * 8) * 2; \
                  const bf16x8 x0 = *(LAS bf16x8*)X, x1 = *(LAS bf16x8*)(X + 64); \
_Pragma("unroll") \
                  for (int jt = 0; jt < 4; ++jt) { \
                      LAS unsigned char* Y = lds + (lora ? L_A2T : L_W2T) + ((jt * 16 + r16) * PITCH + quad * 8) * 2; \
                      acc[lora][jt] = (f32x4){0.f, 0.f, 0.f, 0.f}; \
                      acc[lora][jt] = __builtin_amdgcn_mfma_f32_16x16x32_bf16(x0, *(LAS bf16x8*)Y, acc[lora][jt], 0, 0, 0); \
                      acc[lora][jt] = __builtin_amdgcn_mfma_f32_16x16x32_bf16(x1, *(LAS bf16x8*)(Y + 64), acc[lora][jt], 0, 0, 0); } } \
              if (quad < 2) { \
_Pragma("unroll") \
                  for (int lora = 0; lora < 2; ++lora) \
_Pragma("unroll") \
                      for (int jt = 0; jt < 4; ++jt) \
_Pragma("unroll") \
                          for (int r = 0; r < 4; ++r) *(LAS float*)(buf + (lora ? O_B : O_W) + ((pw * 8 + quad * 4 + r) * 64 + jt * 16 + r16) * 4) = acc[lora][jt][r]; } } \
            asm volatile("s_waitcnt lgkmcnt(0)" ::: "memory"); \
            { float bs = 0.f, nn = 0.f; f32x4 kk[2], al[2]; \
_Pragma("unroll") \
              for (int hh = 0; hh < 2; ++hh) { const int off = (tslot * 64 + c8 + 4 * hh) * 4; \
                  const f32x4 aw = *(LAS f32x4*)(buf + O_W + off) + cw0[hh], aa = *(LAS f32x4*)(buf + O_B + off) + ca0[hh]; \
                  f32x4 wv; \
_Pragma("unroll") \
                  for (int q = 0; q < 4; ++q) { const float sg = __builtin_amdgcn_rcpf(1.0f + __builtin_amdgcn_exp2f(-1.4426950408889634f * aw[q])); \
                      wv[q] = __builtin_amdgcn_exp2f(-0.8750612633917f * sg); al[hh][q] = __builtin_amdgcn_rcpf(1.0f + __builtin_amdgcn_exp2f(-1.4426950408889634f * aa[q])); kk[hh][q] = kv[hh][q] * ckk[hh][q]; nn += kk[hh][q] * kk[hh][q]; } \
                  *(LAS f32x4*)(buf + O_W + off) = wv; } \
              nn = allreduce8(nn); \
              const float inv = __builtin_amdgcn_rsqf(fmaxf(nn, 1e-24f)); \
_Pragma("unroll") \
              for (int hh = 0; hh < 2; ++hh) { const int off = (tslot * 64 + c8 + 4 * hh) * 4; \
                  const f32x4 r = rr[hh]; \
                  f32x4 av, bv, kd; \
_Pragma("unroll") \
                  for (int q = 0; q < 4; ++q) { const float kn = kk[hh][q] * inv; av[q] = -kn; bv[q] = kn * al[hh][q]; kd[q] = kv[hh][q] * (1.0f + (al[hh][q] - 1.0f) * cka[hh][q]); bs += r[q] * kd[q] * crk[hh][q]; } \
                  *(LAS f32x4*)(buf + O_B + off) = bv; *(LAS f32x4*)(buf + O_KD + off) = kd; *(LAS f32x4*)(buf + O_A + off) = av; } \
              bs = allreduce8(bs); \
              if (MODE == 0 && latent && eighth == 0 && (lane & 7) == 0) bon[rw_row(dir, p0 + tslot) - CTXN] = bs; } \
            } \
            __syncthreads(); \
        } while (0)
        for (int c = -1; c < NC - 1; c += 2) { RW_PREP_ITER(rawA, c); RW_PREP_ITER(rawB, c + 1); }
#undef RW_PREP_ITER
#undef RW_LOADRAW
#undef RW_CST
    } else if (wave >= 4) {
        const int sw = wave - 4, et = lane >> 1, erp = lane & 1;
#define RW_EMIT(cc) do { if ((cc) * CH >= CTXN) { const LAS f32x4* yp = (const LAS f32x4*)(lds + L_Y + ((((cc) & 1) * 2 + sw) * 8192) + et * 256 + erp * 128); \
            f32x4 s0 = yp[0] + yp[1] + yp[2] + yp[3], s1 = yp[4] + yp[5] + yp[6] + yp[7]; \
            *(unsigned*)(BR + (size_t)rw_row(dir, (cc) * CH + et) * 2048 + dir * 1024 + h * 64 + eighth * 8 + sw * 4 + erp * 2) = pkbf((s0[0] + s0[1]) + (s0[2] + s0[3]), (s1[0] + s1[1]) + (s1[2] + s1[3])); } } while (0)
        __syncthreads();
        for (int c = 0; c < NC; ++c) { if (c >= 1) RW_EMIT(c - 1); if (c + 1 < NC) __syncthreads(); }
    } else {
        __builtin_amdgcn_s_setprio(0);
        typedef float f32x2 __attribute__((ext_vector_type(2)));
        f32x2 S01 = {0.f, 0.f}, S23 = {0.f, 0.f};
        const int srow = wave * 4 + (lane >> 4), sj = (lane & 15) * 4;
        __syncthreads();
        struct Ops { f32x4 a, w, b, k, r; float v; };
#define RW_LD(o, t) do { o.a = *(LAS f32x4*)(bp + O_A + (t) * 256); \
            if (MODE == 9) { o.w = o.a; o.b = o.a; o.k = o.a; o.r = o.a; o.v = o.a[0]; } else { o.w = *(LAS f32x4*)(bp + O_W + (t) * 256); o.b = *(LAS f32x4*)(bp + O_B + (t) * 256); \
            o.k = *(LAS f32x4*)(bp + O_KD + (t) * 256); o.r = *(LAS f32x4*)(bp + O_R + (t) * 256); o.v = *(LAS float*)(vp + (t) * 32); } } while (0)
#define RW_STEP(o, t) do { f32x2 pd = S01 * o.a.lo; pd = S23 * o.a.hi + pd; float sa = pd.x + pd.y; if (MODE != 5 && MODE != 7) sa = allreduce16(sa); \
            S01 = o.b.lo * sa + (S01 * o.w.lo + o.k.lo * o.v); S23 = o.b.hi * sa + (S23 * o.w.hi + o.k.hi * o.v); \
            { f32x2 py = S01 * o.r.lo; py = S23 * o.r.hi + py; *(LAS float*)(yb + (t) * 256) = py.x + py.y; } } while (0)
        for (int c = 0; c < NC; ++c) {
            LAS unsigned char* bp = lds + (c & 1) * BUFB + sj * 4; LAS unsigned char* vp = lds + (c & 1) * BUFB + O_V + srow * 4; LAS unsigned char* yb = lds + L_Y + ((c & 1) * 2 + wave) * 8192 + lane * 4;
            Ops A0, A1, A2, A3, B0, B1, B2, B3;
            if (MODE != 2) {
            RW_LD(A0, 0); RW_LD(A1, 1); RW_LD(A2, 2); RW_LD(A3, 3);
#pragma unroll
            for (int g = 0; g < CH / 8; ++g) {
                RW_LD(B0, 8 * g + 4); RW_LD(B1, 8 * g + 5); RW_LD(B2, 8 * g + 6); RW_LD(B3, 8 * g + 7);
                __builtin_amdgcn_sched_barrier(0);
                RW_STEP(A0, 8 * g); RW_STEP(A1, 8 * g + 1); RW_STEP(A2, 8 * g + 2); RW_STEP(A3, 8 * g + 3);
                __builtin_amdgcn_sched_barrier(0);
                if (g + 1 < CH / 8) { RW_LD(A0, 8 * g + 8); RW_LD(A1, 8 * g + 9); RW_LD(A2, 8 * g + 10); RW_LD(A3, 8 * g + 11); }
                __builtin_amdgcn_sched_barrier(0);
                RW_STEP(B0, 8 * g + 4); RW_STEP(B1, 8 * g + 5); RW_STEP(B2, 8 * g + 6); RW_STEP(B3, 8 * g + 7);
                __builtin_amdgcn_sched_barrier(0);
            }
            }
            if (c + 1 < NC) __syncthreads();
        }
#undef RW_LD
#undef RW_STEP
        if (MODE != 0) asm volatile("" :: "v"(S01), "v"(S23));
        __builtin_amdgcn_s_setprio(0);
    }
    __syncthreads();
    if (wave == 4 || wave == 5) { const int sw = wave - 4, et = lane >> 1, erp = lane & 1; RW_EMIT(NC - 1); }
#undef RW_EMIT
    __syncthreads();
}

__device__ __forceinline__ float wave_sum(float v) {
    v = allreduce16(v);
    { auto r = __builtin_amdgcn_permlane16_swap(__float_as_uint(v), __float_as_uint(v), false, false); v = __uint_as_float(r[0]) + __uint_as_float(r[1]); }
    { auto r = __builtin_amdgcn_permlane32_swap(__float_as_uint(v), __float_as_uint(v), false, false); v = __uint_as_float(r[0]) + __uint_as_float(r[1]); }
    return v;
}
__device__ __forceinline__ void finish_phase(const Params& p) {
    int tid_ = threadIdx.x; asm volatile("" : "+v"(tid_));
    const int lane = tid_ & 63, gw = (int)blockIdx.x * NWAVES + (tid_ >> 6), ngw = (int)gridDim.x * NWAVES;
    const bf16_t* Z = ws_big(p); bf16_t* BR = ws_br(p); const float* bon = (const float*)(p.ws + WS_BON);
    for (int it = gw; it < SEQ * 4; it += ngw) {
        const int t = it >> 2, h = (it & 3) * 4 + (lane >> 4), row = CTXN + t, col = h * 64 + (lane & 15) * 4;
        bf16_t* b = BR + (size_t)row * 2048;
        const u32x2 wf = *(const u32x2*)(b + col), wb = *(const u32x2*)(b + 1024 + col), zv = *(const u32x2*)(Z + (size_t)row * ZW + 2048 + col);
        const f32x4 x = {bflo(wf.x) + bflo(wb.x), bfhi(wf.x) + bfhi(wb.x), bflo(wf.y) + bflo(wb.y), bfhi(wf.y) + bfhi(wb.y)};
        const float mean = allreduce16((x[0] + x[1]) + (x[2] + x[3])) * (1.0f / 64.f);
        const f32x4 d = x - mean;
        const float var = allreduce16((d[0] * d[0] + d[1] * d[1]) + (d[2] * d[2] + d[3] * d[3])) * (1.0f / 64.f);
        const float rstd = __builtin_amdgcn_rsqf(var + GN_EPS), bsum = bon[(size_t)h * SEQ + t] + bon[((size_t)16 + h) * SEQ + t];
        const f32x4 g = *(const f32x4*)(p.lnx_g + col), bb = *(const f32x4*)(p.lnx_b + col), v = {bflo(zv.x), bfhi(zv.x), bflo(zv.y), bfhi(zv.y)};
        const f32x4 y = d * rstd * g + bb + v * bsum;
        u32x2 o; o.x = pkbf(y[0], y[1]); o.y = pkbf(y[2], y[3]);
        *(u32x2*)(b + 1024 + col) = o;
    }
}
}

namespace wy {
typedef short bf16x4 __attribute__((ext_vector_type(4)));
using rw::f32x4; using rw::u32x4; using rw::u32x2; using rw::bf16x8; using rw::bflo; using rw::bfhi; using rw::PITCH;
typedef float f32x2_t __attribute__((ext_vector_type(2)));
typedef __bf16 bf2_t __attribute__((ext_vector_type(2)));
__device__ __forceinline__ unsigned pkbf(float lo, float hi) { const f32x2_t v = {lo, hi}; return __builtin_bit_cast(unsigned, __builtin_convertvector(v, bf2_t)); }
typedef GAS unsigned gu32;
#define WY_RLX __ATOMIC_RELAXED, __HIP_MEMORY_SCOPE_AGENT
constexpr int NJOB = R / 64, NCHUNK = R / 16, NSLOT = 8, ATP = 144, REC = 13056, JOBB = 4 * REC;
static_assert(R % 64 == 0 && CTXN % 64 == 0 && (R / 64) % 2 == 0, "jobs are 64 tokens; the loader is unrolled by two jobs");
constexpr int R_AT = 0, R_RT = 2304, R_BK = 4608, R_VT = 8704, R_AAK = 10752, R_TT = 11264, R_ARBK = 11776, R_WL = 12800;
__device__ __forceinline__ int permj(int j) { return (j >> 5) * 32 + ((j >> 2) & 3) * 8 + ((j >> 4) & 1) * 4 + (j & 3); }
constexpr int C_SLOTS = 3, C_SYNC = C_SLOTS * JOBB;
static_assert(C_SYNC + 64 <= 163840 - 64 && (JOBB / 4) % 16 == 0, "consumer LDS map");
constexpr size_t WS_RING = WS_WB;
constexpr size_t RING_TOTAL = (size_t)32 * NSLOT * JOBB;
constexpr size_t WS_WYF = 256 * 1024 + 16384;
constexpr int WYF_ACK = 32 * NSLOT * 64, WYF_ABORT = WYF_ACK + 32 * 64, WYF_WORDS = WYF_ABORT + 64;
constexpr unsigned SPIN_CAP = 1u << 17;
constexpr int P_A = 0, P_B = 16384, P_KD = 32768, P_LW = 49152, P_IMG = 65536, P_BRM = P_IMG + JOBB, P_KRM = P_BRM + 8192, P_AAB = P_KRM + 8192, P_W2T = P_AAB + 4096, P_A2T = P_W2T + 64 * PITCH * 2, P_END = P_A2T + 64 * PITCH * 2;
constexpr int P_SCR = P_BRM, SCRW = 2 * 8 * PITCH * 2;
constexpr int P_CST = P_IMG;
static_assert(P_END <= 163840 - 64 && P_SCR + 8 * SCRW + 8 * PITCH * 2 <= P_W2T, "wy LDS map");

__device__ __forceinline__ bf16x4 pack4(f32x4 v) { u32x2 r; r.x = pkbf(v[0], v[1]); r.y = pkbf(v[2], v[3]); return __builtin_bit_cast(bf16x4, r); }
__device__ __forceinline__ f32x4 mm(u32x2 a, bf16x4 b, f32x4 c) { return __builtin_amdgcn_mfma_f32_16x16x16bf16_1k(__builtin_bit_cast(bf16x4, a), b, c, 0, 0, 0); }
__device__ __forceinline__ f32x4 mm(u32x2 a, u32x2 b, f32x4 c) { return __builtin_amdgcn_mfma_f32_16x16x16bf16_1k(__builtin_bit_cast(bf16x4, a), __builtin_bit_cast(bf16x4, b), c, 0, 0, 0); }
__device__ __forceinline__ void wait_ge(gu32* word, unsigned want, gu32* abortw, int lane) {
    for (unsigned spins = 0;;) {
        unsigned v = 0u; if (lane == 0) v = __hip_atomic_load(word, WY_RLX);
        if ((unsigned)__builtin_amdgcn_readfirstlane(v) >= want) return;
        __builtin_amdgcn_s_sleep(1);
        if ((++spins & 255u) == 0u) { unsigned a = 0u; if (lane == 0) a = __hip_atomic_load(abortw, WY_RLX);
            if (__builtin_amdgcn_readfirstlane(a)) return;
            if (spins > SPIN_CAP) { if (lane == 0) __hip_atomic_store(abortw, 1u, WY_RLX); return; } }
    }
}

__device__ __forceinline__ void wait_ge4(gu32* words, unsigned want, gu32* abortw, int lane) {
    for (unsigned spins = 0;;) {
        unsigned v = 0xffffffffu; if (lane < 4) v = __hip_atomic_load(words + lane, WY_RLX);
        const unsigned v0 = (unsigned)__builtin_amdgcn_readlane((int)v, 0), v1 = (unsigned)__builtin_amdgcn_readlane((int)v, 1), v2 = (unsigned)__builtin_amdgcn_readlane((int)v, 2), v3 = (unsigned)__builtin_amdgcn_readlane((int)v, 3);
        const unsigned m01 = v0 < v1 ? v0 : v1, m23 = v2 < v3 ? v2 : v3;
        if ((m01 < m23 ? m01 : m23) >= want) return;
        __builtin_amdgcn_s_sleep(1);
        if ((++spins & 255u) == 0u) { unsigned a = 0u; if (lane == 0) a = __hip_atomic_load(abortw, WY_RLX);
            if (__builtin_amdgcn_readfirstlane(a)) return;
            if (spins > SPIN_CAP) { if (lane == 0) __hip_atomic_store(abortw, 1u, WY_RLX); return; } }
    }
}

struct Frag { u32x4 a01, a23, r01, r23, bk[4], arbk; u32x2 vT, aak, tt; f32x4 wl[4]; };

__device__ __forceinline__ void wait_lds_min4(LAS unsigned* w, unsigned want, gu32* abortw, int lane) {
    for (unsigned spins = 0;;) {
        const unsigned a = __hip_atomic_load(w, __ATOMIC_RELAXED, __HIP_MEMORY_SCOPE_WORKGROUP), b = __hip_atomic_load(w + 1, __ATOMIC_RELAXED, __HIP_MEMORY_SCOPE_WORKGROUP),
                       c = __hip_atomic_load(w + 2, __ATOMIC_RELAXED, __HIP_MEMORY_SCOPE_WORKGROUP), d = __hip_atomic_load(w + 3, __ATOMIC_RELAXED, __HIP_MEMORY_SCOPE_WORKGROUP);
        const unsigned m0 = a < b ? a : b, m1 = c < d ? c : d;
        if ((unsigned)__builtin_amdgcn_readfirstlane((int)(m0 < m1 ? m0 : m1)) >= want) return;
        __builtin_amdgcn_s_sleep(1);
        if ((++spins & 1023u) == 0u) { unsigned ab = 0u; if (lane == 0) ab = __hip_atomic_load(abortw, WY_RLX);
            if (__builtin_amdgcn_readfirstlane(ab)) return;
            if (spins > (SPIN_CAP << 3)) { if (lane == 0) __hip_atomic_store(abortw, 1u, WY_RLX); return; } }
    }
}
template <int MODE> __device__ __forceinline__ void loader(const Params& p, int chain, int lw, int lane, LAS unsigned char* lds) {
    gu32* wf = (gu32*)(p.ws + WS_WYF); gu32* flags = wf + chain * NSLOT * 64; gu32* ackw = wf + WYF_ACK + chain * 64; gu32* abortw = wf + WYF_ABORT;
    LAS unsigned* loaded = (LAS unsigned*)(lds + C_SYNC); LAS unsigned* done = loaded + 4;
    const __amdgpu_buffer_rsrc_t ring_rsrc = __builtin_amdgcn_make_buffer_rsrc((void*)(p.ws + WS_RING), 0, (int)RING_TOTAL, 0x00020000);
    constexpr int QB = JOBB / 4, NIT = (QB / 16 + 63) / 64, TAIL = QB / 16 - (NIT - 1) * 64;
    static_assert(NIT == 13, "the counted waits below assume 13 loads per set");
    u32x4 va[NIT], vb[NIT];
#define WY_ISSUE(v, g_) do { if (MODE < 2) wait_ge(flags + ((g_) % NSLOT) * 64, (unsigned)(g_) + 1u, abortw, lane); \
        const int soff = (chain * NSLOT + (g_) % NSLOT) * JOBB + lw * QB + lane * 16; \
        _Pragma("unroll") for (int k = 0; k < NIT; ++k) if (MODE == 0 && (k < NIT - 1 || lane < TAIL)) v[k] = __builtin_amdgcn_raw_buffer_load_b128(ring_rsrc, soff + k * 1024, 0, 16); } while (0)
#define WY_COMMIT(v, g_, WAITSTR) do { \
        if (MODE != 1 && (g_) >= C_SLOTS) { wait_lds_min4(done, (unsigned)((g_) - C_SLOTS + 1), abortw, lane); __builtin_amdgcn_fence(__ATOMIC_ACQUIRE, "workgroup"); }     \
        asm volatile(WAITSTR ::: "memory");                                                     \
        LAS unsigned char* dst = lds + ((g_) % C_SLOTS) * JOBB + lw * QB + lane * 16; \
        _Pragma("unroll") for (int k = 0; k < NIT; ++k) if (MODE == 0 && (k < NIT - 1 || lane < TAIL)) *(LAS u32x4*)(dst + k * 1024) = v[k]; \
        asm volatile("s_waitcnt lgkmcnt(0)" ::: "memory"); \
        __builtin_amdgcn_fence(__ATOMIC_RELEASE, "workgroup"); \
        if (lane == 0) { __hip_atomic_store(ackw + lw, (unsigned)(g_) + 1u, WY_RLX); __hip_atomic_store(loaded + lw, (unsigned)(g_) + 1u, __ATOMIC_RELAXED, __HIP_MEMORY_SCOPE_WORKGROUP); } } while (0)
    WY_ISSUE(va, 0);
    for (int g = 0; g < NJOB; g += 2) {
        WY_ISSUE(vb, g + 1); WY_COMMIT(va, g, "s_waitcnt vmcnt(13)");
        if (g + 2 < NJOB) { WY_ISSUE(va, g + 2); WY_COMMIT(vb, g + 1, "s_waitcnt vmcnt(13)"); } else WY_COMMIT(vb, g + 1, "s_waitcnt vmcnt(0)");
    }
#undef WY_ISSUE
#undef WY_COMMIT
}
__device__ __forceinline__ bf16x8 cat(u32x2 a, u32x2 b) { const u32x4 v = {a.x, a.y, b.x, b.y}; return __builtin_bit_cast(bf16x8, v); }
__device__ __forceinline__ u32x2 pack4u(f32x4 v) { u32x2 r; r.x = pkbf(v[0], v[1]); r.y = pkbf(v[2], v[3]); return r; }
__device__ __forceinline__ f32x4 mm32(bf16x8 a, bf16x8 b, f32x4 c) { return __builtin_amdgcn_mfma_f32_16x16x32_bf16(a, b, c, 0, 0, 0); }
template <int MODE> __device__ __forceinline__ void consumer(const Params& p, int chain, int wave, int lane, LAS unsigned char* lds) {
    const int n = lane & 15, q = lane >> 4, dir = chain >> 4, h = chain & 15;
    gu32* abortw = (gu32*)(p.ws + WS_WYF) + WYF_ABORT;
    LAS unsigned* loaded = (LAS unsigned*)(lds + C_SYNC); LAS unsigned* done = loaded + 4;
    f32x4 S0 = {0.f, 0.f, 0.f, 0.f}, S1 = S0, S2 = S0, S3 = S0;
    const int offA = n * ATP + 16 * q, offB = n * 32 + 8 * q, offW = 16 * q, offS = n * 64 + ((q ^ ((n >> 2) & 3)) * 16);
    const long rstep = dir ? -2048 : 2048;
    bf16_t* yq = ws_br(p) + (size_t)(CTXN + (dir ? SEQ - 1 - 4 * q : 4 * q)) * 2048 + dir * 1024 + h * 64 + 16 * wave + n;
#define WY_LOAD(F, base, k) do { \
        F.a01 = *(const LAS u32x4*)(base + offA + (k) * REC + R_AT); F.a23 = *(const LAS u32x4*)(base + offA + (k) * REC + R_AT + 64); \
        F.r01 = *(const LAS u32x4*)(base + offA + (k) * REC + R_RT); F.r23 = *(const LAS u32x4*)(base + offA + (k) * REC + R_RT + 64); \
        _Pragma("unroll") for (int jt = 0; jt < 4; ++jt) { F.bk[jt] = *(const LAS u32x4*)(base + offS + (k) * REC + R_BK + 1024 * jt); F.wl[jt] = *(const LAS f32x4*)(base + offW + (k) * REC + R_WL + 64 * jt); } \
        F.arbk = *(const LAS u32x4*)(base + offS + (k) * REC + R_ARBK); \
        F.vT = *(const LAS u32x2*)(base + offB + (k) * REC + R_VT + 512 * wave); F.aak = *(const LAS u32x2*)(base + offB + (k) * REC + R_AAK); F.tt = *(const LAS u32x2*)(base + offB + (k) * REC + R_TT); } while (0)
#define WY_Q(v) __builtin_bit_cast(bf16x8, v)
#define WY_COMPUTE(F, cidx) do { const f32x4 z0_ = {0.f, 0.f, 0.f, 0.f}; const u32x2 zz_ = {0u, 0u};     \
        const bf16x8 s01 = cat(pack4u(S0), pack4u(S1)), s23 = cat(pack4u(S2), pack4u(S3)); \
        f32x4 Z = mm32(WY_Q(F.a01), s01, z0_); Z = mm32(WY_Q(F.a23), s23, Z); Z = mm32(cat(F.aak, zz_), cat(F.vT, zz_), Z); \
        f32x4 Y = mm32(WY_Q(F.r01), s01, z0_); Y = mm32(WY_Q(F.r23), s23, Y); \
        const u32x2 zb = pack4u(Z); const f32x4 U = mm32(cat(F.tt, zz_), cat(zb, zz_), z0_); const u32x2 ub = pack4u(U); \
        const bf16x8 vu = cat(F.vT, ub); \
        Y = mm32(WY_Q(F.arbk), vu, Y); \
        S0 = mm32(WY_Q(F.bk[0]), vu, S0); S1 = mm32(WY_Q(F.bk[1]), vu, S1); S2 = mm32(WY_Q(F.bk[2]), vu, S2); S3 = mm32(WY_Q(F.bk[3]), vu, S3); \
        S0 *= F.wl[0]; S1 *= F.wl[1]; S2 *= F.wl[2]; S3 *= F.wl[3]; \
        if (MODE == 0 && (cidx) * 16 >= CTXN) { const unsigned y01 = pkbf(Y[0], Y[1]), y23 = pkbf(Y[2], Y[3]); bf16_t* yp_ = yq + (long)((cidx) * 16 - CTXN) * rstep; \
            *(unsigned short*)yp_ = (unsigned short)(y01 & 0xffffu); *(unsigned short*)(yp_ + rstep) = (unsigned short)(y01 >> 16); \
            *(unsigned short*)(yp_ + 2 * rstep) = (unsigned short)(y23 & 0xffffu); *(unsigned short*)(yp_ + 3 * rstep) = (unsigned short)(y23 >> 16); } } while (0)
    Frag FA, FB;
    wait_lds_min4(loaded, 1u, abortw, lane); __builtin_amdgcn_fence(__ATOMIC_ACQUIRE, "workgroup");
    int slot = 0;
    { const LAS unsigned char* b0 = lds; WY_LOAD(FA, b0, 0); if (MODE == 3) WY_LOAD(FB, b0, 1); }
    for (int g = 0; g < NJOB; ++g) {
        const LAS unsigned char* base = lds + slot * JOBB;
        if (MODE != 3) WY_LOAD(FB, base, 1); WY_COMPUTE(FA, 4 * g);
        if (MODE != 3) WY_LOAD(FA, base, 2); WY_COMPUTE(FB, 4 * g + 1);
        if (MODE != 3) WY_LOAD(FB, base, 3); WY_COMPUTE(FA, 4 * g + 2);
        slot = slot == C_SLOTS - 1 ? 0 : slot + 1;
        if (g + 1 < NJOB) { wait_lds_min4(loaded, (unsigned)g + 2u, abortw, lane); __builtin_amdgcn_fence(__ATOMIC_ACQUIRE, "workgroup");
            const LAS unsigned char* nb = lds + slot * JOBB; if (MODE != 3) WY_LOAD(FA, nb, 0); }
        WY_COMPUTE(FB, 4 * g + 3);
        asm volatile("s_waitcnt lgkmcnt(0)" ::: "memory");
        __builtin_amdgcn_fence(__ATOMIC_RELEASE, "workgroup");
        if (lane == 0) __hip_atomic_store(done + wave, (unsigned)g + 1u, __ATOMIC_RELAXED, __HIP_MEMORY_SCOPE_WORKGROUP);
    }
#undef WY_LOAD
#undef WY_COMPUTE
#undef WY_Q
    if (MODE != 0) asm volatile("" :: "v"(S0), "v"(S1), "v"(S2), "v"(S3));
}

template <int HALF> __device__ __forceinline__ void stage2(LAS unsigned char* lds, LAS unsigned char* img, int ch, int j) {
    LAS unsigned char* rec = img + ch * REC;
    const LAS float* LW = (const LAS float*)(lds + P_LW) + (ch * 16) * 64 + j;
    const LAS float* XA = (const LAS float*)(lds + (HALF ? P_KD : P_A)) + (ch * 16) * 64 + j;
    const LAS float* XB = (const LAS float*)(lds + P_B) + (ch * 16) * 64 + j;
    LAS unsigned short* rowm0 = (LAS unsigned short*)(rec + (HALF ? R_RT : R_AT)) + permj(j);
    LAS unsigned short* rowm1 = (LAS unsigned short*)(lds + (HALF ? P_KRM : P_BRM) + ch * 2048) + permj(j);
    float lw[16], s0[16], s1[16];
#pragma unroll
    for (int t = 0; t < 16; ++t) { lw[t] = LW[t * 64]; s1[t] = HALF ? XA[t * 64] : XB[t * 64];
        if (HALF) s0[t] = __uint_as_float((unsigned)rowm0[t * (ATP / 2)] << 16); else s0[t] = XA[t * 64]; }
    float cum = 0.f, x0p = 0.f, x1p = 0.f; unsigned tp[8];
#pragma unroll
    for (int t = 0; t < 16; ++t) {
        const float cprev = cum; cum += lw[t];
        const float x0 = s0[t] * __builtin_amdgcn_exp2f(HALF ? cum : cprev), x1 = s1[t] * __builtin_amdgcn_exp2f(-cum);
        if (t & 1) { const unsigned p0 = pkbf(x0p, x0), p1 = pkbf(x1p, x1);
            rowm0[(t - 1) * (ATP / 2)] = (unsigned short)(p0 & 0xffffu); rowm0[t * (ATP / 2)] = (unsigned short)(p0 >> 16);
            rowm1[(t - 1) * 64] = (unsigned short)(p1 & 0xffffu); rowm1[t * 64] = (unsigned short)(p1 >> 16);
            tp[t >> 1] = p1; }
        x0p = x0; x1p = x1; }
    { LAS unsigned char* bkr = rec + R_BK + j * 64 + (HALF ? 0 : 8); const int sw = (j >> 2) & 3;
#pragma unroll
      for (int qq = 0; qq < 4; ++qq) *(LAS u32x2*)(bkr + ((qq ^ sw) * 16)) = (u32x2){tp[2 * qq], tp[2 * qq + 1]}; }
    if (HALF) *(LAS float*)(rec + R_WL + j * 4) = __builtin_amdgcn_exp2f(cum);
}

template <int SKIP> __device__ __forceinline__ void producer(const Params& p, int chain, int first, int step, LAS unsigned char* lds) {
    int tid_ = threadIdx.x; asm volatile("" : "+v"(tid_));
    const int tid = tid_, lane = tid & 63, wave = __builtin_amdgcn_readfirstlane(tid >> 6);
    const int dir = chain >> 4, h = chain & 15;
    const float* w0 = dir ? p.w0b : p.w0f; const float* w2 = dir ? p.w2b : p.w2f; const float* a0 = dir ? p.a0b : p.a0f; const float* a2 = dir ? p.a2b : p.a2f;
    const bf16_t* Z = ws_big(p); float* bon = (float*)(p.ws + rw::WS_BON) + ((size_t)dir * 16 + h) * SEQ;
    gu32* wf = (gu32*)(p.ws + WS_WYF); gu32* flags = wf + chain * NSLOT * 64; gu32* ackw = wf + WYF_ACK + chain * 64; gu32* abortw = wf + WYF_ABORT;
    const __amdgpu_buffer_rsrc_t ring_rsrc = __builtin_amdgcn_make_buffer_rsrc((void*)(p.ws + WS_RING), 0, (int)RING_TOTAL, 0x00020000);
    { const int m = tid >> 3, j8 = (tid & 7) * 8;
      const f32x4 wa = *(const f32x4*)(w2 + (size_t)m * 1024 + h * 64 + j8), wb = *(const f32x4*)(w2 + (size_t)m * 1024 + h * 64 + j8 + 4);
      const f32x4 aa = *(const f32x4*)(a2 + (size_t)m * 1024 + h * 64 + j8), ab = *(const f32x4*)(a2 + (size_t)m * 1024 + h * 64 + j8 + 4);
      LAS bf16_t* yw = (LAS bf16_t*)(lds + P_W2T); LAS bf16_t* ya = (LAS bf16_t*)(lds + P_A2T);
#pragma unroll
      for (int qq = 0; qq < 4; ++qq) { yw[(j8 + qq) * PITCH + m] = f2bf(wa[qq]); yw[(j8 + 4 + qq) * PITCH + m] = f2bf(wb[qq]); ya[(j8 + qq) * PITCH + m] = f2bf(aa[qq]); ya[(j8 + 4 + qq) * PITCH + m] = f2bf(ab[qq]); }
      for (int i = tid; i < 320; i += NTHR) { const int gI = i >> 6, cc = i & 63, hc = h * 64 + cc; float v;
          if (gI == 0) v = w0[hc]; else if (gI == 1) v = a0[hc]; else if (gI == 2) v = p.k_k[hc]; else if (gI == 3) v = p.k_a[hc]; else v = p.r_k[hc];
          *(LAS float*)(lds + P_CST + i * 4) = v; } }
    __syncthreads();
    const int tq = lane >> 3, c8 = (lane & 7) * 8, hj = h * 64 + c8, tslot = wave * 8 + tq, ch1 = tslot >> 4, t1 = tslot & 15;
    const int gcol[5] = {hj, 1024 + hj, 2048 + hj, 3072 + dir * 64 + c8, 3200 + dir * 64 + c8};
    f32x4 cw0[2], ca0[2], ckk[2], cka[2], crk[2];
#pragma unroll
    for (int hh = 0; hh < 2; ++hh) {
#define WY_CST(gI) (*(LAS f32x4*)(lds + P_CST + ((gI) * 64 + c8 + 4 * hh) * 4))
        cw0[hh] = WY_CST(0); ca0[hh] = WY_CST(1); ckk[hh] = WY_CST(2); cka[hh] = WY_CST(3); crk[hh] = WY_CST(4);
#undef WY_CST
        asm volatile("" : "+v"(cw0[hh]), "+v"(ca0[hh]), "+v"(ckk[hh]), "+v"(cka[hh]), "+v"(crk[hh])); }
    __syncthreads();
    LAS unsigned char* scr = lds + P_SCR + wave * SCRW;
    LAS unsigned char* img = lds + P_IMG;
    rw::Raw raw;
#define WY_LOADRAW(gj) do { const bf16_t* zr_ = Z + (size_t)rw_row(dir, (gj) * 64 + tslot) * ZW; \
        _Pragma("unroll") for (int g5 = 0; g5 < 5; ++g5) raw.c[g5] = *(const u32x4*)(zr_ + gcol[g5]); } while (0)
    if (first < NJOB) WY_LOADRAW(first);
    for (int g = first; g < NJOB; g += step) {
        const bool latent = g * 64 >= CTXN;
        if (!(SKIP & 1)) { f32x4 rr[2], kv[2];
          { const u32x4 u = raw.c[0]; rr[0] = (f32x4){bflo(u.x), bfhi(u.x), bflo(u.y), bfhi(u.y)}; rr[1] = (f32x4){bflo(u.z), bfhi(u.z), bflo(u.w), bfhi(u.w)};
            LAS unsigned char* rr_ = img + ch1 * REC + R_RT + t1 * ATP + permj(c8) * 2; *(LAS u32x2*)rr_ = (u32x2){u.x, u.y}; *(LAS u32x2*)(rr_ + 16) = (u32x2){u.z, u.w}; }
          { const u32x4 u = raw.c[1]; kv[0] = (f32x4){bflo(u.x), bfhi(u.x), bflo(u.y), bfhi(u.y)}; kv[1] = (f32x4){bflo(u.z), bfhi(u.z), bflo(u.w), bfhi(u.w)}; }
          { const u32x4 u = raw.c[2]; LAS unsigned short* vt = (LAS unsigned short*)(img + ch1 * REC + R_VT) + c8 * 16 + t1;
            vt[0] = (unsigned short)(u.x & 0xffffu); vt[16] = (unsigned short)(u.x >> 16); vt[32] = (unsigned short)(u.y & 0xffffu); vt[48] = (unsigned short)(u.y >> 16);
            vt[64] = (unsigned short)(u.z & 0xffffu); vt[80] = (unsigned short)(u.z >> 16); vt[96] = (unsigned short)(u.w & 0xffffu); vt[112] = (unsigned short)(u.w >> 16); }
          { const u32x4 u = raw.c[3]; u32x4 o;
            o.x = pkbf(rw::fast_tanh(bflo(u.x)), rw::fast_tanh(bfhi(u.x))); o.y = pkbf(rw::fast_tanh(bflo(u.y)), rw::fast_tanh(bfhi(u.y))); o.z = pkbf(rw::fast_tanh(bflo(u.z)), rw::fast_tanh(bfhi(u.z))); o.w = pkbf(rw::fast_tanh(bflo(u.w)), rw::fast_tanh(bfhi(u.w)));
            *(LAS u32x4*)(scr + (tq * PITCH + c8) * 2) = o; *(LAS u32x4*)(scr + 8 * PITCH * 2 + (tq * PITCH + c8) * 2) = raw.c[4]; }
          if (g + step < NJOB) WY_LOADRAW(g + step);
          asm volatile("s_waitcnt lgkmcnt(0)" ::: "memory");
          { const int r16 = lane & 15, quad = lane >> 4; f32x4 acc[2][4];
#pragma unroll
            for (int lora = 0; lora < 2; ++lora) {
                LAS unsigned char* X = scr + lora * 8 * PITCH * 2 + (r16 * PITCH + quad * 8) * 2;
                const bf16x8 x0 = *(LAS bf16x8*)X, x1 = *(LAS bf16x8*)(X + 64);
#pragma unroll
                for (int jt = 0; jt < 4; ++jt) {
                    LAS unsigned char* Y = lds + (lora ? P_A2T : P_W2T) + ((jt * 16 + r16) * PITCH + quad * 8) * 2;
                    acc[lora][jt] = (f32x4){0.f, 0.f, 0.f, 0.f};
                    acc[lora][jt] = __builtin_amdgcn_mfma_f32_16x16x32_bf16(x0, *(LAS bf16x8*)Y, acc[lora][jt], 0, 0, 0);
                    acc[lora][jt] = __builtin_amdgcn_mfma_f32_16x16x32_bf16(x1, *(LAS bf16x8*)(Y + 64), acc[lora][jt], 0, 0, 0); } }
            if (quad < 2) {
#pragma unroll
                for (int lora = 0; lora < 2; ++lora)
#pragma unroll
                    for (int jt = 0; jt < 4; ++jt)
#pragma unroll
                        for (int r = 0; r < 4; ++r) *(LAS float*)(lds + (lora ? P_B : P_LW) + ((wave * 8 + quad * 4 + r) * 64 + jt * 16 + r16) * 4) = acc[lora][jt][r]; } }
          asm volatile("s_waitcnt lgkmcnt(0)" ::: "memory");
          { float bs = 0.f, nn = 0.f; f32x4 kk[2], al[2];
#pragma unroll
            for (int hh = 0; hh < 2; ++hh) { const int off = (tslot * 64 + c8 + 4 * hh) * 4;
                const f32x4 aw = *(LAS f32x4*)(lds + P_LW + off) + cw0[hh], aa = *(LAS f32x4*)(lds + P_B + off) + ca0[hh];
                f32x4 lw;
#pragma unroll
                for (int qq = 0; qq < 4; ++qq) { const float sg = __builtin_amdgcn_rcpf(1.0f + __builtin_amdgcn_exp2f(-1.4426950408889634f * aw[qq]));
                    lw[qq] = -0.8750612633917f * sg; al[hh][qq] = __builtin_amdgcn_rcpf(1.0f + __builtin_amdgcn_exp2f(-1.4426950408889634f * aa[qq])); kk[hh][qq] = kv[hh][qq] * ckk[hh][qq]; nn += kk[hh][qq] * kk[hh][qq]; }
                *(LAS f32x4*)(lds + P_LW + off) = lw; }
            nn = rw::allreduce8(nn);
            const float inv = __builtin_amdgcn_rsqf(fmaxf(nn, 1e-24f));
#pragma unroll
            for (int hh = 0; hh < 2; ++hh) { const int off = (tslot * 64 + c8 + 4 * hh) * 4;
                const f32x4 r = rr[hh];
                f32x4 av, bv, kd;
#pragma unroll
                for (int qq = 0; qq < 4; ++qq) { const float kn = kk[hh][qq] * inv; av[qq] = -kn; bv[qq] = kn * al[hh][qq]; kd[qq] = kv[hh][qq] * (1.0f + (al[hh][qq] - 1.0f) * cka[hh][qq]); bs += r[qq] * kd[qq] * crk[hh][qq]; }
                *(LAS f32x4*)(lds + P_B + off) = bv; *(LAS f32x4*)(lds + P_KD + off) = kd; *(LAS f32x4*)(lds + P_A + off) = av; }
            bs = rw::allreduce8(bs);
            if (latent && (lane & 7) == 0) bon[rw_row(dir, g * 64 + tslot) - CTXN] = bs; } }
        __syncthreads();
        if (!(SKIP & 2)) { if (wave >> 2) stage2<1>(lds, img, wave & 3, lane); else stage2<0>(lds, img, wave & 3, lane); }
        __syncthreads();
        if (!(SKIP & 4)) { const int ch = wave & 3, pair = wave >> 2, n = lane & 15, q = lane >> 4;
          LAS unsigned char* rec = img + ch * REC;
          const LAS unsigned char* Yrm = rec + (pair ? R_RT : R_AT) + n * ATP + 16 * q;
          const LAS unsigned char* Xb = lds + P_BRM + ch * 2048 + n * 128 + 16 * q;
          const LAS unsigned char* Xk = lds + P_KRM + ch * 2048 + n * 128 + 16 * q;
          f32x4 cb = {0.f, 0.f, 0.f, 0.f}, ck = cb;
#pragma unroll
          for (int jt = 0; jt < 4; ++jt) { const int o_ = (jt >> 1) * 64 + (jt & 1) * 8; const u32x2 yb = *(const LAS u32x2*)(Yrm + o_);
              cb = mm(*(const LAS u32x2*)(Xb + o_), yb, cb); ck = mm(*(const LAS u32x2*)(Xk + o_), yb, ck); }
#pragma unroll
          for (int r = 0; r < 4; ++r) { const int s = 4 * q + r; const bool keep = pair ? (s <= n) : (s < n); if (!keep) { cb[r] = 0.f; ck[r] = 0.f; } }
          u32x2 ob, ok; ob.x = pkbf(cb[0], cb[1]); ob.y = pkbf(cb[2], cb[3]); ok.x = pkbf(ck[0], ck[1]); ok.y = pkbf(ck[2], ck[3]);
          if (pair) *(LAS u32x4*)(rec + R_ARBK + n * 64 + ((q ^ ((n >> 2) & 3)) * 16)) = (u32x4){ok.x, ok.y, ob.x, ob.y};
          else {
              *(LAS u32x2*)(rec + R_AAK + n * 32 + 8 * q) = ok;
              LAS float* A2 = (LAS float*)(lds + P_AAB + ch * 1024);
#pragma unroll
              for (int r = 0; r < 4; ++r) A2[n * 16 + r * 4 + q] = cb[r];
              asm volatile("s_waitcnt lgkmcnt(0)" ::: "memory");
              const int c = lane >> 2, pp = lane & 3;
              f32x4 a4[16];
#pragma unroll
              for (int t = 0; t < 16; ++t) a4[t] = *(const LAS f32x4*)(A2 + t * 16 + pp * 4);
              float Tk0 = 0.f, Tk1 = 0.f, Tk2 = 0.f, Tk3 = 0.f, Tprev = 0.f;
              LAS unsigned short* tt = (LAS unsigned short*)(rec + R_TT) + c;
#pragma unroll
              for (int t = 0; t < 16; ++t) {
                  float acc = (a4[t][0] * Tk0 + a4[t][1] * Tk1) + (a4[t][2] * Tk2 + a4[t][3] * Tk3);
                  acc += rw::dppmov<0xB1>(acc); acc += rw::dppmov<0x4E>(acc);
                  const float Tt = acc + ((t == c) ? 1.0f : 0.0f);
                  const bool mine = (t & 3) == pp;
                  if ((t >> 2) == 0) Tk0 = mine ? Tt : Tk0; else if ((t >> 2) == 1) Tk1 = mine ? Tt : Tk1; else if ((t >> 2) == 2) Tk2 = mine ? Tt : Tk2; else Tk3 = mine ? Tt : Tk3;
                  if (t & 1) { const unsigned pk_ = pkbf(Tprev, Tt); if (pp == 0) { tt[(t - 1) * 16] = (unsigned short)(pk_ & 0xffffu); tt[t * 16] = (unsigned short)(pk_ >> 16); } }
                  Tprev = Tt; }
          } }
        if (wave == 0 && g >= NSLOT) wait_ge4(ackw, (unsigned)(g - NSLOT + 1), abortw, lane);
        __syncthreads();
        { const int slot = g % NSLOT; const int base = (chain * NSLOT + slot) * JOBB;
          if (!(SKIP & 8)) for (int i = tid; i < JOBB / 16; i += NTHR) __builtin_amdgcn_raw_buffer_store_b128(*(LAS u32x4*)(img + i * 16), ring_rsrc, base + i * 16, 0, 16);
          asm volatile("s_waitcnt vmcnt(0)" ::: "memory");
          __syncthreads();
          if (tid == 0) __hip_atomic_store(flags + slot * 64, (unsigned)g + 1u, WY_RLX); }
    }
#undef WY_LOADRAW
}

__device__ __forceinline__ void zero_words(const Params& p) {
    int t_ = threadIdx.x; asm volatile("" : "+v"(t_)); unsigned* wf_ = (unsigned*)(p.ws + WS_WYF);
    for (long g = (long)blockIdx.x * NTHR + t_; g < (long)WYF_WORDS; g += (long)gridDim.x * NTHR) wf_[g] = 0u;
}
template <int MODE, int SKIP = 0> __device__ __forceinline__ void phase(const Params& p, LAS unsigned char* lds) {
    const int G = (int)gridDim.x, b = (int)blockIdx.x, nper = (G - 32) / 32;
    if (b < 32) {
        int tid_ = threadIdx.x; asm volatile("" : "+v"(tid_)); const int wave = __builtin_amdgcn_readfirstlane(tid_ >> 6);
        if (tid_ < 8) *(LAS unsigned*)(lds + C_SYNC + 4 * tid_) = 0u;
        __syncthreads();
        if (wave < 4) { if (MODE != 1) consumer<MODE>(p, b, wave, tid_ & 63, lds); } else loader<MODE>(p, b, wave - 4, tid_ & 63, lds);
    }
    else if (MODE < 2) { const int pp = b - 32; if (pp < 32 * nper) producer<SKIP>(p, pp % 32, pp / 32, nper, lds); }
}
}

namespace ret {
using attn::bf16x8; using attn::s16x4; using attn::f32x16; using attn::u32x4;
typedef float f32x4 __attribute__((ext_vector_type(4)));
typedef unsigned u32x2 __attribute__((ext_vector_type(2)));
constexpr int NQ = R / 128;
constexpr size_t SLOT_BYTES = 256 * 128 * 2;
constexpr size_t WS_SCTX = 254 * MiB;
#define RKSWZ(row, colB) ((row) * 256 + ((colB) ^ (((row) & 7) << 4)))
__device__ __forceinline__ bf16_t* slot(const Params& p, int dir, int q, int head) {
    return q >= 2 ? (bf16_t*)((unsigned char*)p.out + (((size_t)dir * (NQ - 2) + (q - 2)) * 4 + head) * SLOT_BYTES)
                  : (bf16_t*)(p.ws + WS_SCTX + (((size_t)dir * 2 + q) * 4 + head) * SLOT_BYTES);
}
__device__ __forceinline__ float log2_sigmoid(float x) { return -1.4426950408889634f * (fmaxf(-x, 0.f) + log1pf(expf(-fabsf(x)))); }
__device__ __forceinline__ bf16x8 scale8(bf16x8 v, float s) {
    u32x4 w = __builtin_bit_cast(u32x4, v), o;
#pragma unroll
    for (int i = 0; i < 4; ++i) o[i] = attn::cvtpk(__uint_as_float(w[i] << 16) * s, __uint_as_float(w[i] & 0xffff0000u) * s);
    return __builtin_bit_cast(bf16x8, o);
}
__device__ __forceinline__ void pk4(const f32x16& P, int base, bf16x8& out) {
    const unsigned a0 = attn::cvtpk(P[base + 0], P[base + 1]), a1 = attn::cvtpk(P[base + 2], P[base + 3]);
    const unsigned b0 = attn::cvtpk(P[base + 4], P[base + 5]), b1 = attn::cvtpk(P[base + 6], P[base + 7]);
    auto r0 = __builtin_amdgcn_permlane32_swap(a0, b0, false, false); auto r1 = __builtin_amdgcn_permlane32_swap(a1, b1, false, false);
    u32x4 w = {r0[0], r1[0], r0[1], r1[1]}; out = __builtin_bit_cast(bf16x8, w);
}
#define RPK(L, H) (bf16x8){L[0], L[1], L[2], L[3], H[0], H[1], H[2], H[3]}

__device__ __forceinline__ void summaries_unit(const Params& p, int q, int h, char* lds) {
    int tid_ = threadIdx.x; asm volatile("" : "+v"(tid_));
    const int tid = tid_, lane = tid & 63, wave = __builtin_amdgcn_readfirstlane(tid >> 6), r32 = lane & 31, hi = lane >> 5;
    const bf16_t* P = ws_big(p) + (size_t)q * 128 * P0W;
    const float lgf = log2_sigmoid(p.dec_f[h]), lgb = log2_sigmoid(p.dec_b[h]);
    const int sr = tid >> 4, sc = (tid & 15) * 8, st0 = attn::v_st(sr, sc), st1 = attn::v_st(32 + sr, sc);
#pragma unroll
    for (int th = 0; th < 2; ++th) {
        const int t0 = th * 64 + sr, t1 = t0 + 32;
        const bf16_t* r0 = P + (size_t)t0 * P0W; const bf16_t* r1 = P + (size_t)t1 * P0W;
#pragma unroll
        for (int eh = 0; eh < 2; ++eh) { char* vt = lds + (th * 2 + eh) * 16384;
            *(bf16x8*)(vt + st0) = *(const bf16x8*)(r0 + C_VA + h * 256 + eh * 128 + sc); *(bf16x8*)(vt + st1) = *(const bf16x8*)(r1 + C_VA + h * 256 + eh * 128 + sc); }
        const bf16x8 k0 = *(const bf16x8*)(r0 + C_KA + h * 128 + sc), k1 = *(const bf16x8*)(r1 + C_KA + h * 128 + sc);
        char* kf = lds + 65536 + th * 16384; char* kb = lds + 98304 + th * 16384;
        *(bf16x8*)(kf + st0) = scale8(k0, __builtin_amdgcn_exp2f((float)(127 - t0) * lgf)); *(bf16x8*)(kf + st1) = scale8(k1, __builtin_amdgcn_exp2f((float)(127 - t1) * lgf));
        *(bf16x8*)(kb + st0) = scale8(k0, __builtin_amdgcn_exp2f((float)t0 * lgb)); *(bf16x8*)(kb + st1) = scale8(k1, __builtin_amdgcn_exp2f((float)t1 * lgb));
    }
    __syncthreads();
    const int lbase = (int)(uintptr_t)lds + attn::v_rd_base(lane);
    f32x16 acc[2][4];
#pragma unroll
    for (int d = 0; d < 2; ++d)
#pragma unroll
        for (int b = 0; b < 4; ++b) acc[d][b] = f32x16{};
#pragma unroll
    for (int th = 0; th < 2; ++th) {
        const int va = lbase + (th * 2 + (wave >> 2)) * 16384 + (wave & 3) * 512, kfb = lbase + 65536 + th * 16384, kbb = lbase + 98304 + th * 16384;
#define R1_STEP(KS) do { \
        const s16x4 al = attn::tr_read<attn::v_rd_off(0, KS, 0)>(va), ah = attn::tr_read<attn::v_rd_off(0, KS, 1)>(va); \
        const s16x4 f0l = attn::tr_read<attn::v_rd_off(0, KS, 0)>(kfb), f0h = attn::tr_read<attn::v_rd_off(0, KS, 1)>(kfb), f1l = attn::tr_read<attn::v_rd_off(1, KS, 0)>(kfb), f1h = attn::tr_read<attn::v_rd_off(1, KS, 1)>(kfb); \
        const s16x4 f2l = attn::tr_read<attn::v_rd_off(2, KS, 0)>(kfb), f2h = attn::tr_read<attn::v_rd_off(2, KS, 1)>(kfb), f3l = attn::tr_read<attn::v_rd_off(3, KS, 0)>(kfb), f3h = attn::tr_read<attn::v_rd_off(3, KS, 1)>(kfb); \
        const s16x4 g0l = attn::tr_read<attn::v_rd_off(0, KS, 0)>(kbb), g0h = attn::tr_read<attn::v_rd_off(0, KS, 1)>(kbb), g1l = attn::tr_read<attn::v_rd_off(1, KS, 0)>(kbb), g1h = attn::tr_read<attn::v_rd_off(1, KS, 1)>(kbb); \
        const s16x4 g2l = attn::tr_read<attn::v_rd_off(2, KS, 0)>(kbb), g2h = attn::tr_read<attn::v_rd_off(2, KS, 1)>(kbb), g3l = attn::tr_read<attn::v_rd_off(3, KS, 0)>(kbb), g3h = attn::tr_read<attn::v_rd_off(3, KS, 1)>(kbb); \
        asm volatile("s_waitcnt lgkmcnt(0)" ::: "memory"); __builtin_amdgcn_sched_barrier(0); \
        const bf16x8 a = RPK(al, ah); \
        acc[0][0] = __builtin_amdgcn_mfma_f32_32x32x16_bf16(a, RPK(f0l, f0h), acc[0][0], 0, 0, 0); acc[0][1] = __builtin_amdgcn_mfma_f32_32x32x16_bf16(a, RPK(f1l, f1h), acc[0][1], 0, 0, 0); \
        acc[0][2] = __builtin_amdgcn_mfma_f32_32x32x16_bf16(a, RPK(f2l, f2h), acc[0][2], 0, 0, 0); acc[0][3] = __builtin_amdgcn_mfma_f32_32x32x16_bf16(a, RPK(f3l, f3h), acc[0][3], 0, 0, 0); \
        acc[1][0] = __builtin_amdgcn_mfma_f32_32x32x16_bf16(a, RPK(g0l, g0h), acc[1][0], 0, 0, 0); acc[1][1] = __builtin_amdgcn_mfma_f32_32x32x16_bf16(a, RPK(g1l, g1h), acc[1][1], 0, 0, 0); \
        acc[1][2] = __builtin_amdgcn_mfma_f32_32x32x16_bf16(a, RPK(g2l, g2h), acc[1][2], 0, 0, 0); acc[1][3] = __builtin_amdgcn_mfma_f32_32x32x16_bf16(a, RPK(g3l, g3h), acc[1][3], 0, 0, 0); \
        __builtin_amdgcn_sched_barrier(0); } while (0)
        R1_STEP(0); R1_STEP(1); R1_STEP(2); R1_STEP(3);
#undef R1_STEP
    }
#pragma unroll
    for (int d = 0; d < 2; ++d) { bf16_t* dst = slot(p, d, q, h);
#pragma unroll
        for (int db = 0; db < 4; ++db)
#pragma unroll
            for (int r = 0; r < 16; ++r) dst[(size_t)(32 * wave + attn::crow(r, hi)) * 128 + 32 * db + r32] = (bf16_t)(attn::cvtpk(acc[d][db][r], 0.f) & 0xffffu); }
    __syncthreads();
}

__device__ __forceinline__ void state_scan(const Params& p) {
    int tid_ = threadIdx.x; asm volatile("" : "+v"(tid_));
    for (long gt = (long)blockIdx.x * NTHR + tid_; gt < 2L * 4 * 16384; gt += (long)gridDim.x * NTHR) {
    const int pair = (int)(gt & 16383), h = (int)((gt >> 14) & 3), dir = (int)(gt >> 16);
    const float G = __builtin_amdgcn_exp2f(128.0f * log2_sigmoid((dir ? p.dec_b : p.dec_f)[h]));
    float s0 = 0.f, s1 = 0.f;
    for (int n = 0; n < NQ; ++n) {
        const int q = dir == 0 ? n : (n < 2 ? 1 - n : NQ + 1 - n);
        unsigned* ptr = (unsigned*)slot(p, dir, q, h) + pair;
        const unsigned u = *ptr;
        *ptr = attn::cvtpk(s0, s1);
        s0 = G * s0 + __uint_as_float(u << 16); s1 = G * s1 + __uint_as_float(u & 0xffff0000u);
    }    }
}

__device__ __forceinline__ void output_unit(const Params& p, int q, int h, char* lds) {
    int tid_ = threadIdx.x; asm volatile("" : "+v"(tid_));
    const int tid = tid_, lane = tid & 63, wave = __builtin_amdgcn_readfirstlane(tid >> 6), r32 = lane & 31, hi = lane >> 5;
    const int ib = wave >> 1, eh = wave & 1;
    const bf16_t* P = ws_big(p) + (size_t)q * 128 * P0W;
    const float lgf = log2_sigmoid(p.dec_f[h]), lgb = log2_sigmoid(p.dec_b[h]);
    { const int sr = tid >> 4, sc = (tid & 15) * 8, st0 = attn::v_st(sr, sc), st1 = attn::v_st(32 + sr, sc);
#pragma unroll
      for (int jt = 0; jt < 2; ++jt) {
          const bf16_t* r0 = P + (size_t)(jt * 64 + sr) * P0W; const bf16_t* r1 = r0 + (size_t)32 * P0W;
          char* kt = lds + jt * 16384;
          *(bf16x8*)(kt + RKSWZ(sr, sc * 2)) = *(const bf16x8*)(r0 + C_KA + h * 128 + sc); *(bf16x8*)(kt + RKSWZ(32 + sr, sc * 2)) = *(const bf16x8*)(r1 + C_KA + h * 128 + sc);
#pragma unroll
          for (int e2 = 0; e2 < 2; ++e2) { char* vt = lds + 32768 + (jt * 2 + e2) * 16384;
              *(bf16x8*)(vt + st0) = *(const bf16x8*)(r0 + C_VA + h * 256 + e2 * 128 + sc); *(bf16x8*)(vt + st1) = *(const bf16x8*)(r1 + C_VA + h * 256 + e2 * 128 + sc); }
      } }
    bf16x8 qr[8];
    { const bf16_t* Qw = P + (size_t)(ib * 32 + r32) * P0W + C_QA + h * 128 + hi * 8;
#pragma unroll
      for (int d0 = 0; d0 < 8; ++d0) qr[d0] = *(const bf16x8*)(Qw + d0 * 16); }
    const bf16_t* Sf = slot(p, 0, q, h) + (size_t)(eh * 128 + r32) * 128 + hi * 8; const bf16_t* Sb = slot(p, 1, q, h) + (size_t)(eh * 128 + r32) * 128 + hi * 8;
    bf16x8 fa[8], fb[8];
#define RET_LOADB(F, S, sb) do { _Pragma("unroll") for (int s_ = 0; s_ < 2; ++s_) _Pragma("unroll") for (int d0 = 0; d0 < 4; ++d0) F[s_ * 4 + d0] = *(const bf16x8*)((S) + (size_t)d0 * 32 * 128 + ((sb) * 2 + s_) * 16); } while (0)
#define RET_MMAB(F, sc, sb) do { _Pragma("unroll") for (int s_ = 0; s_ < 2; ++s_) { const bf16x8 a = scale8(qr[(sb) * 2 + s_], sc); \
        _Pragma("unroll") for (int d0 = 0; d0 < 4; ++d0) o[d0] = __builtin_amdgcn_mfma_f32_32x32x16_bf16(a, F[s_ * 4 + d0], o[d0], 0, 0, 0); } } while (0)
    RET_LOADB(fa, Sf, 0);
    __syncthreads();
    f32x16 o[4] = {};
    const int i_loc = ib * 32 + r32;
    const int vb0 = (int)(uintptr_t)lds + 32768 + attn::v_rd_base(lane);
#pragma unroll
    for (int jt = 0; jt < 2; ++jt) {
        f32x16 p0, p1;
        attn::qkt(p0, p1, (const attn::bf16*)(lds + jt * 16384), qr, r32, hi);
#pragma unroll
        for (int r = 0; r < 16; ++r) {
            const int j0 = jt * 64 + attn::crow(r, hi), dl0 = i_loc - j0, dl1 = dl0 - 32;
            const float m0 = dl0 > 0 ? __builtin_amdgcn_exp2f((float)dl0 * lgf) : (dl0 < 0 ? __builtin_amdgcn_exp2f((float)(-dl0) * lgb) : 2.0f);
            const float m1 = dl1 > 0 ? __builtin_amdgcn_exp2f((float)dl1 * lgf) : (dl1 < 0 ? __builtin_amdgcn_exp2f((float)(-dl1) * lgb) : 2.0f);
            p0[r] *= m0; p1[r] *= m1;
        }
        bf16x8 pa0, pa1, pa2, pa3; pk4(p0, 0, pa0); pk4(p0, 8, pa1); pk4(p1, 0, pa2); pk4(p1, 8, pa3);
        __builtin_amdgcn_sched_barrier(0);
        attn::pv_d0(o, vb0 + (jt * 2 + eh) * 16384, pa0, pa1, pa2, pa3);
    }
    { const float scf = __builtin_amdgcn_exp2f((float)(i_loc + 1) * lgf), scb = __builtin_amdgcn_exp2f((float)(128 - i_loc) * lgb);
      RET_LOADB(fb, Sf, 1); __builtin_amdgcn_sched_barrier(0);
      RET_MMAB(fa, scf, 0); __builtin_amdgcn_sched_barrier(0); RET_LOADB(fa, Sf, 2); __builtin_amdgcn_sched_barrier(0);
      RET_MMAB(fb, scf, 1); __builtin_amdgcn_sched_barrier(0); RET_LOADB(fb, Sf, 3); __builtin_amdgcn_sched_barrier(0);
      RET_MMAB(fa, scf, 2); __builtin_amdgcn_sched_barrier(0); RET_LOADB(fa, Sb, 0); __builtin_amdgcn_sched_barrier(0);
      RET_MMAB(fb, scf, 3); __builtin_amdgcn_sched_barrier(0); RET_LOADB(fb, Sb, 1); __builtin_amdgcn_sched_barrier(0);
      RET_MMAB(fa, scb, 0); __builtin_amdgcn_sched_barrier(0); RET_LOADB(fa, Sb, 2); __builtin_amdgcn_sched_barrier(0);
      RET_MMAB(fb, scb, 1); __builtin_amdgcn_sched_barrier(0); RET_LOADB(fb, Sb, 3); __builtin_amdgcn_sched_barrier(0);
      RET_MMAB(fa, scb, 2); __builtin_amdgcn_sched_barrier(0);
      RET_MMAB(fb, scb, 3); }
#undef RET_LOADB
#undef RET_MMAB
    __syncthreads();
    float* O = (float*)lds;
#pragma unroll
    for (int r = 0; r < 16; ++r)
#pragma unroll
        for (int d0 = 0; d0 < 4; ++d0) O[(ib * 32 + attn::crow(r, hi)) * 256 + eh * 128 + d0 * 32 + r32] = o[d0][r];
    __syncthreads();
    bf16_t* BR = ws_br(p) + (size_t)q * 128 * 2048 + h * 256;
#pragma unroll 4
    for (int rr = 0; rr < 16; ++rr) {
        const int row = wave * 16 + rr; const f32x4 x = *(const f32x4*)(O + row * 256 + lane * 4);
        const float mean = rw::wave_sum((x[0] + x[1]) + (x[2] + x[3])) * (1.0f / 256.f);
        const f32x4 d = x - mean;
        const float var = rw::wave_sum((d[0] * d[0] + d[1] * d[1]) + (d[2] * d[2] + d[3] * d[3])) * (1.0f / 256.f);
        const float rstd = 1.0f / sqrtf(var + NORM_EPS);
        f32x4 y = d * rstd;
        if (q < 2) { const u32x2 gg = *(const u32x2*)((const bf16_t*)(p.ws + 255 * MiB) + (size_t)(q * 128 + row) * 2048 + h * 256 + lane * 4);
            y[0] *= __uint_as_float(gg.x << 16); y[1] *= __uint_as_float(gg.x & 0xffff0000u); y[2] *= __uint_as_float(gg.y << 16); y[3] *= __uint_as_float(gg.y & 0xffff0000u); }
        u32x2 w; w.x = attn::cvtpk(y[0], y[1]); w.y = attn::cvtpk(y[2], y[3]);
        *(u32x2*)(BR + (size_t)row * 2048 + lane * 4) = w;
    }
    __syncthreads();
}
#undef RPK
#undef RKSWZ
}

namespace na {
using attn::bf16x8; using attn::f32x16; using attn::u32x4;
constexpr float L2E = 1.4426950408889634f;
constexpr int WH = GROWS < 8 ? GROWS : 8;
constexpr int L_K = 0, L_V = 32768, L_WS = 65536, L_RPB = L_WS + NWAVES * 64 * 4, L_END = L_RPB + 15 * 31 * 4;
#define NKSWZ(row, colB) ((row) * 256 + ((colB) ^ (((row) & 7) << 4)))
__device__ __forceinline__ int win_r0(int r) { int r0 = r - WH / 2; return r0 < 0 ? 0 : (r0 > GROWS - WH ? GROWS - WH : r0); }
__device__ __forceinline__ int win_c0(int c) { int c0 = c - 8; return c0 < 0 ? 0 : (c0 > GW - 16 ? GW - 16 : c0); }

__device__ __forceinline__ void na_unit(const Params& p, int rg, int h, char* lds) {
    int tid_ = threadIdx.x; asm volatile("" : "+v"(tid_));
    const int tid = tid_, lane = tid & 63, wave = __builtin_amdgcn_readfirstlane(tid >> 6), r32 = lane & 31, hi = lane >> 5;
    const bf16_t* P = ws_big(p); const bf16_t* NAC = (const bf16_t*)(p.ws + 255 * MiB);
    const int r = 4 * rg + (wave >> 1), qc = (wave & 1) * 32 + r32, my_r0 = win_r0(r), my_c0 = win_c0(qc);
    const int lo = win_r0(4 * rg), hiw = win_r0(4 * rg + 3) + WH, NT = hiw - lo + CTXN / 64;
    float* wsf = (float*)(lds + L_WS) + wave * 64; float* rpb_l = (float*)(lds + L_RPB);
    if (tid < 15 * 31) rpb_l[tid] = p.rpb[h * 15 * 31 + tid];
    bf16x8 qr[4];
    { const bf16_t* Qw = P + (size_t)(CTXN + r * 64 + qc) * NAW + h * 64 + hi * 8;
#pragma unroll
      for (int d0 = 0; d0 < 4; ++d0) qr[d0] = *(const bf16x8*)(Qw + d0 * 16); }
    const int sk = tid >> 3, sc = (tid & 7) * 8, kst = NKSWZ(sk, sc * 2), vst = attn::v_st(sk, sc);
    bf16x8 kA, vA, kB, vB;
#define NA_LOAD(KR, VR, t) do { if ((t) < hiw - lo) { const int krow_ = CTXN + (lo + (t)) * 64 + sk; \
            KR = *(const bf16x8*)(P + (size_t)krow_ * NAW + 1024 + h * 64 + sc); VR = *(const bf16x8*)(P + (size_t)krow_ * NAW + 2048 + h * 64 + sc); } \
        else { const bf16_t* c_ = NAC + (size_t)(((t) - (hiw - lo)) * 64 + sk) * 2048 + h * 64 + sc; KR = *(const bf16x8*)c_; VR = *(const bf16x8*)(c_ + 1024); } } while (0)
#define NA_WRITE(KR, VR, b) do { *(bf16x8*)(lds + L_K + (b) * 16384 + kst) = KR; *(bf16x8*)(lds + L_V + (b) * 16384 + vst) = VR; } while (0)
    NA_LOAD(kA, vA, 0); NA_WRITE(kA, vA, 0);
    NA_LOAD(kB, vB, 1);
    __syncthreads();
    float m_reg = -1e30f, l_reg = 0.f; f32x16 o[2] = {};
    const int vb0 = (int)(uintptr_t)lds + L_V + attn::v_rd_base(lane);
#define NA_TILE(t, KW, VW, KL, VL) do { \
        if ((t) + 2 < NT) NA_LOAD(KL, VL, (t) + 2);            \
        const bool is_ctx = (t) >= hiw - lo; const int kr = lo + (t); \
        if (is_ctx || (kr >= my_r0 && kr < my_r0 + WH)) { \
            const char* Ks = lds + L_K + ((t) & 1) * 16384; \
            f32x16 p0 = {}, p1 = {}; \
            _Pragma("unroll") for (int d0 = 0; d0 < 4; ++d0) { const int cb = (d0 * 16 + hi * 8) * 2; \
                const bf16x8 b0 = *(const bf16x8*)(Ks + NKSWZ(r32, cb)), b1 = *(const bf16x8*)(Ks + NKSWZ(32 + r32, cb)); \
                p0 = __builtin_amdgcn_mfma_f32_32x32x16_bf16(b0, qr[d0], p0, 0, 0, 0); p1 = __builtin_amdgcn_mfma_f32_32x32x16_bf16(b1, qr[d0], p1, 0, 0, 0); } \
            if (is_ctx) { \
                _Pragma("unroll") for (int q = 0; q < 16; ++q) { p0[q] *= 0.125f; p1[q] *= 0.125f; } \
            } else { \
                const float* brow = rpb_l + (kr - r + 7) * 31 + 15 - qc; \
                _Pragma("unroll") for (int q = 0; q < 16; ++q) { const int kc0 = attn::crow(q, hi), kc1 = kc0 + 32; \
                    const bool v0 = kc0 >= my_c0 && kc0 < my_c0 + 16, v1 = kc1 >= my_c0 && kc1 < my_c0 + 16; \
                    p0[q] = v0 ? p0[q] * 0.125f + brow[v0 ? kc0 : qc] : -1e30f; p1[q] = v1 ? p1[q] * 0.125f + brow[v1 ? kc1 : qc] : -1e30f; } \
            } \
            float pmax = p0[0]; \
            _Pragma("unroll") for (int q = 1; q < 16; ++q) pmax = fmaxf(pmax, p0[q]); \
            _Pragma("unroll") for (int q = 0; q < 16; ++q) pmax = fmaxf(pmax, p1[q]); \
            { auto rr = __builtin_amdgcn_permlane32_swap(__float_as_uint(pmax), __float_as_uint(pmax), false, false); pmax = fmaxf(__uint_as_float(rr[0]), __uint_as_float(rr[1])); } \
            const float mn = fmaxf(m_reg, pmax), alpha = __builtin_amdgcn_exp2f((m_reg - mn) * L2E), mnl = -mn * L2E; m_reg = mn; \
            float ps = 0.f; \
            _Pragma("unroll") for (int q = 0; q < 16; ++q) { p0[q] = __builtin_amdgcn_exp2f(fmaf(p0[q], L2E, mnl)); p1[q] = __builtin_amdgcn_exp2f(fmaf(p1[q], L2E, mnl)); ps += p0[q] + p1[q]; } \
            { auto rr = __builtin_amdgcn_permlane32_swap(__float_as_uint(ps), __float_as_uint(ps), false, false); ps = __uint_as_float(rr[0]) + __uint_as_float(rr[1]); } \
            l_reg = l_reg * alpha + ps; \
            if (__any(alpha < 1.f)) { if (hi == 0) wsf[r32] = alpha; asm volatile("s_waitcnt lgkmcnt(0)" ::: "memory"); \
                _Pragma("unroll") for (int d = 0; d < 2; ++d) _Pragma("unroll") for (int q = 0; q < 16; ++q) o[d][q] *= wsf[attn::crow(q, hi)]; } \
            bf16x8 pa0, pa1, pa2, pa3; ret::pk4(p0, 0, pa0); ret::pk4(p0, 8, pa1); ret::pk4(p1, 0, pa2); ret::pk4(p1, 8, pa3); \
            __builtin_amdgcn_sched_barrier(0); \
            const int vb = vb0 + ((t) & 1) * 16384; \
            attn::pv_one<0>(o[0], vb, pa0, pa1, pa2, pa3); attn::pv_one<1>(o[1], vb, pa0, pa1, pa2, pa3); \
        } \
        if ((t) + 1 < NT) NA_WRITE(KW, VW, ((t) + 1) & 1);     \
        __syncthreads(); } while (0)
    for (int t = 0; t < NT; t += 2) {
        NA_TILE(t, kB, vB, kA, vA);
        if (t + 1 < NT) NA_TILE(t + 1, kA, vA, kB, vB);
    }
#undef NA_TILE
#undef NA_LOAD
#undef NA_WRITE
    if (hi == 0) wsf[32 + r32] = l_reg; asm volatile("s_waitcnt lgkmcnt(0)" ::: "memory");
    bf16_t* Ow = ws_br(p) + (size_t)(CTXN + r * 64 + (wave & 1) * 32) * 2048 + h * 64;
#pragma unroll
    for (int q = 0; q < 16; ++q) { const int orow = attn::crow(q, hi); const float rl = __builtin_amdgcn_rcpf(wsf[32 + orow]);
#pragma unroll
        for (int d0 = 0; d0 < 2; ++d0) Ow[(size_t)orow * 2048 + d0 * 32 + r32] = (bf16_t)(attn::cvtpk(o[d0][q] * rl, 0.f) & 0xffffu); }
    __syncthreads();
}
#undef NKSWZ
}

namespace el {
typedef float f32x4 __attribute__((ext_vector_type(4)));
typedef unsigned u32x2 __attribute__((ext_vector_type(2)));
__device__ __forceinline__ float wsum(float v) { return rw::wave_sum(v); }
__device__ __forceinline__ unsigned pk(float lo, float hi) { unsigned r; asm volatile("v_cvt_pk_bf16_f32 %0, %1, %2" : "=v"(r) : "v"(lo), "v"(hi)); return r; }

__device__ __forceinline__ void mod_phase(const Params& p, char* lds) {
    int tid_ = threadIdx.x; asm volatile("" : "+v"(tid_));
    const int tid = tid_, ks = tid >> 6, jl = tid & 63;
    float* sc = (float*)lds; float* red = sc + 2048;
    for (int b = blockIdx.x; b < 2 * 48; b += gridDim.x) {
        const int l = b / 48, j = (b % 48) * 64 + jl;
        __syncthreads();
        for (int k = tid; k < 2048; k += NTHR) { const float x = k < 1024 ? p.c[k] : p.c_ctx[k - 1024]; sc[k] = x / (1.0f + __expf(-x)); }
        __syncthreads();
        const float* w = p.w_mod + (size_t)l * DM * 3072 + (size_t)(ks * 128) * 3072 + j; float a0 = 0.f, a1 = 0.f;
#pragma unroll 8
        for (int k = 0; k < 128; ++k) { const float wv = w[(size_t)k * 3072]; a0 += sc[ks * 128 + k] * wv; a1 += sc[1024 + ks * 128 + k] * wv; }
        red[ks * 64 + jl] = a0; red[512 + ks * 64 + jl] = a1;
        __syncthreads();
        if (tid < 128) { const int s = tid >> 6; float t = 0.f;
#pragma unroll
            for (int q = 0; q < 8; ++q) t += red[s * 512 + q * 64 + jl];
            ws_modv(p)[(l * 2 + s) * 3072 + j] = t + p.b_mod[l * 3072 + j]; }
    }
    __syncthreads();
}

template <int LAYER> __device__ __forceinline__ void modnorm_store(const Params& p, const f32x4 (&v)[4], int row, int lane) {
    const float* mv = ws_modv(p) + (LAYER * 2 + (row < CTXN ? 1 : 0)) * 3072; const float* g = p.g_pre + LAYER * DM;
    float ss = 0.f;
#pragma unroll
    for (int j = 0; j < 4; ++j) ss += (v[j][0] * v[j][0] + v[j][1] * v[j][1]) + (v[j][2] * v[j][2] + v[j][3] * v[j][3]);
    const float rstd = 1.0f / sqrtf(wsum(ss) * (1.0f / DM) + NORM_EPS);
    bf16_t* o = ws_xn(p) + (size_t)row * DM;
#pragma unroll
    for (int j = 0; j < 4; ++j) { const int c = lane * 4 + 256 * j;
        const f32x4 gg = *(const f32x4*)(g + c), sh = *(const f32x4*)(mv + c), sc = *(const f32x4*)(mv + 1024 + c);
        const f32x4 y = v[j] * rstd * gg * (sc + 1.0f) + sh;
        u32x2 w; w.x = pk(y[0], y[1]); w.y = pk(y[2], y[3]); *(u32x2*)(o + c) = w; }
}
__device__ __forceinline__ void prenorm0_phase(const Params& p) {
    int tid_ = threadIdx.x; asm volatile("" : "+v"(tid_));
    const int lane = tid_ & 63, gw = (int)blockIdx.x * NWAVES + (tid_ >> 6), ngw = (int)gridDim.x * NWAVES;
    for (int row = gw; row < R; row += ngw) {
        const float* src = row < CTXN ? p.ctx + (size_t)row * DM : p.x + (size_t)(row - CTXN) * DM;
        f32x4 v[4];
#pragma unroll
        for (int j = 0; j < 4; ++j) v[j] = *(const f32x4*)(src + lane * 4 + 256 * j);
        modnorm_store<0>(p, v, row, lane);
    }
}
template <int LAYER> __device__ __forceinline__ void resid_phase(const Params& p) {
    int tid_ = threadIdx.x; asm volatile("" : "+v"(tid_));
    const int lane = tid_ & 63, gw = (int)blockIdx.x * NWAVES + (tid_ >> 6), ngw = (int)gridDim.x * NWAVES;
    for (int row = (LAYER == 0 ? 0 : CTXN) + gw; row < R; row += ngw) {
        const bool ctxsum = LAYER == 0 && row < CTXN;
        const float* y = ctxsum ? (const float*)(p.ws + WS_BIG + 72 * MiB) + (size_t)row * DM : ws_y(p) + (size_t)row * DM; const float* mv = ws_modv(p) + (LAYER * 2 + (row < CTXN ? 1 : 0)) * 3072 + 2048; const float* g = p.g_post + LAYER * DM;
        const float* src; float* dst;
        if (row < CTXN) { src = p.ctx + (size_t)row * DM; dst = ws_ctx1(p) + (size_t)row * DM; }
        else { src = (LAYER == 0 ? p.x : p.out) + (size_t)(row - CTXN) * DM; dst = p.out + (size_t)(row - CTXN) * DM; }
        f32x4 yv[4]; float ss = 0.f;
#pragma unroll
        for (int j = 0; j < 4; ++j) { yv[j] = *(const f32x4*)(y + lane * 4 + 256 * j);
            if (ctxsum) { _Pragma("unroll") for (int s = 1; s < 8; ++s) yv[j] += *(const f32x4*)(y + (size_t)s * CTXN * DM + lane * 4 + 256 * j); }
            ss += (yv[j][0] * yv[j][0] + yv[j][1] * yv[j][1]) + (yv[j][2] * yv[j][2] + yv[j][3] * yv[j][3]); }
        const float rstd = 1.0f / sqrtf(wsum(ss) * (1.0f / DM) + NORM_EPS);
        f32x4 xn[4];
#pragma unroll
        for (int j = 0; j < 4; ++j) { const int c = lane * 4 + 256 * j;
            xn[j] = *(const f32x4*)(src + c) + *(const f32x4*)(mv + c) * (yv[j] * rstd * *(const f32x4*)(g + c));
            *(f32x4*)(dst + c) = xn[j]; }
        if (LAYER == 0) modnorm_store<1>(p, xn, row, lane);
    }
}
__device__ __forceinline__ void ropenorm_phase(const Params& p) {
    int tid_ = threadIdx.x; asm volatile("" : "+v"(tid_));
    const int lane = tid_ & 63, gw = (int)blockIdx.x * NWAVES + (tid_ >> 6), ngw = (int)gridDim.x * NWAVES;
    const float* ct = ws_rope(p); const float* st = ct + N_ROPE;
    const float qn0 = p.q_norm[2 * lane], qn1 = p.q_norm[2 * lane + 1], kn0 = p.k_norm[2 * lane], kn1 = p.k_norm[2 * lane + 1];
    for (int row = gw; row < R; row += ngw) {
        const bool rot = row >= CTXN; const int t = row - CTXN; float cs = 1.f, sn = 0.f;
        if (rot) { const int pos = lane < 32 ? t / GW : t % GW, f = lane & 31; cs = ct[pos * 32 + f]; sn = st[pos * 32 + f]; }
        bf16_t* base = ws_big(p) + (size_t)row * P0W;
#pragma unroll
        for (int slot = 0; slot < 18; ++slot) {
            const int col = slot < 4 ? C_QA + slot * 128 : slot < 8 ? C_KA + (slot - 4) * 128 : slot < 16 ? C_QB + (slot - 8) * 128 : C_KB + (slot - 16) * 128;
            unsigned* ptr = (unsigned*)(base + col) + lane; const unsigned u = *ptr;
            float x1 = __uint_as_float(u << 16), x2 = __uint_as_float(u & 0xffff0000u);
            if (slot >= 4 && slot < 8) { x1 *= 0.08838834764831845f; x2 *= 0.08838834764831845f; }
            if (slot >= 8) { const float sc = 1.0f / sqrtf(wsum(x1 * x1 + x2 * x2) * (1.0f / 128.f) + NORM_EPS);
                x1 *= sc * (slot < 16 ? qn0 : kn0); x2 *= sc * (slot < 16 ? qn1 : kn1); }
            *ptr = pk(x1 * cs - x2 * sn, x1 * sn + x2 * cs);
        }
    }
}
}

constexpr int RING_BYTES = 131072, LDS_BYTES = 163840;
constexpr size_t WS_BAR = 256 * 1024;
constexpr size_t WS_SIDE = 255 * MiB;
constexpr size_t WS_YC = WS_BIG + 72 * MiB;
constexpr int LDS_BARW = LDS_BYTES - 64;
constexpr size_t WB_IN0 = WS_WB, WB_OUT0 = WB_IN0 + (size_t)EVEN_IN * DM * 2, WB_IN1 = WB_OUT0 + (size_t)DM * 2048 * 2, WB_OUT1 = WB_IN1 + (size_t)ODD_IN * DM * 2, WB_END = WB_OUT1 + (size_t)DM * 2048 * 2;
static_assert(WB_END <= WS_XN, "weight copies overflow their region");
static_assert(wy::WS_RING + wy::RING_TOTAL <= WB_IN1 && XCD_BAR_WORDS * 4 <= 16384 && wy::WS_WYF + (size_t)wy::WYF_WORDS * 4 <= WS_CTX1, "rwkv ring / flag words");

__device__ __forceinline__ unsigned pk2(float lo, float hi) { return (unsigned)f2bf(lo) | ((unsigned)f2bf(hi) << 16); }
__device__ __forceinline__ void transpose_item(const float* W, int K, int N, int ldw, bf16_t* WT, LAS float* scr, int item, int lane) {
    const int nblk = N / 32, kb = item / nblk, nb = item % nblk, k0 = 64 * kb, n0 = 32 * nb;
#pragma unroll 8
    for (int i = 0; i < 32; ++i) { const int kk = 2 * i + (lane >> 5); scr[kk * 33 + (lane & 31)] = W[(size_t)(k0 + kk) * ldw + n0 + (lane & 31)]; }
    asm volatile("s_waitcnt lgkmcnt(0)" ::: "memory");
    const int c = lane & 7;
#pragma unroll
    for (int j = 0; j < 4; ++j) { const int n = (lane >> 3) + 8 * j; const LAS float* s = scr + (8 * c) * 33 + n;
        v4u o; o.x = pk2(s[0 * 33], s[1 * 33]); o.y = pk2(s[2 * 33], s[3 * 33]); o.z = pk2(s[4 * 33], s[5 * 33]); o.w = pk2(s[6 * 33], s[7 * 33]);
        *(v4u*)(WT + (size_t)(n0 + n) * K + k0 + 8 * c) = o; }
    asm volatile("s_waitcnt lgkmcnt(0)" ::: "memory");
}
__device__ __forceinline__ void p0_weights(const Params& p, LAS unsigned char* lds) {
    const int lane = threadIdx.x & 63, wave = __builtin_amdgcn_readfirstlane(threadIdx.x >> 6);
    LAS float* scr = (LAS float*)(lds + wave * 16384);
    const int gw = blockIdx.x * NWAVES + wave, NGW = gridDim.x * NWAVES;
    constexpr int I_IN0 = (DM / 64) * (EVEN_IN / 32), I_OUT = (2048 / 64) * (DM / 32), I_IN1 = (DM / 64) * (ODD_IN / 32);
    for (int it = gw; it < I_IN0 + I_OUT + I_IN1 + I_OUT; it += NGW) {
        int r = it;
        if (r < I_IN0) { transpose_item(p.ev_w_in, DM, EVEN_IN, EVEN_IN, (bf16_t*)(p.ws + WB_IN0), scr, r, lane); continue; } r -= I_IN0;
        if (r < I_OUT) { transpose_item(p.ev_w_out, 2048, DM, DM, (bf16_t*)(p.ws + WB_OUT0), scr, r, lane); continue; } r -= I_OUT;
        if (r < I_IN1) { transpose_item(p.od_w_in, DM, ODD_IN, ODD_IN, (bf16_t*)(p.ws + WB_IN1), scr, r, lane); continue; } r -= I_IN1;
        transpose_item(p.od_w_out, 2048, DM, DM, (bf16_t*)(p.ws + WB_OUT1), scr, r, lane);
    }
}

template <class Epi> __device__ __forceinline__ void run_gemm(LAS unsigned char* lds, const bf16_t* A, const bf16_t* Bt, int M, int N, int K, const Epi& E, int rot = 0, int lda = 0, int ldb = 0) {
    const int G = (int)gridDim.x;
    pg8::Gemm g{A, Bt, M, N, K, lda, ldb}; pg8::StaticOrder S; S.init(M, N, G, ((int)blockIdx.x + rot) % G);
    pg8::gemm_phase<Epi, pg8::StaticOrder, true, true>(lds, g, S, E);
}
__device__ __forceinline__ int tail_rot(int units) { const int G = (int)gridDim.x; return (G - units % G) % G; }

#ifndef PROBE
#define PROBE 0
#endif
#define REP(bit) for (int rep_ = 0; rep_ < (((PROBE) >> (bit)) & 1) + 1; ++rep_)
__global__ void __launch_bounds__(NTHR, 2) mega(Params p) {
    extern __shared__ __attribute__((aligned(16))) unsigned char lds_raw[];
    cg::grid_group grid = cg::this_grid();
    LAS unsigned char* lds = (LAS unsigned char*)lds_raw;
    const long gsz = (long)gridDim.x * NTHR;
    if (threadIdx.x < 2) *(LAS unsigned*)(lds + LDS_BARW + 4 * threadIdx.x) = 0u;
    __syncthreads();
    const XcdBarrier xbar = xcd_barrier_post((unsigned*)(p.ws + WS_BAR), (volatile LAS unsigned*)(lds + LDS_BARW));
    const bf16_t* wt_in0 = (const bf16_t*)(p.ws + WB_IN0); const bf16_t* wt_out0 = (const bf16_t*)(p.ws + WB_OUT0);
    const bf16_t* wt_in1 = (const bf16_t*)(p.ws + WB_IN1); const bf16_t* wt_out1 = (const bf16_t*)(p.ws + WB_OUT1);
#define X(fn, n) { int t_ = threadIdx.x; asm volatile("" : "+v"(t_)); for (long g = (long)blockIdx.x * NTHR + t_; g < (long)(n); g += gsz) fn(p, g); }
#define SYNC xcd_barrier(xbar);
    if ((PROBE >> 13) & 1) { for (int i_ = 0; i_ < 20; ++i_) xcd_barrier(xbar); }
    REP(14) { el::mod_phase(p, (char*)lds_raw); X(ph_rope_table, N_ROPE) p0_weights(p, lds);
              if (p.out == nullptr) grid.sync();
              SYNC }
    REP(15) { el::prenorm0_phase(p); SYNC }
    REP(2) { run_gemm(lds, ws_xn(p), wt_in0, R, P0W, DM, pg8::EpiBf16<0>{ws_big(p), P0W, nullptr, 0, 0, 1.f});
             run_gemm(lds, ws_xn(p), wt_in0 + (size_t)C_GA * DM, CTXN, 2048, DM, pg8::EpiSiluBf16{(bf16_t*)(p.ws + WS_SIDE), 2048}, tail_rot((R / 256) * (P0W / 256)));
             SYNC }
    el::ropenorm_phase(p); SYNC
    REP(5) { for (int u = blockIdx.x; u < ret::NQ * 4; u += gridDim.x) { const int q = u < (ret::NQ - 2) * 4 ? 2 + u / 4 : (u - (ret::NQ - 2) * 4) / 4; ret::summaries_unit(p, q, u & 3, (char*)lds_raw); } SYNC }
    ret::state_scan(p); SYNC
    REP(6) { for (int u = blockIdx.x; u < ret::NQ * 4; u += gridDim.x) { const int q = u < (ret::NQ - 2) * 4 ? 2 + u / 4 : (u - (ret::NQ - 2) * 4) / 4; ret::output_unit(p, q, u & 3, (char*)lds_raw); } SYNC }
    REP(0) {
        const int G = (int)gridDim.x, vcu = (G % 8 == 0) ? ((int)blockIdx.x % 8) * (G / 8) + (int)blockIdx.x / 8 : (int)blockIdx.x;
        const int NLAT = (SEQ / 256) * 8, per = (NLAT + G - 1) / G;
        const bf16_t* P = ws_big(p); bf16_t* BR = ws_br(p);
        bool nomax; { int t_ = threadIdx.x; asm volatile("" : "+v"(t_)); const int l_ = t_ & 63; float gq = fmaxf(fabsf(p.q_norm[l_]), fabsf(p.q_norm[64 + l_])), gk = fmaxf(fabsf(p.k_norm[l_]), fabsf(p.k_norm[64 + l_]));
          for (int m_ = 32; m_ >= 1; m_ >>= 1) { gq = fmaxf(gq, __shfl_xor(gq, m_)); gk = fmaxf(gk, __shfl_xor(gk, m_)); }
          nomax = 11.3137085f * 1.4426950409f * 1.02f * gq * gk <= 40.0f; }
        for (int i = 0; i <= per; ++i) {
            int head, row0, seq;
            if (i < per) { const int unit = vcu * per + i; if (unit >= NLAT) continue; const int nqb = SEQ / 256, kv = unit / (4 * nqb), rem = unit % (4 * nqb); head = kv * 4 + rem / nqb; row0 = CTXN + (rem % nqb) * 256; seq = R; }
            else { if (vcu >= 8) break; head = vcu; row0 = 0; seq = CTXN; }
            const int kv = head / 4;
            if (nomax) attn::attn_dense_body<attn::bf16, true>(P + (size_t)row0 * P0W + C_QB + head * 128, P + C_KB + kv * 128, P + C_VB + kv * 128, BR + (size_t)row0 * 2048 + 1024 + head * 128, seq, (char*)lds_raw);
            else attn::attn_dense_body<attn::bf16, false>(P + (size_t)row0 * P0W + C_QB + head * 128, P + C_KB + kv * 128, P + C_VB + kv * 128, BR + (size_t)row0 * 2048 + 1024 + head * 128, seq, (char*)lds_raw);
            __syncthreads();
            if (row0 == 0) {
                int t_ = threadIdx.x; asm volatile("" : "+v"(t_)); const bf16_t* GC = (const bf16_t*)(p.ws + WS_SIDE);
                const size_t o = (size_t)(t_ >> 1) * 2048 + 1024 + head * 128 + (t_ & 1) * 64;
#pragma unroll
                for (int i = 0; i < 8; ++i) { v4u a = *(const v4u*)(BR + o + 8 * i); const v4u b = *(const v4u*)(GC + o + 8 * i);
#pragma unroll
                    for (int q = 0; q < 4; ++q) a[q] = attn::cvtpk(__uint_as_float(a[q] << 16) * __uint_as_float(b[q] << 16), __uint_as_float(a[q] & 0xffff0000u) * __uint_as_float(b[q] & 0xffff0000u));
                    *(v4u*)(BR + o + 8 * i) = a; }
                __syncthreads();
            }
        }
        if (PROBE & 1) xcd_barrier(xbar);
    }
    SYNC
    run_gemm(lds, ws_xn(p) + (size_t)CTXN * DM, wt_in0 + (size_t)C_GA * DM, SEQ, 2048, DM, pg8::EpiGateMul{ws_br(p) + (size_t)CTXN * 2048, 2048});
    {
        pg8::Gemm gk{ws_br(p), wt_out0, 8 * 256, DM, 256, 2048, 2048, 256 * 2}; pg8::StaticOrder S; S.init(8 * 256, DM, (int)gridDim.x, (int)blockIdx.x);
        pg8::gemm_phase<pg8::EpiF32, pg8::StaticOrder, true, true>(lds, gk, S, pg8::EpiF32{(float*)(p.ws + WS_YC), DM}); }
    SYNC
    REP(4) { run_gemm(lds, ws_br(p) + (size_t)CTXN * 2048, wt_out0, SEQ, DM, 2048, pg8::EpiF32{ws_y(p) + (size_t)CTXN * DM, DM}); SYNC }
    REP(15) { el::resid_phase<0>(p); SYNC }
    REP(3) { run_gemm(lds, ws_xn(p), wt_in1 + (size_t)O_RW * DM, R, ZW, DM, pg8::EpiBf16<0>{ws_big(p), ZW, nullptr, 0, 0, 1.f});
             run_gemm(lds, ws_xn(p), wt_in1 + (size_t)(O_NA + 1024) * DM, CTXN, 2048, DM, pg8::EpiBf16<0>{(bf16_t*)(p.ws + WS_SIDE), 2048, nullptr, 0, 0, 1.f}, tail_rot((R / 256) * (ZW / 256)));
             SYNC }
    rw::shift_halo(p); SYNC
    rw::shift_inplace(p); wy::zero_words(p); SYNC
#ifndef PSKIP
#define PSKIP 0
#endif
    if ((PROBE >> 16) & 1) { wy::phase<1, PSKIP>(p, lds); SYNC wy::zero_words(p); SYNC }
    if ((PROBE >> 17) & 1) { wy::phase<2>(p, lds); SYNC wy::zero_words(p); SYNC }
    if ((PROBE >> 18) & 1) { wy::phase<3>(p, lds); SYNC wy::zero_words(p); SYNC }
    if (gridDim.x >= 64) wy::phase<0>(p, lds);
    else { for (int b = blockIdx.x; b < 256; b += gridDim.x) rw::scan_block<0>(p, b, lds); }
    SYNC
    rw::finish_phase(p); SYNC
    REP(3) { run_gemm(lds, ws_xn(p) + (size_t)CTXN * DM, wt_in1 + (size_t)O_NA * DM, SEQ, NAW, DM, pg8::EpiBf16<0>{ws_big(p) + (size_t)CTXN * NAW, NAW, nullptr, 0, 0, 1.f}); SYNC }
    REP(7) { for (int u = blockIdx.x; u < (GROWS / 4) * 16; u += gridDim.x) na::na_unit(p, u >> 4, u & 15, (char*)lds_raw); SYNC }
    run_gemm(lds, ws_xn(p) + (size_t)CTXN * DM, wt_in1 + (size_t)O_GC * DM, SEQ, 2048, DM, pg8::EpiGateMul{ws_br(p) + (size_t)CTXN * 2048, 2048}); SYNC
    REP(4) { run_gemm(lds, ws_br(p) + (size_t)CTXN * 2048, wt_out1, SEQ, DM, 2048, pg8::EpiF32{ws_y(p) + (size_t)CTXN * DM, DM}); SYNC }
    el::resid_phase<1>(p);
#undef X
#undef SYNC
}

extern "C" void kernel_launch(void* const* d_in, const int* in_sizes, int n_in, void* d_out, int out_size, void* d_ws, size_t ws_size, hipStream_t stream) {
    static int grid_blocks = 0;
    if (!grid_blocks) {
        int dev = 0, cus = 0, per_cu = 0;
        (void)hipGetDevice(&dev); (void)hipDeviceGetAttribute(&cus, hipDeviceAttributeMultiprocessorCount, dev);
        (void)hipFuncSetAttribute((const void*)mega, hipFuncAttributeMaxDynamicSharedMemorySize, LDS_BYTES);
        (void)hipOccupancyMaxActiveBlocksPerMultiprocessor(&per_cu, mega, NTHR, LDS_BYTES);
        if (per_cu < 1) per_cu = 1;
        grid_blocks = cus * per_cu;
        if (ws_size < WS_END) fprintf(stderr, "kernel_launch: workspace too small: %zu < %zu\n", ws_size, (size_t)WS_END);
    }
    (void)hipMemsetAsync((char*)d_ws + WS_BAR, 0, XCD_BAR_WORDS * 4, stream);
    Params p = make_params(d_in, d_out, d_ws);
    void* args[] = {&p};
    hipError_t e = hipLaunchCooperativeKernel((void*)mega, dim3(grid_blocks), dim3(NTHR), args, LDS_BYTES, stream);
    if (e != hipSuccess) fprintf(stderr, "cooperative launch failed: %s (grid %d)\n", hipGetErrorString(e), grid_blocks);
}

#else
int main(int argc, char** argv) {
    const char* dir = argc > 1 ? argv[1] : "data";
    char path[512]; snprintf(path, 512, "%s/sizes.txt", dir); FILE* f = fopen(path, "r"); if (!f) { printf("no sizes\n"); return 1; }
    std::vector<long> sizes; long v; while (fscanf(f, "%ld", &v) == 1) sizes.push_back(v); fclose(f);
    if (sizes.size() != 31) { printf("bad n inputs %zu\n", sizes.size()); return 1; }
    snprintf(path, 512, "%s/inputs.bin", dir); f = fopen(path, "rb");
    std::vector<std::vector<float>> in(31); std::vector<void*> ptrs(31);
    for (int i = 0; i < 31; ++i) { in[i].resize(sizes[i]); if (fread(in[i].data(), 4, sizes[i], f) != (size_t)sizes[i]) { printf("short read\n"); return 1; } ptrs[i] = in[i].data(); }
    fclose(f);
    if (sizes[0] != (long)SEQ * DM) { printf("SEQ mismatch: build with -DSEQ_LEN=%ld\n", sizes[0] / DM); return 1; }
    std::vector<float> out((size_t)SEQ * DM, 0.f); std::vector<unsigned char> ws(WS_END, 0xAA);
    Params p = make_params(ptrs.data(), out.data(), ws.data());
    auto check = [&](const char* name, const float* got, size_t n) {
        snprintf(path, 512, "%s/%s", dir, name); FILE* g = fopen(path, "rb"); std::vector<float> ref(n); if (fread(ref.data(), 4, n, g) != n) printf("short ref\n"); fclose(g);
        double num = 0, den = 0, mx = 0; for (size_t i = 0; i < n; ++i) { const double d = (double)got[i] - ref[i]; num += d * d; den += (double)ref[i] * ref[i]; if (fabs(d) > mx) mx = fabs(d); }
        printf("%s: rvr=%.3e absmax=%.3e\n", name, num / den, mx); };
    static RwShared sh;
    int phase = 0;
#define X(fn, n) { printf("phase %d %s n=%ld\n", phase++, #fn, (long)(n)); fflush(stdout); _Pragma("omp parallel for schedule(dynamic, 64)") for (long g = 0; g < (long)(n); ++g) fn(p, g); }
#define SYNC
#define SCAN { printf("phase %d scan\n", phase++); fflush(stdout); _Pragma("omp parallel for schedule(dynamic, 1)") for (int b = 0; b < 32; ++b) { RwShared* s = new RwShared; rwkv_scan_block(p, b, *s); delete s; } }
    X(ph_mod, N_MOD) X(ph_rope_table, N_ROPE) X(ph_prenorm<0>, (long)R) X(ph_gemm_l0_qkv, (long)R * P0W) X(ph_ropenorm, N_ROPENORM) X(ph_ret_scan, N_RETSCAN)
    X(ph_ret_merge, N_RETMERGE) X(ph_gqa_attn, N_GQA) X(ph_gemm_l0_gate, (long)R * 2048) X(ph_gemm_l0_out, (long)R * DM) X(ph_resid<0>, (long)R)
    check("x0.bin", out.data(), out.size()); check("ctx0.bin", ws_ctx1(p), (size_t)CTXN * DM);
    X(ph_prenorm<1>, (long)R) X(ph_gemm_l1_rw, (long)R * ZW) SCAN X(ph_rwkv_finish, N_RWFIN) X(ph_gemm_l1_na, (long)R * NAW) X(ph_na, N_NA)
    X(ph_gemm_l1_gate, (long)SEQ * 2048) X(ph_gemm_l1_out, (long)SEQ * DM) X(ph_resid<1>, (long)SEQ)
    check("out.bin", out.data(), out.size());
    return 0;
}
#endif
```

```cpp
#ifdef CPU_EMU
#include <cstdio>
#include <cstdlib>
#include <cstring>
#include <cmath>
#include <vector>
#define DEV static inline
#else
#include <hip/hip_runtime.h>
#include <hip/hip_cooperative_groups.h>
#include <cstdio>
namespace cg = cooperative_groups;
#define DEV __device__ __forceinline__
#endif

#ifndef SEQ_LEN
#define SEQ_LEN 16384
#endif
typedef unsigned short bf16_t;
constexpr int DM = 1024, CTXN = 256, SEQ = SEQ_LEN, R = CTXN + SEQ, GW = 64, GROWS = SEQ / GW;
constexpr int EVEN_IN = 5632, ODD_IN = 8448;
constexpr int P0W = 3584;
constexpr int C_QA = 0, C_KA = 512, C_VA = 1024, C_QB = 2048, C_KB = 3072, C_VB = 3328, C_GA = 3584;
constexpr int ZW = 3328;
constexpr int O_NA = 0, O_RW = 3072, O_GC = 6400;
constexpr int NAW = 3072;
constexpr float NORM_EPS = 1e-6f, GN_EPS = 64e-5f;

constexpr size_t MiB = 1u << 20;
constexpr size_t WS_MODV = 0;
constexpr size_t WS_ROPE = 64 * 1024;
constexpr size_t WS_CTX1 = 1 * MiB;
constexpr size_t WS_WB = 2 * MiB;
constexpr size_t WS_XN = 42 * MiB;
constexpr size_t WS_BIG = WS_XN + (((size_t)R * DM * 2 + MiB - 1) / MiB) * MiB;
constexpr size_t WS_BR = WS_BIG + (((size_t)R * P0W * 2 + MiB - 1) / MiB) * MiB;
constexpr size_t WS_END = WS_BR + (size_t)R * 2048 * 2;
static_assert(SEQ != 16384 || WS_END <= 256 * MiB, "workspace map exceeds 256 MiB");

struct Params {
    const float *x, *c, *ctx, *c_ctx, *w_mod, *b_mod, *g_pre, *g_post, *ev_w_in, *ev_w_out, *dec_f, *dec_b, *q_norm, *k_norm;
    const float *od_w_in, *od_w_out, *rpb, *mu, *w0f, *w2f, *w0b, *w2b, *a0f, *a2f, *a0b, *a2b, *k_k, *k_a, *r_k, *lnx_g, *lnx_b;
    float* out; unsigned char* ws;
};

DEV bf16_t f2bf(float f) { unsigned u; __builtin_memcpy(&u, &f, 4); u = (u + 0x7fffu + ((u >> 16) & 1u)) >> 16; return (bf16_t)u; }
DEV float bf2f(bf16_t h) { unsigned u = ((unsigned)h) << 16; float f; __builtin_memcpy(&f, &u, 4); return f; }
DEV float siluf(float x) { return x / (1.0f + expf(-x)); }
DEV float sigmf(float x) { return 1.0f / (1.0f + expf(-x)); }
DEV float softplusf(float x) { return fmaxf(x, 0.f) + log1pf(expf(-fabsf(x))); }

DEV float* ws_modv(const Params& p) { return (float*)(p.ws + WS_MODV); }
DEV float* ws_rope(const Params& p) { return (float*)(p.ws + WS_ROPE); }
DEV float* ws_ctx1(const Params& p) { return (float*)(p.ws + WS_CTX1); }
DEV bf16_t* ws_xn(const Params& p) { return (bf16_t*)(p.ws + WS_XN); }
DEV bf16_t* ws_big(const Params& p) { return (bf16_t*)(p.ws + WS_BIG); }
DEV float* ws_y(const Params& p) { return (float*)(p.ws + WS_BIG); }
DEV bf16_t* ws_br(const Params& p) { return (bf16_t*)(p.ws + WS_BR); }

constexpr long N_MOD = 2 * 2 * 3072;
DEV void ph_mod(const Params& p, long gid) {
    const int j = (int)(gid % 3072), s = (int)((gid / 3072) % 2), l = (int)(gid / 6144);
    const float* cv = s ? p.c_ctx : p.c; const float* w = p.w_mod + (size_t)l * DM * 3072 + j;
    float acc = 0.f;
    for (int k = 0; k < DM; ++k) acc += siluf(cv[k]) * w[(size_t)k * 3072];
    ws_modv(p)[gid] = acc + p.b_mod[l * 3072 + j];
}
constexpr long N_ROPE = 256 * 32;
DEV void ph_rope_table(const Params& p, long gid) {
    const int f = (int)(gid % 32), pos = (int)(gid / 32);
    const float inv = powf(10000.0f, -(float)f / 32.0f); const float ang = (float)pos * inv;
    ws_rope(p)[gid] = cosf(ang); ws_rope(p)[N_ROPE + gid] = sinf(ang);
}
template <int LAYER> DEV void ph_prenorm(const Params& p, long gid) {
    const int row = (int)gid; const int s = row < CTXN ? 1 : 0;
    const float* src = row < CTXN ? ((LAYER == 0 ? p.ctx : ws_ctx1(p)) + (size_t)row * DM) : ((LAYER == 0 ? p.x : p.out) + (size_t)(row - CTXN) * DM);
    const float* mv = ws_modv(p) + (LAYER * 2 + s) * 3072; const float* g = p.g_pre + LAYER * DM;
    float ss = 0.f;
    for (int k = 0; k < DM; ++k) ss += src[k] * src[k];
    const float rstd = 1.0f / sqrtf(ss / DM + NORM_EPS);
    bf16_t* o = ws_xn(p) + (size_t)row * DM;
    for (int k = 0; k < DM; ++k) o[k] = f2bf(src[k] * rstd * g[k] * (1.0f + mv[1024 + k]) + mv[k]);
}
template <int MODE> DEV void gemm_item(const bf16_t* A, int K, const float* W, int ldw, void* out, int pitch, int row, int col) {
    const bf16_t* a = A + (size_t)row * K; const float* w = W + col; float acc = 0.f;
    for (int k = 0; k < K; ++k) acc += bf2f(a[k]) * w[(size_t)k * ldw];
    if (MODE == 0) ((bf16_t*)out)[(size_t)row * pitch + col] = f2bf(acc);
    else if (MODE == 1) { bf16_t* o = (bf16_t*)out + (size_t)row * pitch + col; *o = f2bf(siluf(acc) * bf2f(*o)); }
    else ((float*)out)[(size_t)row * pitch + col] = acc;
}
DEV void ph_gemm_l0_qkv(const Params& p, long gid) { gemm_item<0>(ws_xn(p), DM, p.ev_w_in, EVEN_IN, ws_big(p), P0W, (int)(gid / P0W), (int)(gid % P0W)); }
DEV void ph_gemm_l0_gate(const Params& p, long gid) { gemm_item<1>(ws_xn(p), DM, p.ev_w_in + C_GA, EVEN_IN, ws_br(p), 2048, (int)(gid / 2048), (int)(gid % 2048)); }
DEV void ph_gemm_l0_out(const Params& p, long gid) { gemm_item<2>(ws_br(p), 2048, p.ev_w_out, DM, ws_y(p), DM, (int)(gid / DM), (int)(gid % DM)); }
DEV void ph_gemm_l1_rw(const Params& p, long gid) { gemm_item<0>(ws_xn(p), DM, p.od_w_in + O_RW, ODD_IN, ws_big(p), ZW, (int)(gid / ZW), (int)(gid % ZW)); }
DEV void ph_gemm_l1_na(const Params& p, long gid) { gemm_item<0>(ws_xn(p), DM, p.od_w_in + O_NA, ODD_IN, ws_big(p), NAW, (int)(gid / NAW), (int)(gid % NAW)); }
DEV void ph_gemm_l1_gate(const Params& p, long gid) { gemm_item<1>(ws_xn(p), DM, p.od_w_in + O_GC, ODD_IN, ws_br(p), 2048, CTXN + (int)(gid / 2048), (int)(gid % 2048)); }
DEV void ph_gemm_l1_out(const Params& p, long gid) { gemm_item<2>(ws_br(p), 2048, p.od_w_out, DM, ws_y(p), DM, CTXN + (int)(gid / DM), (int)(gid % DM)); }

constexpr long N_ROPENORM = (long)R * 18;
DEV void ph_ropenorm(const Params& p, long gid) {
    const int slot = (int)(gid % 18), row = (int)(gid / 18);
    int col; const float* nw = nullptr; float sc = 1.f;
    if (slot < 4) col = C_QA + slot * 128; else if (slot < 8) { col = C_KA + (slot - 4) * 128; sc = 0.08838834764831845f; }
    else if (slot < 16) { col = C_QB + (slot - 8) * 128; nw = p.q_norm; } else { col = C_KB + (slot - 16) * 128; nw = p.k_norm; }
    bf16_t* v = ws_big(p) + (size_t)row * P0W + col;
    if (nw) { float ss = 0.f; for (int d = 0; d < 128; ++d) { const float t = bf2f(v[d]); ss += t * t; } sc = 1.0f / sqrtf(ss / 128.f + NORM_EPS); }
    const bool rot = row >= CTXN; const int t = row - CTXN; const int gr = rot ? t / GW : 0, gc = rot ? t % GW : 0;
    const float* ct = ws_rope(p); const float* st = ct + N_ROPE;
    for (int i = 0; i < 64; ++i) {
        float x1 = bf2f(v[2 * i]) * sc, x2 = bf2f(v[2 * i + 1]) * sc;
        if (nw) { x1 *= nw[2 * i]; x2 *= nw[2 * i + 1]; }
        if (rot) { const int pos = i < 32 ? gr : gc, f = i & 31; const float cs = ct[pos * 32 + f], sn = st[pos * 32 + f]; const float y1 = x1 * cs - x2 * sn, y2 = x1 * sn + x2 * cs; x1 = y1; x2 = y2; }
        v[2 * i] = f2bf(x1); v[2 * i + 1] = f2bf(x2);
    }
}
constexpr long N_RETSCAN = 2 * 4 * 256;
DEV void ph_ret_scan(const Params& p, long gid) {
    const int e = (int)(gid % 256), h = (int)((gid / 256) % 4), dir = (int)(gid / 1024);
    const float g = sigmf((dir ? p.dec_b : p.dec_f)[h]);
    float S[128];
#pragma unroll
    for (int d = 0; d < 128; ++d) S[d] = 0.f;
    const bf16_t* P = ws_big(p); bf16_t* BR = ws_br(p);
    for (int pos = 0; pos < R; ++pos) {
        int row; if (pos < CTXN) row = dir ? CTXN - 1 - pos : pos; else { const int t = pos - CTXN; row = CTXN + (dir ? SEQ - 1 - t : t); }
        const bf16_t* pr = P + (size_t)row * P0W; const float v = bf2f(pr[C_VA + h * 256 + e]);
        const bf16_t* kq = pr + C_KA + h * 128; const bf16_t* qq = pr + C_QA + h * 128; float y = 0.f;
#pragma unroll
        for (int d = 0; d < 128; ++d) { S[d] = g * S[d] + bf2f(kq[d]) * v; y += bf2f(qq[d]) * S[d]; }
        BR[(size_t)row * 2048 + dir * 1024 + h * 256 + e] = f2bf(y);
    }
}
constexpr long N_RETMERGE = (long)R * 4;
DEV void ph_ret_merge(const Params& p, long gid) {
    const int h = (int)(gid % 4), row = (int)(gid / 4);
    bf16_t* b = ws_br(p) + (size_t)row * 2048 + h * 256;
    float s = 0.f; for (int e = 0; e < 256; ++e) s += bf2f(b[e]) + bf2f(b[1024 + e]);
    const float mean = s / 256.f; float q = 0.f;
    for (int e = 0; e < 256; ++e) { const float d = bf2f(b[e]) + bf2f(b[1024 + e]) - mean; q += d * d; }
    const float rstd = 1.0f / sqrtf(q / 256.f + NORM_EPS);
    for (int e = 0; e < 256; ++e) b[e] = f2bf((bf2f(b[e]) + bf2f(b[1024 + e]) - mean) * rstd);
}
constexpr long N_GQA = (long)R * 8 * 8;
DEV void ph_gqa_attn(const Params& p, long gid) {
    const int sl = (int)(gid % 8), row = (int)((gid / 8) % R), head = (int)(gid / (8L * R)), g = head / 4;
    const bf16_t* P = ws_big(p); const int nk = row < CTXN ? CTXN : R;
    float q[128];
    { const bf16_t* qp = P + (size_t)row * P0W + C_QB + head * 128;
#pragma unroll
      for (int d = 0; d < 128; ++d) q[d] = bf2f(qp[d]) * 0.08838834764831845f; }
    float acc[16];
#pragma unroll
    for (int i = 0; i < 16; ++i) acc[i] = 0.f;
    float m = -1e30f, l = 0.f;
    for (int j = 0; j < nk; ++j) {
        const bf16_t* kp = P + (size_t)j * P0W + C_KB + g * 128; float s = 0.f;
#pragma unroll
        for (int d = 0; d < 128; ++d) s += q[d] * bf2f(kp[d]);
        const float mn = fmaxf(m, s), al = expf(m - mn), pe = expf(s - mn);
        const bf16_t* vp = P + (size_t)j * P0W + C_VB + g * 128 + sl * 16;
        l = l * al + pe;
#pragma unroll
        for (int i = 0; i < 16; ++i) acc[i] = acc[i] * al + pe * bf2f(vp[i]);
        m = mn;
    }
    bf16_t* o = ws_br(p) + (size_t)row * 2048 + 1024 + head * 128 + sl * 16; const float il = 1.0f / l;
#pragma unroll
    for (int i = 0; i < 16; ++i) o[i] = f2bf(acc[i] * il);
}
template <int LAYER> DEV void ph_resid(const Params& p, long gid) {
    const int row = LAYER == 0 ? (int)gid : CTXN + (int)gid; const int s = row < CTXN ? 1 : 0;
    const float* y = ws_y(p) + (size_t)row * DM; const float* mv = ws_modv(p) + (LAYER * 2 + s) * 3072 + 2048; const float* g = p.g_post + LAYER * DM;
    float ss = 0.f; for (int k = 0; k < DM; ++k) ss += y[k] * y[k];
    const float rstd = 1.0f / sqrtf(ss / DM + NORM_EPS);
    const float* src; float* dst;
    if (row < CTXN) { src = p.ctx + (size_t)row * DM; dst = ws_ctx1(p) + (size_t)row * DM; }
    else { src = (LAYER == 0 ? p.x : p.out) + (size_t)(row - CTXN) * DM; dst = p.out + (size_t)(row - CTXN) * DM; }
    for (int k = 0; k < DM; ++k) dst[k] = src[k] + mv[k] * (y[k] * rstd * g[k]);
}
DEV float zshift(const bf16_t* Z, const float* mu, int row, int col) {
    const int lo = row < CTXN ? 0 : CTXN, hi = row < CTXN ? CTXN : R;
    const float z = bf2f(Z[(size_t)row * ZW + col]);
    const float pv = row > lo ? bf2f(Z[(size_t)(row - 1) * ZW + col]) : 0.f, nx = row + 1 < hi ? bf2f(Z[(size_t)(row + 1) * ZW + col]) : 0.f;
    return z + (0.5f * (pv + nx) - z) * mu[col];
}
constexpr long N_RWFIN = (long)SEQ * 16;
DEV void ph_rwkv_finish(const Params& p, long gid) {
    const int h = (int)(gid % 16), t = (int)(gid / 16), row = CTXN + t;
    const bf16_t* Z = ws_big(p); bf16_t* b = ws_br(p) + (size_t)row * 2048;
    float bon[2];
    for (int d = 0; d < 2; ++d) {
        const float* a0 = d ? p.a0b : p.a0f; const float* a2 = d ? p.a2b : p.a2f;
        float s = 0.f;
        for (int j = 0; j < 64; ++j) { const int hj = h * 64 + j; float acc = a0[hj];
            for (int m = 0; m < 64; ++m) acc += zshift(Z, p.mu, row, 3200 + d * 64 + m) * a2[m * 1024 + hj];
            const float al = sigmf(acc); const float r = zshift(Z, p.mu, row, hj), k = zshift(Z, p.mu, row, 1024 + hj);
            s += r * (k * (1.0f + (al - 1.0f) * p.k_a[hj])) * p.r_k[hj]; }
        bon[d] = s;
    }
    float sm = 0.f; for (int i = 0; i < 64; ++i) sm += bf2f(b[h * 64 + i]) + bf2f(b[1024 + h * 64 + i]);
    const float mean = sm / 64.f; float q = 0.f;
    for (int i = 0; i < 64; ++i) { const float d = bf2f(b[h * 64 + i]) + bf2f(b[1024 + h * 64 + i]) - mean; q += d * d; }
    const float rstd = 1.0f / sqrtf(q / 64.f + GN_EPS);
    for (int i = 0; i < 64; ++i) { const int hi = h * 64 + i; const float w = bf2f(b[hi]) + bf2f(b[1024 + hi]);
        const float v = zshift(Z, p.mu, row, 2048 + hi);
        b[1024 + hi] = f2bf((w - mean) * rstd * p.lnx_g[hi] + p.lnx_b[hi] + (bon[0] + bon[1]) * v); }
}
constexpr long N_NA = (long)SEQ * 16;
DEV void ph_na(const Params& p, long gid) {
    const int h = (int)(gid % 16), t = (int)(gid / 16), r = t / GW, c = t % GW;
    const bf16_t* P = ws_big(p);
    float q[64];
    { const bf16_t* qp = P + (size_t)(CTXN + t) * NAW + h * 64;
#pragma unroll
      for (int d = 0; d < 64; ++d) q[d] = bf2f(qp[d]) * 0.125f; }
    float acc[64];
#pragma unroll
    for (int d = 0; d < 64; ++d) acc[d] = 0.f;
    float m = -1e30f, l = 0.f;
    const int wh = GROWS < 8 ? GROWS : 8;
    int r0 = r - wh / 2; r0 = r0 < 0 ? 0 : (r0 > GROWS - wh ? GROWS - wh : r0);
    int c0 = c - 8; c0 = c0 < 0 ? 0 : (c0 > GW - 16 ? GW - 16 : c0);
    const float* rp = p.rpb + h * 15 * 31;
    for (int kk = 0; kk < wh * 16 + CTXN; ++kk) {
        int krow; float bias = 0.f;
        if (kk < wh * 16) { const int i = kk / 16, j = kk % 16; krow = CTXN + (r0 + i) * GW + c0 + j; bias = rp[(r0 + i - r + 7) * 31 + (c0 + j - c + 15)]; }
        else krow = kk - wh * 16;
        const bf16_t* kp = P + (size_t)krow * NAW + 1024 + h * 64; float s = bias;
#pragma unroll
        for (int d = 0; d < 64; ++d) s += q[d] * bf2f(kp[d]);
        const float mn = fmaxf(m, s), al = expf(m - mn), pe = expf(s - mn);
        const bf16_t* vp = P + (size_t)krow * NAW + 2048 + h * 64;
        l = l * al + pe;
#pragma unroll
        for (int d = 0; d < 64; ++d) acc[d] = acc[d] * al + pe * bf2f(vp[d]);
        m = mn;
    }
    bf16_t* o = ws_br(p) + (size_t)(CTXN + t) * 2048 + h * 64; const float il = 1.0f / l;
#pragma unroll
    for (int d = 0; d < 64; ++d) o[d] = f2bf(acc[d] * il);
}

constexpr int RW_CH = 16;
struct RwShared { float r[RW_CH][64], w[RW_CH][64], kd[RW_CH][64], v[RW_CH][64], a[RW_CH][64], b[RW_CH][64], tz[RW_CH][64], za[RW_CH][64], kk[RW_CH][64]; };
#ifdef CPU_EMU
#define FOR_THREADS(tid) for (int tid = 0; tid < 64; ++tid)
#define BLOCK_SYNC()
#define TSTATE(tid) S_all[tid]
#else
#define FOR_THREADS(tid) const int tid = threadIdx.x; if (tid < 64)
#define BLOCK_SYNC() __syncthreads()
#define TSTATE(tid) S_reg
#endif
DEV int rw_row(int dir, int pos) { if (pos < CTXN) return dir ? CTXN - 1 - pos : pos; const int t = pos - CTXN; return CTXN + (dir ? SEQ - 1 - t : t); }
#ifdef CPU_EMU
static void rwkv_scan_block(const Params& p, int blk, RwShared& sh) {
    static thread_local float S_all[64][64];
    for (int i = 0; i < 64; ++i) for (int j = 0; j < 64; ++j) S_all[i][j] = 0.f;
#else
__device__ void rwkv_scan_block(const Params& p, int blk, RwShared& sh) {
    float S_reg[64];
#pragma unroll
    for (int j = 0; j < 64; ++j) S_reg[j] = 0.f;
#endif
    const int dir = blk / 16, h = blk % 16;
    const float* w0 = dir ? p.w0b : p.w0f; const float* w2 = dir ? p.w2b : p.w2f; const float* a0 = dir ? p.a0b : p.a0f; const float* a2 = dir ? p.a2b : p.a2f;
    const bf16_t* Z = ws_big(p); bf16_t* BR = ws_br(p);
    for (int p0 = 0; p0 < R; p0 += RW_CH) {
        { FOR_THREADS(tid) { const int hj = h * 64 + tid;
            for (int tt = 0; tt < RW_CH; ++tt) { const int row = rw_row(dir, p0 + tt);
                sh.tz[tt][tid] = tanhf(zshift(Z, p.mu, row, 3072 + dir * 64 + tid)); sh.za[tt][tid] = zshift(Z, p.mu, row, 3200 + dir * 64 + tid);
                sh.r[tt][tid] = zshift(Z, p.mu, row, hj); sh.v[tt][tid] = zshift(Z, p.mu, row, 2048 + hj);
                const float k = zshift(Z, p.mu, row, 1024 + hj); sh.kd[tt][tid] = k; sh.kk[tt][tid] = k * p.k_k[hj]; } } }
        BLOCK_SYNC();
        { FOR_THREADS(tid) { const int hj = h * 64 + tid;
            for (int tt = 0; tt < RW_CH; ++tt) { float aw = w0[hj], aa = a0[hj], nn = 0.f;
                for (int m = 0; m < 64; ++m) { aw += sh.tz[tt][m] * w2[m * 1024 + hj]; aa += sh.za[tt][m] * a2[m * 1024 + hj]; nn += sh.kk[tt][m] * sh.kk[tt][m]; }
                const float lw = -softplusf(-aw) - 0.5f; const float al = sigmf(aa);
                const float kkn = sh.kk[tt][tid] / fmaxf(sqrtf(nn), 1e-12f);
                sh.w[tt][tid] = expf(-expf(lw)); sh.a[tt][tid] = -kkn; sh.b[tt][tid] = kkn * al;
                sh.kd[tt][tid] = sh.kd[tt][tid] * (1.0f + (al - 1.0f) * p.k_a[hj]); } } }
        BLOCK_SYNC();
        { FOR_THREADS(tid) { float* S = TSTATE(tid);
            for (int tt = 0; tt < RW_CH; ++tt) { float sa = 0.f;
#pragma unroll
                for (int j = 0; j < 64; ++j) sa += S[j] * sh.a[tt][j];
                const float vi = sh.v[tt][tid]; float y = 0.f;
#pragma unroll
                for (int j = 0; j < 64; ++j) { S[j] = S[j] * sh.w[tt][j] + sa * sh.b[tt][j] + vi * sh.kd[tt][j]; y += S[j] * sh.r[tt][j]; }
                if (p0 >= CTXN) BR[(size_t)rw_row(dir, p0 + tt) * 2048 + dir * 1024 + h * 64 + tid] = f2bf(y); } } }
        BLOCK_SYNC();
    }
}

static Params make_params(void* const* d_in, void* d_out, void* d_ws) {
    Params p{};
    const float** f = (const float**)&p;
    for (int i = 0; i < 31; ++i) f[i] = (const float*)d_in[i];
    p.out = (float*)d_out; p.ws = (unsigned char*)d_ws; return p;
}


#ifndef CPU_EMU
#define LAS __attribute__((address_space(3)))
#define GAS __attribute__((address_space(1)))
typedef unsigned v4u __attribute__((ext_vector_type(4)));
constexpr int NWAVES = 8, NTHR = NWAVES * 64;
#ifndef PROBE
#define PROBE 0
#endif
#define XB_TMO      128
#define XB_XCNT(j)  (256  + 64 * (j))
#define XB_XSUB(j)  (1280 + 64 * (j))
#define XB_XGEN(j)  (2304 + 64 * (j))
#define XB_TOP      3328
#define XB_TOPGEN   3392
#define XCD_BAR_WORDS 3456
#define XB_SPIN_CAP (1u << 18)

__device__ __forceinline__ unsigned xb_ld(unsigned* p)              { return __hip_atomic_load(p, __ATOMIC_RELAXED, __HIP_MEMORY_SCOPE_AGENT); }
__device__ __forceinline__ unsigned xb_add(unsigned* p, unsigned v) { return __hip_atomic_fetch_add(p, v, __ATOMIC_RELAXED, __HIP_MEMORY_SCOPE_AGENT); }
__device__ __forceinline__ unsigned xb_xcc_id() { return (unsigned)__builtin_amdgcn_s_getreg((3 << 11) | 20) & 0xFu; }
#define XB_SPIN(cond, bar) do { unsigned _sp = 0; while (cond) { __builtin_amdgcn_s_sleep(1); \
    if ((++_sp & 255u) == 0u) { if (xb_ld(&(bar)[XB_TMO])) break; if (_sp > XB_SPIN_CAP) { atomicAdd(&(bar)[XB_TMO], 1u); break; } } } } while (0)

struct XcdBarrier {
    unsigned* bar; unsigned x;
    volatile LAS unsigned* st;
};

__device__ __forceinline__ XcdBarrier xcd_barrier_post(unsigned* bar, volatile LAS unsigned* st) {
    XcdBarrier b; b.bar = bar; b.x = xb_xcc_id(); b.st = st;
    if (threadIdx.x == 0) (void)xb_add(&bar[XB_XCNT(b.x)], 1u);
    return b;
}
__device__ __forceinline__ void xcd_barrier_complete(unsigned* bar, unsigned x, unsigned& nloc, unsigned& nx) {
    const unsigned G = gridDim.x * gridDim.y * gridDim.z;
    unsigned sum, cnt, mine, sp = 0u;
    for (;;) {
        sum = 0u; cnt = 0u; mine = 0u;
#pragma unroll
        for (unsigned j = 0; j < 16; ++j) { const unsigned c = xb_ld(&bar[XB_XCNT(j)]); sum += c; cnt += (c > 0u) ? 1u : 0u; mine = (j == x) ? c : mine; }
        if (sum == G) break;
        __builtin_amdgcn_s_sleep(1);
        if ((++sp & 255u) == 0u) { if (xb_ld(&bar[XB_TMO])) break; if (sp > XB_SPIN_CAP) { atomicAdd(&bar[XB_TMO], 1u); break; } }
    }
    nloc = mine > 0u ? mine : 1u; nx = cnt > 0u ? cnt : 1u;
}

__device__ __forceinline__ void xcd_barrier(const XcdBarrier& b) {
    asm volatile("s_waitcnt vmcnt(0)" ::: "memory");
    __syncthreads();
    if (threadIdx.x == 0) {
        unsigned* bar = b.bar;
        __builtin_amdgcn_s_waitcnt(0);
        unsigned nloc = b.st[0], nx = b.st[1];
        if (nloc == 0u) { xcd_barrier_complete(bar, b.x, nloc, nx); b.st[0] = nloc; b.st[1] = nx; }
        const unsigned old = xb_add(&bar[XB_XSUB(b.x)], 1u);
        const unsigned gen = old / nloc;
        if (old + 1u == (gen + 1u) * nloc) {
            __builtin_amdgcn_fence(__ATOMIC_RELEASE, "agent");
            asm volatile("s_waitcnt vmcnt(0)" ::: "memory");
            const unsigned og = xb_add(&bar[XB_TOP], 1u);
            const unsigned tg = og / nx;
            if (og + 1u == (tg + 1u) * nx) xb_add(&bar[XB_TOPGEN], 1u);
            else XB_SPIN(xb_ld(&bar[XB_TOPGEN]) == tg, bar);
            __builtin_amdgcn_fence(__ATOMIC_ACQUIRE, "agent");
            xb_add(&bar[XB_XGEN(b.x)], 1u);
            asm volatile("s_waitcnt vmcnt(0)" ::: "memory");
        } else {
            XB_SPIN(xb_ld(&bar[XB_XGEN(b.x)]) == gen, bar);
            __builtin_amdgcn_fence(__ATOMIC_ACQUIRE, "agent");
            asm volatile("s_waitcnt vmcnt(0)" ::: "memory");
        }
    }
    __syncthreads();
}
namespace pg8 {
#define PG8_LAS __attribute__((address_space(3)))
typedef unsigned short bf16_t;
typedef short bf16x8 __attribute__((ext_vector_type(8)));
typedef float f32x4 __attribute__((ext_vector_type(4)));
typedef unsigned u32x4 __attribute__((ext_vector_type(4)));
constexpr int BM = 256, BK = 64, HALF = 128, HTB = HALF * BK * 2  , STAGE_BYTES = 8 * HTB, NXCD = 8, WGM = 8;

__host__ __device__ __forceinline__ int lds_byte(int r, int c) { const int st = (r >> 4) * 2 + (c >> 5), rr = r & 15, cc = c & 31, ob = rr * 64 + cc * 2; return st * 1024 + (ob ^ (((ob >> 9) & 1) << 5)); }
__host__ __device__ __forceinline__ void stage_rc(int b, int& R, int& C) { const int st = b / 1024, sb = b % 1024, swz = sb ^ (((sb >> 9) & 1) << 5); R = (st >> 1) * 16 + swz / 64; C = (st & 1) * 32 + (swz % 64) / 2; }
__host__ __device__ __forceinline__ int perm32(int rho) { const int n = rho >> 4, i = rho & 15; return 8 * (i >> 2) + 4 * n + (i & 3); }

struct Unit { int pm, pn; };
struct Gemm { const bf16_t* A; const bf16_t* Bt; int M, N, K; int lda = 0, ldb = 0; int ksl = 0; };

struct StaticOrder {
    int nM, nN, nwg, G, c;
    __host__ __device__ void init(int M, int N, int G_, int c_) { nM = M / BM; nN = N / BM; nwg = nM * nN; G = G_; c = c_; }
    __host__ __device__ bool next(int i, Unit& u) const {
        const long L = (long)i * G + c; if (L >= nwg) return false;
        int wgid = (int)L; { const int q = nwg / NXCD, r = nwg % NXCD, xcd = wgid % NXCD, off = wgid / NXCD; wgid = (xcd < r ? xcd * (q + 1) : r * (q + 1) + (xcd - r) * q) + off; }
        const int nig = WGM * nN, gid = wgid / nig, fm = gid * WGM, gsz = (nM - fm) < WGM ? (nM - fm) : WGM;
        u.pm = fm + ((wgid % nig) % gsz); u.pn = (wgid % nig) / gsz; return true;
    }
    __device__ __forceinline__ void a_ready(const Unit&) const {}
    __device__ __forceinline__ void done(const Unit&) const {}
};

__device__ __forceinline__ unsigned cvt_pk_bf16(float lo, float hi) { unsigned r; asm volatile("v_cvt_pk_bf16_f32 %0, %1, %2" : "=v"(r) : "v"(lo), "v"(hi)); return r; }
typedef float f32x2 __attribute__((ext_vector_type(2)));
__device__ __forceinline__ f32x2 gelu_pk(f32x2 v) {
    const f32x2 av = __builtin_elementwise_abs(v), d = av * 0.2316418882f + 1.0f;
    f32x2 t; t.x = __builtin_amdgcn_rcpf(d.x); t.y = __builtin_amdgcn_rcpf(d.y);
    f32x2 q = t * 0.5307027145f + (-0.7265760135f); q = q * t + 0.7107068705f; q = q * t + (-0.142248368f); q = q * t + 0.127414796f; q = q * t;
    const f32x2 s = (v * v) * (-0.72134752044f);
    f32x2 e; e.x = __builtin_amdgcn_exp2f(s.x); e.y = __builtin_amdgcn_exp2f(s.y);
    const f32x2 m = v * (q * e), r = v - m;
    f32x2 o; o.x = v.x < 0.f ? m.x : r.x; o.y = v.y < 0.f ? m.y : r.y; return o;
}

template <int ACT  > struct EpiBf16 {
    static constexpr bool PERM = true, AFTER_DRAIN = false; static_assert(ACT == 0 || ACT == 1, "EpiBf16: ACT is 0 (none) or 1 (gelu_pk)");
    bf16_t* O; int ldc; const float* bias; int split_cols; size_t split_stride; float scale0;
    __device__ __forceinline__ void operator()(const f32x4 (&acc)[2][2][4][2], const Unit& u, int wr, int wc, int fr, int fq) const {
        const int row0 = u.pm * BM + wr * 64 + fr; int colt = u.pn * BM; bf16_t* base = O;
        float sc = 1.f; if (split_cols) { const int t = colt / split_cols; base += (size_t)t * split_stride; colt -= t * split_cols; if (t == 0) sc = scale0; }
        const int col0 = colt + wc * 32 + 8 * fq, bcol0 = u.pn * BM + wc * 32 + 8 * fq;
        f32x4 bv[2][2];
#pragma unroll
        for (int bj = 0; bj < 2; ++bj)
#pragma unroll
            for (int n = 0; n < 2; ++n) bv[bj][n] = bias ? *(const f32x4*)(bias + bcol0 + bj * HALF + 4 * n) : (f32x4){0.f, 0.f, 0.f, 0.f};
#pragma unroll
        for (int ai = 0; ai < 2; ++ai)
#pragma unroll
            for (int m = 0; m < 4; ++m) { bf16_t* rowp = base + (size_t)(row0 + ai * HALF + m * 16) * ldc + col0;
#pragma unroll
                for (int bj = 0; bj < 2; ++bj) { f32x4 v0 = acc[ai][bj][m][0] + bv[bj][0], v1 = acc[ai][bj][m][1] + bv[bj][1];
                    if (ACT == 1) { f32x2 a = gelu_pk((f32x2){v0[0], v0[1]}), b = gelu_pk((f32x2){v0[2], v0[3]}), c = gelu_pk((f32x2){v1[0], v1[1]}), d = gelu_pk((f32x2){v1[2], v1[3]});
                        v0 = (f32x4){a.x, a.y, b.x, b.y}; v1 = (f32x4){c.x, c.y, d.x, d.y}; }
                    v0 = v0 * sc; v1 = v1 * sc; u32x4 w; w.x = cvt_pk_bf16(v0[0], v0[1]); w.y = cvt_pk_bf16(v0[2], v0[3]); w.z = cvt_pk_bf16(v1[0], v1[1]); w.w = cvt_pk_bf16(v1[2], v1[3]);
                    *(u32x4*)(rowp + bj * HALF) = w; } }
    }
};

__device__ __forceinline__ float silu_fast(float v) { return v * __builtin_amdgcn_rcpf(1.0f + __builtin_amdgcn_exp2f(-1.4426950408889634f * v)); }
struct EpiGateMul {
    static constexpr bool PERM = true, AFTER_DRAIN = false;
    bf16_t* O; int ldc;
    __device__ __forceinline__ void operator()(const f32x4 (&acc)[2][2][4][2], const Unit& u, int wr, int wc, int fr, int fq) const {
        const int row0 = u.pm * BM + wr * 64 + fr, col0 = u.pn * BM + wc * 32 + 8 * fq;
#pragma unroll
        for (int ai = 0; ai < 2; ++ai)
#pragma unroll
            for (int m = 0; m < 4; ++m) { bf16_t* rowp = O + (size_t)(row0 + ai * HALF + m * 16) * ldc + col0;
#pragma unroll
                for (int bj = 0; bj < 2; ++bj) { const u32x4 old = *(const u32x4*)(rowp + bj * HALF); const f32x4 v0 = acc[ai][bj][m][0], v1 = acc[ai][bj][m][1];
                    u32x4 w;
                    w.x = cvt_pk_bf16(silu_fast(v0[0]) * __uint_as_float(old.x << 16), silu_fast(v0[1]) * __uint_as_float(old.x & 0xffff0000u));
                    w.y = cvt_pk_bf16(silu_fast(v0[2]) * __uint_as_float(old.y << 16), silu_fast(v0[3]) * __uint_as_float(old.y & 0xffff0000u));
                    w.z = cvt_pk_bf16(silu_fast(v1[0]) * __uint_as_float(old.z << 16), silu_fast(v1[1]) * __uint_as_float(old.z & 0xffff0000u));
                    w.w = cvt_pk_bf16(silu_fast(v1[2]) * __uint_as_float(old.w << 16), silu_fast(v1[3]) * __uint_as_float(old.w & 0xffff0000u));
                    *(u32x4*)(rowp + bj * HALF) = w; } }
    }
};
struct EpiSiluBf16 {
    static constexpr bool PERM = true, AFTER_DRAIN = false;
    bf16_t* O; int ldc;
    __device__ __forceinline__ void operator()(const f32x4 (&acc)[2][2][4][2], const Unit& u, int wr, int wc, int fr, int fq) const {
        const int row0 = u.pm * BM + wr * 64 + fr, col0 = u.pn * BM + wc * 32 + 8 * fq;
#pragma unroll
        for (int ai = 0; ai < 2; ++ai)
#pragma unroll
            for (int m = 0; m < 4; ++m) { bf16_t* rowp = O + (size_t)(row0 + ai * HALF + m * 16) * ldc + col0;
#pragma unroll
                for (int bj = 0; bj < 2; ++bj) { const f32x4 v0 = acc[ai][bj][m][0], v1 = acc[ai][bj][m][1]; u32x4 w;
                    w.x = cvt_pk_bf16(silu_fast(v0[0]), silu_fast(v0[1])); w.y = cvt_pk_bf16(silu_fast(v0[2]), silu_fast(v0[3]));
                    w.z = cvt_pk_bf16(silu_fast(v1[0]), silu_fast(v1[1])); w.w = cvt_pk_bf16(silu_fast(v1[2]), silu_fast(v1[3]));
                    *(u32x4*)(rowp + bj * HALF) = w; } }
    }
};
struct EpiF32 {
    static constexpr bool PERM = true, AFTER_DRAIN = false;
    float* O; int ldc;
    __device__ __forceinline__ void operator()(const f32x4 (&acc)[2][2][4][2], const Unit& u, int wr, int wc, int fr, int fq) const {
        const int row0 = u.pm * BM + wr * 64 + fr, col0 = u.pn * BM + wc * 32 + 8 * fq;
#pragma unroll
        for (int ai = 0; ai < 2; ++ai)
#pragma unroll
            for (int m = 0; m < 4; ++m) { float* rowp = O + (size_t)(row0 + ai * HALF + m * 16) * ldc + col0;
#pragma unroll
                for (int bj = 0; bj < 2; ++bj) { *(f32x4*)(rowp + bj * HALF) = acc[ai][bj][m][0]; *(f32x4*)(rowp + bj * HALF + 4) = acc[ai][bj][m][1]; } }
    }
};

template <class Epi, class Sched, bool ALIGN_EPI = false, bool SP2 = false>
__device__ __forceinline__ void gemm_phase(PG8_LAS unsigned char* lds, const Gemm g, const Sched& S, const Epi& E) {
    int tid_ = threadIdx.x; asm volatile("" : "+v"(tid_));
    const int tid = tid_, wid = __builtin_amdgcn_readfirstlane(tid >> 6), lane = tid & 63, wr = wid >> 2, wc = wid & 3, fr = lane & 15, fq = lane >> 4;
    const int K = g.K, nt = K / BK, lda = g.lda ? g.lda : K, ldb = g.ldb ? g.ldb : K;
    unsigned voffA[2], voffB[2];
#pragma unroll
    for (int i = 0; i < 2; ++i) { int R, C; stage_rc(tid * 16 + i * 8192, R, C); const int Rb = Epi::PERM ? ((R & ~31) + perm32(R & 31)) : R;
        voffA[i] = (unsigned)(R * lda + C) * 2u; voffB[i] = (unsigned)(Rb * ldb + C) * 2u; }
    const size_t kstep = (size_t)(BK * 2);
    const size_t hstepA = (size_t)HALF * lda * 2, hstepB = (size_t)HALF * ldb * 2;
    const size_t tstepA = g.ksl ? (size_t)g.ksl : 2 * hstepA, tstepB = 2 * hstepB, bpm = (size_t)g.ksl;
    const unsigned ldsw = (unsigned)wid * 1024u;
    const int aoff = lds_byte(wr * 64 + fr, fq * 8), boff = lds_byte(wc * 32 + fr, fq * 8);
#define PG8_SA(b, h) (((b) * 2 + (h)) * HTB)
#define PG8_SB(b, h) ((4 + (b) * 2 + (h)) * HTB)
#define PG8_STAGE(bufoff, gbase, voff) do { _Pragma("unroll") for (int _i = 0; _i < 2; ++_i) \
        __builtin_amdgcn_global_load_lds((const unsigned*)((const char*)(gbase) + (voff)[_i]), (PG8_LAS unsigned*)(lds + (bufoff) + ldsw + _i * 8192), 16, 0, 0); } while (0)
#define PG8_LDA(dst, b, h) do { _Pragma("unroll") for (int m = 0; m < 4; ++m) _Pragma("unroll") for (int k = 0; k < 2; ++k) dst[m][k] = *(const PG8_LAS bf16x8*)(lds + PG8_SA(b, h) + aoff + m * 2048 + k * 1024); } while (0)
#define PG8_LDB(dst, b, h) do { _Pragma("unroll") for (int n = 0; n < 2; ++n) _Pragma("unroll") for (int k = 0; k < 2; ++k) dst[n][k] = *(const PG8_LAS bf16x8*)(lds + PG8_SB(b, h) + boff + n * 2048 + k * 1024); } while (0)
#define PG8_MMA(ai, bj, At, Bt) do { __builtin_amdgcn_s_setprio(1); _Pragma("unroll") for (int m = 0; m < 4; ++m) _Pragma("unroll") for (int n = 0; n < 2; ++n) _Pragma("unroll") for (int k = 0; k < 2; ++k) \
        acc[ai][bj][m][n] = __builtin_amdgcn_mfma_f32_16x16x32_bf16(Bt[n][k], At[m][k], acc[ai][bj][m][n], 0, 0, 0); __builtin_amdgcn_s_setprio(0); } while (0)
#define PG8_WAIT_V(n) asm volatile("s_waitcnt vmcnt(" #n ")" ::: "memory")
#define PG8_WAIT_L(n) asm volatile("s_waitcnt lgkmcnt(" #n ")" ::: "memory")
#define PG8_BAR __builtin_amdgcn_s_barrier()
#define PG8_SCHED __builtin_amdgcn_sched_barrier(0)
    Unit cur, nxt; int ui = 0;
    if (!S.next(0, cur)) return;
    f32x4 acc[2][2][4][2];
#pragma unroll
    for (int a = 0; a < 2; ++a)
#pragma unroll
        for (int b = 0; b < 2; ++b)
#pragma unroll
            for (int m = 0; m < 4; ++m)
#pragma unroll
                for (int n = 0; n < 2; ++n) acc[a][b][m][n] = (f32x4){0.f, 0.f, 0.f, 0.f};
    bf16x8 At[4][2], B0[2][2], B1[2][2];
    const char* cA = (const char*)g.A + (size_t)cur.pm * tstepA; const char* cB = (const char*)g.Bt + (size_t)cur.pn * tstepB + (size_t)cur.pm * bpm;
    S.a_ready(cur);
    if constexpr (SP2) {
        PG8_STAGE(PG8_SB(0, 0), cB, voffB); PG8_STAGE(PG8_SB(0, 1), cB + hstepB, voffB); PG8_STAGE(PG8_SA(0, 0), cA, voffA); PG8_STAGE(PG8_SA(0, 1), cA + hstepA, voffA);
        if (wr == 1) PG8_BAR;
        PG8_WAIT_V(2); PG8_BAR;
        PG8_STAGE(PG8_SB(1, 0), cB + kstep, voffB); PG8_STAGE(PG8_SA(1, 0), cA + kstep, voffA); PG8_STAGE(PG8_SB(1, 1), cB + hstepB + kstep, voffB);
        PG8_WAIT_V(6); PG8_BAR;
    } else {
        PG8_STAGE(PG8_SB(0, 0), cB, voffB); PG8_STAGE(PG8_SA(0, 0), cA, voffA); PG8_STAGE(PG8_SB(0, 1), cB + hstepB, voffB); PG8_STAGE(PG8_SA(0, 1), cA + hstepA, voffA);
        if (wr == 1) PG8_BAR;
        PG8_WAIT_V(4); PG8_BAR;
        PG8_STAGE(PG8_SB(1, 0), cB + kstep, voffB); PG8_STAGE(PG8_SA(1, 0), cA + kstep, voffA); PG8_STAGE(PG8_SB(1, 1), cB + hstepB + kstep, voffB);
        PG8_WAIT_V(6); PG8_BAR;
    }
    for (;;) {
        const bool has_next = S.next(ui + 1, nxt);
        const char* nA = has_next ? (const char*)g.A + (size_t)nxt.pm * tstepA : cA; const char* nB = has_next ? (const char*)g.Bt + (size_t)nxt.pn * tstepB + (size_t)nxt.pm * bpm : cB;
        for (int t = 0; t < nt; t += 2) {
            const bool last = (t == nt - 2);
            const char* a1 = cA + (size_t)(t + 1) * kstep;
            const char* a2 = last ? nA : cA + (size_t)(t + 2) * kstep; const char* b2 = last ? nB : cB + (size_t)(t + 2) * kstep;
            const char* a3 = a2 + kstep; const char* b3 = b2 + kstep;
            if (last && has_next) S.a_ready(nxt);
            if constexpr (SP2) {
            PG8_LDB(B0, 0, 0); PG8_LDB(B1, 0, 1); PG8_SCHED; PG8_LDA(At, 0, 0); PG8_STAGE(PG8_SA(1, 1), a1 + hstepA, voffA);
            PG8_WAIT_V(8); PG8_WAIT_L(0); PG8_BAR; PG8_MMA(0, 0, At, B0); PG8_MMA(0, 1, At, B1); PG8_BAR; PG8_SCHED;
            PG8_LDA(At, 0, 1); PG8_STAGE(PG8_SB(0, 0), b2, voffB); PG8_STAGE(PG8_SB(0, 1), b2 + hstepB, voffB); PG8_STAGE(PG8_SA(0, 0), a2, voffA);
            PG8_WAIT_V(8); PG8_WAIT_L(0); PG8_BAR; PG8_MMA(1, 0, At, B0); PG8_MMA(1, 1, At, B1); PG8_BAR; PG8_SCHED;
            PG8_LDB(B0, 1, 0); PG8_LDB(B1, 1, 1); PG8_SCHED; PG8_LDA(At, 1, 0); PG8_STAGE(PG8_SA(0, 1), a2 + hstepA, voffA);
            PG8_WAIT_V(8); PG8_WAIT_L(0); PG8_BAR; PG8_MMA(0, 0, At, B0); PG8_MMA(0, 1, At, B1); PG8_BAR; PG8_SCHED;
            PG8_LDA(At, 1, 1); PG8_STAGE(PG8_SB(1, 0), b3, voffB); PG8_STAGE(PG8_SB(1, 1), b3 + hstepB, voffB); PG8_STAGE(PG8_SA(1, 0), a3, voffA);
            PG8_WAIT_V(8); PG8_WAIT_L(0); PG8_BAR; PG8_MMA(1, 0, At, B0); PG8_MMA(1, 1, At, B1); PG8_BAR; PG8_SCHED;
            } else {
            PG8_LDB(B0, 0, 0); PG8_SCHED; PG8_LDA(At, 0, 0); PG8_STAGE(PG8_SA(1, 1), a1 + hstepA, voffA);
            PG8_WAIT_L(8); PG8_BAR; PG8_WAIT_L(0); PG8_MMA(0, 0, At, B0); PG8_BAR; PG8_SCHED;
            PG8_LDB(B1, 0, 1); PG8_STAGE(PG8_SB(0, 0), b2, voffB);
            PG8_BAR; PG8_WAIT_L(0); PG8_MMA(0, 1, At, B1); PG8_BAR;
            PG8_LDA(At, 0, 1); PG8_STAGE(PG8_SA(0, 0), a2, voffA);
            PG8_BAR; PG8_WAIT_L(0); PG8_MMA(1, 0, At, B0); PG8_BAR; PG8_SCHED;
            PG8_STAGE(PG8_SB(0, 1), b2 + hstepB, voffB);
            PG8_WAIT_V(6); PG8_BAR; PG8_MMA(1, 1, At, B1); PG8_BAR;
            PG8_LDB(B0, 1, 0); PG8_SCHED; PG8_LDA(At, 1, 0); PG8_STAGE(PG8_SA(0, 1), a2 + hstepA, voffA);
            PG8_WAIT_L(8); PG8_BAR; PG8_WAIT_L(0); PG8_MMA(0, 0, At, B0); PG8_BAR; PG8_SCHED;
            PG8_LDB(B1, 1, 1); PG8_STAGE(PG8_SB(1, 0), b3, voffB);
            PG8_BAR; PG8_WAIT_L(0); PG8_MMA(0, 1, At, B1); PG8_BAR;
            PG8_LDA(At, 1, 1); PG8_STAGE(PG8_SA(1, 0), a3, voffA);
            PG8_BAR; PG8_WAIT_L(0); PG8_MMA(1, 0, At, B0); PG8_BAR; PG8_SCHED;
            PG8_STAGE(PG8_SB(1, 1), b3 + hstepB, voffB);
            PG8_WAIT_V(6); PG8_BAR; PG8_MMA(1, 1, At, B1); PG8_BAR;
            }
        }
        if constexpr (ALIGN_EPI) { if (wr == 0) PG8_BAR; }
        if constexpr (!Epi::AFTER_DRAIN) { E(acc, cur, wr, wc, fr, fq); S.done(cur); }
        if (!has_next) break;
#pragma unroll
        for (int a = 0; a < 2; ++a)
#pragma unroll
            for (int b = 0; b < 2; ++b)
#pragma unroll
                for (int m = 0; m < 4; ++m)
#pragma unroll
                    for (int n = 0; n < 2; ++n) acc[a][b][m][n] = (f32x4){0.f, 0.f, 0.f, 0.f};
        cur = nxt; cA = nA; cB = nB; ++ui;
        if constexpr (ALIGN_EPI) { if (wr == 1) PG8_BAR; }
    }
    PG8_WAIT_V(0);
    if constexpr (!ALIGN_EPI) { if (wr == 0) PG8_BAR; }
    PG8_BAR;
    if constexpr (Epi::AFTER_DRAIN) { E.fused(acc, cur, wr, wc, fr, fq, lds, wid, lane); S.done(cur); }
#undef PG8_SA
#undef PG8_SB
#undef PG8_STAGE
#undef PG8_LDA
#undef PG8_LDB
#undef PG8_MMA
#undef PG8_WAIT_V
#undef PG8_WAIT_L
#undef PG8_BAR
#undef PG8_SCHED
}
}

namespace attn {
using bf16 = unsigned short;
constexpr int   D = 128, NW = 8, QBLK = 32, KVBLK = 64;
constexpr float SCALE = 0.088388347648318440f;
constexpr float THR = 8.f;
constexpr int SDEPTH = 2;
constexpr int LDQ = P0W, LDK = P0W, LDO = 2048;
constexpr size_t SHM_V = KVBLK * D * 2, SHM_K = KVBLK * D * 2, SHM_ATTN = 2 * SHM_V + 2 * SHM_K + NW * 64 * 4;
using bf16x8 = __attribute__((ext_vector_type(8))) short;
using s16x4  = __attribute__((ext_vector_type(4))) short;
using f32x16 = __attribute__((ext_vector_type(16))) float;
using f32x8  = __attribute__((ext_vector_type(8))) float;
using u32x4  = __attribute__((ext_vector_type(4))) unsigned;
#define KSWZ(row, colB) ((row) * 256 + ((colB) ^ (((row) & 7) << 4)))
#define SBAR() __builtin_amdgcn_sched_barrier(0)
__device__ __forceinline__ int crow(int r, int hi) { return (r & 3) + 8 * (r >> 2) + 4 * hi; }
__device__ __forceinline__ unsigned cvtpk(float lo, float hi) {
  unsigned r; asm volatile("v_cvt_pk_bf16_f32 %0, %1, %2" : "=v"(r) : "v"(lo), "v"(hi)); return r;
}
template <typename TIn> struct Stage;
template <> struct Stage<bf16>  { using T = bf16x8;
  __device__ static __forceinline__ T ld8(const bf16* p) { return *reinterpret_cast<const bf16x8*>(p); }
  __device__ static __forceinline__ bf16x8 tobf(T x) { return x; } };
template <> struct Stage<float> { using T = f32x8;
  __device__ static __forceinline__ T ld8(const float* p) { return *reinterpret_cast<const f32x8*>(p); }
  __device__ static __forceinline__ bf16x8 tobf(T x) {
    u32x4 w = {cvtpk(x[0], x[1]), cvtpk(x[2], x[3]), cvtpk(x[4], x[5]), cvtpk(x[6], x[7])}; return *reinterpret_cast<bf16x8*>(&w); } };

template <bool NOMAX> __device__ __forceinline__ void partialSM(f32x16& p0, f32x16& p1, float& m_reg, float& mn, float& alpha) {
  if constexpr (NOMAX) { for (int r = 0; r < 16; ++r) p0[r] = __builtin_amdgcn_exp2f(p0[r]); alpha = 1.f; return; }
  constexpr float C = SCALE * 1.4426950408889634f;
  float pmax = p0[0]; for (int r = 1; r < 16; ++r) pmax = fmaxf(pmax, p0[r]); for (int r = 0; r < 16; ++r) pmax = fmaxf(pmax, p1[r]);
  { auto rr = __builtin_amdgcn_permlane32_swap(__float_as_uint(pmax), __float_as_uint(pmax), false, false);
    pmax = fmaxf(__uint_as_float(rr[0]), __uint_as_float(rr[1])); }
  if (__builtin_expect(__all(pmax - m_reg <= THR / SCALE), 1)) { mn = m_reg; alpha = 1.f; }
  else { mn = fmaxf(m_reg, pmax); alpha = __builtin_amdgcn_exp2f((m_reg - mn) * C); m_reg = mn; }
  float mnC = -mn * C;
  for (int r = 0; r < 16; ++r) p0[r] = fmaf(p0[r], C, mnC); for (int r = 0; r < 16; ++r) p1[r] = fmaf(p1[r], C, mnC);
  for (int r = 0; r < 16; ++r) p0[r] = __builtin_amdgcn_exp2f(p0[r]);
}
__device__ __forceinline__ void finishSM(f32x16& p0, f32x16& p1, float alpha, float& l_reg, bf16x8& pa0, bf16x8& pa1, bf16x8& pa2, bf16x8& pa3) {
  for (int r = 0; r < 16; ++r) p1[r] = __builtin_amdgcn_exp2f(p1[r]);
  float ps = 0; for (int r = 0; r < 16; ++r) ps += p0[r]; for (int r = 0; r < 16; ++r) ps += p1[r];
  { auto rr = __builtin_amdgcn_permlane32_swap(__float_as_uint(ps), __float_as_uint(ps), false, false);
    ps = __uint_as_float(rr[0]) + __uint_as_float(rr[1]); }
  l_reg = l_reg * alpha + ps;
#define PK4(P, BASE, OUT) do { unsigned a0 = cvtpk(P[BASE + 0], P[BASE + 1]), a1 = cvtpk(P[BASE + 2], P[BASE + 3]);   \
    unsigned b0 = cvtpk(P[BASE + 4], P[BASE + 5]), b1 = cvtpk(P[BASE + 6], P[BASE + 7]);                              \
    auto r0 = __builtin_amdgcn_permlane32_swap(a0, b0, false, false); auto r1 = __builtin_amdgcn_permlane32_swap(a1, b1, false, false); \
    u32x4 w = {r0[0], r1[0], r0[1], r1[1]}; OUT = *reinterpret_cast<bf16x8*>(&w); } while (0)
  PK4(p0, 0, pa0); PK4(p0, 8, pa1); PK4(p1, 0, pa2); PK4(p1, 8, pa3);
#undef PK4
}
__device__ __forceinline__ void qkt(f32x16& p0, f32x16& p1, const bf16* Ks, const bf16x8* qr, int r32, int hi) {
  p0 = f32x16{}; p1 = f32x16{};
  for (int d0 = 0; d0 < 8; ++d0) { int cb = (d0 * 16 + hi * 8) * 2;
    bf16x8 b0 = *reinterpret_cast<const bf16x8*>((const char*)Ks + KSWZ(r32, cb));
    bf16x8 b1 = *reinterpret_cast<const bf16x8*>((const char*)Ks + KSWZ(32 + r32, cb));
    p0 = __builtin_amdgcn_mfma_f32_32x32x16_bf16(b0, qr[d0], p0, 0, 0, 0);
    p1 = __builtin_amdgcn_mfma_f32_32x32x16_bf16(b1, qr[d0], p1, 0, 0, 0); }
}
__device__ __forceinline__ int v_st(int k, int c) { const int kk = (k & ~0xC) | ((k & 4) << 1) | ((k & 8) >> 1); return ((kk >> 3) * 4 + (c >> 5)) * 512 + ((kk & 7) * 32 + (c & 31)) * 2; }
__device__ __forceinline__ int v_rd_base(int lane) { return ((lane & 3) << 3) | (((lane >> 2) & 3) << 6) | (((lane >> 4) & 1) << 5) | (((lane >> 5) & 1) << 8); }
constexpr int v_rd_off(int d0, int ks, int half) { return d0 * 512 + ks * 4096 + half * 2048; }
template <int OFF> __device__ __forceinline__ s16x4 tr_read(int vb) {
  s16x4 r; asm volatile("ds_read_b64_tr_b16 %0, %1 offset:%2" : "=&v"(r) : "v"(vb), "i"(OFF) : "memory"); return r;
}
template <int D0> __device__ __forceinline__ void pv_one(f32x16& od, int vb, bf16x8 pa0, bf16x8 pa1, bf16x8 pa2, bf16x8 pa3) {
  const s16x4 l0 = tr_read<v_rd_off(D0, 0, 0)>(vb), h0 = tr_read<v_rd_off(D0, 0, 1)>(vb), l1 = tr_read<v_rd_off(D0, 1, 0)>(vb), h1 = tr_read<v_rd_off(D0, 1, 1)>(vb);
  const s16x4 l2 = tr_read<v_rd_off(D0, 2, 0)>(vb), h2 = tr_read<v_rd_off(D0, 2, 1)>(vb), l3 = tr_read<v_rd_off(D0, 3, 0)>(vb), h3 = tr_read<v_rd_off(D0, 3, 1)>(vb);
  asm volatile("s_waitcnt lgkmcnt(0)" ::: "memory"); SBAR();
#define PK(L, H) (bf16x8){L[0], L[1], L[2], L[3], H[0], H[1], H[2], H[3]}
  od = __builtin_amdgcn_mfma_f32_32x32x16_bf16(pa0, PK(l0, h0), od, 0, 0, 0);
  od = __builtin_amdgcn_mfma_f32_32x32x16_bf16(pa1, PK(l1, h1), od, 0, 0, 0);
  od = __builtin_amdgcn_mfma_f32_32x32x16_bf16(pa2, PK(l2, h2), od, 0, 0, 0);
  od = __builtin_amdgcn_mfma_f32_32x32x16_bf16(pa3, PK(l3, h3), od, 0, 0, 0);
#undef PK
}
__device__ __forceinline__ void pv_d0(f32x16* o, int vb, bf16x8 pa0, bf16x8 pa1, bf16x8 pa2, bf16x8 pa3) {
  pv_one<0>(o[0], vb, pa0, pa1, pa2, pa3); pv_one<1>(o[1], vb, pa0, pa1, pa2, pa3); pv_one<2>(o[2], vb, pa0, pa1, pa2, pa3); pv_one<3>(o[3], vb, pa0, pa1, pa2, pa3);
}

template <typename TQ, bool NOMAX>
__device__ __forceinline__ void attn_dense_body(const TQ* __restrict__ Qb, const bf16* __restrict__ Kh, const bf16* __restrict__ Vh,
                                                bf16* __restrict__ Ob, int seq, char* lds) {
  using St = Stage<bf16>; using SQ = Stage<TQ>;
  int tid_ = threadIdx.x; asm volatile("" : "+v"(tid_));
  const int tid = tid_, wid = tid >> 6, lane = tid & 63, r32 = lane & 31, hi = lane >> 5;
  bf16* V_lds = (bf16*)lds; bf16* K_lds = (bf16*)(lds + 2 * SHM_V);
  float* ws = (float*)(lds + 2 * SHM_V + 2 * SHM_K) + wid * 64; float* li_l = ws; float* al_l = ws + 32;
  float m_reg = -1e30f, l_reg = 0; f32x16 o[4] = {}; bf16x8 qr[8];
  const TQ* Qw = Qb + (long)(wid * QBLK + r32) * LDQ + hi * 8;
#pragma unroll
  for (int d0 = 0; d0 < 8; ++d0) { qr[d0] = SQ::tobf(SQ::ld8(Qw + d0 * 16));
    if constexpr (NOMAX) { constexpr float C = SCALE * 1.4426950408889634f; u32x4 w = *reinterpret_cast<u32x4*>(&qr[d0]);
      for (int i = 0; i < 4; ++i) w[i] = cvtpk(__uint_as_float(w[i] << 16) * C, __uint_as_float(w[i] & 0xffff0000u) * C);
      qr[d0] = *reinterpret_cast<bf16x8*>(&w); } }
  const int sr = tid >> 4, sc = (tid & 15) * 8, vst0 = v_st(sr, sc), vst1 = v_st(32 + sr, sc);
  const int vb0 = (int)(uintptr_t)V_lds + v_rd_base(lane);
  struct { typename St::T vs0, vs1, ks0, ks1; } sr_[SDEPTH];
#define SLOAD(i, k0) do { sr_[i].vs0 = St::ld8(&Vh[(long)((k0) + sr) * LDK + sc]); sr_[i].vs1 = St::ld8(&Vh[(long)((k0) + 32 + sr) * LDK + sc]); \
    sr_[i].ks0 = St::ld8(&Kh[(long)((k0) + sr) * LDK + sc]); sr_[i].ks1 = St::ld8(&Kh[(long)((k0) + 32 + sr) * LDK + sc]); } while (0)
#define SWRITE(b, i) do { *(bf16x8*)((char*)V_lds + (b) * SHM_V + vst0) = St::tobf(sr_[i].vs0);          \
    *(bf16x8*)((char*)V_lds + (b) * SHM_V + vst1) = St::tobf(sr_[i].vs1); int kc = sc * 2;               \
    *(bf16x8*)((char*)K_lds + (b) * SHM_K + KSWZ(sr, kc)) = St::tobf(sr_[i].ks0);                       \
    *(bf16x8*)((char*)K_lds + (b) * SHM_K + KSWZ(32 + sr, kc)) = St::tobf(sr_[i].ks1); } while (0)
#define SWAIT() do { if constexpr (SDEPTH == 2) asm volatile("s_waitcnt vmcnt(4)" ::: "memory"); else asm volatile("s_waitcnt vmcnt(0)" ::: "memory"); } while (0)
#define RESC(a) do { if (!NOMAX && __any((a) < 1.f)) { if (hi == 0) al_l[r32] = (a); asm volatile("s_waitcnt lgkmcnt(0)" ::: "memory"); \
    for (int d = 0; d < 4; ++d) for (int r = 0; r < 16; ++r) o[d][r] *= al_l[crow(r, hi)]; } } while (0)
  f32x16 pA0, pA1, pB0, pB1; float mnA, mnB, alA, alB; bf16x8 pa0, pa1, pa2, pa3; const int NT = seq / KVBLK;
  constexpr int SE = 0, SO = SDEPTH - 1;
  SLOAD(SE, 0); asm volatile("s_waitcnt vmcnt(0)" ::: "memory"); SWRITE(0, SE); __syncthreads();
  qkt(pA0, pA1, K_lds, qr, r32, hi); partialSM<NOMAX>(pA0, pA1, m_reg, mnA, alA);
  SLOAD(SO, KVBLK); if constexpr (SDEPTH == 2) { if (2 < NT) SLOAD(SE, 2 * KVBLK); }
  SWAIT(); SWRITE(1, SO); __syncthreads();
  for (int j = 1; j + 1 < NT; j += 2) {
    SBAR(); qkt(pB0, pB1, (bf16*)((char*)K_lds + SHM_K), qr, r32, hi);
    finishSM(pA0, pA1, alA, l_reg, pa0, pa1, pa2, pa3); SBAR();
    SLOAD(SO, (j + SDEPTH) * KVBLK); SBAR();
    pv_d0(o, vb0, pa0, pa1, pa2, pa3); partialSM<NOMAX>(pB0, pB1, m_reg, mnB, alB);
    __syncthreads(); SWAIT(); SWRITE(0, SE);
    RESC(alB); __syncthreads();
    SBAR(); qkt(pA0, pA1, K_lds, qr, r32, hi);
    finishSM(pB0, pB1, alB, l_reg, pa0, pa1, pa2, pa3); SBAR();
    if (SDEPTH == 1 || j + 3 < NT) SLOAD(SE, (j + 1 + SDEPTH) * KVBLK); SBAR();
    pv_d0(o, vb0 + (int)SHM_V, pa0, pa1, pa2, pa3); partialSM<NOMAX>(pA0, pA1, m_reg, mnA, alA);
    __syncthreads(); SWAIT(); SWRITE(1, SO);
    RESC(alA); __syncthreads();
  }
  SBAR(); qkt(pB0, pB1, (bf16*)((char*)K_lds + SHM_K), qr, r32, hi);
  finishSM(pA0, pA1, alA, l_reg, pa0, pa1, pa2, pa3); SBAR();
  pv_d0(o, vb0, pa0, pa1, pa2, pa3); partialSM<NOMAX>(pB0, pB1, m_reg, mnB, alB);
  __syncthreads(); RESC(alB);
  finishSM(pB0, pB1, alB, l_reg, pa0, pa1, pa2, pa3); SBAR();
  pv_d0(o, vb0 + (int)SHM_V, pa0, pa1, pa2, pa3);
  if (hi == 0) li_l[r32] = l_reg; asm volatile("s_waitcnt lgkmcnt(0)" ::: "memory");
  float rli[16];
#pragma unroll
  for (int r = 0; r < 16; ++r) rli[r] = __builtin_amdgcn_rcpf(li_l[crow(r, hi)]);
  bf16* Ow = Ob + (long)(wid * QBLK) * LDO;
#pragma unroll
  for (int r = 0; r < 16; ++r) { int orow = crow(r, hi);
    for (int d0 = 0; d0 < 4; ++d0) Ow[(long)orow * LDO + d0 * 32 + r32] = (bf16)(cvtpk(o[d0][r] * rli[r], 0.f) & 0xffffu); }
#undef SLOAD
#undef SWRITE
#undef SWAIT
#undef RESC
}
#undef KSWZ
#undef SBAR
}

namespace rw {
typedef short bf16x8 __attribute__((ext_vector_type(8)));
typedef float f32x4 __attribute__((ext_vector_type(4)));
typedef unsigned u32x4 __attribute__((ext_vector_type(4)));
typedef unsigned u32x2 __attribute__((ext_vector_type(2)));
constexpr int CH = 32, NC = R / CH;
static_assert(NC % 2 == 0, "the prep loop is unrolled by two");
constexpr int BUFB = 5 * 8192 + 1024;
constexpr int O_W = 0, O_B = 8192, O_KD = 16384, O_A = 24576, O_R = 32768, O_V = 40960;
constexpr int PITCH = 72;
constexpr int L_SCR = 2 * BUFB, SCRB = 2 * 16 * PITCH * 2;
constexpr int L_W2T = L_SCR + 4 * SCRB, L_A2T = L_W2T + 64 * PITCH * 2;
constexpr int L_Y = L_A2T + 64 * PITCH * 2;
constexpr int L_CST = L_Y + 2 * 2 * CH * 64 * 4;
constexpr int L_END = L_CST + 10 * 64 * 4;
static_assert(L_END <= 163840 - 64 && (BUFB % 16) == 0 && (L_SCR % 16) == 0 && (SCRB % 16) == 0 && (L_W2T % 16) == 0 && (L_A2T % 16) == 0 && (L_Y % 16) == 0 && (L_CST % 16) == 0, "rwkv LDS map");
constexpr size_t WS_BON = 38 * MiB;

template <int CTRL> __device__ __forceinline__ float dppmov(float x) { return __builtin_bit_cast(float, __builtin_amdgcn_update_dpp(0, __builtin_bit_cast(int, x), CTRL, 0xF, 0xF, true)); }
__device__ __forceinline__ float allreduce8(float x) {
    x += dppmov<0xB1>(x);
    x += dppmov<0x4E>(x);
    x += dppmov<0x141>(x);
    return x;
}
__device__ __forceinline__ float allreduce16(float x) { x = allreduce8(x); x += dppmov<0x140>(x); return x; }
__device__ __forceinline__ float fast_tanh(float x) { const float e = __builtin_amdgcn_exp2f(2.885390081777927f * x); return 1.0f - 2.0f * __builtin_amdgcn_rcpf(1.0f + e); }
__device__ __forceinline__ float bflo(unsigned u) { return __uint_as_float(u << 16); }
__device__ __forceinline__ float bfhi(unsigned u) { return __uint_as_float(u & 0xffff0000u); }
__device__ __forceinline__ unsigned pkbf(float lo, float hi) { unsigned r; asm volatile("v_cvt_pk_bf16_f32 %0, %1, %2" : "=v"(r) : "v"(lo), "v"(hi)); return r; }

constexpr int SEGR = 128, NSEG = R / SEGR, NCG = (ZW + 511) / 512;
constexpr size_t WS_HALO = 40 * MiB;
static_assert(WS_HALO + (size_t)NSEG * 2 * ZW * 2 <= WS_XN, "halo rows overflow");
__device__ __forceinline__ void shift_halo(const Params& p) {
    int tid_ = threadIdx.x; asm volatile("" : "+v"(tid_));
    const bf16_t* Z = ws_big(p); bf16_t* H = (bf16_t*)(p.ws + WS_HALO);
    for (int it = (int)blockIdx.x * NTHR + tid_; it < NSEG * 2 * (ZW / 8); it += (int)gridDim.x * NTHR) {
        const int c8 = it % (ZW / 8), w = (it / (ZW / 8)) & 1, seg = it / (2 * (ZW / 8));
        *(u32x4*)(H + ((size_t)seg * 2 + w) * ZW + c8 * 8) = *(const u32x4*)(Z + (size_t)(seg * SEGR + (w ? SEGR - 1 : 0)) * ZW + c8 * 8);
    }
}
__device__ __forceinline__ u32x4 shift8(u32x4 c, u32x4 pv, u32x4 nx, f32x4 m0, f32x4 m1) {
    u32x4 o;
#pragma unroll
    for (int q = 0; q < 4; ++q) { const float ml = q < 2 ? m0[2 * q] : m1[2 * q - 4], mh = q < 2 ? m0[2 * q + 1] : m1[2 * q - 3];
        const float zl = bflo(c[q]), zh = bfhi(c[q]);
        o[q] = pkbf(zl + (0.5f * (bflo(pv[q]) + bflo(nx[q])) - zl) * ml, zh + (0.5f * (bfhi(pv[q]) + bfhi(nx[q])) - zh) * mh); }
    return o;
}
__device__ __forceinline__ void shift_inplace(const Params& p) {
    int tid_ = threadIdx.x; asm volatile("" : "+v"(tid_));
    const int lane = tid_ & 63, gw = (int)blockIdx.x * NWAVES + (tid_ >> 6), ngw = (int)gridDim.x * NWAVES;
    bf16_t* Z = ws_big(p); const bf16_t* H = (const bf16_t*)(p.ws + WS_HALO);
    for (int u = gw; u < NSEG * NCG; u += ngw) {
        const int seg = u / NCG, col = (u % NCG) * 512 + lane * 8;
        if (col < ZW) {
            const f32x4 m0 = *(const f32x4*)(p.mu + col), m1 = *(const f32x4*)(p.mu + col + 4);
            const bool first = seg == 0 || seg == CTXN / SEGR, last = seg == CTXN / SEGR - 1 || seg == NSEG - 1;
            bf16_t* zr = Z + (size_t)seg * SEGR * ZW + col;
            u32x4 pv = first ? (u32x4){0u, 0u, 0u, 0u} : *(const u32x4*)(H + ((size_t)(seg - 1) * 2 + 1) * ZW + col);
            const u32x4 tail = last ? (u32x4){0u, 0u, 0u, 0u} : *(const u32x4*)(H + ((size_t)(seg + 1) * 2) * ZW + col);
            u32x4 c0 = *(const u32x4*)zr, c1 = *(const u32x4*)(zr + ZW), c2 = *(const u32x4*)(zr + 2 * ZW), c3 = *(const u32x4*)(zr + 3 * ZW);
            for (int r = 0; r < SEGR; r += 4) {
                u32x4 n0 = tail, n1 = tail, n2 = tail, n3 = tail;
                if (r + 4 < SEGR) { n0 = *(const u32x4*)(zr + (size_t)(r + 4) * ZW); n1 = *(const u32x4*)(zr + (size_t)(r + 5) * ZW); n2 = *(const u32x4*)(zr + (size_t)(r + 6) * ZW); n3 = *(const u32x4*)(zr + (size_t)(r + 7) * ZW); }
                const u32x4 o0 = shift8(c0, pv, c1, m0, m1), o1 = shift8(c1, c0, c2, m0, m1), o2 = shift8(c2, c1, c3, m0, m1), o3 = shift8(c3, c2, n0, m0, m1);
                *(u32x4*)(zr + (size_t)r * ZW) = o0; *(u32x4*)(zr + (size_t)(r + 1) * ZW) = o1; *(u32x4*)(zr + (size_t)(r + 2) * ZW) = o2; *(u32x4*)(zr + (size_t)(r + 3) * ZW) = o3;
                pv = c3; c0 = n0; c1 = n1; c2 = n2; c3 = n3;
            }
        }
    }
}

struct Raw { u32x4 c[5]; };

template <int MODE> __device__ __forceinline__ void scan_block(const Params& p, int blk, LAS unsigned char* lds) {
    int tid_ = threadIdx.x; asm volatile("" : "+v"(tid_));
    const int tid = tid_, lane = tid & 63, wave = __builtin_amdgcn_readfirstlane(tid >> 6);
    const int dir = blk >> 7, h = (blk >> 3) & 15, eighth = blk & 7;
    const float* w0 = dir ? p.w0b : p.w0f; const float* w2 = dir ? p.w2b : p.w2f; const float* a0 = dir ? p.a0b : p.a0f; const float* a2 = dir ? p.a2b : p.a2f;
    const bf16_t* Z = ws_big(p); bf16_t* BR = ws_br(p); float* bon = (float*)(p.ws + WS_BON) + ((size_t)dir * 16 + h) * SEQ;
    { const int m = tid >> 3, j8 = (tid & 7) * 8;
      const f32x4 wa = *(const f32x4*)(w2 + (size_t)m * 1024 + h * 64 + j8), wb = *(const f32x4*)(w2 + (size_t)m * 1024 + h * 64 + j8 + 4);
      const f32x4 aa = *(const f32x4*)(a2 + (size_t)m * 1024 + h * 64 + j8), ab = *(const f32x4*)(a2 + (size_t)m * 1024 + h * 64 + j8 + 4);
      LAS bf16_t* yw = (LAS bf16_t*)(lds + L_W2T); LAS bf16_t* ya = (LAS bf16_t*)(lds + L_A2T);
#pragma unroll
      for (int q = 0; q < 4; ++q) { yw[(j8 + q) * PITCH + m] = f2bf(wa[q]); yw[(j8 + 4 + q) * PITCH + m] = f2bf(wb[q]); ya[(j8 + q) * PITCH + m] = f2bf(aa[q]); ya[(j8 + 4 + q) * PITCH + m] = f2bf(ab[q]); }
      for (int i = tid; i < 4 * SCRB / 4; i += NTHR) *(LAS unsigned*)(lds + L_SCR + i * 4) = 0u;
      for (int i = tid; i < 640; i += NTHR) { const int g = i >> 6, cc = i & 63, hc = h * 64 + cc; float v;
          if (g < 3) v = p.mu[g * 1024 + hc]; else if (g == 3) v = p.mu[3072 + dir * 64 + cc]; else if (g == 4) v = p.mu[3200 + dir * 64 + cc];
          else if (g == 5) v = w0[hc]; else if (g == 6) v = a0[hc]; else if (g == 7) v = p.k_k[hc]; else if (g == 8) v = p.k_a[hc]; else v = p.r_k[hc];
          *(LAS float*)(lds + L_CST + i * 4) = v; } }
    __syncthreads();
    if ((wave & 2) != 0) {
        const int pw = (wave & 1) + ((wave >> 2) << 1), tq = lane >> 3, c8 = (lane & 7) * 8, hj = h * 64 + c8, tslot = pw * 8 + tq;
        const int gcol[5] = {hj, 1024 + hj, 2048 + hj, 3072 + dir * 64 + c8, 3200 + dir * 64 + c8};
        LAS unsigned char* scr = lds + L_SCR + pw * SCRB;
#define RW_CST(g, hh) (*(LAS f32x4*)(lds + L_CST + ((g) * 64 + c8 + 4 * (hh)) * 4))
#define RW_LOADRAW(raw, cc) do { const bf16_t* zr_ = Z + (size_t)rw_row(dir, (cc) * CH + tslot) * ZW; \
            _Pragma("unroll") for (int g = 0; g < 5; ++g) raw.c[g] = *(const u32x4*)(zr_ + gcol[g]); } while (0)
        Raw rawA, rawB;
        f32x4 cw0[2], ca0[2], ckk[2], cka[2], crk[2];
#pragma unroll
        for (int hh = 0; hh < 2; ++hh) { cw0[hh] = RW_CST(5, hh); ca0[hh] = RW_CST(6, hh); ckk[hh] = RW_CST(7, hh); cka[hh] = RW_CST(8, hh); crk[hh] = RW_CST(9, hh);
            asm volatile("" : "+v"(cw0[hh]), "+v"(ca0[hh]), "+v"(ckk[hh]), "+v"(cka[hh]), "+v"(crk[hh])); }
        if (MODE == 0 || MODE == 2 || MODE == 3 || MODE == 9) { RW_LOADRAW(rawA, 0); RW_LOADRAW(rawB, 1); }
#define RW_PREP_ITER(RAWSET, cc_) do { \
            if (MODE == 0 || MODE == 2 || MODE == 3 || MODE == 9) { \
            const int cn = (cc_) + 1; LAS unsigned char* buf = lds + (cn & 1) * BUFB; const int p0 = cn * CH; const bool latent = p0 >= CTXN; \
            f32x4 rr[2], kv[2]; \
            { const u32x4 u = RAWSET.c[0]; rr[0] = (f32x4){bflo(u.x), bfhi(u.x), bflo(u.y), bfhi(u.y)}; rr[1] = (f32x4){bflo(u.z), bfhi(u.z), bflo(u.w), bfhi(u.w)}; \
              *(LAS f32x4*)(buf + O_R + (tslot * 64 + c8) * 4) = rr[0]; *(LAS f32x4*)(buf + O_R + (tslot * 64 + c8) * 4 + 16) = rr[1]; } \
            { const u32x4 u = RAWSET.c[1]; kv[0] = (f32x4){bflo(u.x), bfhi(u.x), bflo(u.y), bfhi(u.y)}; kv[1] = (f32x4){bflo(u.z), bfhi(u.z), bflo(u.w), bfhi(u.w)}; } \
            if ((lane & 7) == eighth) { const u32x4 u = RAWSET.c[2]; *(LAS f32x4*)(buf + O_V + tslot * 32) = (f32x4){bflo(u.x), bfhi(u.x), bflo(u.y), bfhi(u.y)}; *(LAS f32x4*)(buf + O_V + tslot * 32 + 16) = (f32x4){bflo(u.z), bfhi(u.z), bflo(u.w), bfhi(u.w)}; } \
            { const u32x4 u = RAWSET.c[3]; u32x4 o; \
              o.x = pkbf(fast_tanh(bflo(u.x)), fast_tanh(bfhi(u.x))); o.y = pkbf(fast_tanh(bflo(u.y)), fast_tanh(bfhi(u.y))); o.z = pkbf(fast_tanh(bflo(u.z)), fast_tanh(bfhi(u.z))); o.w = pkbf(fast_tanh(bflo(u.w)), fast_tanh(bfhi(u.w))); \
              *(LAS u32x4*)(scr + (tq * PITCH + c8) * 2) = o; *(LAS u32x4*)(scr + 16 * PITCH * 2 + (tq * PITCH + c8) * 2) = RAWSET.c[4]; } \
            if (cn + 2 < NC) RW_LOADRAW(RAWSET, cn + 2);              \
            asm volatile("s_waitcnt lgkmcnt(0)" ::: "memory"); \
            { const int r16 = lane & 15, quad = lane >> 4; f32x4 acc[2][4]; \
_Pragma("unroll") \
              for (int lora = 0; lora < 2; ++lora) { \
                  LAS unsigned char* X = scr + lora * 16 * PITCH * 2 + (r16 * PITCH + quad * 8) * 2; \
                  const bf16x8 x0 = *(LAS bf16x8*)X, x1 = *(LAS bf16x8*)(X + 64); \
_Pragma("unroll") \
                  for (int jt = 0; jt < 4; ++jt) { \
                      LAS unsigned char* Y = lds + (lora ? L_A2T : L_W2T) + ((jt * 16 + r16) * PITCH + quad * 8) * 2; \
                      acc[lora][jt] = (f32x4){0.f, 0.f, 0.f, 0.f}; \
                      acc[lora][jt] = __builtin_amdgcn_mfma_f32_16x16x32_bf16(x0, *(LAS bf16x8*)Y, acc[lora][jt], 0, 0, 0); \
                      acc[lora][jt] = __builtin_amdgcn_mfma_f32_16x16x32_bf16(x1, *(LAS bf16x8*)(Y + 64), acc[lora][jt], 0, 0, 0); } } \
              if (quad < 2) { \
_Pragma("unroll") \
                  for (int lora = 0; lora < 2; ++lora) \
_Pragma("unroll") \
                      for (int jt = 0; jt < 4; ++jt) \
_Pragma("unroll") \
                          for (int r = 0; r < 4; ++r) *(LAS float*)(buf + (lora ? O_B : O_W) + ((pw * 8 + quad * 4 + r) * 64 + jt * 16 + r16) * 4) = acc[lora][jt][r]; } } \
            asm volatile("s_waitcnt lgkmcnt(0)" ::: "memory"); \
            { float bs = 0.f, nn = 0.f; f32x4 kk[2], al[2]; \
_Pragma("unroll") \
              for (int hh = 0; hh < 2; ++hh) { const int off = (tslot * 64 + c8 + 4 * hh) * 4; \
                  const f32x4 aw = *(LAS f32x4*)(buf + O_W + off) + cw0[hh], aa = *(LAS f32x4*)(buf + O_B + off) + ca0[hh]; \
                  f32x4 wv; \
_Pragma("unroll") \
                  for (int q = 0; q < 4; ++q) { const float sg = __builtin_amdgcn_rcpf(1.0f + __builtin_amdgcn_exp2f(-1.4426950408889634f * aw[q])); \
                      wv[q] = __builtin_amdgcn_exp2f(-0.8750612633917f * sg); al[hh][q] = __builtin_amdgcn_rcpf(1.0f + __builtin_amdgcn_exp2f(-1.4426950408889634f * aa[q])); kk[hh][q] = kv[hh][q] * ckk[hh][q]; nn += kk[hh][q] * kk[hh][q]; } \
                  *(LAS f32x4*)(buf + O_W + off) = wv; } \
              nn = allreduce8(nn); \
              const float inv = __builtin_amdgcn_rsqf(fmaxf(nn, 1e-24f)); \
_Pragma("unroll") \
              for (int hh = 0; hh < 2; ++hh) { const int off = (tslot * 64 + c8 + 4 * hh) * 4; \
                  const f32x4 r = rr[hh]; \
                  f32x4 av, bv, kd; \
_Pragma("unroll") \
                  for (int q = 0; q < 4; ++q) { const float kn = kk[hh][q] * inv; av[q] = -kn; bv[q] = kn * al[hh][q]; kd[q] = kv[hh][q] * (1.0f + (al[hh][q] - 1.0f) * cka[hh][q]); bs += r[q] * kd[q] * crk[hh][q]; } \
                  *(LAS f32x4*)(buf + O_B + off) = bv; *(LAS f32x4*)(buf + O_KD + off) = kd; *(LAS f32x4*)(buf + O_A + off) = av; } \
              bs = allreduce8(bs); \
              if (MODE == 0 && latent && eighth == 0 && (lane & 7) == 0) bon[rw_row(dir, p0 + tslot) - CTXN] = bs; } \
            } \
            __syncthreads(); \
        } while (0)
        for (int c = -1; c < NC - 1; c += 2) { RW_PREP_ITER(rawA, c); RW_PREP_ITER(rawB, c + 1); }
#undef RW_PREP_ITER
#undef RW_LOADRAW
#undef RW_CST
    } else if (wave >= 4) {
        const int sw = wave - 4, et = lane >> 1, erp = lane & 1;
#define RW_EMIT(cc) do { if ((cc) * CH >= CTXN) { const LAS f32x4* yp = (const LAS f32x4*)(lds + L_Y + ((((cc) & 1) * 2 + sw) * 8192) + et * 256 + erp * 128); \
            f32x4 s0 = yp[0] + yp[1] + yp[2] + yp[3], s1 = yp[4] + yp[5] + yp[6] + yp[7]; \
            *(unsigned*)(BR + (size_t)rw_row(dir, (cc) * CH + et) * 2048 + dir * 1024 + h * 64 + eighth * 8 + sw * 4 + erp * 2) = pkbf((s0[0] + s0[1]) + (s0[2] + s0[3]), (s1[0] + s1[1]) + (s1[2] + s1[3])); } } while (0)
        __syncthreads();
        for (int c = 0; c < NC; ++c) { if (c >= 1) RW_EMIT(c - 1); if (c + 1 < NC) __syncthreads(); }
    } else {
        __builtin_amdgcn_s_setprio(0);
        typedef float f32x2 __attribute__((ext_vector_type(2)));
        f32x2 S01 = {0.f, 0.f}, S23 = {0.f, 0.f};
        const int srow = wave * 4 + (lane >> 4), sj = (lane & 15) * 4;
        __syncthreads();
        struct Ops { f32x4 a, w, b, k, r; float v; };
#define RW_LD(o, t) do { o.a = *(LAS f32x4*)(bp + O_A + (t) * 256); \
            if (MODE == 9) { o.w = o.a; o.b = o.a; o.k = o.a; o.r = o.a; o.v = o.a[0]; } else { o.w = *(LAS f32x4*)(bp + O_W + (t) * 256); o.b = *(LAS f32x4*)(bp + O_B + (t) * 256); \
            o.k = *(LAS f32x4*)(bp + O_KD + (t) * 256); o.r = *(LAS f32x4*)(bp + O_R + (t) * 256); o.v = *(LAS float*)(vp + (t) * 32); } } while (0)
#define RW_STEP(o, t) do { f32x2 pd = S01 * o.a.lo; pd = S23 * o.a.hi + pd; float sa = pd.x + pd.y; if (MODE != 5 && MODE != 7) sa = allreduce16(sa); \
            S01 = o.b.lo * sa + (S01 * o.w.lo + o.k.lo * o.v); S23 = o.b.hi * sa + (S23 * o.w.hi + o.k.hi * o.v); \
            { f32x2 py = S01 * o.r.lo; py = S23 * o.r.hi + py; *(LAS float*)(yb + (t) * 256) = py.x + py.y; } } while (0)
        for (int c = 0; c < NC; ++c) {
            LAS unsigned char* bp = lds + (c & 1) * BUFB + sj * 4; LAS unsigned char* vp = lds + (c & 1) * BUFB + O_V + srow * 4; LAS unsigned char* yb = lds + L_Y + ((c & 1) * 2 + wave) * 8192 + lane * 4;
            Ops A0, A1, A2, A3, B0, B1, B2, B3;
            if (MODE != 2) {
            RW_LD(A0, 0); RW_LD(A1, 1); RW_LD(A2, 2); RW_LD(A3, 3);
#pragma unroll
            for (int g = 0; g < CH / 8; ++g) {
                RW_LD(B0, 8 * g + 4); RW_LD(B1, 8 * g + 5); RW_LD(B2, 8 * g + 6); RW_LD(B3, 8 * g + 7);
                __builtin_amdgcn_sched_barrier(0);
                RW_STEP(A0, 8 * g); RW_STEP(A1, 8 * g + 1); RW_STEP(A2, 8 * g + 2); RW_STEP(A3, 8 * g + 3);
                __builtin_amdgcn_sched_barrier(0);
                if (g + 1 < CH / 8) { RW_LD(A0, 8 * g + 8); RW_LD(A1, 8 * g + 9); RW_LD(A2, 8 * g + 10); RW_LD(A3, 8 * g + 11); }
                __builtin_amdgcn_sched_barrier(0);
                RW_STEP(B0, 8 * g + 4); RW_STEP(B1, 8 * g + 5); RW_STEP(B2, 8 * g + 6); RW_STEP(B3, 8 * g + 7);
                __builtin_amdgcn_sched_barrier(0);
            }
            }
            if (c + 1 < NC) __syncthreads();
        }
#undef RW_LD
#undef RW_STEP
        if (MODE != 0) asm volatile("" :: "v"(S01), "v"(S23));
        __builtin_amdgcn_s_setprio(0);
    }
    __syncthreads();
    if (wave == 4 || wave == 5) { const int sw = wave - 4, et = lane >> 1, erp = lane & 1; RW_EMIT(NC - 1); }
#undef RW_EMIT
    __syncthreads();
}

__device__ __forceinline__ float wave_sum(float v) {
    v = allreduce16(v);
    { auto r = __builtin_amdgcn_permlane16_swap(__float_as_uint(v), __float_as_uint(v), false, false); v = __uint_as_float(r[0]) + __uint_as_float(r[1]); }
    { auto r = __builtin_amdgcn_permlane32_swap(__float_as_uint(v), __float_as_uint(v), false, false); v = __uint_as_float(r[0]) + __uint_as_float(r[1]); }
    return v;
}
__device__ __forceinline__ void finish_phase(const Params& p) {
    int tid_ = threadIdx.x; asm volatile("" : "+v"(tid_));
    const int lane = tid_ & 63, gw = (int)blockIdx.x * NWAVES + (tid_ >> 6), ngw = (int)gridDim.x * NWAVES;
    const bf16_t* Z = ws_big(p); bf16_t* BR = ws_br(p); const float* bon = (const float*)(p.ws + WS_BON);
    for (int it = gw; it < SEQ * 4; it += ngw) {
        const int t = it >> 2, h = (it & 3) * 4 + (lane >> 4), row = CTXN + t, col = h * 64 + (lane & 15) * 4;
        bf16_t* b = BR + (size_t)row * 2048;
        const u32x2 wf = *(const u32x2*)(b + col), wb = *(const u32x2*)(b + 1024 + col), zv = *(const u32x2*)(Z + (size_t)row * ZW + 2048 + col);
        const f32x4 x = {bflo(wf.x) + bflo(wb.x), bfhi(wf.x) + bfhi(wb.x), bflo(wf.y) + bflo(wb.y), bfhi(wf.y) + bfhi(wb.y)};
        const float mean = allreduce16((x[0] + x[1]) + (x[2] + x[3])) * (1.0f / 64.f);
        const f32x4 d = x - mean;
        const float var = allreduce16((d[0] * d[0] + d[1] * d[1]) + (d[2] * d[2] + d[3] * d[3])) * (1.0f / 64.f);
        const float rstd = __builtin_amdgcn_rsqf(var + GN_EPS), bsum = bon[(size_t)h * SEQ + t] + bon[((size_t)16 + h) * SEQ + t];
        const f32x4 g = *(const f32x4*)(p.lnx_g + col), bb = *(const f32x4*)(p.lnx_b + col), v = {bflo(zv.x), bfhi(zv.x), bflo(zv.y), bfhi(zv.y)};
        const f32x4 y = d * rstd * g + bb + v * bsum;
        u32x2 o; o.x = pkbf(y[0], y[1]); o.y = pkbf(y[2], y[3]);
        *(u32x2*)(b + 1024 + col) = o;
    }
}
}

namespace wy {
typedef short bf16x4 __attribute__((ext_vector_type(4)));
using rw::f32x4; using rw::u32x4; using rw::u32x2; using rw::bf16x8; using rw::bflo; using rw::bfhi; using rw::PITCH;
typedef float f32x2_t __attribute__((ext_vector_type(2)));
typedef __bf16 bf2_t __attribute__((ext_vector_type(2)));
__device__ __forceinline__ unsigned pkbf(float lo, float hi) { const f32x2_t v = {lo, hi}; return __builtin_bit_cast(unsigned, __builtin_convertvector(v, bf2_t)); }
typedef GAS unsigned gu32;
#define WY_RLX __ATOMIC_RELAXED, __HIP_MEMORY_SCOPE_AGENT
constexpr int NJOB = R / 64, NCHUNK = R / 16, NSLOT = 8, ATP = 144, REC = 13056, JOBB = 4 * REC;
static_assert(R % 64 == 0 && CTXN % 64 == 0 && (R / 64) % 2 == 0, "jobs are 64 tokens; the loader is unrolled by two jobs");
constexpr int R_AT = 0, R_RT = 2304, R_BK = 4608, R_VT = 8704, R_AAK = 10752, R_TT = 11264, R_ARBK = 11776, R_WL = 12800;
__device__ __forceinline__ int permj(int j) { return (j >> 5) * 32 + ((j >> 2) & 3) * 8 + ((j >> 4) & 1) * 4 + (j & 3); }
constexpr int C_SLOTS = 3, C_SYNC = C_SLOTS * JOBB;
static_assert(C_SYNC + 64 <= 163840 - 64 && (JOBB / 4) % 16 == 0, "consumer LDS map");
constexpr size_t WS_RING = WS_WB;
constexpr size_t RING_TOTAL = (size_t)32 * NSLOT * JOBB;
constexpr size_t WS_WYF = 256 * 1024 + 16384;
constexpr int WYF_ACK = 32 * NSLOT * 64, WYF_ABORT = WYF_ACK + 32 * 64, WYF_WORDS = WYF_ABORT + 64;
constexpr unsigned SPIN_CAP = 1u << 17;
constexpr int P_A = 0, P_B = 16384, P_KD = 32768, P_LW = 49152, P_IMG = 65536, P_BRM = P_IMG + JOBB, P_KRM = P_BRM + 8192, P_AAB = P_KRM + 8192, P_W2T = P_AAB + 4096, P_A2T = P_W2T + 64 * PITCH * 2, P_END = P_A2T + 64 * PITCH * 2;
constexpr int P_SCR = P_BRM, SCRW = 2 * 8 * PITCH * 2;
constexpr int P_CST = P_IMG;
static_assert(P_END <= 163840 - 64 && P_SCR + 8 * SCRW + 8 * PITCH * 2 <= P_W2T, "wy LDS map");

__device__ __forceinline__ bf16x4 pack4(f32x4 v) { u32x2 r; r.x = pkbf(v[0], v[1]); r.y = pkbf(v[2], v[3]); return __builtin_bit_cast(bf16x4, r); }
__device__ __forceinline__ f32x4 mm(u32x2 a, bf16x4 b, f32x4 c) { return __builtin_amdgcn_mfma_f32_16x16x16bf16_1k(__builtin_bit_cast(bf16x4, a), b, c, 0, 0, 0); }
__device__ __forceinline__ f32x4 mm(u32x2 a, u32x2 b, f32x4 c) { return __builtin_amdgcn_mfma_f32_16x16x16bf16_1k(__builtin_bit_cast(bf16x4, a), __builtin_bit_cast(bf16x4, b), c, 0, 0, 0); }
__device__ __forceinline__ void wait_ge(gu32* word, unsigned want, gu32* abortw, int lane) {
    for (unsigned spins = 0;;) {
        unsigned v = 0u; if (lane == 0) v = __hip_atomic_load(word, WY_RLX);
        if ((unsigned)__builtin_amdgcn_readfirstlane(v) >= want) return;
        __builtin_amdgcn_s_sleep(1);
        if ((++spins & 255u) == 0u) { unsigned a = 0u; if (lane == 0) a = __hip_atomic_load(abortw, WY_RLX);
            if (__builtin_amdgcn_readfirstlane(a)) return;
            if (spins > SPIN_CAP) { if (lane == 0) __hip_atomic_store(abortw, 1u, WY_RLX); return; } }
    }
}

__device__ __forceinline__ void wait_ge4(gu32* words, unsigned want, gu32* abortw, int lane) {
    for (unsigned spins = 0;;) {
        unsigned v = 0xffffffffu; if (lane < 4) v = __hip_atomic_load(words + lane, WY_RLX);
        const unsigned v0 = (unsigned)__builtin_amdgcn_readlane((int)v, 0), v1 = (unsigned)__builtin_amdgcn_readlane((int)v, 1), v2 = (unsigned)__builtin_amdgcn_readlane((int)v, 2), v3 = (unsigned)__builtin_amdgcn_readlane((int)v, 3);
        const unsigned m01 = v0 < v1 ? v0 : v1, m23 = v2 < v3 ? v2 : v3;
        if ((m01 < m23 ? m01 : m23) >= want) return;
        __builtin_amdgcn_s_sleep(1);
        if ((++spins & 255u) == 0u) { unsigned a = 0u; if (lane == 0) a = __hip_atomic_load(abortw, WY_RLX);
            if (__builtin_amdgcn_readfirstlane(a)) return;
            if (spins > SPIN_CAP) { if (lane == 0) __hip_atomic_store(abortw, 1u, WY_RLX); return; } }
    }
}

struct Frag { u32x4 a01, a23, r01, r23, bk[4], arbk; u32x2 vT, aak, tt; f32x4 wl[4]; };

__device__ __forceinline__ void wait_lds_min4(LAS unsigned* w, unsigned want, gu32* abortw, int lane) {
    for (unsigned spins = 0;;) {
        const unsigned a = __hip_atomic_load(w, __ATOMIC_RELAXED, __HIP_MEMORY_SCOPE_WORKGROUP), b = __hip_atomic_load(w + 1, __ATOMIC_RELAXED, __HIP_MEMORY_SCOPE_WORKGROUP),
                       c = __hip_atomic_load(w + 2, __ATOMIC_RELAXED, __HIP_MEMORY_SCOPE_WORKGROUP), d = __hip_atomic_load(w + 3, __ATOMIC_RELAXED, __HIP_MEMORY_SCOPE_WORKGROUP);
        const unsigned m0 = a < b ? a : b, m1 = c < d ? c : d;
        if ((unsigned)__builtin_amdgcn_readfirstlane((int)(m0 < m1 ? m0 : m1)) >= want) return;
        __builtin_amdgcn_s_sleep(1);
        if ((++spins & 1023u) == 0u) { unsigned ab = 0u; if (lane == 0) ab = __hip_atomic_load(abortw, WY_RLX);
            if (__builtin_amdgcn_readfirstlane(ab)) return;
            if (spins > (SPIN_CAP << 3)) { if (lane == 0) __hip_atomic_store(abortw, 1u, WY_RLX); return; } }
    }
}
template <int MODE> __device__ __forceinline__ void loader(const Params& p, int chain, int lw, int lane, LAS unsigned char* lds) {
    gu32* wf = (gu32*)(p.ws + WS_WYF); gu32* flags = wf + chain * NSLOT * 64; gu32* ackw = wf + WYF_ACK + chain * 64; gu32* abortw = wf + WYF_ABORT;
    LAS unsigned* loaded = (LAS unsigned*)(lds + C_SYNC); LAS unsigned* done = loaded + 4;
    const __amdgpu_buffer_rsrc_t ring_rsrc = __builtin_amdgcn_make_buffer_rsrc((void*)(p.ws + WS_RING), 0, (int)RING_TOTAL, 0x00020000);
    constexpr int QB = JOBB / 4, NIT = (QB / 16 + 63) / 64, TAIL = QB / 16 - (NIT - 1) * 64;
    static_assert(NIT == 13, "the counted waits below assume 13 loads per set");
    u32x4 va[NIT], vb[NIT];
#define WY_ISSUE(v, g_) do { if (MODE < 2) wait_ge(flags + ((g_) % NSLOT) * 64, (unsigned)(g_) + 1u, abortw, lane); \
        const int soff = (chain * NSLOT + (g_) % NSLOT) * JOBB + lw * QB + lane * 16; \
        _Pragma("unroll") for (int k = 0; k < NIT; ++k) if (MODE == 0 && (k < NIT - 1 || lane < TAIL)) v[k] = __builtin_amdgcn_raw_buffer_load_b128(ring_rsrc, soff + k * 1024, 0, 16); } while (0)
#define WY_COMMIT(v, g_, WAITSTR) do { \
        if (MODE != 1 && (g_) >= C_SLOTS) { wait_lds_min4(done, (unsigned)((g_) - C_SLOTS + 1), abortw, lane); __builtin_amdgcn_fence(__ATOMIC_ACQUIRE, "workgroup"); }     \
        asm volatile(WAITSTR ::: "memory");                                                     \
        LAS unsigned char* dst = lds + ((g_) % C_SLOTS) * JOBB + lw * QB + lane * 16; \
        _Pragma("unroll") for (int k = 0; k < NIT; ++k) if (MODE == 0 && (k < NIT - 1 || lane < TAIL)) *(LAS u32x4*)(dst + k * 1024) = v[k]; \
        asm volatile("s_waitcnt lgkmcnt(0)" ::: "memory"); \
        __builtin_amdgcn_fence(__ATOMIC_RELEASE, "workgroup"); \
        if (lane == 0) { __hip_atomic_store(ackw + lw, (unsigned)(g_) + 1u, WY_RLX); __hip_atomic_store(loaded + lw, (unsigned)(g_) + 1u, __ATOMIC_RELAXED, __HIP_MEMORY_SCOPE_WORKGROUP); } } while (0)
    WY_ISSUE(va, 0);
    for (int g = 0; g < NJOB; g += 2) {
        WY_ISSUE(vb, g + 1); WY_COMMIT(va, g, "s_waitcnt vmcnt(13)");
        if (g + 2 < NJOB) { WY_ISSUE(va, g + 2); WY_COMMIT(vb, g + 1, "s_waitcnt vmcnt(13)"); } else WY_COMMIT(vb, g + 1, "s_waitcnt vmcnt(0)");
    }
#undef WY_ISSUE
#undef WY_COMMIT
}
__device__ __forceinline__ bf16x8 cat(u32x2 a, u32x2 b) { const u32x4 v = {a.x, a.y, b.x, b.y}; return __builtin_bit_cast(bf16x8, v); }
__device__ __forceinline__ u32x2 pack4u(f32x4 v) { u32x2 r; r.x = pkbf(v[0], v[1]); r.y = pkbf(v[2], v[3]); return r; }
__device__ __forceinline__ f32x4 mm32(bf16x8 a, bf16x8 b, f32x4 c) { return __builtin_amdgcn_mfma_f32_16x16x32_bf16(a, b, c, 0, 0, 0); }
template <int MODE> __device__ __forceinline__ void consumer(const Params& p, int chain, int wave, int lane, LAS unsigned char* lds) {
    const int n = lane & 15, q = lane >> 4, dir = chain >> 4, h = chain & 15;
    gu32* abortw = (gu32*)(p.ws + WS_WYF) + WYF_ABORT;
    LAS unsigned* loaded = (LAS unsigned*)(lds + C_SYNC); LAS unsigned* done = loaded + 4;
    f32x4 S0 = {0.f, 0.f, 0.f, 0.f}, S1 = S0, S2 = S0, S3 = S0;
    const int offA = n * ATP + 16 * q, offB = n * 32 + 8 * q, offW = 16 * q, offS = n * 64 + ((q ^ ((n >> 2) & 3)) * 16);
    const long rstep = dir ? -2048 : 2048;
    bf16_t* yq = ws_br(p) + (size_t)(CTXN + (dir ? SEQ - 1 - 4 * q : 4 * q)) * 2048 + dir * 1024 + h * 64 + 16 * wave + n;
#define WY_LOAD(F, base, k) do { \
        F.a01 = *(const LAS u32x4*)(base + offA + (k) * REC + R_AT); F.a23 = *(const LAS u32x4*)(base + offA + (k) * REC + R_AT + 64); \
        F.r01 = *(const LAS u32x4*)(base + offA + (k) * REC + R_RT); F.r23 = *(const LAS u32x4*)(base + offA + (k) * REC + R_RT + 64); \
        _Pragma("unroll") for (int jt = 0; jt < 4; ++jt) { F.bk[jt] = *(const LAS u32x4*)(base + offS + (k) * REC + R_BK + 1024 * jt); F.wl[jt] = *(const LAS f32x4*)(base + offW + (k) * REC + R_WL + 64 * jt); } \
        F.arbk = *(const LAS u32x4*)(base + offS + (k) * REC + R_ARBK); \
        F.vT = *(const LAS u32x2*)(base + offB + (k) * REC + R_VT + 512 * wave); F.aak = *(const LAS u32x2*)(base + offB + (k) * REC + R_AAK); F.tt = *(const LAS u32x2*)(base + offB + (k) * REC + R_TT); } while (0)
#define WY_Q(v) __builtin_bit_cast(bf16x8, v)
#define WY_COMPUTE(F, cidx) do { const f32x4 z0_ = {0.f, 0.f, 0.f, 0.f}; const u32x2 zz_ = {0u, 0u};     \
        f32x4 Z = mm32(cat(F.aak, zz_), cat(F.vT, zz_), z0_); \
        const bf16x8 s01 = cat(pack4u(S0), pack4u(S1)), s23 = cat(pack4u(S2), pack4u(S3)); \
        Z = mm32(WY_Q(F.a01), s01, Z); Z = mm32(WY_Q(F.a23), s23, Z);     \
        f32x4 Y = mm32(WY_Q(F.r01), s01, z0_); Y = mm32(WY_Q(F.r23), s23, Y); \
        const u32x2 zb = pack4u(Z); const f32x4 U = mm32(cat(F.tt, zz_), cat(zb, zz_), z0_); const u32x2 ub = pack4u(U); \
        const bf16x8 vu = cat(F.vT, ub); \
        Y = mm32(WY_Q(F.arbk), vu, Y); \
        S0 = mm32(WY_Q(F.bk[0]), vu, S0); S1 = mm32(WY_Q(F.bk[1]), vu, S1); S2 = mm32(WY_Q(F.bk[2]), vu, S2); S3 = mm32(WY_Q(F.bk[3]), vu, S3); \
        S0 *= F.wl[0]; S1 *= F.wl[1]; S2 *= F.wl[2]; S3 *= F.wl[3]; \
        if (MODE == 0 && (cidx) * 16 >= CTXN) { const unsigned y01 = pkbf(Y[0], Y[1]), y23 = pkbf(Y[2], Y[3]); bf16_t* yp_ = yq + (long)((cidx) * 16 - CTXN) * rstep; \
            *(unsigned short*)yp_ = (unsigned short)(y01 & 0xffffu); *(unsigned short*)(yp_ + rstep) = (unsigned short)(y01 >> 16); \
            *(unsigned short*)(yp_ + 2 * rstep) = (unsigned short)(y23 & 0xffffu); *(unsigned short*)(yp_ + 3 * rstep) = (unsigned short)(y23 >> 16); } } while (0)
    Frag FA, FB;
    wait_lds_min4(loaded, 1u, abortw, lane); __builtin_amdgcn_fence(__ATOMIC_ACQUIRE, "workgroup");
    int slot = 0;
    { const LAS unsigned char* b0 = lds; WY_LOAD(FA, b0, 0); if (MODE == 3) WY_LOAD(FB, b0, 1); }
    for (int g = 0; g < NJOB; ++g) {
        const LAS unsigned char* base = lds + slot * JOBB;
        if (MODE != 3) WY_LOAD(FB, base, 1); WY_COMPUTE(FA, 4 * g);
        if (MODE != 3) WY_LOAD(FA, base, 2); WY_COMPUTE(FB, 4 * g + 1);
        if (MODE != 3) WY_LOAD(FB, base, 3); WY_COMPUTE(FA, 4 * g + 2);
        slot = slot == C_SLOTS - 1 ? 0 : slot + 1;
        if (g + 1 < NJOB) { wait_lds_min4(loaded, (unsigned)g + 2u, abortw, lane); __builtin_amdgcn_fence(__ATOMIC_ACQUIRE, "workgroup");
            const LAS unsigned char* nb = lds + slot * JOBB; if (MODE != 3) WY_LOAD(FA, nb, 0); }
        WY_COMPUTE(FB, 4 * g + 3);
        asm volatile("s_waitcnt lgkmcnt(0)" ::: "memory");
        __builtin_amdgcn_fence(__ATOMIC_RELEASE, "workgroup");
        if (lane == 0) __hip_atomic_store(done + wave, (unsigned)g + 1u, __ATOMIC_RELAXED, __HIP_MEMORY_SCOPE_WORKGROUP);
    }
#undef WY_LOAD
#undef WY_COMPUTE
#undef WY_Q
    if (MODE != 0) asm volatile("" :: "v"(S0), "v"(S1), "v"(S2), "v"(S3));
}

template <int HALF> __device__ __forceinline__ void stage2(LAS unsigned char* lds, LAS unsigned char* img, int ch, int j) {
    LAS unsigned char* rec = img + ch * REC;
    const LAS float* LW = (const LAS float*)(lds + P_LW) + (ch * 16) * 64 + j;
    const LAS float* XA = (const LAS float*)(lds + (HALF ? P_KD : P_A)) + (ch * 16) * 64 + j;
    const LAS float* XB = (const LAS float*)(lds + P_B) + (ch * 16) * 64 + j;
    LAS unsigned short* rowm0 = (LAS unsigned short*)(rec + (HALF ? R_RT : R_AT)) + permj(j);
    LAS unsigned short* rowm1 = (LAS unsigned short*)(lds + (HALF ? P_KRM : P_BRM) + ch * 2048) + permj(j);
    float lw[16], s0[16], s1[16];
#pragma unroll
    for (int t = 0; t < 16; ++t) { lw[t] = LW[t * 64]; s1[t] = HALF ? XA[t * 64] : XB[t * 64];
        if (HALF) s0[t] = __uint_as_float((unsigned)rowm0[t * (ATP / 2)] << 16); else s0[t] = XA[t * 64]; }
    float cum = 0.f, x0p = 0.f, x1p = 0.f; unsigned tp[8];
#pragma unroll
    for (int t = 0; t < 16; ++t) {
        const float cprev = cum; cum += lw[t];
        const float x0 = s0[t] * __builtin_amdgcn_exp2f(HALF ? cum : cprev), x1 = s1[t] * __builtin_amdgcn_exp2f(-cum);
        if (t & 1) { const unsigned p0 = pkbf(x0p, x0), p1 = pkbf(x1p, x1);
            rowm0[(t - 1) * (ATP / 2)] = (unsigned short)(p0 & 0xffffu); rowm0[t * (ATP / 2)] = (unsigned short)(p0 >> 16);
            rowm1[(t - 1) * 64] = (unsigned short)(p1 & 0xffffu); rowm1[t * 64] = (unsigned short)(p1 >> 16);
            tp[t >> 1] = p1; }
        x0p = x0; x1p = x1; }
    { LAS unsigned char* bkr = rec + R_BK + j * 64 + (HALF ? 0 : 8); const int sw = (j >> 2) & 3;
#pragma unroll
      for (int qq = 0; qq < 4; ++qq) *(LAS u32x2*)(bkr + ((qq ^ sw) * 16)) = (u32x2){tp[2 * qq], tp[2 * qq + 1]}; }
    if (HALF) *(LAS float*)(rec + R_WL + j * 4) = __builtin_amdgcn_exp2f(cum);
}

template <int SKIP> __device__ __forceinline__ void producer(const Params& p, int chain, int first, int step, LAS unsigned char* lds) {
    int tid_ = threadIdx.x; asm volatile("" : "+v"(tid_));
    const int tid = tid_, lane = tid & 63, wave = __builtin_amdgcn_readfirstlane(tid >> 6);
    const int dir = chain >> 4, h = chain & 15;
    const float* w0 = dir ? p.w0b : p.w0f; const float* w2 = dir ? p.w2b : p.w2f; const float* a0 = dir ? p.a0b : p.a0f; const float* a2 = dir ? p.a2b : p.a2f;
    const bf16_t* Z = ws_big(p); float* bon = (float*)(p.ws + rw::WS_BON) + ((size_t)dir * 16 + h) * SEQ;
    gu32* wf = (gu32*)(p.ws + WS_WYF); gu32* flags = wf + chain * NSLOT * 64; gu32* ackw = wf + WYF_ACK + chain * 64; gu32* abortw = wf + WYF_ABORT;
    const __amdgpu_buffer_rsrc_t ring_rsrc = __builtin_amdgcn_make_buffer_rsrc((void*)(p.ws + WS_RING), 0, (int)RING_TOTAL, 0x00020000);
    { const int m = tid >> 3, j8 = (tid & 7) * 8;
      const f32x4 wa = *(const f32x4*)(w2 + (size_t)m * 1024 + h * 64 + j8), wb = *(const f32x4*)(w2 + (size_t)m * 1024 + h * 64 + j8 + 4);
      const f32x4 aa = *(const f32x4*)(a2 + (size_t)m * 1024 + h * 64 + j8), ab = *(const f32x4*)(a2 + (size_t)m * 1024 + h * 64 + j8 + 4);
      LAS bf16_t* yw = (LAS bf16_t*)(lds + P_W2T); LAS bf16_t* ya = (LAS bf16_t*)(lds + P_A2T);
#pragma unroll
      for (int qq = 0; qq < 4; ++qq) { yw[(j8 + qq) * PITCH + m] = f2bf(wa[qq]); yw[(j8 + 4 + qq) * PITCH + m] = f2bf(wb[qq]); ya[(j8 + qq) * PITCH + m] = f2bf(aa[qq]); ya[(j8 + 4 + qq) * PITCH + m] = f2bf(ab[qq]); }
      for (int i = tid; i < 320; i += NTHR) { const int gI = i >> 6, cc = i & 63, hc = h * 64 + cc; float v;
          if (gI == 0) v = w0[hc]; else if (gI == 1) v = a0[hc]; else if (gI == 2) v = p.k_k[hc]; else if (gI == 3) v = p.k_a[hc]; else v = p.r_k[hc];
          *(LAS float*)(lds + P_CST + i * 4) = v; } }
    __syncthreads();
    const int tq = lane >> 3, c8 = (lane & 7) * 8, hj = h * 64 + c8, tslot = wave * 8 + tq, ch1 = tslot >> 4, t1 = tslot & 15;
    const int gcol[5] = {hj, 1024 + hj, 2048 + hj, 3072 + dir * 64 + c8, 3200 + dir * 64 + c8};
    f32x4 cw0[2], ca0[2], ckk[2], cka[2], crk[2];
#pragma unroll
    for (int hh = 0; hh < 2; ++hh) {
#define WY_CST(gI) (*(LAS f32x4*)(lds + P_CST + ((gI) * 64 + c8 + 4 * hh) * 4))
        cw0[hh] = WY_CST(0); ca0[hh] = WY_CST(1); ckk[hh] = WY_CST(2); cka[hh] = WY_CST(3); crk[hh] = WY_CST(4);
#undef WY_CST
        asm volatile("" : "+v"(cw0[hh]), "+v"(ca0[hh]), "+v"(ckk[hh]), "+v"(cka[hh]), "+v"(crk[hh])); }
    __syncthreads();
    LAS unsigned char* scr = lds + P_SCR + wave * SCRW;
    LAS unsigned char* img = lds + P_IMG;
    rw::Raw raw;
#define WY_LOADRAW(gj) do { const bf16_t* zr_ = Z + (size_t)rw_row(dir, (gj) * 64 + tslot) * ZW; \
        _Pragma("unroll") for (int g5 = 0; g5 < 5; ++g5) raw.c[g5] = *(const u32x4*)(zr_ + gcol[g5]); } while (0)
    if (first < NJOB) WY_LOADRAW(first);
    for (int g = first; g < NJOB; g += step) {
        const bool latent = g * 64 >= CTXN;
        if (!(SKIP & 1)) { f32x4 rr[2], kv[2];
          { const u32x4 u = raw.c[0]; rr[0] = (f32x4){bflo(u.x), bfhi(u.x), bflo(u.y), bfhi(u.y)}; rr[1] = (f32x4){bflo(u.z), bfhi(u.z), bflo(u.w), bfhi(u.w)};
            LAS unsigned char* rr_ = img + ch1 * REC + R_RT + t1 * ATP + permj(c8) * 2; *(LAS u32x2*)rr_ = (u32x2){u.x, u.y}; *(LAS u32x2*)(rr_ + 16) = (u32x2){u.z, u.w}; }
          { const u32x4 u = raw.c[1]; kv[0] = (f32x4){bflo(u.x), bfhi(u.x), bflo(u.y), bfhi(u.y)}; kv[1] = (f32x4){bflo(u.z), bfhi(u.z), bflo(u.w), bfhi(u.w)}; }
          { const u32x4 u = raw.c[2]; LAS unsigned short* vt = (LAS unsigned short*)(img + ch1 * REC + R_VT) + c8 * 16 + t1;
            vt[0] = (unsigned short)(u.x & 0xffffu); vt[16] = (unsigned short)(u.x >> 16); vt[32] = (unsigned short)(u.y & 0xffffu); vt[48] = (unsigned short)(u.y >> 16);
            vt[64] = (unsigned short)(u.z & 0xffffu); vt[80] = (unsigned short)(u.z >> 16); vt[96] = (unsigned short)(u.w & 0xffffu); vt[112] = (unsigned short)(u.w >> 16); }
          { const u32x4 u = raw.c[3]; u32x4 o;
            o.x = pkbf(rw::fast_tanh(bflo(u.x)), rw::fast_tanh(bfhi(u.x))); o.y = pkbf(rw::fast_tanh(bflo(u.y)), rw::fast_tanh(bfhi(u.y))); o.z = pkbf(rw::fast_tanh(bflo(u.z)), rw::fast_tanh(bfhi(u.z))); o.w = pkbf(rw::fast_tanh(bflo(u.w)), rw::fast_tanh(bfhi(u.w)));
            *(LAS u32x4*)(scr + (tq * PITCH + c8) * 2) = o; *(LAS u32x4*)(scr + 8 * PITCH * 2 + (tq * PITCH + c8) * 2) = raw.c[4]; }
          if (g + step < NJOB) WY_LOADRAW(g + step);
          asm volatile("s_waitcnt lgkmcnt(0)" ::: "memory");
          { const int r16 = lane & 15, quad = lane >> 4; f32x4 acc[2][4];
#pragma unroll
            for (int lora = 0; lora < 2; ++lora) {
                LAS unsigned char* X = scr + lora * 8 * PITCH * 2 + (r16 * PITCH + quad * 8) * 2;
                const bf16x8 x0 = *(LAS bf16x8*)X, x1 = *(LAS bf16x8*)(X + 64);
#pragma unroll
                for (int jt = 0; jt < 4; ++jt) {
                    LAS unsigned char* Y = lds + (lora ? P_A2T : P_W2T) + ((jt * 16 + r16) * PITCH + quad * 8) * 2;
                    acc[lora][jt] = (f32x4){0.f, 0.f, 0.f, 0.f};
                    acc[lora][jt] = __builtin_amdgcn_mfma_f32_16x16x32_bf16(x0, *(LAS bf16x8*)Y, acc[lora][jt], 0, 0, 0);
                    acc[lora][jt] = __builtin_amdgcn_mfma_f32_16x16x32_bf16(x1, *(LAS bf16x8*)(Y + 64), acc[lora][jt], 0, 0, 0); } }
            if (quad < 2) {
#pragma unroll
                for (int lora = 0; lora < 2; ++lora)
#pragma unroll
                    for (int jt = 0; jt < 4; ++jt)
#pragma unroll
                        for (int r = 0; r < 4; ++r) *(LAS float*)(lds + (lora ? P_B : P_LW) + ((wave * 8 + quad * 4 + r) * 64 + jt * 16 + r16) * 4) = acc[lora][jt][r]; } }
          asm volatile("s_waitcnt lgkmcnt(0)" ::: "memory");
          { float bs = 0.f, nn = 0.f; f32x4 kk[2], al[2];
#pragma unroll
            for (int hh = 0; hh < 2; ++hh) { const int off = (tslot * 64 + c8 + 4 * hh) * 4;
                const f32x4 aw = *(LAS f32x4*)(lds + P_LW + off) + cw0[hh], aa = *(LAS f32x4*)(lds + P_B + off) + ca0[hh];
                f32x4 lw;
#pragma unroll
                for (int qq = 0; qq < 4; ++qq) { const float sg = __builtin_amdgcn_rcpf(1.0f + __builtin_amdgcn_exp2f(-1.4426950408889634f * aw[qq]));
                    lw[qq] = -0.8750612633917f * sg; al[hh][qq] = __builtin_amdgcn_rcpf(1.0f + __builtin_amdgcn_exp2f(-1.4426950408889634f * aa[qq])); kk[hh][qq] = kv[hh][qq] * ckk[hh][qq]; nn += kk[hh][qq] * kk[hh][qq]; }
                *(LAS f32x4*)(lds + P_LW + off) = lw; }
            nn = rw::allreduce8(nn);
            const float inv = __builtin_amdgcn_rsqf(fmaxf(nn, 1e-24f));
#pragma unroll
            for (int hh = 0; hh < 2; ++hh) { const int off = (tslot * 64 + c8 + 4 * hh) * 4;
                const f32x4 r = rr[hh];
                f32x4 av, bv, kd;
#pragma unroll
                for (int qq = 0; qq < 4; ++qq) { const float kn = kk[hh][qq] * inv; av[qq] = -kn; bv[qq] = kn * al[hh][qq]; kd[qq] = kv[hh][qq] * (1.0f + (al[hh][qq] - 1.0f) * cka[hh][qq]); bs += r[qq] * kd[qq] * crk[hh][qq]; }
                *(LAS f32x4*)(lds + P_B + off) = bv; *(LAS f32x4*)(lds + P_KD + off) = kd; *(LAS f32x4*)(lds + P_A + off) = av; }
            bs = rw::allreduce8(bs);
            if (latent && (lane & 7) == 0) bon[rw_row(dir, g * 64 + tslot) - CTXN] = bs; } }
        __syncthreads();
        if (!(SKIP & 2)) { if (wave >> 2) stage2<1>(lds, img, wave & 3, lane); else stage2<0>(lds, img, wave & 3, lane); }
        __syncthreads();
        if (!(SKIP & 4)) { const int ch = wave & 3, pair = wave >> 2, n = lane & 15, q = lane >> 4;
          LAS unsigned char* rec = img + ch * REC;
          const LAS unsigned char* Yrm = rec + (pair ? R_RT : R_AT) + n * ATP + 16 * q;
          const LAS unsigned char* Xb = lds + P_BRM + ch * 2048 + n * 128 + 16 * q;
          const LAS unsigned char* Xk = lds + P_KRM + ch * 2048 + n * 128 + 16 * q;
          f32x4 cb = {0.f, 0.f, 0.f, 0.f}, ck = cb;
#pragma unroll
          for (int jt = 0; jt < 4; ++jt) { const int o_ = (jt >> 1) * 64 + (jt & 1) * 8; const u32x2 yb = *(const LAS u32x2*)(Yrm + o_);
              cb = mm(*(const LAS u32x2*)(Xb + o_), yb, cb); ck = mm(*(const LAS u32x2*)(Xk + o_), yb, ck); }
#pragma unroll
          for (int r = 0; r < 4; ++r) { const int s = 4 * q + r; const bool keep = pair ? (s <= n) : (s < n); if (!keep) { cb[r] = 0.f; ck[r] = 0.f; } }
          u32x2 ob, ok; ob.x = pkbf(cb[0], cb[1]); ob.y = pkbf(cb[2], cb[3]); ok.x = pkbf(ck[0], ck[1]); ok.y = pkbf(ck[2], ck[3]);
          if (pair) *(LAS u32x4*)(rec + R_ARBK + n * 64 + ((q ^ ((n >> 2) & 3)) * 16)) = (u32x4){ok.x, ok.y, ob.x, ob.y};
          else {
              *(LAS u32x2*)(rec + R_AAK + n * 32 + 8 * q) = ok;
              LAS float* A2 = (LAS float*)(lds + P_AAB + ch * 1024);
#pragma unroll
              for (int r = 0; r < 4; ++r) A2[n * 16 + r * 4 + q] = cb[r];
              asm volatile("s_waitcnt lgkmcnt(0)" ::: "memory");
              const int c = lane >> 2, pp = lane & 3;
              f32x4 a4[16];
#pragma unroll
              for (int t = 0; t < 16; ++t) a4[t] = *(const LAS f32x4*)(A2 + t * 16 + pp * 4);
              float Tk0 = 0.f, Tk1 = 0.f, Tk2 = 0.f, Tk3 = 0.f, Tprev = 0.f;
              LAS unsigned short* tt = (LAS unsigned short*)(rec + R_TT) + c;
#pragma unroll
              for (int t = 0; t < 16; ++t) {
                  float acc = (a4[t][0] * Tk0 + a4[t][1] * Tk1) + (a4[t][2] * Tk2 + a4[t][3] * Tk3);
                  acc += rw::dppmov<0xB1>(acc); acc += rw::dppmov<0x4E>(acc);
                  const float Tt = acc + ((t == c) ? 1.0f : 0.0f);
                  const bool mine = (t & 3) == pp;
                  if ((t >> 2) == 0) Tk0 = mine ? Tt : Tk0; else if ((t >> 2) == 1) Tk1 = mine ? Tt : Tk1; else if ((t >> 2) == 2) Tk2 = mine ? Tt : Tk2; else Tk3 = mine ? Tt : Tk3;
                  if (t & 1) { const unsigned pk_ = pkbf(Tprev, Tt); if (pp == 0) { tt[(t - 1) * 16] = (unsigned short)(pk_ & 0xffffu); tt[t * 16] = (unsigned short)(pk_ >> 16); } }
                  Tprev = Tt; }
          } }
        if (wave == 0 && g >= NSLOT) wait_ge4(ackw, (unsigned)(g - NSLOT + 1), abortw, lane);
        __syncthreads();
        { const int slot = g % NSLOT; const int base = (chain * NSLOT + slot) * JOBB;
          if (!(SKIP & 8)) for (int i = tid; i < JOBB / 16; i += NTHR) __builtin_amdgcn_raw_buffer_store_b128(*(LAS u32x4*)(img + i * 16), ring_rsrc, base + i * 16, 0, 16);
          asm volatile("s_waitcnt vmcnt(0)" ::: "memory");
          __syncthreads();
          if (tid == 0) __hip_atomic_store(flags + slot * 64, (unsigned)g + 1u, WY_RLX); }
    }
#undef WY_LOADRAW
}

__device__ __forceinline__ void zero_words(const Params& p) {
    int t_ = threadIdx.x; asm volatile("" : "+v"(t_)); unsigned* wf_ = (unsigned*)(p.ws + WS_WYF);
    for (long g = (long)blockIdx.x * NTHR + t_; g < (long)WYF_WORDS; g += (long)gridDim.x * NTHR) wf_[g] = 0u;
}
template <int MODE, int SKIP = 0> __device__ __forceinline__ void phase(const Params& p, LAS unsigned char* lds) {
    const int G = (int)gridDim.x, b = (int)blockIdx.x, nper = (G - 32) / 32;
    if (b < 32) {
        int tid_ = threadIdx.x; asm volatile("" : "+v"(tid_)); const int wave = __builtin_amdgcn_readfirstlane(tid_ >> 6);
        if (tid_ < 8) *(LAS unsigned*)(lds + C_SYNC + 4 * tid_) = 0u;
        __syncthreads();
        if (wave < 4) { if (MODE != 1) consumer<MODE>(p, b, wave, tid_ & 63, lds); } else loader<MODE>(p, b, wave - 4, tid_ & 63, lds);
    }
    else if (MODE < 2) { const int pp = b - 32; if (pp < 32 * nper) producer<SKIP>(p, pp % 32, pp / 32, nper, lds); }
}
}

namespace ret {
using attn::bf16x8; using attn::s16x4; using attn::f32x16; using attn::u32x4;
typedef float f32x4 __attribute__((ext_vector_type(4)));
typedef unsigned u32x2 __attribute__((ext_vector_type(2)));
constexpr int NQ = R / 128;
constexpr size_t SLOT_BYTES = 256 * 128 * 2;
constexpr size_t WS_SCTX = 254 * MiB;
#define RKSWZ(row, colB) ((row) * 256 + ((colB) ^ (((row) & 7) << 4)))
__device__ __forceinline__ bf16_t* slot(const Params& p, int dir, int q, int head) {
    return q >= 2 ? (bf16_t*)((unsigned char*)p.out + (((size_t)dir * (NQ - 2) + (q - 2)) * 4 + head) * SLOT_BYTES)
                  : (bf16_t*)(p.ws + WS_SCTX + (((size_t)dir * 2 + q) * 4 + head) * SLOT_BYTES);
}
__device__ __forceinline__ float log2_sigmoid(float x) { return -1.4426950408889634f * (fmaxf(-x, 0.f) + log1pf(expf(-fabsf(x)))); }
__device__ __forceinline__ bf16x8 scale8(bf16x8 v, float s) {
    u32x4 w = __builtin_bit_cast(u32x4, v), o;
#pragma unroll
    for (int i = 0; i < 4; ++i) o[i] = attn::cvtpk(__uint_as_float(w[i] << 16) * s, __uint_as_float(w[i] & 0xffff0000u) * s);
    return __builtin_bit_cast(bf16x8, o);
}
__device__ __forceinline__ void pk4(const f32x16& P, int base, bf16x8& out) {
    const unsigned a0 = attn::cvtpk(P[base + 0], P[base + 1]), a1 = attn::cvtpk(P[base + 2], P[base + 3]);
    const unsigned b0 = attn::cvtpk(P[base + 4], P[base + 5]), b1 = attn::cvtpk(P[base + 6], P[base + 7]);
    auto r0 = __builtin_amdgcn_permlane32_swap(a0, b0, false, false); auto r1 = __builtin_amdgcn_permlane32_swap(a1, b1, false, false);
    u32x4 w = {r0[0], r1[0], r0[1], r1[1]}; out = __builtin_bit_cast(bf16x8, w);
}
#define RPK(L, H) (bf16x8){L[0], L[1], L[2], L[3], H[0], H[1], H[2], H[3]}

__device__ __forceinline__ void summaries_unit(const Params& p, int q, int h, char* lds) {
    int tid_ = threadIdx.x; asm volatile("" : "+v"(tid_));
    const int tid = tid_, lane = tid & 63, wave = __builtin_amdgcn_readfirstlane(tid >> 6), r32 = lane & 31, hi = lane >> 5;
    const bf16_t* P = ws_big(p) + (size_t)q * 128 * P0W;
    const float lgf = log2_sigmoid(p.dec_f[h]), lgb = log2_sigmoid(p.dec_b[h]);
    const int sr = tid >> 4, sc = (tid & 15) * 8, st0 = attn::v_st(sr, sc), st1 = attn::v_st(32 + sr, sc);
#pragma unroll
    for (int th = 0; th < 2; ++th) {
        const int t0 = th * 64 + sr, t1 = t0 + 32;
        const bf16_t* r0 = P + (size_t)t0 * P0W; const bf16_t* r1 = P + (size_t)t1 * P0W;
#pragma unroll
        for (int eh = 0; eh < 2; ++eh) { char* vt = lds + (th * 2 + eh) * 16384;
            *(bf16x8*)(vt + st0) = *(const bf16x8*)(r0 + C_VA + h * 256 + eh * 128 + sc); *(bf16x8*)(vt + st1) = *(const bf16x8*)(r1 + C_VA + h * 256 + eh * 128 + sc); }
        const bf16x8 k0 = *(const bf16x8*)(r0 + C_KA + h * 128 + sc), k1 = *(const bf16x8*)(r1 + C_KA + h * 128 + sc);
        char* kf = lds + 65536 + th * 16384; char* kb = lds + 98304 + th * 16384;
        *(bf16x8*)(kf + st0) = scale8(k0, __builtin_amdgcn_exp2f((float)(127 - t0) * lgf)); *(bf16x8*)(kf + st1) = scale8(k1, __builtin_amdgcn_exp2f((float)(127 - t1) * lgf));
        *(bf16x8*)(kb + st0) = scale8(k0, __builtin_amdgcn_exp2f((float)t0 * lgb)); *(bf16x8*)(kb + st1) = scale8(k1, __builtin_amdgcn_exp2f((float)t1 * lgb));
    }
    __syncthreads();
    const int lbase = (int)(uintptr_t)lds + attn::v_rd_base(lane);
    f32x16 acc[2][4];
#pragma unroll
    for (int d = 0; d < 2; ++d)
#pragma unroll
        for (int b = 0; b < 4; ++b) acc[d][b] = f32x16{};
#pragma unroll
    for (int th = 0; th < 2; ++th) {
        const int va = lbase + (th * 2 + (wave >> 2)) * 16384 + (wave & 3) * 512, kfb = lbase + 65536 + th * 16384, kbb = lbase + 98304 + th * 16384;
#define R1_STEP(KS) do { \
        const s16x4 al = attn::tr_read<attn::v_rd_off(0, KS, 0)>(va), ah = attn::tr_read<attn::v_rd_off(0, KS, 1)>(va); \
        const s16x4 f0l = attn::tr_read<attn::v_rd_off(0, KS, 0)>(kfb), f0h = attn::tr_read<attn::v_rd_off(0, KS, 1)>(kfb), f1l = attn::tr_read<attn::v_rd_off(1, KS, 0)>(kfb), f1h = attn::tr_read<attn::v_rd_off(1, KS, 1)>(kfb); \
        const s16x4 f2l = attn::tr_read<attn::v_rd_off(2, KS, 0)>(kfb), f2h = attn::tr_read<attn::v_rd_off(2, KS, 1)>(kfb), f3l = attn::tr_read<attn::v_rd_off(3, KS, 0)>(kfb), f3h = attn::tr_read<attn::v_rd_off(3, KS, 1)>(kfb); \
        const s16x4 g0l = attn::tr_read<attn::v_rd_off(0, KS, 0)>(kbb), g0h = attn::tr_read<attn::v_rd_off(0, KS, 1)>(kbb), g1l = attn::tr_read<attn::v_rd_off(1, KS, 0)>(kbb), g1h = attn::tr_read<attn::v_rd_off(1, KS, 1)>(kbb); \
        const s16x4 g2l = attn::tr_read<attn::v_rd_off(2, KS, 0)>(kbb), g2h = attn::tr_read<attn::v_rd_off(2, KS, 1)>(kbb), g3l = attn::tr_read<attn::v_rd_off(3, KS, 0)>(kbb), g3h = attn::tr_read<attn::v_rd_off(3, KS, 1)>(kbb); \
        asm volatile("s_waitcnt lgkmcnt(0)" ::: "memory"); __builtin_amdgcn_sched_barrier(0); \
        const bf16x8 a = RPK(al, ah); \
        acc[0][0] = __builtin_amdgcn_mfma_f32_32x32x16_bf16(a, RPK(f0l, f0h), acc[0][0], 0, 0, 0); acc[0][1] = __builtin_amdgcn_mfma_f32_32x32x16_bf16(a, RPK(f1l, f1h), acc[0][1], 0, 0, 0); \
        acc[0][2] = __builtin_amdgcn_mfma_f32_32x32x16_bf16(a, RPK(f2l, f2h), acc[0][2], 0, 0, 0); acc[0][3] = __builtin_amdgcn_mfma_f32_32x32x16_bf16(a, RPK(f3l, f3h), acc[0][3], 0, 0, 0); \
        acc[1][0] = __builtin_amdgcn_mfma_f32_32x32x16_bf16(a, RPK(g0l, g0h), acc[1][0], 0, 0, 0); acc[1][1] = __builtin_amdgcn_mfma_f32_32x32x16_bf16(a, RPK(g1l, g1h), acc[1][1], 0, 0, 0); \
        acc[1][2] = __builtin_amdgcn_mfma_f32_32x32x16_bf16(a, RPK(g2l, g2h), acc[1][2], 0, 0, 0); acc[1][3] = __builtin_amdgcn_mfma_f32_32x32x16_bf16(a, RPK(g3l, g3h), acc[1][3], 0, 0, 0); \
        __builtin_amdgcn_sched_barrier(0); } while (0)
        R1_STEP(0); R1_STEP(1); R1_STEP(2); R1_STEP(3);
#undef R1_STEP
    }
#pragma unroll
    for (int d = 0; d < 2; ++d) { bf16_t* dst = slot(p, d, q, h);
#pragma unroll
        for (int db = 0; db < 4; ++db)
#pragma unroll
            for (int r = 0; r < 16; ++r) dst[(size_t)(32 * wave + attn::crow(r, hi)) * 128 + 32 * db + r32] = (bf16_t)(attn::cvtpk(acc[d][db][r], 0.f) & 0xffffu); }
    __syncthreads();
}

__device__ __forceinline__ void state_scan(const Params& p) {
    int tid_ = threadIdx.x; asm volatile("" : "+v"(tid_));
    for (long gt = (long)blockIdx.x * NTHR + tid_; gt < 2L * 4 * 16384; gt += (long)gridDim.x * NTHR) {
    const int pair = (int)(gt & 16383), h = (int)((gt >> 14) & 3), dir = (int)(gt >> 16);
    const float G = __builtin_amdgcn_exp2f(128.0f * log2_sigmoid((dir ? p.dec_b : p.dec_f)[h]));
    float s0 = 0.f, s1 = 0.f;
    for (int n = 0; n < NQ; ++n) {
        const int q = dir == 0 ? n : (n < 2 ? 1 - n : NQ + 1 - n);
        unsigned* ptr = (unsigned*)slot(p, dir, q, h) + pair;
        const unsigned u = *ptr;
        *ptr = attn::cvtpk(s0, s1);
        s0 = G * s0 + __uint_as_float(u << 16); s1 = G * s1 + __uint_as_float(u & 0xffff0000u);
    }    }
}

__device__ __forceinline__ void output_unit(const Params& p, int q, int h, char* lds) {
    int tid_ = threadIdx.x; asm volatile("" : "+v"(tid_));
    const int tid = tid_, lane = tid & 63, wave = __builtin_amdgcn_readfirstlane(tid >> 6), r32 = lane & 31, hi = lane >> 5;
    const int ib = wave >> 1, eh = wave & 1;
    const bf16_t* P = ws_big(p) + (size_t)q * 128 * P0W;
    const float lgf = log2_sigmoid(p.dec_f[h]), lgb = log2_sigmoid(p.dec_b[h]);
    { const int sr = tid >> 4, sc = (tid & 15) * 8, st0 = attn::v_st(sr, sc), st1 = attn::v_st(32 + sr, sc);
#pragma unroll
      for (int jt = 0; jt < 2; ++jt) {
          const bf16_t* r0 = P + (size_t)(jt * 64 + sr) * P0W; const bf16_t* r1 = r0 + (size_t)32 * P0W;
          char* kt = lds + jt * 16384;
          *(bf16x8*)(kt + RKSWZ(sr, sc * 2)) = *(const bf16x8*)(r0 + C_KA + h * 128 + sc); *(bf16x8*)(kt + RKSWZ(32 + sr, sc * 2)) = *(const bf16x8*)(r1 + C_KA + h * 128 + sc);
#pragma unroll
          for (int e2 = 0; e2 < 2; ++e2) { char* vt = lds + 32768 + (jt * 2 + e2) * 16384;
              *(bf16x8*)(vt + st0) = *(const bf16x8*)(r0 + C_VA + h * 256 + e2 * 128 + sc); *(bf16x8*)(vt + st1) = *(const bf16x8*)(r1 + C_VA + h * 256 + e2 * 128 + sc); }
      } }
    bf16x8 qr[8];
    { const bf16_t* Qw = P + (size_t)(ib * 32 + r32) * P0W + C_QA + h * 128 + hi * 8;
#pragma unroll
      for (int d0 = 0; d0 < 8; ++d0) qr[d0] = *(const bf16x8*)(Qw + d0 * 16); }
    const bf16_t* Sf = slot(p, 0, q, h) + (size_t)(eh * 128 + r32) * 128 + hi * 8; const bf16_t* Sb = slot(p, 1, q, h) + (size_t)(eh * 128 + r32) * 128 + hi * 8;
    bf16x8 fa[8], fb[8];
#define RET_LOADB(F, S, sb) do { _Pragma("unroll") for (int s_ = 0; s_ < 2; ++s_) _Pragma("unroll") for (int d0 = 0; d0 < 4; ++d0) F[s_ * 4 + d0] = *(const bf16x8*)((S) + (size_t)d0 * 32 * 128 + ((sb) * 2 + s_) * 16); } while (0)
#define RET_MMAB(F, sc, sb) do { _Pragma("unroll") for (int s_ = 0; s_ < 2; ++s_) { const bf16x8 a = scale8(qr[(sb) * 2 + s_], sc); \
        _Pragma("unroll") for (int d0 = 0; d0 < 4; ++d0) o[d0] = __builtin_amdgcn_mfma_f32_32x32x16_bf16(a, F[s_ * 4 + d0], o[d0], 0, 0, 0); } } while (0)
    RET_LOADB(fa, Sf, 0);
    __syncthreads();
    f32x16 o[4] = {};
    const int i_loc = ib * 32 + r32;
    const int vb0 = (int)(uintptr_t)lds + 32768 + attn::v_rd_base(lane);
#pragma unroll
    for (int jt = 0; jt < 2; ++jt) {
        f32x16 p0, p1;
        attn::qkt(p0, p1, (const attn::bf16*)(lds + jt * 16384), qr, r32, hi);
#pragma unroll
        for (int r = 0; r < 16; ++r) {
            const int j0 = jt * 64 + attn::crow(r, hi), dl0 = i_loc - j0, dl1 = dl0 - 32;
            const float m0 = dl0 > 0 ? __builtin_amdgcn_exp2f((float)dl0 * lgf) : (dl0 < 0 ? __builtin_amdgcn_exp2f((float)(-dl0) * lgb) : 2.0f);
            const float m1 = dl1 > 0 ? __builtin_amdgcn_exp2f((float)dl1 * lgf) : (dl1 < 0 ? __builtin_amdgcn_exp2f((float)(-dl1) * lgb) : 2.0f);
            p0[r] *= m0; p1[r] *= m1;
        }
        bf16x8 pa0, pa1, pa2, pa3; pk4(p0, 0, pa0); pk4(p0, 8, pa1); pk4(p1, 0, pa2); pk4(p1, 8, pa3);
        __builtin_amdgcn_sched_barrier(0);
        attn::pv_d0(o, vb0 + (jt * 2 + eh) * 16384, pa0, pa1, pa2, pa3);
    }
    { const float scf = __builtin_amdgcn_exp2f((float)(i_loc + 1) * lgf), scb = __builtin_amdgcn_exp2f((float)(128 - i_loc) * lgb);
      RET_LOADB(fb, Sf, 1); __builtin_amdgcn_sched_barrier(0);
      RET_MMAB(fa, scf, 0); __builtin_amdgcn_sched_barrier(0); RET_LOADB(fa, Sf, 2); __builtin_amdgcn_sched_barrier(0);
      RET_MMAB(fb, scf, 1); __builtin_amdgcn_sched_barrier(0); RET_LOADB(fb, Sf, 3); __builtin_amdgcn_sched_barrier(0);
      RET_MMAB(fa, scf, 2); __builtin_amdgcn_sched_barrier(0); RET_LOADB(fa, Sb, 0); __builtin_amdgcn_sched_barrier(0);
      RET_MMAB(fb, scf, 3); __builtin_amdgcn_sched_barrier(0); RET_LOADB(fb, Sb, 1); __builtin_amdgcn_sched_barrier(0);
      RET_MMAB(fa, scb, 0); __builtin_amdgcn_sched_barrier(0); RET_LOADB(fa, Sb, 2); __builtin_amdgcn_sched_barrier(0);
      RET_MMAB(fb, scb, 1); __builtin_amdgcn_sched_barrier(0); RET_LOADB(fb, Sb, 3); __builtin_amdgcn_sched_barrier(0);
      RET_MMAB(fa, scb, 2); __builtin_amdgcn_sched_barrier(0);
      RET_MMAB(fb, scb, 3); }
#undef RET_LOADB
#undef RET_MMAB
    __syncthreads();
    float* O = (float*)lds;
#pragma unroll
    for (int r = 0; r < 16; ++r)
#pragma unroll
        for (int d0 = 0; d0 < 4; ++d0) O[(ib * 32 + attn::crow(r, hi)) * 256 + eh * 128 + d0 * 32 + r32] = o[d0][r];
    __syncthreads();
    bf16_t* BR = ws_br(p) + (size_t)q * 128 * 2048 + h * 256;
#pragma unroll 4
    for (int rr = 0; rr < 16; ++rr) {
        const int row = wave * 16 + rr; const f32x4 x = *(const f32x4*)(O + row * 256 + lane * 4);
        const float mean = rw::wave_sum((x[0] + x[1]) + (x[2] + x[3])) * (1.0f / 256.f);
        const f32x4 d = x - mean;
        const float var = rw::wave_sum((d[0] * d[0] + d[1] * d[1]) + (d[2] * d[2] + d[3] * d[3])) * (1.0f / 256.f);
        const float rstd = 1.0f / sqrtf(var + NORM_EPS);
        f32x4 y = d * rstd;
        if (q < 2) { const u32x2 gg = *(const u32x2*)((const bf16_t*)(p.ws + 255 * MiB) + (size_t)(q * 128 + row) * 2048 + h * 256 + lane * 4);
            y[0] *= __uint_as_float(gg.x << 16); y[1] *= __uint_as_float(gg.x & 0xffff0000u); y[2] *= __uint_as_float(gg.y << 16); y[3] *= __uint_as_float(gg.y & 0xffff0000u); }
        u32x2 w; w.x = attn::cvtpk(y[0], y[1]); w.y = attn::cvtpk(y[2], y[3]);
        *(u32x2*)(BR + (size_t)row * 2048 + lane * 4) = w;
    }
    __syncthreads();
}
#undef RPK
#undef RKSWZ
}

namespace na {
using attn::bf16x8; using attn::f32x16; using attn::u32x4;
constexpr float L2E = 1.4426950408889634f;
constexpr int WH = GROWS < 8 ? GROWS : 8;
constexpr int L_K = 0, L_V = 32768, L_WS = 65536, L_RPB = L_WS + NWAVES * 64 * 4, L_END = L_RPB + 15 * 31 * 4;
#define NKSWZ(row, colB) ((row) * 256 + ((colB) ^ (((row) & 7) << 4)))
__device__ __forceinline__ int win_r0(int r) { int r0 = r - WH / 2; return r0 < 0 ? 0 : (r0 > GROWS - WH ? GROWS - WH : r0); }
__device__ __forceinline__ int win_c0(int c) { int c0 = c - 8; return c0 < 0 ? 0 : (c0 > GW - 16 ? GW - 16 : c0); }

__device__ __forceinline__ void na_unit(const Params& p, int rg, int h, char* lds) {
    int tid_ = threadIdx.x; asm volatile("" : "+v"(tid_));
    const int tid = tid_, lane = tid & 63, wave = __builtin_amdgcn_readfirstlane(tid >> 6), r32 = lane & 31, hi = lane >> 5;
    const bf16_t* P = ws_big(p); const bf16_t* NAC = (const bf16_t*)(p.ws + 255 * MiB);
    const int r = 4 * rg + (wave >> 1), qc = (wave & 1) * 32 + r32, my_r0 = win_r0(r), my_c0 = win_c0(qc);
    const int lo = win_r0(4 * rg), hiw = win_r0(4 * rg + 3) + WH, NT = hiw - lo + CTXN / 64;
    float* wsf = (float*)(lds + L_WS) + wave * 64; float* rpb_l = (float*)(lds + L_RPB);
    if (tid < 15 * 31) rpb_l[tid] = p.rpb[h * 15 * 31 + tid];
    bf16x8 qr[4];
    { const bf16_t* Qw = P + (size_t)(CTXN + r * 64 + qc) * NAW + h * 64 + hi * 8;
#pragma unroll
      for (int d0 = 0; d0 < 4; ++d0) qr[d0] = *(const bf16x8*)(Qw + d0 * 16); }
    const int sk = tid >> 3, sc = (tid & 7) * 8, kst = NKSWZ(sk, sc * 2), vst = attn::v_st(sk, sc);
    bf16x8 kA, vA, kB, vB;
#define NA_LOAD(KR, VR, t) do { if ((t) < hiw - lo) { const int krow_ = CTXN + (lo + (t)) * 64 + sk; \
            KR = *(const bf16x8*)(P + (size_t)krow_ * NAW + 1024 + h * 64 + sc); VR = *(const bf16x8*)(P + (size_t)krow_ * NAW + 2048 + h * 64 + sc); } \
        else { const bf16_t* c_ = NAC + (size_t)(((t) - (hiw - lo)) * 64 + sk) * 2048 + h * 64 + sc; KR = *(const bf16x8*)c_; VR = *(const bf16x8*)(c_ + 1024); } } while (0)
#define NA_WRITE(KR, VR, b) do { *(bf16x8*)(lds + L_K + (b) * 16384 + kst) = KR; *(bf16x8*)(lds + L_V + (b) * 16384 + vst) = VR; } while (0)
    NA_LOAD(kA, vA, 0); NA_WRITE(kA, vA, 0);
    NA_LOAD(kB, vB, 1);
    __syncthreads();
    float m_reg = -1e30f, l_reg = 0.f; f32x16 o[2] = {};
    const int vb0 = (int)(uintptr_t)lds + L_V + attn::v_rd_base(lane);
#define NA_TILE(t, KW, VW, KL, VL) do { \
        if ((t) + 2 < NT) NA_LOAD(KL, VL, (t) + 2);            \
        const bool is_ctx = (t) >= hiw - lo; const int kr = lo + (t); \
        if (is_ctx || (kr >= my_r0 && kr < my_r0 + WH)) { \
            const char* Ks = lds + L_K + ((t) & 1) * 16384; \
            f32x16 p0 = {}, p1 = {}; \
            _Pragma("unroll") for (int d0 = 0; d0 < 4; ++d0) { const int cb = (d0 * 16 + hi * 8) * 2; \
                const bf16x8 b0 = *(const bf16x8*)(Ks + NKSWZ(r32, cb)), b1 = *(const bf16x8*)(Ks + NKSWZ(32 + r32, cb)); \
                p0 = __builtin_amdgcn_mfma_f32_32x32x16_bf16(b0, qr[d0], p0, 0, 0, 0); p1 = __builtin_amdgcn_mfma_f32_32x32x16_bf16(b1, qr[d0], p1, 0, 0, 0); } \
            if (is_ctx) { \
                _Pragma("unroll") for (int q = 0; q < 16; ++q) { p0[q] *= 0.125f; p1[q] *= 0.125f; } \
            } else { \
                const float* brow = rpb_l + (kr - r + 7) * 31 + 15 - qc; \
                _Pragma("unroll") for (int q = 0; q < 16; ++q) { const int kc0 = attn::crow(q, hi), kc1 = kc0 + 32; \
                    const bool v0 = kc0 >= my_c0 && kc0 < my_c0 + 16, v1 = kc1 >= my_c0 && kc1 < my_c0 + 16; \
                    p0[q] = v0 ? p0[q] * 0.125f + brow[v0 ? kc0 : qc] : -1e30f; p1[q] = v1 ? p1[q] * 0.125f + brow[v1 ? kc1 : qc] : -1e30f; } \
            } \
            float pmax = p0[0]; \
            _Pragma("unroll") for (int q = 1; q < 16; ++q) pmax = fmaxf(pmax, p0[q]); \
            _Pragma("unroll") for (int q = 0; q < 16; ++q) pmax = fmaxf(pmax, p1[q]); \
            { auto rr = __builtin_amdgcn_permlane32_swap(__float_as_uint(pmax), __float_as_uint(pmax), false, false); pmax = fmaxf(__uint_as_float(rr[0]), __uint_as_float(rr[1])); } \
            const float mn = fmaxf(m_reg, pmax), alpha = __builtin_amdgcn_exp2f((m_reg - mn) * L2E), mnl = -mn * L2E; m_reg = mn; \
            float ps = 0.f; \
            _Pragma("unroll") for (int q = 0; q < 16; ++q) { p0[q] = __builtin_amdgcn_exp2f(fmaf(p0[q], L2E, mnl)); p1[q] = __builtin_amdgcn_exp2f(fmaf(p1[q], L2E, mnl)); ps += p0[q] + p1[q]; } \
            { auto rr = __builtin_amdgcn_permlane32_swap(__float_as_uint(ps), __float_as_uint(ps), false, false); ps = __uint_as_float(rr[0]) + __uint_as_float(rr[1]); } \
            l_reg = l_reg * alpha + ps; \
            if (__any(alpha < 1.f)) { if (hi == 0) wsf[r32] = alpha; asm volatile("s_waitcnt lgkmcnt(0)" ::: "memory"); \
                _Pragma("unroll") for (int d = 0; d < 2; ++d) _Pragma("unroll") for (int q = 0; q < 16; ++q) o[d][q] *= wsf[attn::crow(q, hi)]; } \
            bf16x8 pa0, pa1, pa2, pa3; ret::pk4(p0, 0, pa0); ret::pk4(p0, 8, pa1); ret::pk4(p1, 0, pa2); ret::pk4(p1, 8, pa3); \
            __builtin_amdgcn_sched_barrier(0); \
            const int vb = vb0 + ((t) & 1) * 16384; \
            attn::pv_one<0>(o[0], vb, pa0, pa1, pa2, pa3); attn::pv_one<1>(o[1], vb, pa0, pa1, pa2, pa3); \
        } \
        if ((t) + 1 < NT) NA_WRITE(KW, VW, ((t) + 1) & 1);     \
        __syncthreads(); } while (0)
    for (int t = 0; t < NT; t += 2) {
        NA_TILE(t, kB, vB, kA, vA);
        if (t + 1 < NT) NA_TILE(t + 1, kA, vA, kB, vB);
    }
#undef NA_TILE
#undef NA_LOAD
#undef NA_WRITE
    if (hi == 0) wsf[32 + r32] = l_reg; asm volatile("s_waitcnt lgkmcnt(0)" ::: "memory");
    bf16_t* Ow = ws_br(p) + (size_t)(CTXN + r * 64 + (wave & 1) * 32) * 2048 + h * 64;
#pragma unroll
    for (int q = 0; q < 16; ++q) { const int orow = attn::crow(q, hi); const float rl = __builtin_amdgcn_rcpf(wsf[32 + orow]);
#pragma unroll
        for (int d0 = 0; d0 < 2; ++d0) Ow[(size_t)orow * 2048 + d0 * 32 + r32] = (bf16_t)(attn::cvtpk(o[d0][q] * rl, 0.f) & 0xffffu); }
    __syncthreads();
}
#undef NKSWZ
}

namespace el {
typedef float f32x4 __attribute__((ext_vector_type(4)));
typedef unsigned u32x2 __attribute__((ext_vector_type(2)));
__device__ __forceinline__ float wsum(float v) { return rw::wave_sum(v); }
__device__ __forceinline__ unsigned pk(float lo, float hi) { unsigned r; asm volatile("v_cvt_pk_bf16_f32 %0, %1, %2" : "=v"(r) : "v"(lo), "v"(hi)); return r; }

__device__ __forceinline__ void mod_phase(const Params& p, char* lds) {
    int tid_ = threadIdx.x; asm volatile("" : "+v"(tid_));
    const int tid = tid_, ks = tid >> 6, jl = tid & 63;
    float* sc = (float*)lds; float* red = sc + 2048;
    for (int b = blockIdx.x; b < 2 * 48; b += gridDim.x) {
        const int l = b / 48, j = (b % 48) * 64 + jl;
        __syncthreads();
        for (int k = tid; k < 2048; k += NTHR) { const float x = k < 1024 ? p.c[k] : p.c_ctx[k - 1024]; sc[k] = x / (1.0f + __expf(-x)); }
        __syncthreads();
        const float* w = p.w_mod + (size_t)l * DM * 3072 + (size_t)(ks * 128) * 3072 + j; float a0 = 0.f, a1 = 0.f;
#pragma unroll 8
        for (int k = 0; k < 128; ++k) { const float wv = w[(size_t)k * 3072]; a0 += sc[ks * 128 + k] * wv; a1 += sc[1024 + ks * 128 + k] * wv; }
        red[ks * 64 + jl] = a0; red[512 + ks * 64 + jl] = a1;
        __syncthreads();
        if (tid < 128) { const int s = tid >> 6; float t = 0.f;
#pragma unroll
            for (int q = 0; q < 8; ++q) t += red[s * 512 + q * 64 + jl];
            ws_modv(p)[(l * 2 + s) * 3072 + j] = t + p.b_mod[l * 3072 + j]; }
    }
    __syncthreads();
}

template <int LAYER> __device__ __forceinline__ void modnorm_store(const Params& p, const f32x4 (&v)[4], int row, int lane) {
    const float* mv = ws_modv(p) + (LAYER * 2 + (row < CTXN ? 1 : 0)) * 3072; const float* g = p.g_pre + LAYER * DM;
    float ss = 0.f;
#pragma unroll
    for (int j = 0; j < 4; ++j) ss += (v[j][0] * v[j][0] + v[j][1] * v[j][1]) + (v[j][2] * v[j][2] + v[j][3] * v[j][3]);
    const float rstd = 1.0f / sqrtf(wsum(ss) * (1.0f / DM) + NORM_EPS);
    bf16_t* o = ws_xn(p) + (size_t)row * DM;
#pragma unroll
    for (int j = 0; j < 4; ++j) { const int c = lane * 4 + 256 * j;
        const f32x4 gg = *(const f32x4*)(g + c), sh = *(const f32x4*)(mv + c), sc = *(const f32x4*)(mv + 1024 + c);
        const f32x4 y = v[j] * rstd * gg * (sc + 1.0f) + sh;
        u32x2 w; w.x = pk(y[0], y[1]); w.y = pk(y[2], y[3]); *(u32x2*)(o + c) = w; }
}
__device__ __forceinline__ void prenorm0_phase(const Params& p) {
    int tid_ = threadIdx.x; asm volatile("" : "+v"(tid_));
    const int lane = tid_ & 63, gw = (int)blockIdx.x * NWAVES + (tid_ >> 6), ngw = (int)gridDim.x * NWAVES;
    for (int row = gw; row < R; row += ngw) {
        const float* src = row < CTXN ? p.ctx + (size_t)row * DM : p.x + (size_t)(row - CTXN) * DM;
        f32x4 v[4];
#pragma unroll
        for (int j = 0; j < 4; ++j) v[j] = *(const f32x4*)(src + lane * 4 + 256 * j);
        modnorm_store<0>(p, v, row, lane);
    }
}
template <int LAYER> __device__ __forceinline__ void resid_phase(const Params& p) {
    int tid_ = threadIdx.x; asm volatile("" : "+v"(tid_));
    const int lane = tid_ & 63, gw = (int)blockIdx.x * NWAVES + (tid_ >> 6), ngw = (int)gridDim.x * NWAVES;
    for (int row = (LAYER == 0 ? 0 : CTXN) + gw; row < R; row += ngw) {
        const bool ctxsum = LAYER == 0 && row < CTXN;
        const float* y = ctxsum ? (const float*)(p.ws + WS_BIG + 72 * MiB) + (size_t)row * DM : ws_y(p) + (size_t)row * DM; const float* mv = ws_modv(p) + (LAYER * 2 + (row < CTXN ? 1 : 0)) * 3072 + 2048; const float* g = p.g_post + LAYER * DM;
        const float* src; float* dst;
        if (row < CTXN) { src = p.ctx + (size_t)row * DM; dst = ws_ctx1(p) + (size_t)row * DM; }
        else { src = (LAYER == 0 ? p.x : p.out) + (size_t)(row - CTXN) * DM; dst = p.out + (size_t)(row - CTXN) * DM; }
        f32x4 yv[4]; float ss = 0.f;
#pragma unroll
        for (int j = 0; j < 4; ++j) { yv[j] = *(const f32x4*)(y + lane * 4 + 256 * j);
            if (ctxsum) { _Pragma("unroll") for (int s = 1; s < 8; ++s) yv[j] += *(const f32x4*)(y + (size_t)s * CTXN * DM + lane * 4 + 256 * j); }
            ss += (yv[j][0] * yv[j][0] + yv[j][1] * yv[j][1]) + (yv[j][2] * yv[j][2] + yv[j][3] * yv[j][3]); }
        const float rstd = 1.0f / sqrtf(wsum(ss) * (1.0f / DM) + NORM_EPS);
        f32x4 xn[4];
#pragma unroll
        for (int j = 0; j < 4; ++j) { const int c = lane * 4 + 256 * j;
            xn[j] = *(const f32x4*)(src + c) + *(const f32x4*)(mv + c) * (yv[j] * rstd * *(const f32x4*)(g + c));
            *(f32x4*)(dst + c) = xn[j]; }
        if (LAYER == 0) modnorm_store<1>(p, xn, row, lane);
    }
}
__device__ __forceinline__ void ropenorm_phase(const Params& p) {
    int tid_ = threadIdx.x; asm volatile("" : "+v"(tid_));
    const int lane = tid_ & 63, gw = (int)blockIdx.x * NWAVES + (tid_ >> 6), ngw = (int)gridDim.x * NWAVES;
    const float* ct = ws_rope(p); const float* st = ct + N_ROPE;
    const float qn0 = p.q_norm[2 * lane], qn1 = p.q_norm[2 * lane + 1], kn0 = p.k_norm[2 * lane], kn1 = p.k_norm[2 * lane + 1];
    for (int row = gw; row < R; row += ngw) {
        const bool rot = row >= CTXN; const int t = row - CTXN; float cs = 1.f, sn = 0.f;
        if (rot) { const int pos = lane < 32 ? t / GW : t % GW, f = lane & 31; cs = ct[pos * 32 + f]; sn = st[pos * 32 + f]; }
        bf16_t* base = ws_big(p) + (size_t)row * P0W;
#pragma unroll
        for (int slot = 0; slot < 18; ++slot) {
            const int col = slot < 4 ? C_QA + slot * 128 : slot < 8 ? C_KA + (slot - 4) * 128 : slot < 16 ? C_QB + (slot - 8) * 128 : C_KB + (slot - 16) * 128;
            unsigned* ptr = (unsigned*)(base + col) + lane; const unsigned u = *ptr;
            float x1 = __uint_as_float(u << 16), x2 = __uint_as_float(u & 0xffff0000u);
            if (slot >= 4 && slot < 8) { x1 *= 0.08838834764831845f; x2 *= 0.08838834764831845f; }
            if (slot >= 8) { const float sc = 1.0f / sqrtf(wsum(x1 * x1 + x2 * x2) * (1.0f / 128.f) + NORM_EPS);
                x1 *= sc * (slot < 16 ? qn0 : kn0); x2 *= sc * (slot < 16 ? qn1 : kn1); }
            *ptr = pk(x1 * cs - x2 * sn, x1 * sn + x2 * cs);
        }
    }
}
}

constexpr int RING_BYTES = 131072, LDS_BYTES = 163840;
constexpr size_t WS_BAR = 256 * 1024;
constexpr size_t WS_SIDE = 255 * MiB;
constexpr size_t WS_YC = WS_BIG + 72 * MiB;
constexpr int LDS_BARW = LDS_BYTES - 64;
constexpr size_t WB_IN0 = WS_WB, WB_OUT0 = WB_IN0 + (size_t)EVEN_IN * DM * 2, WB_IN1 = WB_OUT0 + (size_t)DM * 2048 * 2, WB_OUT1 = WB_IN1 + (size_t)ODD_IN * DM * 2, WB_END = WB_OUT1 + (size_t)DM * 2048 * 2;
static_assert(WB_END <= WS_XN, "weight copies overflow their region");
static_assert(wy::WS_RING + wy::RING_TOTAL <= WB_IN1 && XCD_BAR_WORDS * 4 <= 16384 && wy::WS_WYF + (size_t)wy::WYF_WORDS * 4 <= WS_CTX1, "rwkv ring / flag words");

__device__ __forceinline__ unsigned pk2(float lo, float hi) { return (unsigned)f2bf(lo) | ((unsigned)f2bf(hi) << 16); }
__device__ __forceinline__ void transpose_item(const float* W, int K, int N, int ldw, bf16_t* WT, LAS float* scr, int item, int lane) {
    const int nblk = N / 32, kb = item / nblk, nb = item % nblk, k0 = 64 * kb, n0 = 32 * nb;
#pragma unroll 8
    for (int i = 0; i < 32; ++i) { const int kk = 2 * i + (lane >> 5); scr[kk * 33 + (lane & 31)] = W[(size_t)(k0 + kk) * ldw + n0 + (lane & 31)]; }
    asm volatile("s_waitcnt lgkmcnt(0)" ::: "memory");
    const int c = lane & 7;
#pragma unroll
    for (int j = 0; j < 4; ++j) { const int n = (lane >> 3) + 8 * j; const LAS float* s = scr + (8 * c) * 33 + n;
        v4u o; o.x = pk2(s[0 * 33], s[1 * 33]); o.y = pk2(s[2 * 33], s[3 * 33]); o.z = pk2(s[4 * 33], s[5 * 33]); o.w = pk2(s[6 * 33], s[7 * 33]);
        *(v4u*)(WT + (size_t)(n0 + n) * K + k0 + 8 * c) = o; }
    asm volatile("s_waitcnt lgkmcnt(0)" ::: "memory");
}
__device__ __forceinline__ void p0_weights(const Params& p, LAS unsigned char* lds) {
    const int lane = threadIdx.x & 63, wave = __builtin_amdgcn_readfirstlane(threadIdx.x >> 6);
    LAS float* scr = (LAS float*)(lds + wave * 16384);
    const int gw = blockIdx.x * NWAVES + wave, NGW = gridDim.x * NWAVES;
    constexpr int I_IN0 = (DM / 64) * (EVEN_IN / 32), I_OUT = (2048 / 64) * (DM / 32), I_IN1 = (DM / 64) * (ODD_IN / 32);
    for (int it = gw; it < I_IN0 + I_OUT + I_IN1 + I_OUT; it += NGW) {
        int r = it;
        if (r < I_IN0) { transpose_item(p.ev_w_in, DM, EVEN_IN, EVEN_IN, (bf16_t*)(p.ws + WB_IN0), scr, r, lane); continue; } r -= I_IN0;
        if (r < I_OUT) { transpose_item(p.ev_w_out, 2048, DM, DM, (bf16_t*)(p.ws + WB_OUT0), scr, r, lane); continue; } r -= I_OUT;
        if (r < I_IN1) { transpose_item(p.od_w_in, DM, ODD_IN, ODD_IN, (bf16_t*)(p.ws + WB_IN1), scr, r, lane); continue; } r -= I_IN1;
        transpose_item(p.od_w_out, 2048, DM, DM, (bf16_t*)(p.ws + WB_OUT1), scr, r, lane);
    }
}

template <class Epi> __device__ __forceinline__ void run_gemm(LAS unsigned char* lds, const bf16_t* A, const bf16_t* Bt, int M, int N, int K, const Epi& E, int rot = 0, int lda = 0, int ldb = 0) {
    const int G = (int)gridDim.x;
    pg8::Gemm g{A, Bt, M, N, K, lda, ldb}; pg8::StaticOrder S; S.init(M, N, G, ((int)blockIdx.x + rot) % G);
    pg8::gemm_phase<Epi, pg8::StaticOrder, true, true>(lds, g, S, E);
}
__device__ __forceinline__ int tail_rot(int units) { const int G = (int)gridDim.x; return (G - units % G) % G; }

#ifndef PROBE
#define PROBE 0
#endif
#define REP(bit) for (int rep_ = 0; rep_ < (((PROBE) >> (bit)) & 1) + 1; ++rep_)
__global__ void __launch_bounds__(NTHR, 2) mega(Params p) {
    extern __shared__ __attribute__((aligned(16))) unsigned char lds_raw[];
    cg::grid_group grid = cg::this_grid();
    LAS unsigned char* lds = (LAS unsigned char*)lds_raw;
    const long gsz = (long)gridDim.x * NTHR;
    if (threadIdx.x < 2) *(LAS unsigned*)(lds + LDS_BARW + 4 * threadIdx.x) = 0u;
    __syncthreads();
    const XcdBarrier xbar = xcd_barrier_post((unsigned*)(p.ws + WS_BAR), (volatile LAS unsigned*)(lds + LDS_BARW));
    const bf16_t* wt_in0 = (const bf16_t*)(p.ws + WB_IN0); const bf16_t* wt_out0 = (const bf16_t*)(p.ws + WB_OUT0);
    const bf16_t* wt_in1 = (const bf16_t*)(p.ws + WB_IN1); const bf16_t* wt_out1 = (const bf16_t*)(p.ws + WB_OUT1);
#define X(fn, n) { int t_ = threadIdx.x; asm volatile("" : "+v"(t_)); for (long g = (long)blockIdx.x * NTHR + t_; g < (long)(n); g += gsz) fn(p, g); }
#define SYNC xcd_barrier(xbar);
    if ((PROBE >> 13) & 1) { for (int i_ = 0; i_ < 20; ++i_) xcd_barrier(xbar); }
    REP(14) { el::mod_phase(p, (char*)lds_raw); X(ph_rope_table, N_ROPE) p0_weights(p, lds);
              if (p.out == nullptr) grid.sync();
              SYNC }
    REP(15) { el::prenorm0_phase(p); SYNC }
    REP(2) { run_gemm(lds, ws_xn(p), wt_in0, R, P0W, DM, pg8::EpiBf16<0>{ws_big(p), P0W, nullptr, 0, 0, 1.f});
             run_gemm(lds, ws_xn(p), wt_in0 + (size_t)C_GA * DM, CTXN, 2048, DM, pg8::EpiSiluBf16{(bf16_t*)(p.ws + WS_SIDE), 2048}, tail_rot((R / 256) * (P0W / 256)));
             SYNC }
    el::ropenorm_phase(p); SYNC
    REP(5) { for (int u = blockIdx.x; u < ret::NQ * 4; u += gridDim.x) { const int q = u < (ret::NQ - 2) * 4 ? 2 + u / 4 : (u - (ret::NQ - 2) * 4) / 4; ret::summaries_unit(p, q, u & 3, (char*)lds_raw); } SYNC }
    ret::state_scan(p); SYNC
#define CTX_ATTN_UNIT(head_) do { const int hd_ = (head_), kv_ = hd_ / 4; const bf16_t* P_ = ws_big(p); bf16_t* BR_ = ws_br(p); \
        attn::attn_dense_body<attn::bf16, false>(P_ + C_QB + hd_ * 128, P_ + C_KB + kv_ * 128, P_ + C_VB + kv_ * 128, BR_ + 1024 + hd_ * 128, CTXN, (char*)lds_raw); \
        __syncthreads(); \
        {     \
            int t_ = threadIdx.x; asm volatile("" : "+v"(t_)); const bf16_t* GC = (const bf16_t*)(p.ws + WS_SIDE); \
            const size_t o = (size_t)(t_ >> 1) * 2048 + 1024 + hd_ * 128 + (t_ & 1) * 64; \
            _Pragma("unroll") for (int i_ = 0; i_ < 8; ++i_) { v4u a = *(const v4u*)(BR_ + o + 8 * i_); const v4u b = *(const v4u*)(GC + o + 8 * i_); \
                _Pragma("unroll") for (int q_ = 0; q_ < 4; ++q_) a[q_] = attn::cvtpk(__uint_as_float(a[q_] << 16) * __uint_as_float(b[q_] << 16), __uint_as_float(a[q_] & 0xffff0000u) * __uint_as_float(b[q_] & 0xffff0000u)); \
                *(v4u*)(BR_ + o + 8 * i_) = a; } \
            __syncthreads(); } } while (0)
    const bool ctx_attn_early = gridDim.x >= 16;
    REP(6) { for (int u = blockIdx.x; u < ret::NQ * 4; u += gridDim.x) { const int q = u < (ret::NQ - 2) * 4 ? 2 + u / 4 : (u - (ret::NQ - 2) * 4) / 4; ret::output_unit(p, q, u & 3, (char*)lds_raw); }
             if (ctx_attn_early && (int)blockIdx.x >= (int)gridDim.x - 8) CTX_ATTN_UNIT((int)blockIdx.x - ((int)gridDim.x - 8));
             SYNC }
    REP(0) {
        const int G = (int)gridDim.x, vcu = (G % 8 == 0) ? ((int)blockIdx.x % 8) * (G / 8) + (int)blockIdx.x / 8 : (int)blockIdx.x;
        const int NLAT = (SEQ / 256) * 8, per = (NLAT + G - 1) / G;
        const bf16_t* P = ws_big(p); bf16_t* BR = ws_br(p);
        bool nomax; { int t_ = threadIdx.x; asm volatile("" : "+v"(t_)); const int l_ = t_ & 63; float gq = fmaxf(fabsf(p.q_norm[l_]), fabsf(p.q_norm[64 + l_])), gk = fmaxf(fabsf(p.k_norm[l_]), fabsf(p.k_norm[64 + l_]));
          for (int m_ = 32; m_ >= 1; m_ >>= 1) { gq = fmaxf(gq, __shfl_xor(gq, m_)); gk = fmaxf(gk, __shfl_xor(gk, m_)); }
          nomax = 11.3137085f * 1.4426950409f * 1.02f * gq * gk <= 40.0f; }
        for (int i = 0; i <= per; ++i) {
            int head, row0, seq;
            if (i < per) { const int unit = vcu * per + i; if (unit >= NLAT) continue; const int nqb = SEQ / 256, kv = unit / (4 * nqb), rem = unit % (4 * nqb); head = kv * 4 + rem / nqb; row0 = CTXN + (rem % nqb) * 256; seq = R; }
            else { if (ctx_attn_early || vcu >= 8) break; CTX_ATTN_UNIT(vcu); break; }
            const int kv = head / 4;
            if (nomax) attn::attn_dense_body<attn::bf16, true>(P + (size_t)row0 * P0W + C_QB + head * 128, P + C_KB + kv * 128, P + C_VB + kv * 128, BR + (size_t)row0 * 2048 + 1024 + head * 128, seq, (char*)lds_raw);
            else attn::attn_dense_body<attn::bf16, false>(P + (size_t)row0 * P0W + C_QB + head * 128, P + C_KB + kv * 128, P + C_VB + kv * 128, BR + (size_t)row0 * 2048 + 1024 + head * 128, seq, (char*)lds_raw);
            __syncthreads();
        }
        if (PROBE & 1) xcd_barrier(xbar);
    }
    SYNC
    run_gemm(lds, ws_xn(p) + (size_t)CTXN * DM, wt_in0 + (size_t)C_GA * DM, SEQ, 2048, DM, pg8::EpiGateMul{ws_br(p) + (size_t)CTXN * 2048, 2048});
    {
        pg8::Gemm gk{ws_br(p), wt_out0, 8 * 256, DM, 256, 2048, 2048, 256 * 2}; pg8::StaticOrder S; S.init(8 * 256, DM, (int)gridDim.x, (int)blockIdx.x);
        pg8::gemm_phase<pg8::EpiF32, pg8::StaticOrder, true, true>(lds, gk, S, pg8::EpiF32{(float*)(p.ws + WS_YC), DM}); }
    SYNC
    REP(4) { run_gemm(lds, ws_br(p) + (size_t)CTXN * 2048, wt_out0, SEQ, DM, 2048, pg8::EpiF32{ws_y(p) + (size_t)CTXN * DM, DM}); SYNC }
    REP(15) { el::resid_phase<0>(p); SYNC }
    REP(3) { run_gemm(lds, ws_xn(p), wt_in1 + (size_t)O_RW * DM, R, ZW, DM, pg8::EpiBf16<0>{ws_big(p), ZW, nullptr, 0, 0, 1.f});
             run_gemm(lds, ws_xn(p), wt_in1 + (size_t)(O_NA + 1024) * DM, CTXN, 2048, DM, pg8::EpiBf16<0>{(bf16_t*)(p.ws + WS_SIDE), 2048, nullptr, 0, 0, 1.f}, tail_rot((R / 256) * (ZW / 256)));
             SYNC }
    rw::shift_halo(p); SYNC
    rw::shift_inplace(p); wy::zero_words(p); SYNC
#ifndef PSKIP
#define PSKIP 0
#endif
    if ((PROBE >> 16) & 1) { wy::phase<1, PSKIP>(p, lds); SYNC wy::zero_words(p); SYNC }
    if ((PROBE >> 17) & 1) { wy::phase<2>(p, lds); SYNC wy::zero_words(p); SYNC }
    if ((PROBE >> 18) & 1) { wy::phase<3>(p, lds); SYNC wy::zero_words(p); SYNC }
    if (gridDim.x >= 64) wy::phase<0>(p, lds);
    else { for (int b = blockIdx.x; b < 256; b += gridDim.x) rw::scan_block<0>(p, b, lds); }
    SYNC
    rw::finish_phase(p); SYNC
    REP(3) { run_gemm(lds, ws_xn(p) + (size_t)CTXN * DM, wt_in1 + (size_t)O_NA * DM, SEQ, NAW, DM, pg8::EpiBf16<0>{ws_big(p) + (size_t)CTXN * NAW, NAW, nullptr, 0, 0, 1.f}); SYNC }
    REP(7) { for (int u = blockIdx.x; u < (GROWS / 4) * 16; u += gridDim.x) na::na_unit(p, u >> 4, u & 15, (char*)lds_raw); SYNC }
    run_gemm(lds, ws_xn(p) + (size_t)CTXN * DM, wt_in1 + (size_t)O_GC * DM, SEQ, 2048, DM, pg8::EpiGateMul{ws_br(p) + (size_t)CTXN * 2048, 2048}); SYNC
    REP(4) { run_gemm(lds, ws_br(p) + (size_t)CTXN * 2048, wt_out1, SEQ, DM, 2048, pg8::EpiF32{ws_y(p) + (size_t)CTXN * DM, DM}); SYNC }
    el::resid_phase<1>(p);
#undef X
#undef SYNC
}

extern "C" void kernel_launch(void* const* d_in, const int* in_sizes, int n_in, void* d_out, int out_size, void* d_ws, size_t ws_size, hipStream_t stream) {
    static int grid_blocks = 0;
    if (!grid_blocks) {
        int dev = 0, cus = 0, per_cu = 0;
        (void)hipGetDevice(&dev); (void)hipDeviceGetAttribute(&cus, hipDeviceAttributeMultiprocessorCount, dev);
        (void)hipFuncSetAttribute((const void*)mega, hipFuncAttributeMaxDynamicSharedMemorySize, LDS_BYTES);
        (void)hipOccupancyMaxActiveBlocksPerMultiprocessor(&per_cu, mega, NTHR, LDS_BYTES);
        if (per_cu < 1) per_cu = 1;
        grid_blocks = cus * per_cu;
        if (ws_size < WS_END) fprintf(stderr, "kernel_launch: workspace too small: %zu < %zu\n", ws_size, (size_t)WS_END);
    }
    (void)hipMemsetAsync((char*)d_ws + WS_BAR, 0, XCD_BAR_WORDS * 4, stream);
    Params p = make_params(d_in, d_out, d_ws);
    void* args[] = {&p};
    hipError_t e = hipLaunchCooperativeKernel((void*)mega, dim3(grid_blocks), dim3(NTHR), args, LDS_BYTES, stream);
    if (e != hipSuccess) fprintf(stderr, "cooperative launch failed: %s (grid %d)\n", hipGetErrorString(e), grid_blocks);
}

#else
int main(int argc, char** argv) {
    const char* dir = argc > 1 ? argv[1] : "data";
    char path[512]; snprintf(path, 512, "%s/sizes.txt", dir); FILE* f = fopen(path, "r"); if (!f) { printf("no sizes\n"); return 1; }
    std::vector<long> sizes; long v; while (fscanf(f, "%ld", &v) == 1) sizes.push_back(v); fclose(f);
    if (sizes.size() != 31) { printf("bad n inputs %zu\n", sizes.size()); return 1; }
    snprintf(path, 512, "%s/inputs.bin", dir); f = fopen(path, "rb");
    std::vector<std::vector<float>> in(31); std::vector<void*> ptrs(31);
    for (int i = 0; i < 31; ++i) { in[i].resize(sizes[i]); if (fread(in[i].data(), 4, sizes[i], f) != (size_t)sizes[i]) { printf("short read\n"); return 1; } ptrs[i] = in[i].data(); }
    fclose(f);
    if (sizes[0] != (long)SEQ * DM) { printf("SEQ mismatch: build with -DSEQ_LEN=%ld\n", sizes[0] / DM); return 1; }
    std::vector<float> out((size_t)SEQ * DM, 0.f); std::vector<unsigned char> ws(WS_END, 0xAA);
    Params p = make_params(ptrs.data(), out.data(), ws.data());
    auto check = [&](const char* name, const float* got, size_t n) {
        snprintf(path, 512, "%s/%s", dir, name); FILE* g = fopen(path, "rb"); std::vector<float> ref(n); if (fread(ref.data(), 4, n, g) != n) printf("short ref\n"); fclose(g);
        double num = 0, den = 0, mx = 0; for (size_t i = 0; i < n; ++i) { const double d = (double)got[i] - ref[i]; num += d * d; den += (double)ref[i] * ref[i]; if (fabs(d) > mx) mx = fabs(d); }
        printf("%s: rvr=%.3e absmax=%.3e\n", name, num / den, mx); };
    static RwShared sh;
    int phase = 0;
#define X(fn, n) { printf("phase %d %s n=%ld\n", phase++, #fn, (long)(n)); fflush(stdout); _Pragma("omp parallel for schedule(dynamic, 64)") for (long g = 0; g < (long)(n); ++g) fn(p, g); }
#define SYNC
#define SCAN { printf("phase %d scan\n", phase++); fflush(stdout); _Pragma("omp parallel for schedule(dynamic, 1)") for (int b = 0; b < 32; ++b) { RwShared* s = new RwShared; rwkv_scan_block(p, b, *s); delete s; } }
    X(ph_mod, N_MOD) X(ph_rope_table, N_ROPE) X(ph_prenorm<0>, (long)R) X(ph_gemm_l0_qkv, (long)R * P0W) X(ph_ropenorm, N_ROPENORM) X(ph_ret_scan, N_RETSCAN)
    X(ph_ret_merge, N_RETMERGE) X(ph_gqa_attn, N_GQA) X(ph_gemm_l0_gate, (long)R * 2048) X(ph_gemm_l0_out, (long)R * DM) X(ph_resid<0>, (long)R)
    check("x0.bin", out.data(), out.size()); check("ctx0.bin", ws_ctx1(p), (size_t)CTXN * DM);
    X(ph_prenorm<1>, (long)R) X(ph_gemm_l1_rw, (long)R * ZW) SCAN X(ph_rwkv_finish, N_RWFIN) X(ph_gemm_l1_na, (long)R * NAW) X(ph_na, N_NA)
    X(ph_gemm_l1_gate, (long)SEQ * 2048) X(ph_gemm_l1_out, (long)SEQ * DM) X(ph_resid<1>, (long)SEQ)
    check("out.bin", out.data(), out.size());
    return 0;
}
#endif
```

```cpp
#ifdef CPU_EMU
#include <cstdio>
#include <cstdlib>
#include <cstring>
#include <cmath>
#include <vector>
#define DEV static inline
#else
#include <hip/hip_runtime.h>
#include <hip/hip_cooperative_groups.h>
#include <cstdio>
namespace cg = cooperative_groups;
#define DEV __device__ __forceinline__
#endif

#ifndef SEQ_LEN
#define SEQ_LEN 16384
#endif
typedef unsigned short bf16_t;
constexpr int DM = 1024, CTXN = 256, SEQ = SEQ_LEN, R = CTXN + SEQ, GW = 64, GROWS = SEQ / GW;
constexpr int EVEN_IN = 5632, ODD_IN = 8448;
constexpr int P0W = 3584;
constexpr int C_QA = 0, C_KA = 512, C_VA = 1024, C_QB = 2048, C_KB = 3072, C_VB = 3328, C_GA = 3584;
constexpr int ZW = 3328;
constexpr int O_NA = 0, O_RW = 3072, O_GC = 6400;
constexpr int NAW = 3072;
constexpr float NORM_EPS = 1e-6f, GN_EPS = 64e-5f;

constexpr size_t MiB = 1u << 20;
constexpr size_t WS_MODV = 0;
constexpr size_t WS_ROPE = 64 * 1024;
constexpr size_t WS_CTX1 = 1 * MiB;
constexpr size_t WS_WB = 2 * MiB;
constexpr size_t WS_XN = 42 * MiB;
constexpr size_t WS_BIG = WS_XN + (((size_t)R * DM * 2 + MiB - 1) / MiB) * MiB;
constexpr size_t WS_BR = WS_BIG + (((size_t)R * P0W * 2 + MiB - 1) / MiB) * MiB;
constexpr size_t WS_END = WS_BR + (size_t)R * 2048 * 2;
static_assert(SEQ != 16384 || WS_END <= 256 * MiB, "workspace map exceeds 256 MiB");

struct Params {
    const float *x, *c, *ctx, *c_ctx, *w_mod, *b_mod, *g_pre, *g_post, *ev_w_in, *ev_w_out, *dec_f, *dec_b, *q_norm, *k_norm;
    const float *od_w_in, *od_w_out, *rpb, *mu, *w0f, *w2f, *w0b, *w2b, *a0f, *a2f, *a0b, *a2b, *k_k, *k_a, *r_k, *lnx_g, *lnx_b;
    float* out; unsigned char* ws;
};

DEV bf16_t f2bf(float f) { unsigned u; __builtin_memcpy(&u, &f, 4); u = (u + 0x7fffu + ((u >> 16) & 1u)) >> 16; return (bf16_t)u; }
DEV float bf2f(bf16_t h) { unsigned u = ((unsigned)h) << 16; float f; __builtin_memcpy(&f, &u, 4); return f; }
DEV float siluf(float x) { return x / (1.0f + expf(-x)); }
DEV float sigmf(float x) { return 1.0f / (1.0f + expf(-x)); }
DEV float softplusf(float x) { return fmaxf(x, 0.f) + log1pf(expf(-fabsf(x))); }

DEV float* ws_modv(const Params& p) { return (float*)(p.ws + WS_MODV); }
DEV float* ws_rope(const Params& p) { return (float*)(p.ws + WS_ROPE); }
DEV float* ws_ctx1(const Params& p) { return (float*)(p.ws + WS_CTX1); }
DEV bf16_t* ws_xn(const Params& p) { return (bf16_t*)(p.ws + WS_XN); }
DEV bf16_t* ws_big(const Params& p) { return (bf16_t*)(p.ws + WS_BIG); }
DEV float* ws_y(const Params& p) { return (float*)(p.ws + WS_BIG); }
DEV bf16_t* ws_br(const Params& p) { return (bf16_t*)(p.ws + WS_BR); }

constexpr long N_MOD = 2 * 2 * 3072;
DEV void ph_mod(const Params& p, long gid) {
    const int j = (int)(gid % 3072), s = (int)((gid / 3072) % 2), l = (int)(gid / 6144);
    const float* cv = s ? p.c_ctx : p.c; const float* w = p.w_mod + (size_t)l * DM * 3072 + j;
    float acc = 0.f;
    for (int k = 0; k < DM; ++k) acc += siluf(cv[k]) * w[(size_t)k * 3072];
    ws_modv(p)[gid] = acc + p.b_mod[l * 3072 + j];
}
constexpr long N_ROPE = 256 * 32;
DEV void ph_rope_table(const Params& p, long gid) {
    const int f = (int)(gid % 32), pos = (int)(gid / 32);
    const float inv = powf(10000.0f, -(float)f / 32.0f); const float ang = (float)pos * inv;
    ws_rope(p)[gid] = cosf(ang); ws_rope(p)[N_ROPE + gid] = sinf(ang);
}
template <int LAYER> DEV void ph_prenorm(const Params& p, long gid) {
    const int row = (int)gid; const int s = row < CTXN ? 1 : 0;
    const float* src = row < CTXN ? ((LAYER == 0 ? p.ctx : ws_ctx1(p)) + (size_t)row * DM) : ((LAYER == 0 ? p.x : p.out) + (size_t)(row - CTXN) * DM);
    const float* mv = ws_modv(p) + (LAYER * 2 + s) * 3072; const float* g = p.g_pre + LAYER * DM;
    float ss = 0.f;
    for (int k = 0; k < DM; ++k) ss += src[k] * src[k];
    const float rstd = 1.0f / sqrtf(ss / DM + NORM_EPS);
    bf16_t* o = ws_xn(p) + (size_t)row * DM;
    for (int k = 0; k < DM; ++k) o[k] = f2bf(src[k] * rstd * g[k] * (1.0f + mv[1024 + k]) + mv[k]);
}
template <int MODE> DEV void gemm_item(const bf16_t* A, int K, const float* W, int ldw, void* out, int pitch, int row, int col) {
    const bf16_t* a = A + (size_t)row * K; const float* w = W + col; float acc = 0.f;
    for (int k = 0; k < K; ++k) acc += bf2f(a[k]) * w[(size_t)k * ldw];
    if (MODE == 0) ((bf16_t*)out)[(size_t)row * pitch + col] = f2bf(acc);
    else if (MODE == 1) { bf16_t* o = (bf16_t*)out + (size_t)row * pitch + col; *o = f2bf(siluf(acc) * bf2f(*o)); }
    else ((float*)out)[(size_t)row * pitch + col] = acc;
}
DEV void ph_gemm_l0_qkv(const Params& p, long gid) { gemm_item<0>(ws_xn(p), DM, p.ev_w_in, EVEN_IN, ws_big(p), P0W, (int)(gid / P0W), (int)(gid % P0W)); }
DEV void ph_gemm_l0_gate(const Params& p, long gid) { gemm_item<1>(ws_xn(p), DM, p.ev_w_in + C_GA, EVEN_IN, ws_br(p), 2048, (int)(gid / 2048), (int)(gid % 2048)); }
DEV void ph_gemm_l0_out(const Params& p, long gid) { gemm_item<2>(ws_br(p), 2048, p.ev_w_out, DM, ws_y(p), DM, (int)(gid / DM), (int)(gid % DM)); }
DEV void ph_gemm_l1_rw(const Params& p, long gid) { gemm_item<0>(ws_xn(p), DM, p.od_w_in + O_RW, ODD_IN, ws_big(p), ZW, (int)(gid / ZW), (int)(gid % ZW)); }
DEV void ph_gemm_l1_na(const Params& p, long gid) { gemm_item<0>(ws_xn(p), DM, p.od_w_in + O_NA, ODD_IN, ws_big(p), NAW, (int)(gid / NAW), (int)(gid % NAW)); }
DEV void ph_gemm_l1_gate(const Params& p, long gid) { gemm_item<1>(ws_xn(p), DM, p.od_w_in + O_GC, ODD_IN, ws_br(p), 2048, CTXN + (int)(gid / 2048), (int)(gid % 2048)); }
DEV void ph_gemm_l1_out(const Params& p, long gid) { gemm_item<2>(ws_br(p), 2048, p.od_w_out, DM, ws_y(p), DM, CTXN + (int)(gid / DM), (int)(gid % DM)); }

constexpr long N_ROPENORM = (long)R * 18;
DEV void ph_ropenorm(const Params& p, long gid) {
    const int slot = (int)(gid % 18), row = (int)(gid / 18);
    int col; const float* nw = nullptr; float sc = 1.f;
    if (slot < 4) col = C_QA + slot * 128; else if (slot < 8) { col = C_KA + (slot - 4) * 128; sc = 0.08838834764831845f; }
    else if (slot < 16) { col = C_QB + (slot - 8) * 128; nw = p.q_norm; } else { col = C_KB + (slot - 16) * 128; nw = p.k_norm; }
    bf16_t* v = ws_big(p) + (size_t)row * P0W + col;
    if (nw) { float ss = 0.f; for (int d = 0; d < 128; ++d) { const float t = bf2f(v[d]); ss += t * t; } sc = 1.0f / sqrtf(ss / 128.f + NORM_EPS); }
    const bool rot = row >= CTXN; const int t = row - CTXN; const int gr = rot ? t / GW : 0, gc = rot ? t % GW : 0;
    const float* ct = ws_rope(p); const float* st = ct + N_ROPE;
    for (int i = 0; i < 64; ++i) {
        float x1 = bf2f(v[2 * i]) * sc, x2 = bf2f(v[2 * i + 1]) * sc;
        if (nw) { x1 *= nw[2 * i]; x2 *= nw[2 * i + 1]; }
        if (rot) { const int pos = i < 32 ? gr : gc, f = i & 31; const float cs = ct[pos * 32 + f], sn = st[pos * 32 + f]; const float y1 = x1 * cs - x2 * sn, y2 = x1 * sn + x2 * cs; x1 = y1; x2 = y2; }
        v[2 * i] = f2bf(x1); v[2 * i + 1] = f2bf(x2);
    }
}
constexpr long N_RETSCAN = 2 * 4 * 256;
DEV void ph_ret_scan(const Params& p, long gid) {
    const int e = (int)(gid % 256), h = (int)((gid / 256) % 4), dir = (int)(gid / 1024);
    const float g = sigmf((dir ? p.dec_b : p.dec_f)[h]);
    float S[128];
#pragma unroll
    for (int d = 0; d < 128; ++d) S[d] = 0.f;
    const bf16_t* P = ws_big(p); bf16_t* BR = ws_br(p);
    for (int pos = 0; pos < R; ++pos) {
        int row; if (pos < CTXN) row = dir ? CTXN - 1 - pos : pos; else { const int t = pos - CTXN; row = CTXN + (dir ? SEQ - 1 - t : t); }
        const bf16_t* pr = P + (size_t)row * P0W; const float v = bf2f(pr[C_VA + h * 256 + e]);
        const bf16_t* kq = pr + C_KA + h * 128; const bf16_t* qq = pr + C_QA + h * 128; float y = 0.f;
#pragma unroll
        for (int d = 0; d < 128; ++d) { S[d] = g * S[d] + bf2f(kq[d]) * v; y += bf2f(qq[d]) * S[d]; }
        BR[(size_t)row * 2048 + dir * 1024 + h * 256 + e] = f2bf(y);
    }
}
constexpr long N_RETMERGE = (long)R * 4;
DEV void ph_ret_merge(const Params& p, long gid) {
    const int h = (int)(gid % 4), row = (int)(gid / 4);
    bf16_t* b = ws_br(p) + (size_t)row * 2048 + h * 256;
    float s = 0.f; for (int e = 0; e < 256; ++e) s += bf2f(b[e]) + bf2f(b[1024 + e]);
    const float mean = s / 256.f; float q = 0.f;
    for (int e = 0; e < 256; ++e) { const float d = bf2f(b[e]) + bf2f(b[1024 + e]) - mean; q += d * d; }
    const float rstd = 1.0f / sqrtf(q / 256.f + NORM_EPS);
    for (int e = 0; e < 256; ++e) b[e] = f2bf((bf2f(b[e]) + bf2f(b[1024 + e]) - mean) * rstd);
}
constexpr long N_GQA = (long)R * 8 * 8;
DEV void ph_gqa_attn(const Params& p, long gid) {
    const int sl = (int)(gid % 8), row = (int)((gid / 8) % R), head = (int)(gid / (8L * R)), g = head / 4;
    const bf16_t* P = ws_big(p); const int nk = row < CTXN ? CTXN : R;
    float q[128];
    { const bf16_t* qp = P + (size_t)row * P0W + C_QB + head * 128;
#pragma unroll
      for (int d = 0; d < 128; ++d) q[d] = bf2f(qp[d]) * 0.08838834764831845f; }
    float acc[16];
#pragma unroll
    for (int i = 0; i < 16; ++i) acc[i] = 0.f;
    float m = -1e30f, l = 0.f;
    for (int j = 0; j < nk; ++j) {
        const bf16_t* kp = P + (size_t)j * P0W + C_KB + g * 128; float s = 0.f;
#pragma unroll
        for (int d = 0; d < 128; ++d) s += q[d] * bf2f(kp[d]);
        const float mn = fmaxf(m, s), al = expf(m - mn), pe = expf(s - mn);
        const bf16_t* vp = P + (size_t)j * P0W + C_VB + g * 128 + sl * 16;
        l = l * al + pe;
#pragma unroll
        for (int i = 0; i < 16; ++i) acc[i] = acc[i] * al + pe * bf2f(vp[i]);
        m = mn;
    }
    bf16_t* o = ws_br(p) + (size_t)row * 2048 + 1024 + head * 128 + sl * 16; const float il = 1.0f / l;
#pragma unroll
    for (int i = 0; i < 16; ++i) o[i] = f2bf(acc[i] * il);
}
template <int LAYER> DEV void ph_resid(const Params& p, long gid) {
    const int row = LAYER == 0 ? (int)gid : CTXN + (int)gid; const int s = row < CTXN ? 1 : 0;
    const float* y = ws_y(p) + (size_t)row * DM; const float* mv = ws_modv(p) + (LAYER * 2 + s) * 3072 + 2048; const float* g = p.g_post + LAYER * DM;
    float ss = 0.f; for (int k = 0; k < DM; ++k) ss += y[k] * y[k];
    const float rstd = 1.0f / sqrtf(ss / DM + NORM_EPS);
    const float* src; float* dst;
    if (row < CTXN) { src = p.ctx + (size_t)row * DM; dst = ws_ctx1(p) + (size_t)row * DM; }
    else { src = (LAYER == 0 ? p.x : p.out) + (size_t)(row - CTXN) * DM; dst = p.out + (size_t)(row - CTXN) * DM; }
    for (int k = 0; k < DM; ++k) dst[k] = src[k] + mv[k] * (y[k] * rstd * g[k]);
}
DEV float zshift(const bf16_t* Z, const float* mu, int row, int col) {
    const int lo = row < CTXN ? 0 : CTXN, hi = row < CTXN ? CTXN : R;
    const float z = bf2f(Z[(size_t)row * ZW + col]);
    const float pv = row > lo ? bf2f(Z[(size_t)(row - 1) * ZW + col]) : 0.f, nx = row + 1 < hi ? bf2f(Z[(size_t)(row + 1) * ZW + col]) : 0.f;
    return z + (0.5f * (pv + nx) - z) * mu[col];
}
constexpr long N_RWFIN = (long)SEQ * 16;
DEV void ph_rwkv_finish(const Params& p, long gid) {
    const int h = (int)(gid % 16), t = (int)(gid / 16), row = CTXN + t;
    const bf16_t* Z = ws_big(p); bf16_t* b = ws_br(p) + (size_t)row * 2048;
    float bon[2];
    for (int d = 0; d < 2; ++d) {
        const float* a0 = d ? p.a0b : p.a0f; const float* a2 = d ? p.a2b : p.a2f;
        float s = 0.f;
        for (int j = 0; j < 64; ++j) { const int hj = h * 64 + j; float acc = a0[hj];
            for (int m = 0; m < 64; ++m) acc += zshift(Z, p.mu, row, 3200 + d * 64 + m) * a2[m * 1024 + hj];
            const float al = sigmf(acc); const float r = zshift(Z, p.mu, row, hj), k = zshift(Z, p.mu, row, 1024 + hj);
            s += r * (k * (1.0f + (al - 1.0f) * p.k_a[hj])) * p.r_k[hj]; }
        bon[d] = s;
    }
    float sm = 0.f; for (int i = 0; i < 64; ++i) sm += bf2f(b[h * 64 + i]) + bf2f(b[1024 + h * 64 + i]);
    const float mean = sm / 64.f; float q = 0.f;
    for (int i = 0; i < 64; ++i) { const float d = bf2f(b[h * 64 + i]) + bf2f(b[1024 + h * 64 + i]) - mean; q += d * d; }
    const float rstd = 1.0f / sqrtf(q / 64.f + GN_EPS);
    for (int i = 0; i < 64; ++i) { const int hi = h * 64 + i; const float w = bf2f(b[hi]) + bf2f(b[1024 + hi]);
        const float v = zshift(Z, p.mu, row, 2048 + hi);
        b[1024 + hi] = f2bf((w - mean) * rstd * p.lnx_g[hi] + p.lnx_b[hi] + (bon[0] + bon[1]) * v); }
}
constexpr long N_NA = (long)SEQ * 16;
DEV void ph_na(const Params& p, long gid) {
    const int h = (int)(gid % 16), t = (int)(gid / 16), r = t / GW, c = t % GW;
    const bf16_t* P = ws_big(p);
    float q[64];
    { const bf16_t* qp = P + (size_t)(CTXN + t) * NAW + h * 64;
#pragma unroll
      for (int d = 0; d < 64; ++d) q[d] = bf2f(qp[d]) * 0.125f; }
    float acc[64];
#pragma unroll
    for (int d = 0; d < 64; ++d) acc[d] = 0.f;
    float m = -1e30f, l = 0.f;
    const int wh = GROWS < 8 ? GROWS : 8;
    int r0 = r - wh / 2; r0 = r0 < 0 ? 0 : (r0 > GROWS - wh ? GROWS - wh : r0);
    int c0 = c - 8; c0 = c0 < 0 ? 0 : (c0 > GW - 16 ? GW - 16 : c0);
    const float* rp = p.rpb + h * 15 * 31;
    for (int kk = 0; kk < wh * 16 + CTXN; ++kk) {
        int krow; float bias = 0.f;
        if (kk < wh * 16) { const int i = kk / 16, j = kk % 16; krow = CTXN + (r0 + i) * GW + c0 + j; bias = rp[(r0 + i - r + 7) * 31 + (c0 + j - c + 15)]; }
        else krow = kk - wh * 16;
        const bf16_t* kp = P + (size_t)krow * NAW + 1024 + h * 64; float s = bias;
#pragma unroll
        for (int d = 0; d < 64; ++d) s += q[d] * bf2f(kp[d]);
        const float mn = fmaxf(m, s), al = expf(m - mn), pe = expf(s - mn);
        const bf16_t* vp = P + (size_t)krow * NAW + 2048 + h * 64;
        l = l * al + pe;
#pragma unroll
        for (int d = 0; d < 64; ++d) acc[d] = acc[d] * al + pe * bf2f(vp[d]);
        m = mn;
    }
    bf16_t* o = ws_br(p) + (size_t)(CTXN + t) * 2048 + h * 64; const float il = 1.0f / l;
#pragma unroll
    for (int d = 0; d < 64; ++d) o[d] = f2bf(acc[d] * il);
}

constexpr int RW_CH = 16;
struct RwShared { float r[RW_CH][64], w[RW_CH][64], kd[RW_CH][64], v[RW_CH][64], a[RW_CH][64], b[RW_CH][64], tz[RW_CH][64], za[RW_CH][64], kk[RW_CH][64]; };
#ifdef CPU_EMU
#define FOR_THREADS(tid) for (int tid = 0; tid < 64; ++tid)
#define BLOCK_SYNC()
#define TSTATE(tid) S_all[tid]
#else
#define FOR_THREADS(tid) const int tid = threadIdx.x; if (tid < 64)
#define BLOCK_SYNC() __syncthreads()
#define TSTATE(tid) S_reg
#endif
DEV int rw_row(int dir, int pos) { if (pos < CTXN) return dir ? CTXN - 1 - pos : pos; const int t = pos - CTXN; return CTXN + (dir ? SEQ - 1 - t : t); }
#ifdef CPU_EMU
static void rwkv_scan_block(const Params& p, int blk, RwShared& sh) {
    static thread_local float S_all[64][64];
    for (int i = 0; i < 64; ++i) for (int j = 0; j < 64; ++j) S_all[i][j] = 0.f;
#else
__device__ void rwkv_scan_block(const Params& p, int blk, RwShared& sh) {
    float S_reg[64];
#pragma unroll
    for (int j = 0; j < 64; ++j) S_reg[j] = 0.f;
#endif
    const int dir = blk / 16, h = blk % 16;
    const float* w0 = dir ? p.w0b : p.w0f; const float* w2 = dir ? p.w2b : p.w2f; const float* a0 = dir ? p.a0b : p.a0f; const float* a2 = dir ? p.a2b : p.a2f;
    const bf16_t* Z = ws_big(p); bf16_t* BR = ws_br(p);
    for (int p0 = 0; p0 < R; p0 += RW_CH) {
        { FOR_THREADS(tid) { const int hj = h * 64 + tid;
            for (int tt = 0; tt < RW_CH; ++tt) { const int row = rw_row(dir, p0 + tt);
                sh.tz[tt][tid] = tanhf(zshift(Z, p.mu, row, 3072 + dir * 64 + tid)); sh.za[tt][tid] = zshift(Z, p.mu, row, 3200 + dir * 64 + tid);
                sh.r[tt][tid] = zshift(Z, p.mu, row, hj); sh.v[tt][tid] = zshift(Z, p.mu, row, 2048 + hj);
                const float k = zshift(Z, p.mu, row, 1024 + hj); sh.kd[tt][tid] = k; sh.kk[tt][tid] = k * p.k_k[hj]; } } }
        BLOCK_SYNC();
        { FOR_THREADS(tid) { const int hj = h * 64 + tid;
            for (int tt = 0; tt < RW_CH; ++tt) { float aw = w0[hj], aa = a0[hj], nn = 0.f;
                for (int m = 0; m < 64; ++m) { aw += sh.tz[tt][m] * w2[m * 1024 + hj]; aa += sh.za[tt][m] * a2[m * 1024 + hj]; nn += sh.kk[tt][m] * sh.kk[tt][m]; }
                const float lw = -softplusf(-aw) - 0.5f; const float al = sigmf(aa);
                const float kkn = sh.kk[tt][tid] / fmaxf(sqrtf(nn), 1e-12f);
                sh.w[tt][tid] = expf(-expf(lw)); sh.a[tt][tid] = -kkn; sh.b[tt][tid] = kkn * al;
                sh.kd[tt][tid] = sh.kd[tt][tid] * (1.0f + (al - 1.0f) * p.k_a[hj]); } } }
        BLOCK_SYNC();
        { FOR_THREADS(tid) { float* S = TSTATE(tid);
            for (int tt = 0; tt < RW_CH; ++tt) { float sa = 0.f;
#pragma unroll
                for (int j = 0; j < 64; ++j) sa += S[j] * sh.a[tt][j];
                const float vi = sh.v[tt][tid]; float y = 0.f;
#pragma unroll
                for (int j = 0; j < 64; ++j) { S[j] = S[j] * sh.w[tt][j] + sa * sh.b[tt][j] + vi * sh.kd[tt][j]; y += S[j] * sh.r[tt][j]; }
                if (p0 >= CTXN) BR[(size_t)rw_row(dir, p0 + tt) * 2048 + dir * 1024 + h * 64 + tid] = f2bf(y); } } }
        BLOCK_SYNC();
    }
}

static Params make_params(void* const* d_in, void* d_out, void* d_ws) {
    Params p{};
    const float** f = (const float**)&p;
    for (int i = 0; i < 31; ++i) f[i] = (const float*)d_in[i];
    p.out = (float*)d_out; p.ws = (unsigned char*)d_ws; return p;
}


#ifndef CPU_EMU
#define LAS __attribute__((address_space(3)))
#define GAS __attribute__((address_space(1)))
typedef unsigned v4u __attribute__((ext_vector_type(4)));
constexpr int NWAVES = 8, NTHR = NWAVES * 64;
#ifndef PROBE
#define PROBE 0
#endif
#define XB_TMO      128
#define XB_XCNT(j)  (256  + 64 * (j))
#define XB_XSUB(j)  (1280 + 64 * (j))
#define XB_XGEN(j)  (2304 + 64 * (j))
#define XB_TOP      3328
#define XB_TOPGEN   3392
#define XCD_BAR_WORDS 3456
#define XB_SPIN_CAP (1u << 18)

__device__ __forceinline__ unsigned xb_ld(unsigned* p)              { return __hip_atomic_load(p, __ATOMIC_RELAXED, __HIP_MEMORY_SCOPE_AGENT); }
__device__ __forceinline__ unsigned xb_add(unsigned* p, unsigned v) { return __hip_atomic_fetch_add(p, v, __ATOMIC_RELAXED, __HIP_MEMORY_SCOPE_AGENT); }
__device__ __forceinline__ unsigned xb_xcc_id() { return (unsigned)__builtin_amdgcn_s_getreg((3 << 11) | 20) & 0xFu; }
#define XB_SPIN(cond, bar) do { unsigned _sp = 0; while (cond) { __builtin_amdgcn_s_sleep(1); \
    if ((++_sp & 255u) == 0u) { if (xb_ld(&(bar)[XB_TMO])) break; if (_sp > XB_SPIN_CAP) { atomicAdd(&(bar)[XB_TMO], 1u); break; } } } } while (0)

struct XcdBarrier {
    unsigned* bar; unsigned x;
    volatile LAS unsigned* st;
};

__device__ __forceinline__ XcdBarrier xcd_barrier_post(unsigned* bar, volatile LAS unsigned* st) {
    XcdBarrier b; b.bar = bar; b.x = xb_xcc_id(); b.st = st;
    if (threadIdx.x == 0) (void)xb_add(&bar[XB_XCNT(b.x)], 1u);
    return b;
}
__device__ __forceinline__ void xcd_barrier_complete(unsigned* bar, unsigned x, unsigned& nloc, unsigned& nx) {
    const unsigned G = gridDim.x * gridDim.y * gridDim.z;
    unsigned sum, cnt, mine, sp = 0u;
    for (;;) {
        sum = 0u; cnt = 0u; mine = 0u;
#pragma unroll
        for (unsigned j = 0; j < 16; ++j) { const unsigned c = xb_ld(&bar[XB_XCNT(j)]); sum += c; cnt += (c > 0u) ? 1u : 0u; mine = (j == x) ? c : mine; }
        if (sum == G) break;
        __builtin_amdgcn_s_sleep(1);
        if ((++sp & 255u) == 0u) { if (xb_ld(&bar[XB_TMO])) break; if (sp > XB_SPIN_CAP) { atomicAdd(&bar[XB_TMO], 1u); break; } }
    }
    nloc = mine > 0u ? mine : 1u; nx = cnt > 0u ? cnt : 1u;
}

__device__ __forceinline__ void xcd_barrier(const XcdBarrier& b) {
    asm volatile("s_waitcnt vmcnt(0)" ::: "memory");
    __syncthreads();
    if (threadIdx.x == 0) {
        unsigned* bar = b.bar;
        __builtin_amdgcn_s_waitcnt(0);
        unsigned nloc = b.st[0], nx = b.st[1];
        if (nloc == 0u) { xcd_barrier_complete(bar, b.x, nloc, nx); b.st[0] = nloc; b.st[1] = nx; }
        const unsigned old = xb_add(&bar[XB_XSUB(b.x)], 1u);
        const unsigned gen = old / nloc;
        if (old + 1u == (gen + 1u) * nloc) {
            __builtin_amdgcn_fence(__ATOMIC_RELEASE, "agent");
            asm volatile("s_waitcnt vmcnt(0)" ::: "memory");
            const unsigned og = xb_add(&bar[XB_TOP], 1u);
            const unsigned tg = og / nx;
            if (og + 1u == (tg + 1u) * nx) xb_add(&bar[XB_TOPGEN], 1u);
            else XB_SPIN(xb_ld(&bar[XB_TOPGEN]) == tg, bar);
            __builtin_amdgcn_fence(__ATOMIC_ACQUIRE, "agent");
            xb_add(&bar[XB_XGEN(b.x)], 1u);
            asm volatile("s_waitcnt vmcnt(0)" ::: "memory");
        } else {
            XB_SPIN(xb_ld(&bar[XB_XGEN(b.x)]) == gen, bar);
            __builtin_amdgcn_fence(__ATOMIC_ACQUIRE, "agent");
            asm volatile("s_waitcnt vmcnt(0)" ::: "memory");
        }
    }
    __syncthreads();
}
namespace pg8 {
#define PG8_LAS __attribute__((address_space(3)))
typedef unsigned short bf16_t;
typedef short bf16x8 __attribute__((ext_vector_type(8)));
typedef float f32x4 __attribute__((ext_vector_type(4)));
typedef unsigned u32x4 __attribute__((ext_vector_type(4)));
constexpr int BM = 256, BK = 64, HALF = 128, HTB = HALF * BK * 2  , STAGE_BYTES = 8 * HTB, NXCD = 8, WGM = 8;

__host__ __device__ __forceinline__ int lds_byte(int r, int c) { const int st = (r >> 4) * 2 + (c >> 5), rr = r & 15, cc = c & 31, ob = rr * 64 + cc * 2; return st * 1024 + (ob ^ (((ob >> 9) & 1) << 5)); }
__host__ __device__ __forceinline__ void stage_rc(int b, int& R, int& C) { const int st = b / 1024, sb = b % 1024, swz = sb ^ (((sb >> 9) & 1) << 5); R = (st >> 1) * 16 + swz / 64; C = (st & 1) * 32 + (swz % 64) / 2; }
__host__ __device__ __forceinline__ int perm32(int rho) { const int n = rho >> 4, i = rho & 15; return 8 * (i >> 2) + 4 * n + (i & 3); }

struct Unit { int pm, pn; };
struct Gemm { const bf16_t* A; const bf16_t* Bt; int M, N, K; int lda = 0, ldb = 0; int ksl = 0; };

struct StaticOrder {
    int nM, nN, nwg, G, c;
    __host__ __device__ void init(int M, int N, int G_, int c_) { nM = M / BM; nN = N / BM; nwg = nM * nN; G = G_; c = c_; }
    __host__ __device__ bool next(int i, Unit& u) const {
        const long L = (long)i * G + c; if (L >= nwg) return false;
        int wgid = (int)L; { const int q = nwg / NXCD, r = nwg % NXCD, xcd = wgid % NXCD, off = wgid / NXCD; wgid = (xcd < r ? xcd * (q + 1) : r * (q + 1) + (xcd - r) * q) + off; }
        const int nig = WGM * nN, gid = wgid / nig, fm = gid * WGM, gsz = (nM - fm) < WGM ? (nM - fm) : WGM;
        u.pm = fm + ((wgid % nig) % gsz); u.pn = (wgid % nig) / gsz; return true;
    }
    __device__ __forceinline__ void a_ready(const Unit&) const {}
    __device__ __forceinline__ void done(const Unit&) const {}
};

__device__ __forceinline__ unsigned cvt_pk_bf16(float lo, float hi) { unsigned r; asm volatile("v_cvt_pk_bf16_f32 %0, %1, %2" : "=v"(r) : "v"(lo), "v"(hi)); return r; }
typedef float f32x2 __attribute__((ext_vector_type(2)));
__device__ __forceinline__ f32x2 gelu_pk(f32x2 v) {
    const f32x2 av = __builtin_elementwise_abs(v), d = av * 0.2316418882f + 1.0f;
    f32x2 t; t.x = __builtin_amdgcn_rcpf(d.x); t.y = __builtin_amdgcn_rcpf(d.y);
    f32x2 q = t * 0.5307027145f + (-0.7265760135f); q = q * t + 0.7107068705f; q = q * t + (-0.142248368f); q = q * t + 0.127414796f; q = q * t;
    const f32x2 s = (v * v) * (-0.72134752044f);
    f32x2 e; e.x = __builtin_amdgcn_exp2f(s.x); e.y = __builtin_amdgcn_exp2f(s.y);
    const f32x2 m = v * (q * e), r = v - m;
    f32x2 o; o.x = v.x < 0.f ? m.x : r.x; o.y = v.y < 0.f ? m.y : r.y; return o;
}

template <int ACT  > struct EpiBf16 {
    static constexpr bool PERM = true, AFTER_DRAIN = false; static_assert(ACT == 0 || ACT == 1, "EpiBf16: ACT is 0 (none) or 1 (gelu_pk)");
    bf16_t* O; int ldc; const float* bias; int split_cols; size_t split_stride; float scale0;
    __device__ __forceinline__ void operator()(const f32x4 (&acc)[2][2][4][2], const Unit& u, int wr, int wc, int fr, int fq) const {
        const int row0 = u.pm * BM + wr * 64 + fr; int colt = u.pn * BM; bf16_t* base = O;
        float sc = 1.f; if (split_cols) { const int t = colt / split_cols; base += (size_t)t * split_stride; colt -= t * split_cols; if (t == 0) sc = scale0; }
        const int col0 = colt + wc * 32 + 8 * fq, bcol0 = u.pn * BM + wc * 32 + 8 * fq;
        f32x4 bv[2][2];
#pragma unroll
        for (int bj = 0; bj < 2; ++bj)
#pragma unroll
            for (int n = 0; n < 2; ++n) bv[bj][n] = bias ? *(const f32x4*)(bias + bcol0 + bj * HALF + 4 * n) : (f32x4){0.f, 0.f, 0.f, 0.f};
#pragma unroll
        for (int ai = 0; ai < 2; ++ai)
#pragma unroll
            for (int m = 0; m < 4; ++m) { bf16_t* rowp = base + (size_t)(row0 + ai * HALF + m * 16) * ldc + col0;
#pragma unroll
                for (int bj = 0; bj < 2; ++bj) { f32x4 v0 = acc[ai][bj][m][0] + bv[bj][0], v1 = acc[ai][bj][m][1] + bv[bj][1];
                    if (ACT == 1) { f32x2 a = gelu_pk((f32x2){v0[0], v0[1]}), b = gelu_pk((f32x2){v0[2], v0[3]}), c = gelu_pk((f32x2){v1[0], v1[1]}), d = gelu_pk((f32x2){v1[2], v1[3]});
                        v0 = (f32x4){a.x, a.y, b.x, b.y}; v1 = (f32x4){c.x, c.y, d.x, d.y}; }
                    v0 = v0 * sc; v1 = v1 * sc; u32x4 w; w.x = cvt_pk_bf16(v0[0], v0[1]); w.y = cvt_pk_bf16(v0[2], v0[3]); w.z = cvt_pk_bf16(v1[0], v1[1]); w.w = cvt_pk_bf16(v1[2], v1[3]);
                    *(u32x4*)(rowp + bj * HALF) = w; } }
    }
};

__device__ __forceinline__ float silu_fast(float v) { return v * __builtin_amdgcn_rcpf(1.0f + __builtin_amdgcn_exp2f(-1.4426950408889634f * v)); }
struct EpiGateMul {
    static constexpr bool PERM = true, AFTER_DRAIN = false;
    bf16_t* O; int ldc;
    __device__ __forceinline__ void operator()(const f32x4 (&acc)[2][2][4][2], const Unit& u, int wr, int wc, int fr, int fq) const {
        const int row0 = u.pm * BM + wr * 64 + fr, col0 = u.pn * BM + wc * 32 + 8 * fq;
#pragma unroll
        for (int ai = 0; ai < 2; ++ai)
#pragma unroll
            for (int m = 0; m < 4; ++m) { bf16_t* rowp = O + (size_t)(row0 + ai * HALF + m * 16) * ldc + col0;
#pragma unroll
                for (int bj = 0; bj < 2; ++bj) { const u32x4 old = *(const u32x4*)(rowp + bj * HALF); const f32x4 v0 = acc[ai][bj][m][0], v1 = acc[ai][bj][m][1];
                    u32x4 w;
                    w.x = cvt_pk_bf16(silu_fast(v0[0]) * __uint_as_float(old.x << 16), silu_fast(v0[1]) * __uint_as_float(old.x & 0xffff0000u));
                    w.y = cvt_pk_bf16(silu_fast(v0[2]) * __uint_as_float(old.y << 16), silu_fast(v0[3]) * __uint_as_float(old.y & 0xffff0000u));
                    w.z = cvt_pk_bf16(silu_fast(v1[0]) * __uint_as_float(old.z << 16), silu_fast(v1[1]) * __uint_as_float(old.z & 0xffff0000u));
                    w.w = cvt_pk_bf16(silu_fast(v1[2]) * __uint_as_float(old.w << 16), silu_fast(v1[3]) * __uint_as_float(old.w & 0xffff0000u));
                    *(u32x4*)(rowp + bj * HALF) = w; } }
    }
};
struct EpiSiluBf16 {
    static constexpr bool PERM = true, AFTER_DRAIN = false;
    bf16_t* O; int ldc;
    __device__ __forceinline__ void operator()(const f32x4 (&acc)[2][2][4][2], const Unit& u, int wr, int wc, int fr, int fq) const {
        const int row0 = u.pm * BM + wr * 64 + fr, col0 = u.pn * BM + wc * 32 + 8 * fq;
#pragma unroll
        for (int ai = 0; ai < 2; ++ai)
#pragma unroll
            for (int m = 0; m < 4; ++m) { bf16_t* rowp = O + (size_t)(row0 + ai * HALF + m * 16) * ldc + col0;
#pragma unroll
                for (int bj = 0; bj < 2; ++bj) { const f32x4 v0 = acc[ai][bj][m][0], v1 = acc[ai][bj][m][1]; u32x4 w;
                    w.x = cvt_pk_bf16(silu_fast(v0[0]), silu_fast(v0[1])); w.y = cvt_pk_bf16(silu_fast(v0[2]), silu_fast(v0[3]));
                    w.z = cvt_pk_bf16(silu_fast(v1[0]), silu_fast(v1[1])); w.w = cvt_pk_bf16(silu_fast(v1[2]), silu_fast(v1[3]));
                    *(u32x4*)(rowp + bj * HALF) = w; } }
    }
};
struct EpiF32 {
    static constexpr bool PERM = true, AFTER_DRAIN = false;
    float* O; int ldc;
    __device__ __forceinline__ void operator()(const f32x4 (&acc)[2][2][4][2], const Unit& u, int wr, int wc, int fr, int fq) const {
        const int row0 = u.pm * BM + wr * 64 + fr, col0 = u.pn * BM + wc * 32 + 8 * fq;
#pragma unroll
        for (int ai = 0; ai < 2; ++ai)
#pragma unroll
            for (int m = 0; m < 4; ++m) { float* rowp = O + (size_t)(row0 + ai * HALF + m * 16) * ldc + col0;
#pragma unroll
                for (int bj = 0; bj < 2; ++bj) { *(f32x4*)(rowp + bj * HALF) = acc[ai][bj][m][0]; *(f32x4*)(rowp + bj * HALF + 4) = acc[ai][bj][m][1]; } }
    }
};

template <class Epi, class Sched, bool ALIGN_EPI = false, bool SP2 = false>
__device__ __forceinline__ void gemm_phase(PG8_LAS unsigned char* lds, const Gemm g, const Sched& S, const Epi& E) {
    int tid_ = threadIdx.x; asm volatile("" : "+v"(tid_));
    const int tid = tid_, wid = __builtin_amdgcn_readfirstlane(tid >> 6), lane = tid & 63, wr = wid >> 2, wc = wid & 3, fr = lane & 15, fq = lane >> 4;
    const int K = g.K, nt = K / BK, lda = g.lda ? g.lda : K, ldb = g.ldb ? g.ldb : K;
    unsigned voffA[2], voffB[2];
#pragma unroll
    for (int i = 0; i < 2; ++i) { int R, C; stage_rc(tid * 16 + i * 8192, R, C); const int Rb = Epi::PERM ? ((R & ~31) + perm32(R & 31)) : R;
        voffA[i] = (unsigned)(R * lda + C) * 2u; voffB[i] = (unsigned)(Rb * ldb + C) * 2u; }
    const size_t kstep = (size_t)(BK * 2);
    const size_t hstepA = (size_t)HALF * lda * 2, hstepB = (size_t)HALF * ldb * 2;
    const size_t tstepA = g.ksl ? (size_t)g.ksl : 2 * hstepA, tstepB = 2 * hstepB, bpm = (size_t)g.ksl;
    const unsigned ldsw = (unsigned)wid * 1024u;
    const int aoff = lds_byte(wr * 64 + fr, fq * 8), boff = lds_byte(wc * 32 + fr, fq * 8);
#define PG8_SA(b, h) (((b) * 2 + (h)) * HTB)
#define PG8_SB(b, h) ((4 + (b) * 2 + (h)) * HTB)
#define PG8_STAGE(bufoff, gbase, voff) do { _Pragma("unroll") for (int _i = 0; _i < 2; ++_i) \
        __builtin_amdgcn_global_load_lds((const unsigned*)((const char*)(gbase) + (voff)[_i]), (PG8_LAS unsigned*)(lds + (bufoff) + ldsw + _i * 8192), 16, 0, 0); } while (0)
#define PG8_LDA(dst, b, h) do { _Pragma("unroll") for (int m = 0; m < 4; ++m) _Pragma("unroll") for (int k = 0; k < 2; ++k) dst[m][k] = *(const PG8_LAS bf16x8*)(lds + PG8_SA(b, h) + aoff + m * 2048 + k * 1024); } while (0)
#define PG8_LDB(dst, b, h) do { _Pragma("unroll") for (int n = 0; n < 2; ++n) _Pragma("unroll") for (int k = 0; k < 2; ++k) dst[n][k] = *(const PG8_LAS bf16x8*)(lds + PG8_SB(b, h) + boff + n * 2048 + k * 1024); } while (0)
#define PG8_MMA(ai, bj, At, Bt) do { __builtin_amdgcn_s_setprio(1); _Pragma("unroll") for (int m = 0; m < 4; ++m) _Pragma("unroll") for (int n = 0; n < 2; ++n) _Pragma("unroll") for (int k = 0; k < 2; ++k) \
        acc[ai][bj][m][n] = __builtin_amdgcn_mfma_f32_16x16x32_bf16(Bt[n][k], At[m][k], acc[ai][bj][m][n], 0, 0, 0); __builtin_amdgcn_s_setprio(0); } while (0)
#define PG8_WAIT_V(n) asm volatile("s_waitcnt vmcnt(" #n ")" ::: "memory")
#define PG8_WAIT_L(n) asm volatile("s_waitcnt lgkmcnt(" #n ")" ::: "memory")
#define PG8_BAR __builtin_amdgcn_s_barrier()
#define PG8_SCHED __builtin_amdgcn_sched_barrier(0)
    Unit cur, nxt; int ui = 0;
    if (!S.next(0, cur)) return;
    f32x4 acc[2][2][4][2];
#pragma unroll
    for (int a = 0; a < 2; ++a)
#pragma unroll
        for (int b = 0; b < 2; ++b)
#pragma unroll
            for (int m = 0; m < 4; ++m)
#pragma unroll
                for (int n = 0; n < 2; ++n) acc[a][b][m][n] = (f32x4){0.f, 0.f, 0.f, 0.f};
    bf16x8 At[4][2], B0[2][2], B1[2][2];
    const char* cA = (const char*)g.A + (size_t)cur.pm * tstepA; const char* cB = (const char*)g.Bt + (size_t)cur.pn * tstepB + (size_t)cur.pm * bpm;
    S.a_ready(cur);
    if constexpr (SP2) {
        PG8_STAGE(PG8_SB(0, 0), cB, voffB); PG8_STAGE(PG8_SB(0, 1), cB + hstepB, voffB); PG8_STAGE(PG8_SA(0, 0), cA, voffA); PG8_STAGE(PG8_SA(0, 1), cA + hstepA, voffA);
        if (wr == 1) PG8_BAR;
        PG8_WAIT_V(2); PG8_BAR;
        PG8_STAGE(PG8_SB(1, 0), cB + kstep, voffB); PG8_STAGE(PG8_SA(1, 0), cA + kstep, voffA); PG8_STAGE(PG8_SB(1, 1), cB + hstepB + kstep, voffB);
        PG8_WAIT_V(6); PG8_BAR;
    } else {
        PG8_STAGE(PG8_SB(0, 0), cB, voffB); PG8_STAGE(PG8_SA(0, 0), cA, voffA); PG8_STAGE(PG8_SB(0, 1), cB + hstepB, voffB); PG8_STAGE(PG8_SA(0, 1), cA + hstepA, voffA);
        if (wr == 1) PG8_BAR;
        PG8_WAIT_V(4); PG8_BAR;
        PG8_STAGE(PG8_SB(1, 0), cB + kstep, voffB); PG8_STAGE(PG8_SA(1, 0), cA + kstep, voffA); PG8_STAGE(PG8_SB(1, 1), cB + hstepB + kstep, voffB);
        PG8_WAIT_V(6); PG8_BAR;
    }
    for (;;) {
        const bool has_next = S.next(ui + 1, nxt);
        const char* nA = has_next ? (const char*)g.A + (size_t)nxt.pm * tstepA : cA; const char* nB = has_next ? (const char*)g.Bt + (size_t)nxt.pn * tstepB + (size_t)nxt.pm * bpm : cB;
        for (int t = 0; t < nt; t += 2) {
            const bool last = (t == nt - 2);
            const char* a1 = cA + (size_t)(t + 1) * kstep;
            const char* a2 = last ? nA : cA + (size_t)(t + 2) * kstep; const char* b2 = last ? nB : cB + (size_t)(t + 2) * kstep;
            const char* a3 = a2 + kstep; const char* b3 = b2 + kstep;
            if (last && has_next) S.a_ready(nxt);
            if constexpr (SP2) {
            PG8_LDB(B0, 0, 0); PG8_LDB(B1, 0, 1); PG8_SCHED; PG8_LDA(At, 0, 0); PG8_STAGE(PG8_SA(1, 1), a1 + hstepA, voffA);
            PG8_WAIT_V(8); PG8_WAIT_L(0); PG8_BAR; PG8_MMA(0, 0, At, B0); PG8_MMA(0, 1, At, B1); PG8_BAR; PG8_SCHED;
            PG8_LDA(At, 0, 1); PG8_STAGE(PG8_SB(0, 0), b2, voffB); PG8_STAGE(PG8_SB(0, 1), b2 + hstepB, voffB); PG8_STAGE(PG8_SA(0, 0), a2, voffA);
            PG8_WAIT_V(8); PG8_WAIT_L(0); PG8_BAR; PG8_MMA(1, 0, At, B0); PG8_MMA(1, 1, At, B1); PG8_BAR; PG8_SCHED;
            PG8_LDB(B0, 1, 0); PG8_LDB(B1, 1, 1); PG8_SCHED; PG8_LDA(At, 1, 0); PG8_STAGE(PG8_SA(0, 1), a2 + hstepA, voffA);
            PG8_WAIT_V(8); PG8_WAIT_L(0); PG8_BAR; PG8_MMA(0, 0, At, B0); PG8_MMA(0, 1, At, B1); PG8_BAR; PG8_SCHED;
            PG8_LDA(At, 1, 1); PG8_STAGE(PG8_SB(1, 0), b3, voffB); PG8_STAGE(PG8_SB(1, 1), b3 + hstepB, voffB); PG8_STAGE(PG8_SA(1, 0), a3, voffA);
            PG8_WAIT_V(8); PG8_WAIT_L(0); PG8_BAR; PG8_MMA(1, 0, At, B0); PG8_MMA(1, 1, At, B1); PG8_BAR; PG8_SCHED;
            } else {
            PG8_LDB(B0, 0, 0); PG8_SCHED; PG8_LDA(At, 0, 0); PG8_STAGE(PG8_SA(1, 1), a1 + hstepA, voffA);
            PG8_WAIT_L(8); PG8_BAR; PG8_WAIT_L(0); PG8_MMA(0, 0, At, B0); PG8_BAR; PG8_SCHED;
            PG8_LDB(B1, 0, 1); PG8_STAGE(PG8_SB(0, 0), b2, voffB);
            PG8_BAR; PG8_WAIT_L(0); PG8_MMA(0, 1, At, B1); PG8_BAR;
            PG8_LDA(At, 0, 1); PG8_STAGE(PG8_SA(0, 0), a2, voffA);
            PG8_BAR; PG8_WAIT_L(0); PG8_MMA(1, 0, At, B0); PG8_BAR; PG8_SCHED;
            PG8_STAGE(PG8_SB(0, 1), b2 + hstepB, voffB);
            PG8_WAIT_V(6); PG8_BAR; PG8_MMA(1, 1, At, B1); PG8_BAR;
            PG8_LDB(B0, 1, 0); PG8_SCHED; PG8_LDA(At, 1, 0); PG8_STAGE(PG8_SA(0, 1), a2 + hstepA, voffA);
            PG8_WAIT_L(8); PG8_BAR; PG8_WAIT_L(0); PG8_MMA(0, 0, At, B0); PG8_BAR; PG8_SCHED;
            PG8_LDB(B1, 1, 1); PG8_STAGE(PG8_SB(1, 0), b3, voffB);
            PG8_BAR; PG8_WAIT_L(0); PG8_MMA(0, 1, At, B1); PG8_BAR;
            PG8_LDA(At, 1, 1); PG8_STAGE(PG8_SA(1, 0), a3, voffA);
            PG8_BAR; PG8_WAIT_L(0); PG8_MMA(1, 0, At, B0); PG8_BAR; PG8_SCHED;
            PG8_STAGE(PG8_SB(1, 1), b3 + hstepB, voffB);
            PG8_WAIT_V(6); PG8_BAR; PG8_MMA(1, 1, At, B1); PG8_BAR;
            }
        }
        if constexpr (ALIGN_EPI) { if (wr == 0) PG8_BAR; }
        if constexpr (!Epi::AFTER_DRAIN) { E(acc, cur, wr, wc, fr, fq); S.done(cur); }
        if (!has_next) break;
#pragma unroll
        for (int a = 0; a < 2; ++a)
#pragma unroll
            for (int b = 0; b < 2; ++b)
#pragma unroll
                for (int m = 0; m < 4; ++m)
#pragma unroll
                    for (int n = 0; n < 2; ++n) acc[a][b][m][n] = (f32x4){0.f, 0.f, 0.f, 0.f};
        cur = nxt; cA = nA; cB = nB; ++ui;
        if constexpr (ALIGN_EPI) { if (wr == 1) PG8_BAR; }
    }
    PG8_WAIT_V(0);
    if constexpr (!ALIGN_EPI) { if (wr == 0) PG8_BAR; }
    PG8_BAR;
    if constexpr (Epi::AFTER_DRAIN) { E.fused(acc, cur, wr, wc, fr, fq, lds, wid, lane); S.done(cur); }
#undef PG8_SA
#undef PG8_SB
#undef PG8_STAGE
#undef PG8_LDA
#undef PG8_LDB
#undef PG8_MMA
#undef PG8_WAIT_V
#undef PG8_WAIT_L
#undef PG8_BAR
#undef PG8_SCHED
}
}

namespace attn {
using bf16 = unsigned short;
constexpr int   D = 128, NW = 8, QBLK = 32, KVBLK = 64;
constexpr float SCALE = 0.088388347648318440f;
constexpr float THR = 8.f;
constexpr int SDEPTH = 2;
constexpr int LDQ = P0W, LDK = P0W, LDO = 2048;
constexpr size_t SHM_V = KVBLK * D * 2, SHM_K = KVBLK * D * 2, SHM_ATTN = 3 * SHM_V + 2 * SHM_K + NW * 64 * 4;
using bf16x8 = __attribute__((ext_vector_type(8))) short;
using s16x4  = __attribute__((ext_vector_type(4))) short;
using f32x16 = __attribute__((ext_vector_type(16))) float;
using f32x8  = __attribute__((ext_vector_type(8))) float;
using u32x4  = __attribute__((ext_vector_type(4))) unsigned;
#define KSWZ(row, colB) ((row) * 256 + ((colB) ^ (((row) & 7) << 4)))
#define SBAR() __builtin_amdgcn_sched_barrier(0)
__device__ __forceinline__ int crow(int r, int hi) { return (r & 3) + 8 * (r >> 2) + 4 * hi; }
__device__ __forceinline__ unsigned cvtpk(float lo, float hi) {
  unsigned r; asm volatile("v_cvt_pk_bf16_f32 %0, %1, %2" : "=v"(r) : "v"(lo), "v"(hi)); return r;
}
template <typename TIn> struct Stage;
template <> struct Stage<bf16>  { using T = bf16x8;
  __device__ static __forceinline__ T ld8(const bf16* p) { return *reinterpret_cast<const bf16x8*>(p); }
  __device__ static __forceinline__ bf16x8 tobf(T x) { return x; } };
template <> struct Stage<float> { using T = f32x8;
  __device__ static __forceinline__ T ld8(const float* p) { return *reinterpret_cast<const f32x8*>(p); }
  __device__ static __forceinline__ bf16x8 tobf(T x) {
    u32x4 w = {cvtpk(x[0], x[1]), cvtpk(x[2], x[3]), cvtpk(x[4], x[5]), cvtpk(x[6], x[7])}; return *reinterpret_cast<bf16x8*>(&w); } };

template <bool NOMAX> __device__ __forceinline__ void partialSM(f32x16& p0, f32x16& p1, float& m_reg, float& mn, float& alpha) {
  if constexpr (NOMAX) { for (int r = 0; r < 16; ++r) p0[r] = __builtin_amdgcn_exp2f(p0[r]); alpha = 1.f; return; }
  constexpr float C = SCALE * 1.4426950408889634f;
  float pmax = p0[0]; for (int r = 1; r < 16; ++r) pmax = fmaxf(pmax, p0[r]); for (int r = 0; r < 16; ++r) pmax = fmaxf(pmax, p1[r]);
  { auto rr = __builtin_amdgcn_permlane32_swap(__float_as_uint(pmax), __float_as_uint(pmax), false, false);
    pmax = fmaxf(__uint_as_float(rr[0]), __uint_as_float(rr[1])); }
  if (__builtin_expect(__all(pmax - m_reg <= THR / SCALE), 1)) { mn = m_reg; alpha = 1.f; }
  else { mn = fmaxf(m_reg, pmax); alpha = __builtin_amdgcn_exp2f((m_reg - mn) * C); m_reg = mn; }
  float mnC = -mn * C;
  for (int r = 0; r < 16; ++r) p0[r] = fmaf(p0[r], C, mnC); for (int r = 0; r < 16; ++r) p1[r] = fmaf(p1[r], C, mnC);
  for (int r = 0; r < 16; ++r) p0[r] = __builtin_amdgcn_exp2f(p0[r]);
}
__device__ __forceinline__ void finishSM(f32x16& p0, f32x16& p1, float alpha, float& l_reg, bf16x8& pa0, bf16x8& pa1, bf16x8& pa2, bf16x8& pa3) {
  for (int r = 0; r < 16; ++r) p1[r] = __builtin_amdgcn_exp2f(p1[r]);
  float ps = 0; for (int r = 0; r < 16; ++r) ps += p0[r]; for (int r = 0; r < 16; ++r) ps += p1[r];
  { auto rr = __builtin_amdgcn_permlane32_swap(__float_as_uint(ps), __float_as_uint(ps), false, false);
    ps = __uint_as_float(rr[0]) + __uint_as_float(rr[1]); }
  l_reg = l_reg * alpha + ps;
#define PK4(P, BASE, OUT) do { unsigned a0 = cvtpk(P[BASE + 0], P[BASE + 1]), a1 = cvtpk(P[BASE + 2], P[BASE + 3]);   \
    unsigned b0 = cvtpk(P[BASE + 4], P[BASE + 5]), b1 = cvtpk(P[BASE + 6], P[BASE + 7]);                              \
    auto r0 = __builtin_amdgcn_permlane32_swap(a0, b0, false, false); auto r1 = __builtin_amdgcn_permlane32_swap(a1, b1, false, false); \
    u32x4 w = {r0[0], r1[0], r0[1], r1[1]}; OUT = *reinterpret_cast<bf16x8*>(&w); } while (0)
  PK4(p0, 0, pa0); PK4(p0, 8, pa1); PK4(p1, 0, pa2); PK4(p1, 8, pa3);
#undef PK4
}
__device__ __forceinline__ void qkt(f32x16& p0, f32x16& p1, const bf16* Ks, const bf16x8* qr, int r32, int hi) {
  p0 = f32x16{}; p1 = f32x16{};
  for (int d0 = 0; d0 < 8; ++d0) { int cb = (d0 * 16 + hi * 8) * 2;
    bf16x8 b0 = *reinterpret_cast<const bf16x8*>((const char*)Ks + KSWZ(r32, cb));
    bf16x8 b1 = *reinterpret_cast<const bf16x8*>((const char*)Ks + KSWZ(32 + r32, cb));
    p0 = __builtin_amdgcn_mfma_f32_32x32x16_bf16(b0, qr[d0], p0, 0, 0, 0);
    p1 = __builtin_amdgcn_mfma_f32_32x32x16_bf16(b1, qr[d0], p1, 0, 0, 0); }
}
__device__ __forceinline__ int v_st(int k, int c) { const int kk = (k & ~0xC) | ((k & 4) << 1) | ((k & 8) >> 1); return ((kk >> 3) * 4 + (c >> 5)) * 512 + ((kk & 7) * 32 + (c & 31)) * 2; }
__device__ __forceinline__ int v_rd_base(int lane) { return ((lane & 3) << 3) | (((lane >> 2) & 3) << 6) | (((lane >> 4) & 1) << 5) | (((lane >> 5) & 1) << 8); }
constexpr int v_rd_off(int d0, int ks, int half) { return d0 * 512 + ks * 4096 + half * 2048; }
template <int OFF> __device__ __forceinline__ s16x4 tr_read(int vb) {
  s16x4 r; asm volatile("ds_read_b64_tr_b16 %0, %1 offset:%2" : "=&v"(r) : "v"(vb), "i"(OFF) : "memory"); return r;
}
template <int D0> __device__ __forceinline__ void pv_one(f32x16& od, int vb, bf16x8 pa0, bf16x8 pa1, bf16x8 pa2, bf16x8 pa3) {
  const s16x4 l0 = tr_read<v_rd_off(D0, 0, 0)>(vb), h0 = tr_read<v_rd_off(D0, 0, 1)>(vb), l1 = tr_read<v_rd_off(D0, 1, 0)>(vb), h1 = tr_read<v_rd_off(D0, 1, 1)>(vb);
  const s16x4 l2 = tr_read<v_rd_off(D0, 2, 0)>(vb), h2 = tr_read<v_rd_off(D0, 2, 1)>(vb), l3 = tr_read<v_rd_off(D0, 3, 0)>(vb), h3 = tr_read<v_rd_off(D0, 3, 1)>(vb);
  asm volatile("s_waitcnt lgkmcnt(0)" ::: "memory"); SBAR();
#define PK(L, H) (bf16x8){L[0], L[1], L[2], L[3], H[0], H[1], H[2], H[3]}
  od = __builtin_amdgcn_mfma_f32_32x32x16_bf16(pa0, PK(l0, h0), od, 0, 0, 0);
  od = __builtin_amdgcn_mfma_f32_32x32x16_bf16(pa1, PK(l1, h1), od, 0, 0, 0);
  od = __builtin_amdgcn_mfma_f32_32x32x16_bf16(pa2, PK(l2, h2), od, 0, 0, 0);
  od = __builtin_amdgcn_mfma_f32_32x32x16_bf16(pa3, PK(l3, h3), od, 0, 0, 0);
#undef PK
}
__device__ __forceinline__ void pv_d0(f32x16* o, int vb, bf16x8 pa0, bf16x8 pa1, bf16x8 pa2, bf16x8 pa3) {
  pv_one<0>(o[0], vb, pa0, pa1, pa2, pa3); pv_one<1>(o[1], vb, pa0, pa1, pa2, pa3); pv_one<2>(o[2], vb, pa0, pa1, pa2, pa3); pv_one<3>(o[3], vb, pa0, pa1, pa2, pa3);
}

template <typename TQ, bool NOMAX>
__device__ __forceinline__ void attn_dense_body(const TQ* __restrict__ Qb, const bf16* __restrict__ Kh, const bf16* __restrict__ Vh,
                                                bf16* __restrict__ Ob, int seq, char* lds) {
  using St = Stage<bf16>; using SQ = Stage<TQ>;
  int tid_ = threadIdx.x; asm volatile("" : "+v"(tid_));
  const int tid = tid_, wid = tid >> 6, lane = tid & 63, r32 = lane & 31, hi = lane >> 5;
  bf16* V_lds = (bf16*)lds; bf16* K_lds = (bf16*)(lds + 3 * SHM_V);
  float* ws = (float*)(lds + 3 * SHM_V + 2 * SHM_K) + wid * 64; float* li_l = ws; float* al_l = ws + 32;
  float m_reg = -1e30f, l_reg = 0; f32x16 o[4] = {}; bf16x8 qr[8];
  const TQ* Qw = Qb + (long)(wid * QBLK + r32) * LDQ + hi * 8;
#pragma unroll
  for (int d0 = 0; d0 < 8; ++d0) { qr[d0] = SQ::tobf(SQ::ld8(Qw + d0 * 16));
    if constexpr (NOMAX) { constexpr float C = SCALE * 1.4426950408889634f; u32x4 w = *reinterpret_cast<u32x4*>(&qr[d0]);
      for (int i = 0; i < 4; ++i) w[i] = cvtpk(__uint_as_float(w[i] << 16) * C, __uint_as_float(w[i] & 0xffff0000u) * C);
      qr[d0] = *reinterpret_cast<bf16x8*>(&w); } }
  const int sr = tid >> 4, sc = (tid & 15) * 8, vst0 = v_st(sr, sc), vst1 = v_st(32 + sr, sc);
  const int vb0 = (int)(uintptr_t)V_lds + v_rd_base(lane);
  struct { typename St::T vs0, vs1, ks0, ks1; } sr_[SDEPTH];
#define SLOAD(i, k0) do { sr_[i].vs0 = St::ld8(&Vh[(long)((k0) + sr) * LDK + sc]); sr_[i].vs1 = St::ld8(&Vh[(long)((k0) + 32 + sr) * LDK + sc]); \
    sr_[i].ks0 = St::ld8(&Kh[(long)((k0) + sr) * LDK + sc]); sr_[i].ks1 = St::ld8(&Kh[(long)((k0) + 32 + sr) * LDK + sc]); } while (0)
#define SWRITE(b, voff, i) do { *(bf16x8*)((char*)V_lds + (voff) + vst0) = St::tobf(sr_[i].vs0);          \
    *(bf16x8*)((char*)V_lds + (voff) + vst1) = St::tobf(sr_[i].vs1); int kc = sc * 2;               \
    *(bf16x8*)((char*)K_lds + (b) * SHM_K + KSWZ(sr, kc)) = St::tobf(sr_[i].ks0);                       \
    *(bf16x8*)((char*)K_lds + (b) * SHM_K + KSWZ(32 + sr, kc)) = St::tobf(sr_[i].ks1); } while (0)
#define SWAIT() do { if constexpr (SDEPTH == 2) asm volatile("s_waitcnt vmcnt(4)" ::: "memory"); else asm volatile("s_waitcnt vmcnt(0)" ::: "memory"); } while (0)
#define RESC(a) do { if (!NOMAX && __any((a) < 1.f)) { if (hi == 0) al_l[r32] = (a); asm volatile("s_waitcnt lgkmcnt(0)" ::: "memory"); \
    for (int d = 0; d < 4; ++d) for (int r = 0; r < 16; ++r) o[d][r] *= al_l[crow(r, hi)]; } } while (0)
  f32x16 pA0, pA1, pB0, pB1; float mnA, mnB, alA, alB; bf16x8 pa0, pa1, pa2, pa3; const int NT = seq / KVBLK;
  constexpr int SE = 0, SO = SDEPTH - 1;
  SLOAD(SE, 0); asm volatile("s_waitcnt vmcnt(0)" ::: "memory"); SWRITE(0, 0, SE); __syncthreads();
  qkt(pA0, pA1, K_lds, qr, r32, hi); partialSM<NOMAX>(pA0, pA1, m_reg, mnA, alA);
  SLOAD(SO, KVBLK); if constexpr (SDEPTH == 2) { if (2 < NT) SLOAD(SE, 2 * KVBLK); }
  SWAIT(); SWRITE(1, (int)SHM_V, SO); __syncthreads();
  int vr = 0, vw = 2 * (int)SHM_V;
#define VNEXT(x) ((x) == 2 * (int)SHM_V ? 0 : (x) + (int)SHM_V)
  for (int j = 1; j + 1 < NT; j += 2) {
    SBAR(); qkt(pB0, pB1, (bf16*)((char*)K_lds + SHM_K), qr, r32, hi);
    finishSM(pA0, pA1, alA, l_reg, pa0, pa1, pa2, pa3); SBAR();
    SLOAD(SO, (j + SDEPTH) * KVBLK); SBAR();
    pv_d0(o, vb0 + vr, pa0, pa1, pa2, pa3); partialSM<NOMAX>(pB0, pB1, m_reg, mnB, alB);
    SWAIT(); SWRITE(0, vw, SE); vr = VNEXT(vr); vw = VNEXT(vw);
    RESC(alB); __syncthreads();
    SBAR(); qkt(pA0, pA1, K_lds, qr, r32, hi);
    finishSM(pB0, pB1, alB, l_reg, pa0, pa1, pa2, pa3); SBAR();
    if (SDEPTH == 1 || j + 3 < NT) SLOAD(SE, (j + 1 + SDEPTH) * KVBLK); SBAR();
    pv_d0(o, vb0 + vr, pa0, pa1, pa2, pa3); partialSM<NOMAX>(pA0, pA1, m_reg, mnA, alA);
    SWAIT(); SWRITE(1, vw, SO); vr = VNEXT(vr); vw = VNEXT(vw);
    RESC(alA); __syncthreads();
  }
  SBAR(); qkt(pB0, pB1, (bf16*)((char*)K_lds + SHM_K), qr, r32, hi);
  finishSM(pA0, pA1, alA, l_reg, pa0, pa1, pa2, pa3); SBAR();
  pv_d0(o, vb0 + vr, pa0, pa1, pa2, pa3); partialSM<NOMAX>(pB0, pB1, m_reg, mnB, alB);
  vr = VNEXT(vr); RESC(alB);
  finishSM(pB0, pB1, alB, l_reg, pa0, pa1, pa2, pa3); SBAR();
  pv_d0(o, vb0 + vr, pa0, pa1, pa2, pa3);
#undef VNEXT
  if (hi == 0) li_l[r32] = l_reg; asm volatile("s_waitcnt lgkmcnt(0)" ::: "memory");
  float rli[16];
#pragma unroll
  for (int r = 0; r < 16; ++r) rli[r] = __builtin_amdgcn_rcpf(li_l[crow(r, hi)]);
  bf16* Ow = Ob + (long)(wid * QBLK) * LDO;
#pragma unroll
  for (int r = 0; r < 16; ++r) { int orow = crow(r, hi);
    for (int d0 = 0; d0 < 4; ++d0) Ow[(long)orow * LDO + d0 * 32 + r32] = (bf16)(cvtpk(o[d0][r] * rli[r], 0.f) & 0xffffu); }
#undef SLOAD
#undef SWRITE
#undef SWAIT
#undef RESC
}
#undef KSWZ
#undef SBAR
}

namespace rw {
typedef short bf16x8 __attribute__((ext_vector_type(8)));
typedef float f32x4 __attribute__((ext_vector_type(4)));
typedef unsigned u32x4 __attribute__((ext_vector_type(4)));
typedef unsigned u32x2 __attribute__((ext_vector_type(2)));
constexpr int CH = 32, NC = R / CH;
static_assert(NC % 2 == 0, "the prep loop is unrolled by two");
constexpr int BUFB = 5 * 8192 + 1024;
constexpr int O_W = 0, O_B = 8192, O_KD = 16384, O_A = 24576, O_R = 32768, O_V = 40960;
constexpr int PITCH = 72;
constexpr int L_SCR = 2 * BUFB, SCRB = 2 * 16 * PITCH * 2;
constexpr int L_W2T = L_SCR + 4 * SCRB, L_A2T = L_W2T + 64 * PITCH * 2;
constexpr int L_Y = L_A2T + 64 * PITCH * 2;
constexpr int L_CST = L_Y + 2 * 2 * CH * 64 * 4;
constexpr int L_END = L_CST + 10 * 64 * 4;
static_assert(L_END <= 163840 - 64 && (BUFB % 16) == 0 && (L_SCR % 16) == 0 && (SCRB % 16) == 0 && (L_W2T % 16) == 0 && (L_A2T % 16) == 0 && (L_Y % 16) == 0 && (L_CST % 16) == 0, "rwkv LDS map");
constexpr size_t WS_BON = 38 * MiB;

template <int CTRL> __device__ __forceinline__ float dppmov(float x) { return __builtin_bit_cast(float, __builtin_amdgcn_update_dpp(0, __builtin_bit_cast(int, x), CTRL, 0xF, 0xF, true)); }
__device__ __forceinline__ float allreduce8(float x) {
    x += dppmov<0xB1>(x);
    x += dppmov<0x4E>(x);
    x += dppmov<0x141>(x);
    return x;
}
__device__ __forceinline__ float allreduce16(float x) { x = allreduce8(x); x += dppmov<0x140>(x); return x; }
__device__ __forceinline__ float fast_tanh(float x) { const float e = __builtin_amdgcn_exp2f(2.885390081777927f * x); return 1.0f - 2.0f * __builtin_amdgcn_rcpf(1.0f + e); }
__device__ __forceinline__ float bflo(unsigned u) { return __uint_as_float(u << 16); }
__device__ __forceinline__ float bfhi(unsigned u) { return __uint_as_float(u & 0xffff0000u); }
__device__ __forceinline__ unsigned pkbf(float lo, float hi) { unsigned r; asm volatile("v_cvt_pk_bf16_f32 %0, %1, %2" : "=v"(r) : "v"(lo), "v"(hi)); return r; }

constexpr int SEGR = 128, NSEG = R / SEGR, NCG = (ZW + 511) / 512;
constexpr size_t WS_HALO = 40 * MiB;
static_assert(WS_HALO + (size_t)NSEG * 2 * ZW * 2 <= WS_XN, "halo rows overflow");
__device__ __forceinline__ void shift_halo(const Params& p) {
    int tid_ = threadIdx.x; asm volatile("" : "+v"(tid_));
    const bf16_t* Z = ws_big(p); bf16_t* H = (bf16_t*)(p.ws + WS_HALO);
    for (int it = (int)blockIdx.x * NTHR + tid_; it < NSEG * 2 * (ZW / 8); it += (int)gridDim.x * NTHR) {
        const int c8 = it % (ZW / 8), w = (it / (ZW / 8)) & 1, seg = it / (2 * (ZW / 8));
        *(u32x4*)(H + ((size_t)seg * 2 + w) * ZW + c8 * 8) = *(const u32x4*)(Z + (size_t)(seg * SEGR + (w ? SEGR - 1 : 0)) * ZW + c8 * 8);
    }
}
__device__ __forceinline__ u32x4 shift8(u32x4 c, u32x4 pv, u32x4 nx, f32x4 m0, f32x4 m1) {
    u32x4 o;
#pragma unroll
    for (int q = 0; q < 4; ++q) { const float ml = q < 2 ? m0[2 * q] : m1[2 * q - 4], mh = q < 2 ? m0[2 * q + 1] : m1[2 * q - 3];
        const float zl = bflo(c[q]), zh = bfhi(c[q]);
        o[q] = pkbf(zl + (0.5f * (bflo(pv[q]) + bflo(nx[q])) - zl) * ml, zh + (0.5f * (bfhi(pv[q]) + bfhi(nx[q])) - zh) * mh); }
    return o;
}
__device__ __forceinline__ void shift_inplace(const Params& p) {
    int tid_ = threadIdx.x; asm volatile("" : "+v"(tid_));
    const int lane = tid_ & 63, gw = (int)blockIdx.x * NWAVES + (tid_ >> 6), ngw = (int)gridDim.x * NWAVES;
    bf16_t* Z = ws_big(p); const bf16_t* H = (const bf16_t*)(p.ws + WS_HALO);
    for (int u = gw; u < NSEG * NCG; u += ngw) {
        const int seg = u / NCG, col = (u % NCG) * 512 + lane * 8;
        if (col < ZW) {
            const f32x4 m0 = *(const f32x4*)(p.mu + col), m1 = *(const f32x4*)(p.mu + col + 4);
            const bool first = seg == 0 || seg == CTXN / SEGR, last = seg == CTXN / SEGR - 1 || seg == NSEG - 1;
            bf16_t* zr = Z + (size_t)seg * SEGR * ZW + col;
            u32x4 pv = first ? (u32x4){0u, 0u, 0u, 0u} : *(const u32x4*)(H + ((size_t)(seg - 1) * 2 + 1) * ZW + col);
            const u32x4 tail = last ? (u32x4){0u, 0u, 0u, 0u} : *(const u32x4*)(H + ((size_t)(seg + 1) * 2) * ZW + col);
            u32x4 c0 = *(const u32x4*)zr, c1 = *(const u32x4*)(zr + ZW), c2 = *(const u32x4*)(zr + 2 * ZW), c3 = *(const u32x4*)(zr + 3 * ZW);
            for (int r = 0; r < SEGR; r += 4) {
                u32x4 n0 = tail, n1 = tail, n2 = tail, n3 = tail;
                if (r + 4 < SEGR) { n0 = *(const u32x4*)(zr + (size_t)(r + 4) * ZW); n1 = *(const u32x4*)(zr + (size_t)(r + 5) * ZW); n2 = *(const u32x4*)(zr + (size_t)(r + 6) * ZW); n3 = *(const u32x4*)(zr + (size_t)(r + 7) * ZW); }
                const u32x4 o0 = shift8(c0, pv, c1, m0, m1), o1 = shift8(c1, c0, c2, m0, m1), o2 = shift8(c2, c1, c3, m0, m1), o3 = shift8(c3, c2, n0, m0, m1);
                *(u32x4*)(zr + (size_t)r * ZW) = o0; *(u32x4*)(zr + (size_t)(r + 1) * ZW) = o1; *(u32x4*)(zr + (size_t)(r + 2) * ZW) = o2; *(u32x4*)(zr + (size_t)(r + 3) * ZW) = o3;
                pv = c3; c0 = n0; c1 = n1; c2 = n2; c3 = n3;
            }
        }
    }
}

struct Raw { u32x4 c[5]; };

template <int MODE> __device__ __forceinline__ void scan_block(const Params& p, int blk, LAS unsigned char* lds) {
    int tid_ = threadIdx.x; asm volatile("" : "+v"(tid_));
    const int tid = tid_, lane = tid & 63, wave = __builtin_amdgcn_readfirstlane(tid >> 6);
    const int dir = blk >> 7, h = (blk >> 3) & 15, eighth = blk & 7;
    const float* w0 = dir ? p.w0b : p.w0f; const float* w2 = dir ? p.w2b : p.w2f; const float* a0 = dir ? p.a0b : p.a0f; const float* a2 = dir ? p.a2b : p.a2f;
    const bf16_t* Z = ws_big(p); bf16_t* BR = ws_br(p); float* bon = (float*)(p.ws + WS_BON) + ((size_t)dir * 16 + h) * SEQ;
    { const int m = tid >> 3, j8 = (tid & 7) * 8;
      const f32x4 wa = *(const f32x4*)(w2 + (size_t)m * 1024 + h * 64 + j8), wb = *(const f32x4*)(w2 + (size_t)m * 1024 + h * 64 + j8 + 4);
      const f32x4 aa = *(const f32x4*)(a2 + (size_t)m * 1024 + h * 64 + j8), ab = *(const f32x4*)(a2 + (size_t)m * 1024 + h * 64 + j8 + 4);
      LAS bf16_t* yw = (LAS bf16_t*)(lds + L_W2T); LAS bf16_t* ya = (LAS bf16_t*)(lds + L_A2T);
#pragma unroll
      for (int q = 0; q < 4; ++q) { yw[(j8 + q) * PITCH + m] = f2bf(wa[q]); yw[(j8 + 4 + q) * PITCH + m] = f2bf(wb[q]); ya[(j8 + q) * PITCH + m] = f2bf(aa[q]); ya[(j8 + 4 + q) * PITCH + m] = f2bf(ab[q]); }
      for (int i = tid; i < 4 * SCRB / 4; i += NTHR) *(LAS unsigned*)(lds + L_SCR + i * 4) = 0u;
      for (int i = tid; i < 640; i += NTHR) { const int g = i >> 6, cc = i & 63, hc = h * 64 + cc; float v;
          if (g < 3) v = p.mu[g * 1024 + hc]; else if (g == 3) v = p.mu[3072 + dir * 64 + cc]; else if (g == 4) v = p.mu[3200 + dir * 64 + cc];
          else if (g == 5) v = w0[hc]; else if (g == 6) v = a0[hc]; else if (g == 7) v = p.k_k[hc]; else if (g == 8) v = p.k_a[hc]; else v = p.r_k[hc];
          *(LAS float*)(lds + L_CST + i * 4) = v; } }
    __syncthreads();
    if ((wave & 2) != 0) {
        const int pw = (wave & 1) + ((wave >> 2) << 1), tq = lane >> 3, c8 = (lane & 7) * 8, hj = h * 64 + c8, tslot = pw * 8 + tq;
        const int gcol[5] = {hj, 1024 + hj, 2048 + hj, 3072 + dir * 64 + c8, 3200 + dir * 64 + c8};
        LAS unsigned char* scr = lds + L_SCR + pw * SCRB;
#define RW_CST(g, hh) (*(LAS f32x4*)(lds + L_CST + ((g) * 64 + c8 + 4 * (hh)) * 4))
#define RW_LOADRAW(raw, cc) do { const bf16_t* zr_ = Z + (size_t)rw_row(dir, (cc) * CH + tslot) * ZW; \
            _Pragma("unroll") for (int g = 0; g < 5; ++g) raw.c[g] = *(const u32x4*)(zr_ + gcol[g]); } while (0)
        Raw rawA, rawB;
        f32x4 cw0[2], ca0[2], ckk[2], cka[2], crk[2];
#pragma unroll
        for (int hh = 0; hh < 2; ++hh) { cw0[hh] = RW_CST(5, hh); ca0[hh] = RW_CST(6, hh); ckk[hh] = RW_CST(7, hh); cka[hh] = RW_CST(8, hh); crk[hh] = RW_CST(9, hh);
            asm volatile("" : "+v"(cw0[hh]), "+v"(ca0[hh]), "+v"(ckk[hh]), "+v"(cka[hh]), "+v"(crk[hh])); }
        if (MODE == 0 || MODE == 2 || MODE == 3 || MODE == 9) { RW_LOADRAW(rawA, 0); RW_LOADRAW(rawB, 1); }
#define RW_PREP_ITER(RAWSET, cc_) do { \
            if (MODE == 0 || MODE == 2 || MODE == 3 || MODE == 9) { \
            const int cn = (cc_) + 1; LAS unsigned char* buf = lds + (cn & 1) * BUFB; const int p0 = cn * CH; const bool latent = p0 >= CTXN; \
            f32x4 rr[2], kv[2]; \
            { const u32x4 u = RAWSET.c[0]; rr[0] = (f32x4){bflo(u.x), bfhi(u.x), bflo(u.y), bfhi(u.y)}; rr[1] = (f32x4){bflo(u.z), bfhi(u.z), bflo(u.w), bfhi(u.w)}; \
              *(LAS f32x4*)(buf + O_R + (tslot * 64 + c8) * 4) = rr[0]; *(LAS f32x4*)(buf + O_R + (tslot * 64 + c8) * 4 + 16) = rr[1]; } \
            { const u32x4 u = RAWSET.c[1]; kv[0] = (f32x4){bflo(u.x), bfhi(u.x), bflo(u.y), bfhi(u.y)}; kv[1] = (f32x4){bflo(u.z), bfhi(u.z), bflo(u.w), bfhi(u.w)}; } \
            if ((lane & 7) == eighth) { const u32x4 u = RAWSET.c[2]; *(LAS f32x4*)(buf + O_V + tslot * 32) = (f32x4){bflo(u.x), bfhi(u.x), bflo(u.y), bfhi(u.y)}; *(LAS f32x4*)(buf + O_V + tslot * 32 + 16) = (f32x4){bflo(u.z), bfhi(u.z), bflo(u.w), bfhi(u.w)}; } \
            { const u32x4 u = RAWSET.c[3]; u32x4 o; \
              o.x = pkbf(fast_tanh(bflo(u.x)), fast_tanh(bfhi(u.x))); o.y = pkbf(fast_tanh(bflo(u.y)), fast_tanh(bfhi(u.y))); o.z = pkbf(fast_tanh(bflo(u.z)), fast_tanh(bfhi(u.z))); o.w = pkbf(fast_tanh(bflo(u.w)), fast_tanh(bfhi(u.w))); \
              *(LAS u32x4*)(scr + (tq * PITCH + c8) * 2) = o; *(LAS u32x4*)(scr + 16 * PITCH * 2 + (tq * PITCH + c8) * 2) = RAWSET.c[4]; } \
            if (cn + 2 < NC) RW_LOADRAW(RAWSET, cn + 2);              \
            asm volatile("s_waitcnt lgkmcnt(0)" ::: "memory"); \
            { const int r16 = lane & 15, quad = lane >> 4; f32x4 acc[2][4]; \
_Pragma("unroll") \
              for (int lora = 0; lora < 2; ++lora) { \
                  LAS unsigned char* X = scr + lora * 16 * PITCH * 2 + (r16 * PITCH + quad * 8) * 2; \
                  const bf16x8 x0 = *(LAS bf16x8*)X, x1 = *(LAS bf16x8*)(X + 64); \
_Pragma("unroll") \
                  for (int jt = 0; jt < 4; ++jt) { \
                      LAS unsigned char* Y = lds + (lora ? L_A2T : L_W2T) + ((jt * 16 + r16) * PITCH + quad * 8) * 2; \
                      acc[lora][jt] = (f32x4){0.f, 0.f, 0.f, 0.f}; \
                      acc[lora][jt] = __builtin_amdgcn_mfma_f32_16x16x32_bf16(x0, *(LAS bf16x8*)Y, acc[lora][jt], 0, 0, 0); \
                      acc[lora][jt] = __builtin_amdgcn_mfma_f32_16x16x32_bf16(x1, *(LAS bf16x8*)(Y + 64), acc[lora][jt], 0, 0, 0); } } \
              if (quad < 2) { \
_Pragma("unroll") \
                  for (int lora = 0; lora < 2; ++lora) \
_Pragma("unroll") \
                      for (int jt = 0; jt < 4; ++jt) \
_Pragma("unroll") \
                          for (int r = 0; r < 4; ++r) *(LAS float*)(buf + (lora ? O_B : O_W) + ((pw * 8 + quad * 4 + r) * 64 + jt * 16 + r16) * 4) = acc[lora][jt][r]; } } \
            asm volatile("s_waitcnt lgkmcnt(0)" ::: "memory"); \
            { float bs = 0.f, nn = 0.f; f32x4 kk[2], al[2]; \
_Pragma("unroll") \
              for (int hh = 0; hh < 2; ++hh) { const int off = (tslot * 64 + c8 + 4 * hh) * 4; \
                  const f32x4 aw = *(LAS f32x4*)(buf + O_W + off) + cw0[hh], aa = *(LAS f32x4*)(buf + O_B + off) + ca0[hh]; \
                  f32x4 wv; \
_Pragma("unroll") \
                  for (int q = 0; q < 4; ++q) { const float sg = __builtin_amdgcn_rcpf(1.0f + __builtin_amdgcn_exp2f(-1.4426950408889634f * aw[q])); \
                      wv[q] = __builtin_amdgcn_exp2f(-0.8750612633917f * sg); al[hh][q] = __builtin_amdgcn_rcpf(1.0f + __builtin_amdgcn_exp2f(-1.4426950408889634f * aa[q])); kk[hh][q] = kv[hh][q] * ckk[hh][q]; nn += kk[hh][q] * kk[hh][q]; } \
                  *(LAS f32x4*)(buf + O_W + off) = wv; } \
              nn = allreduce8(nn); \
              const float inv = __builtin_amdgcn_rsqf(fmaxf(nn, 1e-24f)); \
_Pragma("unroll") \
              for (int hh = 0; hh < 2; ++hh) { const int off = (tslot * 64 + c8 + 4 * hh) * 4; \
                  const f32x4 r = rr[hh]; \
                  f32x4 av, bv, kd; \
_Pragma("unroll") \
                  for (int q = 0; q < 4; ++q) { const float kn = kk[hh][q] * inv; av[q] = -kn; bv[q] = kn * al[hh][q]; kd[q] = kv[hh][q] * (1.0f + (al[hh][q] - 1.0f) * cka[hh][q]); bs += r[q] * kd[q] * crk[hh][q]; } \
                  *(LAS f32x4*)(buf + O_B + off) = bv; *(LAS f32x4*)(buf + O_KD + off) = kd; *(LAS f32x4*)(buf + O_A + off) = av; } \
              bs = allreduce8(bs); \
              if (MODE == 0 && latent && eighth == 0 && (lane & 7) == 0) bon[rw_row(dir, p0 + tslot) - CTXN] = bs; } \
            } \
            __syncthreads(); \
        } while (0)
        for (int c = -1; c < NC - 1; c += 2) { RW_PREP_ITER(rawA, c); RW_PREP_ITER(rawB, c + 1); }
#undef RW_PREP_ITER
#undef RW_LOADRAW
#undef RW_CST
    } else if (wave >= 4) {
        const int sw = wave - 4, et = lane >> 1, erp = lane & 1;
#define RW_EMIT(cc) do { if ((cc) * CH >= CTXN) { const LAS f32x4* yp = (const LAS f32x4*)(lds + L_Y + ((((cc) & 1) * 2 + sw) * 8192) + et * 256 + erp * 128); \
            f32x4 s0 = yp[0] + yp[1] + yp[2] + yp[3], s1 = yp[4] + yp[5] + yp[6] + yp[7]; \
            *(unsigned*)(BR + (size_t)rw_row(dir, (cc) * CH + et) * 2048 + dir * 1024 + h * 64 + eighth * 8 + sw * 4 + erp * 2) = pkbf((s0[0] + s0[1]) + (s0[2] + s0[3]), (s1[0] + s1[1]) + (s1[2] + s1[3])); } } while (0)
        __syncthreads();
        for (int c = 0; c < NC; ++c) { if (c >= 1) RW_EMIT(c - 1); if (c + 1 < NC) __syncthreads(); }
    } else {
        __builtin_amdgcn_s_setprio(0);
        typedef float f32x2 __attribute__((ext_vector_type(2)));
        f32x2 S01 = {0.f, 0.f}, S23 = {0.f, 0.f};
        const int srow = wave * 4 + (lane >> 4), sj = (lane & 15) * 4;
        __syncthreads();
        struct Ops { f32x4 a, w, b, k, r; float v; };
#define RW_LD(o, t) do { o.a = *(LAS f32x4*)(bp + O_A + (t) * 256); \
            if (MODE == 9) { o.w = o.a; o.b = o.a; o.k = o.a; o.r = o.a; o.v = o.a[0]; } else { o.w = *(LAS f32x4*)(bp + O_W + (t) * 256); o.b = *(LAS f32x4*)(bp + O_B + (t) * 256); \
            o.k = *(LAS f32x4*)(bp + O_KD + (t) * 256); o.r = *(LAS f32x4*)(bp + O_R + (t) * 256); o.v = *(LAS float*)(vp + (t) * 32); } } while (0)
#define RW_STEP(o, t) do { f32x2 pd = S01 * o.a.lo; pd = S23 * o.a.hi + pd; float sa = pd.x + pd.y; if (MODE != 5 && MODE != 7) sa = allreduce16(sa); \
            S01 = o.b.lo * sa + (S01 * o.w.lo + o.k.lo * o.v); S23 = o.b.hi * sa + (S23 * o.w.hi + o.k.hi * o.v); \
            { f32x2 py = S01 * o.r.lo; py = S23 * o.r.hi + py; *(LAS float*)(yb + (t) * 256) = py.x + py.y; } } while (0)
        for (int c = 0; c < NC; ++c) {
            LAS unsigned char* bp = lds + (c & 1) * BUFB + sj * 4; LAS unsigned char* vp = lds + (c & 1) * BUFB + O_V + srow * 4; LAS unsigned char* yb = lds + L_Y + ((c & 1) * 2 + wave) * 8192 + lane * 4;
            Ops A0, A1, A2, A3, B0, B1, B2, B3;
            if (MODE != 2) {
            RW_LD(A0, 0); RW_LD(A1, 1); RW_LD(A2, 2); RW_LD(A3, 3);
#pragma unroll
            for (int g = 0; g < CH / 8; ++g) {
                RW_LD(B0, 8 * g + 4); RW_LD(B1, 8 * g + 5); RW_LD(B2, 8 * g + 6); RW_LD(B3, 8 * g + 7);
                __builtin_amdgcn_sched_barrier(0);
                RW_STEP(A0, 8 * g); RW_STEP(A1, 8 * g + 1); RW_STEP(A2, 8 * g + 2); RW_STEP(A3, 8 * g + 3);
                __builtin_amdgcn_sched_barrier(0);
                if (g + 1 < CH / 8) { RW_LD(A0, 8 * g + 8); RW_LD(A1, 8 * g + 9); RW_LD(A2, 8 * g + 10); RW_LD(A3, 8 * g + 11); }
                __builtin_amdgcn_sched_barrier(0);
                RW_STEP(B0, 8 * g + 4); RW_STEP(B1, 8 * g + 5); RW_STEP(B2, 8 * g + 6); RW_STEP(B3, 8 * g + 7);
                __builtin_amdgcn_sched_barrier(0);
            }
            }
            if (c + 1 < NC) __syncthreads();
        }
#undef RW_LD
#undef RW_STEP
        if (MODE != 0) asm volatile("" :: "v"(S01), "v"(S23));
        __builtin_amdgcn_s_setprio(0);
    }
    __syncthreads();
    if (wave == 4 || wave == 5) { const int sw = wave - 4, et = lane >> 1, erp = lane & 1; RW_EMIT(NC - 1); }
#undef RW_EMIT
    __syncthreads();
}

__device__ __forceinline__ float wave_sum(float v) {
    v = allreduce16(v);
    { auto r = __builtin_amdgcn_permlane16_swap(__float_as_uint(v), __float_as_uint(v), false, false); v = __uint_as_float(r[0]) + __uint_as_float(r[1]); }
    { auto r = __builtin_amdgcn_permlane32_swap(__float_as_uint(v), __float_as_uint(v), false, false); v = __uint_as_float(r[0]) + __uint_as_float(r[1]); }
    return v;
}
__device__ __forceinline__ void finish_phase(const Params& p) {
    int tid_ = threadIdx.x; asm volatile("" : "+v"(tid_));
    const int lane = tid_ & 63, gw = (int)blockIdx.x * NWAVES + (tid_ >> 6), ngw = (int)gridDim.x * NWAVES;
    const bf16_t* Z = ws_big(p); bf16_t* BR = ws_br(p); const float* bon = (const float*)(p.ws + WS_BON);
    for (int it = gw; it < SEQ * 4; it += ngw) {
        const int t = it >> 2, h = (it & 3) * 4 + (lane >> 4), row = CTXN + t, col = h * 64 + (lane & 15) * 4;
        bf16_t* b = BR + (size_t)row * 2048;
        const u32x2 wf = *(const u32x2*)(b + col), wb = *(const u32x2*)(b + 1024 + col), zv = *(const u32x2*)(Z + (size_t)row * ZW + 2048 + col);
        const f32x4 x = {bflo(wf.x) + bflo(wb.x), bfhi(wf.x) + bfhi(wb.x), bflo(wf.y) + bflo(wb.y), bfhi(wf.y) + bfhi(wb.y)};
        const float mean = allreduce16((x[0] + x[1]) + (x[2] + x[3])) * (1.0f / 64.f);
        const f32x4 d = x - mean;
        const float var = allreduce16((d[0] * d[0] + d[1] * d[1]) + (d[2] * d[2] + d[3] * d[3])) * (1.0f / 64.f);
        const float rstd = __builtin_amdgcn_rsqf(var + GN_EPS), bsum = bon[(size_t)h * SEQ + t] + bon[((size_t)16 + h) * SEQ + t];
        const f32x4 g = *(const f32x4*)(p.lnx_g + col), bb = *(const f32x4*)(p.lnx_b + col), v = {bflo(zv.x), bfhi(zv.x), bflo(zv.y), bfhi(zv.y)};
        const f32x4 y = d * rstd * g + bb + v * bsum;
        u32x2 o; o.x = pkbf(y[0], y[1]); o.y = pkbf(y[2], y[3]);
        *(u32x2*)(b + 1024 + col) = o;
    }
}
}

namespace wy {
typedef short bf16x4 __attribute__((ext_vector_type(4)));
using rw::f32x4; using rw::u32x4; using rw::u32x2; using rw::bf16x8; using rw::bflo; using rw::bfhi; using rw::PITCH;
typedef float f32x2_t __attribute__((ext_vector_type(2)));
typedef __bf16 bf2_t __attribute__((ext_vector_type(2)));
__device__ __forceinline__ unsigned pkbf(float lo, float hi) { const f32x2_t v = {lo, hi}; return __builtin_bit_cast(unsigned, __builtin_convertvector(v, bf2_t)); }
typedef GAS unsigned gu32;
#define WY_RLX __ATOMIC_RELAXED, __HIP_MEMORY_SCOPE_AGENT
constexpr int NJOB = R / 64, NCHUNK = R / 16, NSLOT = 8, ATP = 144, REC = 13056, JOBB = 4 * REC;
static_assert(R % 64 == 0 && CTXN % 64 == 0 && (R / 64) % 2 == 0, "jobs are 64 tokens; the loader is unrolled by two jobs");
constexpr int R_AT = 0, R_RT = 2304, R_BK = 4608, R_VT = 8704, R_AAK = 10752, R_TT = 11264, R_ARBK = 11776, R_WL = 12800;
__device__ __forceinline__ int permj(int j) { return (j >> 5) * 32 + ((j >> 2) & 3) * 8 + ((j >> 4) & 1) * 4 + (j & 3); }
constexpr int C_SLOTS = 3, C_SYNC = C_SLOTS * JOBB;
static_assert(C_SYNC + 64 <= 163840 - 64 && (JOBB / 4) % 16 == 0, "consumer LDS map");
constexpr size_t WS_RING = WS_WB;
constexpr size_t RING_TOTAL = (size_t)32 * NSLOT * JOBB;
constexpr size_t WS_WYF = 256 * 1024 + 16384;
constexpr int WYF_ACK = 32 * NSLOT * 64, WYF_ABORT = WYF_ACK + 32 * 64, WYF_WORDS = WYF_ABORT + 64;
constexpr unsigned SPIN_CAP = 1u << 17;
constexpr int P_A = 0, P_B = 16384, P_KD = 32768, P_LW = 49152, P_IMG = 65536, P_BRM = P_IMG + JOBB, P_KRM = P_BRM + 8192, P_AAB = P_KRM + 8192, P_W2T = P_AAB + 4096, P_A2T = P_W2T + 64 * PITCH * 2, P_END = P_A2T + 64 * PITCH * 2;
constexpr int P_SCR = P_BRM, SCRW = 2 * 8 * PITCH * 2;
constexpr int P_CST = P_IMG;
static_assert(P_END <= 163840 - 64 && P_SCR + 8 * SCRW + 8 * PITCH * 2 <= P_W2T, "wy LDS map");

__device__ __forceinline__ bf16x4 pack4(f32x4 v) { u32x2 r; r.x = pkbf(v[0], v[1]); r.y = pkbf(v[2], v[3]); return __builtin_bit_cast(bf16x4, r); }
__device__ __forceinline__ f32x4 mm(u32x2 a, bf16x4 b, f32x4 c) { return __builtin_amdgcn_mfma_f32_16x16x16bf16_1k(__builtin_bit_cast(bf16x4, a), b, c, 0, 0, 0); }
__device__ __forceinline__ f32x4 mm(u32x2 a, u32x2 b, f32x4 c) { return __builtin_amdgcn_mfma_f32_16x16x16bf16_1k(__builtin_bit_cast(bf16x4, a), __builtin_bit_cast(bf16x4, b), c, 0, 0, 0); }
__device__ __forceinline__ void wait_ge(gu32* word, unsigned want, gu32* abortw, int lane) {
    for (unsigned spins = 0;;) {
        unsigned v = 0u; if (lane == 0) v = __hip_atomic_load(word, WY_RLX);
        if ((unsigned)__builtin_amdgcn_readfirstlane(v) >= want) return;
        __builtin_amdgcn_s_sleep(1);
        if ((++spins & 255u) == 0u) { unsigned a = 0u; if (lane == 0) a = __hip_atomic_load(abortw, WY_RLX);
            if (__builtin_amdgcn_readfirstlane(a)) return;
            if (spins > SPIN_CAP) { if (lane == 0) __hip_atomic_store(abortw, 1u, WY_RLX); return; } }
    }
}

__device__ __forceinline__ void wait_ge4(gu32* words, unsigned want, gu32* abortw, int lane) {
    for (unsigned spins = 0;;) {
        unsigned v = 0xffffffffu; if (lane < 4) v = __hip_atomic_load(words + lane, WY_RLX);
        const unsigned v0 = (unsigned)__builtin_amdgcn_readlane((int)v, 0), v1 = (unsigned)__builtin_amdgcn_readlane((int)v, 1), v2 = (unsigned)__builtin_amdgcn_readlane((int)v, 2), v3 = (unsigned)__builtin_amdgcn_readlane((int)v, 3);
        const unsigned m01 = v0 < v1 ? v0 : v1, m23 = v2 < v3 ? v2 : v3;
        if ((m01 < m23 ? m01 : m23) >= want) return;
        __builtin_amdgcn_s_sleep(1);
        if ((++spins & 255u) == 0u) { unsigned a = 0u; if (lane == 0) a = __hip_atomic_load(abortw, WY_RLX);
            if (__builtin_amdgcn_readfirstlane(a)) return;
            if (spins > SPIN_CAP) { if (lane == 0) __hip_atomic_store(abortw, 1u, WY_RLX); return; } }
    }
}

struct Frag { u32x4 a01, a23, r01, r23, bk[4], arbk; u32x2 vT, aak, tt; f32x4 wl[4]; };

__device__ __forceinline__ void wait_lds_min4(LAS unsigned* w, unsigned want, gu32* abortw, int lane) {
    for (unsigned spins = 0;;) {
        const unsigned a = __hip_atomic_load(w, __ATOMIC_RELAXED, __HIP_MEMORY_SCOPE_WORKGROUP), b = __hip_atomic_load(w + 1, __ATOMIC_RELAXED, __HIP_MEMORY_SCOPE_WORKGROUP),
                       c = __hip_atomic_load(w + 2, __ATOMIC_RELAXED, __HIP_MEMORY_SCOPE_WORKGROUP), d = __hip_atomic_load(w + 3, __ATOMIC_RELAXED, __HIP_MEMORY_SCOPE_WORKGROUP);
        const unsigned m0 = a < b ? a : b, m1 = c < d ? c : d;
        if ((unsigned)__builtin_amdgcn_readfirstlane((int)(m0 < m1 ? m0 : m1)) >= want) return;
        __builtin_amdgcn_s_sleep(1);
        if ((++spins & 1023u) == 0u) { unsigned ab = 0u; if (lane == 0) ab = __hip_atomic_load(abortw, WY_RLX);
            if (__builtin_amdgcn_readfirstlane(ab)) return;
            if (spins > (SPIN_CAP << 3)) { if (lane == 0) __hip_atomic_store(abortw, 1u, WY_RLX); return; } }
    }
}
template <int MODE> __device__ __forceinline__ void loader(const Params& p, int chain, int lw, int lane, LAS unsigned char* lds) {
    gu32* wf = (gu32*)(p.ws + WS_WYF); gu32* flags = wf + chain * NSLOT * 64; gu32* ackw = wf + WYF_ACK + chain * 64; gu32* abortw = wf + WYF_ABORT;
    LAS unsigned* loaded = (LAS unsigned*)(lds + C_SYNC); LAS unsigned* done = loaded + 4;
    const __amdgpu_buffer_rsrc_t ring_rsrc = __builtin_amdgcn_make_buffer_rsrc((void*)(p.ws + WS_RING), 0, (int)RING_TOTAL, 0x00020000);
    constexpr int QB = JOBB / 4, NIT = (QB / 16 + 63) / 64, TAIL = QB / 16 - (NIT - 1) * 64;
    static_assert(NIT == 13, "the counted waits below assume 13 loads per set");
    u32x4 va[NIT], vb[NIT];
#define WY_ISSUE(v, g_) do { if (MODE < 2) wait_ge(flags + ((g_) % NSLOT) * 64, (unsigned)(g_) + 1u, abortw, lane); \
        const int soff = (chain * NSLOT + (g_) % NSLOT) * JOBB + lw * QB + lane * 16; \
        _Pragma("unroll") for (int k = 0; k < NIT; ++k) if (MODE == 0 && (k < NIT - 1 || lane < TAIL)) v[k] = __builtin_amdgcn_raw_buffer_load_b128(ring_rsrc, soff + k * 1024, 0, 16); } while (0)
#define WY_COMMIT(v, g_, WAITSTR) do { \
        if (MODE != 1 && (g_) >= C_SLOTS) { wait_lds_min4(done, (unsigned)((g_) - C_SLOTS + 1), abortw, lane); __builtin_amdgcn_fence(__ATOMIC_ACQUIRE, "workgroup"); }     \
        asm volatile(WAITSTR ::: "memory");                                                     \
        LAS unsigned char* dst = lds + ((g_) % C_SLOTS) * JOBB + lw * QB + lane * 16; \
        _Pragma("unroll") for (int k = 0; k < NIT; ++k) if (MODE == 0 && (k < NIT - 1 || lane < TAIL)) *(LAS u32x4*)(dst + k * 1024) = v[k]; \
        asm volatile("s_waitcnt lgkmcnt(0)" ::: "memory"); \
        __builtin_amdgcn_fence(__ATOMIC_RELEASE, "workgroup"); \
        if (lane == 0) { __hip_atomic_store(ackw + lw, (unsigned)(g_) + 1u, WY_RLX); __hip_atomic_store(loaded + lw, (unsigned)(g_) + 1u, __ATOMIC_RELAXED, __HIP_MEMORY_SCOPE_WORKGROUP); } } while (0)
    WY_ISSUE(va, 0);
    for (int g = 0; g < NJOB; g += 2) {
        WY_ISSUE(vb, g + 1); WY_COMMIT(va, g, "s_waitcnt vmcnt(13)");
        if (g + 2 < NJOB) { WY_ISSUE(va, g + 2); WY_COMMIT(vb, g + 1, "s_waitcnt vmcnt(13)"); } else WY_COMMIT(vb, g + 1, "s_waitcnt vmcnt(0)");
    }
#undef WY_ISSUE
#undef WY_COMMIT
}
__device__ __forceinline__ bf16x8 cat(u32x2 a, u32x2 b) { const u32x4 v = {a.x, a.y, b.x, b.y}; return __builtin_bit_cast(bf16x8, v); }
__device__ __forceinline__ u32x2 pack4u(f32x4 v) { u32x2 r; r.x = pkbf(v[0], v[1]); r.y = pkbf(v[2], v[3]); return r; }
__device__ __forceinline__ f32x4 mm32(bf16x8 a, bf16x8 b, f32x4 c) { return __builtin_amdgcn_mfma_f32_16x16x32_bf16(a, b, c, 0, 0, 0); }
template <int MODE> __device__ __forceinline__ void consumer(const Params& p, int chain, int wave, int lane, LAS unsigned char* lds) {
    const int n = lane & 15, q = lane >> 4, dir = chain >> 4, h = chain & 15;
    gu32* abortw = (gu32*)(p.ws + WS_WYF) + WYF_ABORT;
    LAS unsigned* loaded = (LAS unsigned*)(lds + C_SYNC); LAS unsigned* done = loaded + 4;
    f32x4 S0 = {0.f, 0.f, 0.f, 0.f}, S1 = S0, S2 = S0, S3 = S0;
    const int offA = n * ATP + 16 * q, offB = n * 32 + 8 * q, offW = 16 * q, offS = n * 64 + ((q ^ ((n >> 2) & 3)) * 16);
    const long rstep = dir ? -2048 : 2048;
    bf16_t* yq = ws_br(p) + (size_t)(CTXN + (dir ? SEQ - 1 - 4 * q : 4 * q)) * 2048 + dir * 1024 + h * 64 + 16 * wave + n;
#define WY_LOAD(F, base, k) do { \
        F.a01 = *(const LAS u32x4*)(base + offA + (k) * REC + R_AT); F.a23 = *(const LAS u32x4*)(base + offA + (k) * REC + R_AT + 64); \
        F.r01 = *(const LAS u32x4*)(base + offA + (k) * REC + R_RT); F.r23 = *(const LAS u32x4*)(base + offA + (k) * REC + R_RT + 64); \
        _Pragma("unroll") for (int jt = 0; jt < 4; ++jt) { F.bk[jt] = *(const LAS u32x4*)(base + offS + (k) * REC + R_BK + 1024 * jt); F.wl[jt] = *(const LAS f32x4*)(base + offW + (k) * REC + R_WL + 64 * jt); } \
        F.arbk = *(const LAS u32x4*)(base + offS + (k) * REC + R_ARBK); \
        F.vT = *(const LAS u32x2*)(base + offB + (k) * REC + R_VT + 512 * wave); F.aak = *(const LAS u32x2*)(base + offB + (k) * REC + R_AAK); F.tt = *(const LAS u32x2*)(base + offB + (k) * REC + R_TT); } while (0)
#define WY_Q(v) __builtin_bit_cast(bf16x8, v)
#define WY_COMPUTE(F, cidx) do { const f32x4 z0_ = {0.f, 0.f, 0.f, 0.f}; const u32x2 zz_ = {0u, 0u};     \
        f32x4 Z = mm32(cat(F.aak, zz_), cat(F.vT, zz_), z0_); \
        const bf16x8 s01 = cat(pack4u(S0), pack4u(S1)), s23 = cat(pack4u(S2), pack4u(S3)); \
        Z = mm32(WY_Q(F.a01), s01, Z); Z = mm32(WY_Q(F.a23), s23, Z);     \
        f32x4 Y = mm32(WY_Q(F.r01), s01, z0_); Y = mm32(WY_Q(F.r23), s23, Y); \
        const u32x2 zb = pack4u(Z); const f32x4 U = mm32(cat(F.tt, zz_), cat(zb, zz_), z0_); const u32x2 ub = pack4u(U); \
        const bf16x8 vu = cat(F.vT, ub); \
        Y = mm32(WY_Q(F.arbk), vu, Y); \
        S0 = mm32(WY_Q(F.bk[0]), vu, S0); S1 = mm32(WY_Q(F.bk[1]), vu, S1); S2 = mm32(WY_Q(F.bk[2]), vu, S2); S3 = mm32(WY_Q(F.bk[3]), vu, S3); \
        S0 *= F.wl[0]; S1 *= F.wl[1]; S2 *= F.wl[2]; S3 *= F.wl[3]; \
        if (MODE == 0 && (cidx) * 16 >= CTXN) { const unsigned y01 = pkbf(Y[0], Y[1]), y23 = pkbf(Y[2], Y[3]); bf16_t* yp_ = yq + (long)((cidx) * 16 - CTXN) * rstep; \
            *(unsigned short*)yp_ = (unsigned short)(y01 & 0xffffu); *(unsigned short*)(yp_ + rstep) = (unsigned short)(y01 >> 16); \
            *(unsigned short*)(yp_ + 2 * rstep) = (unsigned short)(y23 & 0xffffu); *(unsigned short*)(yp_ + 3 * rstep) = (unsigned short)(y23 >> 16); } } while (0)
    Frag FA, FB;
    wait_lds_min4(loaded, 1u, abortw, lane); __builtin_amdgcn_fence(__ATOMIC_ACQUIRE, "workgroup");
    int slot = 0;
    { const LAS unsigned char* b0 = lds; WY_LOAD(FA, b0, 0); if (MODE == 3) WY_LOAD(FB, b0, 1); }
    for (int g = 0; g < NJOB; ++g) {
        const LAS unsigned char* base = lds + slot * JOBB;
        if (MODE != 3) WY_LOAD(FB, base, 1); WY_COMPUTE(FA, 4 * g);
        if (MODE != 3) WY_LOAD(FA, base, 2); WY_COMPUTE(FB, 4 * g + 1);
        if (MODE != 3) WY_LOAD(FB, base, 3); WY_COMPUTE(FA, 4 * g + 2);
        slot = slot == C_SLOTS - 1 ? 0 : slot + 1;
        if (g + 1 < NJOB) { wait_lds_min4(loaded, (unsigned)g + 2u, abortw, lane); __builtin_amdgcn_fence(__ATOMIC_ACQUIRE, "workgroup");
            const LAS unsigned char* nb = lds + slot * JOBB; if (MODE != 3) WY_LOAD(FA, nb, 0); }
        WY_COMPUTE(FB, 4 * g + 3);
        asm volatile("s_waitcnt lgkmcnt(0)" ::: "memory");
        __builtin_amdgcn_fence(__ATOMIC_RELEASE, "workgroup");
        if (lane == 0) __hip_atomic_store(done + wave, (unsigned)g + 1u, __ATOMIC_RELAXED, __HIP_MEMORY_SCOPE_WORKGROUP);
    }
#undef WY_LOAD
#undef WY_COMPUTE
#undef WY_Q
    if (MODE != 0) asm volatile("" :: "v"(S0), "v"(S1), "v"(S2), "v"(S3));
}

template <int HALF> __device__ __forceinline__ void stage2(LAS unsigned char* lds, LAS unsigned char* img, int ch, int j) {
    LAS unsigned char* rec = img + ch * REC;
    const LAS float* LW = (const LAS float*)(lds + P_LW) + (ch * 16) * 64 + j;
    const LAS float* XA = (const LAS float*)(lds + (HALF ? P_KD : P_A)) + (ch * 16) * 64 + j;
    const LAS float* XB = (const LAS float*)(lds + P_B) + (ch * 16) * 64 + j;
    LAS unsigned short* rowm0 = (LAS unsigned short*)(rec + (HALF ? R_RT : R_AT)) + permj(j);
    LAS unsigned short* rowm1 = (LAS unsigned short*)(lds + (HALF ? P_KRM : P_BRM) + ch * 2048) + permj(j);
    float lw[16], s0[16], s1[16];
#pragma unroll
    for (int t = 0; t < 16; ++t) { lw[t] = LW[t * 64]; s1[t] = HALF ? XA[t * 64] : XB[t * 64];
        if (HALF) s0[t] = __uint_as_float((unsigned)rowm0[t * (ATP / 2)] << 16); else s0[t] = XA[t * 64]; }
    float cum = 0.f, x0p = 0.f, x1p = 0.f; unsigned tp[8];
#pragma unroll
    for (int t = 0; t < 16; ++t) {
        const float cprev = cum; cum += lw[t];
        const float x0 = s0[t] * __builtin_amdgcn_exp2f(HALF ? cum : cprev), x1 = s1[t] * __builtin_amdgcn_exp2f(-cum);
        if (t & 1) { const unsigned p0 = pkbf(x0p, x0), p1 = pkbf(x1p, x1);
            rowm0[(t - 1) * (ATP / 2)] = (unsigned short)(p0 & 0xffffu); rowm0[t * (ATP / 2)] = (unsigned short)(p0 >> 16);
            rowm1[(t - 1) * 64] = (unsigned short)(p1 & 0xffffu); rowm1[t * 64] = (unsigned short)(p1 >> 16);
            tp[t >> 1] = p1; }
        x0p = x0; x1p = x1; }
    { LAS unsigned char* bkr = rec + R_BK + j * 64 + (HALF ? 0 : 8); const int sw = (j >> 2) & 3;
#pragma unroll
      for (int qq = 0; qq < 4; ++qq) *(LAS u32x2*)(bkr + ((qq ^ sw) * 16)) = (u32x2){tp[2 * qq], tp[2 * qq + 1]}; }
    if (HALF) *(LAS float*)(rec + R_WL + j * 4) = __builtin_amdgcn_exp2f(cum);
}

template <int SKIP> __device__ __forceinline__ void producer(const Params& p, int chain, int first, int step, LAS unsigned char* lds) {
    int tid_ = threadIdx.x; asm volatile("" : "+v"(tid_));
    const int tid = tid_, lane = tid & 63, wave = __builtin_amdgcn_readfirstlane(tid >> 6);
    const int dir = chain >> 4, h = chain & 15;
    const float* w0 = dir ? p.w0b : p.w0f; const float* w2 = dir ? p.w2b : p.w2f; const float* a0 = dir ? p.a0b : p.a0f; const float* a2 = dir ? p.a2b : p.a2f;
    const bf16_t* Z = ws_big(p); float* bon = (float*)(p.ws + rw::WS_BON) + ((size_t)dir * 16 + h) * SEQ;
    gu32* wf = (gu32*)(p.ws + WS_WYF); gu32* flags = wf + chain * NSLOT * 64; gu32* ackw = wf + WYF_ACK + chain * 64; gu32* abortw = wf + WYF_ABORT;
    const __amdgpu_buffer_rsrc_t ring_rsrc = __builtin_amdgcn_make_buffer_rsrc((void*)(p.ws + WS_RING), 0, (int)RING_TOTAL, 0x00020000);
    { const int m = tid >> 3, j8 = (tid & 7) * 8;
      const f32x4 wa = *(const f32x4*)(w2 + (size_t)m * 1024 + h * 64 + j8), wb = *(const f32x4*)(w2 + (size_t)m * 1024 + h * 64 + j8 + 4);
      const f32x4 aa = *(const f32x4*)(a2 + (size_t)m * 1024 + h * 64 + j8), ab = *(const f32x4*)(a2 + (size_t)m * 1024 + h * 64 + j8 + 4);
      LAS bf16_t* yw = (LAS bf16_t*)(lds + P_W2T); LAS bf16_t* ya = (LAS bf16_t*)(lds + P_A2T);
#pragma unroll
      for (int qq = 0; qq < 4; ++qq) { yw[(j8 + qq) * PITCH + m] = f2bf(wa[qq]); yw[(j8 + 4 + qq) * PITCH + m] = f2bf(wb[qq]); ya[(j8 + qq) * PITCH + m] = f2bf(aa[qq]); ya[(j8 + 4 + qq) * PITCH + m] = f2bf(ab[qq]); }
      for (int i = tid; i < 320; i += NTHR) { const int gI = i >> 6, cc = i & 63, hc = h * 64 + cc; float v;
          if (gI == 0) v = w0[hc]; else if (gI == 1) v = a0[hc]; else if (gI == 2) v = p.k_k[hc]; else if (gI == 3) v = p.k_a[hc]; else v = p.r_k[hc];
          *(LAS float*)(lds + P_CST + i * 4) = v; } }
    __syncthreads();
    const int tq = lane >> 3, c8 = (lane & 7) * 8, hj = h * 64 + c8, tslot = wave * 8 + tq, ch1 = tslot >> 4, t1 = tslot & 15;
    const int gcol[5] = {hj, 1024 + hj, 2048 + hj, 3072 + dir * 64 + c8, 3200 + dir * 64 + c8};
    f32x4 cw0[2], ca0[2], ckk[2], cka[2], crk[2];
#pragma unroll
    for (int hh = 0; hh < 2; ++hh) {
#define WY_CST(gI) (*(LAS f32x4*)(lds + P_CST + ((gI) * 64 + c8 + 4 * hh) * 4))
        cw0[hh] = WY_CST(0); ca0[hh] = WY_CST(1); ckk[hh] = WY_CST(2); cka[hh] = WY_CST(3); crk[hh] = WY_CST(4);
#undef WY_CST
        asm volatile("" : "+v"(cw0[hh]), "+v"(ca0[hh]), "+v"(ckk[hh]), "+v"(cka[hh]), "+v"(crk[hh])); }
    __syncthreads();
    LAS unsigned char* scr = lds + P_SCR + wave * SCRW;
    LAS unsigned char* img = lds + P_IMG;
    rw::Raw raw;
#define WY_LOADRAW(gj) do { const bf16_t* zr_ = Z + (size_t)rw_row(dir, (gj) * 64 + tslot) * ZW; \
        _Pragma("unroll") for (int g5 = 0; g5 < 5; ++g5) raw.c[g5] = *(const u32x4*)(zr_ + gcol[g5]); } while (0)
    if (first < NJOB) WY_LOADRAW(first);
    for (int g = first; g < NJOB; g += step) {
        const bool latent = g * 64 >= CTXN;
        if (!(SKIP & 1)) { f32x4 rr[2], kv[2];
          { const u32x4 u = raw.c[0]; rr[0] = (f32x4){bflo(u.x), bfhi(u.x), bflo(u.y), bfhi(u.y)}; rr[1] = (f32x4){bflo(u.z), bfhi(u.z), bflo(u.w), bfhi(u.w)};
            LAS unsigned char* rr_ = img + ch1 * REC + R_RT + t1 * ATP + permj(c8) * 2; *(LAS u32x2*)rr_ = (u32x2){u.x, u.y}; *(LAS u32x2*)(rr_ + 16) = (u32x2){u.z, u.w}; }
          { const u32x4 u = raw.c[1]; kv[0] = (f32x4){bflo(u.x), bfhi(u.x), bflo(u.y), bfhi(u.y)}; kv[1] = (f32x4){bflo(u.z), bfhi(u.z), bflo(u.w), bfhi(u.w)}; }
          { const u32x4 u = raw.c[2]; LAS unsigned short* vt = (LAS unsigned short*)(img + ch1 * REC + R_VT) + c8 * 16 + t1;
            vt[0] = (unsigned short)(u.x & 0xffffu); vt[16] = (unsigned short)(u.x >> 16); vt[32] = (unsigned short)(u.y & 0xffffu); vt[48] = (unsigned short)(u.y >> 16);
            vt[64] = (unsigned short)(u.z & 0xffffu); vt[80] = (unsigned short)(u.z >> 16); vt[96] = (unsigned short)(u.w & 0xffffu); vt[112] = (unsigned short)(u.w >> 16); }
          { const u32x4 u = raw.c[3]; u32x4 o;
            o.x = pkbf(rw::fast_tanh(bflo(u.x)), rw::fast_tanh(bfhi(u.x))); o.y = pkbf(rw::fast_tanh(bflo(u.y)), rw::fast_tanh(bfhi(u.y))); o.z = pkbf(rw::fast_tanh(bflo(u.z)), rw::fast_tanh(bfhi(u.z))); o.w = pkbf(rw::fast_tanh(bflo(u.w)), rw::fast_tanh(bfhi(u.w)));
            *(LAS u32x4*)(scr + (tq * PITCH + c8) * 2) = o; *(LAS u32x4*)(scr + 8 * PITCH * 2 + (tq * PITCH + c8) * 2) = raw.c[4]; }
          if (g + step < NJOB) WY_LOADRAW(g + step);
          asm volatile("s_waitcnt lgkmcnt(0)" ::: "memory");
          { const int r16 = lane & 15, quad = lane >> 4; f32x4 acc[2][4];
#pragma unroll
            for (int lora = 0; lora < 2; ++lora) {
                LAS unsigned char* X = scr + lora * 8 * PITCH * 2 + (r16 * PITCH + quad * 8) * 2;
                const bf16x8 x0 = *(LAS bf16x8*)X, x1 = *(LAS bf16x8*)(X + 64);
#pragma unroll
                for (int jt = 0; jt < 4; ++jt) {
                    LAS unsigned char* Y = lds + (lora ? P_A2T : P_W2T) + ((jt * 16 + r16) * PITCH + quad * 8) * 2;
                    acc[lora][jt] = (f32x4){0.f, 0.f, 0.f, 0.f};
                    acc[lora][jt] = __builtin_amdgcn_mfma_f32_16x16x32_bf16(x0, *(LAS bf16x8*)Y, acc[lora][jt], 0, 0, 0);
                    acc[lora][jt] = __builtin_amdgcn_mfma_f32_16x16x32_bf16(x1, *(LAS bf16x8*)(Y + 64), acc[lora][jt], 0, 0, 0); } }
            if (quad < 2) {
#pragma unroll
                for (int lora = 0; lora < 2; ++lora)
#pragma unroll
                    for (int jt = 0; jt < 4; ++jt)
#pragma unroll
                        for (int r = 0; r < 4; ++r) *(LAS float*)(lds + (lora ? P_B : P_LW) + ((wave * 8 + quad * 4 + r) * 64 + jt * 16 + r16) * 4) = acc[lora][jt][r]; } }
          asm volatile("s_waitcnt lgkmcnt(0)" ::: "memory");
          { float bs = 0.f, nn = 0.f; f32x4 kk[2], al[2];
#pragma unroll
            for (int hh = 0; hh < 2; ++hh) { const int off = (tslot * 64 + c8 + 4 * hh) * 4;
                const f32x4 aw = *(LAS f32x4*)(lds + P_LW + off) + cw0[hh], aa = *(LAS f32x4*)(lds + P_B + off) + ca0[hh];
                f32x4 lw;
#pragma unroll
                for (int qq = 0; qq < 4; ++qq) { const float sg = __builtin_amdgcn_rcpf(1.0f + __builtin_amdgcn_exp2f(-1.4426950408889634f * aw[qq]));
                    lw[qq] = -0.8750612633917f * sg; al[hh][qq] = __builtin_amdgcn_rcpf(1.0f + __builtin_amdgcn_exp2f(-1.4426950408889634f * aa[qq])); kk[hh][qq] = kv[hh][qq] * ckk[hh][qq]; nn += kk[hh][qq] * kk[hh][qq]; }
                *(LAS f32x4*)(lds + P_LW + off) = lw; }
            nn = rw::allreduce8(nn);
            const float inv = __builtin_amdgcn_rsqf(fmaxf(nn, 1e-24f));
#pragma unroll
            for (int hh = 0; hh < 2; ++hh) { const int off = (tslot * 64 + c8 + 4 * hh) * 4;
                const f32x4 r = rr[hh];
                f32x4 av, bv, kd;
#pragma unroll
                for (int qq = 0; qq < 4; ++qq) { const float kn = kk[hh][qq] * inv; av[qq] = -kn; bv[qq] = kn * al[hh][qq]; kd[qq] = kv[hh][qq] * (1.0f + (al[hh][qq] - 1.0f) * cka[hh][qq]); bs += r[qq] * kd[qq] * crk[hh][qq]; }
                *(LAS f32x4*)(lds + P_B + off) = bv; *(LAS f32x4*)(lds + P_KD + off) = kd; *(LAS f32x4*)(lds + P_A + off) = av; }
            bs = rw::allreduce8(bs);
            if (latent && (lane & 7) == 0) bon[rw_row(dir, g * 64 + tslot) - CTXN] = bs; } }
        __syncthreads();
        if (!(SKIP & 2)) { if (wave >> 2) stage2<1>(lds, img, wave & 3, lane); else stage2<0>(lds, img, wave & 3, lane); }
        __syncthreads();
        if (!(SKIP & 4)) { const int ch = wave & 3, pair = wave >> 2, n = lane & 15, q = lane >> 4;
          LAS unsigned char* rec = img + ch * REC;
          const LAS unsigned char* Yrm = rec + (pair ? R_RT : R_AT) + n * ATP + 16 * q;
          const LAS unsigned char* Xb = lds + P_BRM + ch * 2048 + n * 128 + 16 * q;
          const LAS unsigned char* Xk = lds + P_KRM + ch * 2048 + n * 128 + 16 * q;
          f32x4 cb = {0.f, 0.f, 0.f, 0.f}, ck = cb;
#pragma unroll
          for (int jt = 0; jt < 4; ++jt) { const int o_ = (jt >> 1) * 64 + (jt & 1) * 8; const u32x2 yb = *(const LAS u32x2*)(Yrm + o_);
              cb = mm(*(const LAS u32x2*)(Xb + o_), yb, cb); ck = mm(*(const LAS u32x2*)(Xk + o_), yb, ck); }
#pragma unroll
          for (int r = 0; r < 4; ++r) { const int s = 4 * q + r; const bool keep = pair ? (s <= n) : (s < n); if (!keep) { cb[r] = 0.f; ck[r] = 0.f; } }
          u32x2 ob, ok; ob.x = pkbf(cb[0], cb[1]); ob.y = pkbf(cb[2], cb[3]); ok.x = pkbf(ck[0], ck[1]); ok.y = pkbf(ck[2], ck[3]);
          if (pair) *(LAS u32x4*)(rec + R_ARBK + n * 64 + ((q ^ ((n >> 2) & 3)) * 16)) = (u32x4){ok.x, ok.y, ob.x, ob.y};
          else {
              *(LAS u32x2*)(rec + R_AAK + n * 32 + 8 * q) = ok;
              LAS float* A2 = (LAS float*)(lds + P_AAB + ch * 1024);
#pragma unroll
              for (int r = 0; r < 4; ++r) A2[n * 16 + r * 4 + q] = cb[r];
              asm volatile("s_waitcnt lgkmcnt(0)" ::: "memory");
              const int c = lane >> 2, pp = lane & 3;
              f32x4 a4[16];
#pragma unroll
              for (int t = 0; t < 16; ++t) a4[t] = *(const LAS f32x4*)(A2 + t * 16 + pp * 4);
              float Tk0 = 0.f, Tk1 = 0.f, Tk2 = 0.f, Tk3 = 0.f, Tprev = 0.f;
              LAS unsigned short* tt = (LAS unsigned short*)(rec + R_TT) + c;
#pragma unroll
              for (int t = 0; t < 16; ++t) {
                  float acc = (a4[t][0] * Tk0 + a4[t][1] * Tk1) + (a4[t][2] * Tk2 + a4[t][3] * Tk3);
                  acc += rw::dppmov<0xB1>(acc); acc += rw::dppmov<0x4E>(acc);
                  const float Tt = acc + ((t == c) ? 1.0f : 0.0f);
                  const bool mine = (t & 3) == pp;
                  if ((t >> 2) == 0) Tk0 = mine ? Tt : Tk0; else if ((t >> 2) == 1) Tk1 = mine ? Tt : Tk1; else if ((t >> 2) == 2) Tk2 = mine ? Tt : Tk2; else Tk3 = mine ? Tt : Tk3;
                  if (t & 1) { const unsigned pk_ = pkbf(Tprev, Tt); if (pp == 0) { tt[(t - 1) * 16] = (unsigned short)(pk_ & 0xffffu); tt[t * 16] = (unsigned short)(pk_ >> 16); } }
                  Tprev = Tt; }
          } }
        if (wave == 0 && g >= NSLOT) wait_ge4(ackw, (unsigned)(g - NSLOT + 1), abortw, lane);
        __syncthreads();
        { const int slot = g % NSLOT; const int base = (chain * NSLOT + slot) * JOBB;
          if (!(SKIP & 8)) for (int i = tid; i < JOBB / 16; i += NTHR) __builtin_amdgcn_raw_buffer_store_b128(*(LAS u32x4*)(img + i * 16), ring_rsrc, base + i * 16, 0, 16);
          asm volatile("s_waitcnt vmcnt(0)" ::: "memory");
          __syncthreads();
          if (tid == 0) __hip_atomic_store(flags + slot * 64, (unsigned)g + 1u, WY_RLX); }
    }
#undef WY_LOADRAW
}

__device__ __forceinline__ void zero_words(const Params& p) {
    int t_ = threadIdx.x; asm volatile("" : "+v"(t_)); unsigned* wf_ = (unsigned*)(p.ws + WS_WYF);
    for (long g = (long)blockIdx.x * NTHR + t_; g < (long)WYF_WORDS; g += (long)gridDim.x * NTHR) wf_[g] = 0u;
}
template <int MODE, int SKIP = 0> __device__ __forceinline__ void phase(const Params& p, LAS unsigned char* lds) {
    const int G = (int)gridDim.x, b = (int)blockIdx.x, nper = (G - 32) / 32;
    if (b < 32) {
        int tid_ = threadIdx.x; asm volatile("" : "+v"(tid_)); const int wave = __builtin_amdgcn_readfirstlane(tid_ >> 6);
        if (tid_ < 8) *(LAS unsigned*)(lds + C_SYNC + 4 * tid_) = 0u;
        __syncthreads();
        if (wave < 4) { if (MODE != 1) consumer<MODE>(p, b, wave, tid_ & 63, lds); } else loader<MODE>(p, b, wave - 4, tid_ & 63, lds);
    }
    else if (MODE < 2) { const int pp = b - 32; if (pp < 32 * nper) producer<SKIP>(p, pp % 32, pp / 32, nper, lds); }
}
}

namespace ret {
using attn::bf16x8; using attn::s16x4; using attn::f32x16; using attn::u32x4;
typedef float f32x4 __attribute__((ext_vector_type(4)));
typedef unsigned u32x2 __attribute__((ext_vector_type(2)));
constexpr int NQ = R / 128;
constexpr size_t SLOT_BYTES = 256 * 128 * 2;
constexpr size_t WS_SCTX = 254 * MiB;
#define RKSWZ(row, colB) ((row) * 256 + ((colB) ^ (((row) & 7) << 4)))
__device__ __forceinline__ bf16_t* slot(const Params& p, int dir, int q, int head) {
    return q >= 2 ? (bf16_t*)((unsigned char*)p.out + (((size_t)dir * (NQ - 2) + (q - 2)) * 4 + head) * SLOT_BYTES)
                  : (bf16_t*)(p.ws + WS_SCTX + (((size_t)dir * 2 + q) * 4 + head) * SLOT_BYTES);
}
__device__ __forceinline__ float log2_sigmoid(float x) { return -1.4426950408889634f * (fmaxf(-x, 0.f) + log1pf(expf(-fabsf(x)))); }
__device__ __forceinline__ bf16x8 scale8(bf16x8 v, float s) {
    u32x4 w = __builtin_bit_cast(u32x4, v), o;
#pragma unroll
    for (int i = 0; i < 4; ++i) o[i] = attn::cvtpk(__uint_as_float(w[i] << 16) * s, __uint_as_float(w[i] & 0xffff0000u) * s);
    return __builtin_bit_cast(bf16x8, o);
}
__device__ __forceinline__ void pk4(const f32x16& P, int base, bf16x8& out) {
    const unsigned a0 = attn::cvtpk(P[base + 0], P[base + 1]), a1 = attn::cvtpk(P[base + 2], P[base + 3]);
    const unsigned b0 = attn::cvtpk(P[base + 4], P[base + 5]), b1 = attn::cvtpk(P[base + 6], P[base + 7]);
    auto r0 = __builtin_amdgcn_permlane32_swap(a0, b0, false, false); auto r1 = __builtin_amdgcn_permlane32_swap(a1, b1, false, false);
    u32x4 w = {r0[0], r1[0], r0[1], r1[1]}; out = __builtin_bit_cast(bf16x8, w);
}
#define RPK(L, H) (bf16x8){L[0], L[1], L[2], L[3], H[0], H[1], H[2], H[3]}

__device__ __forceinline__ void summaries_unit(const Params& p, int q, int h, char* lds) {
    int tid_ = threadIdx.x; asm volatile("" : "+v"(tid_));
    const int tid = tid_, lane = tid & 63, wave = __builtin_amdgcn_readfirstlane(tid >> 6), r32 = lane & 31, hi = lane >> 5;
    const bf16_t* P = ws_big(p) + (size_t)q * 128 * P0W;
    const float lgf = log2_sigmoid(p.dec_f[h]), lgb = log2_sigmoid(p.dec_b[h]);
    const int sr = tid >> 4, sc = (tid & 15) * 8, st0 = attn::v_st(sr, sc), st1 = attn::v_st(32 + sr, sc);
#pragma unroll
    for (int th = 0; th < 2; ++th) {
        const int t0 = th * 64 + sr, t1 = t0 + 32;
        const bf16_t* r0 = P + (size_t)t0 * P0W; const bf16_t* r1 = P + (size_t)t1 * P0W;
#pragma unroll
        for (int eh = 0; eh < 2; ++eh) { char* vt = lds + (th * 2 + eh) * 16384;
            *(bf16x8*)(vt + st0) = *(const bf16x8*)(r0 + C_VA + h * 256 + eh * 128 + sc); *(bf16x8*)(vt + st1) = *(const bf16x8*)(r1 + C_VA + h * 256 + eh * 128 + sc); }
        const bf16x8 k0 = *(const bf16x8*)(r0 + C_KA + h * 128 + sc), k1 = *(const bf16x8*)(r1 + C_KA + h * 128 + sc);
        char* kf = lds + 65536 + th * 16384; char* kb = lds + 98304 + th * 16384;
        *(bf16x8*)(kf + st0) = scale8(k0, __builtin_amdgcn_exp2f((float)(127 - t0) * lgf)); *(bf16x8*)(kf + st1) = scale8(k1, __builtin_amdgcn_exp2f((float)(127 - t1) * lgf));
        *(bf16x8*)(kb + st0) = scale8(k0, __builtin_amdgcn_exp2f((float)t0 * lgb)); *(bf16x8*)(kb + st1) = scale8(k1, __builtin_amdgcn_exp2f((float)t1 * lgb));
    }
    __syncthreads();
    const int lbase = (int)(uintptr_t)lds + attn::v_rd_base(lane);
    f32x16 acc[2][4];
#pragma unroll
    for (int d = 0; d < 2; ++d)
#pragma unroll
        for (int b = 0; b < 4; ++b) acc[d][b] = f32x16{};
#pragma unroll
    for (int th = 0; th < 2; ++th) {
        const int va = lbase + (th * 2 + (wave >> 2)) * 16384 + (wave & 3) * 512, kfb = lbase + 65536 + th * 16384, kbb = lbase + 98304 + th * 16384;
#define R1_STEP(KS) do { \
        const s16x4 al = attn::tr_read<attn::v_rd_off(0, KS, 0)>(va), ah = attn::tr_read<attn::v_rd_off(0, KS, 1)>(va); \
        const s16x4 f0l = attn::tr_read<attn::v_rd_off(0, KS, 0)>(kfb), f0h = attn::tr_read<attn::v_rd_off(0, KS, 1)>(kfb), f1l = attn::tr_read<attn::v_rd_off(1, KS, 0)>(kfb), f1h = attn::tr_read<attn::v_rd_off(1, KS, 1)>(kfb); \
        const s16x4 f2l = attn::tr_read<attn::v_rd_off(2, KS, 0)>(kfb), f2h = attn::tr_read<attn::v_rd_off(2, KS, 1)>(kfb), f3l = attn::tr_read<attn::v_rd_off(3, KS, 0)>(kfb), f3h = attn::tr_read<attn::v_rd_off(3, KS, 1)>(kfb); \
        const s16x4 g0l = attn::tr_read<attn::v_rd_off(0, KS, 0)>(kbb), g0h = attn::tr_read<attn::v_rd_off(0, KS, 1)>(kbb), g1l = attn::tr_read<attn::v_rd_off(1, KS, 0)>(kbb), g1h = attn::tr_read<attn::v_rd_off(1, KS, 1)>(kbb); \
        const s16x4 g2l = attn::tr_read<attn::v_rd_off(2, KS, 0)>(kbb), g2h = attn::tr_read<attn::v_rd_off(2, KS, 1)>(kbb), g3l = attn::tr_read<attn::v_rd_off(3, KS, 0)>(kbb), g3h = attn::tr_read<attn::v_rd_off(3, KS, 1)>(kbb); \
        asm volatile("s_waitcnt lgkmcnt(0)" ::: "memory"); __builtin_amdgcn_sched_barrier(0); \
        const bf16x8 a = RPK(al, ah); \
        acc[0][0] = __builtin_amdgcn_mfma_f32_32x32x16_bf16(a, RPK(f0l, f0h), acc[0][0], 0, 0, 0); acc[0][1] = __builtin_amdgcn_mfma_f32_32x32x16_bf16(a, RPK(f1l, f1h), acc[0][1], 0, 0, 0); \
        acc[0][2] = __builtin_amdgcn_mfma_f32_32x32x16_bf16(a, RPK(f2l, f2h), acc[0][2], 0, 0, 0); acc[0][3] = __builtin_amdgcn_mfma_f32_32x32x16_bf16(a, RPK(f3l, f3h), acc[0][3], 0, 0, 0); \
        acc[1][0] = __builtin_amdgcn_mfma_f32_32x32x16_bf16(a, RPK(g0l, g0h), acc[1][0], 0, 0, 0); acc[1][1] = __builtin_amdgcn_mfma_f32_32x32x16_bf16(a, RPK(g1l, g1h), acc[1][1], 0, 0, 0); \
        acc[1][2] = __builtin_amdgcn_mfma_f32_32x32x16_bf16(a, RPK(g2l, g2h), acc[1][2], 0, 0, 0); acc[1][3] = __builtin_amdgcn_mfma_f32_32x32x16_bf16(a, RPK(g3l, g3h), acc[1][3], 0, 0, 0); \
        __builtin_amdgcn_sched_barrier(0); } while (0)
        R1_STEP(0); R1_STEP(1); R1_STEP(2); R1_STEP(3);
#undef R1_STEP
    }
#pragma unroll
    for (int d = 0; d < 2; ++d) { bf16_t* dst = slot(p, d, q, h);
#pragma unroll
        for (int db = 0; db < 4; ++db)
#pragma unroll
            for (int r = 0; r < 16; ++r) dst[(size_t)(32 * wave + attn::crow(r, hi)) * 128 + 32 * db + r32] = (bf16_t)(attn::cvtpk(acc[d][db][r], 0.f) & 0xffffu); }
    __syncthreads();
}

__device__ __forceinline__ void state_scan(const Params& p) {
    int tid_ = threadIdx.x; asm volatile("" : "+v"(tid_));
    for (long gt = (long)blockIdx.x * NTHR + tid_; gt < 2L * 4 * 16384; gt += (long)gridDim.x * NTHR) {
    const int pair = (int)(gt & 16383), h = (int)((gt >> 14) & 3), dir = (int)(gt >> 16);
    const float G = __builtin_amdgcn_exp2f(128.0f * log2_sigmoid((dir ? p.dec_b : p.dec_f)[h]));
    float s0 = 0.f, s1 = 0.f;
    for (int n = 0; n < NQ; ++n) {
        const int q = dir == 0 ? n : (n < 2 ? 1 - n : NQ + 1 - n);
        unsigned* ptr = (unsigned*)slot(p, dir, q, h) + pair;
        const unsigned u = *ptr;
        *ptr = attn::cvtpk(s0, s1);
        s0 = G * s0 + __uint_as_float(u << 16); s1 = G * s1 + __uint_as_float(u & 0xffff0000u);
    }    }
}

__device__ __forceinline__ void output_unit(const Params& p, int q, int h, char* lds) {
    int tid_ = threadIdx.x; asm volatile("" : "+v"(tid_));
    const int tid = tid_, lane = tid & 63, wave = __builtin_amdgcn_readfirstlane(tid >> 6), r32 = lane & 31, hi = lane >> 5;
    const int ib = wave >> 1, eh = wave & 1;
    const bf16_t* P = ws_big(p) + (size_t)q * 128 * P0W;
    const float lgf = log2_sigmoid(p.dec_f[h]), lgb = log2_sigmoid(p.dec_b[h]);
    { const int sr = tid >> 4, sc = (tid & 15) * 8, st0 = attn::v_st(sr, sc), st1 = attn::v_st(32 + sr, sc);
#pragma unroll
      for (int jt = 0; jt < 2; ++jt) {
          const bf16_t* r0 = P + (size_t)(jt * 64 + sr) * P0W; const bf16_t* r1 = r0 + (size_t)32 * P0W;
          char* kt = lds + jt * 16384;
          *(bf16x8*)(kt + RKSWZ(sr, sc * 2)) = *(const bf16x8*)(r0 + C_KA + h * 128 + sc); *(bf16x8*)(kt + RKSWZ(32 + sr, sc * 2)) = *(const bf16x8*)(r1 + C_KA + h * 128 + sc);
#pragma unroll
          for (int e2 = 0; e2 < 2; ++e2) { char* vt = lds + 32768 + (jt * 2 + e2) * 16384;
              *(bf16x8*)(vt + st0) = *(const bf16x8*)(r0 + C_VA + h * 256 + e2 * 128 + sc); *(bf16x8*)(vt + st1) = *(const bf16x8*)(r1 + C_VA + h * 256 + e2 * 128 + sc); }
      } }
    bf16x8 qr[8];
    { const bf16_t* Qw = P + (size_t)(ib * 32 + r32) * P0W + C_QA + h * 128 + hi * 8;
#pragma unroll
      for (int d0 = 0; d0 < 8; ++d0) qr[d0] = *(const bf16x8*)(Qw + d0 * 16); }
    const bf16_t* Sf = slot(p, 0, q, h) + (size_t)(eh * 128 + r32) * 128 + hi * 8; const bf16_t* Sb = slot(p, 1, q, h) + (size_t)(eh * 128 + r32) * 128 + hi * 8;
    bf16x8 fa[8], fb[8];
#define RET_LOADB(F, S, sb) do { _Pragma("unroll") for (int s_ = 0; s_ < 2; ++s_) _Pragma("unroll") for (int d0 = 0; d0 < 4; ++d0) F[s_ * 4 + d0] = *(const bf16x8*)((S) + (size_t)d0 * 32 * 128 + ((sb) * 2 + s_) * 16); } while (0)
#define RET_MMAB(F, sc, sb) do { _Pragma("unroll") for (int s_ = 0; s_ < 2; ++s_) { const bf16x8 a = scale8(qr[(sb) * 2 + s_], sc); \
        _Pragma("unroll") for (int d0 = 0; d0 < 4; ++d0) o[d0] = __builtin_amdgcn_mfma_f32_32x32x16_bf16(a, F[s_ * 4 + d0], o[d0], 0, 0, 0); } } while (0)
    RET_LOADB(fa, Sf, 0);
    __syncthreads();
    f32x16 o[4] = {};
    const int i_loc = ib * 32 + r32;
    const int vb0 = (int)(uintptr_t)lds + 32768 + attn::v_rd_base(lane);
#pragma unroll
    for (int jt = 0; jt < 2; ++jt) {
        f32x16 p0, p1;
        attn::qkt(p0, p1, (const attn::bf16*)(lds + jt * 16384), qr, r32, hi);
#pragma unroll
        for (int r = 0; r < 16; ++r) {
            const int j0 = jt * 64 + attn::crow(r, hi), dl0 = i_loc - j0, dl1 = dl0 - 32;
            const float m0 = dl0 > 0 ? __builtin_amdgcn_exp2f((float)dl0 * lgf) : (dl0 < 0 ? __builtin_amdgcn_exp2f((float)(-dl0) * lgb) : 2.0f);
            const float m1 = dl1 > 0 ? __builtin_amdgcn_exp2f((float)dl1 * lgf) : (dl1 < 0 ? __builtin_amdgcn_exp2f((float)(-dl1) * lgb) : 2.0f);
            p0[r] *= m0; p1[r] *= m1;
        }
        bf16x8 pa0, pa1, pa2, pa3; pk4(p0, 0, pa0); pk4(p0, 8, pa1); pk4(p1, 0, pa2); pk4(p1, 8, pa3);
        __builtin_amdgcn_sched_barrier(0);
        attn::pv_d0(o, vb0 + (jt * 2 + eh) * 16384, pa0, pa1, pa2, pa3);
    }
    { const float scf = __builtin_amdgcn_exp2f((float)(i_loc + 1) * lgf), scb = __builtin_amdgcn_exp2f((float)(128 - i_loc) * lgb);
      RET_LOADB(fb, Sf, 1); __builtin_amdgcn_sched_barrier(0);
      RET_MMAB(fa, scf, 0); __builtin_amdgcn_sched_barrier(0); RET_LOADB(fa, Sf, 2); __builtin_amdgcn_sched_barrier(0);
      RET_MMAB(fb, scf, 1); __builtin_amdgcn_sched_barrier(0); RET_LOADB(fb, Sf, 3); __builtin_amdgcn_sched_barrier(0);
      RET_MMAB(fa, scf, 2); __builtin_amdgcn_sched_barrier(0); RET_LOADB(fa, Sb, 0); __builtin_amdgcn_sched_barrier(0);
      RET_MMAB(fb, scf, 3); __builtin_amdgcn_sched_barrier(0); RET_LOADB(fb, Sb, 1); __builtin_amdgcn_sched_barrier(0);
      RET_MMAB(fa, scb, 0); __builtin_amdgcn_sched_barrier(0); RET_LOADB(fa, Sb, 2); __builtin_amdgcn_sched_barrier(0);
      RET_MMAB(fb, scb, 1); __builtin_amdgcn_sched_barrier(0); RET_LOADB(fb, Sb, 3); __builtin_amdgcn_sched_barrier(0);
      RET_MMAB(fa, scb, 2); __builtin_amdgcn_sched_barrier(0);
      RET_MMAB(fb, scb, 3); }
#undef RET_LOADB
#undef RET_MMAB
    __syncthreads();
    float* O = (float*)lds;
#pragma unroll
    for (int r = 0; r < 16; ++r)
#pragma unroll
        for (int d0 = 0; d0 < 4; ++d0) O[(ib * 32 + attn::crow(r, hi)) * 256 + eh * 128 + d0 * 32 + r32] = o[d0][r];
    __syncthreads();
    bf16_t* BR = ws_br(p) + (size_t)q * 128 * 2048 + h * 256;
#pragma unroll 4
    for (int rr = 0; rr < 16; ++rr) {
        const int row = wave * 16 + rr; const f32x4 x = *(const f32x4*)(O + row * 256 + lane * 4);
        const float mean = rw::wave_sum((x[0] + x[1]) + (x[2] + x[3])) * (1.0f / 256.f);
        const f32x4 d = x - mean;
        const float var = rw::wave_sum((d[0] * d[0] + d[1] * d[1]) + (d[2] * d[2] + d[3] * d[3])) * (1.0f / 256.f);
        const float rstd = 1.0f / sqrtf(var + NORM_EPS);
        f32x4 y = d * rstd;
        if (q < 2) { const u32x2 gg = *(const u32x2*)((const bf16_t*)(p.ws + 255 * MiB) + (size_t)(q * 128 + row) * 2048 + h * 256 + lane * 4);
            y[0] *= __uint_as_float(gg.x << 16); y[1] *= __uint_as_float(gg.x & 0xffff0000u); y[2] *= __uint_as_float(gg.y << 16); y[3] *= __uint_as_float(gg.y & 0xffff0000u); }
        u32x2 w; w.x = attn::cvtpk(y[0], y[1]); w.y = attn::cvtpk(y[2], y[3]);
        *(u32x2*)(BR + (size_t)row * 2048 + lane * 4) = w;
    }
    __syncthreads();
}
#undef RPK
#undef RKSWZ
}

namespace na {
using attn::bf16x8; using attn::f32x16; using attn::u32x4;
constexpr float L2E = 1.4426950408889634f;
constexpr int WH = GROWS < 8 ? GROWS : 8;
constexpr int L_K = 0, L_V = 32768, L_WS = 65536, L_RPB = L_WS + NWAVES * 64 * 4, L_END = L_RPB + 15 * 31 * 4;
#define NKSWZ(row, colB) ((row) * 256 + ((colB) ^ (((row) & 7) << 4)))
__device__ __forceinline__ int win_r0(int r) { int r0 = r - WH / 2; return r0 < 0 ? 0 : (r0 > GROWS - WH ? GROWS - WH : r0); }
__device__ __forceinline__ int win_c0(int c) { int c0 = c - 8; return c0 < 0 ? 0 : (c0 > GW - 16 ? GW - 16 : c0); }

__device__ __forceinline__ void na_unit(const Params& p, int rg, int h, char* lds) {
    int tid_ = threadIdx.x; asm volatile("" : "+v"(tid_));
    const int tid = tid_, lane = tid & 63, wave = __builtin_amdgcn_readfirstlane(tid >> 6), r32 = lane & 31, hi = lane >> 5;
    const bf16_t* P = ws_big(p); const bf16_t* NAC = (const bf16_t*)(p.ws + 255 * MiB);
    const int r = 4 * rg + (wave >> 1), qc = (wave & 1) * 32 + r32, my_r0 = win_r0(r), my_c0 = win_c0(qc);
    const int lo = win_r0(4 * rg), hiw = win_r0(4 * rg + 3) + WH, NT = hiw - lo + CTXN / 64;
    float* wsf = (float*)(lds + L_WS) + wave * 64; float* rpb_l = (float*)(lds + L_RPB);
    if (tid < 15 * 31) rpb_l[tid] = p.rpb[h * 15 * 31 + tid];
    bf16x8 qr[4];
    { const bf16_t* Qw = P + (size_t)(CTXN + r * 64 + qc) * NAW + h * 64 + hi * 8;
#pragma unroll
      for (int d0 = 0; d0 < 4; ++d0) qr[d0] = *(const bf16x8*)(Qw + d0 * 16); }
    const int sk = tid >> 3, sc = (tid & 7) * 8, kst = NKSWZ(sk, sc * 2), vst = attn::v_st(sk, sc);
    bf16x8 kA, vA, kB, vB;
#define NA_LOAD(KR, VR, t) do { if ((t) < hiw - lo) { const int krow_ = CTXN + (lo + (t)) * 64 + sk; \
            KR = *(const bf16x8*)(P + (size_t)krow_ * NAW + 1024 + h * 64 + sc); VR = *(const bf16x8*)(P + (size_t)krow_ * NAW + 2048 + h * 64 + sc); } \
        else { const bf16_t* c_ = NAC + (size_t)(((t) - (hiw - lo)) * 64 + sk) * 2048 + h * 64 + sc; KR = *(const bf16x8*)c_; VR = *(const bf16x8*)(c_ + 1024); } } while (0)
#define NA_WRITE(KR, VR, b) do { *(bf16x8*)(lds + L_K + (b) * 16384 + kst) = KR; *(bf16x8*)(lds + L_V + (b) * 16384 + vst) = VR; } while (0)
    NA_LOAD(kA, vA, 0); NA_WRITE(kA, vA, 0);
    NA_LOAD(kB, vB, 1);
    __syncthreads();
    float m_reg = -1e30f, l_reg = 0.f; f32x16 o[2] = {};
    const int vb0 = (int)(uintptr_t)lds + L_V + attn::v_rd_base(lane);
#define NA_TILE(t, KW, VW, KL, VL) do { \
        if ((t) + 2 < NT) NA_LOAD(KL, VL, (t) + 2);            \
        const bool is_ctx = (t) >= hiw - lo; const int kr = lo + (t); \
        if (is_ctx || (kr >= my_r0 && kr < my_r0 + WH)) { \
            const char* Ks = lds + L_K + ((t) & 1) * 16384; \
            f32x16 p0 = {}, p1 = {}; \
            _Pragma("unroll") for (int d0 = 0; d0 < 4; ++d0) { const int cb = (d0 * 16 + hi * 8) * 2; \
                const bf16x8 b0 = *(const bf16x8*)(Ks + NKSWZ(r32, cb)), b1 = *(const bf16x8*)(Ks + NKSWZ(32 + r32, cb)); \
                p0 = __builtin_amdgcn_mfma_f32_32x32x16_bf16(b0, qr[d0], p0, 0, 0, 0); p1 = __builtin_amdgcn_mfma_f32_32x32x16_bf16(b1, qr[d0], p1, 0, 0, 0); } \
            if (is_ctx) { \
                _Pragma("unroll") for (int q = 0; q < 16; ++q) { p0[q] *= 0.125f; p1[q] *= 0.125f; } \
            } else { \
                const float* brow = rpb_l + (kr - r + 7) * 31 + 15 - qc; \
                _Pragma("unroll") for (int q = 0; q < 16; ++q) { const int kc0 = attn::crow(q, hi), kc1 = kc0 + 32; \
                    const bool v0 = kc0 >= my_c0 && kc0 < my_c0 + 16, v1 = kc1 >= my_c0 && kc1 < my_c0 + 16; \
                    p0[q] = v0 ? p0[q] * 0.125f + brow[v0 ? kc0 : qc] : -1e30f; p1[q] = v1 ? p1[q] * 0.125f + brow[v1 ? kc1 : qc] : -1e30f; } \
            } \
            float pmax = p0[0]; \
            _Pragma("unroll") for (int q = 1; q < 16; ++q) pmax = fmaxf(pmax, p0[q]); \
            _Pragma("unroll") for (int q = 0; q < 16; ++q) pmax = fmaxf(pmax, p1[q]); \
            { auto rr = __builtin_amdgcn_permlane32_swap(__float_as_uint(pmax), __float_as_uint(pmax), false, false); pmax = fmaxf(__uint_as_float(rr[0]), __uint_as_float(rr[1])); } \
            const float mn = fmaxf(m_reg, pmax), alpha = __builtin_amdgcn_exp2f((m_reg - mn) * L2E), mnl = -mn * L2E; m_reg = mn; \
            float ps = 0.f; \
            _Pragma("unroll") for (int q = 0; q < 16; ++q) { p0[q] = __builtin_amdgcn_exp2f(fmaf(p0[q], L2E, mnl)); p1[q] = __builtin_amdgcn_exp2f(fmaf(p1[q], L2E, mnl)); ps += p0[q] + p1[q]; } \
            { auto rr = __builtin_amdgcn_permlane32_swap(__float_as_uint(ps), __float_as_uint(ps), false, false); ps = __uint_as_float(rr[0]) + __uint_as_float(rr[1]); } \
            l_reg = l_reg * alpha + ps; \
            if (__any(alpha < 1.f)) { if (hi == 0) wsf[r32] = alpha; asm volatile("s_waitcnt lgkmcnt(0)" ::: "memory"); \
                _Pragma("unroll") for (int d = 0; d < 2; ++d) _Pragma("unroll") for (int q = 0; q < 16; ++q) o[d][q] *= wsf[attn::crow(q, hi)]; } \
            bf16x8 pa0, pa1, pa2, pa3; ret::pk4(p0, 0, pa0); ret::pk4(p0, 8, pa1); ret::pk4(p1, 0, pa2); ret::pk4(p1, 8, pa3); \
            __builtin_amdgcn_sched_barrier(0); \
            const int vb = vb0 + ((t) & 1) * 16384; \
            attn::pv_one<0>(o[0], vb, pa0, pa1, pa2, pa3); attn::pv_one<1>(o[1], vb, pa0, pa1, pa2, pa3); \
        } \
        if ((t) + 1 < NT) NA_WRITE(KW, VW, ((t) + 1) & 1);     \
        __syncthreads(); } while (0)
    for (int t = 0; t < NT; t += 2) {
        NA_TILE(t, kB, vB, kA, vA);
        if (t + 1 < NT) NA_TILE(t + 1, kA, vA, kB, vB);
    }
#undef NA_TILE
#undef NA_LOAD
#undef NA_WRITE
    if (hi == 0) wsf[32 + r32] = l_reg; asm volatile("s_waitcnt lgkmcnt(0)" ::: "memory");
    bf16_t* Ow = ws_br(p) + (size_t)(CTXN + r * 64 + (wave & 1) * 32) * 2048 + h * 64;
#pragma unroll
    for (int q = 0; q < 16; ++q) { const int orow = attn::crow(q, hi); const float rl = __builtin_amdgcn_rcpf(wsf[32 + orow]);
#pragma unroll
        for (int d0 = 0; d0 < 2; ++d0) Ow[(size_t)orow * 2048 + d0 * 32 + r32] = (bf16_t)(attn::cvtpk(o[d0][q] * rl, 0.f) & 0xffffu); }
    __syncthreads();
}
#undef NKSWZ
}

namespace el {
typedef float f32x4 __attribute__((ext_vector_type(4)));
typedef unsigned u32x2 __attribute__((ext_vector_type(2)));
__device__ __forceinline__ float wsum(float v) { return rw::wave_sum(v); }
__device__ __forceinline__ unsigned pk(float lo, float hi) { unsigned r; asm volatile("v_cvt_pk_bf16_f32 %0, %1, %2" : "=v"(r) : "v"(lo), "v"(hi)); return r; }

__device__ __forceinline__ void mod_phase(const Params& p, char* lds) {
    int tid_ = threadIdx.x; asm volatile("" : "+v"(tid_));
    const int tid = tid_, ks = tid >> 6, jl = tid & 63;
    float* sc = (float*)lds; float* red = sc + 2048;
    for (int b = blockIdx.x; b < 2 * 48; b += gridDim.x) {
        const int l = b / 48, j = (b % 48) * 64 + jl;
        __syncthreads();
        for (int k = tid; k < 2048; k += NTHR) { const float x = k < 1024 ? p.c[k] : p.c_ctx[k - 1024]; sc[k] = x / (1.0f + __expf(-x)); }
        __syncthreads();
        const float* w = p.w_mod + (size_t)l * DM * 3072 + (size_t)(ks * 128) * 3072 + j; float a0 = 0.f, a1 = 0.f;
#pragma unroll 8
        for (int k = 0; k < 128; ++k) { const float wv = w[(size_t)k * 3072]; a0 += sc[ks * 128 + k] * wv; a1 += sc[1024 + ks * 128 + k] * wv; }
        red[ks * 64 + jl] = a0; red[512 + ks * 64 + jl] = a1;
        __syncthreads();
        if (tid < 128) { const int s = tid >> 6; float t = 0.f;
#pragma unroll
            for (int q = 0; q < 8; ++q) t += red[s * 512 + q * 64 + jl];
            ws_modv(p)[(l * 2 + s) * 3072 + j] = t + p.b_mod[l * 3072 + j]; }
    }
    __syncthreads();
}

template <int LAYER> __device__ __forceinline__ void modnorm_store(const Params& p, const f32x4 (&v)[4], int row, int lane) {
    const float* mv = ws_modv(p) + (LAYER * 2 + (row < CTXN ? 1 : 0)) * 3072; const float* g = p.g_pre + LAYER * DM;
    float ss = 0.f;
#pragma unroll
    for (int j = 0; j < 4; ++j) ss += (v[j][0] * v[j][0] + v[j][1] * v[j][1]) + (v[j][2] * v[j][2] + v[j][3] * v[j][3]);
    const float rstd = 1.0f / sqrtf(wsum(ss) * (1.0f / DM) + NORM_EPS);
    bf16_t* o = ws_xn(p) + (size_t)row * DM;
#pragma unroll
    for (int j = 0; j < 4; ++j) { const int c = lane * 4 + 256 * j;
        const f32x4 gg = *(const f32x4*)(g + c), sh = *(const f32x4*)(mv + c), sc = *(const f32x4*)(mv + 1024 + c);
        const f32x4 y = v[j] * rstd * gg * (sc + 1.0f) + sh;
        u32x2 w; w.x = pk(y[0], y[1]); w.y = pk(y[2], y[3]); *(u32x2*)(o + c) = w; }
}
__device__ __forceinline__ void prenorm0_phase(const Params& p) {
    int tid_ = threadIdx.x; asm volatile("" : "+v"(tid_));
    const int lane = tid_ & 63, gw = (int)blockIdx.x * NWAVES + (tid_ >> 6), ngw = (int)gridDim.x * NWAVES;
    for (int row = gw; row < R; row += ngw) {
        const float* src = row < CTXN ? p.ctx + (size_t)row * DM : p.x + (size_t)(row - CTXN) * DM;
        f32x4 v[4];
#pragma unroll
        for (int j = 0; j < 4; ++j) v[j] = *(const f32x4*)(src + lane * 4 + 256 * j);
        modnorm_store<0>(p, v, row, lane);
    }
}
template <int LAYER> __device__ __forceinline__ void resid_phase(const Params& p) {
    int tid_ = threadIdx.x; asm volatile("" : "+v"(tid_));
    const int lane = tid_ & 63, gw = (int)blockIdx.x * NWAVES + (tid_ >> 6), ngw = (int)gridDim.x * NWAVES;
    for (int row = (LAYER == 0 ? 0 : CTXN) + gw; row < R; row += ngw) {
        const bool ctxsum = LAYER == 0 && row < CTXN;
        const float* y = ctxsum ? (const float*)(p.ws + WS_BIG + 72 * MiB) + (size_t)row * DM : ws_y(p) + (size_t)row * DM; const float* mv = ws_modv(p) + (LAYER * 2 + (row < CTXN ? 1 : 0)) * 3072 + 2048; const float* g = p.g_post + LAYER * DM;
        const float* src; float* dst;
        if (row < CTXN) { src = p.ctx + (size_t)row * DM; dst = ws_ctx1(p) + (size_t)row * DM; }
        else { src = (LAYER == 0 ? p.x : p.out) + (size_t)(row - CTXN) * DM; dst = p.out + (size_t)(row - CTXN) * DM; }
        f32x4 yv[4]; float ss = 0.f;
#pragma unroll
        for (int j = 0; j < 4; ++j) { yv[j] = *(const f32x4*)(y + lane * 4 + 256 * j);
            if (ctxsum) { _Pragma("unroll") for (int s = 1; s < 8; ++s) yv[j] += *(const f32x4*)(y + (size_t)s * CTXN * DM + lane * 4 + 256 * j); }
            ss += (yv[j][0] * yv[j][0] + yv[j][1] * yv[j][1]) + (yv[j][2] * yv[j][2] + yv[j][3] * yv[j][3]); }
        const float rstd = 1.0f / sqrtf(wsum(ss) * (1.0f / DM) + NORM_EPS);
        f32x4 xn[4];
#pragma unroll
        for (int j = 0; j < 4; ++j) { const int c = lane * 4 + 256 * j;
            xn[j] = *(const f32x4*)(src + c) + *(const f32x4*)(mv + c) * (yv[j] * rstd * *(const f32x4*)(g + c));
            *(f32x4*)(dst + c) = xn[j]; }
        if (LAYER == 0) modnorm_store<1>(p, xn, row, lane);
    }
}
__device__ __forceinline__ void ropenorm_phase(const Params& p) {
    int tid_ = threadIdx.x; asm volatile("" : "+v"(tid_));
    const int lane = tid_ & 63, gw = (int)blockIdx.x * NWAVES + (tid_ >> 6), ngw = (int)gridDim.x * NWAVES;
    const float* ct = ws_rope(p); const float* st = ct + N_ROPE;
    const float qn0 = p.q_norm[2 * lane], qn1 = p.q_norm[2 * lane + 1], kn0 = p.k_norm[2 * lane], kn1 = p.k_norm[2 * lane + 1];
    for (int row = gw; row < R; row += ngw) {
        const bool rot = row >= CTXN; const int t = row - CTXN; float cs = 1.f, sn = 0.f;
        if (rot) { const int pos = lane < 32 ? t / GW : t % GW, f = lane & 31; cs = ct[pos * 32 + f]; sn = st[pos * 32 + f]; }
        bf16_t* base = ws_big(p) + (size_t)row * P0W;
#pragma unroll
        for (int slot = 0; slot < 18; ++slot) {
            const int col = slot < 4 ? C_QA + slot * 128 : slot < 8 ? C_KA + (slot - 4) * 128 : slot < 16 ? C_QB + (slot - 8) * 128 : C_KB + (slot - 16) * 128;
            unsigned* ptr = (unsigned*)(base + col) + lane; const unsigned u = *ptr;
            float x1 = __uint_as_float(u << 16), x2 = __uint_as_float(u & 0xffff0000u);
            if (slot >= 4 && slot < 8) { x1 *= 0.08838834764831845f; x2 *= 0.08838834764831845f; }
            if (slot >= 8) { const float sc = 1.0f / sqrtf(wsum(x1 * x1 + x2 * x2) * (1.0f / 128.f) + NORM_EPS);
                x1 *= sc * (slot < 16 ? qn0 : kn0); x2 *= sc * (slot < 16 ? qn1 : kn1); }
            *ptr = pk(x1 * cs - x2 * sn, x1 * sn + x2 * cs);
        }
    }
}
}

constexpr int RING_BYTES = 131072, LDS_BYTES = 163840;
constexpr size_t WS_BAR = 256 * 1024;
constexpr size_t WS_SIDE = 255 * MiB;
constexpr size_t WS_YC = WS_BIG + 72 * MiB;
constexpr int LDS_BARW = LDS_BYTES - 64;
constexpr size_t WB_IN0 = WS_WB, WB_OUT0 = WB_IN0 + (size_t)EVEN_IN * DM * 2, WB_IN1 = WB_OUT0 + (size_t)DM * 2048 * 2, WB_OUT1 = WB_IN1 + (size_t)ODD_IN * DM * 2, WB_END = WB_OUT1 + (size_t)DM * 2048 * 2;
static_assert(WB_END <= WS_XN, "weight copies overflow their region");
static_assert(wy::WS_RING + wy::RING_TOTAL <= WB_IN1 && XCD_BAR_WORDS * 4 <= 16384 && wy::WS_WYF + (size_t)wy::WYF_WORDS * 4 <= WS_CTX1, "rwkv ring / flag words");

__device__ __forceinline__ unsigned pk2(float lo, float hi) { return (unsigned)f2bf(lo) | ((unsigned)f2bf(hi) << 16); }
__device__ __forceinline__ void transpose_item(const float* W, int K, int N, int ldw, bf16_t* WT, LAS float* scr, int item, int lane) {
    const int nblk = N / 32, kb = item / nblk, nb = item % nblk, k0 = 64 * kb, n0 = 32 * nb;
#pragma unroll 8
    for (int i = 0; i < 32; ++i) { const int kk = 2 * i + (lane >> 5); scr[kk * 33 + (lane & 31)] = W[(size_t)(k0 + kk) * ldw + n0 + (lane & 31)]; }
    asm volatile("s_waitcnt lgkmcnt(0)" ::: "memory");
    const int c = lane & 7;
#pragma unroll
    for (int j = 0; j < 4; ++j) { const int n = (lane >> 3) + 8 * j; const LAS float* s = scr + (8 * c) * 33 + n;
        v4u o; o.x = pk2(s[0 * 33], s[1 * 33]); o.y = pk2(s[2 * 33], s[3 * 33]); o.z = pk2(s[4 * 33], s[5 * 33]); o.w = pk2(s[6 * 33], s[7 * 33]);
        *(v4u*)(WT + (size_t)(n0 + n) * K + k0 + 8 * c) = o; }
    asm volatile("s_waitcnt lgkmcnt(0)" ::: "memory");
}
__device__ __forceinline__ void p0_weights(const Params& p, LAS unsigned char* lds) {
    const int lane = threadIdx.x & 63, wave = __builtin_amdgcn_readfirstlane(threadIdx.x >> 6);
    LAS float* scr = (LAS float*)(lds + wave * 16384);
    const int gw = blockIdx.x * NWAVES + wave, NGW = gridDim.x * NWAVES;
    constexpr int I_IN0 = (DM / 64) * (EVEN_IN / 32), I_OUT = (2048 / 64) * (DM / 32), I_IN1 = (DM / 64) * (ODD_IN / 32);
    for (int it = gw; it < I_IN0 + I_OUT + I_IN1 + I_OUT; it += NGW) {
        int r = it;
        if (r < I_IN0) { transpose_item(p.ev_w_in, DM, EVEN_IN, EVEN_IN, (bf16_t*)(p.ws + WB_IN0), scr, r, lane); continue; } r -= I_IN0;
        if (r < I_OUT) { transpose_item(p.ev_w_out, 2048, DM, DM, (bf16_t*)(p.ws + WB_OUT0), scr, r, lane); continue; } r -= I_OUT;
        if (r < I_IN1) { transpose_item(p.od_w_in, DM, ODD_IN, ODD_IN, (bf16_t*)(p.ws + WB_IN1), scr, r, lane); continue; } r -= I_IN1;
        transpose_item(p.od_w_out, 2048, DM, DM, (bf16_t*)(p.ws + WB_OUT1), scr, r, lane);
    }
}

template <class Epi> __device__ __forceinline__ void run_gemm(LAS unsigned char* lds, const bf16_t* A, const bf16_t* Bt, int M, int N, int K, const Epi& E, int rot = 0, int lda = 0, int ldb = 0) {
    const int G = (int)gridDim.x;
    pg8::Gemm g{A, Bt, M, N, K, lda, ldb}; pg8::StaticOrder S; S.init(M, N, G, ((int)blockIdx.x + rot) % G);
    pg8::gemm_phase<Epi, pg8::StaticOrder, true, true>(lds, g, S, E);
}
__device__ __forceinline__ int tail_rot(int units) { const int G = (int)gridDim.x; return (G - units % G) % G; }

#ifndef PROBE
#define PROBE 0
#endif
#define REP(bit) for (int rep_ = 0; rep_ < (((PROBE) >> (bit)) & 1) + 1; ++rep_)
__global__ void __launch_bounds__(NTHR, 2) mega(Params p) {
    extern __shared__ __attribute__((aligned(16))) unsigned char lds_raw[];
    cg::grid_group grid = cg::this_grid();
    LAS unsigned char* lds = (LAS unsigned char*)lds_raw;
    const long gsz = (long)gridDim.x * NTHR;
    if (threadIdx.x < 2) *(LAS unsigned*)(lds + LDS_BARW + 4 * threadIdx.x) = 0u;
    __syncthreads();
    const XcdBarrier xbar = xcd_barrier_post((unsigned*)(p.ws + WS_BAR), (volatile LAS unsigned*)(lds + LDS_BARW));
    const bf16_t* wt_in0 = (const bf16_t*)(p.ws + WB_IN0); const bf16_t* wt_out0 = (const bf16_t*)(p.ws + WB_OUT0);
    const bf16_t* wt_in1 = (const bf16_t*)(p.ws + WB_IN1); const bf16_t* wt_out1 = (const bf16_t*)(p.ws + WB_OUT1);
#define X(fn, n) { int t_ = threadIdx.x; asm volatile("" : "+v"(t_)); for (long g = (long)blockIdx.x * NTHR + t_; g < (long)(n); g += gsz) fn(p, g); }
#define SYNC xcd_barrier(xbar);
    if ((PROBE >> 13) & 1) { for (int i_ = 0; i_ < 20; ++i_) xcd_barrier(xbar); }
    REP(14) { el::mod_phase(p, (char*)lds_raw); X(ph_rope_table, N_ROPE) p0_weights(p, lds);
              if (p.out == nullptr) grid.sync();
              SYNC }
    REP(15) { el::prenorm0_phase(p); SYNC }
    REP(2) { run_gemm(lds, ws_xn(p), wt_in0, R, P0W, DM, pg8::EpiBf16<0>{ws_big(p), P0W, nullptr, 0, 0, 1.f});
             run_gemm(lds, ws_xn(p), wt_in0 + (size_t)C_GA * DM, CTXN, 2048, DM, pg8::EpiSiluBf16{(bf16_t*)(p.ws + WS_SIDE), 2048}, tail_rot((R / 256) * (P0W / 256)));
             SYNC }
    el::ropenorm_phase(p); SYNC
    REP(5) { for (int u = blockIdx.x; u < ret::NQ * 4; u += gridDim.x) { const int q = u < (ret::NQ - 2) * 4 ? 2 + u / 4 : (u - (ret::NQ - 2) * 4) / 4; ret::summaries_unit(p, q, u & 3, (char*)lds_raw); } SYNC }
    ret::state_scan(p); SYNC
#define CTX_ATTN_UNIT(head_) do { const int hd_ = (head_), kv_ = hd_ / 4; const bf16_t* P_ = ws_big(p); bf16_t* BR_ = ws_br(p); \
        attn::attn_dense_body<attn::bf16, false>(P_ + C_QB + hd_ * 128, P_ + C_KB + kv_ * 128, P_ + C_VB + kv_ * 128, BR_ + 1024 + hd_ * 128, CTXN, (char*)lds_raw); \
        __syncthreads(); \
        {     \
            int t_ = threadIdx.x; asm volatile("" : "+v"(t_)); const bf16_t* GC = (const bf16_t*)(p.ws + WS_SIDE); \
            const size_t o = (size_t)(t_ >> 1) * 2048 + 1024 + hd_ * 128 + (t_ & 1) * 64; \
            _Pragma("unroll") for (int i_ = 0; i_ < 8; ++i_) { v4u a = *(const v4u*)(BR_ + o + 8 * i_); const v4u b = *(const v4u*)(GC + o + 8 * i_); \
                _Pragma("unroll") for (int q_ = 0; q_ < 4; ++q_) a[q_] = attn::cvtpk(__uint_as_float(a[q_] << 16) * __uint_as_float(b[q_] << 16), __uint_as_float(a[q_] & 0xffff0000u) * __uint_as_float(b[q_] & 0xffff0000u)); \
                *(v4u*)(BR_ + o + 8 * i_) = a; } \
            __syncthreads(); } } while (0)
    const bool ctx_attn_early = gridDim.x >= 16;
    REP(6) { for (int u = blockIdx.x; u < ret::NQ * 4; u += gridDim.x) { const int q = u < (ret::NQ - 2) * 4 ? 2 + u / 4 : (u - (ret::NQ - 2) * 4) / 4; ret::output_unit(p, q, u & 3, (char*)lds_raw); }
             if (ctx_attn_early && (int)blockIdx.x >= (int)gridDim.x - 8) CTX_ATTN_UNIT((int)blockIdx.x - ((int)gridDim.x - 8));
             SYNC }
    REP(0) {
        const int G = (int)gridDim.x, vcu = (G % 8 == 0) ? ((int)blockIdx.x % 8) * (G / 8) + (int)blockIdx.x / 8 : (int)blockIdx.x;
        const int NLAT = (SEQ / 256) * 8, per = (NLAT + G - 1) / G;
        const bf16_t* P = ws_big(p); bf16_t* BR = ws_br(p);
        bool nomax; { int t_ = threadIdx.x; asm volatile("" : "+v"(t_)); const int l_ = t_ & 63; float gq = fmaxf(fabsf(p.q_norm[l_]), fabsf(p.q_norm[64 + l_])), gk = fmaxf(fabsf(p.k_norm[l_]), fabsf(p.k_norm[64 + l_]));
          for (int m_ = 32; m_ >= 1; m_ >>= 1) { gq = fmaxf(gq, __shfl_xor(gq, m_)); gk = fmaxf(gk, __shfl_xor(gk, m_)); }
          nomax = 11.3137085f * 1.4426950409f * 1.02f * gq * gk <= 40.0f; }
        for (int i = 0; i <= per; ++i) {
            int head, row0, seq;
            if (i < per) { const int unit = vcu * per + i; if (unit >= NLAT) continue; const int nqb = SEQ / 256, kv = unit / (4 * nqb), rem = unit % (4 * nqb); head = kv * 4 + rem / nqb; row0 = CTXN + (rem % nqb) * 256; seq = R; }
            else { if (ctx_attn_early || vcu >= 8) break; CTX_ATTN_UNIT(vcu); break; }
            const int kv = head / 4;
            if (nomax) attn::attn_dense_body<attn::bf16, true>(P + (size_t)row0 * P0W + C_QB + head * 128, P + C_KB + kv * 128, P + C_VB + kv * 128, BR + (size_t)row0 * 2048 + 1024 + head * 128, seq, (char*)lds_raw);
            else attn::attn_dense_body<attn::bf16, false>(P + (size_t)row0 * P0W + C_QB + head * 128, P + C_KB + kv * 128, P + C_VB + kv * 128, BR + (size_t)row0 * 2048 + 1024 + head * 128, seq, (char*)lds_raw);
            __syncthreads();
        }
        if (PROBE & 1) xcd_barrier(xbar);
    }
    SYNC
    run_gemm(lds, ws_xn(p) + (size_t)CTXN * DM, wt_in0 + (size_t)C_GA * DM, SEQ, 2048, DM, pg8::EpiGateMul{ws_br(p) + (size_t)CTXN * 2048, 2048});
    {
        pg8::Gemm gk{ws_br(p), wt_out0, 8 * 256, DM, 256, 2048, 2048, 256 * 2}; pg8::StaticOrder S; S.init(8 * 256, DM, (int)gridDim.x, (int)blockIdx.x);
        pg8::gemm_phase<pg8::EpiF32, pg8::StaticOrder, true, true>(lds, gk, S, pg8::EpiF32{(float*)(p.ws + WS_YC), DM}); }
    SYNC
    REP(4) { run_gemm(lds, ws_br(p) + (size_t)CTXN * 2048, wt_out0, SEQ, DM, 2048, pg8::EpiF32{ws_y(p) + (size_t)CTXN * DM, DM}); SYNC }
    REP(15) { el::resid_phase<0>(p); SYNC }
    REP(3) { run_gemm(lds, ws_xn(p), wt_in1 + (size_t)O_RW * DM, R, ZW, DM, pg8::EpiBf16<0>{ws_big(p), ZW, nullptr, 0, 0, 1.f});
             run_gemm(lds, ws_xn(p), wt_in1 + (size_t)(O_NA + 1024) * DM, CTXN, 2048, DM, pg8::EpiBf16<0>{(bf16_t*)(p.ws + WS_SIDE), 2048, nullptr, 0, 0, 1.f}, tail_rot((R / 256) * (ZW / 256)));
             SYNC }
    rw::shift_halo(p); SYNC
    rw::shift_inplace(p); wy::zero_words(p); SYNC
#ifndef PSKIP
#define PSKIP 0
#endif
    if ((PROBE >> 16) & 1) { wy::phase<1, PSKIP>(p, lds); SYNC wy::zero_words(p); SYNC }
    if ((PROBE >> 17) & 1) { wy::phase<2>(p, lds); SYNC wy::zero_words(p); SYNC }
    if ((PROBE >> 18) & 1) { wy::phase<3>(p, lds); SYNC wy::zero_words(p); SYNC }
    if (gridDim.x >= 64) wy::phase<0>(p, lds);
    else { for (int b = blockIdx.x; b < 256; b += gridDim.x) rw::scan_block<0>(p, b, lds); }
    SYNC
    rw::finish_phase(p); SYNC
    REP(3) { run_gemm(lds, ws_xn(p) + (size_t)CTXN * DM, wt_in1 + (size_t)O_NA * DM, SEQ, NAW, DM, pg8::EpiBf16<0>{ws_big(p) + (size_t)CTXN * NAW, NAW, nullptr, 0, 0, 1.f}); SYNC }
    REP(7) { for (int u = blockIdx.x; u < (GROWS / 4) * 16; u += gridDim.x) na::na_unit(p, u >> 4, u & 15, (char*)lds_raw); SYNC }
    run_gemm(lds, ws_xn(p) + (size_t)CTXN * DM, wt_in1 + (size_t)O_GC * DM, SEQ, 2048, DM, pg8::EpiGateMul{ws_br(p) + (size_t)CTXN * 2048, 2048}); SYNC
    REP(4) { run_gemm(lds, ws_br(p) + (size_t)CTXN * 2048, wt_out1, SEQ, DM, 2048, pg8::EpiF32{ws_y(p) + (size_t)CTXN * DM, DM}); SYNC }
    el::resid_phase<1>(p);
#undef X
#undef SYNC
}

extern "C" void kernel_launch(void* const* d_in, const int* in_sizes, int n_in, void* d_out, int out_size, void* d_ws, size_t ws_size, hipStream_t stream) {
    static int grid_blocks = 0;
    if (!grid_blocks) {
        int dev = 0, cus = 0, per_cu = 0;
        (void)hipGetDevice(&dev); (void)hipDeviceGetAttribute(&cus, hipDeviceAttributeMultiprocessorCount, dev);
        (void)hipFuncSetAttribute((const void*)mega, hipFuncAttributeMaxDynamicSharedMemorySize, LDS_BYTES);
        (void)hipOccupancyMaxActiveBlocksPerMultiprocessor(&per_cu, mega, NTHR, LDS_BYTES);
        if (per_cu < 1) per_cu = 1;
        grid_blocks = cus * per_cu;
        if (ws_size < WS_END) fprintf(stderr, "kernel_launch: workspace too small: %zu < %zu\n", ws_size, (size_t)WS_END);
    }
    (void)hipMemsetAsync((char*)d_ws + WS_BAR, 0, XCD_BAR_WORDS * 4, stream);
    Params p = make_params(d_in, d_out, d_ws);
    void* args[] = {&p};
    hipError_t e = hipLaunchCooperativeKernel((void*)mega, dim3(grid_blocks), dim3(NTHR), args, LDS_BYTES, stream);
    if (e != hipSuccess) fprintf(stderr, "cooperative launch failed: %s (grid %d)\n", hipGetErrorString(e), grid_blocks);
}

#else
int main(int argc, char** argv) {
    const char* dir = argc > 1 ? argv[1] : "data";
    char path[512]; snprintf(path, 512, "%s/sizes.txt", dir); FILE* f = fopen(path, "r"); if (!f) { printf("no sizes\n"); return 1; }
    std::vector<long> sizes; long v; while (fscanf(f, "%ld", &v) == 1) sizes.push_back(v); fclose(f);
    if (sizes.size() != 31) { printf("bad n inputs %zu\n", sizes.size()); return 1; }
    snprintf(path, 512, "%s/inputs.bin", dir); f = fopen(path, "rb");
    std::vector<std::vector<float>> in(31); std::vector<void*> ptrs(31);
    for (int i = 0; i < 31; ++i) { in[i].resize(sizes[i]); if (fread(in[i].data(), 4, sizes[i], f) != (size_t)sizes[i]) { printf("short read\n"); return 1; } ptrs[i] = in[i].data(); }
    fclose(f);
    if (sizes[0] != (long)SEQ * DM) { printf("SEQ mismatch: build with -DSEQ_LEN=%ld\n", sizes[0] / DM); return 1; }
    std::vector<float> out((size_t)SEQ * DM, 0.f); std::vector<unsigned char> ws(WS_END, 0xAA);
    Params p = make_params(ptrs.data(), out.data(), ws.data());
    auto check = [&](const char* name, const float* got, size_t n) {
        snprintf(path, 512, "%s/%s", dir, name); FILE* g = fopen(path, "rb"); std::vector<float> ref(n); if (fread(ref.data(), 4, n, g) != n) printf("short ref\n"); fclose(g);
        double num = 0, den = 0, mx = 0; for (size_t i = 0; i < n; ++i) { const double d = (double)got[i] - ref[i]; num += d * d; den += (double)ref[i] * ref[i]; if (fabs(d) > mx) mx = fabs(d); }
        printf("%s: rvr=%.3e absmax=%.3e\n", name, num / den, mx); };
    static RwShared sh;
    int phase = 0;
#define X(fn, n) { printf("phase %d %s n=%ld\n", phase++, #fn, (long)(n)); fflush(stdout); _Pragma("omp parallel for schedule(dynamic, 64)") for (long g = 0; g < (long)(n); ++g) fn(p, g); }
#define SYNC
#define SCAN { printf("phase %d scan\n", phase++); fflush(stdout); _Pragma("omp parallel for schedule(dynamic, 1)") for (int b = 0; b < 32; ++b) { RwShared* s = new RwShared; rwkv_scan_block(p, b, *s); delete s; } }
    X(ph_mod, N_MOD) X(ph_rope_table, N_ROPE) X(ph_prenorm<0>, (long)R) X(ph_gemm_l0_qkv, (long)R * P0W) X(ph_ropenorm, N_ROPENORM) X(ph_ret_scan, N_RETSCAN)
    X(ph_ret_merge, N_RETMERGE) X(ph_gqa_attn, N_GQA) X(ph_gemm_l0_gate, (long)R * 2048) X(ph_gemm_l0_out, (long)R * DM) X(ph_resid<0>, (long)R)
    check("x0.bin", out.data(), out.size()); check("ctx0.bin", ws_ctx1(p), (size_t)CTXN * DM);
    X(ph_prenorm<1>, (long)R) X(ph_gemm_l1_rw, (long)R * ZW) SCAN X(ph_rwkv_finish, N_RWFIN) X(ph_gemm_l1_na, (long)R * NAW) X(ph_na, N_NA)
    X(ph_gemm_l1_gate, (long)SEQ * 2048) X(ph_gemm_l1_out, (long)SEQ * DM) X(ph_resid<1>, (long)SEQ)
    check("out.bin", out.data(), out.size());
    return 0;
}
#endif
```

```cpp
#ifdef CPU_EMU
#include <cstdio>
#include <cstdlib>
#include <cstring>
#include <cmath>
#include <vector>
#define DEV static inline
#else
#include <hip/hip_runtime.h>
#include <hip/hip_cooperative_groups.h>
#include <cstdio>
namespace cg = cooperative_groups;
#define DEV __device__ __forceinline__
#endif

#ifndef SEQ_LEN
#define SEQ_LEN 16384
#endif
typedef unsigned short bf16_t;
constexpr int DM = 1024, CTXN = 256, SEQ = SEQ_LEN, R = CTXN + SEQ, GW = 64, GROWS = SEQ / GW;
constexpr int EVEN_IN = 5632, ODD_IN = 8448;
constexpr int P0W = 3584;
constexpr int C_QA = 0, C_KA = 512, C_VA = 1024, C_QB = 2048, C_KB = 3072, C_VB = 3328, C_GA = 3584;
constexpr int ZW = 3328;
constexpr int O_NA = 0, O_RW = 3072, O_GC = 6400;
constexpr int NAW = 3072;
constexpr float NORM_EPS = 1e-6f, GN_EPS = 64e-5f;

constexpr size_t MiB = 1u << 20;
constexpr size_t WS_MODV = 0;
constexpr size_t WS_ROPE = 64 * 1024;
constexpr size_t WS_CTX1 = 1 * MiB;
constexpr size_t WS_WB = 2 * MiB;
constexpr size_t WS_XN = 42 * MiB;
constexpr size_t WS_BIG = WS_XN + (((size_t)R * DM * 2 + MiB - 1) / MiB) * MiB;
constexpr size_t WS_BR = WS_BIG + (((size_t)R * P0W * 2 + MiB - 1) / MiB) * MiB;
constexpr size_t WS_END = WS_BR + (size_t)R * 2048 * 2;
static_assert(SEQ != 16384 || WS_END <= 256 * MiB, "workspace map exceeds 256 MiB");

struct Params {
    const float *x, *c, *ctx, *c_ctx, *w_mod, *b_mod, *g_pre, *g_post, *ev_w_in, *ev_w_out, *dec_f, *dec_b, *q_norm, *k_norm;
    const float *od_w_in, *od_w_out, *rpb, *mu, *w0f, *w2f, *w0b, *w2b, *a0f, *a2f, *a0b, *a2b, *k_k, *k_a, *r_k, *lnx_g, *lnx_b;
    float* out; unsigned char* ws;
};

DEV bf16_t f2bf(float f) { unsigned u; __builtin_memcpy(&u, &f, 4); u = (u + 0x7fffu + ((u >> 16) & 1u)) >> 16; return (bf16_t)u; }
DEV float bf2f(bf16_t h) { unsigned u = ((unsigned)h) << 16; float f; __builtin_memcpy(&f, &u, 4); return f; }
DEV float siluf(float x) { return x / (1.0f + expf(-x)); }
DEV float sigmf(float x) { return 1.0f / (1.0f + expf(-x)); }
DEV float softplusf(float x) { return fmaxf(x, 0.f) + log1pf(expf(-fabsf(x))); }

DEV float* ws_modv(const Params& p) { return (float*)(p.ws + WS_MODV); }
DEV float* ws_rope(const Params& p) { return (float*)(p.ws + WS_ROPE); }
DEV float* ws_ctx1(const Params& p) { return (float*)(p.ws + WS_CTX1); }
DEV bf16_t* ws_xn(const Params& p) { return (bf16_t*)(p.ws + WS_XN); }
DEV bf16_t* ws_big(const Params& p) { return (bf16_t*)(p.ws + WS_BIG); }
DEV float* ws_y(const Params& p) { return (float*)(p.ws + WS_BIG); }
DEV bf16_t* ws_br(const Params& p) { return (bf16_t*)(p.ws + WS_BR); }

constexpr long N_MOD = 2 * 2 * 3072;
DEV void ph_mod(const Params& p, long gid) {
    const int j = (int)(gid % 3072), s = (int)((gid / 3072) % 2), l = (int)(gid / 6144);
    const float* cv = s ? p.c_ctx : p.c; const float* w = p.w_mod + (size_t)l * DM * 3072 + j;
    float acc = 0.f;
    for (int k = 0; k < DM; ++k) acc += siluf(cv[k]) * w[(size_t)k * 3072];
    ws_modv(p)[gid] = acc + p.b_mod[l * 3072 + j];
}
constexpr long N_ROPE = 256 * 32;
DEV void ph_rope_table(const Params& p, long gid) {
    const int f = (int)(gid % 32), pos = (int)(gid / 32);
    const float inv = powf(10000.0f, -(float)f / 32.0f); const float ang = (float)pos * inv;
    ws_rope(p)[gid] = cosf(ang); ws_rope(p)[N_ROPE + gid] = sinf(ang);
}
template <int LAYER> DEV void ph_prenorm(const Params& p, long gid) {
    const int row = (int)gid; const int s = row < CTXN ? 1 : 0;
    const float* src = row < CTXN ? ((LAYER == 0 ? p.ctx : ws_ctx1(p)) + (size_t)row * DM) : ((LAYER == 0 ? p.x : p.out) + (size_t)(row - CTXN) * DM);
    const float* mv = ws_modv(p) + (LAYER * 2 + s) * 3072; const float* g = p.g_pre + LAYER * DM;
    float ss = 0.f;
    for (int k = 0; k < DM; ++k) ss += src[k] * src[k];
    const float rstd = 1.0f / sqrtf(ss / DM + NORM_EPS);
    bf16_t* o = ws_xn(p) + (size_t)row * DM;
    for (int k = 0; k < DM; ++k) o[k] = f2bf(src[k] * rstd * g[k] * (1.0f + mv[1024 + k]) + mv[k]);
}
template <int MODE> DEV void gemm_item(const bf16_t* A, int K, const float* W, int ldw, void* out, int pitch, int row, int col) {
    const bf16_t* a = A + (size_t)row * K; const float* w = W + col; float acc = 0.f;
    for (int k = 0; k < K; ++k) acc += bf2f(a[k]) * w[(size_t)k * ldw];
    if (MODE == 0) ((bf16_t*)out)[(size_t)row * pitch + col] = f2bf(acc);
    else if (MODE == 1) { bf16_t* o = (bf16_t*)out + (size_t)row * pitch + col; *o = f2bf(siluf(acc) * bf2f(*o)); }
    else ((float*)out)[(size_t)row * pitch + col] = acc;
}
DEV void ph_gemm_l0_qkv(const Params& p, long gid) { gemm_item<0>(ws_xn(p), DM, p.ev_w_in, EVEN_IN, ws_big(p), P0W, (int)(gid / P0W), (int)(gid % P0W)); }
DEV void ph_gemm_l0_gate(const Params& p, long gid) { gemm_item<1>(ws_xn(p), DM, p.ev_w_in + C_GA, EVEN_IN, ws_br(p), 2048, (int)(gid / 2048), (int)(gid % 2048)); }
DEV void ph_gemm_l0_out(const Params& p, long gid) { gemm_item<2>(ws_br(p), 2048, p.ev_w_out, DM, ws_y(p), DM, (int)(gid / DM), (int)(gid % DM)); }
DEV void ph_gemm_l1_rw(const Params& p, long gid) { gemm_item<0>(ws_xn(p), DM, p.od_w_in + O_RW, ODD_IN, ws_big(p), ZW, (int)(gid / ZW), (int)(gid % ZW)); }
DEV void ph_gemm_l1_na(const Params& p, long gid) { gemm_item<0>(ws_xn(p), DM, p.od_w_in + O_NA, ODD_IN, ws_big(p), NAW, (int)(gid / NAW), (int)(gid % NAW)); }
DEV void ph_gemm_l1_gate(const Params& p, long gid) { gemm_item<1>(ws_xn(p), DM, p.od_w_in + O_GC, ODD_IN, ws_br(p), 2048, CTXN + (int)(gid / 2048), (int)(gid % 2048)); }
DEV void ph_gemm_l1_out(const Params& p, long gid) { gemm_item<2>(ws_br(p), 2048, p.od_w_out, DM, ws_y(p), DM, CTXN + (int)(gid / DM), (int)(gid % DM)); }

constexpr long N_ROPENORM = (long)R * 18;
DEV void ph_ropenorm(const Params& p, long gid) {
    const int slot = (int)(gid % 18), row = (int)(gid / 18);
    int col; const float* nw = nullptr; float sc = 1.f;
    if (slot < 4) col = C_QA + slot * 128; else if (slot < 8) { col = C_KA + (slot - 4) * 128; sc = 0.08838834764831845f; }
    else if (slot < 16) { col = C_QB + (slot - 8) * 128; nw = p.q_norm; } else { col = C_KB + (slot - 16) * 128; nw = p.k_norm; }
    bf16_t* v = ws_big(p) + (size_t)row * P0W + col;
    if (nw) { float ss = 0.f; for (int d = 0; d < 128; ++d) { const float t = bf2f(v[d]); ss += t * t; } sc = 1.0f / sqrtf(ss / 128.f + NORM_EPS); }
    const bool rot = row >= CTXN; const int t = row - CTXN; const int gr = rot ? t / GW : 0, gc = rot ? t % GW : 0;
    const float* ct = ws_rope(p); const float* st = ct + N_ROPE;
    for (int i = 0; i < 64; ++i) {
        float x1 = bf2f(v[2 * i]) * sc, x2 = bf2f(v[2 * i + 1]) * sc;
        if (nw) { x1 *= nw[2 * i]; x2 *= nw[2 * i + 1]; }
        if (rot) { const int pos = i < 32 ? gr : gc, f = i & 31; const float cs = ct[pos * 32 + f], sn = st[pos * 32 + f]; const float y1 = x1 * cs - x2 * sn, y2 = x1 * sn + x2 * cs; x1 = y1; x2 = y2; }
        v[2 * i] = f2bf(x1); v[2 * i + 1] = f2bf(x2);
    }
}
constexpr long N_RETSCAN = 2 * 4 * 256;
DEV void ph_ret_scan(const Params& p, long gid) {
    const int e = (int)(gid % 256), h = (int)((gid / 256) % 4), dir = (int)(gid / 1024);
    const float g = sigmf((dir ? p.dec_b : p.dec_f)[h]);
    float S[128];
#pragma unroll
    for (int d = 0; d < 128; ++d) S[d] = 0.f;
    const bf16_t* P = ws_big(p); bf16_t* BR = ws_br(p);
    for (int pos = 0; pos < R; ++pos) {
        int row; if (pos < CTXN) row = dir ? CTXN - 1 - pos : pos; else { const int t = pos - CTXN; row = CTXN + (dir ? SEQ - 1 - t : t); }
        const bf16_t* pr = P + (size_t)row * P0W; const float v = bf2f(pr[C_VA + h * 256 + e]);
        const bf16_t* kq = pr + C_KA + h * 128; const bf16_t* qq = pr + C_QA + h * 128; float y = 0.f;
#pragma unroll
        for (int d = 0; d < 128; ++d) { S[d] = g * S[d] + bf2f(kq[d]) * v; y += bf2f(qq[d]) * S[d]; }
        BR[(size_t)row * 2048 + dir * 1024 + h * 256 + e] = f2bf(y);
    }
}
constexpr long N_RETMERGE = (long)R * 4;
DEV void ph_ret_merge(const Params& p, long gid) {
    const int h = (int)(gid % 4), row = (int)(gid / 4);
    bf16_t* b = ws_br(p) + (size_t)row * 2048 + h * 256;
    float s = 0.f; for (int e = 0; e < 256; ++e) s += bf2f(b[e]) + bf2f(b[1024 + e]);
    const float mean = s / 256.f; float q = 0.f;
    for (int e = 0; e < 256; ++e) { const float d = bf2f(b[e]) + bf2f(b[1024 + e]) - mean; q += d * d; }
    const float rstd = 1.0f / sqrtf(q / 256.f + NORM_EPS);
    for (int e = 0; e < 256; ++e) b[e] = f2bf((bf2f(b[e]) + bf2f(b[1024 + e]) - mean) * rstd);
}
constexpr long N_GQA = (long)R * 8 * 8;
DEV void ph_gqa_attn(const Params& p, long gid) {
    const int sl = (int)(gid % 8), row = (int)((gid / 8) % R), head = (int)(gid / (8L * R)), g = head / 4;
    const bf16_t* P = ws_big(p); const int nk = row < CTXN ? CTXN : R;
    float q[128];
    { const bf16_t* qp = P + (size_t)row * P0W + C_QB + head * 128;
#pragma unroll
      for (int d = 0; d < 128; ++d) q[d] = bf2f(qp[d]) * 0.08838834764831845f; }
    float acc[16];
#pragma unroll
    for (int i = 0; i < 16; ++i) acc[i] = 0.f;
    float m = -1e30f, l = 0.f;
    for (int j = 0; j < nk; ++j) {
        const bf16_t* kp = P + (size_t)j * P0W + C_KB + g * 128; float s = 0.f;
#pragma unroll
        for (int d = 0; d < 128; ++d) s += q[d] * bf2f(kp[d]);
        const float mn = fmaxf(m, s), al = expf(m - mn), pe = expf(s - mn);
        const bf16_t* vp = P + (size_t)j * P0W + C_VB + g * 128 + sl * 16;
        l = l * al + pe;
#pragma unroll
        for (int i = 0; i < 16; ++i) acc[i] = acc[i] * al + pe * bf2f(vp[i]);
        m = mn;
    }
    bf16_t* o = ws_br(p) + (size_t)row * 2048 + 1024 + head * 128 + sl * 16; const float il = 1.0f / l;
#pragma unroll
    for (int i = 0; i < 16; ++i) o[i] = f2bf(acc[i] * il);
}
template <int LAYER> DEV void ph_resid(const Params& p, long gid) {
    const int row = LAYER == 0 ? (int)gid : CTXN + (int)gid; const int s = row < CTXN ? 1 : 0;
    const float* y = ws_y(p) + (size_t)row * DM; const float* mv = ws_modv(p) + (LAYER * 2 + s) * 3072 + 2048; const float* g = p.g_post + LAYER * DM;
    float ss = 0.f; for (int k = 0; k < DM; ++k) ss += y[k] * y[k];
    const float rstd = 1.0f / sqrtf(ss / DM + NORM_EPS);
    const float* src; float* dst;
    if (row < CTXN) { src = p.ctx + (size_t)row * DM; dst = ws_ctx1(p) + (size_t)row * DM; }
    else { src = (LAYER == 0 ? p.x : p.out) + (size_t)(row - CTXN) * DM; dst = p.out + (size_t)(row - CTXN) * DM; }
    for (int k = 0; k < DM; ++k) dst[k] = src[k] + mv[k] * (y[k] * rstd * g[k]);
}
DEV float zshift(const bf16_t* Z, const float* mu, int row, int col) {
    const int lo = row < CTXN ? 0 : CTXN, hi = row < CTXN ? CTXN : R;
    const float z = bf2f(Z[(size_t)row * ZW + col]);
    const float pv = row > lo ? bf2f(Z[(size_t)(row - 1) * ZW + col]) : 0.f, nx = row + 1 < hi ? bf2f(Z[(size_t)(row + 1) * ZW + col]) : 0.f;
    return z + (0.5f * (pv + nx) - z) * mu[col];
}
constexpr long N_RWFIN = (long)SEQ * 16;
DEV void ph_rwkv_finish(const Params& p, long gid) {
    const int h = (int)(gid % 16), t = (int)(gid / 16), row = CTXN + t;
    const bf16_t* Z = ws_big(p); bf16_t* b = ws_br(p) + (size_t)row * 2048;
    float bon[2];
    for (int d = 0; d < 2; ++d) {
        const float* a0 = d ? p.a0b : p.a0f; const float* a2 = d ? p.a2b : p.a2f;
        float s = 0.f;
        for (int j = 0; j < 64; ++j) { const int hj = h * 64 + j; float acc = a0[hj];
            for (int m = 0; m < 64; ++m) acc += zshift(Z, p.mu, row, 3200 + d * 64 + m) * a2[m * 1024 + hj];
            const float al = sigmf(acc); const float r = zshift(Z, p.mu, row, hj), k = zshift(Z, p.mu, row, 1024 + hj);
            s += r * (k * (1.0f + (al - 1.0f) * p.k_a[hj])) * p.r_k[hj]; }
        bon[d] = s;
    }
    float sm = 0.f; for (int i = 0; i < 64; ++i) sm += bf2f(b[h * 64 + i]) + bf2f(b[1024 + h * 64 + i]);
    const float mean = sm / 64.f; float q = 0.f;
    for (int i = 0; i < 64; ++i) { const float d = bf2f(b[h * 64 + i]) + bf2f(b[1024 + h * 64 + i]) - mean; q += d * d; }
    const float rstd = 1.0f / sqrtf(q / 64.f + GN_EPS);
    for (int i = 0; i < 64; ++i) { const int hi = h * 64 + i; const float w = bf2f(b[hi]) + bf2f(b[1024 + hi]);
        const float v = zshift(Z, p.mu, row, 2048 + hi);
        b[1024 + hi] = f2bf((w - mean) * rstd * p.lnx_g[hi] + p.lnx_b[hi] + (bon[0] + bon[1]) * v); }
}
constexpr long N_NA = (long)SEQ * 16;
DEV void ph_na(const Params& p, long gid) {
    const int h = (int)(gid % 16), t = (int)(gid / 16), r = t / GW, c = t % GW;
    const bf16_t* P = ws_big(p);
    float q[64];
    { const bf16_t* qp = P + (size_t)(CTXN + t) * NAW + h * 64;
#pragma unroll
      for (int d = 0; d < 64; ++d) q[d] = bf2f(qp[d]) * 0.125f; }
    float acc[64];
#pragma unroll
    for (int d = 0; d < 64; ++d) acc[d] = 0.f;
    float m = -1e30f, l = 0.f;
    const int wh = GROWS < 8 ? GROWS : 8;
    int r0 = r - wh / 2; r0 = r0 < 0 ? 0 : (r0 > GROWS - wh ? GROWS - wh : r0);
    int c0 = c - 8; c0 = c0 < 0 ? 0 : (c0 > GW - 16 ? GW - 16 : c0);
    const float* rp = p.rpb + h * 15 * 31;
    for (int kk = 0; kk < wh * 16 + CTXN; ++kk) {
        int krow; float bias = 0.f;
        if (kk < wh * 16) { const int i = kk / 16, j = kk % 16; krow = CTXN + (r0 + i) * GW + c0 + j; bias = rp[(r0 + i - r + 7) * 31 + (c0 + j - c + 15)]; }
        else krow = kk - wh * 16;
        const bf16_t* kp = P + (size_t)krow * NAW + 1024 + h * 64; float s = bias;
#pragma unroll
        for (int d = 0; d < 64; ++d) s += q[d] * bf2f(kp[d]);
        const float mn = fmaxf(m, s), al = expf(m - mn), pe = expf(s - mn);
        const bf16_t* vp = P + (size_t)krow * NAW + 2048 + h * 64;
        l = l * al + pe;
#pragma unroll
        for (int d = 0; d < 64; ++d) acc[d] = acc[d] * al + pe * bf2f(vp[d]);
        m = mn;
    }
    bf16_t* o = ws_br(p) + (size_t)(CTXN + t) * 2048 + h * 64; const float il = 1.0f / l;
#pragma unroll
    for (int d = 0; d < 64; ++d) o[d] = f2bf(acc[d] * il);
}

constexpr int RW_CH = 16;
struct RwShared { float r[RW_CH][64], w[RW_CH][64], kd[RW_CH][64], v[RW_CH][64], a[RW_CH][64], b[RW_CH][64], tz[RW_CH][64], za[RW_CH][64], kk[RW_CH][64]; };
#ifdef CPU_EMU
#define FOR_THREADS(tid) for (int tid = 0; tid < 64; ++tid)
#define BLOCK_SYNC()
#define TSTATE(tid) S_all[tid]
#else
#define FOR_THREADS(tid) const int tid = threadIdx.x; if (tid < 64)
#define BLOCK_SYNC() __syncthreads()
#define TSTATE(tid) S_reg
#endif
DEV int rw_row(int dir, int pos) { if (pos < CTXN) return dir ? CTXN - 1 - pos : pos; const int t = pos - CTXN; return CTXN + (dir ? SEQ - 1 - t : t); }
#ifdef CPU_EMU
static void rwkv_scan_block(const Params& p, int blk, RwShared& sh) {
    static thread_local float S_all[64][64];
    for (int i = 0; i < 64; ++i) for (int j = 0; j < 64; ++j) S_all[i][j] = 0.f;
#else
__device__ void rwkv_scan_block(const Params& p, int blk, RwShared& sh) {
    float S_reg[64];
#pragma unroll
    for (int j = 0; j < 64; ++j) S_reg[j] = 0.f;
#endif
    const int dir = blk / 16, h = blk % 16;
    const float* w0 = dir ? p.w0b : p.w0f; const float* w2 = dir ? p.w2b : p.w2f; const float* a0 = dir ? p.a0b : p.a0f; const float* a2 = dir ? p.a2b : p.a2f;
    const bf16_t* Z = ws_big(p); bf16_t* BR = ws_br(p);
    for (int p0 = 0; p0 < R; p0 += RW_CH) {
        { FOR_THREADS(tid) { const int hj = h * 64 + tid;
            for (int tt = 0; tt < RW_CH; ++tt) { const int row = rw_row(dir, p0 + tt);
                sh.tz[tt][tid] = tanhf(zshift(Z, p.mu, row, 3072 + dir * 64 + tid)); sh.za[tt][tid] = zshift(Z, p.mu, row, 3200 + dir * 64 + tid);
                sh.r[tt][tid] = zshift(Z, p.mu, row, hj); sh.v[tt][tid] = zshift(Z, p.mu, row, 2048 + hj);
                const float k = zshift(Z, p.mu, row, 1024 + hj); sh.kd[tt][tid] = k; sh.kk[tt][tid] = k * p.k_k[hj]; } } }
        BLOCK_SYNC();
        { FOR_THREADS(tid) { const int hj = h * 64 + tid;
            for (int tt = 0; tt < RW_CH; ++tt) { float aw = w0[hj], aa = a0[hj], nn = 0.f;
                for (int m = 0; m < 64; ++m) { aw += sh.tz[tt][m] * w2[m * 1024 + hj]; aa += sh.za[tt][m] * a2[m * 1024 + hj]; nn += sh.kk[tt][m] * sh.kk[tt][m]; }
                const float lw = -softplusf(-aw) - 0.5f; const float al = sigmf(aa);
                const float kkn = sh.kk[tt][tid] / fmaxf(sqrtf(nn), 1e-12f);
                sh.w[tt][tid] = expf(-expf(lw)); sh.a[tt][tid] = -kkn; sh.b[tt][tid] = kkn * al;
                sh.kd[tt][tid] = sh.kd[tt][tid] * (1.0f + (al - 1.0f) * p.k_a[hj]); } } }
        BLOCK_SYNC();
        { FOR_THREADS(tid) { float* S = TSTATE(tid);
            for (int tt = 0; tt < RW_CH; ++tt) { float sa = 0.f;
#pragma unroll
                for (int j = 0; j < 64; ++j) sa += S[j] * sh.a[tt][j];
                const float vi = sh.v[tt][tid]; float y = 0.f;
#pragma unroll
                for (int j = 0; j < 64; ++j) { S[j] = S[j] * sh.w[tt][j] + sa * sh.b[tt][j] + vi * sh.kd[tt][j]; y += S[j] * sh.r[tt][j]; }
                if (p0 >= CTXN) BR[(size_t)rw_row(dir, p0 + tt) * 2048 + dir * 1024 + h * 64 + tid] = f2bf(y); } } }
        BLOCK_SYNC();
    }
}

static Params make_params(void* const* d_in, void* d_out, void* d_ws) {
    Params p{};
    const float** f = (const float**)&p;
    for (int i = 0; i < 31; ++i) f[i] = (const float*)d_in[i];
    p.out = (float*)d_out; p.ws = (unsigned char*)d_ws; return p;
}


#ifndef CPU_EMU
#define LAS __attribute__((address_space(3)))
#define GAS __attribute__((address_space(1)))
typedef unsigned v4u __attribute__((ext_vector_type(4)));
constexpr int NWAVES = 8, NTHR = NWAVES * 64;
#ifndef PROBE
#define PROBE 0
#endif
#define XB_TMO      128
#define XB_XCNT(j)  (256  + 64 * (j))
#define XB_XSUB(j)  (1280 + 64 * (j))
#define XB_XGEN(j)  (2304 + 64 * (j))
#define XB_TOP      3328
#define XB_TOPGEN   3392
#define XCD_BAR_WORDS 3456
#define XB_SPIN_CAP (1u << 18)

__device__ __forceinline__ unsigned xb_ld(unsigned* p)              { return __hip_atomic_load(p, __ATOMIC_RELAXED, __HIP_MEMORY_SCOPE_AGENT); }
__device__ __forceinline__ unsigned xb_add(unsigned* p, unsigned v) { return __hip_atomic_fetch_add(p, v, __ATOMIC_RELAXED, __HIP_MEMORY_SCOPE_AGENT); }
__device__ __forceinline__ unsigned xb_xcc_id() { return (unsigned)__builtin_amdgcn_s_getreg((3 << 11) | 20) & 0xFu; }
#define XB_SPIN(cond, bar) do { unsigned _sp = 0; while (cond) { __builtin_amdgcn_s_sleep(1); \
    if ((++_sp & 255u) == 0u) { if (xb_ld(&(bar)[XB_TMO])) break; if (_sp > XB_SPIN_CAP) { atomicAdd(&(bar)[XB_TMO], 1u); break; } } } } while (0)

struct XcdBarrier {
    unsigned* bar; unsigned x;
    volatile LAS unsigned* st;
};

__device__ __forceinline__ XcdBarrier xcd_barrier_post(unsigned* bar, volatile LAS unsigned* st) {
    XcdBarrier b; b.bar = bar; b.x = xb_xcc_id(); b.st = st;
    if (threadIdx.x == 0) (void)xb_add(&bar[XB_XCNT(b.x)], 1u);
    return b;
}
__device__ __forceinline__ void xcd_barrier_complete(unsigned* bar, unsigned x, unsigned& nloc, unsigned& nx) {
    const unsigned G = gridDim.x * gridDim.y * gridDim.z;
    unsigned sum, cnt, mine, sp = 0u;
    for (;;) {
        sum = 0u; cnt = 0u; mine = 0u;
#pragma unroll
        for (unsigned j = 0; j < 16; ++j) { const unsigned c = xb_ld(&bar[XB_XCNT(j)]); sum += c; cnt += (c > 0u) ? 1u : 0u; mine = (j == x) ? c : mine; }
        if (sum == G) break;
        __builtin_amdgcn_s_sleep(1);
        if ((++sp & 255u) == 0u) { if (xb_ld(&bar[XB_TMO])) break; if (sp > XB_SPIN_CAP) { atomicAdd(&bar[XB_TMO], 1u); break; } }
    }
    nloc = mine > 0u ? mine : 1u; nx = cnt > 0u ? cnt : 1u;
}

__device__ __forceinline__ void xcd_barrier(const XcdBarrier& b) {
    asm volatile("s_waitcnt vmcnt(0)" ::: "memory");
    __syncthreads();
    if (threadIdx.x == 0) {
        unsigned* bar = b.bar;
        __builtin_amdgcn_s_waitcnt(0);
        unsigned nloc = b.st[0], nx = b.st[1];
        if (nloc == 0u) { xcd_barrier_complete(bar, b.x, nloc, nx); b.st[0] = nloc; b.st[1] = nx; }
        const unsigned old = xb_add(&bar[XB_XSUB(b.x)], 1u);
        const unsigned gen = old / nloc;
        if (old + 1u == (gen + 1u) * nloc) {
            __builtin_amdgcn_fence(__ATOMIC_RELEASE, "agent");
            asm volatile("s_waitcnt vmcnt(0)" ::: "memory");
            const unsigned og = xb_add(&bar[XB_TOP], 1u);
            const unsigned tg = og / nx;
            if (og + 1u == (tg + 1u) * nx) xb_add(&bar[XB_TOPGEN], 1u);
            else XB_SPIN(xb_ld(&bar[XB_TOPGEN]) == tg, bar);
            __builtin_amdgcn_fence(__ATOMIC_ACQUIRE, "agent");
            xb_add(&bar[XB_XGEN(b.x)], 1u);
            asm volatile("s_waitcnt vmcnt(0)" ::: "memory");
        } else {
            XB_SPIN(xb_ld(&bar[XB_XGEN(b.x)]) == gen, bar);
            __builtin_amdgcn_fence(__ATOMIC_ACQUIRE, "agent");
            asm volatile("s_waitcnt vmcnt(0)" ::: "memory");
        }
    }
    __syncthreads();
}
namespace pg8 {
#define PG8_LAS __attribute__((address_space(3)))
typedef unsigned short bf16_t;
typedef short bf16x8 __attribute__((ext_vector_type(8)));
typedef float f32x4 __attribute__((ext_vector_type(4)));
typedef unsigned u32x4 __attribute__((ext_vector_type(4)));
constexpr int BM = 256, BK = 64, HALF = 128, HTB = HALF * BK * 2  , STAGE_BYTES = 8 * HTB, NXCD = 8, WGM = 8;

__host__ __device__ __forceinline__ int lds_byte(int r, int c) { const int st = (r >> 4) * 2 + (c >> 5), rr = r & 15, cc = c & 31, ob = rr * 64 + cc * 2; return st * 1024 + (ob ^ (((ob >> 9) & 1) << 5)); }
__host__ __device__ __forceinline__ void stage_rc(int b, int& R, int& C) { const int st = b / 1024, sb = b % 1024, swz = sb ^ (((sb >> 9) & 1) << 5); R = (st >> 1) * 16 + swz / 64; C = (st & 1) * 32 + (swz % 64) / 2; }
__host__ __device__ __forceinline__ int perm32(int rho) { const int n = rho >> 4, i = rho & 15; return 8 * (i >> 2) + 4 * n + (i & 3); }

struct Unit { int pm, pn; };
struct Gemm { const bf16_t* A; const bf16_t* Bt; int M, N, K; int lda = 0, ldb = 0; int ksl = 0; };

struct StaticOrder {
    int nM, nN, nwg, G, c;
    __host__ __device__ void init(int M, int N, int G_, int c_) { nM = M / BM; nN = N / BM; nwg = nM * nN; G = G_; c = c_; }
    __host__ __device__ bool next(int i, Unit& u) const {
        const long L = (long)i * G + c; if (L >= nwg) return false;
        int wgid = (int)L; { const int q = nwg / NXCD, r = nwg % NXCD, xcd = wgid % NXCD, off = wgid / NXCD; wgid = (xcd < r ? xcd * (q + 1) : r * (q + 1) + (xcd - r) * q) + off; }
        const int nig = WGM * nN, gid = wgid / nig, fm = gid * WGM, gsz = (nM - fm) < WGM ? (nM - fm) : WGM;
        u.pm = fm + ((wgid % nig) % gsz); u.pn = (wgid % nig) / gsz; return true;
    }
    __device__ __forceinline__ void a_ready(const Unit&) const {}
    __device__ __forceinline__ void done(const Unit&) const {}
};

__device__ __forceinline__ unsigned cvt_pk_bf16(float lo, float hi) { unsigned r; asm volatile("v_cvt_pk_bf16_f32 %0, %1, %2" : "=v"(r) : "v"(lo), "v"(hi)); return r; }
typedef float f32x2 __attribute__((ext_vector_type(2)));
__device__ __forceinline__ f32x2 gelu_pk(f32x2 v) {
    const f32x2 av = __builtin_elementwise_abs(v), d = av * 0.2316418882f + 1.0f;
    f32x2 t; t.x = __builtin_amdgcn_rcpf(d.x); t.y = __builtin_amdgcn_rcpf(d.y);
    f32x2 q = t * 0.5307027145f + (-0.7265760135f); q = q * t + 0.7107068705f; q = q * t + (-0.142248368f); q = q * t + 0.127414796f; q = q * t;
    const f32x2 s = (v * v) * (-0.72134752044f);
    f32x2 e; e.x = __builtin_amdgcn_exp2f(s.x); e.y = __builtin_amdgcn_exp2f(s.y);
    const f32x2 m = v * (q * e), r = v - m;
    f32x2 o; o.x = v.x < 0.f ? m.x : r.x; o.y = v.y < 0.f ? m.y : r.y; return o;
}

template <int ACT  > struct EpiBf16 {
    static constexpr bool PERM = true, AFTER_DRAIN = false; static_assert(ACT == 0 || ACT == 1, "EpiBf16: ACT is 0 (none) or 1 (gelu_pk)");
    bf16_t* O; int ldc; const float* bias; int split_cols; size_t split_stride; float scale0;
    __device__ __forceinline__ void operator()(const f32x4 (&acc)[2][2][4][2], const Unit& u, int wr, int wc, int fr, int fq) const {
        const int row0 = u.pm * BM + wr * 64 + fr; int colt = u.pn * BM; bf16_t* base = O;
        float sc = 1.f; if (split_cols) { const int t = colt / split_cols; base += (size_t)t * split_stride; colt -= t * split_cols; if (t == 0) sc = scale0; }
        const int col0 = colt + wc * 32 + 8 * fq, bcol0 = u.pn * BM + wc * 32 + 8 * fq;
        f32x4 bv[2][2];
#pragma unroll
        for (int bj = 0; bj < 2; ++bj)
#pragma unroll
            for (int n = 0; n < 2; ++n) bv[bj][n] = bias ? *(const f32x4*)(bias + bcol0 + bj * HALF + 4 * n) : (f32x4){0.f, 0.f, 0.f, 0.f};
#pragma unroll
        for (int ai = 0; ai < 2; ++ai)
#pragma unroll
            for (int m = 0; m < 4; ++m) { bf16_t* rowp = base + (size_t)(row0 + ai * HALF + m * 16) * ldc + col0;
#pragma unroll
                for (int bj = 0; bj < 2; ++bj) { f32x4 v0 = acc[ai][bj][m][0] + bv[bj][0], v1 = acc[ai][bj][m][1] + bv[bj][1];
                    if (ACT == 1) { f32x2 a = gelu_pk((f32x2){v0[0], v0[1]}), b = gelu_pk((f32x2){v0[2], v0[3]}), c = gelu_pk((f32x2){v1[0], v1[1]}), d = gelu_pk((f32x2){v1[2], v1[3]});
                        v0 = (f32x4){a.x, a.y, b.x, b.y}; v1 = (f32x4){c.x, c.y, d.x, d.y}; }
                    v0 = v0 * sc; v1 = v1 * sc; u32x4 w; w.x = cvt_pk_bf16(v0[0], v0[1]); w.y = cvt_pk_bf16(v0[2], v0[3]); w.z = cvt_pk_bf16(v1[0], v1[1]); w.w = cvt_pk_bf16(v1[2], v1[3]);
                    *(u32x4*)(rowp + bj * HALF) = w; } }
    }
};

typedef float f32x2c_ __attribute__((ext_vector_type(2))); typedef __bf16 bf2c_ __attribute__((ext_vector_type(2)));
__device__ __forceinline__ unsigned cvt_pk_bf16_c(float lo, float hi) { const f32x2c_ v = {lo, hi}; return __builtin_bit_cast(unsigned, __builtin_convertvector(v, bf2c_)); }
struct EpiBf16Halo {
    static constexpr bool PERM = true, AFTER_DRAIN = false;
    bf16_t* O; int ldc; bf16_t* H;
    __device__ __forceinline__ void operator()(const f32x4 (&acc)[2][2][4][2], const Unit& u, int wr, int wc, int fr, int fq) const {
        const int row0 = u.pm * BM + wr * 64 + fr, col0 = u.pn * BM + wc * 32 + 8 * fq;
#pragma unroll
        for (int ai = 0; ai < 2; ++ai)
#pragma unroll
            for (int m = 0; m < 4; ++m) { const int row = row0 + ai * HALF + m * 16; bf16_t* rowp = O + (size_t)row * ldc + col0;
                const bool edge = (m == 0 && wr == 0 && fr == 0) || (m == 3 && wr == 1 && fr == 15);
                bf16_t* hp = H + ((size_t)(row >> 7) * 2 + (m == 3 ? 1 : 0)) * ldc + col0;
#pragma unroll
                for (int bj = 0; bj < 2; ++bj) { const f32x4 v0 = acc[ai][bj][m][0], v1 = acc[ai][bj][m][1];
                    u32x4 w; w.x = cvt_pk_bf16_c(v0[0], v0[1]); w.y = cvt_pk_bf16_c(v0[2], v0[3]); w.z = cvt_pk_bf16_c(v1[0], v1[1]); w.w = cvt_pk_bf16_c(v1[2], v1[3]);
                    *(u32x4*)(rowp + bj * HALF) = w;
                    if ((m == 0 || m == 3) && edge) *(u32x4*)(hp + bj * HALF) = w; } }
    }
};
__device__ __forceinline__ float silu_fast(float v) { return v * __builtin_amdgcn_rcpf(1.0f + __builtin_amdgcn_exp2f(-1.4426950408889634f * v)); }
struct EpiGateMul {
    static constexpr bool PERM = true, AFTER_DRAIN = false;
    bf16_t* O; int ldc;
    __device__ __forceinline__ void operator()(const f32x4 (&acc)[2][2][4][2], const Unit& u, int wr, int wc, int fr, int fq) const {
        const int row0 = u.pm * BM + wr * 64 + fr, col0 = u.pn * BM + wc * 32 + 8 * fq;
#pragma unroll
        for (int ai = 0; ai < 2; ++ai)
#pragma unroll
            for (int m = 0; m < 4; ++m) { bf16_t* rowp = O + (size_t)(row0 + ai * HALF + m * 16) * ldc + col0;
#pragma unroll
                for (int bj = 0; bj < 2; ++bj) { const u32x4 old = *(const u32x4*)(rowp + bj * HALF); const f32x4 v0 = acc[ai][bj][m][0], v1 = acc[ai][bj][m][1];
                    u32x4 w;
                    w.x = cvt_pk_bf16(silu_fast(v0[0]) * __uint_as_float(old.x << 16), silu_fast(v0[1]) * __uint_as_float(old.x & 0xffff0000u));
                    w.y = cvt_pk_bf16(silu_fast(v0[2]) * __uint_as_float(old.y << 16), silu_fast(v0[3]) * __uint_as_float(old.y & 0xffff0000u));
                    w.z = cvt_pk_bf16(silu_fast(v1[0]) * __uint_as_float(old.z << 16), silu_fast(v1[1]) * __uint_as_float(old.z & 0xffff0000u));
                    w.w = cvt_pk_bf16(silu_fast(v1[2]) * __uint_as_float(old.w << 16), silu_fast(v1[3]) * __uint_as_float(old.w & 0xffff0000u));
                    *(u32x4*)(rowp + bj * HALF) = w; } }
    }
};
struct EpiSiluBf16 {
    static constexpr bool PERM = true, AFTER_DRAIN = false;
    bf16_t* O; int ldc;
    __device__ __forceinline__ void operator()(const f32x4 (&acc)[2][2][4][2], const Unit& u, int wr, int wc, int fr, int fq) const {
        const int row0 = u.pm * BM + wr * 64 + fr, col0 = u.pn * BM + wc * 32 + 8 * fq;
#pragma unroll
        for (int ai = 0; ai < 2; ++ai)
#pragma unroll
            for (int m = 0; m < 4; ++m) { bf16_t* rowp = O + (size_t)(row0 + ai * HALF + m * 16) * ldc + col0;
#pragma unroll
                for (int bj = 0; bj < 2; ++bj) { const f32x4 v0 = acc[ai][bj][m][0], v1 = acc[ai][bj][m][1]; u32x4 w;
                    w.x = cvt_pk_bf16(silu_fast(v0[0]), silu_fast(v0[1])); w.y = cvt_pk_bf16(silu_fast(v0[2]), silu_fast(v0[3]));
                    w.z = cvt_pk_bf16(silu_fast(v1[0]), silu_fast(v1[1])); w.w = cvt_pk_bf16(silu_fast(v1[2]), silu_fast(v1[3]));
                    *(u32x4*)(rowp + bj * HALF) = w; } }
    }
};
struct EpiF32 {
    static constexpr bool PERM = true, AFTER_DRAIN = false;
    float* O; int ldc;
    __device__ __forceinline__ void operator()(const f32x4 (&acc)[2][2][4][2], const Unit& u, int wr, int wc, int fr, int fq) const {
        const int row0 = u.pm * BM + wr * 64 + fr, col0 = u.pn * BM + wc * 32 + 8 * fq;
#pragma unroll
        for (int ai = 0; ai < 2; ++ai)
#pragma unroll
            for (int m = 0; m < 4; ++m) { float* rowp = O + (size_t)(row0 + ai * HALF + m * 16) * ldc + col0;
#pragma unroll
                for (int bj = 0; bj < 2; ++bj) { *(f32x4*)(rowp + bj * HALF) = acc[ai][bj][m][0]; *(f32x4*)(rowp + bj * HALF + 4) = acc[ai][bj][m][1]; } }
    }
};

template <class Epi, class Sched, bool ALIGN_EPI = false, bool SP2 = false>
__device__ __forceinline__ void gemm_phase(PG8_LAS unsigned char* lds, const Gemm g, const Sched& S, const Epi& E) {
    int tid_ = threadIdx.x; asm volatile("" : "+v"(tid_));
    const int tid = tid_, wid = __builtin_amdgcn_readfirstlane(tid >> 6), lane = tid & 63, wr = wid >> 2, wc = wid & 3, fr = lane & 15, fq = lane >> 4;
    const int K = g.K, nt = K / BK, lda = g.lda ? g.lda : K, ldb = g.ldb ? g.ldb : K;
    unsigned voffA[2], voffB[2];
#pragma unroll
    for (int i = 0; i < 2; ++i) { int R, C; stage_rc(tid * 16 + i * 8192, R, C); const int Rb = Epi::PERM ? ((R & ~31) + perm32(R & 31)) : R;
        voffA[i] = (unsigned)(R * lda + C) * 2u; voffB[i] = (unsigned)(Rb * ldb + C) * 2u; }
    const size_t kstep = (size_t)(BK * 2);
    const size_t hstepA = (size_t)HALF * lda * 2, hstepB = (size_t)HALF * ldb * 2;
    const size_t tstepA = g.ksl ? (size_t)g.ksl : 2 * hstepA, tstepB = 2 * hstepB, bpm = (size_t)g.ksl;
    const unsigned ldsw = (unsigned)wid * 1024u;
    const int aoff = lds_byte(wr * 64 + fr, fq * 8), boff = lds_byte(wc * 32 + fr, fq * 8);
#define PG8_SA(b, h) (((b) * 2 + (h)) * HTB)
#define PG8_SB(b, h) ((4 + (b) * 2 + (h)) * HTB)
#define PG8_STAGE(bufoff, gbase, voff) do { _Pragma("unroll") for (int _i = 0; _i < 2; ++_i) \
        __builtin_amdgcn_global_load_lds((const unsigned*)((const char*)(gbase) + (voff)[_i]), (PG8_LAS unsigned*)(lds + (bufoff) + ldsw + _i * 8192), 16, 0, 0); } while (0)
#define PG8_LDA(dst, b, h) do { _Pragma("unroll") for (int m = 0; m < 4; ++m) _Pragma("unroll") for (int k = 0; k < 2; ++k) dst[m][k] = *(const PG8_LAS bf16x8*)(lds + PG8_SA(b, h) + aoff + m * 2048 + k * 1024); } while (0)
#define PG8_LDB(dst, b, h) do { _Pragma("unroll") for (int n = 0; n < 2; ++n) _Pragma("unroll") for (int k = 0; k < 2; ++k) dst[n][k] = *(const PG8_LAS bf16x8*)(lds + PG8_SB(b, h) + boff + n * 2048 + k * 1024); } while (0)
#define PG8_MMA(ai, bj, At, Bt) do { __builtin_amdgcn_s_setprio(1); _Pragma("unroll") for (int m = 0; m < 4; ++m) _Pragma("unroll") for (int n = 0; n < 2; ++n) _Pragma("unroll") for (int k = 0; k < 2; ++k) \
        acc[ai][bj][m][n] = __builtin_amdgcn_mfma_f32_16x16x32_bf16(Bt[n][k], At[m][k], acc[ai][bj][m][n], 0, 0, 0); __builtin_amdgcn_s_setprio(0); } while (0)
#define PG8_WAIT_V(n) asm volatile("s_waitcnt vmcnt(" #n ")" ::: "memory")
#define PG8_WAIT_L(n) asm volatile("s_waitcnt lgkmcnt(" #n ")" ::: "memory")
#define PG8_BAR __builtin_amdgcn_s_barrier()
#define PG8_SCHED __builtin_amdgcn_sched_barrier(0)
    Unit cur, nxt; int ui = 0;
    if (!S.next(0, cur)) return;
    f32x4 acc[2][2][4][2];
#pragma unroll
    for (int a = 0; a < 2; ++a)
#pragma unroll
        for (int b = 0; b < 2; ++b)
#pragma unroll
            for (int m = 0; m < 4; ++m)
#pragma unroll
                for (int n = 0; n < 2; ++n) acc[a][b][m][n] = (f32x4){0.f, 0.f, 0.f, 0.f};
    bf16x8 At[4][2], B0[2][2], B1[2][2];
    const char* cA = (const char*)g.A + (size_t)cur.pm * tstepA; const char* cB = (const char*)g.Bt + (size_t)cur.pn * tstepB + (size_t)cur.pm * bpm;
    S.a_ready(cur);
    if constexpr (SP2) {
        PG8_STAGE(PG8_SB(0, 0), cB, voffB); PG8_STAGE(PG8_SB(0, 1), cB + hstepB, voffB); PG8_STAGE(PG8_SA(0, 0), cA, voffA); PG8_STAGE(PG8_SA(0, 1), cA + hstepA, voffA);
        if (wr == 1) PG8_BAR;
        PG8_WAIT_V(2); PG8_BAR;
        PG8_STAGE(PG8_SB(1, 0), cB + kstep, voffB); PG8_STAGE(PG8_SA(1, 0), cA + kstep, voffA); PG8_STAGE(PG8_SB(1, 1), cB + hstepB + kstep, voffB);
        PG8_WAIT_V(6); PG8_BAR;
    } else {
        PG8_STAGE(PG8_SB(0, 0), cB, voffB); PG8_STAGE(PG8_SA(0, 0), cA, voffA); PG8_STAGE(PG8_SB(0, 1), cB + hstepB, voffB); PG8_STAGE(PG8_SA(0, 1), cA + hstepA, voffA);
        if (wr == 1) PG8_BAR;
        PG8_WAIT_V(4); PG8_BAR;
        PG8_STAGE(PG8_SB(1, 0), cB + kstep, voffB); PG8_STAGE(PG8_SA(1, 0), cA + kstep, voffA); PG8_STAGE(PG8_SB(1, 1), cB + hstepB + kstep, voffB);
        PG8_WAIT_V(6); PG8_BAR;
    }
    for (;;) {
        const bool has_next = S.next(ui + 1, nxt);
        const char* nA = has_next ? (const char*)g.A + (size_t)nxt.pm * tstepA : cA; const char* nB = has_next ? (const char*)g.Bt + (size_t)nxt.pn * tstepB + (size_t)nxt.pm * bpm : cB;
        for (int t = 0; t < nt; t += 2) {
            const bool last = (t == nt - 2);
            const char* a1 = cA + (size_t)(t + 1) * kstep;
            const char* a2 = last ? nA : cA + (size_t)(t + 2) * kstep; const char* b2 = last ? nB : cB + (size_t)(t + 2) * kstep;
            const char* a3 = a2 + kstep; const char* b3 = b2 + kstep;
            if (last && has_next) S.a_ready(nxt);
            if constexpr (SP2) {
            PG8_LDB(B0, 0, 0); PG8_LDB(B1, 0, 1); PG8_SCHED; PG8_LDA(At, 0, 0); PG8_STAGE(PG8_SA(1, 1), a1 + hstepA, voffA);
            PG8_WAIT_V(8); PG8_WAIT_L(0); PG8_BAR; PG8_MMA(0, 0, At, B0); PG8_MMA(0, 1, At, B1); PG8_BAR; PG8_SCHED;
            PG8_LDA(At, 0, 1); PG8_STAGE(PG8_SB(0, 0), b2, voffB); PG8_STAGE(PG8_SB(0, 1), b2 + hstepB, voffB); PG8_STAGE(PG8_SA(0, 0), a2, voffA);
            PG8_WAIT_V(8); PG8_WAIT_L(0); PG8_BAR; PG8_MMA(1, 0, At, B0); PG8_MMA(1, 1, At, B1); PG8_BAR; PG8_SCHED;
            PG8_LDB(B0, 1, 0); PG8_LDB(B1, 1, 1); PG8_SCHED; PG8_LDA(At, 1, 0); PG8_STAGE(PG8_SA(0, 1), a2 + hstepA, voffA);
            PG8_WAIT_V(8); PG8_WAIT_L(0); PG8_BAR; PG8_MMA(0, 0, At, B0); PG8_MMA(0, 1, At, B1); PG8_BAR; PG8_SCHED;
            PG8_LDA(At, 1, 1); PG8_STAGE(PG8_SB(1, 0), b3, voffB); PG8_STAGE(PG8_SB(1, 1), b3 + hstepB, voffB); PG8_STAGE(PG8_SA(1, 0), a3, voffA);
            PG8_WAIT_V(8); PG8_WAIT_L(0); PG8_BAR; PG8_MMA(1, 0, At, B0); PG8_MMA(1, 1, At, B1); PG8_BAR; PG8_SCHED;
            } else {
            PG8_LDB(B0, 0, 0); PG8_SCHED; PG8_LDA(At, 0, 0); PG8_STAGE(PG8_SA(1, 1), a1 + hstepA, voffA);
            PG8_WAIT_L(8); PG8_BAR; PG8_WAIT_L(0); PG8_MMA(0, 0, At, B0); PG8_BAR; PG8_SCHED;
            PG8_LDB(B1, 0, 1); PG8_STAGE(PG8_SB(0, 0), b2, voffB);
            PG8_BAR; PG8_WAIT_L(0); PG8_MMA(0, 1, At, B1); PG8_BAR;
            PG8_LDA(At, 0, 1); PG8_STAGE(PG8_SA(0, 0), a2, voffA);
            PG8_BAR; PG8_WAIT_L(0); PG8_MMA(1, 0, At, B0); PG8_BAR; PG8_SCHED;
            PG8_STAGE(PG8_SB(0, 1), b2 + hstepB, voffB);
            PG8_WAIT_V(6); PG8_BAR; PG8_MMA(1, 1, At, B1); PG8_BAR;
            PG8_LDB(B0, 1, 0); PG8_SCHED; PG8_LDA(At, 1, 0); PG8_STAGE(PG8_SA(0, 1), a2 + hstepA, voffA);
            PG8_WAIT_L(8); PG8_BAR; PG8_WAIT_L(0); PG8_MMA(0, 0, At, B0); PG8_BAR; PG8_SCHED;
            PG8_LDB(B1, 1, 1); PG8_STAGE(PG8_SB(1, 0), b3, voffB);
            PG8_BAR; PG8_WAIT_L(0); PG8_MMA(0, 1, At, B1); PG8_BAR;
            PG8_LDA(At, 1, 1); PG8_STAGE(PG8_SA(1, 0), a3, voffA);
            PG8_BAR; PG8_WAIT_L(0); PG8_MMA(1, 0, At, B0); PG8_BAR; PG8_SCHED;
            PG8_STAGE(PG8_SB(1, 1), b3 + hstepB, voffB);
            PG8_WAIT_V(6); PG8_BAR; PG8_MMA(1, 1, At, B1); PG8_BAR;
            }
        }
        if constexpr (ALIGN_EPI) { if (wr == 0) PG8_BAR; }
        if constexpr (!Epi::AFTER_DRAIN) { E(acc, cur, wr, wc, fr, fq); S.done(cur); }
        if (!has_next) break;
#pragma unroll
        for (int a = 0; a < 2; ++a)
#pragma unroll
            for (int b = 0; b < 2; ++b)
#pragma unroll
                for (int m = 0; m < 4; ++m)
#pragma unroll
                    for (int n = 0; n < 2; ++n) acc[a][b][m][n] = (f32x4){0.f, 0.f, 0.f, 0.f};
        cur = nxt; cA = nA; cB = nB; ++ui;
        if constexpr (ALIGN_EPI) { if (wr == 1) PG8_BAR; }
    }
    PG8_WAIT_V(0);
    if constexpr (!ALIGN_EPI) { if (wr == 0) PG8_BAR; }
    PG8_BAR;
    if constexpr (Epi::AFTER_DRAIN) { E.fused(acc, cur, wr, wc, fr, fq, lds, wid, lane); S.done(cur); }
#undef PG8_SA
#undef PG8_SB
#undef PG8_STAGE
#undef PG8_LDA
#undef PG8_LDB
#undef PG8_MMA
#undef PG8_WAIT_V
#undef PG8_WAIT_L
#undef PG8_BAR
#undef PG8_SCHED
}
}

namespace attn {
using bf16 = unsigned short;
constexpr int   D = 128, NW = 8, QBLK = 32, KVBLK = 64;
constexpr float SCALE = 0.088388347648318440f;
constexpr float THR = 8.f;
constexpr int SDEPTH = 2;
constexpr int LDQ = P0W, LDK = P0W, LDO = 2048;
constexpr size_t SHM_V = KVBLK * D * 2, SHM_K = KVBLK * D * 2, SHM_ATTN = 3 * SHM_V + 2 * SHM_K + NW * 64 * 4;
using bf16x8 = __attribute__((ext_vector_type(8))) short;
using s16x4  = __attribute__((ext_vector_type(4))) short;
using f32x16 = __attribute__((ext_vector_type(16))) float;
using f32x8  = __attribute__((ext_vector_type(8))) float;
using u32x4  = __attribute__((ext_vector_type(4))) unsigned;
#define KSWZ(row, colB) ((row) * 256 + ((colB) ^ (((row) & 7) << 4)))
#define SBAR() __builtin_amdgcn_sched_barrier(0)
__device__ __forceinline__ int crow(int r, int hi) { return (r & 3) + 8 * (r >> 2) + 4 * hi; }
__device__ __forceinline__ unsigned cvtpk(float lo, float hi) {
  unsigned r; asm volatile("v_cvt_pk_bf16_f32 %0, %1, %2" : "=v"(r) : "v"(lo), "v"(hi)); return r;
}
template <typename TIn> struct Stage;
template <> struct Stage<bf16>  { using T = bf16x8;
  __device__ static __forceinline__ T ld8(const bf16* p) { return *reinterpret_cast<const bf16x8*>(p); }
  __device__ static __forceinline__ bf16x8 tobf(T x) { return x; } };
template <> struct Stage<float> { using T = f32x8;
  __device__ static __forceinline__ T ld8(const float* p) { return *reinterpret_cast<const f32x8*>(p); }
  __device__ static __forceinline__ bf16x8 tobf(T x) {
    u32x4 w = {cvtpk(x[0], x[1]), cvtpk(x[2], x[3]), cvtpk(x[4], x[5]), cvtpk(x[6], x[7])}; return *reinterpret_cast<bf16x8*>(&w); } };

template <bool NOMAX> __device__ __forceinline__ void partialSM(f32x16& p0, f32x16& p1, float& m_reg, float& mn, float& alpha) {
  if constexpr (NOMAX) { for (int r = 0; r < 16; ++r) p0[r] = __builtin_amdgcn_exp2f(p0[r]); alpha = 1.f; return; }
  constexpr float C = SCALE * 1.4426950408889634f;
  float pmax = p0[0]; for (int r = 1; r < 16; ++r) pmax = fmaxf(pmax, p0[r]); for (int r = 0; r < 16; ++r) pmax = fmaxf(pmax, p1[r]);
  { auto rr = __builtin_amdgcn_permlane32_swap(__float_as_uint(pmax), __float_as_uint(pmax), false, false);
    pmax = fmaxf(__uint_as_float(rr[0]), __uint_as_float(rr[1])); }
  if (__builtin_expect(__all(pmax - m_reg <= THR / SCALE), 1)) { mn = m_reg; alpha = 1.f; }
  else { mn = fmaxf(m_reg, pmax); alpha = __builtin_amdgcn_exp2f((m_reg - mn) * C); m_reg = mn; }
  float mnC = -mn * C;
  for (int r = 0; r < 16; ++r) p0[r] = fmaf(p0[r], C, mnC); for (int r = 0; r < 16; ++r) p1[r] = fmaf(p1[r], C, mnC);
  for (int r = 0; r < 16; ++r) p0[r] = __builtin_amdgcn_exp2f(p0[r]);
}
__device__ __forceinline__ void finishSM(f32x16& p0, f32x16& p1, float alpha, float& l_reg, bf16x8& pa0, bf16x8& pa1, bf16x8& pa2, bf16x8& pa3) {
  for (int r = 0; r < 16; ++r) p1[r] = __builtin_amdgcn_exp2f(p1[r]);
  float ps = 0; for (int r = 0; r < 16; ++r) ps += p0[r]; for (int r = 0; r < 16; ++r) ps += p1[r];
  { auto rr = __builtin_amdgcn_permlane32_swap(__float_as_uint(ps), __float_as_uint(ps), false, false);
    ps = __uint_as_float(rr[0]) + __uint_as_float(rr[1]); }
  l_reg = l_reg * alpha + ps;
#define PK4(P, BASE, OUT) do { unsigned a0 = cvtpk(P[BASE + 0], P[BASE + 1]), a1 = cvtpk(P[BASE + 2], P[BASE + 3]);   \
    unsigned b0 = cvtpk(P[BASE + 4], P[BASE + 5]), b1 = cvtpk(P[BASE + 6], P[BASE + 7]);                              \
    auto r0 = __builtin_amdgcn_permlane32_swap(a0, b0, false, false); auto r1 = __builtin_amdgcn_permlane32_swap(a1, b1, false, false); \
    u32x4 w = {r0[0], r1[0], r0[1], r1[1]}; OUT = *reinterpret_cast<bf16x8*>(&w); } while (0)
  PK4(p0, 0, pa0); PK4(p0, 8, pa1); PK4(p1, 0, pa2); PK4(p1, 8, pa3);
#undef PK4
}
__device__ __forceinline__ void qkt(f32x16& p0, f32x16& p1, const bf16* Ks, const bf16x8* qr, int r32, int hi) {
  p0 = f32x16{}; p1 = f32x16{};
  for (int d0 = 0; d0 < 8; ++d0) { int cb = (d0 * 16 + hi * 8) * 2;
    bf16x8 b0 = *reinterpret_cast<const bf16x8*>((const char*)Ks + KSWZ(r32, cb));
    bf16x8 b1 = *reinterpret_cast<const bf16x8*>((const char*)Ks + KSWZ(32 + r32, cb));
    p0 = __builtin_amdgcn_mfma_f32_32x32x16_bf16(b0, qr[d0], p0, 0, 0, 0);
    p1 = __builtin_amdgcn_mfma_f32_32x32x16_bf16(b1, qr[d0], p1, 0, 0, 0); }
}
__device__ __forceinline__ int v_st(int k, int c) { const int kk = (k & ~0xC) | ((k & 4) << 1) | ((k & 8) >> 1); return ((kk >> 3) * 4 + (c >> 5)) * 512 + ((kk & 7) * 32 + (c & 31)) * 2; }
__device__ __forceinline__ int v_rd_base(int lane) { return ((lane & 3) << 3) | (((lane >> 2) & 3) << 6) | (((lane >> 4) & 1) << 5) | (((lane >> 5) & 1) << 8); }
constexpr int v_rd_off(int d0, int ks, int half) { return d0 * 512 + ks * 4096 + half * 2048; }
template <int OFF> __device__ __forceinline__ s16x4 tr_read(int vb) {
  s16x4 r; asm volatile("ds_read_b64_tr_b16 %0, %1 offset:%2" : "=&v"(r) : "v"(vb), "i"(OFF) : "memory"); return r;
}
template <int D0> __device__ __forceinline__ void pv_one(f32x16& od, int vb, bf16x8 pa0, bf16x8 pa1, bf16x8 pa2, bf16x8 pa3) {
  const s16x4 l0 = tr_read<v_rd_off(D0, 0, 0)>(vb), h0 = tr_read<v_rd_off(D0, 0, 1)>(vb), l1 = tr_read<v_rd_off(D0, 1, 0)>(vb), h1 = tr_read<v_rd_off(D0, 1, 1)>(vb);
  const s16x4 l2 = tr_read<v_rd_off(D0, 2, 0)>(vb), h2 = tr_read<v_rd_off(D0, 2, 1)>(vb), l3 = tr_read<v_rd_off(D0, 3, 0)>(vb), h3 = tr_read<v_rd_off(D0, 3, 1)>(vb);
  asm volatile("s_waitcnt lgkmcnt(0)" ::: "memory"); SBAR();
#define PK(L, H) (bf16x8){L[0], L[1], L[2], L[3], H[0], H[1], H[2], H[3]}
  od = __builtin_amdgcn_mfma_f32_32x32x16_bf16(pa0, PK(l0, h0), od, 0, 0, 0);
  od = __builtin_amdgcn_mfma_f32_32x32x16_bf16(pa1, PK(l1, h1), od, 0, 0, 0);
  od = __builtin_amdgcn_mfma_f32_32x32x16_bf16(pa2, PK(l2, h2), od, 0, 0, 0);
  od = __builtin_amdgcn_mfma_f32_32x32x16_bf16(pa3, PK(l3, h3), od, 0, 0, 0);
#undef PK
}
__device__ __forceinline__ void pv_d0(f32x16* o, int vb, bf16x8 pa0, bf16x8 pa1, bf16x8 pa2, bf16x8 pa3) {
  pv_one<0>(o[0], vb, pa0, pa1, pa2, pa3); pv_one<1>(o[1], vb, pa0, pa1, pa2, pa3); pv_one<2>(o[2], vb, pa0, pa1, pa2, pa3); pv_one<3>(o[3], vb, pa0, pa1, pa2, pa3);
}

template <typename TQ, bool NOMAX>
__device__ __forceinline__ void attn_dense_body(const TQ* __restrict__ Qb, const bf16* __restrict__ Kh, const bf16* __restrict__ Vh,
                                                bf16* __restrict__ Ob, int seq, char* lds) {
  using St = Stage<bf16>; using SQ = Stage<TQ>;
  int tid_ = threadIdx.x; asm volatile("" : "+v"(tid_));
  const int tid = tid_, wid = tid >> 6, lane = tid & 63, r32 = lane & 31, hi = lane >> 5;
  bf16* V_lds = (bf16*)lds; bf16* K_lds = (bf16*)(lds + 3 * SHM_V);
  float* ws = (float*)(lds + 3 * SHM_V + 2 * SHM_K) + wid * 64; float* li_l = ws; float* al_l = ws + 32;
  float m_reg = -1e30f, l_reg = 0; f32x16 o[4] = {}; bf16x8 qr[8];
  const TQ* Qw = Qb + (long)(wid * QBLK + r32) * LDQ + hi * 8;
#pragma unroll
  for (int d0 = 0; d0 < 8; ++d0) { qr[d0] = SQ::tobf(SQ::ld8(Qw + d0 * 16));
    if constexpr (NOMAX) { constexpr float C = SCALE * 1.4426950408889634f; u32x4 w = *reinterpret_cast<u32x4*>(&qr[d0]);
      for (int i = 0; i < 4; ++i) w[i] = cvtpk(__uint_as_float(w[i] << 16) * C, __uint_as_float(w[i] & 0xffff0000u) * C);
      qr[d0] = *reinterpret_cast<bf16x8*>(&w); } }
  const int sr = tid >> 4, sc = (tid & 15) * 8, vst0 = v_st(sr, sc), vst1 = v_st(32 + sr, sc);
  const int vb0 = (int)(uintptr_t)V_lds + v_rd_base(lane);
  struct { typename St::T vs0, vs1, ks0, ks1; } sr_[SDEPTH];
#define SLOAD(i, k0) do { sr_[i].vs0 = St::ld8(&Vh[(long)((k0) + sr) * LDK + sc]); sr_[i].vs1 = St::ld8(&Vh[(long)((k0) + 32 + sr) * LDK + sc]); \
    sr_[i].ks0 = St::ld8(&Kh[(long)((k0) + sr) * LDK + sc]); sr_[i].ks1 = St::ld8(&Kh[(long)((k0) + 32 + sr) * LDK + sc]); } while (0)
#define SWRITE(b, voff, i) do { *(bf16x8*)((char*)V_lds + (voff) + vst0) = St::tobf(sr_[i].vs0);          \
    *(bf16x8*)((char*)V_lds + (voff) + vst1) = St::tobf(sr_[i].vs1); int kc = sc * 2;               \
    *(bf16x8*)((char*)K_lds + (b) * SHM_K + KSWZ(sr, kc)) = St::tobf(sr_[i].ks0);                       \
    *(bf16x8*)((char*)K_lds + (b) * SHM_K + KSWZ(32 + sr, kc)) = St::tobf(sr_[i].ks1); } while (0)
#define SWAIT() do { if constexpr (SDEPTH == 2) asm volatile("s_waitcnt vmcnt(4)" ::: "memory"); else asm volatile("s_waitcnt vmcnt(0)" ::: "memory"); } while (0)
#define RESC(a) do { if (!NOMAX && __any((a) < 1.f)) { if (hi == 0) al_l[r32] = (a); asm volatile("s_waitcnt lgkmcnt(0)" ::: "memory"); \
    for (int d = 0; d < 4; ++d) for (int r = 0; r < 16; ++r) o[d][r] *= al_l[crow(r, hi)]; } } while (0)
  f32x16 pA0, pA1, pB0, pB1; float mnA, mnB, alA, alB; bf16x8 pa0, pa1, pa2, pa3; const int NT = seq / KVBLK;
  constexpr int SE = 0, SO = SDEPTH - 1;
  SLOAD(SE, 0); asm volatile("s_waitcnt vmcnt(0)" ::: "memory"); SWRITE(0, 0, SE); __syncthreads();
  qkt(pA0, pA1, K_lds, qr, r32, hi); partialSM<NOMAX>(pA0, pA1, m_reg, mnA, alA);
  SLOAD(SO, KVBLK); if constexpr (SDEPTH == 2) { if (2 < NT) SLOAD(SE, 2 * KVBLK); }
  SWAIT(); SWRITE(1, (int)SHM_V, SO); __syncthreads();
  int vr = 0, vw = 2 * (int)SHM_V;
#define VNEXT(x) ((x) == 2 * (int)SHM_V ? 0 : (x) + (int)SHM_V)
  for (int j = 1; j + 1 < NT; j += 2) {
    SBAR(); qkt(pB0, pB1, (bf16*)((char*)K_lds + SHM_K), qr, r32, hi);
    finishSM(pA0, pA1, alA, l_reg, pa0, pa1, pa2, pa3); SBAR();
    SLOAD(SO, (j + SDEPTH) * KVBLK); SBAR();
    pv_d0(o, vb0 + vr, pa0, pa1, pa2, pa3); partialSM<NOMAX>(pB0, pB1, m_reg, mnB, alB);
    SWAIT(); SWRITE(0, vw, SE); vr = VNEXT(vr); vw = VNEXT(vw);
    RESC(alB); __syncthreads();
    SBAR(); qkt(pA0, pA1, K_lds, qr, r32, hi);
    finishSM(pB0, pB1, alB, l_reg, pa0, pa1, pa2, pa3); SBAR();
    if (SDEPTH == 1 || j + 3 < NT) SLOAD(SE, (j + 1 + SDEPTH) * KVBLK); SBAR();
    pv_d0(o, vb0 + vr, pa0, pa1, pa2, pa3); partialSM<NOMAX>(pA0, pA1, m_reg, mnA, alA);
    SWAIT(); SWRITE(1, vw, SO); vr = VNEXT(vr); vw = VNEXT(vw);
    RESC(alA); __syncthreads();
  }
  SBAR(); qkt(pB0, pB1, (bf16*)((char*)K_lds + SHM_K), qr, r32, hi);
  finishSM(pA0, pA1, alA, l_reg, pa0, pa1, pa2, pa3); SBAR();
  pv_d0(o, vb0 + vr, pa0, pa1, pa2, pa3); partialSM<NOMAX>(pB0, pB1, m_reg, mnB, alB);
  vr = VNEXT(vr); RESC(alB);
  finishSM(pB0, pB1, alB, l_reg, pa0, pa1, pa2, pa3); SBAR();
  pv_d0(o, vb0 + vr, pa0, pa1, pa2, pa3);
#undef VNEXT
  if (hi == 0) li_l[r32] = l_reg; asm volatile("s_waitcnt lgkmcnt(0)" ::: "memory");
  float rli[16];
#pragma unroll
  for (int r = 0; r < 16; ++r) rli[r] = __builtin_amdgcn_rcpf(li_l[crow(r, hi)]);
  bf16* Ow = Ob + (long)(wid * QBLK) * LDO;
#pragma unroll
  for (int r = 0; r < 16; ++r) { int orow = crow(r, hi);
    for (int d0 = 0; d0 < 4; ++d0) Ow[(long)orow * LDO + d0 * 32 + r32] = (bf16)(cvtpk(o[d0][r] * rli[r], 0.f) & 0xffffu); }
#undef SLOAD
#undef SWRITE
#undef SWAIT
#undef RESC
}
#undef KSWZ
#undef SBAR
}

namespace rw {
typedef short bf16x8 __attribute__((ext_vector_type(8)));
typedef float f32x4 __attribute__((ext_vector_type(4)));
typedef unsigned u32x4 __attribute__((ext_vector_type(4)));
typedef unsigned u32x2 __attribute__((ext_vector_type(2)));
constexpr int CH = 32, NC = R / CH;
static_assert(NC % 2 == 0, "the prep loop is unrolled by two");
constexpr int BUFB = 5 * 8192 + 1024;
constexpr int O_W = 0, O_B = 8192, O_KD = 16384, O_A = 24576, O_R = 32768, O_V = 40960;
constexpr int PITCH = 72;
constexpr int L_SCR = 2 * BUFB, SCRB = 2 * 16 * PITCH * 2;
constexpr int L_W2T = L_SCR + 4 * SCRB, L_A2T = L_W2T + 64 * PITCH * 2;
constexpr int L_Y = L_A2T + 64 * PITCH * 2;
constexpr int L_CST = L_Y + 2 * 2 * CH * 64 * 4;
constexpr int L_END = L_CST + 10 * 64 * 4;
static_assert(L_END <= 163840 - 64 && (BUFB % 16) == 0 && (L_SCR % 16) == 0 && (SCRB % 16) == 0 && (L_W2T % 16) == 0 && (L_A2T % 16) == 0 && (L_Y % 16) == 0 && (L_CST % 16) == 0, "rwkv LDS map");
constexpr size_t WS_BON = 38 * MiB;

template <int CTRL> __device__ __forceinline__ float dppmov(float x) { return __builtin_bit_cast(float, __builtin_amdgcn_update_dpp(0, __builtin_bit_cast(int, x), CTRL, 0xF, 0xF, true)); }
__device__ __forceinline__ float allreduce8(float x) {
    x += dppmov<0xB1>(x);
    x += dppmov<0x4E>(x);
    x += dppmov<0x141>(x);
    return x;
}
__device__ __forceinline__ float allreduce16(float x) { x = allreduce8(x); x += dppmov<0x140>(x); return x; }
__device__ __forceinline__ float fast_tanh(float x) { const float e = __builtin_amdgcn_exp2f(2.885390081777927f * x); return 1.0f - 2.0f * __builtin_amdgcn_rcpf(1.0f + e); }
__device__ __forceinline__ float bflo(unsigned u) { return __uint_as_float(u << 16); }
__device__ __forceinline__ float bfhi(unsigned u) { return __uint_as_float(u & 0xffff0000u); }
__device__ __forceinline__ unsigned pkbf(float lo, float hi) { unsigned r; asm volatile("v_cvt_pk_bf16_f32 %0, %1, %2" : "=v"(r) : "v"(lo), "v"(hi)); return r; }

constexpr int SEGR = 128, NSEG = R / SEGR, NCG = (ZW + 511) / 512;
constexpr size_t WS_HALO = 40 * MiB;
static_assert(WS_HALO + (size_t)NSEG * 2 * ZW * 2 <= WS_XN, "halo rows overflow");
__device__ __forceinline__ void shift_halo(const Params& p) {
    int tid_ = threadIdx.x; asm volatile("" : "+v"(tid_));
    const bf16_t* Z = ws_big(p); bf16_t* H = (bf16_t*)(p.ws + WS_HALO);
    for (int it = (int)blockIdx.x * NTHR + tid_; it < NSEG * 2 * (ZW / 8); it += (int)gridDim.x * NTHR) {
        const int c8 = it % (ZW / 8), w = (it / (ZW / 8)) & 1, seg = it / (2 * (ZW / 8));
        *(u32x4*)(H + ((size_t)seg * 2 + w) * ZW + c8 * 8) = *(const u32x4*)(Z + (size_t)(seg * SEGR + (w ? SEGR - 1 : 0)) * ZW + c8 * 8);
    }
}
__device__ __forceinline__ u32x4 shift8(u32x4 c, u32x4 pv, u32x4 nx, f32x4 m0, f32x4 m1) {
    u32x4 o;
#pragma unroll
    for (int q = 0; q < 4; ++q) { const float ml = q < 2 ? m0[2 * q] : m1[2 * q - 4], mh = q < 2 ? m0[2 * q + 1] : m1[2 * q - 3];
        const float zl = bflo(c[q]), zh = bfhi(c[q]);
        o[q] = pkbf(zl + (0.5f * (bflo(pv[q]) + bflo(nx[q])) - zl) * ml, zh + (0.5f * (bfhi(pv[q]) + bfhi(nx[q])) - zh) * mh); }
    return o;
}
__device__ __forceinline__ void shift_inplace(const Params& p) {
    int tid_ = threadIdx.x; asm volatile("" : "+v"(tid_));
    const int lane = tid_ & 63, gw = (int)blockIdx.x * NWAVES + (tid_ >> 6), ngw = (int)gridDim.x * NWAVES;
    bf16_t* Z = ws_big(p); const bf16_t* H = (const bf16_t*)(p.ws + WS_HALO);
    for (int u = gw; u < NSEG * NCG; u += ngw) {
        const int seg = u / NCG, col = (u % NCG) * 512 + lane * 8;
        if (col < ZW) {
            const f32x4 m0 = *(const f32x4*)(p.mu + col), m1 = *(const f32x4*)(p.mu + col + 4);
            const bool first = seg == 0 || seg == CTXN / SEGR, last = seg == CTXN / SEGR - 1 || seg == NSEG - 1;
            bf16_t* zr = Z + (size_t)seg * SEGR * ZW + col;
            u32x4 pv = first ? (u32x4){0u, 0u, 0u, 0u} : *(const u32x4*)(H + ((size_t)(seg - 1) * 2 + 1) * ZW + col);
            const u32x4 tail = last ? (u32x4){0u, 0u, 0u, 0u} : *(const u32x4*)(H + ((size_t)(seg + 1) * 2) * ZW + col);
            u32x4 c0 = *(const u32x4*)zr, c1 = *(const u32x4*)(zr + ZW), c2 = *(const u32x4*)(zr + 2 * ZW), c3 = *(const u32x4*)(zr + 3 * ZW);
            for (int r = 0; r < SEGR; r += 4) {
                u32x4 n0 = tail, n1 = tail, n2 = tail, n3 = tail;
                if (r + 4 < SEGR) { n0 = *(const u32x4*)(zr + (size_t)(r + 4) * ZW); n1 = *(const u32x4*)(zr + (size_t)(r + 5) * ZW); n2 = *(const u32x4*)(zr + (size_t)(r + 6) * ZW); n3 = *(const u32x4*)(zr + (size_t)(r + 7) * ZW); }
                const u32x4 o0 = shift8(c0, pv, c1, m0, m1), o1 = shift8(c1, c0, c2, m0, m1), o2 = shift8(c2, c1, c3, m0, m1), o3 = shift8(c3, c2, n0, m0, m1);
                *(u32x4*)(zr + (size_t)r * ZW) = o0; *(u32x4*)(zr + (size_t)(r + 1) * ZW) = o1; *(u32x4*)(zr + (size_t)(r + 2) * ZW) = o2; *(u32x4*)(zr + (size_t)(r + 3) * ZW) = o3;
                pv = c3; c0 = n0; c1 = n1; c2 = n2; c3 = n3;
            }
        }
    }
}

struct Raw { u32x4 c[5]; };

template <int MODE> __device__ __forceinline__ void scan_block(const Params& p, int blk, LAS unsigned char* lds) {
    int tid_ = threadIdx.x; asm volatile("" : "+v"(tid_));
    const int tid = tid_, lane = tid & 63, wave = __builtin_amdgcn_readfirstlane(tid >> 6);
    const int dir = blk >> 7, h = (blk >> 3) & 15, eighth = blk & 7;
    const float* w0 = dir ? p.w0b : p.w0f; const float* w2 = dir ? p.w2b : p.w2f; const float* a0 = dir ? p.a0b : p.a0f; const float* a2 = dir ? p.a2b : p.a2f;
    const bf16_t* Z = ws_big(p); bf16_t* BR = ws_br(p); float* bon = (float*)(p.ws + WS_BON) + ((size_t)dir * 16 + h) * SEQ;
    { const int m = tid >> 3, j8 = (tid & 7) * 8;
      const f32x4 wa = *(const f32x4*)(w2 + (size_t)m * 1024 + h * 64 + j8), wb = *(const f32x4*)(w2 + (size_t)m * 1024 + h * 64 + j8 + 4);
      const f32x4 aa = *(const f32x4*)(a2 + (size_t)m * 1024 + h * 64 + j8), ab = *(const f32x4*)(a2 + (size_t)m * 1024 + h * 64 + j8 + 4);
      LAS bf16_t* yw = (LAS bf16_t*)(lds + L_W2T); LAS bf16_t* ya = (LAS bf16_t*)(lds + L_A2T);
#pragma unroll
      for (int q = 0; q < 4; ++q) { yw[(j8 + q) * PITCH + m] = f2bf(wa[q]); yw[(j8 + 4 + q) * PITCH + m] = f2bf(wb[q]); ya[(j8 + q) * PITCH + m] = f2bf(aa[q]); ya[(j8 + 4 + q) * PITCH + m] = f2bf(ab[q]); }
      for (int i = tid; i < 4 * SCRB / 4; i += NTHR) *(LAS unsigned*)(lds + L_SCR + i * 4) = 0u;
      for (int i = tid; i < 640; i += NTHR) { const int g = i >> 6, cc = i & 63, hc = h * 64 + cc; float v;
          if (g < 3) v = p.mu[g * 1024 + hc]; else if (g == 3) v = p.mu[3072 + dir * 64 + cc]; else if (g == 4) v = p.mu[3200 + dir * 64 + cc];
          else if (g == 5) v = w0[hc]; else if (g == 6) v = a0[hc]; else if (g == 7) v = p.k_k[hc]; else if (g == 8) v = p.k_a[hc]; else v = p.r_k[hc];
          *(LAS float*)(lds + L_CST + i * 4) = v; } }
    __syncthreads();
    if ((wave & 2) != 0) {
        const int pw = (wave & 1) + ((wave >> 2) << 1), tq = lane >> 3, c8 = (lane & 7) * 8, hj = h * 64 + c8, tslot = pw * 8 + tq;
        const int gcol[5] = {hj, 1024 + hj, 2048 + hj, 3072 + dir * 64 + c8, 3200 + dir * 64 + c8};
        LAS unsigned char* scr = lds + L_SCR + pw * SCRB;
#define RW_CST(g, hh) (*(LAS f32x4*)(lds + L_CST + ((g) * 64 + c8 + 4 * (hh)) * 4))
#define RW_LOADRAW(raw, cc) do { const bf16_t* zr_ = Z + (size_t)rw_row(dir, (cc) * CH + tslot) * ZW; \
            _Pragma("unroll") for (int g = 0; g < 5; ++g) raw.c[g] = *(const u32x4*)(zr_ + gcol[g]); } while (0)
        Raw rawA, rawB;
        f32x4 cw0[2], ca0[2], ckk[2], cka[2], crk[2];
#pragma unroll
        for (int hh = 0; hh < 2; ++hh) { cw0[hh] = RW_CST(5, hh); ca0[hh] = RW_CST(6, hh); ckk[hh] = RW_CST(7, hh); cka[hh] = RW_CST(8, hh); crk[hh] = RW_CST(9, hh);
            asm volatile("" : "+v"(cw0[hh]), "+v"(ca0[hh]), "+v"(ckk[hh]), "+v"(cka[hh]), "+v"(crk[hh])); }
        if (MODE == 0 || MODE == 2 || MODE == 3 || MODE == 9) { RW_LOADRAW(rawA, 0); RW_LOADRAW(rawB, 1); }
#define RW_PREP_ITER(RAWSET, cc_) do { \
            if (MODE == 0 || MODE == 2 || MODE == 3 || MODE == 9) { \
            const int cn = (cc_) + 1; LAS unsigned char* buf = lds + (cn & 1) * BUFB; const int p0 = cn * CH; const bool latent = p0 >= CTXN; \
            f32x4 rr[2], kv[2]; \
            { const u32x4 u = RAWSET.c[0]; rr[0] = (f32x4){bflo(u.x), bfhi(u.x), bflo(u.y), bfhi(u.y)}; rr[1] = (f32x4){bflo(u.z), bfhi(u.z), bflo(u.w), bfhi(u.w)}; \
              *(LAS f32x4*)(buf + O_R + (tslot * 64 + c8) * 4) = rr[0]; *(LAS f32x4*)(buf + O_R + (tslot * 64 + c8) * 4 + 16) = rr[1]; } \
            { const u32x4 u = RAWSET.c[1]; kv[0] = (f32x4){bflo(u.x), bfhi(u.x), bflo(u.y), bfhi(u.y)}; kv[1] = (f32x4){bflo(u.z), bfhi(u.z), bflo(u.w), bfhi(u.w)}; } \
            if ((lane & 7) == eighth) { const u32x4 u = RAWSET.c[2]; *(LAS f32x4*)(buf + O_V + tslot * 32) = (f32x4){bflo(u.x), bfhi(u.x), bflo(u.y), bfhi(u.y)}; *(LAS f32x4*)(buf + O_V + tslot * 32 + 16) = (f32x4){bflo(u.z), bfhi(u.z), bflo(u.w), bfhi(u.w)}; } \
            { const u32x4 u = RAWSET.c[3]; u32x4 o; \
              o.x = pkbf(fast_tanh(bflo(u.x)), fast_tanh(bfhi(u.x))); o.y = pkbf(fast_tanh(bflo(u.y)), fast_tanh(bfhi(u.y))); o.z = pkbf(fast_tanh(bflo(u.z)), fast_tanh(bfhi(u.z))); o.w = pkbf(fast_tanh(bflo(u.w)), fast_tanh(bfhi(u.w))); \
              *(LAS u32x4*)(scr + (tq * PITCH + c8) * 2) = o; *(LAS u32x4*)(scr + 16 * PITCH * 2 + (tq * PITCH + c8) * 2) = RAWSET.c[4]; } \
            if (cn + 2 < NC) RW_LOADRAW(RAWSET, cn + 2);              \
            asm volatile("s_waitcnt lgkmcnt(0)" ::: "memory"); \
            { const int r16 = lane & 15, quad = lane >> 4; f32x4 acc[2][4]; \
_Pragma("unroll") \
              for (int lora = 0; lora < 2; ++lora) { \
                  LAS unsigned char* X = scr + lora * 16 * PITCH * 2 + (r16 * PITCH + quad * 8) * 2; \
                  const bf16x8 x0 = *(LAS bf16x8*)X, x1 = *(LAS bf16x8*)(X + 64); \
_Pragma("unroll") \
                  for (int jt = 0; jt < 4; ++jt) { \
                      LAS unsigned char* Y = lds + (lora ? L_A2T : L_W2T) + ((jt * 16 + r16) * PITCH + quad * 8) * 2; \
                      acc[lora][jt] = (f32x4){0.f, 0.f, 0.f, 0.f}; \
                      acc[lora][jt] = __builtin_amdgcn_mfma_f32_16x16x32_bf16(x0, *(LAS bf16x8*)Y, acc[lora][jt], 0, 0, 0); \
                      acc[lora][jt] = __builtin_amdgcn_mfma_f32_16x16x32_bf16(x1, *(LAS bf16x8*)(Y + 64), acc[lora][jt], 0, 0, 0); } } \
              if (quad < 2) { \
_Pragma("unroll") \
                  for (int lora = 0; lora < 2; ++lora) \
_Pragma("unroll") \
                      for (int jt = 0; jt < 4; ++jt) \
_Pragma("unroll") \
                          for (int r = 0; r < 4; ++r) *(LAS float*)(buf + (lora ? O_B : O_W) + ((pw * 8 + quad * 4 + r) * 64 + jt * 16 + r16) * 4) = acc[lora][jt][r]; } } \
            asm volatile("s_waitcnt lgkmcnt(0)" ::: "memory"); \
            { float bs = 0.f, nn = 0.f; f32x4 kk[2], al[2]; \
_Pragma("unroll") \
              for (int hh = 0; hh < 2; ++hh) { const int off = (tslot * 64 + c8 + 4 * hh) * 4; \
                  const f32x4 aw = *(LAS f32x4*)(buf + O_W + off) + cw0[hh], aa = *(LAS f32x4*)(buf + O_B + off) + ca0[hh]; \
                  f32x4 wv; \
_Pragma("unroll") \
                  for (int q = 0; q < 4; ++q) { const float sg = __builtin_amdgcn_rcpf(1.0f + __builtin_amdgcn_exp2f(-1.4426950408889634f * aw[q])); \
                      wv[q] = __builtin_amdgcn_exp2f(-0.8750612633917f * sg); al[hh][q] = __builtin_amdgcn_rcpf(1.0f + __builtin_amdgcn_exp2f(-1.4426950408889634f * aa[q])); kk[hh][q] = kv[hh][q] * ckk[hh][q]; nn += kk[hh][q] * kk[hh][q]; } \
                  *(LAS f32x4*)(buf + O_W + off) = wv; } \
              nn = allreduce8(nn); \
              const float inv = __builtin_amdgcn_rsqf(fmaxf(nn, 1e-24f)); \
_Pragma("unroll") \
              for (int hh = 0; hh < 2; ++hh) { const int off = (tslot * 64 + c8 + 4 * hh) * 4; \
                  const f32x4 r = rr[hh]; \
                  f32x4 av, bv, kd; \
_Pragma("unroll") \
                  for (int q = 0; q < 4; ++q) { const float kn = kk[hh][q] * inv; av[q] = -kn; bv[q] = kn * al[hh][q]; kd[q] = kv[hh][q] * (1.0f + (al[hh][q] - 1.0f) * cka[hh][q]); bs += r[q] * kd[q] * crk[hh][q]; } \
                  *(LAS f32x4*)(buf + O_B + off) = bv; *(LAS f32x4*)(buf + O_KD + off) = kd; *(LAS f32x4*)(buf + O_A + off) = av; } \
              bs = allreduce8(bs); \
              if (MODE == 0 && latent && eighth == 0 && (lane & 7) == 0) bon[rw_row(dir, p0 + tslot) - CTXN] = bs; } \
            } \
            __syncthreads(); \
        } while (0)
        for (int c = -1; c < NC - 1; c += 2) { RW_PREP_ITER(rawA, c); RW_PREP_ITER(rawB, c + 1); }
#undef RW_PREP_ITER
#undef RW_LOADRAW
#undef RW_CST
    } else if (wave >= 4) {
        const int sw = wave - 4, et = lane >> 1, erp = lane & 1;
#define RW_EMIT(cc) do { if ((cc) * CH >= CTXN) { const LAS f32x4* yp = (const LAS f32x4*)(lds + L_Y + ((((cc) & 1) * 2 + sw) * 8192) + et * 256 + erp * 128); \
            f32x4 s0 = yp[0] + yp[1] + yp[2] + yp[3], s1 = yp[4] + yp[5] + yp[6] + yp[7]; \
            *(unsigned*)(BR + (size_t)rw_row(dir, (cc) * CH + et) * 2048 + dir * 1024 + h * 64 + eighth * 8 + sw * 4 + erp * 2) = pkbf((s0[0] + s0[1]) + (s0[2] + s0[3]), (s1[0] + s1[1]) + (s1[2] + s1[3])); } } while (0)
        __syncthreads();
        for (int c = 0; c < NC; ++c) { if (c >= 1) RW_EMIT(c - 1); if (c + 1 < NC) __syncthreads(); }
    } else {
        __builtin_amdgcn_s_setprio(0);
        typedef float f32x2 __attribute__((ext_vector_type(2)));
        f32x2 S01 = {0.f, 0.f}, S23 = {0.f, 0.f};
        const int srow = wave * 4 + (lane >> 4), sj = (lane & 15) * 4;
        __syncthreads();
        struct Ops { f32x4 a, w, b, k, r; float v; };
#define RW_LD(o, t) do { o.a = *(LAS f32x4*)(bp + O_A + (t) * 256); \
            if (MODE == 9) { o.w = o.a; o.b = o.a; o.k = o.a; o.r = o.a; o.v = o.a[0]; } else { o.w = *(LAS f32x4*)(bp + O_W + (t) * 256); o.b = *(LAS f32x4*)(bp + O_B + (t) * 256); \
            o.k = *(LAS f32x4*)(bp + O_KD + (t) * 256); o.r = *(LAS f32x4*)(bp + O_R + (t) * 256); o.v = *(LAS float*)(vp + (t) * 32); } } while (0)
#define RW_STEP(o, t) do { f32x2 pd = S01 * o.a.lo; pd = S23 * o.a.hi + pd; float sa = pd.x + pd.y; if (MODE != 5 && MODE != 7) sa = allreduce16(sa); \
            S01 = o.b.lo * sa + (S01 * o.w.lo + o.k.lo * o.v); S23 = o.b.hi * sa + (S23 * o.w.hi + o.k.hi * o.v); \
            { f32x2 py = S01 * o.r.lo; py = S23 * o.r.hi + py; *(LAS float*)(yb + (t) * 256) = py.x + py.y; } } while (0)
        for (int c = 0; c < NC; ++c) {
            LAS unsigned char* bp = lds + (c & 1) * BUFB + sj * 4; LAS unsigned char* vp = lds + (c & 1) * BUFB + O_V + srow * 4; LAS unsigned char* yb = lds + L_Y + ((c & 1) * 2 + wave) * 8192 + lane * 4;
            Ops A0, A1, A2, A3, B0, B1, B2, B3;
            if (MODE != 2) {
            RW_LD(A0, 0); RW_LD(A1, 1); RW_LD(A2, 2); RW_LD(A3, 3);
#pragma unroll
            for (int g = 0; g < CH / 8; ++g) {
                RW_LD(B0, 8 * g + 4); RW_LD(B1, 8 * g + 5); RW_LD(B2, 8 * g + 6); RW_LD(B3, 8 * g + 7);
                __builtin_amdgcn_sched_barrier(0);
                RW_STEP(A0, 8 * g); RW_STEP(A1, 8 * g + 1); RW_STEP(A2, 8 * g + 2); RW_STEP(A3, 8 * g + 3);
                __builtin_amdgcn_sched_barrier(0);
                if (g + 1 < CH / 8) { RW_LD(A0, 8 * g + 8); RW_LD(A1, 8 * g + 9); RW_LD(A2, 8 * g + 10); RW_LD(A3, 8 * g + 11); }
                __builtin_amdgcn_sched_barrier(0);
                RW_STEP(B0, 8 * g + 4); RW_STEP(B1, 8 * g + 5); RW_STEP(B2, 8 * g + 6); RW_STEP(B3, 8 * g + 7);
                __builtin_amdgcn_sched_barrier(0);
            }
            }
            if (c + 1 < NC) __syncthreads();
        }
#undef RW_LD
#undef RW_STEP
        if (MODE != 0) asm volatile("" :: "v"(S01), "v"(S23));
        __builtin_amdgcn_s_setprio(0);
    }
    __syncthreads();
    if (wave == 4 || wave == 5) { const int sw = wave - 4, et = lane >> 1, erp = lane & 1; RW_EMIT(NC - 1); }
#undef RW_EMIT
    __syncthreads();
}

__device__ __forceinline__ float wave_sum(float v) {
    v = allreduce16(v);
    { auto r = __builtin_amdgcn_permlane16_swap(__float_as_uint(v), __float_as_uint(v), false, false); v = __uint_as_float(r[0]) + __uint_as_float(r[1]); }
    { auto r = __builtin_amdgcn_permlane32_swap(__float_as_uint(v), __float_as_uint(v), false, false); v = __uint_as_float(r[0]) + __uint_as_float(r[1]); }
    return v;
}
__device__ __forceinline__ void finish_phase(const Params& p) {
    int tid_ = threadIdx.x; asm volatile("" : "+v"(tid_));
    const int lane = tid_ & 63, gw = (int)blockIdx.x * NWAVES + (tid_ >> 6), ngw = (int)gridDim.x * NWAVES;
    const bf16_t* Z = ws_big(p); bf16_t* BR = ws_br(p); const float* bon = (const float*)(p.ws + WS_BON);
    for (int it = gw; it < SEQ * 4; it += ngw) {
        const int t = it >> 2, h = (it & 3) * 4 + (lane >> 4), row = CTXN + t, col = h * 64 + (lane & 15) * 4;
        bf16_t* b = BR + (size_t)row * 2048;
        const u32x2 wf = *(const u32x2*)(b + col), wb = *(const u32x2*)(b + 1024 + col), zv = *(const u32x2*)(Z + (size_t)row * ZW + 2048 + col);
        const f32x4 x = {bflo(wf.x) + bflo(wb.x), bfhi(wf.x) + bfhi(wb.x), bflo(wf.y) + bflo(wb.y), bfhi(wf.y) + bfhi(wb.y)};
        const float mean = allreduce16((x[0] + x[1]) + (x[2] + x[3])) * (1.0f / 64.f);
        const f32x4 d = x - mean;
        const float var = allreduce16((d[0] * d[0] + d[1] * d[1]) + (d[2] * d[2] + d[3] * d[3])) * (1.0f / 64.f);
        const float rstd = __builtin_amdgcn_rsqf(var + GN_EPS), bsum = bon[(size_t)h * SEQ + t] + bon[((size_t)16 + h) * SEQ + t];
        const f32x4 g = *(const f32x4*)(p.lnx_g + col), bb = *(const f32x4*)(p.lnx_b + col), v = {bflo(zv.x), bfhi(zv.x), bflo(zv.y), bfhi(zv.y)};
        const f32x4 y = d * rstd * g + bb + v * bsum;
        u32x2 o; o.x = pkbf(y[0], y[1]); o.y = pkbf(y[2], y[3]);
        *(u32x2*)(b + 1024 + col) = o;
    }
}
}

namespace wy {
typedef short bf16x4 __attribute__((ext_vector_type(4)));
using rw::f32x4; using rw::u32x4; using rw::u32x2; using rw::bf16x8; using rw::bflo; using rw::bfhi; using rw::PITCH;
typedef float f32x2_t __attribute__((ext_vector_type(2)));
typedef __bf16 bf2_t __attribute__((ext_vector_type(2)));
__device__ __forceinline__ unsigned pkbf(float lo, float hi) { const f32x2_t v = {lo, hi}; return __builtin_bit_cast(unsigned, __builtin_convertvector(v, bf2_t)); }
typedef GAS unsigned gu32;
#define WY_RLX __ATOMIC_RELAXED, __HIP_MEMORY_SCOPE_AGENT
constexpr int NJOB = R / 64, NCHUNK = R / 16, NSLOT = 8, ATP = 144, REC = 13056, JOBB = 4 * REC;
static_assert(R % 64 == 0 && CTXN % 64 == 0 && (R / 64) % 2 == 0, "jobs are 64 tokens; the loader is unrolled by two jobs");
constexpr int R_AT = 0, R_RT = 2304, R_BK = 4608, R_VT = 8704, R_AAK = 10752, R_TT = 11264, R_ARBK = 11776, R_WL = 12800;
__device__ __forceinline__ int permj(int j) { return (j >> 5) * 32 + ((j >> 2) & 3) * 8 + ((j >> 4) & 1) * 4 + (j & 3); }
constexpr int C_SLOTS = 3, C_SYNC = C_SLOTS * JOBB;
static_assert(C_SYNC + 64 <= 163840 - 64 && (JOBB / 4) % 16 == 0, "consumer LDS map");
constexpr size_t WS_RING = WS_WB;
constexpr size_t RING_TOTAL = (size_t)32 * NSLOT * JOBB;
constexpr size_t WS_WYF = 256 * 1024 + 16384;
constexpr int WYF_ACK = 32 * NSLOT * 64, WYF_ABORT = WYF_ACK + 32 * 64, WYF_WORDS = WYF_ABORT + 64;
constexpr unsigned SPIN_CAP = 1u << 17;
constexpr int P_A = 0, P_B = 16384, P_KD = 32768, P_LW = 49152, P_IMG = 65536, P_BRM = P_IMG + JOBB, P_KRM = P_BRM + 8192, P_AAB = P_KRM + 8192, P_W2T = P_AAB + 4096, P_A2T = P_W2T + 64 * PITCH * 2, P_END = P_A2T + 64 * PITCH * 2;
constexpr int P_SCR = P_BRM, SCRW = 2 * 8 * PITCH * 2;
constexpr int P_CST = P_IMG;
static_assert(P_END <= 163840 - 64 && P_SCR + 8 * SCRW + 8 * PITCH * 2 <= P_W2T, "wy LDS map");

__device__ __forceinline__ bf16x4 pack4(f32x4 v) { u32x2 r; r.x = pkbf(v[0], v[1]); r.y = pkbf(v[2], v[3]); return __builtin_bit_cast(bf16x4, r); }
__device__ __forceinline__ f32x4 mm(u32x2 a, bf16x4 b, f32x4 c) { return __builtin_amdgcn_mfma_f32_16x16x16bf16_1k(__builtin_bit_cast(bf16x4, a), b, c, 0, 0, 0); }
__device__ __forceinline__ f32x4 mm(u32x2 a, u32x2 b, f32x4 c) { return __builtin_amdgcn_mfma_f32_16x16x16bf16_1k(__builtin_bit_cast(bf16x4, a), __builtin_bit_cast(bf16x4, b), c, 0, 0, 0); }
__device__ __forceinline__ void wait_ge(gu32* word, unsigned want, gu32* abortw, int lane) {
    for (unsigned spins = 0;;) {
        unsigned v = 0u; if (lane == 0) v = __hip_atomic_load(word, WY_RLX);
        if ((unsigned)__builtin_amdgcn_readfirstlane(v) >= want) return;
        __builtin_amdgcn_s_sleep(1);
        if ((++spins & 255u) == 0u) { unsigned a = 0u; if (lane == 0) a = __hip_atomic_load(abortw, WY_RLX);
            if (__builtin_amdgcn_readfirstlane(a)) return;
            if (spins > SPIN_CAP) { if (lane == 0) __hip_atomic_store(abortw, 1u, WY_RLX); return; } }
    }
}

__device__ __forceinline__ void wait_ge4(gu32* words, unsigned want, gu32* abortw, int lane) {
    for (unsigned spins = 0;;) {
        unsigned v = 0xffffffffu; if (lane < 4) v = __hip_atomic_load(words + lane, WY_RLX);
        const unsigned v0 = (unsigned)__builtin_amdgcn_readlane((int)v, 0), v1 = (unsigned)__builtin_amdgcn_readlane((int)v, 1), v2 = (unsigned)__builtin_amdgcn_readlane((int)v, 2), v3 = (unsigned)__builtin_amdgcn_readlane((int)v, 3);
        const unsigned m01 = v0 < v1 ? v0 : v1, m23 = v2 < v3 ? v2 : v3;
        if ((m01 < m23 ? m01 : m23) >= want) return;
        __builtin_amdgcn_s_sleep(1);
        if ((++spins & 255u) == 0u) { unsigned a = 0u; if (lane == 0) a = __hip_atomic_load(abortw, WY_RLX);
            if (__builtin_amdgcn_readfirstlane(a)) return;
            if (spins > SPIN_CAP) { if (lane == 0) __hip_atomic_store(abortw, 1u, WY_RLX); return; } }
    }
}

struct Frag { u32x4 a01, a23, r01, r23, bk[4], arbk; u32x2 vT, aak, tt; f32x4 wl[4]; };

__device__ __forceinline__ void wait_lds_min4(LAS unsigned* w, unsigned want, gu32* abortw, int lane) {
    for (unsigned spins = 0;;) {
        const unsigned a = __hip_atomic_load(w, __ATOMIC_RELAXED, __HIP_MEMORY_SCOPE_WORKGROUP), b = __hip_atomic_load(w + 1, __ATOMIC_RELAXED, __HIP_MEMORY_SCOPE_WORKGROUP),
                       c = __hip_atomic_load(w + 2, __ATOMIC_RELAXED, __HIP_MEMORY_SCOPE_WORKGROUP), d = __hip_atomic_load(w + 3, __ATOMIC_RELAXED, __HIP_MEMORY_SCOPE_WORKGROUP);
        const unsigned m0 = a < b ? a : b, m1 = c < d ? c : d;
        if ((unsigned)__builtin_amdgcn_readfirstlane((int)(m0 < m1 ? m0 : m1)) >= want) return;
        __builtin_amdgcn_s_sleep(1);
        if ((++spins & 1023u) == 0u) { unsigned ab = 0u; if (lane == 0) ab = __hip_atomic_load(abortw, WY_RLX);
            if (__builtin_amdgcn_readfirstlane(ab)) return;
            if (spins > (SPIN_CAP << 3)) { if (lane == 0) __hip_atomic_store(abortw, 1u, WY_RLX); return; } }
    }
}
template <int MODE> __device__ __forceinline__ void loader(const Params& p, int chain, int lw, int lane, LAS unsigned char* lds) {
    gu32* wf = (gu32*)(p.ws + WS_WYF); gu32* flags = wf + chain * NSLOT * 64; gu32* ackw = wf + WYF_ACK + chain * 64; gu32* abortw = wf + WYF_ABORT;
    LAS unsigned* loaded = (LAS unsigned*)(lds + C_SYNC); LAS unsigned* done = loaded + 4;
    const __amdgpu_buffer_rsrc_t ring_rsrc = __builtin_amdgcn_make_buffer_rsrc((void*)(p.ws + WS_RING), 0, (int)RING_TOTAL, 0x00020000);
    constexpr int QB = JOBB / 4, NIT = (QB / 16 + 63) / 64, TAIL = QB / 16 - (NIT - 1) * 64;
    static_assert(NIT == 13, "the counted waits below assume 13 loads per set");
    u32x4 va[NIT], vb[NIT];
#define WY_ISSUE(v, g_) do { if (MODE < 2) wait_ge(flags + ((g_) % NSLOT) * 64, (unsigned)(g_) + 1u, abortw, lane); \
        const int soff = (chain * NSLOT + (g_) % NSLOT) * JOBB + lw * QB + lane * 16; \
        _Pragma("unroll") for (int k = 0; k < NIT; ++k) if (MODE == 0 && (k < NIT - 1 || lane < TAIL)) v[k] = __builtin_amdgcn_raw_buffer_load_b128(ring_rsrc, soff + k * 1024, 0, 16); } while (0)
#define WY_COMMIT(v, g_, WAITSTR) do { \
        if (MODE != 1 && (g_) >= C_SLOTS) { wait_lds_min4(done, (unsigned)((g_) - C_SLOTS + 1), abortw, lane); __builtin_amdgcn_fence(__ATOMIC_ACQUIRE, "workgroup"); }     \
        asm volatile(WAITSTR ::: "memory");                                                     \
        LAS unsigned char* dst = lds + ((g_) % C_SLOTS) * JOBB + lw * QB + lane * 16; \
        _Pragma("unroll") for (int k = 0; k < NIT; ++k) if (MODE == 0 && (k < NIT - 1 || lane < TAIL)) *(LAS u32x4*)(dst + k * 1024) = v[k]; \
        asm volatile("s_waitcnt lgkmcnt(0)" ::: "memory"); \
        __builtin_amdgcn_fence(__ATOMIC_RELEASE, "workgroup"); \
        if (lane == 0) { __hip_atomic_store(ackw + lw, (unsigned)(g_) + 1u, WY_RLX); __hip_atomic_store(loaded + lw, (unsigned)(g_) + 1u, __ATOMIC_RELAXED, __HIP_MEMORY_SCOPE_WORKGROUP); } } while (0)
    WY_ISSUE(va, 0);
    for (int g = 0; g < NJOB; g += 2) {
        WY_ISSUE(vb, g + 1); WY_COMMIT(va, g, "s_waitcnt vmcnt(13)");
        if (g + 2 < NJOB) { WY_ISSUE(va, g + 2); WY_COMMIT(vb, g + 1, "s_waitcnt vmcnt(13)"); } else WY_COMMIT(vb, g + 1, "s_waitcnt vmcnt(0)");
    }
#undef WY_ISSUE
#undef WY_COMMIT
}
__device__ __forceinline__ bf16x8 cat(u32x2 a, u32x2 b) { const u32x4 v = {a.x, a.y, b.x, b.y}; return __builtin_bit_cast(bf16x8, v); }
__device__ __forceinline__ u32x2 pack4u(f32x4 v) { u32x2 r; r.x = pkbf(v[0], v[1]); r.y = pkbf(v[2], v[3]); return r; }
__device__ __forceinline__ f32x4 mm32(bf16x8 a, bf16x8 b, f32x4 c) { return __builtin_amdgcn_mfma_f32_16x16x32_bf16(a, b, c, 0, 0, 0); }
template <int MODE> __device__ __forceinline__ void consumer(const Params& p, int chain, int wave, int lane, LAS unsigned char* lds) {
    const int n = lane & 15, q = lane >> 4, dir = chain >> 4, h = chain & 15;
    gu32* abortw = (gu32*)(p.ws + WS_WYF) + WYF_ABORT;
    LAS unsigned* loaded = (LAS unsigned*)(lds + C_SYNC); LAS unsigned* done = loaded + 4;
    f32x4 S0 = {0.f, 0.f, 0.f, 0.f}, S1 = S0, S2 = S0, S3 = S0;
    const int offA = n * ATP + 16 * q, offB = n * 32 + 8 * q, offW = 16 * q, offS = n * 64 + ((q ^ ((n >> 2) & 3)) * 16);
    const long rstep = dir ? -2048 : 2048;
    bf16_t* yq = ws_br(p) + (size_t)(CTXN + (dir ? SEQ - 1 - 4 * q : 4 * q)) * 2048 + dir * 1024 + h * 64 + 16 * wave + n;
#define WY_LOAD(F, base, k) do { \
        F.a01 = *(const LAS u32x4*)(base + offA + (k) * REC + R_AT); F.a23 = *(const LAS u32x4*)(base + offA + (k) * REC + R_AT + 64); \
        F.r01 = *(const LAS u32x4*)(base + offA + (k) * REC + R_RT); F.r23 = *(const LAS u32x4*)(base + offA + (k) * REC + R_RT + 64); \
        _Pragma("unroll") for (int jt = 0; jt < 4; ++jt) { F.bk[jt] = *(const LAS u32x4*)(base + offS + (k) * REC + R_BK + 1024 * jt); F.wl[jt] = *(const LAS f32x4*)(base + offW + (k) * REC + R_WL + 64 * jt); } \
        F.arbk = *(const LAS u32x4*)(base + offS + (k) * REC + R_ARBK); \
        F.vT = *(const LAS u32x2*)(base + offB + (k) * REC + R_VT + 512 * wave); F.aak = *(const LAS u32x2*)(base + offB + (k) * REC + R_AAK); F.tt = *(const LAS u32x2*)(base + offB + (k) * REC + R_TT); } while (0)
#define WY_Q(v) __builtin_bit_cast(bf16x8, v)
#define WY_COMPUTE(F, cidx) do { const f32x4 z0_ = {0.f, 0.f, 0.f, 0.f}; const u32x2 zz_ = {0u, 0u};     \
        f32x4 Z = mm32(cat(F.aak, zz_), cat(F.vT, zz_), z0_); \
        const bf16x8 s01 = cat(pack4u(S0), pack4u(S1)), s23 = cat(pack4u(S2), pack4u(S3)); \
        Z = mm32(WY_Q(F.a01), s01, Z); Z = mm32(WY_Q(F.a23), s23, Z);     \
        f32x4 Y = mm32(WY_Q(F.r01), s01, z0_); Y = mm32(WY_Q(F.r23), s23, Y); \
        const u32x2 zb = pack4u(Z); const f32x4 U = mm32(cat(F.tt, zz_), cat(zb, zz_), z0_); const u32x2 ub = pack4u(U); \
        const bf16x8 vu = cat(F.vT, ub); \
        Y = mm32(WY_Q(F.arbk), vu, Y); \
        S0 = mm32(WY_Q(F.bk[0]), vu, S0); S1 = mm32(WY_Q(F.bk[1]), vu, S1); S2 = mm32(WY_Q(F.bk[2]), vu, S2); S3 = mm32(WY_Q(F.bk[3]), vu, S3); \
        S0 *= F.wl[0]; S1 *= F.wl[1]; S2 *= F.wl[2]; S3 *= F.wl[3]; \
        if (MODE == 0 && (cidx) * 16 >= CTXN) { const unsigned y01 = pkbf(Y[0], Y[1]), y23 = pkbf(Y[2], Y[3]); bf16_t* yp_ = yq + (long)((cidx) * 16 - CTXN) * rstep; \
            *(unsigned short*)yp_ = (unsigned short)(y01 & 0xffffu); *(unsigned short*)(yp_ + rstep) = (unsigned short)(y01 >> 16); \
            *(unsigned short*)(yp_ + 2 * rstep) = (unsigned short)(y23 & 0xffffu); *(unsigned short*)(yp_ + 3 * rstep) = (unsigned short)(y23 >> 16); } } while (0)
    Frag FA, FB;
    wait_lds_min4(loaded, 1u, abortw, lane); __builtin_amdgcn_fence(__ATOMIC_ACQUIRE, "workgroup");
    int slot = 0;
    { const LAS unsigned char* b0 = lds; WY_LOAD(FA, b0, 0); if (MODE == 3) WY_LOAD(FB, b0, 1); }
    for (int g = 0; g < NJOB; ++g) {
        const LAS unsigned char* base = lds + slot * JOBB;
        if (MODE != 3) WY_LOAD(FB, base, 1); WY_COMPUTE(FA, 4 * g);
        if (MODE != 3) WY_LOAD(FA, base, 2); WY_COMPUTE(FB, 4 * g + 1);
        if (MODE != 3) WY_LOAD(FB, base, 3); WY_COMPUTE(FA, 4 * g + 2);
        slot = slot == C_SLOTS - 1 ? 0 : slot + 1;
        if (g + 1 < NJOB) { wait_lds_min4(loaded, (unsigned)g + 2u, abortw, lane); __builtin_amdgcn_fence(__ATOMIC_ACQUIRE, "workgroup");
            const LAS unsigned char* nb = lds + slot * JOBB; if (MODE != 3) WY_LOAD(FA, nb, 0); }
        WY_COMPUTE(FB, 4 * g + 3);
        asm volatile("s_waitcnt lgkmcnt(0)" ::: "memory");
        __builtin_amdgcn_fence(__ATOMIC_RELEASE, "workgroup");
        if (lane == 0) __hip_atomic_store(done + wave, (unsigned)g + 1u, __ATOMIC_RELAXED, __HIP_MEMORY_SCOPE_WORKGROUP);
    }
#undef WY_LOAD
#undef WY_COMPUTE
#undef WY_Q
    if (MODE != 0) asm volatile("" :: "v"(S0), "v"(S1), "v"(S2), "v"(S3));
}

template <int HALF> __device__ __forceinline__ void stage2(LAS unsigned char* lds, LAS unsigned char* img, int ch, int j) {
    LAS unsigned char* rec = img + ch * REC;
    const LAS float* LW = (const LAS float*)(lds + P_LW) + (ch * 16) * 64 + j;
    const LAS float* XA = (const LAS float*)(lds + (HALF ? P_KD : P_A)) + (ch * 16) * 64 + j;
    const LAS float* XB = (const LAS float*)(lds + P_B) + (ch * 16) * 64 + j;
    LAS unsigned short* rowm0 = (LAS unsigned short*)(rec + (HALF ? R_RT : R_AT)) + permj(j);
    LAS unsigned short* rowm1 = (LAS unsigned short*)(lds + (HALF ? P_KRM : P_BRM) + ch * 2048) + permj(j);
    float lw[16], s0[16], s1[16];
#pragma unroll
    for (int t = 0; t < 16; ++t) { lw[t] = LW[t * 64]; s1[t] = HALF ? XA[t * 64] : XB[t * 64];
        if (HALF) s0[t] = __uint_as_float((unsigned)rowm0[t * (ATP / 2)] << 16); else s0[t] = XA[t * 64]; }
    float cum = 0.f, x0p = 0.f, x1p = 0.f; unsigned tp[8];
#pragma unroll
    for (int t = 0; t < 16; ++t) {
        const float cprev = cum; cum += lw[t];
        const float x0 = s0[t] * __builtin_amdgcn_exp2f(HALF ? cum : cprev), x1 = s1[t] * __builtin_amdgcn_exp2f(-cum);
        if (t & 1) { const unsigned p0 = pkbf(x0p, x0), p1 = pkbf(x1p, x1);
            rowm0[(t - 1) * (ATP / 2)] = (unsigned short)(p0 & 0xffffu); rowm0[t * (ATP / 2)] = (unsigned short)(p0 >> 16);
            rowm1[(t - 1) * 64] = (unsigned short)(p1 & 0xffffu); rowm1[t * 64] = (unsigned short)(p1 >> 16);
            tp[t >> 1] = p1; }
        x0p = x0; x1p = x1; }
    { LAS unsigned char* bkr = rec + R_BK + j * 64 + (HALF ? 0 : 8); const int sw = (j >> 2) & 3;
#pragma unroll
      for (int qq = 0; qq < 4; ++qq) *(LAS u32x2*)(bkr + ((qq ^ sw) * 16)) = (u32x2){tp[2 * qq], tp[2 * qq + 1]}; }
    if (HALF) *(LAS float*)(rec + R_WL + j * 4) = __builtin_amdgcn_exp2f(cum);
}

template <int SKIP> __device__ __forceinline__ void producer(const Params& p, int chain, int first, int step, LAS unsigned char* lds) {
    int tid_ = threadIdx.x; asm volatile("" : "+v"(tid_));
    const int tid = tid_, lane = tid & 63, wave = __builtin_amdgcn_readfirstlane(tid >> 6);
    const int dir = chain >> 4, h = chain & 15;
    const float* w0 = dir ? p.w0b : p.w0f; const float* w2 = dir ? p.w2b : p.w2f; const float* a0 = dir ? p.a0b : p.a0f; const float* a2 = dir ? p.a2b : p.a2f;
    const bf16_t* Z = ws_big(p); float* bon = (float*)(p.ws + rw::WS_BON) + ((size_t)dir * 16 + h) * SEQ;
    gu32* wf = (gu32*)(p.ws + WS_WYF); gu32* flags = wf + chain * NSLOT * 64; gu32* ackw = wf + WYF_ACK + chain * 64; gu32* abortw = wf + WYF_ABORT;
    const __amdgpu_buffer_rsrc_t ring_rsrc = __builtin_amdgcn_make_buffer_rsrc((void*)(p.ws + WS_RING), 0, (int)RING_TOTAL, 0x00020000);
    { const int m = tid >> 3, j8 = (tid & 7) * 8;
      const f32x4 wa = *(const f32x4*)(w2 + (size_t)m * 1024 + h * 64 + j8), wb = *(const f32x4*)(w2 + (size_t)m * 1024 + h * 64 + j8 + 4);
      const f32x4 aa = *(const f32x4*)(a2 + (size_t)m * 1024 + h * 64 + j8), ab = *(const f32x4*)(a2 + (size_t)m * 1024 + h * 64 + j8 + 4);
      LAS bf16_t* yw = (LAS bf16_t*)(lds + P_W2T); LAS bf16_t* ya = (LAS bf16_t*)(lds + P_A2T);
#pragma unroll
      for (int qq = 0; qq < 4; ++qq) { yw[(j8 + qq) * PITCH + m] = f2bf(wa[qq]); yw[(j8 + 4 + qq) * PITCH + m] = f2bf(wb[qq]); ya[(j8 + qq) * PITCH + m] = f2bf(aa[qq]); ya[(j8 + 4 + qq) * PITCH + m] = f2bf(ab[qq]); }
      for (int i = tid; i < 320; i += NTHR) { const int gI = i >> 6, cc = i & 63, hc = h * 64 + cc; float v;
          if (gI == 0) v = w0[hc]; else if (gI == 1) v = a0[hc]; else if (gI == 2) v = p.k_k[hc]; else if (gI == 3) v = p.k_a[hc]; else v = p.r_k[hc];
          *(LAS float*)(lds + P_CST + i * 4) = v; } }
    __syncthreads();
    const int tq = lane >> 3, c8 = (lane & 7) * 8, hj = h * 64 + c8, tslot = wave * 8 + tq, ch1 = tslot >> 4, t1 = tslot & 15;
    const int gcol[5] = {hj, 1024 + hj, 2048 + hj, 3072 + dir * 64 + c8, 3200 + dir * 64 + c8};
    f32x4 cw0[2], ca0[2], ckk[2], cka[2], crk[2];
#pragma unroll
    for (int hh = 0; hh < 2; ++hh) {
#define WY_CST(gI) (*(LAS f32x4*)(lds + P_CST + ((gI) * 64 + c8 + 4 * hh) * 4))
        cw0[hh] = WY_CST(0); ca0[hh] = WY_CST(1); ckk[hh] = WY_CST(2); cka[hh] = WY_CST(3); crk[hh] = WY_CST(4);
#undef WY_CST
        asm volatile("" : "+v"(cw0[hh]), "+v"(ca0[hh]), "+v"(ckk[hh]), "+v"(cka[hh]), "+v"(crk[hh])); }
    __syncthreads();
    LAS unsigned char* scr = lds + P_SCR + wave * SCRW;
    LAS unsigned char* img = lds + P_IMG;
    rw::Raw raw;
#define WY_LOADRAW(gj) do { const bf16_t* zr_ = Z + (size_t)rw_row(dir, (gj) * 64 + tslot) * ZW; \
        _Pragma("unroll") for (int g5 = 0; g5 < 5; ++g5) raw.c[g5] = *(const u32x4*)(zr_ + gcol[g5]); } while (0)
    if (first < NJOB) WY_LOADRAW(first);
    for (int g = first; g < NJOB; g += step) {
        const bool latent = g * 64 >= CTXN;
        if (!(SKIP & 1)) { f32x4 rr[2], kv[2];
          { const u32x4 u = raw.c[0]; rr[0] = (f32x4){bflo(u.x), bfhi(u.x), bflo(u.y), bfhi(u.y)}; rr[1] = (f32x4){bflo(u.z), bfhi(u.z), bflo(u.w), bfhi(u.w)};
            LAS unsigned char* rr_ = img + ch1 * REC + R_RT + t1 * ATP + permj(c8) * 2; *(LAS u32x2*)rr_ = (u32x2){u.x, u.y}; *(LAS u32x2*)(rr_ + 16) = (u32x2){u.z, u.w}; }
          { const u32x4 u = raw.c[1]; kv[0] = (f32x4){bflo(u.x), bfhi(u.x), bflo(u.y), bfhi(u.y)}; kv[1] = (f32x4){bflo(u.z), bfhi(u.z), bflo(u.w), bfhi(u.w)}; }
          { const u32x4 u = raw.c[2]; LAS unsigned short* vt = (LAS unsigned short*)(img + ch1 * REC + R_VT) + c8 * 16 + t1;
            vt[0] = (unsigned short)(u.x & 0xffffu); vt[16] = (unsigned short)(u.x >> 16); vt[32] = (unsigned short)(u.y & 0xffffu); vt[48] = (unsigned short)(u.y >> 16);
            vt[64] = (unsigned short)(u.z & 0xffffu); vt[80] = (unsigned short)(u.z >> 16); vt[96] = (unsigned short)(u.w & 0xffffu); vt[112] = (unsigned short)(u.w >> 16); }
          { const u32x4 u = raw.c[3]; u32x4 o;
            o.x = pkbf(rw::fast_tanh(bflo(u.x)), rw::fast_tanh(bfhi(u.x))); o.y = pkbf(rw::fast_tanh(bflo(u.y)), rw::fast_tanh(bfhi(u.y))); o.z = pkbf(rw::fast_tanh(bflo(u.z)), rw::fast_tanh(bfhi(u.z))); o.w = pkbf(rw::fast_tanh(bflo(u.w)), rw::fast_tanh(bfhi(u.w)));
            *(LAS u32x4*)(scr + (tq * PITCH + c8) * 2) = o; *(LAS u32x4*)(scr + 8 * PITCH * 2 + (tq * PITCH + c8) * 2) = raw.c[4]; }
          if (g + step < NJOB) WY_LOADRAW(g + step);
          asm volatile("s_waitcnt lgkmcnt(0)" ::: "memory");
          { const int r16 = lane & 15, quad = lane >> 4; f32x4 acc[2][4];
#pragma unroll
            for (int lora = 0; lora < 2; ++lora) {
                LAS unsigned char* X = scr + lora * 8 * PITCH * 2 + (r16 * PITCH + quad * 8) * 2;
                const bf16x8 x0 = *(LAS bf16x8*)X, x1 = *(LAS bf16x8*)(X + 64);
#pragma unroll
                for (int jt = 0; jt < 4; ++jt) {
                    LAS unsigned char* Y = lds + (lora ? P_A2T : P_W2T) + ((jt * 16 + r16) * PITCH + quad * 8) * 2;
                    acc[lora][jt] = (f32x4){0.f, 0.f, 0.f, 0.f};
                    acc[lora][jt] = __builtin_amdgcn_mfma_f32_16x16x32_bf16(x0, *(LAS bf16x8*)Y, acc[lora][jt], 0, 0, 0);
                    acc[lora][jt] = __builtin_amdgcn_mfma_f32_16x16x32_bf16(x1, *(LAS bf16x8*)(Y + 64), acc[lora][jt], 0, 0, 0); } }
            if (quad < 2) {
#pragma unroll
                for (int lora = 0; lora < 2; ++lora)
#pragma unroll
                    for (int jt = 0; jt < 4; ++jt)
#pragma unroll
                        for (int r = 0; r < 4; ++r) *(LAS float*)(lds + (lora ? P_B : P_LW) + ((wave * 8 + quad * 4 + r) * 64 + jt * 16 + r16) * 4) = acc[lora][jt][r]; } }
          asm volatile("s_waitcnt lgkmcnt(0)" ::: "memory");
          { float bs = 0.f, nn = 0.f; f32x4 kk[2], al[2];
#pragma unroll
            for (int hh = 0; hh < 2; ++hh) { const int off = (tslot * 64 + c8 + 4 * hh) * 4;
                const f32x4 aw = *(LAS f32x4*)(lds + P_LW + off) + cw0[hh], aa = *(LAS f32x4*)(lds + P_B + off) + ca0[hh];
                f32x4 lw;
#pragma unroll
                for (int qq = 0; qq < 4; ++qq) { const float sg = __builtin_amdgcn_rcpf(1.0f + __builtin_amdgcn_exp2f(-1.4426950408889634f * aw[qq]));
                    lw[qq] = -0.8750612633917f * sg; al[hh][qq] = __builtin_amdgcn_rcpf(1.0f + __builtin_amdgcn_exp2f(-1.4426950408889634f * aa[qq])); kk[hh][qq] = kv[hh][qq] * ckk[hh][qq]; nn += kk[hh][qq] * kk[hh][qq]; }
                *(LAS f32x4*)(lds + P_LW + off) = lw; }
            nn = rw::allreduce8(nn);
            const float inv = __builtin_amdgcn_rsqf(fmaxf(nn, 1e-24f));
#pragma unroll
            for (int hh = 0; hh < 2; ++hh) { const int off = (tslot * 64 + c8 + 4 * hh) * 4;
                const f32x4 r = rr[hh];
                f32x4 av, bv, kd;
#pragma unroll
                for (int qq = 0; qq < 4; ++qq) { const float kn = kk[hh][qq] * inv; av[qq] = -kn; bv[qq] = kn * al[hh][qq]; kd[qq] = kv[hh][qq] * (1.0f + (al[hh][qq] - 1.0f) * cka[hh][qq]); bs += r[qq] * kd[qq] * crk[hh][qq]; }
                *(LAS f32x4*)(lds + P_B + off) = bv; *(LAS f32x4*)(lds + P_KD + off) = kd; *(LAS f32x4*)(lds + P_A + off) = av; }
            bs = rw::allreduce8(bs);
            if (latent && (lane & 7) == 0) bon[rw_row(dir, g * 64 + tslot) - CTXN] = bs; } }
        __syncthreads();
        if (!(SKIP & 2)) { if (wave >> 2) stage2<1>(lds, img, wave & 3, lane); else stage2<0>(lds, img, wave & 3, lane); }
        __syncthreads();
        if (!(SKIP & 4)) { const int ch = wave & 3, pair = wave >> 2, n = lane & 15, q = lane >> 4;
          LAS unsigned char* rec = img + ch * REC;
          const LAS unsigned char* Yrm = rec + (pair ? R_RT : R_AT) + n * ATP + 16 * q;
          const LAS unsigned char* Xb = lds + P_BRM + ch * 2048 + n * 128 + 16 * q;
          const LAS unsigned char* Xk = lds + P_KRM + ch * 2048 + n * 128 + 16 * q;
          f32x4 cb = {0.f, 0.f, 0.f, 0.f}, ck = cb;
#pragma unroll
          for (int jt = 0; jt < 4; ++jt) { const int o_ = (jt >> 1) * 64 + (jt & 1) * 8; const u32x2 yb = *(const LAS u32x2*)(Yrm + o_);
              cb = mm(*(const LAS u32x2*)(Xb + o_), yb, cb); ck = mm(*(const LAS u32x2*)(Xk + o_), yb, ck); }
#pragma unroll
          for (int r = 0; r < 4; ++r) { const int s = 4 * q + r; const bool keep = pair ? (s <= n) : (s < n); if (!keep) { cb[r] = 0.f; ck[r] = 0.f; } }
          u32x2 ob, ok; ob.x = pkbf(cb[0], cb[1]); ob.y = pkbf(cb[2], cb[3]); ok.x = pkbf(ck[0], ck[1]); ok.y = pkbf(ck[2], ck[3]);
          if (pair) *(LAS u32x4*)(rec + R_ARBK + n * 64 + ((q ^ ((n >> 2) & 3)) * 16)) = (u32x4){ok.x, ok.y, ob.x, ob.y};
          else {
              *(LAS u32x2*)(rec + R_AAK + n * 32 + 8 * q) = ok;
              LAS float* A2 = (LAS float*)(lds + P_AAB + ch * 1024);
#pragma unroll
              for (int r = 0; r < 4; ++r) A2[n * 16 + r * 4 + q] = cb[r];
              asm volatile("s_waitcnt lgkmcnt(0)" ::: "memory");
              const int c = lane >> 2, pp = lane & 3;
              f32x4 a4[16];
#pragma unroll
              for (int t = 0; t < 16; ++t) a4[t] = *(const LAS f32x4*)(A2 + t * 16 + pp * 4);
              float Tk0 = 0.f, Tk1 = 0.f, Tk2 = 0.f, Tk3 = 0.f, Tprev = 0.f;
              LAS unsigned short* tt = (LAS unsigned short*)(rec + R_TT) + c;
#pragma unroll
              for (int t = 0; t < 16; ++t) {
                  float acc = (a4[t][0] * Tk0 + a4[t][1] * Tk1) + (a4[t][2] * Tk2 + a4[t][3] * Tk3);
                  acc += rw::dppmov<0xB1>(acc); acc += rw::dppmov<0x4E>(acc);
                  const float Tt = acc + ((t == c) ? 1.0f : 0.0f);
                  const bool mine = (t & 3) == pp;
                  if ((t >> 2) == 0) Tk0 = mine ? Tt : Tk0; else if ((t >> 2) == 1) Tk1 = mine ? Tt : Tk1; else if ((t >> 2) == 2) Tk2 = mine ? Tt : Tk2; else Tk3 = mine ? Tt : Tk3;
                  if (t & 1) { const unsigned pk_ = pkbf(Tprev, Tt); if (pp == 0) { tt[(t - 1) * 16] = (unsigned short)(pk_ & 0xffffu); tt[t * 16] = (unsigned short)(pk_ >> 16); } }
                  Tprev = Tt; }
          } }
        if (!(SKIP & 16) && wave == 0 && g >= NSLOT) wait_ge4(ackw, (unsigned)(g - NSLOT + 1), abortw, lane);
        __syncthreads();
        { const int slot = g % NSLOT; const int base = (chain * NSLOT + slot) * JOBB;
          if (!(SKIP & 8)) for (int i = tid; i < JOBB / 16; i += NTHR) __builtin_amdgcn_raw_buffer_store_b128(*(LAS u32x4*)(img + i * 16), ring_rsrc, base + i * 16, 0, 16);
          asm volatile("s_waitcnt vmcnt(0)" ::: "memory");
          __syncthreads();
          if (tid == 0) __hip_atomic_store(flags + slot * 64, (unsigned)g + 1u, WY_RLX); }
    }
#undef WY_LOADRAW
}

__device__ __forceinline__ void zero_words(const Params& p) {
    int t_ = threadIdx.x; asm volatile("" : "+v"(t_)); unsigned* wf_ = (unsigned*)(p.ws + WS_WYF);
    for (long g = (long)blockIdx.x * NTHR + t_; g < (long)WYF_WORDS; g += (long)gridDim.x * NTHR) wf_[g] = 0u;
}
template <int MODE, int SKIP = 0> __device__ __forceinline__ void phase(const Params& p, LAS unsigned char* lds) {
    const int G = (int)gridDim.x, b = (int)blockIdx.x, nper = (G - 32) / 32;
    if (b < 32) {
        int tid_ = threadIdx.x; asm volatile("" : "+v"(tid_)); const int wave = __builtin_amdgcn_readfirstlane(tid_ >> 6);
        if (tid_ < 8) *(LAS unsigned*)(lds + C_SYNC + 4 * tid_) = 0u;
        __syncthreads();
        if (MODE == 4) { }
        else if (wave < 4) { if (MODE != 1) consumer<MODE>(p, b, wave, tid_ & 63, lds); } else loader<MODE>(p, b, wave - 4, tid_ & 63, lds);
    }
    else if (MODE < 2 || MODE == 4) { const int pp = b - 32; if (pp < 32 * nper) producer<SKIP>(p, pp % 32, pp / 32, nper, lds); }
}
}

namespace ret {
using attn::bf16x8; using attn::s16x4; using attn::f32x16; using attn::u32x4;
typedef float f32x4 __attribute__((ext_vector_type(4)));
typedef unsigned u32x2 __attribute__((ext_vector_type(2)));
constexpr int NQ = R / 128;
constexpr size_t SLOT_BYTES = 256 * 128 * 2;
constexpr size_t WS_SCTX = 254 * MiB;
#define RKSWZ(row, colB) ((row) * 256 + ((colB) ^ (((row) & 7) << 4)))
__device__ __forceinline__ bf16_t* slot(const Params& p, int dir, int q, int head) {
    return q >= 2 ? (bf16_t*)((unsigned char*)p.out + (((size_t)dir * (NQ - 2) + (q - 2)) * 4 + head) * SLOT_BYTES)
                  : (bf16_t*)(p.ws + WS_SCTX + (((size_t)dir * 2 + q) * 4 + head) * SLOT_BYTES);
}
__device__ __forceinline__ float log2_sigmoid(float x) { return -1.4426950408889634f * (fmaxf(-x, 0.f) + log1pf(expf(-fabsf(x)))); }
__device__ __forceinline__ bf16x8 scale8(bf16x8 v, float s) {
    u32x4 w = __builtin_bit_cast(u32x4, v), o;
#pragma unroll
    for (int i = 0; i < 4; ++i) o[i] = attn::cvtpk(__uint_as_float(w[i] << 16) * s, __uint_as_float(w[i] & 0xffff0000u) * s);
    return __builtin_bit_cast(bf16x8, o);
}
__device__ __forceinline__ void pk4(const f32x16& P, int base, bf16x8& out) {
    const unsigned a0 = attn::cvtpk(P[base + 0], P[base + 1]), a1 = attn::cvtpk(P[base + 2], P[base + 3]);
    const unsigned b0 = attn::cvtpk(P[base + 4], P[base + 5]), b1 = attn::cvtpk(P[base + 6], P[base + 7]);
    auto r0 = __builtin_amdgcn_permlane32_swap(a0, b0, false, false); auto r1 = __builtin_amdgcn_permlane32_swap(a1, b1, false, false);
    u32x4 w = {r0[0], r1[0], r0[1], r1[1]}; out = __builtin_bit_cast(bf16x8, w);
}
#define RPK(L, H) (bf16x8){L[0], L[1], L[2], L[3], H[0], H[1], H[2], H[3]}

__device__ __forceinline__ void summaries_unit(const Params& p, int q, int h, char* lds) {
    int tid_ = threadIdx.x; asm volatile("" : "+v"(tid_));
    const int tid = tid_, lane = tid & 63, wave = __builtin_amdgcn_readfirstlane(tid >> 6), r32 = lane & 31, hi = lane >> 5;
    const bf16_t* P = ws_big(p) + (size_t)q * 128 * P0W;
    const float lgf = log2_sigmoid(p.dec_f[h]), lgb = log2_sigmoid(p.dec_b[h]);
    const int sr = tid >> 4, sc = (tid & 15) * 8, st0 = attn::v_st(sr, sc), st1 = attn::v_st(32 + sr, sc);
#pragma unroll
    for (int th = 0; th < 2; ++th) {
        const int t0 = th * 64 + sr, t1 = t0 + 32;
        const bf16_t* r0 = P + (size_t)t0 * P0W; const bf16_t* r1 = P + (size_t)t1 * P0W;
#pragma unroll
        for (int eh = 0; eh < 2; ++eh) { char* vt = lds + (th * 2 + eh) * 16384;
            *(bf16x8*)(vt + st0) = *(const bf16x8*)(r0 + C_VA + h * 256 + eh * 128 + sc); *(bf16x8*)(vt + st1) = *(const bf16x8*)(r1 + C_VA + h * 256 + eh * 128 + sc); }
        const bf16x8 k0 = *(const bf16x8*)(r0 + C_KA + h * 128 + sc), k1 = *(const bf16x8*)(r1 + C_KA + h * 128 + sc);
        char* kf = lds + 65536 + th * 16384; char* kb = lds + 98304 + th * 16384;
        *(bf16x8*)(kf + st0) = scale8(k0, __builtin_amdgcn_exp2f((float)(127 - t0) * lgf)); *(bf16x8*)(kf + st1) = scale8(k1, __builtin_amdgcn_exp2f((float)(127 - t1) * lgf));
        *(bf16x8*)(kb + st0) = scale8(k0, __builtin_amdgcn_exp2f((float)t0 * lgb)); *(bf16x8*)(kb + st1) = scale8(k1, __builtin_amdgcn_exp2f((float)t1 * lgb));
    }
    __syncthreads();
    const int lbase = (int)(uintptr_t)lds + attn::v_rd_base(lane);
    f32x16 acc[2][4];
#pragma unroll
    for (int d = 0; d < 2; ++d)
#pragma unroll
        for (int b = 0; b < 4; ++b) acc[d][b] = f32x16{};
#pragma unroll
    for (int th = 0; th < 2; ++th) {
        const int va = lbase + (th * 2 + (wave >> 2)) * 16384 + (wave & 3) * 512, kfb = lbase + 65536 + th * 16384, kbb = lbase + 98304 + th * 16384;
#define R1_STEP(KS) do { \
        const s16x4 al = attn::tr_read<attn::v_rd_off(0, KS, 0)>(va), ah = attn::tr_read<attn::v_rd_off(0, KS, 1)>(va); \
        const s16x4 f0l = attn::tr_read<attn::v_rd_off(0, KS, 0)>(kfb), f0h = attn::tr_read<attn::v_rd_off(0, KS, 1)>(kfb), f1l = attn::tr_read<attn::v_rd_off(1, KS, 0)>(kfb), f1h = attn::tr_read<attn::v_rd_off(1, KS, 1)>(kfb); \
        const s16x4 f2l = attn::tr_read<attn::v_rd_off(2, KS, 0)>(kfb), f2h = attn::tr_read<attn::v_rd_off(2, KS, 1)>(kfb), f3l = attn::tr_read<attn::v_rd_off(3, KS, 0)>(kfb), f3h = attn::tr_read<attn::v_rd_off(3, KS, 1)>(kfb); \
        const s16x4 g0l = attn::tr_read<attn::v_rd_off(0, KS, 0)>(kbb), g0h = attn::tr_read<attn::v_rd_off(0, KS, 1)>(kbb), g1l = attn::tr_read<attn::v_rd_off(1, KS, 0)>(kbb), g1h = attn::tr_read<attn::v_rd_off(1, KS, 1)>(kbb); \
        const s16x4 g2l = attn::tr_read<attn::v_rd_off(2, KS, 0)>(kbb), g2h = attn::tr_read<attn::v_rd_off(2, KS, 1)>(kbb), g3l = attn::tr_read<attn::v_rd_off(3, KS, 0)>(kbb), g3h = attn::tr_read<attn::v_rd_off(3, KS, 1)>(kbb); \
        asm volatile("s_waitcnt lgkmcnt(0)" ::: "memory"); __builtin_amdgcn_sched_barrier(0); \
        const bf16x8 a = RPK(al, ah); \
        acc[0][0] = __builtin_amdgcn_mfma_f32_32x32x16_bf16(a, RPK(f0l, f0h), acc[0][0], 0, 0, 0); acc[0][1] = __builtin_amdgcn_mfma_f32_32x32x16_bf16(a, RPK(f1l, f1h), acc[0][1], 0, 0, 0); \
        acc[0][2] = __builtin_amdgcn_mfma_f32_32x32x16_bf16(a, RPK(f2l, f2h), acc[0][2], 0, 0, 0); acc[0][3] = __builtin_amdgcn_mfma_f32_32x32x16_bf16(a, RPK(f3l, f3h), acc[0][3], 0, 0, 0); \
        acc[1][0] = __builtin_amdgcn_mfma_f32_32x32x16_bf16(a, RPK(g0l, g0h), acc[1][0], 0, 0, 0); acc[1][1] = __builtin_amdgcn_mfma_f32_32x32x16_bf16(a, RPK(g1l, g1h), acc[1][1], 0, 0, 0); \
        acc[1][2] = __builtin_amdgcn_mfma_f32_32x32x16_bf16(a, RPK(g2l, g2h), acc[1][2], 0, 0, 0); acc[1][3] = __builtin_amdgcn_mfma_f32_32x32x16_bf16(a, RPK(g3l, g3h), acc[1][3], 0, 0, 0); \
        __builtin_amdgcn_sched_barrier(0); } while (0)
        R1_STEP(0); R1_STEP(1); R1_STEP(2); R1_STEP(3);
#undef R1_STEP
    }
#pragma unroll
    for (int d = 0; d < 2; ++d) { bf16_t* dst = slot(p, d, q, h);
#pragma unroll
        for (int db = 0; db < 4; ++db)
#pragma unroll
            for (int r = 0; r < 16; ++r) dst[(size_t)(32 * wave + attn::crow(r, hi)) * 128 + 32 * db + r32] = (bf16_t)(attn::cvtpk(acc[d][db][r], 0.f) & 0xffffu); }
    __syncthreads();
}

__device__ __forceinline__ void state_scan(const Params& p) {
    int tid_ = threadIdx.x; asm volatile("" : "+v"(tid_));
    for (long gt = (long)blockIdx.x * NTHR + tid_; gt < 2L * 4 * 16384; gt += (long)gridDim.x * NTHR) {
    const int pair = (int)(gt & 16383), h = (int)((gt >> 14) & 3), dir = (int)(gt >> 16);
    const float G = __builtin_amdgcn_exp2f(128.0f * log2_sigmoid((dir ? p.dec_b : p.dec_f)[h]));
    float s0 = 0.f, s1 = 0.f;
    for (int n = 0; n < NQ; ++n) {
        const int q = dir == 0 ? n : (n < 2 ? 1 - n : NQ + 1 - n);
        unsigned* ptr = (unsigned*)slot(p, dir, q, h) + pair;
        const unsigned u = *ptr;
        *ptr = attn::cvtpk(s0, s1);
        s0 = G * s0 + __uint_as_float(u << 16); s1 = G * s1 + __uint_as_float(u & 0xffff0000u);
    }    }
}

__device__ __forceinline__ void output_unit(const Params& p, int q, int h, char* lds) {
    int tid_ = threadIdx.x; asm volatile("" : "+v"(tid_));
    const int tid = tid_, lane = tid & 63, wave = __builtin_amdgcn_readfirstlane(tid >> 6), r32 = lane & 31, hi = lane >> 5;
    const int ib = wave >> 1, eh = wave & 1;
    const bf16_t* P = ws_big(p) + (size_t)q * 128 * P0W;
    const float lgf = log2_sigmoid(p.dec_f[h]), lgb = log2_sigmoid(p.dec_b[h]);
    { const int sr = tid >> 4, sc = (tid & 15) * 8, st0 = attn::v_st(sr, sc), st1 = attn::v_st(32 + sr, sc);
#pragma unroll
      for (int jt = 0; jt < 2; ++jt) {
          const bf16_t* r0 = P + (size_t)(jt * 64 + sr) * P0W; const bf16_t* r1 = r0 + (size_t)32 * P0W;
          char* kt = lds + jt * 16384;
          *(bf16x8*)(kt + RKSWZ(sr, sc * 2)) = *(const bf16x8*)(r0 + C_KA + h * 128 + sc); *(bf16x8*)(kt + RKSWZ(32 + sr, sc * 2)) = *(const bf16x8*)(r1 + C_KA + h * 128 + sc);
#pragma unroll
          for (int e2 = 0; e2 < 2; ++e2) { char* vt = lds + 32768 + (jt * 2 + e2) * 16384;
              *(bf16x8*)(vt + st0) = *(const bf16x8*)(r0 + C_VA + h * 256 + e2 * 128 + sc); *(bf16x8*)(vt + st1) = *(const bf16x8*)(r1 + C_VA + h * 256 + e2 * 128 + sc); }
      } }
    bf16x8 qr[8];
    { const bf16_t* Qw = P + (size_t)(ib * 32 + r32) * P0W + C_QA + h * 128 + hi * 8;
#pragma unroll
      for (int d0 = 0; d0 < 8; ++d0) qr[d0] = *(const bf16x8*)(Qw + d0 * 16); }
    const bf16_t* Sf = slot(p, 0, q, h) + (size_t)(eh * 128 + r32) * 128 + hi * 8; const bf16_t* Sb = slot(p, 1, q, h) + (size_t)(eh * 128 + r32) * 128 + hi * 8;
    bf16x8 fa[8], fb[8];
#define RET_LOADB(F, S, sb) do { _Pragma("unroll") for (int s_ = 0; s_ < 2; ++s_) _Pragma("unroll") for (int d0 = 0; d0 < 4; ++d0) F[s_ * 4 + d0] = *(const bf16x8*)((S) + (size_t)d0 * 32 * 128 + ((sb) * 2 + s_) * 16); } while (0)
#define RET_MMAB(F, sc, sb) do { _Pragma("unroll") for (int s_ = 0; s_ < 2; ++s_) { const bf16x8 a = scale8(qr[(sb) * 2 + s_], sc); \
        _Pragma("unroll") for (int d0 = 0; d0 < 4; ++d0) o[d0] = __builtin_amdgcn_mfma_f32_32x32x16_bf16(a, F[s_ * 4 + d0], o[d0], 0, 0, 0); } } while (0)
    RET_LOADB(fa, Sf, 0);
    __syncthreads();
    f32x16 o[4] = {};
    const int i_loc = ib * 32 + r32;
    const int vb0 = (int)(uintptr_t)lds + 32768 + attn::v_rd_base(lane);
#pragma unroll
    for (int jt = 0; jt < 2; ++jt) {
        f32x16 p0, p1;
        attn::qkt(p0, p1, (const attn::bf16*)(lds + jt * 16384), qr, r32, hi);
#pragma unroll
        for (int r = 0; r < 16; ++r) {
            const int j0 = jt * 64 + attn::crow(r, hi), dl0 = i_loc - j0, dl1 = dl0 - 32;
            const float m0 = dl0 > 0 ? __builtin_amdgcn_exp2f((float)dl0 * lgf) : (dl0 < 0 ? __builtin_amdgcn_exp2f((float)(-dl0) * lgb) : 2.0f);
            const float m1 = dl1 > 0 ? __builtin_amdgcn_exp2f((float)dl1 * lgf) : (dl1 < 0 ? __builtin_amdgcn_exp2f((float)(-dl1) * lgb) : 2.0f);
            p0[r] *= m0; p1[r] *= m1;
        }
        bf16x8 pa0, pa1, pa2, pa3; pk4(p0, 0, pa0); pk4(p0, 8, pa1); pk4(p1, 0, pa2); pk4(p1, 8, pa3);
        __builtin_amdgcn_sched_barrier(0);
        attn::pv_d0(o, vb0 + (jt * 2 + eh) * 16384, pa0, pa1, pa2, pa3);
    }
    { const float scf = __builtin_amdgcn_exp2f((float)(i_loc + 1) * lgf), scb = __builtin_amdgcn_exp2f((float)(128 - i_loc) * lgb);
      RET_LOADB(fb, Sf, 1); __builtin_amdgcn_sched_barrier(0);
      RET_MMAB(fa, scf, 0); __builtin_amdgcn_sched_barrier(0); RET_LOADB(fa, Sf, 2); __builtin_amdgcn_sched_barrier(0);
      RET_MMAB(fb, scf, 1); __builtin_amdgcn_sched_barrier(0); RET_LOADB(fb, Sf, 3); __builtin_amdgcn_sched_barrier(0);
      RET_MMAB(fa, scf, 2); __builtin_amdgcn_sched_barrier(0); RET_LOADB(fa, Sb, 0); __builtin_amdgcn_sched_barrier(0);
      RET_MMAB(fb, scf, 3); __builtin_amdgcn_sched_barrier(0); RET_LOADB(fb, Sb, 1); __builtin_amdgcn_sched_barrier(0);
      RET_MMAB(fa, scb, 0); __builtin_amdgcn_sched_barrier(0); RET_LOADB(fa, Sb, 2); __builtin_amdgcn_sched_barrier(0);
      RET_MMAB(fb, scb, 1); __builtin_amdgcn_sched_barrier(0); RET_LOADB(fb, Sb, 3); __builtin_amdgcn_sched_barrier(0);
      RET_MMAB(fa, scb, 2); __builtin_amdgcn_sched_barrier(0);
      RET_MMAB(fb, scb, 3); }
#undef RET_LOADB
#undef RET_MMAB
    __syncthreads();
    float* O = (float*)lds;
#pragma unroll
    for (int r = 0; r < 16; ++r)
#pragma unroll
        for (int d0 = 0; d0 < 4; ++d0) O[(ib * 32 + attn::crow(r, hi)) * 256 + eh * 128 + d0 * 32 + r32] = o[d0][r];
    __syncthreads();
    bf16_t* BR = ws_br(p) + (size_t)q * 128 * 2048 + h * 256;
#pragma unroll 4
    for (int rr = 0; rr < 16; ++rr) {
        const int row = wave * 16 + rr; const f32x4 x = *(const f32x4*)(O + row * 256 + lane * 4);
        const float mean = rw::wave_sum((x[0] + x[1]) + (x[2] + x[3])) * (1.0f / 256.f);
        const f32x4 d = x - mean;
        const float var = rw::wave_sum((d[0] * d[0] + d[1] * d[1]) + (d[2] * d[2] + d[3] * d[3])) * (1.0f / 256.f);
        const float rstd = 1.0f / sqrtf(var + NORM_EPS);
        f32x4 y = d * rstd;
        if (q < 2) { const u32x2 gg = *(const u32x2*)((const bf16_t*)(p.ws + 255 * MiB) + (size_t)(q * 128 + row) * 2048 + h * 256 + lane * 4);
            y[0] *= __uint_as_float(gg.x << 16); y[1] *= __uint_as_float(gg.x & 0xffff0000u); y[2] *= __uint_as_float(gg.y << 16); y[3] *= __uint_as_float(gg.y & 0xffff0000u); }
        u32x2 w; w.x = attn::cvtpk(y[0], y[1]); w.y = attn::cvtpk(y[2], y[3]);
        *(u32x2*)(BR + (size_t)row * 2048 + lane * 4) = w;
    }
    __syncthreads();
}
#undef RPK
#undef RKSWZ
}

namespace na {
using attn::bf16x8; using attn::f32x16; using attn::u32x4;
constexpr float L2E = 1.4426950408889634f;
constexpr int WH = GROWS < 8 ? GROWS : 8;
constexpr int L_K = 0, L_V = 32768, L_WS = 65536, L_RPB = L_WS + NWAVES * 64 * 4, L_END = L_RPB + 15 * 31 * 4;
#define NKSWZ(row, colB) ((row) * 256 + ((colB) ^ (((row) & 7) << 4)))
__device__ __forceinline__ int win_r0(int r) { int r0 = r - WH / 2; return r0 < 0 ? 0 : (r0 > GROWS - WH ? GROWS - WH : r0); }
__device__ __forceinline__ int win_c0(int c) { int c0 = c - 8; return c0 < 0 ? 0 : (c0 > GW - 16 ? GW - 16 : c0); }

__device__ __forceinline__ void na_unit(const Params& p, int rg, int h, char* lds) {
    int tid_ = threadIdx.x; asm volatile("" : "+v"(tid_));
    const int tid = tid_, lane = tid & 63, wave = __builtin_amdgcn_readfirstlane(tid >> 6), r32 = lane & 31, hi = lane >> 5;
    const bf16_t* P = ws_big(p); const bf16_t* NAC = (const bf16_t*)(p.ws + 255 * MiB);
    const int r = 4 * rg + (wave >> 1), qc = (wave & 1) * 32 + r32, my_r0 = win_r0(r), my_c0 = win_c0(qc);
    const int lo = win_r0(4 * rg), hiw = win_r0(4 * rg + 3) + WH, NT = hiw - lo + CTXN / 64;
    float* wsf = (float*)(lds + L_WS) + wave * 64; float* rpb_l = (float*)(lds + L_RPB);
    if (tid < 15 * 31) rpb_l[tid] = p.rpb[h * 15 * 31 + tid];
    bf16x8 qr[4];
    { const bf16_t* Qw = P + (size_t)(CTXN + r * 64 + qc) * NAW + h * 64 + hi * 8;
#pragma unroll
      for (int d0 = 0; d0 < 4; ++d0) qr[d0] = *(const bf16x8*)(Qw + d0 * 16); }
    const int sk = tid >> 3, sc = (tid & 7) * 8, kst = NKSWZ(sk, sc * 2), vst = attn::v_st(sk, sc);
    bf16x8 kA, vA, kB, vB;
#define NA_LOAD(KR, VR, t) do { if ((t) < hiw - lo) { const int krow_ = CTXN + (lo + (t)) * 64 + sk; \
            KR = *(const bf16x8*)(P + (size_t)krow_ * NAW + 1024 + h * 64 + sc); VR = *(const bf16x8*)(P + (size_t)krow_ * NAW + 2048 + h * 64 + sc); } \
        else { const bf16_t* c_ = NAC + (size_t)(((t) - (hiw - lo)) * 64 + sk) * 2048 + h * 64 + sc; KR = *(const bf16x8*)c_; VR = *(const bf16x8*)(c_ + 1024); } } while (0)
#define NA_WRITE(KR, VR, b) do { *(bf16x8*)(lds + L_K + (b) * 16384 + kst) = KR; *(bf16x8*)(lds + L_V + (b) * 16384 + vst) = VR; } while (0)
    NA_LOAD(kA, vA, 0); NA_WRITE(kA, vA, 0);
    NA_LOAD(kB, vB, 1);
    __syncthreads();
    float m_reg = -1e30f, l_reg = 0.f; f32x16 o[2] = {};
    const int vb0 = (int)(uintptr_t)lds + L_V + attn::v_rd_base(lane);
#define NA_TILE(t, KW, VW, KL, VL) do { \
        if ((t) + 2 < NT) NA_LOAD(KL, VL, (t) + 2);            \
        const bool is_ctx = (t) >= hiw - lo; const int kr = lo + (t); \
        if (is_ctx || (kr >= my_r0 && kr < my_r0 + WH)) { \
            const char* Ks = lds + L_K + ((t) & 1) * 16384; \
            f32x16 p0 = {}, p1 = {}; \
            _Pragma("unroll") for (int d0 = 0; d0 < 4; ++d0) { const int cb = (d0 * 16 + hi * 8) * 2; \
                const bf16x8 b0 = *(const bf16x8*)(Ks + NKSWZ(r32, cb)), b1 = *(const bf16x8*)(Ks + NKSWZ(32 + r32, cb)); \
                p0 = __builtin_amdgcn_mfma_f32_32x32x16_bf16(b0, qr[d0], p0, 0, 0, 0); p1 = __builtin_amdgcn_mfma_f32_32x32x16_bf16(b1, qr[d0], p1, 0, 0, 0); } \
            if (is_ctx) { \
                _Pragma("unroll") for (int q = 0; q < 16; ++q) { p0[q] *= 0.125f; p1[q] *= 0.125f; } \
            } else { \
                const float* brow = rpb_l + (kr - r + 7) * 31 + 15 - qc; \
                _Pragma("unroll") for (int q = 0; q < 16; ++q) { const int kc0 = attn::crow(q, hi), kc1 = kc0 + 32; \
                    const bool v0 = kc0 >= my_c0 && kc0 < my_c0 + 16, v1 = kc1 >= my_c0 && kc1 < my_c0 + 16; \
                    p0[q] = v0 ? p0[q] * 0.125f + brow[v0 ? kc0 : qc] : -1e30f; p1[q] = v1 ? p1[q] * 0.125f + brow[v1 ? kc1 : qc] : -1e30f; } \
            } \
            float pmax = p0[0]; \
            _Pragma("unroll") for (int q = 1; q < 16; ++q) pmax = fmaxf(pmax, p0[q]); \
            _Pragma("unroll") for (int q = 0; q < 16; ++q) pmax = fmaxf(pmax, p1[q]); \
            { auto rr = __builtin_amdgcn_permlane32_swap(__float_as_uint(pmax), __float_as_uint(pmax), false, false); pmax = fmaxf(__uint_as_float(rr[0]), __uint_as_float(rr[1])); } \
            const float mn = fmaxf(m_reg, pmax), alpha = __builtin_amdgcn_exp2f((m_reg - mn) * L2E), mnl = -mn * L2E; m_reg = mn; \
            float ps = 0.f; \
            _Pragma("unroll") for (int q = 0; q < 16; ++q) { p0[q] = __builtin_amdgcn_exp2f(fmaf(p0[q], L2E, mnl)); p1[q] = __builtin_amdgcn_exp2f(fmaf(p1[q], L2E, mnl)); ps += p0[q] + p1[q]; } \
            { auto rr = __builtin_amdgcn_permlane32_swap(__float_as_uint(ps), __float_as_uint(ps), false, false); ps = __uint_as_float(rr[0]) + __uint_as_float(rr[1]); } \
            l_reg = l_reg * alpha + ps; \
            if (__any(alpha < 1.f)) { if (hi == 0) wsf[r32] = alpha; asm volatile("s_waitcnt lgkmcnt(0)" ::: "memory"); \
                _Pragma("unroll") for (int d = 0; d < 2; ++d) _Pragma("unroll") for (int q = 0; q < 16; ++q) o[d][q] *= wsf[attn::crow(q, hi)]; } \
            bf16x8 pa0, pa1, pa2, pa3; ret::pk4(p0, 0, pa0); ret::pk4(p0, 8, pa1); ret::pk4(p1, 0, pa2); ret::pk4(p1, 8, pa3); \
            __builtin_amdgcn_sched_barrier(0); \
            const int vb = vb0 + ((t) & 1) * 16384; \
            attn::pv_one<0>(o[0], vb, pa0, pa1, pa2, pa3); attn::pv_one<1>(o[1], vb, pa0, pa1, pa2, pa3); \
        } \
        if ((t) + 1 < NT) NA_WRITE(KW, VW, ((t) + 1) & 1);     \
        __syncthreads(); } while (0)
    for (int t = 0; t < NT; t += 2) {
        NA_TILE(t, kB, vB, kA, vA);
        if (t + 1 < NT) NA_TILE(t + 1, kA, vA, kB, vB);
    }
#undef NA_TILE
#undef NA_LOAD
#undef NA_WRITE
    if (hi == 0) wsf[32 + r32] = l_reg; asm volatile("s_waitcnt lgkmcnt(0)" ::: "memory");
    bf16_t* Ow = ws_br(p) + (size_t)(CTXN + r * 64 + (wave & 1) * 32) * 2048 + h * 64;
#pragma unroll
    for (int q = 0; q < 16; ++q) { const int orow = attn::crow(q, hi); const float rl = __builtin_amdgcn_rcpf(wsf[32 + orow]);
#pragma unroll
        for (int d0 = 0; d0 < 2; ++d0) Ow[(size_t)orow * 2048 + d0 * 32 + r32] = (bf16_t)(attn::cvtpk(o[d0][q] * rl, 0.f) & 0xffffu); }
    __syncthreads();
}
#undef NKSWZ
}

namespace el {
typedef float f32x4 __attribute__((ext_vector_type(4)));
typedef unsigned u32x2 __attribute__((ext_vector_type(2)));
__device__ __forceinline__ float wsum(float v) { return rw::wave_sum(v); }
__device__ __forceinline__ unsigned pk(float lo, float hi) { unsigned r; asm volatile("v_cvt_pk_bf16_f32 %0, %1, %2" : "=v"(r) : "v"(lo), "v"(hi)); return r; }

__device__ __forceinline__ void mod_phase(const Params& p, char* lds) {
    int tid_ = threadIdx.x; asm volatile("" : "+v"(tid_));
    const int tid = tid_, ks = tid >> 6, jl = tid & 63;
    float* sc = (float*)lds; float* red = sc + 2048;
    for (int b = blockIdx.x; b < 2 * 48; b += gridDim.x) {
        const int l = b / 48, j = (b % 48) * 64 + jl;
        __syncthreads();
        for (int k = tid; k < 2048; k += NTHR) { const float x = k < 1024 ? p.c[k] : p.c_ctx[k - 1024]; sc[k] = x / (1.0f + __expf(-x)); }
        __syncthreads();
        const float* w = p.w_mod + (size_t)l * DM * 3072 + (size_t)(ks * 128) * 3072 + j; float a0 = 0.f, a1 = 0.f;
#pragma unroll 8
        for (int k = 0; k < 128; ++k) { const float wv = w[(size_t)k * 3072]; a0 += sc[ks * 128 + k] * wv; a1 += sc[1024 + ks * 128 + k] * wv; }
        red[ks * 64 + jl] = a0; red[512 + ks * 64 + jl] = a1;
        __syncthreads();
        if (tid < 128) { const int s = tid >> 6; float t = 0.f;
#pragma unroll
            for (int q = 0; q < 8; ++q) t += red[s * 512 + q * 64 + jl];
            ws_modv(p)[(l * 2 + s) * 3072 + j] = t + p.b_mod[l * 3072 + j]; }
    }
    __syncthreads();
}

template <int LAYER> __device__ __forceinline__ void modnorm_store(const Params& p, const f32x4 (&v)[4], int row, int lane) {
    const float* mv = ws_modv(p) + (LAYER * 2 + (row < CTXN ? 1 : 0)) * 3072; const float* g = p.g_pre + LAYER * DM;
    float ss = 0.f;
#pragma unroll
    for (int j = 0; j < 4; ++j) ss += (v[j][0] * v[j][0] + v[j][1] * v[j][1]) + (v[j][2] * v[j][2] + v[j][3] * v[j][3]);
    const float rstd = 1.0f / sqrtf(wsum(ss) * (1.0f / DM) + NORM_EPS);
    bf16_t* o = ws_xn(p) + (size_t)row * DM;
#pragma unroll
    for (int j = 0; j < 4; ++j) { const int c = lane * 4 + 256 * j;
        const f32x4 gg = *(const f32x4*)(g + c), sh = *(const f32x4*)(mv + c), sc = *(const f32x4*)(mv + 1024 + c);
        const f32x4 y = v[j] * rstd * gg * (sc + 1.0f) + sh;
        u32x2 w; w.x = pk(y[0], y[1]); w.y = pk(y[2], y[3]); *(u32x2*)(o + c) = w; }
}
__device__ __forceinline__ void prenorm0_phase(const Params& p) {
    int tid_ = threadIdx.x; asm volatile("" : "+v"(tid_));
    const int lane = tid_ & 63, gw = (int)blockIdx.x * NWAVES + (tid_ >> 6), ngw = (int)gridDim.x * NWAVES;
    for (int row = gw; row < R; row += ngw) {
        const float* src = row < CTXN ? p.ctx + (size_t)row * DM : p.x + (size_t)(row - CTXN) * DM;
        f32x4 v[4];
#pragma unroll
        for (int j = 0; j < 4; ++j) v[j] = *(const f32x4*)(src + lane * 4 + 256 * j);
        modnorm_store<0>(p, v, row, lane);
    }
}
template <int LAYER> __device__ __forceinline__ void resid_phase(const Params& p) {
    int tid_ = threadIdx.x; asm volatile("" : "+v"(tid_));
    const int lane = tid_ & 63, gw = (int)blockIdx.x * NWAVES + (tid_ >> 6), ngw = (int)gridDim.x * NWAVES;
    for (int row = (LAYER == 0 ? 0 : CTXN) + gw; row < R; row += ngw) {
        const bool ctxsum = LAYER == 0 && row < CTXN;
        const float* y = ctxsum ? (const float*)(p.ws + WS_BIG + 72 * MiB) + (size_t)row * DM : ws_y(p) + (size_t)row * DM; const float* mv = ws_modv(p) + (LAYER * 2 + (row < CTXN ? 1 : 0)) * 3072 + 2048; const float* g = p.g_post + LAYER * DM;
        const float* src; float* dst;
        if (row < CTXN) { src = p.ctx + (size_t)row * DM; dst = ws_ctx1(p) + (size_t)row * DM; }
        else { src = (LAYER == 0 ? p.x : p.out) + (size_t)(row - CTXN) * DM; dst = p.out + (size_t)(row - CTXN) * DM; }
        f32x4 yv[4]; float ss = 0.f;
#pragma unroll
        for (int j = 0; j < 4; ++j) { yv[j] = *(const f32x4*)(y + lane * 4 + 256 * j);
            if (ctxsum) { _Pragma("unroll") for (int s = 1; s < 8; ++s) yv[j] += *(const f32x4*)(y + (size_t)s * CTXN * DM + lane * 4 + 256 * j); }
            ss += (yv[j][0] * yv[j][0] + yv[j][1] * yv[j][1]) + (yv[j][2] * yv[j][2] + yv[j][3] * yv[j][3]); }
        const float rstd = 1.0f / sqrtf(wsum(ss) * (1.0f / DM) + NORM_EPS);
        f32x4 xn[4];
#pragma unroll
        for (int j = 0; j < 4; ++j) { const int c = lane * 4 + 256 * j;
            xn[j] = *(const f32x4*)(src + c) + *(const f32x4*)(mv + c) * (yv[j] * rstd * *(const f32x4*)(g + c));
            *(f32x4*)(dst + c) = xn[j]; }
        if (LAYER == 0) modnorm_store<1>(p, xn, row, lane);
    }
}
__device__ __forceinline__ void ropenorm_phase(const Params& p) {
    int tid_ = threadIdx.x; asm volatile("" : "+v"(tid_));
    const int lane = tid_ & 63, gw = (int)blockIdx.x * NWAVES + (tid_ >> 6), ngw = (int)gridDim.x * NWAVES;
    const float* ct = ws_rope(p); const float* st = ct + N_ROPE;
    const float qn0 = p.q_norm[2 * lane], qn1 = p.q_norm[2 * lane + 1], kn0 = p.k_norm[2 * lane], kn1 = p.k_norm[2 * lane + 1];
    for (int row = gw; row < R; row += ngw) {
        const bool rot = row >= CTXN; const int t = row - CTXN; float cs = 1.f, sn = 0.f;
        if (rot) { const int pos = lane < 32 ? t / GW : t % GW, f = lane & 31; cs = ct[pos * 32 + f]; sn = st[pos * 32 + f]; }
        bf16_t* base = ws_big(p) + (size_t)row * P0W;
#pragma unroll
        for (int slot = 0; slot < 18; ++slot) {
            const int col = slot < 4 ? C_QA + slot * 128 : slot < 8 ? C_KA + (slot - 4) * 128 : slot < 16 ? C_QB + (slot - 8) * 128 : C_KB + (slot - 16) * 128;
            unsigned* ptr = (unsigned*)(base + col) + lane; const unsigned u = *ptr;
            float x1 = __uint_as_float(u << 16), x2 = __uint_as_float(u & 0xffff0000u);
            if (slot >= 4 && slot < 8) { x1 *= 0.08838834764831845f; x2 *= 0.08838834764831845f; }
            if (slot >= 8) { const float sc = 1.0f / sqrtf(wsum(x1 * x1 + x2 * x2) * (1.0f / 128.f) + NORM_EPS);
                x1 *= sc * (slot < 16 ? qn0 : kn0); x2 *= sc * (slot < 16 ? qn1 : kn1); }
            *ptr = pk(x1 * cs - x2 * sn, x1 * sn + x2 * cs);
        }
    }
}
}

constexpr int RING_BYTES = 131072, LDS_BYTES = 163840;
constexpr size_t WS_BAR = 256 * 1024;
constexpr size_t WS_SIDE = 255 * MiB;
constexpr size_t WS_YC = WS_BIG + 72 * MiB;
constexpr int LDS_BARW = LDS_BYTES - 64;
constexpr size_t WB_IN0 = WS_WB, WB_OUT0 = WB_IN0 + (size_t)EVEN_IN * DM * 2, WB_IN1 = WB_OUT0 + (size_t)DM * 2048 * 2, WB_OUT1 = WB_IN1 + (size_t)ODD_IN * DM * 2, WB_END = WB_OUT1 + (size_t)DM * 2048 * 2;
static_assert(WB_END <= WS_XN, "weight copies overflow their region");
static_assert(wy::WS_RING + wy::RING_TOTAL <= WB_IN1 && XCD_BAR_WORDS * 4 <= 16384 && wy::WS_WYF + (size_t)wy::WYF_WORDS * 4 <= WS_CTX1, "rwkv ring / flag words");

__device__ __forceinline__ unsigned pk2(float lo, float hi) { return (unsigned)f2bf(lo) | ((unsigned)f2bf(hi) << 16); }
__device__ __forceinline__ void transpose_item(const float* W, int K, int N, int ldw, bf16_t* WT, LAS float* scr, int item, int lane) {
    const int nblk = N / 32, kb = item / nblk, nb = item % nblk, k0 = 64 * kb, n0 = 32 * nb;
#pragma unroll 8
    for (int i = 0; i < 32; ++i) { const int kk = 2 * i + (lane >> 5); scr[kk * 33 + (lane & 31)] = W[(size_t)(k0 + kk) * ldw + n0 + (lane & 31)]; }
    asm volatile("s_waitcnt lgkmcnt(0)" ::: "memory");
    const int c = lane & 7;
#pragma unroll
    for (int j = 0; j < 4; ++j) { const int n = (lane >> 3) + 8 * j; const LAS float* s = scr + (8 * c) * 33 + n;
        v4u o; o.x = pk2(s[0 * 33], s[1 * 33]); o.y = pk2(s[2 * 33], s[3 * 33]); o.z = pk2(s[4 * 33], s[5 * 33]); o.w = pk2(s[6 * 33], s[7 * 33]);
        *(v4u*)(WT + (size_t)(n0 + n) * K + k0 + 8 * c) = o; }
    asm volatile("s_waitcnt lgkmcnt(0)" ::: "memory");
}
__device__ __forceinline__ void p0_weights(const Params& p, LAS unsigned char* lds) {
    const int lane = threadIdx.x & 63, wave = __builtin_amdgcn_readfirstlane(threadIdx.x >> 6);
    LAS float* scr = (LAS float*)(lds + wave * 16384);
    const int gw = blockIdx.x * NWAVES + wave, NGW = gridDim.x * NWAVES;
    constexpr int I_IN0 = (DM / 64) * (EVEN_IN / 32), I_OUT = (2048 / 64) * (DM / 32), I_IN1 = (DM / 64) * (ODD_IN / 32);
    for (int it = gw; it < I_IN0 + I_OUT + I_IN1 + I_OUT; it += NGW) {
        int r = it;
        if (r < I_IN0) { transpose_item(p.ev_w_in, DM, EVEN_IN, EVEN_IN, (bf16_t*)(p.ws + WB_IN0), scr, r, lane); continue; } r -= I_IN0;
        if (r < I_OUT) { transpose_item(p.ev_w_out, 2048, DM, DM, (bf16_t*)(p.ws + WB_OUT0), scr, r, lane); continue; } r -= I_OUT;
        if (r < I_IN1) { transpose_item(p.od_w_in, DM, ODD_IN, ODD_IN, (bf16_t*)(p.ws + WB_IN1), scr, r, lane); continue; } r -= I_IN1;
        transpose_item(p.od_w_out, 2048, DM, DM, (bf16_t*)(p.ws + WB_OUT1), scr, r, lane);
    }
}

template <class Epi> __device__ __forceinline__ void run_gemm(LAS unsigned char* lds, const bf16_t* A, const bf16_t* Bt, int M, int N, int K, const Epi& E, int rot = 0, int lda = 0, int ldb = 0) {
    const int G = (int)gridDim.x;
    pg8::Gemm g{A, Bt, M, N, K, lda, ldb}; pg8::StaticOrder S; S.init(M, N, G, ((int)blockIdx.x + rot) % G);
    pg8::gemm_phase<Epi, pg8::StaticOrder, true, true>(lds, g, S, E);
}
__device__ __forceinline__ int tail_rot(int units) { const int G = (int)gridDim.x; return (G - units % G) % G; }

#ifndef PROBE
#define PROBE 0
#endif
#define REP(bit) for (int rep_ = 0; rep_ < (((PROBE) >> (bit)) & 1) + 1; ++rep_)
__global__ void __launch_bounds__(NTHR, 2) mega(Params p) {
    extern __shared__ __attribute__((aligned(16))) unsigned char lds_raw[];
    cg::grid_group grid = cg::this_grid();
    LAS unsigned char* lds = (LAS unsigned char*)lds_raw;
    const long gsz = (long)gridDim.x * NTHR;
    if (threadIdx.x < 2) *(LAS unsigned*)(lds + LDS_BARW + 4 * threadIdx.x) = 0u;
    __syncthreads();
    const XcdBarrier xbar = xcd_barrier_post((unsigned*)(p.ws + WS_BAR), (volatile LAS unsigned*)(lds + LDS_BARW));
    const bf16_t* wt_in0 = (const bf16_t*)(p.ws + WB_IN0); const bf16_t* wt_out0 = (const bf16_t*)(p.ws + WB_OUT0);
    const bf16_t* wt_in1 = (const bf16_t*)(p.ws + WB_IN1); const bf16_t* wt_out1 = (const bf16_t*)(p.ws + WB_OUT1);
#define X(fn, n) { int t_ = threadIdx.x; asm volatile("" : "+v"(t_)); for (long g = (long)blockIdx.x * NTHR + t_; g < (long)(n); g += gsz) fn(p, g); }
#define SYNC xcd_barrier(xbar);
    if ((PROBE >> 13) & 1) { for (int i_ = 0; i_ < 20; ++i_) xcd_barrier(xbar); }
    REP(14) { el::mod_phase(p, (char*)lds_raw); X(ph_rope_table, N_ROPE) p0_weights(p, lds);
              if (p.out == nullptr) grid.sync();
              SYNC }
    REP(15) { el::prenorm0_phase(p); SYNC }
    REP(2) { run_gemm(lds, ws_xn(p), wt_in0, R, P0W, DM, pg8::EpiBf16<0>{ws_big(p), P0W, nullptr, 0, 0, 1.f});
             run_gemm(lds, ws_xn(p), wt_in0 + (size_t)C_GA * DM, CTXN, 2048, DM, pg8::EpiSiluBf16{(bf16_t*)(p.ws + WS_SIDE), 2048}, tail_rot((R / 256) * (P0W / 256)));
             SYNC }
    el::ropenorm_phase(p); SYNC
    REP(5) { for (int u = blockIdx.x; u < ret::NQ * 4; u += gridDim.x) { const int q = u < (ret::NQ - 2) * 4 ? 2 + u / 4 : (u - (ret::NQ - 2) * 4) / 4; ret::summaries_unit(p, q, u & 3, (char*)lds_raw); } SYNC }
    ret::state_scan(p); SYNC
#define CTX_ATTN_UNIT(head_) do { const int hd_ = (head_), kv_ = hd_ / 4; const bf16_t* P_ = ws_big(p); bf16_t* BR_ = ws_br(p); \
        attn::attn_dense_body<attn::bf16, false>(P_ + C_QB + hd_ * 128, P_ + C_KB + kv_ * 128, P_ + C_VB + kv_ * 128, BR_ + 1024 + hd_ * 128, CTXN, (char*)lds_raw); \
        __syncthreads(); \
        {     \
            int t_ = threadIdx.x; asm volatile("" : "+v"(t_)); const bf16_t* GC = (const bf16_t*)(p.ws + WS_SIDE); \
            const size_t o = (size_t)(t_ >> 1) * 2048 + 1024 + hd_ * 128 + (t_ & 1) * 64; \
            _Pragma("unroll") for (int i_ = 0; i_ < 8; ++i_) { v4u a = *(const v4u*)(BR_ + o + 8 * i_); const v4u b = *(const v4u*)(GC + o + 8 * i_); \
                _Pragma("unroll") for (int q_ = 0; q_ < 4; ++q_) a[q_] = attn::cvtpk(__uint_as_float(a[q_] << 16) * __uint_as_float(b[q_] << 16), __uint_as_float(a[q_] & 0xffff0000u) * __uint_as_float(b[q_] & 0xffff0000u)); \
                *(v4u*)(BR_ + o + 8 * i_) = a; } \
            __syncthreads(); } } while (0)
    const bool ctx_attn_early = gridDim.x >= 16;
    REP(6) { for (int u = blockIdx.x; u < ret::NQ * 4; u += gridDim.x) { const int q = u < (ret::NQ - 2) * 4 ? 2 + u / 4 : (u - (ret::NQ - 2) * 4) / 4; ret::output_unit(p, q, u & 3, (char*)lds_raw); }
             if (ctx_attn_early && (int)blockIdx.x >= (int)gridDim.x - 8) CTX_ATTN_UNIT((int)blockIdx.x - ((int)gridDim.x - 8));
             SYNC }
    REP(0) {
        const int G = (int)gridDim.x, vcu = (G % 8 == 0) ? ((int)blockIdx.x % 8) * (G / 8) + (int)blockIdx.x / 8 : (int)blockIdx.x;
        const int NLAT = (SEQ / 256) * 8, per = (NLAT + G - 1) / G;
        const bf16_t* P = ws_big(p); bf16_t* BR = ws_br(p);
        bool nomax; { int t_ = threadIdx.x; asm volatile("" : "+v"(t_)); const int l_ = t_ & 63; float gq = fmaxf(fabsf(p.q_norm[l_]), fabsf(p.q_norm[64 + l_])), gk = fmaxf(fabsf(p.k_norm[l_]), fabsf(p.k_norm[64 + l_]));
          for (int m_ = 32; m_ >= 1; m_ >>= 1) { gq = fmaxf(gq, __shfl_xor(gq, m_)); gk = fmaxf(gk, __shfl_xor(gk, m_)); }
          nomax = 11.3137085f * 1.4426950409f * 1.02f * gq * gk <= 40.0f; }
        for (int i = 0; i <= per; ++i) {
            int head, row0, seq;
            if (i < per) { const int unit = vcu * per + i; if (unit >= NLAT) continue; const int nqb = SEQ / 256, kv = unit / (4 * nqb), rem = unit % (4 * nqb); head = kv * 4 + rem / nqb; row0 = CTXN + (rem % nqb) * 256; seq = R; }
            else { if (ctx_attn_early || vcu >= 8) break; CTX_ATTN_UNIT(vcu); break; }
            const int kv = head / 4;
            if (nomax) attn::attn_dense_body<attn::bf16, true>(P + (size_t)row0 * P0W + C_QB + head * 128, P + C_KB + kv * 128, P + C_VB + kv * 128, BR + (size_t)row0 * 2048 + 1024 + head * 128, seq, (char*)lds_raw);
            else attn::attn_dense_body<attn::bf16, false>(P + (size_t)row0 * P0W + C_QB + head * 128, P + C_KB + kv * 128, P + C_VB + kv * 128, BR + (size_t)row0 * 2048 + 1024 + head * 128, seq, (char*)lds_raw);
            __syncthreads();
        }
        if (PROBE & 1) xcd_barrier(xbar);
    }
    SYNC
    run_gemm(lds, ws_xn(p) + (size_t)CTXN * DM, wt_in0 + (size_t)C_GA * DM, SEQ, 2048, DM, pg8::EpiGateMul{ws_br(p) + (size_t)CTXN * 2048, 2048});
    {
        pg8::Gemm gk{ws_br(p), wt_out0, 8 * 256, DM, 256, 2048, 2048, 256 * 2}; pg8::StaticOrder S; S.init(8 * 256, DM, (int)gridDim.x, (int)blockIdx.x);
        pg8::gemm_phase<pg8::EpiF32, pg8::StaticOrder, true, true>(lds, gk, S, pg8::EpiF32{(float*)(p.ws + WS_YC), DM}); }
    SYNC
    REP(4) { run_gemm(lds, ws_br(p) + (size_t)CTXN * 2048, wt_out0, SEQ, DM, 2048, pg8::EpiF32{ws_y(p) + (size_t)CTXN * DM, DM}); SYNC }
    REP(15) { el::resid_phase<0>(p); SYNC }
    REP(3) { run_gemm(lds, ws_xn(p), wt_in1 + (size_t)O_RW * DM, R, ZW, DM, pg8::EpiBf16Halo{ws_big(p), ZW, (bf16_t*)(p.ws + rw::WS_HALO)});
             run_gemm(lds, ws_xn(p), wt_in1 + (size_t)(O_NA + 1024) * DM, CTXN, 2048, DM, pg8::EpiBf16<0>{(bf16_t*)(p.ws + WS_SIDE), 2048, nullptr, 0, 0, 1.f}, tail_rot((R / 256) * (ZW / 256)));
             SYNC }
    rw::shift_inplace(p); wy::zero_words(p); SYNC
#ifndef PSKIP
#define PSKIP 0
#endif
    if ((PROBE >> 16) & 1) { wy::phase<1, PSKIP>(p, lds); SYNC wy::zero_words(p); SYNC }
    if ((PROBE >> 17) & 1) { wy::phase<2>(p, lds); SYNC wy::zero_words(p); SYNC }
    if ((PROBE >> 19) & 1) { wy::phase<4, 16>(p, lds); SYNC wy::zero_words(p); SYNC }
    if ((PROBE >> 18) & 1) { wy::phase<3>(p, lds); SYNC wy::zero_words(p); SYNC }
    if (gridDim.x >= 64) wy::phase<0>(p, lds);
    else { for (int b = blockIdx.x; b < 256; b += gridDim.x) rw::scan_block<0>(p, b, lds); }
    SYNC
    rw::finish_phase(p); SYNC
    REP(3) { run_gemm(lds, ws_xn(p) + (size_t)CTXN * DM, wt_in1 + (size_t)O_NA * DM, SEQ, NAW, DM, pg8::EpiBf16<0>{ws_big(p) + (size_t)CTXN * NAW, NAW, nullptr, 0, 0, 1.f}); SYNC }
    REP(7) { for (int u = blockIdx.x; u < (GROWS / 4) * 16; u += gridDim.x) na::na_unit(p, u >> 4, u & 15, (char*)lds_raw); SYNC }
    run_gemm(lds, ws_xn(p) + (size_t)CTXN * DM, wt_in1 + (size_t)O_GC * DM, SEQ, 2048, DM, pg8::EpiGateMul{ws_br(p) + (size_t)CTXN * 2048, 2048}); SYNC
    REP(4) { run_gemm(lds, ws_br(p) + (size_t)CTXN * 2048, wt_out1, SEQ, DM, 2048, pg8::EpiF32{ws_y(p) + (size_t)CTXN * DM, DM}); SYNC }
    el::resid_phase<1>(p);
#undef X
#undef SYNC
}

extern "C" void kernel_launch(void* const* d_in, const int* in_sizes, int n_in, void* d_out, int out_size, void* d_ws, size_t ws_size, hipStream_t stream) {
    static int grid_blocks = 0;
    if (!grid_blocks) {
        int dev = 0, cus = 0, per_cu = 0;
        (void)hipGetDevice(&dev); (void)hipDeviceGetAttribute(&cus, hipDeviceAttributeMultiprocessorCount, dev);
        (void)hipFuncSetAttribute((const void*)mega, hipFuncAttributeMaxDynamicSharedMemorySize, LDS_BYTES);
        (void)hipOccupancyMaxActiveBlocksPerMultiprocessor(&per_cu, mega, NTHR, LDS_BYTES);
        if (per_cu < 1) per_cu = 1;
        grid_blocks = cus * per_cu;
        if (ws_size < WS_END) fprintf(stderr, "kernel_launch: workspace too small: %zu < %zu\n", ws_size, (size_t)WS_END);
    }
    (void)hipMemsetAsync((char*)d_ws + WS_BAR, 0, XCD_BAR_WORDS * 4, stream);
    Params p = make_params(d_in, d_out, d_ws);
    void* args[] = {&p};
    hipError_t e = hipLaunchCooperativeKernel((void*)mega, dim3(grid_blocks), dim3(NTHR), args, LDS_BYTES, stream);
    if (e != hipSuccess) fprintf(stderr, "cooperative launch failed: %s (grid %d)\n", hipGetErrorString(e), grid_blocks);
}

#else
int main(int argc, char** argv) {
    const char* dir = argc > 1 ? argv[1] : "data";
    char path[512]; snprintf(path, 512, "%s/sizes.txt", dir); FILE* f = fopen(path, "r"); if (!f) { printf("no sizes\n"); return 1; }
    std::vector<long> sizes; long v; while (fscanf(f, "%ld", &v) == 1) sizes.push_back(v); fclose(f);
    if (sizes.size() != 31) { printf("bad n inputs %zu\n", sizes.size()); return 1; }
    snprintf(path, 512, "%s/inputs.bin", dir); f = fopen(path, "rb");
    std::vector<std::vector<float>> in(31); std::vector<void*> ptrs(31);
    for (int i = 0; i < 31; ++i) { in[i].resize(sizes[i]); if (fread(in[i].data(), 4, sizes[i], f) != (size_t)sizes[i]) { printf("short read\n"); return 1; } ptrs[i] = in[i].data(); }
    fclose(f);
    if (sizes[0] != (long)SEQ * DM) { printf("SEQ mismatch: build with -DSEQ_LEN=%ld\n", sizes[0] / DM); return 1; }
    std::vector<float> out((size_t)SEQ * DM, 0.f); std::vector<unsigned char> ws(WS_END, 0xAA);
    Params p = make_params(ptrs.data(), out.data(), ws.data());
    auto check = [&](const char* name, const float* got, size_t n) {
        snprintf(path, 512, "%s/%s", dir, name); FILE* g = fopen(path, "rb"); std::vector<float> ref(n); if (fread(ref.data(), 4, n, g) != n) printf("short ref\n"); fclose(g);
        double num = 0, den = 0, mx = 0; for (size_t i = 0; i < n; ++i) { const double d = (double)got[i] - ref[i]; num += d * d; den += (double)ref[i] * ref[i]; if (fabs(d) > mx) mx = fabs(d); }
        printf("%s: rvr=%.3e absmax=%.3e\n", name, num / den, mx); };
    static RwShared sh;
    int phase = 0;
#define X(fn, n) { printf("phase %d %s n=%ld\n", phase++, #fn, (long)(n)); fflush(stdout); _Pragma("omp parallel for schedule(dynamic, 64)") for (long g = 0; g < (long)(n); ++g) fn(p, g); }
#define SYNC
#define SCAN { printf("phase %d scan\n", phase++); fflush(stdout); _Pragma("omp parallel for schedule(dynamic, 1)") for (int b = 0; b < 32; ++b) { RwShared* s = new RwShared; rwkv_scan_block(p, b, *s); delete s; } }
    X(ph_mod, N_MOD) X(ph_rope_table, N_ROPE) X(ph_prenorm<0>, (long)R) X(ph_gemm_l0_qkv, (long)R * P0W) X(ph_ropenorm, N_ROPENORM) X(ph_ret_scan, N_RETSCAN)
    X(ph_ret_merge, N_RETMERGE) X(ph_gqa_attn, N_GQA) X(ph_gemm_l0_gate, (long)R * 2048) X(ph_gemm_l0_out, (long)R * DM) X(ph_resid<0>, (long)R)
    check("x0.bin", out.data(), out.size()); check("ctx0.bin", ws_ctx1(p), (size_t)CTXN * DM);
    X(ph_prenorm<1>, (long)R) X(ph_gemm_l1_rw, (long)R * ZW) SCAN X(ph_rwkv_finish, N_RWFIN) X(ph_gemm_l1_na, (long)R * NAW) X(ph_na, N_NA)
    X(ph_gemm_l1_gate, (long)SEQ * 2048) X(ph_gemm_l1_out, (long)SEQ * DM) X(ph_resid<1>, (long)SEQ)
    check("out.bin", out.data(), out.size());
    return 0;
}
#endif
```

```cpp
#ifdef CPU_EMU
#include <cstdio>
#include <cstdlib>
#include <cstring>
#include <cmath>
#include <vector>
#define DEV static inline
#else
#include <hip/hip_runtime.h>
#include <hip/hip_cooperative_groups.h>
#include <cstdio>
namespace cg = cooperative_groups;
#define DEV __device__ __forceinline__
#endif

#ifndef SEQ_LEN
#define SEQ_LEN 16384
#endif
typedef unsigned short bf16_t;
constexpr int DM = 1024, CTXN = 256, SEQ = SEQ_LEN, R = CTXN + SEQ, GW = 64, GROWS = SEQ / GW;
constexpr int EVEN_IN = 5632, ODD_IN = 8448;
constexpr int P0W = 3584;
constexpr int C_QA = 0, C_KA = 512, C_VA = 1024, C_QB = 2048, C_KB = 3072, C_VB = 3328, C_GA = 3584;
constexpr int ZW = 3328;
constexpr int O_NA = 0, O_RW = 3072, O_GC = 6400;
constexpr int NAW = 3072;
constexpr float NORM_EPS = 1e-6f, GN_EPS = 64e-5f;

constexpr size_t MiB = 1u << 20;
constexpr size_t WS_MODV = 0;
constexpr size_t WS_ROPE = 64 * 1024;
constexpr size_t WS_CTX1 = 1 * MiB;
constexpr size_t WS_WB = 2 * MiB;
constexpr size_t WS_XN = 42 * MiB;
constexpr size_t WS_BIG = WS_XN + (((size_t)R * DM * 2 + MiB - 1) / MiB) * MiB;
constexpr size_t WS_BR = WS_BIG + (((size_t)R * P0W * 2 + MiB - 1) / MiB) * MiB;
constexpr size_t WS_END = WS_BR + (size_t)R * 2048 * 2;
static_assert(SEQ != 16384 || WS_END <= 256 * MiB, "workspace map exceeds 256 MiB");

struct Params {
    const float *x, *c, *ctx, *c_ctx, *w_mod, *b_mod, *g_pre, *g_post, *ev_w_in, *ev_w_out, *dec_f, *dec_b, *q_norm, *k_norm;
    const float *od_w_in, *od_w_out, *rpb, *mu, *w0f, *w2f, *w0b, *w2b, *a0f, *a2f, *a0b, *a2b, *k_k, *k_a, *r_k, *lnx_g, *lnx_b;
    float* out; unsigned char* ws;
};

DEV bf16_t f2bf(float f) { unsigned u; __builtin_memcpy(&u, &f, 4); u = (u + 0x7fffu + ((u >> 16) & 1u)) >> 16; return (bf16_t)u; }
DEV float bf2f(bf16_t h) { unsigned u = ((unsigned)h) << 16; float f; __builtin_memcpy(&f, &u, 4); return f; }
DEV float siluf(float x) { return x / (1.0f + expf(-x)); }
DEV float sigmf(float x) { return 1.0f / (1.0f + expf(-x)); }
DEV float softplusf(float x) { return fmaxf(x, 0.f) + log1pf(expf(-fabsf(x))); }

DEV float* ws_modv(const Params& p) { return (float*)(p.ws + WS_MODV); }
DEV float* ws_rope(const Params& p) { return (float*)(p.ws + WS_ROPE); }
DEV float* ws_ctx1(const Params& p) { return (float*)(p.ws + WS_CTX1); }
DEV bf16_t* ws_xn(const Params& p) { return (bf16_t*)(p.ws + WS_XN); }
DEV bf16_t* ws_big(const Params& p) { return (bf16_t*)(p.ws + WS_BIG); }
DEV float* ws_y(const Params& p) { return (float*)(p.ws + WS_BIG); }
DEV bf16_t* ws_br(const Params& p) { return (bf16_t*)(p.ws + WS_BR); }

constexpr long N_MOD = 2 * 2 * 3072;
DEV void ph_mod(const Params& p, long gid) {
    const int j = (int)(gid % 3072), s = (int)((gid / 3072) % 2), l = (int)(gid / 6144);
    const float* cv = s ? p.c_ctx : p.c; const float* w = p.w_mod + (size_t)l * DM * 3072 + j;
    float acc = 0.f;
    for (int k = 0; k < DM; ++k) acc += siluf(cv[k]) * w[(size_t)k * 3072];
    ws_modv(p)[gid] = acc + p.b_mod[l * 3072 + j];
}
constexpr long N_ROPE = 256 * 32;
DEV void ph_rope_table(const Params& p, long gid) {
    const int f = (int)(gid % 32), pos = (int)(gid / 32);
    const float inv = powf(10000.0f, -(float)f / 32.0f); const float ang = (float)pos * inv;
    ws_rope(p)[gid] = cosf(ang); ws_rope(p)[N_ROPE + gid] = sinf(ang);
}
template <int LAYER> DEV void ph_prenorm(const Params& p, long gid) {
    const int row = (int)gid; const int s = row < CTXN ? 1 : 0;
    const float* src = row < CTXN ? ((LAYER == 0 ? p.ctx : ws_ctx1(p)) + (size_t)row * DM) : ((LAYER == 0 ? p.x : p.out) + (size_t)(row - CTXN) * DM);
    const float* mv = ws_modv(p) + (LAYER * 2 + s) * 3072; const float* g = p.g_pre + LAYER * DM;
    float ss = 0.f;
    for (int k = 0; k < DM; ++k) ss += src[k] * src[k];
    const float rstd = 1.0f / sqrtf(ss / DM + NORM_EPS);
    bf16_t* o = ws_xn(p) + (size_t)row * DM;
    for (int k = 0; k < DM; ++k) o[k] = f2bf(src[k] * rstd * g[k] * (1.0f + mv[1024 + k]) + mv[k]);
}
template <int MODE> DEV void gemm_item(const bf16_t* A, int K, const float* W, int ldw, void* out, int pitch, int row, int col) {
    const bf16_t* a = A + (size_t)row * K; const float* w = W + col; float acc = 0.f;
    for (int k = 0; k < K; ++k) acc += bf2f(a[k]) * w[(size_t)k * ldw];
    if (MODE == 0) ((bf16_t*)out)[(size_t)row * pitch + col] = f2bf(acc);
    else if (MODE == 1) { bf16_t* o = (bf16_t*)out + (size_t)row * pitch + col; *o = f2bf(siluf(acc) * bf2f(*o)); }
    else ((float*)out)[(size_t)row * pitch + col] = acc;
}
DEV void ph_gemm_l0_qkv(const Params& p, long gid) { gemm_item<0>(ws_xn(p), DM, p.ev_w_in, EVEN_IN, ws_big(p), P0W, (int)(gid / P0W), (int)(gid % P0W)); }
DEV void ph_gemm_l0_gate(const Params& p, long gid) { gemm_item<1>(ws_xn(p), DM, p.ev_w_in + C_GA, EVEN_IN, ws_br(p), 2048, (int)(gid / 2048), (int)(gid % 2048)); }
DEV void ph_gemm_l0_out(const Params& p, long gid) { gemm_item<2>(ws_br(p), 2048, p.ev_w_out, DM, ws_y(p), DM, (int)(gid / DM), (int)(gid % DM)); }
DEV void ph_gemm_l1_rw(const Params& p, long gid) { gemm_item<0>(ws_xn(p), DM, p.od_w_in + O_RW, ODD_IN, ws_big(p), ZW, (int)(gid / ZW), (int)(gid % ZW)); }
DEV void ph_gemm_l1_na(const Params& p, long gid) { gemm_item<0>(ws_xn(p), DM, p.od_w_in + O_NA, ODD_IN, ws_big(p), NAW, (int)(gid / NAW), (int)(gid % NAW)); }
DEV void ph_gemm_l1_gate(const Params& p, long gid) { gemm_item<1>(ws_xn(p), DM, p.od_w_in + O_GC, ODD_IN, ws_br(p), 2048, CTXN + (int)(gid / 2048), (int)(gid % 2048)); }
DEV void ph_gemm_l1_out(const Params& p, long gid) { gemm_item<2>(ws_br(p), 2048, p.od_w_out, DM, ws_y(p), DM, CTXN + (int)(gid / DM), (int)(gid % DM)); }

constexpr long N_ROPENORM = (long)R * 18;
DEV void ph_ropenorm(const Params& p, long gid) {
    const int slot = (int)(gid % 18), row = (int)(gid / 18);
    int col; const float* nw = nullptr; float sc = 1.f;
    if (slot < 4) col = C_QA + slot * 128; else if (slot < 8) { col = C_KA + (slot - 4) * 128; sc = 0.08838834764831845f; }
    else if (slot < 16) { col = C_QB + (slot - 8) * 128; nw = p.q_norm; } else { col = C_KB + (slot - 16) * 128; nw = p.k_norm; }
    bf16_t* v = ws_big(p) + (size_t)row * P0W + col;
    if (nw) { float ss = 0.f; for (int d = 0; d < 128; ++d) { const float t = bf2f(v[d]); ss += t * t; } sc = 1.0f / sqrtf(ss / 128.f + NORM_EPS); }
    const bool rot = row >= CTXN; const int t = row - CTXN; const int gr = rot ? t / GW : 0, gc = rot ? t % GW : 0;
    const float* ct = ws_rope(p); const float* st = ct + N_ROPE;
    for (int i = 0; i < 64; ++i) {
        float x1 = bf2f(v[2 * i]) * sc, x2 = bf2f(v[2 * i + 1]) * sc;
        if (nw) { x1 *= nw[2 * i]; x2 *= nw[2 * i + 1]; }
        if (rot) { const int pos = i < 32 ? gr : gc, f = i & 31; const float cs = ct[pos * 32 + f], sn = st[pos * 32 + f]; const float y1 = x1 * cs - x2 * sn, y2 = x1 * sn + x2 * cs; x1 = y1; x2 = y2; }
        v[2 * i] = f2bf(x1); v[2 * i + 1] = f2bf(x2);
    }
}
constexpr long N_RETSCAN = 2 * 4 * 256;
DEV void ph_ret_scan(const Params& p, long gid) {
    const int e = (int)(gid % 256), h = (int)((gid / 256) % 4), dir = (int)(gid / 1024);
    const float g = sigmf((dir ? p.dec_b : p.dec_f)[h]);
    float S[128];
#pragma unroll
    for (int d = 0; d < 128; ++d) S[d] = 0.f;
    const bf16_t* P = ws_big(p); bf16_t* BR = ws_br(p);
    for (int pos = 0; pos < R; ++pos) {
        int row; if (pos < CTXN) row = dir ? CTXN - 1 - pos : pos; else { const int t = pos - CTXN; row = CTXN + (dir ? SEQ - 1 - t : t); }
        const bf16_t* pr = P + (size_t)row * P0W; const float v = bf2f(pr[C_VA + h * 256 + e]);
        const bf16_t* kq = pr + C_KA + h * 128; const bf16_t* qq = pr + C_QA + h * 128; float y = 0.f;
#pragma unroll
        for (int d = 0; d < 128; ++d) { S[d] = g * S[d] + bf2f(kq[d]) * v; y += bf2f(qq[d]) * S[d]; }
        BR[(size_t)row * 2048 + dir * 1024 + h * 256 + e] = f2bf(y);
    }
}
constexpr long N_RETMERGE = (long)R * 4;
DEV void ph_ret_merge(const Params& p, long gid) {
    const int h = (int)(gid % 4), row = (int)(gid / 4);
    bf16_t* b = ws_br(p) + (size_t)row * 2048 + h * 256;
    float s = 0.f; for (int e = 0; e < 256; ++e) s += bf2f(b[e]) + bf2f(b[1024 + e]);
    const float mean = s / 256.f; float q = 0.f;
    for (int e = 0; e < 256; ++e) { const float d = bf2f(b[e]) + bf2f(b[1024 + e]) - mean; q += d * d; }
    const float rstd = 1.0f / sqrtf(q / 256.f + NORM_EPS);
    for (int e = 0; e < 256; ++e) b[e] = f2bf((bf2f(b[e]) + bf2f(b[1024 + e]) - mean) * rstd);
}
constexpr long N_GQA = (long)R * 8 * 8;
DEV void ph_gqa_attn(const Params& p, long gid) {
    const int sl = (int)(gid % 8), row = (int)((gid / 8) % R), head = (int)(gid / (8L * R)), g = head / 4;
    const bf16_t* P = ws_big(p); const int nk = row < CTXN ? CTXN : R;
    float q[128];
    { const bf16_t* qp = P + (size_t)row * P0W + C_QB + head * 128;
#pragma unroll
      for (int d = 0; d < 128; ++d) q[d] = bf2f(qp[d]) * 0.08838834764831845f; }
    float acc[16];
#pragma unroll
    for (int i = 0; i < 16; ++i) acc[i] = 0.f;
    float m = -1e30f, l = 0.f;
    for (int j = 0; j < nk; ++j) {
        const bf16_t* kp = P + (size_t)j * P0W + C_KB + g * 128; float s = 0.f;
#pragma unroll
        for (int d = 0; d < 128; ++d) s += q[d] * bf2f(kp[d]);
        const float mn = fmaxf(m, s), al = expf(m - mn), pe = expf(s - mn);
        const bf16_t* vp = P + (size_t)j * P0W + C_VB + g * 128 + sl * 16;
        l = l * al + pe;
#pragma unroll
        for (int i = 0; i < 16; ++i) acc[i] = acc[i] * al + pe * bf2f(vp[i]);
        m = mn;
    }
    bf16_t* o = ws_br(p) + (size_t)row * 2048 + 1024 + head * 128 + sl * 16; const float il = 1.0f / l;
#pragma unroll
    for (int i = 0; i < 16; ++i) o[i] = f2bf(acc[i] * il);
}
template <int LAYER> DEV void ph_resid(const Params& p, long gid) {
    const int row = LAYER == 0 ? (int)gid : CTXN + (int)gid; const int s = row < CTXN ? 1 : 0;
    const float* y = ws_y(p) + (size_t)row * DM; const float* mv = ws_modv(p) + (LAYER * 2 + s) * 3072 + 2048; const float* g = p.g_post + LAYER * DM;
    float ss = 0.f; for (int k = 0; k < DM; ++k) ss += y[k] * y[k];
    const float rstd = 1.0f / sqrtf(ss / DM + NORM_EPS);
    const float* src; float* dst;
    if (row < CTXN) { src = p.ctx + (size_t)row * DM; dst = ws_ctx1(p) + (size_t)row * DM; }
    else { src = (LAYER == 0 ? p.x : p.out) + (size_t)(row - CTXN) * DM; dst = p.out + (size_t)(row - CTXN) * DM; }
    for (int k = 0; k < DM; ++k) dst[k] = src[k] + mv[k] * (y[k] * rstd * g[k]);
}
DEV float zshift(const bf16_t* Z, const float* mu, int row, int col) {
    const int lo = row < CTXN ? 0 : CTXN, hi = row < CTXN ? CTXN : R;
    const float z = bf2f(Z[(size_t)row * ZW + col]);
    const float pv = row > lo ? bf2f(Z[(size_t)(row - 1) * ZW + col]) : 0.f, nx = row + 1 < hi ? bf2f(Z[(size_t)(row + 1) * ZW + col]) : 0.f;
    return z + (0.5f * (pv + nx) - z) * mu[col];
}
constexpr long N_RWFIN = (long)SEQ * 16;
DEV void ph_rwkv_finish(const Params& p, long gid) {
    const int h = (int)(gid % 16), t = (int)(gid / 16), row = CTXN + t;
    const bf16_t* Z = ws_big(p); bf16_t* b = ws_br(p) + (size_t)row * 2048;
    float bon[2];
    for (int d = 0; d < 2; ++d) {
        const float* a0 = d ? p.a0b : p.a0f; const float* a2 = d ? p.a2b : p.a2f;
        float s = 0.f;
        for (int j = 0; j < 64; ++j) { const int hj = h * 64 + j; float acc = a0[hj];
            for (int m = 0; m < 64; ++m) acc += zshift(Z, p.mu, row, 3200 + d * 64 + m) * a2[m * 1024 + hj];
            const float al = sigmf(acc); const float r = zshift(Z, p.mu, row, hj), k = zshift(Z, p.mu, row, 1024 + hj);
            s += r * (k * (1.0f + (al - 1.0f) * p.k_a[hj])) * p.r_k[hj]; }
        bon[d] = s;
    }
    float sm = 0.f; for (int i = 0; i < 64; ++i) sm += bf2f(b[h * 64 + i]) + bf2f(b[1024 + h * 64 + i]);
    const float mean = sm / 64.f; float q = 0.f;
    for (int i = 0; i < 64; ++i) { const float d = bf2f(b[h * 64 + i]) + bf2f(b[1024 + h * 64 + i]) - mean; q += d * d; }
    const float rstd = 1.0f / sqrtf(q / 64.f + GN_EPS);
    for (int i = 0; i < 64; ++i) { const int hi = h * 64 + i; const float w = bf2f(b[hi]) + bf2f(b[1024 + hi]);
        const float v = zshift(Z, p.mu, row, 2048 + hi);
        b[1024 + hi] = f2bf((w - mean) * rstd * p.lnx_g[hi] + p.lnx_b[hi] + (bon[0] + bon[1]) * v); }
}
constexpr long N_NA = (long)SEQ * 16;
DEV void ph_na(const Params& p, long gid) {
    const int h = (int)(gid % 16), t = (int)(gid / 16), r = t / GW, c = t % GW;
    const bf16_t* P = ws_big(p);
    float q[64];
    { const bf16_t* qp = P + (size_t)(CTXN + t) * NAW + h * 64;
#pragma unroll
      for (int d = 0; d < 64; ++d) q[d] = bf2f(qp[d]) * 0.125f; }
    float acc[64];
#pragma unroll
    for (int d = 0; d < 64; ++d) acc[d] = 0.f;
    float m = -1e30f, l = 0.f;
    const int wh = GROWS < 8 ? GROWS : 8;
    int r0 = r - wh / 2; r0 = r0 < 0 ? 0 : (r0 > GROWS - wh ? GROWS - wh : r0);
    int c0 = c - 8; c0 = c0 < 0 ? 0 : (c0 > GW - 16 ? GW - 16 : c0);
    const float* rp = p.rpb + h * 15 * 31;
    for (int kk = 0; kk < wh * 16 + CTXN; ++kk) {
        int krow; float bias = 0.f;
        if (kk < wh * 16) { const int i = kk / 16, j = kk % 16; krow = CTXN + (r0 + i) * GW + c0 + j; bias = rp[(r0 + i - r + 7) * 31 + (c0 + j - c + 15)]; }
        else krow = kk - wh * 16;
        const bf16_t* kp = P + (size_t)krow * NAW + 1024 + h * 64; float s = bias;
#pragma unroll
        for (int d = 0; d < 64; ++d) s += q[d] * bf2f(kp[d]);
        const float mn = fmaxf(m, s), al = expf(m - mn), pe = expf(s - mn);
        const bf16_t* vp = P + (size_t)krow * NAW + 2048 + h * 64;
        l = l * al + pe;
#pragma unroll
        for (int d = 0; d < 64; ++d) acc[d] = acc[d] * al + pe * bf2f(vp[d]);
        m = mn;
    }
    bf16_t* o = ws_br(p) + (size_t)(CTXN + t) * 2048 + h * 64; const float il = 1.0f / l;
#pragma unroll
    for (int d = 0; d < 64; ++d) o[d] = f2bf(acc[d] * il);
}

constexpr int RW_CH = 16;
struct RwShared { float r[RW_CH][64], w[RW_CH][64], kd[RW_CH][64], v[RW_CH][64], a[RW_CH][64], b[RW_CH][64], tz[RW_CH][64], za[RW_CH][64], kk[RW_CH][64]; };
#ifdef CPU_EMU
#define FOR_THREADS(tid) for (int tid = 0; tid < 64; ++tid)
#define BLOCK_SYNC()
#define TSTATE(tid) S_all[tid]
#else
#define FOR_THREADS(tid) const int tid = threadIdx.x; if (tid < 64)
#define BLOCK_SYNC() __syncthreads()
#define TSTATE(tid) S_reg
#endif
DEV int rw_row(int dir, int pos) { if (pos < CTXN) return dir ? CTXN - 1 - pos : pos; const int t = pos - CTXN; return CTXN + (dir ? SEQ - 1 - t : t); }
#ifdef CPU_EMU
static void rwkv_scan_block(const Params& p, int blk, RwShared& sh) {
    static thread_local float S_all[64][64];
    for (int i = 0; i < 64; ++i) for (int j = 0; j < 64; ++j) S_all[i][j] = 0.f;
#else
__device__ void rwkv_scan_block(const Params& p, int blk, RwShared& sh) {
    float S_reg[64];
#pragma unroll
    for (int j = 0; j < 64; ++j) S_reg[j] = 0.f;
#endif
    const int dir = blk / 16, h = blk % 16;
    const float* w0 = dir ? p.w0b : p.w0f; const float* w2 = dir ? p.w2b : p.w2f; const float* a0 = dir ? p.a0b : p.a0f; const float* a2 = dir ? p.a2b : p.a2f;
    const bf16_t* Z = ws_big(p); bf16_t* BR = ws_br(p);
    for (int p0 = 0; p0 < R; p0 += RW_CH) {
        { FOR_THREADS(tid) { const int hj = h * 64 + tid;
            for (int tt = 0; tt < RW_CH; ++tt) { const int row = rw_row(dir, p0 + tt);
                sh.tz[tt][tid] = tanhf(zshift(Z, p.mu, row, 3072 + dir * 64 + tid)); sh.za[tt][tid] = zshift(Z, p.mu, row, 3200 + dir * 64 + tid);
                sh.r[tt][tid] = zshift(Z, p.mu, row, hj); sh.v[tt][tid] = zshift(Z, p.mu, row, 2048 + hj);
                const float k = zshift(Z, p.mu, row, 1024 + hj); sh.kd[tt][tid] = k; sh.kk[tt][tid] = k * p.k_k[hj]; } } }
        BLOCK_SYNC();
        { FOR_THREADS(tid) { const int hj = h * 64 + tid;
            for (int tt = 0; tt < RW_CH; ++tt) { float aw = w0[hj], aa = a0[hj], nn = 0.f;
                for (int m = 0; m < 64; ++m) { aw += sh.tz[tt][m] * w2[m * 1024 + hj]; aa += sh.za[tt][m] * a2[m * 1024 + hj]; nn += sh.kk[tt][m] * sh.kk[tt][m]; }
                const float lw = -softplusf(-aw) - 0.5f; const float al = sigmf(aa);
                const float kkn = sh.kk[tt][tid] / fmaxf(sqrtf(nn), 1e-12f);
                sh.w[tt][tid] = expf(-expf(lw)); sh.a[tt][tid] = -kkn; sh.b[tt][tid] = kkn * al;
                sh.kd[tt][tid] = sh.kd[tt][tid] * (1.0f + (al - 1.0f) * p.k_a[hj]); } } }
        BLOCK_SYNC();
        { FOR_THREADS(tid) { float* S = TSTATE(tid);
            for (int tt = 0; tt < RW_CH; ++tt) { float sa = 0.f;
#pragma unroll
                for (int j = 0; j < 64; ++j) sa += S[j] * sh.a[tt][j];
                const float vi = sh.v[tt][tid]; float y = 0.f;
#pragma unroll
                for (int j = 0; j < 64; ++j) { S[j] = S[j] * sh.w[tt][j] + sa * sh.b[tt][j] + vi * sh.kd[tt][j]; y += S[j] * sh.r[tt][j]; }
                if (p0 >= CTXN) BR[(size_t)rw_row(dir, p0 + tt) * 2048 + dir * 1024 + h * 64 + tid] = f2bf(y); } } }
        BLOCK_SYNC();
    }
}

static Params make_params(void* const* d_in, void* d_out, void* d_ws) {
    Params p{};
    const float** f = (const float**)&p;
    for (int i = 0; i < 31; ++i) f[i] = (const float*)d_in[i];
    p.out = (float*)d_out; p.ws = (unsigned char*)d_ws; return p;
}


#ifndef CPU_EMU
#define LAS __attribute__((address_space(3)))
#define GAS __attribute__((address_space(1)))
typedef unsigned v4u __attribute__((ext_vector_type(4)));
constexpr int NWAVES = 8, NTHR = NWAVES * 64;
#ifndef PROBE
#define PROBE 0
#endif
#define XB_TMO      128
#define XB_XCNT(j)  (256  + 64 * (j))
#define XB_XSUB(j)  (1280 + 64 * (j))
#define XB_XGEN(j)  (2304 + 64 * (j))
#define XB_TOP      3328
#define XB_TOPGEN   3392
#define XCD_BAR_WORDS 3456
#define XB_SPIN_CAP (1u << 18)

__device__ __forceinline__ unsigned xb_ld(unsigned* p)              { return __hip_atomic_load(p, __ATOMIC_RELAXED, __HIP_MEMORY_SCOPE_AGENT); }
__device__ __forceinline__ unsigned xb_add(unsigned* p, unsigned v) { return __hip_atomic_fetch_add(p, v, __ATOMIC_RELAXED, __HIP_MEMORY_SCOPE_AGENT); }
__device__ __forceinline__ unsigned xb_xcc_id() { return (unsigned)__builtin_amdgcn_s_getreg((3 << 11) | 20) & 0xFu; }
#define XB_SPIN(cond, bar) do { unsigned _sp = 0; while (cond) { __builtin_amdgcn_s_sleep(1); \
    if ((++_sp & 255u) == 0u) { if (xb_ld(&(bar)[XB_TMO])) break; if (_sp > XB_SPIN_CAP) { atomicAdd(&(bar)[XB_TMO], 1u); break; } } } } while (0)

struct XcdBarrier {
    unsigned* bar; unsigned x;
    volatile LAS unsigned* st;
};

__device__ __forceinline__ XcdBarrier xcd_barrier_post(unsigned* bar, volatile LAS unsigned* st) {
    XcdBarrier b; b.bar = bar; b.x = xb_xcc_id(); b.st = st;
    if (threadIdx.x == 0) (void)xb_add(&bar[XB_XCNT(b.x)], 1u);
    return b;
}
__device__ __forceinline__ void xcd_barrier_complete(unsigned* bar, unsigned x, unsigned& nloc, unsigned& nx) {
    const unsigned G = gridDim.x * gridDim.y * gridDim.z;
    unsigned sum, cnt, mine, sp = 0u;
    for (;;) {
        sum = 0u; cnt = 0u; mine = 0u;
#pragma unroll
        for (unsigned j = 0; j < 16; ++j) { const unsigned c = xb_ld(&bar[XB_XCNT(j)]); sum += c; cnt += (c > 0u) ? 1u : 0u; mine = (j == x) ? c : mine; }
        if (sum == G) break;
        __builtin_amdgcn_s_sleep(1);
        if ((++sp & 255u) == 0u) { if (xb_ld(&bar[XB_TMO])) break; if (sp > XB_SPIN_CAP) { atomicAdd(&bar[XB_TMO], 1u); break; } }
    }
    nloc = mine > 0u ? mine : 1u; nx = cnt > 0u ? cnt : 1u;
}

__device__ __forceinline__ void xcd_barrier(const XcdBarrier& b) {
    asm volatile("s_waitcnt vmcnt(0)" ::: "memory");
    __syncthreads();
    if (threadIdx.x == 0) {
        unsigned* bar = b.bar;
        __builtin_amdgcn_s_waitcnt(0);
        unsigned nloc = b.st[0], nx = b.st[1];
        if (nloc == 0u) { xcd_barrier_complete(bar, b.x, nloc, nx); b.st[0] = nloc; b.st[1] = nx; }
        const unsigned old = xb_add(&bar[XB_XSUB(b.x)], 1u);
        const unsigned gen = old / nloc;
        if (old + 1u == (gen + 1u) * nloc) {
            __builtin_amdgcn_fence(__ATOMIC_RELEASE, "agent");
            asm volatile("s_waitcnt vmcnt(0)" ::: "memory");
            const unsigned og = xb_add(&bar[XB_TOP], 1u);
            const unsigned tg = og / nx;
            if (og + 1u == (tg + 1u) * nx) xb_add(&bar[XB_TOPGEN], 1u);
            else XB_SPIN(xb_ld(&bar[XB_TOPGEN]) == tg, bar);
            __builtin_amdgcn_fence(__ATOMIC_ACQUIRE, "agent");
            xb_add(&bar[XB_XGEN(b.x)], 1u);
            asm volatile("s_waitcnt vmcnt(0)" ::: "memory");
        } else {
            XB_SPIN(xb_ld(&bar[XB_XGEN(b.x)]) == gen, bar);
            __builtin_amdgcn_fence(__ATOMIC_ACQUIRE, "agent");
            asm volatile("s_waitcnt vmcnt(0)" ::: "memory");
        }
    }
    __syncthreads();
}
namespace pg8 {
#define PG8_LAS __attribute__((address_space(3)))
typedef unsigned short bf16_t;
typedef short bf16x8 __attribute__((ext_vector_type(8)));
typedef float f32x4 __attribute__((ext_vector_type(4)));
typedef unsigned u32x4 __attribute__((ext_vector_type(4)));
constexpr int BM = 256, BK = 64, HALF = 128, HTB = HALF * BK * 2  , STAGE_BYTES = 8 * HTB, NXCD = 8, WGM = 8;

__host__ __device__ __forceinline__ int lds_byte(int r, int c) { const int st = (r >> 4) * 2 + (c >> 5), rr = r & 15, cc = c & 31, ob = rr * 64 + cc * 2; return st * 1024 + (ob ^ (((ob >> 9) & 1) << 5)); }
__host__ __device__ __forceinline__ void stage_rc(int b, int& R, int& C) { const int st = b / 1024, sb = b % 1024, swz = sb ^ (((sb >> 9) & 1) << 5); R = (st >> 1) * 16 + swz / 64; C = (st & 1) * 32 + (swz % 64) / 2; }
__host__ __device__ __forceinline__ int perm32(int rho) { const int n = rho >> 4, i = rho & 15; return 8 * (i >> 2) + 4 * n + (i & 3); }

struct Unit { int pm, pn; };
struct Gemm { const bf16_t* A; const bf16_t* Bt; int M, N, K; int lda = 0, ldb = 0; int ksl = 0; };

struct StaticOrder {
    int nM, nN, nwg, G, c;
    __host__ __device__ void init(int M, int N, int G_, int c_) { nM = M / BM; nN = N / BM; nwg = nM * nN; G = G_; c = c_; }
    __host__ __device__ bool next(int i, Unit& u) const {
        const long L = (long)i * G + c; if (L >= nwg) return false;
        int wgid = (int)L; { const int q = nwg / NXCD, r = nwg % NXCD, xcd = wgid % NXCD, off = wgid / NXCD; wgid = (xcd < r ? xcd * (q + 1) : r * (q + 1) + (xcd - r) * q) + off; }
        const int nig = WGM * nN, gid = wgid / nig, fm = gid * WGM, gsz = (nM - fm) < WGM ? (nM - fm) : WGM;
        u.pm = fm + ((wgid % nig) % gsz); u.pn = (wgid % nig) / gsz; return true;
    }
    __device__ __forceinline__ void a_ready(const Unit&) const {}
    __device__ __forceinline__ void done(const Unit&) const {}
};

__device__ __forceinline__ unsigned cvt_pk_bf16(float lo, float hi) { unsigned r; asm volatile("v_cvt_pk_bf16_f32 %0, %1, %2" : "=v"(r) : "v"(lo), "v"(hi)); return r; }
typedef float f32x2 __attribute__((ext_vector_type(2)));
__device__ __forceinline__ f32x2 gelu_pk(f32x2 v) {
    const f32x2 av = __builtin_elementwise_abs(v), d = av * 0.2316418882f + 1.0f;
    f32x2 t; t.x = __builtin_amdgcn_rcpf(d.x); t.y = __builtin_amdgcn_rcpf(d.y);
    f32x2 q = t * 0.5307027145f + (-0.7265760135f); q = q * t + 0.7107068705f; q = q * t + (-0.142248368f); q = q * t + 0.127414796f; q = q * t;
    const f32x2 s = (v * v) * (-0.72134752044f);
    f32x2 e; e.x = __builtin_amdgcn_exp2f(s.x); e.y = __builtin_amdgcn_exp2f(s.y);
    const f32x2 m = v * (q * e), r = v - m;
    f32x2 o; o.x = v.x < 0.f ? m.x : r.x; o.y = v.y < 0.f ? m.y : r.y; return o;
}

template <int ACT  > struct EpiBf16 {
    static constexpr bool PERM = true, AFTER_DRAIN = false; static_assert(ACT == 0 || ACT == 1, "EpiBf16: ACT is 0 (none) or 1 (gelu_pk)");
    bf16_t* O; int ldc; const float* bias; int split_cols; size_t split_stride; float scale0;
    __device__ __forceinline__ void operator()(const f32x4 (&acc)[2][2][4][2], const Unit& u, int wr, int wc, int fr, int fq) const {
        const int row0 = u.pm * BM + wr * 64 + fr; int colt = u.pn * BM; bf16_t* base = O;
        float sc = 1.f; if (split_cols) { const int t = colt / split_cols; base += (size_t)t * split_stride; colt -= t * split_cols; if (t == 0) sc = scale0; }
        const int col0 = colt + wc * 32 + 8 * fq, bcol0 = u.pn * BM + wc * 32 + 8 * fq;
        f32x4 bv[2][2];
#pragma unroll
        for (int bj = 0; bj < 2; ++bj)
#pragma unroll
            for (int n = 0; n < 2; ++n) bv[bj][n] = bias ? *(const f32x4*)(bias + bcol0 + bj * HALF + 4 * n) : (f32x4){0.f, 0.f, 0.f, 0.f};
#pragma unroll
        for (int ai = 0; ai < 2; ++ai)
#pragma unroll
            for (int m = 0; m < 4; ++m) { bf16_t* rowp = base + (size_t)(row0 + ai * HALF + m * 16) * ldc + col0;
#pragma unroll
                for (int bj = 0; bj < 2; ++bj) { f32x4 v0 = acc[ai][bj][m][0] + bv[bj][0], v1 = acc[ai][bj][m][1] + bv[bj][1];
                    if (ACT == 1) { f32x2 a = gelu_pk((f32x2){v0[0], v0[1]}), b = gelu_pk((f32x2){v0[2], v0[3]}), c = gelu_pk((f32x2){v1[0], v1[1]}), d = gelu_pk((f32x2){v1[2], v1[3]});
                        v0 = (f32x4){a.x, a.y, b.x, b.y}; v1 = (f32x4){c.x, c.y, d.x, d.y}; }
                    v0 = v0 * sc; v1 = v1 * sc; u32x4 w; w.x = cvt_pk_bf16(v0[0], v0[1]); w.y = cvt_pk_bf16(v0[2], v0[3]); w.z = cvt_pk_bf16(v1[0], v1[1]); w.w = cvt_pk_bf16(v1[2], v1[3]);
                    *(u32x4*)(rowp + bj * HALF) = w; } }
    }
};

typedef float f32x2c_ __attribute__((ext_vector_type(2))); typedef __bf16 bf2c_ __attribute__((ext_vector_type(2)));
__device__ __forceinline__ unsigned cvt_pk_bf16_c(float lo, float hi) { const f32x2c_ v = {lo, hi}; return __builtin_bit_cast(unsigned, __builtin_convertvector(v, bf2c_)); }
struct EpiBf16Halo {
    static constexpr bool PERM = true, AFTER_DRAIN = false;
    bf16_t* O; int ldc; bf16_t* H;
    __device__ __forceinline__ void operator()(const f32x4 (&acc)[2][2][4][2], const Unit& u, int wr, int wc, int fr, int fq) const {
        const int row0 = u.pm * BM + wr * 64 + fr, col0 = u.pn * BM + wc * 32 + 8 * fq;
#pragma unroll
        for (int ai = 0; ai < 2; ++ai)
#pragma unroll
            for (int m = 0; m < 4; ++m) { const int row = row0 + ai * HALF + m * 16; bf16_t* rowp = O + (size_t)row * ldc + col0;
                const bool edge = (m == 0 && wr == 0 && fr == 0) || (m == 3 && wr == 1 && fr == 15);
                bf16_t* hp = H + ((size_t)(row >> 7) * 2 + (m == 3 ? 1 : 0)) * ldc + col0;
#pragma unroll
                for (int bj = 0; bj < 2; ++bj) { const f32x4 v0 = acc[ai][bj][m][0], v1 = acc[ai][bj][m][1];
                    u32x4 w; w.x = cvt_pk_bf16_c(v0[0], v0[1]); w.y = cvt_pk_bf16_c(v0[2], v0[3]); w.z = cvt_pk_bf16_c(v1[0], v1[1]); w.w = cvt_pk_bf16_c(v1[2], v1[3]);
                    *(u32x4*)(rowp + bj * HALF) = w;
                    if ((m == 0 || m == 3) && edge) *(u32x4*)(hp + bj * HALF) = w; } }
    }
};
__device__ __forceinline__ float silu_fast(float v) { return v * __builtin_amdgcn_rcpf(1.0f + __builtin_amdgcn_exp2f(-1.4426950408889634f * v)); }
struct EpiGateMul {
    static constexpr bool PERM = true, AFTER_DRAIN = false;
    bf16_t* O; int ldc;
    __device__ __forceinline__ void operator()(const f32x4 (&acc)[2][2][4][2], const Unit& u, int wr, int wc, int fr, int fq) const {
        const int row0 = u.pm * BM + wr * 64 + fr, col0 = u.pn * BM + wc * 32 + 8 * fq;
#pragma unroll
        for (int ai = 0; ai < 2; ++ai)
#pragma unroll
            for (int m = 0; m < 4; ++m) { bf16_t* rowp = O + (size_t)(row0 + ai * HALF + m * 16) * ldc + col0;
#pragma unroll
                for (int bj = 0; bj < 2; ++bj) { const u32x4 old = *(const u32x4*)(rowp + bj * HALF); const f32x4 v0 = acc[ai][bj][m][0], v1 = acc[ai][bj][m][1];
                    u32x4 w;
                    w.x = cvt_pk_bf16(silu_fast(v0[0]) * __uint_as_float(old.x << 16), silu_fast(v0[1]) * __uint_as_float(old.x & 0xffff0000u));
                    w.y = cvt_pk_bf16(silu_fast(v0[2]) * __uint_as_float(old.y << 16), silu_fast(v0[3]) * __uint_as_float(old.y & 0xffff0000u));
                    w.z = cvt_pk_bf16(silu_fast(v1[0]) * __uint_as_float(old.z << 16), silu_fast(v1[1]) * __uint_as_float(old.z & 0xffff0000u));
                    w.w = cvt_pk_bf16(silu_fast(v1[2]) * __uint_as_float(old.w << 16), silu_fast(v1[3]) * __uint_as_float(old.w & 0xffff0000u));
                    *(u32x4*)(rowp + bj * HALF) = w; } }
    }
};
struct EpiSiluBf16 {
    static constexpr bool PERM = true, AFTER_DRAIN = false;
    bf16_t* O; int ldc;
    __device__ __forceinline__ void operator()(const f32x4 (&acc)[2][2][4][2], const Unit& u, int wr, int wc, int fr, int fq) const {
        const int row0 = u.pm * BM + wr * 64 + fr, col0 = u.pn * BM + wc * 32 + 8 * fq;
#pragma unroll
        for (int ai = 0; ai < 2; ++ai)
#pragma unroll
            for (int m = 0; m < 4; ++m) { bf16_t* rowp = O + (size_t)(row0 + ai * HALF + m * 16) * ldc + col0;
#pragma unroll
                for (int bj = 0; bj < 2; ++bj) { const f32x4 v0 = acc[ai][bj][m][0], v1 = acc[ai][bj][m][1]; u32x4 w;
                    w.x = cvt_pk_bf16(silu_fast(v0[0]), silu_fast(v0[1])); w.y = cvt_pk_bf16(silu_fast(v0[2]), silu_fast(v0[3]));
                    w.z = cvt_pk_bf16(silu_fast(v1[0]), silu_fast(v1[1])); w.w = cvt_pk_bf16(silu_fast(v1[2]), silu_fast(v1[3]));
                    *(u32x4*)(rowp + bj * HALF) = w; } }
    }
};
struct EpiF32 {
    static constexpr bool PERM = true, AFTER_DRAIN = false;
    float* O; int ldc;
    __device__ __forceinline__ void operator()(const f32x4 (&acc)[2][2][4][2], const Unit& u, int wr, int wc, int fr, int fq) const {
        const int row0 = u.pm * BM + wr * 64 + fr, col0 = u.pn * BM + wc * 32 + 8 * fq;
#pragma unroll
        for (int ai = 0; ai < 2; ++ai)
#pragma unroll
            for (int m = 0; m < 4; ++m) { float* rowp = O + (size_t)(row0 + ai * HALF + m * 16) * ldc + col0;
#pragma unroll
                for (int bj = 0; bj < 2; ++bj) { *(f32x4*)(rowp + bj * HALF) = acc[ai][bj][m][0]; *(f32x4*)(rowp + bj * HALF + 4) = acc[ai][bj][m][1]; } }
    }
};

template <class Epi, class Sched, bool ALIGN_EPI = false, bool SP2 = false>
__device__ __forceinline__ void gemm_phase(PG8_LAS unsigned char* lds, const Gemm g, const Sched& S, const Epi& E) {
    int tid_ = threadIdx.x; asm volatile("" : "+v"(tid_));
    const int tid = tid_, wid = __builtin_amdgcn_readfirstlane(tid >> 6), lane = tid & 63, wr = wid >> 2, wc = wid & 3, fr = lane & 15, fq = lane >> 4;
    const int K = g.K, nt = K / BK, lda = g.lda ? g.lda : K, ldb = g.ldb ? g.ldb : K;
    unsigned voffA[2], voffB[2];
#pragma unroll
    for (int i = 0; i < 2; ++i) { int R, C; stage_rc(tid * 16 + i * 8192, R, C); const int Rb = Epi::PERM ? ((R & ~31) + perm32(R & 31)) : R;
        voffA[i] = (unsigned)(R * lda + C) * 2u; voffB[i] = (unsigned)(Rb * ldb + C) * 2u; }
    const size_t kstep = (size_t)(BK * 2);
    const size_t hstepA = (size_t)HALF * lda * 2, hstepB = (size_t)HALF * ldb * 2;
    const size_t tstepA = g.ksl ? (size_t)g.ksl : 2 * hstepA, tstepB = 2 * hstepB, bpm = (size_t)g.ksl;
    const unsigned ldsw = (unsigned)wid * 1024u;
    const int aoff = lds_byte(wr * 64 + fr, fq * 8), boff = lds_byte(wc * 32 + fr, fq * 8);
#define PG8_SA(b, h) (((b) * 2 + (h)) * HTB)
#define PG8_SB(b, h) ((4 + (b) * 2 + (h)) * HTB)
#define PG8_STAGE(bufoff, gbase, voff) do { _Pragma("unroll") for (int _i = 0; _i < 2; ++_i) \
        __builtin_amdgcn_global_load_lds((const unsigned*)((const char*)(gbase) + (voff)[_i]), (PG8_LAS unsigned*)(lds + (bufoff) + ldsw + _i * 8192), 16, 0, 0); } while (0)
#define PG8_LDA(dst, b, h) do { _Pragma("unroll") for (int m = 0; m < 4; ++m) _Pragma("unroll") for (int k = 0; k < 2; ++k) dst[m][k] = *(const PG8_LAS bf16x8*)(lds + PG8_SA(b, h) + aoff + m * 2048 + k * 1024); } while (0)
#define PG8_LDB(dst, b, h) do { _Pragma("unroll") for (int n = 0; n < 2; ++n) _Pragma("unroll") for (int k = 0; k < 2; ++k) dst[n][k] = *(const PG8_LAS bf16x8*)(lds + PG8_SB(b, h) + boff + n * 2048 + k * 1024); } while (0)
#define PG8_MMA(ai, bj, At, Bt) do { __builtin_amdgcn_s_setprio(1); _Pragma("unroll") for (int m = 0; m < 4; ++m) _Pragma("unroll") for (int n = 0; n < 2; ++n) _Pragma("unroll") for (int k = 0; k < 2; ++k) \
        acc[ai][bj][m][n] = __builtin_amdgcn_mfma_f32_16x16x32_bf16(Bt[n][k], At[m][k], acc[ai][bj][m][n], 0, 0, 0); __builtin_amdgcn_s_setprio(0); } while (0)
#define PG8_WAIT_V(n) asm volatile("s_waitcnt vmcnt(" #n ")" ::: "memory")
#define PG8_WAIT_L(n) asm volatile("s_waitcnt lgkmcnt(" #n ")" ::: "memory")
#define PG8_BAR __builtin_amdgcn_s_barrier()
#define PG8_SCHED __builtin_amdgcn_sched_barrier(0)
    Unit cur, nxt; int ui = 0;
    if (!S.next(0, cur)) return;
    f32x4 acc[2][2][4][2];
#pragma unroll
    for (int a = 0; a < 2; ++a)
#pragma unroll
        for (int b = 0; b < 2; ++b)
#pragma unroll
            for (int m = 0; m < 4; ++m)
#pragma unroll
                for (int n = 0; n < 2; ++n) acc[a][b][m][n] = (f32x4){0.f, 0.f, 0.f, 0.f};
    bf16x8 At[4][2], B0[2][2], B1[2][2];
    const char* cA = (const char*)g.A + (size_t)cur.pm * tstepA; const char* cB = (const char*)g.Bt + (size_t)cur.pn * tstepB + (size_t)cur.pm * bpm;
    S.a_ready(cur);
    if constexpr (SP2) {
        PG8_STAGE(PG8_SB(0, 0), cB, voffB); PG8_STAGE(PG8_SB(0, 1), cB + hstepB, voffB); PG8_STAGE(PG8_SA(0, 0), cA, voffA); PG8_STAGE(PG8_SA(0, 1), cA + hstepA, voffA);
        if (wr == 1) PG8_BAR;
        PG8_WAIT_V(2); PG8_BAR;
        PG8_STAGE(PG8_SB(1, 0), cB + kstep, voffB); PG8_STAGE(PG8_SA(1, 0), cA + kstep, voffA); PG8_STAGE(PG8_SB(1, 1), cB + hstepB + kstep, voffB);
        PG8_WAIT_V(6); PG8_BAR;
    } else {
        PG8_STAGE(PG8_SB(0, 0), cB, voffB); PG8_STAGE(PG8_SA(0, 0), cA, voffA); PG8_STAGE(PG8_SB(0, 1), cB + hstepB, voffB); PG8_STAGE(PG8_SA(0, 1), cA + hstepA, voffA);
        if (wr == 1) PG8_BAR;
        PG8_WAIT_V(4); PG8_BAR;
        PG8_STAGE(PG8_SB(1, 0), cB + kstep, voffB); PG8_STAGE(PG8_SA(1, 0), cA + kstep, voffA); PG8_STAGE(PG8_SB(1, 1), cB + hstepB + kstep, voffB);
        PG8_WAIT_V(6); PG8_BAR;
    }
    for (;;) {
        const bool has_next = S.next(ui + 1, nxt);
        const char* nA = has_next ? (const char*)g.A + (size_t)nxt.pm * tstepA : cA; const char* nB = has_next ? (const char*)g.Bt + (size_t)nxt.pn * tstepB + (size_t)nxt.pm * bpm : cB;
        for (int t = 0; t < nt; t += 2) {
            const bool last = (t == nt - 2);
            const char* a1 = cA + (size_t)(t + 1) * kstep;
            const char* a2 = last ? nA : cA + (size_t)(t + 2) * kstep; const char* b2 = last ? nB : cB + (size_t)(t + 2) * kstep;
            const char* a3 = a2 + kstep; const char* b3 = b2 + kstep;
            if (last && has_next) S.a_ready(nxt);
            if constexpr (SP2) {
            PG8_LDB(B0, 0, 0); PG8_LDB(B1, 0, 1); PG8_SCHED; PG8_LDA(At, 0, 0); PG8_STAGE(PG8_SA(1, 1), a1 + hstepA, voffA);
            PG8_WAIT_V(8); PG8_WAIT_L(0); PG8_BAR; PG8_MMA(0, 0, At, B0); PG8_MMA(0, 1, At, B1); PG8_BAR; PG8_SCHED;
            PG8_LDA(At, 0, 1); PG8_STAGE(PG8_SB(0, 0), b2, voffB); PG8_STAGE(PG8_SB(0, 1), b2 + hstepB, voffB); PG8_STAGE(PG8_SA(0, 0), a2, voffA);
            PG8_WAIT_V(8); PG8_WAIT_L(0); PG8_BAR; PG8_MMA(1, 0, At, B0); PG8_MMA(1, 1, At, B1); PG8_BAR; PG8_SCHED;
            PG8_LDB(B0, 1, 0); PG8_LDB(B1, 1, 1); PG8_SCHED; PG8_LDA(At, 1, 0); PG8_STAGE(PG8_SA(0, 1), a2 + hstepA, voffA);
            PG8_WAIT_V(8); PG8_WAIT_L(0); PG8_BAR; PG8_MMA(0, 0, At, B0); PG8_MMA(0, 1, At, B1); PG8_BAR; PG8_SCHED;
            PG8_LDA(At, 1, 1); PG8_STAGE(PG8_SB(1, 0), b3, voffB); PG8_STAGE(PG8_SB(1, 1), b3 + hstepB, voffB); PG8_STAGE(PG8_SA(1, 0), a3, voffA);
            PG8_WAIT_V(8); PG8_WAIT_L(0); PG8_BAR; PG8_MMA(1, 0, At, B0); PG8_MMA(1, 1, At, B1); PG8_BAR; PG8_SCHED;
            } else {
            PG8_LDB(B0, 0, 0); PG8_SCHED; PG8_LDA(At, 0, 0); PG8_STAGE(PG8_SA(1, 1), a1 + hstepA, voffA);
            PG8_WAIT_L(8); PG8_BAR; PG8_WAIT_L(0); PG8_MMA(0, 0, At, B0); PG8_BAR; PG8_SCHED;
            PG8_LDB(B1, 0, 1); PG8_STAGE(PG8_SB(0, 0), b2, voffB);
            PG8_BAR; PG8_WAIT_L(0); PG8_MMA(0, 1, At, B1); PG8_BAR;
            PG8_LDA(At, 0, 1); PG8_STAGE(PG8_SA(0, 0), a2, voffA);
            PG8_BAR; PG8_WAIT_L(0); PG8_MMA(1, 0, At, B0); PG8_BAR; PG8_SCHED;
            PG8_STAGE(PG8_SB(0, 1), b2 + hstepB, voffB);
            PG8_WAIT_V(6); PG8_BAR; PG8_MMA(1, 1, At, B1); PG8_BAR;
            PG8_LDB(B0, 1, 0); PG8_SCHED; PG8_LDA(At, 1, 0); PG8_STAGE(PG8_SA(0, 1), a2 + hstepA, voffA);
            PG8_WAIT_L(8); PG8_BAR; PG8_WAIT_L(0); PG8_MMA(0, 0, At, B0); PG8_BAR; PG8_SCHED;
            PG8_LDB(B1, 1, 1); PG8_STAGE(PG8_SB(1, 0), b3, voffB);
            PG8_BAR; PG8_WAIT_L(0); PG8_MMA(0, 1, At, B1); PG8_BAR;
            PG8_LDA(At, 1, 1); PG8_STAGE(PG8_SA(1, 0), a3, voffA);
            PG8_BAR; PG8_WAIT_L(0); PG8_MMA(1, 0, At, B0); PG8_BAR; PG8_SCHED;
            PG8_STAGE(PG8_SB(1, 1), b3 + hstepB, voffB);
            PG8_WAIT_V(6); PG8_BAR; PG8_MMA(1, 1, At, B1); PG8_BAR;
            }
        }
        if constexpr (ALIGN_EPI) { if (wr == 0) PG8_BAR; }
        if constexpr (!Epi::AFTER_DRAIN) { E(acc, cur, wr, wc, fr, fq); S.done(cur); }
        if (!has_next) break;
#pragma unroll
        for (int a = 0; a < 2; ++a)
#pragma unroll
            for (int b = 0; b < 2; ++b)
#pragma unroll
                for (int m = 0; m < 4; ++m)
#pragma unroll
                    for (int n = 0; n < 2; ++n) acc[a][b][m][n] = (f32x4){0.f, 0.f, 0.f, 0.f};
        cur = nxt; cA = nA; cB = nB; ++ui;
        if constexpr (ALIGN_EPI) { if (wr == 1) PG8_BAR; }
    }
    PG8_WAIT_V(0);
    if constexpr (!ALIGN_EPI) { if (wr == 0) PG8_BAR; }
    PG8_BAR;
    if constexpr (Epi::AFTER_DRAIN) { E.fused(acc, cur, wr, wc, fr, fq, lds, wid, lane); S.done(cur); }
#undef PG8_SA
#undef PG8_SB
#undef PG8_STAGE
#undef PG8_LDA
#undef PG8_LDB
#undef PG8_MMA
#undef PG8_WAIT_V
#undef PG8_WAIT_L
#undef PG8_BAR
#undef PG8_SCHED
}
}

namespace attn {
using bf16 = unsigned short;
constexpr int   D = 128, NW = 8, QBLK = 32, KVBLK = 64;
constexpr float SCALE = 0.088388347648318440f;
constexpr float THR = 8.f;
constexpr int SDEPTH = 2;
constexpr int LDQ = P0W, LDK = P0W, LDO = 2048;
constexpr size_t SHM_V = KVBLK * D * 2, SHM_K = KVBLK * D * 2, SHM_ATTN = 3 * SHM_V + 2 * SHM_K + NW * 64 * 4;
using bf16x8 = __attribute__((ext_vector_type(8))) short;
using s16x4  = __attribute__((ext_vector_type(4))) short;
using f32x16 = __attribute__((ext_vector_type(16))) float;
using f32x8  = __attribute__((ext_vector_type(8))) float;
using u32x4  = __attribute__((ext_vector_type(4))) unsigned;
#define KSWZ(row, colB) ((row) * 256 + ((colB) ^ (((row) & 7) << 4)))
#define SBAR() __builtin_amdgcn_sched_barrier(0)
__device__ __forceinline__ int crow(int r, int hi) { return (r & 3) + 8 * (r >> 2) + 4 * hi; }
__device__ __forceinline__ unsigned cvtpk(float lo, float hi) {
  unsigned r; asm volatile("v_cvt_pk_bf16_f32 %0, %1, %2" : "=v"(r) : "v"(lo), "v"(hi)); return r;
}
template <typename TIn> struct Stage;
template <> struct Stage<bf16>  { using T = bf16x8;
  __device__ static __forceinline__ T ld8(const bf16* p) { return *reinterpret_cast<const bf16x8*>(p); }
  __device__ static __forceinline__ bf16x8 tobf(T x) { return x; } };
template <> struct Stage<float> { using T = f32x8;
  __device__ static __forceinline__ T ld8(const float* p) { return *reinterpret_cast<const f32x8*>(p); }
  __device__ static __forceinline__ bf16x8 tobf(T x) {
    u32x4 w = {cvtpk(x[0], x[1]), cvtpk(x[2], x[3]), cvtpk(x[4], x[5]), cvtpk(x[6], x[7])}; return *reinterpret_cast<bf16x8*>(&w); } };

template <bool NOMAX> __device__ __forceinline__ void partialSM(f32x16& p0, f32x16& p1, float& m_reg, float& mn, float& alpha) {
  if constexpr (NOMAX) { for (int r = 0; r < 16; ++r) p0[r] = __builtin_amdgcn_exp2f(p0[r]); alpha = 1.f; return; }
  constexpr float C = SCALE * 1.4426950408889634f;
  float pmax = p0[0]; for (int r = 1; r < 16; ++r) pmax = fmaxf(pmax, p0[r]); for (int r = 0; r < 16; ++r) pmax = fmaxf(pmax, p1[r]);
  { auto rr = __builtin_amdgcn_permlane32_swap(__float_as_uint(pmax), __float_as_uint(pmax), false, false);
    pmax = fmaxf(__uint_as_float(rr[0]), __uint_as_float(rr[1])); }
  if (__builtin_expect(__all(pmax - m_reg <= THR / SCALE), 1)) { mn = m_reg; alpha = 1.f; }
  else { mn = fmaxf(m_reg, pmax); alpha = __builtin_amdgcn_exp2f((m_reg - mn) * C); m_reg = mn; }
  float mnC = -mn * C;
  for (int r = 0; r < 16; ++r) p0[r] = fmaf(p0[r], C, mnC); for (int r = 0; r < 16; ++r) p1[r] = fmaf(p1[r], C, mnC);
  for (int r = 0; r < 16; ++r) p0[r] = __builtin_amdgcn_exp2f(p0[r]);
}
__device__ __forceinline__ void finishSM(f32x16& p0, f32x16& p1, float alpha, float& l_reg, bf16x8& pa0, bf16x8& pa1, bf16x8& pa2, bf16x8& pa3) {
  for (int r = 0; r < 16; ++r) p1[r] = __builtin_amdgcn_exp2f(p1[r]);
  float ps = 0; for (int r = 0; r < 16; ++r) ps += p0[r]; for (int r = 0; r < 16; ++r) ps += p1[r];
  { auto rr = __builtin_amdgcn_permlane32_swap(__float_as_uint(ps), __float_as_uint(ps), false, false);
    ps = __uint_as_float(rr[0]) + __uint_as_float(rr[1]); }
  l_reg = l_reg * alpha + ps;
#define PK4(P, BASE, OUT) do { unsigned a0 = cvtpk(P[BASE + 0], P[BASE + 1]), a1 = cvtpk(P[BASE + 2], P[BASE + 3]);   \
    unsigned b0 = cvtpk(P[BASE + 4], P[BASE + 5]), b1 = cvtpk(P[BASE + 6], P[BASE + 7]);                              \
    auto r0 = __builtin_amdgcn_permlane32_swap(a0, b0, false, false); auto r1 = __builtin_amdgcn_permlane32_swap(a1, b1, false, false); \
    u32x4 w = {r0[0], r1[0], r0[1], r1[1]}; OUT = *reinterpret_cast<bf16x8*>(&w); } while (0)
  PK4(p0, 0, pa0); PK4(p0, 8, pa1); PK4(p1, 0, pa2); PK4(p1, 8, pa3);
#undef PK4
}
__device__ __forceinline__ void qkt(f32x16& p0, f32x16& p1, const bf16* Ks, const bf16x8* qr, int r32, int hi) {
  p0 = f32x16{}; p1 = f32x16{};
  for (int d0 = 0; d0 < 8; ++d0) { int cb = (d0 * 16 + hi * 8) * 2;
    bf16x8 b0 = *reinterpret_cast<const bf16x8*>((const char*)Ks + KSWZ(r32, cb));
    bf16x8 b1 = *reinterpret_cast<const bf16x8*>((const char*)Ks + KSWZ(32 + r32, cb));
    p0 = __builtin_amdgcn_mfma_f32_32x32x16_bf16(b0, qr[d0], p0, 0, 0, 0);
    p1 = __builtin_amdgcn_mfma_f32_32x32x16_bf16(b1, qr[d0], p1, 0, 0, 0); }
}
__device__ __forceinline__ int v_st(int k, int c) { const int kk = (k & ~0xC) | ((k & 4) << 1) | ((k & 8) >> 1); return ((kk >> 3) * 4 + (c >> 5)) * 512 + ((kk & 7) * 32 + (c & 31)) * 2; }
__device__ __forceinline__ int v_rd_base(int lane) { return ((lane & 3) << 3) | (((lane >> 2) & 3) << 6) | (((lane >> 4) & 1) << 5) | (((lane >> 5) & 1) << 8); }
constexpr int v_rd_off(int d0, int ks, int half) { return d0 * 512 + ks * 4096 + half * 2048; }
template <int OFF> __device__ __forceinline__ s16x4 tr_read(int vb) {
  s16x4 r; asm volatile("ds_read_b64_tr_b16 %0, %1 offset:%2" : "=&v"(r) : "v"(vb), "i"(OFF) : "memory"); return r;
}
template <int D0> __device__ __forceinline__ void pv_one(f32x16& od, int vb, bf16x8 pa0, bf16x8 pa1, bf16x8 pa2, bf16x8 pa3) {
  const s16x4 l0 = tr_read<v_rd_off(D0, 0, 0)>(vb), h0 = tr_read<v_rd_off(D0, 0, 1)>(vb), l1 = tr_read<v_rd_off(D0, 1, 0)>(vb), h1 = tr_read<v_rd_off(D0, 1, 1)>(vb);
  const s16x4 l2 = tr_read<v_rd_off(D0, 2, 0)>(vb), h2 = tr_read<v_rd_off(D0, 2, 1)>(vb), l3 = tr_read<v_rd_off(D0, 3, 0)>(vb), h3 = tr_read<v_rd_off(D0, 3, 1)>(vb);
  asm volatile("s_waitcnt lgkmcnt(0)" ::: "memory"); SBAR();
#define PK(L, H) (bf16x8){L[0], L[1], L[2], L[3], H[0], H[1], H[2], H[3]}
  od = __builtin_amdgcn_mfma_f32_32x32x16_bf16(pa0, PK(l0, h0), od, 0, 0, 0);
  od = __builtin_amdgcn_mfma_f32_32x32x16_bf16(pa1, PK(l1, h1), od, 0, 0, 0);
  od = __builtin_amdgcn_mfma_f32_32x32x16_bf16(pa2, PK(l2, h2), od, 0, 0, 0);
  od = __builtin_amdgcn_mfma_f32_32x32x16_bf16(pa3, PK(l3, h3), od, 0, 0, 0);
#undef PK
}
__device__ __forceinline__ void pv_d0(f32x16* o, int vb, bf16x8 pa0, bf16x8 pa1, bf16x8 pa2, bf16x8 pa3) {
  pv_one<0>(o[0], vb, pa0, pa1, pa2, pa3); pv_one<1>(o[1], vb, pa0, pa1, pa2, pa3); pv_one<2>(o[2], vb, pa0, pa1, pa2, pa3); pv_one<3>(o[3], vb, pa0, pa1, pa2, pa3);
}

template <typename TQ, bool NOMAX>
__device__ __forceinline__ void attn_dense_body(const TQ* __restrict__ Qb, const bf16* __restrict__ Kh, const bf16* __restrict__ Vh,
                                                bf16* __restrict__ Ob, int seq, char* lds) {
  using St = Stage<bf16>; using SQ = Stage<TQ>;
  int tid_ = threadIdx.x; asm volatile("" : "+v"(tid_));
  const int tid = tid_, wid = tid >> 6, lane = tid & 63, r32 = lane & 31, hi = lane >> 5;
  bf16* V_lds = (bf16*)lds; bf16* K_lds = (bf16*)(lds + 3 * SHM_V);
  float* ws = (float*)(lds + 3 * SHM_V + 2 * SHM_K) + wid * 64; float* li_l = ws; float* al_l = ws + 32;
  float m_reg = -1e30f, l_reg = 0; f32x16 o[4] = {}; bf16x8 qr[8];
  const TQ* Qw = Qb + (long)(wid * QBLK + r32) * LDQ + hi * 8;
#pragma unroll
  for (int d0 = 0; d0 < 8; ++d0) { qr[d0] = SQ::tobf(SQ::ld8(Qw + d0 * 16));
    if constexpr (NOMAX) { constexpr float C = SCALE * 1.4426950408889634f; u32x4 w = *reinterpret_cast<u32x4*>(&qr[d0]);
      for (int i = 0; i < 4; ++i) w[i] = cvtpk(__uint_as_float(w[i] << 16) * C, __uint_as_float(w[i] & 0xffff0000u) * C);
      qr[d0] = *reinterpret_cast<bf16x8*>(&w); } }
  const int sr = tid >> 4, sc = (tid & 15) * 8, vst0 = v_st(sr, sc), vst1 = v_st(32 + sr, sc);
  const int vb0 = (int)(uintptr_t)V_lds + v_rd_base(lane);
  struct { typename St::T vs0, vs1, ks0, ks1; } sr_[SDEPTH];
#define SLOAD(i, k0) do { sr_[i].vs0 = St::ld8(&Vh[(long)((k0) + sr) * LDK + sc]); sr_[i].vs1 = St::ld8(&Vh[(long)((k0) + 32 + sr) * LDK + sc]); \
    sr_[i].ks0 = St::ld8(&Kh[(long)((k0) + sr) * LDK + sc]); sr_[i].ks1 = St::ld8(&Kh[(long)((k0) + 32 + sr) * LDK + sc]); } while (0)
#define SWRITE(b, voff, i) do { *(bf16x8*)((char*)V_lds + (voff) + vst0) = St::tobf(sr_[i].vs0);          \
    *(bf16x8*)((char*)V_lds + (voff) + vst1) = St::tobf(sr_[i].vs1); int kc = sc * 2;               \
    *(bf16x8*)((char*)K_lds + (b) * SHM_K + KSWZ(sr, kc)) = St::tobf(sr_[i].ks0);                       \
    *(bf16x8*)((char*)K_lds + (b) * SHM_K + KSWZ(32 + sr, kc)) = St::tobf(sr_[i].ks1); } while (0)
#define SWAIT() do { if constexpr (SDEPTH == 2) asm volatile("s_waitcnt vmcnt(4)" ::: "memory"); else asm volatile("s_waitcnt vmcnt(0)" ::: "memory"); } while (0)
#define RESC(a) do { if (!NOMAX && __any((a) < 1.f)) { if (hi == 0) al_l[r32] = (a); asm volatile("s_waitcnt lgkmcnt(0)" ::: "memory"); \
    for (int d = 0; d < 4; ++d) for (int r = 0; r < 16; ++r) o[d][r] *= al_l[crow(r, hi)]; } } while (0)
  f32x16 pA0, pA1, pB0, pB1; float mnA, mnB, alA, alB; bf16x8 pa0, pa1, pa2, pa3; const int NT = seq / KVBLK;
  constexpr int SE = 0, SO = SDEPTH - 1;
  SLOAD(SE, 0); asm volatile("s_waitcnt vmcnt(0)" ::: "memory"); SWRITE(0, 0, SE); __syncthreads();
  qkt(pA0, pA1, K_lds, qr, r32, hi); partialSM<NOMAX>(pA0, pA1, m_reg, mnA, alA);
  SLOAD(SO, KVBLK); if constexpr (SDEPTH == 2) { if (2 < NT) SLOAD(SE, 2 * KVBLK); }
  SWAIT(); SWRITE(1, (int)SHM_V, SO); __syncthreads();
  int vr = 0, vw = 2 * (int)SHM_V;
#define VNEXT(x) ((x) == 2 * (int)SHM_V ? 0 : (x) + (int)SHM_V)
  for (int j = 1; j + 1 < NT; j += 2) {
    SBAR(); qkt(pB0, pB1, (bf16*)((char*)K_lds + SHM_K), qr, r32, hi);
    finishSM(pA0, pA1, alA, l_reg, pa0, pa1, pa2, pa3); SBAR();
    SLOAD(SO, (j + SDEPTH) * KVBLK); SBAR();
    pv_d0(o, vb0 + vr, pa0, pa1, pa2, pa3); partialSM<NOMAX>(pB0, pB1, m_reg, mnB, alB);
    SWAIT(); SWRITE(0, vw, SE); vr = VNEXT(vr); vw = VNEXT(vw);
    RESC(alB); __syncthreads();
    SBAR(); qkt(pA0, pA1, K_lds, qr, r32, hi);
    finishSM(pB0, pB1, alB, l_reg, pa0, pa1, pa2, pa3); SBAR();
    if (SDEPTH == 1 || j + 3 < NT) SLOAD(SE, (j + 1 + SDEPTH) * KVBLK); SBAR();
    pv_d0(o, vb0 + vr, pa0, pa1, pa2, pa3); partialSM<NOMAX>(pA0, pA1, m_reg, mnA, alA);
    SWAIT(); SWRITE(1, vw, SO); vr = VNEXT(vr); vw = VNEXT(vw);
    RESC(alA); __syncthreads();
  }
  SBAR(); qkt(pB0, pB1, (bf16*)((char*)K_lds + SHM_K), qr, r32, hi);
  finishSM(pA0, pA1, alA, l_reg, pa0, pa1, pa2, pa3); SBAR();
  pv_d0(o, vb0 + vr, pa0, pa1, pa2, pa3); partialSM<NOMAX>(pB0, pB1, m_reg, mnB, alB);
  vr = VNEXT(vr); RESC(alB);
  finishSM(pB0, pB1, alB, l_reg, pa0, pa1, pa2, pa3); SBAR();
  pv_d0(o, vb0 + vr, pa0, pa1, pa2, pa3);
#undef VNEXT
  if (hi == 0) li_l[r32] = l_reg; asm volatile("s_waitcnt lgkmcnt(0)" ::: "memory");
  float rli[16];
#pragma unroll
  for (int r = 0; r < 16; ++r) rli[r] = __builtin_amdgcn_rcpf(li_l[crow(r, hi)]);
  bf16* Ow = Ob + (long)(wid * QBLK) * LDO;
#pragma unroll
  for (int r = 0; r < 16; ++r) { int orow = crow(r, hi);
    for (int d0 = 0; d0 < 4; ++d0) Ow[(long)orow * LDO + d0 * 32 + r32] = (bf16)(cvtpk(o[d0][r] * rli[r], 0.f) & 0xffffu); }
#undef SLOAD
#undef SWRITE
#undef SWAIT
#undef RESC
}
#undef KSWZ
#undef SBAR
}

namespace rw {
typedef short bf16x8 __attribute__((ext_vector_type(8)));
typedef float f32x4 __attribute__((ext_vector_type(4)));
typedef unsigned u32x4 __attribute__((ext_vector_type(4)));
typedef unsigned u32x2 __attribute__((ext_vector_type(2)));
constexpr int CH = 32, NC = R / CH;
static_assert(NC % 2 == 0, "the prep loop is unrolled by two");
constexpr int BUFB = 5 * 8192 + 1024;
constexpr int O_W = 0, O_B = 8192, O_KD = 16384, O_A = 24576, O_R = 32768, O_V = 40960;
constexpr int PITCH = 72;
constexpr int L_SCR = 2 * BUFB, SCRB = 2 * 16 * PITCH * 2;
constexpr int L_W2T = L_SCR + 4 * SCRB, L_A2T = L_W2T + 64 * PITCH * 2;
constexpr int L_Y = L_A2T + 64 * PITCH * 2;
constexpr int L_CST = L_Y + 2 * 2 * CH * 64 * 4;
constexpr int L_END = L_CST + 10 * 64 * 4;
static_assert(L_END <= 163840 - 64 && (BUFB % 16) == 0 && (L_SCR % 16) == 0 && (SCRB % 16) == 0 && (L_W2T % 16) == 0 && (L_A2T % 16) == 0 && (L_Y % 16) == 0 && (L_CST % 16) == 0, "rwkv LDS map");
constexpr size_t WS_BON = 38 * MiB;

template <int CTRL> __device__ __forceinline__ float dppmov(float x) { return __builtin_bit_cast(float, __builtin_amdgcn_update_dpp(0, __builtin_bit_cast(int, x), CTRL, 0xF, 0xF, true)); }
__device__ __forceinline__ float allreduce8(float x) {
    x += dppmov<0xB1>(x);
    x += dppmov<0x4E>(x);
    x += dppmov<0x141>(x);
    return x;
}
__device__ __forceinline__ float allreduce16(float x) { x = allreduce8(x); x += dppmov<0x140>(x); return x; }
__device__ __forceinline__ float fast_tanh(float x) { const float e = __builtin_amdgcn_exp2f(2.885390081777927f * x); return 1.0f - 2.0f * __builtin_amdgcn_rcpf(1.0f + e); }
__device__ __forceinline__ float bflo(unsigned u) { return __uint_as_float(u << 16); }
__device__ __forceinline__ float bfhi(unsigned u) { return __uint_as_float(u & 0xffff0000u); }
__device__ __forceinline__ unsigned pkbf(float lo, float hi) { unsigned r; asm volatile("v_cvt_pk_bf16_f32 %0, %1, %2" : "=v"(r) : "v"(lo), "v"(hi)); return r; }

constexpr int SEGR = 128, NSEG = R / SEGR, NCG = (ZW + 511) / 512;
constexpr size_t WS_HALO = 40 * MiB;
static_assert(WS_HALO + (size_t)NSEG * 2 * ZW * 2 <= WS_XN, "halo rows overflow");
__device__ __forceinline__ void shift_halo(const Params& p) {
    int tid_ = threadIdx.x; asm volatile("" : "+v"(tid_));
    const bf16_t* Z = ws_big(p); bf16_t* H = (bf16_t*)(p.ws + WS_HALO);
    for (int it = (int)blockIdx.x * NTHR + tid_; it < NSEG * 2 * (ZW / 8); it += (int)gridDim.x * NTHR) {
        const int c8 = it % (ZW / 8), w = (it / (ZW / 8)) & 1, seg = it / (2 * (ZW / 8));
        *(u32x4*)(H + ((size_t)seg * 2 + w) * ZW + c8 * 8) = *(const u32x4*)(Z + (size_t)(seg * SEGR + (w ? SEGR - 1 : 0)) * ZW + c8 * 8);
    }
}
__device__ __forceinline__ u32x4 shift8(u32x4 c, u32x4 pv, u32x4 nx, f32x4 m0, f32x4 m1) {
    u32x4 o;
#pragma unroll
    for (int q = 0; q < 4; ++q) { const float ml = q < 2 ? m0[2 * q] : m1[2 * q - 4], mh = q < 2 ? m0[2 * q + 1] : m1[2 * q - 3];
        const float zl = bflo(c[q]), zh = bfhi(c[q]);
        o[q] = pkbf(zl + (0.5f * (bflo(pv[q]) + bflo(nx[q])) - zl) * ml, zh + (0.5f * (bfhi(pv[q]) + bfhi(nx[q])) - zh) * mh); }
    return o;
}
__device__ __forceinline__ void shift_inplace(const Params& p) {
    int tid_ = threadIdx.x; asm volatile("" : "+v"(tid_));
    const int lane = tid_ & 63, gw = (int)blockIdx.x * NWAVES + (tid_ >> 6), ngw = (int)gridDim.x * NWAVES;
    bf16_t* Z = ws_big(p); const bf16_t* H = (const bf16_t*)(p.ws + WS_HALO);
    for (int u = gw; u < NSEG * NCG; u += ngw) {
        const int seg = u / NCG, col = (u % NCG) * 512 + lane * 8;
        if (col < ZW) {
            const f32x4 m0 = *(const f32x4*)(p.mu + col), m1 = *(const f32x4*)(p.mu + col + 4);
            const bool first = seg == 0 || seg == CTXN / SEGR, last = seg == CTXN / SEGR - 1 || seg == NSEG - 1;
            bf16_t* zr = Z + (size_t)seg * SEGR * ZW + col;
            u32x4 pv = first ? (u32x4){0u, 0u, 0u, 0u} : *(const u32x4*)(H + ((size_t)(seg - 1) * 2 + 1) * ZW + col);
            const u32x4 tail = last ? (u32x4){0u, 0u, 0u, 0u} : *(const u32x4*)(H + ((size_t)(seg + 1) * 2) * ZW + col);
            u32x4 c0 = *(const u32x4*)zr, c1 = *(const u32x4*)(zr + ZW), c2 = *(const u32x4*)(zr + 2 * ZW), c3 = *(const u32x4*)(zr + 3 * ZW);
            for (int r = 0; r < SEGR; r += 4) {
                u32x4 n0 = tail, n1 = tail, n2 = tail, n3 = tail;
                if (r + 4 < SEGR) { n0 = *(const u32x4*)(zr + (size_t)(r + 4) * ZW); n1 = *(const u32x4*)(zr + (size_t)(r + 5) * ZW); n2 = *(const u32x4*)(zr + (size_t)(r + 6) * ZW); n3 = *(const u32x4*)(zr + (size_t)(r + 7) * ZW); }
                const u32x4 o0 = shift8(c0, pv, c1, m0, m1), o1 = shift8(c1, c0, c2, m0, m1), o2 = shift8(c2, c1, c3, m0, m1), o3 = shift8(c3, c2, n0, m0, m1);
                *(u32x4*)(zr + (size_t)r * ZW) = o0; *(u32x4*)(zr + (size_t)(r + 1) * ZW) = o1; *(u32x4*)(zr + (size_t)(r + 2) * ZW) = o2; *(u32x4*)(zr + (size_t)(r + 3) * ZW) = o3;
                pv = c3; c0 = n0; c1 = n1; c2 = n2; c3 = n3;
            }
        }
    }
}

struct Raw { u32x4 c[5]; };

template <int MODE> __device__ __forceinline__ void scan_block(const Params& p, int blk, LAS unsigned char* lds) {
    int tid_ = threadIdx.x; asm volatile("" : "+v"(tid_));
    const int tid = tid_, lane = tid & 63, wave = __builtin_amdgcn_readfirstlane(tid >> 6);
    const int dir = blk >> 7, h = (blk >> 3) & 15, eighth = blk & 7;
    const float* w0 = dir ? p.w0b : p.w0f; const float* w2 = dir ? p.w2b : p.w2f; const float* a0 = dir ? p.a0b : p.a0f; const float* a2 = dir ? p.a2b : p.a2f;
    const bf16_t* Z = ws_big(p); bf16_t* BR = ws_br(p); float* bon = (float*)(p.ws + WS_BON) + ((size_t)dir * 16 + h) * SEQ;
    { const int m = tid >> 3, j8 = (tid & 7) * 8;
      const f32x4 wa = *(const f32x4*)(w2 + (size_t)m * 1024 + h * 64 + j8), wb = *(const f32x4*)(w2 + (size_t)m * 1024 + h * 64 + j8 + 4);
      const f32x4 aa = *(const f32x4*)(a2 + (size_t)m * 1024 + h * 64 + j8), ab = *(const f32x4*)(a2 + (size_t)m * 1024 + h * 64 + j8 + 4);
      LAS bf16_t* yw = (LAS bf16_t*)(lds + L_W2T); LAS bf16_t* ya = (LAS bf16_t*)(lds + L_A2T);
#pragma unroll
      for (int q = 0; q < 4; ++q) { yw[(j8 + q) * PITCH + m] = f2bf(wa[q]); yw[(j8 + 4 + q) * PITCH + m] = f2bf(wb[q]); ya[(j8 + q) * PITCH + m] = f2bf(aa[q]); ya[(j8 + 4 + q) * PITCH + m] = f2bf(ab[q]); }
      for (int i = tid; i < 4 * SCRB / 4; i += NTHR) *(LAS unsigned*)(lds + L_SCR + i * 4) = 0u;
      for (int i = tid; i < 640; i += NTHR) { const int g = i >> 6, cc = i & 63, hc = h * 64 + cc; float v;
          if (g < 3) v = p.mu[g * 1024 + hc]; else if (g == 3) v = p.mu[3072 + dir * 64 + cc]; else if (g == 4) v = p.mu[3200 + dir * 64 + cc];
          else if (g == 5) v = w0[hc]; else if (g == 6) v = a0[hc]; else if (g == 7) v = p.k_k[hc]; else if (g == 8) v = p.k_a[hc]; else v = p.r_k[hc];
          *(LAS float*)(lds + L_CST + i * 4) = v; } }
    __syncthreads();
    if ((wave & 2) != 0) {
        const int pw = (wave & 1) + ((wave >> 2) << 1), tq = lane >> 3, c8 = (lane & 7) * 8, hj = h * 64 + c8, tslot = pw * 8 + tq;
        const int gcol[5] = {hj, 1024 + hj, 2048 + hj, 3072 + dir * 64 + c8, 3200 + dir * 64 + c8};
        LAS unsigned char* scr = lds + L_SCR + pw * SCRB;
#define RW_CST(g, hh) (*(LAS f32x4*)(lds + L_CST + ((g) * 64 + c8 + 4 * (hh)) * 4))
#define RW_LOADRAW(raw, cc) do { const bf16_t* zr_ = Z + (size_t)rw_row(dir, (cc) * CH + tslot) * ZW; \
            _Pragma("unroll") for (int g = 0; g < 5; ++g) raw.c[g] = *(const u32x4*)(zr_ + gcol[g]); } while (0)
        Raw rawA, rawB;
        f32x4 cw0[2], ca0[2], ckk[2], cka[2], crk[2];
#pragma unroll
        for (int hh = 0; hh < 2; ++hh) { cw0[hh] = RW_CST(5, hh); ca0[hh] = RW_CST(6, hh); ckk[hh] = RW_CST(7, hh); cka[hh] = RW_CST(8, hh); crk[hh] = RW_CST(9, hh);
            asm volatile("" : "+v"(cw0[hh]), "+v"(ca0[hh]), "+v"(ckk[hh]), "+v"(cka[hh]), "+v"(crk[hh])); }
        if (MODE == 0 || MODE == 2 || MODE == 3 || MODE == 9) { RW_LOADRAW(rawA, 0); RW_LOADRAW(rawB, 1); }
#define RW_PREP_ITER(RAWSET, cc_) do { \
            if (MODE == 0 || MODE == 2 || MODE == 3 || MODE == 9) { \
            const int cn = (cc_) + 1; LAS unsigned char* buf = lds + (cn & 1) * BUFB; const int p0 = cn * CH; const bool latent = p0 >= CTXN; \
            f32x4 rr[2], kv[2]; \
            { const u32x4 u = RAWSET.c[0]; rr[0] = (f32x4){bflo(u.x), bfhi(u.x), bflo(u.y), bfhi(u.y)}; rr[1] = (f32x4){bflo(u.z), bfhi(u.z), bflo(u.w), bfhi(u.w)}; \
              *(LAS f32x4*)(buf + O_R + (tslot * 64 + c8) * 4) = rr[0]; *(LAS f32x4*)(buf + O_R + (tslot * 64 + c8) * 4 + 16) = rr[1]; } \
            { const u32x4 u = RAWSET.c[1]; kv[0] = (f32x4){bflo(u.x), bfhi(u.x), bflo(u.y), bfhi(u.y)}; kv[1] = (f32x4){bflo(u.z), bfhi(u.z), bflo(u.w), bfhi(u.w)}; } \
            if ((lane & 7) == eighth) { const u32x4 u = RAWSET.c[2]; *(LAS f32x4*)(buf + O_V + tslot * 32) = (f32x4){bflo(u.x), bfhi(u.x), bflo(u.y), bfhi(u.y)}; *(LAS f32x4*)(buf + O_V + tslot * 32 + 16) = (f32x4){bflo(u.z), bfhi(u.z), bflo(u.w), bfhi(u.w)}; } \
            { const u32x4 u = RAWSET.c[3]; u32x4 o; \
              o.x = pkbf(fast_tanh(bflo(u.x)), fast_tanh(bfhi(u.x))); o.y = pkbf(fast_tanh(bflo(u.y)), fast_tanh(bfhi(u.y))); o.z = pkbf(fast_tanh(bflo(u.z)), fast_tanh(bfhi(u.z))); o.w = pkbf(fast_tanh(bflo(u.w)), fast_tanh(bfhi(u.w))); \
              *(LAS u32x4*)(scr + (tq * PITCH + c8) * 2) = o; *(LAS u32x4*)(scr + 16 * PITCH * 2 + (tq * PITCH + c8) * 2) = RAWSET.c[4]; } \
            if (cn + 2 < NC) RW_LOADRAW(RAWSET, cn + 2);              \
            asm volatile("s_waitcnt lgkmcnt(0)" ::: "memory"); \
            { const int r16 = lane & 15, quad = lane >> 4; f32x4 acc[2][4]; \
_Pragma("unroll") \
              for (int lora = 0; lora < 2; ++lora) { \
                  LAS unsigned char* X = scr + lora * 16 * PITCH * 2 + (r16 * PITCH + quad * 8) * 2; \
                  const bf16x8 x0 = *(LAS bf16x8*)X, x1 = *(LAS bf16x8*)(X + 64); \
_Pragma("unroll") \
                  for (int jt = 0; jt < 4; ++jt) { \
                      LAS unsigned char* Y = lds + (lora ? L_A2T : L_W2T) + ((jt * 16 + r16) * PITCH + quad * 8) * 2; \
                      acc[lora][jt] = (f32x4){0.f, 0.f, 0.f, 0.f}; \
                      acc[lora][jt] = __builtin_amdgcn_mfma_f32_16x16x32_bf16(x0, *(LAS bf16x8*)Y, acc[lora][jt], 0, 0, 0); \
                      acc[lora][jt] = __builtin_amdgcn_mfma_f32_16x16x32_bf16(x1, *(LAS bf16x8*)(Y + 64), acc[lora][jt], 0, 0, 0); } } \
              if (quad < 2) { \
_Pragma("unroll") \
                  for (int lora = 0; lora < 2; ++lora) \
_Pragma("unroll") \
                      for (int jt = 0; jt < 4; ++jt) \
_Pragma("unroll") \
                          for (int r = 0; r < 4; ++r) *(LAS float*)(buf + (lora ? O_B : O_W) + ((pw * 8 + quad * 4 + r) * 64 + jt * 16 + r16) * 4) = acc[lora][jt][r]; } } \
            asm volatile("s_waitcnt lgkmcnt(0)" ::: "memory"); \
            { float bs = 0.f, nn = 0.f; f32x4 kk[2], al[2]; \
_Pragma("unroll") \
              for (int hh = 0; hh < 2; ++hh) { const int off = (tslot * 64 + c8 + 4 * hh) * 4; \
                  const f32x4 aw = *(LAS f32x4*)(buf + O_W + off) + cw0[hh], aa = *(LAS f32x4*)(buf + O_B + off) + ca0[hh]; \
                  f32x4 wv; \
_Pragma("unroll") \
                  for (int q = 0; q < 4; ++q) { const float sg = __builtin_amdgcn_rcpf(1.0f + __builtin_amdgcn_exp2f(-1.4426950408889634f * aw[q])); \
                      wv[q] = __builtin_amdgcn_exp2f(-0.8750612633917f * sg); al[hh][q] = __builtin_amdgcn_rcpf(1.0f + __builtin_amdgcn_exp2f(-1.4426950408889634f * aa[q])); kk[hh][q] = kv[hh][q] * ckk[hh][q]; nn += kk[hh][q] * kk[hh][q]; } \
                  *(LAS f32x4*)(buf + O_W + off) = wv; } \
              nn = allreduce8(nn); \
              const float inv = __builtin_amdgcn_rsqf(fmaxf(nn, 1e-24f)); \
_Pragma("unroll") \
              for (int hh = 0; hh < 2; ++hh) { const int off = (tslot * 64 + c8 + 4 * hh) * 4; \
                  const f32x4 r = rr[hh]; \
                  f32x4 av, bv, kd; \
_Pragma("unroll") \
                  for (int q = 0; q < 4; ++q) { const float kn = kk[hh][q] * inv; av[q] = -kn; bv[q] = kn * al[hh][q]; kd[q] = kv[hh][q] * (1.0f + (al[hh][q] - 1.0f) * cka[hh][q]); bs += r[q] * kd[q] * crk[hh][q]; } \
                  *(LAS f32x4*)(buf + O_B + off) = bv; *(LAS f32x4*)(buf + O_KD + off) = kd; *(LAS f32x4*)(buf + O_A + off) = av; } \
              bs = allreduce8(bs); \
              if (MODE == 0 && latent && eighth == 0 && (lane & 7) == 0) bon[rw_row(dir, p0 + tslot) - CTXN] = bs; } \
            } \
            __syncthreads(); \
        } while (0)
        for (int c = -1; c < NC - 1; c += 2) { RW_PREP_ITER(rawA, c); RW_PREP_ITER(rawB, c + 1); }
#undef RW_PREP_ITER
#undef RW_LOADRAW
#undef RW_CST
    } else if (wave >= 4) {
        const int sw = wave - 4, et = lane >> 1, erp = lane & 1;
#define RW_EMIT(cc) do { if ((cc) * CH >= CTXN) { const LAS f32x4* yp = (const LAS f32x4*)(lds + L_Y + ((((cc) & 1) * 2 + sw) * 8192) + et * 256 + erp * 128); \
            f32x4 s0 = yp[0] + yp[1] + yp[2] + yp[3], s1 = yp[4] + yp[5] + yp[6] + yp[7]; \
            *(unsigned*)(BR + (size_t)rw_row(dir, (cc) * CH + et) * 2048 + dir * 1024 + h * 64 + eighth * 8 + sw * 4 + erp * 2) = pkbf((s0[0] + s0[1]) + (s0[2] + s0[3]), (s1[0] + s1[1]) + (s1[2] + s1[3])); } } while (0)
        __syncthreads();
        for (int c = 0; c < NC; ++c) { if (c >= 1) RW_EMIT(c - 1); if (c + 1 < NC) __syncthreads(); }
    } else {
        __builtin_amdgcn_s_setprio(0);
        typedef float f32x2 __attribute__((ext_vector_type(2)));
        f32x2 S01 = {0.f, 0.f}, S23 = {0.f, 0.f};
        const int srow = wave * 4 + (lane >> 4), sj = (lane & 15) * 4;
        __syncthreads();
        struct Ops { f32x4 a, w, b, k, r; float v; };
#define RW_LD(o, t) do { o.a = *(LAS f32x4*)(bp + O_A + (t) * 256); \
            if (MODE == 9) { o.w = o.a; o.b = o.a; o.k = o.a; o.r = o.a; o.v = o.a[0]; } else { o.w = *(LAS f32x4*)(bp + O_W + (t) * 256); o.b = *(LAS f32x4*)(bp + O_B + (t) * 256); \
            o.k = *(LAS f32x4*)(bp + O_KD + (t) * 256); o.r = *(LAS f32x4*)(bp + O_R + (t) * 256); o.v = *(LAS float*)(vp + (t) * 32); } } while (0)
#define RW_STEP(o, t) do { f32x2 pd = S01 * o.a.lo; pd = S23 * o.a.hi + pd; float sa = pd.x + pd.y; if (MODE != 5 && MODE != 7) sa = allreduce16(sa); \
            S01 = o.b.lo * sa + (S01 * o.w.lo + o.k.lo * o.v); S23 = o.b.hi * sa + (S23 * o.w.hi + o.k.hi * o.v); \
            { f32x2 py = S01 * o.r.lo; py = S23 * o.r.hi + py; *(LAS float*)(yb + (t) * 256) = py.x + py.y; } } while (0)
        for (int c = 0; c < NC; ++c) {
            LAS unsigned char* bp = lds + (c & 1) * BUFB + sj * 4; LAS unsigned char* vp = lds + (c & 1) * BUFB + O_V + srow * 4; LAS unsigned char* yb = lds + L_Y + ((c & 1) * 2 + wave) * 8192 + lane * 4;
            Ops A0, A1, A2, A3, B0, B1, B2, B3;
            if (MODE != 2) {
            RW_LD(A0, 0); RW_LD(A1, 1); RW_LD(A2, 2); RW_LD(A3, 3);
#pragma unroll
            for (int g = 0; g < CH / 8; ++g) {
                RW_LD(B0, 8 * g + 4); RW_LD(B1, 8 * g + 5); RW_LD(B2, 8 * g + 6); RW_LD(B3, 8 * g + 7);
                __builtin_amdgcn_sched_barrier(0);
                RW_STEP(A0, 8 * g); RW_STEP(A1, 8 * g + 1); RW_STEP(A2, 8 * g + 2); RW_STEP(A3, 8 * g + 3);
                __builtin_amdgcn_sched_barrier(0);
                if (g + 1 < CH / 8) { RW_LD(A0, 8 * g + 8); RW_LD(A1, 8 * g + 9); RW_LD(A2, 8 * g + 10); RW_LD(A3, 8 * g + 11); }
                __builtin_amdgcn_sched_barrier(0);
                RW_STEP(B0, 8 * g + 4); RW_STEP(B1, 8 * g + 5); RW_STEP(B2, 8 * g + 6); RW_STEP(B3, 8 * g + 7);
                __builtin_amdgcn_sched_barrier(0);
            }
            }
            if (c + 1 < NC) __syncthreads();
        }
#undef RW_LD
#undef RW_STEP
        if (MODE != 0) asm volatile("" :: "v"(S01), "v"(S23));
        __builtin_amdgcn_s_setprio(0);
    }
    __syncthreads();
    if (wave == 4 || wave == 5) { const int sw = wave - 4, et = lane >> 1, erp = lane & 1; RW_EMIT(NC - 1); }
#undef RW_EMIT
    __syncthreads();
}

__device__ __forceinline__ float wave_sum(float v) {
    v = allreduce16(v);
    { auto r = __builtin_amdgcn_permlane16_swap(__float_as_uint(v), __float_as_uint(v), false, false); v = __uint_as_float(r[0]) + __uint_as_float(r[1]); }
    { auto r = __builtin_amdgcn_permlane32_swap(__float_as_uint(v), __float_as_uint(v), false, false); v = __uint_as_float(r[0]) + __uint_as_float(r[1]); }
    return v;
}
__device__ __forceinline__ void finish_phase(const Params& p) {
    int tid_ = threadIdx.x; asm volatile("" : "+v"(tid_));
    const int lane = tid_ & 63, gw = (int)blockIdx.x * NWAVES + (tid_ >> 6), ngw = (int)gridDim.x * NWAVES;
    const bf16_t* Z = ws_big(p); bf16_t* BR = ws_br(p); const float* bon = (const float*)(p.ws + WS_BON);
    for (int it = gw; it < SEQ * 4; it += ngw) {
        const int t = it >> 2, h = (it & 3) * 4 + (lane >> 4), row = CTXN + t, col = h * 64 + (lane & 15) * 4;
        bf16_t* b = BR + (size_t)row * 2048;
        const u32x2 wf = *(const u32x2*)(b + col), wb = *(const u32x2*)(b + 1024 + col), zv = *(const u32x2*)(Z + (size_t)row * ZW + 2048 + col);
        const f32x4 x = {bflo(wf.x) + bflo(wb.x), bfhi(wf.x) + bfhi(wb.x), bflo(wf.y) + bflo(wb.y), bfhi(wf.y) + bfhi(wb.y)};
        const float mean = allreduce16((x[0] + x[1]) + (x[2] + x[3])) * (1.0f / 64.f);
        const f32x4 d = x - mean;
        const float var = allreduce16((d[0] * d[0] + d[1] * d[1]) + (d[2] * d[2] + d[3] * d[3])) * (1.0f / 64.f);
        const float rstd = __builtin_amdgcn_rsqf(var + GN_EPS), bsum = bon[(size_t)h * SEQ + t] + bon[((size_t)16 + h) * SEQ + t];
        const f32x4 g = *(const f32x4*)(p.lnx_g + col), bb = *(const f32x4*)(p.lnx_b + col), v = {bflo(zv.x), bfhi(zv.x), bflo(zv.y), bfhi(zv.y)};
        const f32x4 y = d * rstd * g + bb + v * bsum;
        u32x2 o; o.x = pkbf(y[0], y[1]); o.y = pkbf(y[2], y[3]);
        *(u32x2*)(b + 1024 + col) = o;
    }
}
}

namespace wy {
typedef short bf16x4 __attribute__((ext_vector_type(4)));
using rw::f32x4; using rw::u32x4; using rw::u32x2; using rw::bf16x8; using rw::bflo; using rw::bfhi; using rw::PITCH;
typedef float f32x2_t __attribute__((ext_vector_type(2)));
typedef __bf16 bf2_t __attribute__((ext_vector_type(2)));
__device__ __forceinline__ unsigned pkbf(float lo, float hi) { const f32x2_t v = {lo, hi}; return __builtin_bit_cast(unsigned, __builtin_convertvector(v, bf2_t)); }
typedef GAS unsigned gu32;
#define WY_RLX __ATOMIC_RELAXED, __HIP_MEMORY_SCOPE_AGENT
constexpr int NJOB = R / 64, NCHUNK = R / 16, NSLOT = 8, ATP = 144, REC = 13056, JOBB = 4 * REC;
static_assert(R % 64 == 0 && CTXN % 64 == 0 && (R / 64) % 2 == 0, "jobs are 64 tokens; the loader is unrolled by two jobs");
constexpr int R_AT = 0, R_RT = 2304, R_BK = 4608, R_VT = 8704, R_AAK = 10752, R_TT = 11264, R_ARBK = 11776, R_WL = 12800;
__device__ __forceinline__ int permj(int j) { return (j >> 5) * 32 + ((j >> 2) & 3) * 8 + ((j >> 4) & 1) * 4 + (j & 3); }
constexpr int C_SLOTS = 3, C_SYNC = C_SLOTS * JOBB;
static_assert(C_SYNC + 64 <= 163840 - 64 && (JOBB / 4) % 16 == 0, "consumer LDS map");
constexpr size_t WS_RING = WS_WB;
constexpr size_t RING_TOTAL = (size_t)32 * NSLOT * JOBB;
constexpr size_t WS_WYF = 256 * 1024 + 16384;
constexpr int WYF_ACK = 32 * NSLOT * 64, WYF_ABORT = WYF_ACK + 32 * 64, WYF_WORDS = WYF_ABORT + 64;
constexpr unsigned SPIN_CAP = 1u << 17;
constexpr int P_A = 0, P_B = 16384, P_KD = 32768, P_LW = 49152, P_IMG = 65536, P_BRM = P_IMG + JOBB, P_KRM = P_BRM + 8192, P_AAB = P_KRM + 8192, P_W2T = P_AAB + 4096, P_A2T = P_W2T + 64 * PITCH * 2, P_END = P_A2T + 64 * PITCH * 2;
constexpr int P_SCR = P_BRM, SCRW = 2 * 8 * PITCH * 2;
constexpr int P_CST = P_IMG;
static_assert(P_END <= 163840 - 64 && P_SCR + 8 * SCRW + 8 * PITCH * 2 <= P_W2T, "wy LDS map");

__device__ __forceinline__ bf16x4 pack4(f32x4 v) { u32x2 r; r.x = pkbf(v[0], v[1]); r.y = pkbf(v[2], v[3]); return __builtin_bit_cast(bf16x4, r); }
__device__ __forceinline__ f32x4 mm(u32x2 a, bf16x4 b, f32x4 c) { return __builtin_amdgcn_mfma_f32_16x16x16bf16_1k(__builtin_bit_cast(bf16x4, a), b, c, 0, 0, 0); }
__device__ __forceinline__ f32x4 mm(u32x2 a, u32x2 b, f32x4 c) { return __builtin_amdgcn_mfma_f32_16x16x16bf16_1k(__builtin_bit_cast(bf16x4, a), __builtin_bit_cast(bf16x4, b), c, 0, 0, 0); }
__device__ __forceinline__ void wait_ge(gu32* word, unsigned want, gu32* abortw, int lane) {
    for (unsigned spins = 0;;) {
        unsigned v = 0u; if (lane == 0) v = __hip_atomic_load(word, WY_RLX);
        if ((unsigned)__builtin_amdgcn_readfirstlane(v) >= want) return;
        __builtin_amdgcn_s_sleep(1);
        if ((++spins & 255u) == 0u) { unsigned a = 0u; if (lane == 0) a = __hip_atomic_load(abortw, WY_RLX);
            if (__builtin_amdgcn_readfirstlane(a)) return;
            if (spins > SPIN_CAP) { if (lane == 0) __hip_atomic_store(abortw, 1u, WY_RLX); return; } }
    }
}

__device__ __forceinline__ void wait_ge4(gu32* words, unsigned want, gu32* abortw, int lane) {
    for (unsigned spins = 0;;) {
        unsigned v = 0xffffffffu; if (lane < 4) v = __hip_atomic_load(words + lane, WY_RLX);
        const unsigned v0 = (unsigned)__builtin_amdgcn_readlane((int)v, 0), v1 = (unsigned)__builtin_amdgcn_readlane((int)v, 1), v2 = (unsigned)__builtin_amdgcn_readlane((int)v, 2), v3 = (unsigned)__builtin_amdgcn_readlane((int)v, 3);
        const unsigned m01 = v0 < v1 ? v0 : v1, m23 = v2 < v3 ? v2 : v3;
        if ((m01 < m23 ? m01 : m23) >= want) return;
        __builtin_amdgcn_s_sleep(1);
        if ((++spins & 255u) == 0u) { unsigned a = 0u; if (lane == 0) a = __hip_atomic_load(abortw, WY_RLX);
            if (__builtin_amdgcn_readfirstlane(a)) return;
            if (spins > SPIN_CAP) { if (lane == 0) __hip_atomic_store(abortw, 1u, WY_RLX); return; } }
    }
}

struct Frag { u32x4 a01, a23, r01, r23, bk[4], arbk; u32x2 vT, aak, tt; f32x4 wl[4]; };

__device__ __forceinline__ void wait_lds_min4(LAS unsigned* w, unsigned want, gu32* abortw, int lane) {
    for (unsigned spins = 0;;) {
        const unsigned a = __hip_atomic_load(w, __ATOMIC_RELAXED, __HIP_MEMORY_SCOPE_WORKGROUP), b = __hip_atomic_load(w + 1, __ATOMIC_RELAXED, __HIP_MEMORY_SCOPE_WORKGROUP),
                       c = __hip_atomic_load(w + 2, __ATOMIC_RELAXED, __HIP_MEMORY_SCOPE_WORKGROUP), d = __hip_atomic_load(w + 3, __ATOMIC_RELAXED, __HIP_MEMORY_SCOPE_WORKGROUP);
        const unsigned m0 = a < b ? a : b, m1 = c < d ? c : d;
        if ((unsigned)__builtin_amdgcn_readfirstlane((int)(m0 < m1 ? m0 : m1)) >= want) return;
        __builtin_amdgcn_s_sleep(1);
        if ((++spins & 1023u) == 0u) { unsigned ab = 0u; if (lane == 0) ab = __hip_atomic_load(abortw, WY_RLX);
            if (__builtin_amdgcn_readfirstlane(ab)) return;
            if (spins > (SPIN_CAP << 3)) { if (lane == 0) __hip_atomic_store(abortw, 1u, WY_RLX); return; } }
    }
}
template <int MODE> __device__ __forceinline__ void loader(const Params& p, int chain, int lw, int lane, LAS unsigned char* lds) {
    gu32* wf = (gu32*)(p.ws + WS_WYF); gu32* flags = wf + chain * NSLOT * 64; gu32* ackw = wf + WYF_ACK + chain * 64; gu32* abortw = wf + WYF_ABORT;
    LAS unsigned* loaded = (LAS unsigned*)(lds + C_SYNC); LAS unsigned* done = loaded + 4;
    const __amdgpu_buffer_rsrc_t ring_rsrc = __builtin_amdgcn_make_buffer_rsrc((void*)(p.ws + WS_RING), 0, (int)RING_TOTAL, 0x00020000);
    constexpr int QB = JOBB / 4, NIT = (QB / 16 + 63) / 64, TAIL = QB / 16 - (NIT - 1) * 64;
    static_assert(NIT == 13, "the counted waits below assume 13 loads per set");
    u32x4 va[NIT], vb[NIT];
#define WY_ISSUE(v, g_) do { if (MODE < 2) wait_ge(flags + ((g_) % NSLOT) * 64, (unsigned)(g_) + 1u, abortw, lane); \
        const int soff = (chain * NSLOT + (g_) % NSLOT) * JOBB + lw * QB + lane * 16; \
        _Pragma("unroll") for (int k = 0; k < NIT; ++k) if (MODE == 0 && (k < NIT - 1 || lane < TAIL)) v[k] = __builtin_amdgcn_raw_buffer_load_b128(ring_rsrc, soff + k * 1024, 0, 16); } while (0)
#define WY_COMMIT(v, g_, WAITSTR) do { \
        if (MODE != 1 && (g_) >= C_SLOTS) { wait_lds_min4(done, (unsigned)((g_) - C_SLOTS + 1), abortw, lane); __builtin_amdgcn_fence(__ATOMIC_ACQUIRE, "workgroup"); }     \
        asm volatile(WAITSTR ::: "memory");                                                     \
        LAS unsigned char* dst = lds + ((g_) % C_SLOTS) * JOBB + lw * QB + lane * 16; \
        _Pragma("unroll") for (int k = 0; k < NIT; ++k) if (MODE == 0 && (k < NIT - 1 || lane < TAIL)) *(LAS u32x4*)(dst + k * 1024) = v[k]; \
        asm volatile("s_waitcnt lgkmcnt(0)" ::: "memory"); \
        __builtin_amdgcn_fence(__ATOMIC_RELEASE, "workgroup"); \
        if (lane == 0) { __hip_atomic_store(ackw + lw, (unsigned)(g_) + 1u, WY_RLX); __hip_atomic_store(loaded + lw, (unsigned)(g_) + 1u, __ATOMIC_RELAXED, __HIP_MEMORY_SCOPE_WORKGROUP); } } while (0)
    WY_ISSUE(va, 0);
    for (int g = 0; g < NJOB; g += 2) {
        WY_ISSUE(vb, g + 1); WY_COMMIT(va, g, "s_waitcnt vmcnt(13)");
        if (g + 2 < NJOB) { WY_ISSUE(va, g + 2); WY_COMMIT(vb, g + 1, "s_waitcnt vmcnt(13)"); } else WY_COMMIT(vb, g + 1, "s_waitcnt vmcnt(0)");
    }
#undef WY_ISSUE
#undef WY_COMMIT
}
__device__ __forceinline__ bf16x8 cat(u32x2 a, u32x2 b) { const u32x4 v = {a.x, a.y, b.x, b.y}; return __builtin_bit_cast(bf16x8, v); }
__device__ __forceinline__ u32x2 pack4u(f32x4 v) { u32x2 r; r.x = pkbf(v[0], v[1]); r.y = pkbf(v[2], v[3]); return r; }
__device__ __forceinline__ f32x4 mm32(bf16x8 a, bf16x8 b, f32x4 c) { return __builtin_amdgcn_mfma_f32_16x16x32_bf16(a, b, c, 0, 0, 0); }
template <int MODE> __device__ __forceinline__ void consumer(const Params& p, int chain, int wave, int lane, LAS unsigned char* lds) {
    const int n = lane & 15, q = lane >> 4, dir = chain >> 4, h = chain & 15;
    gu32* abortw = (gu32*)(p.ws + WS_WYF) + WYF_ABORT;
    LAS unsigned* loaded = (LAS unsigned*)(lds + C_SYNC); LAS unsigned* done = loaded + 4;
    f32x4 S0 = {0.f, 0.f, 0.f, 0.f}, S1 = S0, S2 = S0, S3 = S0;
    const int offA = n * ATP + 16 * q, offB = n * 32 + 8 * q, offW = 16 * q, offS = n * 64 + ((q ^ ((n >> 2) & 3)) * 16);
    const long rstep = dir ? -2048 : 2048;
    bf16_t* yq = ws_br(p) + (size_t)(CTXN + (dir ? SEQ - 1 - 4 * q : 4 * q)) * 2048 + dir * 1024 + h * 64 + 16 * wave + n;
#define WY_LOAD(F, base, k) do { \
        F.a01 = *(const LAS u32x4*)(base + offA + (k) * REC + R_AT); F.a23 = *(const LAS u32x4*)(base + offA + (k) * REC + R_AT + 64); \
        F.r01 = *(const LAS u32x4*)(base + offA + (k) * REC + R_RT); F.r23 = *(const LAS u32x4*)(base + offA + (k) * REC + R_RT + 64); \
        _Pragma("unroll") for (int jt = 0; jt < 4; ++jt) { F.bk[jt] = *(const LAS u32x4*)(base + offS + (k) * REC + R_BK + 1024 * jt); F.wl[jt] = *(const LAS f32x4*)(base + offW + (k) * REC + R_WL + 64 * jt); } \
        F.arbk = *(const LAS u32x4*)(base + offS + (k) * REC + R_ARBK); \
        F.vT = *(const LAS u32x2*)(base + offB + (k) * REC + R_VT + 512 * wave); F.aak = *(const LAS u32x2*)(base + offB + (k) * REC + R_AAK); F.tt = *(const LAS u32x2*)(base + offB + (k) * REC + R_TT); } while (0)
#define WY_Q(v) __builtin_bit_cast(bf16x8, v)
#define WY_COMPUTE(F, cidx) do { const f32x4 z0_ = {0.f, 0.f, 0.f, 0.f}; const u32x2 zz_ = {0u, 0u};     \
        f32x4 Z = mm32(cat(F.aak, zz_), cat(F.vT, zz_), z0_); \
        const bf16x8 s01 = cat(pack4u(S0), pack4u(S1)), s23 = cat(pack4u(S2), pack4u(S3)); \
        Z = mm32(WY_Q(F.a01), s01, Z); Z = mm32(WY_Q(F.a23), s23, Z);     \
        f32x4 Y = mm32(WY_Q(F.r01), s01, z0_); Y = mm32(WY_Q(F.r23), s23, Y); \
        const u32x2 zb = pack4u(Z); const f32x4 U = mm32(cat(F.tt, zz_), cat(zb, zz_), z0_); const u32x2 ub = pack4u(U); \
        const bf16x8 vu = cat(F.vT, ub); \
        Y = mm32(WY_Q(F.arbk), vu, Y); \
        S0 = mm32(WY_Q(F.bk[0]), vu, S0); S1 = mm32(WY_Q(F.bk[1]), vu, S1); S2 = mm32(WY_Q(F.bk[2]), vu, S2); S3 = mm32(WY_Q(F.bk[3]), vu, S3); \
        S0 *= F.wl[0]; S1 *= F.wl[1]; S2 *= F.wl[2]; S3 *= F.wl[3]; \
        if (MODE == 0 && (cidx) * 16 >= CTXN) { const unsigned y01 = pkbf(Y[0], Y[1]), y23 = pkbf(Y[2], Y[3]); bf16_t* yp_ = yq + (long)((cidx) * 16 - CTXN) * rstep; \
            *(unsigned short*)yp_ = (unsigned short)(y01 & 0xffffu); *(unsigned short*)(yp_ + rstep) = (unsigned short)(y01 >> 16); \
            *(unsigned short*)(yp_ + 2 * rstep) = (unsigned short)(y23 & 0xffffu); *(unsigned short*)(yp_ + 3 * rstep) = (unsigned short)(y23 >> 16); } } while (0)
    Frag FA, FB;
    wait_lds_min4(loaded, 1u, abortw, lane); __builtin_amdgcn_fence(__ATOMIC_ACQUIRE, "workgroup");
    int slot = 0;
    { const LAS unsigned char* b0 = lds; WY_LOAD(FA, b0, 0); if (MODE == 3) WY_LOAD(FB, b0, 1); }
    for (int g = 0; g < NJOB; ++g) {
        const LAS unsigned char* base = lds + slot * JOBB;
        if (MODE != 3) WY_LOAD(FB, base, 1); WY_COMPUTE(FA, 4 * g);
        if (MODE != 3) WY_LOAD(FA, base, 2); WY_COMPUTE(FB, 4 * g + 1);
        if (MODE != 3) WY_LOAD(FB, base, 3); WY_COMPUTE(FA, 4 * g + 2);
        slot = slot == C_SLOTS - 1 ? 0 : slot + 1;
        if (g + 1 < NJOB) { wait_lds_min4(loaded, (unsigned)g + 2u, abortw, lane); __builtin_amdgcn_fence(__ATOMIC_ACQUIRE, "workgroup");
            const LAS unsigned char* nb = lds + slot * JOBB; if (MODE != 3) WY_LOAD(FA, nb, 0); }
        WY_COMPUTE(FB, 4 * g + 3);
        asm volatile("s_waitcnt lgkmcnt(0)" ::: "memory");
        __builtin_amdgcn_fence(__ATOMIC_RELEASE, "workgroup");
        if (lane == 0) __hip_atomic_store(done + wave, (unsigned)g + 1u, __ATOMIC_RELAXED, __HIP_MEMORY_SCOPE_WORKGROUP);
    }
#undef WY_LOAD
#undef WY_COMPUTE
#undef WY_Q
    if (MODE != 0) asm volatile("" :: "v"(S0), "v"(S1), "v"(S2), "v"(S3));
}

template <int HALF> __device__ __forceinline__ void stage2(LAS unsigned char* lds, LAS unsigned char* img, int ch, int j) {
    LAS unsigned char* rec = img + ch * REC;
    const LAS float* LW = (const LAS float*)(lds + P_LW) + (ch * 16) * 64 + j;
    const LAS float* XA = (const LAS float*)(lds + (HALF ? P_KD : P_A)) + (ch * 16) * 64 + j;
    const LAS float* XB = (const LAS float*)(lds + P_B) + (ch * 16) * 64 + j;
    LAS unsigned short* rowm0 = (LAS unsigned short*)(rec + (HALF ? R_RT : R_AT)) + permj(j);
    LAS unsigned short* rowm1 = (LAS unsigned short*)(lds + (HALF ? P_KRM : P_BRM) + ch * 2048) + permj(j);
    float lw[16], s0[16], s1[16];
#pragma unroll
    for (int t = 0; t < 16; ++t) { lw[t] = LW[t * 64]; s1[t] = HALF ? XA[t * 64] : XB[t * 64];
        if (HALF) s0[t] = __uint_as_float((unsigned)rowm0[t * (ATP / 2)] << 16); else s0[t] = XA[t * 64]; }
    float cum = 0.f, x0p = 0.f, x1p = 0.f; unsigned tp[8];
#pragma unroll
    for (int t = 0; t < 16; ++t) {
        const float cprev = cum; cum += lw[t];
        const float x0 = s0[t] * __builtin_amdgcn_exp2f(HALF ? cum : cprev), x1 = s1[t] * __builtin_amdgcn_exp2f(-cum);
        if (t & 1) { const unsigned p0 = pkbf(x0p, x0), p1 = pkbf(x1p, x1);
            rowm0[(t - 1) * (ATP / 2)] = (unsigned short)(p0 & 0xffffu); rowm0[t * (ATP / 2)] = (unsigned short)(p0 >> 16);
            rowm1[(t - 1) * 64] = (unsigned short)(p1 & 0xffffu); rowm1[t * 64] = (unsigned short)(p1 >> 16);
            tp[t >> 1] = p1; }
        x0p = x0; x1p = x1; }
    { LAS unsigned char* bkr = rec + R_BK + j * 64 + (HALF ? 0 : 8); const int sw = (j >> 2) & 3;
#pragma unroll
      for (int qq = 0; qq < 4; ++qq) *(LAS u32x2*)(bkr + ((qq ^ sw) * 16)) = (u32x2){tp[2 * qq], tp[2 * qq + 1]}; }
    if (HALF) *(LAS float*)(rec + R_WL + j * 4) = __builtin_amdgcn_exp2f(cum);
}

template <int SKIP> __device__ __forceinline__ void producer(const Params& p, int chain, int first, int step, LAS unsigned char* lds) {
    int tid_ = threadIdx.x; asm volatile("" : "+v"(tid_));
    const int tid = tid_, lane = tid & 63, wave = __builtin_amdgcn_readfirstlane(tid >> 6);
    const int dir = chain >> 4, h = chain & 15;
    const float* w0 = dir ? p.w0b : p.w0f; const float* w2 = dir ? p.w2b : p.w2f; const float* a0 = dir ? p.a0b : p.a0f; const float* a2 = dir ? p.a2b : p.a2f;
    const bf16_t* Z = ws_big(p); float* bon = (float*)(p.ws + rw::WS_BON) + ((size_t)dir * 16 + h) * SEQ;
    gu32* wf = (gu32*)(p.ws + WS_WYF); gu32* flags = wf + chain * NSLOT * 64; gu32* ackw = wf + WYF_ACK + chain * 64; gu32* abortw = wf + WYF_ABORT;
    const __amdgpu_buffer_rsrc_t ring_rsrc = __builtin_amdgcn_make_buffer_rsrc((void*)(p.ws + WS_RING), 0, (int)RING_TOTAL, 0x00020000);
    { const int m = tid >> 3, j8 = (tid & 7) * 8;
      const f32x4 wa = *(const f32x4*)(w2 + (size_t)m * 1024 + h * 64 + j8), wb = *(const f32x4*)(w2 + (size_t)m * 1024 + h * 64 + j8 + 4);
      const f32x4 aa = *(const f32x4*)(a2 + (size_t)m * 1024 + h * 64 + j8), ab = *(const f32x4*)(a2 + (size_t)m * 1024 + h * 64 + j8 + 4);
      LAS bf16_t* yw = (LAS bf16_t*)(lds + P_W2T); LAS bf16_t* ya = (LAS bf16_t*)(lds + P_A2T);
#pragma unroll
      for (int qq = 0; qq < 4; ++qq) { yw[(j8 + qq) * PITCH + m] = f2bf(wa[qq]); yw[(j8 + 4 + qq) * PITCH + m] = f2bf(wb[qq]); ya[(j8 + qq) * PITCH + m] = f2bf(aa[qq]); ya[(j8 + 4 + qq) * PITCH + m] = f2bf(ab[qq]); }
      for (int i = tid; i < 320; i += NTHR) { const int gI = i >> 6, cc = i & 63, hc = h * 64 + cc; float v;
          if (gI == 0) v = w0[hc]; else if (gI == 1) v = a0[hc]; else if (gI == 2) v = p.k_k[hc]; else if (gI == 3) v = p.k_a[hc]; else v = p.r_k[hc];
          *(LAS float*)(lds + P_CST + i * 4) = v; } }
    __syncthreads();
    const int tq = lane >> 3, c8 = (lane & 7) * 8, hj = h * 64 + c8, tslot = wave * 8 + tq, ch1 = tslot >> 4, t1 = tslot & 15;
    const int gcol[5] = {hj, 1024 + hj, 2048 + hj, 3072 + dir * 64 + c8, 3200 + dir * 64 + c8};
    f32x4 cw0[2], ca0[2], ckk[2], cka[2], crk[2];
#pragma unroll
    for (int hh = 0; hh < 2; ++hh) {
#define WY_CST(gI) (*(LAS f32x4*)(lds + P_CST + ((gI) * 64 + c8 + 4 * hh) * 4))
        cw0[hh] = WY_CST(0); ca0[hh] = WY_CST(1); ckk[hh] = WY_CST(2); cka[hh] = WY_CST(3); crk[hh] = WY_CST(4);
#undef WY_CST
        asm volatile("" : "+v"(cw0[hh]), "+v"(ca0[hh]), "+v"(ckk[hh]), "+v"(cka[hh]), "+v"(crk[hh])); }
    __syncthreads();
    LAS unsigned char* scr = lds + P_SCR + wave * SCRW;
    LAS unsigned char* img = lds + P_IMG;
    rw::Raw raw;
#define WY_LOADRAW(gj) do { const bf16_t* zr_ = Z + (size_t)rw_row(dir, (gj) * 64 + tslot) * ZW; \
        _Pragma("unroll") for (int g5 = 0; g5 < 5; ++g5) raw.c[g5] = *(const u32x4*)(zr_ + gcol[g5]); } while (0)
    if (first < NJOB) WY_LOADRAW(first);
    for (int g = first; g < NJOB; g += step) {
        const bool latent = g * 64 >= CTXN;
        if (!(SKIP & 1)) { f32x4 rr[2], kv[2];
          { const u32x4 u = raw.c[0]; rr[0] = (f32x4){bflo(u.x), bfhi(u.x), bflo(u.y), bfhi(u.y)}; rr[1] = (f32x4){bflo(u.z), bfhi(u.z), bflo(u.w), bfhi(u.w)};
            LAS unsigned char* rr_ = img + ch1 * REC + R_RT + t1 * ATP + permj(c8) * 2; *(LAS u32x2*)rr_ = (u32x2){u.x, u.y}; *(LAS u32x2*)(rr_ + 16) = (u32x2){u.z, u.w}; }
          { const u32x4 u = raw.c[1]; kv[0] = (f32x4){bflo(u.x), bfhi(u.x), bflo(u.y), bfhi(u.y)}; kv[1] = (f32x4){bflo(u.z), bfhi(u.z), bflo(u.w), bfhi(u.w)}; }
          { const u32x4 u = raw.c[2]; LAS unsigned short* vt = (LAS unsigned short*)(img + ch1 * REC + R_VT) + c8 * 16 + t1;
            vt[0] = (unsigned short)(u.x & 0xffffu); vt[16] = (unsigned short)(u.x >> 16); vt[32] = (unsigned short)(u.y & 0xffffu); vt[48] = (unsigned short)(u.y >> 16);
            vt[64] = (unsigned short)(u.z & 0xffffu); vt[80] = (unsigned short)(u.z >> 16); vt[96] = (unsigned short)(u.w & 0xffffu); vt[112] = (unsigned short)(u.w >> 16); }
          { const u32x4 u = raw.c[3]; u32x4 o;
            o.x = pkbf(rw::fast_tanh(bflo(u.x)), rw::fast_tanh(bfhi(u.x))); o.y = pkbf(rw::fast_tanh(bflo(u.y)), rw::fast_tanh(bfhi(u.y))); o.z = pkbf(rw::fast_tanh(bflo(u.z)), rw::fast_tanh(bfhi(u.z))); o.w = pkbf(rw::fast_tanh(bflo(u.w)), rw::fast_tanh(bfhi(u.w)));
            *(LAS u32x4*)(scr + (tq * PITCH + c8) * 2) = o; *(LAS u32x4*)(scr + 8 * PITCH * 2 + (tq * PITCH + c8) * 2) = raw.c[4]; }
          if (g + step < NJOB) WY_LOADRAW(g + step);
          asm volatile("s_waitcnt lgkmcnt(0)" ::: "memory");
          { const int r16 = lane & 15, quad = lane >> 4; f32x4 acc[2][4];
#pragma unroll
            for (int lora = 0; lora < 2; ++lora) {
                LAS unsigned char* X = scr + lora * 8 * PITCH * 2 + (r16 * PITCH + quad * 8) * 2;
                const bf16x8 x0 = *(LAS bf16x8*)X, x1 = *(LAS bf16x8*)(X + 64);
#pragma unroll
                for (int jt = 0; jt < 4; ++jt) {
                    LAS unsigned char* Y = lds + (lora ? P_A2T : P_W2T) + ((jt * 16 + r16) * PITCH + quad * 8) * 2;
                    acc[lora][jt] = (f32x4){0.f, 0.f, 0.f, 0.f};
                    acc[lora][jt] = __builtin_amdgcn_mfma_f32_16x16x32_bf16(x0, *(LAS bf16x8*)Y, acc[lora][jt], 0, 0, 0);
                    acc[lora][jt] = __builtin_amdgcn_mfma_f32_16x16x32_bf16(x1, *(LAS bf16x8*)(Y + 64), acc[lora][jt], 0, 0, 0); } }
            if (quad < 2) {
#pragma unroll
                for (int lora = 0; lora < 2; ++lora)
#pragma unroll
                    for (int jt = 0; jt < 4; ++jt)
#pragma unroll
                        for (int r = 0; r < 4; ++r) *(LAS float*)(lds + (lora ? P_B : P_LW) + ((wave * 8 + quad * 4 + r) * 64 + jt * 16 + r16) * 4) = acc[lora][jt][r]; } }
          asm volatile("s_waitcnt lgkmcnt(0)" ::: "memory");
          { float bs = 0.f, nn = 0.f; f32x4 kk[2], al[2];
#pragma unroll
            for (int hh = 0; hh < 2; ++hh) { const int off = (tslot * 64 + c8 + 4 * hh) * 4;
                const f32x4 aw = *(LAS f32x4*)(lds + P_LW + off) + cw0[hh], aa = *(LAS f32x4*)(lds + P_B + off) + ca0[hh];
                f32x4 lw;
#pragma unroll
                for (int qq = 0; qq < 4; ++qq) { const float sg = __builtin_amdgcn_rcpf(1.0f + __builtin_amdgcn_exp2f(-1.4426950408889634f * aw[qq]));
                    lw[qq] = -0.8750612633917f * sg; al[hh][qq] = __builtin_amdgcn_rcpf(1.0f + __builtin_amdgcn_exp2f(-1.4426950408889634f * aa[qq])); kk[hh][qq] = kv[hh][qq] * ckk[hh][qq]; nn += kk[hh][qq] * kk[hh][qq]; }
                *(LAS f32x4*)(lds + P_LW + off) = lw; }
            nn = rw::allreduce8(nn);
            const float inv = __builtin_amdgcn_rsqf(fmaxf(nn, 1e-24f));
#pragma unroll
            for (int hh = 0; hh < 2; ++hh) { const int off = (tslot * 64 + c8 + 4 * hh) * 4;
                const f32x4 r = rr[hh];
                f32x4 av, bv, kd;
#pragma unroll
                for (int qq = 0; qq < 4; ++qq) { const float kn = kk[hh][qq] * inv; av[qq] = -kn; bv[qq] = kn * al[hh][qq]; kd[qq] = kv[hh][qq] * (1.0f + (al[hh][qq] - 1.0f) * cka[hh][qq]); bs += r[qq] * kd[qq] * crk[hh][qq]; }
                *(LAS f32x4*)(lds + P_B + off) = bv; *(LAS f32x4*)(lds + P_KD + off) = kd; *(LAS f32x4*)(lds + P_A + off) = av; }
            bs = rw::allreduce8(bs);
            if (latent && (lane & 7) == 0) bon[rw_row(dir, g * 64 + tslot) - CTXN] = bs; } }
        __syncthreads();
        if (!(SKIP & 2)) { if (wave >> 2) stage2<1>(lds, img, wave & 3, lane); else stage2<0>(lds, img, wave & 3, lane); }
        __syncthreads();
        if (!(SKIP & 4)) { const int ch = wave & 3, pair = wave >> 2, n = lane & 15, q = lane >> 4;
          LAS unsigned char* rec = img + ch * REC;
          const LAS unsigned char* Yrm = rec + (pair ? R_RT : R_AT) + n * ATP + 16 * q;
          const LAS unsigned char* Xb = lds + P_BRM + ch * 2048 + n * 128 + 16 * q;
          const LAS unsigned char* Xk = lds + P_KRM + ch * 2048 + n * 128 + 16 * q;
          f32x4 cb = {0.f, 0.f, 0.f, 0.f}, ck = cb;
#pragma unroll
          for (int jt = 0; jt < 4; ++jt) { const int o_ = (jt >> 1) * 64 + (jt & 1) * 8; const u32x2 yb = *(const LAS u32x2*)(Yrm + o_);
              cb = mm(*(const LAS u32x2*)(Xb + o_), yb, cb); ck = mm(*(const LAS u32x2*)(Xk + o_), yb, ck); }
#pragma unroll
          for (int r = 0; r < 4; ++r) { const int s = 4 * q + r; const bool keep = pair ? (s <= n) : (s < n); if (!keep) { cb[r] = 0.f; ck[r] = 0.f; } }
          u32x2 ob, ok; ob.x = pkbf(cb[0], cb[1]); ob.y = pkbf(cb[2], cb[3]); ok.x = pkbf(ck[0], ck[1]); ok.y = pkbf(ck[2], ck[3]);
          if (pair) *(LAS u32x4*)(rec + R_ARBK + n * 64 + ((q ^ ((n >> 2) & 3)) * 16)) = (u32x4){ok.x, ok.y, ob.x, ob.y};
          else {
              *(LAS u32x2*)(rec + R_AAK + n * 32 + 8 * q) = ok;
              LAS float* A2 = (LAS float*)(lds + P_AAB + ch * 1024);
#pragma unroll
              for (int r = 0; r < 4; ++r) A2[n * 16 + r * 4 + q] = cb[r];
              asm volatile("s_waitcnt lgkmcnt(0)" ::: "memory");
              const int c = lane >> 2, pp = lane & 3;
              f32x4 a4[16];
#pragma unroll
              for (int t = 0; t < 16; ++t) a4[t] = *(const LAS f32x4*)(A2 + t * 16 + pp * 4);
              float Tk0 = 0.f, Tk1 = 0.f, Tk2 = 0.f, Tk3 = 0.f, Tprev = 0.f;
              LAS unsigned short* tt = (LAS unsigned short*)(rec + R_TT) + c;
#pragma unroll
              for (int t = 0; t < 16; ++t) {
                  float acc = (a4[t][0] * Tk0 + a4[t][1] * Tk1) + (a4[t][2] * Tk2 + a4[t][3] * Tk3);
                  acc += rw::dppmov<0xB1>(acc); acc += rw::dppmov<0x4E>(acc);
                  const float Tt = acc + ((t == c) ? 1.0f : 0.0f);
                  const bool mine = (t & 3) == pp;
                  if ((t >> 2) == 0) Tk0 = mine ? Tt : Tk0; else if ((t >> 2) == 1) Tk1 = mine ? Tt : Tk1; else if ((t >> 2) == 2) Tk2 = mine ? Tt : Tk2; else Tk3 = mine ? Tt : Tk3;
                  if (t & 1) { const unsigned pk_ = pkbf(Tprev, Tt); if (pp == 0) { tt[(t - 1) * 16] = (unsigned short)(pk_ & 0xffffu); tt[t * 16] = (unsigned short)(pk_ >> 16); } }
                  Tprev = Tt; }
          } }
        if (!(SKIP & 16) && wave == 0 && g >= NSLOT) wait_ge4(ackw, (unsigned)(g - NSLOT + 1), abortw, lane);
        __syncthreads();
        { const int slot = g % NSLOT; const int base = (chain * NSLOT + slot) * JOBB;
          if (!(SKIP & 8)) for (int i = tid; i < JOBB / 16; i += NTHR) __builtin_amdgcn_raw_buffer_store_b128(*(LAS u32x4*)(img + i * 16), ring_rsrc, base + i * 16, 0, 16);
          asm volatile("s_waitcnt vmcnt(0)" ::: "memory");
          __syncthreads();
          if (tid == 0) __hip_atomic_store(flags + slot * 64, (unsigned)g + 1u, WY_RLX); }
    }
#undef WY_LOADRAW
}

__device__ __forceinline__ void zero_words(const Params& p) {
    int t_ = threadIdx.x; asm volatile("" : "+v"(t_)); unsigned* wf_ = (unsigned*)(p.ws + WS_WYF);
    for (long g = (long)blockIdx.x * NTHR + t_; g < (long)WYF_WORDS; g += (long)gridDim.x * NTHR) wf_[g] = 0u;
}
template <int MODE, int SKIP = 0> __device__ __forceinline__ void phase(const Params& p, LAS unsigned char* lds) {
    const int G = (int)gridDim.x, b = (int)blockIdx.x, nper = (G - 32) / 32;
    if (b < 32) {
        int tid_ = threadIdx.x; asm volatile("" : "+v"(tid_)); const int wave = __builtin_amdgcn_readfirstlane(tid_ >> 6);
        if (tid_ < 8) *(LAS unsigned*)(lds + C_SYNC + 4 * tid_) = 0u;
        __syncthreads();
        if (MODE == 4) { }
        else if (wave < 4) { if (MODE != 1) consumer<MODE>(p, b, wave, tid_ & 63, lds); } else loader<MODE>(p, b, wave - 4, tid_ & 63, lds);
    }
    else if (MODE < 2 || MODE == 4) { const int pp = b - 32; if (pp < 32 * nper) producer<SKIP>(p, pp % 32, pp / 32, nper, lds); }
}
}

namespace ret {
using attn::bf16x8; using attn::s16x4; using attn::f32x16; using attn::u32x4;
typedef float f32x4 __attribute__((ext_vector_type(4)));
typedef unsigned u32x2 __attribute__((ext_vector_type(2)));
constexpr int NQ = R / 128;
constexpr size_t SLOT_BYTES = 256 * 128 * 2;
constexpr size_t WS_SCTX = 254 * MiB;
#define RKSWZ(row, colB) ((row) * 256 + ((colB) ^ (((row) & 7) << 4)))
__device__ __forceinline__ bf16_t* slot(const Params& p, int dir, int q, int head) {
    return q >= 2 ? (bf16_t*)((unsigned char*)p.out + (((size_t)dir * (NQ - 2) + (q - 2)) * 4 + head) * SLOT_BYTES)
                  : (bf16_t*)(p.ws + WS_SCTX + (((size_t)dir * 2 + q) * 4 + head) * SLOT_BYTES);
}
__device__ __forceinline__ float log2_sigmoid(float x) { return -1.4426950408889634f * (fmaxf(-x, 0.f) + log1pf(expf(-fabsf(x)))); }
__device__ __forceinline__ bf16x8 scale8(bf16x8 v, float s) {
    u32x4 w = __builtin_bit_cast(u32x4, v), o;
#pragma unroll
    for (int i = 0; i < 4; ++i) o[i] = attn::cvtpk(__uint_as_float(w[i] << 16) * s, __uint_as_float(w[i] & 0xffff0000u) * s);
    return __builtin_bit_cast(bf16x8, o);
}
__device__ __forceinline__ void pk4(const f32x16& P, int base, bf16x8& out) {
    const unsigned a0 = attn::cvtpk(P[base + 0], P[base + 1]), a1 = attn::cvtpk(P[base + 2], P[base + 3]);
    const unsigned b0 = attn::cvtpk(P[base + 4], P[base + 5]), b1 = attn::cvtpk(P[base + 6], P[base + 7]);
    auto r0 = __builtin_amdgcn_permlane32_swap(a0, b0, false, false); auto r1 = __builtin_amdgcn_permlane32_swap(a1, b1, false, false);
    u32x4 w = {r0[0], r1[0], r0[1], r1[1]}; out = __builtin_bit_cast(bf16x8, w);
}
#define RPK(L, H) (bf16x8){L[0], L[1], L[2], L[3], H[0], H[1], H[2], H[3]}

__device__ __forceinline__ void summaries_unit(const Params& p, int q, int h, char* lds) {
    int tid_ = threadIdx.x; asm volatile("" : "+v"(tid_));
    const int tid = tid_, lane = tid & 63, wave = __builtin_amdgcn_readfirstlane(tid >> 6), r32 = lane & 31, hi = lane >> 5;
    const bf16_t* P = ws_big(p) + (size_t)q * 128 * P0W;
    const float lgf = log2_sigmoid(p.dec_f[h]), lgb = log2_sigmoid(p.dec_b[h]);
    const int sr = tid >> 4, sc = (tid & 15) * 8, st0 = attn::v_st(sr, sc), st1 = attn::v_st(32 + sr, sc);
#pragma unroll
    for (int th = 0; th < 2; ++th) {
        const int t0 = th * 64 + sr, t1 = t0 + 32;
        const bf16_t* r0 = P + (size_t)t0 * P0W; const bf16_t* r1 = P + (size_t)t1 * P0W;
#pragma unroll
        for (int eh = 0; eh < 2; ++eh) { char* vt = lds + (th * 2 + eh) * 16384;
            *(bf16x8*)(vt + st0) = *(const bf16x8*)(r0 + C_VA + h * 256 + eh * 128 + sc); *(bf16x8*)(vt + st1) = *(const bf16x8*)(r1 + C_VA + h * 256 + eh * 128 + sc); }
        const bf16x8 k0 = *(const bf16x8*)(r0 + C_KA + h * 128 + sc), k1 = *(const bf16x8*)(r1 + C_KA + h * 128 + sc);
        char* kf = lds + 65536 + th * 16384; char* kb = lds + 98304 + th * 16384;
        *(bf16x8*)(kf + st0) = scale8(k0, __builtin_amdgcn_exp2f((float)(127 - t0) * lgf)); *(bf16x8*)(kf + st1) = scale8(k1, __builtin_amdgcn_exp2f((float)(127 - t1) * lgf));
        *(bf16x8*)(kb + st0) = scale8(k0, __builtin_amdgcn_exp2f((float)t0 * lgb)); *(bf16x8*)(kb + st1) = scale8(k1, __builtin_amdgcn_exp2f((float)t1 * lgb));
    }
    __syncthreads();
    const int lbase = (int)(uintptr_t)lds + attn::v_rd_base(lane);
    f32x16 acc[2][4];
#pragma unroll
    for (int d = 0; d < 2; ++d)
#pragma unroll
        for (int b = 0; b < 4; ++b) acc[d][b] = f32x16{};
#pragma unroll
    for (int th = 0; th < 2; ++th) {
        const int va = lbase + (th * 2 + (wave >> 2)) * 16384 + (wave & 3) * 512, kfb = lbase + 65536 + th * 16384, kbb = lbase + 98304 + th * 16384;
#define R1_STEP(KS) do { \
        const s16x4 al = attn::tr_read<attn::v_rd_off(0, KS, 0)>(va), ah = attn::tr_read<attn::v_rd_off(0, KS, 1)>(va); \
        const s16x4 f0l = attn::tr_read<attn::v_rd_off(0, KS, 0)>(kfb), f0h = attn::tr_read<attn::v_rd_off(0, KS, 1)>(kfb), f1l = attn::tr_read<attn::v_rd_off(1, KS, 0)>(kfb), f1h = attn::tr_read<attn::v_rd_off(1, KS, 1)>(kfb); \
        const s16x4 f2l = attn::tr_read<attn::v_rd_off(2, KS, 0)>(kfb), f2h = attn::tr_read<attn::v_rd_off(2, KS, 1)>(kfb), f3l = attn::tr_read<attn::v_rd_off(3, KS, 0)>(kfb), f3h = attn::tr_read<attn::v_rd_off(3, KS, 1)>(kfb); \
        const s16x4 g0l = attn::tr_read<attn::v_rd_off(0, KS, 0)>(kbb), g0h = attn::tr_read<attn::v_rd_off(0, KS, 1)>(kbb), g1l = attn::tr_read<attn::v_rd_off(1, KS, 0)>(kbb), g1h = attn::tr_read<attn::v_rd_off(1, KS, 1)>(kbb); \
        const s16x4 g2l = attn::tr_read<attn::v_rd_off(2, KS, 0)>(kbb), g2h = attn::tr_read<attn::v_rd_off(2, KS, 1)>(kbb), g3l = attn::tr_read<attn::v_rd_off(3, KS, 0)>(kbb), g3h = attn::tr_read<attn::v_rd_off(3, KS, 1)>(kbb); \
        asm volatile("s_waitcnt lgkmcnt(0)" ::: "memory"); __builtin_amdgcn_sched_barrier(0); \
        const bf16x8 a = RPK(al, ah); \
        acc[0][0] = __builtin_amdgcn_mfma_f32_32x32x16_bf16(a, RPK(f0l, f0h), acc[0][0], 0, 0, 0); acc[0][1] = __builtin_amdgcn_mfma_f32_32x32x16_bf16(a, RPK(f1l, f1h), acc[0][1], 0, 0, 0); \
        acc[0][2] = __builtin_amdgcn_mfma_f32_32x32x16_bf16(a, RPK(f2l, f2h), acc[0][2], 0, 0, 0); acc[0][3] = __builtin_amdgcn_mfma_f32_32x32x16_bf16(a, RPK(f3l, f3h), acc[0][3], 0, 0, 0); \
        acc[1][0] = __builtin_amdgcn_mfma_f32_32x32x16_bf16(a, RPK(g0l, g0h), acc[1][0], 0, 0, 0); acc[1][1] = __builtin_amdgcn_mfma_f32_32x32x16_bf16(a, RPK(g1l, g1h), acc[1][1], 0, 0, 0); \
        acc[1][2] = __builtin_amdgcn_mfma_f32_32x32x16_bf16(a, RPK(g2l, g2h), acc[1][2], 0, 0, 0); acc[1][3] = __builtin_amdgcn_mfma_f32_32x32x16_bf16(a, RPK(g3l, g3h), acc[1][3], 0, 0, 0); \
        __builtin_amdgcn_sched_barrier(0); } while (0)
        R1_STEP(0); R1_STEP(1); R1_STEP(2); R1_STEP(3);
#undef R1_STEP
    }
#pragma unroll
    for (int d = 0; d < 2; ++d) { bf16_t* dst = slot(p, d, q, h);
#pragma unroll
        for (int db = 0; db < 4; ++db)
#pragma unroll
            for (int r = 0; r < 16; ++r) dst[(size_t)(32 * wave + attn::crow(r, hi)) * 128 + 32 * db + r32] = (bf16_t)(attn::cvtpk(acc[d][db][r], 0.f) & 0xffffu); }
    __syncthreads();
}

__device__ __forceinline__ void state_scan(const Params& p) {
    int tid_ = threadIdx.x; asm volatile("" : "+v"(tid_));
    for (long gt = (long)blockIdx.x * NTHR + tid_; gt < 2L * 4 * 16384; gt += (long)gridDim.x * NTHR) {
    const int pair = (int)(gt & 16383), h = (int)((gt >> 14) & 3), dir = (int)(gt >> 16);
    const float G = __builtin_amdgcn_exp2f(128.0f * log2_sigmoid((dir ? p.dec_b : p.dec_f)[h]));
    float s0 = 0.f, s1 = 0.f;
    for (int n = 0; n < NQ; ++n) {
        const int q = dir == 0 ? n : (n < 2 ? 1 - n : NQ + 1 - n);
        unsigned* ptr = (unsigned*)slot(p, dir, q, h) + pair;
        const unsigned u = *ptr;
        *ptr = attn::cvtpk(s0, s1);
        s0 = G * s0 + __uint_as_float(u << 16); s1 = G * s1 + __uint_as_float(u & 0xffff0000u);
    }    }
}

__device__ __forceinline__ void output_unit(const Params& p, int q, int h, char* lds) {
    int tid_ = threadIdx.x; asm volatile("" : "+v"(tid_));
    const int tid = tid_, lane = tid & 63, wave = __builtin_amdgcn_readfirstlane(tid >> 6), r32 = lane & 31, hi = lane >> 5;
    const int ib = wave >> 1, eh = wave & 1;
    const bf16_t* P = ws_big(p) + (size_t)q * 128 * P0W;
    const float lgf = log2_sigmoid(p.dec_f[h]), lgb = log2_sigmoid(p.dec_b[h]);
    { const int sr = tid >> 4, sc = (tid & 15) * 8, st0 = attn::v_st(sr, sc), st1 = attn::v_st(32 + sr, sc);
#pragma unroll
      for (int jt = 0; jt < 2; ++jt) {
          const bf16_t* r0 = P + (size_t)(jt * 64 + sr) * P0W; const bf16_t* r1 = r0 + (size_t)32 * P0W;
          char* kt = lds + jt * 16384;
          *(bf16x8*)(kt + RKSWZ(sr, sc * 2)) = *(const bf16x8*)(r0 + C_KA + h * 128 + sc); *(bf16x8*)(kt + RKSWZ(32 + sr, sc * 2)) = *(const bf16x8*)(r1 + C_KA + h * 128 + sc);
#pragma unroll
          for (int e2 = 0; e2 < 2; ++e2) { char* vt = lds + 32768 + (jt * 2 + e2) * 16384;
              *(bf16x8*)(vt + st0) = *(const bf16x8*)(r0 + C_VA + h * 256 + e2 * 128 + sc); *(bf16x8*)(vt + st1) = *(const bf16x8*)(r1 + C_VA + h * 256 + e2 * 128 + sc); }
      } }
    bf16x8 qr[8];
    { const bf16_t* Qw = P + (size_t)(ib * 32 + r32) * P0W + C_QA + h * 128 + hi * 8;
#pragma unroll
      for (int d0 = 0; d0 < 8; ++d0) qr[d0] = *(const bf16x8*)(Qw + d0 * 16); }
    const bf16_t* Sf = slot(p, 0, q, h) + (size_t)(eh * 128 + r32) * 128 + hi * 8; const bf16_t* Sb = slot(p, 1, q, h) + (size_t)(eh * 128 + r32) * 128 + hi * 8;
    bf16x8 fa[8], fb[8];
#define RET_LOADB(F, S, sb) do { _Pragma("unroll") for (int s_ = 0; s_ < 2; ++s_) _Pragma("unroll") for (int d0 = 0; d0 < 4; ++d0) F[s_ * 4 + d0] = *(const bf16x8*)((S) + (size_t)d0 * 32 * 128 + ((sb) * 2 + s_) * 16); } while (0)
#define RET_MMAB(F, sc, sb) do { _Pragma("unroll") for (int s_ = 0; s_ < 2; ++s_) { const bf16x8 a = scale8(qr[(sb) * 2 + s_], sc); \
        _Pragma("unroll") for (int d0 = 0; d0 < 4; ++d0) o[d0] = __builtin_amdgcn_mfma_f32_32x32x16_bf16(a, F[s_ * 4 + d0], o[d0], 0, 0, 0); } } while (0)
    RET_LOADB(fa, Sf, 0);
    __syncthreads();
    f32x16 o[4] = {};
    const int i_loc = ib * 32 + r32;
    const int vb0 = (int)(uintptr_t)lds + 32768 + attn::v_rd_base(lane);
#pragma unroll
    for (int jt = 0; jt < 2; ++jt) {
        f32x16 p0, p1;
        attn::qkt(p0, p1, (const attn::bf16*)(lds + jt * 16384), qr, r32, hi);
#pragma unroll
        for (int r = 0; r < 16; ++r) {
            const int j0 = jt * 64 + attn::crow(r, hi), dl0 = i_loc - j0, dl1 = dl0 - 32;
            const float m0 = dl0 > 0 ? __builtin_amdgcn_exp2f((float)dl0 * lgf) : (dl0 < 0 ? __builtin_amdgcn_exp2f((float)(-dl0) * lgb) : 2.0f);
            const float m1 = dl1 > 0 ? __builtin_amdgcn_exp2f((float)dl1 * lgf) : (dl1 < 0 ? __builtin_amdgcn_exp2f((float)(-dl1) * lgb) : 2.0f);
            p0[r] *= m0; p1[r] *= m1;
        }
        bf16x8 pa0, pa1, pa2, pa3; pk4(p0, 0, pa0); pk4(p0, 8, pa1); pk4(p1, 0, pa2); pk4(p1, 8, pa3);
        __builtin_amdgcn_sched_barrier(0);
        attn::pv_d0(o, vb0 + (jt * 2 + eh) * 16384, pa0, pa1, pa2, pa3);
    }
    { const float scf = __builtin_amdgcn_exp2f((float)(i_loc + 1) * lgf), scb = __builtin_amdgcn_exp2f((float)(128 - i_loc) * lgb);
      RET_LOADB(fb, Sf, 1); __builtin_amdgcn_sched_barrier(0);
      RET_MMAB(fa, scf, 0); __builtin_amdgcn_sched_barrier(0); RET_LOADB(fa, Sf, 2); __builtin_amdgcn_sched_barrier(0);
      RET_MMAB(fb, scf, 1); __builtin_amdgcn_sched_barrier(0); RET_LOADB(fb, Sf, 3); __builtin_amdgcn_sched_barrier(0);
      RET_MMAB(fa, scf, 2); __builtin_amdgcn_sched_barrier(0); RET_LOADB(fa, Sb, 0); __builtin_amdgcn_sched_barrier(0);
      RET_MMAB(fb, scf, 3); __builtin_amdgcn_sched_barrier(0); RET_LOADB(fb, Sb, 1); __builtin_amdgcn_sched_barrier(0);
      RET_MMAB(fa, scb, 0); __builtin_amdgcn_sched_barrier(0); RET_LOADB(fa, Sb, 2); __builtin_amdgcn_sched_barrier(0);
      RET_MMAB(fb, scb, 1); __builtin_amdgcn_sched_barrier(0); RET_LOADB(fb, Sb, 3); __builtin_amdgcn_sched_barrier(0);
      RET_MMAB(fa, scb, 2); __builtin_amdgcn_sched_barrier(0);
      RET_MMAB(fb, scb, 3); }
#undef RET_LOADB
#undef RET_MMAB
    __syncthreads();
    float* O = (float*)lds;
#pragma unroll
    for (int r = 0; r < 16; ++r)
#pragma unroll
        for (int d0 = 0; d0 < 4; ++d0) O[(ib * 32 + attn::crow(r, hi)) * 256 + eh * 128 + d0 * 32 + r32] = o[d0][r];
    __syncthreads();
    bf16_t* BR = ws_br(p) + (size_t)q * 128 * 2048 + h * 256;
#pragma unroll 4
    for (int rr = 0; rr < 16; ++rr) {
        const int row = wave * 16 + rr; const f32x4 x = *(const f32x4*)(O + row * 256 + lane * 4);
        const float mean = rw::wave_sum((x[0] + x[1]) + (x[2] + x[3])) * (1.0f / 256.f);
        const f32x4 d = x - mean;
        const float var = rw::wave_sum((d[0] * d[0] + d[1] * d[1]) + (d[2] * d[2] + d[3] * d[3])) * (1.0f / 256.f);
        const float rstd = 1.0f / sqrtf(var + NORM_EPS);
        f32x4 y = d * rstd;
        if (q < 2) { const u32x2 gg = *(const u32x2*)((const bf16_t*)(p.ws + 255 * MiB) + (size_t)(q * 128 + row) * 2048 + h * 256 + lane * 4);
            y[0] *= __uint_as_float(gg.x << 16); y[1] *= __uint_as_float(gg.x & 0xffff0000u); y[2] *= __uint_as_float(gg.y << 16); y[3] *= __uint_as_float(gg.y & 0xffff0000u); }
        u32x2 w; w.x = attn::cvtpk(y[0], y[1]); w.y = attn::cvtpk(y[2], y[3]);
        *(u32x2*)(BR + (size_t)row * 2048 + lane * 4) = w;
    }
    __syncthreads();
}
#undef RPK
#undef RKSWZ
}

namespace na {
using attn::bf16x8; using attn::f32x16; using attn::u32x4;
constexpr float L2E = 1.4426950408889634f;
constexpr int WH = GROWS < 8 ? GROWS : 8;
constexpr int L_K = 0, L_V = 32768, L_WS = 65536, L_RPB = L_WS + NWAVES * 64 * 4, L_END = L_RPB + 15 * 31 * 4;
#define NKSWZ(row, colB) ((row) * 256 + ((colB) ^ (((row) & 7) << 4)))
__device__ __forceinline__ int win_r0(int r) { int r0 = r - WH / 2; return r0 < 0 ? 0 : (r0 > GROWS - WH ? GROWS - WH : r0); }
__device__ __forceinline__ int win_c0(int c) { int c0 = c - 8; return c0 < 0 ? 0 : (c0 > GW - 16 ? GW - 16 : c0); }

__device__ __forceinline__ void na_unit(const Params& p, int rg, int h, char* lds) {
    int tid_ = threadIdx.x; asm volatile("" : "+v"(tid_));
    const int tid = tid_, lane = tid & 63, wave = __builtin_amdgcn_readfirstlane(tid >> 6), r32 = lane & 31, hi = lane >> 5;
    const bf16_t* P = ws_big(p); const bf16_t* NAC = (const bf16_t*)(p.ws + 255 * MiB);
    const int r = 4 * rg + (wave >> 1), qc = (wave & 1) * 32 + r32, my_r0 = win_r0(r), my_c0 = win_c0(qc);
    const int lo = win_r0(4 * rg), hiw = win_r0(4 * rg + 3) + WH, NT = hiw - lo + CTXN / 64;
    float* wsf = (float*)(lds + L_WS) + wave * 64; float* rpb_l = (float*)(lds + L_RPB);
    if (tid < 15 * 31) rpb_l[tid] = p.rpb[h * 15 * 31 + tid];
    bf16x8 qr[4];
    { const bf16_t* Qw = P + (size_t)(CTXN + r * 64 + qc) * NAW + h * 64 + hi * 8;
#pragma unroll
      for (int d0 = 0; d0 < 4; ++d0) { u32x4 w = *(const u32x4*)(Qw + d0 * 16);
        for (int i = 0; i < 4; ++i) w[i] = attn::cvtpk(__uint_as_float(w[i] << 16) * 0.125f, __uint_as_float(w[i] & 0xffff0000u) * 0.125f);
        qr[d0] = *reinterpret_cast<bf16x8*>(&w); } }
    const int sk = tid >> 3, sc = (tid & 7) * 8, kst = NKSWZ(sk, sc * 2), vst = attn::v_st(sk, sc);
    bf16x8 kA, vA, kB, vB;
#define NA_LOAD(KR, VR, t) do { if ((t) < hiw - lo) { const int krow_ = CTXN + (lo + (t)) * 64 + sk; \
            KR = *(const bf16x8*)(P + (size_t)krow_ * NAW + 1024 + h * 64 + sc); VR = *(const bf16x8*)(P + (size_t)krow_ * NAW + 2048 + h * 64 + sc); } \
        else { const bf16_t* c_ = NAC + (size_t)(((t) - (hiw - lo)) * 64 + sk) * 2048 + h * 64 + sc; KR = *(const bf16x8*)c_; VR = *(const bf16x8*)(c_ + 1024); } } while (0)
#define NA_WRITE(KR, VR, b) do { *(bf16x8*)(lds + L_K + (b) * 16384 + kst) = KR; *(bf16x8*)(lds + L_V + (b) * 16384 + vst) = VR; } while (0)
    NA_LOAD(kA, vA, 0); NA_WRITE(kA, vA, 0);
    NA_LOAD(kB, vB, 1);
    __syncthreads();
    float m_reg = -1e30f, l_reg = 0.f; f32x16 o[2] = {};
    const int dl = 4 * hi - my_c0;
    const int vb0 = (int)(uintptr_t)lds + L_V + attn::v_rd_base(lane);
#define NA_TILE(t, KW, VW, KL, VL) do { \
        if ((t) + 2 < NT) NA_LOAD(KL, VL, (t) + 2);            \
        const bool is_ctx = (t) >= hiw - lo; const int kr = lo + (t); \
        if (is_ctx || (kr >= my_r0 && kr < my_r0 + WH)) { \
            const char* Ks = lds + L_K + ((t) & 1) * 16384; \
            f32x16 p0 = {}, p1 = {}; \
            _Pragma("unroll") for (int d0 = 0; d0 < 4; ++d0) { const int cb = (d0 * 16 + hi * 8) * 2; \
                const bf16x8 b0 = *(const bf16x8*)(Ks + NKSWZ(r32, cb)), b1 = *(const bf16x8*)(Ks + NKSWZ(32 + r32, cb)); \
                p0 = __builtin_amdgcn_mfma_f32_32x32x16_bf16(b0, qr[d0], p0, 0, 0, 0); p1 = __builtin_amdgcn_mfma_f32_32x32x16_bf16(b1, qr[d0], p1, 0, 0, 0); } \
            if (!is_ctx) {     \
                const float* bb = rpb_l + (kr - r + 7) * 31 + 15 - qc + 4 * hi; float bz0[16], bz1[16]; \
                _Pragma("unroll") for (int q = 0; q < 16; ++q) { const int cq = (q & 3) + 8 * (q >> 2); bz0[q] = bb[cq]; bz1[q] = bb[cq + 32]; } \
                _Pragma("unroll") for (int q = 0; q < 16; ++q) { const int cq = (q & 3) + 8 * (q >> 2); \
                    p0[q] = (unsigned)(cq + dl) < 16u ? p0[q] + bz0[q] : -1e30f; p1[q] = (unsigned)(cq + 32 + dl) < 16u ? p1[q] + bz1[q] : -1e30f; } \
            } \
            float pmax = p0[0]; \
            _Pragma("unroll") for (int q = 1; q < 16; ++q) pmax = fmaxf(pmax, p0[q]); \
            _Pragma("unroll") for (int q = 0; q < 16; ++q) pmax = fmaxf(pmax, p1[q]); \
            { auto rr = __builtin_amdgcn_permlane32_swap(__float_as_uint(pmax), __float_as_uint(pmax), false, false); pmax = fmaxf(__uint_as_float(rr[0]), __uint_as_float(rr[1])); } \
            const float mn = fmaxf(m_reg, pmax), alpha = __builtin_amdgcn_exp2f((m_reg - mn) * L2E), mnl = -mn * L2E; m_reg = mn; \
            float ps = 0.f; \
            _Pragma("unroll") for (int q = 0; q < 16; ++q) { p0[q] = __builtin_amdgcn_exp2f(fmaf(p0[q], L2E, mnl)); p1[q] = __builtin_amdgcn_exp2f(fmaf(p1[q], L2E, mnl)); ps += p0[q] + p1[q]; } \
            { auto rr = __builtin_amdgcn_permlane32_swap(__float_as_uint(ps), __float_as_uint(ps), false, false); ps = __uint_as_float(rr[0]) + __uint_as_float(rr[1]); } \
            l_reg = l_reg * alpha + ps; \
            if (__any(alpha < 1.f)) { if (hi == 0) wsf[r32] = alpha; asm volatile("s_waitcnt lgkmcnt(0)" ::: "memory"); \
                _Pragma("unroll") for (int d = 0; d < 2; ++d) _Pragma("unroll") for (int q = 0; q < 16; ++q) o[d][q] *= wsf[attn::crow(q, hi)]; } \
            bf16x8 pa0, pa1, pa2, pa3; ret::pk4(p0, 0, pa0); ret::pk4(p0, 8, pa1); ret::pk4(p1, 0, pa2); ret::pk4(p1, 8, pa3); \
            __builtin_amdgcn_sched_barrier(0); \
            const int vb = vb0 + ((t) & 1) * 16384; \
            attn::pv_one<0>(o[0], vb, pa0, pa1, pa2, pa3); attn::pv_one<1>(o[1], vb, pa0, pa1, pa2, pa3); \
        } \
        if ((t) + 1 < NT) NA_WRITE(KW, VW, ((t) + 1) & 1);     \
        __syncthreads(); } while (0)
    for (int t = 0; t < NT; t += 2) {
        NA_TILE(t, kB, vB, kA, vA);
        if (t + 1 < NT) NA_TILE(t + 1, kA, vA, kB, vB);
    }
#undef NA_TILE
#undef NA_LOAD
#undef NA_WRITE
    if (hi == 0) wsf[32 + r32] = l_reg; asm volatile("s_waitcnt lgkmcnt(0)" ::: "memory");
    bf16_t* Ow = ws_br(p) + (size_t)(CTXN + r * 64 + (wave & 1) * 32) * 2048 + h * 64;
#pragma unroll
    for (int q = 0; q < 16; ++q) { const int orow = attn::crow(q, hi); const float rl = __builtin_amdgcn_rcpf(wsf[32 + orow]);
#pragma unroll
        for (int d0 = 0; d0 < 2; ++d0) Ow[(size_t)orow * 2048 + d0 * 32 + r32] = (bf16_t)(attn::cvtpk(o[d0][q] * rl, 0.f) & 0xffffu); }
    __syncthreads();
}
#undef NKSWZ
}

namespace el {
typedef float f32x4 __attribute__((ext_vector_type(4)));
typedef unsigned u32x2 __attribute__((ext_vector_type(2)));
__device__ __forceinline__ float wsum(float v) { return rw::wave_sum(v); }
__device__ __forceinline__ unsigned pk(float lo, float hi) { unsigned r; asm volatile("v_cvt_pk_bf16_f32 %0, %1, %2" : "=v"(r) : "v"(lo), "v"(hi)); return r; }

__device__ __forceinline__ void mod_phase(const Params& p, char* lds) {
    int tid_ = threadIdx.x; asm volatile("" : "+v"(tid_));
    const int tid = tid_, ks = tid >> 6, jl = tid & 63;
    float* sc = (float*)lds; float* red = sc + 2048;
    for (int b = blockIdx.x; b < 2 * 48; b += gridDim.x) {
        const int l = b / 48, j = (b % 48) * 64 + jl;
        __syncthreads();
        for (int k = tid; k < 2048; k += NTHR) { const float x = k < 1024 ? p.c[k] : p.c_ctx[k - 1024]; sc[k] = x / (1.0f + __expf(-x)); }
        __syncthreads();
        const float* w = p.w_mod + (size_t)l * DM * 3072 + (size_t)(ks * 128) * 3072 + j; float a0 = 0.f, a1 = 0.f;
#pragma unroll 8
        for (int k = 0; k < 128; ++k) { const float wv = w[(size_t)k * 3072]; a0 += sc[ks * 128 + k] * wv; a1 += sc[1024 + ks * 128 + k] * wv; }
        red[ks * 64 + jl] = a0; red[512 + ks * 64 + jl] = a1;
        __syncthreads();
        if (tid < 128) { const int s = tid >> 6; float t = 0.f;
#pragma unroll
            for (int q = 0; q < 8; ++q) t += red[s * 512 + q * 64 + jl];
            ws_modv(p)[(l * 2 + s) * 3072 + j] = t + p.b_mod[l * 3072 + j]; }
    }
    __syncthreads();
}

template <int LAYER> __device__ __forceinline__ void modnorm_store(const Params& p, const f32x4 (&v)[4], int row, int lane) {
    const float* mv = ws_modv(p) + (LAYER * 2 + (row < CTXN ? 1 : 0)) * 3072; const float* g = p.g_pre + LAYER * DM;
    float ss = 0.f;
#pragma unroll
    for (int j = 0; j < 4; ++j) ss += (v[j][0] * v[j][0] + v[j][1] * v[j][1]) + (v[j][2] * v[j][2] + v[j][3] * v[j][3]);
    const float rstd = 1.0f / sqrtf(wsum(ss) * (1.0f / DM) + NORM_EPS);
    bf16_t* o = ws_xn(p) + (size_t)row * DM;
#pragma unroll
    for (int j = 0; j < 4; ++j) { const int c = lane * 4 + 256 * j;
        const f32x4 gg = *(const f32x4*)(g + c), sh = *(const f32x4*)(mv + c), sc = *(const f32x4*)(mv + 1024 + c);
        const f32x4 y = v[j] * rstd * gg * (sc + 1.0f) + sh;
        u32x2 w; w.x = pk(y[0], y[1]); w.y = pk(y[2], y[3]); *(u32x2*)(o + c) = w; }
}
__device__ __forceinline__ void prenorm0_phase(const Params& p) {
    int tid_ = threadIdx.x; asm volatile("" : "+v"(tid_));
    const int lane = tid_ & 63, gw = (int)blockIdx.x * NWAVES + (tid_ >> 6), ngw = (int)gridDim.x * NWAVES;
    for (int row = gw; row < R; row += ngw) {
        const float* src = row < CTXN ? p.ctx + (size_t)row * DM : p.x + (size_t)(row - CTXN) * DM;
        f32x4 v[4];
#pragma unroll
        for (int j = 0; j < 4; ++j) v[j] = *(const f32x4*)(src + lane * 4 + 256 * j);
        modnorm_store<0>(p, v, row, lane);
    }
}
template <int LAYER> __device__ __forceinline__ void resid_phase(const Params& p) {
    int tid_ = threadIdx.x; asm volatile("" : "+v"(tid_));
    const int lane = tid_ & 63, gw = (int)blockIdx.x * NWAVES + (tid_ >> 6), ngw = (int)gridDim.x * NWAVES;
    for (int row = (LAYER == 0 ? 0 : CTXN) + gw; row < R; row += ngw) {
        const bool ctxsum = LAYER == 0 && row < CTXN;
        const float* y = ctxsum ? (const float*)(p.ws + WS_BIG + 72 * MiB) + (size_t)row * DM : ws_y(p) + (size_t)row * DM; const float* mv = ws_modv(p) + (LAYER * 2 + (row < CTXN ? 1 : 0)) * 3072 + 2048; const float* g = p.g_post + LAYER * DM;
        const float* src; float* dst;
        if (row < CTXN) { src = p.ctx + (size_t)row * DM; dst = ws_ctx1(p) + (size_t)row * DM; }
        else { src = (LAYER == 0 ? p.x : p.out) + (size_t)(row - CTXN) * DM; dst = p.out + (size_t)(row - CTXN) * DM; }
        f32x4 yv[4]; float ss = 0.f;
#pragma unroll
        for (int j = 0; j < 4; ++j) { yv[j] = *(const f32x4*)(y + lane * 4 + 256 * j);
            if (ctxsum) { _Pragma("unroll") for (int s = 1; s < 8; ++s) yv[j] += *(const f32x4*)(y + (size_t)s * CTXN * DM + lane * 4 + 256 * j); }
            ss += (yv[j][0] * yv[j][0] + yv[j][1] * yv[j][1]) + (yv[j][2] * yv[j][2] + yv[j][3] * yv[j][3]); }
        const float rstd = 1.0f / sqrtf(wsum(ss) * (1.0f / DM) + NORM_EPS);
        f32x4 xn[4];
#pragma unroll
        for (int j = 0; j < 4; ++j) { const int c = lane * 4 + 256 * j;
            xn[j] = *(const f32x4*)(src + c) + *(const f32x4*)(mv + c) * (yv[j] * rstd * *(const f32x4*)(g + c));
            *(f32x4*)(dst + c) = xn[j]; }
        if (LAYER == 0) modnorm_store<1>(p, xn, row, lane);
    }
}
__device__ __forceinline__ void ropenorm_phase(const Params& p) {
    int tid_ = threadIdx.x; asm volatile("" : "+v"(tid_));
    const int lane = tid_ & 63, gw = (int)blockIdx.x * NWAVES + (tid_ >> 6), ngw = (int)gridDim.x * NWAVES;
    const float* ct = ws_rope(p); const float* st = ct + N_ROPE;
    const float qn0 = p.q_norm[2 * lane], qn1 = p.q_norm[2 * lane + 1], kn0 = p.k_norm[2 * lane], kn1 = p.k_norm[2 * lane + 1];
    for (int row = gw; row < R; row += ngw) {
        const bool rot = row >= CTXN; const int t = row - CTXN; float cs = 1.f, sn = 0.f;
        if (rot) { const int pos = lane < 32 ? t / GW : t % GW, f = lane & 31; cs = ct[pos * 32 + f]; sn = st[pos * 32 + f]; }
        bf16_t* base = ws_big(p) + (size_t)row * P0W;
#pragma unroll
        for (int slot = 0; slot < 18; ++slot) {
            const int col = slot < 4 ? C_QA + slot * 128 : slot < 8 ? C_KA + (slot - 4) * 128 : slot < 16 ? C_QB + (slot - 8) * 128 : C_KB + (slot - 16) * 128;
            unsigned* ptr = (unsigned*)(base + col) + lane; const unsigned u = *ptr;
            float x1 = __uint_as_float(u << 16), x2 = __uint_as_float(u & 0xffff0000u);
            if (slot >= 4 && slot < 8) { x1 *= 0.08838834764831845f; x2 *= 0.08838834764831845f; }
            if (slot >= 8) { const float sc = 1.0f / sqrtf(wsum(x1 * x1 + x2 * x2) * (1.0f / 128.f) + NORM_EPS);
                x1 *= sc * (slot < 16 ? qn0 : kn0); x2 *= sc * (slot < 16 ? qn1 : kn1); }
            *ptr = pk(x1 * cs - x2 * sn, x1 * sn + x2 * cs);
        }
    }
}
}

constexpr int RING_BYTES = 131072, LDS_BYTES = 163840;
constexpr size_t WS_BAR = 256 * 1024;
constexpr size_t WS_SIDE = 255 * MiB;
constexpr size_t WS_YC = WS_BIG + 72 * MiB;
constexpr int LDS_BARW = LDS_BYTES - 64;
constexpr size_t WB_IN0 = WS_WB, WB_OUT0 = WB_IN0 + (size_t)EVEN_IN * DM * 2, WB_IN1 = WB_OUT0 + (size_t)DM * 2048 * 2, WB_OUT1 = WB_IN1 + (size_t)ODD_IN * DM * 2, WB_END = WB_OUT1 + (size_t)DM * 2048 * 2;
static_assert(WB_END <= WS_XN, "weight copies overflow their region");
static_assert(wy::WS_RING + wy::RING_TOTAL <= WB_IN1 && XCD_BAR_WORDS * 4 <= 16384 && wy::WS_WYF + (size_t)wy::WYF_WORDS * 4 <= WS_CTX1, "rwkv ring / flag words");

__device__ __forceinline__ unsigned pk2(float lo, float hi) { return (unsigned)f2bf(lo) | ((unsigned)f2bf(hi) << 16); }
__device__ __forceinline__ void transpose_item(const float* W, int K, int N, int ldw, bf16_t* WT, LAS float* scr, int item, int lane) {
    const int nblk = N / 32, kb = item / nblk, nb = item % nblk, k0 = 64 * kb, n0 = 32 * nb;
#pragma unroll 8
    for (int i = 0; i < 32; ++i) { const int kk = 2 * i + (lane >> 5); scr[kk * 33 + (lane & 31)] = W[(size_t)(k0 + kk) * ldw + n0 + (lane & 31)]; }
    asm volatile("s_waitcnt lgkmcnt(0)" ::: "memory");
    const int c = lane & 7;
#pragma unroll
    for (int j = 0; j < 4; ++j) { const int n = (lane >> 3) + 8 * j; const LAS float* s = scr + (8 * c) * 33 + n;
        v4u o; o.x = pk2(s[0 * 33], s[1 * 33]); o.y = pk2(s[2 * 33], s[3 * 33]); o.z = pk2(s[4 * 33], s[5 * 33]); o.w = pk2(s[6 * 33], s[7 * 33]);
        *(v4u*)(WT + (size_t)(n0 + n) * K + k0 + 8 * c) = o; }
    asm volatile("s_waitcnt lgkmcnt(0)" ::: "memory");
}
__device__ __forceinline__ void p0_weights(const Params& p, LAS unsigned char* lds) {
    const int lane = threadIdx.x & 63, wave = __builtin_amdgcn_readfirstlane(threadIdx.x >> 6);
    LAS float* scr = (LAS float*)(lds + wave * 16384);
    const int gw = blockIdx.x * NWAVES + wave, NGW = gridDim.x * NWAVES;
    constexpr int I_IN0 = (DM / 64) * (EVEN_IN / 32), I_OUT = (2048 / 64) * (DM / 32), I_IN1 = (DM / 64) * (ODD_IN / 32);
    for (int it = gw; it < I_IN0 + I_OUT + I_IN1 + I_OUT; it += NGW) {
        int r = it;
        if (r < I_IN0) { transpose_item(p.ev_w_in, DM, EVEN_IN, EVEN_IN, (bf16_t*)(p.ws + WB_IN0), scr, r, lane); continue; } r -= I_IN0;
        if (r < I_OUT) { transpose_item(p.ev_w_out, 2048, DM, DM, (bf16_t*)(p.ws + WB_OUT0), scr, r, lane); continue; } r -= I_OUT;
        if (r < I_IN1) { transpose_item(p.od_w_in, DM, ODD_IN, ODD_IN, (bf16_t*)(p.ws + WB_IN1), scr, r, lane); continue; } r -= I_IN1;
        transpose_item(p.od_w_out, 2048, DM, DM, (bf16_t*)(p.ws + WB_OUT1), scr, r, lane);
    }
}

template <class Epi> __device__ __forceinline__ void run_gemm(LAS unsigned char* lds, const bf16_t* A, const bf16_t* Bt, int M, int N, int K, const Epi& E, int rot = 0, int lda = 0, int ldb = 0) {
    const int G = (int)gridDim.x;
    pg8::Gemm g{A, Bt, M, N, K, lda, ldb}; pg8::StaticOrder S; S.init(M, N, G, ((int)blockIdx.x + rot) % G);
    pg8::gemm_phase<Epi, pg8::StaticOrder, true, true>(lds, g, S, E);
}
__device__ __forceinline__ int tail_rot(int units) { const int G = (int)gridDim.x; return (G - units % G) % G; }

#ifndef PROBE
#define PROBE 0
#endif
#define REP(bit) for (int rep_ = 0; rep_ < (((PROBE) >> (bit)) & 1) + 1; ++rep_)
__global__ void __launch_bounds__(NTHR, 2) mega(Params p) {
    extern __shared__ __attribute__((aligned(16))) unsigned char lds_raw[];
    cg::grid_group grid = cg::this_grid();
    LAS unsigned char* lds = (LAS unsigned char*)lds_raw;
    const long gsz = (long)gridDim.x * NTHR;
    if (threadIdx.x < 2) *(LAS unsigned*)(lds + LDS_BARW + 4 * threadIdx.x) = 0u;
    __syncthreads();
    const XcdBarrier xbar = xcd_barrier_post((unsigned*)(p.ws + WS_BAR), (volatile LAS unsigned*)(lds + LDS_BARW));
    const bf16_t* wt_in0 = (const bf16_t*)(p.ws + WB_IN0); const bf16_t* wt_out0 = (const bf16_t*)(p.ws + WB_OUT0);
    const bf16_t* wt_in1 = (const bf16_t*)(p.ws + WB_IN1); const bf16_t* wt_out1 = (const bf16_t*)(p.ws + WB_OUT1);
#define X(fn, n) { int t_ = threadIdx.x; asm volatile("" : "+v"(t_)); for (long g = (long)blockIdx.x * NTHR + t_; g < (long)(n); g += gsz) fn(p, g); }
#define SYNC xcd_barrier(xbar);
    if ((PROBE >> 13) & 1) { for (int i_ = 0; i_ < 20; ++i_) xcd_barrier(xbar); }
    REP(14) { el::mod_phase(p, (char*)lds_raw); X(ph_rope_table, N_ROPE) p0_weights(p, lds);
              if (p.out == nullptr) grid.sync();
              SYNC }
    REP(15) { el::prenorm0_phase(p); SYNC }
    REP(2) { run_gemm(lds, ws_xn(p), wt_in0, R, P0W, DM, pg8::EpiBf16<0>{ws_big(p), P0W, nullptr, 0, 0, 1.f});
             run_gemm(lds, ws_xn(p), wt_in0 + (size_t)C_GA * DM, CTXN, 2048, DM, pg8::EpiSiluBf16{(bf16_t*)(p.ws + WS_SIDE), 2048}, tail_rot((R / 256) * (P0W / 256)));
             SYNC }
    el::ropenorm_phase(p); SYNC
    REP(5) { for (int u = blockIdx.x; u < ret::NQ * 4; u += gridDim.x) { const int q = u < (ret::NQ - 2) * 4 ? 2 + u / 4 : (u - (ret::NQ - 2) * 4) / 4; ret::summaries_unit(p, q, u & 3, (char*)lds_raw); } SYNC }
    ret::state_scan(p); SYNC
#define CTX_ATTN_UNIT(head_) do { const int hd_ = (head_), kv_ = hd_ / 4; const bf16_t* P_ = ws_big(p); bf16_t* BR_ = ws_br(p); \
        attn::attn_dense_body<attn::bf16, false>(P_ + C_QB + hd_ * 128, P_ + C_KB + kv_ * 128, P_ + C_VB + kv_ * 128, BR_ + 1024 + hd_ * 128, CTXN, (char*)lds_raw); \
        __syncthreads(); \
        {     \
            int t_ = threadIdx.x; asm volatile("" : "+v"(t_)); const bf16_t* GC = (const bf16_t*)(p.ws + WS_SIDE); \
            const size_t o = (size_t)(t_ >> 1) * 2048 + 1024 + hd_ * 128 + (t_ & 1) * 64; \
            _Pragma("unroll") for (int i_ = 0; i_ < 8; ++i_) { v4u a = *(const v4u*)(BR_ + o + 8 * i_); const v4u b = *(const v4u*)(GC + o + 8 * i_); \
                _Pragma("unroll") for (int q_ = 0; q_ < 4; ++q_) a[q_] = attn::cvtpk(__uint_as_float(a[q_] << 16) * __uint_as_float(b[q_] << 16), __uint_as_float(a[q_] & 0xffff0000u) * __uint_as_float(b[q_] & 0xffff0000u)); \
                *(v4u*)(BR_ + o + 8 * i_) = a; } \
            __syncthreads(); } } while (0)
    const bool ctx_attn_early = gridDim.x >= 16;
    REP(6) { for (int u = blockIdx.x; u < ret::NQ * 4; u += gridDim.x) { const int q = u < (ret::NQ - 2) * 4 ? 2 + u / 4 : (u - (ret::NQ - 2) * 4) / 4; ret::output_unit(p, q, u & 3, (char*)lds_raw); }
             if (ctx_attn_early && (int)blockIdx.x >= (int)gridDim.x - 8) CTX_ATTN_UNIT((int)blockIdx.x - ((int)gridDim.x - 8));
             SYNC }
    REP(0) {
        const int G = (int)gridDim.x, vcu = (G % 8 == 0) ? ((int)blockIdx.x % 8) * (G / 8) + (int)blockIdx.x / 8 : (int)blockIdx.x;
        const int NLAT = (SEQ / 256) * 8, per = (NLAT + G - 1) / G;
        const bf16_t* P = ws_big(p); bf16_t* BR = ws_br(p);
        bool nomax; { int t_ = threadIdx.x; asm volatile("" : "+v"(t_)); const int l_ = t_ & 63; float gq = fmaxf(fabsf(p.q_norm[l_]), fabsf(p.q_norm[64 + l_])), gk = fmaxf(fabsf(p.k_norm[l_]), fabsf(p.k_norm[64 + l_]));
          for (int m_ = 32; m_ >= 1; m_ >>= 1) { gq = fmaxf(gq, __shfl_xor(gq, m_)); gk = fmaxf(gk, __shfl_xor(gk, m_)); }
          nomax = 11.3137085f * 1.4426950409f * 1.02f * gq * gk <= 40.0f; }
        for (int i = 0; i <= per; ++i) {
            int head, row0, seq;
            if (i < per) { const int unit = vcu * per + i; if (unit >= NLAT) continue; const int nqb = SEQ / 256, kv = unit / (4 * nqb), rem = unit % (4 * nqb); head = kv * 4 + rem / nqb; row0 = CTXN + (rem % nqb) * 256; seq = R; }
            else { if (ctx_attn_early || vcu >= 8) break; CTX_ATTN_UNIT(vcu); break; }
            const int kv = head / 4;
            if (nomax) attn::attn_dense_body<attn::bf16, true>(P + (size_t)row0 * P0W + C_QB + head * 128, P + C_KB + kv * 128, P + C_VB + kv * 128, BR + (size_t)row0 * 2048 + 1024 + head * 128, seq, (char*)lds_raw);
            else attn::attn_dense_body<attn::bf16, false>(P + (size_t)row0 * P0W + C_QB + head * 128, P + C_KB + kv * 128, P + C_VB + kv * 128, BR + (size_t)row0 * 2048 + 1024 + head * 128, seq, (char*)lds_raw);
            __syncthreads();
        }
        if (PROBE & 1) xcd_barrier(xbar);
    }
    SYNC
    run_gemm(lds, ws_xn(p) + (size_t)CTXN * DM, wt_in0 + (size_t)C_GA * DM, SEQ, 2048, DM, pg8::EpiGateMul{ws_br(p) + (size_t)CTXN * 2048, 2048});
    {
        pg8::Gemm gk{ws_br(p), wt_out0, 8 * 256, DM, 256, 2048, 2048, 256 * 2}; pg8::StaticOrder S; S.init(8 * 256, DM, (int)gridDim.x, (int)blockIdx.x);
        pg8::gemm_phase<pg8::EpiF32, pg8::StaticOrder, true, true>(lds, gk, S, pg8::EpiF32{(float*)(p.ws + WS_YC), DM}); }
    SYNC
    REP(4) { run_gemm(lds, ws_br(p) + (size_t)CTXN * 2048, wt_out0, SEQ, DM, 2048, pg8::EpiF32{ws_y(p) + (size_t)CTXN * DM, DM}); SYNC }
    REP(15) { el::resid_phase<0>(p); SYNC }
    REP(3) { run_gemm(lds, ws_xn(p), wt_in1 + (size_t)O_RW * DM, R, ZW, DM, pg8::EpiBf16Halo{ws_big(p), ZW, (bf16_t*)(p.ws + rw::WS_HALO)});
             run_gemm(lds, ws_xn(p), wt_in1 + (size_t)(O_NA + 1024) * DM, CTXN, 2048, DM, pg8::EpiBf16<0>{(bf16_t*)(p.ws + WS_SIDE), 2048, nullptr, 0, 0, 1.f}, tail_rot((R / 256) * (ZW / 256)));
             SYNC }
    rw::shift_inplace(p); wy::zero_words(p); SYNC
#ifndef PSKIP
#define PSKIP 0
#endif
    if ((PROBE >> 16) & 1) { wy::phase<1, PSKIP>(p, lds); SYNC wy::zero_words(p); SYNC }
    if ((PROBE >> 17) & 1) { wy::phase<2>(p, lds); SYNC wy::zero_words(p); SYNC }
    if ((PROBE >> 19) & 1) { wy::phase<4, 16>(p, lds); SYNC wy::zero_words(p); SYNC }
    if ((PROBE >> 18) & 1) { wy::phase<3>(p, lds); SYNC wy::zero_words(p); SYNC }
    if (gridDim.x >= 64) wy::phase<0>(p, lds);
    else { for (int b = blockIdx.x; b < 256; b += gridDim.x) rw::scan_block<0>(p, b, lds); }
    SYNC
    rw::finish_phase(p); SYNC
    REP(3) { run_gemm(lds, ws_xn(p) + (size_t)CTXN * DM, wt_in1 + (size_t)O_NA * DM, SEQ, NAW, DM, pg8::EpiBf16<0>{ws_big(p) + (size_t)CTXN * NAW, NAW, nullptr, 0, 0, 1.f}); SYNC }
    REP(7) { for (int u = blockIdx.x; u < (GROWS / 4) * 16; u += gridDim.x) na::na_unit(p, u >> 4, u & 15, (char*)lds_raw); SYNC }
    run_gemm(lds, ws_xn(p) + (size_t)CTXN * DM, wt_in1 + (size_t)O_GC * DM, SEQ, 2048, DM, pg8::EpiGateMul{ws_br(p) + (size_t)CTXN * 2048, 2048}); SYNC
    REP(4) { run_gemm(lds, ws_br(p) + (size_t)CTXN * 2048, wt_out1, SEQ, DM, 2048, pg8::EpiF32{ws_y(p) + (size_t)CTXN * DM, DM}); SYNC }
    el::resid_phase<1>(p);
#undef X
#undef SYNC
}

extern "C" void kernel_launch(void* const* d_in, const int* in_sizes, int n_in, void* d_out, int out_size, void* d_ws, size_t ws_size, hipStream_t stream) {
    static int grid_blocks = 0;
    if (!grid_blocks) {
        int dev = 0, cus = 0, per_cu = 0;
        (void)hipGetDevice(&dev); (void)hipDeviceGetAttribute(&cus, hipDeviceAttributeMultiprocessorCount, dev);
        (void)hipFuncSetAttribute((const void*)mega, hipFuncAttributeMaxDynamicSharedMemorySize, LDS_BYTES);
        (void)hipOccupancyMaxActiveBlocksPerMultiprocessor(&per_cu, mega, NTHR, LDS_BYTES);
        if (per_cu < 1) per_cu = 1;
        grid_blocks = cus * per_cu;
        if (ws_size < WS_END) fprintf(stderr, "kernel_launch: workspace too small: %zu < %zu\n", ws_size, (size_t)WS_END);
    }
    (void)hipMemsetAsync((char*)d_ws + WS_BAR, 0, XCD_BAR_WORDS * 4, stream);
    Params p = make_params(d_in, d_out, d_ws);
    void* args[] = {&p};
    hipError_t e = hipLaunchCooperativeKernel((void*)mega, dim3(grid_blocks), dim3(NTHR), args, LDS_BYTES, stream);
    if (e != hipSuccess) fprintf(stderr, "cooperative launch failed: %s (grid %d)\n", hipGetErrorString(e), grid_blocks);
}

#else
int main(int argc, char** argv) {
    const char* dir = argc > 1 ? argv[1] : "data";
    char path[512]; snprintf(path, 512, "%s/sizes.txt", dir); FILE* f = fopen(path, "r"); if (!f) { printf("no sizes\n"); return 1; }
    std::vector<long> sizes; long v; while (fscanf(f, "%ld", &v) == 1) sizes.push_back(v); fclose(f);
    if (sizes.size() != 31) { printf("bad n inputs %zu\n", sizes.size()); return 1; }
    snprintf(path, 512, "%s/inputs.bin", dir); f = fopen(path, "rb");
    std::vector<std::vector<float>> in(31); std::vector<void*> ptrs(31);
    for (int i = 0; i < 31; ++i) { in[i].resize(sizes[i]); if (fread(in[i].data(), 4, sizes[i], f) != (size_t)sizes[i]) { printf("short read\n"); return 1; } ptrs[i] = in[i].data(); }
    fclose(f);
    if (sizes[0] != (long)SEQ * DM) { printf("SEQ mismatch: build with -DSEQ_LEN=%ld\n", sizes[0] / DM); return 1; }
    std::vector<float> out((size_t)SEQ * DM, 0.f); std::vector<unsigned char> ws(WS_END, 0xAA);
    Params p = make_params(ptrs.data(), out.data(), ws.data());
    auto check = [&](const char* name, const float* got, size_t n) {
        snprintf(path, 512, "%s/%s", dir, name); FILE* g = fopen(path, "rb"); std::vector<float> ref(n); if (fread(ref.data(), 4, n, g) != n) printf("short ref\n"); fclose(g);
        double num = 0, den = 0, mx = 0; for (size_t i = 0; i < n; ++i) { const double d = (double)got[i] - ref[i]; num += d * d; den += (double)ref[i] * ref[i]; if (fabs(d) > mx) mx = fabs(d); }
        printf("%s: rvr=%.3e absmax=%.3e\n", name, num / den, mx); };
    static RwShared sh;
    int phase = 0;
#define X(fn, n) { printf("phase %d %s n=%ld\n", phase++, #fn, (long)(n)); fflush(stdout); _Pragma("omp parallel for schedule(dynamic, 64)") for (long g = 0; g < (long)(n); ++g) fn(p, g); }
#define SYNC
#define SCAN { printf("phase %d scan\n", phase++); fflush(stdout); _Pragma("omp parallel for schedule(dynamic, 1)") for (int b = 0; b < 32; ++b) { RwShared* s = new RwShared; rwkv_scan_block(p, b, *s); delete s; } }
    X(ph_mod, N_MOD) X(ph_rope_table, N_ROPE) X(ph_prenorm<0>, (long)R) X(ph_gemm_l0_qkv, (long)R * P0W) X(ph_ropenorm, N_ROPENORM) X(ph_ret_scan, N_RETSCAN)
    X(ph_ret_merge, N_RETMERGE) X(ph_gqa_attn, N_GQA) X(ph_gemm_l0_gate, (long)R * 2048) X(ph_gemm_l0_out, (long)R * DM) X(ph_resid<0>, (long)R)
    check("x0.bin", out.data(), out.size()); check("ctx0.bin", ws_ctx1(p), (size_t)CTXN * DM);
    X(ph_prenorm<1>, (long)R) X(ph_gemm_l1_rw, (long)R * ZW) SCAN X(ph_rwkv_finish, N_RWFIN) X(ph_gemm_l1_na, (long)R * NAW) X(ph_na, N_NA)
    X(ph_gemm_l1_gate, (long)SEQ * 2048) X(ph_gemm_l1_out, (long)SEQ * DM) X(ph_resid<1>, (long)SEQ)
    check("out.bin", out.data(), out.size());
    return 0;
}
#endif
```

```cpp
#ifdef CPU_EMU
#include <cstdio>
#include <cstdlib>
#include <cstring>
#include <cmath>
#include <vector>
#define DEV static inline
#else
#include <hip/hip_runtime.h>
#include <hip/hip_cooperative_groups.h>
#include <cstdio>
namespace cg = cooperative_groups;
#define DEV __device__ __forceinline__
#endif

#ifndef SEQ_LEN
#define SEQ_LEN 16384
#endif
typedef unsigned short bf16_t;
constexpr int DM = 1024, CTXN = 256, SEQ = SEQ_LEN, R = CTXN + SEQ, GW = 64, GROWS = SEQ / GW;
constexpr int EVEN_IN = 5632, ODD_IN = 8448;
constexpr int P0W = 3584;
constexpr int C_QA = 0, C_KA = 512, C_VA = 1024, C_QB = 2048, C_KB = 3072, C_VB = 3328, C_GA = 3584;
constexpr int ZW = 3328;
constexpr int O_NA = 0, O_RW = 3072, O_GC = 6400;
constexpr int NAW = 3072;
constexpr float NORM_EPS = 1e-6f, GN_EPS = 64e-5f;

constexpr size_t MiB = 1u << 20;
constexpr size_t WS_MODV = 0;
constexpr size_t WS_ROPE = 64 * 1024;
constexpr size_t WS_CTX1 = 1 * MiB;
constexpr size_t WS_WB = 2 * MiB;
constexpr size_t WS_XN = 42 * MiB;
constexpr size_t WS_BIG = WS_XN + (((size_t)R * DM * 2 + MiB - 1) / MiB) * MiB;
constexpr size_t WS_BR = WS_BIG + (((size_t)R * P0W * 2 + MiB - 1) / MiB) * MiB;
constexpr size_t WS_END = WS_BR + (size_t)R * 2048 * 2;
static_assert(SEQ != 16384 || WS_END <= 256 * MiB, "workspace map exceeds 256 MiB");

struct Params {
    const float *x, *c, *ctx, *c_ctx, *w_mod, *b_mod, *g_pre, *g_post, *ev_w_in, *ev_w_out, *dec_f, *dec_b, *q_norm, *k_norm;
    const float *od_w_in, *od_w_out, *rpb, *mu, *w0f, *w2f, *w0b, *w2b, *a0f, *a2f, *a0b, *a2b, *k_k, *k_a, *r_k, *lnx_g, *lnx_b;
    float* out; unsigned char* ws;
};

DEV bf16_t f2bf(float f) { unsigned u; __builtin_memcpy(&u, &f, 4); u = (u + 0x7fffu + ((u >> 16) & 1u)) >> 16; return (bf16_t)u; }
DEV float bf2f(bf16_t h) { unsigned u = ((unsigned)h) << 16; float f; __builtin_memcpy(&f, &u, 4); return f; }
DEV float siluf(float x) { return x / (1.0f + expf(-x)); }
DEV float sigmf(float x) { return 1.0f / (1.0f + expf(-x)); }
DEV float softplusf(float x) { return fmaxf(x, 0.f) + log1pf(expf(-fabsf(x))); }

DEV float* ws_modv(const Params& p) { return (float*)(p.ws + WS_MODV); }
DEV float* ws_rope(const Params& p) { return (float*)(p.ws + WS_ROPE); }
DEV float* ws_ctx1(const Params& p) { return (float*)(p.ws + WS_CTX1); }
DEV bf16_t* ws_xn(const Params& p) { return (bf16_t*)(p.ws + WS_XN); }
DEV bf16_t* ws_big(const Params& p) { return (bf16_t*)(p.ws + WS_BIG); }
DEV float* ws_y(const Params& p) { return (float*)(p.ws + WS_BIG); }
DEV bf16_t* ws_br(const Params& p) { return (bf16_t*)(p.ws + WS_BR); }

constexpr long N_MOD = 2 * 2 * 3072;
DEV void ph_mod(const Params& p, long gid) {
    const int j = (int)(gid % 3072), s = (int)((gid / 3072) % 2), l = (int)(gid / 6144);
    const float* cv = s ? p.c_ctx : p.c; const float* w = p.w_mod + (size_t)l * DM * 3072 + j;
    float acc = 0.f;
    for (int k = 0; k < DM; ++k) acc += siluf(cv[k]) * w[(size_t)k * 3072];
    ws_modv(p)[gid] = acc + p.b_mod[l * 3072 + j];
}
constexpr long N_ROPE = 256 * 32;
DEV void ph_rope_table(const Params& p, long gid) {
    const int f = (int)(gid % 32), pos = (int)(gid / 32);
    const float inv = powf(10000.0f, -(float)f / 32.0f); const float ang = (float)pos * inv;
    ws_rope(p)[gid] = cosf(ang); ws_rope(p)[N_ROPE + gid] = sinf(ang);
}
template <int LAYER> DEV void ph_prenorm(const Params& p, long gid) {
    const int row = (int)gid; const int s = row < CTXN ? 1 : 0;
    const float* src = row < CTXN ? ((LAYER == 0 ? p.ctx : ws_ctx1(p)) + (size_t)row * DM) : ((LAYER == 0 ? p.x : p.out) + (size_t)(row - CTXN) * DM);
    const float* mv = ws_modv(p) + (LAYER * 2 + s) * 3072; const float* g = p.g_pre + LAYER * DM;
    float ss = 0.f;
    for (int k = 0; k < DM; ++k) ss += src[k] * src[k];
    const float rstd = 1.0f / sqrtf(ss / DM + NORM_EPS);
    bf16_t* o = ws_xn(p) + (size_t)row * DM;
    for (int k = 0; k < DM; ++k) o[k] = f2bf(src[k] * rstd * g[k] * (1.0f + mv[1024 + k]) + mv[k]);
}
template <int MODE> DEV void gemm_item(const bf16_t* A, int K, const float* W, int ldw, void* out, int pitch, int row, int col) {
    const bf16_t* a = A + (size_t)row * K; const float* w = W + col; float acc = 0.f;
    for (int k = 0; k < K; ++k) acc += bf2f(a[k]) * w[(size_t)k * ldw];
    if (MODE == 0) ((bf16_t*)out)[(size_t)row * pitch + col] = f2bf(acc);
    else if (MODE == 1) { bf16_t* o = (bf16_t*)out + (size_t)row * pitch + col; *o = f2bf(siluf(acc) * bf2f(*o)); }
    else ((float*)out)[(size_t)row * pitch + col] = acc;
}
DEV void ph_gemm_l0_qkv(const Params& p, long gid) { gemm_item<0>(ws_xn(p), DM, p.ev_w_in, EVEN_IN, ws_big(p), P0W, (int)(gid / P0W), (int)(gid % P0W)); }
DEV void ph_gemm_l0_gate(const Params& p, long gid) { gemm_item<1>(ws_xn(p), DM, p.ev_w_in + C_GA, EVEN_IN, ws_br(p), 2048, (int)(gid / 2048), (int)(gid % 2048)); }
DEV void ph_gemm_l0_out(const Params& p, long gid) { gemm_item<2>(ws_br(p), 2048, p.ev_w_out, DM, ws_y(p), DM, (int)(gid / DM), (int)(gid % DM)); }
DEV void ph_gemm_l1_rw(const Params& p, long gid) { gemm_item<0>(ws_xn(p), DM, p.od_w_in + O_RW, ODD_IN, ws_big(p), ZW, (int)(gid / ZW), (int)(gid % ZW)); }
DEV void ph_gemm_l1_na(const Params& p, long gid) { gemm_item<0>(ws_xn(p), DM, p.od_w_in + O_NA, ODD_IN, ws_big(p), NAW, (int)(gid / NAW), (int)(gid % NAW)); }
DEV void ph_gemm_l1_gate(const Params& p, long gid) { gemm_item<1>(ws_xn(p), DM, p.od_w_in + O_GC, ODD_IN, ws_br(p), 2048, CTXN + (int)(gid / 2048), (int)(gid % 2048)); }
DEV void ph_gemm_l1_out(const Params& p, long gid) { gemm_item<2>(ws_br(p), 2048, p.od_w_out, DM, ws_y(p), DM, CTXN + (int)(gid / DM), (int)(gid % DM)); }

constexpr long N_ROPENORM = (long)R * 18;
DEV void ph_ropenorm(const Params& p, long gid) {
    const int slot = (int)(gid % 18), row = (int)(gid / 18);
    int col; const float* nw = nullptr; float sc = 1.f;
    if (slot < 4) col = C_QA + slot * 128; else if (slot < 8) { col = C_KA + (slot - 4) * 128; sc = 0.08838834764831845f; }
    else if (slot < 16) { col = C_QB + (slot - 8) * 128; nw = p.q_norm; } else { col = C_KB + (slot - 16) * 128; nw = p.k_norm; }
    bf16_t* v = ws_big(p) + (size_t)row * P0W + col;
    if (nw) { float ss = 0.f; for (int d = 0; d < 128; ++d) { const float t = bf2f(v[d]); ss += t * t; } sc = 1.0f / sqrtf(ss / 128.f + NORM_EPS); }
    const bool rot = row >= CTXN; const int t = row - CTXN; const int gr = rot ? t / GW : 0, gc = rot ? t % GW : 0;
    const float* ct = ws_rope(p); const float* st = ct + N_ROPE;
    for (int i = 0; i < 64; ++i) {
        float x1 = bf2f(v[2 * i]) * sc, x2 = bf2f(v[2 * i + 1]) * sc;
        if (nw) { x1 *= nw[2 * i]; x2 *= nw[2 * i + 1]; }
        if (rot) { const int pos = i < 32 ? gr : gc, f = i & 31; const float cs = ct[pos * 32 + f], sn = st[pos * 32 + f]; const float y1 = x1 * cs - x2 * sn, y2 = x1 * sn + x2 * cs; x1 = y1; x2 = y2; }
        v[2 * i] = f2bf(x1); v[2 * i + 1] = f2bf(x2);
    }
}
constexpr long N_RETSCAN = 2 * 4 * 256;
DEV void ph_ret_scan(const Params& p, long gid) {
    const int e = (int)(gid % 256), h = (int)((gid / 256) % 4), dir = (int)(gid / 1024);
    const float g = sigmf((dir ? p.dec_b : p.dec_f)[h]);
    float S[128];
#pragma unroll
    for (int d = 0; d < 128; ++d) S[d] = 0.f;
    const bf16_t* P = ws_big(p); bf16_t* BR = ws_br(p);
    for (int pos = 0; pos < R; ++pos) {
        int row; if (pos < CTXN) row = dir ? CTXN - 1 - pos : pos; else { const int t = pos - CTXN; row = CTXN + (dir ? SEQ - 1 - t : t); }
        const bf16_t* pr = P + (size_t)row * P0W; const float v = bf2f(pr[C_VA + h * 256 + e]);
        const bf16_t* kq = pr + C_KA + h * 128; const bf16_t* qq = pr + C_QA + h * 128; float y = 0.f;
#pragma unroll
        for (int d = 0; d < 128; ++d) { S[d] = g * S[d] + bf2f(kq[d]) * v; y += bf2f(qq[d]) * S[d]; }
        BR[(size_t)row * 2048 + dir * 1024 + h * 256 + e] = f2bf(y);
    }
}
constexpr long N_RETMERGE = (long)R * 4;
DEV void ph_ret_merge(const Params& p, long gid) {
    const int h = (int)(gid % 4), row = (int)(gid / 4);
    bf16_t* b = ws_br(p) + (size_t)row * 2048 + h * 256;
    float s = 0.f; for (int e = 0; e < 256; ++e) s += bf2f(b[e]) + bf2f(b[1024 + e]);
    const float mean = s / 256.f; float q = 0.f;
    for (int e = 0; e < 256; ++e) { const float d = bf2f(b[e]) + bf2f(b[1024 + e]) - mean; q += d * d; }
    const float rstd = 1.0f / sqrtf(q / 256.f + NORM_EPS);
    for (int e = 0; e < 256; ++e) b[e] = f2bf((bf2f(b[e]) + bf2f(b[1024 + e]) - mean) * rstd);
}
constexpr long N_GQA = (long)R * 8 * 8;
DEV void ph_gqa_attn(const Params& p, long gid) {
    const int sl = (int)(gid % 8), row = (int)((gid / 8) % R), head = (int)(gid / (8L * R)), g = head / 4;
    const bf16_t* P = ws_big(p); const int nk = row < CTXN ? CTXN : R;
    float q[128];
    { const bf16_t* qp = P + (size_t)row * P0W + C_QB + head * 128;
#pragma unroll
      for (int d = 0; d < 128; ++d) q[d] = bf2f(qp[d]) * 0.08838834764831845f; }
    float acc[16];
#pragma unroll
    for (int i = 0; i < 16; ++i) acc[i] = 0.f;
    float m = -1e30f, l = 0.f;
    for (int j = 0; j < nk; ++j) {
        const bf16_t* kp = P + (size_t)j * P0W + C_KB + g * 128; float s = 0.f;
#pragma unroll
        for (int d = 0; d < 128; ++d) s += q[d] * bf2f(kp[d]);
        const float mn = fmaxf(m, s), al = expf(m - mn), pe = expf(s - mn);
        const bf16_t* vp = P + (size_t)j * P0W + C_VB + g * 128 + sl * 16;
        l = l * al + pe;
#pragma unroll
        for (int i = 0; i < 16; ++i) acc[i] = acc[i] * al + pe * bf2f(vp[i]);
        m = mn;
    }
    bf16_t* o = ws_br(p) + (size_t)row * 2048 + 1024 + head * 128 + sl * 16; const float il = 1.0f / l;
#pragma unroll
    for (int i = 0; i < 16; ++i) o[i] = f2bf(acc[i] * il);
}
template <int LAYER> DEV void ph_resid(const Params& p, long gid) {
    const int row = LAYER == 0 ? (int)gid : CTXN + (int)gid; const int s = row < CTXN ? 1 : 0;
    const float* y = ws_y(p) + (size_t)row * DM; const float* mv = ws_modv(p) + (LAYER * 2 + s) * 3072 + 2048; const float* g = p.g_post + LAYER * DM;
    float ss = 0.f; for (int k = 0; k < DM; ++k) ss += y[k] * y[k];
    const float rstd = 1.0f / sqrtf(ss / DM + NORM_EPS);
    const float* src; float* dst;
    if (row < CTXN) { src = p.ctx + (size_t)row * DM; dst = ws_ctx1(p) + (size_t)row * DM; }
    else { src = (LAYER == 0 ? p.x : p.out) + (size_t)(row - CTXN) * DM; dst = p.out + (size_t)(row - CTXN) * DM; }
    for (int k = 0; k < DM; ++k) dst[k] = src[k] + mv[k] * (y[k] * rstd * g[k]);
}
DEV float zshift(const bf16_t* Z, const float* mu, int row, int col) {
    const int lo = row < CTXN ? 0 : CTXN, hi = row < CTXN ? CTXN : R;
    const float z = bf2f(Z[(size_t)row * ZW + col]);
    const float pv = row > lo ? bf2f(Z[(size_t)(row - 1) * ZW + col]) : 0.f, nx = row + 1 < hi ? bf2f(Z[(size_t)(row + 1) * ZW + col]) : 0.f;
    return z + (0.5f * (pv + nx) - z) * mu[col];
}
constexpr long N_RWFIN = (long)SEQ * 16;
DEV void ph_rwkv_finish(const Params& p, long gid) {
    const int h = (int)(gid % 16), t = (int)(gid / 16), row = CTXN + t;
    const bf16_t* Z = ws_big(p); bf16_t* b = ws_br(p) + (size_t)row * 2048;
    float bon[2];
    for (int d = 0; d < 2; ++d) {
        const float* a0 = d ? p.a0b : p.a0f; const float* a2 = d ? p.a2b : p.a2f;
        float s = 0.f;
        for (int j = 0; j < 64; ++j) { const int hj = h * 64 + j; float acc = a0[hj];
            for (int m = 0; m < 64; ++m) acc += zshift(Z, p.mu, row, 3200 + d * 64 + m) * a2[m * 1024 + hj];
            const float al = sigmf(acc); const float r = zshift(Z, p.mu, row, hj), k = zshift(Z, p.mu, row, 1024 + hj);
            s += r * (k * (1.0f + (al - 1.0f) * p.k_a[hj])) * p.r_k[hj]; }
        bon[d] = s;
    }
    float sm = 0.f; for (int i = 0; i < 64; ++i) sm += bf2f(b[h * 64 + i]) + bf2f(b[1024 + h * 64 + i]);
    const float mean = sm / 64.f; float q = 0.f;
    for (int i = 0; i < 64; ++i) { const float d = bf2f(b[h * 64 + i]) + bf2f(b[1024 + h * 64 + i]) - mean; q += d * d; }
    const float rstd = 1.0f / sqrtf(q / 64.f + GN_EPS);
    for (int i = 0; i < 64; ++i) { const int hi = h * 64 + i; const float w = bf2f(b[hi]) + bf2f(b[1024 + hi]);
        const float v = zshift(Z, p.mu, row, 2048 + hi);
        b[1024 + hi] = f2bf((w - mean) * rstd * p.lnx_g[hi] + p.lnx_b[hi] + (bon[0] + bon[1]) * v); }
}
constexpr long N_NA = (long)SEQ * 16;
DEV void ph_na(const Params& p, long gid) {
    const int h = (int)(gid % 16), t = (int)(gid / 16), r = t / GW, c = t % GW;
    const bf16_t* P = ws_big(p);
    float q[64];
    { const bf16_t* qp = P + (size_t)(CTXN + t) * NAW + h * 64;
#pragma unroll
      for (int d = 0; d < 64; ++d) q[d] = bf2f(qp[d]) * 0.125f; }
    float acc[64];
#pragma unroll
    for (int d = 0; d < 64; ++d) acc[d] = 0.f;
    float m = -1e30f, l = 0.f;
    const int wh = GROWS < 8 ? GROWS : 8;
    int r0 = r - wh / 2; r0 = r0 < 0 ? 0 : (r0 > GROWS - wh ? GROWS - wh : r0);
    int c0 = c - 8; c0 = c0 < 0 ? 0 : (c0 > GW - 16 ? GW - 16 : c0);
    const float* rp = p.rpb + h * 15 * 31;
    for (int kk = 0; kk < wh * 16 + CTXN; ++kk) {
        int krow; float bias = 0.f;
        if (kk < wh * 16) { const int i = kk / 16, j = kk % 16; krow = CTXN + (r0 + i) * GW + c0 + j; bias = rp[(r0 + i - r + 7) * 31 + (c0 + j - c + 15)]; }
        else krow = kk - wh * 16;
        const bf16_t* kp = P + (size_t)krow * NAW + 1024 + h * 64; float s = bias;
#pragma unroll
        for (int d = 0; d < 64; ++d) s += q[d] * bf2f(kp[d]);
        const float mn = fmaxf(m, s), al = expf(m - mn), pe = expf(s - mn);
        const bf16_t* vp = P + (size_t)krow * NAW + 2048 + h * 64;
        l = l * al + pe;
#pragma unroll
        for (int d = 0; d < 64; ++d) acc[d] = acc[d] * al + pe * bf2f(vp[d]);
        m = mn;
    }
    bf16_t* o = ws_br(p) + (size_t)(CTXN + t) * 2048 + h * 64; const float il = 1.0f / l;
#pragma unroll
    for (int d = 0; d < 64; ++d) o[d] = f2bf(acc[d] * il);
}

constexpr int RW_CH = 16;
struct RwShared { float r[RW_CH][64], w[RW_CH][64], kd[RW_CH][64], v[RW_CH][64], a[RW_CH][64], b[RW_CH][64], tz[RW_CH][64], za[RW_CH][64], kk[RW_CH][64]; };
#ifdef CPU_EMU
#define FOR_THREADS(tid) for (int tid = 0; tid < 64; ++tid)
#define BLOCK_SYNC()
#define TSTATE(tid) S_all[tid]
#else
#define FOR_THREADS(tid) const int tid = threadIdx.x; if (tid < 64)
#define BLOCK_SYNC() __syncthreads()
#define TSTATE(tid) S_reg
#endif
DEV int rw_row(int dir, int pos) { if (pos < CTXN) return dir ? CTXN - 1 - pos : pos; const int t = pos - CTXN; return CTXN + (dir ? SEQ - 1 - t : t); }
#ifdef CPU_EMU
static void rwkv_scan_block(const Params& p, int blk, RwShared& sh) {
    static thread_local float S_all[64][64];
    for (int i = 0; i < 64; ++i) for (int j = 0; j < 64; ++j) S_all[i][j] = 0.f;
#else
__device__ void rwkv_scan_block(const Params& p, int blk, RwShared& sh) {
    float S_reg[64];
#pragma unroll
    for (int j = 0; j < 64; ++j) S_reg[j] = 0.f;
#endif
    const int dir = blk / 16, h = blk % 16;
    const float* w0 = dir ? p.w0b : p.w0f; const float* w2 = dir ? p.w2b : p.w2f; const float* a0 = dir ? p.a0b : p.a0f; const float* a2 = dir ? p.a2b : p.a2f;
    const bf16_t* Z = ws_big(p); bf16_t* BR = ws_br(p);
    for (int p0 = 0; p0 < R; p0 += RW_CH) {
        { FOR_THREADS(tid) { const int hj = h * 64 + tid;
            for (int tt = 0; tt < RW_CH; ++tt) { const int row = rw_row(dir, p0 + tt);
                sh.tz[tt][tid] = tanhf(zshift(Z, p.mu, row, 3072 + dir * 64 + tid)); sh.za[tt][tid] = zshift(Z, p.mu, row, 3200 + dir * 64 + tid);
                sh.r[tt][tid] = zshift(Z, p.mu, row, hj); sh.v[tt][tid] = zshift(Z, p.mu, row, 2048 + hj);
                const float k = zshift(Z, p.mu, row, 1024 + hj); sh.kd[tt][tid] = k; sh.kk[tt][tid] = k * p.k_k[hj]; } } }
        BLOCK_SYNC();
        { FOR_THREADS(tid) { const int hj = h * 64 + tid;
            for (int tt = 0; tt < RW_CH; ++tt) { float aw = w0[hj], aa = a0[hj], nn = 0.f;
                for (int m = 0; m < 64; ++m) { aw += sh.tz[tt][m] * w2[m * 1024 + hj]; aa += sh.za[tt][m] * a2[m * 1024 + hj]; nn += sh.kk[tt][m] * sh.kk[tt][m]; }
                const float lw = -softplusf(-aw) - 0.5f; const float al = sigmf(aa);
                const float kkn = sh.kk[tt][tid] / fmaxf(sqrtf(nn), 1e-12f);
                sh.w[tt][tid] = expf(-expf(lw)); sh.a[tt][tid] = -kkn; sh.b[tt][tid] = kkn * al;
                sh.kd[tt][tid] = sh.kd[tt][tid] * (1.0f + (al - 1.0f) * p.k_a[hj]); } } }
        BLOCK_SYNC();
        { FOR_THREADS(tid) { float* S = TSTATE(tid);
            for (int tt = 0; tt < RW_CH; ++tt) { float sa = 0.f;
#pragma unroll
                for (int j = 0; j < 64; ++j) sa += S[j] * sh.a[tt][j];
                const float vi = sh.v[tt][tid]; float y = 0.f;
#pragma unroll
                for (int j = 0; j < 64; ++j) { S[j] = S[j] * sh.w[tt][j] + sa * sh.b[tt][j] + vi * sh.kd[tt][j]; y += S[j] * sh.r[tt][j]; }
                if (p0 >= CTXN) BR[(size_t)rw_row(dir, p0 + tt) * 2048 + dir * 1024 + h * 64 + tid] = f2bf(y); } } }
        BLOCK_SYNC();
    }
}

static Params make_params(void* const* d_in, void* d_out, void* d_ws) {
    Params p{};
    const float** f = (const float**)&p;
    for (int i = 0; i < 31; ++i) f[i] = (const float*)d_in[i];
    p.out = (float*)d_out; p.ws = (unsigned char*)d_ws; return p;
}


#ifndef CPU_EMU
#define LAS __attribute__((address_space(3)))
#define GAS __attribute__((address_space(1)))
typedef unsigned v4u __attribute__((ext_vector_type(4)));
constexpr int NWAVES = 8, NTHR = NWAVES * 64;
#ifndef PROBE
#define PROBE 0
#endif
#define XB_TMO      128
#define XB_XCNT(j)  (256  + 64 * (j))
#define XB_XSUB(j)  (1280 + 64 * (j))
#define XB_XGEN(j)  (2304 + 64 * (j))
#define XB_TOP      3328
#define XB_TOPGEN   3392
#define XCD_BAR_WORDS 3456
#define XB_SPIN_CAP (1u << 18)

__device__ __forceinline__ unsigned xb_ld(unsigned* p)              { return __hip_atomic_load(p, __ATOMIC_RELAXED, __HIP_MEMORY_SCOPE_AGENT); }
__device__ __forceinline__ unsigned xb_add(unsigned* p, unsigned v) { return __hip_atomic_fetch_add(p, v, __ATOMIC_RELAXED, __HIP_MEMORY_SCOPE_AGENT); }
__device__ __forceinline__ unsigned xb_xcc_id() { return (unsigned)__builtin_amdgcn_s_getreg((3 << 11) | 20) & 0xFu; }
#define XB_SPIN(cond, bar) do { unsigned _sp = 0; while (cond) { __builtin_amdgcn_s_sleep(1); \
    if ((++_sp & 255u) == 0u) { if (xb_ld(&(bar)[XB_TMO])) break; if (_sp > XB_SPIN_CAP) { atomicAdd(&(bar)[XB_TMO], 1u); break; } } } } while (0)

struct XcdBarrier {
    unsigned* bar; unsigned x;
    volatile LAS unsigned* st;
};

__device__ __forceinline__ XcdBarrier xcd_barrier_post(unsigned* bar, volatile LAS unsigned* st) {
    XcdBarrier b; b.bar = bar; b.x = xb_xcc_id(); b.st = st;
    if (threadIdx.x == 0) (void)xb_add(&bar[XB_XCNT(b.x)], 1u);
    return b;
}
__device__ __forceinline__ void xcd_barrier_complete(unsigned* bar, unsigned x, unsigned& nloc, unsigned& nx) {
    const unsigned G = gridDim.x * gridDim.y * gridDim.z;
    unsigned sum, cnt, mine, sp = 0u;
    for (;;) {
        sum = 0u; cnt = 0u; mine = 0u;
#pragma unroll
        for (unsigned j = 0; j < 16; ++j) { const unsigned c = xb_ld(&bar[XB_XCNT(j)]); sum += c; cnt += (c > 0u) ? 1u : 0u; mine = (j == x) ? c : mine; }
        if (sum == G) break;
        __builtin_amdgcn_s_sleep(1);
        if ((++sp & 255u) == 0u) { if (xb_ld(&bar[XB_TMO])) break; if (sp > XB_SPIN_CAP) { atomicAdd(&bar[XB_TMO], 1u); break; } }
    }
    nloc = mine > 0u ? mine : 1u; nx = cnt > 0u ? cnt : 1u;
}

__device__ __forceinline__ void xcd_barrier(const XcdBarrier& b) {
    asm volatile("s_waitcnt vmcnt(0)" ::: "memory");
    __syncthreads();
    if (threadIdx.x == 0) {
        unsigned* bar = b.bar;
        __builtin_amdgcn_s_waitcnt(0);
        unsigned nloc = b.st[0], nx = b.st[1];
        if (nloc == 0u) { xcd_barrier_complete(bar, b.x, nloc, nx); b.st[0] = nloc; b.st[1] = nx; }
        const unsigned old = xb_add(&bar[XB_XSUB(b.x)], 1u);
        const unsigned gen = old / nloc;
        if (old + 1u == (gen + 1u) * nloc) {
            __builtin_amdgcn_fence(__ATOMIC_RELEASE, "agent");
            asm volatile("s_waitcnt vmcnt(0)" ::: "memory");
            const unsigned og = xb_add(&bar[XB_TOP], 1u);
            const unsigned tg = og / nx;
            if (og + 1u == (tg + 1u) * nx) xb_add(&bar[XB_TOPGEN], 1u);
            else XB_SPIN(xb_ld(&bar[XB_TOPGEN]) == tg, bar);
            __builtin_amdgcn_fence(__ATOMIC_ACQUIRE, "agent");
            xb_add(&bar[XB_XGEN(b.x)], 1u);
            asm volatile("s_waitcnt vmcnt(0)" ::: "memory");
        } else {
            XB_SPIN(xb_ld(&bar[XB_XGEN(b.x)]) == gen, bar);
            __builtin_amdgcn_fence(__ATOMIC_ACQUIRE, "agent");
            asm volatile("s_waitcnt vmcnt(0)" ::: "memory");
        }
    }
    __syncthreads();
}
namespace pg8 {
#define PG8_LAS __attribute__((address_space(3)))
typedef unsigned short bf16_t;
typedef short bf16x8 __attribute__((ext_vector_type(8)));
typedef float f32x4 __attribute__((ext_vector_type(4)));
typedef unsigned u32x4 __attribute__((ext_vector_type(4)));
constexpr int BM = 256, BK = 64, HALF = 128, HTB = HALF * BK * 2  , STAGE_BYTES = 8 * HTB, NXCD = 8, WGM = 8;

__host__ __device__ __forceinline__ int lds_byte(int r, int c) { const int st = (r >> 4) * 2 + (c >> 5), rr = r & 15, cc = c & 31, ob = rr * 64 + cc * 2; return st * 1024 + (ob ^ (((ob >> 9) & 1) << 5)); }
__host__ __device__ __forceinline__ void stage_rc(int b, int& R, int& C) { const int st = b / 1024, sb = b % 1024, swz = sb ^ (((sb >> 9) & 1) << 5); R = (st >> 1) * 16 + swz / 64; C = (st & 1) * 32 + (swz % 64) / 2; }
__host__ __device__ __forceinline__ int perm32(int rho) { const int n = rho >> 4, i = rho & 15; return 8 * (i >> 2) + 4 * n + (i & 3); }

struct Unit { int pm, pn; };
struct Gemm { const bf16_t* A; const bf16_t* Bt; int M, N, K; int lda = 0, ldb = 0; int ksl = 0; };

struct StaticOrder {
    int nM, nN, nwg, G, c;
    __host__ __device__ void init(int M, int N, int G_, int c_) { nM = M / BM; nN = N / BM; nwg = nM * nN; G = G_; c = c_; }
    __host__ __device__ bool next(int i, Unit& u) const {
        const long L = (long)i * G + c; if (L >= nwg) return false;
        int wgid = (int)L; { const int q = nwg / NXCD, r = nwg % NXCD, xcd = wgid % NXCD, off = wgid / NXCD; wgid = (xcd < r ? xcd * (q + 1) : r * (q + 1) + (xcd - r) * q) + off; }
        const int nig = WGM * nN, gid = wgid / nig, fm = gid * WGM, gsz = (nM - fm) < WGM ? (nM - fm) : WGM;
        u.pm = fm + ((wgid % nig) % gsz); u.pn = (wgid % nig) / gsz; return true;
    }
    __device__ __forceinline__ void a_ready(const Unit&) const {}
    __device__ __forceinline__ void done(const Unit&) const {}
};

__device__ __forceinline__ unsigned cvt_pk_bf16(float lo, float hi) { unsigned r; asm volatile("v_cvt_pk_bf16_f32 %0, %1, %2" : "=v"(r) : "v"(lo), "v"(hi)); return r; }
typedef float f32x2 __attribute__((ext_vector_type(2)));
__device__ __forceinline__ f32x2 gelu_pk(f32x2 v) {
    const f32x2 av = __builtin_elementwise_abs(v), d = av * 0.2316418882f + 1.0f;
    f32x2 t; t.x = __builtin_amdgcn_rcpf(d.x); t.y = __builtin_amdgcn_rcpf(d.y);
    f32x2 q = t * 0.5307027145f + (-0.7265760135f); q = q * t + 0.7107068705f; q = q * t + (-0.142248368f); q = q * t + 0.127414796f; q = q * t;
    const f32x2 s = (v * v) * (-0.72134752044f);
    f32x2 e; e.x = __builtin_amdgcn_exp2f(s.x); e.y = __builtin_amdgcn_exp2f(s.y);
    const f32x2 m = v * (q * e), r = v - m;
    f32x2 o; o.x = v.x < 0.f ? m.x : r.x; o.y = v.y < 0.f ? m.y : r.y; return o;
}

template <int ACT  > struct EpiBf16 {
    static constexpr bool PERM = true, AFTER_DRAIN = false; static_assert(ACT == 0 || ACT == 1, "EpiBf16: ACT is 0 (none) or 1 (gelu_pk)");
    bf16_t* O; int ldc; const float* bias; int split_cols; size_t split_stride; float scale0;
    __device__ __forceinline__ void operator()(const f32x4 (&acc)[2][2][4][2], const Unit& u, int wr, int wc, int fr, int fq) const {
        const int row0 = u.pm * BM + wr * 64 + fr; int colt = u.pn * BM; bf16_t* base = O;
        float sc = 1.f; if (split_cols) { const int t = colt / split_cols; base += (size_t)t * split_stride; colt -= t * split_cols; if (t == 0) sc = scale0; }
        const int col0 = colt + wc * 32 + 8 * fq, bcol0 = u.pn * BM + wc * 32 + 8 * fq;
        f32x4 bv[2][2];
#pragma unroll
        for (int bj = 0; bj < 2; ++bj)
#pragma unroll
            for (int n = 0; n < 2; ++n) bv[bj][n] = bias ? *(const f32x4*)(bias + bcol0 + bj * HALF + 4 * n) : (f32x4){0.f, 0.f, 0.f, 0.f};
#pragma unroll
        for (int ai = 0; ai < 2; ++ai)
#pragma unroll
            for (int m = 0; m < 4; ++m) { bf16_t* rowp = base + (size_t)(row0 + ai * HALF + m * 16) * ldc + col0;
#pragma unroll
                for (int bj = 0; bj < 2; ++bj) { f32x4 v0 = acc[ai][bj][m][0] + bv[bj][0], v1 = acc[ai][bj][m][1] + bv[bj][1];
                    if (ACT == 1) { f32x2 a = gelu_pk((f32x2){v0[0], v0[1]}), b = gelu_pk((f32x2){v0[2], v0[3]}), c = gelu_pk((f32x2){v1[0], v1[1]}), d = gelu_pk((f32x2){v1[2], v1[3]});
                        v0 = (f32x4){a.x, a.y, b.x, b.y}; v1 = (f32x4){c.x, c.y, d.x, d.y}; }
                    v0 = v0 * sc; v1 = v1 * sc; u32x4 w; w.x = cvt_pk_bf16(v0[0], v0[1]); w.y = cvt_pk_bf16(v0[2], v0[3]); w.z = cvt_pk_bf16(v1[0], v1[1]); w.w = cvt_pk_bf16(v1[2], v1[3]);
                    *(u32x4*)(rowp + bj * HALF) = w; } }
    }
};

typedef float f32x2c_ __attribute__((ext_vector_type(2))); typedef __bf16 bf2c_ __attribute__((ext_vector_type(2)));
__device__ __forceinline__ unsigned cvt_pk_bf16_c(float lo, float hi) { const f32x2c_ v = {lo, hi}; return __builtin_bit_cast(unsigned, __builtin_convertvector(v, bf2c_)); }
struct EpiBf16Halo {
    static constexpr bool PERM = true, AFTER_DRAIN = false;
    bf16_t* O; int ldc; bf16_t* H;
    __device__ __forceinline__ void operator()(const f32x4 (&acc)[2][2][4][2], const Unit& u, int wr, int wc, int fr, int fq) const {
        const int row0 = u.pm * BM + wr * 64 + fr, col0 = u.pn * BM + wc * 32 + 8 * fq;
#pragma unroll
        for (int ai = 0; ai < 2; ++ai)
#pragma unroll
            for (int m = 0; m < 4; ++m) { const int row = row0 + ai * HALF + m * 16; bf16_t* rowp = O + (size_t)row * ldc + col0;
                const bool edge = (m == 0 && wr == 0 && fr == 0) || (m == 3 && wr == 1 && fr == 15);
                bf16_t* hp = H + ((size_t)(row >> 7) * 2 + (m == 3 ? 1 : 0)) * ldc + col0;
#pragma unroll
                for (int bj = 0; bj < 2; ++bj) { const f32x4 v0 = acc[ai][bj][m][0], v1 = acc[ai][bj][m][1];
                    u32x4 w; w.x = cvt_pk_bf16_c(v0[0], v0[1]); w.y = cvt_pk_bf16_c(v0[2], v0[3]); w.z = cvt_pk_bf16_c(v1[0], v1[1]); w.w = cvt_pk_bf16_c(v1[2], v1[3]);
                    *(u32x4*)(rowp + bj * HALF) = w;
                    if ((m == 0 || m == 3) && edge) *(u32x4*)(hp + bj * HALF) = w; } }
    }
};
__device__ __forceinline__ float silu_fast(float v) { return v * __builtin_amdgcn_rcpf(1.0f + __builtin_amdgcn_exp2f(-1.4426950408889634f * v)); }
struct EpiGateMul {
    static constexpr bool PERM = true, AFTER_DRAIN = false;
    bf16_t* O; int ldc;
    __device__ __forceinline__ void operator()(const f32x4 (&acc)[2][2][4][2], const Unit& u, int wr, int wc, int fr, int fq) const {
        const int row0 = u.pm * BM + wr * 64 + fr, col0 = u.pn * BM + wc * 32 + 8 * fq;
#pragma unroll
        for (int ai = 0; ai < 2; ++ai)
#pragma unroll
            for (int m = 0; m < 4; ++m) { bf16_t* rowp = O + (size_t)(row0 + ai * HALF + m * 16) * ldc + col0;
#pragma unroll
                for (int bj = 0; bj < 2; ++bj) { const u32x4 old = *(const u32x4*)(rowp + bj * HALF); const f32x4 v0 = acc[ai][bj][m][0], v1 = acc[ai][bj][m][1];
                    u32x4 w;
                    w.x = cvt_pk_bf16(silu_fast(v0[0]) * __uint_as_float(old.x << 16), silu_fast(v0[1]) * __uint_as_float(old.x & 0xffff0000u));
                    w.y = cvt_pk_bf16(silu_fast(v0[2]) * __uint_as_float(old.y << 16), silu_fast(v0[3]) * __uint_as_float(old.y & 0xffff0000u));
                    w.z = cvt_pk_bf16(silu_fast(v1[0]) * __uint_as_float(old.z << 16), silu_fast(v1[1]) * __uint_as_float(old.z & 0xffff0000u));
                    w.w = cvt_pk_bf16(silu_fast(v1[2]) * __uint_as_float(old.w << 16), silu_fast(v1[3]) * __uint_as_float(old.w & 0xffff0000u));
                    *(u32x4*)(rowp + bj * HALF) = w; } }
    }
};
struct EpiSiluBf16 {
    static constexpr bool PERM = true, AFTER_DRAIN = false;
    bf16_t* O; int ldc;
    __device__ __forceinline__ void operator()(const f32x4 (&acc)[2][2][4][2], const Unit& u, int wr, int wc, int fr, int fq) const {
        const int row0 = u.pm * BM + wr * 64 + fr, col0 = u.pn * BM + wc * 32 + 8 * fq;
#pragma unroll
        for (int ai = 0; ai < 2; ++ai)
#pragma unroll
            for (int m = 0; m < 4; ++m) { bf16_t* rowp = O + (size_t)(row0 + ai * HALF + m * 16) * ldc + col0;
#pragma unroll
                for (int bj = 0; bj < 2; ++bj) { const f32x4 v0 = acc[ai][bj][m][0], v1 = acc[ai][bj][m][1]; u32x4 w;
                    w.x = cvt_pk_bf16(silu_fast(v0[0]), silu_fast(v0[1])); w.y = cvt_pk_bf16(silu_fast(v0[2]), silu_fast(v0[3]));
                    w.z = cvt_pk_bf16(silu_fast(v1[0]), silu_fast(v1[1])); w.w = cvt_pk_bf16(silu_fast(v1[2]), silu_fast(v1[3]));
                    *(u32x4*)(rowp + bj * HALF) = w; } }
    }
};
struct EpiF32 {
    static constexpr bool PERM = true, AFTER_DRAIN = false;
    float* O; int ldc;
    __device__ __forceinline__ void operator()(const f32x4 (&acc)[2][2][4][2], const Unit& u, int wr, int wc, int fr, int fq) const {
        const int row0 = u.pm * BM + wr * 64 + fr, col0 = u.pn * BM + wc * 32 + 8 * fq;
#pragma unroll
        for (int ai = 0; ai < 2; ++ai)
#pragma unroll
            for (int m = 0; m < 4; ++m) { float* rowp = O + (size_t)(row0 + ai * HALF + m * 16) * ldc + col0;
#pragma unroll
                for (int bj = 0; bj < 2; ++bj) { *(f32x4*)(rowp + bj * HALF) = acc[ai][bj][m][0]; *(f32x4*)(rowp + bj * HALF + 4) = acc[ai][bj][m][1]; } }
    }
};

template <class Epi, class Sched, bool ALIGN_EPI = false, bool SP2 = false>
__device__ __forceinline__ void gemm_phase(PG8_LAS unsigned char* lds, const Gemm g, const Sched& S, const Epi& E) {
    int tid_ = threadIdx.x; asm volatile("" : "+v"(tid_));
    const int tid = tid_, wid = __builtin_amdgcn_readfirstlane(tid >> 6), lane = tid & 63, wr = wid >> 2, wc = wid & 3, fr = lane & 15, fq = lane >> 4;
    const int K = g.K, nt = K / BK, lda = g.lda ? g.lda : K, ldb = g.ldb ? g.ldb : K;
    unsigned voffA[2], voffB[2];
#pragma unroll
    for (int i = 0; i < 2; ++i) { int R, C; stage_rc(tid * 16 + i * 8192, R, C); const int Rb = Epi::PERM ? ((R & ~31) + perm32(R & 31)) : R;
        voffA[i] = (unsigned)(R * lda + C) * 2u; voffB[i] = (unsigned)(Rb * ldb + C) * 2u; }
    const size_t kstep = (size_t)(BK * 2);
    const size_t hstepA = (size_t)HALF * lda * 2, hstepB = (size_t)HALF * ldb * 2;
    const size_t tstepA = g.ksl ? (size_t)g.ksl : 2 * hstepA, tstepB = 2 * hstepB, bpm = (size_t)g.ksl;
    const unsigned ldsw = (unsigned)wid * 1024u;
    const int aoff = lds_byte(wr * 64 + fr, fq * 8), boff = lds_byte(wc * 32 + fr, fq * 8);
#define PG8_SA(b, h) (((b) * 2 + (h)) * HTB)
#define PG8_SB(b, h) ((4 + (b) * 2 + (h)) * HTB)
#define PG8_STAGE(bufoff, gbase, voff) do { _Pragma("unroll") for (int _i = 0; _i < 2; ++_i) \
        __builtin_amdgcn_global_load_lds((const unsigned*)((const char*)(gbase) + (voff)[_i]), (PG8_LAS unsigned*)(lds + (bufoff) + ldsw + _i * 8192), 16, 0, 0); } while (0)
#define PG8_LDA(dst, b, h) do { _Pragma("unroll") for (int m = 0; m < 4; ++m) _Pragma("unroll") for (int k = 0; k < 2; ++k) dst[m][k] = *(const PG8_LAS bf16x8*)(lds + PG8_SA(b, h) + aoff + m * 2048 + k * 1024); } while (0)
#define PG8_LDB(dst, b, h) do { _Pragma("unroll") for (int n = 0; n < 2; ++n) _Pragma("unroll") for (int k = 0; k < 2; ++k) dst[n][k] = *(const PG8_LAS bf16x8*)(lds + PG8_SB(b, h) + boff + n * 2048 + k * 1024); } while (0)
#define PG8_MMA(ai, bj, At, Bt) do { __builtin_amdgcn_s_setprio(1); _Pragma("unroll") for (int m = 0; m < 4; ++m) _Pragma("unroll") for (int n = 0; n < 2; ++n) _Pragma("unroll") for (int k = 0; k < 2; ++k) \
        acc[ai][bj][m][n] = __builtin_amdgcn_mfma_f32_16x16x32_bf16(Bt[n][k], At[m][k], acc[ai][bj][m][n], 0, 0, 0); __builtin_amdgcn_s_setprio(0); } while (0)
#define PG8_WAIT_V(n) asm volatile("s_waitcnt vmcnt(" #n ")" ::: "memory")
#define PG8_WAIT_L(n) asm volatile("s_waitcnt lgkmcnt(" #n ")" ::: "memory")
#define PG8_BAR __builtin_amdgcn_s_barrier()
#define PG8_SCHED __builtin_amdgcn_sched_barrier(0)
    Unit cur, nxt; int ui = 0;
    if (!S.next(0, cur)) return;
    f32x4 acc[2][2][4][2];
#pragma unroll
    for (int a = 0; a < 2; ++a)
#pragma unroll
        for (int b = 0; b < 2; ++b)
#pragma unroll
            for (int m = 0; m < 4; ++m)
#pragma unroll
                for (int n = 0; n < 2; ++n) acc[a][b][m][n] = (f32x4){0.f, 0.f, 0.f, 0.f};
    bf16x8 At[4][2], B0[2][2], B1[2][2];
    const char* cA = (const char*)g.A + (size_t)cur.pm * tstepA; const char* cB = (const char*)g.Bt + (size_t)cur.pn * tstepB + (size_t)cur.pm * bpm;
    S.a_ready(cur);
    if constexpr (SP2) {
        PG8_STAGE(PG8_SB(0, 0), cB, voffB); PG8_STAGE(PG8_SB(0, 1), cB + hstepB, voffB); PG8_STAGE(PG8_SA(0, 0), cA, voffA); PG8_STAGE(PG8_SA(0, 1), cA + hstepA, voffA);
        if (wr == 1) PG8_BAR;
        PG8_WAIT_V(2); PG8_BAR;
        PG8_STAGE(PG8_SB(1, 0), cB + kstep, voffB); PG8_STAGE(PG8_SA(1, 0), cA + kstep, voffA); PG8_STAGE(PG8_SB(1, 1), cB + hstepB + kstep, voffB);
        PG8_WAIT_V(6); PG8_BAR;
    } else {
        PG8_STAGE(PG8_SB(0, 0), cB, voffB); PG8_STAGE(PG8_SA(0, 0), cA, voffA); PG8_STAGE(PG8_SB(0, 1), cB + hstepB, voffB); PG8_STAGE(PG8_SA(0, 1), cA + hstepA, voffA);
        if (wr == 1) PG8_BAR;
        PG8_WAIT_V(4); PG8_BAR;
        PG8_STAGE(PG8_SB(1, 0), cB + kstep, voffB); PG8_STAGE(PG8_SA(1, 0), cA + kstep, voffA); PG8_STAGE(PG8_SB(1, 1), cB + hstepB + kstep, voffB);
        PG8_WAIT_V(6); PG8_BAR;
    }
    for (;;) {
        const bool has_next = S.next(ui + 1, nxt);
        const char* nA = has_next ? (const char*)g.A + (size_t)nxt.pm * tstepA : cA; const char* nB = has_next ? (const char*)g.Bt + (size_t)nxt.pn * tstepB + (size_t)nxt.pm * bpm : cB;
        for (int t = 0; t < nt; t += 2) {
            const bool last = (t == nt - 2);
            const char* a1 = cA + (size_t)(t + 1) * kstep;
            const char* a2 = last ? nA : cA + (size_t)(t + 2) * kstep; const char* b2 = last ? nB : cB + (size_t)(t + 2) * kstep;
            const char* a3 = a2 + kstep; const char* b3 = b2 + kstep;
            if (last && has_next) S.a_ready(nxt);
            if constexpr (SP2) {
            PG8_LDB(B0, 0, 0); PG8_LDB(B1, 0, 1); PG8_SCHED; PG8_LDA(At, 0, 0); PG8_STAGE(PG8_SA(1, 1), a1 + hstepA, voffA);
            PG8_WAIT_V(8); PG8_WAIT_L(0); PG8_BAR; PG8_MMA(0, 0, At, B0); PG8_MMA(0, 1, At, B1); PG8_BAR; PG8_SCHED;
            PG8_LDA(At, 0, 1); PG8_STAGE(PG8_SB(0, 0), b2, voffB); PG8_STAGE(PG8_SB(0, 1), b2 + hstepB, voffB); PG8_STAGE(PG8_SA(0, 0), a2, voffA);
            PG8_WAIT_V(8); PG8_WAIT_L(0); PG8_BAR; PG8_MMA(1, 0, At, B0); PG8_MMA(1, 1, At, B1); PG8_BAR; PG8_SCHED;
            PG8_LDB(B0, 1, 0); PG8_LDB(B1, 1, 1); PG8_SCHED; PG8_LDA(At, 1, 0); PG8_STAGE(PG8_SA(0, 1), a2 + hstepA, voffA);
            PG8_WAIT_V(8); PG8_WAIT_L(0); PG8_BAR; PG8_MMA(0, 0, At, B0); PG8_MMA(0, 1, At, B1); PG8_BAR; PG8_SCHED;
            PG8_LDA(At, 1, 1); PG8_STAGE(PG8_SB(1, 0), b3, voffB); PG8_STAGE(PG8_SB(1, 1), b3 + hstepB, voffB); PG8_STAGE(PG8_SA(1, 0), a3, voffA);
            PG8_WAIT_V(8); PG8_WAIT_L(0); PG8_BAR; PG8_MMA(1, 0, At, B0); PG8_MMA(1, 1, At, B1); PG8_BAR; PG8_SCHED;
            } else {
            PG8_LDB(B0, 0, 0); PG8_SCHED; PG8_LDA(At, 0, 0); PG8_STAGE(PG8_SA(1, 1), a1 + hstepA, voffA);
            PG8_WAIT_L(8); PG8_BAR; PG8_WAIT_L(0); PG8_MMA(0, 0, At, B0); PG8_BAR; PG8_SCHED;
            PG8_LDB(B1, 0, 1); PG8_STAGE(PG8_SB(0, 0), b2, voffB);
            PG8_BAR; PG8_WAIT_L(0); PG8_MMA(0, 1, At, B1); PG8_BAR;
            PG8_LDA(At, 0, 1); PG8_STAGE(PG8_SA(0, 0), a2, voffA);
            PG8_BAR; PG8_WAIT_L(0); PG8_MMA(1, 0, At, B0); PG8_BAR; PG8_SCHED;
            PG8_STAGE(PG8_SB(0, 1), b2 + hstepB, voffB);
            PG8_WAIT_V(6); PG8_BAR; PG8_MMA(1, 1, At, B1); PG8_BAR;
            PG8_LDB(B0, 1, 0); PG8_SCHED; PG8_LDA(At, 1, 0); PG8_STAGE(PG8_SA(0, 1), a2 + hstepA, voffA);
            PG8_WAIT_L(8); PG8_BAR; PG8_WAIT_L(0); PG8_MMA(0, 0, At, B0); PG8_BAR; PG8_SCHED;
            PG8_LDB(B1, 1, 1); PG8_STAGE(PG8_SB(1, 0), b3, voffB);
            PG8_BAR; PG8_WAIT_L(0); PG8_MMA(0, 1, At, B1); PG8_BAR;
            PG8_LDA(At, 1, 1); PG8_STAGE(PG8_SA(1, 0), a3, voffA);
            PG8_BAR; PG8_WAIT_L(0); PG8_MMA(1, 0, At, B0); PG8_BAR; PG8_SCHED;
            PG8_STAGE(PG8_SB(1, 1), b3 + hstepB, voffB);
            PG8_WAIT_V(6); PG8_BAR; PG8_MMA(1, 1, At, B1); PG8_BAR;
            }
        }
        if constexpr (ALIGN_EPI) { if (wr == 0) PG8_BAR; }
        if constexpr (!Epi::AFTER_DRAIN) { E(acc, cur, wr, wc, fr, fq); S.done(cur); }
        if (!has_next) break;
#pragma unroll
        for (int a = 0; a < 2; ++a)
#pragma unroll
            for (int b = 0; b < 2; ++b)
#pragma unroll
                for (int m = 0; m < 4; ++m)
#pragma unroll
                    for (int n = 0; n < 2; ++n) acc[a][b][m][n] = (f32x4){0.f, 0.f, 0.f, 0.f};
        cur = nxt; cA = nA; cB = nB; ++ui;
        if constexpr (ALIGN_EPI) { if (wr == 1) PG8_BAR; }
    }
    PG8_WAIT_V(0);
    if constexpr (!ALIGN_EPI) { if (wr == 0) PG8_BAR; }
    PG8_BAR;
    if constexpr (Epi::AFTER_DRAIN) { E.fused(acc, cur, wr, wc, fr, fq, lds, wid, lane); S.done(cur); }
#undef PG8_SA
#undef PG8_SB
#undef PG8_STAGE
#undef PG8_LDA
#undef PG8_LDB
#undef PG8_MMA
#undef PG8_WAIT_V
#undef PG8_WAIT_L
#undef PG8_BAR
#undef PG8_SCHED
}
}

namespace attn {
using bf16 = unsigned short;
constexpr int   D = 128, NW = 8, QBLK = 32, KVBLK = 64;
constexpr float SCALE = 0.088388347648318440f;
constexpr float THR = 8.f;
constexpr int SDEPTH = 2;
constexpr int LDQ = P0W, LDK = P0W, LDO = 2048;
constexpr size_t SHM_V = KVBLK * D * 2, SHM_K = KVBLK * D * 2, SHM_ATTN = 3 * SHM_V + 2 * SHM_K + NW * 64 * 4;
using bf16x8 = __attribute__((ext_vector_type(8))) short;
using s16x4  = __attribute__((ext_vector_type(4))) short;
using f32x16 = __attribute__((ext_vector_type(16))) float;
using f32x8  = __attribute__((ext_vector_type(8))) float;
using u32x4  = __attribute__((ext_vector_type(4))) unsigned;
#define KSWZ(row, colB) ((row) * 256 + ((colB) ^ (((row) & 7) << 4)))
#define SBAR() __builtin_amdgcn_sched_barrier(0)
__device__ __forceinline__ int crow(int r, int hi) { return (r & 3) + 8 * (r >> 2) + 4 * hi; }
__device__ __forceinline__ unsigned cvtpk(float lo, float hi) {
  unsigned r; asm volatile("v_cvt_pk_bf16_f32 %0, %1, %2" : "=v"(r) : "v"(lo), "v"(hi)); return r;
}
template <typename TIn> struct Stage;
template <> struct Stage<bf16>  { using T = bf16x8;
  __device__ static __forceinline__ T ld8(const bf16* p) { return *reinterpret_cast<const bf16x8*>(p); }
  __device__ static __forceinline__ bf16x8 tobf(T x) { return x; } };
template <> struct Stage<float> { using T = f32x8;
  __device__ static __forceinline__ T ld8(const float* p) { return *reinterpret_cast<const f32x8*>(p); }
  __device__ static __forceinline__ bf16x8 tobf(T x) {
    u32x4 w = {cvtpk(x[0], x[1]), cvtpk(x[2], x[3]), cvtpk(x[4], x[5]), cvtpk(x[6], x[7])}; return *reinterpret_cast<bf16x8*>(&w); } };

template <bool NOMAX> __device__ __forceinline__ void partialSM(f32x16& p0, f32x16& p1, float& m_reg, float& mn, float& alpha) {
  if constexpr (NOMAX) { for (int r = 0; r < 16; ++r) p0[r] = __builtin_amdgcn_exp2f(p0[r]); alpha = 1.f; return; }
  constexpr float C = SCALE * 1.4426950408889634f;
  float pmax = p0[0]; for (int r = 1; r < 16; ++r) pmax = fmaxf(pmax, p0[r]); for (int r = 0; r < 16; ++r) pmax = fmaxf(pmax, p1[r]);
  { auto rr = __builtin_amdgcn_permlane32_swap(__float_as_uint(pmax), __float_as_uint(pmax), false, false);
    pmax = fmaxf(__uint_as_float(rr[0]), __uint_as_float(rr[1])); }
  if (__builtin_expect(__all(pmax - m_reg <= THR / SCALE), 1)) { mn = m_reg; alpha = 1.f; }
  else { mn = fmaxf(m_reg, pmax); alpha = __builtin_amdgcn_exp2f((m_reg - mn) * C); m_reg = mn; }
  float mnC = -mn * C;
  for (int r = 0; r < 16; ++r) p0[r] = fmaf(p0[r], C, mnC); for (int r = 0; r < 16; ++r) p1[r] = fmaf(p1[r], C, mnC);
  for (int r = 0; r < 16; ++r) p0[r] = __builtin_amdgcn_exp2f(p0[r]);
}
__device__ __forceinline__ void finishSM(f32x16& p0, f32x16& p1, float alpha, float& l_reg, bf16x8& pa0, bf16x8& pa1, bf16x8& pa2, bf16x8& pa3) {
  for (int r = 0; r < 16; ++r) p1[r] = __builtin_amdgcn_exp2f(p1[r]);
  float ps = 0; for (int r = 0; r < 16; ++r) ps += p0[r]; for (int r = 0; r < 16; ++r) ps += p1[r];
  { auto rr = __builtin_amdgcn_permlane32_swap(__float_as_uint(ps), __float_as_uint(ps), false, false);
    ps = __uint_as_float(rr[0]) + __uint_as_float(rr[1]); }
  l_reg = l_reg * alpha + ps;
#define PK4(P, BASE, OUT) do { unsigned a0 = cvtpk(P[BASE + 0], P[BASE + 1]), a1 = cvtpk(P[BASE + 2], P[BASE + 3]);   \
    unsigned b0 = cvtpk(P[BASE + 4], P[BASE + 5]), b1 = cvtpk(P[BASE + 6], P[BASE + 7]);                              \
    auto r0 = __builtin_amdgcn_permlane32_swap(a0, b0, false, false); auto r1 = __builtin_amdgcn_permlane32_swap(a1, b1, false, false); \
    u32x4 w = {r0[0], r1[0], r0[1], r1[1]}; OUT = *reinterpret_cast<bf16x8*>(&w); } while (0)
  PK4(p0, 0, pa0); PK4(p0, 8, pa1); PK4(p1, 0, pa2); PK4(p1, 8, pa3);
#undef PK4
}
__device__ __forceinline__ void qkt(f32x16& p0, f32x16& p1, const bf16* Ks, const bf16x8* qr, int r32, int hi) {
  p0 = f32x16{}; p1 = f32x16{};
  for (int d0 = 0; d0 < 8; ++d0) { int cb = (d0 * 16 + hi * 8) * 2;
    bf16x8 b0 = *reinterpret_cast<const bf16x8*>((const char*)Ks + KSWZ(r32, cb));
    bf16x8 b1 = *reinterpret_cast<const bf16x8*>((const char*)Ks + KSWZ(32 + r32, cb));
    p0 = __builtin_amdgcn_mfma_f32_32x32x16_bf16(b0, qr[d0], p0, 0, 0, 0);
    p1 = __builtin_amdgcn_mfma_f32_32x32x16_bf16(b1, qr[d0], p1, 0, 0, 0); }
}
__device__ __forceinline__ int v_st(int k, int c) { const int kk = (k & ~0xC) | ((k & 4) << 1) | ((k & 8) >> 1); return ((kk >> 3) * 4 + (c >> 5)) * 512 + ((kk & 7) * 32 + (c & 31)) * 2; }
__device__ __forceinline__ int v_rd_base(int lane) { return ((lane & 3) << 3) | (((lane >> 2) & 3) << 6) | (((lane >> 4) & 1) << 5) | (((lane >> 5) & 1) << 8); }
constexpr int v_rd_off(int d0, int ks, int half) { return d0 * 512 + ks * 4096 + half * 2048; }
template <int OFF> __device__ __forceinline__ s16x4 tr_read(int vb) {
  s16x4 r; asm volatile("ds_read_b64_tr_b16 %0, %1 offset:%2" : "=&v"(r) : "v"(vb), "i"(OFF) : "memory"); return r;
}
template <int D0> __device__ __forceinline__ void pv_one(f32x16& od, int vb, bf16x8 pa0, bf16x8 pa1, bf16x8 pa2, bf16x8 pa3) {
  const s16x4 l0 = tr_read<v_rd_off(D0, 0, 0)>(vb), h0 = tr_read<v_rd_off(D0, 0, 1)>(vb), l1 = tr_read<v_rd_off(D0, 1, 0)>(vb), h1 = tr_read<v_rd_off(D0, 1, 1)>(vb);
  const s16x4 l2 = tr_read<v_rd_off(D0, 2, 0)>(vb), h2 = tr_read<v_rd_off(D0, 2, 1)>(vb), l3 = tr_read<v_rd_off(D0, 3, 0)>(vb), h3 = tr_read<v_rd_off(D0, 3, 1)>(vb);
  asm volatile("s_waitcnt lgkmcnt(0)" ::: "memory"); SBAR();
#define PK(L, H) (bf16x8){L[0], L[1], L[2], L[3], H[0], H[1], H[2], H[3]}
  od = __builtin_amdgcn_mfma_f32_32x32x16_bf16(pa0, PK(l0, h0), od, 0, 0, 0);
  od = __builtin_amdgcn_mfma_f32_32x32x16_bf16(pa1, PK(l1, h1), od, 0, 0, 0);
  od = __builtin_amdgcn_mfma_f32_32x32x16_bf16(pa2, PK(l2, h2), od, 0, 0, 0);
  od = __builtin_amdgcn_mfma_f32_32x32x16_bf16(pa3, PK(l3, h3), od, 0, 0, 0);
#undef PK
}
__device__ __forceinline__ void pv_d0(f32x16* o, int vb, bf16x8 pa0, bf16x8 pa1, bf16x8 pa2, bf16x8 pa3) {
  pv_one<0>(o[0], vb, pa0, pa1, pa2, pa3); pv_one<1>(o[1], vb, pa0, pa1, pa2, pa3); pv_one<2>(o[2], vb, pa0, pa1, pa2, pa3); pv_one<3>(o[3], vb, pa0, pa1, pa2, pa3);
}

template <typename TQ, bool NOMAX>
__device__ __forceinline__ void attn_dense_body(const TQ* __restrict__ Qb, const bf16* __restrict__ Kh, const bf16* __restrict__ Vh,
                                                bf16* __restrict__ Ob, int seq, char* lds) {
  using St = Stage<bf16>; using SQ = Stage<TQ>;
  int tid_ = threadIdx.x; asm volatile("" : "+v"(tid_));
  const int tid = tid_, wid = tid >> 6, lane = tid & 63, r32 = lane & 31, hi = lane >> 5;
  bf16* V_lds = (bf16*)lds; bf16* K_lds = (bf16*)(lds + 3 * SHM_V);
  float* ws = (float*)(lds + 3 * SHM_V + 2 * SHM_K) + wid * 64; float* li_l = ws; float* al_l = ws + 32;
  float m_reg = -1e30f, l_reg = 0; f32x16 o[4] = {}; bf16x8 qr[8];
  const TQ* Qw = Qb + (long)(wid * QBLK + r32) * LDQ + hi * 8;
#pragma unroll
  for (int d0 = 0; d0 < 8; ++d0) { qr[d0] = SQ::tobf(SQ::ld8(Qw + d0 * 16));
    if constexpr (NOMAX) { constexpr float C = SCALE * 1.4426950408889634f; u32x4 w = *reinterpret_cast<u32x4*>(&qr[d0]);
      for (int i = 0; i < 4; ++i) w[i] = cvtpk(__uint_as_float(w[i] << 16) * C, __uint_as_float(w[i] & 0xffff0000u) * C);
      qr[d0] = *reinterpret_cast<bf16x8*>(&w); } }
  const int sr = tid >> 4, sc = (tid & 15) * 8, vst0 = v_st(sr, sc), vst1 = v_st(32 + sr, sc);
  const int vb0 = (int)(uintptr_t)V_lds + v_rd_base(lane);
  struct { typename St::T vs0, vs1, ks0, ks1; } sr_[SDEPTH];
#define SLOAD(i, k0) do { sr_[i].vs0 = St::ld8(&Vh[(long)((k0) + sr) * LDK + sc]); sr_[i].vs1 = St::ld8(&Vh[(long)((k0) + 32 + sr) * LDK + sc]); \
    sr_[i].ks0 = St::ld8(&Kh[(long)((k0) + sr) * LDK + sc]); sr_[i].ks1 = St::ld8(&Kh[(long)((k0) + 32 + sr) * LDK + sc]); } while (0)
#define SWRITE(b, voff, i) do { *(bf16x8*)((char*)V_lds + (voff) + vst0) = St::tobf(sr_[i].vs0);          \
    *(bf16x8*)((char*)V_lds + (voff) + vst1) = St::tobf(sr_[i].vs1); int kc = sc * 2;               \
    *(bf16x8*)((char*)K_lds + (b) * SHM_K + KSWZ(sr, kc)) = St::tobf(sr_[i].ks0);                       \
    *(bf16x8*)((char*)K_lds + (b) * SHM_K + KSWZ(32 + sr, kc)) = St::tobf(sr_[i].ks1); } while (0)
#define SWAIT() do { if constexpr (SDEPTH == 2) asm volatile("s_waitcnt vmcnt(4)" ::: "memory"); else asm volatile("s_waitcnt vmcnt(0)" ::: "memory"); } while (0)
#define RESC(a) do { if (!NOMAX && __any((a) < 1.f)) { if (hi == 0) al_l[r32] = (a); asm volatile("s_waitcnt lgkmcnt(0)" ::: "memory"); \
    for (int d = 0; d < 4; ++d) for (int r = 0; r < 16; ++r) o[d][r] *= al_l[crow(r, hi)]; } } while (0)
  f32x16 pA0, pA1, pB0, pB1; float mnA, mnB, alA, alB; bf16x8 pa0, pa1, pa2, pa3; const int NT = seq / KVBLK;
  constexpr int SE = 0, SO = SDEPTH - 1;
  SLOAD(SE, 0); asm volatile("s_waitcnt vmcnt(0)" ::: "memory"); SWRITE(0, 0, SE); __syncthreads();
  qkt(pA0, pA1, K_lds, qr, r32, hi); partialSM<NOMAX>(pA0, pA1, m_reg, mnA, alA);
  SLOAD(SO, KVBLK); if constexpr (SDEPTH == 2) { if (2 < NT) SLOAD(SE, 2 * KVBLK); }
  SWAIT(); SWRITE(1, (int)SHM_V, SO); __syncthreads();
  int vr = 0, vw = 2 * (int)SHM_V;
#define VNEXT(x) ((x) == 2 * (int)SHM_V ? 0 : (x) + (int)SHM_V)
  for (int j = 1; j + 1 < NT; j += 2) {
    SBAR(); qkt(pB0, pB1, (bf16*)((char*)K_lds + SHM_K), qr, r32, hi);
    finishSM(pA0, pA1, alA, l_reg, pa0, pa1, pa2, pa3); SBAR();
    SLOAD(SO, (j + SDEPTH) * KVBLK); SBAR();
    pv_d0(o, vb0 + vr, pa0, pa1, pa2, pa3); partialSM<NOMAX>(pB0, pB1, m_reg, mnB, alB);
    SWAIT(); SWRITE(0, vw, SE); vr = VNEXT(vr); vw = VNEXT(vw);
    RESC(alB); __syncthreads();
    SBAR(); qkt(pA0, pA1, K_lds, qr, r32, hi);
    finishSM(pB0, pB1, alB, l_reg, pa0, pa1, pa2, pa3); SBAR();
    if (SDEPTH == 1 || j + 3 < NT) SLOAD(SE, (j + 1 + SDEPTH) * KVBLK); SBAR();
    pv_d0(o, vb0 + vr, pa0, pa1, pa2, pa3); partialSM<NOMAX>(pA0, pA1, m_reg, mnA, alA);
    SWAIT(); SWRITE(1, vw, SO); vr = VNEXT(vr); vw = VNEXT(vw);
    RESC(alA); __syncthreads();
  }
  SBAR(); qkt(pB0, pB1, (bf16*)((char*)K_lds + SHM_K), qr, r32, hi);
  finishSM(pA0, pA1, alA, l_reg, pa0, pa1, pa2, pa3); SBAR();
  pv_d0(o, vb0 + vr, pa0, pa1, pa2, pa3); partialSM<NOMAX>(pB0, pB1, m_reg, mnB, alB);
  vr = VNEXT(vr); RESC(alB);
  finishSM(pB0, pB1, alB, l_reg, pa0, pa1, pa2, pa3); SBAR();
  pv_d0(o, vb0 + vr, pa0, pa1, pa2, pa3);
#undef VNEXT
  if (hi == 0) li_l[r32] = l_reg; asm volatile("s_waitcnt lgkmcnt(0)" ::: "memory");
  float rli[16];
#pragma unroll
  for (int r = 0; r < 16; ++r) rli[r] = __builtin_amdgcn_rcpf(li_l[crow(r, hi)]);
  bf16* Ow = Ob + (long)(wid * QBLK) * LDO;
#pragma unroll
  for (int r = 0; r < 16; ++r) { int orow = crow(r, hi);
    for (int d0 = 0; d0 < 4; ++d0) Ow[(long)orow * LDO + d0 * 32 + r32] = (bf16)(cvtpk(o[d0][r] * rli[r], 0.f) & 0xffffu); }
#undef SLOAD
#undef SWRITE
#undef SWAIT
#undef RESC
}
#undef KSWZ
#undef SBAR
}

namespace rw {
typedef short bf16x8 __attribute__((ext_vector_type(8)));
typedef float f32x4 __attribute__((ext_vector_type(4)));
typedef unsigned u32x4 __attribute__((ext_vector_type(4)));
typedef unsigned u32x2 __attribute__((ext_vector_type(2)));
constexpr int CH = 32, NC = R / CH;
static_assert(NC % 2 == 0, "the prep loop is unrolled by two");
constexpr int BUFB = 5 * 8192 + 1024;
constexpr int O_W = 0, O_B = 8192, O_KD = 16384, O_A = 24576, O_R = 32768, O_V = 40960;
constexpr int PITCH = 72;
constexpr int L_SCR = 2 * BUFB, SCRB = 2 * 16 * PITCH * 2;
constexpr int L_W2T = L_SCR + 4 * SCRB, L_A2T = L_W2T + 64 * PITCH * 2;
constexpr int L_Y = L_A2T + 64 * PITCH * 2;
constexpr int L_CST = L_Y + 2 * 2 * CH * 64 * 4;
constexpr int L_END = L_CST + 10 * 64 * 4;
static_assert(L_END <= 163840 - 64 && (BUFB % 16) == 0 && (L_SCR % 16) == 0 && (SCRB % 16) == 0 && (L_W2T % 16) == 0 && (L_A2T % 16) == 0 && (L_Y % 16) == 0 && (L_CST % 16) == 0, "rwkv LDS map");
constexpr size_t WS_BON = 38 * MiB;

template <int CTRL> __device__ __forceinline__ float dppmov(float x) { return __builtin_bit_cast(float, __builtin_amdgcn_update_dpp(0, __builtin_bit_cast(int, x), CTRL, 0xF, 0xF, true)); }
__device__ __forceinline__ float allreduce8(float x) {
    x += dppmov<0xB1>(x);
    x += dppmov<0x4E>(x);
    x += dppmov<0x141>(x);
    return x;
}
__device__ __forceinline__ float allreduce16(float x) { x = allreduce8(x); x += dppmov<0x140>(x); return x; }
__device__ __forceinline__ float fast_tanh(float x) { const float e = __builtin_amdgcn_exp2f(2.885390081777927f * x); return 1.0f - 2.0f * __builtin_amdgcn_rcpf(1.0f + e); }
__device__ __forceinline__ float bflo(unsigned u) { return __uint_as_float(u << 16); }
__device__ __forceinline__ float bfhi(unsigned u) { return __uint_as_float(u & 0xffff0000u); }
__device__ __forceinline__ unsigned pkbf(float lo, float hi) { unsigned r; asm volatile("v_cvt_pk_bf16_f32 %0, %1, %2" : "=v"(r) : "v"(lo), "v"(hi)); return r; }

constexpr int SEGR = 128, NSEG = R / SEGR, NCG = (ZW + 511) / 512;
constexpr size_t WS_HALO = 40 * MiB;
static_assert(WS_HALO + (size_t)NSEG * 2 * ZW * 2 <= WS_XN, "halo rows overflow");
__device__ __forceinline__ void shift_halo(const Params& p) {
    int tid_ = threadIdx.x; asm volatile("" : "+v"(tid_));
    const bf16_t* Z = ws_big(p); bf16_t* H = (bf16_t*)(p.ws + WS_HALO);
    for (int it = (int)blockIdx.x * NTHR + tid_; it < NSEG * 2 * (ZW / 8); it += (int)gridDim.x * NTHR) {
        const int c8 = it % (ZW / 8), w = (it / (ZW / 8)) & 1, seg = it / (2 * (ZW / 8));
        *(u32x4*)(H + ((size_t)seg * 2 + w) * ZW + c8 * 8) = *(const u32x4*)(Z + (size_t)(seg * SEGR + (w ? SEGR - 1 : 0)) * ZW + c8 * 8);
    }
}
__device__ __forceinline__ u32x4 shift8(u32x4 c, u32x4 pv, u32x4 nx, f32x4 m0, f32x4 m1) {
    u32x4 o;
#pragma unroll
    for (int q = 0; q < 4; ++q) { const float ml = q < 2 ? m0[2 * q] : m1[2 * q - 4], mh = q < 2 ? m0[2 * q + 1] : m1[2 * q - 3];
        const float zl = bflo(c[q]), zh = bfhi(c[q]);
        o[q] = pkbf(zl + (0.5f * (bflo(pv[q]) + bflo(nx[q])) - zl) * ml, zh + (0.5f * (bfhi(pv[q]) + bfhi(nx[q])) - zh) * mh); }
    return o;
}
__device__ __forceinline__ void shift_inplace(const Params& p) {
    int tid_ = threadIdx.x; asm volatile("" : "+v"(tid_));
    const int lane = tid_ & 63, gw = (int)blockIdx.x * NWAVES + (tid_ >> 6), ngw = (int)gridDim.x * NWAVES;
    bf16_t* Z = ws_big(p); const bf16_t* H = (const bf16_t*)(p.ws + WS_HALO);
    for (int u = gw; u < NSEG * NCG; u += ngw) {
        const int seg = u / NCG, col = (u % NCG) * 512 + lane * 8;
        if (col < ZW) {
            const f32x4 m0 = *(const f32x4*)(p.mu + col), m1 = *(const f32x4*)(p.mu + col + 4);
            const bool first = seg == 0 || seg == CTXN / SEGR, last = seg == CTXN / SEGR - 1 || seg == NSEG - 1;
            bf16_t* zr = Z + (size_t)seg * SEGR * ZW + col;
            u32x4 pv = first ? (u32x4){0u, 0u, 0u, 0u} : *(const u32x4*)(H + ((size_t)(seg - 1) * 2 + 1) * ZW + col);
            const u32x4 tail = last ? (u32x4){0u, 0u, 0u, 0u} : *(const u32x4*)(H + ((size_t)(seg + 1) * 2) * ZW + col);
            u32x4 c0 = *(const u32x4*)zr, c1 = *(const u32x4*)(zr + ZW), c2 = *(const u32x4*)(zr + 2 * ZW), c3 = *(const u32x4*)(zr + 3 * ZW);
            for (int r = 0; r < SEGR; r += 4) {
                u32x4 n0 = tail, n1 = tail, n2 = tail, n3 = tail;
                if (r + 4 < SEGR) { n0 = *(const u32x4*)(zr + (size_t)(r + 4) * ZW); n1 = *(const u32x4*)(zr + (size_t)(r + 5) * ZW); n2 = *(const u32x4*)(zr + (size_t)(r + 6) * ZW); n3 = *(const u32x4*)(zr + (size_t)(r + 7) * ZW); }
                const u32x4 o0 = shift8(c0, pv, c1, m0, m1), o1 = shift8(c1, c0, c2, m0, m1), o2 = shift8(c2, c1, c3, m0, m1), o3 = shift8(c3, c2, n0, m0, m1);
                *(u32x4*)(zr + (size_t)r * ZW) = o0; *(u32x4*)(zr + (size_t)(r + 1) * ZW) = o1; *(u32x4*)(zr + (size_t)(r + 2) * ZW) = o2; *(u32x4*)(zr + (size_t)(r + 3) * ZW) = o3;
                pv = c3; c0 = n0; c1 = n1; c2 = n2; c3 = n3;
            }
        }
    }
}

struct Raw { u32x4 c[5]; };

template <int MODE> __device__ __forceinline__ void scan_block(const Params& p, int blk, LAS unsigned char* lds) {
    int tid_ = threadIdx.x; asm volatile("" : "+v"(tid_));
    const int tid = tid_, lane = tid & 63, wave = __builtin_amdgcn_readfirstlane(tid >> 6);
    const int dir = blk >> 7, h = (blk >> 3) & 15, eighth = blk & 7;
    const float* w0 = dir ? p.w0b : p.w0f; const float* w2 = dir ? p.w2b : p.w2f; const float* a0 = dir ? p.a0b : p.a0f; const float* a2 = dir ? p.a2b : p.a2f;
    const bf16_t* Z = ws_big(p); bf16_t* BR = ws_br(p); float* bon = (float*)(p.ws + WS_BON) + ((size_t)dir * 16 + h) * SEQ;
    { const int m = tid >> 3, j8 = (tid & 7) * 8;
      const f32x4 wa = *(const f32x4*)(w2 + (size_t)m * 1024 + h * 64 + j8), wb = *(const f32x4*)(w2 + (size_t)m * 1024 + h * 64 + j8 + 4);
      const f32x4 aa = *(const f32x4*)(a2 + (size_t)m * 1024 + h * 64 + j8), ab = *(const f32x4*)(a2 + (size_t)m * 1024 + h * 64 + j8 + 4);
      LAS bf16_t* yw = (LAS bf16_t*)(lds + L_W2T); LAS bf16_t* ya = (LAS bf16_t*)(lds + L_A2T);
#pragma unroll
      for (int q = 0; q < 4; ++q) { yw[(j8 + q) * PITCH + m] = f2bf(wa[q]); yw[(j8 + 4 + q) * PITCH + m] = f2bf(wb[q]); ya[(j8 + q) * PITCH + m] = f2bf(aa[q]); ya[(j8 + 4 + q) * PITCH + m] = f2bf(ab[q]); }
      for (int i = tid; i < 4 * SCRB / 4; i += NTHR) *(LAS unsigned*)(lds + L_SCR + i * 4) = 0u;
      for (int i = tid; i < 640; i += NTHR) { const int g = i >> 6, cc = i & 63, hc = h * 64 + cc; float v;
          if (g < 3) v = p.mu[g * 1024 + hc]; else if (g == 3) v = p.mu[3072 + dir * 64 + cc]; else if (g == 4) v = p.mu[3200 + dir * 64 + cc];
          else if (g == 5) v = w0[hc]; else if (g == 6) v = a0[hc]; else if (g == 7) v = p.k_k[hc]; else if (g == 8) v = p.k_a[hc]; else v = p.r_k[hc];
          *(LAS float*)(lds + L_CST + i * 4) = v; } }
    __syncthreads();
    if ((wave & 2) != 0) {
        const int pw = (wave & 1) + ((wave >> 2) << 1), tq = lane >> 3, c8 = (lane & 7) * 8, hj = h * 64 + c8, tslot = pw * 8 + tq;
        const int gcol[5] = {hj, 1024 + hj, 2048 + hj, 3072 + dir * 64 + c8, 3200 + dir * 64 + c8};
        LAS unsigned char* scr = lds + L_SCR + pw * SCRB;
#define RW_CST(g, hh) (*(LAS f32x4*)(lds + L_CST + ((g) * 64 + c8 + 4 * (hh)) * 4))
#define RW_LOADRAW(raw, cc) do { const bf16_t* zr_ = Z + (size_t)rw_row(dir, (cc) * CH + tslot) * ZW; \
            _Pragma("unroll") for (int g = 0; g < 5; ++g) raw.c[g] = *(const u32x4*)(zr_ + gcol[g]); } while (0)
        Raw rawA, rawB;
        f32x4 cw0[2], ca0[2], ckk[2], cka[2], crk[2];
#pragma unroll
        for (int hh = 0; hh < 2; ++hh) { cw0[hh] = RW_CST(5, hh); ca0[hh] = RW_CST(6, hh); ckk[hh] = RW_CST(7, hh); cka[hh] = RW_CST(8, hh); crk[hh] = RW_CST(9, hh);
            asm volatile("" : "+v"(cw0[hh]), "+v"(ca0[hh]), "+v"(ckk[hh]), "+v"(cka[hh]), "+v"(crk[hh])); }
        if (MODE == 0 || MODE == 2 || MODE == 3 || MODE == 9) { RW_LOADRAW(rawA, 0); RW_LOADRAW(rawB, 1); }
#define RW_PREP_ITER(RAWSET, cc_) do { \
            if (MODE == 0 || MODE == 2 || MODE == 3 || MODE == 9) { \
            const int cn = (cc_) + 1; LAS unsigned char* buf = lds + (cn & 1) * BUFB; const int p0 = cn * CH; const bool latent = p0 >= CTXN; \
            f32x4 rr[2], kv[2]; \
            { const u32x4 u = RAWSET.c[0]; rr[0] = (f32x4){bflo(u.x), bfhi(u.x), bflo(u.y), bfhi(u.y)}; rr[1] = (f32x4){bflo(u.z), bfhi(u.z), bflo(u.w), bfhi(u.w)}; \
              *(LAS f32x4*)(buf + O_R + (tslot * 64 + c8) * 4) = rr[0]; *(LAS f32x4*)(buf + O_R + (tslot * 64 + c8) * 4 + 16) = rr[1]; } \
            { const u32x4 u = RAWSET.c[1]; kv[0] = (f32x4){bflo(u.x), bfhi(u.x), bflo(u.y), bfhi(u.y)}; kv[1] = (f32x4){bflo(u.z), bfhi(u.z), bflo(u.w), bfhi(u.w)}; } \
            if ((lane & 7) == eighth) { const u32x4 u = RAWSET.c[2]; *(LAS f32x4*)(buf + O_V + tslot * 32) = (f32x4){bflo(u.x), bfhi(u.x), bflo(u.y), bfhi(u.y)}; *(LAS f32x4*)(buf + O_V + tslot * 32 + 16) = (f32x4){bflo(u.z), bfhi(u.z), bflo(u.w), bfhi(u.w)}; } \
            { const u32x4 u = RAWSET.c[3]; u32x4 o; \
              o.x = pkbf(fast_tanh(bflo(u.x)), fast_tanh(bfhi(u.x))); o.y = pkbf(fast_tanh(bflo(u.y)), fast_tanh(bfhi(u.y))); o.z = pkbf(fast_tanh(bflo(u.z)), fast_tanh(bfhi(u.z))); o.w = pkbf(fast_tanh(bflo(u.w)), fast_tanh(bfhi(u.w))); \
              *(LAS u32x4*)(scr + (tq * PITCH + c8) * 2) = o; *(LAS u32x4*)(scr + 16 * PITCH * 2 + (tq * PITCH + c8) * 2) = RAWSET.c[4]; } \
            if (cn + 2 < NC) RW_LOADRAW(RAWSET, cn + 2);              \
            asm volatile("s_waitcnt lgkmcnt(0)" ::: "memory"); \
            { const int r16 = lane & 15, quad = lane >> 4; f32x4 acc[2][4]; \
_Pragma("unroll") \
              for (int lora = 0; lora < 2; ++lora) { \
                  LAS unsigned char* X = scr + lora * 16 * PITCH * 2 + (r16 * PITCH + quad * 8) * 2; \
                  const bf16x8 x0 = *(LAS bf16x8*)X, x1 = *(LAS bf16x8*)(X + 64); \
_Pragma("unroll") \
                  for (int jt = 0; jt < 4; ++jt) { \
                      LAS unsigned char* Y = lds + (lora ? L_A2T : L_W2T) + ((jt * 16 + r16) * PITCH + quad * 8) * 2; \
                      acc[lora][jt] = (f32x4){0.f, 0.f, 0.f, 0.f}; \
                      acc[lora][jt] = __builtin_amdgcn_mfma_f32_16x16x32_bf16(x0, *(LAS bf16x8*)Y, acc[lora][jt], 0, 0, 0); \
                      acc[lora][jt] = __builtin_amdgcn_mfma_f32_16x16x32_bf16(x1, *(LAS bf16x8*)(Y + 64), acc[lora][jt], 0, 0, 0); } } \
              if (quad < 2) { \
_Pragma("unroll") \
                  for (int lora = 0; lora < 2; ++lora) \
_Pragma("unroll") \
                      for (int jt = 0; jt < 4; ++jt) \
_Pragma("unroll") \
                          for (int r = 0; r < 4; ++r) *(LAS float*)(buf + (lora ? O_B : O_W) + ((pw * 8 + quad * 4 + r) * 64 + jt * 16 + r16) * 4) = acc[lora][jt][r]; } } \
            asm volatile("s_waitcnt lgkmcnt(0)" ::: "memory"); \
            { float bs = 0.f, nn = 0.f; f32x4 kk[2], al[2]; \
_Pragma("unroll") \
              for (int hh = 0; hh < 2; ++hh) { const int off = (tslot * 64 + c8 + 4 * hh) * 4; \
                  const f32x4 aw = *(LAS f32x4*)(buf + O_W + off) + cw0[hh], aa = *(LAS f32x4*)(buf + O_B + off) + ca0[hh]; \
                  f32x4 wv; \
_Pragma("unroll") \
                  for (int q = 0; q < 4; ++q) { const float sg = __builtin_amdgcn_rcpf(1.0f + __builtin_amdgcn_exp2f(-1.4426950408889634f * aw[q])); \
                      wv[q] = __builtin_amdgcn_exp2f(-0.8750612633917f * sg); al[hh][q] = __builtin_amdgcn_rcpf(1.0f + __builtin_amdgcn_exp2f(-1.4426950408889634f * aa[q])); kk[hh][q] = kv[hh][q] * ckk[hh][q]; nn += kk[hh][q] * kk[hh][q]; } \
                  *(LAS f32x4*)(buf + O_W + off) = wv; } \
              nn = allreduce8(nn); \
              const float inv = __builtin_amdgcn_rsqf(fmaxf(nn, 1e-24f)); \
_Pragma("unroll") \
              for (int hh = 0; hh < 2; ++hh) { const int off = (tslot * 64 + c8 + 4 * hh) * 4; \
                  const f32x4 r = rr[hh]; \
                  f32x4 av, bv, kd; \
_Pragma("unroll") \
                  for (int q = 0; q < 4; ++q) { const float kn = kk[hh][q] * inv; av[q] = -kn; bv[q] = kn * al[hh][q]; kd[q] = kv[hh][q] * (1.0f + (al[hh][q] - 1.0f) * cka[hh][q]); bs += r[q] * kd[q] * crk[hh][q]; } \
                  *(LAS f32x4*)(buf + O_B + off) = bv; *(LAS f32x4*)(buf + O_KD + off) = kd; *(LAS f32x4*)(buf + O_A + off) = av; } \
              bs = allreduce8(bs); \
              if (MODE == 0 && latent && eighth == 0 && (lane & 7) == 0) bon[rw_row(dir, p0 + tslot) - CTXN] = bs; } \
            } \
            __syncthreads(); \
        } while (0)
        for (int c = -1; c < NC - 1; c += 2) { RW_PREP_ITER(rawA, c); RW_PREP_ITER(rawB, c + 1); }
#undef RW_PREP_ITER
#undef RW_LOADRAW
#undef RW_CST
    } else if (wave >= 4) {
        const int sw = wave - 4, et = lane >> 1, erp = lane & 1;
#define RW_EMIT(cc) do { if ((cc) * CH >= CTXN) { const LAS f32x4* yp = (const LAS f32x4*)(lds + L_Y + ((((cc) & 1) * 2 + sw) * 8192) + et * 256 + erp * 128); \
            f32x4 s0 = yp[0] + yp[1] + yp[2] + yp[3], s1 = yp[4] + yp[5] + yp[6] + yp[7]; \
            *(unsigned*)(BR + (size_t)rw_row(dir, (cc) * CH + et) * 2048 + dir * 1024 + h * 64 + eighth * 8 + sw * 4 + erp * 2) = pkbf((s0[0] + s0[1]) + (s0[2] + s0[3]), (s1[0] + s1[1]) + (s1[2] + s1[3])); } } while (0)
        __syncthreads();
        for (int c = 0; c < NC; ++c) { if (c >= 1) RW_EMIT(c - 1); if (c + 1 < NC) __syncthreads(); }
    } else {
        __builtin_amdgcn_s_setprio(0);
        typedef float f32x2 __attribute__((ext_vector_type(2)));
        f32x2 S01 = {0.f, 0.f}, S23 = {0.f, 0.f};
        const int srow = wave * 4 + (lane >> 4), sj = (lane & 15) * 4;
        __syncthreads();
        struct Ops { f32x4 a, w, b, k, r; float v; };
#define RW_LD(o, t) do { o.a = *(LAS f32x4*)(bp + O_A + (t) * 256); \
            if (MODE == 9) { o.w = o.a; o.b = o.a; o.k = o.a; o.r = o.a; o.v = o.a[0]; } else { o.w = *(LAS f32x4*)(bp + O_W + (t) * 256); o.b = *(LAS f32x4*)(bp + O_B + (t) * 256); \
            o.k = *(LAS f32x4*)(bp + O_KD + (t) * 256); o.r = *(LAS f32x4*)(bp + O_R + (t) * 256); o.v = *(LAS float*)(vp + (t) * 32); } } while (0)
#define RW_STEP(o, t) do { f32x2 pd = S01 * o.a.lo; pd = S23 * o.a.hi + pd; float sa = pd.x + pd.y; if (MODE != 5 && MODE != 7) sa = allreduce16(sa); \
            S01 = o.b.lo * sa + (S01 * o.w.lo + o.k.lo * o.v); S23 = o.b.hi * sa + (S23 * o.w.hi + o.k.hi * o.v); \
            { f32x2 py = S01 * o.r.lo; py = S23 * o.r.hi + py; *(LAS float*)(yb + (t) * 256) = py.x + py.y; } } while (0)
        for (int c = 0; c < NC; ++c) {
            LAS unsigned char* bp = lds + (c & 1) * BUFB + sj * 4; LAS unsigned char* vp = lds + (c & 1) * BUFB + O_V + srow * 4; LAS unsigned char* yb = lds + L_Y + ((c & 1) * 2 + wave) * 8192 + lane * 4;
            Ops A0, A1, A2, A3, B0, B1, B2, B3;
            if (MODE != 2) {
            RW_LD(A0, 0); RW_LD(A1, 1); RW_LD(A2, 2); RW_LD(A3, 3);
#pragma unroll
            for (int g = 0; g < CH / 8; ++g) {
                RW_LD(B0, 8 * g + 4); RW_LD(B1, 8 * g + 5); RW_LD(B2, 8 * g + 6); RW_LD(B3, 8 * g + 7);
                __builtin_amdgcn_sched_barrier(0);
                RW_STEP(A0, 8 * g); RW_STEP(A1, 8 * g + 1); RW_STEP(A2, 8 * g + 2); RW_STEP(A3, 8 * g + 3);
                __builtin_amdgcn_sched_barrier(0);
                if (g + 1 < CH / 8) { RW_LD(A0, 8 * g + 8); RW_LD(A1, 8 * g + 9); RW_LD(A2, 8 * g + 10); RW_LD(A3, 8 * g + 11); }
                __builtin_amdgcn_sched_barrier(0);
                RW_STEP(B0, 8 * g + 4); RW_STEP(B1, 8 * g + 5); RW_STEP(B2, 8 * g + 6); RW_STEP(B3, 8 * g + 7);
                __builtin_amdgcn_sched_barrier(0);
            }
            }
            if (c + 1 < NC) __syncthreads();
        }
#undef RW_LD
#undef RW_STEP
        if (MODE != 0) asm volatile("" :: "v"(S01), "v"(S23));
        __builtin_amdgcn_s_setprio(0);
    }
    __syncthreads();
    if (wave == 4 || wave == 5) { const int sw = wave - 4, et = lane >> 1, erp = lane & 1; RW_EMIT(NC - 1); }
#undef RW_EMIT
    __syncthreads();
}

__device__ __forceinline__ float wave_sum(float v) {
    v = allreduce16(v);
    { auto r = __builtin_amdgcn_permlane16_swap(__float_as_uint(v), __float_as_uint(v), false, false); v = __uint_as_float(r[0]) + __uint_as_float(r[1]); }
    { auto r = __builtin_amdgcn_permlane32_swap(__float_as_uint(v), __float_as_uint(v), false, false); v = __uint_as_float(r[0]) + __uint_as_float(r[1]); }
    return v;
}
__device__ __forceinline__ void finish_phase(const Params& p) {
    int tid_ = threadIdx.x; asm volatile("" : "+v"(tid_));
    const int lane = tid_ & 63, gw = (int)blockIdx.x * NWAVES + (tid_ >> 6), ngw = (int)gridDim.x * NWAVES;
    const bf16_t* Z = ws_big(p); bf16_t* BR = ws_br(p); const float* bon = (const float*)(p.ws + WS_BON);
    for (int it = gw; it < SEQ * 4; it += ngw) {
        const int t = it >> 2, h = (it & 3) * 4 + (lane >> 4), row = CTXN + t, col = h * 64 + (lane & 15) * 4;
        bf16_t* b = BR + (size_t)row * 2048;
        const u32x2 wf = *(const u32x2*)(b + col), wb = *(const u32x2*)(b + 1024 + col), zv = *(const u32x2*)(Z + (size_t)row * ZW + 2048 + col);
        const f32x4 x = {bflo(wf.x) + bflo(wb.x), bfhi(wf.x) + bfhi(wb.x), bflo(wf.y) + bflo(wb.y), bfhi(wf.y) + bfhi(wb.y)};
        const float mean = allreduce16((x[0] + x[1]) + (x[2] + x[3])) * (1.0f / 64.f);
        const f32x4 d = x - mean;
        const float var = allreduce16((d[0] * d[0] + d[1] * d[1]) + (d[2] * d[2] + d[3] * d[3])) * (1.0f / 64.f);
        const float rstd = __builtin_amdgcn_rsqf(var + GN_EPS), bsum = bon[(size_t)h * SEQ + t] + bon[((size_t)16 + h) * SEQ + t];
        const f32x4 g = *(const f32x4*)(p.lnx_g + col), bb = *(const f32x4*)(p.lnx_b + col), v = {bflo(zv.x), bfhi(zv.x), bflo(zv.y), bfhi(zv.y)};
        const f32x4 y = d * rstd * g + bb + v * bsum;
        u32x2 o; o.x = pkbf(y[0], y[1]); o.y = pkbf(y[2], y[3]);
        *(u32x2*)(b + 1024 + col) = o;
    }
}
}

namespace wy {
typedef short bf16x4 __attribute__((ext_vector_type(4)));
using rw::f32x4; using rw::u32x4; using rw::u32x2; using rw::bf16x8; using rw::bflo; using rw::bfhi; using rw::PITCH;
typedef float f32x2_t __attribute__((ext_vector_type(2)));
typedef __bf16 bf2_t __attribute__((ext_vector_type(2)));
__device__ __forceinline__ unsigned pkbf(float lo, float hi) { const f32x2_t v = {lo, hi}; return __builtin_bit_cast(unsigned, __builtin_convertvector(v, bf2_t)); }
typedef GAS unsigned gu32;
#define WY_RLX __ATOMIC_RELAXED, __HIP_MEMORY_SCOPE_AGENT
constexpr int NJOB = R / 64, NCHUNK = R / 16, NSLOT = 8, ATP = 144, REC = 13056, JOBB = 4 * REC;
static_assert(R % 64 == 0 && CTXN % 64 == 0 && (R / 64) % 2 == 0, "jobs are 64 tokens; the loader is unrolled by two jobs");
constexpr int R_AT = 0, R_RT = 2304, R_BK = 4608, R_VT = 8704, R_AAK = 10752, R_TT = 11264, R_ARBK = 11776, R_WL = 12800;
__device__ __forceinline__ int permj(int j) { return (j >> 5) * 32 + ((j >> 2) & 3) * 8 + ((j >> 4) & 1) * 4 + (j & 3); }
constexpr int C_SLOTS = 3, C_SYNC = C_SLOTS * JOBB;
static_assert(C_SYNC + 64 <= 163840 - 64 && (JOBB / 4) % 16 == 0, "consumer LDS map");
constexpr size_t WS_RING = WS_WB;
constexpr size_t RING_TOTAL = (size_t)32 * NSLOT * JOBB;
constexpr size_t WS_WYF = 256 * 1024 + 16384;
constexpr int WYF_ACK = 32 * NSLOT * 64, WYF_ABORT = WYF_ACK + 32 * 64, WYF_WORDS = WYF_ABORT + 64;
constexpr unsigned SPIN_CAP = 1u << 17;
constexpr int P_A = 0, P_B = 16384, P_KD = 32768, P_LW = 49152, P_IMG = 65536, P_BRM = P_IMG + JOBB, P_KRM = P_BRM + 8192, P_AAB = P_KRM + 8192, P_W2T = P_AAB + 4096, P_A2T = P_W2T + 64 * PITCH * 2, P_END = P_A2T + 64 * PITCH * 2;
constexpr int P_SCR = P_BRM, SCRW = 2 * 8 * PITCH * 2;
constexpr int P_CST = P_IMG;
static_assert(P_END <= 163840 - 64 && P_SCR + 8 * SCRW + 8 * PITCH * 2 <= P_W2T, "wy LDS map");

__device__ __forceinline__ bf16x4 pack4(f32x4 v) { u32x2 r; r.x = pkbf(v[0], v[1]); r.y = pkbf(v[2], v[3]); return __builtin_bit_cast(bf16x4, r); }
__device__ __forceinline__ f32x4 mm(u32x2 a, bf16x4 b, f32x4 c) { return __builtin_amdgcn_mfma_f32_16x16x16bf16_1k(__builtin_bit_cast(bf16x4, a), b, c, 0, 0, 0); }
__device__ __forceinline__ f32x4 mm(u32x2 a, u32x2 b, f32x4 c) { return __builtin_amdgcn_mfma_f32_16x16x16bf16_1k(__builtin_bit_cast(bf16x4, a), __builtin_bit_cast(bf16x4, b), c, 0, 0, 0); }
__device__ __forceinline__ void wait_ge(gu32* word, unsigned want, gu32* abortw, int lane) {
    for (unsigned spins = 0;;) {
        unsigned v = 0u; if (lane == 0) v = __hip_atomic_load(word, WY_RLX);
        if ((unsigned)__builtin_amdgcn_readfirstlane(v) >= want) return;
        __builtin_amdgcn_s_sleep(1);
        if ((++spins & 255u) == 0u) { unsigned a = 0u; if (lane == 0) a = __hip_atomic_load(abortw, WY_RLX);
            if (__builtin_amdgcn_readfirstlane(a)) return;
            if (spins > SPIN_CAP) { if (lane == 0) __hip_atomic_store(abortw, 1u, WY_RLX); return; } }
    }
}

__device__ __forceinline__ void wait_ge4(gu32* words, unsigned want, gu32* abortw, int lane) {
    for (unsigned spins = 0;;) {
        unsigned v = 0xffffffffu; if (lane < 4) v = __hip_atomic_load(words + lane, WY_RLX);
        const unsigned v0 = (unsigned)__builtin_amdgcn_readlane((int)v, 0), v1 = (unsigned)__builtin_amdgcn_readlane((int)v, 1), v2 = (unsigned)__builtin_amdgcn_readlane((int)v, 2), v3 = (unsigned)__builtin_amdgcn_readlane((int)v, 3);
        const unsigned m01 = v0 < v1 ? v0 : v1, m23 = v2 < v3 ? v2 : v3;
        if ((m01 < m23 ? m01 : m23) >= want) return;
        __builtin_amdgcn_s_sleep(1);
        if ((++spins & 255u) == 0u) { unsigned a = 0u; if (lane == 0) a = __hip_atomic_load(abortw, WY_RLX);
            if (__builtin_amdgcn_readfirstlane(a)) return;
            if (spins > SPIN_CAP) { if (lane == 0) __hip_atomic_store(abortw, 1u, WY_RLX); return; } }
    }
}

struct Frag { u32x4 a01, a23, r01, r23, bk[4], arbk; u32x2 vT, aak, tt; f32x4 wl[4]; };

__device__ __forceinline__ void wait_lds_min4(LAS unsigned* w, unsigned want, gu32* abortw, int lane) {
    for (unsigned spins = 0;;) {
        const unsigned a = __hip_atomic_load(w, __ATOMIC_RELAXED, __HIP_MEMORY_SCOPE_WORKGROUP), b = __hip_atomic_load(w + 1, __ATOMIC_RELAXED, __HIP_MEMORY_SCOPE_WORKGROUP),
                       c = __hip_atomic_load(w + 2, __ATOMIC_RELAXED, __HIP_MEMORY_SCOPE_WORKGROUP), d = __hip_atomic_load(w + 3, __ATOMIC_RELAXED, __HIP_MEMORY_SCOPE_WORKGROUP);
        const unsigned m0 = a < b ? a : b, m1 = c < d ? c : d;
        if ((unsigned)__builtin_amdgcn_readfirstlane((int)(m0 < m1 ? m0 : m1)) >= want) return;
        __builtin_amdgcn_s_sleep(1);
        if ((++spins & 1023u) == 0u) { unsigned ab = 0u; if (lane == 0) ab = __hip_atomic_load(abortw, WY_RLX);
            if (__builtin_amdgcn_readfirstlane(ab)) return;
            if (spins > (SPIN_CAP << 3)) { if (lane == 0) __hip_atomic_store(abortw, 1u, WY_RLX); return; } }
    }
}
template <int MODE> __device__ __forceinline__ void loader(const Params& p, int chain, int lw, int lane, LAS unsigned char* lds) {
    gu32* wf = (gu32*)(p.ws + WS_WYF); gu32* flags = wf + chain * NSLOT * 64; gu32* ackw = wf + WYF_ACK + chain * 64; gu32* abortw = wf + WYF_ABORT;
    LAS unsigned* loaded = (LAS unsigned*)(lds + C_SYNC); LAS unsigned* done = loaded + 4;
    const __amdgpu_buffer_rsrc_t ring_rsrc = __builtin_amdgcn_make_buffer_rsrc((void*)(p.ws + WS_RING), 0, (int)RING_TOTAL, 0x00020000);
    constexpr int QB = JOBB / 4, NIT = (QB / 16 + 63) / 64, TAIL = QB / 16 - (NIT - 1) * 64;
    static_assert(NIT == 13, "the counted waits below assume 13 loads per set");
    u32x4 va[NIT], vb[NIT];
#define WY_ISSUE(v, g_) do { if (MODE < 2) wait_ge(flags + ((g_) % NSLOT) * 64, (unsigned)(g_) + 1u, abortw, lane); \
        const int soff = (chain * NSLOT + (g_) % NSLOT) * JOBB + lw * QB + lane * 16; \
        _Pragma("unroll") for (int k = 0; k < NIT; ++k) if (MODE == 0 && (k < NIT - 1 || lane < TAIL)) v[k] = __builtin_amdgcn_raw_buffer_load_b128(ring_rsrc, soff + k * 1024, 0, 16); } while (0)
#define WY_COMMIT(v, g_, WAITSTR) do { \
        if (MODE != 1 && (g_) >= C_SLOTS) { wait_lds_min4(done, (unsigned)((g_) - C_SLOTS + 1), abortw, lane); __builtin_amdgcn_fence(__ATOMIC_ACQUIRE, "workgroup"); }     \
        asm volatile(WAITSTR ::: "memory");                                                     \
        LAS unsigned char* dst = lds + ((g_) % C_SLOTS) * JOBB + lw * QB + lane * 16; \
        _Pragma("unroll") for (int k = 0; k < NIT; ++k) if (MODE == 0 && (k < NIT - 1 || lane < TAIL)) *(LAS u32x4*)(dst + k * 1024) = v[k]; \
        asm volatile("s_waitcnt lgkmcnt(0)" ::: "memory"); \
        __builtin_amdgcn_fence(__ATOMIC_RELEASE, "workgroup"); \
        if (lane == 0) { __hip_atomic_store(ackw + lw, (unsigned)(g_) + 1u, WY_RLX); __hip_atomic_store(loaded + lw, (unsigned)(g_) + 1u, __ATOMIC_RELAXED, __HIP_MEMORY_SCOPE_WORKGROUP); } } while (0)
    WY_ISSUE(va, 0);
    for (int g = 0; g < NJOB; g += 2) {
        WY_ISSUE(vb, g + 1); WY_COMMIT(va, g, "s_waitcnt vmcnt(13)");
        if (g + 2 < NJOB) { WY_ISSUE(va, g + 2); WY_COMMIT(vb, g + 1, "s_waitcnt vmcnt(13)"); } else WY_COMMIT(vb, g + 1, "s_waitcnt vmcnt(0)");
    }
#undef WY_ISSUE
#undef WY_COMMIT
}
__device__ __forceinline__ bf16x8 cat(u32x2 a, u32x2 b) { const u32x4 v = {a.x, a.y, b.x, b.y}; return __builtin_bit_cast(bf16x8, v); }
__device__ __forceinline__ u32x2 pack4u(f32x4 v) { u32x2 r; r.x = pkbf(v[0], v[1]); r.y = pkbf(v[2], v[3]); return r; }
__device__ __forceinline__ f32x4 mm32(bf16x8 a, bf16x8 b, f32x4 c) { return __builtin_amdgcn_mfma_f32_16x16x32_bf16(a, b, c, 0, 0, 0); }
template <int MODE> __device__ __forceinline__ void consumer(const Params& p, int chain, int wave, int lane, LAS unsigned char* lds) {
    const int n = lane & 15, q = lane >> 4, dir = chain >> 4, h = chain & 15;
    gu32* abortw = (gu32*)(p.ws + WS_WYF) + WYF_ABORT;
    LAS unsigned* loaded = (LAS unsigned*)(lds + C_SYNC); LAS unsigned* done = loaded + 4;
    f32x4 S0 = {0.f, 0.f, 0.f, 0.f}, S1 = S0, S2 = S0, S3 = S0;
    const int offA = n * ATP + 16 * q, offB = n * 32 + 8 * q, offW = 16 * q, offS = n * 64 + ((q ^ ((n >> 2) & 3)) * 16);
    const long rstep = dir ? -2048 : 2048;
    bf16_t* yq = ws_br(p) + (size_t)(CTXN + (dir ? SEQ - 1 - 4 * q : 4 * q)) * 2048 + dir * 1024 + h * 64 + 16 * wave + n;
#define WY_LOAD(F, base, k) do { \
        F.a01 = *(const LAS u32x4*)(base + offA + (k) * REC + R_AT); F.a23 = *(const LAS u32x4*)(base + offA + (k) * REC + R_AT + 64); \
        F.r01 = *(const LAS u32x4*)(base + offA + (k) * REC + R_RT); F.r23 = *(const LAS u32x4*)(base + offA + (k) * REC + R_RT + 64); \
        _Pragma("unroll") for (int jt = 0; jt < 4; ++jt) { F.bk[jt] = *(const LAS u32x4*)(base + offS + (k) * REC + R_BK + 1024 * jt); F.wl[jt] = *(const LAS f32x4*)(base + offW + (k) * REC + R_WL + 64 * jt); } \
        F.arbk = *(const LAS u32x4*)(base + offS + (k) * REC + R_ARBK); \
        F.vT = *(const LAS u32x2*)(base + offB + (k) * REC + R_VT + 512 * wave); F.aak = *(const LAS u32x2*)(base + offB + (k) * REC + R_AAK); F.tt = *(const LAS u32x2*)(base + offB + (k) * REC + R_TT); } while (0)
#define WY_Q(v) __builtin_bit_cast(bf16x8, v)
#define WY_COMPUTE(F, cidx) do { const f32x4 z0_ = {0.f, 0.f, 0.f, 0.f}; const u32x2 zz_ = {0u, 0u};     \
        f32x4 Z = mm32(cat(F.aak, zz_), cat(F.vT, zz_), z0_); \
        const bf16x8 s01 = cat(pack4u(S0), pack4u(S1)), s23 = cat(pack4u(S2), pack4u(S3)); \
        Z = mm32(WY_Q(F.a01), s01, Z); Z = mm32(WY_Q(F.a23), s23, Z);     \
        f32x4 Y = mm32(WY_Q(F.r01), s01, z0_); Y = mm32(WY_Q(F.r23), s23, Y); \
        const u32x2 zb = pack4u(Z); const f32x4 U = mm32(cat(F.tt, zz_), cat(zb, zz_), z0_); const u32x2 ub = pack4u(U); \
        const bf16x8 vu = cat(F.vT, ub); \
        Y = mm32(WY_Q(F.arbk), vu, Y); \
        S0 = mm32(WY_Q(F.bk[0]), vu, S0); S1 = mm32(WY_Q(F.bk[1]), vu, S1); S2 = mm32(WY_Q(F.bk[2]), vu, S2); S3 = mm32(WY_Q(F.bk[3]), vu, S3); \
        S0 *= F.wl[0]; S1 *= F.wl[1]; S2 *= F.wl[2]; S3 *= F.wl[3]; \
        if (MODE == 0 && (cidx) * 16 >= CTXN) { const unsigned y01 = pkbf(Y[0], Y[1]), y23 = pkbf(Y[2], Y[3]); bf16_t* yp_ = yq + (long)((cidx) * 16 - CTXN) * rstep; \
            *(unsigned short*)yp_ = (unsigned short)(y01 & 0xffffu); *(unsigned short*)(yp_ + rstep) = (unsigned short)(y01 >> 16); \
            *(unsigned short*)(yp_ + 2 * rstep) = (unsigned short)(y23 & 0xffffu); *(unsigned short*)(yp_ + 3 * rstep) = (unsigned short)(y23 >> 16); } } while (0)
    Frag FA, FB;
    wait_lds_min4(loaded, 1u, abortw, lane); __builtin_amdgcn_fence(__ATOMIC_ACQUIRE, "workgroup");
    int slot = 0;
    { const LAS unsigned char* b0 = lds; WY_LOAD(FA, b0, 0); if (MODE == 3) WY_LOAD(FB, b0, 1); }
    for (int g = 0; g < NJOB; ++g) {
        const LAS unsigned char* base = lds + slot * JOBB;
        if (MODE != 3) WY_LOAD(FB, base, 1); WY_COMPUTE(FA, 4 * g);
        if (MODE != 3) WY_LOAD(FA, base, 2); WY_COMPUTE(FB, 4 * g + 1);
        if (MODE != 3) WY_LOAD(FB, base, 3); WY_COMPUTE(FA, 4 * g + 2);
        slot = slot == C_SLOTS - 1 ? 0 : slot + 1;
        if (g + 1 < NJOB) { wait_lds_min4(loaded, (unsigned)g + 2u, abortw, lane); __builtin_amdgcn_fence(__ATOMIC_ACQUIRE, "workgroup");
            const LAS unsigned char* nb = lds + slot * JOBB; if (MODE != 3) WY_LOAD(FA, nb, 0); }
        WY_COMPUTE(FB, 4 * g + 3);
        asm volatile("s_waitcnt lgkmcnt(0)" ::: "memory");
        __builtin_amdgcn_fence(__ATOMIC_RELEASE, "workgroup");
        if (lane == 0) __hip_atomic_store(done + wave, (unsigned)g + 1u, __ATOMIC_RELAXED, __HIP_MEMORY_SCOPE_WORKGROUP);
    }
#undef WY_LOAD
#undef WY_COMPUTE
#undef WY_Q
    if (MODE != 0) asm volatile("" :: "v"(S0), "v"(S1), "v"(S2), "v"(S3));
}

template <int HALF> __device__ __forceinline__ void stage2(LAS unsigned char* lds, LAS unsigned char* img, int ch, int j) {
    LAS unsigned char* rec = img + ch * REC;
    const LAS float* LW = (const LAS float*)(lds + P_LW) + (ch * 16) * 64 + j;
    const LAS float* XA = (const LAS float*)(lds + (HALF ? P_KD : P_A)) + (ch * 16) * 64 + j;
    const LAS float* XB = (const LAS float*)(lds + P_B) + (ch * 16) * 64 + j;
    LAS unsigned short* rowm0 = (LAS unsigned short*)(rec + (HALF ? R_RT : R_AT)) + permj(j);
    LAS unsigned short* rowm1 = (LAS unsigned short*)(lds + (HALF ? P_KRM : P_BRM) + ch * 2048) + permj(j);
    float lw[16], s0[16], s1[16];
#pragma unroll
    for (int t = 0; t < 16; ++t) { lw[t] = LW[t * 64]; s1[t] = HALF ? XA[t * 64] : XB[t * 64];
        if (HALF) s0[t] = __uint_as_float((unsigned)rowm0[t * (ATP / 2)] << 16); else s0[t] = XA[t * 64]; }
    float cum = 0.f, x0p = 0.f, x1p = 0.f; unsigned tp[8];
#pragma unroll
    for (int t = 0; t < 16; ++t) {
        const float cprev = cum; cum += lw[t];
        const float x0 = s0[t] * __builtin_amdgcn_exp2f(HALF ? cum : cprev), x1 = s1[t] * __builtin_amdgcn_exp2f(-cum);
        if (t & 1) { const unsigned p0 = pkbf(x0p, x0), p1 = pkbf(x1p, x1);
            rowm0[(t - 1) * (ATP / 2)] = (unsigned short)(p0 & 0xffffu); rowm0[t * (ATP / 2)] = (unsigned short)(p0 >> 16);
            rowm1[(t - 1) * 64] = (unsigned short)(p1 & 0xffffu); rowm1[t * 64] = (unsigned short)(p1 >> 16);
            tp[t >> 1] = p1; }
        x0p = x0; x1p = x1; }
    { LAS unsigned char* bkr = rec + R_BK + j * 64 + (HALF ? 0 : 8); const int sw = (j >> 2) & 3;
#pragma unroll
      for (int qq = 0; qq < 4; ++qq) *(LAS u32x2*)(bkr + ((qq ^ sw) * 16)) = (u32x2){tp[2 * qq], tp[2 * qq + 1]}; }
    if (HALF) *(LAS float*)(rec + R_WL + j * 4) = __builtin_amdgcn_exp2f(cum);
}

template <int SKIP> __device__ __forceinline__ void producer(const Params& p, int chain, int first, int step, LAS unsigned char* lds) {
    int tid_ = threadIdx.x; asm volatile("" : "+v"(tid_));
    const int tid = tid_, lane = tid & 63, wave = __builtin_amdgcn_readfirstlane(tid >> 6);
    const int dir = chain >> 4, h = chain & 15;
    const float* w0 = dir ? p.w0b : p.w0f; const float* w2 = dir ? p.w2b : p.w2f; const float* a0 = dir ? p.a0b : p.a0f; const float* a2 = dir ? p.a2b : p.a2f;
    const bf16_t* Z = ws_big(p); float* bon = (float*)(p.ws + rw::WS_BON) + ((size_t)dir * 16 + h) * SEQ;
    gu32* wf = (gu32*)(p.ws + WS_WYF); gu32* flags = wf + chain * NSLOT * 64; gu32* ackw = wf + WYF_ACK + chain * 64; gu32* abortw = wf + WYF_ABORT;
    const __amdgpu_buffer_rsrc_t ring_rsrc = __builtin_amdgcn_make_buffer_rsrc((void*)(p.ws + WS_RING), 0, (int)RING_TOTAL, 0x00020000);
    { const int m = tid >> 3, j8 = (tid & 7) * 8;
      const f32x4 wa = *(const f32x4*)(w2 + (size_t)m * 1024 + h * 64 + j8), wb = *(const f32x4*)(w2 + (size_t)m * 1024 + h * 64 + j8 + 4);
      const f32x4 aa = *(const f32x4*)(a2 + (size_t)m * 1024 + h * 64 + j8), ab = *(const f32x4*)(a2 + (size_t)m * 1024 + h * 64 + j8 + 4);
      LAS bf16_t* yw = (LAS bf16_t*)(lds + P_W2T); LAS bf16_t* ya = (LAS bf16_t*)(lds + P_A2T);
#pragma unroll
      for (int qq = 0; qq < 4; ++qq) { yw[(j8 + qq) * PITCH + m] = f2bf(wa[qq]); yw[(j8 + 4 + qq) * PITCH + m] = f2bf(wb[qq]); ya[(j8 + qq) * PITCH + m] = f2bf(aa[qq]); ya[(j8 + 4 + qq) * PITCH + m] = f2bf(ab[qq]); }
      for (int i = tid; i < 320; i += NTHR) { const int gI = i >> 6, cc = i & 63, hc = h * 64 + cc; float v;
          if (gI == 0) v = w0[hc]; else if (gI == 1) v = a0[hc]; else if (gI == 2) v = p.k_k[hc]; else if (gI == 3) v = p.k_a[hc]; else v = p.r_k[hc];
          *(LAS float*)(lds + P_CST + i * 4) = v; } }
    __syncthreads();
    const int tq = lane >> 3, c8 = (lane & 7) * 8, hj = h * 64 + c8, tslot = wave * 8 + tq, ch1 = tslot >> 4, t1 = tslot & 15;
    const int gcol[5] = {hj, 1024 + hj, 2048 + hj, 3072 + dir * 64 + c8, 3200 + dir * 64 + c8};
    f32x4 cw0[2], ca0[2], ckk[2], cka[2], crk[2];
#pragma unroll
    for (int hh = 0; hh < 2; ++hh) {
#define WY_CST(gI) (*(LAS f32x4*)(lds + P_CST + ((gI) * 64 + c8 + 4 * hh) * 4))
        cw0[hh] = WY_CST(0); ca0[hh] = WY_CST(1); ckk[hh] = WY_CST(2); cka[hh] = WY_CST(3); crk[hh] = WY_CST(4);
#undef WY_CST
        asm volatile("" : "+v"(cw0[hh]), "+v"(ca0[hh]), "+v"(ckk[hh]), "+v"(cka[hh]), "+v"(crk[hh])); }
    __syncthreads();
    LAS unsigned char* scr = lds + P_SCR + wave * SCRW;
    LAS unsigned char* img = lds + P_IMG;
    rw::Raw raw;
#define WY_LOADRAW(gj) do { const bf16_t* zr_ = Z + (size_t)rw_row(dir, (gj) * 64 + tslot) * ZW; \
        _Pragma("unroll") for (int g5 = 0; g5 < 5; ++g5) raw.c[g5] = *(const u32x4*)(zr_ + gcol[g5]); } while (0)
    if (first < NJOB) WY_LOADRAW(first);
    for (int g = first; g < NJOB; g += step) {
        const bool latent = g * 64 >= CTXN;
        if (!(SKIP & 1)) { f32x4 rr[2], kv[2];
          { const u32x4 u = raw.c[0]; rr[0] = (f32x4){bflo(u.x), bfhi(u.x), bflo(u.y), bfhi(u.y)}; rr[1] = (f32x4){bflo(u.z), bfhi(u.z), bflo(u.w), bfhi(u.w)};
            LAS unsigned char* rr_ = img + ch1 * REC + R_RT + t1 * ATP + permj(c8) * 2; *(LAS u32x2*)rr_ = (u32x2){u.x, u.y}; *(LAS u32x2*)(rr_ + 16) = (u32x2){u.z, u.w}; }
          { const u32x4 u = raw.c[1]; kv[0] = (f32x4){bflo(u.x), bfhi(u.x), bflo(u.y), bfhi(u.y)}; kv[1] = (f32x4){bflo(u.z), bfhi(u.z), bflo(u.w), bfhi(u.w)}; }
          { const u32x4 u = raw.c[2]; LAS unsigned short* vt = (LAS unsigned short*)(img + ch1 * REC + R_VT) + c8 * 16 + t1;
            vt[0] = (unsigned short)(u.x & 0xffffu); vt[16] = (unsigned short)(u.x >> 16); vt[32] = (unsigned short)(u.y & 0xffffu); vt[48] = (unsigned short)(u.y >> 16);
            vt[64] = (unsigned short)(u.z & 0xffffu); vt[80] = (unsigned short)(u.z >> 16); vt[96] = (unsigned short)(u.w & 0xffffu); vt[112] = (unsigned short)(u.w >> 16); }
          { const u32x4 u = raw.c[3]; u32x4 o;
            o.x = pkbf(rw::fast_tanh(bflo(u.x)), rw::fast_tanh(bfhi(u.x))); o.y = pkbf(rw::fast_tanh(bflo(u.y)), rw::fast_tanh(bfhi(u.y))); o.z = pkbf(rw::fast_tanh(bflo(u.z)), rw::fast_tanh(bfhi(u.z))); o.w = pkbf(rw::fast_tanh(bflo(u.w)), rw::fast_tanh(bfhi(u.w)));
            *(LAS u32x4*)(scr + (tq * PITCH + c8) * 2) = o; *(LAS u32x4*)(scr + 8 * PITCH * 2 + (tq * PITCH + c8) * 2) = raw.c[4]; }
          if (g + step < NJOB) WY_LOADRAW(g + step);
          asm volatile("s_waitcnt lgkmcnt(0)" ::: "memory");
          { const int r16 = lane & 15, quad = lane >> 4; f32x4 acc[2][4];
#pragma unroll
            for (int lora = 0; lora < 2; ++lora) {
                LAS unsigned char* X = scr + lora * 8 * PITCH * 2 + (r16 * PITCH + quad * 8) * 2;
                const bf16x8 x0 = *(LAS bf16x8*)X, x1 = *(LAS bf16x8*)(X + 64);
#pragma unroll
                for (int jt = 0; jt < 4; ++jt) {
                    LAS unsigned char* Y = lds + (lora ? P_A2T : P_W2T) + ((jt * 16 + r16) * PITCH + quad * 8) * 2;
                    acc[lora][jt] = (f32x4){0.f, 0.f, 0.f, 0.f};
                    acc[lora][jt] = __builtin_amdgcn_mfma_f32_16x16x32_bf16(x0, *(LAS bf16x8*)Y, acc[lora][jt], 0, 0, 0);
                    acc[lora][jt] = __builtin_amdgcn_mfma_f32_16x16x32_bf16(x1, *(LAS bf16x8*)(Y + 64), acc[lora][jt], 0, 0, 0); } }
            if (quad < 2) {
#pragma unroll
                for (int lora = 0; lora < 2; ++lora)
#pragma unroll
                    for (int jt = 0; jt < 4; ++jt)
#pragma unroll
                        for (int r = 0; r < 4; ++r) *(LAS float*)(lds + (lora ? P_B : P_LW) + ((wave * 8 + quad * 4 + r) * 64 + jt * 16 + r16) * 4) = acc[lora][jt][r]; } }
          asm volatile("s_waitcnt lgkmcnt(0)" ::: "memory");
          { float bs = 0.f, nn = 0.f; f32x4 kk[2], al[2];
#pragma unroll
            for (int hh = 0; hh < 2; ++hh) { const int off = (tslot * 64 + c8 + 4 * hh) * 4;
                const f32x4 aw = *(LAS f32x4*)(lds + P_LW + off) + cw0[hh], aa = *(LAS f32x4*)(lds + P_B + off) + ca0[hh];
                f32x4 lw;
#pragma unroll
                for (int qq = 0; qq < 4; ++qq) { const float sg = __builtin_amdgcn_rcpf(1.0f + __builtin_amdgcn_exp2f(-1.4426950408889634f * aw[qq]));
                    lw[qq] = -0.8750612633917f * sg; al[hh][qq] = __builtin_amdgcn_rcpf(1.0f + __builtin_amdgcn_exp2f(-1.4426950408889634f * aa[qq])); kk[hh][qq] = kv[hh][qq] * ckk[hh][qq]; nn += kk[hh][qq] * kk[hh][qq]; }
                *(LAS f32x4*)(lds + P_LW + off) = lw; }
            nn = rw::allreduce8(nn);
            const float inv = __builtin_amdgcn_rsqf(fmaxf(nn, 1e-24f));
#pragma unroll
            for (int hh = 0; hh < 2; ++hh) { const int off = (tslot * 64 + c8 + 4 * hh) * 4;
                const f32x4 r = rr[hh];
                f32x4 av, bv, kd;
#pragma unroll
                for (int qq = 0; qq < 4; ++qq) { const float kn = kk[hh][qq] * inv; av[qq] = -kn; bv[qq] = kn * al[hh][qq]; kd[qq] = kv[hh][qq] * (1.0f + (al[hh][qq] - 1.0f) * cka[hh][qq]); bs += r[qq] * kd[qq] * crk[hh][qq]; }
                *(LAS f32x4*)(lds + P_B + off) = bv; *(LAS f32x4*)(lds + P_KD + off) = kd; *(LAS f32x4*)(lds + P_A + off) = av; }
            bs = rw::allreduce8(bs);
            if (latent && (lane & 7) == 0) bon[rw_row(dir, g * 64 + tslot) - CTXN] = bs; } }
        __syncthreads();
        if (!(SKIP & 2)) { if (wave >> 2) stage2<1>(lds, img, wave & 3, lane); else stage2<0>(lds, img, wave & 3, lane); }
        __syncthreads();
        if (!(SKIP & 4)) { const int ch = wave & 3, pair = wave >> 2, n = lane & 15, q = lane >> 4;
          LAS unsigned char* rec = img + ch * REC;
          const LAS unsigned char* Yrm = rec + (pair ? R_RT : R_AT) + n * ATP + 16 * q;
          const LAS unsigned char* Xb = lds + P_BRM + ch * 2048 + n * 128 + 16 * q;
          const LAS unsigned char* Xk = lds + P_KRM + ch * 2048 + n * 128 + 16 * q;
          f32x4 cb = {0.f, 0.f, 0.f, 0.f}, ck = cb;
#pragma unroll
          for (int jt = 0; jt < 4; ++jt) { const int o_ = (jt >> 1) * 64 + (jt & 1) * 8; const u32x2 yb = *(const LAS u32x2*)(Yrm + o_);
              cb = mm(*(const LAS u32x2*)(Xb + o_), yb, cb); ck = mm(*(const LAS u32x2*)(Xk + o_), yb, ck); }
#pragma unroll
          for (int r = 0; r < 4; ++r) { const int s = 4 * q + r; const bool keep = pair ? (s <= n) : (s < n); if (!keep) { cb[r] = 0.f; ck[r] = 0.f; } }
          u32x2 ob, ok; ob.x = pkbf(cb[0], cb[1]); ob.y = pkbf(cb[2], cb[3]); ok.x = pkbf(ck[0], ck[1]); ok.y = pkbf(ck[2], ck[3]);
          if (pair) *(LAS u32x4*)(rec + R_ARBK + n * 64 + ((q ^ ((n >> 2) & 3)) * 16)) = (u32x4){ok.x, ok.y, ob.x, ob.y};
          else {
              *(LAS u32x2*)(rec + R_AAK + n * 32 + 8 * q) = ok;
              LAS float* A2 = (LAS float*)(lds + P_AAB + ch * 1024);
#pragma unroll
              for (int r = 0; r < 4; ++r) A2[n * 16 + r * 4 + q] = cb[r];
              asm volatile("s_waitcnt lgkmcnt(0)" ::: "memory");
              const int c = lane >> 2, pp = lane & 3;
              f32x4 a4[16];
#pragma unroll
              for (int t = 0; t < 16; ++t) a4[t] = *(const LAS f32x4*)(A2 + t * 16 + pp * 4);
              float Tk0 = 0.f, Tk1 = 0.f, Tk2 = 0.f, Tk3 = 0.f, Tprev = 0.f;
              LAS unsigned short* tt = (LAS unsigned short*)(rec + R_TT) + c;
#pragma unroll
              for (int t = 0; t < 16; ++t) {
                  float acc = (a4[t][0] * Tk0 + a4[t][1] * Tk1) + (a4[t][2] * Tk2 + a4[t][3] * Tk3);
                  acc += rw::dppmov<0xB1>(acc); acc += rw::dppmov<0x4E>(acc);
                  const float Tt = acc + ((t == c) ? 1.0f : 0.0f);
                  const bool mine = (t & 3) == pp;
                  if ((t >> 2) == 0) Tk0 = mine ? Tt : Tk0; else if ((t >> 2) == 1) Tk1 = mine ? Tt : Tk1; else if ((t >> 2) == 2) Tk2 = mine ? Tt : Tk2; else Tk3 = mine ? Tt : Tk3;
                  if (t & 1) { const unsigned pk_ = pkbf(Tprev, Tt); if (pp == 0) { tt[(t - 1) * 16] = (unsigned short)(pk_ & 0xffffu); tt[t * 16] = (unsigned short)(pk_ >> 16); } }
                  Tprev = Tt; }
          } }
        if (!(SKIP & 16) && wave == 0 && g >= NSLOT) wait_ge4(ackw, (unsigned)(g - NSLOT + 1), abortw, lane);
        __syncthreads();
        { const int slot = g % NSLOT; const int base = (chain * NSLOT + slot) * JOBB;
          if (!(SKIP & 8)) for (int i = tid; i < JOBB / 16; i += NTHR) __builtin_amdgcn_raw_buffer_store_b128(*(LAS u32x4*)(img + i * 16), ring_rsrc, base + i * 16, 0, 16);
          asm volatile("s_waitcnt vmcnt(0)" ::: "memory");
          __syncthreads();
          if (tid == 0) __hip_atomic_store(flags + slot * 64, (unsigned)g + 1u, WY_RLX); }
    }
#undef WY_LOADRAW
}

__device__ __forceinline__ void zero_words(const Params& p) {
    int t_ = threadIdx.x; asm volatile("" : "+v"(t_)); unsigned* wf_ = (unsigned*)(p.ws + WS_WYF);
    for (long g = (long)blockIdx.x * NTHR + t_; g < (long)WYF_WORDS; g += (long)gridDim.x * NTHR) wf_[g] = 0u;
}
template <int MODE, int SKIP = 0> __device__ __forceinline__ void phase(const Params& p, LAS unsigned char* lds) {
    const int G = (int)gridDim.x, b = (int)blockIdx.x, nper = (G - 32) / 32;
    if (b < 32) {
        int tid_ = threadIdx.x; asm volatile("" : "+v"(tid_)); const int wave = __builtin_amdgcn_readfirstlane(tid_ >> 6);
        if (tid_ < 8) *(LAS unsigned*)(lds + C_SYNC + 4 * tid_) = 0u;
        __syncthreads();
        if (MODE == 4) { }
        else if (wave < 4) { if (MODE != 1) consumer<MODE>(p, b, wave, tid_ & 63, lds); } else loader<MODE>(p, b, wave - 4, tid_ & 63, lds);
    }
    else if (MODE < 2 || MODE == 4) { const int pp = b - 32; if (pp < 32 * nper) producer<SKIP>(p, pp % 32, pp / 32, nper, lds); }
}
}

namespace ret {
using attn::bf16x8; using attn::s16x4; using attn::f32x16; using attn::u32x4;
typedef float f32x4 __attribute__((ext_vector_type(4)));
typedef unsigned u32x2 __attribute__((ext_vector_type(2)));
constexpr int NQ = R / 128;
constexpr size_t SLOT_BYTES = 256 * 128 * 2;
constexpr size_t WS_SCTX = 254 * MiB;
#define RKSWZ(row, colB) ((row) * 256 + ((colB) ^ (((row) & 7) << 4)))
__device__ __forceinline__ bf16_t* slot(const Params& p, int dir, int q, int head) {
    return q >= 2 ? (bf16_t*)((unsigned char*)p.out + (((size_t)dir * (NQ - 2) + (q - 2)) * 4 + head) * SLOT_BYTES)
                  : (bf16_t*)(p.ws + WS_SCTX + (((size_t)dir * 2 + q) * 4 + head) * SLOT_BYTES);
}
__device__ __forceinline__ float log2_sigmoid(float x) { return -1.4426950408889634f * (fmaxf(-x, 0.f) + log1pf(expf(-fabsf(x)))); }
__device__ __forceinline__ bf16x8 scale8(bf16x8 v, float s) {
    u32x4 w = __builtin_bit_cast(u32x4, v), o;
#pragma unroll
    for (int i = 0; i < 4; ++i) o[i] = attn::cvtpk(__uint_as_float(w[i] << 16) * s, __uint_as_float(w[i] & 0xffff0000u) * s);
    return __builtin_bit_cast(bf16x8, o);
}
__device__ __forceinline__ void pk4(const f32x16& P, int base, bf16x8& out) {
    const unsigned a0 = attn::cvtpk(P[base + 0], P[base + 1]), a1 = attn::cvtpk(P[base + 2], P[base + 3]);
    const unsigned b0 = attn::cvtpk(P[base + 4], P[base + 5]), b1 = attn::cvtpk(P[base + 6], P[base + 7]);
    auto r0 = __builtin_amdgcn_permlane32_swap(a0, b0, false, false); auto r1 = __builtin_amdgcn_permlane32_swap(a1, b1, false, false);
    u32x4 w = {r0[0], r1[0], r0[1], r1[1]}; out = __builtin_bit_cast(bf16x8, w);
}
#define RPK(L, H) (bf16x8){L[0], L[1], L[2], L[3], H[0], H[1], H[2], H[3]}

__device__ __forceinline__ void summaries_unit(const Params& p, int q, int h, char* lds) {
    int tid_ = threadIdx.x; asm volatile("" : "+v"(tid_));
    const int tid = tid_, lane = tid & 63, wave = __builtin_amdgcn_readfirstlane(tid >> 6), r32 = lane & 31, hi = lane >> 5;
    const bf16_t* P = ws_big(p) + (size_t)q * 128 * P0W;
    const float lgf = log2_sigmoid(p.dec_f[h]), lgb = log2_sigmoid(p.dec_b[h]);
    const int sr = tid >> 4, sc = (tid & 15) * 8, st0 = attn::v_st(sr, sc), st1 = attn::v_st(32 + sr, sc);
#pragma unroll
    for (int th = 0; th < 2; ++th) {
        const int t0 = th * 64 + sr, t1 = t0 + 32;
        const bf16_t* r0 = P + (size_t)t0 * P0W; const bf16_t* r1 = P + (size_t)t1 * P0W;
#pragma unroll
        for (int eh = 0; eh < 2; ++eh) { char* vt = lds + (th * 2 + eh) * 16384;
            *(bf16x8*)(vt + st0) = *(const bf16x8*)(r0 + C_VA + h * 256 + eh * 128 + sc); *(bf16x8*)(vt + st1) = *(const bf16x8*)(r1 + C_VA + h * 256 + eh * 128 + sc); }
        const bf16x8 k0 = *(const bf16x8*)(r0 + C_KA + h * 128 + sc), k1 = *(const bf16x8*)(r1 + C_KA + h * 128 + sc);
        char* kf = lds + 65536 + th * 16384; char* kb = lds + 98304 + th * 16384;
        *(bf16x8*)(kf + st0) = scale8(k0, __builtin_amdgcn_exp2f((float)(127 - t0) * lgf)); *(bf16x8*)(kf + st1) = scale8(k1, __builtin_amdgcn_exp2f((float)(127 - t1) * lgf));
        *(bf16x8*)(kb + st0) = scale8(k0, __builtin_amdgcn_exp2f((float)t0 * lgb)); *(bf16x8*)(kb + st1) = scale8(k1, __builtin_amdgcn_exp2f((float)t1 * lgb));
    }
    __syncthreads();
    const int lbase = (int)(uintptr_t)lds + attn::v_rd_base(lane);
    f32x16 acc[2][4];
#pragma unroll
    for (int d = 0; d < 2; ++d)
#pragma unroll
        for (int b = 0; b < 4; ++b) acc[d][b] = f32x16{};
#pragma unroll
    for (int th = 0; th < 2; ++th) {
        const int va = lbase + (th * 2 + (wave >> 2)) * 16384 + (wave & 3) * 512, kfb = lbase + 65536 + th * 16384, kbb = lbase + 98304 + th * 16384;
#define R1_STEP(KS) do { \
        const s16x4 al = attn::tr_read<attn::v_rd_off(0, KS, 0)>(va), ah = attn::tr_read<attn::v_rd_off(0, KS, 1)>(va); \
        const s16x4 f0l = attn::tr_read<attn::v_rd_off(0, KS, 0)>(kfb), f0h = attn::tr_read<attn::v_rd_off(0, KS, 1)>(kfb), f1l = attn::tr_read<attn::v_rd_off(1, KS, 0)>(kfb), f1h = attn::tr_read<attn::v_rd_off(1, KS, 1)>(kfb); \
        const s16x4 f2l = attn::tr_read<attn::v_rd_off(2, KS, 0)>(kfb), f2h = attn::tr_read<attn::v_rd_off(2, KS, 1)>(kfb), f3l = attn::tr_read<attn::v_rd_off(3, KS, 0)>(kfb), f3h = attn::tr_read<attn::v_rd_off(3, KS, 1)>(kfb); \
        const s16x4 g0l = attn::tr_read<attn::v_rd_off(0, KS, 0)>(kbb), g0h = attn::tr_read<attn::v_rd_off(0, KS, 1)>(kbb), g1l = attn::tr_read<attn::v_rd_off(1, KS, 0)>(kbb), g1h = attn::tr_read<attn::v_rd_off(1, KS, 1)>(kbb); \
        const s16x4 g2l = attn::tr_read<attn::v_rd_off(2, KS, 0)>(kbb), g2h = attn::tr_read<attn::v_rd_off(2, KS, 1)>(kbb), g3l = attn::tr_read<attn::v_rd_off(3, KS, 0)>(kbb), g3h = attn::tr_read<attn::v_rd_off(3, KS, 1)>(kbb); \
        asm volatile("s_waitcnt lgkmcnt(0)" ::: "memory"); __builtin_amdgcn_sched_barrier(0); \
        const bf16x8 a = RPK(al, ah); \
        acc[0][0] = __builtin_amdgcn_mfma_f32_32x32x16_bf16(a, RPK(f0l, f0h), acc[0][0], 0, 0, 0); acc[0][1] = __builtin_amdgcn_mfma_f32_32x32x16_bf16(a, RPK(f1l, f1h), acc[0][1], 0, 0, 0); \
        acc[0][2] = __builtin_amdgcn_mfma_f32_32x32x16_bf16(a, RPK(f2l, f2h), acc[0][2], 0, 0, 0); acc[0][3] = __builtin_amdgcn_mfma_f32_32x32x16_bf16(a, RPK(f3l, f3h), acc[0][3], 0, 0, 0); \
        acc[1][0] = __builtin_amdgcn_mfma_f32_32x32x16_bf16(a, RPK(g0l, g0h), acc[1][0], 0, 0, 0); acc[1][1] = __builtin_amdgcn_mfma_f32_32x32x16_bf16(a, RPK(g1l, g1h), acc[1][1], 0, 0, 0); \
        acc[1][2] = __builtin_amdgcn_mfma_f32_32x32x16_bf16(a, RPK(g2l, g2h), acc[1][2], 0, 0, 0); acc[1][3] = __builtin_amdgcn_mfma_f32_32x32x16_bf16(a, RPK(g3l, g3h), acc[1][3], 0, 0, 0); \
        __builtin_amdgcn_sched_barrier(0); } while (0)
        R1_STEP(0); R1_STEP(1); R1_STEP(2); R1_STEP(3);
#undef R1_STEP
    }
#pragma unroll
    for (int d = 0; d < 2; ++d) { bf16_t* dst = slot(p, d, q, h);
#pragma unroll
        for (int db = 0; db < 4; ++db)
#pragma unroll
            for (int r = 0; r < 16; ++r) dst[(size_t)(32 * wave + attn::crow(r, hi)) * 128 + 32 * db + r32] = (bf16_t)(attn::cvtpk(acc[d][db][r], 0.f) & 0xffffu); }
    __syncthreads();
}

__device__ __forceinline__ void state_scan(const Params& p) {
    int tid_ = threadIdx.x; asm volatile("" : "+v"(tid_));
    for (long gt = (long)blockIdx.x * NTHR + tid_; gt < 2L * 4 * 16384; gt += (long)gridDim.x * NTHR) {
    const int pair = (int)(gt & 16383), h = (int)((gt >> 14) & 3), dir = (int)(gt >> 16);
    const float G = __builtin_amdgcn_exp2f(128.0f * log2_sigmoid((dir ? p.dec_b : p.dec_f)[h]));
    float s0 = 0.f, s1 = 0.f;
    for (int n = 0; n < NQ; ++n) {
        const int q = dir == 0 ? n : (n < 2 ? 1 - n : NQ + 1 - n);
        unsigned* ptr = (unsigned*)slot(p, dir, q, h) + pair;
        const unsigned u = *ptr;
        *ptr = attn::cvtpk(s0, s1);
        s0 = G * s0 + __uint_as_float(u << 16); s1 = G * s1 + __uint_as_float(u & 0xffff0000u);
    }    }
}

__device__ __forceinline__ void output_unit(const Params& p, int q, int h, char* lds) {
    int tid_ = threadIdx.x; asm volatile("" : "+v"(tid_));
    const int tid = tid_, lane = tid & 63, wave = __builtin_amdgcn_readfirstlane(tid >> 6), r32 = lane & 31, hi = lane >> 5;
    const int ib = wave >> 1, eh = wave & 1;
    const bf16_t* P = ws_big(p) + (size_t)q * 128 * P0W;
    const float lgf = log2_sigmoid(p.dec_f[h]), lgb = log2_sigmoid(p.dec_b[h]);
    const int sr = tid >> 4, sc = (tid & 15) * 8, st0 = attn::v_st(sr, sc), st1 = attn::v_st(32 + sr, sc);
    bf16x8 qr[8];
    { const bf16_t* Qw = P + (size_t)(ib * 32 + r32) * P0W + C_QA + h * 128 + hi * 8;
#pragma unroll
      for (int d0 = 0; d0 < 8; ++d0) qr[d0] = *(const bf16x8*)(Qw + d0 * 16); }
    { const bf16_t* Sf = slot(p, 0, q, h); const bf16_t* Sb = slot(p, 1, q, h);
      bf16x8 sv[16];
#pragma unroll
      for (int k = 0; k < 8; ++k) { const int i = tid + 512 * k; sv[k] = *(const bf16x8*)(Sf + (size_t)i * 8); sv[8 + k] = *(const bf16x8*)(Sb + (size_t)i * 8); }
#pragma unroll
      for (int k = 0; k < 8; ++k) { const int i = tid + 512 * k, e = i >> 4, cb = (i & 15) * 16;
          *(bf16x8*)(lds + RKSWZ(e, cb)) = sv[k]; *(bf16x8*)(lds + 65536 + RKSWZ(e, cb)) = sv[8 + k]; } }
    __syncthreads();
    bf16x8 kvr[12];
    f32x16 o[4] = {};
    const int i_loc = ib * 32 + r32;
    { const float scf = __builtin_amdgcn_exp2f((float)(i_loc + 1) * lgf), scb = __builtin_amdgcn_exp2f((float)(128 - i_loc) * lgb);
#pragma unroll
      for (int dir = 0; dir < 2; ++dir) {
          const char* Sl = lds + dir * 65536;
          if (dir == 1) {
#pragma unroll
    for (int jt = 0; jt < 2; ++jt) {
        const bf16_t* r0 = P + (size_t)(jt * 64 + sr) * P0W; const bf16_t* r1 = r0 + (size_t)32 * P0W;
        kvr[jt * 6 + 0] = *(const bf16x8*)(r0 + C_KA + h * 128 + sc); kvr[jt * 6 + 1] = *(const bf16x8*)(r1 + C_KA + h * 128 + sc);
#pragma unroll
        for (int e2 = 0; e2 < 2; ++e2) { kvr[jt * 6 + 2 + e2 * 2] = *(const bf16x8*)(r0 + C_VA + h * 256 + e2 * 128 + sc); kvr[jt * 6 + 3 + e2 * 2] = *(const bf16x8*)(r1 + C_VA + h * 256 + e2 * 128 + sc); }
    }
          }
#pragma unroll
          for (int ks = 0; ks < 8; ++ks) { const bf16x8 a = scale8(qr[ks], dir ? scb : scf); const int cb = (ks * 16 + hi * 8) * 2;
              bf16x8 f[4];
#pragma unroll
              for (int d0 = 0; d0 < 4; ++d0) f[d0] = *(const bf16x8*)(Sl + RKSWZ(eh * 128 + d0 * 32 + r32, cb));
#pragma unroll
              for (int d0 = 0; d0 < 4; ++d0) o[d0] = __builtin_amdgcn_mfma_f32_32x32x16_bf16(a, f[d0], o[d0], 0, 0, 0); } } }
    __syncthreads();
#pragma unroll
    for (int jt = 0; jt < 2; ++jt) { char* kt = lds + jt * 16384;
        *(bf16x8*)(kt + RKSWZ(sr, sc * 2)) = kvr[jt * 6 + 0]; *(bf16x8*)(kt + RKSWZ(32 + sr, sc * 2)) = kvr[jt * 6 + 1];
#pragma unroll
        for (int e2 = 0; e2 < 2; ++e2) { char* vt = lds + 32768 + (jt * 2 + e2) * 16384; *(bf16x8*)(vt + st0) = kvr[jt * 6 + 2 + e2 * 2]; *(bf16x8*)(vt + st1) = kvr[jt * 6 + 3 + e2 * 2]; } }
    __syncthreads();
    const int vb0 = (int)(uintptr_t)lds + 32768 + attn::v_rd_base(lane);
#pragma unroll
    for (int jt = 0; jt < 2; ++jt) {
        f32x16 p0, p1;
        attn::qkt(p0, p1, (const attn::bf16*)(lds + jt * 16384), qr, r32, hi);
#pragma unroll
        for (int r = 0; r < 16; ++r) {
            const int j0 = jt * 64 + attn::crow(r, hi), dl0 = i_loc - j0, dl1 = dl0 - 32;
            const float m0 = dl0 > 0 ? __builtin_amdgcn_exp2f((float)dl0 * lgf) : (dl0 < 0 ? __builtin_amdgcn_exp2f((float)(-dl0) * lgb) : 2.0f);
            const float m1 = dl1 > 0 ? __builtin_amdgcn_exp2f((float)dl1 * lgf) : (dl1 < 0 ? __builtin_amdgcn_exp2f((float)(-dl1) * lgb) : 2.0f);
            p0[r] *= m0; p1[r] *= m1;
        }
        bf16x8 pa0, pa1, pa2, pa3; pk4(p0, 0, pa0); pk4(p0, 8, pa1); pk4(p1, 0, pa2); pk4(p1, 8, pa3);
        __builtin_amdgcn_sched_barrier(0);
        attn::pv_d0(o, vb0 + (jt * 2 + eh) * 16384, pa0, pa1, pa2, pa3);
    }
    __syncthreads();
    float* O = (float*)lds;
#pragma unroll
    for (int r = 0; r < 16; ++r)
#pragma unroll
        for (int d0 = 0; d0 < 4; ++d0) O[(ib * 32 + attn::crow(r, hi)) * 256 + eh * 128 + d0 * 32 + r32] = o[d0][r];
    __syncthreads();
    bf16_t* BR = ws_br(p) + (size_t)q * 128 * 2048 + h * 256;
#pragma unroll 4
    for (int rr = 0; rr < 16; ++rr) {
        const int row = wave * 16 + rr; const f32x4 x = *(const f32x4*)(O + row * 256 + lane * 4);
        const float mean = rw::wave_sum((x[0] + x[1]) + (x[2] + x[3])) * (1.0f / 256.f);
        const f32x4 d = x - mean;
        const float var = rw::wave_sum((d[0] * d[0] + d[1] * d[1]) + (d[2] * d[2] + d[3] * d[3])) * (1.0f / 256.f);
        const float rstd = 1.0f / sqrtf(var + NORM_EPS);
        f32x4 y = d * rstd;
        if (q < 2) { const u32x2 gg = *(const u32x2*)((const bf16_t*)(p.ws + 255 * MiB) + (size_t)(q * 128 + row) * 2048 + h * 256 + lane * 4);
            y[0] *= __uint_as_float(gg.x << 16); y[1] *= __uint_as_float(gg.x & 0xffff0000u); y[2] *= __uint_as_float(gg.y << 16); y[3] *= __uint_as_float(gg.y & 0xffff0000u); }
        u32x2 w; w.x = attn::cvtpk(y[0], y[1]); w.y = attn::cvtpk(y[2], y[3]);
        *(u32x2*)(BR + (size_t)row * 2048 + lane * 4) = w;
    }
    __syncthreads();
}
#undef RPK
#undef RKSWZ
}

namespace na {
using attn::bf16x8; using attn::f32x16; using attn::u32x4;
constexpr float L2E = 1.4426950408889634f;
constexpr int WH = GROWS < 8 ? GROWS : 8;
constexpr int L_K = 0, L_V = 32768, L_WS = 65536, L_RPB = L_WS + NWAVES * 64 * 4, L_END = L_RPB + 15 * 31 * 4;
#define NKSWZ(row, colB) ((row) * 256 + ((colB) ^ (((row) & 7) << 4)))
__device__ __forceinline__ int win_r0(int r) { int r0 = r - WH / 2; return r0 < 0 ? 0 : (r0 > GROWS - WH ? GROWS - WH : r0); }
__device__ __forceinline__ int win_c0(int c) { int c0 = c - 8; return c0 < 0 ? 0 : (c0 > GW - 16 ? GW - 16 : c0); }

__device__ __forceinline__ void na_unit(const Params& p, int rg, int h, char* lds) {
    int tid_ = threadIdx.x; asm volatile("" : "+v"(tid_));
    const int tid = tid_, lane = tid & 63, wave = __builtin_amdgcn_readfirstlane(tid >> 6), r32 = lane & 31, hi = lane >> 5;
    const bf16_t* P = ws_big(p); const bf16_t* NAC = (const bf16_t*)(p.ws + 255 * MiB);
    const int r = 4 * rg + (wave >> 1), qc = (wave & 1) * 32 + r32, my_r0 = win_r0(r), my_c0 = win_c0(qc);
    const int lo = win_r0(4 * rg), hiw = win_r0(4 * rg + 3) + WH, NT = hiw - lo + CTXN / 64;
    float* wsf = (float*)(lds + L_WS) + wave * 64; float* rpb_l = (float*)(lds + L_RPB);
    if (tid < 15 * 31) rpb_l[tid] = p.rpb[h * 15 * 31 + tid];
    bf16x8 qr[4];
    { const bf16_t* Qw = P + (size_t)(CTXN + r * 64 + qc) * NAW + h * 64 + hi * 8;
#pragma unroll
      for (int d0 = 0; d0 < 4; ++d0) { u32x4 w = *(const u32x4*)(Qw + d0 * 16);
        for (int i = 0; i < 4; ++i) w[i] = attn::cvtpk(__uint_as_float(w[i] << 16) * 0.125f, __uint_as_float(w[i] & 0xffff0000u) * 0.125f);
        qr[d0] = *reinterpret_cast<bf16x8*>(&w); } }
    const int sk = tid >> 3, sc = (tid & 7) * 8, kst = NKSWZ(sk, sc * 2), vst = attn::v_st(sk, sc);
    bf16x8 kA, vA, kB, vB;
#define NA_LOAD(KR, VR, t) do { if ((t) < hiw - lo) { const int krow_ = CTXN + (lo + (t)) * 64 + sk; \
            KR = *(const bf16x8*)(P + (size_t)krow_ * NAW + 1024 + h * 64 + sc); VR = *(const bf16x8*)(P + (size_t)krow_ * NAW + 2048 + h * 64 + sc); } \
        else { const bf16_t* c_ = NAC + (size_t)(((t) - (hiw - lo)) * 64 + sk) * 2048 + h * 64 + sc; KR = *(const bf16x8*)c_; VR = *(const bf16x8*)(c_ + 1024); } } while (0)
#define NA_WRITE(KR, VR, b) do { *(bf16x8*)(lds + L_K + (b) * 16384 + kst) = KR; *(bf16x8*)(lds + L_V + (b) * 16384 + vst) = VR; } while (0)
    NA_LOAD(kA, vA, 0); NA_WRITE(kA, vA, 0);
    NA_LOAD(kB, vB, 1);
    __syncthreads();
    float m_reg = -1e30f, l_reg = 0.f; f32x16 o[2] = {};
    const int dl = 4 * hi - my_c0;
    const int vb0 = (int)(uintptr_t)lds + L_V + attn::v_rd_base(lane);
#define NA_TILE(t, KW, VW, KL, VL) do { \
        if ((t) + 2 < NT) NA_LOAD(KL, VL, (t) + 2);            \
        const bool is_ctx = (t) >= hiw - lo; const int kr = lo + (t); \
        if (is_ctx || (kr >= my_r0 && kr < my_r0 + WH)) { \
            const char* Ks = lds + L_K + ((t) & 1) * 16384; \
            f32x16 p0 = {}, p1 = {}; \
            _Pragma("unroll") for (int d0 = 0; d0 < 4; ++d0) { const int cb = (d0 * 16 + hi * 8) * 2; \
                const bf16x8 b0 = *(const bf16x8*)(Ks + NKSWZ(r32, cb)), b1 = *(const bf16x8*)(Ks + NKSWZ(32 + r32, cb)); \
                p0 = __builtin_amdgcn_mfma_f32_32x32x16_bf16(b0, qr[d0], p0, 0, 0, 0); p1 = __builtin_amdgcn_mfma_f32_32x32x16_bf16(b1, qr[d0], p1, 0, 0, 0); } \
            if (!is_ctx) {     \
                const float* bb = rpb_l + (kr - r + 7) * 31 + 15 - qc + 4 * hi; float bz0[16], bz1[16]; \
                _Pragma("unroll") for (int q = 0; q < 16; ++q) { const int cq = (q & 3) + 8 * (q >> 2); bz0[q] = bb[cq]; bz1[q] = bb[cq + 32]; } \
                _Pragma("unroll") for (int q = 0; q < 16; ++q) { const int cq = (q & 3) + 8 * (q >> 2); \
                    p0[q] = (unsigned)(cq + dl) < 16u ? p0[q] + bz0[q] : -1e30f; p1[q] = (unsigned)(cq + 32 + dl) < 16u ? p1[q] + bz1[q] : -1e30f; } \
            } \
            float pmax = p0[0]; \
            _Pragma("unroll") for (int q = 1; q < 16; ++q) pmax = fmaxf(pmax, p0[q]); \
            _Pragma("unroll") for (int q = 0; q < 16; ++q) pmax = fmaxf(pmax, p1[q]); \
            { auto rr = __builtin_amdgcn_permlane32_swap(__float_as_uint(pmax), __float_as_uint(pmax), false, false); pmax = fmaxf(__uint_as_float(rr[0]), __uint_as_float(rr[1])); } \
            const float mn = fmaxf(m_reg, pmax), alpha = __builtin_amdgcn_exp2f((m_reg - mn) * L2E), mnl = -mn * L2E; m_reg = mn; \
            float ps = 0.f; \
            _Pragma("unroll") for (int q = 0; q < 16; ++q) { p0[q] = __builtin_amdgcn_exp2f(fmaf(p0[q], L2E, mnl)); p1[q] = __builtin_amdgcn_exp2f(fmaf(p1[q], L2E, mnl)); ps += p0[q] + p1[q]; } \
            { auto rr = __builtin_amdgcn_permlane32_swap(__float_as_uint(ps), __float_as_uint(ps), false, false); ps = __uint_as_float(rr[0]) + __uint_as_float(rr[1]); } \
            l_reg = l_reg * alpha + ps; \
            if (__any(alpha < 1.f)) { if (hi == 0) wsf[r32] = alpha; asm volatile("s_waitcnt lgkmcnt(0)" ::: "memory"); \
                _Pragma("unroll") for (int d = 0; d < 2; ++d) _Pragma("unroll") for (int q = 0; q < 16; ++q) o[d][q] *= wsf[attn::crow(q, hi)]; } \
            bf16x8 pa0, pa1, pa2, pa3; ret::pk4(p0, 0, pa0); ret::pk4(p0, 8, pa1); ret::pk4(p1, 0, pa2); ret::pk4(p1, 8, pa3); \
            __builtin_amdgcn_sched_barrier(0); \
            const int vb = vb0 + ((t) & 1) * 16384; \
            attn::pv_one<0>(o[0], vb, pa0, pa1, pa2, pa3); attn::pv_one<1>(o[1], vb, pa0, pa1, pa2, pa3); \
        } \
        if ((t) + 1 < NT) NA_WRITE(KW, VW, ((t) + 1) & 1);     \
        __syncthreads(); } while (0)
    for (int t = 0; t < NT; t += 2) {
        NA_TILE(t, kB, vB, kA, vA);
        if (t + 1 < NT) NA_TILE(t + 1, kA, vA, kB, vB);
    }
#undef NA_TILE
#undef NA_LOAD
#undef NA_WRITE
    if (hi == 0) wsf[32 + r32] = l_reg; asm volatile("s_waitcnt lgkmcnt(0)" ::: "memory");
    bf16_t* Ow = ws_br(p) + (size_t)(CTXN + r * 64 + (wave & 1) * 32) * 2048 + h * 64;
#pragma unroll
    for (int q = 0; q < 16; ++q) { const int orow = attn::crow(q, hi); const float rl = __builtin_amdgcn_rcpf(wsf[32 + orow]);
#pragma unroll
        for (int d0 = 0; d0 < 2; ++d0) Ow[(size_t)orow * 2048 + d0 * 32 + r32] = (bf16_t)(attn::cvtpk(o[d0][q] * rl, 0.f) & 0xffffu); }
    __syncthreads();
}
#undef NKSWZ
}

namespace el {
typedef float f32x4 __attribute__((ext_vector_type(4)));
typedef unsigned u32x2 __attribute__((ext_vector_type(2)));
__device__ __forceinline__ float wsum(float v) { return rw::wave_sum(v); }
__device__ __forceinline__ unsigned pk(float lo, float hi) { unsigned r; asm volatile("v_cvt_pk_bf16_f32 %0, %1, %2" : "=v"(r) : "v"(lo), "v"(hi)); return r; }

__device__ __forceinline__ void mod_phase(const Params& p, char* lds) {
    int tid_ = threadIdx.x; asm volatile("" : "+v"(tid_));
    const int tid = tid_, ks = tid >> 6, jl = tid & 63;
    float* sc = (float*)lds; float* red = sc + 2048;
    for (int b = blockIdx.x; b < 2 * 48; b += gridDim.x) {
        const int l = b / 48, j = (b % 48) * 64 + jl;
        __syncthreads();
        for (int k = tid; k < 2048; k += NTHR) { const float x = k < 1024 ? p.c[k] : p.c_ctx[k - 1024]; sc[k] = x / (1.0f + __expf(-x)); }
        __syncthreads();
        const float* w = p.w_mod + (size_t)l * DM * 3072 + (size_t)(ks * 128) * 3072 + j; float a0 = 0.f, a1 = 0.f;
#pragma unroll 8
        for (int k = 0; k < 128; ++k) { const float wv = w[(size_t)k * 3072]; a0 += sc[ks * 128 + k] * wv; a1 += sc[1024 + ks * 128 + k] * wv; }
        red[ks * 64 + jl] = a0; red[512 + ks * 64 + jl] = a1;
        __syncthreads();
        if (tid < 128) { const int s = tid >> 6; float t = 0.f;
#pragma unroll
            for (int q = 0; q < 8; ++q) t += red[s * 512 + q * 64 + jl];
            ws_modv(p)[(l * 2 + s) * 3072 + j] = t + p.b_mod[l * 3072 + j]; }
    }
    __syncthreads();
}

template <int LAYER> __device__ __forceinline__ void modnorm_store(const Params& p, const f32x4 (&v)[4], int row, int lane) {
    const float* mv = ws_modv(p) + (LAYER * 2 + (row < CTXN ? 1 : 0)) * 3072; const float* g = p.g_pre + LAYER * DM;
    float ss = 0.f;
#pragma unroll
    for (int j = 0; j < 4; ++j) ss += (v[j][0] * v[j][0] + v[j][1] * v[j][1]) + (v[j][2] * v[j][2] + v[j][3] * v[j][3]);
    const float rstd = 1.0f / sqrtf(wsum(ss) * (1.0f / DM) + NORM_EPS);
    bf16_t* o = ws_xn(p) + (size_t)row * DM;
#pragma unroll
    for (int j = 0; j < 4; ++j) { const int c = lane * 4 + 256 * j;
        const f32x4 gg = *(const f32x4*)(g + c), sh = *(const f32x4*)(mv + c), sc = *(const f32x4*)(mv + 1024 + c);
        const f32x4 y = v[j] * rstd * gg * (sc + 1.0f) + sh;
        u32x2 w; w.x = pk(y[0], y[1]); w.y = pk(y[2], y[3]); *(u32x2*)(o + c) = w; }
}
__device__ __forceinline__ void prenorm0_phase(const Params& p) {
    int tid_ = threadIdx.x; asm volatile("" : "+v"(tid_));
    const int lane = tid_ & 63, gw = (int)blockIdx.x * NWAVES + (tid_ >> 6), ngw = (int)gridDim.x * NWAVES;
    for (int row = gw; row < R; row += ngw) {
        const float* src = row < CTXN ? p.ctx + (size_t)row * DM : p.x + (size_t)(row - CTXN) * DM;
        f32x4 v[4];
#pragma unroll
        for (int j = 0; j < 4; ++j) v[j] = *(const f32x4*)(src + lane * 4 + 256 * j);
        modnorm_store<0>(p, v, row, lane);
    }
}
template <int LAYER> __device__ __forceinline__ void resid_phase(const Params& p) {
    int tid_ = threadIdx.x; asm volatile("" : "+v"(tid_));
    const int lane = tid_ & 63, gw = (int)blockIdx.x * NWAVES + (tid_ >> 6), ngw = (int)gridDim.x * NWAVES;
    for (int row = (LAYER == 0 ? 0 : CTXN) + gw; row < R; row += ngw) {
        const bool ctxsum = LAYER == 0 && row < CTXN;
        const float* y = ctxsum ? (const float*)(p.ws + WS_BIG + 72 * MiB) + (size_t)row * DM : ws_y(p) + (size_t)row * DM; const float* mv = ws_modv(p) + (LAYER * 2 + (row < CTXN ? 1 : 0)) * 3072 + 2048; const float* g = p.g_post + LAYER * DM;
        const float* src; float* dst;
        if (row < CTXN) { src = p.ctx + (size_t)row * DM; dst = ws_ctx1(p) + (size_t)row * DM; }
        else { src = (LAYER == 0 ? p.x : p.out) + (size_t)(row - CTXN) * DM; dst = p.out + (size_t)(row - CTXN) * DM; }
        f32x4 yv[4]; float ss = 0.f;
#pragma unroll
        for (int j = 0; j < 4; ++j) { yv[j] = *(const f32x4*)(y + lane * 4 + 256 * j);
            if (ctxsum) { _Pragma("unroll") for (int s = 1; s < 8; ++s) yv[j] += *(const f32x4*)(y + (size_t)s * CTXN * DM + lane * 4 + 256 * j); }
            ss += (yv[j][0] * yv[j][0] + yv[j][1] * yv[j][1]) + (yv[j][2] * yv[j][2] + yv[j][3] * yv[j][3]); }
        const float rstd = 1.0f / sqrtf(wsum(ss) * (1.0f / DM) + NORM_EPS);
        f32x4 xn[4];
#pragma unroll
        for (int j = 0; j < 4; ++j) { const int c = lane * 4 + 256 * j;
            xn[j] = *(const f32x4*)(src + c) + *(const f32x4*)(mv + c) * (yv[j] * rstd * *(const f32x4*)(g + c));
            *(f32x4*)(dst + c) = xn[j]; }
        if (LAYER == 0) modnorm_store<1>(p, xn, row, lane);
    }
}
__device__ __forceinline__ void ropenorm_phase(const Params& p) {
    int tid_ = threadIdx.x; asm volatile("" : "+v"(tid_));
    const int lane = tid_ & 63, gw = (int)blockIdx.x * NWAVES + (tid_ >> 6), ngw = (int)gridDim.x * NWAVES;
    const float* ct = ws_rope(p); const float* st = ct + N_ROPE;
    const float qn0 = p.q_norm[2 * lane], qn1 = p.q_norm[2 * lane + 1], kn0 = p.k_norm[2 * lane], kn1 = p.k_norm[2 * lane + 1];
    for (int row = gw; row < R; row += ngw) {
        const bool rot = row >= CTXN; const int t = row - CTXN; float cs = 1.f, sn = 0.f;
        if (rot) { const int pos = lane < 32 ? t / GW : t % GW, f = lane & 31; cs = ct[pos * 32 + f]; sn = st[pos * 32 + f]; }
        bf16_t* base = ws_big(p) + (size_t)row * P0W;
#pragma unroll
        for (int slot = 0; slot < 18; ++slot) {
            const int col = slot < 4 ? C_QA + slot * 128 : slot < 8 ? C_KA + (slot - 4) * 128 : slot < 16 ? C_QB + (slot - 8) * 128 : C_KB + (slot - 16) * 128;
            unsigned* ptr = (unsigned*)(base + col) + lane; const unsigned u = *ptr;
            float x1 = __uint_as_float(u << 16), x2 = __uint_as_float(u & 0xffff0000u);
            if (slot >= 4 && slot < 8) { x1 *= 0.08838834764831845f; x2 *= 0.08838834764831845f; }
            if (slot >= 8) { const float sc = 1.0f / sqrtf(wsum(x1 * x1 + x2 * x2) * (1.0f / 128.f) + NORM_EPS);
                x1 *= sc * (slot < 16 ? qn0 : kn0); x2 *= sc * (slot < 16 ? qn1 : kn1); }
            *ptr = pk(x1 * cs - x2 * sn, x1 * sn + x2 * cs);
        }
    }
}
}

constexpr int RING_BYTES = 131072, LDS_BYTES = 163840;
constexpr size_t WS_BAR = 256 * 1024;
constexpr size_t WS_SIDE = 255 * MiB;
constexpr size_t WS_YC = WS_BIG + 72 * MiB;
constexpr int LDS_BARW = LDS_BYTES - 64;
constexpr size_t WB_IN0 = WS_WB, WB_OUT0 = WB_IN0 + (size_t)EVEN_IN * DM * 2, WB_IN1 = WB_OUT0 + (size_t)DM * 2048 * 2, WB_OUT1 = WB_IN1 + (size_t)ODD_IN * DM * 2, WB_END = WB_OUT1 + (size_t)DM * 2048 * 2;
static_assert(WB_END <= WS_XN, "weight copies overflow their region");
static_assert(wy::WS_RING + wy::RING_TOTAL <= WB_IN1 && XCD_BAR_WORDS * 4 <= 16384 && wy::WS_WYF + (size_t)wy::WYF_WORDS * 4 <= WS_CTX1, "rwkv ring / flag words");

__device__ __forceinline__ unsigned pk2(float lo, float hi) { return (unsigned)f2bf(lo) | ((unsigned)f2bf(hi) << 16); }
__device__ __forceinline__ void transpose_item(const float* W, int K, int N, int ldw, bf16_t* WT, LAS float* scr, int item, int lane) {
    const int nblk = N / 32, kb = item / nblk, nb = item % nblk, k0 = 64 * kb, n0 = 32 * nb;
#pragma unroll 8
    for (int i = 0; i < 32; ++i) { const int kk = 2 * i + (lane >> 5); scr[kk * 33 + (lane & 31)] = W[(size_t)(k0 + kk) * ldw + n0 + (lane & 31)]; }
    asm volatile("s_waitcnt lgkmcnt(0)" ::: "memory");
    const int c = lane & 7;
#pragma unroll
    for (int j = 0; j < 4; ++j) { const int n = (lane >> 3) + 8 * j; const LAS float* s = scr + (8 * c) * 33 + n;
        v4u o; o.x = pk2(s[0 * 33], s[1 * 33]); o.y = pk2(s[2 * 33], s[3 * 33]); o.z = pk2(s[4 * 33], s[5 * 33]); o.w = pk2(s[6 * 33], s[7 * 33]);
        *(v4u*)(WT + (size_t)(n0 + n) * K + k0 + 8 * c) = o; }
    asm volatile("s_waitcnt lgkmcnt(0)" ::: "memory");
}
__device__ __forceinline__ void p0_weights(const Params& p, LAS unsigned char* lds) {
    const int lane = threadIdx.x & 63, wave = __builtin_amdgcn_readfirstlane(threadIdx.x >> 6);
    LAS float* scr = (LAS float*)(lds + wave * 16384);
    const int gw = blockIdx.x * NWAVES + wave, NGW = gridDim.x * NWAVES;
    constexpr int I_IN0 = (DM / 64) * (EVEN_IN / 32), I_OUT = (2048 / 64) * (DM / 32), I_IN1 = (DM / 64) * (ODD_IN / 32);
    for (int it = gw; it < I_IN0 + I_OUT + I_IN1 + I_OUT; it += NGW) {
        int r = it;
        if (r < I_IN0) { transpose_item(p.ev_w_in, DM, EVEN_IN, EVEN_IN, (bf16_t*)(p.ws + WB_IN0), scr, r, lane); continue; } r -= I_IN0;
        if (r < I_OUT) { transpose_item(p.ev_w_out, 2048, DM, DM, (bf16_t*)(p.ws + WB_OUT0), scr, r, lane); continue; } r -= I_OUT;
        if (r < I_IN1) { transpose_item(p.od_w_in, DM, ODD_IN, ODD_IN, (bf16_t*)(p.ws + WB_IN1), scr, r, lane); continue; } r -= I_IN1;
        transpose_item(p.od_w_out, 2048, DM, DM, (bf16_t*)(p.ws + WB_OUT1), scr, r, lane);
    }
}

template <class Epi> __device__ __forceinline__ void run_gemm(LAS unsigned char* lds, const bf16_t* A, const bf16_t* Bt, int M, int N, int K, const Epi& E, int rot = 0, int lda = 0, int ldb = 0) {
    const int G = (int)gridDim.x;
    pg8::Gemm g{A, Bt, M, N, K, lda, ldb}; pg8::StaticOrder S; S.init(M, N, G, ((int)blockIdx.x + rot) % G);
    pg8::gemm_phase<Epi, pg8::StaticOrder, true, true>(lds, g, S, E);
}
__device__ __forceinline__ int tail_rot(int units) { const int G = (int)gridDim.x; return (G - units % G) % G; }

#ifndef PROBE
#define PROBE 0
#endif
#define REP(bit) for (int rep_ = 0; rep_ < (((PROBE) >> (bit)) & 1) + 1; ++rep_)
__global__ void __launch_bounds__(NTHR, 2) mega(Params p) {
    extern __shared__ __attribute__((aligned(16))) unsigned char lds_raw[];
    cg::grid_group grid = cg::this_grid();
    LAS unsigned char* lds = (LAS unsigned char*)lds_raw;
    const long gsz = (long)gridDim.x * NTHR;
    if (threadIdx.x < 2) *(LAS unsigned*)(lds + LDS_BARW + 4 * threadIdx.x) = 0u;
    __syncthreads();
    const XcdBarrier xbar = xcd_barrier_post((unsigned*)(p.ws + WS_BAR), (volatile LAS unsigned*)(lds + LDS_BARW));
    const bf16_t* wt_in0 = (const bf16_t*)(p.ws + WB_IN0); const bf16_t* wt_out0 = (const bf16_t*)(p.ws + WB_OUT0);
    const bf16_t* wt_in1 = (const bf16_t*)(p.ws + WB_IN1); const bf16_t* wt_out1 = (const bf16_t*)(p.ws + WB_OUT1);
#define X(fn, n) { int t_ = threadIdx.x; asm volatile("" : "+v"(t_)); for (long g = (long)blockIdx.x * NTHR + t_; g < (long)(n); g += gsz) fn(p, g); }
#define SYNC xcd_barrier(xbar);
    if ((PROBE >> 13) & 1) { for (int i_ = 0; i_ < 20; ++i_) xcd_barrier(xbar); }
    REP(14) { el::mod_phase(p, (char*)lds_raw); X(ph_rope_table, N_ROPE) p0_weights(p, lds);
              if (p.out == nullptr) grid.sync();
              SYNC }
    REP(15) { el::prenorm0_phase(p); SYNC }
    REP(2) { run_gemm(lds, ws_xn(p), wt_in0, R, P0W, DM, pg8::EpiBf16<0>{ws_big(p), P0W, nullptr, 0, 0, 1.f});
             run_gemm(lds, ws_xn(p), wt_in0 + (size_t)C_GA * DM, CTXN, 2048, DM, pg8::EpiSiluBf16{(bf16_t*)(p.ws + WS_SIDE), 2048}, tail_rot((R / 256) * (P0W / 256)));
             SYNC }
    el::ropenorm_phase(p); SYNC
    REP(5) { for (int u = blockIdx.x; u < ret::NQ * 4; u += gridDim.x) { const int q = u < (ret::NQ - 2) * 4 ? 2 + u / 4 : (u - (ret::NQ - 2) * 4) / 4; ret::summaries_unit(p, q, u & 3, (char*)lds_raw); } SYNC }
    ret::state_scan(p); SYNC
#define CTX_ATTN_UNIT(head_) do { const int hd_ = (head_), kv_ = hd_ / 4; const bf16_t* P_ = ws_big(p); bf16_t* BR_ = ws_br(p); \
        attn::attn_dense_body<attn::bf16, false>(P_ + C_QB + hd_ * 128, P_ + C_KB + kv_ * 128, P_ + C_VB + kv_ * 128, BR_ + 1024 + hd_ * 128, CTXN, (char*)lds_raw); \
        __syncthreads(); \
        {     \
            int t_ = threadIdx.x; asm volatile("" : "+v"(t_)); const bf16_t* GC = (const bf16_t*)(p.ws + WS_SIDE); \
            const size_t o = (size_t)(t_ >> 1) * 2048 + 1024 + hd_ * 128 + (t_ & 1) * 64; \
            _Pragma("unroll") for (int i_ = 0; i_ < 8; ++i_) { v4u a = *(const v4u*)(BR_ + o + 8 * i_); const v4u b = *(const v4u*)(GC + o + 8 * i_); \
                _Pragma("unroll") for (int q_ = 0; q_ < 4; ++q_) a[q_] = attn::cvtpk(__uint_as_float(a[q_] << 16) * __uint_as_float(b[q_] << 16), __uint_as_float(a[q_] & 0xffff0000u) * __uint_as_float(b[q_] & 0xffff0000u)); \
                *(v4u*)(BR_ + o + 8 * i_) = a; } \
            __syncthreads(); } } while (0)
    const bool ctx_attn_early = gridDim.x >= 16;
    REP(6) { for (int u = blockIdx.x; u < ret::NQ * 4; u += gridDim.x) { const int q = u < (ret::NQ - 2) * 4 ? 2 + u / 4 : (u - (ret::NQ - 2) * 4) / 4; ret::output_unit(p, q, u & 3, (char*)lds_raw); }
             if (ctx_attn_early && (int)blockIdx.x >= (int)gridDim.x - 8) CTX_ATTN_UNIT((int)blockIdx.x - ((int)gridDim.x - 8));
             SYNC }
    REP(0) {
        const int G = (int)gridDim.x, vcu = (G % 8 == 0) ? ((int)blockIdx.x % 8) * (G / 8) + (int)blockIdx.x / 8 : (int)blockIdx.x;
        const int NLAT = (SEQ / 256) * 8, per = (NLAT + G - 1) / G;
        const bf16_t* P = ws_big(p); bf16_t* BR = ws_br(p);
        bool nomax; { int t_ = threadIdx.x; asm volatile("" : "+v"(t_)); const int l_ = t_ & 63; float gq = fmaxf(fabsf(p.q_norm[l_]), fabsf(p.q_norm[64 + l_])), gk = fmaxf(fabsf(p.k_norm[l_]), fabsf(p.k_norm[64 + l_]));
          for (int m_ = 32; m_ >= 1; m_ >>= 1) { gq = fmaxf(gq, __shfl_xor(gq, m_)); gk = fmaxf(gk, __shfl_xor(gk, m_)); }
          nomax = 11.3137085f * 1.4426950409f * 1.02f * gq * gk <= 40.0f; }
        for (int i = 0; i <= per; ++i) {
            int head, row0, seq;
            if (i < per) { const int unit = vcu * per + i; if (unit >= NLAT) continue; const int nqb = SEQ / 256, kv = unit / (4 * nqb), rem = unit % (4 * nqb); head = kv * 4 + rem / nqb; row0 = CTXN + (rem % nqb) * 256; seq = R; }
            else { if (ctx_attn_early || vcu >= 8) break; CTX_ATTN_UNIT(vcu); break; }
            const int kv = head / 4;
            if (nomax) attn::attn_dense_body<attn::bf16, true>(P + (size_t)row0 * P0W + C_QB + head * 128, P + C_KB + kv * 128, P + C_VB + kv * 128, BR + (size_t)row0 * 2048 + 1024 + head * 128, seq, (char*)lds_raw);
            else attn::attn_dense_body<attn::bf16, false>(P + (size_t)row0 * P0W + C_QB + head * 128, P + C_KB + kv * 128, P + C_VB + kv * 128, BR + (size_t)row0 * 2048 + 1024 + head * 128, seq, (char*)lds_raw);
            __syncthreads();
        }
        if (PROBE & 1) xcd_barrier(xbar);
    }
    SYNC
    run_gemm(lds, ws_xn(p) + (size_t)CTXN * DM, wt_in0 + (size_t)C_GA * DM, SEQ, 2048, DM, pg8::EpiGateMul{ws_br(p) + (size_t)CTXN * 2048, 2048});
    {
        pg8::Gemm gk{ws_br(p), wt_out0, 8 * 256, DM, 256, 2048, 2048, 256 * 2}; pg8::StaticOrder S; S.init(8 * 256, DM, (int)gridDim.x, (int)blockIdx.x);
        pg8::gemm_phase<pg8::EpiF32, pg8::StaticOrder, true, true>(lds, gk, S, pg8::EpiF32{(float*)(p.ws + WS_YC), DM}); }
    SYNC
    REP(4) { run_gemm(lds, ws_br(p) + (size_t)CTXN * 2048, wt_out0, SEQ, DM, 2048, pg8::EpiF32{ws_y(p) + (size_t)CTXN * DM, DM}); SYNC }
    REP(15) { el::resid_phase<0>(p); SYNC }
    REP(3) { run_gemm(lds, ws_xn(p), wt_in1 + (size_t)O_RW * DM, R, ZW, DM, pg8::EpiBf16Halo{ws_big(p), ZW, (bf16_t*)(p.ws + rw::WS_HALO)});
             run_gemm(lds, ws_xn(p), wt_in1 + (size_t)(O_NA + 1024) * DM, CTXN, 2048, DM, pg8::EpiBf16<0>{(bf16_t*)(p.ws + WS_SIDE), 2048, nullptr, 0, 0, 1.f}, tail_rot((R / 256) * (ZW / 256)));
             SYNC }
    rw::shift_inplace(p); wy::zero_words(p); SYNC
#ifndef PSKIP
#define PSKIP 0
#endif
    if ((PROBE >> 16) & 1) { wy::phase<1, PSKIP>(p, lds); SYNC wy::zero_words(p); SYNC }
    if ((PROBE >> 17) & 1) { wy::phase<2>(p, lds); SYNC wy::zero_words(p); SYNC }
    if ((PROBE >> 19) & 1) { wy::phase<4, 16>(p, lds); SYNC wy::zero_words(p); SYNC }
    if ((PROBE >> 18) & 1) { wy::phase<3>(p, lds); SYNC wy::zero_words(p); SYNC }
    if (gridDim.x >= 64) wy::phase<0>(p, lds);
    else { for (int b = blockIdx.x; b < 256; b += gridDim.x) rw::scan_block<0>(p, b, lds); }
    SYNC
    rw::finish_phase(p); SYNC
    REP(3) { run_gemm(lds, ws_xn(p) + (size_t)CTXN * DM, wt_in1 + (size_t)O_NA * DM, SEQ, NAW, DM, pg8::EpiBf16<0>{ws_big(p) + (size_t)CTXN * NAW, NAW, nullptr, 0, 0, 1.f}); SYNC }
    REP(7) { for (int u = blockIdx.x; u < (GROWS / 4) * 16; u += gridDim.x) na::na_unit(p, u >> 4, u & 15, (char*)lds_raw); SYNC }
    run_gemm(lds, ws_xn(p) + (size_t)CTXN * DM, wt_in1 + (size_t)O_GC * DM, SEQ, 2048, DM, pg8::EpiGateMul{ws_br(p) + (size_t)CTXN * 2048, 2048}); SYNC
    REP(4) { run_gemm(lds, ws_br(p) + (size_t)CTXN * 2048, wt_out1, SEQ, DM, 2048, pg8::EpiF32{ws_y(p) + (size_t)CTXN * DM, DM}); SYNC }
    el::resid_phase<1>(p);
#undef X
#undef SYNC
}

extern "C" void kernel_launch(void* const* d_in, const int* in_sizes, int n_in, void* d_out, int out_size, void* d_ws, size_t ws_size, hipStream_t stream) {
    static int grid_blocks = 0;
    if (!grid_blocks) {
        int dev = 0, cus = 0, per_cu = 0;
        (void)hipGetDevice(&dev); (void)hipDeviceGetAttribute(&cus, hipDeviceAttributeMultiprocessorCount, dev);
        (void)hipFuncSetAttribute((const void*)mega, hipFuncAttributeMaxDynamicSharedMemorySize, LDS_BYTES);
        (void)hipOccupancyMaxActiveBlocksPerMultiprocessor(&per_cu, mega, NTHR, LDS_BYTES);
        if (per_cu < 1) per_cu = 1;
        grid_blocks = cus * per_cu;
        if (ws_size < WS_END) fprintf(stderr, "kernel_launch: workspace too small: %zu < %zu\n", ws_size, (size_t)WS_END);
    }
    (void)hipMemsetAsync((char*)d_ws + WS_BAR, 0, XCD_BAR_WORDS * 4, stream);
    Params p = make_params(d_in, d_out, d_ws);
    void* args[] = {&p};
    hipError_t e = hipLaunchCooperativeKernel((void*)mega, dim3(grid_blocks), dim3(NTHR), args, LDS_BYTES, stream);
    if (e != hipSuccess) fprintf(stderr, "cooperative launch failed: %s (grid %d)\n", hipGetErrorString(e), grid_blocks);
}

#else
int main(int argc, char** argv) {
    const char* dir = argc > 1 ? argv[1] : "data";
    char path[512]; snprintf(path, 512, "%s/sizes.txt", dir); FILE* f = fopen(path, "r"); if (!f) { printf("no sizes\n"); return 1; }
    std::vector<long> sizes; long v; while (fscanf(f, "%ld", &v) == 1) sizes.push_back(v); fclose(f);
    if (sizes.size() != 31) { printf("bad n inputs %zu\n", sizes.size()); return 1; }
    snprintf(path, 512, "%s/inputs.bin", dir); f = fopen(path, "rb");
    std::vector<std::vector<float>> in(31); std::vector<void*> ptrs(31);
    for (int i = 0; i < 31; ++i) { in[i].resize(sizes[i]); if (fread(in[i].data(), 4, sizes[i], f) != (size_t)sizes[i]) { printf("short read\n"); return 1; } ptrs[i] = in[i].data(); }
    fclose(f);
    if (sizes[0] != (long)SEQ * DM) { printf("SEQ mismatch: build with -DSEQ_LEN=%ld\n", sizes[0] / DM); return 1; }
    std::vector<float> out((size_t)SEQ * DM, 0.f); std::vector<unsigned char> ws(WS_END, 0xAA);
    Params p = make_params(ptrs.data(), out.data(), ws.data());
    auto check = [&](const char* name, const float* got, size_t n) {
        snprintf(path, 512, "%s/%s", dir, name); FILE* g = fopen(path, "rb"); std::vector<float> ref(n); if (fread(ref.data(), 4, n, g) != n) printf("short ref\n"); fclose(g);
        double num = 0, den = 0, mx = 0; for (size_t i = 0; i < n; ++i) { const double d = (double)got[i] - ref[i]; num += d * d; den += (double)ref[i] * ref[i]; if (fabs(d) > mx) mx = fabs(d); }
        printf("%s: rvr=%.3e absmax=%.3e\n", name, num / den, mx); };
    static RwShared sh;
    int phase = 0;
#define X(fn, n) { printf("phase %d %s n=%ld\n", phase++, #fn, (long)(n)); fflush(stdout); _Pragma("omp parallel for schedule(dynamic, 64)") for (long g = 0; g < (long)(n); ++g) fn(p, g); }
#define SYNC
#define SCAN { printf("phase %d scan\n", phase++); fflush(stdout); _Pragma("omp parallel for schedule(dynamic, 1)") for (int b = 0; b < 32; ++b) { RwShared* s = new RwShared; rwkv_scan_block(p, b, *s); delete s; } }
    X(ph_mod, N_MOD) X(ph_rope_table, N_ROPE) X(ph_prenorm<0>, (long)R) X(ph_gemm_l0_qkv, (long)R * P0W) X(ph_ropenorm, N_ROPENORM) X(ph_ret_scan, N_RETSCAN)
    X(ph_ret_merge, N_RETMERGE) X(ph_gqa_attn, N_GQA) X(ph_gemm_l0_gate, (long)R * 2048) X(ph_gemm_l0_out, (long)R * DM) X(ph_resid<0>, (long)R)
    check("x0.bin", out.data(), out.size()); check("ctx0.bin", ws_ctx1(p), (size_t)CTXN * DM);
    X(ph_prenorm<1>, (long)R) X(ph_gemm_l1_rw, (long)R * ZW) SCAN X(ph_rwkv_finish, N_RWFIN) X(ph_gemm_l1_na, (long)R * NAW) X(ph_na, N_NA)
    X(ph_gemm_l1_gate, (long)SEQ * 2048) X(ph_gemm_l1_out, (long)SEQ * DM) X(ph_resid<1>, (long)SEQ)
    check("out.bin", out.data(), out.size());
    return 0;
}
#endif
```

```cpp
#ifdef CPU_EMU
#include <cstdio>
#include <cstdlib>
#include <cstring>
#include <cmath>
#include <vector>
#define DEV static inline
#else
#include <hip/hip_runtime.h>
#include <hip/hip_cooperative_groups.h>
#include <cstdio>
namespace cg = cooperative_groups;
#define DEV __device__ __forceinline__
#endif

#ifndef SEQ_LEN
#define SEQ_LEN 16384
#endif
typedef unsigned short bf16_t;
constexpr int DM = 1024, CTXN = 256, SEQ = SEQ_LEN, R = CTXN + SEQ, GW = 64, GROWS = SEQ / GW;
constexpr int EVEN_IN = 5632, ODD_IN = 8448;
constexpr int P0W = 3584;
constexpr int C_QA = 0, C_KA = 512, C_VA = 1024, C_QB = 2048, C_KB = 3072, C_VB = 3328, C_GA = 3584;
constexpr int ZW = 3328;
constexpr int O_NA = 0, O_RW = 3072, O_GC = 6400;
constexpr int NAW = 3072;
constexpr float NORM_EPS = 1e-6f, GN_EPS = 64e-5f;

constexpr size_t MiB = 1u << 20;
constexpr size_t WS_MODV = 0;
constexpr size_t WS_ROPE = 64 * 1024;
constexpr size_t WS_CTX1 = 1 * MiB;
constexpr size_t WS_WB = 2 * MiB;
constexpr size_t WS_XN = 42 * MiB;
constexpr size_t WS_BIG = WS_XN + (((size_t)R * DM * 2 + MiB - 1) / MiB) * MiB;
constexpr size_t WS_BR = WS_BIG + (((size_t)R * P0W * 2 + MiB - 1) / MiB) * MiB;
constexpr size_t WS_END = WS_BR + (size_t)R * 2048 * 2;
static_assert(SEQ != 16384 || WS_END <= 256 * MiB, "workspace map exceeds 256 MiB");

struct Params {
    const float *x, *c, *ctx, *c_ctx, *w_mod, *b_mod, *g_pre, *g_post, *ev_w_in, *ev_w_out, *dec_f, *dec_b, *q_norm, *k_norm;
    const float *od_w_in, *od_w_out, *rpb, *mu, *w0f, *w2f, *w0b, *w2b, *a0f, *a2f, *a0b, *a2b, *k_k, *k_a, *r_k, *lnx_g, *lnx_b;
    float* out; unsigned char* ws;
};

DEV bf16_t f2bf(float f) { unsigned u; __builtin_memcpy(&u, &f, 4); u = (u + 0x7fffu + ((u >> 16) & 1u)) >> 16; return (bf16_t)u; }
DEV float bf2f(bf16_t h) { unsigned u = ((unsigned)h) << 16; float f; __builtin_memcpy(&f, &u, 4); return f; }
DEV float siluf(float x) { return x / (1.0f + expf(-x)); }
DEV float sigmf(float x) { return 1.0f / (1.0f + expf(-x)); }
DEV float softplusf(float x) { return fmaxf(x, 0.f) + log1pf(expf(-fabsf(x))); }

DEV float* ws_modv(const Params& p) { return (float*)(p.ws + WS_MODV); }
DEV float* ws_rope(const Params& p) { return (float*)(p.ws + WS_ROPE); }
DEV float* ws_ctx1(const Params& p) { return (float*)(p.ws + WS_CTX1); }
DEV bf16_t* ws_xn(const Params& p) { return (bf16_t*)(p.ws + WS_XN); }
DEV bf16_t* ws_big(const Params& p) { return (bf16_t*)(p.ws + WS_BIG); }
DEV float* ws_y(const Params& p) { return (float*)(p.ws + WS_BIG); }
DEV bf16_t* ws_br(const Params& p) { return (bf16_t*)(p.ws + WS_BR); }

constexpr long N_MOD = 2 * 2 * 3072;
DEV void ph_mod(const Params& p, long gid) {
    const int j = (int)(gid % 3072), s = (int)((gid / 3072) % 2), l = (int)(gid / 6144);
    const float* cv = s ? p.c_ctx : p.c; const float* w = p.w_mod + (size_t)l * DM * 3072 + j;
    float acc = 0.f;
    for (int k = 0; k < DM; ++k) acc += siluf(cv[k]) * w[(size_t)k * 3072];
    ws_modv(p)[gid] = acc + p.b_mod[l * 3072 + j];
}
constexpr long N_ROPE = 256 * 32;
DEV void ph_rope_table(const Params& p, long gid) {
    const int f = (int)(gid % 32), pos = (int)(gid / 32);
    const float inv = powf(10000.0f, -(float)f / 32.0f); const float ang = (float)pos * inv;
    ws_rope(p)[gid] = cosf(ang); ws_rope(p)[N_ROPE + gid] = sinf(ang);
}
template <int LAYER> DEV void ph_prenorm(const Params& p, long gid) {
    const int row = (int)gid; const int s = row < CTXN ? 1 : 0;
    const float* src = row < CTXN ? ((LAYER == 0 ? p.ctx : ws_ctx1(p)) + (size_t)row * DM) : ((LAYER == 0 ? p.x : p.out) + (size_t)(row - CTXN) * DM);
    const float* mv = ws_modv(p) + (LAYER * 2 + s) * 3072; const float* g = p.g_pre + LAYER * DM;
    float ss = 0.f;
    for (int k = 0; k < DM; ++k) ss += src[k] * src[k];
    const float rstd = 1.0f / sqrtf(ss / DM + NORM_EPS);
    bf16_t* o = ws_xn(p) + (size_t)row * DM;
    for (int k = 0; k < DM; ++k) o[k] = f2bf(src[k] * rstd * g[k] * (1.0f + mv[1024 + k]) + mv[k]);
}
template <int MODE> DEV void gemm_item(const bf16_t* A, int K, const float* W, int ldw, void* out, int pitch, int row, int col) {
    const bf16_t* a = A + (size_t)row * K; const float* w = W + col; float acc = 0.f;
    for (int k = 0; k < K; ++k) acc += bf2f(a[k]) * w[(size_t)k * ldw];
    if (MODE == 0) ((bf16_t*)out)[(size_t)row * pitch + col] = f2bf(acc);
    else if (MODE == 1) { bf16_t* o = (bf16_t*)out + (size_t)row * pitch + col; *o = f2bf(siluf(acc) * bf2f(*o)); }
    else ((float*)out)[(size_t)row * pitch + col] = acc;
}
DEV void ph_gemm_l0_qkv(const Params& p, long gid) { gemm_item<0>(ws_xn(p), DM, p.ev_w_in, EVEN_IN, ws_big(p), P0W, (int)(gid / P0W), (int)(gid % P0W)); }
DEV void ph_gemm_l0_gate(const Params& p, long gid) { gemm_item<1>(ws_xn(p), DM, p.ev_w_in + C_GA, EVEN_IN, ws_br(p), 2048, (int)(gid / 2048), (int)(gid % 2048)); }
DEV void ph_gemm_l0_out(const Params& p, long gid) { gemm_item<2>(ws_br(p), 2048, p.ev_w_out, DM, ws_y(p), DM, (int)(gid / DM), (int)(gid % DM)); }
DEV void ph_gemm_l1_rw(const Params& p, long gid) { gemm_item<0>(ws_xn(p), DM, p.od_w_in + O_RW, ODD_IN, ws_big(p), ZW, (int)(gid / ZW), (int)(gid % ZW)); }
DEV void ph_gemm_l1_na(const Params& p, long gid) { gemm_item<0>(ws_xn(p), DM, p.od_w_in + O_NA, ODD_IN, ws_big(p), NAW, (int)(gid / NAW), (int)(gid % NAW)); }
DEV void ph_gemm_l1_gate(const Params& p, long gid) { gemm_item<1>(ws_xn(p), DM, p.od_w_in + O_GC, ODD_IN, ws_br(p), 2048, CTXN + (int)(gid / 2048), (int)(gid % 2048)); }
DEV void ph_gemm_l1_out(const Params& p, long gid) { gemm_item<2>(ws_br(p), 2048, p.od_w_out, DM, ws_y(p), DM, CTXN + (int)(gid / DM), (int)(gid % DM)); }

constexpr long N_ROPENORM = (long)R * 18;
DEV void ph_ropenorm(const Params& p, long gid) {
    const int slot = (int)(gid % 18), row = (int)(gid / 18);
    int col; const float* nw = nullptr; float sc = 1.f;
    if (slot < 4) col = C_QA + slot * 128; else if (slot < 8) { col = C_KA + (slot - 4) * 128; sc = 0.08838834764831845f; }
    else if (slot < 16) { col = C_QB + (slot - 8) * 128; nw = p.q_norm; } else { col = C_KB + (slot - 16) * 128; nw = p.k_norm; }
    bf16_t* v = ws_big(p) + (size_t)row * P0W + col;
    if (nw) { float ss = 0.f; for (int d = 0; d < 128; ++d) { const float t = bf2f(v[d]); ss += t * t; } sc = 1.0f / sqrtf(ss / 128.f + NORM_EPS); }
    const bool rot = row >= CTXN; const int t = row - CTXN; const int gr = rot ? t / GW : 0, gc = rot ? t % GW : 0;
    const float* ct = ws_rope(p); const float* st = ct + N_ROPE;
    for (int i = 0; i < 64; ++i) {
        float x1 = bf2f(v[2 * i]) * sc, x2 = bf2f(v[2 * i + 1]) * sc;
        if (nw) { x1 *= nw[2 * i]; x2 *= nw[2 * i + 1]; }
        if (rot) { const int pos = i < 32 ? gr : gc, f = i & 31; const float cs = ct[pos * 32 + f], sn = st[pos * 32 + f]; const float y1 = x1 * cs - x2 * sn, y2 = x1 * sn + x2 * cs; x1 = y1; x2 = y2; }
        v[2 * i] = f2bf(x1); v[2 * i + 1] = f2bf(x2);
    }
}
constexpr long N_RETSCAN = 2 * 4 * 256;
DEV void ph_ret_scan(const Params& p, long gid) {
    const int e = (int)(gid % 256), h = (int)((gid / 256) % 4), dir = (int)(gid / 1024);
    const float g = sigmf((dir ? p.dec_b : p.dec_f)[h]);
    float S[128];
#pragma unroll
    for (int d = 0; d < 128; ++d) S[d] = 0.f;
    const bf16_t* P = ws_big(p); bf16_t* BR = ws_br(p);
    for (int pos = 0; pos < R; ++pos) {
        int row; if (pos < CTXN) row = dir ? CTXN - 1 - pos : pos; else { const int t = pos - CTXN; row = CTXN + (dir ? SEQ - 1 - t : t); }
        const bf16_t* pr = P + (size_t)row * P0W; const float v = bf2f(pr[C_VA + h * 256 + e]);
        const bf16_t* kq = pr + C_KA + h * 128; const bf16_t* qq = pr + C_QA + h * 128; float y = 0.f;
#pragma unroll
        for (int d = 0; d < 128; ++d) { S[d] = g * S[d] + bf2f(kq[d]) * v; y += bf2f(qq[d]) * S[d]; }
        BR[(size_t)row * 2048 + dir * 1024 + h * 256 + e] = f2bf(y);
    }
}
constexpr long N_RETMERGE = (long)R * 4;
DEV void ph_ret_merge(const Params& p, long gid) {
    const int h = (int)(gid % 4), row = (int)(gid / 4);
    bf16_t* b = ws_br(p) + (size_t)row * 2048 + h * 256;
    float s = 0.f; for (int e = 0; e < 256; ++e) s += bf2f(b[e]) + bf2f(b[1024 + e]);
    const float mean = s / 256.f; float q = 0.f;
    for (int e = 0; e < 256; ++e) { const float d = bf2f(b[e]) + bf2f(b[1024 + e]) - mean; q += d * d; }
    const float rstd = 1.0f / sqrtf(q / 256.f + NORM_EPS);
    for (int e = 0; e < 256; ++e) b[e] = f2bf((bf2f(b[e]) + bf2f(b[1024 + e]) - mean) * rstd);
}
constexpr long N_GQA = (long)R * 8 * 8;
DEV void ph_gqa_attn(const Params& p, long gid) {
    const int sl = (int)(gid % 8), row = (int)((gid / 8) % R), head = (int)(gid / (8L * R)), g = head / 4;
    const bf16_t* P = ws_big(p); const int nk = row < CTXN ? CTXN : R;
    float q[128];
    { const bf16_t* qp = P + (size_t)row * P0W + C_QB + head * 128;
#pragma unroll
      for (int d = 0; d < 128; ++d) q[d] = bf2f(qp[d]) * 0.08838834764831845f; }
    float acc[16];
#pragma unroll
    for (int i = 0; i < 16; ++i) acc[i] = 0.f;
    float m = -1e30f, l = 0.f;
    for (int j = 0; j < nk; ++j) {
        const bf16_t* kp = P + (size_t)j * P0W + C_KB + g * 128; float s = 0.f;
#pragma unroll
        for (int d = 0; d < 128; ++d) s += q[d] * bf2f(kp[d]);
        const float mn = fmaxf(m, s), al = expf(m - mn), pe = expf(s - mn);
        const bf16_t* vp = P + (size_t)j * P0W + C_VB + g * 128 + sl * 16;
        l = l * al + pe;
#pragma unroll
        for (int i = 0; i < 16; ++i) acc[i] = acc[i] * al + pe * bf2f(vp[i]);
        m = mn;
    }
    bf16_t* o = ws_br(p) + (size_t)row * 2048 + 1024 + head * 128 + sl * 16; const float il = 1.0f / l;
#pragma unroll
    for (int i = 0; i < 16; ++i) o[i] = f2bf(acc[i] * il);
}
template <int LAYER> DEV void ph_resid(const Params& p, long gid) {
    const int row = LAYER == 0 ? (int)gid : CTXN + (int)gid; const int s = row < CTXN ? 1 : 0;
    const float* y = ws_y(p) + (size_t)row * DM; const float* mv = ws_modv(p) + (LAYER * 2 + s) * 3072 + 2048; const float* g = p.g_post + LAYER * DM;
    float ss = 0.f; for (int k = 0; k < DM; ++k) ss += y[k] * y[k];
    const float rstd = 1.0f / sqrtf(ss / DM + NORM_EPS);
    const float* src; float* dst;
    if (row < CTXN) { src = p.ctx + (size_t)row * DM; dst = ws_ctx1(p) + (size_t)row * DM; }
    else { src = (LAYER == 0 ? p.x : p.out) + (size_t)(row - CTXN) * DM; dst = p.out + (size_t)(row - CTXN) * DM; }
    for (int k = 0; k < DM; ++k) dst[k] = src[k] + mv[k] * (y[k] * rstd * g[k]);
}
DEV float zshift(const bf16_t* Z, const float* mu, int row, int col) {
    const int lo = row < CTXN ? 0 : CTXN, hi = row < CTXN ? CTXN : R;
    const float z = bf2f(Z[(size_t)row * ZW + col]);
    const float pv = row > lo ? bf2f(Z[(size_t)(row - 1) * ZW + col]) : 0.f, nx = row + 1 < hi ? bf2f(Z[(size_t)(row + 1) * ZW + col]) : 0.f;
    return z + (0.5f * (pv + nx) - z) * mu[col];
}
constexpr long N_RWFIN = (long)SEQ * 16;
DEV void ph_rwkv_finish(const Params& p, long gid) {
    const int h = (int)(gid % 16), t = (int)(gid / 16), row = CTXN + t;
    const bf16_t* Z = ws_big(p); bf16_t* b = ws_br(p) + (size_t)row * 2048;
    float bon[2];
    for (int d = 0; d < 2; ++d) {
        const float* a0 = d ? p.a0b : p.a0f; const float* a2 = d ? p.a2b : p.a2f;
        float s = 0.f;
        for (int j = 0; j < 64; ++j) { const int hj = h * 64 + j; float acc = a0[hj];
            for (int m = 0; m < 64; ++m) acc += zshift(Z, p.mu, row, 3200 + d * 64 + m) * a2[m * 1024 + hj];
            const float al = sigmf(acc); const float r = zshift(Z, p.mu, row, hj), k = zshift(Z, p.mu, row, 1024 + hj);
            s += r * (k * (1.0f + (al - 1.0f) * p.k_a[hj])) * p.r_k[hj]; }
        bon[d] = s;
    }
    float sm = 0.f; for (int i = 0; i < 64; ++i) sm += bf2f(b[h * 64 + i]) + bf2f(b[1024 + h * 64 + i]);
    const float mean = sm / 64.f; float q = 0.f;
    for (int i = 0; i < 64; ++i) { const float d = bf2f(b[h * 64 + i]) + bf2f(b[1024 + h * 64 + i]) - mean; q += d * d; }
    const float rstd = 1.0f / sqrtf(q / 64.f + GN_EPS);
    for (int i = 0; i < 64; ++i) { const int hi = h * 64 + i; const float w = bf2f(b[hi]) + bf2f(b[1024 + hi]);
        const float v = zshift(Z, p.mu, row, 2048 + hi);
        b[1024 + hi] = f2bf((w - mean) * rstd * p.lnx_g[hi] + p.lnx_b[hi] + (bon[0] + bon[1]) * v); }
}
constexpr long N_NA = (long)SEQ * 16;
DEV void ph_na(const Params& p, long gid) {
    const int h = (int)(gid % 16), t = (int)(gid / 16), r = t / GW, c = t % GW;
    const bf16_t* P = ws_big(p);
    float q[64];
    { const bf16_t* qp = P + (size_t)(CTXN + t) * NAW + h * 64;
#pragma unroll
      for (int d = 0; d < 64; ++d) q[d] = bf2f(qp[d]) * 0.125f; }
    float acc[64];
#pragma unroll
    for (int d = 0; d < 64; ++d) acc[d] = 0.f;
    float m = -1e30f, l = 0.f;
    const int wh = GROWS < 8 ? GROWS : 8;
    int r0 = r - wh / 2; r0 = r0 < 0 ? 0 : (r0 > GROWS - wh ? GROWS - wh : r0);
    int c0 = c - 8; c0 = c0 < 0 ? 0 : (c0 > GW - 16 ? GW - 16 : c0);
    const float* rp = p.rpb + h * 15 * 31;
    for (int kk = 0; kk < wh * 16 + CTXN; ++kk) {
        int krow; float bias = 0.f;
        if (kk < wh * 16) { const int i = kk / 16, j = kk % 16; krow = CTXN + (r0 + i) * GW + c0 + j; bias = rp[(r0 + i - r + 7) * 31 + (c0 + j - c + 15)]; }
        else krow = kk - wh * 16;
        const bf16_t* kp = P + (size_t)krow * NAW + 1024 + h * 64; float s = bias;
#pragma unroll
        for (int d = 0; d < 64; ++d) s += q[d] * bf2f(kp[d]);
        const float mn = fmaxf(m, s), al = expf(m - mn), pe = expf(s - mn);
        const bf16_t* vp = P + (size_t)krow * NAW + 2048 + h * 64;
        l = l * al + pe;
#pragma unroll
        for (int d = 0; d < 64; ++d) acc[d] = acc[d] * al + pe * bf2f(vp[d]);
        m = mn;
    }
    bf16_t* o = ws_br(p) + (size_t)(CTXN + t) * 2048 + h * 64; const float il = 1.0f / l;
#pragma unroll
    for (int d = 0; d < 64; ++d) o[d] = f2bf(acc[d] * il);
}

constexpr int RW_CH = 16;
struct RwShared { float r[RW_CH][64], w[RW_CH][64], kd[RW_CH][64], v[RW_CH][64], a[RW_CH][64], b[RW_CH][64], tz[RW_CH][64], za[RW_CH][64], kk[RW_CH][64]; };
#ifdef CPU_EMU
#define FOR_THREADS(tid) for (int tid = 0; tid < 64; ++tid)
#define BLOCK_SYNC()
#define TSTATE(tid) S_all[tid]
#else
#define FOR_THREADS(tid) const int tid = threadIdx.x; if (tid < 64)
#define BLOCK_SYNC() __syncthreads()
#define TSTATE(tid) S_reg
#endif
DEV int rw_row(int dir, int pos) { if (pos < CTXN) return dir ? CTXN - 1 - pos : pos; const int t = pos - CTXN; return CTXN + (dir ? SEQ - 1 - t : t); }
#ifdef CPU_EMU
static void rwkv_scan_block(const Params& p, int blk, RwShared& sh) {
    static thread_local float S_all[64][64];
    for (int i = 0; i < 64; ++i) for (int j = 0; j < 64; ++j) S_all[i][j] = 0.f;
#else
__device__ void rwkv_scan_block(const Params& p, int blk, RwShared& sh) {
    float S_reg[64];
#pragma unroll
    for (int j = 0; j < 64; ++j) S_reg[j] = 0.f;
#endif
    const int dir = blk / 16, h = blk % 16;
    const float* w0 = dir ? p.w0b : p.w0f; const float* w2 = dir ? p.w2b : p.w2f; const float* a0 = dir ? p.a0b : p.a0f; const float* a2 = dir ? p.a2b : p.a2f;
    const bf16_t* Z = ws_big(p); bf16_t* BR = ws_br(p);
    for (int p0 = 0; p0 < R; p0 += RW_CH) {
        { FOR_THREADS(tid) { const int hj = h * 64 + tid;
            for (int tt = 0; tt < RW_CH; ++tt) { const int row = rw_row(dir, p0 + tt);
                sh.tz[tt][tid] = tanhf(zshift(Z, p.mu, row, 3072 + dir * 64 + tid)); sh.za[tt][tid] = zshift(Z, p.mu, row, 3200 + dir * 64 + tid);
                sh.r[tt][tid] = zshift(Z, p.mu, row, hj); sh.v[tt][tid] = zshift(Z, p.mu, row, 2048 + hj);
                const float k = zshift(Z, p.mu, row, 1024 + hj); sh.kd[tt][tid] = k; sh.kk[tt][tid] = k * p.k_k[hj]; } } }
        BLOCK_SYNC();
        { FOR_THREADS(tid) { const int hj = h * 64 + tid;
            for (int tt = 0; tt < RW_CH; ++tt) { float aw = w0[hj], aa = a0[hj], nn = 0.f;
                for (int m = 0; m < 64; ++m) { aw += sh.tz[tt][m] * w2[m * 1024 + hj]; aa += sh.za[tt][m] * a2[m * 1024 + hj]; nn += sh.kk[tt][m] * sh.kk[tt][m]; }
                const float lw = -softplusf(-aw) - 0.5f; const float al = sigmf(aa);
                const float kkn = sh.kk[tt][tid] / fmaxf(sqrtf(nn), 1e-12f);
                sh.w[tt][tid] = expf(-expf(lw)); sh.a[tt][tid] = -kkn; sh.b[tt][tid] = kkn * al;
                sh.kd[tt][tid] = sh.kd[tt][tid] * (1.0f + (al - 1.0f) * p.k_a[hj]); } } }
        BLOCK_SYNC();
        { FOR_THREADS(tid) { float* S = TSTATE(tid);
            for (int tt = 0; tt < RW_CH; ++tt) { float sa = 0.f;
#pragma unroll
                for (int j = 0; j < 64; ++j) sa += S[j] * sh.a[tt][j];
                const float vi = sh.v[tt][tid]; float y = 0.f;
#pragma unroll
                for (int j = 0; j < 64; ++j) { S[j] = S[j] * sh.w[tt][j] + sa * sh.b[tt][j] + vi * sh.kd[tt][j]; y += S[j] * sh.r[tt][j]; }
                if (p0 >= CTXN) BR[(size_t)rw_row(dir, p0 + tt) * 2048 + dir * 1024 + h * 64 + tid] = f2bf(y); } } }
        BLOCK_SYNC();
    }
}

static Params make_params(void* const* d_in, void* d_out, void* d_ws) {
    Params p{};
    const float** f = (const float**)&p;
    for (int i = 0; i < 31; ++i) f[i] = (const float*)d_in[i];
    p.out = (float*)d_out; p.ws = (unsigned char*)d_ws; return p;
}


#ifndef CPU_EMU
#define LAS __attribute__((address_space(3)))
#define GAS __attribute__((address_space(1)))
typedef unsigned v4u __attribute__((ext_vector_type(4)));
constexpr int NWAVES = 8, NTHR = NWAVES * 64;
#ifndef PROBE
#define PROBE 0
#endif
#define XB_TMO      128
#define XB_XCNT(j)  (256  + 64 * (j))
#define XB_XSUB(j)  (1280 + 64 * (j))
#define XB_XGEN(j)  (2304 + 64 * (j))
#define XB_TOP      3328
#define XB_TOPGEN   3392
#define XCD_BAR_WORDS 3456
#define XB_SPIN_CAP (1u << 18)

__device__ __forceinline__ unsigned xb_ld(unsigned* p)              { return __hip_atomic_load(p, __ATOMIC_RELAXED, __HIP_MEMORY_SCOPE_AGENT); }
__device__ __forceinline__ unsigned xb_add(unsigned* p, unsigned v) { return __hip_atomic_fetch_add(p, v, __ATOMIC_RELAXED, __HIP_MEMORY_SCOPE_AGENT); }
__device__ __forceinline__ unsigned xb_xcc_id() { return (unsigned)__builtin_amdgcn_s_getreg((3 << 11) | 20) & 0xFu; }
#define XB_SPIN(cond, bar) do { unsigned _sp = 0; while (cond) { __builtin_amdgcn_s_sleep(1); \
    if ((++_sp & 255u) == 0u) { if (xb_ld(&(bar)[XB_TMO])) break; if (_sp > XB_SPIN_CAP) { atomicAdd(&(bar)[XB_TMO], 1u); break; } } } } while (0)

struct XcdBarrier {
    unsigned* bar; unsigned x;
    volatile LAS unsigned* st;
};

__device__ __forceinline__ XcdBarrier xcd_barrier_post(unsigned* bar, volatile LAS unsigned* st) {
    XcdBarrier b; b.bar = bar; b.x = xb_xcc_id(); b.st = st;
    if (threadIdx.x == 0) (void)xb_add(&bar[XB_XCNT(b.x)], 1u);
    return b;
}
__device__ __forceinline__ void xcd_barrier_complete(unsigned* bar, unsigned x, unsigned& nloc, unsigned& nx) {
    const unsigned G = gridDim.x * gridDim.y * gridDim.z;
    unsigned sum, cnt, mine, sp = 0u;
    for (;;) {
        sum = 0u; cnt = 0u; mine = 0u;
#pragma unroll
        for (unsigned j = 0; j < 16; ++j) { const unsigned c = xb_ld(&bar[XB_XCNT(j)]); sum += c; cnt += (c > 0u) ? 1u : 0u; mine = (j == x) ? c : mine; }
        if (sum == G) break;
        __builtin_amdgcn_s_sleep(1);
        if ((++sp & 255u) == 0u) { if (xb_ld(&bar[XB_TMO])) break; if (sp > XB_SPIN_CAP) { atomicAdd(&bar[XB_TMO], 1u); break; } }
    }
    nloc = mine > 0u ? mine : 1u; nx = cnt > 0u ? cnt : 1u;
}

__device__ __forceinline__ void xcd_barrier(const XcdBarrier& b) {
    asm volatile("s_waitcnt vmcnt(0)" ::: "memory");
    __syncthreads();
    if (threadIdx.x == 0) {
        unsigned* bar = b.bar;
        __builtin_amdgcn_s_waitcnt(0);
        unsigned nloc = b.st[0], nx = b.st[1];
        if (nloc == 0u) { xcd_barrier_complete(bar, b.x, nloc, nx); b.st[0] = nloc; b.st[1] = nx; }
        const unsigned old = xb_add(&bar[XB_XSUB(b.x)], 1u);
        const unsigned gen = old / nloc;
        if (old + 1u == (gen + 1u) * nloc) {
            __builtin_amdgcn_fence(__ATOMIC_RELEASE, "agent");
            asm volatile("s_waitcnt vmcnt(0)" ::: "memory");
            const unsigned og = xb_add(&bar[XB_TOP], 1u);
            const unsigned tg = og / nx;
            if (og + 1u == (tg + 1u) * nx) xb_add(&bar[XB_TOPGEN], 1u);
            else XB_SPIN(xb_ld(&bar[XB_TOPGEN]) == tg, bar);
            __builtin_amdgcn_fence(__ATOMIC_ACQUIRE, "agent");
            xb_add(&bar[XB_XGEN(b.x)], 1u);
            asm volatile("s_waitcnt vmcnt(0)" ::: "memory");
        } else {
            XB_SPIN(xb_ld(&bar[XB_XGEN(b.x)]) == gen, bar);
            __builtin_amdgcn_fence(__ATOMIC_ACQUIRE, "agent");
            asm volatile("s_waitcnt vmcnt(0)" ::: "memory");
        }
    }
    __syncthreads();
}
namespace pg8 {
#define PG8_LAS __attribute__((address_space(3)))
typedef unsigned short bf16_t;
typedef short bf16x8 __attribute__((ext_vector_type(8)));
typedef float f32x4 __attribute__((ext_vector_type(4)));
typedef unsigned u32x4 __attribute__((ext_vector_type(4)));
constexpr int BM = 256, BK = 64, HALF = 128, HTB = HALF * BK * 2  , STAGE_BYTES = 8 * HTB, NXCD = 8, WGM = 8;

__host__ __device__ __forceinline__ int lds_byte(int r, int c) { const int st = (r >> 4) * 2 + (c >> 5), rr = r & 15, cc = c & 31, ob = rr * 64 + cc * 2; return st * 1024 + (ob ^ (((ob >> 9) & 1) << 5)); }
__host__ __device__ __forceinline__ void stage_rc(int b, int& R, int& C) { const int st = b / 1024, sb = b % 1024, swz = sb ^ (((sb >> 9) & 1) << 5); R = (st >> 1) * 16 + swz / 64; C = (st & 1) * 32 + (swz % 64) / 2; }
__host__ __device__ __forceinline__ int perm32(int rho) { const int n = rho >> 4, i = rho & 15; return 8 * (i >> 2) + 4 * n + (i & 3); }

struct Unit { int pm, pn; };
struct Gemm { const bf16_t* A; const bf16_t* Bt; int M, N, K; int lda = 0, ldb = 0; int ksl = 0; };

struct StaticOrder {
    int nM, nN, nwg, G, c;
    __host__ __device__ void init(int M, int N, int G_, int c_) { nM = M / BM; nN = N / BM; nwg = nM * nN; G = G_; c = c_; }
    __host__ __device__ bool next(int i, Unit& u) const {
        const long L = (long)i * G + c; if (L >= nwg) return false;
        int wgid = (int)L; { const int q = nwg / NXCD, r = nwg % NXCD, xcd = wgid % NXCD, off = wgid / NXCD; wgid = (xcd < r ? xcd * (q + 1) : r * (q + 1) + (xcd - r) * q) + off; }
        const int nig = WGM * nN, gid = wgid / nig, fm = gid * WGM, gsz = (nM - fm) < WGM ? (nM - fm) : WGM;
        u.pm = fm + ((wgid % nig) % gsz); u.pn = (wgid % nig) / gsz; return true;
    }
    __device__ __forceinline__ void a_ready(const Unit&) const {}
    __device__ __forceinline__ void done(const Unit&) const {}
};

__device__ __forceinline__ unsigned cvt_pk_bf16(float lo, float hi) { unsigned r; asm volatile("v_cvt_pk_bf16_f32 %0, %1, %2" : "=v"(r) : "v"(lo), "v"(hi)); return r; }
typedef float f32x2 __attribute__((ext_vector_type(2)));
__device__ __forceinline__ f32x2 gelu_pk(f32x2 v) {
    const f32x2 av = __builtin_elementwise_abs(v), d = av * 0.2316418882f + 1.0f;
    f32x2 t; t.x = __builtin_amdgcn_rcpf(d.x); t.y = __builtin_amdgcn_rcpf(d.y);
    f32x2 q = t * 0.5307027145f + (-0.7265760135f); q = q * t + 0.7107068705f; q = q * t + (-0.142248368f); q = q * t + 0.127414796f; q = q * t;
    const f32x2 s = (v * v) * (-0.72134752044f);
    f32x2 e; e.x = __builtin_amdgcn_exp2f(s.x); e.y = __builtin_amdgcn_exp2f(s.y);
    const f32x2 m = v * (q * e), r = v - m;
    f32x2 o; o.x = v.x < 0.f ? m.x : r.x; o.y = v.y < 0.f ? m.y : r.y; return o;
}

template <int ACT  > struct EpiBf16 {
    static constexpr bool PERM = true, AFTER_DRAIN = false; static_assert(ACT == 0 || ACT == 1, "EpiBf16: ACT is 0 (none) or 1 (gelu_pk)");
    bf16_t* O; int ldc; const float* bias; int split_cols; size_t split_stride; float scale0;
    __device__ __forceinline__ void operator()(const f32x4 (&acc)[2][2][4][2], const Unit& u, int wr, int wc, int fr, int fq) const {
        const int row0 = u.pm * BM + wr * 64 + fr; int colt = u.pn * BM; bf16_t* base = O;
        float sc = 1.f; if (split_cols) { const int t = colt / split_cols; base += (size_t)t * split_stride; colt -= t * split_cols; if (t == 0) sc = scale0; }
        const int col0 = colt + wc * 32 + 8 * fq, bcol0 = u.pn * BM + wc * 32 + 8 * fq;
        f32x4 bv[2][2];
#pragma unroll
        for (int bj = 0; bj < 2; ++bj)
#pragma unroll
            for (int n = 0; n < 2; ++n) bv[bj][n] = bias ? *(const f32x4*)(bias + bcol0 + bj * HALF + 4 * n) : (f32x4){0.f, 0.f, 0.f, 0.f};
#pragma unroll
        for (int ai = 0; ai < 2; ++ai)
#pragma unroll
            for (int m = 0; m < 4; ++m) { bf16_t* rowp = base + (size_t)(row0 + ai * HALF + m * 16) * ldc + col0;
#pragma unroll
                for (int bj = 0; bj < 2; ++bj) { f32x4 v0 = acc[ai][bj][m][0] + bv[bj][0], v1 = acc[ai][bj][m][1] + bv[bj][1];
                    if (ACT == 1) { f32x2 a = gelu_pk((f32x2){v0[0], v0[1]}), b = gelu_pk((f32x2){v0[2], v0[3]}), c = gelu_pk((f32x2){v1[0], v1[1]}), d = gelu_pk((f32x2){v1[2], v1[3]});
                        v0 = (f32x4){a.x, a.y, b.x, b.y}; v1 = (f32x4){c.x, c.y, d.x, d.y}; }
                    v0 = v0 * sc; v1 = v1 * sc; u32x4 w; w.x = cvt_pk_bf16(v0[0], v0[1]); w.y = cvt_pk_bf16(v0[2], v0[3]); w.z = cvt_pk_bf16(v1[0], v1[1]); w.w = cvt_pk_bf16(v1[2], v1[3]);
                    *(u32x4*)(rowp + bj * HALF) = w; } }
    }
};

typedef float f32x2c_ __attribute__((ext_vector_type(2))); typedef __bf16 bf2c_ __attribute__((ext_vector_type(2)));
__device__ __forceinline__ unsigned cvt_pk_bf16_c(float lo, float hi) { const f32x2c_ v = {lo, hi}; return __builtin_bit_cast(unsigned, __builtin_convertvector(v, bf2c_)); }
struct EpiBf16Halo {
    static constexpr bool PERM = true, AFTER_DRAIN = false;
    bf16_t* O; int ldc; bf16_t* H;
    __device__ __forceinline__ void operator()(const f32x4 (&acc)[2][2][4][2], const Unit& u, int wr, int wc, int fr, int fq) const {
        const int row0 = u.pm * BM + wr * 64 + fr, col0 = u.pn * BM + wc * 32 + 8 * fq;
#pragma unroll
        for (int ai = 0; ai < 2; ++ai)
#pragma unroll
            for (int m = 0; m < 4; ++m) { const int row = row0 + ai * HALF + m * 16; bf16_t* rowp = O + (size_t)row * ldc + col0;
                const bool edge = (m == 0 && wr == 0 && fr == 0) || (m == 3 && wr == 1 && fr == 15);
                bf16_t* hp = H + ((size_t)(row >> 7) * 2 + (m == 3 ? 1 : 0)) * ldc + col0;
#pragma unroll
                for (int bj = 0; bj < 2; ++bj) { const f32x4 v0 = acc[ai][bj][m][0], v1 = acc[ai][bj][m][1];
                    u32x4 w; w.x = cvt_pk_bf16_c(v0[0], v0[1]); w.y = cvt_pk_bf16_c(v0[2], v0[3]); w.z = cvt_pk_bf16_c(v1[0], v1[1]); w.w = cvt_pk_bf16_c(v1[2], v1[3]);
                    *(u32x4*)(rowp + bj * HALF) = w;
                    if ((m == 0 || m == 3) && edge) *(u32x4*)(hp + bj * HALF) = w; } }
    }
};
__device__ __forceinline__ float silu_fast(float v) { return v * __builtin_amdgcn_rcpf(1.0f + __builtin_amdgcn_exp2f(-1.4426950408889634f * v)); }
struct EpiGateMul {
    static constexpr bool PERM = true, AFTER_DRAIN = false;
    bf16_t* O; int ldc;
    __device__ __forceinline__ void operator()(const f32x4 (&acc)[2][2][4][2], const Unit& u, int wr, int wc, int fr, int fq) const {
        const int row0 = u.pm * BM + wr * 64 + fr, col0 = u.pn * BM + wc * 32 + 8 * fq;
#pragma unroll
        for (int ai = 0; ai < 2; ++ai)
#pragma unroll
            for (int m = 0; m < 4; ++m) { bf16_t* rowp = O + (size_t)(row0 + ai * HALF + m * 16) * ldc + col0;
#pragma unroll
                for (int bj = 0; bj < 2; ++bj) { const u32x4 old = *(const u32x4*)(rowp + bj * HALF); const f32x4 v0 = acc[ai][bj][m][0], v1 = acc[ai][bj][m][1];
                    u32x4 w;
                    w.x = cvt_pk_bf16(silu_fast(v0[0]) * __uint_as_float(old.x << 16), silu_fast(v0[1]) * __uint_as_float(old.x & 0xffff0000u));
                    w.y = cvt_pk_bf16(silu_fast(v0[2]) * __uint_as_float(old.y << 16), silu_fast(v0[3]) * __uint_as_float(old.y & 0xffff0000u));
                    w.z = cvt_pk_bf16(silu_fast(v1[0]) * __uint_as_float(old.z << 16), silu_fast(v1[1]) * __uint_as_float(old.z & 0xffff0000u));
                    w.w = cvt_pk_bf16(silu_fast(v1[2]) * __uint_as_float(old.w << 16), silu_fast(v1[3]) * __uint_as_float(old.w & 0xffff0000u));
                    *(u32x4*)(rowp + bj * HALF) = w; } }
    }
};
struct EpiSiluBf16 {
    static constexpr bool PERM = true, AFTER_DRAIN = false;
    bf16_t* O; int ldc;
    __device__ __forceinline__ void operator()(const f32x4 (&acc)[2][2][4][2], const Unit& u, int wr, int wc, int fr, int fq) const {
        const int row0 = u.pm * BM + wr * 64 + fr, col0 = u.pn * BM + wc * 32 + 8 * fq;
#pragma unroll
        for (int ai = 0; ai < 2; ++ai)
#pragma unroll
            for (int m = 0; m < 4; ++m) { bf16_t* rowp = O + (size_t)(row0 + ai * HALF + m * 16) * ldc + col0;
#pragma unroll
                for (int bj = 0; bj < 2; ++bj) { const f32x4 v0 = acc[ai][bj][m][0], v1 = acc[ai][bj][m][1]; u32x4 w;
                    w.x = cvt_pk_bf16(silu_fast(v0[0]), silu_fast(v0[1])); w.y = cvt_pk_bf16(silu_fast(v0[2]), silu_fast(v0[3]));
                    w.z = cvt_pk_bf16(silu_fast(v1[0]), silu_fast(v1[1])); w.w = cvt_pk_bf16(silu_fast(v1[2]), silu_fast(v1[3]));
                    *(u32x4*)(rowp + bj * HALF) = w; } }
    }
};
struct EpiF32 {
    static constexpr bool PERM = true, AFTER_DRAIN = false;
    float* O; int ldc;
    __device__ __forceinline__ void operator()(const f32x4 (&acc)[2][2][4][2], const Unit& u, int wr, int wc, int fr, int fq) const {
        const int row0 = u.pm * BM + wr * 64 + fr, col0 = u.pn * BM + wc * 32 + 8 * fq;
#pragma unroll
        for (int ai = 0; ai < 2; ++ai)
#pragma unroll
            for (int m = 0; m < 4; ++m) { float* rowp = O + (size_t)(row0 + ai * HALF + m * 16) * ldc + col0;
#pragma unroll
                for (int bj = 0; bj < 2; ++bj) { *(f32x4*)(rowp + bj * HALF) = acc[ai][bj][m][0]; *(f32x4*)(rowp + bj * HALF + 4) = acc[ai][bj][m][1]; } }
    }
};

template <class Epi, class Sched, bool ALIGN_EPI = false, bool SP2 = false>
__device__ __forceinline__ void gemm_phase(PG8_LAS unsigned char* lds, const Gemm g, const Sched& S, const Epi& E) {
    int tid_ = threadIdx.x; asm volatile("" : "+v"(tid_));
    const int tid = tid_, wid = __builtin_amdgcn_readfirstlane(tid >> 6), lane = tid & 63, wr = wid >> 2, wc = wid & 3, fr = lane & 15, fq = lane >> 4;
    const int K = g.K, nt = K / BK, lda = g.lda ? g.lda : K, ldb = g.ldb ? g.ldb : K;
    unsigned voffA[2], voffB[2];
#pragma unroll
    for (int i = 0; i < 2; ++i) { int R, C; stage_rc(tid * 16 + i * 8192, R, C); const int Rb = Epi::PERM ? ((R & ~31) + perm32(R & 31)) : R;
        voffA[i] = (unsigned)(R * lda + C) * 2u; voffB[i] = (unsigned)(Rb * ldb + C) * 2u; }
    const size_t kstep = (size_t)(BK * 2);
    const size_t hstepA = (size_t)HALF * lda * 2, hstepB = (size_t)HALF * ldb * 2;
    const size_t tstepA = g.ksl ? (size_t)g.ksl : 2 * hstepA, tstepB = 2 * hstepB, bpm = (size_t)g.ksl;
    const unsigned ldsw = (unsigned)wid * 1024u;
    const int aoff = lds_byte(wr * 64 + fr, fq * 8), boff = lds_byte(wc * 32 + fr, fq * 8);
#define PG8_SA(b, h) (((b) * 2 + (h)) * HTB)
#define PG8_SB(b, h) ((4 + (b) * 2 + (h)) * HTB)
#define PG8_STAGE(bufoff, gbase, voff) do { _Pragma("unroll") for (int _i = 0; _i < 2; ++_i) \
        __builtin_amdgcn_global_load_lds((const unsigned*)((const char*)(gbase) + (voff)[_i]), (PG8_LAS unsigned*)(lds + (bufoff) + ldsw + _i * 8192), 16, 0, 0); } while (0)
#define PG8_LDA(dst, b, h) do { _Pragma("unroll") for (int m = 0; m < 4; ++m) _Pragma("unroll") for (int k = 0; k < 2; ++k) dst[m][k] = *(const PG8_LAS bf16x8*)(lds + PG8_SA(b, h) + aoff + m * 2048 + k * 1024); } while (0)
#define PG8_LDB(dst, b, h) do { _Pragma("unroll") for (int n = 0; n < 2; ++n) _Pragma("unroll") for (int k = 0; k < 2; ++k) dst[n][k] = *(const PG8_LAS bf16x8*)(lds + PG8_SB(b, h) + boff + n * 2048 + k * 1024); } while (0)
#define PG8_MMA(ai, bj, At, Bt) do { __builtin_amdgcn_s_setprio(1); _Pragma("unroll") for (int m = 0; m < 4; ++m) _Pragma("unroll") for (int n = 0; n < 2; ++n) _Pragma("unroll") for (int k = 0; k < 2; ++k) \
        acc[ai][bj][m][n] = __builtin_amdgcn_mfma_f32_16x16x32_bf16(Bt[n][k], At[m][k], acc[ai][bj][m][n], 0, 0, 0); __builtin_amdgcn_s_setprio(0); } while (0)
#define PG8_WAIT_V(n) asm volatile("s_waitcnt vmcnt(" #n ")" ::: "memory")
#define PG8_WAIT_L(n) asm volatile("s_waitcnt lgkmcnt(" #n ")" ::: "memory")
#define PG8_BAR __builtin_amdgcn_s_barrier()
#define PG8_SCHED __builtin_amdgcn_sched_barrier(0)
    Unit cur, nxt; int ui = 0;
    if (!S.next(0, cur)) return;
    f32x4 acc[2][2][4][2];
#pragma unroll
    for (int a = 0; a < 2; ++a)
#pragma unroll
        for (int b = 0; b < 2; ++b)
#pragma unroll
            for (int m = 0; m < 4; ++m)
#pragma unroll
                for (int n = 0; n < 2; ++n) acc[a][b][m][n] = (f32x4){0.f, 0.f, 0.f, 0.f};
    bf16x8 At[4][2], B0[2][2], B1[2][2];
    const char* cA = (const char*)g.A + (size_t)cur.pm * tstepA; const char* cB = (const char*)g.Bt + (size_t)cur.pn * tstepB + (size_t)cur.pm * bpm;
    S.a_ready(cur);
    if constexpr (SP2) {
        PG8_STAGE(PG8_SB(0, 0), cB, voffB); PG8_STAGE(PG8_SB(0, 1), cB + hstepB, voffB); PG8_STAGE(PG8_SA(0, 0), cA, voffA); PG8_STAGE(PG8_SA(0, 1), cA + hstepA, voffA);
        if (wr == 1) PG8_BAR;
        PG8_WAIT_V(2); PG8_BAR;
        PG8_STAGE(PG8_SB(1, 0), cB + kstep, voffB); PG8_STAGE(PG8_SA(1, 0), cA + kstep, voffA); PG8_STAGE(PG8_SB(1, 1), cB + hstepB + kstep, voffB);
        PG8_WAIT_V(6); PG8_BAR;
    } else {
        PG8_STAGE(PG8_SB(0, 0), cB, voffB); PG8_STAGE(PG8_SA(0, 0), cA, voffA); PG8_STAGE(PG8_SB(0, 1), cB + hstepB, voffB); PG8_STAGE(PG8_SA(0, 1), cA + hstepA, voffA);
        if (wr == 1) PG8_BAR;
        PG8_WAIT_V(4); PG8_BAR;
        PG8_STAGE(PG8_SB(1, 0), cB + kstep, voffB); PG8_STAGE(PG8_SA(1, 0), cA + kstep, voffA); PG8_STAGE(PG8_SB(1, 1), cB + hstepB + kstep, voffB);
        PG8_WAIT_V(6); PG8_BAR;
    }
    for (;;) {
        const bool has_next = S.next(ui + 1, nxt);
        const char* nA = has_next ? (const char*)g.A + (size_t)nxt.pm * tstepA : cA; const char* nB = has_next ? (const char*)g.Bt + (size_t)nxt.pn * tstepB + (size_t)nxt.pm * bpm : cB;
        for (int t = 0; t < nt; t += 2) {
            const bool last = (t == nt - 2);
            const char* a1 = cA + (size_t)(t + 1) * kstep;
            const char* a2 = last ? nA : cA + (size_t)(t + 2) * kstep; const char* b2 = last ? nB : cB + (size_t)(t + 2) * kstep;
            const char* a3 = a2 + kstep; const char* b3 = b2 + kstep;
            if (last && has_next) S.a_ready(nxt);
            if constexpr (SP2) {
            PG8_LDB(B0, 0, 0); PG8_LDB(B1, 0, 1); PG8_SCHED; PG8_LDA(At, 0, 0); PG8_STAGE(PG8_SA(1, 1), a1 + hstepA, voffA);
            PG8_WAIT_V(8); PG8_WAIT_L(0); PG8_BAR; PG8_MMA(0, 0, At, B0); PG8_MMA(0, 1, At, B1); PG8_BAR; PG8_SCHED;
            PG8_LDA(At, 0, 1); PG8_STAGE(PG8_SB(0, 0), b2, voffB); PG8_STAGE(PG8_SB(0, 1), b2 + hstepB, voffB); PG8_STAGE(PG8_SA(0, 0), a2, voffA);
            PG8_WAIT_V(8); PG8_WAIT_L(0); PG8_BAR; PG8_MMA(1, 0, At, B0); PG8_MMA(1, 1, At, B1); PG8_BAR; PG8_SCHED;
            PG8_LDB(B0, 1, 0); PG8_LDB(B1, 1, 1); PG8_SCHED; PG8_LDA(At, 1, 0); PG8_STAGE(PG8_SA(0, 1), a2 + hstepA, voffA);
            PG8_WAIT_V(8); PG8_WAIT_L(0); PG8_BAR; PG8_MMA(0, 0, At, B0); PG8_MMA(0, 1, At, B1); PG8_BAR; PG8_SCHED;
            PG8_LDA(At, 1, 1); PG8_STAGE(PG8_SB(1, 0), b3, voffB); PG8_STAGE(PG8_SB(1, 1), b3 + hstepB, voffB); PG8_STAGE(PG8_SA(1, 0), a3, voffA);
            PG8_WAIT_V(8); PG8_WAIT_L(0); PG8_BAR; PG8_MMA(1, 0, At, B0); PG8_MMA(1, 1, At, B1); PG8_BAR; PG8_SCHED;
            } else {
            PG8_LDB(B0, 0, 0); PG8_SCHED; PG8_LDA(At, 0, 0); PG8_STAGE(PG8_SA(1, 1), a1 + hstepA, voffA);
            PG8_WAIT_L(8); PG8_BAR; PG8_WAIT_L(0); PG8_MMA(0, 0, At, B0); PG8_BAR; PG8_SCHED;
            PG8_LDB(B1, 0, 1); PG8_STAGE(PG8_SB(0, 0), b2, voffB);
            PG8_BAR; PG8_WAIT_L(0); PG8_MMA(0, 1, At, B1); PG8_BAR;
            PG8_LDA(At, 0, 1); PG8_STAGE(PG8_SA(0, 0), a2, voffA);
            PG8_BAR; PG8_WAIT_L(0); PG8_MMA(1, 0, At, B0); PG8_BAR; PG8_SCHED;
            PG8_STAGE(PG8_SB(0, 1), b2 + hstepB, voffB);
            PG8_WAIT_V(6); PG8_BAR; PG8_MMA(1, 1, At, B1); PG8_BAR;
            PG8_LDB(B0, 1, 0); PG8_SCHED; PG8_LDA(At, 1, 0); PG8_STAGE(PG8_SA(0, 1), a2 + hstepA, voffA);
            PG8_WAIT_L(8); PG8_BAR; PG8_WAIT_L(0); PG8_MMA(0, 0, At, B0); PG8_BAR; PG8_SCHED;
            PG8_LDB(B1, 1, 1); PG8_STAGE(PG8_SB(1, 0), b3, voffB);
            PG8_BAR; PG8_WAIT_L(0); PG8_MMA(0, 1, At, B1); PG8_BAR;
            PG8_LDA(At, 1, 1); PG8_STAGE(PG8_SA(1, 0), a3, voffA);
            PG8_BAR; PG8_WAIT_L(0); PG8_MMA(1, 0, At, B0); PG8_BAR; PG8_SCHED;
            PG8_STAGE(PG8_SB(1, 1), b3 + hstepB, voffB);
            PG8_WAIT_V(6); PG8_BAR; PG8_MMA(1, 1, At, B1); PG8_BAR;
            }
        }
        if constexpr (ALIGN_EPI) { if (wr == 0) PG8_BAR; }
        if constexpr (!Epi::AFTER_DRAIN) { E(acc, cur, wr, wc, fr, fq); S.done(cur); }
        if (!has_next) break;
#pragma unroll
        for (int a = 0; a < 2; ++a)
#pragma unroll
            for (int b = 0; b < 2; ++b)
#pragma unroll
                for (int m = 0; m < 4; ++m)
#pragma unroll
                    for (int n = 0; n < 2; ++n) acc[a][b][m][n] = (f32x4){0.f, 0.f, 0.f, 0.f};
        cur = nxt; cA = nA; cB = nB; ++ui;
        if constexpr (ALIGN_EPI) { if (wr == 1) PG8_BAR; }
    }
    PG8_WAIT_V(0);
    if constexpr (!ALIGN_EPI) { if (wr == 0) PG8_BAR; }
    PG8_BAR;
    if constexpr (Epi::AFTER_DRAIN) { E.fused(acc, cur, wr, wc, fr, fq, lds, wid, lane); S.done(cur); }
#undef PG8_SA
#undef PG8_SB
#undef PG8_STAGE
#undef PG8_LDA
#undef PG8_LDB
#undef PG8_MMA
#undef PG8_WAIT_V
#undef PG8_WAIT_L
#undef PG8_BAR
#undef PG8_SCHED
}
}

namespace attn {
using bf16 = unsigned short;
constexpr int   D = 128, NW = 8, QBLK = 32, KVBLK = 64;
constexpr float SCALE = 0.088388347648318440f;
constexpr float THR = 8.f;
constexpr int SDEPTH = 2;
constexpr int LDQ = P0W, LDK = P0W, LDO = 2048;
constexpr size_t SHM_V = KVBLK * D * 2, SHM_K = KVBLK * D * 2, SHM_ATTN = 3 * SHM_V + 2 * SHM_K + NW * 64 * 4;
using bf16x8 = __attribute__((ext_vector_type(8))) short;
using s16x4  = __attribute__((ext_vector_type(4))) short;
using f32x16 = __attribute__((ext_vector_type(16))) float;
using f32x8  = __attribute__((ext_vector_type(8))) float;
using u32x4  = __attribute__((ext_vector_type(4))) unsigned;
#define KSWZ(row, colB) ((row) * 256 + ((colB) ^ (((row) & 7) << 4)))
#define SBAR() __builtin_amdgcn_sched_barrier(0)
__device__ __forceinline__ int crow(int r, int hi) { return (r & 3) + 8 * (r >> 2) + 4 * hi; }
__device__ __forceinline__ unsigned cvtpk(float lo, float hi) {
  unsigned r; asm volatile("v_cvt_pk_bf16_f32 %0, %1, %2" : "=v"(r) : "v"(lo), "v"(hi)); return r;
}
template <typename TIn> struct Stage;
template <> struct Stage<bf16>  { using T = bf16x8;
  __device__ static __forceinline__ T ld8(const bf16* p) { return *reinterpret_cast<const bf16x8*>(p); }
  __device__ static __forceinline__ bf16x8 tobf(T x) { return x; } };
template <> struct Stage<float> { using T = f32x8;
  __device__ static __forceinline__ T ld8(const float* p) { return *reinterpret_cast<const f32x8*>(p); }
  __device__ static __forceinline__ bf16x8 tobf(T x) {
    u32x4 w = {cvtpk(x[0], x[1]), cvtpk(x[2], x[3]), cvtpk(x[4], x[5]), cvtpk(x[6], x[7])}; return *reinterpret_cast<bf16x8*>(&w); } };

template <bool NOMAX> __device__ __forceinline__ void partialSM(f32x16& p0, f32x16& p1, float& m_reg, float& mn, float& alpha) {
  if constexpr (NOMAX) { for (int r = 0; r < 16; ++r) p0[r] = __builtin_amdgcn_exp2f(p0[r]); alpha = 1.f; return; }
  constexpr float C = SCALE * 1.4426950408889634f;
  float pmax = p0[0]; for (int r = 1; r < 16; ++r) pmax = fmaxf(pmax, p0[r]); for (int r = 0; r < 16; ++r) pmax = fmaxf(pmax, p1[r]);
  { auto rr = __builtin_amdgcn_permlane32_swap(__float_as_uint(pmax), __float_as_uint(pmax), false, false);
    pmax = fmaxf(__uint_as_float(rr[0]), __uint_as_float(rr[1])); }
  if (__builtin_expect(__all(pmax - m_reg <= THR / SCALE), 1)) { mn = m_reg; alpha = 1.f; }
  else { mn = fmaxf(m_reg, pmax); alpha = __builtin_amdgcn_exp2f((m_reg - mn) * C); m_reg = mn; }
  float mnC = -mn * C;
  for (int r = 0; r < 16; ++r) p0[r] = fmaf(p0[r], C, mnC); for (int r = 0; r < 16; ++r) p1[r] = fmaf(p1[r], C, mnC);
  for (int r = 0; r < 16; ++r) p0[r] = __builtin_amdgcn_exp2f(p0[r]);
}
__device__ __forceinline__ void finishSM(f32x16& p0, f32x16& p1, float alpha, float& l_reg, bf16x8& pa0, bf16x8& pa1, bf16x8& pa2, bf16x8& pa3) {
  for (int r = 0; r < 16; ++r) p1[r] = __builtin_amdgcn_exp2f(p1[r]);
  float ps = 0; for (int r = 0; r < 16; ++r) ps += p0[r]; for (int r = 0; r < 16; ++r) ps += p1[r];
  { auto rr = __builtin_amdgcn_permlane32_swap(__float_as_uint(ps), __float_as_uint(ps), false, false);
    ps = __uint_as_float(rr[0]) + __uint_as_float(rr[1]); }
  l_reg = l_reg * alpha + ps;
#define PK4(P, BASE, OUT) do { unsigned a0 = cvtpk(P[BASE + 0], P[BASE + 1]), a1 = cvtpk(P[BASE + 2], P[BASE + 3]);   \
    unsigned b0 = cvtpk(P[BASE + 4], P[BASE + 5]), b1 = cvtpk(P[BASE + 6], P[BASE + 7]);                              \
    auto r0 = __builtin_amdgcn_permlane32_swap(a0, b0, false, false); auto r1 = __builtin_amdgcn_permlane32_swap(a1, b1, false, false); \
    u32x4 w = {r0[0], r1[0], r0[1], r1[1]}; OUT = *reinterpret_cast<bf16x8*>(&w); } while (0)
  PK4(p0, 0, pa0); PK4(p0, 8, pa1); PK4(p1, 0, pa2); PK4(p1, 8, pa3);
#undef PK4
}
__device__ __forceinline__ void qkt(f32x16& p0, f32x16& p1, const bf16* Ks, const bf16x8* qr, int r32, int hi) {
  p0 = f32x16{}; p1 = f32x16{};
  for (int d0 = 0; d0 < 8; ++d0) { int cb = (d0 * 16 + hi * 8) * 2;
    bf16x8 b0 = *reinterpret_cast<const bf16x8*>((const char*)Ks + KSWZ(r32, cb));
    bf16x8 b1 = *reinterpret_cast<const bf16x8*>((const char*)Ks + KSWZ(32 + r32, cb));
    p0 = __builtin_amdgcn_mfma_f32_32x32x16_bf16(b0, qr[d0], p0, 0, 0, 0);
    p1 = __builtin_amdgcn_mfma_f32_32x32x16_bf16(b1, qr[d0], p1, 0, 0, 0); }
}
__device__ __forceinline__ int v_st(int k, int c) { const int kk = (k & ~0xC) | ((k & 4) << 1) | ((k & 8) >> 1); return ((kk >> 3) * 4 + (c >> 5)) * 512 + ((kk & 7) * 32 + (c & 31)) * 2; }
__device__ __forceinline__ int v_rd_base(int lane) { return ((lane & 3) << 3) | (((lane >> 2) & 3) << 6) | (((lane >> 4) & 1) << 5) | (((lane >> 5) & 1) << 8); }
constexpr int v_rd_off(int d0, int ks, int half) { return d0 * 512 + ks * 4096 + half * 2048; }
template <int OFF> __device__ __forceinline__ s16x4 tr_read(int vb) {
  s16x4 r; asm volatile("ds_read_b64_tr_b16 %0, %1 offset:%2" : "=&v"(r) : "v"(vb), "i"(OFF) : "memory"); return r;
}
template <int D0> __device__ __forceinline__ void pv_one(f32x16& od, int vb, bf16x8 pa0, bf16x8 pa1, bf16x8 pa2, bf16x8 pa3) {
  const s16x4 l0 = tr_read<v_rd_off(D0, 0, 0)>(vb), h0 = tr_read<v_rd_off(D0, 0, 1)>(vb), l1 = tr_read<v_rd_off(D0, 1, 0)>(vb), h1 = tr_read<v_rd_off(D0, 1, 1)>(vb);
  const s16x4 l2 = tr_read<v_rd_off(D0, 2, 0)>(vb), h2 = tr_read<v_rd_off(D0, 2, 1)>(vb), l3 = tr_read<v_rd_off(D0, 3, 0)>(vb), h3 = tr_read<v_rd_off(D0, 3, 1)>(vb);
  asm volatile("s_waitcnt lgkmcnt(0)" ::: "memory"); SBAR();
#define PK(L, H) (bf16x8){L[0], L[1], L[2], L[3], H[0], H[1], H[2], H[3]}
  od = __builtin_amdgcn_mfma_f32_32x32x16_bf16(pa0, PK(l0, h0), od, 0, 0, 0);
  od = __builtin_amdgcn_mfma_f32_32x32x16_bf16(pa1, PK(l1, h1), od, 0, 0, 0);
  od = __builtin_amdgcn_mfma_f32_32x32x16_bf16(pa2, PK(l2, h2), od, 0, 0, 0);
  od = __builtin_amdgcn_mfma_f32_32x32x16_bf16(pa3, PK(l3, h3), od, 0, 0, 0);
#undef PK
}
__device__ __forceinline__ void pv_d0(f32x16* o, int vb, bf16x8 pa0, bf16x8 pa1, bf16x8 pa2, bf16x8 pa3) {
  pv_one<0>(o[0], vb, pa0, pa1, pa2, pa3); pv_one<1>(o[1], vb, pa0, pa1, pa2, pa3); pv_one<2>(o[2], vb, pa0, pa1, pa2, pa3); pv_one<3>(o[3], vb, pa0, pa1, pa2, pa3);
}

template <typename TQ, bool NOMAX>
__device__ __forceinline__ void attn_dense_body(const TQ* __restrict__ Qb, const bf16* __restrict__ Kh, const bf16* __restrict__ Vh,
                                                bf16* __restrict__ Ob, int seq, char* lds) {
  using St = Stage<bf16>; using SQ = Stage<TQ>;
  int tid_ = threadIdx.x; asm volatile("" : "+v"(tid_));
  const int tid = tid_, wid = tid >> 6, lane = tid & 63, r32 = lane & 31, hi = lane >> 5;
  bf16* V_lds = (bf16*)lds; bf16* K_lds = (bf16*)(lds + 3 * SHM_V);
  float* ws = (float*)(lds + 3 * SHM_V + 2 * SHM_K) + wid * 64; float* li_l = ws; float* al_l = ws + 32;
  float m_reg = -1e30f, l_reg = 0; f32x16 o[4] = {}; bf16x8 qr[8];
  const TQ* Qw = Qb + (long)(wid * QBLK + r32) * LDQ + hi * 8;
#pragma unroll
  for (int d0 = 0; d0 < 8; ++d0) { qr[d0] = SQ::tobf(SQ::ld8(Qw + d0 * 16));
    if constexpr (NOMAX) { constexpr float C = SCALE * 1.4426950408889634f; u32x4 w = *reinterpret_cast<u32x4*>(&qr[d0]);
      for (int i = 0; i < 4; ++i) w[i] = cvtpk(__uint_as_float(w[i] << 16) * C, __uint_as_float(w[i] & 0xffff0000u) * C);
      qr[d0] = *reinterpret_cast<bf16x8*>(&w); } }
  const int sr = tid >> 4, sc = (tid & 15) * 8, vst0 = v_st(sr, sc), vst1 = v_st(32 + sr, sc);
  const int vb0 = (int)(uintptr_t)V_lds + v_rd_base(lane);
  struct { typename St::T vs0, vs1, ks0, ks1; } sr_[SDEPTH];
#define SLOAD(i, k0) do { sr_[i].vs0 = St::ld8(&Vh[(long)((k0) + sr) * LDK + sc]); sr_[i].vs1 = St::ld8(&Vh[(long)((k0) + 32 + sr) * LDK + sc]); \
    sr_[i].ks0 = St::ld8(&Kh[(long)((k0) + sr) * LDK + sc]); sr_[i].ks1 = St::ld8(&Kh[(long)((k0) + 32 + sr) * LDK + sc]); } while (0)
#define SWRITE(b, voff, i) do { *(bf16x8*)((char*)V_lds + (voff) + vst0) = St::tobf(sr_[i].vs0);          \
    *(bf16x8*)((char*)V_lds + (voff) + vst1) = St::tobf(sr_[i].vs1); int kc = sc * 2;               \
    *(bf16x8*)((char*)K_lds + (b) * SHM_K + KSWZ(sr, kc)) = St::tobf(sr_[i].ks0);                       \
    *(bf16x8*)((char*)K_lds + (b) * SHM_K + KSWZ(32 + sr, kc)) = St::tobf(sr_[i].ks1); } while (0)
#define SWAIT() do { if constexpr (SDEPTH == 2) asm volatile("s_waitcnt vmcnt(4)" ::: "memory"); else asm volatile("s_waitcnt vmcnt(0)" ::: "memory"); } while (0)
#define RESC(a) do { if (!NOMAX && __any((a) < 1.f)) { if (hi == 0) al_l[r32] = (a); asm volatile("s_waitcnt lgkmcnt(0)" ::: "memory"); \
    for (int d = 0; d < 4; ++d) for (int r = 0; r < 16; ++r) o[d][r] *= al_l[crow(r, hi)]; } } while (0)
  f32x16 pA0, pA1, pB0, pB1; float mnA, mnB, alA, alB; bf16x8 pa0, pa1, pa2, pa3; const int NT = seq / KVBLK;
  constexpr int SE = 0, SO = SDEPTH - 1;
  SLOAD(SE, 0); asm volatile("s_waitcnt vmcnt(0)" ::: "memory"); SWRITE(0, 0, SE); __syncthreads();
  qkt(pA0, pA1, K_lds, qr, r32, hi); partialSM<NOMAX>(pA0, pA1, m_reg, mnA, alA);
  SLOAD(SO, KVBLK); if constexpr (SDEPTH == 2) { if (2 < NT) SLOAD(SE, 2 * KVBLK); }
  SWAIT(); SWRITE(1, (int)SHM_V, SO); __syncthreads();
  int vr = 0, vw = 2 * (int)SHM_V;
#define VNEXT(x) ((x) == 2 * (int)SHM_V ? 0 : (x) + (int)SHM_V)
  for (int j = 1; j + 1 < NT; j += 2) {
    SBAR(); qkt(pB0, pB1, (bf16*)((char*)K_lds + SHM_K), qr, r32, hi);
    finishSM(pA0, pA1, alA, l_reg, pa0, pa1, pa2, pa3); SBAR();
    SLOAD(SO, (j + SDEPTH) * KVBLK); SBAR();
    pv_d0(o, vb0 + vr, pa0, pa1, pa2, pa3); partialSM<NOMAX>(pB0, pB1, m_reg, mnB, alB);
    SWAIT(); SWRITE(0, vw, SE); vr = VNEXT(vr); vw = VNEXT(vw);
    RESC(alB); __syncthreads();
    SBAR(); qkt(pA0, pA1, K_lds, qr, r32, hi);
    finishSM(pB0, pB1, alB, l_reg, pa0, pa1, pa2, pa3); SBAR();
    if (SDEPTH == 1 || j + 3 < NT) SLOAD(SE, (j + 1 + SDEPTH) * KVBLK); SBAR();
    pv_d0(o, vb0 + vr, pa0, pa1, pa2, pa3); partialSM<NOMAX>(pA0, pA1, m_reg, mnA, alA);
    SWAIT(); SWRITE(1, vw, SO); vr = VNEXT(vr); vw = VNEXT(vw);
    RESC(alA); __syncthreads();
  }
  SBAR(); qkt(pB0, pB1, (bf16*)((char*)K_lds + SHM_K), qr, r32, hi);
  finishSM(pA0, pA1, alA, l_reg, pa0, pa1, pa2, pa3); SBAR();
  pv_d0(o, vb0 + vr, pa0, pa1, pa2, pa3); partialSM<NOMAX>(pB0, pB1, m_reg, mnB, alB);
  vr = VNEXT(vr); RESC(alB);
  finishSM(pB0, pB1, alB, l_reg, pa0, pa1, pa2, pa3); SBAR();
  pv_d0(o, vb0 + vr, pa0, pa1, pa2, pa3);
#undef VNEXT
  if (hi == 0) li_l[r32] = l_reg; asm volatile("s_waitcnt lgkmcnt(0)" ::: "memory");
  float rli[16];
#pragma unroll
  for (int r = 0; r < 16; ++r) rli[r] = __builtin_amdgcn_rcpf(li_l[crow(r, hi)]);
  bf16* Ow = Ob + (long)(wid * QBLK) * LDO;
#pragma unroll
  for (int r = 0; r < 16; ++r) { int orow = crow(r, hi);
    for (int d0 = 0; d0 < 4; ++d0) Ow[(long)orow * LDO + d0 * 32 + r32] = (bf16)(cvtpk(o[d0][r] * rli[r], 0.f) & 0xffffu); }
#undef SLOAD
#undef SWRITE
#undef SWAIT
#undef RESC
}
#undef KSWZ
#undef SBAR
}

namespace rw {
typedef short bf16x8 __attribute__((ext_vector_type(8)));
typedef float f32x4 __attribute__((ext_vector_type(4)));
typedef unsigned u32x4 __attribute__((ext_vector_type(4)));
typedef unsigned u32x2 __attribute__((ext_vector_type(2)));
constexpr int CH = 32, NC = R / CH;
static_assert(NC % 2 == 0, "the prep loop is unrolled by two");
constexpr int BUFB = 5 * 8192 + 1024;
constexpr int O_W = 0, O_B = 8192, O_KD = 16384, O_A = 24576, O_R = 32768, O_V = 40960;
constexpr int PITCH = 72;
constexpr int L_SCR = 2 * BUFB, SCRB = 2 * 16 * PITCH * 2;
constexpr int L_W2T = L_SCR + 4 * SCRB, L_A2T = L_W2T + 64 * PITCH * 2;
constexpr int L_Y = L_A2T + 64 * PITCH * 2;
constexpr int L_CST = L_Y + 2 * 2 * CH * 64 * 4;
constexpr int L_END = L_CST + 10 * 64 * 4;
static_assert(L_END <= 163840 - 64 && (BUFB % 16) == 0 && (L_SCR % 16) == 0 && (SCRB % 16) == 0 && (L_W2T % 16) == 0 && (L_A2T % 16) == 0 && (L_Y % 16) == 0 && (L_CST % 16) == 0, "rwkv LDS map");
constexpr size_t WS_BON = 38 * MiB;

template <int CTRL> __device__ __forceinline__ float dppmov(float x) { return __builtin_bit_cast(float, __builtin_amdgcn_update_dpp(0, __builtin_bit_cast(int, x), CTRL, 0xF, 0xF, true)); }
__device__ __forceinline__ float allreduce8(float x) {
    x += dppmov<0xB1>(x);
    x += dppmov<0x4E>(x);
    x += dppmov<0x141>(x);
    return x;
}
__device__ __forceinline__ float allreduce16(float x) { x = allreduce8(x); x += dppmov<0x140>(x); return x; }
__device__ __forceinline__ float fast_tanh(float x) { const float e = __builtin_amdgcn_exp2f(2.885390081777927f * x); return 1.0f - 2.0f * __builtin_amdgcn_rcpf(1.0f + e); }
__device__ __forceinline__ float bflo(unsigned u) { return __uint_as_float(u << 16); }
__device__ __forceinline__ float bfhi(unsigned u) { return __uint_as_float(u & 0xffff0000u); }
__device__ __forceinline__ unsigned pkbf(float lo, float hi) { unsigned r; asm volatile("v_cvt_pk_bf16_f32 %0, %1, %2" : "=v"(r) : "v"(lo), "v"(hi)); return r; }

constexpr int SEGR = 128, NSEG = R / SEGR, NCG = (ZW + 511) / 512;
constexpr size_t WS_HALO = 40 * MiB;
static_assert(WS_HALO + (size_t)NSEG * 2 * ZW * 2 <= WS_XN, "halo rows overflow");
__device__ __forceinline__ void shift_halo(const Params& p) {
    int tid_ = threadIdx.x; asm volatile("" : "+v"(tid_));
    const bf16_t* Z = ws_big(p); bf16_t* H = (bf16_t*)(p.ws + WS_HALO);
    for (int it = (int)blockIdx.x * NTHR + tid_; it < NSEG * 2 * (ZW / 8); it += (int)gridDim.x * NTHR) {
        const int c8 = it % (ZW / 8), w = (it / (ZW / 8)) & 1, seg = it / (2 * (ZW / 8));
        *(u32x4*)(H + ((size_t)seg * 2 + w) * ZW + c8 * 8) = *(const u32x4*)(Z + (size_t)(seg * SEGR + (w ? SEGR - 1 : 0)) * ZW + c8 * 8);
    }
}
__device__ __forceinline__ u32x4 shift8(u32x4 c, u32x4 pv, u32x4 nx, f32x4 m0, f32x4 m1) {
    u32x4 o;
#pragma unroll
    for (int q = 0; q < 4; ++q) { const float ml = q < 2 ? m0[2 * q] : m1[2 * q - 4], mh = q < 2 ? m0[2 * q + 1] : m1[2 * q - 3];
        const float zl = bflo(c[q]), zh = bfhi(c[q]);
        o[q] = pkbf(zl + (0.5f * (bflo(pv[q]) + bflo(nx[q])) - zl) * ml, zh + (0.5f * (bfhi(pv[q]) + bfhi(nx[q])) - zh) * mh); }
    return o;
}
__device__ __forceinline__ void shift_inplace(const Params& p) {
    int tid_ = threadIdx.x; asm volatile("" : "+v"(tid_));
    const int lane = tid_ & 63, gw = (int)blockIdx.x * NWAVES + (tid_ >> 6), ngw = (int)gridDim.x * NWAVES;
    bf16_t* Z = ws_big(p); const bf16_t* H = (const bf16_t*)(p.ws + WS_HALO);
    for (int u = gw; u < NSEG * NCG; u += ngw) {
        const int seg = u / NCG, col = (u % NCG) * 512 + lane * 8;
        if (col < ZW) {
            const f32x4 m0 = *(const f32x4*)(p.mu + col), m1 = *(const f32x4*)(p.mu + col + 4);
            const bool first = seg == 0 || seg == CTXN / SEGR, last = seg == CTXN / SEGR - 1 || seg == NSEG - 1;
            bf16_t* zr = Z + (size_t)seg * SEGR * ZW + col;
            u32x4 pv = first ? (u32x4){0u, 0u, 0u, 0u} : *(const u32x4*)(H + ((size_t)(seg - 1) * 2 + 1) * ZW + col);
            const u32x4 tail = last ? (u32x4){0u, 0u, 0u, 0u} : *(const u32x4*)(H + ((size_t)(seg + 1) * 2) * ZW + col);
            u32x4 c0 = *(const u32x4*)zr, c1 = *(const u32x4*)(zr + ZW), c2 = *(const u32x4*)(zr + 2 * ZW), c3 = *(const u32x4*)(zr + 3 * ZW);
            for (int r = 0; r < SEGR; r += 4) {
                u32x4 n0 = tail, n1 = tail, n2 = tail, n3 = tail;
                if (r + 4 < SEGR) { n0 = *(const u32x4*)(zr + (size_t)(r + 4) * ZW); n1 = *(const u32x4*)(zr + (size_t)(r + 5) * ZW); n2 = *(const u32x4*)(zr + (size_t)(r + 6) * ZW); n3 = *(const u32x4*)(zr + (size_t)(r + 7) * ZW); }
                const u32x4 o0 = shift8(c0, pv, c1, m0, m1), o1 = shift8(c1, c0, c2, m0, m1), o2 = shift8(c2, c1, c3, m0, m1), o3 = shift8(c3, c2, n0, m0, m1);
                *(u32x4*)(zr + (size_t)r * ZW) = o0; *(u32x4*)(zr + (size_t)(r + 1) * ZW) = o1; *(u32x4*)(zr + (size_t)(r + 2) * ZW) = o2; *(u32x4*)(zr + (size_t)(r + 3) * ZW) = o3;
                pv = c3; c0 = n0; c1 = n1; c2 = n2; c3 = n3;
            }
        }
    }
}

struct Raw { u32x4 c[5]; };

template <int MODE> __device__ __forceinline__ void scan_block(const Params& p, int blk, LAS unsigned char* lds) {
    int tid_ = threadIdx.x; asm volatile("" : "+v"(tid_));
    const int tid = tid_, lane = tid & 63, wave = __builtin_amdgcn_readfirstlane(tid >> 6);
    const int dir = blk >> 7, h = (blk >> 3) & 15, eighth = blk & 7;
    const float* w0 = dir ? p.w0b : p.w0f; const float* w2 = dir ? p.w2b : p.w2f; const float* a0 = dir ? p.a0b : p.a0f; const float* a2 = dir ? p.a2b : p.a2f;
    const bf16_t* Z = ws_big(p); bf16_t* BR = ws_br(p); float* bon = (float*)(p.ws + WS_BON) + ((size_t)dir * 16 + h) * SEQ;
    { const int m = tid >> 3, j8 = (tid & 7) * 8;
      const f32x4 wa = *(const f32x4*)(w2 + (size_t)m * 1024 + h * 64 + j8), wb = *(const f32x4*)(w2 + (size_t)m * 1024 + h * 64 + j8 + 4);
      const f32x4 aa = *(const f32x4*)(a2 + (size_t)m * 1024 + h * 64 + j8), ab = *(const f32x4*)(a2 + (size_t)m * 1024 + h * 64 + j8 + 4);
      LAS bf16_t* yw = (LAS bf16_t*)(lds + L_W2T); LAS bf16_t* ya = (LAS bf16_t*)(lds + L_A2T);
#pragma unroll
      for (int q = 0; q < 4; ++q) { yw[(j8 + q) * PITCH + m] = f2bf(wa[q]); yw[(j8 + 4 + q) * PITCH + m] = f2bf(wb[q]); ya[(j8 + q) * PITCH + m] = f2bf(aa[q]); ya[(j8 + 4 + q) * PITCH + m] = f2bf(ab[q]); }
      for (int i = tid; i < 4 * SCRB / 4; i += NTHR) *(LAS unsigned*)(lds + L_SCR + i * 4) = 0u;
      for (int i = tid; i < 640; i += NTHR) { const int g = i >> 6, cc = i & 63, hc = h * 64 + cc; float v;
          if (g < 3) v = p.mu[g * 1024 + hc]; else if (g == 3) v = p.mu[3072 + dir * 64 + cc]; else if (g == 4) v = p.mu[3200 + dir * 64 + cc];
          else if (g == 5) v = w0[hc]; else if (g == 6) v = a0[hc]; else if (g == 7) v = p.k_k[hc]; else if (g == 8) v = p.k_a[hc]; else v = p.r_k[hc];
          *(LAS float*)(lds + L_CST + i * 4) = v; } }
    __syncthreads();
    if ((wave & 2) != 0) {
        const int pw = (wave & 1) + ((wave >> 2) << 1), tq = lane >> 3, c8 = (lane & 7) * 8, hj = h * 64 + c8, tslot = pw * 8 + tq;
        const int gcol[5] = {hj, 1024 + hj, 2048 + hj, 3072 + dir * 64 + c8, 3200 + dir * 64 + c8};
        LAS unsigned char* scr = lds + L_SCR + pw * SCRB;
#define RW_CST(g, hh) (*(LAS f32x4*)(lds + L_CST + ((g) * 64 + c8 + 4 * (hh)) * 4))
#define RW_LOADRAW(raw, cc) do { const bf16_t* zr_ = Z + (size_t)rw_row(dir, (cc) * CH + tslot) * ZW; \
            _Pragma("unroll") for (int g = 0; g < 5; ++g) raw.c[g] = *(const u32x4*)(zr_ + gcol[g]); } while (0)
        Raw rawA, rawB;
        f32x4 cw0[2], ca0[2], ckk[2], cka[2], crk[2];
#pragma unroll
        for (int hh = 0; hh < 2; ++hh) { cw0[hh] = RW_CST(5, hh); ca0[hh] = RW_CST(6, hh); ckk[hh] = RW_CST(7, hh); cka[hh] = RW_CST(8, hh); crk[hh] = RW_CST(9, hh);
            asm volatile("" : "+v"(cw0[hh]), "+v"(ca0[hh]), "+v"(ckk[hh]), "+v"(cka[hh]), "+v"(crk[hh])); }
        if (MODE == 0 || MODE == 2 || MODE == 3 || MODE == 9) { RW_LOADRAW(rawA, 0); RW_LOADRAW(rawB, 1); }
#define RW_PREP_ITER(RAWSET, cc_) do { \
            if (MODE == 0 || MODE == 2 || MODE == 3 || MODE == 9) { \
            const int cn = (cc_) + 1; LAS unsigned char* buf = lds + (cn & 1) * BUFB; const int p0 = cn * CH; const bool latent = p0 >= CTXN; \
            f32x4 rr[2], kv[2]; \
            { const u32x4 u = RAWSET.c[0]; rr[0] = (f32x4){bflo(u.x), bfhi(u.x), bflo(u.y), bfhi(u.y)}; rr[1] = (f32x4){bflo(u.z), bfhi(u.z), bflo(u.w), bfhi(u.w)}; \
              *(LAS f32x4*)(buf + O_R + (tslot * 64 + c8) * 4) = rr[0]; *(LAS f32x4*)(buf + O_R + (tslot * 64 + c8) * 4 + 16) = rr[1]; } \
            { const u32x4 u = RAWSET.c[1]; kv[0] = (f32x4){bflo(u.x), bfhi(u.x), bflo(u.y), bfhi(u.y)}; kv[1] = (f32x4){bflo(u.z), bfhi(u.z), bflo(u.w), bfhi(u.w)}; } \
            if ((lane & 7) == eighth) { const u32x4 u = RAWSET.c[2]; *(LAS f32x4*)(buf + O_V + tslot * 32) = (f32x4){bflo(u.x), bfhi(u.x), bflo(u.y), bfhi(u.y)}; *(LAS f32x4*)(buf + O_V + tslot * 32 + 16) = (f32x4){bflo(u.z), bfhi(u.z), bflo(u.w), bfhi(u.w)}; } \
            { const u32x4 u = RAWSET.c[3]; u32x4 o; \
              o.x = pkbf(fast_tanh(bflo(u.x)), fast_tanh(bfhi(u.x))); o.y = pkbf(fast_tanh(bflo(u.y)), fast_tanh(bfhi(u.y))); o.z = pkbf(fast_tanh(bflo(u.z)), fast_tanh(bfhi(u.z))); o.w = pkbf(fast_tanh(bflo(u.w)), fast_tanh(bfhi(u.w))); \
              *(LAS u32x4*)(scr + (tq * PITCH + c8) * 2) = o; *(LAS u32x4*)(scr + 16 * PITCH * 2 + (tq * PITCH + c8) * 2) = RAWSET.c[4]; } \
            if (cn + 2 < NC) RW_LOADRAW(RAWSET, cn + 2);              \
            asm volatile("s_waitcnt lgkmcnt(0)" ::: "memory"); \
            { const int r16 = lane & 15, quad = lane >> 4; f32x4 acc[2][4]; \
_Pragma("unroll") \
              for (int lora = 0; lora < 2; ++lora) { \
                  LAS unsigned char* X = scr + lora * 16 * PITCH * 2 + (r16 * PITCH + quad * 8) * 2; \
                  const bf16x8 x0 = *(LAS bf16x8*)X, x1 = *(LAS bf16x8*)(X + 64); \
_Pragma("unroll") \
                  for (int jt = 0; jt < 4; ++jt) { \
                      LAS unsigned char* Y = lds + (lora ? L_A2T : L_W2T) + ((jt * 16 + r16) * PITCH + quad * 8) * 2; \
                      acc[lora][jt] = (f32x4){0.f, 0.f, 0.f, 0.f}; \
                      acc[lora][jt] = __builtin_amdgcn_mfma_f32_16x16x32_bf16(x0, *(LAS bf16x8*)Y, acc[lora][jt], 0, 0, 0); \
                      acc[lora][jt] = __builtin_amdgcn_mfma_f32_16x16x32_bf16(x1, *(LAS bf16x8*)(Y + 64), acc[lora][jt], 0, 0, 0); } } \
              if (quad < 2) { \
_Pragma("unroll") \
                  for (int lora = 0; lora < 2; ++lora) \
_Pragma("unroll") \
                      for (int jt = 0; jt < 4; ++jt) \
_Pragma("unroll") \
                          for (int r = 0; r < 4; ++r) *(LAS float*)(buf + (lora ? O_B : O_W) + ((pw * 8 + quad * 4 + r) * 64 + jt * 16 + r16) * 4) = acc[lora][jt][r]; } } \
            asm volatile("s_waitcnt lgkmcnt(0)" ::: "memory"); \
            { float bs = 0.f, nn = 0.f; f32x4 kk[2], al[2]; \
_Pragma("unroll") \
              for (int hh = 0; hh < 2; ++hh) { const int off = (tslot * 64 + c8 + 4 * hh) * 4; \
                  const f32x4 aw = *(LAS f32x4*)(buf + O_W + off) + cw0[hh], aa = *(LAS f32x4*)(buf + O_B + off) + ca0[hh]; \
                  f32x4 wv; \
_Pragma("unroll") \
                  for (int q = 0; q < 4; ++q) { const float sg = __builtin_amdgcn_rcpf(1.0f + __builtin_amdgcn_exp2f(-1.4426950408889634f * aw[q])); \
                      wv[q] = __builtin_amdgcn_exp2f(-0.8750612633917f * sg); al[hh][q] = __builtin_amdgcn_rcpf(1.0f + __builtin_amdgcn_exp2f(-1.4426950408889634f * aa[q])); kk[hh][q] = kv[hh][q] * ckk[hh][q]; nn += kk[hh][q] * kk[hh][q]; } \
                  *(LAS f32x4*)(buf + O_W + off) = wv; } \
              nn = allreduce8(nn); \
              const float inv = __builtin_amdgcn_rsqf(fmaxf(nn, 1e-24f)); \
_Pragma("unroll") \
              for (int hh = 0; hh < 2; ++hh) { const int off = (tslot * 64 + c8 + 4 * hh) * 4; \
                  const f32x4 r = rr[hh]; \
                  f32x4 av, bv, kd; \
_Pragma("unroll") \
                  for (int q = 0; q < 4; ++q) { const float kn = kk[hh][q] * inv; av[q] = -kn; bv[q] = kn * al[hh][q]; kd[q] = kv[hh][q] * (1.0f + (al[hh][q] - 1.0f) * cka[hh][q]); bs += r[q] * kd[q] * crk[hh][q]; } \
                  *(LAS f32x4*)(buf + O_B + off) = bv; *(LAS f32x4*)(buf + O_KD + off) = kd; *(LAS f32x4*)(buf + O_A + off) = av; } \
              bs = allreduce8(bs); \
              if (MODE == 0 && latent && eighth == 0 && (lane & 7) == 0) bon[rw_row(dir, p0 + tslot) - CTXN] = bs; } \
            } \
            __syncthreads(); \
        } while (0)
        for (int c = -1; c < NC - 1; c += 2) { RW_PREP_ITER(rawA, c); RW_PREP_ITER(rawB, c + 1); }
#undef RW_PREP_ITER
#undef RW_LOADRAW
#undef RW_CST
    } else if (wave >= 4) {
        const int sw = wave - 4, et = lane >> 1, erp = lane & 1;
#define RW_EMIT(cc) do { if ((cc) * CH >= CTXN) { const LAS f32x4* yp = (const LAS f32x4*)(lds + L_Y + ((((cc) & 1) * 2 + sw) * 8192) + et * 256 + erp * 128); \
            f32x4 s0 = yp[0] + yp[1] + yp[2] + yp[3], s1 = yp[4] + yp[5] + yp[6] + yp[7]; \
            *(unsigned*)(BR + (size_t)rw_row(dir, (cc) * CH + et) * 2048 + dir * 1024 + h * 64 + eighth * 8 + sw * 4 + erp * 2) = pkbf((s0[0] + s0[1]) + (s0[2] + s0[3]), (s1[0] + s1[1]) + (s1[2] + s1[3])); } } while (0)
        __syncthreads();
        for (int c = 0; c < NC; ++c) { if (c >= 1) RW_EMIT(c - 1); if (c + 1 < NC) __syncthreads(); }
    } else {
        __builtin_amdgcn_s_setprio(0);
        typedef float f32x2 __attribute__((ext_vector_type(2)));
        f32x2 S01 = {0.f, 0.f}, S23 = {0.f, 0.f};
        const int srow = wave * 4 + (lane >> 4), sj = (lane & 15) * 4;
        __syncthreads();
        struct Ops { f32x4 a, w, b, k, r; float v; };
#define RW_LD(o, t) do { o.a = *(LAS f32x4*)(bp + O_A + (t) * 256); \
            if (MODE == 9) { o.w = o.a; o.b = o.a; o.k = o.a; o.r = o.a; o.v = o.a[0]; } else { o.w = *(LAS f32x4*)(bp + O_W + (t) * 256); o.b = *(LAS f32x4*)(bp + O_B + (t) * 256); \
            o.k = *(LAS f32x4*)(bp + O_KD + (t) * 256); o.r = *(LAS f32x4*)(bp + O_R + (t) * 256); o.v = *(LAS float*)(vp + (t) * 32); } } while (0)
#define RW_STEP(o, t) do { f32x2 pd = S01 * o.a.lo; pd = S23 * o.a.hi + pd; float sa = pd.x + pd.y; if (MODE != 5 && MODE != 7) sa = allreduce16(sa); \
            S01 = o.b.lo * sa + (S01 * o.w.lo + o.k.lo * o.v); S23 = o.b.hi * sa + (S23 * o.w.hi + o.k.hi * o.v); \
            { f32x2 py = S01 * o.r.lo; py = S23 * o.r.hi + py; *(LAS float*)(yb + (t) * 256) = py.x + py.y; } } while (0)
        for (int c = 0; c < NC; ++c) {
            LAS unsigned char* bp = lds + (c & 1) * BUFB + sj * 4; LAS unsigned char* vp = lds + (c & 1) * BUFB + O_V + srow * 4; LAS unsigned char* yb = lds + L_Y + ((c & 1) * 2 + wave) * 8192 + lane * 4;
            Ops A0, A1, A2, A3, B0, B1, B2, B3;
            if (MODE != 2) {
            RW_LD(A0, 0); RW_LD(A1, 1); RW_LD(A2, 2); RW_LD(A3, 3);
#pragma unroll
            for (int g = 0; g < CH / 8; ++g) {
                RW_LD(B0, 8 * g + 4); RW_LD(B1, 8 * g + 5); RW_LD(B2, 8 * g + 6); RW_LD(B3, 8 * g + 7);
                __builtin_amdgcn_sched_barrier(0);
                RW_STEP(A0, 8 * g); RW_STEP(A1, 8 * g + 1); RW_STEP(A2, 8 * g + 2); RW_STEP(A3, 8 * g + 3);
                __builtin_amdgcn_sched_barrier(0);
                if (g + 1 < CH / 8) { RW_LD(A0, 8 * g + 8); RW_LD(A1, 8 * g + 9); RW_LD(A2, 8 * g + 10); RW_LD(A3, 8 * g + 11); }
                __builtin_amdgcn_sched_barrier(0);
                RW_STEP(B0, 8 * g + 4); RW_STEP(B1, 8 * g + 5); RW_STEP(B2, 8 * g + 6); RW_STEP(B3, 8 * g + 7);
                __builtin_amdgcn_sched_barrier(0);
            }
            }
            if (c + 1 < NC) __syncthreads();
        }
#undef RW_LD
#undef RW_STEP
        if (MODE != 0) asm volatile("" :: "v"(S01), "v"(S23));
        __builtin_amdgcn_s_setprio(0);
    }
    __syncthreads();
    if (wave == 4 || wave == 5) { const int sw = wave - 4, et = lane >> 1, erp = lane & 1; RW_EMIT(NC - 1); }
#undef RW_EMIT
    __syncthreads();
}

__device__ __forceinline__ float wave_sum(float v) {
    v = allreduce16(v);
    { auto r = __builtin_amdgcn_permlane16_swap(__float_as_uint(v), __float_as_uint(v), false, false); v = __uint_as_float(r[0]) + __uint_as_float(r[1]); }
    { auto r = __builtin_amdgcn_permlane32_swap(__float_as_uint(v), __float_as_uint(v), false, false); v = __uint_as_float(r[0]) + __uint_as_float(r[1]); }
    return v;
}
__device__ __forceinline__ void finish_phase(const Params& p) {
    int tid_ = threadIdx.x; asm volatile("" : "+v"(tid_));
    const int lane = tid_ & 63, gw = (int)blockIdx.x * NWAVES + (tid_ >> 6), ngw = (int)gridDim.x * NWAVES;
    const bf16_t* Z = ws_big(p); bf16_t* BR = ws_br(p); const float* bon = (const float*)(p.ws + WS_BON);
    for (int it = gw; it < SEQ * 4; it += ngw) {
        const int t = it >> 2, h = (it & 3) * 4 + (lane >> 4), row = CTXN + t, col = h * 64 + (lane & 15) * 4;
        bf16_t* b = BR + (size_t)row * 2048;
        const u32x2 wf = *(const u32x2*)(b + col), wb = *(const u32x2*)(b + 1024 + col), zv = *(const u32x2*)(Z + (size_t)row * ZW + 2048 + col);
        const f32x4 x = {bflo(wf.x) + bflo(wb.x), bfhi(wf.x) + bfhi(wb.x), bflo(wf.y) + bflo(wb.y), bfhi(wf.y) + bfhi(wb.y)};
        const float mean = allreduce16((x[0] + x[1]) + (x[2] + x[3])) * (1.0f / 64.f);
        const f32x4 d = x - mean;
        const float var = allreduce16((d[0] * d[0] + d[1] * d[1]) + (d[2] * d[2] + d[3] * d[3])) * (1.0f / 64.f);
        const float rstd = __builtin_amdgcn_rsqf(var + GN_EPS), bsum = bon[(size_t)h * SEQ + t] + bon[((size_t)16 + h) * SEQ + t];
        const f32x4 g = *(const f32x4*)(p.lnx_g + col), bb = *(const f32x4*)(p.lnx_b + col), v = {bflo(zv.x), bfhi(zv.x), bflo(zv.y), bfhi(zv.y)};
        const f32x4 y = d * rstd * g + bb + v * bsum;
        u32x2 o; o.x = pkbf(y[0], y[1]); o.y = pkbf(y[2], y[3]);
        *(u32x2*)(b + 1024 + col) = o;
    }
}
}

namespace wy {
typedef short bf16x4 __attribute__((ext_vector_type(4)));
using rw::f32x4; using rw::u32x4; using rw::u32x2; using rw::bf16x8; using rw::bflo; using rw::bfhi; using rw::PITCH;
typedef float f32x2_t __attribute__((ext_vector_type(2)));
typedef __bf16 bf2_t __attribute__((ext_vector_type(2)));
__device__ __forceinline__ unsigned pkbf(float lo, float hi) { const f32x2_t v = {lo, hi}; return __builtin_bit_cast(unsigned, __builtin_convertvector(v, bf2_t)); }
typedef GAS unsigned gu32;
#define WY_RLX __ATOMIC_RELAXED, __HIP_MEMORY_SCOPE_AGENT
constexpr int NJOB = R / 64, NCHUNK = R / 16, NSLOT = 8, ATP = 144, REC = 13056, JOBB = 4 * REC;
static_assert(R % 64 == 0 && CTXN % 64 == 0 && (R / 64) % 2 == 0, "jobs are 64 tokens; the loader is unrolled by two jobs");
constexpr int R_AT = 0, R_RT = 2304, R_BK = 4608, R_VT = 8704, R_AAK = 10752, R_TT = 11264, R_ARBK = 11776, R_WL = 12800;
__device__ __forceinline__ int permj(int j) { return (j >> 5) * 32 + ((j >> 2) & 3) * 8 + ((j >> 4) & 1) * 4 + (j & 3); }
constexpr int C_SLOTS = 3, C_SYNC = C_SLOTS * JOBB;
static_assert(C_SYNC + 64 <= 163840 - 64 && (JOBB / 4) % 16 == 0, "consumer LDS map");
constexpr size_t WS_RING = WS_WB;
constexpr size_t RING_TOTAL = (size_t)32 * NSLOT * JOBB;
constexpr size_t WS_WYF = 256 * 1024 + 16384;
constexpr int WYF_ACK = 32 * NSLOT * 64, WYF_ABORT = WYF_ACK + 32 * 64, WYF_WORDS = WYF_ABORT + 64;
constexpr unsigned SPIN_CAP = 1u << 17;
constexpr int P_A = 0, P_B = 16384, P_KD = 32768, P_LW = 49152, P_IMG = 65536, P_BRM = P_IMG + JOBB, P_KRM = P_BRM + 8192, P_AAB = P_KRM + 8192, P_W2T = P_AAB + 4096, P_A2T = P_W2T + 64 * PITCH * 2, P_END = P_A2T + 64 * PITCH * 2;
constexpr int P_SCR = P_BRM, SCRW = 2 * 8 * PITCH * 2;
constexpr int P_CST = P_IMG;
static_assert(P_END <= 163840 - 64 && P_SCR + 8 * SCRW + 8 * PITCH * 2 <= P_W2T, "wy LDS map");

__device__ __forceinline__ bf16x4 pack4(f32x4 v) { u32x2 r; r.x = pkbf(v[0], v[1]); r.y = pkbf(v[2], v[3]); return __builtin_bit_cast(bf16x4, r); }
__device__ __forceinline__ f32x4 mm(u32x2 a, bf16x4 b, f32x4 c) { return __builtin_amdgcn_mfma_f32_16x16x16bf16_1k(__builtin_bit_cast(bf16x4, a), b, c, 0, 0, 0); }
__device__ __forceinline__ f32x4 mm(u32x2 a, u32x2 b, f32x4 c) { return __builtin_amdgcn_mfma_f32_16x16x16bf16_1k(__builtin_bit_cast(bf16x4, a), __builtin_bit_cast(bf16x4, b), c, 0, 0, 0); }
__device__ __forceinline__ void wait_ge(gu32* word, unsigned want, gu32* abortw, int lane) {
    for (unsigned spins = 0;;) {
        unsigned v = 0u; if (lane == 0) v = __hip_atomic_load(word, WY_RLX);
        if ((unsigned)__builtin_amdgcn_readfirstlane(v) >= want) return;
        __builtin_amdgcn_s_sleep(1);
        if ((++spins & 255u) == 0u) { unsigned a = 0u; if (lane == 0) a = __hip_atomic_load(abortw, WY_RLX);
            if (__builtin_amdgcn_readfirstlane(a)) return;
            if (spins > SPIN_CAP) { if (lane == 0) __hip_atomic_store(abortw, 1u, WY_RLX); return; } }
    }
}

__device__ __forceinline__ void wait_ge4(gu32* words, unsigned want, gu32* abortw, int lane) {
    for (unsigned spins = 0;;) {
        unsigned v = 0xffffffffu; if (lane < 4) v = __hip_atomic_load(words + lane, WY_RLX);
        const unsigned v0 = (unsigned)__builtin_amdgcn_readlane((int)v, 0), v1 = (unsigned)__builtin_amdgcn_readlane((int)v, 1), v2 = (unsigned)__builtin_amdgcn_readlane((int)v, 2), v3 = (unsigned)__builtin_amdgcn_readlane((int)v, 3);
        const unsigned m01 = v0 < v1 ? v0 : v1, m23 = v2 < v3 ? v2 : v3;
        if ((m01 < m23 ? m01 : m23) >= want) return;
        __builtin_amdgcn_s_sleep(1);
        if ((++spins & 255u) == 0u) { unsigned a = 0u; if (lane == 0) a = __hip_atomic_load(abortw, WY_RLX);
            if (__builtin_amdgcn_readfirstlane(a)) return;
            if (spins > SPIN_CAP) { if (lane == 0) __hip_atomic_store(abortw, 1u, WY_RLX); return; } }
    }
}

struct Frag { u32x4 a01, a23, r01, r23, bk[4], arbk; u32x2 vT, aak, tt; f32x4 wl[4]; };

__device__ __forceinline__ void wait_lds_min4(LAS unsigned* w, unsigned want, gu32* abortw, int lane) {
    for (unsigned spins = 0;;) {
        const unsigned a = __hip_atomic_load(w, __ATOMIC_RELAXED, __HIP_MEMORY_SCOPE_WORKGROUP), b = __hip_atomic_load(w + 1, __ATOMIC_RELAXED, __HIP_MEMORY_SCOPE_WORKGROUP),
                       c = __hip_atomic_load(w + 2, __ATOMIC_RELAXED, __HIP_MEMORY_SCOPE_WORKGROUP), d = __hip_atomic_load(w + 3, __ATOMIC_RELAXED, __HIP_MEMORY_SCOPE_WORKGROUP);
        const unsigned m0 = a < b ? a : b, m1 = c < d ? c : d;
        if ((unsigned)__builtin_amdgcn_readfirstlane((int)(m0 < m1 ? m0 : m1)) >= want) return;
        __builtin_amdgcn_s_sleep(1);
        if ((++spins & 1023u) == 0u) { unsigned ab = 0u; if (lane == 0) ab = __hip_atomic_load(abortw, WY_RLX);
            if (__builtin_amdgcn_readfirstlane(ab)) return;
            if (spins > (SPIN_CAP << 3)) { if (lane == 0) __hip_atomic_store(abortw, 1u, WY_RLX); return; } }
    }
}
template <int MODE> __device__ __forceinline__ void loader(const Params& p, int chain, int lw, int lane, LAS unsigned char* lds) {
    gu32* wf = (gu32*)(p.ws + WS_WYF); gu32* flags = wf + chain * NSLOT * 64; gu32* ackw = wf + WYF_ACK + chain * 64; gu32* abortw = wf + WYF_ABORT;
    LAS unsigned* loaded = (LAS unsigned*)(lds + C_SYNC); LAS unsigned* done = loaded + 4;
    const __amdgpu_buffer_rsrc_t ring_rsrc = __builtin_amdgcn_make_buffer_rsrc((void*)(p.ws + WS_RING), 0, (int)RING_TOTAL, 0x00020000);
    constexpr int QB = JOBB / 4, NIT = (QB / 16 + 63) / 64, TAIL = QB / 16 - (NIT - 1) * 64;
    static_assert(NIT == 13, "the counted waits below assume 13 loads per set");
    u32x4 va[NIT], vb[NIT];
#define WY_ISSUE(v, g_) do { if (MODE < 2) wait_ge(flags + ((g_) % NSLOT) * 64, (unsigned)(g_) + 1u, abortw, lane); \
        const int soff = (chain * NSLOT + (g_) % NSLOT) * JOBB + lw * QB + lane * 16; \
        _Pragma("unroll") for (int k = 0; k < NIT; ++k) if (MODE == 0 && (k < NIT - 1 || lane < TAIL)) v[k] = __builtin_amdgcn_raw_buffer_load_b128(ring_rsrc, soff + k * 1024, 0, 16); } while (0)
#define WY_COMMIT(v, g_, WAITSTR) do { \
        if (MODE != 1 && (g_) >= C_SLOTS) { wait_lds_min4(done, (unsigned)((g_) - C_SLOTS + 1), abortw, lane); __builtin_amdgcn_fence(__ATOMIC_ACQUIRE, "workgroup"); }     \
        asm volatile(WAITSTR ::: "memory");                                                     \
        LAS unsigned char* dst = lds + ((g_) % C_SLOTS) * JOBB + lw * QB + lane * 16; \
        _Pragma("unroll") for (int k = 0; k < NIT; ++k) if (MODE == 0 && (k < NIT - 1 || lane < TAIL)) *(LAS u32x4*)(dst + k * 1024) = v[k]; \
        asm volatile("s_waitcnt lgkmcnt(0)" ::: "memory"); \
        __builtin_amdgcn_fence(__ATOMIC_RELEASE, "workgroup"); \
        if (lane == 0) { __hip_atomic_store(ackw + lw, (unsigned)(g_) + 1u, WY_RLX); __hip_atomic_store(loaded + lw, (unsigned)(g_) + 1u, __ATOMIC_RELAXED, __HIP_MEMORY_SCOPE_WORKGROUP); } } while (0)
    WY_ISSUE(va, 0);
    for (int g = 0; g < NJOB; g += 2) {
        WY_ISSUE(vb, g + 1); WY_COMMIT(va, g, "s_waitcnt vmcnt(13)");
        if (g + 2 < NJOB) { WY_ISSUE(va, g + 2); WY_COMMIT(vb, g + 1, "s_waitcnt vmcnt(13)"); } else WY_COMMIT(vb, g + 1, "s_waitcnt vmcnt(0)");
    }
#undef WY_ISSUE
#undef WY_COMMIT
}
__device__ __forceinline__ bf16x8 cat(u32x2 a, u32x2 b) { const u32x4 v = {a.x, a.y, b.x, b.y}; return __builtin_bit_cast(bf16x8, v); }
__device__ __forceinline__ u32x2 pack4u(f32x4 v) { u32x2 r; r.x = pkbf(v[0], v[1]); r.y = pkbf(v[2], v[3]); return r; }
__device__ __forceinline__ f32x4 mm32(bf16x8 a, bf16x8 b, f32x4 c) { return __builtin_amdgcn_mfma_f32_16x16x32_bf16(a, b, c, 0, 0, 0); }
template <int MODE> __device__ __forceinline__ void consumer(const Params& p, int chain, int wave, int lane, LAS unsigned char* lds) {
    const int n = lane & 15, q = lane >> 4, dir = chain >> 4, h = chain & 15;
    gu32* abortw = (gu32*)(p.ws + WS_WYF) + WYF_ABORT;
    LAS unsigned* loaded = (LAS unsigned*)(lds + C_SYNC); LAS unsigned* done = loaded + 4;
    f32x4 S0 = {0.f, 0.f, 0.f, 0.f}, S1 = S0, S2 = S0, S3 = S0;
    const int offA = n * ATP + 16 * q, offB = n * 32 + 8 * q, offW = 16 * q, offS = n * 64 + ((q ^ ((n >> 2) & 3)) * 16);
    const long rstep = dir ? -2048 : 2048;
    bf16_t* yq = ws_br(p) + (size_t)(CTXN + (dir ? SEQ - 1 - 4 * q : 4 * q)) * 2048 + dir * 1024 + h * 64 + 16 * wave + n;
#define WY_LOAD(F, base, k) do { \
        F.a01 = *(const LAS u32x4*)(base + offA + (k) * REC + R_AT); F.a23 = *(const LAS u32x4*)(base + offA + (k) * REC + R_AT + 64); \
        F.r01 = *(const LAS u32x4*)(base + offA + (k) * REC + R_RT); F.r23 = *(const LAS u32x4*)(base + offA + (k) * REC + R_RT + 64); \
        _Pragma("unroll") for (int jt = 0; jt < 4; ++jt) { F.bk[jt] = *(const LAS u32x4*)(base + offS + (k) * REC + R_BK + 1024 * jt); F.wl[jt] = *(const LAS f32x4*)(base + offW + (k) * REC + R_WL + 64 * jt); } \
        F.arbk = *(const LAS u32x4*)(base + offS + (k) * REC + R_ARBK); \
        F.vT = *(const LAS u32x2*)(base + offB + (k) * REC + R_VT + 512 * wave); F.aak = *(const LAS u32x2*)(base + offB + (k) * REC + R_AAK); F.tt = *(const LAS u32x2*)(base + offB + (k) * REC + R_TT); } while (0)
#define WY_Q(v) __builtin_bit_cast(bf16x8, v)
#define WY_COMPUTE(F, cidx) do { const f32x4 z0_ = {0.f, 0.f, 0.f, 0.f}; const u32x2 zz_ = {0u, 0u};     \
        f32x4 Z = mm32(cat(F.aak, zz_), cat(F.vT, zz_), z0_); \
        const bf16x8 s01 = cat(pack4u(S0), pack4u(S1)), s23 = cat(pack4u(S2), pack4u(S3)); \
        Z = mm32(WY_Q(F.a01), s01, Z); Z = mm32(WY_Q(F.a23), s23, Z);     \
        f32x4 Y = mm32(WY_Q(F.r01), s01, z0_); Y = mm32(WY_Q(F.r23), s23, Y); \
        const u32x2 zb = pack4u(Z); const f32x4 U = mm32(cat(F.tt, zz_), cat(zb, zz_), z0_); const u32x2 ub = pack4u(U); \
        const bf16x8 vu = cat(F.vT, ub); \
        Y = mm32(WY_Q(F.arbk), vu, Y); \
        S0 = mm32(WY_Q(F.bk[0]), vu, S0); S1 = mm32(WY_Q(F.bk[1]), vu, S1); S2 = mm32(WY_Q(F.bk[2]), vu, S2); S3 = mm32(WY_Q(F.bk[3]), vu, S3); \
        S0 *= F.wl[0]; S1 *= F.wl[1]; S2 *= F.wl[2]; S3 *= F.wl[3]; \
        if (MODE == 0 && (cidx) * 16 >= CTXN) { const unsigned y01 = pkbf(Y[0], Y[1]), y23 = pkbf(Y[2], Y[3]); bf16_t* yp_ = yq + (long)((cidx) * 16 - CTXN) * rstep; \
            *(unsigned short*)yp_ = (unsigned short)(y01 & 0xffffu); *(unsigned short*)(yp_ + rstep) = (unsigned short)(y01 >> 16); \
            *(unsigned short*)(yp_ + 2 * rstep) = (unsigned short)(y23 & 0xffffu); *(unsigned short*)(yp_ + 3 * rstep) = (unsigned short)(y23 >> 16); } } while (0)
    Frag FA, FB;
    wait_lds_min4(loaded, 1u, abortw, lane); __builtin_amdgcn_fence(__ATOMIC_ACQUIRE, "workgroup");
    int slot = 0;
    { const LAS unsigned char* b0 = lds; WY_LOAD(FA, b0, 0); if (MODE == 3) WY_LOAD(FB, b0, 1); }
    for (int g = 0; g < NJOB; ++g) {
        const LAS unsigned char* base = lds + slot * JOBB;
        if (MODE != 3) WY_LOAD(FB, base, 1); WY_COMPUTE(FA, 4 * g);
        if (MODE != 3) WY_LOAD(FA, base, 2); WY_COMPUTE(FB, 4 * g + 1);
        if (MODE != 3) WY_LOAD(FB, base, 3); WY_COMPUTE(FA, 4 * g + 2);
        slot = slot == C_SLOTS - 1 ? 0 : slot + 1;
        if (g + 1 < NJOB) { wait_lds_min4(loaded, (unsigned)g + 2u, abortw, lane); __builtin_amdgcn_fence(__ATOMIC_ACQUIRE, "workgroup");
            const LAS unsigned char* nb = lds + slot * JOBB; if (MODE != 3) WY_LOAD(FA, nb, 0); }
        WY_COMPUTE(FB, 4 * g + 3);
        asm volatile("s_waitcnt lgkmcnt(0)" ::: "memory");
        __builtin_amdgcn_fence(__ATOMIC_RELEASE, "workgroup");
        if (lane == 0) __hip_atomic_store(done + wave, (unsigned)g + 1u, __ATOMIC_RELAXED, __HIP_MEMORY_SCOPE_WORKGROUP);
    }
#undef WY_LOAD
#undef WY_COMPUTE
#undef WY_Q
    if (MODE != 0) asm volatile("" :: "v"(S0), "v"(S1), "v"(S2), "v"(S3));
}

template <int HALF> __device__ __forceinline__ void stage2(LAS unsigned char* lds, LAS unsigned char* img, int ch, int j) {
    LAS unsigned char* rec = img + ch * REC;
    const LAS float* LW = (const LAS float*)(lds + P_LW) + (ch * 16) * 64 + j;
    const LAS float* XA = (const LAS float*)(lds + (HALF ? P_KD : P_A)) + (ch * 16) * 64 + j;
    const LAS float* XB = (const LAS float*)(lds + P_B) + (ch * 16) * 64 + j;
    LAS unsigned short* rowm0 = (LAS unsigned short*)(rec + (HALF ? R_RT : R_AT)) + permj(j);
    LAS unsigned short* rowm1 = (LAS unsigned short*)(lds + (HALF ? P_KRM : P_BRM) + ch * 2048) + permj(j);
    float lw[16], s0[16], s1[16];
#pragma unroll
    for (int t = 0; t < 16; ++t) { lw[t] = LW[t * 64]; s1[t] = HALF ? XA[t * 64] : XB[t * 64];
        if (HALF) s0[t] = __uint_as_float((unsigned)rowm0[t * (ATP / 2)] << 16); else s0[t] = XA[t * 64]; }
    float cum = 0.f, x0p = 0.f, x1p = 0.f; unsigned tp[8];
#pragma unroll
    for (int t = 0; t < 16; ++t) {
        const float cprev = cum; cum += lw[t];
        const float x0 = s0[t] * __builtin_amdgcn_exp2f(HALF ? cum : cprev), x1 = s1[t] * __builtin_amdgcn_exp2f(-cum);
        if (t & 1) { const unsigned p0 = pkbf(x0p, x0), p1 = pkbf(x1p, x1);
            rowm0[(t - 1) * (ATP / 2)] = (unsigned short)(p0 & 0xffffu); rowm0[t * (ATP / 2)] = (unsigned short)(p0 >> 16);
            rowm1[(t - 1) * 64] = (unsigned short)(p1 & 0xffffu); rowm1[t * 64] = (unsigned short)(p1 >> 16);
            tp[t >> 1] = p1; }
        x0p = x0; x1p = x1; }
    { LAS unsigned char* bkr = rec + R_BK + j * 64 + (HALF ? 0 : 8); const int sw = (j >> 2) & 3;
#pragma unroll
      for (int qq = 0; qq < 4; ++qq) *(LAS u32x2*)(bkr + ((qq ^ sw) * 16)) = (u32x2){tp[2 * qq], tp[2 * qq + 1]}; }
    if (HALF) *(LAS float*)(rec + R_WL + j * 4) = __builtin_amdgcn_exp2f(cum);
}

template <int SKIP> __device__ __forceinline__ void producer(const Params& p, int chain, int first, int step, LAS unsigned char* lds) {
    int tid_ = threadIdx.x; asm volatile("" : "+v"(tid_));
    const int tid = tid_, lane = tid & 63, wave = __builtin_amdgcn_readfirstlane(tid >> 6);
    const int dir = chain >> 4, h = chain & 15;
    const float* w0 = dir ? p.w0b : p.w0f; const float* w2 = dir ? p.w2b : p.w2f; const float* a0 = dir ? p.a0b : p.a0f; const float* a2 = dir ? p.a2b : p.a2f;
    const bf16_t* Z = ws_big(p); float* bon = (float*)(p.ws + rw::WS_BON) + ((size_t)dir * 16 + h) * SEQ;
    gu32* wf = (gu32*)(p.ws + WS_WYF); gu32* flags = wf + chain * NSLOT * 64; gu32* ackw = wf + WYF_ACK + chain * 64; gu32* abortw = wf + WYF_ABORT;
    const __amdgpu_buffer_rsrc_t ring_rsrc = __builtin_amdgcn_make_buffer_rsrc((void*)(p.ws + WS_RING), 0, (int)RING_TOTAL, 0x00020000);
    { const int m = tid >> 3, j8 = (tid & 7) * 8;
      const f32x4 wa = *(const f32x4*)(w2 + (size_t)m * 1024 + h * 64 + j8), wb = *(const f32x4*)(w2 + (size_t)m * 1024 + h * 64 + j8 + 4);
      const f32x4 aa = *(const f32x4*)(a2 + (size_t)m * 1024 + h * 64 + j8), ab = *(const f32x4*)(a2 + (size_t)m * 1024 + h * 64 + j8 + 4);
      LAS bf16_t* yw = (LAS bf16_t*)(lds + P_W2T); LAS bf16_t* ya = (LAS bf16_t*)(lds + P_A2T);
#pragma unroll
      for (int qq = 0; qq < 4; ++qq) { yw[(j8 + qq) * PITCH + m] = f2bf(wa[qq]); yw[(j8 + 4 + qq) * PITCH + m] = f2bf(wb[qq]); ya[(j8 + qq) * PITCH + m] = f2bf(aa[qq]); ya[(j8 + 4 + qq) * PITCH + m] = f2bf(ab[qq]); }
      for (int i = tid; i < 320; i += NTHR) { const int gI = i >> 6, cc = i & 63, hc = h * 64 + cc; float v;
          if (gI == 0) v = w0[hc]; else if (gI == 1) v = a0[hc]; else if (gI == 2) v = p.k_k[hc]; else if (gI == 3) v = p.k_a[hc]; else v = p.r_k[hc];
          *(LAS float*)(lds + P_CST + i * 4) = v; } }
    __syncthreads();
    const int tq = lane >> 3, c8 = (lane & 7) * 8, hj = h * 64 + c8, tslot = wave * 8 + tq, ch1 = tslot >> 4, t1 = tslot & 15;
    const int gcol[5] = {hj, 1024 + hj, 2048 + hj, 3072 + dir * 64 + c8, 3200 + dir * 64 + c8};
    f32x4 cw0[2], ca0[2], ckk[2], cka[2], crk[2];
#pragma unroll
    for (int hh = 0; hh < 2; ++hh) {
#define WY_CST(gI) (*(LAS f32x4*)(lds + P_CST + ((gI) * 64 + c8 + 4 * hh) * 4))
        cw0[hh] = WY_CST(0); ca0[hh] = WY_CST(1); ckk[hh] = WY_CST(2); cka[hh] = WY_CST(3); crk[hh] = WY_CST(4);
#undef WY_CST
        asm volatile("" : "+v"(cw0[hh]), "+v"(ca0[hh]), "+v"(ckk[hh]), "+v"(cka[hh]), "+v"(crk[hh])); }
    __syncthreads();
    LAS unsigned char* scr = lds + P_SCR + wave * SCRW;
    LAS unsigned char* img = lds + P_IMG;
    rw::Raw raw;
#define WY_LOADRAW(gj) do { const bf16_t* zr_ = Z + (size_t)rw_row(dir, (gj) * 64 + tslot) * ZW; \
        _Pragma("unroll") for (int g5 = 0; g5 < 5; ++g5) raw.c[g5] = *(const u32x4*)(zr_ + gcol[g5]); } while (0)
    if (first < NJOB) WY_LOADRAW(first);
    for (int g = first; g < NJOB; g += step) {
        const bool latent = g * 64 >= CTXN;
        if (!(SKIP & 1)) { f32x4 rr[2], kv[2];
          { const u32x4 u = raw.c[0]; rr[0] = (f32x4){bflo(u.x), bfhi(u.x), bflo(u.y), bfhi(u.y)}; rr[1] = (f32x4){bflo(u.z), bfhi(u.z), bflo(u.w), bfhi(u.w)};
            LAS unsigned char* rr_ = img + ch1 * REC + R_RT + t1 * ATP + permj(c8) * 2; *(LAS u32x2*)rr_ = (u32x2){u.x, u.y}; *(LAS u32x2*)(rr_ + 16) = (u32x2){u.z, u.w}; }
          { const u32x4 u = raw.c[1]; kv[0] = (f32x4){bflo(u.x), bfhi(u.x), bflo(u.y), bfhi(u.y)}; kv[1] = (f32x4){bflo(u.z), bfhi(u.z), bflo(u.w), bfhi(u.w)}; }
          { const u32x4 u = raw.c[2]; LAS unsigned short* vt = (LAS unsigned short*)(img + ch1 * REC + R_VT) + c8 * 16 + t1;
            vt[0] = (unsigned short)(u.x & 0xffffu); vt[16] = (unsigned short)(u.x >> 16); vt[32] = (unsigned short)(u.y & 0xffffu); vt[48] = (unsigned short)(u.y >> 16);
            vt[64] = (unsigned short)(u.z & 0xffffu); vt[80] = (unsigned short)(u.z >> 16); vt[96] = (unsigned short)(u.w & 0xffffu); vt[112] = (unsigned short)(u.w >> 16); }
          { const u32x4 u = raw.c[3]; u32x4 o;
            o.x = pkbf(rw::fast_tanh(bflo(u.x)), rw::fast_tanh(bfhi(u.x))); o.y = pkbf(rw::fast_tanh(bflo(u.y)), rw::fast_tanh(bfhi(u.y))); o.z = pkbf(rw::fast_tanh(bflo(u.z)), rw::fast_tanh(bfhi(u.z))); o.w = pkbf(rw::fast_tanh(bflo(u.w)), rw::fast_tanh(bfhi(u.w)));
            *(LAS u32x4*)(scr + (tq * PITCH + c8) * 2) = o; *(LAS u32x4*)(scr + 8 * PITCH * 2 + (tq * PITCH + c8) * 2) = raw.c[4]; }
          if (g + step < NJOB) WY_LOADRAW(g + step);
          asm volatile("s_waitcnt lgkmcnt(0)" ::: "memory");
          { const int r16 = lane & 15, quad = lane >> 4; f32x4 acc[2][4];
#pragma unroll
            for (int lora = 0; lora < 2; ++lora) {
                LAS unsigned char* X = scr + lora * 8 * PITCH * 2 + (r16 * PITCH + quad * 8) * 2;
                const bf16x8 x0 = *(LAS bf16x8*)X, x1 = *(LAS bf16x8*)(X + 64);
#pragma unroll
                for (int jt = 0; jt < 4; ++jt) {
                    LAS unsigned char* Y = lds + (lora ? P_A2T : P_W2T) + ((jt * 16 + r16) * PITCH + quad * 8) * 2;
                    acc[lora][jt] = (f32x4){0.f, 0.f, 0.f, 0.f};
                    acc[lora][jt] = __builtin_amdgcn_mfma_f32_16x16x32_bf16(x0, *(LAS bf16x8*)Y, acc[lora][jt], 0, 0, 0);
                    acc[lora][jt] = __builtin_amdgcn_mfma_f32_16x16x32_bf16(x1, *(LAS bf16x8*)(Y + 64), acc[lora][jt], 0, 0, 0); } }
            if (quad < 2) {
#pragma unroll
                for (int lora = 0; lora < 2; ++lora)
#pragma unroll
                    for (int jt = 0; jt < 4; ++jt)
#pragma unroll
                        for (int r = 0; r < 4; ++r) *(LAS float*)(lds + (lora ? P_B : P_LW) + ((wave * 8 + quad * 4 + r) * 64 + jt * 16 + r16) * 4) = acc[lora][jt][r]; } }
          asm volatile("s_waitcnt lgkmcnt(0)" ::: "memory");
          { float bs = 0.f, nn = 0.f; f32x4 kk[2], al[2];
#pragma unroll
            for (int hh = 0; hh < 2; ++hh) { const int off = (tslot * 64 + c8 + 4 * hh) * 4;
                const f32x4 aw = *(LAS f32x4*)(lds + P_LW + off) + cw0[hh], aa = *(LAS f32x4*)(lds + P_B + off) + ca0[hh];
                f32x4 lw;
#pragma unroll
                for (int qq = 0; qq < 4; ++qq) { const float sg = __builtin_amdgcn_rcpf(1.0f + __builtin_amdgcn_exp2f(-1.4426950408889634f * aw[qq]));
                    lw[qq] = -0.8750612633917f * sg; al[hh][qq] = __builtin_amdgcn_rcpf(1.0f + __builtin_amdgcn_exp2f(-1.4426950408889634f * aa[qq])); kk[hh][qq] = kv[hh][qq] * ckk[hh][qq]; nn += kk[hh][qq] * kk[hh][qq]; }
                *(LAS f32x4*)(lds + P_LW + off) = lw; }
            nn = rw::allreduce8(nn);
            const float inv = __builtin_amdgcn_rsqf(fmaxf(nn, 1e-24f));
#pragma unroll
            for (int hh = 0; hh < 2; ++hh) { const int off = (tslot * 64 + c8 + 4 * hh) * 4;
                const f32x4 r = rr[hh];
                f32x4 av, bv, kd;
#pragma unroll
                for (int qq = 0; qq < 4; ++qq) { const float kn = kk[hh][qq] * inv; av[qq] = -kn; bv[qq] = kn * al[hh][qq]; kd[qq] = kv[hh][qq] * (1.0f + (al[hh][qq] - 1.0f) * cka[hh][qq]); bs += r[qq] * kd[qq] * crk[hh][qq]; }
                *(LAS f32x4*)(lds + P_B + off) = bv; *(LAS f32x4*)(lds + P_KD + off) = kd; *(LAS f32x4*)(lds + P_A + off) = av; }
            bs = rw::allreduce8(bs);
            if (latent && (lane & 7) == 0) bon[rw_row(dir, g * 64 + tslot) - CTXN] = bs; } }
        __syncthreads();
        if (!(SKIP & 2)) { if (wave >> 2) stage2<1>(lds, img, wave & 3, lane); else stage2<0>(lds, img, wave & 3, lane); }
        __syncthreads();
        if (!(SKIP & 4)) { const int ch = wave & 3, pair = wave >> 2, n = lane & 15, q = lane >> 4;
          LAS unsigned char* rec = img + ch * REC;
          const LAS unsigned char* Yrm = rec + (pair ? R_RT : R_AT) + n * ATP + 16 * q;
          const LAS unsigned char* Xb = lds + P_BRM + ch * 2048 + n * 128 + 16 * q;
          const LAS unsigned char* Xk = lds + P_KRM + ch * 2048 + n * 128 + 16 * q;
          f32x4 cb = {0.f, 0.f, 0.f, 0.f}, ck = cb;
#pragma unroll
          for (int jt = 0; jt < 4; ++jt) { const int o_ = (jt >> 1) * 64 + (jt & 1) * 8; const u32x2 yb = *(const LAS u32x2*)(Yrm + o_);
              cb = mm(*(const LAS u32x2*)(Xb + o_), yb, cb); ck = mm(*(const LAS u32x2*)(Xk + o_), yb, ck); }
#pragma unroll
          for (int r = 0; r < 4; ++r) { const int s = 4 * q + r; const bool keep = pair ? (s <= n) : (s < n); if (!keep) { cb[r] = 0.f; ck[r] = 0.f; } }
          u32x2 ob, ok; ob.x = pkbf(cb[0], cb[1]); ob.y = pkbf(cb[2], cb[3]); ok.x = pkbf(ck[0], ck[1]); ok.y = pkbf(ck[2], ck[3]);
          if (pair) *(LAS u32x4*)(rec + R_ARBK + n * 64 + ((q ^ ((n >> 2) & 3)) * 16)) = (u32x4){ok.x, ok.y, ob.x, ob.y};
          else {
              *(LAS u32x2*)(rec + R_AAK + n * 32 + 8 * q) = ok;
              LAS float* A2 = (LAS float*)(lds + P_AAB + ch * 1024);
#pragma unroll
              for (int r = 0; r < 4; ++r) A2[n * 16 + r * 4 + q] = cb[r];
              asm volatile("s_waitcnt lgkmcnt(0)" ::: "memory");
              const int c = lane >> 2, pp = lane & 3;
              f32x4 a4[16];
#pragma unroll
              for (int t = 0; t < 16; ++t) a4[t] = *(const LAS f32x4*)(A2 + t * 16 + pp * 4);
              float Tk0 = 0.f, Tk1 = 0.f, Tk2 = 0.f, Tk3 = 0.f, Tprev = 0.f;
              LAS unsigned short* tt = (LAS unsigned short*)(rec + R_TT) + c;
#pragma unroll
              for (int t = 0; t < 16; ++t) {
                  float acc = (a4[t][0] * Tk0 + a4[t][1] * Tk1) + (a4[t][2] * Tk2 + a4[t][3] * Tk3);
                  acc += rw::dppmov<0xB1>(acc); acc += rw::dppmov<0x4E>(acc);
                  const float Tt = acc + ((t == c) ? 1.0f : 0.0f);
                  const bool mine = (t & 3) == pp;
                  if ((t >> 2) == 0) Tk0 = mine ? Tt : Tk0; else if ((t >> 2) == 1) Tk1 = mine ? Tt : Tk1; else if ((t >> 2) == 2) Tk2 = mine ? Tt : Tk2; else Tk3 = mine ? Tt : Tk3;
                  if (t & 1) { const unsigned pk_ = pkbf(Tprev, Tt); if (pp == 0) { tt[(t - 1) * 16] = (unsigned short)(pk_ & 0xffffu); tt[t * 16] = (unsigned short)(pk_ >> 16); } }
                  Tprev = Tt; }
          } }
        if (!(SKIP & 16) && wave == 0 && g >= NSLOT) wait_ge4(ackw, (unsigned)(g - NSLOT + 1), abortw, lane);
        __syncthreads();
        { const int slot = g % NSLOT; const int base = (chain * NSLOT + slot) * JOBB;
          if (!(SKIP & 8)) for (int i = tid; i < JOBB / 16; i += NTHR) __builtin_amdgcn_raw_buffer_store_b128(*(LAS u32x4*)(img + i * 16), ring_rsrc, base + i * 16, 0, 16);
          asm volatile("s_waitcnt vmcnt(0)" ::: "memory");
          __syncthreads();
          if (tid == 0) __hip_atomic_store(flags + slot * 64, (unsigned)g + 1u, WY_RLX); }
    }
#undef WY_LOADRAW
}

__device__ __forceinline__ void zero_words(const Params& p) {
    int t_ = threadIdx.x; asm volatile("" : "+v"(t_)); unsigned* wf_ = (unsigned*)(p.ws + WS_WYF);
    for (long g = (long)blockIdx.x * NTHR + t_; g < (long)WYF_WORDS; g += (long)gridDim.x * NTHR) wf_[g] = 0u;
}
template <int MODE, int SKIP = 0> __device__ __forceinline__ void phase(const Params& p, LAS unsigned char* lds) {
    const int G = (int)gridDim.x, b = (int)blockIdx.x, nper = (G - 32) / 32;
    if (b < 32) {
        int tid_ = threadIdx.x; asm volatile("" : "+v"(tid_)); const int wave = __builtin_amdgcn_readfirstlane(tid_ >> 6);
        if (tid_ < 8) *(LAS unsigned*)(lds + C_SYNC + 4 * tid_) = 0u;
        __syncthreads();
        if (MODE == 4) { }
        else if (wave < 4) { if (MODE != 1) consumer<MODE>(p, b, wave, tid_ & 63, lds); } else loader<MODE>(p, b, wave - 4, tid_ & 63, lds);
    }
    else if (MODE < 2 || MODE == 4) { const int pp = b - 32; if (pp < 32 * nper) producer<SKIP>(p, pp % 32, pp / 32, nper, lds); }
}
}

namespace ret {
using attn::bf16x8; using attn::s16x4; using attn::f32x16; using attn::u32x4;
typedef float f32x4 __attribute__((ext_vector_type(4)));
typedef unsigned u32x2 __attribute__((ext_vector_type(2)));
constexpr int NQ = R / 128;
constexpr size_t SLOT_BYTES = 256 * 128 * 2;
constexpr size_t WS_SCTX = 254 * MiB;
#define RKSWZ(row, colB) ((row) * 256 + ((colB) ^ (((row) & 7) << 4)))
__device__ __forceinline__ bf16_t* slot(const Params& p, int dir, int q, int head) {
    return q >= 2 ? (bf16_t*)((unsigned char*)p.out + (((size_t)dir * (NQ - 2) + (q - 2)) * 4 + head) * SLOT_BYTES)
                  : (bf16_t*)(p.ws + WS_SCTX + (((size_t)dir * 2 + q) * 4 + head) * SLOT_BYTES);
}
__device__ __forceinline__ float log2_sigmoid(float x) { return -1.4426950408889634f * (fmaxf(-x, 0.f) + log1pf(expf(-fabsf(x)))); }
__device__ __forceinline__ bf16x8 scale8(bf16x8 v, float s) {
    u32x4 w = __builtin_bit_cast(u32x4, v), o;
#pragma unroll
    for (int i = 0; i < 4; ++i) o[i] = attn::cvtpk(__uint_as_float(w[i] << 16) * s, __uint_as_float(w[i] & 0xffff0000u) * s);
    return __builtin_bit_cast(bf16x8, o);
}
__device__ __forceinline__ void pk4(const f32x16& P, int base, bf16x8& out) {
    const unsigned a0 = attn::cvtpk(P[base + 0], P[base + 1]), a1 = attn::cvtpk(P[base + 2], P[base + 3]);
    const unsigned b0 = attn::cvtpk(P[base + 4], P[base + 5]), b1 = attn::cvtpk(P[base + 6], P[base + 7]);
    auto r0 = __builtin_amdgcn_permlane32_swap(a0, b0, false, false); auto r1 = __builtin_amdgcn_permlane32_swap(a1, b1, false, false);
    u32x4 w = {r0[0], r1[0], r0[1], r1[1]}; out = __builtin_bit_cast(bf16x8, w);
}
#define RPK(L, H) (bf16x8){L[0], L[1], L[2], L[3], H[0], H[1], H[2], H[3]}

__device__ __forceinline__ void summaries_unit(const Params& p, int q, int h, char* lds) {
    int tid_ = threadIdx.x; asm volatile("" : "+v"(tid_));
    const int tid = tid_, lane = tid & 63, wave = __builtin_amdgcn_readfirstlane(tid >> 6), r32 = lane & 31, hi = lane >> 5;
    const bf16_t* P = ws_big(p) + (size_t)q * 128 * P0W;
    const float lgf = log2_sigmoid(p.dec_f[h]), lgb = log2_sigmoid(p.dec_b[h]);
    const int sr = tid >> 4, sc = (tid & 15) * 8, st0 = attn::v_st(sr, sc), st1 = attn::v_st(32 + sr, sc);
#pragma unroll
    for (int th = 0; th < 2; ++th) {
        const int t0 = th * 64 + sr, t1 = t0 + 32;
        const bf16_t* r0 = P + (size_t)t0 * P0W; const bf16_t* r1 = P + (size_t)t1 * P0W;
#pragma unroll
        for (int eh = 0; eh < 2; ++eh) { char* vt = lds + (th * 2 + eh) * 16384;
            *(bf16x8*)(vt + st0) = *(const bf16x8*)(r0 + C_VA + h * 256 + eh * 128 + sc); *(bf16x8*)(vt + st1) = *(const bf16x8*)(r1 + C_VA + h * 256 + eh * 128 + sc); }
        const bf16x8 k0 = *(const bf16x8*)(r0 + C_KA + h * 128 + sc), k1 = *(const bf16x8*)(r1 + C_KA + h * 128 + sc);
        char* kf = lds + 65536 + th * 16384; char* kb = lds + 98304 + th * 16384;
        *(bf16x8*)(kf + st0) = scale8(k0, __builtin_amdgcn_exp2f((float)(127 - t0) * lgf)); *(bf16x8*)(kf + st1) = scale8(k1, __builtin_amdgcn_exp2f((float)(127 - t1) * lgf));
        *(bf16x8*)(kb + st0) = scale8(k0, __builtin_amdgcn_exp2f((float)t0 * lgb)); *(bf16x8*)(kb + st1) = scale8(k1, __builtin_amdgcn_exp2f((float)t1 * lgb));
    }
    __syncthreads();
    const int lbase = (int)(uintptr_t)lds + attn::v_rd_base(lane);
    f32x16 acc[2][4];
#pragma unroll
    for (int d = 0; d < 2; ++d)
#pragma unroll
        for (int b = 0; b < 4; ++b) acc[d][b] = f32x16{};
#pragma unroll
    for (int th = 0; th < 2; ++th) {
        const int va = lbase + (th * 2 + (wave >> 2)) * 16384 + (wave & 3) * 512, kfb = lbase + 65536 + th * 16384, kbb = lbase + 98304 + th * 16384;
#define R1_STEP(KS) do { \
        const s16x4 al = attn::tr_read<attn::v_rd_off(0, KS, 0)>(va), ah = attn::tr_read<attn::v_rd_off(0, KS, 1)>(va); \
        const s16x4 f0l = attn::tr_read<attn::v_rd_off(0, KS, 0)>(kfb), f0h = attn::tr_read<attn::v_rd_off(0, KS, 1)>(kfb), f1l = attn::tr_read<attn::v_rd_off(1, KS, 0)>(kfb), f1h = attn::tr_read<attn::v_rd_off(1, KS, 1)>(kfb); \
        const s16x4 f2l = attn::tr_read<attn::v_rd_off(2, KS, 0)>(kfb), f2h = attn::tr_read<attn::v_rd_off(2, KS, 1)>(kfb), f3l = attn::tr_read<attn::v_rd_off(3, KS, 0)>(kfb), f3h = attn::tr_read<attn::v_rd_off(3, KS, 1)>(kfb); \
        const s16x4 g0l = attn::tr_read<attn::v_rd_off(0, KS, 0)>(kbb), g0h = attn::tr_read<attn::v_rd_off(0, KS, 1)>(kbb), g1l = attn::tr_read<attn::v_rd_off(1, KS, 0)>(kbb), g1h = attn::tr_read<attn::v_rd_off(1, KS, 1)>(kbb); \
        const s16x4 g2l = attn::tr_read<attn::v_rd_off(2, KS, 0)>(kbb), g2h = attn::tr_read<attn::v_rd_off(2, KS, 1)>(kbb), g3l = attn::tr_read<attn::v_rd_off(3, KS, 0)>(kbb), g3h = attn::tr_read<attn::v_rd_off(3, KS, 1)>(kbb); \
        asm volatile("s_waitcnt lgkmcnt(0)" ::: "memory"); __builtin_amdgcn_sched_barrier(0); \
        const bf16x8 a = RPK(al, ah); \
        acc[0][0] = __builtin_amdgcn_mfma_f32_32x32x16_bf16(a, RPK(f0l, f0h), acc[0][0], 0, 0, 0); acc[0][1] = __builtin_amdgcn_mfma_f32_32x32x16_bf16(a, RPK(f1l, f1h), acc[0][1], 0, 0, 0); \
        acc[0][2] = __builtin_amdgcn_mfma_f32_32x32x16_bf16(a, RPK(f2l, f2h), acc[0][2], 0, 0, 0); acc[0][3] = __builtin_amdgcn_mfma_f32_32x32x16_bf16(a, RPK(f3l, f3h), acc[0][3], 0, 0, 0); \
        acc[1][0] = __builtin_amdgcn_mfma_f32_32x32x16_bf16(a, RPK(g0l, g0h), acc[1][0], 0, 0, 0); acc[1][1] = __builtin_amdgcn_mfma_f32_32x32x16_bf16(a, RPK(g1l, g1h), acc[1][1], 0, 0, 0); \
        acc[1][2] = __builtin_amdgcn_mfma_f32_32x32x16_bf16(a, RPK(g2l, g2h), acc[1][2], 0, 0, 0); acc[1][3] = __builtin_amdgcn_mfma_f32_32x32x16_bf16(a, RPK(g3l, g3h), acc[1][3], 0, 0, 0); \
        __builtin_amdgcn_sched_barrier(0); } while (0)
        R1_STEP(0); R1_STEP(1); R1_STEP(2); R1_STEP(3);
#undef R1_STEP
    }
#pragma unroll
    for (int d = 0; d < 2; ++d) { bf16_t* dst = slot(p, d, q, h);
#pragma unroll
        for (int db = 0; db < 4; ++db)
#pragma unroll
            for (int r = 0; r < 16; ++r) dst[(size_t)(32 * wave + attn::crow(r, hi)) * 128 + 32 * db + r32] = (bf16_t)(attn::cvtpk(acc[d][db][r], 0.f) & 0xffffu); }
    __syncthreads();
}

__device__ __forceinline__ void state_scan(const Params& p) {
    int tid_ = threadIdx.x; asm volatile("" : "+v"(tid_));
    for (long gt = (long)blockIdx.x * NTHR + tid_; gt < 2L * 4 * 16384; gt += (long)gridDim.x * NTHR) {
    const int pair = (int)(gt & 16383), h = (int)((gt >> 14) & 3), dir = (int)(gt >> 16);
    const float G = __builtin_amdgcn_exp2f(128.0f * log2_sigmoid((dir ? p.dec_b : p.dec_f)[h]));
    float s0 = 0.f, s1 = 0.f;
    static_assert(NQ % 10 == 0, "the scan is unrolled by ten chunks");
    for (int n0 = 0; n0 < NQ; n0 += 10) {
        unsigned* ptr[10]; unsigned u[10];
#pragma unroll
        for (int k = 0; k < 10; ++k) { const int n = n0 + k, q = dir == 0 ? n : (n < 2 ? 1 - n : NQ + 1 - n);
            ptr[k] = (unsigned*)slot(p, dir, q, h) + pair; u[k] = *ptr[k]; }
#pragma unroll
        for (int k = 0; k < 10; ++k) { *ptr[k] = attn::cvtpk(s0, s1);
            s0 = G * s0 + __uint_as_float(u[k] << 16); s1 = G * s1 + __uint_as_float(u[k] & 0xffff0000u); }
    }    }
}

__device__ __forceinline__ void output_unit(const Params& p, int q, int h, char* lds) {
    int tid_ = threadIdx.x; asm volatile("" : "+v"(tid_));
    const int tid = tid_, lane = tid & 63, wave = __builtin_amdgcn_readfirstlane(tid >> 6), r32 = lane & 31, hi = lane >> 5;
    const int ib = wave >> 1, eh = wave & 1;
    const bf16_t* P = ws_big(p) + (size_t)q * 128 * P0W;
    const float lgf = log2_sigmoid(p.dec_f[h]), lgb = log2_sigmoid(p.dec_b[h]);
    const int sr = tid >> 4, sc = (tid & 15) * 8, st0 = attn::v_st(sr, sc), st1 = attn::v_st(32 + sr, sc);
    bf16x8 qr[8];
    { const bf16_t* Qw = P + (size_t)(ib * 32 + r32) * P0W + C_QA + h * 128 + hi * 8;
#pragma unroll
      for (int d0 = 0; d0 < 8; ++d0) qr[d0] = *(const bf16x8*)(Qw + d0 * 16); }
    { const bf16_t* Sf = slot(p, 0, q, h); const bf16_t* Sb = slot(p, 1, q, h);
      bf16x8 sv[16];
#pragma unroll
      for (int k = 0; k < 8; ++k) { const int i = tid + 512 * k; sv[k] = *(const bf16x8*)(Sf + (size_t)i * 8); sv[8 + k] = *(const bf16x8*)(Sb + (size_t)i * 8); }
#pragma unroll
      for (int k = 0; k < 8; ++k) { const int i = tid + 512 * k, e = i >> 4, cb = (i & 15) * 16;
          *(bf16x8*)(lds + RKSWZ(e, cb)) = sv[k]; *(bf16x8*)(lds + 65536 + RKSWZ(e, cb)) = sv[8 + k]; } }
    __syncthreads();
    bf16x8 kvr[12];
    f32x16 o[4] = {};
    const int i_loc = ib * 32 + r32;
    { const float scf = __builtin_amdgcn_exp2f((float)(i_loc + 1) * lgf), scb = __builtin_amdgcn_exp2f((float)(128 - i_loc) * lgb);
#pragma unroll
      for (int dir = 0; dir < 2; ++dir) {
          const char* Sl = lds + dir * 65536;
          if (dir == 1) {
#pragma unroll
    for (int jt = 0; jt < 2; ++jt) {
        const bf16_t* r0 = P + (size_t)(jt * 64 + sr) * P0W; const bf16_t* r1 = r0 + (size_t)32 * P0W;
        kvr[jt * 6 + 0] = *(const bf16x8*)(r0 + C_KA + h * 128 + sc); kvr[jt * 6 + 1] = *(const bf16x8*)(r1 + C_KA + h * 128 + sc);
#pragma unroll
        for (int e2 = 0; e2 < 2; ++e2) { kvr[jt * 6 + 2 + e2 * 2] = *(const bf16x8*)(r0 + C_VA + h * 256 + e2 * 128 + sc); kvr[jt * 6 + 3 + e2 * 2] = *(const bf16x8*)(r1 + C_VA + h * 256 + e2 * 128 + sc); }
    }
          }
#pragma unroll
          for (int ks = 0; ks < 8; ++ks) { const bf16x8 a = scale8(qr[ks], dir ? scb : scf); const int cb = (ks * 16 + hi * 8) * 2;
              bf16x8 f[4];
#pragma unroll
              for (int d0 = 0; d0 < 4; ++d0) f[d0] = *(const bf16x8*)(Sl + RKSWZ(eh * 128 + d0 * 32 + r32, cb));
#pragma unroll
              for (int d0 = 0; d0 < 4; ++d0) o[d0] = __builtin_amdgcn_mfma_f32_32x32x16_bf16(a, f[d0], o[d0], 0, 0, 0); } } }
    __syncthreads();
#pragma unroll
    for (int jt = 0; jt < 2; ++jt) { char* kt = lds + jt * 16384;
        *(bf16x8*)(kt + RKSWZ(sr, sc * 2)) = kvr[jt * 6 + 0]; *(bf16x8*)(kt + RKSWZ(32 + sr, sc * 2)) = kvr[jt * 6 + 1];
#pragma unroll
        for (int e2 = 0; e2 < 2; ++e2) { char* vt = lds + 32768 + (jt * 2 + e2) * 16384; *(bf16x8*)(vt + st0) = kvr[jt * 6 + 2 + e2 * 2]; *(bf16x8*)(vt + st1) = kvr[jt * 6 + 3 + e2 * 2]; } }
    __syncthreads();
    const int vb0 = (int)(uintptr_t)lds + 32768 + attn::v_rd_base(lane);
#pragma unroll
    for (int jt = 0; jt < 2; ++jt) {
        f32x16 p0, p1;
        attn::qkt(p0, p1, (const attn::bf16*)(lds + jt * 16384), qr, r32, hi);
#pragma unroll
        for (int r = 0; r < 16; ++r) {
            const int j0 = jt * 64 + attn::crow(r, hi), dl0 = i_loc - j0, dl1 = dl0 - 32;
            const float m0 = dl0 > 0 ? __builtin_amdgcn_exp2f((float)dl0 * lgf) : (dl0 < 0 ? __builtin_amdgcn_exp2f((float)(-dl0) * lgb) : 2.0f);
            const float m1 = dl1 > 0 ? __builtin_amdgcn_exp2f((float)dl1 * lgf) : (dl1 < 0 ? __builtin_amdgcn_exp2f((float)(-dl1) * lgb) : 2.0f);
            p0[r] *= m0; p1[r] *= m1;
        }
        bf16x8 pa0, pa1, pa2, pa3; pk4(p0, 0, pa0); pk4(p0, 8, pa1); pk4(p1, 0, pa2); pk4(p1, 8, pa3);
        __builtin_amdgcn_sched_barrier(0);
        attn::pv_d0(o, vb0 + (jt * 2 + eh) * 16384, pa0, pa1, pa2, pa3);
    }
    __syncthreads();
    float* O = (float*)lds;
#pragma unroll
    for (int r = 0; r < 16; ++r)
#pragma unroll
        for (int d0 = 0; d0 < 4; ++d0) O[(ib * 32 + attn::crow(r, hi)) * 256 + eh * 128 + d0 * 32 + r32] = o[d0][r];
    __syncthreads();
    bf16_t* BR = ws_br(p) + (size_t)q * 128 * 2048 + h * 256;
#pragma unroll 4
    for (int rr = 0; rr < 16; ++rr) {
        const int row = wave * 16 + rr; const f32x4 x = *(const f32x4*)(O + row * 256 + lane * 4);
        const float mean = rw::wave_sum((x[0] + x[1]) + (x[2] + x[3])) * (1.0f / 256.f);
        const f32x4 d = x - mean;
        const float var = rw::wave_sum((d[0] * d[0] + d[1] * d[1]) + (d[2] * d[2] + d[3] * d[3])) * (1.0f / 256.f);
        const float rstd = 1.0f / sqrtf(var + NORM_EPS);
        f32x4 y = d * rstd;
        if (q < 2) { const u32x2 gg = *(const u32x2*)((const bf16_t*)(p.ws + 255 * MiB) + (size_t)(q * 128 + row) * 2048 + h * 256 + lane * 4);
            y[0] *= __uint_as_float(gg.x << 16); y[1] *= __uint_as_float(gg.x & 0xffff0000u); y[2] *= __uint_as_float(gg.y << 16); y[3] *= __uint_as_float(gg.y & 0xffff0000u); }
        u32x2 w; w.x = attn::cvtpk(y[0], y[1]); w.y = attn::cvtpk(y[2], y[3]);
        *(u32x2*)(BR + (size_t)row * 2048 + lane * 4) = w;
    }
    __syncthreads();
}
#undef RPK
#undef RKSWZ
}

namespace na {
using attn::bf16x8; using attn::f32x16; using attn::u32x4;
constexpr float L2E = 1.4426950408889634f;
constexpr int WH = GROWS < 8 ? GROWS : 8;
constexpr int L_K = 0, L_V = 32768, L_WS = 65536, L_RPB = L_WS + NWAVES * 64 * 4, L_END = L_RPB + 15 * 31 * 4;
#define NKSWZ(row, colB) ((row) * 256 + ((colB) ^ (((row) & 7) << 4)))
__device__ __forceinline__ int win_r0(int r) { int r0 = r - WH / 2; return r0 < 0 ? 0 : (r0 > GROWS - WH ? GROWS - WH : r0); }
__device__ __forceinline__ int win_c0(int c) { int c0 = c - 8; return c0 < 0 ? 0 : (c0 > GW - 16 ? GW - 16 : c0); }

__device__ __forceinline__ void na_unit(const Params& p, int rg, int h, char* lds) {
    int tid_ = threadIdx.x; asm volatile("" : "+v"(tid_));
    const int tid = tid_, lane = tid & 63, wave = __builtin_amdgcn_readfirstlane(tid >> 6), r32 = lane & 31, hi = lane >> 5;
    const bf16_t* P = ws_big(p); const bf16_t* NAC = (const bf16_t*)(p.ws + 255 * MiB);
    const int r = 4 * rg + (wave >> 1), qc = (wave & 1) * 32 + r32, my_r0 = win_r0(r), my_c0 = win_c0(qc);
    const int lo = win_r0(4 * rg), hiw = win_r0(4 * rg + 3) + WH, NT = hiw - lo + CTXN / 64;
    float* wsf = (float*)(lds + L_WS) + wave * 64; float* rpb_l = (float*)(lds + L_RPB);
    if (tid < 15 * 31) rpb_l[tid] = p.rpb[h * 15 * 31 + tid];
    bf16x8 qr[4];
    { const bf16_t* Qw = P + (size_t)(CTXN + r * 64 + qc) * NAW + h * 64 + hi * 8;
#pragma unroll
      for (int d0 = 0; d0 < 4; ++d0) { u32x4 w = *(const u32x4*)(Qw + d0 * 16);
        for (int i = 0; i < 4; ++i) w[i] = attn::cvtpk(__uint_as_float(w[i] << 16) * 0.125f, __uint_as_float(w[i] & 0xffff0000u) * 0.125f);
        qr[d0] = *reinterpret_cast<bf16x8*>(&w); } }
    const int sk = tid >> 3, sc = (tid & 7) * 8, kst = NKSWZ(sk, sc * 2), vst = attn::v_st(sk, sc);
    bf16x8 kA, vA, kB, vB;
#define NA_LOAD(KR, VR, t) do { if ((t) < hiw - lo) { const int krow_ = CTXN + (lo + (t)) * 64 + sk; \
            KR = *(const bf16x8*)(P + (size_t)krow_ * NAW + 1024 + h * 64 + sc); VR = *(const bf16x8*)(P + (size_t)krow_ * NAW + 2048 + h * 64 + sc); } \
        else { const bf16_t* c_ = NAC + (size_t)(((t) - (hiw - lo)) * 64 + sk) * 2048 + h * 64 + sc; KR = *(const bf16x8*)c_; VR = *(const bf16x8*)(c_ + 1024); } } while (0)
#define NA_WRITE(KR, VR, b) do { *(bf16x8*)(lds + L_K + (b) * 16384 + kst) = KR; *(bf16x8*)(lds + L_V + (b) * 16384 + vst) = VR; } while (0)
    NA_LOAD(kA, vA, 0); NA_WRITE(kA, vA, 0);
    NA_LOAD(kB, vB, 1);
    __syncthreads();
    float m_reg = -1e30f, l_reg = 0.f; f32x16 o[2] = {};
    const int dl = 4 * hi - my_c0;
    const int vb0 = (int)(uintptr_t)lds + L_V + attn::v_rd_base(lane);
#define NA_TILE(t, KW, VW, KL, VL) do { \
        if ((t) + 2 < NT) NA_LOAD(KL, VL, (t) + 2);            \
        const bool is_ctx = (t) >= hiw - lo; const int kr = lo + (t); \
        if (is_ctx || (kr >= my_r0 && kr < my_r0 + WH)) { \
            const char* Ks = lds + L_K + ((t) & 1) * 16384; \
            f32x16 p0 = {}, p1 = {}; \
            _Pragma("unroll") for (int d0 = 0; d0 < 4; ++d0) { const int cb = (d0 * 16 + hi * 8) * 2; \
                const bf16x8 b0 = *(const bf16x8*)(Ks + NKSWZ(r32, cb)), b1 = *(const bf16x8*)(Ks + NKSWZ(32 + r32, cb)); \
                p0 = __builtin_amdgcn_mfma_f32_32x32x16_bf16(b0, qr[d0], p0, 0, 0, 0); p1 = __builtin_amdgcn_mfma_f32_32x32x16_bf16(b1, qr[d0], p1, 0, 0, 0); } \
            if (!is_ctx) {     \
                const float* bb = rpb_l + (kr - r + 7) * 31 + 15 - qc + 4 * hi; float bz0[16], bz1[16]; \
                _Pragma("unroll") for (int q = 0; q < 16; ++q) { const int cq = (q & 3) + 8 * (q >> 2); bz0[q] = bb[cq]; bz1[q] = bb[cq + 32]; } \
                _Pragma("unroll") for (int q = 0; q < 16; ++q) { const int cq = (q & 3) + 8 * (q >> 2); \
                    p0[q] = (unsigned)(cq + dl) < 16u ? p0[q] + bz0[q] : -1e30f; p1[q] = (unsigned)(cq + 32 + dl) < 16u ? p1[q] + bz1[q] : -1e30f; } \
            } \
            float pmax = p0[0]; \
            _Pragma("unroll") for (int q = 1; q < 16; ++q) pmax = fmaxf(pmax, p0[q]); \
            _Pragma("unroll") for (int q = 0; q < 16; ++q) pmax = fmaxf(pmax, p1[q]); \
            { auto rr = __builtin_amdgcn_permlane32_swap(__float_as_uint(pmax), __float_as_uint(pmax), false, false); pmax = fmaxf(__uint_as_float(rr[0]), __uint_as_float(rr[1])); } \
            const float mn = fmaxf(m_reg, pmax), alpha = __builtin_amdgcn_exp2f((m_reg - mn) * L2E), mnl = -mn * L2E; m_reg = mn; \
            float ps = 0.f; \
            _Pragma("unroll") for (int q = 0; q < 16; ++q) { p0[q] = __builtin_amdgcn_exp2f(fmaf(p0[q], L2E, mnl)); p1[q] = __builtin_amdgcn_exp2f(fmaf(p1[q], L2E, mnl)); ps += p0[q] + p1[q]; } \
            { auto rr = __builtin_amdgcn_permlane32_swap(__float_as_uint(ps), __float_as_uint(ps), false, false); ps = __uint_as_float(rr[0]) + __uint_as_float(rr[1]); } \
            l_reg = l_reg * alpha + ps; \
            if (__any(alpha < 1.f)) { if (hi == 0) wsf[r32] = alpha; asm volatile("s_waitcnt lgkmcnt(0)" ::: "memory"); \
                _Pragma("unroll") for (int d = 0; d < 2; ++d) _Pragma("unroll") for (int q = 0; q < 16; ++q) o[d][q] *= wsf[attn::crow(q, hi)]; } \
            bf16x8 pa0, pa1, pa2, pa3; ret::pk4(p0, 0, pa0); ret::pk4(p0, 8, pa1); ret::pk4(p1, 0, pa2); ret::pk4(p1, 8, pa3); \
            __builtin_amdgcn_sched_barrier(0); \
            const int vb = vb0 + ((t) & 1) * 16384; \
            attn::pv_one<0>(o[0], vb, pa0, pa1, pa2, pa3); attn::pv_one<1>(o[1], vb, pa0, pa1, pa2, pa3); \
        } \
        if ((t) + 1 < NT) NA_WRITE(KW, VW, ((t) + 1) & 1);     \
        __syncthreads(); } while (0)
    for (int t = 0; t < NT; t += 2) {
        NA_TILE(t, kB, vB, kA, vA);
        if (t + 1 < NT) NA_TILE(t + 1, kA, vA, kB, vB);
    }
#undef NA_TILE
#undef NA_LOAD
#undef NA_WRITE
    if (hi == 0) wsf[32 + r32] = l_reg; asm volatile("s_waitcnt lgkmcnt(0)" ::: "memory");
    bf16_t* Ow = ws_br(p) + (size_t)(CTXN + r * 64 + (wave & 1) * 32) * 2048 + h * 64;
#pragma unroll
    for (int q = 0; q < 16; ++q) { const int orow = attn::crow(q, hi); const float rl = __builtin_amdgcn_rcpf(wsf[32 + orow]);
#pragma unroll
        for (int d0 = 0; d0 < 2; ++d0) Ow[(size_t)orow * 2048 + d0 * 32 + r32] = (bf16_t)(attn::cvtpk(o[d0][q] * rl, 0.f) & 0xffffu); }
    __syncthreads();
}
#undef NKSWZ
}

namespace el {
typedef float f32x4 __attribute__((ext_vector_type(4)));
typedef unsigned u32x2 __attribute__((ext_vector_type(2)));
__device__ __forceinline__ float wsum(float v) { return rw::wave_sum(v); }
__device__ __forceinline__ unsigned pk(float lo, float hi) { unsigned r; asm volatile("v_cvt_pk_bf16_f32 %0, %1, %2" : "=v"(r) : "v"(lo), "v"(hi)); return r; }

__device__ __forceinline__ void mod_phase(const Params& p, char* lds) {
    int tid_ = threadIdx.x; asm volatile("" : "+v"(tid_));
    const int tid = tid_, ks = tid >> 6, jl = tid & 63;
    float* sc = (float*)lds; float* red = sc + 2048;
    for (int b = blockIdx.x; b < 2 * 48; b += gridDim.x) {
        const int l = b / 48, j = (b % 48) * 64 + jl;
        __syncthreads();
        for (int k = tid; k < 2048; k += NTHR) { const float x = k < 1024 ? p.c[k] : p.c_ctx[k - 1024]; sc[k] = x / (1.0f + __expf(-x)); }
        __syncthreads();
        const float* w = p.w_mod + (size_t)l * DM * 3072 + (size_t)(ks * 128) * 3072 + j; float a0 = 0.f, a1 = 0.f;
#pragma unroll 8
        for (int k = 0; k < 128; ++k) { const float wv = w[(size_t)k * 3072]; a0 += sc[ks * 128 + k] * wv; a1 += sc[1024 + ks * 128 + k] * wv; }
        red[ks * 64 + jl] = a0; red[512 + ks * 64 + jl] = a1;
        __syncthreads();
        if (tid < 128) { const int s = tid >> 6; float t = 0.f;
#pragma unroll
            for (int q = 0; q < 8; ++q) t += red[s * 512 + q * 64 + jl];
            ws_modv(p)[(l * 2 + s) * 3072 + j] = t + p.b_mod[l * 3072 + j]; }
    }
    __syncthreads();
}

template <int LAYER> __device__ __forceinline__ void modnorm_store(const Params& p, const f32x4 (&v)[4], int row, int lane) {
    const float* mv = ws_modv(p) + (LAYER * 2 + (row < CTXN ? 1 : 0)) * 3072; const float* g = p.g_pre + LAYER * DM;
    float ss = 0.f;
#pragma unroll
    for (int j = 0; j < 4; ++j) ss += (v[j][0] * v[j][0] + v[j][1] * v[j][1]) + (v[j][2] * v[j][2] + v[j][3] * v[j][3]);
    const float rstd = 1.0f / sqrtf(wsum(ss) * (1.0f / DM) + NORM_EPS);
    bf16_t* o = ws_xn(p) + (size_t)row * DM;
    f32x4 gg[4], sh[4], sc[4];
#pragma unroll
    for (int j = 0; j < 4; ++j) { const int c = lane * 4 + 256 * j; gg[j] = *(const f32x4*)(g + c); sh[j] = *(const f32x4*)(mv + c); sc[j] = *(const f32x4*)(mv + 1024 + c); }
#pragma unroll
    for (int j = 0; j < 4; ++j) { const int c = lane * 4 + 256 * j;
        const f32x4 y = v[j] * rstd * gg[j] * (sc[j] + 1.0f) + sh[j];
        u32x2 w; w.x = pk(y[0], y[1]); w.y = pk(y[2], y[3]); *(u32x2*)(o + c) = w; }
}
__device__ __forceinline__ void prenorm0_phase(const Params& p) {
    int tid_ = threadIdx.x; asm volatile("" : "+v"(tid_));
    const int lane = tid_ & 63, gw = (int)blockIdx.x * NWAVES + (tid_ >> 6), ngw = (int)gridDim.x * NWAVES;
    for (int row = gw; row < R; row += ngw) {
        const float* src = row < CTXN ? p.ctx + (size_t)row * DM : p.x + (size_t)(row - CTXN) * DM;
        f32x4 v[4];
#pragma unroll
        for (int j = 0; j < 4; ++j) v[j] = *(const f32x4*)(src + lane * 4 + 256 * j);
        modnorm_store<0>(p, v, row, lane);
    }
}
template <int LAYER> __device__ __forceinline__ void resid_phase(const Params& p) {
    int tid_ = threadIdx.x; asm volatile("" : "+v"(tid_));
    const int lane = tid_ & 63, gw = (int)blockIdx.x * NWAVES + (tid_ >> 6), ngw = (int)gridDim.x * NWAVES;
    for (int row = (LAYER == 0 ? 0 : CTXN) + gw; row < R; row += ngw) {
        const bool ctxsum = LAYER == 0 && row < CTXN;
        const float* y = ctxsum ? (const float*)(p.ws + WS_BIG + 72 * MiB) + (size_t)row * DM : ws_y(p) + (size_t)row * DM; const float* mv = ws_modv(p) + (LAYER * 2 + (row < CTXN ? 1 : 0)) * 3072 + 2048; const float* g = p.g_post + LAYER * DM;
        const float* src; float* dst;
        if (row < CTXN) { src = p.ctx + (size_t)row * DM; dst = ws_ctx1(p) + (size_t)row * DM; }
        else { src = (LAYER == 0 ? p.x : p.out) + (size_t)(row - CTXN) * DM; dst = p.out + (size_t)(row - CTXN) * DM; }
        f32x4 yv[4]; float ss = 0.f;
#pragma unroll
        for (int j = 0; j < 4; ++j) { yv[j] = *(const f32x4*)(y + lane * 4 + 256 * j);
            if (ctxsum) { _Pragma("unroll") for (int s = 1; s < 8; ++s) yv[j] += *(const f32x4*)(y + (size_t)s * CTXN * DM + lane * 4 + 256 * j); }
            ss += (yv[j][0] * yv[j][0] + yv[j][1] * yv[j][1]) + (yv[j][2] * yv[j][2] + yv[j][3] * yv[j][3]); }
        const float rstd = 1.0f / sqrtf(wsum(ss) * (1.0f / DM) + NORM_EPS);
        f32x4 xn[4], sv[4], mvv[4], gv[4];
#pragma unroll
        for (int j = 0; j < 4; ++j) { const int c = lane * 4 + 256 * j; sv[j] = *(const f32x4*)(src + c); mvv[j] = *(const f32x4*)(mv + c); gv[j] = *(const f32x4*)(g + c); }
#pragma unroll
        for (int j = 0; j < 4; ++j) { const int c = lane * 4 + 256 * j;
            xn[j] = sv[j] + mvv[j] * (yv[j] * rstd * gv[j]);
            *(f32x4*)(dst + c) = xn[j]; }
        if (LAYER == 0) modnorm_store<1>(p, xn, row, lane);
    }
}
__device__ __forceinline__ void ropenorm_phase(const Params& p) {
    int tid_ = threadIdx.x; asm volatile("" : "+v"(tid_));
    const int lane = tid_ & 63, gw = (int)blockIdx.x * NWAVES + (tid_ >> 6), ngw = (int)gridDim.x * NWAVES;
    const float* ct = ws_rope(p); const float* st = ct + N_ROPE;
    const float qn0 = p.q_norm[2 * lane], qn1 = p.q_norm[2 * lane + 1], kn0 = p.k_norm[2 * lane], kn1 = p.k_norm[2 * lane + 1];
    for (int row = gw; row < R; row += ngw) {
        const bool rot = row >= CTXN; const int t = row - CTXN; float cs = 1.f, sn = 0.f;
        if (rot) { const int pos = lane < 32 ? t / GW : t % GW, f = lane & 31; cs = ct[pos * 32 + f]; sn = st[pos * 32 + f]; }
        bf16_t* base = ws_big(p) + (size_t)row * P0W;
        unsigned u[18];
#pragma unroll
        for (int slot = 0; slot < 18; ++slot) {
            const int col = slot < 4 ? C_QA + slot * 128 : slot < 8 ? C_KA + (slot - 4) * 128 : slot < 16 ? C_QB + (slot - 8) * 128 : C_KB + (slot - 16) * 128;
            u[slot] = *((const unsigned*)(base + col) + lane); }
#pragma unroll
        for (int slot = 0; slot < 18; ++slot) {
            const int col = slot < 4 ? C_QA + slot * 128 : slot < 8 ? C_KA + (slot - 4) * 128 : slot < 16 ? C_QB + (slot - 8) * 128 : C_KB + (slot - 16) * 128;
            unsigned* ptr = (unsigned*)(base + col) + lane;
            float x1 = __uint_as_float(u[slot] << 16), x2 = __uint_as_float(u[slot] & 0xffff0000u);
            if (slot >= 4 && slot < 8) { x1 *= 0.08838834764831845f; x2 *= 0.08838834764831845f; }
            if (slot >= 8) { const float sc = 1.0f / sqrtf(wsum(x1 * x1 + x2 * x2) * (1.0f / 128.f) + NORM_EPS);
                x1 *= sc * (slot < 16 ? qn0 : kn0); x2 *= sc * (slot < 16 ? qn1 : kn1); }
            *ptr = pk(x1 * cs - x2 * sn, x1 * sn + x2 * cs);
        }
    }
}
}

constexpr int RING_BYTES = 131072, LDS_BYTES = 163840;
constexpr size_t WS_BAR = 256 * 1024;
constexpr size_t WS_SIDE = 255 * MiB;
constexpr size_t WS_YC = WS_BIG + 72 * MiB;
constexpr int LDS_BARW = LDS_BYTES - 64;
constexpr size_t WB_IN0 = WS_WB, WB_OUT0 = WB_IN0 + (size_t)EVEN_IN * DM * 2, WB_IN1 = WB_OUT0 + (size_t)DM * 2048 * 2, WB_OUT1 = WB_IN1 + (size_t)ODD_IN * DM * 2, WB_END = WB_OUT1 + (size_t)DM * 2048 * 2;
static_assert(WB_END <= WS_XN, "weight copies overflow their region");
static_assert(wy::WS_RING + wy::RING_TOTAL <= WB_IN1 && XCD_BAR_WORDS * 4 <= 16384 && wy::WS_WYF + (size_t)wy::WYF_WORDS * 4 <= WS_CTX1, "rwkv ring / flag words");

__device__ __forceinline__ unsigned pk2(float lo, float hi) { return (unsigned)f2bf(lo) | ((unsigned)f2bf(hi) << 16); }
__device__ __forceinline__ void transpose_item(const float* W, int K, int N, int ldw, bf16_t* WT, LAS float* scr, int item, int lane) {
    const int nblk = N / 32, kb = item / nblk, nb = item % nblk, k0 = 64 * kb, n0 = 32 * nb;
#pragma unroll 8
    for (int i = 0; i < 32; ++i) { const int kk = 2 * i + (lane >> 5); scr[kk * 33 + (lane & 31)] = W[(size_t)(k0 + kk) * ldw + n0 + (lane & 31)]; }
    asm volatile("s_waitcnt lgkmcnt(0)" ::: "memory");
    const int c = lane & 7;
#pragma unroll
    for (int j = 0; j < 4; ++j) { const int n = (lane >> 3) + 8 * j; const LAS float* s = scr + (8 * c) * 33 + n;
        v4u o; o.x = pk2(s[0 * 33], s[1 * 33]); o.y = pk2(s[2 * 33], s[3 * 33]); o.z = pk2(s[4 * 33], s[5 * 33]); o.w = pk2(s[6 * 33], s[7 * 33]);
        *(v4u*)(WT + (size_t)(n0 + n) * K + k0 + 8 * c) = o; }
    asm volatile("s_waitcnt lgkmcnt(0)" ::: "memory");
}
__device__ __forceinline__ void p0_weights(const Params& p, LAS unsigned char* lds) {
    const int lane = threadIdx.x & 63, wave = __builtin_amdgcn_readfirstlane(threadIdx.x >> 6);
    LAS float* scr = (LAS float*)(lds + wave * 16384);
    const int gw = blockIdx.x * NWAVES + wave, NGW = gridDim.x * NWAVES;
    constexpr int I_IN0 = (DM / 64) * (EVEN_IN / 32), I_OUT = (2048 / 64) * (DM / 32), I_IN1 = (DM / 64) * (ODD_IN / 32);
    for (int it = gw; it < I_IN0 + I_OUT + I_IN1 + I_OUT; it += NGW) {
        int r = it;
        if (r < I_IN0) { transpose_item(p.ev_w_in, DM, EVEN_IN, EVEN_IN, (bf16_t*)(p.ws + WB_IN0), scr, r, lane); continue; } r -= I_IN0;
        if (r < I_OUT) { transpose_item(p.ev_w_out, 2048, DM, DM, (bf16_t*)(p.ws + WB_OUT0), scr, r, lane); continue; } r -= I_OUT;
        if (r < I_IN1) { transpose_item(p.od_w_in, DM, ODD_IN, ODD_IN, (bf16_t*)(p.ws + WB_IN1), scr, r, lane); continue; } r -= I_IN1;
        transpose_item(p.od_w_out, 2048, DM, DM, (bf16_t*)(p.ws + WB_OUT1), scr, r, lane);
    }
}

template <class Epi> __device__ __forceinline__ void run_gemm(LAS unsigned char* lds, const bf16_t* A, const bf16_t* Bt, int M, int N, int K, const Epi& E, int rot = 0, int lda = 0, int ldb = 0) {
    const int G = (int)gridDim.x;
    pg8::Gemm g{A, Bt, M, N, K, lda, ldb}; pg8::StaticOrder S; S.init(M, N, G, ((int)blockIdx.x + rot) % G);
    pg8::gemm_phase<Epi, pg8::StaticOrder, true, true>(lds, g, S, E);
}
__device__ __forceinline__ int tail_rot(int units) { const int G = (int)gridDim.x; return (G - units % G) % G; }

#ifndef PROBE
#define PROBE 0
#endif
#define REP(bit) for (int rep_ = 0; rep_ < (((PROBE) >> (bit)) & 1) + 1; ++rep_)
__global__ void __launch_bounds__(NTHR, 2) mega(Params p) {
    extern __shared__ __attribute__((aligned(16))) unsigned char lds_raw[];
    cg::grid_group grid = cg::this_grid();
    LAS unsigned char* lds = (LAS unsigned char*)lds_raw;
    const long gsz = (long)gridDim.x * NTHR;
    if (threadIdx.x < 2) *(LAS unsigned*)(lds + LDS_BARW + 4 * threadIdx.x) = 0u;
    __syncthreads();
    const XcdBarrier xbar = xcd_barrier_post((unsigned*)(p.ws + WS_BAR), (volatile LAS unsigned*)(lds + LDS_BARW));
    const bf16_t* wt_in0 = (const bf16_t*)(p.ws + WB_IN0); const bf16_t* wt_out0 = (const bf16_t*)(p.ws + WB_OUT0);
    const bf16_t* wt_in1 = (const bf16_t*)(p.ws + WB_IN1); const bf16_t* wt_out1 = (const bf16_t*)(p.ws + WB_OUT1);
#define X(fn, n) { int t_ = threadIdx.x; asm volatile("" : "+v"(t_)); for (long g = (long)blockIdx.x * NTHR + t_; g < (long)(n); g += gsz) fn(p, g); }
#define SYNC xcd_barrier(xbar);
    if ((PROBE >> 13) & 1) { for (int i_ = 0; i_ < 20; ++i_) xcd_barrier(xbar); }
    REP(14) { el::mod_phase(p, (char*)lds_raw); X(ph_rope_table, N_ROPE) p0_weights(p, lds);
              if (p.out == nullptr) grid.sync();
              SYNC }
    REP(15) { el::prenorm0_phase(p); SYNC }
    REP(2) { run_gemm(lds, ws_xn(p), wt_in0, R, P0W, DM, pg8::EpiBf16<0>{ws_big(p), P0W, nullptr, 0, 0, 1.f});
             run_gemm(lds, ws_xn(p), wt_in0 + (size_t)C_GA * DM, CTXN, 2048, DM, pg8::EpiSiluBf16{(bf16_t*)(p.ws + WS_SIDE), 2048}, tail_rot((R / 256) * (P0W / 256)));
             SYNC }
    el::ropenorm_phase(p); SYNC
    REP(5) { for (int u = blockIdx.x; u < ret::NQ * 4; u += gridDim.x) { const int q = u < (ret::NQ - 2) * 4 ? 2 + u / 4 : (u - (ret::NQ - 2) * 4) / 4; ret::summaries_unit(p, q, u & 3, (char*)lds_raw); } SYNC }
    ret::state_scan(p); SYNC
#define CTX_ATTN_UNIT(head_) do { const int hd_ = (head_), kv_ = hd_ / 4; const bf16_t* P_ = ws_big(p); bf16_t* BR_ = ws_br(p); \
        attn::attn_dense_body<attn::bf16, false>(P_ + C_QB + hd_ * 128, P_ + C_KB + kv_ * 128, P_ + C_VB + kv_ * 128, BR_ + 1024 + hd_ * 128, CTXN, (char*)lds_raw); \
        __syncthreads(); \
        {     \
            int t_ = threadIdx.x; asm volatile("" : "+v"(t_)); const bf16_t* GC = (const bf16_t*)(p.ws + WS_SIDE); \
            const size_t o = (size_t)(t_ >> 1) * 2048 + 1024 + hd_ * 128 + (t_ & 1) * 64; \
            _Pragma("unroll") for (int i_ = 0; i_ < 8; ++i_) { v4u a = *(const v4u*)(BR_ + o + 8 * i_); const v4u b = *(const v4u*)(GC + o + 8 * i_); \
                _Pragma("unroll") for (int q_ = 0; q_ < 4; ++q_) a[q_] = attn::cvtpk(__uint_as_float(a[q_] << 16) * __uint_as_float(b[q_] << 16), __uint_as_float(a[q_] & 0xffff0000u) * __uint_as_float(b[q_] & 0xffff0000u)); \
                *(v4u*)(BR_ + o + 8 * i_) = a; } \
            __syncthreads(); } } while (0)
    const bool ctx_attn_early = gridDim.x >= 16;
    REP(6) { for (int u = blockIdx.x; u < ret::NQ * 4; u += gridDim.x) { const int q = u < (ret::NQ - 2) * 4 ? 2 + u / 4 : (u - (ret::NQ - 2) * 4) / 4; ret::output_unit(p, q, u & 3, (char*)lds_raw); }
             if (ctx_attn_early && (int)blockIdx.x >= (int)gridDim.x - 8) CTX_ATTN_UNIT((int)blockIdx.x - ((int)gridDim.x - 8));
             SYNC }
    REP(0) {
        const int G = (int)gridDim.x, vcu = (G % 8 == 0) ? ((int)blockIdx.x % 8) * (G / 8) + (int)blockIdx.x / 8 : (int)blockIdx.x;
        const int NLAT = (SEQ / 256) * 8, per = (NLAT + G - 1) / G;
        const bf16_t* P = ws_big(p); bf16_t* BR = ws_br(p);
        bool nomax; { int t_ = threadIdx.x; asm volatile("" : "+v"(t_)); const int l_ = t_ & 63; float gq = fmaxf(fabsf(p.q_norm[l_]), fabsf(p.q_norm[64 + l_])), gk = fmaxf(fabsf(p.k_norm[l_]), fabsf(p.k_norm[64 + l_]));
          for (int m_ = 32; m_ >= 1; m_ >>= 1) { gq = fmaxf(gq, __shfl_xor(gq, m_)); gk = fmaxf(gk, __shfl_xor(gk, m_)); }
          nomax = 11.3137085f * 1.4426950409f * 1.02f * gq * gk <= 40.0f; }
        for (int i = 0; i <= per; ++i) {
            int head, row0, seq;
            if (i < per) { const int unit = vcu * per + i; if (unit >= NLAT) continue; const int nqb = SEQ / 256, kv = unit / (4 * nqb), rem = unit % (4 * nqb); head = kv * 4 + rem / nqb; row0 = CTXN + (rem % nqb) * 256; seq = R; }
            else { if (ctx_attn_early || vcu >= 8) break; CTX_ATTN_UNIT(vcu); break; }
            const int kv = head / 4;
            if (nomax) attn::attn_dense_body<attn::bf16, true>(P + (size_t)row0 * P0W + C_QB + head * 128, P + C_KB + kv * 128, P + C_VB + kv * 128, BR + (size_t)row0 * 2048 + 1024 + head * 128, seq, (char*)lds_raw);
            else attn::attn_dense_body<attn::bf16, false>(P + (size_t)row0 * P0W + C_QB + head * 128, P + C_KB + kv * 128, P + C_VB + kv * 128, BR + (size_t)row0 * 2048 + 1024 + head * 128, seq, (char*)lds_raw);
            __syncthreads();
        }
        if (PROBE & 1) xcd_barrier(xbar);
    }
    SYNC
    run_gemm(lds, ws_xn(p) + (size_t)CTXN * DM, wt_in0 + (size_t)C_GA * DM, SEQ, 2048, DM, pg8::EpiGateMul{ws_br(p) + (size_t)CTXN * 2048, 2048});
    {
        pg8::Gemm gk{ws_br(p), wt_out0, 8 * 256, DM, 256, 2048, 2048, 256 * 2}; pg8::StaticOrder S; S.init(8 * 256, DM, (int)gridDim.x, (int)blockIdx.x);
        pg8::gemm_phase<pg8::EpiF32, pg8::StaticOrder, true, true>(lds, gk, S, pg8::EpiF32{(float*)(p.ws + WS_YC), DM}); }
    SYNC
    REP(4) { run_gemm(lds, ws_br(p) + (size_t)CTXN * 2048, wt_out0, SEQ, DM, 2048, pg8::EpiF32{ws_y(p) + (size_t)CTXN * DM, DM}); SYNC }
    REP(15) { el::resid_phase<0>(p); SYNC }
    REP(3) { run_gemm(lds, ws_xn(p), wt_in1 + (size_t)O_RW * DM, R, ZW, DM, pg8::EpiBf16Halo{ws_big(p), ZW, (bf16_t*)(p.ws + rw::WS_HALO)});
             run_gemm(lds, ws_xn(p), wt_in1 + (size_t)(O_NA + 1024) * DM, CTXN, 2048, DM, pg8::EpiBf16<0>{(bf16_t*)(p.ws + WS_SIDE), 2048, nullptr, 0, 0, 1.f}, tail_rot((R / 256) * (ZW / 256)));
             SYNC }
    rw::shift_inplace(p); wy::zero_words(p); SYNC
#ifndef PSKIP
#define PSKIP 0
#endif
    if ((PROBE >> 16) & 1) { wy::phase<1, PSKIP>(p, lds); SYNC wy::zero_words(p); SYNC }
    if ((PROBE >> 17) & 1) { wy::phase<2>(p, lds); SYNC wy::zero_words(p); SYNC }
    if ((PROBE >> 19) & 1) { wy::phase<4, 16>(p, lds); SYNC wy::zero_words(p); SYNC }
    if ((PROBE >> 18) & 1) { wy::phase<3>(p, lds); SYNC wy::zero_words(p); SYNC }
    if (gridDim.x >= 64) wy::phase<0>(p, lds);
    else { for (int b = blockIdx.x; b < 256; b += gridDim.x) rw::scan_block<0>(p, b, lds); }
    SYNC
    rw::finish_phase(p); SYNC
    REP(3) { run_gemm(lds, ws_xn(p) + (size_t)CTXN * DM, wt_in1 + (size_t)O_NA * DM, SEQ, NAW, DM, pg8::EpiBf16<0>{ws_big(p) + (size_t)CTXN * NAW, NAW, nullptr, 0, 0, 1.f}); SYNC }
    REP(7) { for (int u = blockIdx.x; u < (GROWS / 4) * 16; u += gridDim.x) na::na_unit(p, u >> 4, u & 15, (char*)lds_raw); SYNC }
    run_gemm(lds, ws_xn(p) + (size_t)CTXN * DM, wt_in1 + (size_t)O_GC * DM, SEQ, 2048, DM, pg8::EpiGateMul{ws_br(p) + (size_t)CTXN * 2048, 2048}); SYNC
    REP(4) { run_gemm(lds, ws_br(p) + (size_t)CTXN * 2048, wt_out1, SEQ, DM, 2048, pg8::EpiF32{ws_y(p) + (size_t)CTXN * DM, DM}); SYNC }
    el::resid_phase<1>(p);
#undef X
#undef SYNC
}

extern "C" void kernel_launch(void* const* d_in, const int* in_sizes, int n_in, void* d_out, int out_size, void* d_ws, size_t ws_size, hipStream_t stream) {
    static int grid_blocks = 0;
    if (!grid_blocks) {
        int dev = 0, cus = 0, per_cu = 0;
        (void)hipGetDevice(&dev); (void)hipDeviceGetAttribute(&cus, hipDeviceAttributeMultiprocessorCount, dev);
        (void)hipFuncSetAttribute((const void*)mega, hipFuncAttributeMaxDynamicSharedMemorySize, LDS_BYTES);
        (void)hipOccupancyMaxActiveBlocksPerMultiprocessor(&per_cu, mega, NTHR, LDS_BYTES);
        if (per_cu < 1) per_cu = 1;
        grid_blocks = cus * per_cu;
        if (ws_size < WS_END) fprintf(stderr, "kernel_launch: workspace too small: %zu < %zu\n", ws_size, (size_t)WS_END);
    }
    (void)hipMemsetAsync((char*)d_ws + WS_BAR, 0, XCD_BAR_WORDS * 4, stream);
    Params p = make_params(d_in, d_out, d_ws);
    void* args[] = {&p};
    hipError_t e = hipLaunchCooperativeKernel((void*)mega, dim3(grid_blocks), dim3(NTHR), args, LDS_BYTES, stream);
    if (e != hipSuccess) fprintf(stderr, "cooperative launch failed: %s (grid %d)\n", hipGetErrorString(e), grid_blocks);
}

#else
int main(int argc, char** argv) {
    const char* dir = argc > 1 ? argv[1] : "data";
    char path[512]; snprintf(path, 512, "%s/sizes.txt", dir); FILE* f = fopen(path, "r"); if (!f) { printf("no sizes\n"); return 1; }
    std::vector<long> sizes; long v; while (fscanf(f, "%ld", &v) == 1) sizes.push_back(v); fclose(f);
    if (sizes.size() != 31) { printf("bad n inputs %zu\n", sizes.size()); return 1; }
    snprintf(path, 512, "%s/inputs.bin", dir); f = fopen(path, "rb");
    std::vector<std::vector<float>> in(31); std::vector<void*> ptrs(31);
    for (int i = 0; i < 31; ++i) { in[i].resize(sizes[i]); if (fread(in[i].data(), 4, sizes[i], f) != (size_t)sizes[i]) { printf("short read\n"); return 1; } ptrs[i] = in[i].data(); }
    fclose(f);
    if (sizes[0] != (long)SEQ * DM) { printf("SEQ mismatch: build with -DSEQ_LEN=%ld\n", sizes[0] / DM); return 1; }
    std::vector<float> out((size_t)SEQ * DM, 0.f); std::vector<unsigned char> ws(WS_END, 0xAA);
    Params p = make_params(ptrs.data(), out.data(), ws.data());
    auto check = [&](const char* name, const float* got, size_t n) {
        snprintf(path, 512, "%s/%s", dir, name); FILE* g = fopen(path, "rb"); std::vector<float> ref(n); if (fread(ref.data(), 4, n, g) != n) printf("short ref\n"); fclose(g);
        double num = 0, den = 0, mx = 0; for (size_t i = 0; i < n; ++i) { const double d = (double)got[i] - ref[i]; num += d * d; den += (double)ref[i] * ref[i]; if (fabs(d) > mx) mx = fabs(d); }
        printf("%s: rvr=%.3e absmax=%.3e\n", name, num / den, mx); };
    static RwShared sh;
    int phase = 0;
#define X(fn, n) { printf("phase %d %s n=%ld\n", phase++, #fn, (long)(n)); fflush(stdout); _Pragma("omp parallel for schedule(dynamic, 64)") for (long g = 0; g < (long)(n); ++g) fn(p, g); }
#define SYNC
#define SCAN { printf("phase %d scan\n", phase++); fflush(stdout); _Pragma("omp parallel for schedule(dynamic, 1)") for (int b = 0; b < 32; ++b) { RwShared* s = new RwShared; rwkv_scan_block(p, b, *s); delete s; } }
    X(ph_mod, N_MOD) X(ph_rope_table, N_ROPE) X(ph_prenorm<0>, (long)R) X(ph_gemm_l0_qkv, (long)R * P0W) X(ph_ropenorm, N_ROPENORM) X(ph_ret_scan, N_RETSCAN)
    X(ph_ret_merge, N_RETMERGE) X(ph_gqa_attn, N_GQA) X(ph_gemm_l0_gate, (long)R * 2048) X(ph_gemm_l0_out, (long)R * DM) X(ph_resid<0>, (long)R)
    check("x0.bin", out.data(), out.size()); check("ctx0.bin", ws_ctx1(p), (size_t)CTXN * DM);
    X(ph_prenorm<1>, (long)R) X(ph_gemm_l1_rw, (long)R * ZW) SCAN X(ph_rwkv_finish, N_RWFIN) X(ph_gemm_l1_na, (long)R * NAW) X(ph_na, N_NA)
    X(ph_gemm_l1_gate, (long)SEQ * 2048) X(ph_gemm_l1_out, (long)SEQ * DM) X(ph_resid<1>, (long)SEQ)
    check("out.bin", out.data(), out.size());
    return 0;
}
#endif
```

```cpp
#ifdef CPU_EMU
#include <cstdio>
#include <cstdlib>
#include <cstring>
#include <cmath>
#include <vector>
#define DEV static inline
#else
#include <hip/hip_runtime.h>
#include <hip/hip_cooperative_groups.h>
#include <cstdio>
namespace cg = cooperative_groups;
#define DEV __device__ __forceinline__
#endif

#ifndef SEQ_LEN
#define SEQ_LEN 16384
#endif
typedef unsigned short bf16_t;
constexpr int DM = 1024, CTXN = 256, SEQ = SEQ_LEN, R = CTXN + SEQ, GW = 64, GROWS = SEQ / GW;
constexpr int EVEN_IN = 5632, ODD_IN = 8448;
constexpr int P0W = 3584;
constexpr int C_QA = 0, C_KA = 512, C_VA = 1024, C_QB = 2048, C_KB = 3072, C_VB = 3328, C_GA = 3584;
constexpr int ZW = 3328;
constexpr int O_NA = 0, O_RW = 3072, O_GC = 6400;
constexpr int NAW = 3072;
constexpr float NORM_EPS = 1e-6f, GN_EPS = 64e-5f;

constexpr size_t MiB = 1u << 20;
constexpr size_t WS_MODV = 0;
constexpr size_t WS_ROPE = 64 * 1024;
constexpr size_t WS_CTX1 = 1 * MiB;
constexpr size_t WS_WB = 2 * MiB;
constexpr size_t WS_XN = 42 * MiB;
constexpr size_t WS_BIG = WS_XN + (((size_t)R * DM * 2 + MiB - 1) / MiB) * MiB;
constexpr size_t WS_BR = WS_BIG + (((size_t)R * P0W * 2 + MiB - 1) / MiB) * MiB;
constexpr size_t WS_END = WS_BR + (size_t)R * 2048 * 2;
static_assert(SEQ != 16384 || WS_END <= 256 * MiB, "workspace map exceeds 256 MiB");

struct Params {
    const float *x, *c, *ctx, *c_ctx, *w_mod, *b_mod, *g_pre, *g_post, *ev_w_in, *ev_w_out, *dec_f, *dec_b, *q_norm, *k_norm;
    const float *od_w_in, *od_w_out, *rpb, *mu, *w0f, *w2f, *w0b, *w2b, *a0f, *a2f, *a0b, *a2b, *k_k, *k_a, *r_k, *lnx_g, *lnx_b;
    float* out; unsigned char* ws;
};

DEV bf16_t f2bf(float f) { unsigned u; __builtin_memcpy(&u, &f, 4); u = (u + 0x7fffu + ((u >> 16) & 1u)) >> 16; return (bf16_t)u; }
DEV float bf2f(bf16_t h) { unsigned u = ((unsigned)h) << 16; float f; __builtin_memcpy(&f, &u, 4); return f; }
DEV float siluf(float x) { return x / (1.0f + expf(-x)); }
DEV float sigmf(float x) { return 1.0f / (1.0f + expf(-x)); }
DEV float softplusf(float x) { return fmaxf(x, 0.f) + log1pf(expf(-fabsf(x))); }

DEV float* ws_modv(const Params& p) { return (float*)(p.ws + WS_MODV); }
DEV float* ws_rope(const Params& p) { return (float*)(p.ws + WS_ROPE); }
DEV float* ws_ctx1(const Params& p) { return (float*)(p.ws + WS_CTX1); }
DEV bf16_t* ws_xn(const Params& p) { return (bf16_t*)(p.ws + WS_XN); }
DEV bf16_t* ws_big(const Params& p) { return (bf16_t*)(p.ws + WS_BIG); }
DEV float* ws_y(const Params& p) { return (float*)(p.ws + WS_BIG); }
DEV bf16_t* ws_br(const Params& p) { return (bf16_t*)(p.ws + WS_BR); }

constexpr long N_MOD = 2 * 2 * 3072;
DEV void ph_mod(const Params& p, long gid) {
    const int j = (int)(gid % 3072), s = (int)((gid / 3072) % 2), l = (int)(gid / 6144);
    const float* cv = s ? p.c_ctx : p.c; const float* w = p.w_mod + (size_t)l * DM * 3072 + j;
    float acc = 0.f;
    for (int k = 0; k < DM; ++k) acc += siluf(cv[k]) * w[(size_t)k * 3072];
    ws_modv(p)[gid] = acc + p.b_mod[l * 3072 + j];
}
constexpr long N_ROPE = 256 * 32;
DEV void ph_rope_table(const Params& p, long gid) {
    const int f = (int)(gid % 32), pos = (int)(gid / 32);
    const float inv = powf(10000.0f, -(float)f / 32.0f); const float ang = (float)pos * inv;
    ws_rope(p)[gid] = cosf(ang); ws_rope(p)[N_ROPE + gid] = sinf(ang);
}
template <int LAYER> DEV void ph_prenorm(const Params& p, long gid) {
    const int row = (int)gid; const int s = row < CTXN ? 1 : 0;
    const float* src = row < CTXN ? ((LAYER == 0 ? p.ctx : ws_ctx1(p)) + (size_t)row * DM) : ((LAYER == 0 ? p.x : p.out) + (size_t)(row - CTXN) * DM);
    const float* mv = ws_modv(p) + (LAYER * 2 + s) * 3072; const float* g = p.g_pre + LAYER * DM;
    float ss = 0.f;
    for (int k = 0; k < DM; ++k) ss += src[k] * src[k];
    const float rstd = 1.0f / sqrtf(ss / DM + NORM_EPS);
    bf16_t* o = ws_xn(p) + (size_t)row * DM;
    for (int k = 0; k < DM; ++k) o[k] = f2bf(src[k] * rstd * g[k] * (1.0f + mv[1024 + k]) + mv[k]);
}
template <int MODE> DEV void gemm_item(const bf16_t* A, int K, const float* W, int ldw, void* out, int pitch, int row, int col) {
    const bf16_t* a = A + (size_t)row * K; const float* w = W + col; float acc = 0.f;
    for (int k = 0; k < K; ++k) acc += bf2f(a[k]) * w[(size_t)k * ldw];
    if (MODE == 0) ((bf16_t*)out)[(size_t)row * pitch + col] = f2bf(acc);
    else if (MODE == 1) { bf16_t* o = (bf16_t*)out + (size_t)row * pitch + col; *o = f2bf(siluf(acc) * bf2f(*o)); }
    else ((float*)out)[(size_t)row * pitch + col] = acc;
}
DEV void ph_gemm_l0_qkv(const Params& p, long gid) { gemm_item<0>(ws_xn(p), DM, p.ev_w_in, EVEN_IN, ws_big(p), P0W, (int)(gid / P0W), (int)(gid % P0W)); }
DEV void ph_gemm_l0_gate(const Params& p, long gid) { gemm_item<1>(ws_xn(p), DM, p.ev_w_in + C_GA, EVEN_IN, ws_br(p), 2048, (int)(gid / 2048), (int)(gid % 2048)); }
DEV void ph_gemm_l0_out(const Params& p, long gid) { gemm_item<2>(ws_br(p), 2048, p.ev_w_out, DM, ws_y(p), DM, (int)(gid / DM), (int)(gid % DM)); }
DEV void ph_gemm_l1_rw(const Params& p, long gid) { gemm_item<0>(ws_xn(p), DM, p.od_w_in + O_RW, ODD_IN, ws_big(p), ZW, (int)(gid / ZW), (int)(gid % ZW)); }
DEV void ph_gemm_l1_na(const Params& p, long gid) { gemm_item<0>(ws_xn(p), DM, p.od_w_in + O_NA, ODD_IN, ws_big(p), NAW, (int)(gid / NAW), (int)(gid % NAW)); }
DEV void ph_gemm_l1_gate(const Params& p, long gid) { gemm_item<1>(ws_xn(p), DM, p.od_w_in + O_GC, ODD_IN, ws_br(p), 2048, CTXN + (int)(gid / 2048), (int)(gid % 2048)); }
DEV void ph_gemm_l1_out(const Params& p, long gid) { gemm_item<2>(ws_br(p), 2048, p.od_w_out, DM, ws_y(p), DM, CTXN + (int)(gid / DM), (int)(gid % DM)); }

constexpr long N_ROPENORM = (long)R * 18;
DEV void ph_ropenorm(const Params& p, long gid) {
    const int slot = (int)(gid % 18), row = (int)(gid / 18);
    int col; const float* nw = nullptr; float sc = 1.f;
    if (slot < 4) col = C_QA + slot * 128; else if (slot < 8) { col = C_KA + (slot - 4) * 128; sc = 0.08838834764831845f; }
    else if (slot < 16) { col = C_QB + (slot - 8) * 128; nw = p.q_norm; } else { col = C_KB + (slot - 16) * 128; nw = p.k_norm; }
    bf16_t* v = ws_big(p) + (size_t)row * P0W + col;
    if (nw) { float ss = 0.f; for (int d = 0; d < 128; ++d) { const float t = bf2f(v[d]); ss += t * t; } sc = 1.0f / sqrtf(ss / 128.f + NORM_EPS); }
    const bool rot = row >= CTXN; const int t = row - CTXN; const int gr = rot ? t / GW : 0, gc = rot ? t % GW : 0;
    const float* ct = ws_rope(p); const float* st = ct + N_ROPE;
    for (int i = 0; i < 64; ++i) {
        float x1 = bf2f(v[2 * i]) * sc, x2 = bf2f(v[2 * i + 1]) * sc;
        if (nw) { x1 *= nw[2 * i]; x2 *= nw[2 * i + 1]; }
        if (rot) { const int pos = i < 32 ? gr : gc, f = i & 31; const float cs = ct[pos * 32 + f], sn = st[pos * 32 + f]; const float y1 = x1 * cs - x2 * sn, y2 = x1 * sn + x2 * cs; x1 = y1; x2 = y2; }
        v[2 * i] = f2bf(x1); v[2 * i + 1] = f2bf(x2);
    }
}
constexpr long N_RETSCAN = 2 * 4 * 256;
DEV void ph_ret_scan(const Params& p, long gid) {
    const int e = (int)(gid % 256), h = (int)((gid / 256) % 4), dir = (int)(gid / 1024);
    const float g = sigmf((dir ? p.dec_b : p.dec_f)[h]);
    float S[128];
#pragma unroll
    for (int d = 0; d < 128; ++d) S[d] = 0.f;
    const bf16_t* P = ws_big(p); bf16_t* BR = ws_br(p);
    for (int pos = 0; pos < R; ++pos) {
        int row; if (pos < CTXN) row = dir ? CTXN - 1 - pos : pos; else { const int t = pos - CTXN; row = CTXN + (dir ? SEQ - 1 - t : t); }
        const bf16_t* pr = P + (size_t)row * P0W; const float v = bf2f(pr[C_VA + h * 256 + e]);
        const bf16_t* kq = pr + C_KA + h * 128; const bf16_t* qq = pr + C_QA + h * 128; float y = 0.f;
#pragma unroll
        for (int d = 0; d < 128; ++d) { S[d] = g * S[d] + bf2f(kq[d]) * v; y += bf2f(qq[d]) * S[d]; }
        BR[(size_t)row * 2048 + dir * 1024 + h * 256 + e] = f2bf(y);
    }
}
constexpr long N_RETMERGE = (long)R * 4;
DEV void ph_ret_merge(const Params& p, long gid) {
    const int h = (int)(gid % 4), row = (int)(gid / 4);
    bf16_t* b = ws_br(p) + (size_t)row * 2048 + h * 256;
    float s = 0.f; for (int e = 0; e < 256; ++e) s += bf2f(b[e]) + bf2f(b[1024 + e]);
    const float mean = s / 256.f; float q = 0.f;
    for (int e = 0; e < 256; ++e) { const float d = bf2f(b[e]) + bf2f(b[1024 + e]) - mean; q += d * d; }
    const float rstd = 1.0f / sqrtf(q / 256.f + NORM_EPS);
    for (int e = 0; e < 256; ++e) b[e] = f2bf((bf2f(b[e]) + bf2f(b[1024 + e]) - mean) * rstd);
}
constexpr long N_GQA = (long)R * 8 * 8;
DEV void ph_gqa_attn(const Params& p, long gid) {
    const int sl = (int)(gid % 8), row = (int)((gid / 8) % R), head = (int)(gid / (8L * R)), g = head / 4;
    const bf16_t* P = ws_big(p); const int nk = row < CTXN ? CTXN : R;
    float q[128];
    { const bf16_t* qp = P + (size_t)row * P0W + C_QB + head * 128;
#pragma unroll
      for (int d = 0; d < 128; ++d) q[d] = bf2f(qp[d]) * 0.08838834764831845f; }
    float acc[16];
#pragma unroll
    for (int i = 0; i < 16; ++i) acc[i] = 0.f;
    float m = -1e30f, l = 0.f;
    for (int j = 0; j < nk; ++j) {
        const bf16_t* kp = P + (size_t)j * P0W + C_KB + g * 128; float s = 0.f;
#pragma unroll
        for (int d = 0; d < 128; ++d) s += q[d] * bf2f(kp[d]);
        const float mn = fmaxf(m, s), al = expf(m - mn), pe = expf(s - mn);
        const bf16_t* vp = P + (size_t)j * P0W + C_VB + g * 128 + sl * 16;
        l = l * al + pe;
#pragma unroll
        for (int i = 0; i < 16; ++i) acc[i] = acc[i] * al + pe * bf2f(vp[i]);
        m = mn;
    }
    bf16_t* o = ws_br(p) + (size_t)row * 2048 + 1024 + head * 128 + sl * 16; const float il = 1.0f / l;
#pragma unroll
    for (int i = 0; i < 16; ++i) o[i] = f2bf(acc[i] * il);
}
template <int LAYER> DEV void ph_resid(const Params& p, long gid) {
    const int row = LAYER == 0 ? (int)gid : CTXN + (int)gid; const int s = row < CTXN ? 1 : 0;
    const float* y = ws_y(p) + (size_t)row * DM; const float* mv = ws_modv(p) + (LAYER * 2 + s) * 3072 + 2048; const float* g = p.g_post + LAYER * DM;
    float ss = 0.f; for (int k = 0; k < DM; ++k) ss += y[k] * y[k];
    const float rstd = 1.0f / sqrtf(ss / DM + NORM_EPS);
    const float* src; float* dst;
    if (row < CTXN) { src = p.ctx + (size_t)row * DM; dst = ws_ctx1(p) + (size_t)row * DM; }
    else { src = (LAYER == 0 ? p.x : p.out) + (size_t)(row - CTXN) * DM; dst = p.out + (size_t)(row - CTXN) * DM; }
    for (int k = 0; k < DM; ++k) dst[k] = src[k] + mv[k] * (y[k] * rstd * g[k]);
}
DEV float zshift(const bf16_t* Z, const float* mu, int row, int col) {
    const int lo = row < CTXN ? 0 : CTXN, hi = row < CTXN ? CTXN : R;
    const float z = bf2f(Z[(size_t)row * ZW + col]);
    const float pv = row > lo ? bf2f(Z[(size_t)(row - 1) * ZW + col]) : 0.f, nx = row + 1 < hi ? bf2f(Z[(size_t)(row + 1) * ZW + col]) : 0.f;
    return z + (0.5f * (pv + nx) - z) * mu[col];
}
constexpr long N_RWFIN = (long)SEQ * 16;
DEV void ph_rwkv_finish(const Params& p, long gid) {
    const int h = (int)(gid % 16), t = (int)(gid / 16), row = CTXN + t;
    const bf16_t* Z = ws_big(p); bf16_t* b = ws_br(p) + (size_t)row * 2048;
    float bon[2];
    for (int d = 0; d < 2; ++d) {
        const float* a0 = d ? p.a0b : p.a0f; const float* a2 = d ? p.a2b : p.a2f;
        float s = 0.f;
        for (int j = 0; j < 64; ++j) { const int hj = h * 64 + j; float acc = a0[hj];
            for (int m = 0; m < 64; ++m) acc += zshift(Z, p.mu, row, 3200 + d * 64 + m) * a2[m * 1024 + hj];
            const float al = sigmf(acc); const float r = zshift(Z, p.mu, row, hj), k = zshift(Z, p.mu, row, 1024 + hj);
            s += r * (k * (1.0f + (al - 1.0f) * p.k_a[hj])) * p.r_k[hj]; }
        bon[d] = s;
    }
    float sm = 0.f; for (int i = 0; i < 64; ++i) sm += bf2f(b[h * 64 + i]) + bf2f(b[1024 + h * 64 + i]);
    const float mean = sm / 64.f; float q = 0.f;
    for (int i = 0; i < 64; ++i) { const float d = bf2f(b[h * 64 + i]) + bf2f(b[1024 + h * 64 + i]) - mean; q += d * d; }
    const float rstd = 1.0f / sqrtf(q / 64.f + GN_EPS);
    for (int i = 0; i < 64; ++i) { const int hi = h * 64 + i; const float w = bf2f(b[hi]) + bf2f(b[1024 + hi]);
        const float v = zshift(Z, p.mu, row, 2048 + hi);
        b[1024 + hi] = f2bf((w - mean) * rstd * p.lnx_g[hi] + p.lnx_b[hi] + (bon[0] + bon[1]) * v); }
}
constexpr long N_NA = (long)SEQ * 16;
DEV void ph_na(const Params& p, long gid) {
    const int h = (int)(gid % 16), t = (int)(gid / 16), r = t / GW, c = t % GW;
    const bf16_t* P = ws_big(p);
    float q[64];
    { const bf16_t* qp = P + (size_t)(CTXN + t) * NAW + h * 64;
#pragma unroll
      for (int d = 0; d < 64; ++d) q[d] = bf2f(qp[d]) * 0.125f; }
    float acc[64];
#pragma unroll
    for (int d = 0; d < 64; ++d) acc[d] = 0.f;
    float m = -1e30f, l = 0.f;
    const int wh = GROWS < 8 ? GROWS : 8;
    int r0 = r - wh / 2; r0 = r0 < 0 ? 0 : (r0 > GROWS - wh ? GROWS - wh : r0);
    int c0 = c - 8; c0 = c0 < 0 ? 0 : (c0 > GW - 16 ? GW - 16 : c0);
    const float* rp = p.rpb + h * 15 * 31;
    for (int kk = 0; kk < wh * 16 + CTXN; ++kk) {
        int krow; float bias = 0.f;
        if (kk < wh * 16) { const int i = kk / 16, j = kk % 16; krow = CTXN + (r0 + i) * GW + c0 + j; bias = rp[(r0 + i - r + 7) * 31 + (c0 + j - c + 15)]; }
        else krow = kk - wh * 16;
        const bf16_t* kp = P + (size_t)krow * NAW + 1024 + h * 64; float s = bias;
#pragma unroll
        for (int d = 0; d < 64; ++d) s += q[d] * bf2f(kp[d]);
        const float mn = fmaxf(m, s), al = expf(m - mn), pe = expf(s - mn);
        const bf16_t* vp = P + (size_t)krow * NAW + 2048 + h * 64;
        l = l * al + pe;
#pragma unroll
        for (int d = 0; d < 64; ++d) acc[d] = acc[d] * al + pe * bf2f(vp[d]);
        m = mn;
    }
    bf16_t* o = ws_br(p) + (size_t)(CTXN + t) * 2048 + h * 64; const float il = 1.0f / l;
#pragma unroll
    for (int d = 0; d < 64; ++d) o[d] = f2bf(acc[d] * il);
}

constexpr int RW_CH = 16;
struct RwShared { float r[RW_CH][64], w[RW_CH][64], kd[RW_CH][64], v[RW_CH][64], a[RW_CH][64], b[RW_CH][64], tz[RW_CH][64], za[RW_CH][64], kk[RW_CH][64]; };
#ifdef CPU_EMU
#define FOR_THREADS(tid) for (int tid = 0; tid < 64; ++tid)
#define BLOCK_SYNC()
#define TSTATE(tid) S_all[tid]
#else
#define FOR_THREADS(tid) const int tid = threadIdx.x; if (tid < 64)
#define BLOCK_SYNC() __syncthreads()
#define TSTATE(tid) S_reg
#endif
DEV int rw_row(int dir, int pos) { if (pos < CTXN) return dir ? CTXN - 1 - pos : pos; const int t = pos - CTXN; return CTXN + (dir ? SEQ - 1 - t : t); }
#ifdef CPU_EMU
static void rwkv_scan_block(const Params& p, int blk, RwShared& sh) {
    static thread_local float S_all[64][64];
    for (int i = 0; i < 64; ++i) for (int j = 0; j < 64; ++j) S_all[i][j] = 0.f;
#else
__device__ void rwkv_scan_block(const Params& p, int blk, RwShared& sh) {
    float S_reg[64];
#pragma unroll
    for (int j = 0; j < 64; ++j) S_reg[j] = 0.f;
#endif
    const int dir = blk / 16, h = blk % 16;
    const float* w0 = dir ? p.w0b : p.w0f; const float* w2 = dir ? p.w2b : p.w2f; const float* a0 = dir ? p.a0b : p.a0f; const float* a2 = dir ? p.a2b : p.a2f;
    const bf16_t* Z = ws_big(p); bf16_t* BR = ws_br(p);
    for (int p0 = 0; p0 < R; p0 += RW_CH) {
        { FOR_THREADS(tid) { const int hj = h * 64 + tid;
            for (int tt = 0; tt < RW_CH; ++tt) { const int row = rw_row(dir, p0 + tt);
                sh.tz[tt][tid] = tanhf(zshift(Z, p.mu, row, 3072 + dir * 64 + tid)); sh.za[tt][tid] = zshift(Z, p.mu, row, 3200 + dir * 64 + tid);
                sh.r[tt][tid] = zshift(Z, p.mu, row, hj); sh.v[tt][tid] = zshift(Z, p.mu, row, 2048 + hj);
                const float k = zshift(Z, p.mu, row, 1024 + hj); sh.kd[tt][tid] = k; sh.kk[tt][tid] = k * p.k_k[hj]; } } }
        BLOCK_SYNC();
        { FOR_THREADS(tid) { const int hj = h * 64 + tid;
            for (int tt = 0; tt < RW_CH; ++tt) { float aw = w0[hj], aa = a0[hj], nn = 0.f;
                for (int m = 0; m < 64; ++m) { aw += sh.tz[tt][m] * w2[m * 1024 + hj]; aa += sh.za[tt][m] * a2[m * 1024 + hj]; nn += sh.kk[tt][m] * sh.kk[tt][m]; }
                const float lw = -softplusf(-aw) - 0.5f; const float al = sigmf(aa);
                const float kkn = sh.kk[tt][tid] / fmaxf(sqrtf(nn), 1e-12f);
                sh.w[tt][tid] = expf(-expf(lw)); sh.a[tt][tid] = -kkn; sh.b[tt][tid] = kkn * al;
                sh.kd[tt][tid] = sh.kd[tt][tid] * (1.0f + (al - 1.0f) * p.k_a[hj]); } } }
        BLOCK_SYNC();
        { FOR_THREADS(tid) { float* S = TSTATE(tid);
            for (int tt = 0; tt < RW_CH; ++tt) { float sa = 0.f;
#pragma unroll
                for (int j = 0; j < 64; ++j) sa += S[j] * sh.a[tt][j];
                const float vi = sh.v[tt][tid]; float y = 0.f;
#pragma unroll
                for (int j = 0; j < 64; ++j) { S[j] = S[j] * sh.w[tt][j] + sa * sh.b[tt][j] + vi * sh.kd[tt][j]; y += S[j] * sh.r[tt][j]; }
                if (p0 >= CTXN) BR[(size_t)rw_row(dir, p0 + tt) * 2048 + dir * 1024 + h * 64 + tid] = f2bf(y); } } }
        BLOCK_SYNC();
    }
}

static Params make_params(void* const* d_in, void* d_out, void* d_ws) {
    Params p{};
    const float** f = (const float**)&p;
    for (int i = 0; i < 31; ++i) f[i] = (const float*)d_in[i];
    p.out = (float*)d_out; p.ws = (unsigned char*)d_ws; return p;
}


#ifndef CPU_EMU
#define LAS __attribute__((address_space(3)))
#define GAS __attribute__((address_space(1)))
typedef unsigned v4u __attribute__((ext_vector_type(4)));
constexpr int NWAVES = 8, NTHR = NWAVES * 64;
#ifndef PROBE
#define PROBE 0
#endif
#define XB_TMO      128
#define XB_XCNT(j)  (256  + 64 * (j))
#define XB_XSUB(j)  (1280 + 64 * (j))
#define XB_XGEN(j)  (2304 + 64 * (j))
#define XB_TOP      3328
#define XB_TOPGEN   3392
#define XCD_BAR_WORDS 3456
#define XB_SPIN_CAP (1u << 18)

__device__ __forceinline__ unsigned xb_ld(unsigned* p)              { return __hip_atomic_load(p, __ATOMIC_RELAXED, __HIP_MEMORY_SCOPE_AGENT); }
__device__ __forceinline__ unsigned xb_add(unsigned* p, unsigned v) { return __hip_atomic_fetch_add(p, v, __ATOMIC_RELAXED, __HIP_MEMORY_SCOPE_AGENT); }
__device__ __forceinline__ unsigned xb_xcc_id() { return (unsigned)__builtin_amdgcn_s_getreg((3 << 11) | 20) & 0xFu; }
#define XB_SPIN(cond, bar) do { unsigned _sp = 0; while (cond) { __builtin_amdgcn_s_sleep(1); \
    if ((++_sp & 255u) == 0u) { if (xb_ld(&(bar)[XB_TMO])) break; if (_sp > XB_SPIN_CAP) { atomicAdd(&(bar)[XB_TMO], 1u); break; } } } } while (0)

struct XcdBarrier {
    unsigned* bar; unsigned x;
    volatile LAS unsigned* st;
};

__device__ __forceinline__ XcdBarrier xcd_barrier_post(unsigned* bar, volatile LAS unsigned* st) {
    XcdBarrier b; b.bar = bar; b.x = xb_xcc_id(); b.st = st;
    if (threadIdx.x == 0) (void)xb_add(&bar[XB_XCNT(b.x)], 1u);
    return b;
}
__device__ __forceinline__ void xcd_barrier_complete(unsigned* bar, unsigned x, unsigned& nloc, unsigned& nx) {
    const unsigned G = gridDim.x * gridDim.y * gridDim.z;
    unsigned sum, cnt, mine, sp = 0u;
    for (;;) {
        sum = 0u; cnt = 0u; mine = 0u;
#pragma unroll
        for (unsigned j = 0; j < 16; ++j) { const unsigned c = xb_ld(&bar[XB_XCNT(j)]); sum += c; cnt += (c > 0u) ? 1u : 0u; mine = (j == x) ? c : mine; }
        if (sum == G) break;
        __builtin_amdgcn_s_sleep(1);
        if ((++sp & 255u) == 0u) { if (xb_ld(&bar[XB_TMO])) break; if (sp > XB_SPIN_CAP) { atomicAdd(&bar[XB_TMO], 1u); break; } }
    }
    nloc = mine > 0u ? mine : 1u; nx = cnt > 0u ? cnt : 1u;
}

__device__ __forceinline__ void xcd_barrier(const XcdBarrier& b) {
    asm volatile("s_waitcnt vmcnt(0)" ::: "memory");
    __syncthreads();
    if (threadIdx.x == 0) {
        unsigned* bar = b.bar;
        __builtin_amdgcn_s_waitcnt(0);
        unsigned nloc = b.st[0], nx = b.st[1];
        if (nloc == 0u) { xcd_barrier_complete(bar, b.x, nloc, nx); b.st[0] = nloc; b.st[1] = nx; }
        const unsigned old = xb_add(&bar[XB_XSUB(b.x)], 1u);
        const unsigned gen = old / nloc;
        if (old + 1u == (gen + 1u) * nloc) {
            __builtin_amdgcn_fence(__ATOMIC_RELEASE, "agent");
            asm volatile("s_waitcnt vmcnt(0)" ::: "memory");
            const unsigned og = xb_add(&bar[XB_TOP], 1u);
            const unsigned tg = og / nx;
            if (og + 1u == (tg + 1u) * nx) xb_add(&bar[XB_TOPGEN], 1u);
            else XB_SPIN(xb_ld(&bar[XB_TOPGEN]) == tg, bar);
            __builtin_amdgcn_fence(__ATOMIC_ACQUIRE, "agent");
            xb_add(&bar[XB_XGEN(b.x)], 1u);
            asm volatile("s_waitcnt vmcnt(0)" ::: "memory");
        } else {
            XB_SPIN(xb_ld(&bar[XB_XGEN(b.x)]) == gen, bar);
            __builtin_amdgcn_fence(__ATOMIC_ACQUIRE, "agent");
            asm volatile("s_waitcnt vmcnt(0)" ::: "memory");
        }
    }
    __syncthreads();
}
namespace pg8 {
#define PG8_LAS __attribute__((address_space(3)))
typedef unsigned short bf16_t;
typedef short bf16x8 __attribute__((ext_vector_type(8)));
typedef float f32x4 __attribute__((ext_vector_type(4)));
typedef unsigned u32x4 __attribute__((ext_vector_type(4)));
constexpr int BM = 256, BK = 64, HALF = 128, HTB = HALF * BK * 2  , STAGE_BYTES = 8 * HTB, NXCD = 8, WGM = 8;

__host__ __device__ __forceinline__ int lds_byte(int r, int c) { const int st = (r >> 4) * 2 + (c >> 5), rr = r & 15, cc = c & 31, ob = rr * 64 + cc * 2; return st * 1024 + (ob ^ (((ob >> 9) & 1) << 5)); }
__host__ __device__ __forceinline__ void stage_rc(int b, int& R, int& C) { const int st = b / 1024, sb = b % 1024, swz = sb ^ (((sb >> 9) & 1) << 5); R = (st >> 1) * 16 + swz / 64; C = (st & 1) * 32 + (swz % 64) / 2; }
__host__ __device__ __forceinline__ int perm32(int rho) { const int n = rho >> 4, i = rho & 15; return 8 * (i >> 2) + 4 * n + (i & 3); }

struct Unit { int pm, pn; };
struct Gemm { const bf16_t* A; const bf16_t* Bt; int M, N, K; int lda = 0, ldb = 0; int ksl = 0; };

struct StaticOrder {
    int nM, nN, nwg, G, c;
    __host__ __device__ void init(int M, int N, int G_, int c_) { nM = M / BM; nN = N / BM; nwg = nM * nN; G = G_; c = c_; }
    __host__ __device__ bool next(int i, Unit& u) const {
        const long L = (long)i * G + c; if (L >= nwg) return false;
        int wgid = (int)L; { const int q = nwg / NXCD, r = nwg % NXCD, xcd = wgid % NXCD, off = wgid / NXCD; wgid = (xcd < r ? xcd * (q + 1) : r * (q + 1) + (xcd - r) * q) + off; }
        const int nig = WGM * nN, gid = wgid / nig, fm = gid * WGM, gsz = (nM - fm) < WGM ? (nM - fm) : WGM;
        u.pm = fm + ((wgid % nig) % gsz); u.pn = (wgid % nig) / gsz; return true;
    }
    __device__ __forceinline__ void a_ready(const Unit&) const {}
    __device__ __forceinline__ void done(const Unit&) const {}
};

__device__ __forceinline__ unsigned cvt_pk_bf16(float lo, float hi) { unsigned r; asm volatile("v_cvt_pk_bf16_f32 %0, %1, %2" : "=v"(r) : "v"(lo), "v"(hi)); return r; }
typedef float f32x2 __attribute__((ext_vector_type(2)));
__device__ __forceinline__ f32x2 gelu_pk(f32x2 v) {
    const f32x2 av = __builtin_elementwise_abs(v), d = av * 0.2316418882f + 1.0f;
    f32x2 t; t.x = __builtin_amdgcn_rcpf(d.x); t.y = __builtin_amdgcn_rcpf(d.y);
    f32x2 q = t * 0.5307027145f + (-0.7265760135f); q = q * t + 0.7107068705f; q = q * t + (-0.142248368f); q = q * t + 0.127414796f; q = q * t;
    const f32x2 s = (v * v) * (-0.72134752044f);
    f32x2 e; e.x = __builtin_amdgcn_exp2f(s.x); e.y = __builtin_amdgcn_exp2f(s.y);
    const f32x2 m = v * (q * e), r = v - m;
    f32x2 o; o.x = v.x < 0.f ? m.x : r.x; o.y = v.y < 0.f ? m.y : r.y; return o;
}

template <int ACT  > struct EpiBf16 {
    static constexpr bool PERM = true, AFTER_DRAIN = false; static_assert(ACT == 0 || ACT == 1, "EpiBf16: ACT is 0 (none) or 1 (gelu_pk)");
    bf16_t* O; int ldc; const float* bias; int split_cols; size_t split_stride; float scale0;
    __device__ __forceinline__ void operator()(const f32x4 (&acc)[2][2][4][2], const Unit& u, int wr, int wc, int fr, int fq) const {
        const int row0 = u.pm * BM + wr * 64 + fr; int colt = u.pn * BM; bf16_t* base = O;
        float sc = 1.f; if (split_cols) { const int t = colt / split_cols; base += (size_t)t * split_stride; colt -= t * split_cols; if (t == 0) sc = scale0; }
        const int col0 = colt + wc * 32 + 8 * fq, bcol0 = u.pn * BM + wc * 32 + 8 * fq;
        f32x4 bv[2][2];
#pragma unroll
        for (int bj = 0; bj < 2; ++bj)
#pragma unroll
            for (int n = 0; n < 2; ++n) bv[bj][n] = bias ? *(const f32x4*)(bias + bcol0 + bj * HALF + 4 * n) : (f32x4){0.f, 0.f, 0.f, 0.f};
#pragma unroll
        for (int ai = 0; ai < 2; ++ai)
#pragma unroll
            for (int m = 0; m < 4; ++m) { bf16_t* rowp = base + (size_t)(row0 + ai * HALF + m * 16) * ldc + col0;
#pragma unroll
                for (int bj = 0; bj < 2; ++bj) { f32x4 v0 = acc[ai][bj][m][0] + bv[bj][0], v1 = acc[ai][bj][m][1] + bv[bj][1];
                    if (ACT == 1) { f32x2 a = gelu_pk((f32x2){v0[0], v0[1]}), b = gelu_pk((f32x2){v0[2], v0[3]}), c = gelu_pk((f32x2){v1[0], v1[1]}), d = gelu_pk((f32x2){v1[2], v1[3]});
                        v0 = (f32x4){a.x, a.y, b.x, b.y}; v1 = (f32x4){c.x, c.y, d.x, d.y}; }
                    v0 = v0 * sc; v1 = v1 * sc; u32x4 w; w.x = cvt_pk_bf16(v0[0], v0[1]); w.y = cvt_pk_bf16(v0[2], v0[3]); w.z = cvt_pk_bf16(v1[0], v1[1]); w.w = cvt_pk_bf16(v1[2], v1[3]);
                    *(u32x4*)(rowp + bj * HALF) = w; } }
    }
};

typedef float f32x2c_ __attribute__((ext_vector_type(2))); typedef __bf16 bf2c_ __attribute__((ext_vector_type(2)));
__device__ __forceinline__ unsigned cvt_pk_bf16_c(float lo, float hi) { const f32x2c_ v = {lo, hi}; return __builtin_bit_cast(unsigned, __builtin_convertvector(v, bf2c_)); }
struct EpiBf16Halo {
    static constexpr bool PERM = true, AFTER_DRAIN = false;
    bf16_t* O; int ldc; bf16_t* H;
    __device__ __forceinline__ void operator()(const f32x4 (&acc)[2][2][4][2], const Unit& u, int wr, int wc, int fr, int fq) const {
        const int row0 = u.pm * BM + wr * 64 + fr, col0 = u.pn * BM + wc * 32 + 8 * fq;
#pragma unroll
        for (int ai = 0; ai < 2; ++ai)
#pragma unroll
            for (int m = 0; m < 4; ++m) { const int row = row0 + ai * HALF + m * 16; bf16_t* rowp = O + (size_t)row * ldc + col0;
                const bool edge = (m == 0 && fr == 0) || (m == 3 && fr == 15);
                bf16_t* hp = H + ((size_t)(row >> 6) * 2 + (m == 3 ? 1 : 0)) * ldc + col0;
#pragma unroll
                for (int bj = 0; bj < 2; ++bj) { const f32x4 v0 = acc[ai][bj][m][0], v1 = acc[ai][bj][m][1];
                    u32x4 w; w.x = cvt_pk_bf16_c(v0[0], v0[1]); w.y = cvt_pk_bf16_c(v0[2], v0[3]); w.z = cvt_pk_bf16_c(v1[0], v1[1]); w.w = cvt_pk_bf16_c(v1[2], v1[3]);
                    *(u32x4*)(rowp + bj * HALF) = w;
                    if ((m == 0 || m == 3) && edge) *(u32x4*)(hp + bj * HALF) = w; } }
    }
};
__device__ __forceinline__ float silu_fast(float v) { return v * __builtin_amdgcn_rcpf(1.0f + __builtin_amdgcn_exp2f(-1.4426950408889634f * v)); }
struct EpiGateMul {
    static constexpr bool PERM = true, AFTER_DRAIN = false;
    bf16_t* O; int ldc;
    __device__ __forceinline__ void operator()(const f32x4 (&acc)[2][2][4][2], const Unit& u, int wr, int wc, int fr, int fq) const {
        const int row0 = u.pm * BM + wr * 64 + fr, col0 = u.pn * BM + wc * 32 + 8 * fq;
#pragma unroll
        for (int ai = 0; ai < 2; ++ai)
#pragma unroll
            for (int m = 0; m < 4; ++m) { bf16_t* rowp = O + (size_t)(row0 + ai * HALF + m * 16) * ldc + col0;
#pragma unroll
                for (int bj = 0; bj < 2; ++bj) { const u32x4 old = *(const u32x4*)(rowp + bj * HALF); const f32x4 v0 = acc[ai][bj][m][0], v1 = acc[ai][bj][m][1];
                    u32x4 w;
                    w.x = cvt_pk_bf16(silu_fast(v0[0]) * __uint_as_float(old.x << 16), silu_fast(v0[1]) * __uint_as_float(old.x & 0xffff0000u));
                    w.y = cvt_pk_bf16(silu_fast(v0[2]) * __uint_as_float(old.y << 16), silu_fast(v0[3]) * __uint_as_float(old.y & 0xffff0000u));
                    w.z = cvt_pk_bf16(silu_fast(v1[0]) * __uint_as_float(old.z << 16), silu_fast(v1[1]) * __uint_as_float(old.z & 0xffff0000u));
                    w.w = cvt_pk_bf16(silu_fast(v1[2]) * __uint_as_float(old.w << 16), silu_fast(v1[3]) * __uint_as_float(old.w & 0xffff0000u));
                    *(u32x4*)(rowp + bj * HALF) = w; } }
    }
};
struct EpiSiluBf16 {
    static constexpr bool PERM = true, AFTER_DRAIN = false;
    bf16_t* O; int ldc;
    __device__ __forceinline__ void operator()(const f32x4 (&acc)[2][2][4][2], const Unit& u, int wr, int wc, int fr, int fq) const {
        const int row0 = u.pm * BM + wr * 64 + fr, col0 = u.pn * BM + wc * 32 + 8 * fq;
#pragma unroll
        for (int ai = 0; ai < 2; ++ai)
#pragma unroll
            for (int m = 0; m < 4; ++m) { bf16_t* rowp = O + (size_t)(row0 + ai * HALF + m * 16) * ldc + col0;
#pragma unroll
                for (int bj = 0; bj < 2; ++bj) { const f32x4 v0 = acc[ai][bj][m][0], v1 = acc[ai][bj][m][1]; u32x4 w;
                    w.x = cvt_pk_bf16(silu_fast(v0[0]), silu_fast(v0[1])); w.y = cvt_pk_bf16(silu_fast(v0[2]), silu_fast(v0[3]));
                    w.z = cvt_pk_bf16(silu_fast(v1[0]), silu_fast(v1[1])); w.w = cvt_pk_bf16(silu_fast(v1[2]), silu_fast(v1[3]));
                    *(u32x4*)(rowp + bj * HALF) = w; } }
    }
};
struct EpiF32 {
    static constexpr bool PERM = true, AFTER_DRAIN = false;
    float* O; int ldc;
    __device__ __forceinline__ void operator()(const f32x4 (&acc)[2][2][4][2], const Unit& u, int wr, int wc, int fr, int fq) const {
        const int row0 = u.pm * BM + wr * 64 + fr, col0 = u.pn * BM + wc * 32 + 8 * fq;
#pragma unroll
        for (int ai = 0; ai < 2; ++ai)
#pragma unroll
            for (int m = 0; m < 4; ++m) { float* rowp = O + (size_t)(row0 + ai * HALF + m * 16) * ldc + col0;
#pragma unroll
                for (int bj = 0; bj < 2; ++bj) { *(f32x4*)(rowp + bj * HALF) = acc[ai][bj][m][0]; *(f32x4*)(rowp + bj * HALF + 4) = acc[ai][bj][m][1]; } }
    }
};

template <class Epi, class Sched, bool ALIGN_EPI = false, bool SP2 = false>
__device__ __forceinline__ void gemm_phase(PG8_LAS unsigned char* lds, const Gemm g, const Sched& S, const Epi& E) {
    int tid_ = threadIdx.x; asm volatile("" : "+v"(tid_));
    const int tid = tid_, wid = __builtin_amdgcn_readfirstlane(tid >> 6), lane = tid & 63, wr = wid >> 2, wc = wid & 3, fr = lane & 15, fq = lane >> 4;
    const int K = g.K, nt = K / BK, lda = g.lda ? g.lda : K, ldb = g.ldb ? g.ldb : K;
    unsigned voffA[2], voffB[2];
#pragma unroll
    for (int i = 0; i < 2; ++i) { int R, C; stage_rc(tid * 16 + i * 8192, R, C); const int Rb = Epi::PERM ? ((R & ~31) + perm32(R & 31)) : R;
        voffA[i] = (unsigned)(R * lda + C) * 2u; voffB[i] = (unsigned)(Rb * ldb + C) * 2u; }
    const size_t kstep = (size_t)(BK * 2);
    const size_t hstepA = (size_t)HALF * lda * 2, hstepB = (size_t)HALF * ldb * 2;
    const size_t tstepA = g.ksl ? (size_t)g.ksl : 2 * hstepA, tstepB = 2 * hstepB, bpm = (size_t)g.ksl;
    const unsigned ldsw = (unsigned)wid * 1024u;
    const int aoff = lds_byte(wr * 64 + fr, fq * 8), boff = lds_byte(wc * 32 + fr, fq * 8);
#define PG8_SA(b, h) (((b) * 2 + (h)) * HTB)
#define PG8_SB(b, h) ((4 + (b) * 2 + (h)) * HTB)
#define PG8_STAGE(bufoff, gbase, voff) do { _Pragma("unroll") for (int _i = 0; _i < 2; ++_i) \
        __builtin_amdgcn_global_load_lds((const unsigned*)((const char*)(gbase) + (voff)[_i]), (PG8_LAS unsigned*)(lds + (bufoff) + ldsw + _i * 8192), 16, 0, 0); } while (0)
#define PG8_LDA(dst, b, h) do { _Pragma("unroll") for (int m = 0; m < 4; ++m) _Pragma("unroll") for (int k = 0; k < 2; ++k) dst[m][k] = *(const PG8_LAS bf16x8*)(lds + PG8_SA(b, h) + aoff + m * 2048 + k * 1024); } while (0)
#define PG8_LDB(dst, b, h) do { _Pragma("unroll") for (int n = 0; n < 2; ++n) _Pragma("unroll") for (int k = 0; k < 2; ++k) dst[n][k] = *(const PG8_LAS bf16x8*)(lds + PG8_SB(b, h) + boff + n * 2048 + k * 1024); } while (0)
#define PG8_MMA(ai, bj, At, Bt) do { __builtin_amdgcn_s_setprio(1); _Pragma("unroll") for (int m = 0; m < 4; ++m) _Pragma("unroll") for (int n = 0; n < 2; ++n) _Pragma("unroll") for (int k = 0; k < 2; ++k) \
        acc[ai][bj][m][n] = __builtin_amdgcn_mfma_f32_16x16x32_bf16(Bt[n][k], At[m][k], acc[ai][bj][m][n], 0, 0, 0); __builtin_amdgcn_s_setprio(0); } while (0)
#define PG8_WAIT_V(n) asm volatile("s_waitcnt vmcnt(" #n ")" ::: "memory")
#define PG8_WAIT_L(n) asm volatile("s_waitcnt lgkmcnt(" #n ")" ::: "memory")
#define PG8_BAR __builtin_amdgcn_s_barrier()
#define PG8_SCHED __builtin_amdgcn_sched_barrier(0)
    Unit cur, nxt; int ui = 0;
    if (!S.next(0, cur)) return;
    f32x4 acc[2][2][4][2];
#pragma unroll
    for (int a = 0; a < 2; ++a)
#pragma unroll
        for (int b = 0; b < 2; ++b)
#pragma unroll
            for (int m = 0; m < 4; ++m)
#pragma unroll
                for (int n = 0; n < 2; ++n) acc[a][b][m][n] = (f32x4){0.f, 0.f, 0.f, 0.f};
    bf16x8 At[4][2], B0[2][2], B1[2][2];
    const char* cA = (const char*)g.A + (size_t)cur.pm * tstepA; const char* cB = (const char*)g.Bt + (size_t)cur.pn * tstepB + (size_t)cur.pm * bpm;
    S.a_ready(cur);
    if constexpr (SP2) {
        PG8_STAGE(PG8_SB(0, 0), cB, voffB); PG8_STAGE(PG8_SB(0, 1), cB + hstepB, voffB); PG8_STAGE(PG8_SA(0, 0), cA, voffA); PG8_STAGE(PG8_SA(0, 1), cA + hstepA, voffA);
        if (wr == 1) PG8_BAR;
        PG8_WAIT_V(2); PG8_BAR;
        PG8_STAGE(PG8_SB(1, 0), cB + kstep, voffB); PG8_STAGE(PG8_SA(1, 0), cA + kstep, voffA); PG8_STAGE(PG8_SB(1, 1), cB + hstepB + kstep, voffB);
        PG8_WAIT_V(6); PG8_BAR;
    } else {
        PG8_STAGE(PG8_SB(0, 0), cB, voffB); PG8_STAGE(PG8_SA(0, 0), cA, voffA); PG8_STAGE(PG8_SB(0, 1), cB + hstepB, voffB); PG8_STAGE(PG8_SA(0, 1), cA + hstepA, voffA);
        if (wr == 1) PG8_BAR;
        PG8_WAIT_V(4); PG8_BAR;
        PG8_STAGE(PG8_SB(1, 0), cB + kstep, voffB); PG8_STAGE(PG8_SA(1, 0), cA + kstep, voffA); PG8_STAGE(PG8_SB(1, 1), cB + hstepB + kstep, voffB);
        PG8_WAIT_V(6); PG8_BAR;
    }
    for (;;) {
        const bool has_next = S.next(ui + 1, nxt);
        const char* nA = has_next ? (const char*)g.A + (size_t)nxt.pm * tstepA : cA; const char* nB = has_next ? (const char*)g.Bt + (size_t)nxt.pn * tstepB + (size_t)nxt.pm * bpm : cB;
        for (int t = 0; t < nt; t += 2) {
            const bool last = (t == nt - 2);
            const char* a1 = cA + (size_t)(t + 1) * kstep;
            const char* a2 = last ? nA : cA + (size_t)(t + 2) * kstep; const char* b2 = last ? nB : cB + (size_t)(t + 2) * kstep;
            const char* a3 = a2 + kstep; const char* b3 = b2 + kstep;
            if (last && has_next) S.a_ready(nxt);
            if constexpr (SP2) {
            PG8_LDB(B0, 0, 0); PG8_LDB(B1, 0, 1); PG8_SCHED; PG8_LDA(At, 0, 0); PG8_STAGE(PG8_SA(1, 1), a1 + hstepA, voffA);
            PG8_WAIT_V(8); PG8_WAIT_L(0); PG8_BAR; PG8_MMA(0, 0, At, B0); PG8_MMA(0, 1, At, B1); PG8_BAR; PG8_SCHED;
            PG8_LDA(At, 0, 1); PG8_STAGE(PG8_SB(0, 0), b2, voffB); PG8_STAGE(PG8_SB(0, 1), b2 + hstepB, voffB); PG8_STAGE(PG8_SA(0, 0), a2, voffA);
            PG8_WAIT_V(8); PG8_WAIT_L(0); PG8_BAR; PG8_MMA(1, 0, At, B0); PG8_MMA(1, 1, At, B1); PG8_BAR; PG8_SCHED;
            PG8_LDB(B0, 1, 0); PG8_LDB(B1, 1, 1); PG8_SCHED; PG8_LDA(At, 1, 0); PG8_STAGE(PG8_SA(0, 1), a2 + hstepA, voffA);
            PG8_WAIT_V(8); PG8_WAIT_L(0); PG8_BAR; PG8_MMA(0, 0, At, B0); PG8_MMA(0, 1, At, B1); PG8_BAR; PG8_SCHED;
            PG8_LDA(At, 1, 1); PG8_STAGE(PG8_SB(1, 0), b3, voffB); PG8_STAGE(PG8_SB(1, 1), b3 + hstepB, voffB); PG8_STAGE(PG8_SA(1, 0), a3, voffA);
            PG8_WAIT_V(8); PG8_WAIT_L(0); PG8_BAR; PG8_MMA(1, 0, At, B0); PG8_MMA(1, 1, At, B1); PG8_BAR; PG8_SCHED;
            } else {
            PG8_LDB(B0, 0, 0); PG8_SCHED; PG8_LDA(At, 0, 0); PG8_STAGE(PG8_SA(1, 1), a1 + hstepA, voffA);
            PG8_WAIT_L(8); PG8_BAR; PG8_WAIT_L(0); PG8_MMA(0, 0, At, B0); PG8_BAR; PG8_SCHED;
            PG8_LDB(B1, 0, 1); PG8_STAGE(PG8_SB(0, 0), b2, voffB);
            PG8_BAR; PG8_WAIT_L(0); PG8_MMA(0, 1, At, B1); PG8_BAR;
            PG8_LDA(At, 0, 1); PG8_STAGE(PG8_SA(0, 0), a2, voffA);
            PG8_BAR; PG8_WAIT_L(0); PG8_MMA(1, 0, At, B0); PG8_BAR; PG8_SCHED;
            PG8_STAGE(PG8_SB(0, 1), b2 + hstepB, voffB);
            PG8_WAIT_V(6); PG8_BAR; PG8_MMA(1, 1, At, B1); PG8_BAR;
            PG8_LDB(B0, 1, 0); PG8_SCHED; PG8_LDA(At, 1, 0); PG8_STAGE(PG8_SA(0, 1), a2 + hstepA, voffA);
            PG8_WAIT_L(8); PG8_BAR; PG8_WAIT_L(0); PG8_MMA(0, 0, At, B0); PG8_BAR; PG8_SCHED;
            PG8_LDB(B1, 1, 1); PG8_STAGE(PG8_SB(1, 0), b3, voffB);
            PG8_BAR; PG8_WAIT_L(0); PG8_MMA(0, 1, At, B1); PG8_BAR;
            PG8_LDA(At, 1, 1); PG8_STAGE(PG8_SA(1, 0), a3, voffA);
            PG8_BAR; PG8_WAIT_L(0); PG8_MMA(1, 0, At, B0); PG8_BAR; PG8_SCHED;
            PG8_STAGE(PG8_SB(1, 1), b3 + hstepB, voffB);
            PG8_WAIT_V(6); PG8_BAR; PG8_MMA(1, 1, At, B1); PG8_BAR;
            }
        }
        if constexpr (ALIGN_EPI) { if (wr == 0) PG8_BAR; }
        if constexpr (!Epi::AFTER_DRAIN) { E(acc, cur, wr, wc, fr, fq); S.done(cur); }
        if (!has_next) break;
#pragma unroll
        for (int a = 0; a < 2; ++a)
#pragma unroll
            for (int b = 0; b < 2; ++b)
#pragma unroll
                for (int m = 0; m < 4; ++m)
#pragma unroll
                    for (int n = 0; n < 2; ++n) acc[a][b][m][n] = (f32x4){0.f, 0.f, 0.f, 0.f};
        cur = nxt; cA = nA; cB = nB; ++ui;
        if constexpr (ALIGN_EPI) { if (wr == 1) PG8_BAR; }
    }
    PG8_WAIT_V(0);
    if constexpr (!ALIGN_EPI) { if (wr == 0) PG8_BAR; }
    PG8_BAR;
    if constexpr (Epi::AFTER_DRAIN) { E.fused(acc, cur, wr, wc, fr, fq, lds, wid, lane); S.done(cur); }
#undef PG8_SA
#undef PG8_SB
#undef PG8_STAGE
#undef PG8_LDA
#undef PG8_LDB
#undef PG8_MMA
#undef PG8_WAIT_V
#undef PG8_WAIT_L
#undef PG8_BAR
#undef PG8_SCHED
}
}

namespace attn {
using bf16 = unsigned short;
constexpr int   D = 128, NW = 8, QBLK = 32, KVBLK = 64;
constexpr float SCALE = 0.088388347648318440f;
constexpr float THR = 8.f;
constexpr int SDEPTH = 2;
constexpr int LDQ = P0W, LDK = P0W, LDO = 2048;
constexpr size_t SHM_V = KVBLK * D * 2, SHM_K = KVBLK * D * 2, SHM_ATTN = 3 * SHM_V + 2 * SHM_K + NW * 64 * 4;
using bf16x8 = __attribute__((ext_vector_type(8))) short;
using s16x4  = __attribute__((ext_vector_type(4))) short;
using f32x16 = __attribute__((ext_vector_type(16))) float;
using f32x8  = __attribute__((ext_vector_type(8))) float;
using u32x4  = __attribute__((ext_vector_type(4))) unsigned;
#define KSWZ(row, colB) ((row) * 256 + ((colB) ^ (((row) & 7) << 4)))
#define SBAR() __builtin_amdgcn_sched_barrier(0)
__device__ __forceinline__ int crow(int r, int hi) { return (r & 3) + 8 * (r >> 2) + 4 * hi; }
__device__ __forceinline__ unsigned cvtpk(float lo, float hi) {
  unsigned r; asm volatile("v_cvt_pk_bf16_f32 %0, %1, %2" : "=v"(r) : "v"(lo), "v"(hi)); return r;
}
template <typename TIn> struct Stage;
template <> struct Stage<bf16>  { using T = bf16x8;
  __device__ static __forceinline__ T ld8(const bf16* p) { return *reinterpret_cast<const bf16x8*>(p); }
  __device__ static __forceinline__ bf16x8 tobf(T x) { return x; } };
template <> struct Stage<float> { using T = f32x8;
  __device__ static __forceinline__ T ld8(const float* p) { return *reinterpret_cast<const f32x8*>(p); }
  __device__ static __forceinline__ bf16x8 tobf(T x) {
    u32x4 w = {cvtpk(x[0], x[1]), cvtpk(x[2], x[3]), cvtpk(x[4], x[5]), cvtpk(x[6], x[7])}; return *reinterpret_cast<bf16x8*>(&w); } };

template <bool NOMAX> __device__ __forceinline__ void partialSM(f32x16& p0, f32x16& p1, float& m_reg, float& mn, float& alpha) {
  if constexpr (NOMAX) { for (int r = 0; r < 16; ++r) p0[r] = __builtin_amdgcn_exp2f(p0[r]); alpha = 1.f; return; }
  constexpr float C = SCALE * 1.4426950408889634f;
  float pmax = p0[0]; for (int r = 1; r < 16; ++r) pmax = fmaxf(pmax, p0[r]); for (int r = 0; r < 16; ++r) pmax = fmaxf(pmax, p1[r]);
  { auto rr = __builtin_amdgcn_permlane32_swap(__float_as_uint(pmax), __float_as_uint(pmax), false, false);
    pmax = fmaxf(__uint_as_float(rr[0]), __uint_as_float(rr[1])); }
  if (__builtin_expect(__all(pmax - m_reg <= THR / SCALE), 1)) { mn = m_reg; alpha = 1.f; }
  else { mn = fmaxf(m_reg, pmax); alpha = __builtin_amdgcn_exp2f((m_reg - mn) * C); m_reg = mn; }
  float mnC = -mn * C;
  for (int r = 0; r < 16; ++r) p0[r] = fmaf(p0[r], C, mnC); for (int r = 0; r < 16; ++r) p1[r] = fmaf(p1[r], C, mnC);
  for (int r = 0; r < 16; ++r) p0[r] = __builtin_amdgcn_exp2f(p0[r]);
}
__device__ __forceinline__ void finishSM(f32x16& p0, f32x16& p1, float alpha, float& l_reg, bf16x8& pa0, bf16x8& pa1, bf16x8& pa2, bf16x8& pa3) {
  for (int r = 0; r < 16; ++r) p1[r] = __builtin_amdgcn_exp2f(p1[r]);
  float ps = 0; for (int r = 0; r < 16; ++r) ps += p0[r]; for (int r = 0; r < 16; ++r) ps += p1[r];
  { auto rr = __builtin_amdgcn_permlane32_swap(__float_as_uint(ps), __float_as_uint(ps), false, false);
    ps = __uint_as_float(rr[0]) + __uint_as_float(rr[1]); }
  l_reg = l_reg * alpha + ps;
#define PK4(P, BASE, OUT) do { unsigned a0 = cvtpk(P[BASE + 0], P[BASE + 1]), a1 = cvtpk(P[BASE + 2], P[BASE + 3]);   \
    unsigned b0 = cvtpk(P[BASE + 4], P[BASE + 5]), b1 = cvtpk(P[BASE + 6], P[BASE + 7]);                              \
    auto r0 = __builtin_amdgcn_permlane32_swap(a0, b0, false, false); auto r1 = __builtin_amdgcn_permlane32_swap(a1, b1, false, false); \
    u32x4 w = {r0[0], r1[0], r0[1], r1[1]}; OUT = *reinterpret_cast<bf16x8*>(&w); } while (0)
  PK4(p0, 0, pa0); PK4(p0, 8, pa1); PK4(p1, 0, pa2); PK4(p1, 8, pa3);
#undef PK4
}
__device__ __forceinline__ void qkt(f32x16& p0, f32x16& p1, const bf16* Ks, const bf16x8* qr, int r32, int hi) {
  p0 = f32x16{}; p1 = f32x16{};
  for (int d0 = 0; d0 < 8; ++d0) { int cb = (d0 * 16 + hi * 8) * 2;
    bf16x8 b0 = *reinterpret_cast<const bf16x8*>((const char*)Ks + KSWZ(r32, cb));
    bf16x8 b1 = *reinterpret_cast<const bf16x8*>((const char*)Ks + KSWZ(32 + r32, cb));
    p0 = __builtin_amdgcn_mfma_f32_32x32x16_bf16(b0, qr[d0], p0, 0, 0, 0);
    p1 = __builtin_amdgcn_mfma_f32_32x32x16_bf16(b1, qr[d0], p1, 0, 0, 0); }
}
__device__ __forceinline__ int v_st(int k, int c) { const int kk = (k & ~0xC) | ((k & 4) << 1) | ((k & 8) >> 1); return ((kk >> 3) * 4 + (c >> 5)) * 512 + ((kk & 7) * 32 + (c & 31)) * 2; }
__device__ __forceinline__ int v_rd_base(int lane) { return ((lane & 3) << 3) | (((lane >> 2) & 3) << 6) | (((lane >> 4) & 1) << 5) | (((lane >> 5) & 1) << 8); }
constexpr int v_rd_off(int d0, int ks, int half) { return d0 * 512 + ks * 4096 + half * 2048; }
template <int OFF> __device__ __forceinline__ s16x4 tr_read(int vb) {
  s16x4 r; asm volatile("ds_read_b64_tr_b16 %0, %1 offset:%2" : "=&v"(r) : "v"(vb), "i"(OFF) : "memory"); return r;
}
template <int D0> __device__ __forceinline__ void pv_one(f32x16& od, int vb, bf16x8 pa0, bf16x8 pa1, bf16x8 pa2, bf16x8 pa3) {
  const s16x4 l0 = tr_read<v_rd_off(D0, 0, 0)>(vb), h0 = tr_read<v_rd_off(D0, 0, 1)>(vb), l1 = tr_read<v_rd_off(D0, 1, 0)>(vb), h1 = tr_read<v_rd_off(D0, 1, 1)>(vb);
  const s16x4 l2 = tr_read<v_rd_off(D0, 2, 0)>(vb), h2 = tr_read<v_rd_off(D0, 2, 1)>(vb), l3 = tr_read<v_rd_off(D0, 3, 0)>(vb), h3 = tr_read<v_rd_off(D0, 3, 1)>(vb);
  asm volatile("s_waitcnt lgkmcnt(0)" ::: "memory"); SBAR();
#define PK(L, H) (bf16x8){L[0], L[1], L[2], L[3], H[0], H[1], H[2], H[3]}
  od = __builtin_amdgcn_mfma_f32_32x32x16_bf16(pa0, PK(l0, h0), od, 0, 0, 0);
  od = __builtin_amdgcn_mfma_f32_32x32x16_bf16(pa1, PK(l1, h1), od, 0, 0, 0);
  od = __builtin_amdgcn_mfma_f32_32x32x16_bf16(pa2, PK(l2, h2), od, 0, 0, 0);
  od = __builtin_amdgcn_mfma_f32_32x32x16_bf16(pa3, PK(l3, h3), od, 0, 0, 0);
#undef PK
}
__device__ __forceinline__ void pv_d0(f32x16* o, int vb, bf16x8 pa0, bf16x8 pa1, bf16x8 pa2, bf16x8 pa3) {
  pv_one<0>(o[0], vb, pa0, pa1, pa2, pa3); pv_one<1>(o[1], vb, pa0, pa1, pa2, pa3); pv_one<2>(o[2], vb, pa0, pa1, pa2, pa3); pv_one<3>(o[3], vb, pa0, pa1, pa2, pa3);
}

template <typename TQ, bool NOMAX>
__device__ __forceinline__ void attn_dense_body(const TQ* __restrict__ Qb, const bf16* __restrict__ Kh, const bf16* __restrict__ Vh,
                                                bf16* __restrict__ Ob, int seq, char* lds) {
  using St = Stage<bf16>; using SQ = Stage<TQ>;
  int tid_ = threadIdx.x; asm volatile("" : "+v"(tid_));
  const int tid = tid_, wid = tid >> 6, lane = tid & 63, r32 = lane & 31, hi = lane >> 5;
  bf16* V_lds = (bf16*)lds; bf16* K_lds = (bf16*)(lds + 3 * SHM_V);
  float* ws = (float*)(lds + 3 * SHM_V + 2 * SHM_K) + wid * 64; float* li_l = ws; float* al_l = ws + 32;
  float m_reg = -1e30f, l_reg = 0; f32x16 o[4] = {}; bf16x8 qr[8];
  const TQ* Qw = Qb + (long)(wid * QBLK + r32) * LDQ + hi * 8;
#pragma unroll
  for (int d0 = 0; d0 < 8; ++d0) { qr[d0] = SQ::tobf(SQ::ld8(Qw + d0 * 16));
    if constexpr (NOMAX) { constexpr float C = SCALE * 1.4426950408889634f; u32x4 w = *reinterpret_cast<u32x4*>(&qr[d0]);
      for (int i = 0; i < 4; ++i) w[i] = cvtpk(__uint_as_float(w[i] << 16) * C, __uint_as_float(w[i] & 0xffff0000u) * C);
      qr[d0] = *reinterpret_cast<bf16x8*>(&w); } }
  const int sr = tid >> 4, sc = (tid & 15) * 8, vst0 = v_st(sr, sc), vst1 = v_st(32 + sr, sc);
  const int vb0 = (int)(uintptr_t)V_lds + v_rd_base(lane);
  struct { typename St::T vs0, vs1, ks0, ks1; } sr_[SDEPTH];
#define SLOAD(i, k0) do { sr_[i].vs0 = St::ld8(&Vh[(long)((k0) + sr) * LDK + sc]); sr_[i].vs1 = St::ld8(&Vh[(long)((k0) + 32 + sr) * LDK + sc]); \
    sr_[i].ks0 = St::ld8(&Kh[(long)((k0) + sr) * LDK + sc]); sr_[i].ks1 = St::ld8(&Kh[(long)((k0) + 32 + sr) * LDK + sc]); } while (0)
#define SWRITE(b, voff, i) do { *(bf16x8*)((char*)V_lds + (voff) + vst0) = St::tobf(sr_[i].vs0);          \
    *(bf16x8*)((char*)V_lds + (voff) + vst1) = St::tobf(sr_[i].vs1); int kc = sc * 2;               \
    *(bf16x8*)((char*)K_lds + (b) * SHM_K + KSWZ(sr, kc)) = St::tobf(sr_[i].ks0);                       \
    *(bf16x8*)((char*)K_lds + (b) * SHM_K + KSWZ(32 + sr, kc)) = St::tobf(sr_[i].ks1); } while (0)
#define SWAIT() do { if constexpr (SDEPTH == 2) asm volatile("s_waitcnt vmcnt(4)" ::: "memory"); else asm volatile("s_waitcnt vmcnt(0)" ::: "memory"); } while (0)
#define RESC(a) do { if (!NOMAX && __any((a) < 1.f)) { if (hi == 0) al_l[r32] = (a); asm volatile("s_waitcnt lgkmcnt(0)" ::: "memory"); \
    for (int d = 0; d < 4; ++d) for (int r = 0; r < 16; ++r) o[d][r] *= al_l[crow(r, hi)]; } } while (0)
  f32x16 pA0, pA1, pB0, pB1; float mnA, mnB, alA, alB; bf16x8 pa0, pa1, pa2, pa3; const int NT = seq / KVBLK;
  constexpr int SE = 0, SO = SDEPTH - 1;
  SLOAD(SE, 0); asm volatile("s_waitcnt vmcnt(0)" ::: "memory"); SWRITE(0, 0, SE); __syncthreads();
  qkt(pA0, pA1, K_lds, qr, r32, hi); partialSM<NOMAX>(pA0, pA1, m_reg, mnA, alA);
  SLOAD(SO, KVBLK); if constexpr (SDEPTH == 2) { if (2 < NT) SLOAD(SE, 2 * KVBLK); }
  SWAIT(); SWRITE(1, (int)SHM_V, SO); __syncthreads();
  int vr = 0, vw = 2 * (int)SHM_V;
#define VNEXT(x) ((x) == 2 * (int)SHM_V ? 0 : (x) + (int)SHM_V)
  for (int j = 1; j + 1 < NT; j += 2) {
    SBAR(); qkt(pB0, pB1, (bf16*)((char*)K_lds + SHM_K), qr, r32, hi);
    finishSM(pA0, pA1, alA, l_reg, pa0, pa1, pa2, pa3); SBAR();
    SLOAD(SO, (j + SDEPTH) * KVBLK); SBAR();
    pv_d0(o, vb0 + vr, pa0, pa1, pa2, pa3); partialSM<NOMAX>(pB0, pB1, m_reg, mnB, alB);
    SWAIT(); SWRITE(0, vw, SE); vr = VNEXT(vr); vw = VNEXT(vw);
    RESC(alB); __syncthreads();
    SBAR(); qkt(pA0, pA1, K_lds, qr, r32, hi);
    finishSM(pB0, pB1, alB, l_reg, pa0, pa1, pa2, pa3); SBAR();
    if (SDEPTH == 1 || j + 3 < NT) SLOAD(SE, (j + 1 + SDEPTH) * KVBLK); SBAR();
    pv_d0(o, vb0 + vr, pa0, pa1, pa2, pa3); partialSM<NOMAX>(pA0, pA1, m_reg, mnA, alA);
    SWAIT(); SWRITE(1, vw, SO); vr = VNEXT(vr); vw = VNEXT(vw);
    RESC(alA); __syncthreads();
  }
  SBAR(); qkt(pB0, pB1, (bf16*)((char*)K_lds + SHM_K), qr, r32, hi);
  finishSM(pA0, pA1, alA, l_reg, pa0, pa1, pa2, pa3); SBAR();
  pv_d0(o, vb0 + vr, pa0, pa1, pa2, pa3); partialSM<NOMAX>(pB0, pB1, m_reg, mnB, alB);
  vr = VNEXT(vr); RESC(alB);
  finishSM(pB0, pB1, alB, l_reg, pa0, pa1, pa2, pa3); SBAR();
  pv_d0(o, vb0 + vr, pa0, pa1, pa2, pa3);
#undef VNEXT
  if (hi == 0) li_l[r32] = l_reg; asm volatile("s_waitcnt lgkmcnt(0)" ::: "memory");
  float rli[16];
#pragma unroll
  for (int r = 0; r < 16; ++r) rli[r] = __builtin_amdgcn_rcpf(li_l[crow(r, hi)]);
  bf16* Ow = Ob + (long)(wid * QBLK) * LDO;
#pragma unroll
  for (int r = 0; r < 16; ++r) { int orow = crow(r, hi);
    for (int d0 = 0; d0 < 4; ++d0) Ow[(long)orow * LDO + d0 * 32 + r32] = (bf16)(cvtpk(o[d0][r] * rli[r], 0.f) & 0xffffu); }
#undef SLOAD
#undef SWRITE
#undef SWAIT
#undef RESC
}
#undef KSWZ
#undef SBAR
}

namespace rw {
typedef short bf16x8 __attribute__((ext_vector_type(8)));
typedef float f32x4 __attribute__((ext_vector_type(4)));
typedef unsigned u32x4 __attribute__((ext_vector_type(4)));
typedef unsigned u32x2 __attribute__((ext_vector_type(2)));
constexpr int CH = 32, NC = R / CH;
static_assert(NC % 2 == 0, "the prep loop is unrolled by two");
constexpr int BUFB = 5 * 8192 + 1024;
constexpr int O_W = 0, O_B = 8192, O_KD = 16384, O_A = 24576, O_R = 32768, O_V = 40960;
constexpr int PITCH = 72;
constexpr int L_SCR = 2 * BUFB, SCRB = 2 * 16 * PITCH * 2;
constexpr int L_W2T = L_SCR + 4 * SCRB, L_A2T = L_W2T + 64 * PITCH * 2;
constexpr int L_Y = L_A2T + 64 * PITCH * 2;
constexpr int L_CST = L_Y + 2 * 2 * CH * 64 * 4;
constexpr int L_END = L_CST + 10 * 64 * 4;
static_assert(L_END <= 163840 - 64 && (BUFB % 16) == 0 && (L_SCR % 16) == 0 && (SCRB % 16) == 0 && (L_W2T % 16) == 0 && (L_A2T % 16) == 0 && (L_Y % 16) == 0 && (L_CST % 16) == 0, "rwkv LDS map");
constexpr size_t WS_BON = 15 * MiB;

template <int CTRL> __device__ __forceinline__ float dppmov(float x) { return __builtin_bit_cast(float, __builtin_amdgcn_update_dpp(0, __builtin_bit_cast(int, x), CTRL, 0xF, 0xF, true)); }
__device__ __forceinline__ float allreduce8(float x) {
    x += dppmov<0xB1>(x);
    x += dppmov<0x4E>(x);
    x += dppmov<0x141>(x);
    return x;
}
__device__ __forceinline__ float allreduce16(float x) { x = allreduce8(x); x += dppmov<0x140>(x); return x; }
__device__ __forceinline__ float fast_tanh(float x) { const float e = __builtin_amdgcn_exp2f(2.885390081777927f * x); return 1.0f - 2.0f * __builtin_amdgcn_rcpf(1.0f + e); }
__device__ __forceinline__ float bflo(unsigned u) { return __uint_as_float(u << 16); }
__device__ __forceinline__ float bfhi(unsigned u) { return __uint_as_float(u & 0xffff0000u); }
__device__ __forceinline__ unsigned pkbf(float lo, float hi) { unsigned r; asm volatile("v_cvt_pk_bf16_f32 %0, %1, %2" : "=v"(r) : "v"(lo), "v"(hi)); return r; }

constexpr int SEGR = 64, NSEG = R / SEGR, NCG = (ZW + 511) / 512;
constexpr size_t WS_HALO = 38 * MiB;
static_assert(WS_HALO + (size_t)NSEG * 2 * ZW * 2 <= WS_XN, "halo rows overflow");
__device__ __forceinline__ void shift_halo(const Params& p) {
    int tid_ = threadIdx.x; asm volatile("" : "+v"(tid_));
    const bf16_t* Z = ws_big(p); bf16_t* H = (bf16_t*)(p.ws + WS_HALO);
    for (int it = (int)blockIdx.x * NTHR + tid_; it < NSEG * 2 * (ZW / 8); it += (int)gridDim.x * NTHR) {
        const int c8 = it % (ZW / 8), w = (it / (ZW / 8)) & 1, seg = it / (2 * (ZW / 8));
        *(u32x4*)(H + ((size_t)seg * 2 + w) * ZW + c8 * 8) = *(const u32x4*)(Z + (size_t)(seg * SEGR + (w ? SEGR - 1 : 0)) * ZW + c8 * 8);
    }
}
__device__ __forceinline__ u32x4 shift8(u32x4 c, u32x4 pv, u32x4 nx, f32x4 m0, f32x4 m1) {
    u32x4 o;
#pragma unroll
    for (int q = 0; q < 4; ++q) { const float ml = q < 2 ? m0[2 * q] : m1[2 * q - 4], mh = q < 2 ? m0[2 * q + 1] : m1[2 * q - 3];
        const float zl = bflo(c[q]), zh = bfhi(c[q]);
        o[q] = pkbf(zl + (0.5f * (bflo(pv[q]) + bflo(nx[q])) - zl) * ml, zh + (0.5f * (bfhi(pv[q]) + bfhi(nx[q])) - zh) * mh); }
    return o;
}
__device__ __forceinline__ void shift_inplace(const Params& p) {
    int tid_ = threadIdx.x; asm volatile("" : "+v"(tid_));
    const int lane = tid_ & 63, gw = (int)blockIdx.x * NWAVES + (tid_ >> 6), ngw = (int)gridDim.x * NWAVES;
    bf16_t* Z = ws_big(p); const bf16_t* H = (const bf16_t*)(p.ws + WS_HALO);
    for (int u = gw; u < NSEG * NCG; u += ngw) {
        const int seg = u / NCG, col = (u % NCG) * 512 + lane * 8;
        if (col < ZW) {
            const f32x4 m0 = *(const f32x4*)(p.mu + col), m1 = *(const f32x4*)(p.mu + col + 4);
            const bool first = seg == 0 || seg == CTXN / SEGR, last = seg == CTXN / SEGR - 1 || seg == NSEG - 1;
            bf16_t* zr = Z + (size_t)seg * SEGR * ZW + col;
            u32x4 pv = first ? (u32x4){0u, 0u, 0u, 0u} : *(const u32x4*)(H + ((size_t)(seg - 1) * 2 + 1) * ZW + col);
            const u32x4 tail = last ? (u32x4){0u, 0u, 0u, 0u} : *(const u32x4*)(H + ((size_t)(seg + 1) * 2) * ZW + col);
            u32x4 c0 = *(const u32x4*)zr, c1 = *(const u32x4*)(zr + ZW), c2 = *(const u32x4*)(zr + 2 * ZW), c3 = *(const u32x4*)(zr + 3 * ZW);
            u32x4 n0 = *(const u32x4*)(zr + 4 * ZW), n1 = *(const u32x4*)(zr + 5 * ZW), n2 = *(const u32x4*)(zr + 6 * ZW), n3 = *(const u32x4*)(zr + 7 * ZW);
            for (int r = 0; r < SEGR; r += 4) {
                u32x4 m0_ = tail, m1_ = tail, m2_ = tail, m3_ = tail;
                if (r + 8 < SEGR) { m0_ = *(const u32x4*)(zr + (size_t)(r + 8) * ZW); m1_ = *(const u32x4*)(zr + (size_t)(r + 9) * ZW); m2_ = *(const u32x4*)(zr + (size_t)(r + 10) * ZW); m3_ = *(const u32x4*)(zr + (size_t)(r + 11) * ZW); }
                const u32x4 nx = (r + 4 < SEGR) ? n0 : tail;
                const u32x4 o0 = shift8(c0, pv, c1, m0, m1), o1 = shift8(c1, c0, c2, m0, m1), o2 = shift8(c2, c1, c3, m0, m1), o3 = shift8(c3, c2, nx, m0, m1);
                *(u32x4*)(zr + (size_t)r * ZW) = o0; *(u32x4*)(zr + (size_t)(r + 1) * ZW) = o1; *(u32x4*)(zr + (size_t)(r + 2) * ZW) = o2; *(u32x4*)(zr + (size_t)(r + 3) * ZW) = o3;
                pv = c3; c0 = n0; c1 = n1; c2 = n2; c3 = n3; n0 = m0_; n1 = m1_; n2 = m2_; n3 = m3_;
            }
        }
    }
}

struct Raw { u32x4 c[5]; };

template <int MODE> __device__ __forceinline__ void scan_block(const Params& p, int blk, LAS unsigned char* lds) {
    int tid_ = threadIdx.x; asm volatile("" : "+v"(tid_));
    const int tid = tid_, lane = tid & 63, wave = __builtin_amdgcn_readfirstlane(tid >> 6);
    const int dir = blk >> 7, h = (blk >> 3) & 15, eighth = blk & 7;
    const float* w0 = dir ? p.w0b : p.w0f; const float* w2 = dir ? p.w2b : p.w2f; const float* a0 = dir ? p.a0b : p.a0f; const float* a2 = dir ? p.a2b : p.a2f;
    const bf16_t* Z = ws_big(p); bf16_t* BR = ws_br(p); float* bon = (float*)(p.ws + WS_BON) + ((size_t)dir * 16 + h) * SEQ;
    { const int m = tid >> 3, j8 = (tid & 7) * 8;
      const f32x4 wa = *(const f32x4*)(w2 + (size_t)m * 1024 + h * 64 + j8), wb = *(const f32x4*)(w2 + (size_t)m * 1024 + h * 64 + j8 + 4);
      const f32x4 aa = *(const f32x4*)(a2 + (size_t)m * 1024 + h * 64 + j8), ab = *(const f32x4*)(a2 + (size_t)m * 1024 + h * 64 + j8 + 4);
      LAS bf16_t* yw = (LAS bf16_t*)(lds + L_W2T); LAS bf16_t* ya = (LAS bf16_t*)(lds + L_A2T);
#pragma unroll
      for (int q = 0; q < 4; ++q) { yw[(j8 + q) * PITCH + m] = f2bf(wa[q]); yw[(j8 + 4 + q) * PITCH + m] = f2bf(wb[q]); ya[(j8 + q) * PITCH + m] = f2bf(aa[q]); ya[(j8 + 4 + q) * PITCH + m] = f2bf(ab[q]); }
      for (int i = tid; i < 4 * SCRB / 4; i += NTHR) *(LAS unsigned*)(lds + L_SCR + i * 4) = 0u;
      for (int i = tid; i < 640; i += NTHR) { const int g = i >> 6, cc = i & 63, hc = h * 64 + cc; float v;
          if (g < 3) v = p.mu[g * 1024 + hc]; else if (g == 3) v = p.mu[3072 + dir * 64 + cc]; else if (g == 4) v = p.mu[3200 + dir * 64 + cc];
          else if (g == 5) v = w0[hc]; else if (g == 6) v = a0[hc]; else if (g == 7) v = p.k_k[hc]; else if (g == 8) v = p.k_a[hc]; else v = p.r_k[hc];
          *(LAS float*)(lds + L_CST + i * 4) = v; } }
    __syncthreads();
    if ((wave & 2) != 0) {
        const int pw = (wave & 1) + ((wave >> 2) << 1), tq = lane >> 3, c8 = (lane & 7) * 8, hj = h * 64 + c8, tslot = pw * 8 + tq;
        const int gcol[5] = {hj, 1024 + hj, 2048 + hj, 3072 + dir * 64 + c8, 3200 + dir * 64 + c8};
        LAS unsigned char* scr = lds + L_SCR + pw * SCRB;
#define RW_CST(g, hh) (*(LAS f32x4*)(lds + L_CST + ((g) * 64 + c8 + 4 * (hh)) * 4))
#define RW_LOADRAW(raw, cc) do { const bf16_t* zr_ = Z + (size_t)rw_row(dir, (cc) * CH + tslot) * ZW; \
            _Pragma("unroll") for (int g = 0; g < 5; ++g) raw.c[g] = *(const u32x4*)(zr_ + gcol[g]); } while (0)
        Raw rawA, rawB;
        f32x4 cw0[2], ca0[2], ckk[2], cka[2], crk[2];
#pragma unroll
        for (int hh = 0; hh < 2; ++hh) { cw0[hh] = RW_CST(5, hh); ca0[hh] = RW_CST(6, hh); ckk[hh] = RW_CST(7, hh); cka[hh] = RW_CST(8, hh); crk[hh] = RW_CST(9, hh);
            asm volatile("" : "+v"(cw0[hh]), "+v"(ca0[hh]), "+v"(ckk[hh]), "+v"(cka[hh]), "+v"(crk[hh])); }
        if (MODE == 0 || MODE == 2 || MODE == 3 || MODE == 9) { RW_LOADRAW(rawA, 0); RW_LOADRAW(rawB, 1); }
#define RW_PREP_ITER(RAWSET, cc_) do { \
            if (MODE == 0 || MODE == 2 || MODE == 3 || MODE == 9) { \
            const int cn = (cc_) + 1; LAS unsigned char* buf = lds + (cn & 1) * BUFB; const int p0 = cn * CH; const bool latent = p0 >= CTXN; \
            f32x4 rr[2], kv[2]; \
            { const u32x4 u = RAWSET.c[0]; rr[0] = (f32x4){bflo(u.x), bfhi(u.x), bflo(u.y), bfhi(u.y)}; rr[1] = (f32x4){bflo(u.z), bfhi(u.z), bflo(u.w), bfhi(u.w)}; \
              *(LAS f32x4*)(buf + O_R + (tslot * 64 + c8) * 4) = rr[0]; *(LAS f32x4*)(buf + O_R + (tslot * 64 + c8) * 4 + 16) = rr[1]; } \
            { const u32x4 u = RAWSET.c[1]; kv[0] = (f32x4){bflo(u.x), bfhi(u.x), bflo(u.y), bfhi(u.y)}; kv[1] = (f32x4){bflo(u.z), bfhi(u.z), bflo(u.w), bfhi(u.w)}; } \
            if ((lane & 7) == eighth) { const u32x4 u = RAWSET.c[2]; *(LAS f32x4*)(buf + O_V + tslot * 32) = (f32x4){bflo(u.x), bfhi(u.x), bflo(u.y), bfhi(u.y)}; *(LAS f32x4*)(buf + O_V + tslot * 32 + 16) = (f32x4){bflo(u.z), bfhi(u.z), bflo(u.w), bfhi(u.w)}; } \
            { const u32x4 u = RAWSET.c[3]; u32x4 o; \
              o.x = pkbf(fast_tanh(bflo(u.x)), fast_tanh(bfhi(u.x))); o.y = pkbf(fast_tanh(bflo(u.y)), fast_tanh(bfhi(u.y))); o.z = pkbf(fast_tanh(bflo(u.z)), fast_tanh(bfhi(u.z))); o.w = pkbf(fast_tanh(bflo(u.w)), fast_tanh(bfhi(u.w))); \
              *(LAS u32x4*)(scr + (tq * PITCH + c8) * 2) = o; *(LAS u32x4*)(scr + 16 * PITCH * 2 + (tq * PITCH + c8) * 2) = RAWSET.c[4]; } \
            if (cn + 2 < NC) RW_LOADRAW(RAWSET, cn + 2);              \
            asm volatile("s_waitcnt lgkmcnt(0)" ::: "memory"); \
            { const int r16 = lane & 15, quad = lane >> 4; f32x4 acc[2][4]; \
_Pragma("unroll") \
              for (int lora = 0; lora < 2; ++lora) { \
                  LAS unsigned char* X = scr + lora * 16 * PITCH * 2 + (r16 * PITCH + quad * 8) * 2; \
                  const bf16x8 x0 = *(LAS bf16x8*)X, x1 = *(LAS bf16x8*)(X + 64); \
_Pragma("unroll") \
                  for (int jt = 0; jt < 4; ++jt) { \
                      LAS unsigned char* Y = lds + (lora ? L_A2T : L_W2T) + ((jt * 16 + r16) * PITCH + quad * 8) * 2; \
                      acc[lora][jt] = (f32x4){0.f, 0.f, 0.f, 0.f}; \
                      acc[lora][jt] = __builtin_amdgcn_mfma_f32_16x16x32_bf16(x0, *(LAS bf16x8*)Y, acc[lora][jt], 0, 0, 0); \
                      acc[lora][jt] = __builtin_amdgcn_mfma_f32_16x16x32_bf16(x1, *(LAS bf16x8*)(Y + 64), acc[lora][jt], 0, 0, 0); } } \
              if (quad < 2) { \
_Pragma("unroll") \
                  for (int lora = 0; lora < 2; ++lora) \
_Pragma("unroll") \
                      for (int jt = 0; jt < 4; ++jt) \
_Pragma("unroll") \
                          for (int r = 0; r < 4; ++r) *(LAS float*)(buf + (lora ? O_B : O_W) + ((pw * 8 + quad * 4 + r) * 64 + jt * 16 + r16) * 4) = acc[lora][jt][r]; } } \
            asm volatile("s_waitcnt lgkmcnt(0)" ::: "memory"); \
            { float bs = 0.f, nn = 0.f; f32x4 kk[2], al[2]; \
_Pragma("unroll") \
              for (int hh = 0; hh < 2; ++hh) { const int off = (tslot * 64 + c8 + 4 * hh) * 4; \
                  const f32x4 aw = *(LAS f32x4*)(buf + O_W + off) + cw0[hh], aa = *(LAS f32x4*)(buf + O_B + off) + ca0[hh]; \
                  f32x4 wv; \
_Pragma("unroll") \
                  for (int q = 0; q < 4; ++q) { const float sg = __builtin_amdgcn_rcpf(1.0f + __builtin_amdgcn_exp2f(-1.4426950408889634f * aw[q])); \
                      wv[q] = __builtin_amdgcn_exp2f(-0.8750612633917f * sg); al[hh][q] = __builtin_amdgcn_rcpf(1.0f + __builtin_amdgcn_exp2f(-1.4426950408889634f * aa[q])); kk[hh][q] = kv[hh][q] * ckk[hh][q]; nn += kk[hh][q] * kk[hh][q]; } \
                  *(LAS f32x4*)(buf + O_W + off) = wv; } \
              nn = allreduce8(nn); \
              const float inv = __builtin_amdgcn_rsqf(fmaxf(nn, 1e-24f)); \
_Pragma("unroll") \
              for (int hh = 0; hh < 2; ++hh) { const int off = (tslot * 64 + c8 + 4 * hh) * 4; \
                  const f32x4 r = rr[hh]; \
                  f32x4 av, bv, kd; \
_Pragma("unroll") \
                  for (int q = 0; q < 4; ++q) { const float kn = kk[hh][q] * inv; av[q] = -kn; bv[q] = kn * al[hh][q]; kd[q] = kv[hh][q] * (1.0f + (al[hh][q] - 1.0f) * cka[hh][q]); bs += r[q] * kd[q] * crk[hh][q]; } \
                  *(LAS f32x4*)(buf + O_B + off) = bv; *(LAS f32x4*)(buf + O_KD + off) = kd; *(LAS f32x4*)(buf + O_A + off) = av; } \
              bs = allreduce8(bs); \
              if (MODE == 0 && latent && eighth == 0 && (lane & 7) == 0) bon[rw_row(dir, p0 + tslot) - CTXN] = bs; } \
            } \
            __syncthreads(); \
        } while (0)
        for (int c = -1; c < NC - 1; c += 2) { RW_PREP_ITER(rawA, c); RW_PREP_ITER(rawB, c + 1); }
#undef RW_PREP_ITER
#undef RW_LOADRAW
#undef RW_CST
    } else if (wave >= 4) {
        const int sw = wave - 4, et = lane >> 1, erp = lane & 1;
#define RW_EMIT(cc) do { if ((cc) * CH >= CTXN) { const LAS f32x4* yp = (const LAS f32x4*)(lds + L_Y + ((((cc) & 1) * 2 + sw) * 8192) + et * 256 + erp * 128); \
            f32x4 s0 = yp[0] + yp[1] + yp[2] + yp[3], s1 = yp[4] + yp[5] + yp[6] + yp[7]; \
            *(unsigned*)(BR + (size_t)rw_row(dir, (cc) * CH + et) * 2048 + dir * 1024 + h * 64 + eighth * 8 + sw * 4 + erp * 2) = pkbf((s0[0] + s0[1]) + (s0[2] + s0[3]), (s1[0] + s1[1]) + (s1[2] + s1[3])); } } while (0)
        __syncthreads();
        for (int c = 0; c < NC; ++c) { if (c >= 1) RW_EMIT(c - 1); if (c + 1 < NC) __syncthreads(); }
    } else {
        __builtin_amdgcn_s_setprio(0);
        typedef float f32x2 __attribute__((ext_vector_type(2)));
        f32x2 S01 = {0.f, 0.f}, S23 = {0.f, 0.f};
        const int srow = wave * 4 + (lane >> 4), sj = (lane & 15) * 4;
        __syncthreads();
        struct Ops { f32x4 a, w, b, k, r; float v; };
#define RW_LD(o, t) do { o.a = *(LAS f32x4*)(bp + O_A + (t) * 256); \
            if (MODE == 9) { o.w = o.a; o.b = o.a; o.k = o.a; o.r = o.a; o.v = o.a[0]; } else { o.w = *(LAS f32x4*)(bp + O_W + (t) * 256); o.b = *(LAS f32x4*)(bp + O_B + (t) * 256); \
            o.k = *(LAS f32x4*)(bp + O_KD + (t) * 256); o.r = *(LAS f32x4*)(bp + O_R + (t) * 256); o.v = *(LAS float*)(vp + (t) * 32); } } while (0)
#define RW_STEP(o, t) do { f32x2 pd = S01 * o.a.lo; pd = S23 * o.a.hi + pd; float sa = pd.x + pd.y; if (MODE != 5 && MODE != 7) sa = allreduce16(sa); \
            S01 = o.b.lo * sa + (S01 * o.w.lo + o.k.lo * o.v); S23 = o.b.hi * sa + (S23 * o.w.hi + o.k.hi * o.v); \
            { f32x2 py = S01 * o.r.lo; py = S23 * o.r.hi + py; *(LAS float*)(yb + (t) * 256) = py.x + py.y; } } while (0)
        for (int c = 0; c < NC; ++c) {
            LAS unsigned char* bp = lds + (c & 1) * BUFB + sj * 4; LAS unsigned char* vp = lds + (c & 1) * BUFB + O_V + srow * 4; LAS unsigned char* yb = lds + L_Y + ((c & 1) * 2 + wave) * 8192 + lane * 4;
            Ops A0, A1, A2, A3, B0, B1, B2, B3;
            if (MODE != 2) {
            RW_LD(A0, 0); RW_LD(A1, 1); RW_LD(A2, 2); RW_LD(A3, 3);
#pragma unroll
            for (int g = 0; g < CH / 8; ++g) {
                RW_LD(B0, 8 * g + 4); RW_LD(B1, 8 * g + 5); RW_LD(B2, 8 * g + 6); RW_LD(B3, 8 * g + 7);
                __builtin_amdgcn_sched_barrier(0);
                RW_STEP(A0, 8 * g); RW_STEP(A1, 8 * g + 1); RW_STEP(A2, 8 * g + 2); RW_STEP(A3, 8 * g + 3);
                __builtin_amdgcn_sched_barrier(0);
                if (g + 1 < CH / 8) { RW_LD(A0, 8 * g + 8); RW_LD(A1, 8 * g + 9); RW_LD(A2, 8 * g + 10); RW_LD(A3, 8 * g + 11); }
                __builtin_amdgcn_sched_barrier(0);
                RW_STEP(B0, 8 * g + 4); RW_STEP(B1, 8 * g + 5); RW_STEP(B2, 8 * g + 6); RW_STEP(B3, 8 * g + 7);
                __builtin_amdgcn_sched_barrier(0);
            }
            }
            if (c + 1 < NC) __syncthreads();
        }
#undef RW_LD
#undef RW_STEP
        if (MODE != 0) asm volatile("" :: "v"(S01), "v"(S23));
        __builtin_amdgcn_s_setprio(0);
    }
    __syncthreads();
    if (wave == 4 || wave == 5) { const int sw = wave - 4, et = lane >> 1, erp = lane & 1; RW_EMIT(NC - 1); }
#undef RW_EMIT
    __syncthreads();
}

__device__ __forceinline__ float wave_sum(float v) {
    v = allreduce16(v);
    { auto r = __builtin_amdgcn_permlane16_swap(__float_as_uint(v), __float_as_uint(v), false, false); v = __uint_as_float(r[0]) + __uint_as_float(r[1]); }
    { auto r = __builtin_amdgcn_permlane32_swap(__float_as_uint(v), __float_as_uint(v), false, false); v = __uint_as_float(r[0]) + __uint_as_float(r[1]); }
    return v;
}
__device__ __forceinline__ void finish_phase(const Params& p) {
    int tid_ = threadIdx.x; asm volatile("" : "+v"(tid_));
    const int lane = tid_ & 63, gw = (int)blockIdx.x * NWAVES + (tid_ >> 6), ngw = (int)gridDim.x * NWAVES;
    const bf16_t* Z = ws_big(p); bf16_t* BR = ws_br(p); const float* bon = (const float*)(p.ws + WS_BON);
    for (int it = gw; it < SEQ * 4; it += ngw) {
        const int t = it >> 2, h = (it & 3) * 4 + (lane >> 4), row = CTXN + t, col = h * 64 + (lane & 15) * 4;
        bf16_t* b = BR + (size_t)row * 2048;
        const u32x2 wf = *(const u32x2*)(b + col), wb = *(const u32x2*)(b + 1024 + col), zv = *(const u32x2*)(Z + (size_t)row * ZW + 2048 + col);
        const f32x4 x = {bflo(wf.x) + bflo(wb.x), bfhi(wf.x) + bfhi(wb.x), bflo(wf.y) + bflo(wb.y), bfhi(wf.y) + bfhi(wb.y)};
        const float mean = allreduce16((x[0] + x[1]) + (x[2] + x[3])) * (1.0f / 64.f);
        const f32x4 d = x - mean;
        const float var = allreduce16((d[0] * d[0] + d[1] * d[1]) + (d[2] * d[2] + d[3] * d[3])) * (1.0f / 64.f);
        const float rstd = __builtin_amdgcn_rsqf(var + GN_EPS), bsum = bon[(size_t)h * SEQ + t] + bon[((size_t)16 + h) * SEQ + t];
        const f32x4 g = *(const f32x4*)(p.lnx_g + col), bb = *(const f32x4*)(p.lnx_b + col), v = {bflo(zv.x), bfhi(zv.x), bflo(zv.y), bfhi(zv.y)};
        const f32x4 y = d * rstd * g + bb + v * bsum;
        u32x2 o; o.x = pkbf(y[0], y[1]); o.y = pkbf(y[2], y[3]);
        *(u32x2*)(b + 1024 + col) = o;
    }
}
}

namespace wy {
typedef short bf16x4 __attribute__((ext_vector_type(4)));
using rw::f32x4; using rw::u32x4; using rw::u32x2; using rw::bf16x8; using rw::bflo; using rw::bfhi; using rw::PITCH;
typedef float f32x2_t __attribute__((ext_vector_type(2)));
typedef __bf16 bf2_t __attribute__((ext_vector_type(2)));
__device__ __forceinline__ unsigned pkbf(float lo, float hi) { const f32x2_t v = {lo, hi}; return __builtin_bit_cast(unsigned, __builtin_convertvector(v, bf2_t)); }
typedef GAS unsigned gu32;
#define WY_RLX __ATOMIC_RELAXED, __HIP_MEMORY_SCOPE_AGENT
constexpr int NJOB = R / 64, NCHUNK = R / 16, NSLOT = 8, ATP = 144, REC = 13056, JOBB = 4 * REC;
static_assert(R % 64 == 0 && CTXN % 64 == 0 && (R / 64) % 2 == 0, "jobs are 64 tokens; the loader is unrolled by two jobs");
constexpr int R_AT = 0, R_RT = 2304, R_BK = 4608, R_VT = 8704, R_AAK = 10752, R_TT = 11264, R_ARBK = 11776, R_WL = 12800;
__device__ __forceinline__ int permj(int j) { return (j >> 5) * 32 + ((j >> 2) & 3) * 8 + ((j >> 4) & 1) * 4 + (j & 3); }
constexpr int C_SLOTS = 3, C_SYNC = C_SLOTS * JOBB;
static_assert(C_SYNC + 64 <= 163840 - 64 && (JOBB / 4) % 16 == 0, "consumer LDS map");
constexpr size_t WS_RING = WS_WB;
constexpr size_t RING_TOTAL = (size_t)32 * NSLOT * JOBB;
static_assert(WS_RING + RING_TOTAL <= rw::WS_BON && rw::WS_BON + (size_t)2 * 16 * SEQ * 4 <= WS_WB + (size_t)EVEN_IN * DM * 2 + (size_t)DM * 2048 * 2, "ring | bonus scalars inside layer 0's weight copies");
constexpr size_t WS_WYF = 256 * 1024 + 16384;
constexpr int WYF_ACK = 32 * NSLOT * 64, WYF_ABORT = WYF_ACK + 32 * 64, WYF_WORDS = WYF_ABORT + 64;
constexpr unsigned SPIN_CAP = 1u << 17;
constexpr int P_A = 0, P_B = 16384, P_KD = 32768, P_LW = 49152, P_IMG = 65536, P_BRM = P_IMG + JOBB, P_KRM = P_BRM + 8192, P_AAB = P_KRM + 8192, P_W2T = P_AAB + 4096, P_A2T = P_W2T + 64 * PITCH * 2, P_END = P_A2T + 64 * PITCH * 2;
constexpr int P_SCR = P_BRM, SCRW = 2 * 8 * PITCH * 2;
constexpr int P_CST = P_IMG;
static_assert(P_END <= 163840 - 64 && P_SCR + 8 * SCRW + 8 * PITCH * 2 <= P_W2T, "wy LDS map");

__device__ __forceinline__ bf16x4 pack4(f32x4 v) { u32x2 r; r.x = pkbf(v[0], v[1]); r.y = pkbf(v[2], v[3]); return __builtin_bit_cast(bf16x4, r); }
__device__ __forceinline__ f32x4 mm(u32x2 a, bf16x4 b, f32x4 c) { return __builtin_amdgcn_mfma_f32_16x16x16bf16_1k(__builtin_bit_cast(bf16x4, a), b, c, 0, 0, 0); }
__device__ __forceinline__ f32x4 mm(u32x2 a, u32x2 b, f32x4 c) { return __builtin_amdgcn_mfma_f32_16x16x16bf16_1k(__builtin_bit_cast(bf16x4, a), __builtin_bit_cast(bf16x4, b), c, 0, 0, 0); }
__device__ __forceinline__ void wait_ge(gu32* word, unsigned want, gu32* abortw, int lane) {
    for (unsigned spins = 0;;) {
        unsigned v = 0u; if (lane == 0) v = __hip_atomic_load(word, WY_RLX);
        if ((unsigned)__builtin_amdgcn_readfirstlane(v) >= want) return;
        __builtin_amdgcn_s_sleep(1);
        if ((++spins & 255u) == 0u) { unsigned a = 0u; if (lane == 0) a = __hip_atomic_load(abortw, WY_RLX);
            if (__builtin_amdgcn_readfirstlane(a)) return;
            if (spins > SPIN_CAP) { if (lane == 0) __hip_atomic_store(abortw, 1u, WY_RLX); return; } }
    }
}

__device__ __forceinline__ void wait_ge4(gu32* words, unsigned want, gu32* abortw, int lane) {
    for (unsigned spins = 0;;) {
        unsigned v = 0xffffffffu; if (lane < 4) v = __hip_atomic_load(words + lane, WY_RLX);
        const unsigned v0 = (unsigned)__builtin_amdgcn_readlane((int)v, 0), v1 = (unsigned)__builtin_amdgcn_readlane((int)v, 1), v2 = (unsigned)__builtin_amdgcn_readlane((int)v, 2), v3 = (unsigned)__builtin_amdgcn_readlane((int)v, 3);
        const unsigned m01 = v0 < v1 ? v0 : v1, m23 = v2 < v3 ? v2 : v3;
        if ((m01 < m23 ? m01 : m23) >= want) return;
        __builtin_amdgcn_s_sleep(1);
        if ((++spins & 255u) == 0u) { unsigned a = 0u; if (lane == 0) a = __hip_atomic_load(abortw, WY_RLX);
            if (__builtin_amdgcn_readfirstlane(a)) return;
            if (spins > SPIN_CAP) { if (lane == 0) __hip_atomic_store(abortw, 1u, WY_RLX); return; } }
    }
}

struct Frag { u32x4 a01, a23, r01, r23, bk[4], arbk; u32x2 vT, aak, tt; f32x4 wl[4]; };

__device__ __forceinline__ void wait_lds_min4(LAS unsigned* w, unsigned want, gu32* abortw, int lane) {
    for (unsigned spins = 0;;) {
        const unsigned a = __hip_atomic_load(w, __ATOMIC_RELAXED, __HIP_MEMORY_SCOPE_WORKGROUP), b = __hip_atomic_load(w + 1, __ATOMIC_RELAXED, __HIP_MEMORY_SCOPE_WORKGROUP),
                       c = __hip_atomic_load(w + 2, __ATOMIC_RELAXED, __HIP_MEMORY_SCOPE_WORKGROUP), d = __hip_atomic_load(w + 3, __ATOMIC_RELAXED, __HIP_MEMORY_SCOPE_WORKGROUP);
        const unsigned m0 = a < b ? a : b, m1 = c < d ? c : d;
        if ((unsigned)__builtin_amdgcn_readfirstlane((int)(m0 < m1 ? m0 : m1)) >= want) return;
        __builtin_amdgcn_s_sleep(1);
        if ((++spins & 1023u) == 0u) { unsigned ab = 0u; if (lane == 0) ab = __hip_atomic_load(abortw, WY_RLX);
            if (__builtin_amdgcn_readfirstlane(ab)) return;
            if (spins > (SPIN_CAP << 3)) { if (lane == 0) __hip_atomic_store(abortw, 1u, WY_RLX); return; } }
    }
}
template <int MODE> __device__ __forceinline__ void loader(const Params& p, int chain, int lw, int lane, LAS unsigned char* lds) {
    gu32* wf = (gu32*)(p.ws + WS_WYF); gu32* flags = wf + chain * NSLOT * 64; gu32* ackw = wf + WYF_ACK + chain * 64; gu32* abortw = wf + WYF_ABORT;
    LAS unsigned* loaded = (LAS unsigned*)(lds + C_SYNC); LAS unsigned* done = loaded + 4;
    const __amdgpu_buffer_rsrc_t ring_rsrc = __builtin_amdgcn_make_buffer_rsrc((void*)(p.ws + WS_RING), 0, (int)RING_TOTAL, 0x00020000);
    constexpr int QB = JOBB / 4, NIT = (QB / 16 + 63) / 64, TAIL = QB / 16 - (NIT - 1) * 64;
    static_assert(NIT == 13, "the counted waits below assume 13 loads per set");
    u32x4 va[NIT], vb[NIT];
#define WY_ISSUE(v, g_) do { if (MODE < 2) wait_ge(flags + ((g_) % NSLOT) * 64, (unsigned)(g_) + 1u, abortw, lane); \
        const int soff = (chain * NSLOT + (g_) % NSLOT) * JOBB + lw * QB + lane * 16; \
        _Pragma("unroll") for (int k = 0; k < NIT; ++k) if (MODE == 0 && (k < NIT - 1 || lane < TAIL)) v[k] = __builtin_amdgcn_raw_buffer_load_b128(ring_rsrc, soff + k * 1024, 0, 16); } while (0)
#define WY_COMMIT(v, g_, WAITSTR) do { \
        if (MODE != 1 && (g_) >= C_SLOTS) { wait_lds_min4(done, (unsigned)((g_) - C_SLOTS + 1), abortw, lane); __builtin_amdgcn_fence(__ATOMIC_ACQUIRE, "workgroup"); }     \
        asm volatile(WAITSTR ::: "memory");                                                     \
        LAS unsigned char* dst = lds + ((g_) % C_SLOTS) * JOBB + lw * QB + lane * 16; \
        _Pragma("unroll") for (int k = 0; k < NIT; ++k) if (MODE == 0 && (k < NIT - 1 || lane < TAIL)) *(LAS u32x4*)(dst + k * 1024) = v[k]; \
        asm volatile("s_waitcnt lgkmcnt(0)" ::: "memory"); \
        __builtin_amdgcn_fence(__ATOMIC_RELEASE, "workgroup"); \
        if (lane == 0) { __hip_atomic_store(ackw + lw, (unsigned)(g_) + 1u, WY_RLX); __hip_atomic_store(loaded + lw, (unsigned)(g_) + 1u, __ATOMIC_RELAXED, __HIP_MEMORY_SCOPE_WORKGROUP); } } while (0)
    WY_ISSUE(va, 0);
    for (int g = 0; g < NJOB; g += 2) {
        WY_ISSUE(vb, g + 1); WY_COMMIT(va, g, "s_waitcnt vmcnt(13)");
        if (g + 2 < NJOB) { WY_ISSUE(va, g + 2); WY_COMMIT(vb, g + 1, "s_waitcnt vmcnt(13)"); } else WY_COMMIT(vb, g + 1, "s_waitcnt vmcnt(0)");
    }
#undef WY_ISSUE
#undef WY_COMMIT
}
__device__ __forceinline__ bf16x8 cat(u32x2 a, u32x2 b) { const u32x4 v = {a.x, a.y, b.x, b.y}; return __builtin_bit_cast(bf16x8, v); }
__device__ __forceinline__ u32x2 pack4u(f32x4 v) { u32x2 r; r.x = pkbf(v[0], v[1]); r.y = pkbf(v[2], v[3]); return r; }
__device__ __forceinline__ f32x4 mm32(bf16x8 a, bf16x8 b, f32x4 c) { return __builtin_amdgcn_mfma_f32_16x16x32_bf16(a, b, c, 0, 0, 0); }
template <int MODE> __device__ __forceinline__ void consumer(const Params& p, int chain, int wave, int lane, LAS unsigned char* lds) {
    const int n = lane & 15, q = lane >> 4, dir = chain >> 4, h = chain & 15;
    gu32* abortw = (gu32*)(p.ws + WS_WYF) + WYF_ABORT;
    LAS unsigned* loaded = (LAS unsigned*)(lds + C_SYNC); LAS unsigned* done = loaded + 4;
    f32x4 S0 = {0.f, 0.f, 0.f, 0.f}, S1 = S0, S2 = S0, S3 = S0;
    const int offA = n * ATP + 16 * q, offB = n * 32 + 8 * q, offW = 16 * q, offS = n * 64 + ((q ^ ((n >> 2) & 3)) * 16);
    const long rstep = dir ? -2048 : 2048;
    bf16_t* yq = ws_br(p) + (size_t)(CTXN + (dir ? SEQ - 1 - 4 * q : 4 * q)) * 2048 + dir * 1024 + h * 64 + 16 * wave + n;
#define WY_LOAD(F, base, k) do { \
        F.a01 = *(const LAS u32x4*)(base + offA + (k) * REC + R_AT); F.a23 = *(const LAS u32x4*)(base + offA + (k) * REC + R_AT + 64); \
        F.r01 = *(const LAS u32x4*)(base + offA + (k) * REC + R_RT); F.r23 = *(const LAS u32x4*)(base + offA + (k) * REC + R_RT + 64); \
        _Pragma("unroll") for (int jt = 0; jt < 4; ++jt) { F.bk[jt] = *(const LAS u32x4*)(base + offS + (k) * REC + R_BK + 1024 * jt); F.wl[jt] = *(const LAS f32x4*)(base + offW + (k) * REC + R_WL + 64 * jt); } \
        F.arbk = *(const LAS u32x4*)(base + offS + (k) * REC + R_ARBK); \
        F.vT = *(const LAS u32x2*)(base + offB + (k) * REC + R_VT + 512 * wave); F.aak = *(const LAS u32x2*)(base + offB + (k) * REC + R_AAK); F.tt = *(const LAS u32x2*)(base + offB + (k) * REC + R_TT); } while (0)
#define WY_Q(v) __builtin_bit_cast(bf16x8, v)
#define WY_COMPUTE(F, cidx) do { const f32x4 z0_ = {0.f, 0.f, 0.f, 0.f}; const u32x2 zz_ = {0u, 0u};     \
        f32x4 Z = mm32(cat(F.aak, zz_), cat(F.vT, zz_), z0_); \
        const bf16x8 s01 = cat(pack4u(S0), pack4u(S1)), s23 = cat(pack4u(S2), pack4u(S3)); \
        Z = mm32(WY_Q(F.a01), s01, Z); Z = mm32(WY_Q(F.a23), s23, Z);     \
        f32x4 Y = mm32(WY_Q(F.r01), s01, z0_); Y = mm32(WY_Q(F.r23), s23, Y); \
        const u32x2 zb = pack4u(Z); const f32x4 U = mm32(cat(F.tt, zz_), cat(zb, zz_), z0_); const u32x2 ub = pack4u(U); \
        const bf16x8 vu = cat(F.vT, ub); \
        Y = mm32(WY_Q(F.arbk), vu, Y); \
        S0 = mm32(WY_Q(F.bk[0]), vu, S0); S1 = mm32(WY_Q(F.bk[1]), vu, S1); S2 = mm32(WY_Q(F.bk[2]), vu, S2); S3 = mm32(WY_Q(F.bk[3]), vu, S3); \
        S0 *= F.wl[0]; S1 *= F.wl[1]; S2 *= F.wl[2]; S3 *= F.wl[3]; \
        if (MODE == 0 && (cidx) * 16 >= CTXN) { const unsigned y01 = pkbf(Y[0], Y[1]), y23 = pkbf(Y[2], Y[3]); bf16_t* yp_ = yq + (long)((cidx) * 16 - CTXN) * rstep; \
            *(unsigned short*)yp_ = (unsigned short)(y01 & 0xffffu); *(unsigned short*)(yp_ + rstep) = (unsigned short)(y01 >> 16); \
            *(unsigned short*)(yp_ + 2 * rstep) = (unsigned short)(y23 & 0xffffu); *(unsigned short*)(yp_ + 3 * rstep) = (unsigned short)(y23 >> 16); } } while (0)
    Frag FA, FB;
    wait_lds_min4(loaded, 1u, abortw, lane); __builtin_amdgcn_fence(__ATOMIC_ACQUIRE, "workgroup");
    int slot = 0;
    { const LAS unsigned char* b0 = lds; WY_LOAD(FA, b0, 0); if (MODE == 3) WY_LOAD(FB, b0, 1); }
    for (int g = 0; g < NJOB; ++g) {
        const LAS unsigned char* base = lds + slot * JOBB;
        if (MODE != 3) WY_LOAD(FB, base, 1); WY_COMPUTE(FA, 4 * g);
        if (MODE != 3) WY_LOAD(FA, base, 2); WY_COMPUTE(FB, 4 * g + 1);
        if (MODE != 3) WY_LOAD(FB, base, 3); WY_COMPUTE(FA, 4 * g + 2);
        slot = slot == C_SLOTS - 1 ? 0 : slot + 1;
        if (g + 1 < NJOB) { wait_lds_min4(loaded, (unsigned)g + 2u, abortw, lane); __builtin_amdgcn_fence(__ATOMIC_ACQUIRE, "workgroup");
            const LAS unsigned char* nb = lds + slot * JOBB; if (MODE != 3) WY_LOAD(FA, nb, 0); }
        WY_COMPUTE(FB, 4 * g + 3);
        asm volatile("s_waitcnt lgkmcnt(0)" ::: "memory");
        __builtin_amdgcn_fence(__ATOMIC_RELEASE, "workgroup");
        if (lane == 0) __hip_atomic_store(done + wave, (unsigned)g + 1u, __ATOMIC_RELAXED, __HIP_MEMORY_SCOPE_WORKGROUP);
    }
#undef WY_LOAD
#undef WY_COMPUTE
#undef WY_Q
    if (MODE != 0) asm volatile("" :: "v"(S0), "v"(S1), "v"(S2), "v"(S3));
}

template <int HALF> __device__ __forceinline__ void stage2(LAS unsigned char* lds, LAS unsigned char* img, int ch, int j) {
    LAS unsigned char* rec = img + ch * REC;
    const LAS float* LW = (const LAS float*)(lds + P_LW) + (ch * 16) * 64 + j;
    const LAS float* XA = (const LAS float*)(lds + (HALF ? P_KD : P_A)) + (ch * 16) * 64 + j;
    const LAS float* XB = (const LAS float*)(lds + P_B) + (ch * 16) * 64 + j;
    LAS unsigned short* rowm0 = (LAS unsigned short*)(rec + (HALF ? R_RT : R_AT)) + permj(j);
    LAS unsigned short* rowm1 = (LAS unsigned short*)(lds + (HALF ? P_KRM : P_BRM) + ch * 2048) + permj(j);
    float lw[16], s0[16], s1[16];
#pragma unroll
    for (int t = 0; t < 16; ++t) { lw[t] = LW[t * 64]; s1[t] = HALF ? XA[t * 64] : XB[t * 64];
        if (HALF) s0[t] = __uint_as_float((unsigned)rowm0[t * (ATP / 2)] << 16); else s0[t] = XA[t * 64]; }
    float cum = 0.f, x0p = 0.f, x1p = 0.f; unsigned tp[8];
#pragma unroll
    for (int t = 0; t < 16; ++t) {
        const float cprev = cum; cum += lw[t];
        const float x0 = s0[t] * __builtin_amdgcn_exp2f(HALF ? cum : cprev), x1 = s1[t] * __builtin_amdgcn_exp2f(-cum);
        if (t & 1) { const unsigned p0 = pkbf(x0p, x0), p1 = pkbf(x1p, x1);
            rowm0[(t - 1) * (ATP / 2)] = (unsigned short)(p0 & 0xffffu); rowm0[t * (ATP / 2)] = (unsigned short)(p0 >> 16);
            rowm1[(t - 1) * 64] = (unsigned short)(p1 & 0xffffu); rowm1[t * 64] = (unsigned short)(p1 >> 16);
            tp[t >> 1] = p1; }
        x0p = x0; x1p = x1; }
    { LAS unsigned char* bkr = rec + R_BK + j * 64 + (HALF ? 0 : 8); const int sw = (j >> 2) & 3;
#pragma unroll
      for (int qq = 0; qq < 4; ++qq) *(LAS u32x2*)(bkr + ((qq ^ sw) * 16)) = (u32x2){tp[2 * qq], tp[2 * qq + 1]}; }
    if (HALF) *(LAS float*)(rec + R_WL + j * 4) = __builtin_amdgcn_exp2f(cum);
}

template <int SKIP> __device__ __forceinline__ void producer(const Params& p, int chain, int first, int step, LAS unsigned char* lds) {
    int tid_ = threadIdx.x; asm volatile("" : "+v"(tid_));
    const int tid = tid_, lane = tid & 63, wave = __builtin_amdgcn_readfirstlane(tid >> 6);
    const int dir = chain >> 4, h = chain & 15;
    const float* w0 = dir ? p.w0b : p.w0f; const float* w2 = dir ? p.w2b : p.w2f; const float* a0 = dir ? p.a0b : p.a0f; const float* a2 = dir ? p.a2b : p.a2f;
    const bf16_t* Z = ws_big(p); float* bon = (float*)(p.ws + rw::WS_BON) + ((size_t)dir * 16 + h) * SEQ;
    gu32* wf = (gu32*)(p.ws + WS_WYF); gu32* flags = wf + chain * NSLOT * 64; gu32* ackw = wf + WYF_ACK + chain * 64; gu32* abortw = wf + WYF_ABORT;
    const __amdgpu_buffer_rsrc_t ring_rsrc = __builtin_amdgcn_make_buffer_rsrc((void*)(p.ws + WS_RING), 0, (int)RING_TOTAL, 0x00020000);
    { const int m = tid >> 3, j8 = (tid & 7) * 8;
      const f32x4 wa = *(const f32x4*)(w2 + (size_t)m * 1024 + h * 64 + j8), wb = *(const f32x4*)(w2 + (size_t)m * 1024 + h * 64 + j8 + 4);
      const f32x4 aa = *(const f32x4*)(a2 + (size_t)m * 1024 + h * 64 + j8), ab = *(const f32x4*)(a2 + (size_t)m * 1024 + h * 64 + j8 + 4);
      LAS bf16_t* yw = (LAS bf16_t*)(lds + P_W2T); LAS bf16_t* ya = (LAS bf16_t*)(lds + P_A2T);
#pragma unroll
      for (int qq = 0; qq < 4; ++qq) { yw[(j8 + qq) * PITCH + m] = f2bf(wa[qq]); yw[(j8 + 4 + qq) * PITCH + m] = f2bf(wb[qq]); ya[(j8 + qq) * PITCH + m] = f2bf(aa[qq]); ya[(j8 + 4 + qq) * PITCH + m] = f2bf(ab[qq]); }
      for (int i = tid; i < 320; i += NTHR) { const int gI = i >> 6, cc = i & 63, hc = h * 64 + cc; float v;
          if (gI == 0) v = w0[hc]; else if (gI == 1) v = a0[hc]; else if (gI == 2) v = p.k_k[hc]; else if (gI == 3) v = p.k_a[hc]; else v = p.r_k[hc];
          *(LAS float*)(lds + P_CST + i * 4) = v; } }
    __syncthreads();
    const int tq = lane >> 3, c8 = (lane & 7) * 8, hj = h * 64 + c8, tslot = wave * 8 + tq, ch1 = tslot >> 4, t1 = tslot & 15;
    const int gcol[5] = {hj, 1024 + hj, 2048 + hj, 3072 + dir * 64 + c8, 3200 + dir * 64 + c8};
    f32x4 cw0[2], ca0[2], ckk[2], cka[2], crk[2];
#pragma unroll
    for (int hh = 0; hh < 2; ++hh) {
#define WY_CST(gI) (*(LAS f32x4*)(lds + P_CST + ((gI) * 64 + c8 + 4 * hh) * 4))
        cw0[hh] = WY_CST(0); ca0[hh] = WY_CST(1); ckk[hh] = WY_CST(2); cka[hh] = WY_CST(3); crk[hh] = WY_CST(4);
#undef WY_CST
        asm volatile("" : "+v"(cw0[hh]), "+v"(ca0[hh]), "+v"(ckk[hh]), "+v"(cka[hh]), "+v"(crk[hh])); }
    __syncthreads();
    LAS unsigned char* scr = lds + P_SCR + wave * SCRW;
    LAS unsigned char* img = lds + P_IMG;
    rw::Raw raw;
#define WY_LOADRAW(gj) do { const bf16_t* zr_ = Z + (size_t)rw_row(dir, (gj) * 64 + tslot) * ZW; \
        _Pragma("unroll") for (int g5 = 0; g5 < 5; ++g5) raw.c[g5] = *(const u32x4*)(zr_ + gcol[g5]); } while (0)
    if (first < NJOB) WY_LOADRAW(first);
    for (int g = first; g < NJOB; g += step) {
        const bool latent = g * 64 >= CTXN;
        if (!(SKIP & 1)) { f32x4 rr[2], kv[2];
          { const u32x4 u = raw.c[0]; rr[0] = (f32x4){bflo(u.x), bfhi(u.x), bflo(u.y), bfhi(u.y)}; rr[1] = (f32x4){bflo(u.z), bfhi(u.z), bflo(u.w), bfhi(u.w)};
            LAS unsigned char* rr_ = img + ch1 * REC + R_RT + t1 * ATP + permj(c8) * 2; *(LAS u32x2*)rr_ = (u32x2){u.x, u.y}; *(LAS u32x2*)(rr_ + 16) = (u32x2){u.z, u.w}; }
          { const u32x4 u = raw.c[1]; kv[0] = (f32x4){bflo(u.x), bfhi(u.x), bflo(u.y), bfhi(u.y)}; kv[1] = (f32x4){bflo(u.z), bfhi(u.z), bflo(u.w), bfhi(u.w)}; }
          { const u32x4 u = raw.c[2]; LAS unsigned short* vt = (LAS unsigned short*)(img + ch1 * REC + R_VT) + c8 * 16 + t1;
            vt[0] = (unsigned short)(u.x & 0xffffu); vt[16] = (unsigned short)(u.x >> 16); vt[32] = (unsigned short)(u.y & 0xffffu); vt[48] = (unsigned short)(u.y >> 16);
            vt[64] = (unsigned short)(u.z & 0xffffu); vt[80] = (unsigned short)(u.z >> 16); vt[96] = (unsigned short)(u.w & 0xffffu); vt[112] = (unsigned short)(u.w >> 16); }
          { const u32x4 u = raw.c[3]; u32x4 o;
            o.x = pkbf(rw::fast_tanh(bflo(u.x)), rw::fast_tanh(bfhi(u.x))); o.y = pkbf(rw::fast_tanh(bflo(u.y)), rw::fast_tanh(bfhi(u.y))); o.z = pkbf(rw::fast_tanh(bflo(u.z)), rw::fast_tanh(bfhi(u.z))); o.w = pkbf(rw::fast_tanh(bflo(u.w)), rw::fast_tanh(bfhi(u.w)));
            *(LAS u32x4*)(scr + (tq * PITCH + c8) * 2) = o; *(LAS u32x4*)(scr + 8 * PITCH * 2 + (tq * PITCH + c8) * 2) = raw.c[4]; }
          if (g + step < NJOB) WY_LOADRAW(g + step);
          asm volatile("s_waitcnt lgkmcnt(0)" ::: "memory");
          { const int r16 = lane & 15, quad = lane >> 4; f32x4 acc[2][4];
#pragma unroll
            for (int lora = 0; lora < 2; ++lora) {
                LAS unsigned char* X = scr + lora * 8 * PITCH * 2 + (r16 * PITCH + quad * 8) * 2;
                const bf16x8 x0 = *(LAS bf16x8*)X, x1 = *(LAS bf16x8*)(X + 64);
#pragma unroll
                for (int jt = 0; jt < 4; ++jt) {
                    LAS unsigned char* Y = lds + (lora ? P_A2T : P_W2T) + ((jt * 16 + r16) * PITCH + quad * 8) * 2;
                    acc[lora][jt] = (f32x4){0.f, 0.f, 0.f, 0.f};
                    acc[lora][jt] = __builtin_amdgcn_mfma_f32_16x16x32_bf16(x0, *(LAS bf16x8*)Y, acc[lora][jt], 0, 0, 0);
                    acc[lora][jt] = __builtin_amdgcn_mfma_f32_16x16x32_bf16(x1, *(LAS bf16x8*)(Y + 64), acc[lora][jt], 0, 0, 0); } }
            if (quad < 2) {
#pragma unroll
                for (int lora = 0; lora < 2; ++lora)
#pragma unroll
                    for (int jt = 0; jt < 4; ++jt)
#pragma unroll
                        for (int r = 0; r < 4; ++r) *(LAS float*)(lds + (lora ? P_B : P_LW) + ((wave * 8 + quad * 4 + r) * 64 + jt * 16 + r16) * 4) = acc[lora][jt][r]; } }
          asm volatile("s_waitcnt lgkmcnt(0)" ::: "memory");
          { float bs = 0.f, nn = 0.f; f32x4 kk[2], al[2];
#pragma unroll
            for (int hh = 0; hh < 2; ++hh) { const int off = (tslot * 64 + c8 + 4 * hh) * 4;
                const f32x4 aw = *(LAS f32x4*)(lds + P_LW + off) + cw0[hh], aa = *(LAS f32x4*)(lds + P_B + off) + ca0[hh];
                f32x4 lw;
#pragma unroll
                for (int qq = 0; qq < 4; ++qq) { const float sg = __builtin_amdgcn_rcpf(1.0f + __builtin_amdgcn_exp2f(-1.4426950408889634f * aw[qq]));
                    lw[qq] = -0.8750612633917f * sg; al[hh][qq] = __builtin_amdgcn_rcpf(1.0f + __builtin_amdgcn_exp2f(-1.4426950408889634f * aa[qq])); kk[hh][qq] = kv[hh][qq] * ckk[hh][qq]; nn += kk[hh][qq] * kk[hh][qq]; }
                *(LAS f32x4*)(lds + P_LW + off) = lw; }
            nn = rw::allreduce8(nn);
            const float inv = __builtin_amdgcn_rsqf(fmaxf(nn, 1e-24f));
#pragma unroll
            for (int hh = 0; hh < 2; ++hh) { const int off = (tslot * 64 + c8 + 4 * hh) * 4;
                const f32x4 r = rr[hh];
                f32x4 av, bv, kd;
#pragma unroll
                for (int qq = 0; qq < 4; ++qq) { const float kn = kk[hh][qq] * inv; av[qq] = -kn; bv[qq] = kn * al[hh][qq]; kd[qq] = kv[hh][qq] * (1.0f + (al[hh][qq] - 1.0f) * cka[hh][qq]); bs += r[qq] * kd[qq] * crk[hh][qq]; }
                *(LAS f32x4*)(lds + P_B + off) = bv; *(LAS f32x4*)(lds + P_KD + off) = kd; *(LAS f32x4*)(lds + P_A + off) = av; }
            bs = rw::allreduce8(bs);
            if (latent && (lane & 7) == 0) bon[rw_row(dir, g * 64 + tslot) - CTXN] = bs; } }
        __syncthreads();
        if (!(SKIP & 2)) { if (wave >> 2) stage2<1>(lds, img, wave & 3, lane); else stage2<0>(lds, img, wave & 3, lane); }
        __syncthreads();
        if (!(SKIP & 4)) { const int ch = wave & 3, pair = wave >> 2, n = lane & 15, q = lane >> 4;
          LAS unsigned char* rec = img + ch * REC;
          const LAS unsigned char* Yrm = rec + (pair ? R_RT : R_AT) + n * ATP + 16 * q;
          const LAS unsigned char* Xb = lds + P_BRM + ch * 2048 + n * 128 + 16 * q;
          const LAS unsigned char* Xk = lds + P_KRM + ch * 2048 + n * 128 + 16 * q;
          f32x4 cb = {0.f, 0.f, 0.f, 0.f}, ck = cb;
#pragma unroll
          for (int jt = 0; jt < 4; ++jt) { const int o_ = (jt >> 1) * 64 + (jt & 1) * 8; const u32x2 yb = *(const LAS u32x2*)(Yrm + o_);
              cb = mm(*(const LAS u32x2*)(Xb + o_), yb, cb); ck = mm(*(const LAS u32x2*)(Xk + o_), yb, ck); }
#pragma unroll
          for (int r = 0; r < 4; ++r) { const int s = 4 * q + r; const bool keep = pair ? (s <= n) : (s < n); if (!keep) { cb[r] = 0.f; ck[r] = 0.f; } }
          u32x2 ob, ok; ob.x = pkbf(cb[0], cb[1]); ob.y = pkbf(cb[2], cb[3]); ok.x = pkbf(ck[0], ck[1]); ok.y = pkbf(ck[2], ck[3]);
          if (pair) *(LAS u32x4*)(rec + R_ARBK + n * 64 + ((q ^ ((n >> 2) & 3)) * 16)) = (u32x4){ok.x, ok.y, ob.x, ob.y};
          else {
              *(LAS u32x2*)(rec + R_AAK + n * 32 + 8 * q) = ok;
              LAS float* A2 = (LAS float*)(lds + P_AAB + ch * 1024);
#pragma unroll
              for (int r = 0; r < 4; ++r) A2[n * 16 + r * 4 + q] = cb[r];
              asm volatile("s_waitcnt lgkmcnt(0)" ::: "memory");
              const int c = lane >> 2, pp = lane & 3;
              f32x4 a4[16];
#pragma unroll
              for (int t = 0; t < 16; ++t) a4[t] = *(const LAS f32x4*)(A2 + t * 16 + pp * 4);
              float Tk0 = 0.f, Tk1 = 0.f, Tk2 = 0.f, Tk3 = 0.f, Tprev = 0.f;
              LAS unsigned short* tt = (LAS unsigned short*)(rec + R_TT) + c;
#pragma unroll
              for (int t = 0; t < 16; ++t) {
                  float acc = (a4[t][0] * Tk0 + a4[t][1] * Tk1) + (a4[t][2] * Tk2 + a4[t][3] * Tk3);
                  acc += rw::dppmov<0xB1>(acc); acc += rw::dppmov<0x4E>(acc);
                  const float Tt = acc + ((t == c) ? 1.0f : 0.0f);
                  const bool mine = (t & 3) == pp;
                  if ((t >> 2) == 0) Tk0 = mine ? Tt : Tk0; else if ((t >> 2) == 1) Tk1 = mine ? Tt : Tk1; else if ((t >> 2) == 2) Tk2 = mine ? Tt : Tk2; else Tk3 = mine ? Tt : Tk3;
                  if (t & 1) { const unsigned pk_ = pkbf(Tprev, Tt); if (pp == 0) { tt[(t - 1) * 16] = (unsigned short)(pk_ & 0xffffu); tt[t * 16] = (unsigned short)(pk_ >> 16); } }
                  Tprev = Tt; }
          } }
        if (!(SKIP & 16) && wave == 0 && g >= NSLOT) wait_ge4(ackw, (unsigned)(g - NSLOT + 1), abortw, lane);
        __syncthreads();
        { const int slot = g % NSLOT; const int base = (chain * NSLOT + slot) * JOBB;
          if (!(SKIP & 8)) for (int i = tid; i < JOBB / 16; i += NTHR) __builtin_amdgcn_raw_buffer_store_b128(*(LAS u32x4*)(img + i * 16), ring_rsrc, base + i * 16, 0, 16);
          asm volatile("s_waitcnt vmcnt(0)" ::: "memory");
          __syncthreads();
          if (tid == 0) __hip_atomic_store(flags + slot * 64, (unsigned)g + 1u, WY_RLX); }
    }
#undef WY_LOADRAW
}

__device__ __forceinline__ void zero_words(const Params& p) {
    int t_ = threadIdx.x; asm volatile("" : "+v"(t_)); unsigned* wf_ = (unsigned*)(p.ws + WS_WYF);
    for (long g = (long)blockIdx.x * NTHR + t_; g < (long)WYF_WORDS; g += (long)gridDim.x * NTHR) wf_[g] = 0u;
}
template <int MODE, int SKIP = 0> __device__ __forceinline__ void phase(const Params& p, LAS unsigned char* lds) {
    const int G = (int)gridDim.x, b = (int)blockIdx.x, nper = (G - 32) / 32;
    if (b < 32) {
        int tid_ = threadIdx.x; asm volatile("" : "+v"(tid_)); const int wave = __builtin_amdgcn_readfirstlane(tid_ >> 6);
        if (tid_ < 8) *(LAS unsigned*)(lds + C_SYNC + 4 * tid_) = 0u;
        __syncthreads();
        if (MODE == 4) { }
        else if (wave < 4) { if (MODE != 1) consumer<MODE>(p, b, wave, tid_ & 63, lds); } else loader<MODE>(p, b, wave - 4, tid_ & 63, lds);
    }
    else if (MODE < 2 || MODE == 4) { const int pp = b - 32; if (pp < 32 * nper) producer<SKIP>(p, pp % 32, pp / 32, nper, lds); }
}
}

namespace ret {
using attn::bf16x8; using attn::s16x4; using attn::f32x16; using attn::u32x4;
typedef float f32x4 __attribute__((ext_vector_type(4)));
typedef unsigned u32x2 __attribute__((ext_vector_type(2)));
constexpr int NQ = R / 128;
constexpr size_t SLOT_BYTES = 256 * 128 * 2;
constexpr size_t WS_SCTX = 254 * MiB;
#define RKSWZ(row, colB) ((row) * 256 + ((colB) ^ (((row) & 7) << 4)))
__device__ __forceinline__ bf16_t* slot(const Params& p, int dir, int q, int head) {
    return q >= 2 ? (bf16_t*)((unsigned char*)p.out + (((size_t)dir * (NQ - 2) + (q - 2)) * 4 + head) * SLOT_BYTES)
                  : (bf16_t*)(p.ws + WS_SCTX + (((size_t)dir * 2 + q) * 4 + head) * SLOT_BYTES);
}
__device__ __forceinline__ float log2_sigmoid(float x) { return -1.4426950408889634f * (fmaxf(-x, 0.f) + log1pf(expf(-fabsf(x)))); }
__device__ __forceinline__ bf16x8 scale8(bf16x8 v, float s) {
    u32x4 w = __builtin_bit_cast(u32x4, v), o;
#pragma unroll
    for (int i = 0; i < 4; ++i) o[i] = attn::cvtpk(__uint_as_float(w[i] << 16) * s, __uint_as_float(w[i] & 0xffff0000u) * s);
    return __builtin_bit_cast(bf16x8, o);
}
__device__ __forceinline__ void pk4(const f32x16& P, int base, bf16x8& out) {
    const unsigned a0 = attn::cvtpk(P[base + 0], P[base + 1]), a1 = attn::cvtpk(P[base + 2], P[base + 3]);
    const unsigned b0 = attn::cvtpk(P[base + 4], P[base + 5]), b1 = attn::cvtpk(P[base + 6], P[base + 7]);
    auto r0 = __builtin_amdgcn_permlane32_swap(a0, b0, false, false); auto r1 = __builtin_amdgcn_permlane32_swap(a1, b1, false, false);
    u32x4 w = {r0[0], r1[0], r0[1], r1[1]}; out = __builtin_bit_cast(bf16x8, w);
}
#define RPK(L, H) (bf16x8){L[0], L[1], L[2], L[3], H[0], H[1], H[2], H[3]}

__device__ __forceinline__ void summaries_unit(const Params& p, int q, int h, char* lds) {
    int tid_ = threadIdx.x; asm volatile("" : "+v"(tid_));
    const int tid = tid_, lane = tid & 63, wave = __builtin_amdgcn_readfirstlane(tid >> 6), r32 = lane & 31, hi = lane >> 5;
    const bf16_t* P = ws_big(p) + (size_t)q * 128 * P0W;
    const float lgf = log2_sigmoid(p.dec_f[h]), lgb = log2_sigmoid(p.dec_b[h]);
    const int sr = tid >> 4, sc = (tid & 15) * 8, st0 = attn::v_st(sr, sc), st1 = attn::v_st(32 + sr, sc);
#pragma unroll
    for (int th = 0; th < 2; ++th) {
        const int t0 = th * 64 + sr, t1 = t0 + 32;
        const bf16_t* r0 = P + (size_t)t0 * P0W; const bf16_t* r1 = P + (size_t)t1 * P0W;
#pragma unroll
        for (int eh = 0; eh < 2; ++eh) { char* vt = lds + (th * 2 + eh) * 16384;
            *(bf16x8*)(vt + st0) = *(const bf16x8*)(r0 + C_VA + h * 256 + eh * 128 + sc); *(bf16x8*)(vt + st1) = *(const bf16x8*)(r1 + C_VA + h * 256 + eh * 128 + sc); }
        const bf16x8 k0 = *(const bf16x8*)(r0 + C_KA + h * 128 + sc), k1 = *(const bf16x8*)(r1 + C_KA + h * 128 + sc);
        char* kf = lds + 65536 + th * 16384; char* kb = lds + 98304 + th * 16384;
        *(bf16x8*)(kf + st0) = scale8(k0, __builtin_amdgcn_exp2f((float)(127 - t0) * lgf)); *(bf16x8*)(kf + st1) = scale8(k1, __builtin_amdgcn_exp2f((float)(127 - t1) * lgf));
        *(bf16x8*)(kb + st0) = scale8(k0, __builtin_amdgcn_exp2f((float)t0 * lgb)); *(bf16x8*)(kb + st1) = scale8(k1, __builtin_amdgcn_exp2f((float)t1 * lgb));
    }
    __syncthreads();
    const int lbase = (int)(uintptr_t)lds + attn::v_rd_base(lane);
    f32x16 acc[2][4];
#pragma unroll
    for (int d = 0; d < 2; ++d)
#pragma unroll
        for (int b = 0; b < 4; ++b) acc[d][b] = f32x16{};
#pragma unroll
    for (int th = 0; th < 2; ++th) {
        const int va = lbase + (th * 2 + (wave >> 2)) * 16384 + (wave & 3) * 512, kfb = lbase + 65536 + th * 16384, kbb = lbase + 98304 + th * 16384;
#define R1_STEP(KS) do { \
        const s16x4 al = attn::tr_read<attn::v_rd_off(0, KS, 0)>(va), ah = attn::tr_read<attn::v_rd_off(0, KS, 1)>(va); \
        const s16x4 f0l = attn::tr_read<attn::v_rd_off(0, KS, 0)>(kfb), f0h = attn::tr_read<attn::v_rd_off(0, KS, 1)>(kfb), f1l = attn::tr_read<attn::v_rd_off(1, KS, 0)>(kfb), f1h = attn::tr_read<attn::v_rd_off(1, KS, 1)>(kfb); \
        const s16x4 f2l = attn::tr_read<attn::v_rd_off(2, KS, 0)>(kfb), f2h = attn::tr_read<attn::v_rd_off(2, KS, 1)>(kfb), f3l = attn::tr_read<attn::v_rd_off(3, KS, 0)>(kfb), f3h = attn::tr_read<attn::v_rd_off(3, KS, 1)>(kfb); \
        const s16x4 g0l = attn::tr_read<attn::v_rd_off(0, KS, 0)>(kbb), g0h = attn::tr_read<attn::v_rd_off(0, KS, 1)>(kbb), g1l = attn::tr_read<attn::v_rd_off(1, KS, 0)>(kbb), g1h = attn::tr_read<attn::v_rd_off(1, KS, 1)>(kbb); \
        const s16x4 g2l = attn::tr_read<attn::v_rd_off(2, KS, 0)>(kbb), g2h = attn::tr_read<attn::v_rd_off(2, KS, 1)>(kbb), g3l = attn::tr_read<attn::v_rd_off(3, KS, 0)>(kbb), g3h = attn::tr_read<attn::v_rd_off(3, KS, 1)>(kbb); \
        asm volatile("s_waitcnt lgkmcnt(0)" ::: "memory"); __builtin_amdgcn_sched_barrier(0); \
        const bf16x8 a = RPK(al, ah); \
        acc[0][0] = __builtin_amdgcn_mfma_f32_32x32x16_bf16(a, RPK(f0l, f0h), acc[0][0], 0, 0, 0); acc[0][1] = __builtin_amdgcn_mfma_f32_32x32x16_bf16(a, RPK(f1l, f1h), acc[0][1], 0, 0, 0); \
        acc[0][2] = __builtin_amdgcn_mfma_f32_32x32x16_bf16(a, RPK(f2l, f2h), acc[0][2], 0, 0, 0); acc[0][3] = __builtin_amdgcn_mfma_f32_32x32x16_bf16(a, RPK(f3l, f3h), acc[0][3], 0, 0, 0); \
        acc[1][0] = __builtin_amdgcn_mfma_f32_32x32x16_bf16(a, RPK(g0l, g0h), acc[1][0], 0, 0, 0); acc[1][1] = __builtin_amdgcn_mfma_f32_32x32x16_bf16(a, RPK(g1l, g1h), acc[1][1], 0, 0, 0); \
        acc[1][2] = __builtin_amdgcn_mfma_f32_32x32x16_bf16(a, RPK(g2l, g2h), acc[1][2], 0, 0, 0); acc[1][3] = __builtin_amdgcn_mfma_f32_32x32x16_bf16(a, RPK(g3l, g3h), acc[1][3], 0, 0, 0); \
        __builtin_amdgcn_sched_barrier(0); } while (0)
        R1_STEP(0); R1_STEP(1); R1_STEP(2); R1_STEP(3);
#undef R1_STEP
    }
#pragma unroll
    for (int d = 0; d < 2; ++d) { bf16_t* dst = slot(p, d, q, h);
#pragma unroll
        for (int db = 0; db < 4; ++db)
#pragma unroll
            for (int r = 0; r < 16; ++r) dst[(size_t)(32 * wave + attn::crow(r, hi)) * 128 + 32 * db + r32] = (bf16_t)(attn::cvtpk(acc[d][db][r], 0.f) & 0xffffu); }
    __syncthreads();
}

__device__ __forceinline__ void state_scan(const Params& p) {
    int tid_ = threadIdx.x; asm volatile("" : "+v"(tid_));
    for (long gt = (long)blockIdx.x * NTHR + tid_; gt < 2L * 4 * 16384; gt += (long)gridDim.x * NTHR) {
    const int pair = (int)(gt & 16383), h = (int)((gt >> 14) & 3), dir = (int)(gt >> 16);
    const float G = __builtin_amdgcn_exp2f(128.0f * log2_sigmoid((dir ? p.dec_b : p.dec_f)[h]));
    float s0 = 0.f, s1 = 0.f;
    static_assert(NQ % 10 == 0, "the scan is unrolled by ten chunks");
    for (int n0 = 0; n0 < NQ; n0 += 10) {
        unsigned* ptr[10]; unsigned u[10];
#pragma unroll
        for (int k = 0; k < 10; ++k) { const int n = n0 + k, q = dir == 0 ? n : (n < 2 ? 1 - n : NQ + 1 - n);
            ptr[k] = (unsigned*)slot(p, dir, q, h) + pair; u[k] = *ptr[k]; }
#pragma unroll
        for (int k = 0; k < 10; ++k) { *ptr[k] = attn::cvtpk(s0, s1);
            s0 = G * s0 + __uint_as_float(u[k] << 16); s1 = G * s1 + __uint_as_float(u[k] & 0xffff0000u); }
    }    }
}

__device__ __forceinline__ void output_unit(const Params& p, int q, int h, char* lds) {
    int tid_ = threadIdx.x; asm volatile("" : "+v"(tid_));
    const int tid = tid_, lane = tid & 63, wave = __builtin_amdgcn_readfirstlane(tid >> 6), r32 = lane & 31, hi = lane >> 5;
    const int ib = wave >> 1, eh = wave & 1;
    const bf16_t* P = ws_big(p) + (size_t)q * 128 * P0W;
    const float lgf = log2_sigmoid(p.dec_f[h]), lgb = log2_sigmoid(p.dec_b[h]);
    const int sr = tid >> 4, sc = (tid & 15) * 8, st0 = attn::v_st(sr, sc), st1 = attn::v_st(32 + sr, sc);
    bf16x8 qr[8];
    { const bf16_t* Qw = P + (size_t)(ib * 32 + r32) * P0W + C_QA + h * 128 + hi * 8;
#pragma unroll
      for (int d0 = 0; d0 < 8; ++d0) qr[d0] = *(const bf16x8*)(Qw + d0 * 16); }
    { const bf16_t* Sf = slot(p, 0, q, h); const bf16_t* Sb = slot(p, 1, q, h);
      bf16x8 sv[16];
#pragma unroll
      for (int k = 0; k < 8; ++k) { const int i = tid + 512 * k; sv[k] = *(const bf16x8*)(Sf + (size_t)i * 8); sv[8 + k] = *(const bf16x8*)(Sb + (size_t)i * 8); }
#pragma unroll
      for (int k = 0; k < 8; ++k) { const int i = tid + 512 * k, e = i >> 4, cb = (i & 15) * 16;
          *(bf16x8*)(lds + RKSWZ(e, cb)) = sv[k]; *(bf16x8*)(lds + 65536 + RKSWZ(e, cb)) = sv[8 + k]; } }
    __syncthreads();
    bf16x8 kvr[12];
    f32x16 o[4] = {};
    const int i_loc = ib * 32 + r32;
    { const float scf = __builtin_amdgcn_exp2f((float)(i_loc + 1) * lgf), scb = __builtin_amdgcn_exp2f((float)(128 - i_loc) * lgb);
#pragma unroll
      for (int dir = 0; dir < 2; ++dir) {
          const char* Sl = lds + dir * 65536;
          if (dir == 1) {
#pragma unroll
    for (int jt = 0; jt < 2; ++jt) {
        const bf16_t* r0 = P + (size_t)(jt * 64 + sr) * P0W; const bf16_t* r1 = r0 + (size_t)32 * P0W;
        kvr[jt * 6 + 0] = *(const bf16x8*)(r0 + C_KA + h * 128 + sc); kvr[jt * 6 + 1] = *(const bf16x8*)(r1 + C_KA + h * 128 + sc);
#pragma unroll
        for (int e2 = 0; e2 < 2; ++e2) { kvr[jt * 6 + 2 + e2 * 2] = *(const bf16x8*)(r0 + C_VA + h * 256 + e2 * 128 + sc); kvr[jt * 6 + 3 + e2 * 2] = *(const bf16x8*)(r1 + C_VA + h * 256 + e2 * 128 + sc); }
    }
          }
#pragma unroll
          for (int ks = 0; ks < 8; ++ks) { const bf16x8 a = scale8(qr[ks], dir ? scb : scf); const int cb = (ks * 16 + hi * 8) * 2;
              bf16x8 f[4];
#pragma unroll
              for (int d0 = 0; d0 < 4; ++d0) f[d0] = *(const bf16x8*)(Sl + RKSWZ(eh * 128 + d0 * 32 + r32, cb));
#pragma unroll
              for (int d0 = 0; d0 < 4; ++d0) o[d0] = __builtin_amdgcn_mfma_f32_32x32x16_bf16(a, f[d0], o[d0], 0, 0, 0); } } }
    __syncthreads();
#pragma unroll
    for (int jt = 0; jt < 2; ++jt) { char* kt = lds + jt * 16384;
        *(bf16x8*)(kt + RKSWZ(sr, sc * 2)) = kvr[jt * 6 + 0]; *(bf16x8*)(kt + RKSWZ(32 + sr, sc * 2)) = kvr[jt * 6 + 1];
#pragma unroll
        for (int e2 = 0; e2 < 2; ++e2) { char* vt = lds + 32768 + (jt * 2 + e2) * 16384; *(bf16x8*)(vt + st0) = kvr[jt * 6 + 2 + e2 * 2]; *(bf16x8*)(vt + st1) = kvr[jt * 6 + 3 + e2 * 2]; } }
    __syncthreads();
    const int vb0 = (int)(uintptr_t)lds + 32768 + attn::v_rd_base(lane);
#pragma unroll
    for (int jt = 0; jt < 2; ++jt) {
        f32x16 p0, p1;
        attn::qkt(p0, p1, (const attn::bf16*)(lds + jt * 16384), qr, r32, hi);
#pragma unroll
        for (int r = 0; r < 16; ++r) {
            const int j0 = jt * 64 + attn::crow(r, hi), dl0 = i_loc - j0, dl1 = dl0 - 32;
            const float m0 = dl0 > 0 ? __builtin_amdgcn_exp2f((float)dl0 * lgf) : (dl0 < 0 ? __builtin_amdgcn_exp2f((float)(-dl0) * lgb) : 2.0f);
            const float m1 = dl1 > 0 ? __builtin_amdgcn_exp2f((float)dl1 * lgf) : (dl1 < 0 ? __builtin_amdgcn_exp2f((float)(-dl1) * lgb) : 2.0f);
            p0[r] *= m0; p1[r] *= m1;
        }
        bf16x8 pa0, pa1, pa2, pa3; pk4(p0, 0, pa0); pk4(p0, 8, pa1); pk4(p1, 0, pa2); pk4(p1, 8, pa3);
        __builtin_amdgcn_sched_barrier(0);
        attn::pv_d0(o, vb0 + (jt * 2 + eh) * 16384, pa0, pa1, pa2, pa3);
    }
    __syncthreads();
    float* O = (float*)lds;
#pragma unroll
    for (int r = 0; r < 16; ++r)
#pragma unroll
        for (int d0 = 0; d0 < 4; ++d0) O[(ib * 32 + attn::crow(r, hi)) * 256 + eh * 128 + d0 * 32 + r32] = o[d0][r];
    __syncthreads();
    bf16_t* BR = ws_br(p) + (size_t)q * 128 * 2048 + h * 256;
#pragma unroll 4
    for (int rr = 0; rr < 16; ++rr) {
        const int row = wave * 16 + rr; const f32x4 x = *(const f32x4*)(O + row * 256 + lane * 4);
        const float mean = rw::wave_sum((x[0] + x[1]) + (x[2] + x[3])) * (1.0f / 256.f);
        const f32x4 d = x - mean;
        const float var = rw::wave_sum((d[0] * d[0] + d[1] * d[1]) + (d[2] * d[2] + d[3] * d[3])) * (1.0f / 256.f);
        const float rstd = 1.0f / sqrtf(var + NORM_EPS);
        f32x4 y = d * rstd;
        if (q < 2) { const u32x2 gg = *(const u32x2*)((const bf16_t*)(p.ws + 255 * MiB) + (size_t)(q * 128 + row) * 2048 + h * 256 + lane * 4);
            y[0] *= __uint_as_float(gg.x << 16); y[1] *= __uint_as_float(gg.x & 0xffff0000u); y[2] *= __uint_as_float(gg.y << 16); y[3] *= __uint_as_float(gg.y & 0xffff0000u); }
        u32x2 w; w.x = attn::cvtpk(y[0], y[1]); w.y = attn::cvtpk(y[2], y[3]);
        *(u32x2*)(BR + (size_t)row * 2048 + lane * 4) = w;
    }
    __syncthreads();
}
#undef RPK
#undef RKSWZ
}

namespace na {
using attn::bf16x8; using attn::f32x16; using attn::u32x4;
constexpr float L2E = 1.4426950408889634f;
constexpr int WH = GROWS < 8 ? GROWS : 8;
constexpr int L_K = 0, L_V = 32768, L_WS = 65536, L_RPB = L_WS + NWAVES * 64 * 4, L_END = L_RPB + 15 * 31 * 4;
#define NKSWZ(row, colB) ((row) * 256 + ((colB) ^ (((row) & 7) << 4)))
__device__ __forceinline__ int win_r0(int r) { int r0 = r - WH / 2; return r0 < 0 ? 0 : (r0 > GROWS - WH ? GROWS - WH : r0); }
__device__ __forceinline__ int win_c0(int c) { int c0 = c - 8; return c0 < 0 ? 0 : (c0 > GW - 16 ? GW - 16 : c0); }

__device__ __forceinline__ void na_unit(const Params& p, int rg, int h, char* lds) {
    int tid_ = threadIdx.x; asm volatile("" : "+v"(tid_));
    const int tid = tid_, lane = tid & 63, wave = __builtin_amdgcn_readfirstlane(tid >> 6), r32 = lane & 31, hi = lane >> 5;
    const bf16_t* P = ws_big(p); const bf16_t* NAC = (const bf16_t*)(p.ws + 255 * MiB);
    const int r = 4 * rg + (wave >> 1), qc = (wave & 1) * 32 + r32, my_r0 = win_r0(r), my_c0 = win_c0(qc);
    const int lo = win_r0(4 * rg), hiw = win_r0(4 * rg + 3) + WH, NT = hiw - lo + CTXN / 64;
    float* wsf = (float*)(lds + L_WS) + wave * 64; float* rpb_l = (float*)(lds + L_RPB);
    if (tid < 15 * 31) rpb_l[tid] = p.rpb[h * 15 * 31 + tid];
    bf16x8 qr[4];
    { const bf16_t* Qw = P + (size_t)(CTXN + r * 64 + qc) * NAW + h * 64 + hi * 8;
#pragma unroll
      for (int d0 = 0; d0 < 4; ++d0) { u32x4 w = *(const u32x4*)(Qw + d0 * 16);
        for (int i = 0; i < 4; ++i) w[i] = attn::cvtpk(__uint_as_float(w[i] << 16) * 0.125f, __uint_as_float(w[i] & 0xffff0000u) * 0.125f);
        qr[d0] = *reinterpret_cast<bf16x8*>(&w); } }
    const int sk = tid >> 3, sc = (tid & 7) * 8, kst = NKSWZ(sk, sc * 2), vst = attn::v_st(sk, sc);
    bf16x8 kA, vA, kB, vB;
#define NA_LOAD(KR, VR, t) do { if ((t) < hiw - lo) { const int krow_ = CTXN + (lo + (t)) * 64 + sk; \
            KR = *(const bf16x8*)(P + (size_t)krow_ * NAW + 1024 + h * 64 + sc); VR = *(const bf16x8*)(P + (size_t)krow_ * NAW + 2048 + h * 64 + sc); } \
        else { const bf16_t* c_ = NAC + (size_t)(((t) - (hiw - lo)) * 64 + sk) * 2048 + h * 64 + sc; KR = *(const bf16x8*)c_; VR = *(const bf16x8*)(c_ + 1024); } } while (0)
#define NA_WRITE(KR, VR, b) do { *(bf16x8*)(lds + L_K + (b) * 16384 + kst) = KR; *(bf16x8*)(lds + L_V + (b) * 16384 + vst) = VR; } while (0)
    NA_LOAD(kA, vA, 0); NA_WRITE(kA, vA, 0);
    NA_LOAD(kB, vB, 1);
    __syncthreads();
    float m_reg = -1e30f, l_reg = 0.f; f32x16 o[2] = {};
    const int dl = 4 * hi - my_c0;
    const int vb0 = (int)(uintptr_t)lds + L_V + attn::v_rd_base(lane);
#define NA_TILE(t, KW, VW, KL, VL) do { \
        if ((t) + 2 < NT) NA_LOAD(KL, VL, (t) + 2);            \
        const bool is_ctx = (t) >= hiw - lo; const int kr = lo + (t); \
        if (is_ctx || (kr >= my_r0 && kr < my_r0 + WH)) { \
            const char* Ks = lds + L_K + ((t) & 1) * 16384; \
            f32x16 p0 = {}, p1 = {}; \
            _Pragma("unroll") for (int d0 = 0; d0 < 4; ++d0) { const int cb = (d0 * 16 + hi * 8) * 2; \
                const bf16x8 b0 = *(const bf16x8*)(Ks + NKSWZ(r32, cb)), b1 = *(const bf16x8*)(Ks + NKSWZ(32 + r32, cb)); \
                p0 = __builtin_amdgcn_mfma_f32_32x32x16_bf16(b0, qr[d0], p0, 0, 0, 0); p1 = __builtin_amdgcn_mfma_f32_32x32x16_bf16(b1, qr[d0], p1, 0, 0, 0); } \
            if (!is_ctx) {     \
                const float* bb = rpb_l + (kr - r + 7) * 31 + 15 - qc + 4 * hi; float bz0[16], bz1[16]; \
                _Pragma("unroll") for (int q = 0; q < 16; ++q) { const int cq = (q & 3) + 8 * (q >> 2); bz0[q] = bb[cq]; bz1[q] = bb[cq + 32]; } \
                _Pragma("unroll") for (int q = 0; q < 16; ++q) { const int cq = (q & 3) + 8 * (q >> 2); \
                    p0[q] = (unsigned)(cq + dl) < 16u ? p0[q] + bz0[q] : -1e30f; p1[q] = (unsigned)(cq + 32 + dl) < 16u ? p1[q] + bz1[q] : -1e30f; } \
            } \
            float pmax = p0[0]; \
            _Pragma("unroll") for (int q = 1; q < 16; ++q) pmax = fmaxf(pmax, p0[q]); \
            _Pragma("unroll") for (int q = 0; q < 16; ++q) pmax = fmaxf(pmax, p1[q]); \
            { auto rr = __builtin_amdgcn_permlane32_swap(__float_as_uint(pmax), __float_as_uint(pmax), false, false); pmax = fmaxf(__uint_as_float(rr[0]), __uint_as_float(rr[1])); } \
            const float mn = fmaxf(m_reg, pmax), alpha = __builtin_amdgcn_exp2f((m_reg - mn) * L2E), mnl = -mn * L2E; m_reg = mn; \
            float ps = 0.f; \
            _Pragma("unroll") for (int q = 0; q < 16; ++q) { p0[q] = __builtin_amdgcn_exp2f(fmaf(p0[q], L2E, mnl)); p1[q] = __builtin_amdgcn_exp2f(fmaf(p1[q], L2E, mnl)); ps += p0[q] + p1[q]; } \
            { auto rr = __builtin_amdgcn_permlane32_swap(__float_as_uint(ps), __float_as_uint(ps), false, false); ps = __uint_as_float(rr[0]) + __uint_as_float(rr[1]); } \
            l_reg = l_reg * alpha + ps; \
            if (__any(alpha < 1.f)) { if (hi == 0) wsf[r32] = alpha; asm volatile("s_waitcnt lgkmcnt(0)" ::: "memory"); \
                _Pragma("unroll") for (int d = 0; d < 2; ++d) _Pragma("unroll") for (int q = 0; q < 16; ++q) o[d][q] *= wsf[attn::crow(q, hi)]; } \
            bf16x8 pa0, pa1, pa2, pa3; ret::pk4(p0, 0, pa0); ret::pk4(p0, 8, pa1); ret::pk4(p1, 0, pa2); ret::pk4(p1, 8, pa3); \
            __builtin_amdgcn_sched_barrier(0); \
            const int vb = vb0 + ((t) & 1) * 16384; \
            attn::pv_one<0>(o[0], vb, pa0, pa1, pa2, pa3); attn::pv_one<1>(o[1], vb, pa0, pa1, pa2, pa3); \
        } \
        if ((t) + 1 < NT) NA_WRITE(KW, VW, ((t) + 1) & 1);     \
        __syncthreads(); } while (0)
    for (int t = 0; t < NT; t += 2) {
        NA_TILE(t, kB, vB, kA, vA);
        if (t + 1 < NT) NA_TILE(t + 1, kA, vA, kB, vB);
    }
#undef NA_TILE
#undef NA_LOAD
#undef NA_WRITE
    if (hi == 0) wsf[32 + r32] = l_reg; asm volatile("s_waitcnt lgkmcnt(0)" ::: "memory");
    bf16_t* Ow = ws_br(p) + (size_t)(CTXN + r * 64 + (wave & 1) * 32) * 2048 + h * 64;
#pragma unroll
    for (int q = 0; q < 16; ++q) { const int orow = attn::crow(q, hi); const float rl = __builtin_amdgcn_rcpf(wsf[32 + orow]);
#pragma unroll
        for (int d0 = 0; d0 < 2; ++d0) Ow[(size_t)orow * 2048 + d0 * 32 + r32] = (bf16_t)(attn::cvtpk(o[d0][q] * rl, 0.f) & 0xffffu); }
    __syncthreads();
}
#undef NKSWZ
}

namespace el {
typedef float f32x4 __attribute__((ext_vector_type(4)));
typedef unsigned u32x2 __attribute__((ext_vector_type(2)));
__device__ __forceinline__ float wsum(float v) { return rw::wave_sum(v); }
__device__ __forceinline__ unsigned pk(float lo, float hi) { unsigned r; asm volatile("v_cvt_pk_bf16_f32 %0, %1, %2" : "=v"(r) : "v"(lo), "v"(hi)); return r; }

__device__ __forceinline__ void mod_phase(const Params& p, char* lds) {
    int tid_ = threadIdx.x; asm volatile("" : "+v"(tid_));
    const int tid = tid_, ks = tid >> 6, jl = tid & 63;
    float* sc = (float*)lds; float* red = sc + 2048;
    for (int b = blockIdx.x; b < 2 * 48; b += gridDim.x) {
        const int l = b / 48, j = (b % 48) * 64 + jl;
        __syncthreads();
        for (int k = tid; k < 2048; k += NTHR) { const float x = k < 1024 ? p.c[k] : p.c_ctx[k - 1024]; sc[k] = x / (1.0f + __expf(-x)); }
        __syncthreads();
        const float* w = p.w_mod + (size_t)l * DM * 3072 + (size_t)(ks * 128) * 3072 + j; float a0 = 0.f, a1 = 0.f;
#pragma unroll 32
        for (int k = 0; k < 128; ++k) { const float wv = w[(size_t)k * 3072]; a0 += sc[ks * 128 + k] * wv; a1 += sc[1024 + ks * 128 + k] * wv; }
        red[ks * 64 + jl] = a0; red[512 + ks * 64 + jl] = a1;
        __syncthreads();
        if (tid < 128) { const int s = tid >> 6; float t = 0.f;
#pragma unroll
            for (int q = 0; q < 8; ++q) t += red[s * 512 + q * 64 + jl];
            ws_modv(p)[(l * 2 + s) * 3072 + j] = t + p.b_mod[l * 3072 + j]; }
    }
    __syncthreads();
}

template <int LAYER> __device__ __forceinline__ void modnorm_store(const Params& p, const f32x4 (&v)[4], int row, int lane) {
    const float* mv = ws_modv(p) + (LAYER * 2 + (row < CTXN ? 1 : 0)) * 3072; const float* g = p.g_pre + LAYER * DM;
    float ss = 0.f;
#pragma unroll
    for (int j = 0; j < 4; ++j) ss += (v[j][0] * v[j][0] + v[j][1] * v[j][1]) + (v[j][2] * v[j][2] + v[j][3] * v[j][3]);
    const float rstd = 1.0f / sqrtf(wsum(ss) * (1.0f / DM) + NORM_EPS);
    bf16_t* o = ws_xn(p) + (size_t)row * DM;
    f32x4 gg[4], sh[4], sc[4];
#pragma unroll
    for (int j = 0; j < 4; ++j) { const int c = lane * 4 + 256 * j; gg[j] = *(const f32x4*)(g + c); sh[j] = *(const f32x4*)(mv + c); sc[j] = *(const f32x4*)(mv + 1024 + c); }
#pragma unroll
    for (int j = 0; j < 4; ++j) { const int c = lane * 4 + 256 * j;
        const f32x4 y = v[j] * rstd * gg[j] * (sc[j] + 1.0f) + sh[j];
        u32x2 w; w.x = pk(y[0], y[1]); w.y = pk(y[2], y[3]); *(u32x2*)(o + c) = w; }
}
__device__ __forceinline__ void prenorm0_phase(const Params& p) {
    int tid_ = threadIdx.x; asm volatile("" : "+v"(tid_));
    const int lane = tid_ & 63, gw = (int)blockIdx.x * NWAVES + (tid_ >> 6), ngw = (int)gridDim.x * NWAVES;
    for (int row = gw; row < R; row += ngw) {
        const float* src = row < CTXN ? p.ctx + (size_t)row * DM : p.x + (size_t)(row - CTXN) * DM;
        f32x4 v[4];
#pragma unroll
        for (int j = 0; j < 4; ++j) v[j] = *(const f32x4*)(src + lane * 4 + 256 * j);
        modnorm_store<0>(p, v, row, lane);
    }
}
template <int LAYER> __device__ __forceinline__ void resid_phase(const Params& p) {
    int tid_ = threadIdx.x; asm volatile("" : "+v"(tid_));
    const int lane = tid_ & 63, gw = (int)blockIdx.x * NWAVES + (tid_ >> 6), ngw = (int)gridDim.x * NWAVES;
    for (int row = (LAYER == 0 ? 0 : CTXN) + gw; row < R; row += ngw) {
        const bool ctxsum = LAYER == 0 && row < CTXN;
        const float* y = ctxsum ? (const float*)(p.ws + WS_BIG + 72 * MiB) + (size_t)row * DM : ws_y(p) + (size_t)row * DM; const float* mv = ws_modv(p) + (LAYER * 2 + (row < CTXN ? 1 : 0)) * 3072 + 2048; const float* g = p.g_post + LAYER * DM;
        const float* src; float* dst;
        if (row < CTXN) { src = p.ctx + (size_t)row * DM; dst = ws_ctx1(p) + (size_t)row * DM; }
        else { src = (LAYER == 0 ? p.x : p.out) + (size_t)(row - CTXN) * DM; dst = p.out + (size_t)(row - CTXN) * DM; }
        f32x4 yv[4]; float ss = 0.f;
#pragma unroll
        for (int j = 0; j < 4; ++j) { yv[j] = *(const f32x4*)(y + lane * 4 + 256 * j);
            if (ctxsum) { _Pragma("unroll") for (int s = 1; s < 8; ++s) yv[j] += *(const f32x4*)(y + (size_t)s * CTXN * DM + lane * 4 + 256 * j); }
            ss += (yv[j][0] * yv[j][0] + yv[j][1] * yv[j][1]) + (yv[j][2] * yv[j][2] + yv[j][3] * yv[j][3]); }
        const float rstd = 1.0f / sqrtf(wsum(ss) * (1.0f / DM) + NORM_EPS);
        f32x4 xn[4], sv[4], mvv[4], gv[4];
#pragma unroll
        for (int j = 0; j < 4; ++j) { const int c = lane * 4 + 256 * j; sv[j] = *(const f32x4*)(src + c); mvv[j] = *(const f32x4*)(mv + c); gv[j] = *(const f32x4*)(g + c); }
#pragma unroll
        for (int j = 0; j < 4; ++j) { const int c = lane * 4 + 256 * j;
            xn[j] = sv[j] + mvv[j] * (yv[j] * rstd * gv[j]);
            *(f32x4*)(dst + c) = xn[j]; }
        if (LAYER == 0) modnorm_store<1>(p, xn, row, lane);
    }
}
__device__ __forceinline__ void ropenorm_phase(const Params& p) {
    int tid_ = threadIdx.x; asm volatile("" : "+v"(tid_));
    const int lane = tid_ & 63, gw = (int)blockIdx.x * NWAVES + (tid_ >> 6), ngw = (int)gridDim.x * NWAVES;
    const float* ct = ws_rope(p); const float* st = ct + N_ROPE;
    const float qn0 = p.q_norm[2 * lane], qn1 = p.q_norm[2 * lane + 1], kn0 = p.k_norm[2 * lane], kn1 = p.k_norm[2 * lane + 1];
    for (int row = gw; row < R; row += ngw) {
        const bool rot = row >= CTXN; const int t = row - CTXN; float cs = 1.f, sn = 0.f;
        if (rot) { const int pos = lane < 32 ? t / GW : t % GW, f = lane & 31; cs = ct[pos * 32 + f]; sn = st[pos * 32 + f]; }
        bf16_t* base = ws_big(p) + (size_t)row * P0W;
        unsigned u[18];
#pragma unroll
        for (int slot = 0; slot < 18; ++slot) {
            const int col = slot < 4 ? C_QA + slot * 128 : slot < 8 ? C_KA + (slot - 4) * 128 : slot < 16 ? C_QB + (slot - 8) * 128 : C_KB + (slot - 16) * 128;
            u[slot] = *((const unsigned*)(base + col) + lane); }
#pragma unroll
        for (int slot = 0; slot < 18; ++slot) {
            const int col = slot < 4 ? C_QA + slot * 128 : slot < 8 ? C_KA + (slot - 4) * 128 : slot < 16 ? C_QB + (slot - 8) * 128 : C_KB + (slot - 16) * 128;
            unsigned* ptr = (unsigned*)(base + col) + lane;
            float x1 = __uint_as_float(u[slot] << 16), x2 = __uint_as_float(u[slot] & 0xffff0000u);
            if (slot >= 4 && slot < 8) { x1 *= 0.08838834764831845f; x2 *= 0.08838834764831845f; }
            if (slot >= 8) { const float sc = 1.0f / sqrtf(wsum(x1 * x1 + x2 * x2) * (1.0f / 128.f) + NORM_EPS);
                x1 *= sc * (slot < 16 ? qn0 : kn0); x2 *= sc * (slot < 16 ? qn1 : kn1); }
            *ptr = pk(x1 * cs - x2 * sn, x1 * sn + x2 * cs);
        }
    }
}
}

constexpr int RING_BYTES = 131072, LDS_BYTES = 163840;
constexpr size_t WS_BAR = 256 * 1024;
constexpr size_t WS_SIDE = 255 * MiB;
constexpr size_t WS_YC = WS_BIG + 72 * MiB;
constexpr int LDS_BARW = LDS_BYTES - 64;
constexpr size_t WB_IN0 = WS_WB, WB_OUT0 = WB_IN0 + (size_t)EVEN_IN * DM * 2, WB_IN1 = WB_OUT0 + (size_t)DM * 2048 * 2, WB_OUT1 = WB_IN1 + (size_t)ODD_IN * DM * 2, WB_END = WB_OUT1 + (size_t)DM * 2048 * 2;
static_assert(WB_END <= WS_XN, "weight copies overflow their region");
static_assert(wy::WS_RING + wy::RING_TOTAL <= WB_IN1 && XCD_BAR_WORDS * 4 <= 16384 && wy::WS_WYF + (size_t)wy::WYF_WORDS * 4 <= WS_CTX1, "rwkv ring / flag words");

__device__ __forceinline__ unsigned pk2(float lo, float hi) { return (unsigned)f2bf(lo) | ((unsigned)f2bf(hi) << 16); }
__device__ __forceinline__ void transpose_item(const float* W, int K, int N, int ldw, bf16_t* WT, LAS float* scr, int item, int lane) {
    const int nblk = N / 32, kb = item / nblk, nb = item % nblk, k0 = 64 * kb, n0 = 32 * nb;
#pragma unroll
    for (int i = 0; i < 32; ++i) { const int kk = 2 * i + (lane >> 5); scr[kk * 33 + (lane & 31)] = W[(size_t)(k0 + kk) * ldw + n0 + (lane & 31)]; }
    asm volatile("s_waitcnt lgkmcnt(0)" ::: "memory");
    const int c = lane & 7;
#pragma unroll
    for (int j = 0; j < 4; ++j) { const int n = (lane >> 3) + 8 * j; const LAS float* s = scr + (8 * c) * 33 + n;
        v4u o; o.x = pk2(s[0 * 33], s[1 * 33]); o.y = pk2(s[2 * 33], s[3 * 33]); o.z = pk2(s[4 * 33], s[5 * 33]); o.w = pk2(s[6 * 33], s[7 * 33]);
        *(v4u*)(WT + (size_t)(n0 + n) * K + k0 + 8 * c) = o; }
    asm volatile("s_waitcnt lgkmcnt(0)" ::: "memory");
}
__device__ __forceinline__ void p0_weights(const Params& p, LAS unsigned char* lds) {
    const int lane = threadIdx.x & 63, wave = __builtin_amdgcn_readfirstlane(threadIdx.x >> 6);
    LAS float* scr = (LAS float*)(lds + wave * 16384);
    const int gw = blockIdx.x * NWAVES + wave, NGW = gridDim.x * NWAVES;
    constexpr int I_IN0 = (DM / 64) * (EVEN_IN / 32), I_OUT = (2048 / 64) * (DM / 32), I_IN1 = (DM / 64) * (ODD_IN / 32);
    for (int it = gw; it < I_IN0 + I_OUT + I_IN1 + I_OUT; it += NGW) {
        int r = it;
        if (r < I_IN0) { transpose_item(p.ev_w_in, DM, EVEN_IN, EVEN_IN, (bf16_t*)(p.ws + WB_IN0), scr, r, lane); continue; } r -= I_IN0;
        if (r < I_OUT) { transpose_item(p.ev_w_out, 2048, DM, DM, (bf16_t*)(p.ws + WB_OUT0), scr, r, lane); continue; } r -= I_OUT;
        if (r < I_IN1) { transpose_item(p.od_w_in, DM, ODD_IN, ODD_IN, (bf16_t*)(p.ws + WB_IN1), scr, r, lane); continue; } r -= I_IN1;
        transpose_item(p.od_w_out, 2048, DM, DM, (bf16_t*)(p.ws + WB_OUT1), scr, r, lane);
    }
}

template <class Epi> __device__ __forceinline__ void run_gemm(LAS unsigned char* lds, const bf16_t* A, const bf16_t* Bt, int M, int N, int K, const Epi& E, int rot = 0, int lda = 0, int ldb = 0) {
    const int G = (int)gridDim.x;
    pg8::Gemm g{A, Bt, M, N, K, lda, ldb}; pg8::StaticOrder S; S.init(M, N, G, ((int)blockIdx.x + rot) % G);
    pg8::gemm_phase<Epi, pg8::StaticOrder, true, true>(lds, g, S, E);
}
__device__ __forceinline__ int tail_rot(int units) { const int G = (int)gridDim.x; return (G - units % G) % G; }

#ifndef PROBE
#define PROBE 0
#endif
#define REP(bit) for (int rep_ = 0; rep_ < (((PROBE) >> (bit)) & 1) + 1; ++rep_)
__global__ void __launch_bounds__(NTHR, 2) mega(Params p) {
    extern __shared__ __attribute__((aligned(16))) unsigned char lds_raw[];
    cg::grid_group grid = cg::this_grid();
    LAS unsigned char* lds = (LAS unsigned char*)lds_raw;
    const long gsz = (long)gridDim.x * NTHR;
    if (threadIdx.x < 2) *(LAS unsigned*)(lds + LDS_BARW + 4 * threadIdx.x) = 0u;
    __syncthreads();
    const XcdBarrier xbar = xcd_barrier_post((unsigned*)(p.ws + WS_BAR), (volatile LAS unsigned*)(lds + LDS_BARW));
    const bf16_t* wt_in0 = (const bf16_t*)(p.ws + WB_IN0); const bf16_t* wt_out0 = (const bf16_t*)(p.ws + WB_OUT0);
    const bf16_t* wt_in1 = (const bf16_t*)(p.ws + WB_IN1); const bf16_t* wt_out1 = (const bf16_t*)(p.ws + WB_OUT1);
#define X(fn, n) { int t_ = threadIdx.x; asm volatile("" : "+v"(t_)); for (long g = (long)blockIdx.x * NTHR + t_; g < (long)(n); g += gsz) fn(p, g); }
#define SYNC xcd_barrier(xbar);
    if ((PROBE >> 13) & 1) { for (int i_ = 0; i_ < 20; ++i_) xcd_barrier(xbar); }
    REP(14) { el::mod_phase(p, (char*)lds_raw); X(ph_rope_table, N_ROPE) p0_weights(p, lds);
              if (p.out == nullptr) grid.sync();
              SYNC }
    REP(15) { el::prenorm0_phase(p); SYNC }
    REP(2) { run_gemm(lds, ws_xn(p), wt_in0, R, P0W, DM, pg8::EpiBf16<0>{ws_big(p), P0W, nullptr, 0, 0, 1.f});
             run_gemm(lds, ws_xn(p), wt_in0 + (size_t)C_GA * DM, CTXN, 2048, DM, pg8::EpiSiluBf16{(bf16_t*)(p.ws + WS_SIDE), 2048}, tail_rot((R / 256) * (P0W / 256)));
             SYNC }
    el::ropenorm_phase(p); SYNC
    REP(5) { for (int u = blockIdx.x; u < ret::NQ * 4; u += gridDim.x) { const int q = u < (ret::NQ - 2) * 4 ? 2 + u / 4 : (u - (ret::NQ - 2) * 4) / 4; ret::summaries_unit(p, q, u & 3, (char*)lds_raw); } SYNC }
    ret::state_scan(p); SYNC
#define CTX_ATTN_UNIT(head_) do { const int hd_ = (head_), kv_ = hd_ / 4; const bf16_t* P_ = ws_big(p); bf16_t* BR_ = ws_br(p); \
        attn::attn_dense_body<attn::bf16, false>(P_ + C_QB + hd_ * 128, P_ + C_KB + kv_ * 128, P_ + C_VB + kv_ * 128, BR_ + 1024 + hd_ * 128, CTXN, (char*)lds_raw); \
        __syncthreads(); \
        {     \
            int t_ = threadIdx.x; asm volatile("" : "+v"(t_)); const bf16_t* GC = (const bf16_t*)(p.ws + WS_SIDE); \
            const size_t o = (size_t)(t_ >> 1) * 2048 + 1024 + hd_ * 128 + (t_ & 1) * 64; \
            _Pragma("unroll") for (int i_ = 0; i_ < 8; ++i_) { v4u a = *(const v4u*)(BR_ + o + 8 * i_); const v4u b = *(const v4u*)(GC + o + 8 * i_); \
                _Pragma("unroll") for (int q_ = 0; q_ < 4; ++q_) a[q_] = attn::cvtpk(__uint_as_float(a[q_] << 16) * __uint_as_float(b[q_] << 16), __uint_as_float(a[q_] & 0xffff0000u) * __uint_as_float(b[q_] & 0xffff0000u)); \
                *(v4u*)(BR_ + o + 8 * i_) = a; } \
            __syncthreads(); } } while (0)
    const bool ctx_attn_early = gridDim.x >= 16;
    REP(6) { for (int u = blockIdx.x; u < ret::NQ * 4; u += gridDim.x) { const int q = u < (ret::NQ - 2) * 4 ? 2 + u / 4 : (u - (ret::NQ - 2) * 4) / 4; ret::output_unit(p, q, u & 3, (char*)lds_raw); }
             if (ctx_attn_early && (int)blockIdx.x >= (int)gridDim.x - 8) CTX_ATTN_UNIT((int)blockIdx.x - ((int)gridDim.x - 8));
             SYNC }
    REP(0) {
        const int G = (int)gridDim.x, vcu = (G % 8 == 0) ? ((int)blockIdx.x % 8) * (G / 8) + (int)blockIdx.x / 8 : (int)blockIdx.x;
        const int NLAT = (SEQ / 256) * 8, per = (NLAT + G - 1) / G;
        const bf16_t* P = ws_big(p); bf16_t* BR = ws_br(p);
        bool nomax; { int t_ = threadIdx.x; asm volatile("" : "+v"(t_)); const int l_ = t_ & 63; float gq = fmaxf(fabsf(p.q_norm[l_]), fabsf(p.q_norm[64 + l_])), gk = fmaxf(fabsf(p.k_norm[l_]), fabsf(p.k_norm[64 + l_]));
          for (int m_ = 32; m_ >= 1; m_ >>= 1) { gq = fmaxf(gq, __shfl_xor(gq, m_)); gk = fmaxf(gk, __shfl_xor(gk, m_)); }
          nomax = 11.3137085f * 1.4426950409f * 1.02f * gq * gk <= 40.0f; }
        for (int i = 0; i <= per; ++i) {
            int head, row0, seq;
            if (i < per) { const int unit = vcu * per + i; if (unit >= NLAT) continue; const int nqb = SEQ / 256, kv = unit / (4 * nqb), rem = unit % (4 * nqb); head = kv * 4 + rem / nqb; row0 = CTXN + (rem % nqb) * 256; seq = R; }
            else { if (ctx_attn_early || vcu >= 8) break; CTX_ATTN_UNIT(vcu); break; }
            const int kv = head / 4;
            if (nomax) attn::attn_dense_body<attn::bf16, true>(P + (size_t)row0 * P0W + C_QB + head * 128, P + C_KB + kv * 128, P + C_VB + kv * 128, BR + (size_t)row0 * 2048 + 1024 + head * 128, seq, (char*)lds_raw);
            else attn::attn_dense_body<attn::bf16, false>(P + (size_t)row0 * P0W + C_QB + head * 128, P + C_KB + kv * 128, P + C_VB + kv * 128, BR + (size_t)row0 * 2048 + 1024 + head * 128, seq, (char*)lds_raw);
            __syncthreads();
        }
        if (PROBE & 1) xcd_barrier(xbar);
    }
    SYNC
    run_gemm(lds, ws_xn(p) + (size_t)CTXN * DM, wt_in0 + (size_t)C_GA * DM, SEQ, 2048, DM, pg8::EpiGateMul{ws_br(p) + (size_t)CTXN * 2048, 2048});
    {
        pg8::Gemm gk{ws_br(p), wt_out0, 8 * 256, DM, 256, 2048, 2048, 256 * 2}; pg8::StaticOrder S; S.init(8 * 256, DM, (int)gridDim.x, (int)blockIdx.x);
        pg8::gemm_phase<pg8::EpiF32, pg8::StaticOrder, true, true>(lds, gk, S, pg8::EpiF32{(float*)(p.ws + WS_YC), DM}); }
    SYNC
    REP(4) { run_gemm(lds, ws_br(p) + (size_t)CTXN * 2048, wt_out0, SEQ, DM, 2048, pg8::EpiF32{ws_y(p) + (size_t)CTXN * DM, DM}); SYNC }
    REP(15) { el::resid_phase<0>(p); SYNC }
    REP(3) { run_gemm(lds, ws_xn(p), wt_in1 + (size_t)O_RW * DM, R, ZW, DM, pg8::EpiBf16Halo{ws_big(p), ZW, (bf16_t*)(p.ws + rw::WS_HALO)});
             run_gemm(lds, ws_xn(p), wt_in1 + (size_t)(O_NA + 1024) * DM, CTXN, 2048, DM, pg8::EpiBf16<0>{(bf16_t*)(p.ws + WS_SIDE), 2048, nullptr, 0, 0, 1.f}, tail_rot((R / 256) * (ZW / 256)));
             SYNC }
    rw::shift_inplace(p); wy::zero_words(p); SYNC
#ifndef PSKIP
#define PSKIP 0
#endif
    if ((PROBE >> 16) & 1) { wy::phase<1, PSKIP>(p, lds); SYNC wy::zero_words(p); SYNC }
    if ((PROBE >> 17) & 1) { wy::phase<2>(p, lds); SYNC wy::zero_words(p); SYNC }
    if ((PROBE >> 19) & 1) { wy::phase<4, 16>(p, lds); SYNC wy::zero_words(p); SYNC }
    if ((PROBE >> 18) & 1) { wy::phase<3>(p, lds); SYNC wy::zero_words(p); SYNC }
    if (gridDim.x >= 64) wy::phase<0>(p, lds);
    else { for (int b = blockIdx.x; b < 256; b += gridDim.x) rw::scan_block<0>(p, b, lds); }
    SYNC
    rw::finish_phase(p); SYNC
    REP(3) { run_gemm(lds, ws_xn(p) + (size_t)CTXN * DM, wt_in1 + (size_t)O_NA * DM, SEQ, NAW, DM, pg8::EpiBf16<0>{ws_big(p) + (size_t)CTXN * NAW, NAW, nullptr, 0, 0, 1.f}); SYNC }
    REP(7) { for (int u = blockIdx.x; u < (GROWS / 4) * 16; u += gridDim.x) na::na_unit(p, u >> 4, u & 15, (char*)lds_raw); SYNC }
    run_gemm(lds, ws_xn(p) + (size_t)CTXN * DM, wt_in1 + (size_t)O_GC * DM, SEQ, 2048, DM, pg8::EpiGateMul{ws_br(p) + (size_t)CTXN * 2048, 2048}); SYNC
    REP(4) { run_gemm(lds, ws_br(p) + (size_t)CTXN * 2048, wt_out1, SEQ, DM, 2048, pg8::EpiF32{ws_y(p) + (size_t)CTXN * DM, DM}); SYNC }
    el::resid_phase<1>(p);
#undef X
#undef SYNC
}

extern "C" void kernel_launch(void* const* d_in, const int* in_sizes, int n_in, void* d_out, int out_size, void* d_ws, size_t ws_size, hipStream_t stream) {
    static int grid_blocks = 0;
    if (!grid_blocks) {
        int dev = 0, cus = 0, per_cu = 0;
        (void)hipGetDevice(&dev); (void)hipDeviceGetAttribute(&cus, hipDeviceAttributeMultiprocessorCount, dev);
        (void)hipFuncSetAttribute((const void*)mega, hipFuncAttributeMaxDynamicSharedMemorySize, LDS_BYTES);
        (void)hipOccupancyMaxActiveBlocksPerMultiprocessor(&per_cu, mega, NTHR, LDS_BYTES);
        if (per_cu < 1) per_cu = 1;
        grid_blocks = cus * per_cu;
        if (ws_size < WS_END) fprintf(stderr, "kernel_launch: workspace too small: %zu < %zu\n", ws_size, (size_t)WS_END);
    }
    (void)hipMemsetAsync((char*)d_ws + WS_BAR, 0, XCD_BAR_WORDS * 4, stream);
    Params p = make_params(d_in, d_out, d_ws);
    void* args[] = {&p};
    hipError_t e = hipLaunchCooperativeKernel((void*)mega, dim3(grid_blocks), dim3(NTHR), args, LDS_BYTES, stream);
    if (e != hipSuccess) fprintf(stderr, "cooperative launch failed: %s (grid %d)\n", hipGetErrorString(e), grid_blocks);
}

#else
int main(int argc, char** argv) {
    const char* dir = argc > 1 ? argv[1] : "data";
    char path[512]; snprintf(path, 512, "%s/sizes.txt", dir); FILE* f = fopen(path, "r"); if (!f) { printf("no sizes\n"); return 1; }
    std::vector<long> sizes; long v; while (fscanf(f, "%ld", &v) == 1) sizes.push_back(v); fclose(f);
    if (sizes.size() != 31) { printf("bad n inputs %zu\n", sizes.size()); return 1; }
    snprintf(path, 512, "%s/inputs.bin", dir); f = fopen(path, "rb");
    std::vector<std::vector<float>> in(31); std::vector<void*> ptrs(31);
    for (int i = 0; i < 31; ++i) { in[i].resize(sizes[i]); if (fread(in[i].data(), 4, sizes[i], f) != (size_t)sizes[i]) { printf("short read\n"); return 1; } ptrs[i] = in[i].data(); }
    fclose(f);
    if (sizes[0] != (long)SEQ * DM) { printf("SEQ mismatch: build with -DSEQ_LEN=%ld\n", sizes[0] / DM); return 1; }
    std::vector<float> out((size_t)SEQ * DM, 0.f); std::vector<unsigned char> ws(WS_END, 0xAA);
    Params p = make_params(ptrs.data(), out.data(), ws.data());
    auto check = [&](const char* name, const float* got, size_t n) {
        snprintf(path, 512, "%s/%s", dir, name); FILE* g = fopen(path, "rb"); std::vector<float> ref(n); if (fread(ref.data(), 4, n, g) != n) printf("short ref\n"); fclose(g);
        double num = 0, den = 0, mx = 0; for (size_t i = 0; i < n; ++i) { const double d = (double)got[i] - ref[i]; num += d * d; den += (double)ref[i] * ref[i]; if (fabs(d) > mx) mx = fabs(d); }
        printf("%s: rvr=%.3e absmax=%.3e\n", name, num / den, mx); };
    static RwShared sh;
    int phase = 0;
#define X(fn, n) { printf("phase %d %s n=%ld\n", phase++, #fn, (long)(n)); fflush(stdout); _Pragma("omp parallel for schedule(dynamic, 64)") for (long g = 0; g < (long)(n); ++g) fn(p, g); }
#define SYNC
#define SCAN { printf("phase %d scan\n", phase++); fflush(stdout); _Pragma("omp parallel for schedule(dynamic, 1)") for (int b = 0; b < 32; ++b) { RwShared* s = new RwShared; rwkv_scan_block(p, b, *s); delete s; } }
    X(ph_mod, N_MOD) X(ph_rope_table, N_ROPE) X(ph_prenorm<0>, (long)R) X(ph_gemm_l0_qkv, (long)R * P0W) X(ph_ropenorm, N_ROPENORM) X(ph_ret_scan, N_RETSCAN)
    X(ph_ret_merge, N_RETMERGE) X(ph_gqa_attn, N_GQA) X(ph_gemm_l0_gate, (long)R * 2048) X(ph_gemm_l0_out, (long)R * DM) X(ph_resid<0>, (long)R)
    check("x0.bin", out.data(), out.size()); check("ctx0.bin", ws_ctx1(p), (size_t)CTXN * DM);
    X(ph_prenorm<1>, (long)R) X(ph_gemm_l1_rw, (long)R * ZW) SCAN X(ph_rwkv_finish, N_RWFIN) X(ph_gemm_l1_na, (long)R * NAW) X(ph_na, N_NA)
    X(ph_gemm_l1_gate, (long)SEQ * 2048) X(ph_gemm_l1_out, (long)SEQ * DM) X(ph_resid<1>, (long)SEQ)
    check("out.bin", out.data(), out.size());
    return 0;
}
#endif
```

```cpp
#ifdef CPU_EMU
#include <cstdio>
#include <cstdlib>
#include <cstring>
#include <cmath>
#include <vector>
#define DEV static inline
#else
#include <hip/hip_runtime.h>
#include <hip/hip_cooperative_groups.h>
#include <cstdio>
namespace cg = cooperative_groups;
#define DEV __device__ __forceinline__
#endif

#ifndef SEQ_LEN
#define SEQ_LEN 16384
#endif
typedef unsigned short bf16_t;
constexpr int DM = 1024, CTXN = 256, SEQ = SEQ_LEN, R = CTXN + SEQ, GW = 64, GROWS = SEQ / GW;
constexpr int EVEN_IN = 5632, ODD_IN = 8448;
constexpr int P0W = 3584;
constexpr int C_QA = 0, C_KA = 512, C_VA = 1024, C_QB = 2048, C_KB = 3072, C_VB = 3328, C_GA = 3584;
constexpr int ZW = 3328;
constexpr int O_NA = 0, O_RW = 3072, O_GC = 6400;
constexpr int NAW = 3072;
constexpr float NORM_EPS = 1e-6f, GN_EPS = 64e-5f;

constexpr size_t MiB = 1u << 20;
constexpr size_t WS_MODV = 0;
constexpr size_t WS_ROPE = 64 * 1024;
constexpr size_t WS_CTX1 = 1 * MiB;
constexpr size_t WS_WB = 2 * MiB;
constexpr size_t WS_XN = 42 * MiB;
constexpr size_t WS_BIG = WS_XN + (((size_t)R * DM * 2 + MiB - 1) / MiB) * MiB;
constexpr size_t WS_BR = WS_BIG + (((size_t)R * P0W * 2 + MiB - 1) / MiB) * MiB;
constexpr size_t WS_END = WS_BR + (size_t)R * 2048 * 2;
static_assert(SEQ != 16384 || WS_END <= 256 * MiB, "workspace map exceeds 256 MiB");

struct Params {
    const float *x, *c, *ctx, *c_ctx, *w_mod, *b_mod, *g_pre, *g_post, *ev_w_in, *ev_w_out, *dec_f, *dec_b, *q_norm, *k_norm;
    const float *od_w_in, *od_w_out, *rpb, *mu, *w0f, *w2f, *w0b, *w2b, *a0f, *a2f, *a0b, *a2b, *k_k, *k_a, *r_k, *lnx_g, *lnx_b;
    float* out; unsigned char* ws;
};

DEV bf16_t f2bf(float f) { unsigned u; __builtin_memcpy(&u, &f, 4); u = (u + 0x7fffu + ((u >> 16) & 1u)) >> 16; return (bf16_t)u; }
DEV float bf2f(bf16_t h) { unsigned u = ((unsigned)h) << 16; float f; __builtin_memcpy(&f, &u, 4); return f; }
DEV float siluf(float x) { return x / (1.0f + expf(-x)); }
DEV float sigmf(float x) { return 1.0f / (1.0f + expf(-x)); }
DEV float softplusf(float x) { return fmaxf(x, 0.f) + log1pf(expf(-fabsf(x))); }

DEV float* ws_modv(const Params& p) { return (float*)(p.ws + WS_MODV); }
DEV float* ws_rope(const Params& p) { return (float*)(p.ws + WS_ROPE); }
DEV float* ws_ctx1(const Params& p) { return (float*)(p.ws + WS_CTX1); }
DEV bf16_t* ws_xn(const Params& p) { return (bf16_t*)(p.ws + WS_XN); }
DEV bf16_t* ws_big(const Params& p) { return (bf16_t*)(p.ws + WS_BIG); }
DEV float* ws_y(const Params& p) { return (float*)(p.ws + WS_BIG); }
DEV bf16_t* ws_br(const Params& p) { return (bf16_t*)(p.ws + WS_BR); }

constexpr long N_MOD = 2 * 2 * 3072;
DEV void ph_mod(const Params& p, long gid) {
    const int j = (int)(gid % 3072), s = (int)((gid / 3072) % 2), l = (int)(gid / 6144);
    const float* cv = s ? p.c_ctx : p.c; const float* w = p.w_mod + (size_t)l * DM * 3072 + j;
    float acc = 0.f;
    for (int k = 0; k < DM; ++k) acc += siluf(cv[k]) * w[(size_t)k * 3072];
    ws_modv(p)[gid] = acc + p.b_mod[l * 3072 + j];
}
constexpr long N_ROPE = 256 * 32;
DEV void ph_rope_table(const Params& p, long gid) {
    const int f = (int)(gid % 32), pos = (int)(gid / 32);
    const float inv = powf(10000.0f, -(float)f / 32.0f); const float ang = (float)pos * inv;
    ws_rope(p)[gid] = cosf(ang); ws_rope(p)[N_ROPE + gid] = sinf(ang);
}
template <int LAYER> DEV void ph_prenorm(const Params& p, long gid) {
    const int row = (int)gid; const int s = row < CTXN ? 1 : 0;
    const float* src = row < CTXN ? ((LAYER == 0 ? p.ctx : ws_ctx1(p)) + (size_t)row * DM) : ((LAYER == 0 ? p.x : p.out) + (size_t)(row - CTXN) * DM);
    const float* mv = ws_modv(p) + (LAYER * 2 + s) * 3072; const float* g = p.g_pre + LAYER * DM;
    float ss = 0.f;
    for (int k = 0; k < DM; ++k) ss += src[k] * src[k];
    const float rstd = 1.0f / sqrtf(ss / DM + NORM_EPS);
    bf16_t* o = ws_xn(p) + (size_t)row * DM;
    for (int k = 0; k < DM; ++k) o[k] = f2bf(src[k] * rstd * g[k] * (1.0f + mv[1024 + k]) + mv[k]);
}
template <int MODE> DEV void gemm_item(const bf16_t* A, int K, const float* W, int ldw, void* out, int pitch, int row, int col) {
    const bf16_t* a = A + (size_t)row * K; const float* w = W + col; float acc = 0.f;
    for (int k = 0; k < K; ++k) acc += bf2f(a[k]) * w[(size_t)k * ldw];
    if (MODE == 0) ((bf16_t*)out)[(size_t)row * pitch + col] = f2bf(acc);
    else if (MODE == 1) { bf16_t* o = (bf16_t*)out + (size_t)row * pitch + col; *o = f2bf(siluf(acc) * bf2f(*o)); }
    else ((float*)out)[(size_t)row * pitch + col] = acc;
}
DEV void ph_gemm_l0_qkv(const Params& p, long gid) { gemm_item<0>(ws_xn(p), DM, p.ev_w_in, EVEN_IN, ws_big(p), P0W, (int)(gid / P0W), (int)(gid % P0W)); }
DEV void ph_gemm_l0_gate(const Params& p, long gid) { gemm_item<1>(ws_xn(p), DM, p.ev_w_in + C_GA, EVEN_IN, ws_br(p), 2048, (int)(gid / 2048), (int)(gid % 2048)); }
DEV void ph_gemm_l0_out(const Params& p, long gid) { gemm_item<2>(ws_br(p), 2048, p.ev_w_out, DM, ws_y(p), DM, (int)(gid / DM), (int)(gid % DM)); }
DEV void ph_gemm_l1_rw(const Params& p, long gid) { gemm_item<0>(ws_xn(p), DM, p.od_w_in + O_RW, ODD_IN, ws_big(p), ZW, (int)(gid / ZW), (int)(gid % ZW)); }
DEV void ph_gemm_l1_na(const Params& p, long gid) { gemm_item<0>(ws_xn(p), DM, p.od_w_in + O_NA, ODD_IN, ws_big(p), NAW, (int)(gid / NAW), (int)(gid % NAW)); }
DEV void ph_gemm_l1_gate(const Params& p, long gid) { gemm_item<1>(ws_xn(p), DM, p.od_w_in + O_GC, ODD_IN, ws_br(p), 2048, CTXN + (int)(gid / 2048), (int)(gid % 2048)); }
DEV void ph_gemm_l1_out(const Params& p, long gid) { gemm_item<2>(ws_br(p), 2048, p.od_w_out, DM, ws_y(p), DM, CTXN + (int)(gid / DM), (int)(gid % DM)); }

constexpr long N_ROPENORM = (long)R * 18;
DEV void ph_ropenorm(const Params& p, long gid) {
    const int slot = (int)(gid % 18), row = (int)(gid / 18);
    int col; const float* nw = nullptr; float sc = 1.f;
    if (slot < 4) col = C_QA + slot * 128; else if (slot < 8) { col = C_KA + (slot - 4) * 128; sc = 0.08838834764831845f; }
    else if (slot < 16) { col = C_QB + (slot - 8) * 128; nw = p.q_norm; } else { col = C_KB + (slot - 16) * 128; nw = p.k_norm; }
    bf16_t* v = ws_big(p) + (size_t)row * P0W + col;
    if (nw) { float ss = 0.f; for (int d = 0; d < 128; ++d) { const float t = bf2f(v[d]); ss += t * t; } sc = 1.0f / sqrtf(ss / 128.f + NORM_EPS); }
    const bool rot = row >= CTXN; const int t = row - CTXN; const int gr = rot ? t / GW : 0, gc = rot ? t % GW : 0;
    const float* ct = ws_rope(p); const float* st = ct + N_ROPE;
    for (int i = 0; i < 64; ++i) {
        float x1 = bf2f(v[2 * i]) * sc, x2 = bf2f(v[2 * i + 1]) * sc;
        if (nw) { x1 *= nw[2 * i]; x2 *= nw[2 * i + 1]; }
        if (rot) { const int pos = i < 32 ? gr : gc, f = i & 31; const float cs = ct[pos * 32 + f], sn = st[pos * 32 + f]; const float y1 = x1 * cs - x2 * sn, y2 = x1 * sn + x2 * cs; x1 = y1; x2 = y2; }
        v[2 * i] = f2bf(x1); v[2 * i + 1] = f2bf(x2);
    }
}
constexpr long N_RETSCAN = 2 * 4 * 256;
DEV void ph_ret_scan(const Params& p, long gid) {
    const int e = (int)(gid % 256), h = (int)((gid / 256) % 4), dir = (int)(gid / 1024);
    const float g = sigmf((dir ? p.dec_b : p.dec_f)[h]);
    float S[128];
#pragma unroll
    for (int d = 0; d < 128; ++d) S[d] = 0.f;
    const bf16_t* P = ws_big(p); bf16_t* BR = ws_br(p);
    for (int pos = 0; pos < R; ++pos) {
        int row; if (pos < CTXN) row = dir ? CTXN - 1 - pos : pos; else { const int t = pos - CTXN; row = CTXN + (dir ? SEQ - 1 - t : t); }
        const bf16_t* pr = P + (size_t)row * P0W; const float v = bf2f(pr[C_VA + h * 256 + e]);
        const bf16_t* kq = pr + C_KA + h * 128; const bf16_t* qq = pr + C_QA + h * 128; float y = 0.f;
#pragma unroll
        for (int d = 0; d < 128; ++d) { S[d] = g * S[d] + bf2f(kq[d]) * v; y += bf2f(qq[d]) * S[d]; }
        BR[(size_t)row * 2048 + dir * 1024 + h * 256 + e] = f2bf(y);
    }
}
constexpr long N_RETMERGE = (long)R * 4;
DEV void ph_ret_merge(const Params& p, long gid) {
    const int h = (int)(gid % 4), row = (int)(gid / 4);
    bf16_t* b = ws_br(p) + (size_t)row * 2048 + h * 256;
    float s = 0.f; for (int e = 0; e < 256; ++e) s += bf2f(b[e]) + bf2f(b[1024 + e]);
    const float mean = s / 256.f; float q = 0.f;
    for (int e = 0; e < 256; ++e) { const float d = bf2f(b[e]) + bf2f(b[1024 + e]) - mean; q += d * d; }
    const float rstd = 1.0f / sqrtf(q / 256.f + NORM_EPS);
    for (int e = 0; e < 256; ++e) b[e] = f2bf((bf2f(b[e]) + bf2f(b[1024 + e]) - mean) * rstd);
}
constexpr long N_GQA = (long)R * 8 * 8;
DEV void ph_gqa_attn(const Params& p, long gid) {
    const int sl = (int)(gid % 8), row = (int)((gid / 8) % R), head = (int)(gid / (8L * R)), g = head / 4;
    const bf16_t* P = ws_big(p); const int nk = row < CTXN ? CTXN : R;
    float q[128];
    { const bf16_t* qp = P + (size_t)row * P0W + C_QB + head * 128;
#pragma unroll
      for (int d = 0; d < 128; ++d) q[d] = bf2f(qp[d]) * 0.08838834764831845f; }
    float acc[16];
#pragma unroll
    for (int i = 0; i < 16; ++i) acc[i] = 0.f;
    float m = -1e30f, l = 0.f;
    for (int j = 0; j < nk; ++j) {
        const bf16_t* kp = P + (size_t)j * P0W + C_KB + g * 128; float s = 0.f;
#pragma unroll
        for (int d = 0; d < 128; ++d) s += q[d] * bf2f(kp[d]);
        const float mn = fmaxf(m, s), al = expf(m - mn), pe = expf(s - mn);
        const bf16_t* vp = P + (size_t)j * P0W + C_VB + g * 128 + sl * 16;
        l = l * al + pe;
#pragma unroll
        for (int i = 0; i < 16; ++i) acc[i] = acc[i] * al + pe * bf2f(vp[i]);
        m = mn;
    }
    bf16_t* o = ws_br(p) + (size_t)row * 2048 + 1024 + head * 128 + sl * 16; const float il = 1.0f / l;
#pragma unroll
    for (int i = 0; i < 16; ++i) o[i] = f2bf(acc[i] * il);
}
template <int LAYER> DEV void ph_resid(const Params& p, long gid) {
    const int row = LAYER == 0 ? (int)gid : CTXN + (int)gid; const int s = row < CTXN ? 1 : 0;
    const float* y = ws_y(p) + (size_t)row * DM; const float* mv = ws_modv(p) + (LAYER * 2 + s) * 3072 + 2048; const float* g = p.g_post + LAYER * DM;
    float ss = 0.f; for (int k = 0; k < DM; ++k) ss += y[k] * y[k];
    const float rstd = 1.0f / sqrtf(ss / DM + NORM_EPS);
    const float* src; float* dst;
    if (row < CTXN) { src = p.ctx + (size_t)row * DM; dst = ws_ctx1(p) + (size_t)row * DM; }
    else { src = (LAYER == 0 ? p.x : p.out) + (size_t)(row - CTXN) * DM; dst = p.out + (size_t)(row - CTXN) * DM; }
    for (int k = 0; k < DM; ++k) dst[k] = src[k] + mv[k] * (y[k] * rstd * g[k]);
}
DEV float zshift(const bf16_t* Z, const float* mu, int row, int col) {
    const int lo = row < CTXN ? 0 : CTXN, hi = row < CTXN ? CTXN : R;
    const float z = bf2f(Z[(size_t)row * ZW + col]);
    const float pv = row > lo ? bf2f(Z[(size_t)(row - 1) * ZW + col]) : 0.f, nx = row + 1 < hi ? bf2f(Z[(size_t)(row + 1) * ZW + col]) : 0.f;
    return z + (0.5f * (pv + nx) - z) * mu[col];
}
constexpr long N_RWFIN = (long)SEQ * 16;
DEV void ph_rwkv_finish(const Params& p, long gid) {
    const int h = (int)(gid % 16), t = (int)(gid / 16), row = CTXN + t;
    const bf16_t* Z = ws_big(p); bf16_t* b = ws_br(p) + (size_t)row * 2048;
    float bon[2];
    for (int d = 0; d < 2; ++d) {
        const float* a0 = d ? p.a0b : p.a0f; const float* a2 = d ? p.a2b : p.a2f;
        float s = 0.f;
        for (int j = 0; j < 64; ++j) { const int hj = h * 64 + j; float acc = a0[hj];
            for (int m = 0; m < 64; ++m) acc += zshift(Z, p.mu, row, 3200 + d * 64 + m) * a2[m * 1024 + hj];
            const float al = sigmf(acc); const float r = zshift(Z, p.mu, row, hj), k = zshift(Z, p.mu, row, 1024 + hj);
            s += r * (k * (1.0f + (al - 1.0f) * p.k_a[hj])) * p.r_k[hj]; }
        bon[d] = s;
    }
    float sm = 0.f; for (int i = 0; i < 64; ++i) sm += bf2f(b[h * 64 + i]) + bf2f(b[1024 + h * 64 + i]);
    const float mean = sm / 64.f; float q = 0.f;
    for (int i = 0; i < 64; ++i) { const float d = bf2f(b[h * 64 + i]) + bf2f(b[1024 + h * 64 + i]) - mean; q += d * d; }
    const float rstd = 1.0f / sqrtf(q / 64.f + GN_EPS);
    for (int i = 0; i < 64; ++i) { const int hi = h * 64 + i; const float w = bf2f(b[hi]) + bf2f(b[1024 + hi]);
        const float v = zshift(Z, p.mu, row, 2048 + hi);
        b[1024 + hi] = f2bf((w - mean) * rstd * p.lnx_g[hi] + p.lnx_b[hi] + (bon[0] + bon[1]) * v); }
}
constexpr long N_NA = (long)SEQ * 16;
DEV void ph_na(const Params& p, long gid) {
    const int h = (int)(gid % 16), t = (int)(gid / 16), r = t / GW, c = t % GW;
    const bf16_t* P = ws_big(p);
    float q[64];
    { const bf16_t* qp = P + (size_t)(CTXN + t) * NAW + h * 64;
#pragma unroll
      for (int d = 0; d < 64; ++d) q[d] = bf2f(qp[d]) * 0.125f; }
    float acc[64];
#pragma unroll
    for (int d = 0; d < 64; ++d) acc[d] = 0.f;
    float m = -1e30f, l = 0.f;
    const int wh = GROWS < 8 ? GROWS : 8;
    int r0 = r - wh / 2; r0 = r0 < 0 ? 0 : (r0 > GROWS - wh ? GROWS - wh : r0);
    int c0 = c - 8; c0 = c0 < 0 ? 0 : (c0 > GW - 16 ? GW - 16 : c0);
    const float* rp = p.rpb + h * 15 * 31;
    for (int kk = 0; kk < wh * 16 + CTXN; ++kk) {
        int krow; float bias = 0.f;
        if (kk < wh * 16) { const int i = kk / 16, j = kk % 16; krow = CTXN + (r0 + i) * GW + c0 + j; bias = rp[(r0 + i - r + 7) * 31 + (c0 + j - c + 15)]; }
        else krow = kk - wh * 16;
        const bf16_t* kp = P + (size_t)krow * NAW + 1024 + h * 64; float s = bias;
#pragma unroll
        for (int d = 0; d < 64; ++d) s += q[d] * bf2f(kp[d]);
        const float mn = fmaxf(m, s), al = expf(m - mn), pe = expf(s - mn);
        const bf16_t* vp = P + (size_t)krow * NAW + 2048 + h * 64;
        l = l * al + pe;
#pragma unroll
        for (int d = 0; d < 64; ++d) acc[d] = acc[d] * al + pe * bf2f(vp[d]);
        m = mn;
    }
    bf16_t* o = ws_br(p) + (size_t)(CTXN + t) * 2048 + h * 64; const float il = 1.0f / l;
#pragma unroll
    for (int d = 0; d < 64; ++d) o[d] = f2bf(acc[d] * il);
}

constexpr int RW_CH = 16;
struct RwShared { float r[RW_CH][64], w[RW_CH][64], kd[RW_CH][64], v[RW_CH][64], a[RW_CH][64], b[RW_CH][64], tz[RW_CH][64], za[RW_CH][64], kk[RW_CH][64]; };
#ifdef CPU_EMU
#define FOR_THREADS(tid) for (int tid = 0; tid < 64; ++tid)
#define BLOCK_SYNC()
#define TSTATE(tid) S_all[tid]
#else
#define FOR_THREADS(tid) const int tid = threadIdx.x; if (tid < 64)
#define BLOCK_SYNC() __syncthreads()
#define TSTATE(tid) S_reg
#endif
DEV int rw_row(int dir, int pos) { if (pos < CTXN) return dir ? CTXN - 1 - pos : pos; const int t = pos - CTXN; return CTXN + (dir ? SEQ - 1 - t : t); }
#ifdef CPU_EMU
static void rwkv_scan_block(const Params& p, int blk, RwShared& sh) {
    static thread_local float S_all[64][64];
    for (int i = 0; i < 64; ++i) for (int j = 0; j < 64; ++j) S_all[i][j] = 0.f;
#else
__device__ void rwkv_scan_block(const Params& p, int blk, RwShared& sh) {
    float S_reg[64];
#pragma unroll
    for (int j = 0; j < 64; ++j) S_reg[j] = 0.f;
#endif
    const int dir = blk / 16, h = blk % 16;
    const float* w0 = dir ? p.w0b : p.w0f; const float* w2 = dir ? p.w2b : p.w2f; const float* a0 = dir ? p.a0b : p.a0f; const float* a2 = dir ? p.a2b : p.a2f;
    const bf16_t* Z = ws_big(p); bf16_t* BR = ws_br(p);
    for (int p0 = 0; p0 < R; p0 += RW_CH) {
        { FOR_THREADS(tid) { const int hj = h * 64 + tid;
            for (int tt = 0; tt < RW_CH; ++tt) { const int row = rw_row(dir, p0 + tt);
                sh.tz[tt][tid] = tanhf(zshift(Z, p.mu, row, 3072 + dir * 64 + tid)); sh.za[tt][tid] = zshift(Z, p.mu, row, 3200 + dir * 64 + tid);
                sh.r[tt][tid] = zshift(Z, p.mu, row, hj); sh.v[tt][tid] = zshift(Z, p.mu, row, 2048 + hj);
                const float k = zshift(Z, p.mu, row, 1024 + hj); sh.kd[tt][tid] = k; sh.kk[tt][tid] = k * p.k_k[hj]; } } }
        BLOCK_SYNC();
        { FOR_THREADS(tid) { const int hj = h * 64 + tid;
            for (int tt = 0; tt < RW_CH; ++tt) { float aw = w0[hj], aa = a0[hj], nn = 0.f;
                for (int m = 0; m < 64; ++m) { aw += sh.tz[tt][m] * w2[m * 1024 + hj]; aa += sh.za[tt][m] * a2[m * 1024 + hj]; nn += sh.kk[tt][m] * sh.kk[tt][m]; }
                const float lw = -softplusf(-aw) - 0.5f; const float al = sigmf(aa);
                const float kkn = sh.kk[tt][tid] / fmaxf(sqrtf(nn), 1e-12f);
                sh.w[tt][tid] = expf(-expf(lw)); sh.a[tt][tid] = -kkn; sh.b[tt][tid] = kkn * al;
                sh.kd[tt][tid] = sh.kd[tt][tid] * (1.0f + (al - 1.0f) * p.k_a[hj]); } } }
        BLOCK_SYNC();
        { FOR_THREADS(tid) { float* S = TSTATE(tid);
            for (int tt = 0; tt < RW_CH; ++tt) { float sa = 0.f;
#pragma unroll
                for (int j = 0; j < 64; ++j) sa += S[j] * sh.a[tt][j];
                const float vi = sh.v[tt][tid]; float y = 0.f;
#pragma unroll
                for (int j = 0; j < 64; ++j) { S[j] = S[j] * sh.w[tt][j] + sa * sh.b[tt][j] + vi * sh.kd[tt][j]; y += S[j] * sh.r[tt][j]; }
                if (p0 >= CTXN) BR[(size_t)rw_row(dir, p0 + tt) * 2048 + dir * 1024 + h * 64 + tid] = f2bf(y); } } }
        BLOCK_SYNC();
    }
}

static Params make_params(void* const* d_in, void* d_out, void* d_ws) {
    Params p{};
    const float** f = (const float**)&p;
    for (int i = 0; i < 31; ++i) f[i] = (const float*)d_in[i];
    p.out = (float*)d_out; p.ws = (unsigned char*)d_ws; return p;
}


#ifndef CPU_EMU
#define LAS __attribute__((address_space(3)))
#define GAS __attribute__((address_space(1)))
typedef unsigned v4u __attribute__((ext_vector_type(4)));
constexpr int NWAVES = 8, NTHR = NWAVES * 64;
#ifndef PROBE
#define PROBE 0
#endif
#define XB_TMO      128
#define XB_XCNT(j)  (256  + 64 * (j))
#define XB_XSUB(j)  (1280 + 64 * (j))
#define XB_XGEN(j)  (2304 + 64 * (j))
#define XB_TOP      3328
#define XB_TOPGEN   3392
#define XCD_BAR_WORDS 3456
#define XB_SPIN_CAP (1u << 18)

__device__ __forceinline__ unsigned xb_ld(unsigned* p)              { return __hip_atomic_load(p, __ATOMIC_RELAXED, __HIP_MEMORY_SCOPE_AGENT); }
__device__ __forceinline__ unsigned xb_add(unsigned* p, unsigned v) { return __hip_atomic_fetch_add(p, v, __ATOMIC_RELAXED, __HIP_MEMORY_SCOPE_AGENT); }
__device__ __forceinline__ unsigned xb_xcc_id() { return (unsigned)__builtin_amdgcn_s_getreg((3 << 11) | 20) & 0xFu; }
#define XB_SPIN(cond, bar) do { unsigned _sp = 0; while (cond) { __builtin_amdgcn_s_sleep(1); \
    if ((++_sp & 255u) == 0u) { if (xb_ld(&(bar)[XB_TMO])) break; if (_sp > XB_SPIN_CAP) { atomicAdd(&(bar)[XB_TMO], 1u); break; } } } } while (0)

struct XcdBarrier {
    unsigned* bar; unsigned x;
    volatile LAS unsigned* st;
};

__device__ __forceinline__ XcdBarrier xcd_barrier_post(unsigned* bar, volatile LAS unsigned* st) {
    XcdBarrier b; b.bar = bar; b.x = xb_xcc_id(); b.st = st;
    if (threadIdx.x == 0) (void)xb_add(&bar[XB_XCNT(b.x)], 1u);
    return b;
}
__device__ __forceinline__ void xcd_barrier_complete(unsigned* bar, unsigned x, unsigned& nloc, unsigned& nx) {
    const unsigned G = gridDim.x * gridDim.y * gridDim.z;
    unsigned sum, cnt, mine, sp = 0u;
    for (;;) {
        sum = 0u; cnt = 0u; mine = 0u;
#pragma unroll
        for (unsigned j = 0; j < 16; ++j) { const unsigned c = xb_ld(&bar[XB_XCNT(j)]); sum += c; cnt += (c > 0u) ? 1u : 0u; mine = (j == x) ? c : mine; }
        if (sum == G) break;
        __builtin_amdgcn_s_sleep(1);
        if ((++sp & 255u) == 0u) { if (xb_ld(&bar[XB_TMO])) break; if (sp > XB_SPIN_CAP) { atomicAdd(&bar[XB_TMO], 1u); break; } }
    }
    nloc = mine > 0u ? mine : 1u; nx = cnt > 0u ? cnt : 1u;
}

__device__ __forceinline__ void xcd_barrier(const XcdBarrier& b) {
    asm volatile("s_waitcnt vmcnt(0)" ::: "memory");
    __syncthreads();
    if (threadIdx.x == 0) {
        unsigned* bar = b.bar;
        __builtin_amdgcn_s_waitcnt(0);
        unsigned nloc = b.st[0], nx = b.st[1];
        if (nloc == 0u) { xcd_barrier_complete(bar, b.x, nloc, nx); b.st[0] = nloc; b.st[1] = nx; }
        const unsigned old = xb_add(&bar[XB_XSUB(b.x)], 1u);
        const unsigned gen = old / nloc;
        if (old + 1u == (gen + 1u) * nloc) {
            __builtin_amdgcn_fence(__ATOMIC_RELEASE, "agent");
            asm volatile("s_waitcnt vmcnt(0)" ::: "memory");
            const unsigned og = xb_add(&bar[XB_TOP], 1u);
            const unsigned tg = og / nx;
            if (og + 1u == (tg + 1u) * nx) xb_add(&bar[XB_TOPGEN], 1u);
            else XB_SPIN(xb_ld(&bar[XB_TOPGEN]) == tg, bar);
            __builtin_amdgcn_fence(__ATOMIC_ACQUIRE, "agent");
            xb_add(&bar[XB_XGEN(b.x)], 1u);
            asm volatile("s_waitcnt vmcnt(0)" ::: "memory");
        } else {
            XB_SPIN(xb_ld(&bar[XB_XGEN(b.x)]) == gen, bar);
            __builtin_amdgcn_fence(__ATOMIC_ACQUIRE, "agent");
            asm volatile("s_waitcnt vmcnt(0)" ::: "memory");
        }
    }
    __syncthreads();
}
namespace pg8 {
#define PG8_LAS __attribute__((address_space(3)))
typedef unsigned short bf16_t;
typedef short bf16x8 __attribute__((ext_vector_type(8)));
typedef float f32x4 __attribute__((ext_vector_type(4)));
typedef unsigned u32x4 __attribute__((ext_vector_type(4)));
constexpr int BM = 256, BK = 64, HALF = 128, HTB = HALF * BK * 2  , STAGE_BYTES = 8 * HTB, NXCD = 8, WGM = 8;

__host__ __device__ __forceinline__ int lds_byte(int r, int c) { const int st = (r >> 4) * 2 + (c >> 5), rr = r & 15, cc = c & 31, ob = rr * 64 + cc * 2; return st * 1024 + (ob ^ (((ob >> 9) & 1) << 5)); }
__host__ __device__ __forceinline__ void stage_rc(int b, int& R, int& C) { const int st = b / 1024, sb = b % 1024, swz = sb ^ (((sb >> 9) & 1) << 5); R = (st >> 1) * 16 + swz / 64; C = (st & 1) * 32 + (swz % 64) / 2; }
__host__ __device__ __forceinline__ int perm32(int rho) { const int n = rho >> 4, i = rho & 15; return 8 * (i >> 2) + 4 * n + (i & 3); }

struct Unit { int pm, pn; };
struct Gemm { const bf16_t* A; const bf16_t* Bt; int M, N, K; int lda = 0, ldb = 0; int ksl = 0; };

struct StaticOrder {
    int nM, nN, nwg, G, c;
    __host__ __device__ void init(int M, int N, int G_, int c_) { nM = M / BM; nN = N / BM; nwg = nM * nN; G = G_; c = c_; }
    __host__ __device__ bool next(int i, Unit& u) const {
        const long L = (long)i * G + c; if (L >= nwg) return false;
        int wgid = (int)L; { const int q = nwg / NXCD, r = nwg % NXCD, xcd = wgid % NXCD, off = wgid / NXCD; wgid = (xcd < r ? xcd * (q + 1) : r * (q + 1) + (xcd - r) * q) + off; }
        const int nig = WGM * nN, gid = wgid / nig, fm = gid * WGM, gsz = (nM - fm) < WGM ? (nM - fm) : WGM;
        u.pm = fm + ((wgid % nig) % gsz); u.pn = (wgid % nig) / gsz; return true;
    }
    __device__ __forceinline__ void a_ready(const Unit&) const {}
    __device__ __forceinline__ void done(const Unit&) const {}
};

__device__ __forceinline__ unsigned cvt_pk_bf16(float lo, float hi) { unsigned r; asm volatile("v_cvt_pk_bf16_f32 %0, %1, %2" : "=v"(r) : "v"(lo), "v"(hi)); return r; }
typedef float f32x2 __attribute__((ext_vector_type(2)));
__device__ __forceinline__ f32x2 gelu_pk(f32x2 v) {
    const f32x2 av = __builtin_elementwise_abs(v), d = av * 0.2316418882f + 1.0f;
    f32x2 t; t.x = __builtin_amdgcn_rcpf(d.x); t.y = __builtin_amdgcn_rcpf(d.y);
    f32x2 q = t * 0.5307027145f + (-0.7265760135f); q = q * t + 0.7107068705f; q = q * t + (-0.142248368f); q = q * t + 0.127414796f; q = q * t;
    const f32x2 s = (v * v) * (-0.72134752044f);
    f32x2 e; e.x = __builtin_amdgcn_exp2f(s.x); e.y = __builtin_amdgcn_exp2f(s.y);
    const f32x2 m = v * (q * e), r = v - m;
    f32x2 o; o.x = v.x < 0.f ? m.x : r.x; o.y = v.y < 0.f ? m.y : r.y; return o;
}

template <int ACT  > struct EpiBf16 {
    static constexpr bool PERM = true, AFTER_DRAIN = false; static_assert(ACT == 0 || ACT == 1, "EpiBf16: ACT is 0 (none) or 1 (gelu_pk)");
    bf16_t* O; int ldc; const float* bias; int split_cols; size_t split_stride; float scale0;
    __device__ __forceinline__ void operator()(const f32x4 (&acc)[2][2][4][2], const Unit& u, int wr, int wc, int fr, int fq) const {
        const int row0 = u.pm * BM + wr * 64 + fr; int colt = u.pn * BM; bf16_t* base = O;
        float sc = 1.f; if (split_cols) { const int t = colt / split_cols; base += (size_t)t * split_stride; colt -= t * split_cols; if (t == 0) sc = scale0; }
        const int col0 = colt + wc * 32 + 8 * fq, bcol0 = u.pn * BM + wc * 32 + 8 * fq;
        f32x4 bv[2][2];
#pragma unroll
        for (int bj = 0; bj < 2; ++bj)
#pragma unroll
            for (int n = 0; n < 2; ++n) bv[bj][n] = bias ? *(const f32x4*)(bias + bcol0 + bj * HALF + 4 * n) : (f32x4){0.f, 0.f, 0.f, 0.f};
#pragma unroll
        for (int ai = 0; ai < 2; ++ai)
#pragma unroll
            for (int m = 0; m < 4; ++m) { bf16_t* rowp = base + (size_t)(row0 + ai * HALF + m * 16) * ldc + col0;
#pragma unroll
                for (int bj = 0; bj < 2; ++bj) { f32x4 v0 = acc[ai][bj][m][0] + bv[bj][0], v1 = acc[ai][bj][m][1] + bv[bj][1];
                    if (ACT == 1) { f32x2 a = gelu_pk((f32x2){v0[0], v0[1]}), b = gelu_pk((f32x2){v0[2], v0[3]}), c = gelu_pk((f32x2){v1[0], v1[1]}), d = gelu_pk((f32x2){v1[2], v1[3]});
                        v0 = (f32x4){a.x, a.y, b.x, b.y}; v1 = (f32x4){c.x, c.y, d.x, d.y}; }
                    v0 = v0 * sc; v1 = v1 * sc; u32x4 w; w.x = cvt_pk_bf16(v0[0], v0[1]); w.y = cvt_pk_bf16(v0[2], v0[3]); w.z = cvt_pk_bf16(v1[0], v1[1]); w.w = cvt_pk_bf16(v1[2], v1[3]);
                    *(u32x4*)(rowp + bj * HALF) = w; } }
    }
};

typedef float f32x2c_ __attribute__((ext_vector_type(2))); typedef __bf16 bf2c_ __attribute__((ext_vector_type(2)));
__device__ __forceinline__ unsigned cvt_pk_bf16_c(float lo, float hi) { const f32x2c_ v = {lo, hi}; return __builtin_bit_cast(unsigned, __builtin_convertvector(v, bf2c_)); }
struct EpiBf16Halo {
    static constexpr bool PERM = true, AFTER_DRAIN = false;
    bf16_t* O; int ldc; bf16_t* H;
    __device__ __forceinline__ void operator()(const f32x4 (&acc)[2][2][4][2], const Unit& u, int wr, int wc, int fr, int fq) const {
        const int row0 = u.pm * BM + wr * 64 + fr, col0 = u.pn * BM + wc * 32 + 8 * fq;
#pragma unroll
        for (int ai = 0; ai < 2; ++ai)
#pragma unroll
            for (int m = 0; m < 4; ++m) { const int row = row0 + ai * HALF + m * 16; bf16_t* rowp = O + (size_t)row * ldc + col0;
                const bool edge = (m == 0 && fr == 0) || (m == 3 && fr == 15);
                bf16_t* hp = H + ((size_t)(row >> 6) * 2 + (m == 3 ? 1 : 0)) * ldc + col0;
#pragma unroll
                for (int bj = 0; bj < 2; ++bj) { const f32x4 v0 = acc[ai][bj][m][0], v1 = acc[ai][bj][m][1];
                    u32x4 w; w.x = cvt_pk_bf16_c(v0[0], v0[1]); w.y = cvt_pk_bf16_c(v0[2], v0[3]); w.z = cvt_pk_bf16_c(v1[0], v1[1]); w.w = cvt_pk_bf16_c(v1[2], v1[3]);
                    *(u32x4*)(rowp + bj * HALF) = w;
                    if ((m == 0 || m == 3) && edge) *(u32x4*)(hp + bj * HALF) = w; } }
    }
};
__device__ __forceinline__ float silu_fast(float v) { return v * __builtin_amdgcn_rcpf(1.0f + __builtin_amdgcn_exp2f(-1.4426950408889634f * v)); }
struct EpiGateMul {
    static constexpr bool PERM = true, AFTER_DRAIN = false;
    bf16_t* O; int ldc;
    __device__ __forceinline__ void operator()(const f32x4 (&acc)[2][2][4][2], const Unit& u, int wr, int wc, int fr, int fq) const {
        const int row0 = u.pm * BM + wr * 64 + fr, col0 = u.pn * BM + wc * 32 + 8 * fq;
        u32x4 old[2][4][2];
#pragma unroll
        for (int ai = 0; ai < 2; ++ai)
#pragma unroll
            for (int m = 0; m < 4; ++m)
#pragma unroll
                for (int bj = 0; bj < 2; ++bj) old[ai][m][bj] = *(const u32x4*)(O + (size_t)(row0 + ai * HALF + m * 16) * ldc + col0 + bj * HALF);
#pragma unroll
        for (int ai = 0; ai < 2; ++ai)
#pragma unroll
            for (int m = 0; m < 4; ++m) { bf16_t* rowp = O + (size_t)(row0 + ai * HALF + m * 16) * ldc + col0;
#pragma unroll
                for (int bj = 0; bj < 2; ++bj) { const u32x4 od = old[ai][m][bj]; const f32x4 v0 = acc[ai][bj][m][0], v1 = acc[ai][bj][m][1];
                    u32x4 w;
                    w.x = cvt_pk_bf16(silu_fast(v0[0]) * __uint_as_float(od.x << 16), silu_fast(v0[1]) * __uint_as_float(od.x & 0xffff0000u));
                    w.y = cvt_pk_bf16(silu_fast(v0[2]) * __uint_as_float(od.y << 16), silu_fast(v0[3]) * __uint_as_float(od.y & 0xffff0000u));
                    w.z = cvt_pk_bf16(silu_fast(v1[0]) * __uint_as_float(od.z << 16), silu_fast(v1[1]) * __uint_as_float(od.z & 0xffff0000u));
                    w.w = cvt_pk_bf16(silu_fast(v1[2]) * __uint_as_float(od.w << 16), silu_fast(v1[3]) * __uint_as_float(od.w & 0xffff0000u));
                    *(u32x4*)(rowp + bj * HALF) = w; } }
    }
};
struct EpiSiluBf16 {
    static constexpr bool PERM = true, AFTER_DRAIN = false;
    bf16_t* O; int ldc;
    __device__ __forceinline__ void operator()(const f32x4 (&acc)[2][2][4][2], const Unit& u, int wr, int wc, int fr, int fq) const {
        const int row0 = u.pm * BM + wr * 64 + fr, col0 = u.pn * BM + wc * 32 + 8 * fq;
#pragma unroll
        for (int ai = 0; ai < 2; ++ai)
#pragma unroll
            for (int m = 0; m < 4; ++m) { bf16_t* rowp = O + (size_t)(row0 + ai * HALF + m * 16) * ldc + col0;
#pragma unroll
                for (int bj = 0; bj < 2; ++bj) { const f32x4 v0 = acc[ai][bj][m][0], v1 = acc[ai][bj][m][1]; u32x4 w;
                    w.x = cvt_pk_bf16(silu_fast(v0[0]), silu_fast(v0[1])); w.y = cvt_pk_bf16(silu_fast(v0[2]), silu_fast(v0[3]));
                    w.z = cvt_pk_bf16(silu_fast(v1[0]), silu_fast(v1[1])); w.w = cvt_pk_bf16(silu_fast(v1[2]), silu_fast(v1[3]));
                    *(u32x4*)(rowp + bj * HALF) = w; } }
    }
};
struct EpiF32 {
    static constexpr bool PERM = true, AFTER_DRAIN = false;
    float* O; int ldc;
    __device__ __forceinline__ void operator()(const f32x4 (&acc)[2][2][4][2], const Unit& u, int wr, int wc, int fr, int fq) const {
        const int row0 = u.pm * BM + wr * 64 + fr, col0 = u.pn * BM + wc * 32 + 8 * fq;
#pragma unroll
        for (int ai = 0; ai < 2; ++ai)
#pragma unroll
            for (int m = 0; m < 4; ++m) { float* rowp = O + (size_t)(row0 + ai * HALF + m * 16) * ldc + col0;
#pragma unroll
                for (int bj = 0; bj < 2; ++bj) { *(f32x4*)(rowp + bj * HALF) = acc[ai][bj][m][0]; *(f32x4*)(rowp + bj * HALF + 4) = acc[ai][bj][m][1]; } }
    }
};

template <class Epi, class Sched, bool ALIGN_EPI = false, bool SP2 = false>
__device__ __forceinline__ void gemm_phase(PG8_LAS unsigned char* lds, const Gemm g, const Sched& S, const Epi& E) {
    int tid_ = threadIdx.x; asm volatile("" : "+v"(tid_));
    const int tid = tid_, wid = __builtin_amdgcn_readfirstlane(tid >> 6), lane = tid & 63, wr = wid >> 2, wc = wid & 3, fr = lane & 15, fq = lane >> 4;
    const int K = g.K, nt = K / BK, lda = g.lda ? g.lda : K, ldb = g.ldb ? g.ldb : K;
    unsigned voffA[2], voffB[2];
#pragma unroll
    for (int i = 0; i < 2; ++i) { int R, C; stage_rc(tid * 16 + i * 8192, R, C); const int Rb = Epi::PERM ? ((R & ~31) + perm32(R & 31)) : R;
        voffA[i] = (unsigned)(R * lda + C) * 2u; voffB[i] = (unsigned)(Rb * ldb + C) * 2u; }
    const size_t kstep = (size_t)(BK * 2);
    const size_t hstepA = (size_t)HALF * lda * 2, hstepB = (size_t)HALF * ldb * 2;
    const size_t tstepA = g.ksl ? (size_t)g.ksl : 2 * hstepA, tstepB = 2 * hstepB, bpm = (size_t)g.ksl;
    const unsigned ldsw = (unsigned)wid * 1024u;
    const int aoff = lds_byte(wr * 64 + fr, fq * 8), boff = lds_byte(wc * 32 + fr, fq * 8);
#define PG8_SA(b, h) (((b) * 2 + (h)) * HTB)
#define PG8_SB(b, h) ((4 + (b) * 2 + (h)) * HTB)
#define PG8_STAGE(bufoff, gbase, voff) do { _Pragma("unroll") for (int _i = 0; _i < 2; ++_i) \
        __builtin_amdgcn_global_load_lds((const unsigned*)((const char*)(gbase) + (voff)[_i]), (PG8_LAS unsigned*)(lds + (bufoff) + ldsw + _i * 8192), 16, 0, 0); } while (0)
#define PG8_LDA(dst, b, h) do { _Pragma("unroll") for (int m = 0; m < 4; ++m) _Pragma("unroll") for (int k = 0; k < 2; ++k) dst[m][k] = *(const PG8_LAS bf16x8*)(lds + PG8_SA(b, h) + aoff + m * 2048 + k * 1024); } while (0)
#define PG8_LDB(dst, b, h) do { _Pragma("unroll") for (int n = 0; n < 2; ++n) _Pragma("unroll") for (int k = 0; k < 2; ++k) dst[n][k] = *(const PG8_LAS bf16x8*)(lds + PG8_SB(b, h) + boff + n * 2048 + k * 1024); } while (0)
#define PG8_MMA(ai, bj, At, Bt) do { __builtin_amdgcn_s_setprio(1); _Pragma("unroll") for (int m = 0; m < 4; ++m) _Pragma("unroll") for (int n = 0; n < 2; ++n) _Pragma("unroll") for (int k = 0; k < 2; ++k) \
        acc[ai][bj][m][n] = __builtin_amdgcn_mfma_f32_16x16x32_bf16(Bt[n][k], At[m][k], acc[ai][bj][m][n], 0, 0, 0); __builtin_amdgcn_s_setprio(0); } while (0)
#define PG8_WAIT_V(n) asm volatile("s_waitcnt vmcnt(" #n ")" ::: "memory")
#define PG8_WAIT_L(n) asm volatile("s_waitcnt lgkmcnt(" #n ")" ::: "memory")
#define PG8_BAR __builtin_amdgcn_s_barrier()
#define PG8_SCHED __builtin_amdgcn_sched_barrier(0)
    Unit cur, nxt; int ui = 0;
    if (!S.next(0, cur)) return;
    f32x4 acc[2][2][4][2];
#pragma unroll
    for (int a = 0; a < 2; ++a)
#pragma unroll
        for (int b = 0; b < 2; ++b)
#pragma unroll
            for (int m = 0; m < 4; ++m)
#pragma unroll
                for (int n = 0; n < 2; ++n) acc[a][b][m][n] = (f32x4){0.f, 0.f, 0.f, 0.f};
    bf16x8 At[4][2], B0[2][2], B1[2][2];
    const char* cA = (const char*)g.A + (size_t)cur.pm * tstepA; const char* cB = (const char*)g.Bt + (size_t)cur.pn * tstepB + (size_t)cur.pm * bpm;
    S.a_ready(cur);
    if constexpr (SP2) {
        PG8_STAGE(PG8_SB(0, 0), cB, voffB); PG8_STAGE(PG8_SB(0, 1), cB + hstepB, voffB); PG8_STAGE(PG8_SA(0, 0), cA, voffA); PG8_STAGE(PG8_SA(0, 1), cA + hstepA, voffA);
        if (wr == 1) PG8_BAR;
        PG8_WAIT_V(2); PG8_BAR;
        PG8_STAGE(PG8_SB(1, 0), cB + kstep, voffB); PG8_STAGE(PG8_SA(1, 0), cA + kstep, voffA); PG8_STAGE(PG8_SB(1, 1), cB + hstepB + kstep, voffB);
        PG8_WAIT_V(6); PG8_BAR;
    } else {
        PG8_STAGE(PG8_SB(0, 0), cB, voffB); PG8_STAGE(PG8_SA(0, 0), cA, voffA); PG8_STAGE(PG8_SB(0, 1), cB + hstepB, voffB); PG8_STAGE(PG8_SA(0, 1), cA + hstepA, voffA);
        if (wr == 1) PG8_BAR;
        PG8_WAIT_V(4); PG8_BAR;
        PG8_STAGE(PG8_SB(1, 0), cB + kstep, voffB); PG8_STAGE(PG8_SA(1, 0), cA + kstep, voffA); PG8_STAGE(PG8_SB(1, 1), cB + hstepB + kstep, voffB);
        PG8_WAIT_V(6); PG8_BAR;
    }
    for (;;) {
        const bool has_next = S.next(ui + 1, nxt);
        const char* nA = has_next ? (const char*)g.A + (size_t)nxt.pm * tstepA : cA; const char* nB = has_next ? (const char*)g.Bt + (size_t)nxt.pn * tstepB + (size_t)nxt.pm * bpm : cB;
        for (int t = 0; t < nt; t += 2) {
            const bool last = (t == nt - 2);
            const char* a1 = cA + (size_t)(t + 1) * kstep;
            const char* a2 = last ? nA : cA + (size_t)(t + 2) * kstep; const char* b2 = last ? nB : cB + (size_t)(t + 2) * kstep;
            const char* a3 = a2 + kstep; const char* b3 = b2 + kstep;
            if (last && has_next) S.a_ready(nxt);
            if constexpr (SP2) {
            PG8_LDB(B0, 0, 0); PG8_LDB(B1, 0, 1); PG8_SCHED; PG8_LDA(At, 0, 0); PG8_STAGE(PG8_SA(1, 1), a1 + hstepA, voffA);
            PG8_WAIT_V(8); PG8_WAIT_L(0); PG8_BAR; PG8_MMA(0, 0, At, B0); PG8_MMA(0, 1, At, B1); PG8_BAR; PG8_SCHED;
            PG8_LDA(At, 0, 1); PG8_STAGE(PG8_SB(0, 0), b2, voffB); PG8_STAGE(PG8_SB(0, 1), b2 + hstepB, voffB); PG8_STAGE(PG8_SA(0, 0), a2, voffA);
            PG8_WAIT_V(8); PG8_WAIT_L(0); PG8_BAR; PG8_MMA(1, 0, At, B0); PG8_MMA(1, 1, At, B1); PG8_BAR; PG8_SCHED;
            PG8_LDB(B0, 1, 0); PG8_LDB(B1, 1, 1); PG8_SCHED; PG8_LDA(At, 1, 0); PG8_STAGE(PG8_SA(0, 1), a2 + hstepA, voffA);
            PG8_WAIT_V(8); PG8_WAIT_L(0); PG8_BAR; PG8_MMA(0, 0, At, B0); PG8_MMA(0, 1, At, B1); PG8_BAR; PG8_SCHED;
            PG8_LDA(At, 1, 1); PG8_STAGE(PG8_SB(1, 0), b3, voffB); PG8_STAGE(PG8_SB(1, 1), b3 + hstepB, voffB); PG8_STAGE(PG8_SA(1, 0), a3, voffA);
            PG8_WAIT_V(8); PG8_WAIT_L(0); PG8_BAR; PG8_MMA(1, 0, At, B0); PG8_MMA(1, 1, At, B1); PG8_BAR; PG8_SCHED;
            } else {
            PG8_LDB(B0, 0, 0); PG8_SCHED; PG8_LDA(At, 0, 0); PG8_STAGE(PG8_SA(1, 1), a1 + hstepA, voffA);
            PG8_WAIT_L(8); PG8_BAR; PG8_WAIT_L(0); PG8_MMA(0, 0, At, B0); PG8_BAR; PG8_SCHED;
            PG8_LDB(B1, 0, 1); PG8_STAGE(PG8_SB(0, 0), b2, voffB);
            PG8_BAR; PG8_WAIT_L(0); PG8_MMA(0, 1, At, B1); PG8_BAR;
            PG8_LDA(At, 0, 1); PG8_STAGE(PG8_SA(0, 0), a2, voffA);
            PG8_BAR; PG8_WAIT_L(0); PG8_MMA(1, 0, At, B0); PG8_BAR; PG8_SCHED;
            PG8_STAGE(PG8_SB(0, 1), b2 + hstepB, voffB);
            PG8_WAIT_V(6); PG8_BAR; PG8_MMA(1, 1, At, B1); PG8_BAR;
            PG8_LDB(B0, 1, 0); PG8_SCHED; PG8_LDA(At, 1, 0); PG8_STAGE(PG8_SA(0, 1), a2 + hstepA, voffA);
            PG8_WAIT_L(8); PG8_BAR; PG8_WAIT_L(0); PG8_MMA(0, 0, At, B0); PG8_BAR; PG8_SCHED;
            PG8_LDB(B1, 1, 1); PG8_STAGE(PG8_SB(1, 0), b3, voffB);
            PG8_BAR; PG8_WAIT_L(0); PG8_MMA(0, 1, At, B1); PG8_BAR;
            PG8_LDA(At, 1, 1); PG8_STAGE(PG8_SA(1, 0), a3, voffA);
            PG8_BAR; PG8_WAIT_L(0); PG8_MMA(1, 0, At, B0); PG8_BAR; PG8_SCHED;
            PG8_STAGE(PG8_SB(1, 1), b3 + hstepB, voffB);
            PG8_WAIT_V(6); PG8_BAR; PG8_MMA(1, 1, At, B1); PG8_BAR;
            }
        }
        if constexpr (ALIGN_EPI) { if (wr == 0) PG8_BAR; }
        if constexpr (!Epi::AFTER_DRAIN) { E(acc, cur, wr, wc, fr, fq); S.done(cur); }
        if (!has_next) break;
#pragma unroll
        for (int a = 0; a < 2; ++a)
#pragma unroll
            for (int b = 0; b < 2; ++b)
#pragma unroll
                for (int m = 0; m < 4; ++m)
#pragma unroll
                    for (int n = 0; n < 2; ++n) acc[a][b][m][n] = (f32x4){0.f, 0.f, 0.f, 0.f};
        cur = nxt; cA = nA; cB = nB; ++ui;
        if constexpr (ALIGN_EPI) { if (wr == 1) PG8_BAR; }
    }
    PG8_WAIT_V(0);
    if constexpr (!ALIGN_EPI) { if (wr == 0) PG8_BAR; }
    PG8_BAR;
    if constexpr (Epi::AFTER_DRAIN) { E.fused(acc, cur, wr, wc, fr, fq, lds, wid, lane); S.done(cur); }
#undef PG8_SA
#undef PG8_SB
#undef PG8_STAGE
#undef PG8_LDA
#undef PG8_LDB
#undef PG8_MMA
#undef PG8_WAIT_V
#undef PG8_WAIT_L
#undef PG8_BAR
#undef PG8_SCHED
}
}

namespace attn {
using bf16 = unsigned short;
constexpr int   D = 128, NW = 8, QBLK = 32, KVBLK = 64;
constexpr float SCALE = 0.088388347648318440f;
constexpr float THR = 8.f;
constexpr int SDEPTH = 2;
constexpr int LDQ = P0W, LDK = P0W, LDO = 2048;
constexpr size_t SHM_V = KVBLK * D * 2, SHM_K = KVBLK * D * 2, SHM_ATTN = 3 * SHM_V + 2 * SHM_K + NW * 64 * 4;
using bf16x8 = __attribute__((ext_vector_type(8))) short;
using s16x4  = __attribute__((ext_vector_type(4))) short;
using f32x16 = __attribute__((ext_vector_type(16))) float;
using f32x8  = __attribute__((ext_vector_type(8))) float;
using u32x4  = __attribute__((ext_vector_type(4))) unsigned;
#define KSWZ(row, colB) ((row) * 256 + ((colB) ^ (((row) & 7) << 4)))
#define SBAR() __builtin_amdgcn_sched_barrier(0)
__device__ __forceinline__ int crow(int r, int hi) { return (r & 3) + 8 * (r >> 2) + 4 * hi; }
__device__ __forceinline__ unsigned cvtpk(float lo, float hi) {
  unsigned r; asm volatile("v_cvt_pk_bf16_f32 %0, %1, %2" : "=v"(r) : "v"(lo), "v"(hi)); return r;
}
template <typename TIn> struct Stage;
template <> struct Stage<bf16>  { using T = bf16x8;
  __device__ static __forceinline__ T ld8(const bf16* p) { return *reinterpret_cast<const bf16x8*>(p); }
  __device__ static __forceinline__ bf16x8 tobf(T x) { return x; } };
template <> struct Stage<float> { using T = f32x8;
  __device__ static __forceinline__ T ld8(const float* p) { return *reinterpret_cast<const f32x8*>(p); }
  __device__ static __forceinline__ bf16x8 tobf(T x) {
    u32x4 w = {cvtpk(x[0], x[1]), cvtpk(x[2], x[3]), cvtpk(x[4], x[5]), cvtpk(x[6], x[7])}; return *reinterpret_cast<bf16x8*>(&w); } };

template <bool NOMAX> __device__ __forceinline__ void partialSM(f32x16& p0, f32x16& p1, float& m_reg, float& mn, float& alpha) {
  if constexpr (NOMAX) { for (int r = 0; r < 16; ++r) p0[r] = __builtin_amdgcn_exp2f(p0[r]); alpha = 1.f; return; }
  constexpr float C = SCALE * 1.4426950408889634f;
  float pmax = p0[0]; for (int r = 1; r < 16; ++r) pmax = fmaxf(pmax, p0[r]); for (int r = 0; r < 16; ++r) pmax = fmaxf(pmax, p1[r]);
  { auto rr = __builtin_amdgcn_permlane32_swap(__float_as_uint(pmax), __float_as_uint(pmax), false, false);
    pmax = fmaxf(__uint_as_float(rr[0]), __uint_as_float(rr[1])); }
  if (__builtin_expect(__all(pmax - m_reg <= THR / SCALE), 1)) { mn = m_reg; alpha = 1.f; }
  else { mn = fmaxf(m_reg, pmax); alpha = __builtin_amdgcn_exp2f((m_reg - mn) * C); m_reg = mn; }
  float mnC = -mn * C;
  for (int r = 0; r < 16; ++r) p0[r] = fmaf(p0[r], C, mnC); for (int r = 0; r < 16; ++r) p1[r] = fmaf(p1[r], C, mnC);
  for (int r = 0; r < 16; ++r) p0[r] = __builtin_amdgcn_exp2f(p0[r]);
}
__device__ __forceinline__ void finishSM(f32x16& p0, f32x16& p1, float alpha, float& l_reg, bf16x8& pa0, bf16x8& pa1, bf16x8& pa2, bf16x8& pa3) {
  for (int r = 0; r < 16; ++r) p1[r] = __builtin_amdgcn_exp2f(p1[r]);
  float ps = 0; for (int r = 0; r < 16; ++r) ps += p0[r]; for (int r = 0; r < 16; ++r) ps += p1[r];
  { auto rr = __builtin_amdgcn_permlane32_swap(__float_as_uint(ps), __float_as_uint(ps), false, false);
    ps = __uint_as_float(rr[0]) + __uint_as_float(rr[1]); }
  l_reg = l_reg * alpha + ps;
#define PK4(P, BASE, OUT) do { unsigned a0 = cvtpk(P[BASE + 0], P[BASE + 1]), a1 = cvtpk(P[BASE + 2], P[BASE + 3]);   \
    unsigned b0 = cvtpk(P[BASE + 4], P[BASE + 5]), b1 = cvtpk(P[BASE + 6], P[BASE + 7]);                              \
    auto r0 = __builtin_amdgcn_permlane32_swap(a0, b0, false, false); auto r1 = __builtin_amdgcn_permlane32_swap(a1, b1, false, false); \
    u32x4 w = {r0[0], r1[0], r0[1], r1[1]}; OUT = *reinterpret_cast<bf16x8*>(&w); } while (0)
  PK4(p0, 0, pa0); PK4(p0, 8, pa1); PK4(p1, 0, pa2); PK4(p1, 8, pa3);
#undef PK4
}
__device__ __forceinline__ void qkt(f32x16& p0, f32x16& p1, const bf16* Ks, const bf16x8* qr, int r32, int hi) {
  p0 = f32x16{}; p1 = f32x16{};
  for (int d0 = 0; d0 < 8; ++d0) { int cb = (d0 * 16 + hi * 8) * 2;
    bf16x8 b0 = *reinterpret_cast<const bf16x8*>((const char*)Ks + KSWZ(r32, cb));
    bf16x8 b1 = *reinterpret_cast<const bf16x8*>((const char*)Ks + KSWZ(32 + r32, cb));
    p0 = __builtin_amdgcn_mfma_f32_32x32x16_bf16(b0, qr[d0], p0, 0, 0, 0);
    p1 = __builtin_amdgcn_mfma_f32_32x32x16_bf16(b1, qr[d0], p1, 0, 0, 0); }
}
__device__ __forceinline__ int v_st(int k, int c) { const int kk = (k & ~0xC) | ((k & 4) << 1) | ((k & 8) >> 1); return ((kk >> 3) * 4 + (c >> 5)) * 512 + ((kk & 7) * 32 + (c & 31)) * 2; }
__device__ __forceinline__ int v_rd_base(int lane) { return ((lane & 3) << 3) | (((lane >> 2) & 3) << 6) | (((lane >> 4) & 1) << 5) | (((lane >> 5) & 1) << 8); }
constexpr int v_rd_off(int d0, int ks, int half) { return d0 * 512 + ks * 4096 + half * 2048; }
template <int OFF> __device__ __forceinline__ s16x4 tr_read(int vb) {
  s16x4 r; asm volatile("ds_read_b64_tr_b16 %0, %1 offset:%2" : "=&v"(r) : "v"(vb), "i"(OFF) : "memory"); return r;
}
template <int D0> __device__ __forceinline__ void pv_one(f32x16& od, int vb, bf16x8 pa0, bf16x8 pa1, bf16x8 pa2, bf16x8 pa3) {
  const s16x4 l0 = tr_read<v_rd_off(D0, 0, 0)>(vb), h0 = tr_read<v_rd_off(D0, 0, 1)>(vb), l1 = tr_read<v_rd_off(D0, 1, 0)>(vb), h1 = tr_read<v_rd_off(D0, 1, 1)>(vb);
  const s16x4 l2 = tr_read<v_rd_off(D0, 2, 0)>(vb), h2 = tr_read<v_rd_off(D0, 2, 1)>(vb), l3 = tr_read<v_rd_off(D0, 3, 0)>(vb), h3 = tr_read<v_rd_off(D0, 3, 1)>(vb);
  asm volatile("s_waitcnt lgkmcnt(0)" ::: "memory"); SBAR();
#define PK(L, H) (bf16x8){L[0], L[1], L[2], L[3], H[0], H[1], H[2], H[3]}
  od = __builtin_amdgcn_mfma_f32_32x32x16_bf16(pa0, PK(l0, h0), od, 0, 0, 0);
  od = __builtin_amdgcn_mfma_f32_32x32x16_bf16(pa1, PK(l1, h1), od, 0, 0, 0);
  od = __builtin_amdgcn_mfma_f32_32x32x16_bf16(pa2, PK(l2, h2), od, 0, 0, 0);
  od = __builtin_amdgcn_mfma_f32_32x32x16_bf16(pa3, PK(l3, h3), od, 0, 0, 0);
#undef PK
}
__device__ __forceinline__ void pv_d0(f32x16* o, int vb, bf16x8 pa0, bf16x8 pa1, bf16x8 pa2, bf16x8 pa3) {
  pv_one<0>(o[0], vb, pa0, pa1, pa2, pa3); pv_one<1>(o[1], vb, pa0, pa1, pa2, pa3); pv_one<2>(o[2], vb, pa0, pa1, pa2, pa3); pv_one<3>(o[3], vb, pa0, pa1, pa2, pa3);
}

template <typename TQ, bool NOMAX>
__device__ __forceinline__ void attn_dense_body(const TQ* __restrict__ Qb, const bf16* __restrict__ Kh, const bf16* __restrict__ Vh,
                                                bf16* __restrict__ Ob, int seq, char* lds) {
  using St = Stage<bf16>; using SQ = Stage<TQ>;
  int tid_ = threadIdx.x; asm volatile("" : "+v"(tid_));
  const int tid = tid_, wid = tid >> 6, lane = tid & 63, r32 = lane & 31, hi = lane >> 5;
  bf16* V_lds = (bf16*)lds; bf16* K_lds = (bf16*)(lds + 3 * SHM_V);
  float* ws = (float*)(lds + 3 * SHM_V + 2 * SHM_K) + wid * 64; float* li_l = ws; float* al_l = ws + 32;
  float m_reg = -1e30f, l_reg = 0; f32x16 o[4] = {}; bf16x8 qr[8];
  const TQ* Qw = Qb + (long)(wid * QBLK + r32) * LDQ + hi * 8;
#pragma unroll
  for (int d0 = 0; d0 < 8; ++d0) { qr[d0] = SQ::tobf(SQ::ld8(Qw + d0 * 16));
    if constexpr (NOMAX) { constexpr float C = SCALE * 1.4426950408889634f; u32x4 w = *reinterpret_cast<u32x4*>(&qr[d0]);
      for (int i = 0; i < 4; ++i) w[i] = cvtpk(__uint_as_float(w[i] << 16) * C, __uint_as_float(w[i] & 0xffff0000u) * C);
      qr[d0] = *reinterpret_cast<bf16x8*>(&w); } }
  const int sr = tid >> 4, sc = (tid & 15) * 8, vst0 = v_st(sr, sc), vst1 = v_st(32 + sr, sc);
  const int vb0 = (int)(uintptr_t)V_lds + v_rd_base(lane);
  struct { typename St::T vs0, vs1, ks0, ks1; } sr_[SDEPTH];
#define SLOAD(i, k0) do { sr_[i].vs0 = St::ld8(&Vh[(long)((k0) + sr) * LDK + sc]); sr_[i].vs1 = St::ld8(&Vh[(long)((k0) + 32 + sr) * LDK + sc]); \
    sr_[i].ks0 = St::ld8(&Kh[(long)((k0) + sr) * LDK + sc]); sr_[i].ks1 = St::ld8(&Kh[(long)((k0) + 32 + sr) * LDK + sc]); } while (0)
#define SWRITE(b, voff, i) do { *(bf16x8*)((char*)V_lds + (voff) + vst0) = St::tobf(sr_[i].vs0);          \
    *(bf16x8*)((char*)V_lds + (voff) + vst1) = St::tobf(sr_[i].vs1); int kc = sc * 2;               \
    *(bf16x8*)((char*)K_lds + (b) * SHM_K + KSWZ(sr, kc)) = St::tobf(sr_[i].ks0);                       \
    *(bf16x8*)((char*)K_lds + (b) * SHM_K + KSWZ(32 + sr, kc)) = St::tobf(sr_[i].ks1); } while (0)
#define SWAIT() do { if constexpr (SDEPTH == 2) asm volatile("s_waitcnt vmcnt(4)" ::: "memory"); else asm volatile("s_waitcnt vmcnt(0)" ::: "memory"); } while (0)
#define RESC(a) do { if (!NOMAX && __any((a) < 1.f)) { if (hi == 0) al_l[r32] = (a); asm volatile("s_waitcnt lgkmcnt(0)" ::: "memory"); \
    for (int d = 0; d < 4; ++d) for (int r = 0; r < 16; ++r) o[d][r] *= al_l[crow(r, hi)]; } } while (0)
  f32x16 pA0, pA1, pB0, pB1; float mnA, mnB, alA, alB; bf16x8 pa0, pa1, pa2, pa3; const int NT = seq / KVBLK;
  constexpr int SE = 0, SO = SDEPTH - 1;
  SLOAD(SE, 0); asm volatile("s_waitcnt vmcnt(0)" ::: "memory"); SWRITE(0, 0, SE); __syncthreads();
  qkt(pA0, pA1, K_lds, qr, r32, hi); partialSM<NOMAX>(pA0, pA1, m_reg, mnA, alA);
  SLOAD(SO, KVBLK); if constexpr (SDEPTH == 2) { if (2 < NT) SLOAD(SE, 2 * KVBLK); }
  SWAIT(); SWRITE(1, (int)SHM_V, SO); __syncthreads();
  int vr = 0, vw = 2 * (int)SHM_V;
#define VNEXT(x) ((x) == 2 * (int)SHM_V ? 0 : (x) + (int)SHM_V)
  for (int j = 1; j + 1 < NT; j += 2) {
    SBAR(); qkt(pB0, pB1, (bf16*)((char*)K_lds + SHM_K), qr, r32, hi);
    finishSM(pA0, pA1, alA, l_reg, pa0, pa1, pa2, pa3); SBAR();
    SLOAD(SO, (j + SDEPTH) * KVBLK); SBAR();
    pv_d0(o, vb0 + vr, pa0, pa1, pa2, pa3); partialSM<NOMAX>(pB0, pB1, m_reg, mnB, alB);
    SWAIT(); SWRITE(0, vw, SE); vr = VNEXT(vr); vw = VNEXT(vw);
    RESC(alB); __syncthreads();
    SBAR(); qkt(pA0, pA1, K_lds, qr, r32, hi);
    finishSM(pB0, pB1, alB, l_reg, pa0, pa1, pa2, pa3); SBAR();
    if (SDEPTH == 1 || j + 3 < NT) SLOAD(SE, (j + 1 + SDEPTH) * KVBLK); SBAR();
    pv_d0(o, vb0 + vr, pa0, pa1, pa2, pa3); partialSM<NOMAX>(pA0, pA1, m_reg, mnA, alA);
    SWAIT(); SWRITE(1, vw, SO); vr = VNEXT(vr); vw = VNEXT(vw);
    RESC(alA); __syncthreads();
  }
  SBAR(); qkt(pB0, pB1, (bf16*)((char*)K_lds + SHM_K), qr, r32, hi);
  finishSM(pA0, pA1, alA, l_reg, pa0, pa1, pa2, pa3); SBAR();
  pv_d0(o, vb0 + vr, pa0, pa1, pa2, pa3); partialSM<NOMAX>(pB0, pB1, m_reg, mnB, alB);
  vr = VNEXT(vr); RESC(alB);
  finishSM(pB0, pB1, alB, l_reg, pa0, pa1, pa2, pa3); SBAR();
  pv_d0(o, vb0 + vr, pa0, pa1, pa2, pa3);
#undef VNEXT
  if (hi == 0) li_l[r32] = l_reg; asm volatile("s_waitcnt lgkmcnt(0)" ::: "memory");
  float rli[16];
#pragma unroll
  for (int r = 0; r < 16; ++r) rli[r] = __builtin_amdgcn_rcpf(li_l[crow(r, hi)]);
  bf16* Ow = Ob + (long)(wid * QBLK) * LDO;
#pragma unroll
  for (int r = 0; r < 16; ++r) { int orow = crow(r, hi);
    for (int d0 = 0; d0 < 4; ++d0) Ow[(long)orow * LDO + d0 * 32 + r32] = (bf16)(cvtpk(o[d0][r] * rli[r], 0.f) & 0xffffu); }
#undef SLOAD
#undef SWRITE
#undef SWAIT
#undef RESC
}
#undef KSWZ
#undef SBAR
}

namespace rw {
typedef short bf16x8 __attribute__((ext_vector_type(8)));
typedef float f32x4 __attribute__((ext_vector_type(4)));
typedef unsigned u32x4 __attribute__((ext_vector_type(4)));
typedef unsigned u32x2 __attribute__((ext_vector_type(2)));
constexpr int CH = 32, NC = R / CH;
static_assert(NC % 2 == 0, "the prep loop is unrolled by two");
constexpr int BUFB = 5 * 8192 + 1024;
constexpr int O_W = 0, O_B = 8192, O_KD = 16384, O_A = 24576, O_R = 32768, O_V = 40960;
constexpr int PITCH = 72;
constexpr int L_SCR = 2 * BUFB, SCRB = 2 * 16 * PITCH * 2;
constexpr int L_W2T = L_SCR + 4 * SCRB, L_A2T = L_W2T + 64 * PITCH * 2;
constexpr int L_Y = L_A2T + 64 * PITCH * 2;
constexpr int L_CST = L_Y + 2 * 2 * CH * 64 * 4;
constexpr int L_END = L_CST + 10 * 64 * 4;
static_assert(L_END <= 163840 - 64 && (BUFB % 16) == 0 && (L_SCR % 16) == 0 && (SCRB % 16) == 0 && (L_W2T % 16) == 0 && (L_A2T % 16) == 0 && (L_Y % 16) == 0 && (L_CST % 16) == 0, "rwkv LDS map");
constexpr size_t WS_BON = 15 * MiB;

template <int CTRL> __device__ __forceinline__ float dppmov(float x) { return __builtin_bit_cast(float, __builtin_amdgcn_update_dpp(0, __builtin_bit_cast(int, x), CTRL, 0xF, 0xF, true)); }
__device__ __forceinline__ float allreduce8(float x) {
    x += dppmov<0xB1>(x);
    x += dppmov<0x4E>(x);
    x += dppmov<0x141>(x);
    return x;
}
__device__ __forceinline__ float allreduce16(float x) { x = allreduce8(x); x += dppmov<0x140>(x); return x; }
__device__ __forceinline__ float fast_tanh(float x) { const float e = __builtin_amdgcn_exp2f(2.885390081777927f * x); return 1.0f - 2.0f * __builtin_amdgcn_rcpf(1.0f + e); }
__device__ __forceinline__ float bflo(unsigned u) { return __uint_as_float(u << 16); }
__device__ __forceinline__ float bfhi(unsigned u) { return __uint_as_float(u & 0xffff0000u); }
__device__ __forceinline__ unsigned pkbf(float lo, float hi) { unsigned r; asm volatile("v_cvt_pk_bf16_f32 %0, %1, %2" : "=v"(r) : "v"(lo), "v"(hi)); return r; }

constexpr int SEGR = 64, NSEG = R / SEGR, NCG = (ZW + 511) / 512;
constexpr size_t WS_HALO = 38 * MiB;
static_assert(WS_HALO + (size_t)NSEG * 2 * ZW * 2 <= WS_XN, "halo rows overflow");
__device__ __forceinline__ void shift_halo(const Params& p) {
    int tid_ = threadIdx.x; asm volatile("" : "+v"(tid_));
    const bf16_t* Z = ws_big(p); bf16_t* H = (bf16_t*)(p.ws + WS_HALO);
    for (int it = (int)blockIdx.x * NTHR + tid_; it < NSEG * 2 * (ZW / 8); it += (int)gridDim.x * NTHR) {
        const int c8 = it % (ZW / 8), w = (it / (ZW / 8)) & 1, seg = it / (2 * (ZW / 8));
        *(u32x4*)(H + ((size_t)seg * 2 + w) * ZW + c8 * 8) = *(const u32x4*)(Z + (size_t)(seg * SEGR + (w ? SEGR - 1 : 0)) * ZW + c8 * 8);
    }
}
__device__ __forceinline__ u32x4 shift8(u32x4 c, u32x4 pv, u32x4 nx, f32x4 m0, f32x4 m1) {
    u32x4 o;
#pragma unroll
    for (int q = 0; q < 4; ++q) { const float ml = q < 2 ? m0[2 * q] : m1[2 * q - 4], mh = q < 2 ? m0[2 * q + 1] : m1[2 * q - 3];
        const float zl = bflo(c[q]), zh = bfhi(c[q]);
        o[q] = pkbf(zl + (0.5f * (bflo(pv[q]) + bflo(nx[q])) - zl) * ml, zh + (0.5f * (bfhi(pv[q]) + bfhi(nx[q])) - zh) * mh); }
    return o;
}
__device__ __forceinline__ void shift_inplace(const Params& p) {
    int tid_ = threadIdx.x; asm volatile("" : "+v"(tid_));
    const int lane = tid_ & 63, gw = (int)blockIdx.x * NWAVES + (tid_ >> 6), ngw = (int)gridDim.x * NWAVES;
    bf16_t* Z = ws_big(p); const bf16_t* H = (const bf16_t*)(p.ws + WS_HALO);
    for (int u = gw; u < NSEG * NCG; u += ngw) {
        const int seg = u / NCG, col = (u % NCG) * 512 + lane * 8;
        if (col < ZW) {
            const f32x4 m0 = *(const f32x4*)(p.mu + col), m1 = *(const f32x4*)(p.mu + col + 4);
            const bool first = seg == 0 || seg == CTXN / SEGR, last = seg == CTXN / SEGR - 1 || seg == NSEG - 1;
            bf16_t* zr = Z + (size_t)seg * SEGR * ZW + col;
            u32x4 pv = first ? (u32x4){0u, 0u, 0u, 0u} : *(const u32x4*)(H + ((size_t)(seg - 1) * 2 + 1) * ZW + col);
            const u32x4 tail = last ? (u32x4){0u, 0u, 0u, 0u} : *(const u32x4*)(H + ((size_t)(seg + 1) * 2) * ZW + col);
            u32x4 c0 = *(const u32x4*)zr, c1 = *(const u32x4*)(zr + ZW), c2 = *(const u32x4*)(zr + 2 * ZW), c3 = *(const u32x4*)(zr + 3 * ZW);
            u32x4 n0 = *(const u32x4*)(zr + 4 * ZW), n1 = *(const u32x4*)(zr + 5 * ZW), n2 = *(const u32x4*)(zr + 6 * ZW), n3 = *(const u32x4*)(zr + 7 * ZW);
            for (int r = 0; r < SEGR; r += 4) {
                u32x4 m0_ = tail, m1_ = tail, m2_ = tail, m3_ = tail;
                if (r + 8 < SEGR) { m0_ = *(const u32x4*)(zr + (size_t)(r + 8) * ZW); m1_ = *(const u32x4*)(zr + (size_t)(r + 9) * ZW); m2_ = *(const u32x4*)(zr + (size_t)(r + 10) * ZW); m3_ = *(const u32x4*)(zr + (size_t)(r + 11) * ZW); }
                const u32x4 nx = (r + 4 < SEGR) ? n0 : tail;
                const u32x4 o0 = shift8(c0, pv, c1, m0, m1), o1 = shift8(c1, c0, c2, m0, m1), o2 = shift8(c2, c1, c3, m0, m1), o3 = shift8(c3, c2, nx, m0, m1);
                *(u32x4*)(zr + (size_t)r * ZW) = o0; *(u32x4*)(zr + (size_t)(r + 1) * ZW) = o1; *(u32x4*)(zr + (size_t)(r + 2) * ZW) = o2; *(u32x4*)(zr + (size_t)(r + 3) * ZW) = o3;
                pv = c3; c0 = n0; c1 = n1; c2 = n2; c3 = n3; n0 = m0_; n1 = m1_; n2 = m2_; n3 = m3_;
            }
        }
    }
}

struct Raw { u32x4 c[5]; };

template <int MODE> __device__ __forceinline__ void scan_block(const Params& p, int blk, LAS unsigned char* lds) {
    int tid_ = threadIdx.x; asm volatile("" : "+v"(tid_));
    const int tid = tid_, lane = tid & 63, wave = __builtin_amdgcn_readfirstlane(tid >> 6);
    const int dir = blk >> 7, h = (blk >> 3) & 15, eighth = blk & 7;
    const float* w0 = dir ? p.w0b : p.w0f; const float* w2 = dir ? p.w2b : p.w2f; const float* a0 = dir ? p.a0b : p.a0f; const float* a2 = dir ? p.a2b : p.a2f;
    const bf16_t* Z = ws_big(p); bf16_t* BR = ws_br(p); float* bon = (float*)(p.ws + WS_BON) + ((size_t)dir * 16 + h) * SEQ;
    { const int m = tid >> 3, j8 = (tid & 7) * 8;
      const f32x4 wa = *(const f32x4*)(w2 + (size_t)m * 1024 + h * 64 + j8), wb = *(const f32x4*)(w2 + (size_t)m * 1024 + h * 64 + j8 + 4);
      const f32x4 aa = *(const f32x4*)(a2 + (size_t)m * 1024 + h * 64 + j8), ab = *(const f32x4*)(a2 + (size_t)m * 1024 + h * 64 + j8 + 4);
      LAS bf16_t* yw = (LAS bf16_t*)(lds + L_W2T); LAS bf16_t* ya = (LAS bf16_t*)(lds + L_A2T);
#pragma unroll
      for (int q = 0; q < 4; ++q) { yw[(j8 + q) * PITCH + m] = f2bf(wa[q]); yw[(j8 + 4 + q) * PITCH + m] = f2bf(wb[q]); ya[(j8 + q) * PITCH + m] = f2bf(aa[q]); ya[(j8 + 4 + q) * PITCH + m] = f2bf(ab[q]); }
      for (int i = tid; i < 4 * SCRB / 4; i += NTHR) *(LAS unsigned*)(lds + L_SCR + i * 4) = 0u;
      for (int i = tid; i < 640; i += NTHR) { const int g = i >> 6, cc = i & 63, hc = h * 64 + cc; float v;
          if (g < 3) v = p.mu[g * 1024 + hc]; else if (g == 3) v = p.mu[3072 + dir * 64 + cc]; else if (g == 4) v = p.mu[3200 + dir * 64 + cc];
          else if (g == 5) v = w0[hc]; else if (g == 6) v = a0[hc]; else if (g == 7) v = p.k_k[hc]; else if (g == 8) v = p.k_a[hc]; else v = p.r_k[hc];
          *(LAS float*)(lds + L_CST + i * 4) = v; } }
    __syncthreads();
    if ((wave & 2) != 0) {
        const int pw = (wave & 1) + ((wave >> 2) << 1), tq = lane >> 3, c8 = (lane & 7) * 8, hj = h * 64 + c8, tslot = pw * 8 + tq;
        const int gcol[5] = {hj, 1024 + hj, 2048 + hj, 3072 + dir * 64 + c8, 3200 + dir * 64 + c8};
        LAS unsigned char* scr = lds + L_SCR + pw * SCRB;
#define RW_CST(g, hh) (*(LAS f32x4*)(lds + L_CST + ((g) * 64 + c8 + 4 * (hh)) * 4))
#define RW_LOADRAW(raw, cc) do { const bf16_t* zr_ = Z + (size_t)rw_row(dir, (cc) * CH + tslot) * ZW; \
            _Pragma("unroll") for (int g = 0; g < 5; ++g) raw.c[g] = *(const u32x4*)(zr_ + gcol[g]); } while (0)
        Raw rawA, rawB;
        f32x4 cw0[2], ca0[2], ckk[2], cka[2], crk[2];
#pragma unroll
        for (int hh = 0; hh < 2; ++hh) { cw0[hh] = RW_CST(5, hh); ca0[hh] = RW_CST(6, hh); ckk[hh] = RW_CST(7, hh); cka[hh] = RW_CST(8, hh); crk[hh] = RW_CST(9, hh);
            asm volatile("" : "+v"(cw0[hh]), "+v"(ca0[hh]), "+v"(ckk[hh]), "+v"(cka[hh]), "+v"(crk[hh])); }
        if (MODE == 0 || MODE == 2 || MODE == 3 || MODE == 9) { RW_LOADRAW(rawA, 0); RW_LOADRAW(rawB, 1); }
#define RW_PREP_ITER(RAWSET, cc_) do { \
            if (MODE == 0 || MODE == 2 || MODE == 3 || MODE == 9) { \
            const int cn = (cc_) + 1; LAS unsigned char* buf = lds + (cn & 1) * BUFB; const int p0 = cn * CH; const bool latent = p0 >= CTXN; \
            f32x4 rr[2], kv[2]; \
            { const u32x4 u = RAWSET.c[0]; rr[0] = (f32x4){bflo(u.x), bfhi(u.x), bflo(u.y), bfhi(u.y)}; rr[1] = (f32x4){bflo(u.z), bfhi(u.z), bflo(u.w), bfhi(u.w)}; \
              *(LAS f32x4*)(buf + O_R + (tslot * 64 + c8) * 4) = rr[0]; *(LAS f32x4*)(buf + O_R + (tslot * 64 + c8) * 4 + 16) = rr[1]; } \
            { const u32x4 u = RAWSET.c[1]; kv[0] = (f32x4){bflo(u.x), bfhi(u.x), bflo(u.y), bfhi(u.y)}; kv[1] = (f32x4){bflo(u.z), bfhi(u.z), bflo(u.w), bfhi(u.w)}; } \
            if ((lane & 7) == eighth) { const u32x4 u = RAWSET.c[2]; *(LAS f32x4*)(buf + O_V + tslot * 32) = (f32x4){bflo(u.x), bfhi(u.x), bflo(u.y), bfhi(u.y)}; *(LAS f32x4*)(buf + O_V + tslot * 32 + 16) = (f32x4){bflo(u.z), bfhi(u.z), bflo(u.w), bfhi(u.w)}; } \
            { const u32x4 u = RAWSET.c[3]; u32x4 o; \
              o.x = pkbf(fast_tanh(bflo(u.x)), fast_tanh(bfhi(u.x))); o.y = pkbf(fast_tanh(bflo(u.y)), fast_tanh(bfhi(u.y))); o.z = pkbf(fast_tanh(bflo(u.z)), fast_tanh(bfhi(u.z))); o.w = pkbf(fast_tanh(bflo(u.w)), fast_tanh(bfhi(u.w))); \
              *(LAS u32x4*)(scr + (tq * PITCH + c8) * 2) = o; *(LAS u32x4*)(scr + 16 * PITCH * 2 + (tq * PITCH + c8) * 2) = RAWSET.c[4]; } \
            if (cn + 2 < NC) RW_LOADRAW(RAWSET, cn + 2);              \
            asm volatile("s_waitcnt lgkmcnt(0)" ::: "memory"); \
            { const int r16 = lane & 15, quad = lane >> 4; f32x4 acc[2][4]; \
_Pragma("unroll") \
              for (int lora = 0; lora < 2; ++lora) { \
                  LAS unsigned char* X = scr + lora * 16 * PITCH * 2 + (r16 * PITCH + quad * 8) * 2; \
                  const bf16x8 x0 = *(LAS bf16x8*)X, x1 = *(LAS bf16x8*)(X + 64); \
_Pragma("unroll") \
                  for (int jt = 0; jt < 4; ++jt) { \
                      LAS unsigned char* Y = lds + (lora ? L_A2T : L_W2T) + ((jt * 16 + r16) * PITCH + quad * 8) * 2; \
                      acc[lora][jt] = (f32x4){0.f, 0.f, 0.f, 0.f}; \
                      acc[lora][jt] = __builtin_amdgcn_mfma_f32_16x16x32_bf16(x0, *(LAS bf16x8*)Y, acc[lora][jt], 0, 0, 0); \
                      acc[lora][jt] = __builtin_amdgcn_mfma_f32_16x16x32_bf16(x1, *(LAS bf16x8*)(Y + 64), acc[lora][jt], 0, 0, 0); } } \
              if (quad < 2) { \
_Pragma("unroll") \
                  for (int lora = 0; lora < 2; ++lora) \
_Pragma("unroll") \
                      for (int jt = 0; jt < 4; ++jt) \
_Pragma("unroll") \
                          for (int r = 0; r < 4; ++r) *(LAS float*)(buf + (lora ? O_B : O_W) + ((pw * 8 + quad * 4 + r) * 64 + jt * 16 + r16) * 4) = acc[lora][jt][r]; } } \
            asm volatile("s_waitcnt lgkmcnt(0)" ::: "memory"); \
            { float bs = 0.f, nn = 0.f; f32x4 kk[2], al[2]; \
_Pragma("unroll") \
              for (int hh = 0; hh < 2; ++hh) { const int off = (tslot * 64 + c8 + 4 * hh) * 4; \
                  const f32x4 aw = *(LAS f32x4*)(buf + O_W + off) + cw0[hh], aa = *(LAS f32x4*)(buf + O_B + off) + ca0[hh]; \
                  f32x4 wv; \
_Pragma("unroll") \
                  for (int q = 0; q < 4; ++q) { const float sg = __builtin_amdgcn_rcpf(1.0f + __builtin_amdgcn_exp2f(-1.4426950408889634f * aw[q])); \
                      wv[q] = __builtin_amdgcn_exp2f(-0.8750612633917f * sg); al[hh][q] = __builtin_amdgcn_rcpf(1.0f + __builtin_amdgcn_exp2f(-1.4426950408889634f * aa[q])); kk[hh][q] = kv[hh][q] * ckk[hh][q]; nn += kk[hh][q] * kk[hh][q]; } \
                  *(LAS f32x4*)(buf + O_W + off) = wv; } \
              nn = allreduce8(nn); \
              const float inv = __builtin_amdgcn_rsqf(fmaxf(nn, 1e-24f)); \
_Pragma("unroll") \
              for (int hh = 0; hh < 2; ++hh) { const int off = (tslot * 64 + c8 + 4 * hh) * 4; \
                  const f32x4 r = rr[hh]; \
                  f32x4 av, bv, kd; \
_Pragma("unroll") \
                  for (int q = 0; q < 4; ++q) { const float kn = kk[hh][q] * inv; av[q] = -kn; bv[q] = kn * al[hh][q]; kd[q] = kv[hh][q] * (1.0f + (al[hh][q] - 1.0f) * cka[hh][q]); bs += r[q] * kd[q] * crk[hh][q]; } \
                  *(LAS f32x4*)(buf + O_B + off) = bv; *(LAS f32x4*)(buf + O_KD + off) = kd; *(LAS f32x4*)(buf + O_A + off) = av; } \
              bs = allreduce8(bs); \
              if (MODE == 0 && latent && eighth == 0 && (lane & 7) == 0) bon[rw_row(dir, p0 + tslot) - CTXN] = bs; } \
            } \
            __syncthreads(); \
        } while (0)
        for (int c = -1; c < NC - 1; c += 2) { RW_PREP_ITER(rawA, c); RW_PREP_ITER(rawB, c + 1); }
#undef RW_PREP_ITER
#undef RW_LOADRAW
#undef RW_CST
    } else if (wave >= 4) {
        const int sw = wave - 4, et = lane >> 1, erp = lane & 1;
#define RW_EMIT(cc) do { if ((cc) * CH >= CTXN) { const LAS f32x4* yp = (const LAS f32x4*)(lds + L_Y + ((((cc) & 1) * 2 + sw) * 8192) + et * 256 + erp * 128); \
            f32x4 s0 = yp[0] + yp[1] + yp[2] + yp[3], s1 = yp[4] + yp[5] + yp[6] + yp[7]; \
            *(unsigned*)(BR + (size_t)rw_row(dir, (cc) * CH + et) * 2048 + dir * 1024 + h * 64 + eighth * 8 + sw * 4 + erp * 2) = pkbf((s0[0] + s0[1]) + (s0[2] + s0[3]), (s1[0] + s1[1]) + (s1[2] + s1[3])); } } while (0)
        __syncthreads();
        for (int c = 0; c < NC; ++c) { if (c >= 1) RW_EMIT(c - 1); if (c + 1 < NC) __syncthreads(); }
    } else {
        __builtin_amdgcn_s_setprio(0);
        typedef float f32x2 __attribute__((ext_vector_type(2)));
        f32x2 S01 = {0.f, 0.f}, S23 = {0.f, 0.f};
        const int srow = wave * 4 + (lane >> 4), sj = (lane & 15) * 4;
        __syncthreads();
        struct Ops { f32x4 a, w, b, k, r; float v; };
#define RW_LD(o, t) do { o.a = *(LAS f32x4*)(bp + O_A + (t) * 256); \
            if (MODE == 9) { o.w = o.a; o.b = o.a; o.k = o.a; o.r = o.a; o.v = o.a[0]; } else { o.w = *(LAS f32x4*)(bp + O_W + (t) * 256); o.b = *(LAS f32x4*)(bp + O_B + (t) * 256); \
            o.k = *(LAS f32x4*)(bp + O_KD + (t) * 256); o.r = *(LAS f32x4*)(bp + O_R + (t) * 256); o.v = *(LAS float*)(vp + (t) * 32); } } while (0)
#define RW_STEP(o, t) do { f32x2 pd = S01 * o.a.lo; pd = S23 * o.a.hi + pd; float sa = pd.x + pd.y; if (MODE != 5 && MODE != 7) sa = allreduce16(sa); \
            S01 = o.b.lo * sa + (S01 * o.w.lo + o.k.lo * o.v); S23 = o.b.hi * sa + (S23 * o.w.hi + o.k.hi * o.v); \
            { f32x2 py = S01 * o.r.lo; py = S23 * o.r.hi + py; *(LAS float*)(yb + (t) * 256) = py.x + py.y; } } while (0)
        for (int c = 0; c < NC; ++c) {
            LAS unsigned char* bp = lds + (c & 1) * BUFB + sj * 4; LAS unsigned char* vp = lds + (c & 1) * BUFB + O_V + srow * 4; LAS unsigned char* yb = lds + L_Y + ((c & 1) * 2 + wave) * 8192 + lane * 4;
            Ops A0, A1, A2, A3, B0, B1, B2, B3;
            if (MODE != 2) {
            RW_LD(A0, 0); RW_LD(A1, 1); RW_LD(A2, 2); RW_LD(A3, 3);
#pragma unroll
            for (int g = 0; g < CH / 8; ++g) {
                RW_LD(B0, 8 * g + 4); RW_LD(B1, 8 * g + 5); RW_LD(B2, 8 * g + 6); RW_LD(B3, 8 * g + 7);
                __builtin_amdgcn_sched_barrier(0);
                RW_STEP(A0, 8 * g); RW_STEP(A1, 8 * g + 1); RW_STEP(A2, 8 * g + 2); RW_STEP(A3, 8 * g + 3);
                __builtin_amdgcn_sched_barrier(0);
                if (g + 1 < CH / 8) { RW_LD(A0, 8 * g + 8); RW_LD(A1, 8 * g + 9); RW_LD(A2, 8 * g + 10); RW_LD(A3, 8 * g + 11); }
                __builtin_amdgcn_sched_barrier(0);
                RW_STEP(B0, 8 * g + 4); RW_STEP(B1, 8 * g + 5); RW_STEP(B2, 8 * g + 6); RW_STEP(B3, 8 * g + 7);
                __builtin_amdgcn_sched_barrier(0);
            }
            }
            if (c + 1 < NC) __syncthreads();
        }
#undef RW_LD
#undef RW_STEP
        if (MODE != 0) asm volatile("" :: "v"(S01), "v"(S23));
        __builtin_amdgcn_s_setprio(0);
    }
    __syncthreads();
    if (wave == 4 || wave == 5) { const int sw = wave - 4, et = lane >> 1, erp = lane & 1; RW_EMIT(NC - 1); }
#undef RW_EMIT
    __syncthreads();
}

__device__ __forceinline__ float wave_sum(float v) {
    v = allreduce16(v);
    { auto r = __builtin_amdgcn_permlane16_swap(__float_as_uint(v), __float_as_uint(v), false, false); v = __uint_as_float(r[0]) + __uint_as_float(r[1]); }
    { auto r = __builtin_amdgcn_permlane32_swap(__float_as_uint(v), __float_as_uint(v), false, false); v = __uint_as_float(r[0]) + __uint_as_float(r[1]); }
    return v;
}
__device__ __forceinline__ void finish_phase(const Params& p) {
    int tid_ = threadIdx.x; asm volatile("" : "+v"(tid_));
    const int lane = tid_ & 63, gw = (int)blockIdx.x * NWAVES + (tid_ >> 6), ngw = (int)gridDim.x * NWAVES;
    const bf16_t* Z = ws_big(p); bf16_t* BR = ws_br(p); const float* bon = (const float*)(p.ws + WS_BON);
    for (int it = gw; it < SEQ * 4; it += ngw) {
        const int t = it >> 2, h = (it & 3) * 4 + (lane >> 4), row = CTXN + t, col = h * 64 + (lane & 15) * 4;
        bf16_t* b = BR + (size_t)row * 2048;
        const u32x2 wf = *(const u32x2*)(b + col), wb = *(const u32x2*)(b + 1024 + col), zv = *(const u32x2*)(Z + (size_t)row * ZW + 2048 + col);
        const f32x4 x = {bflo(wf.x) + bflo(wb.x), bfhi(wf.x) + bfhi(wb.x), bflo(wf.y) + bflo(wb.y), bfhi(wf.y) + bfhi(wb.y)};
        const float mean = allreduce16((x[0] + x[1]) + (x[2] + x[3])) * (1.0f / 64.f);
        const f32x4 d = x - mean;
        const float var = allreduce16((d[0] * d[0] + d[1] * d[1]) + (d[2] * d[2] + d[3] * d[3])) * (1.0f / 64.f);
        const float rstd = __builtin_amdgcn_rsqf(var + GN_EPS), bsum = bon[(size_t)h * SEQ + t] + bon[((size_t)16 + h) * SEQ + t];
        const f32x4 g = *(const f32x4*)(p.lnx_g + col), bb = *(const f32x4*)(p.lnx_b + col), v = {bflo(zv.x), bfhi(zv.x), bflo(zv.y), bfhi(zv.y)};
        const f32x4 y = d * rstd * g + bb + v * bsum;
        u32x2 o; o.x = pkbf(y[0], y[1]); o.y = pkbf(y[2], y[3]);
        *(u32x2*)(b + 1024 + col) = o;
    }
}
}

namespace wy {
typedef short bf16x4 __attribute__((ext_vector_type(4)));
using rw::f32x4; using rw::u32x4; using rw::u32x2; using rw::bf16x8; using rw::bflo; using rw::bfhi; using rw::PITCH;
typedef float f32x2_t __attribute__((ext_vector_type(2)));
typedef __bf16 bf2_t __attribute__((ext_vector_type(2)));
__device__ __forceinline__ unsigned pkbf(float lo, float hi) { const f32x2_t v = {lo, hi}; return __builtin_bit_cast(unsigned, __builtin_convertvector(v, bf2_t)); }
typedef GAS unsigned gu32;
#define WY_RLX __ATOMIC_RELAXED, __HIP_MEMORY_SCOPE_AGENT
constexpr int NJOB = R / 64, NCHUNK = R / 16, NSLOT = 8, ATP = 144, REC = 13056, JOBB = 4 * REC;
static_assert(R % 64 == 0 && CTXN % 64 == 0 && (R / 64) % 2 == 0, "jobs are 64 tokens; the loader is unrolled by two jobs");
constexpr int R_AT = 0, R_RT = 2304, R_BK = 4608, R_VT = 8704, R_AAK = 10752, R_TT = 11264, R_ARBK = 11776, R_WL = 12800;
__device__ __forceinline__ int permj(int j) { return (j >> 5) * 32 + ((j >> 2) & 3) * 8 + ((j >> 4) & 1) * 4 + (j & 3); }
constexpr int C_SLOTS = 3, C_SYNC = C_SLOTS * JOBB;
static_assert(C_SYNC + 64 <= 163840 - 64 && (JOBB / 4) % 16 == 0, "consumer LDS map");
constexpr size_t WS_RING = WS_WB;
constexpr size_t RING_TOTAL = (size_t)32 * NSLOT * JOBB;
static_assert(WS_RING + RING_TOTAL <= rw::WS_BON && rw::WS_BON + (size_t)2 * 16 * SEQ * 4 <= WS_WB + (size_t)EVEN_IN * DM * 2 + (size_t)DM * 2048 * 2, "ring | bonus scalars inside layer 0's weight copies");
constexpr size_t WS_WYF = 256 * 1024 + 16384;
constexpr int WYF_ACK = 32 * NSLOT * 64, WYF_ABORT = WYF_ACK + 32 * 64, WYF_WORDS = WYF_ABORT + 64;
constexpr unsigned SPIN_CAP = 1u << 17;
constexpr int P_A = 0, P_B = 16384, P_KD = 32768, P_LW = 49152, P_IMG = 65536, P_BRM = P_IMG + JOBB, P_KRM = P_BRM + 8192, P_AAB = P_KRM + 8192, P_W2T = P_AAB + 4096, P_A2T = P_W2T + 64 * PITCH * 2, P_END = P_A2T + 64 * PITCH * 2;
constexpr int P_SCR = P_BRM, SCRW = 2 * 8 * PITCH * 2;
constexpr int P_CST = P_IMG;
static_assert(P_END <= 163840 - 64 && P_SCR + 8 * SCRW + 8 * PITCH * 2 <= P_W2T, "wy LDS map");

__device__ __forceinline__ bf16x4 pack4(f32x4 v) { u32x2 r; r.x = pkbf(v[0], v[1]); r.y = pkbf(v[2], v[3]); return __builtin_bit_cast(bf16x4, r); }
__device__ __forceinline__ f32x4 mm(u32x2 a, bf16x4 b, f32x4 c) { return __builtin_amdgcn_mfma_f32_16x16x16bf16_1k(__builtin_bit_cast(bf16x4, a), b, c, 0, 0, 0); }
__device__ __forceinline__ f32x4 mm(u32x2 a, u32x2 b, f32x4 c) { return __builtin_amdgcn_mfma_f32_16x16x16bf16_1k(__builtin_bit_cast(bf16x4, a), __builtin_bit_cast(bf16x4, b), c, 0, 0, 0); }
__device__ __forceinline__ void wait_ge(gu32* word, unsigned want, gu32* abortw, int lane) {
    for (unsigned spins = 0;;) {
        unsigned v = 0u; if (lane == 0) v = __hip_atomic_load(word, WY_RLX);
        if ((unsigned)__builtin_amdgcn_readfirstlane(v) >= want) return;
        __builtin_amdgcn_s_sleep(1);
        if ((++spins & 255u) == 0u) { unsigned a = 0u; if (lane == 0) a = __hip_atomic_load(abortw, WY_RLX);
            if (__builtin_amdgcn_readfirstlane(a)) return;
            if (spins > SPIN_CAP) { if (lane == 0) __hip_atomic_store(abortw, 1u, WY_RLX); return; } }
    }
}

__device__ __forceinline__ void wait_ge4(gu32* words, unsigned want, gu32* abortw, int lane) {
    for (unsigned spins = 0;;) {
        unsigned v = 0xffffffffu; if (lane < 4) v = __hip_atomic_load(words + lane, WY_RLX);
        const unsigned v0 = (unsigned)__builtin_amdgcn_readlane((int)v, 0), v1 = (unsigned)__builtin_amdgcn_readlane((int)v, 1), v2 = (unsigned)__builtin_amdgcn_readlane((int)v, 2), v3 = (unsigned)__builtin_amdgcn_readlane((int)v, 3);
        const unsigned m01 = v0 < v1 ? v0 : v1, m23 = v2 < v3 ? v2 : v3;
        if ((m01 < m23 ? m01 : m23) >= want) return;
        __builtin_amdgcn_s_sleep(1);
        if ((++spins & 255u) == 0u) { unsigned a = 0u; if (lane == 0) a = __hip_atomic_load(abortw, WY_RLX);
            if (__builtin_amdgcn_readfirstlane(a)) return;
            if (spins > SPIN_CAP) { if (lane == 0) __hip_atomic_store(abortw, 1u, WY_RLX); return; } }
    }
}

struct Frag { u32x4 a01, a23, r01, r23, bk[4], arbk; u32x2 vT, aak, tt; f32x4 wl[4]; };

__device__ __forceinline__ void wait_lds_min4(LAS unsigned* w, unsigned want, gu32* abortw, int lane) {
    for (unsigned spins = 0;;) {
        const unsigned a = __hip_atomic_load(w, __ATOMIC_RELAXED, __HIP_MEMORY_SCOPE_WORKGROUP), b = __hip_atomic_load(w + 1, __ATOMIC_RELAXED, __HIP_MEMORY_SCOPE_WORKGROUP),
                       c = __hip_atomic_load(w + 2, __ATOMIC_RELAXED, __HIP_MEMORY_SCOPE_WORKGROUP), d = __hip_atomic_load(w + 3, __ATOMIC_RELAXED, __HIP_MEMORY_SCOPE_WORKGROUP);
        const unsigned m0 = a < b ? a : b, m1 = c < d ? c : d;
        if ((unsigned)__builtin_amdgcn_readfirstlane((int)(m0 < m1 ? m0 : m1)) >= want) return;
        __builtin_amdgcn_s_sleep(1);
        if ((++spins & 1023u) == 0u) { unsigned ab = 0u; if (lane == 0) ab = __hip_atomic_load(abortw, WY_RLX);
            if (__builtin_amdgcn_readfirstlane(ab)) return;
            if (spins > (SPIN_CAP << 3)) { if (lane == 0) __hip_atomic_store(abortw, 1u, WY_RLX); return; } }
    }
}
template <int MODE> __device__ __forceinline__ void loader(const Params& p, int chain, int lw, int lane, LAS unsigned char* lds) {
    gu32* wf = (gu32*)(p.ws + WS_WYF); gu32* flags = wf + chain * NSLOT * 64; gu32* ackw = wf + WYF_ACK + chain * 64; gu32* abortw = wf + WYF_ABORT;
    LAS unsigned* loaded = (LAS unsigned*)(lds + C_SYNC); LAS unsigned* done = loaded + 4;
    const __amdgpu_buffer_rsrc_t ring_rsrc = __builtin_amdgcn_make_buffer_rsrc((void*)(p.ws + WS_RING), 0, (int)RING_TOTAL, 0x00020000);
    constexpr int QB = JOBB / 4, NIT = (QB / 16 + 63) / 64, TAIL = QB / 16 - (NIT - 1) * 64;
    static_assert(NIT == 13, "the counted waits below assume 13 loads per set");
    u32x4 va[NIT], vb[NIT];
#define WY_ISSUE(v, g_) do { if (MODE < 2) wait_ge(flags + ((g_) % NSLOT) * 64, (unsigned)(g_) + 1u, abortw, lane); \
        const int soff = (chain * NSLOT + (g_) % NSLOT) * JOBB + lw * QB + lane * 16; \
        _Pragma("unroll") for (int k = 0; k < NIT; ++k) if (MODE == 0 && (k < NIT - 1 || lane < TAIL)) v[k] = __builtin_amdgcn_raw_buffer_load_b128(ring_rsrc, soff + k * 1024, 0, 16); } while (0)
#define WY_COMMIT(v, g_, WAITSTR) do { \
        if (MODE != 1 && (g_) >= C_SLOTS) { wait_lds_min4(done, (unsigned)((g_) - C_SLOTS + 1), abortw, lane); __builtin_amdgcn_fence(__ATOMIC_ACQUIRE, "workgroup"); }     \
        asm volatile(WAITSTR ::: "memory");                                                     \
        LAS unsigned char* dst = lds + ((g_) % C_SLOTS) * JOBB + lw * QB + lane * 16; \
        _Pragma("unroll") for (int k = 0; k < NIT; ++k) if (MODE == 0 && (k < NIT - 1 || lane < TAIL)) *(LAS u32x4*)(dst + k * 1024) = v[k]; \
        asm volatile("s_waitcnt lgkmcnt(0)" ::: "memory"); \
        __builtin_amdgcn_fence(__ATOMIC_RELEASE, "workgroup"); \
        if (lane == 0) { __hip_atomic_store(ackw + lw, (unsigned)(g_) + 1u, WY_RLX); __hip_atomic_store(loaded + lw, (unsigned)(g_) + 1u, __ATOMIC_RELAXED, __HIP_MEMORY_SCOPE_WORKGROUP); } } while (0)
    WY_ISSUE(va, 0);
    for (int g = 0; g < NJOB; g += 2) {
        WY_ISSUE(vb, g + 1); WY_COMMIT(va, g, "s_waitcnt vmcnt(13)");
        if (g + 2 < NJOB) { WY_ISSUE(va, g + 2); WY_COMMIT(vb, g + 1, "s_waitcnt vmcnt(13)"); } else WY_COMMIT(vb, g + 1, "s_waitcnt vmcnt(0)");
    }
#undef WY_ISSUE
#undef WY_COMMIT
}
__device__ __forceinline__ bf16x8 cat(u32x2 a, u32x2 b) { const u32x4 v = {a.x, a.y, b.x, b.y}; return __builtin_bit_cast(bf16x8, v); }
__device__ __forceinline__ u32x2 pack4u(f32x4 v) { u32x2 r; r.x = pkbf(v[0], v[1]); r.y = pkbf(v[2], v[3]); return r; }
__device__ __forceinline__ f32x4 mm32(bf16x8 a, bf16x8 b, f32x4 c) { return __builtin_amdgcn_mfma_f32_16x16x32_bf16(a, b, c, 0, 0, 0); }
template <int MODE> __device__ __forceinline__ void consumer(const Params& p, int chain, int wave, int lane, LAS unsigned char* lds) {
    const int n = lane & 15, q = lane >> 4, dir = chain >> 4, h = chain & 15;
    gu32* abortw = (gu32*)(p.ws + WS_WYF) + WYF_ABORT;
    LAS unsigned* loaded = (LAS unsigned*)(lds + C_SYNC); LAS unsigned* done = loaded + 4;
    f32x4 S0 = {0.f, 0.f, 0.f, 0.f}, S1 = S0, S2 = S0, S3 = S0;
    const int offA = n * ATP + 16 * q, offB = n * 32 + 8 * q, offW = 16 * q, offS = n * 64 + ((q ^ ((n >> 2) & 3)) * 16);
    const long rstep = dir ? -2048 : 2048;
    bf16_t* yq = ws_br(p) + (size_t)(CTXN + (dir ? SEQ - 1 - 4 * q : 4 * q)) * 2048 + dir * 1024 + h * 64 + 16 * wave + n;
#define WY_LOAD(F, base, k) do { \
        F.a01 = *(const LAS u32x4*)(base + offA + (k) * REC + R_AT); F.a23 = *(const LAS u32x4*)(base + offA + (k) * REC + R_AT + 64); \
        F.r01 = *(const LAS u32x4*)(base + offA + (k) * REC + R_RT); F.r23 = *(const LAS u32x4*)(base + offA + (k) * REC + R_RT + 64); \
        _Pragma("unroll") for (int jt = 0; jt < 4; ++jt) { F.bk[jt] = *(const LAS u32x4*)(base + offS + (k) * REC + R_BK + 1024 * jt); F.wl[jt] = *(const LAS f32x4*)(base + offW + (k) * REC + R_WL + 64 * jt); } \
        F.arbk = *(const LAS u32x4*)(base + offS + (k) * REC + R_ARBK); \
        F.vT = *(const LAS u32x2*)(base + offB + (k) * REC + R_VT + 512 * wave); F.aak = *(const LAS u32x2*)(base + offB + (k) * REC + R_AAK); F.tt = *(const LAS u32x2*)(base + offB + (k) * REC + R_TT); } while (0)
#define WY_Q(v) __builtin_bit_cast(bf16x8, v)
#define WY_COMPUTE(F, cidx) do { const f32x4 z0_ = {0.f, 0.f, 0.f, 0.f}; const u32x2 zz_ = {0u, 0u};     \
        f32x4 Z = mm32(cat(F.aak, zz_), cat(F.vT, zz_), z0_); \
        const bf16x8 s01 = cat(pack4u(S0), pack4u(S1)), s23 = cat(pack4u(S2), pack4u(S3)); \
        Z = mm32(WY_Q(F.a01), s01, Z); Z = mm32(WY_Q(F.a23), s23, Z);     \
        f32x4 Y = mm32(WY_Q(F.r01), s01, z0_); Y = mm32(WY_Q(F.r23), s23, Y); \
        const u32x2 zb = pack4u(Z); const f32x4 U = mm32(cat(F.tt, zz_), cat(zb, zz_), z0_); const u32x2 ub = pack4u(U); \
        const bf16x8 vu = cat(F.vT, ub); \
        Y = mm32(WY_Q(F.arbk), vu, Y); \
        S0 = mm32(WY_Q(F.bk[0]), vu, S0); S1 = mm32(WY_Q(F.bk[1]), vu, S1); S2 = mm32(WY_Q(F.bk[2]), vu, S2); S3 = mm32(WY_Q(F.bk[3]), vu, S3); \
        S0 *= F.wl[0]; S1 *= F.wl[1]; S2 *= F.wl[2]; S3 *= F.wl[3]; \
        if (MODE == 0 && (cidx) * 16 >= CTXN) { const unsigned y01 = pkbf(Y[0], Y[1]), y23 = pkbf(Y[2], Y[3]); bf16_t* yp_ = yq + (long)((cidx) * 16 - CTXN) * rstep; \
            *(unsigned short*)yp_ = (unsigned short)(y01 & 0xffffu); *(unsigned short*)(yp_ + rstep) = (unsigned short)(y01 >> 16); \
            *(unsigned short*)(yp_ + 2 * rstep) = (unsigned short)(y23 & 0xffffu); *(unsigned short*)(yp_ + 3 * rstep) = (unsigned short)(y23 >> 16); } } while (0)
    Frag FA, FB;
    wait_lds_min4(loaded, 1u, abortw, lane); __builtin_amdgcn_fence(__ATOMIC_ACQUIRE, "workgroup");
    int slot = 0;
    { const LAS unsigned char* b0 = lds; WY_LOAD(FA, b0, 0); if (MODE == 3) WY_LOAD(FB, b0, 1); }
    for (int g = 0; g < NJOB; ++g) {
        const LAS unsigned char* base = lds + slot * JOBB;
        if (MODE != 3) WY_LOAD(FB, base, 1); WY_COMPUTE(FA, 4 * g);
        if (MODE != 3) WY_LOAD(FA, base, 2); WY_COMPUTE(FB, 4 * g + 1);
        if (MODE != 3) WY_LOAD(FB, base, 3); WY_COMPUTE(FA, 4 * g + 2);
        slot = slot == C_SLOTS - 1 ? 0 : slot + 1;
        if (g + 1 < NJOB) { wait_lds_min4(loaded, (unsigned)g + 2u, abortw, lane); __builtin_amdgcn_fence(__ATOMIC_ACQUIRE, "workgroup");
            const LAS unsigned char* nb = lds + slot * JOBB; if (MODE != 3) WY_LOAD(FA, nb, 0); }
        WY_COMPUTE(FB, 4 * g + 3);
        asm volatile("s_waitcnt lgkmcnt(0)" ::: "memory");
        __builtin_amdgcn_fence(__ATOMIC_RELEASE, "workgroup");
        if (lane == 0) __hip_atomic_store(done + wave, (unsigned)g + 1u, __ATOMIC_RELAXED, __HIP_MEMORY_SCOPE_WORKGROUP);
    }
#undef WY_LOAD
#undef WY_COMPUTE
#undef WY_Q
    if (MODE != 0) asm volatile("" :: "v"(S0), "v"(S1), "v"(S2), "v"(S3));
}

template <int HALF> __device__ __forceinline__ void stage2(LAS unsigned char* lds, LAS unsigned char* img, int ch, int j) {
    LAS unsigned char* rec = img + ch * REC;
    const LAS float* LW = (const LAS float*)(lds + P_LW) + (ch * 16) * 64 + j;
    const LAS float* XA = (const LAS float*)(lds + (HALF ? P_KD : P_A)) + (ch * 16) * 64 + j;
    const LAS float* XB = (const LAS float*)(lds + P_B) + (ch * 16) * 64 + j;
    LAS unsigned short* rowm0 = (LAS unsigned short*)(rec + (HALF ? R_RT : R_AT)) + permj(j);
    LAS unsigned short* rowm1 = (LAS unsigned short*)(lds + (HALF ? P_KRM : P_BRM) + ch * 2048) + permj(j);
    float lw[16], s0[16], s1[16];
#pragma unroll
    for (int t = 0; t < 16; ++t) { lw[t] = LW[t * 64]; s1[t] = HALF ? XA[t * 64] : XB[t * 64];
        if (HALF) s0[t] = __uint_as_float((unsigned)rowm0[t * (ATP / 2)] << 16); else s0[t] = XA[t * 64]; }
    float cum = 0.f, x0p = 0.f, x1p = 0.f; unsigned tp[8];
#pragma unroll
    for (int t = 0; t < 16; ++t) {
        const float cprev = cum; cum += lw[t];
        const float x0 = s0[t] * __builtin_amdgcn_exp2f(HALF ? cum : cprev), x1 = s1[t] * __builtin_amdgcn_exp2f(-cum);
        if (t & 1) { const unsigned p0 = pkbf(x0p, x0), p1 = pkbf(x1p, x1);
            rowm0[(t - 1) * (ATP / 2)] = (unsigned short)(p0 & 0xffffu); rowm0[t * (ATP / 2)] = (unsigned short)(p0 >> 16);
            rowm1[(t - 1) * 64] = (unsigned short)(p1 & 0xffffu); rowm1[t * 64] = (unsigned short)(p1 >> 16);
            tp[t >> 1] = p1; }
        x0p = x0; x1p = x1; }
    { LAS unsigned char* bkr = rec + R_BK + j * 64 + (HALF ? 0 : 8); const int sw = (j >> 2) & 3;
#pragma unroll
      for (int qq = 0; qq < 4; ++qq) *(LAS u32x2*)(bkr + ((qq ^ sw) * 16)) = (u32x2){tp[2 * qq], tp[2 * qq + 1]}; }
    if (HALF) *(LAS float*)(rec + R_WL + j * 4) = __builtin_amdgcn_exp2f(cum);
}

template <int SKIP> __device__ __forceinline__ void producer(const Params& p, int chain, int first, int step, LAS unsigned char* lds) {
    int tid_ = threadIdx.x; asm volatile("" : "+v"(tid_));
    const int tid = tid_, lane = tid & 63, wave = __builtin_amdgcn_readfirstlane(tid >> 6);
    const int dir = chain >> 4, h = chain & 15;
    const float* w0 = dir ? p.w0b : p.w0f; const float* w2 = dir ? p.w2b : p.w2f; const float* a0 = dir ? p.a0b : p.a0f; const float* a2 = dir ? p.a2b : p.a2f;
    const bf16_t* Z = ws_big(p); float* bon = (float*)(p.ws + rw::WS_BON) + ((size_t)dir * 16 + h) * SEQ;
    gu32* wf = (gu32*)(p.ws + WS_WYF); gu32* flags = wf + chain * NSLOT * 64; gu32* ackw = wf + WYF_ACK + chain * 64; gu32* abortw = wf + WYF_ABORT;
    const __amdgpu_buffer_rsrc_t ring_rsrc = __builtin_amdgcn_make_buffer_rsrc((void*)(p.ws + WS_RING), 0, (int)RING_TOTAL, 0x00020000);
    { const int m = tid >> 3, j8 = (tid & 7) * 8;
      const f32x4 wa = *(const f32x4*)(w2 + (size_t)m * 1024 + h * 64 + j8), wb = *(const f32x4*)(w2 + (size_t)m * 1024 + h * 64 + j8 + 4);
      const f32x4 aa = *(const f32x4*)(a2 + (size_t)m * 1024 + h * 64 + j8), ab = *(const f32x4*)(a2 + (size_t)m * 1024 + h * 64 + j8 + 4);
      LAS bf16_t* yw = (LAS bf16_t*)(lds + P_W2T); LAS bf16_t* ya = (LAS bf16_t*)(lds + P_A2T);
#pragma unroll
      for (int qq = 0; qq < 4; ++qq) { yw[(j8 + qq) * PITCH + m] = f2bf(wa[qq]); yw[(j8 + 4 + qq) * PITCH + m] = f2bf(wb[qq]); ya[(j8 + qq) * PITCH + m] = f2bf(aa[qq]); ya[(j8 + 4 + qq) * PITCH + m] = f2bf(ab[qq]); }
      for (int i = tid; i < 320; i += NTHR) { const int gI = i >> 6, cc = i & 63, hc = h * 64 + cc; float v;
          if (gI == 0) v = w0[hc]; else if (gI == 1) v = a0[hc]; else if (gI == 2) v = p.k_k[hc]; else if (gI == 3) v = p.k_a[hc]; else v = p.r_k[hc];
          *(LAS float*)(lds + P_CST + i * 4) = v; } }
    __syncthreads();
    const int tq = lane >> 3, c8 = (lane & 7) * 8, hj = h * 64 + c8, tslot = wave * 8 + tq, ch1 = tslot >> 4, t1 = tslot & 15;
    const int gcol[5] = {hj, 1024 + hj, 2048 + hj, 3072 + dir * 64 + c8, 3200 + dir * 64 + c8};
    f32x4 cw0[2], ca0[2], ckk[2], cka[2], crk[2];
#pragma unroll
    for (int hh = 0; hh < 2; ++hh) {
#define WY_CST(gI) (*(LAS f32x4*)(lds + P_CST + ((gI) * 64 + c8 + 4 * hh) * 4))
        cw0[hh] = WY_CST(0); ca0[hh] = WY_CST(1); ckk[hh] = WY_CST(2); cka[hh] = WY_CST(3); crk[hh] = WY_CST(4);
#undef WY_CST
        asm volatile("" : "+v"(cw0[hh]), "+v"(ca0[hh]), "+v"(ckk[hh]), "+v"(cka[hh]), "+v"(crk[hh])); }
    __syncthreads();
    LAS unsigned char* scr = lds + P_SCR + wave * SCRW;
    LAS unsigned char* img = lds + P_IMG;
    rw::Raw raw;
#define WY_LOADRAW(gj) do { const bf16_t* zr_ = Z + (size_t)rw_row(dir, (gj) * 64 + tslot) * ZW; \
        _Pragma("unroll") for (int g5 = 0; g5 < 5; ++g5) raw.c[g5] = *(const u32x4*)(zr_ + gcol[g5]); } while (0)
    if (first < NJOB) WY_LOADRAW(first);
    for (int g = first; g < NJOB; g += step) {
        const bool latent = g * 64 >= CTXN;
        if (!(SKIP & 1)) { f32x4 rr[2], kv[2];
          { const u32x4 u = raw.c[0]; rr[0] = (f32x4){bflo(u.x), bfhi(u.x), bflo(u.y), bfhi(u.y)}; rr[1] = (f32x4){bflo(u.z), bfhi(u.z), bflo(u.w), bfhi(u.w)};
            LAS unsigned char* rr_ = img + ch1 * REC + R_RT + t1 * ATP + permj(c8) * 2; *(LAS u32x2*)rr_ = (u32x2){u.x, u.y}; *(LAS u32x2*)(rr_ + 16) = (u32x2){u.z, u.w}; }
          { const u32x4 u = raw.c[1]; kv[0] = (f32x4){bflo(u.x), bfhi(u.x), bflo(u.y), bfhi(u.y)}; kv[1] = (f32x4){bflo(u.z), bfhi(u.z), bflo(u.w), bfhi(u.w)}; }
          { const u32x4 u = raw.c[2]; LAS unsigned short* vt = (LAS unsigned short*)(img + ch1 * REC + R_VT) + c8 * 16 + t1;
            vt[0] = (unsigned short)(u.x & 0xffffu); vt[16] = (unsigned short)(u.x >> 16); vt[32] = (unsigned short)(u.y & 0xffffu); vt[48] = (unsigned short)(u.y >> 16);
            vt[64] = (unsigned short)(u.z & 0xffffu); vt[80] = (unsigned short)(u.z >> 16); vt[96] = (unsigned short)(u.w & 0xffffu); vt[112] = (unsigned short)(u.w >> 16); }
          { const u32x4 u = raw.c[3]; u32x4 o;
            o.x = pkbf(rw::fast_tanh(bflo(u.x)), rw::fast_tanh(bfhi(u.x))); o.y = pkbf(rw::fast_tanh(bflo(u.y)), rw::fast_tanh(bfhi(u.y))); o.z = pkbf(rw::fast_tanh(bflo(u.z)), rw::fast_tanh(bfhi(u.z))); o.w = pkbf(rw::fast_tanh(bflo(u.w)), rw::fast_tanh(bfhi(u.w)));
            *(LAS u32x4*)(scr + (tq * PITCH + c8) * 2) = o; *(LAS u32x4*)(scr + 8 * PITCH * 2 + (tq * PITCH + c8) * 2) = raw.c[4]; }
          if (g + step < NJOB) WY_LOADRAW(g + step);
          asm volatile("s_waitcnt lgkmcnt(0)" ::: "memory");
          { const int r16 = lane & 15, quad = lane >> 4; f32x4 acc[2][4];
#pragma unroll
            for (int lora = 0; lora < 2; ++lora) {
                LAS unsigned char* X = scr + lora * 8 * PITCH * 2 + (r16 * PITCH + quad * 8) * 2;
                const bf16x8 x0 = *(LAS bf16x8*)X, x1 = *(LAS bf16x8*)(X + 64);
#pragma unroll
                for (int jt = 0; jt < 4; ++jt) {
                    LAS unsigned char* Y = lds + (lora ? P_A2T : P_W2T) + ((jt * 16 + r16) * PITCH + quad * 8) * 2;
                    acc[lora][jt] = (f32x4){0.f, 0.f, 0.f, 0.f};
                    acc[lora][jt] = __builtin_amdgcn_mfma_f32_16x16x32_bf16(x0, *(LAS bf16x8*)Y, acc[lora][jt], 0, 0, 0);
                    acc[lora][jt] = __builtin_amdgcn_mfma_f32_16x16x32_bf16(x1, *(LAS bf16x8*)(Y + 64), acc[lora][jt], 0, 0, 0); } }
            if (quad < 2) {
#pragma unroll
                for (int lora = 0; lora < 2; ++lora)
#pragma unroll
                    for (int jt = 0; jt < 4; ++jt)
#pragma unroll
                        for (int r = 0; r < 4; ++r) *(LAS float*)(lds + (lora ? P_B : P_LW) + ((wave * 8 + quad * 4 + r) * 64 + jt * 16 + r16) * 4) = acc[lora][jt][r]; } }
          asm volatile("s_waitcnt lgkmcnt(0)" ::: "memory");
          { float bs = 0.f, nn = 0.f; f32x4 kk[2], al[2];
#pragma unroll
            for (int hh = 0; hh < 2; ++hh) { const int off = (tslot * 64 + c8 + 4 * hh) * 4;
                const f32x4 aw = *(LAS f32x4*)(lds + P_LW + off) + cw0[hh], aa = *(LAS f32x4*)(lds + P_B + off) + ca0[hh];
                f32x4 lw;
#pragma unroll
                for (int qq = 0; qq < 4; ++qq) { const float sg = __builtin_amdgcn_rcpf(1.0f + __builtin_amdgcn_exp2f(-1.4426950408889634f * aw[qq]));
                    lw[qq] = -0.8750612633917f * sg; al[hh][qq] = __builtin_amdgcn_rcpf(1.0f + __builtin_amdgcn_exp2f(-1.4426950408889634f * aa[qq])); kk[hh][qq] = kv[hh][qq] * ckk[hh][qq]; nn += kk[hh][qq] * kk[hh][qq]; }
                *(LAS f32x4*)(lds + P_LW + off) = lw; }
            nn = rw::allreduce8(nn);
            const float inv = __builtin_amdgcn_rsqf(fmaxf(nn, 1e-24f));
#pragma unroll
            for (int hh = 0; hh < 2; ++hh) { const int off = (tslot * 64 + c8 + 4 * hh) * 4;
                const f32x4 r = rr[hh];
                f32x4 av, bv, kd;
#pragma unroll
                for (int qq = 0; qq < 4; ++qq) { const float kn = kk[hh][qq] * inv; av[qq] = -kn; bv[qq] = kn * al[hh][qq]; kd[qq] = kv[hh][qq] * (1.0f + (al[hh][qq] - 1.0f) * cka[hh][qq]); bs += r[qq] * kd[qq] * crk[hh][qq]; }
                *(LAS f32x4*)(lds + P_B + off) = bv; *(LAS f32x4*)(lds + P_KD + off) = kd; *(LAS f32x4*)(lds + P_A + off) = av; }
            bs = rw::allreduce8(bs);
            if (latent && (lane & 7) == 0) bon[rw_row(dir, g * 64 + tslot) - CTXN] = bs; } }
        __syncthreads();
        if (!(SKIP & 2)) { if (wave >> 2) stage2<1>(lds, img, wave & 3, lane); else stage2<0>(lds, img, wave & 3, lane); }
        __syncthreads();
        if (!(SKIP & 4)) { const int ch = wave & 3, pair = wave >> 2, n = lane & 15, q = lane >> 4;
          LAS unsigned char* rec = img + ch * REC;
          const LAS unsigned char* Yrm = rec + (pair ? R_RT : R_AT) + n * ATP + 16 * q;
          const LAS unsigned char* Xb = lds + P_BRM + ch * 2048 + n * 128 + 16 * q;
          const LAS unsigned char* Xk = lds + P_KRM + ch * 2048 + n * 128 + 16 * q;
          f32x4 cb = {0.f, 0.f, 0.f, 0.f}, ck = cb;
#pragma unroll
          for (int jt = 0; jt < 4; ++jt) { const int o_ = (jt >> 1) * 64 + (jt & 1) * 8; const u32x2 yb = *(const LAS u32x2*)(Yrm + o_);
              cb = mm(*(const LAS u32x2*)(Xb + o_), yb, cb); ck = mm(*(const LAS u32x2*)(Xk + o_), yb, ck); }
#pragma unroll
          for (int r = 0; r < 4; ++r) { const int s = 4 * q + r; const bool keep = pair ? (s <= n) : (s < n); if (!keep) { cb[r] = 0.f; ck[r] = 0.f; } }
          u32x2 ob, ok; ob.x = pkbf(cb[0], cb[1]); ob.y = pkbf(cb[2], cb[3]); ok.x = pkbf(ck[0], ck[1]); ok.y = pkbf(ck[2], ck[3]);
          if (pair) *(LAS u32x4*)(rec + R_ARBK + n * 64 + ((q ^ ((n >> 2) & 3)) * 16)) = (u32x4){ok.x, ok.y, ob.x, ob.y};
          else {
              *(LAS u32x2*)(rec + R_AAK + n * 32 + 8 * q) = ok;
              LAS float* A2 = (LAS float*)(lds + P_AAB + ch * 1024);
#pragma unroll
              for (int r = 0; r < 4; ++r) A2[n * 16 + r * 4 + q] = cb[r];
              asm volatile("s_waitcnt lgkmcnt(0)" ::: "memory");
              const int c = lane >> 2, pp = lane & 3;
              f32x4 a4[16];
#pragma unroll
              for (int t = 0; t < 16; ++t) a4[t] = *(const LAS f32x4*)(A2 + t * 16 + pp * 4);
              float Tk0 = 0.f, Tk1 = 0.f, Tk2 = 0.f, Tk3 = 0.f, Tprev = 0.f;
              LAS unsigned short* tt = (LAS unsigned short*)(rec + R_TT) + c;
#pragma unroll
              for (int t = 0; t < 16; ++t) {
                  float acc = (a4[t][0] * Tk0 + a4[t][1] * Tk1) + (a4[t][2] * Tk2 + a4[t][3] * Tk3);
                  acc += rw::dppmov<0xB1>(acc); acc += rw::dppmov<0x4E>(acc);
                  const float Tt = acc + ((t == c) ? 1.0f : 0.0f);
                  const bool mine = (t & 3) == pp;
                  if ((t >> 2) == 0) Tk0 = mine ? Tt : Tk0; else if ((t >> 2) == 1) Tk1 = mine ? Tt : Tk1; else if ((t >> 2) == 2) Tk2 = mine ? Tt : Tk2; else Tk3 = mine ? Tt : Tk3;
                  if (t & 1) { const unsigned pk_ = pkbf(Tprev, Tt); if (pp == 0) { tt[(t - 1) * 16] = (unsigned short)(pk_ & 0xffffu); tt[t * 16] = (unsigned short)(pk_ >> 16); } }
                  Tprev = Tt; }
          } }
        if (!(SKIP & 16) && wave == 0 && g >= NSLOT) wait_ge4(ackw, (unsigned)(g - NSLOT + 1), abortw, lane);
        __syncthreads();
        { const int slot = g % NSLOT; const int base = (chain * NSLOT + slot) * JOBB;
          if (!(SKIP & 8)) for (int i = tid; i < JOBB / 16; i += NTHR) __builtin_amdgcn_raw_buffer_store_b128(*(LAS u32x4*)(img + i * 16), ring_rsrc, base + i * 16, 0, 16);
          asm volatile("s_waitcnt vmcnt(0)" ::: "memory");
          __syncthreads();
          if (tid == 0) __hip_atomic_store(flags + slot * 64, (unsigned)g + 1u, WY_RLX); }
    }
#undef WY_LOADRAW
}

__device__ __forceinline__ void zero_words(const Params& p) {
    int t_ = threadIdx.x; asm volatile("" : "+v"(t_)); unsigned* wf_ = (unsigned*)(p.ws + WS_WYF);
    for (long g = (long)blockIdx.x * NTHR + t_; g < (long)WYF_WORDS; g += (long)gridDim.x * NTHR) wf_[g] = 0u;
}
template <int MODE, int SKIP = 0> __device__ __forceinline__ void phase(const Params& p, LAS unsigned char* lds) {
    const int G = (int)gridDim.x, b = (int)blockIdx.x, nper = (G - 32) / 32;
    if (b < 32) {
        int tid_ = threadIdx.x; asm volatile("" : "+v"(tid_)); const int wave = __builtin_amdgcn_readfirstlane(tid_ >> 6);
        if (tid_ < 8) *(LAS unsigned*)(lds + C_SYNC + 4 * tid_) = 0u;
        __syncthreads();
        if (MODE == 4) { }
        else if (wave < 4) { if (MODE != 1) consumer<MODE>(p, b, wave, tid_ & 63, lds); } else loader<MODE>(p, b, wave - 4, tid_ & 63, lds);
    }
    else if (MODE < 2 || MODE == 4) { const int pp = b - 32; if (pp < 32 * nper) producer<SKIP>(p, pp % 32, pp / 32, nper, lds); }
}
}

namespace ret {
using attn::bf16x8; using attn::s16x4; using attn::f32x16; using attn::u32x4;
typedef float f32x4 __attribute__((ext_vector_type(4)));
typedef unsigned u32x2 __attribute__((ext_vector_type(2)));
constexpr int NQ = R / 128;
constexpr size_t SLOT_BYTES = 256 * 128 * 2;
constexpr size_t WS_SCTX = 254 * MiB;
#define RKSWZ(row, colB) ((row) * 256 + ((colB) ^ (((row) & 7) << 4)))
__device__ __forceinline__ bf16_t* slot(const Params& p, int dir, int q, int head) {
    return q >= 2 ? (bf16_t*)((unsigned char*)p.out + (((size_t)dir * (NQ - 2) + (q - 2)) * 4 + head) * SLOT_BYTES)
                  : (bf16_t*)(p.ws + WS_SCTX + (((size_t)dir * 2 + q) * 4 + head) * SLOT_BYTES);
}
__device__ __forceinline__ float log2_sigmoid(float x) { return -1.4426950408889634f * (fmaxf(-x, 0.f) + log1pf(expf(-fabsf(x)))); }
__device__ __forceinline__ bf16x8 scale8(bf16x8 v, float s) {
    u32x4 w = __builtin_bit_cast(u32x4, v), o;
#pragma unroll
    for (int i = 0; i < 4; ++i) o[i] = attn::cvtpk(__uint_as_float(w[i] << 16) * s, __uint_as_float(w[i] & 0xffff0000u) * s);
    return __builtin_bit_cast(bf16x8, o);
}
__device__ __forceinline__ void pk4(const f32x16& P, int base, bf16x8& out) {
    const unsigned a0 = attn::cvtpk(P[base + 0], P[base + 1]), a1 = attn::cvtpk(P[base + 2], P[base + 3]);
    const unsigned b0 = attn::cvtpk(P[base + 4], P[base + 5]), b1 = attn::cvtpk(P[base + 6], P[base + 7]);
    auto r0 = __builtin_amdgcn_permlane32_swap(a0, b0, false, false); auto r1 = __builtin_amdgcn_permlane32_swap(a1, b1, false, false);
    u32x4 w = {r0[0], r1[0], r0[1], r1[1]}; out = __builtin_bit_cast(bf16x8, w);
}
#define RPK(L, H) (bf16x8){L[0], L[1], L[2], L[3], H[0], H[1], H[2], H[3]}

__device__ __forceinline__ void summaries_unit(const Params& p, int q, int h, char* lds) {
    int tid_ = threadIdx.x; asm volatile("" : "+v"(tid_));
    const int tid = tid_, lane = tid & 63, wave = __builtin_amdgcn_readfirstlane(tid >> 6), r32 = lane & 31, hi = lane >> 5;
    const bf16_t* P = ws_big(p) + (size_t)q * 128 * P0W;
    const float lgf = log2_sigmoid(p.dec_f[h]), lgb = log2_sigmoid(p.dec_b[h]);
    const int sr = tid >> 4, sc = (tid & 15) * 8, st0 = attn::v_st(sr, sc), st1 = attn::v_st(32 + sr, sc);
#pragma unroll
    for (int th = 0; th < 2; ++th) {
        const int t0 = th * 64 + sr, t1 = t0 + 32;
        const bf16_t* r0 = P + (size_t)t0 * P0W; const bf16_t* r1 = P + (size_t)t1 * P0W;
#pragma unroll
        for (int eh = 0; eh < 2; ++eh) { char* vt = lds + (th * 2 + eh) * 16384;
            *(bf16x8*)(vt + st0) = *(const bf16x8*)(r0 + C_VA + h * 256 + eh * 128 + sc); *(bf16x8*)(vt + st1) = *(const bf16x8*)(r1 + C_VA + h * 256 + eh * 128 + sc); }
        const bf16x8 k0 = *(const bf16x8*)(r0 + C_KA + h * 128 + sc), k1 = *(const bf16x8*)(r1 + C_KA + h * 128 + sc);
        char* kf = lds + 65536 + th * 16384; char* kb = lds + 98304 + th * 16384;
        *(bf16x8*)(kf + st0) = scale8(k0, __builtin_amdgcn_exp2f((float)(127 - t0) * lgf)); *(bf16x8*)(kf + st1) = scale8(k1, __builtin_amdgcn_exp2f((float)(127 - t1) * lgf));
        *(bf16x8*)(kb + st0) = scale8(k0, __builtin_amdgcn_exp2f((float)t0 * lgb)); *(bf16x8*)(kb + st1) = scale8(k1, __builtin_amdgcn_exp2f((float)t1 * lgb));
    }
    __syncthreads();
    const int lbase = (int)(uintptr_t)lds + attn::v_rd_base(lane);
    f32x16 acc[2][4];
#pragma unroll
    for (int d = 0; d < 2; ++d)
#pragma unroll
        for (int b = 0; b < 4; ++b) acc[d][b] = f32x16{};
#pragma unroll
    for (int th = 0; th < 2; ++th) {
        const int va = lbase + (th * 2 + (wave >> 2)) * 16384 + (wave & 3) * 512, kfb = lbase + 65536 + th * 16384, kbb = lbase + 98304 + th * 16384;
#define R1_STEP(KS) do { \
        const s16x4 al = attn::tr_read<attn::v_rd_off(0, KS, 0)>(va), ah = attn::tr_read<attn::v_rd_off(0, KS, 1)>(va); \
        const s16x4 f0l = attn::tr_read<attn::v_rd_off(0, KS, 0)>(kfb), f0h = attn::tr_read<attn::v_rd_off(0, KS, 1)>(kfb), f1l = attn::tr_read<attn::v_rd_off(1, KS, 0)>(kfb), f1h = attn::tr_read<attn::v_rd_off(1, KS, 1)>(kfb); \
        const s16x4 f2l = attn::tr_read<attn::v_rd_off(2, KS, 0)>(kfb), f2h = attn::tr_read<attn::v_rd_off(2, KS, 1)>(kfb), f3l = attn::tr_read<attn::v_rd_off(3, KS, 0)>(kfb), f3h = attn::tr_read<attn::v_rd_off(3, KS, 1)>(kfb); \
        const s16x4 g0l = attn::tr_read<attn::v_rd_off(0, KS, 0)>(kbb), g0h = attn::tr_read<attn::v_rd_off(0, KS, 1)>(kbb), g1l = attn::tr_read<attn::v_rd_off(1, KS, 0)>(kbb), g1h = attn::tr_read<attn::v_rd_off(1, KS, 1)>(kbb); \
        const s16x4 g2l = attn::tr_read<attn::v_rd_off(2, KS, 0)>(kbb), g2h = attn::tr_read<attn::v_rd_off(2, KS, 1)>(kbb), g3l = attn::tr_read<attn::v_rd_off(3, KS, 0)>(kbb), g3h = attn::tr_read<attn::v_rd_off(3, KS, 1)>(kbb); \
        asm volatile("s_waitcnt lgkmcnt(0)" ::: "memory"); __builtin_amdgcn_sched_barrier(0); \
        const bf16x8 a = RPK(al, ah); \
        acc[0][0] = __builtin_amdgcn_mfma_f32_32x32x16_bf16(a, RPK(f0l, f0h), acc[0][0], 0, 0, 0); acc[0][1] = __builtin_amdgcn_mfma_f32_32x32x16_bf16(a, RPK(f1l, f1h), acc[0][1], 0, 0, 0); \
        acc[0][2] = __builtin_amdgcn_mfma_f32_32x32x16_bf16(a, RPK(f2l, f2h), acc[0][2], 0, 0, 0); acc[0][3] = __builtin_amdgcn_mfma_f32_32x32x16_bf16(a, RPK(f3l, f3h), acc[0][3], 0, 0, 0); \
        acc[1][0] = __builtin_amdgcn_mfma_f32_32x32x16_bf16(a, RPK(g0l, g0h), acc[1][0], 0, 0, 0); acc[1][1] = __builtin_amdgcn_mfma_f32_32x32x16_bf16(a, RPK(g1l, g1h), acc[1][1], 0, 0, 0); \
        acc[1][2] = __builtin_amdgcn_mfma_f32_32x32x16_bf16(a, RPK(g2l, g2h), acc[1][2], 0, 0, 0); acc[1][3] = __builtin_amdgcn_mfma_f32_32x32x16_bf16(a, RPK(g3l, g3h), acc[1][3], 0, 0, 0); \
        __builtin_amdgcn_sched_barrier(0); } while (0)
        R1_STEP(0); R1_STEP(1); R1_STEP(2); R1_STEP(3);
#undef R1_STEP
    }
#pragma unroll
    for (int d = 0; d < 2; ++d) { bf16_t* dst = slot(p, d, q, h);
#pragma unroll
        for (int db = 0; db < 4; ++db)
#pragma unroll
            for (int r = 0; r < 16; ++r) dst[(size_t)(32 * wave + attn::crow(r, hi)) * 128 + 32 * db + r32] = (bf16_t)(attn::cvtpk(acc[d][db][r], 0.f) & 0xffffu); }
    __syncthreads();
}

__device__ __forceinline__ void state_scan(const Params& p) {
    int tid_ = threadIdx.x; asm volatile("" : "+v"(tid_));
    for (long gt = (long)blockIdx.x * NTHR + tid_; gt < 2L * 4 * 16384; gt += (long)gridDim.x * NTHR) {
    const int pair = (int)(gt & 16383), h = (int)((gt >> 14) & 3), dir = (int)(gt >> 16);
    const float G = __builtin_amdgcn_exp2f(128.0f * log2_sigmoid((dir ? p.dec_b : p.dec_f)[h]));
    float s0 = 0.f, s1 = 0.f;
    static_assert(NQ % 10 == 0, "the scan is unrolled by ten chunks");
    for (int n0 = 0; n0 < NQ; n0 += 10) {
        unsigned* ptr[10]; unsigned u[10];
#pragma unroll
        for (int k = 0; k < 10; ++k) { const int n = n0 + k, q = dir == 0 ? n : (n < 2 ? 1 - n : NQ + 1 - n);
            ptr[k] = (unsigned*)slot(p, dir, q, h) + pair; u[k] = *ptr[k]; }
#pragma unroll
        for (int k = 0; k < 10; ++k) { *ptr[k] = attn::cvtpk(s0, s1);
            s0 = G * s0 + __uint_as_float(u[k] << 16); s1 = G * s1 + __uint_as_float(u[k] & 0xffff0000u); }
    }    }
}

__device__ __forceinline__ void output_unit(const Params& p, int q, int h, char* lds) {
    int tid_ = threadIdx.x; asm volatile("" : "+v"(tid_));
    const int tid = tid_, lane = tid & 63, wave = __builtin_amdgcn_readfirstlane(tid >> 6), r32 = lane & 31, hi = lane >> 5;
    const int ib = wave >> 1, eh = wave & 1;
    const bf16_t* P = ws_big(p) + (size_t)q * 128 * P0W;
    const float lgf = log2_sigmoid(p.dec_f[h]), lgb = log2_sigmoid(p.dec_b[h]);
    const int sr = tid >> 4, sc = (tid & 15) * 8, st0 = attn::v_st(sr, sc), st1 = attn::v_st(32 + sr, sc);
    bf16x8 qr[8];
    { const bf16_t* Qw = P + (size_t)(ib * 32 + r32) * P0W + C_QA + h * 128 + hi * 8;
#pragma unroll
      for (int d0 = 0; d0 < 8; ++d0) qr[d0] = *(const bf16x8*)(Qw + d0 * 16); }
    { const bf16_t* Sf = slot(p, 0, q, h); const bf16_t* Sb = slot(p, 1, q, h);
      bf16x8 sv[16];
#pragma unroll
      for (int k = 0; k < 8; ++k) { const int i = tid + 512 * k; sv[k] = *(const bf16x8*)(Sf + (size_t)i * 8); sv[8 + k] = *(const bf16x8*)(Sb + (size_t)i * 8); }
#pragma unroll
      for (int k = 0; k < 8; ++k) { const int i = tid + 512 * k, e = i >> 4, cb = (i & 15) * 16;
          *(bf16x8*)(lds + RKSWZ(e, cb)) = sv[k]; *(bf16x8*)(lds + 65536 + RKSWZ(e, cb)) = sv[8 + k]; } }
    __syncthreads();
    bf16x8 kvr[12];
    f32x16 o[4] = {};
    const int i_loc = ib * 32 + r32;
    { const float scf = __builtin_amdgcn_exp2f((float)(i_loc + 1) * lgf), scb = __builtin_amdgcn_exp2f((float)(128 - i_loc) * lgb);
#pragma unroll
      for (int dir = 0; dir < 2; ++dir) {
          const char* Sl = lds + dir * 65536;
          if (dir == 1) {
#pragma unroll
    for (int jt = 0; jt < 2; ++jt) {
        const bf16_t* r0 = P + (size_t)(jt * 64 + sr) * P0W; const bf16_t* r1 = r0 + (size_t)32 * P0W;
        kvr[jt * 6 + 0] = *(const bf16x8*)(r0 + C_KA + h * 128 + sc); kvr[jt * 6 + 1] = *(const bf16x8*)(r1 + C_KA + h * 128 + sc);
#pragma unroll
        for (int e2 = 0; e2 < 2; ++e2) { kvr[jt * 6 + 2 + e2 * 2] = *(const bf16x8*)(r0 + C_VA + h * 256 + e2 * 128 + sc); kvr[jt * 6 + 3 + e2 * 2] = *(const bf16x8*)(r1 + C_VA + h * 256 + e2 * 128 + sc); }
    }
          }
#pragma unroll
          for (int ks = 0; ks < 8; ++ks) { const bf16x8 a = scale8(qr[ks], dir ? scb : scf); const int cb = (ks * 16 + hi * 8) * 2;
              bf16x8 f[4];
#pragma unroll
              for (int d0 = 0; d0 < 4; ++d0) f[d0] = *(const bf16x8*)(Sl + RKSWZ(eh * 128 + d0 * 32 + r32, cb));
#pragma unroll
              for (int d0 = 0; d0 < 4; ++d0) o[d0] = __builtin_amdgcn_mfma_f32_32x32x16_bf16(a, f[d0], o[d0], 0, 0, 0); } } }
    __syncthreads();
#pragma unroll
    for (int jt = 0; jt < 2; ++jt) { char* kt = lds + jt * 16384;
        *(bf16x8*)(kt + RKSWZ(sr, sc * 2)) = kvr[jt * 6 + 0]; *(bf16x8*)(kt + RKSWZ(32 + sr, sc * 2)) = kvr[jt * 6 + 1];
#pragma unroll
        for (int e2 = 0; e2 < 2; ++e2) { char* vt = lds + 32768 + (jt * 2 + e2) * 16384; *(bf16x8*)(vt + st0) = kvr[jt * 6 + 2 + e2 * 2]; *(bf16x8*)(vt + st1) = kvr[jt * 6 + 3 + e2 * 2]; } }
    __syncthreads();
    const int vb0 = (int)(uintptr_t)lds + 32768 + attn::v_rd_base(lane);
#pragma unroll
    for (int jt = 0; jt < 2; ++jt) {
        f32x16 p0, p1;
        attn::qkt(p0, p1, (const attn::bf16*)(lds + jt * 16384), qr, r32, hi);
#pragma unroll
        for (int r = 0; r < 16; ++r) {
            const int j0 = jt * 64 + attn::crow(r, hi), dl0 = i_loc - j0, dl1 = dl0 - 32;
            const float m0 = dl0 > 0 ? __builtin_amdgcn_exp2f((float)dl0 * lgf) : (dl0 < 0 ? __builtin_amdgcn_exp2f((float)(-dl0) * lgb) : 2.0f);
            const float m1 = dl1 > 0 ? __builtin_amdgcn_exp2f((float)dl1 * lgf) : (dl1 < 0 ? __builtin_amdgcn_exp2f((float)(-dl1) * lgb) : 2.0f);
            p0[r] *= m0; p1[r] *= m1;
        }
        bf16x8 pa0, pa1, pa2, pa3; pk4(p0, 0, pa0); pk4(p0, 8, pa1); pk4(p1, 0, pa2); pk4(p1, 8, pa3);
        __builtin_amdgcn_sched_barrier(0);
        attn::pv_d0(o, vb0 + (jt * 2 + eh) * 16384, pa0, pa1, pa2, pa3);
    }
    __syncthreads();
    float* O = (float*)lds;
#pragma unroll
    for (int r = 0; r < 16; ++r)
#pragma unroll
        for (int d0 = 0; d0 < 4; ++d0) O[(ib * 32 + attn::crow(r, hi)) * 256 + eh * 128 + d0 * 32 + r32] = o[d0][r];
    __syncthreads();
    bf16_t* BR = ws_br(p) + (size_t)q * 128 * 2048 + h * 256;
#pragma unroll 4
    for (int rr = 0; rr < 16; ++rr) {
        const int row = wave * 16 + rr; const f32x4 x = *(const f32x4*)(O + row * 256 + lane * 4);
        const float mean = rw::wave_sum((x[0] + x[1]) + (x[2] + x[3])) * (1.0f / 256.f);
        const f32x4 d = x - mean;
        const float var = rw::wave_sum((d[0] * d[0] + d[1] * d[1]) + (d[2] * d[2] + d[3] * d[3])) * (1.0f / 256.f);
        const float rstd = 1.0f / sqrtf(var + NORM_EPS);
        f32x4 y = d * rstd;
        if (q < 2) { const u32x2 gg = *(const u32x2*)((const bf16_t*)(p.ws + 255 * MiB) + (size_t)(q * 128 + row) * 2048 + h * 256 + lane * 4);
            y[0] *= __uint_as_float(gg.x << 16); y[1] *= __uint_as_float(gg.x & 0xffff0000u); y[2] *= __uint_as_float(gg.y << 16); y[3] *= __uint_as_float(gg.y & 0xffff0000u); }
        u32x2 w; w.x = attn::cvtpk(y[0], y[1]); w.y = attn::cvtpk(y[2], y[3]);
        *(u32x2*)(BR + (size_t)row * 2048 + lane * 4) = w;
    }
    __syncthreads();
}
#undef RPK
#undef RKSWZ
}

namespace na {
using attn::bf16x8; using attn::f32x16; using attn::u32x4;
constexpr float L2E = 1.4426950408889634f;
constexpr int WH = GROWS < 8 ? GROWS : 8;
constexpr int L_K = 0, L_V = 32768, L_WS = 65536, L_RPB = L_WS + NWAVES * 64 * 4, L_END = L_RPB + 15 * 31 * 4;
#define NKSWZ(row, colB) ((row) * 256 + ((colB) ^ (((row) & 7) << 4)))
__device__ __forceinline__ int win_r0(int r) { int r0 = r - WH / 2; return r0 < 0 ? 0 : (r0 > GROWS - WH ? GROWS - WH : r0); }
__device__ __forceinline__ int win_c0(int c) { int c0 = c - 8; return c0 < 0 ? 0 : (c0 > GW - 16 ? GW - 16 : c0); }

__device__ __forceinline__ void na_unit(const Params& p, int rg, int h, char* lds) {
    int tid_ = threadIdx.x; asm volatile("" : "+v"(tid_));
    const int tid = tid_, lane = tid & 63, wave = __builtin_amdgcn_readfirstlane(tid >> 6), r32 = lane & 31, hi = lane >> 5;
    const bf16_t* P = ws_big(p); const bf16_t* NAC = (const bf16_t*)(p.ws + 255 * MiB);
    const int r = 4 * rg + (wave >> 1), qc = (wave & 1) * 32 + r32, my_r0 = win_r0(r), my_c0 = win_c0(qc);
    const int lo = win_r0(4 * rg), hiw = win_r0(4 * rg + 3) + WH, NT = hiw - lo + CTXN / 64;
    float* wsf = (float*)(lds + L_WS) + wave * 64; float* rpb_l = (float*)(lds + L_RPB);
    if (tid < 15 * 31) rpb_l[tid] = p.rpb[h * 15 * 31 + tid];
    bf16x8 qr[4];
    { const bf16_t* Qw = P + (size_t)(CTXN + r * 64 + qc) * NAW + h * 64 + hi * 8;
#pragma unroll
      for (int d0 = 0; d0 < 4; ++d0) { u32x4 w = *(const u32x4*)(Qw + d0 * 16);
        for (int i = 0; i < 4; ++i) w[i] = attn::cvtpk(__uint_as_float(w[i] << 16) * 0.125f, __uint_as_float(w[i] & 0xffff0000u) * 0.125f);
        qr[d0] = *reinterpret_cast<bf16x8*>(&w); } }
    const int sk = tid >> 3, sc = (tid & 7) * 8, kst = NKSWZ(sk, sc * 2), vst = attn::v_st(sk, sc);
    bf16x8 kA, vA, kB, vB;
#define NA_LOAD(KR, VR, t) do { if ((t) < hiw - lo) { const int krow_ = CTXN + (lo + (t)) * 64 + sk; \
            KR = *(const bf16x8*)(P + (size_t)krow_ * NAW + 1024 + h * 64 + sc); VR = *(const bf16x8*)(P + (size_t)krow_ * NAW + 2048 + h * 64 + sc); } \
        else { const bf16_t* c_ = NAC + (size_t)(((t) - (hiw - lo)) * 64 + sk) * 2048 + h * 64 + sc; KR = *(const bf16x8*)c_; VR = *(const bf16x8*)(c_ + 1024); } } while (0)
#define NA_WRITE(KR, VR, b) do { *(bf16x8*)(lds + L_K + (b) * 16384 + kst) = KR; *(bf16x8*)(lds + L_V + (b) * 16384 + vst) = VR; } while (0)
    NA_LOAD(kA, vA, 0); NA_WRITE(kA, vA, 0);
    NA_LOAD(kB, vB, 1);
    __syncthreads();
    float m_reg = -1e30f, l_reg = 0.f; f32x16 o[2] = {};
    const int dl = 4 * hi - my_c0;
    const int vb0 = (int)(uintptr_t)lds + L_V + attn::v_rd_base(lane);
#define NA_TILE(t, KW, VW, KL, VL) do { \
        if ((t) + 2 < NT) NA_LOAD(KL, VL, (t) + 2);            \
        const bool is_ctx = (t) >= hiw - lo; const int kr = lo + (t); \
        if (is_ctx || (kr >= my_r0 && kr < my_r0 + WH)) { \
            const char* Ks = lds + L_K + ((t) & 1) * 16384; \
            f32x16 p0 = {}, p1 = {}; \
            _Pragma("unroll") for (int d0 = 0; d0 < 4; ++d0) { const int cb = (d0 * 16 + hi * 8) * 2; \
                const bf16x8 b0 = *(const bf16x8*)(Ks + NKSWZ(r32, cb)), b1 = *(const bf16x8*)(Ks + NKSWZ(32 + r32, cb)); \
                p0 = __builtin_amdgcn_mfma_f32_32x32x16_bf16(b0, qr[d0], p0, 0, 0, 0); p1 = __builtin_amdgcn_mfma_f32_32x32x16_bf16(b1, qr[d0], p1, 0, 0, 0); } \
            if (!is_ctx) {     \
                const float* bb = rpb_l + (kr - r + 7) * 31 + 15 - qc + 4 * hi; float bz0[16], bz1[16]; \
                _Pragma("unroll") for (int q = 0; q < 16; ++q) { const int cq = (q & 3) + 8 * (q >> 2); bz0[q] = bb[cq]; bz1[q] = bb[cq + 32]; } \
                _Pragma("unroll") for (int q = 0; q < 16; ++q) { const int cq = (q & 3) + 8 * (q >> 2); \
                    p0[q] = (unsigned)(cq + dl) < 16u ? p0[q] + bz0[q] : -1e30f; p1[q] = (unsigned)(cq + 32 + dl) < 16u ? p1[q] + bz1[q] : -1e30f; } \
            } \
            float pmax = p0[0]; \
            _Pragma("unroll") for (int q = 1; q < 16; ++q) pmax = fmaxf(pmax, p0[q]); \
            _Pragma("unroll") for (int q = 0; q < 16; ++q) pmax = fmaxf(pmax, p1[q]); \
            { auto rr = __builtin_amdgcn_permlane32_swap(__float_as_uint(pmax), __float_as_uint(pmax), false, false); pmax = fmaxf(__uint_as_float(rr[0]), __uint_as_float(rr[1])); } \
            const float mn = fmaxf(m_reg, pmax), alpha = __builtin_amdgcn_exp2f((m_reg - mn) * L2E), mnl = -mn * L2E; m_reg = mn; \
            float ps = 0.f; \
            _Pragma("unroll") for (int q = 0; q < 16; ++q) { p0[q] = __builtin_amdgcn_exp2f(fmaf(p0[q], L2E, mnl)); p1[q] = __builtin_amdgcn_exp2f(fmaf(p1[q], L2E, mnl)); ps += p0[q] + p1[q]; } \
            { auto rr = __builtin_amdgcn_permlane32_swap(__float_as_uint(ps), __float_as_uint(ps), false, false); ps = __uint_as_float(rr[0]) + __uint_as_float(rr[1]); } \
            l_reg = l_reg * alpha + ps; \
            if (__any(alpha < 1.f)) { if (hi == 0) wsf[r32] = alpha; asm volatile("s_waitcnt lgkmcnt(0)" ::: "memory"); \
                _Pragma("unroll") for (int d = 0; d < 2; ++d) _Pragma("unroll") for (int q = 0; q < 16; ++q) o[d][q] *= wsf[attn::crow(q, hi)]; } \
            bf16x8 pa0, pa1, pa2, pa3; ret::pk4(p0, 0, pa0); ret::pk4(p0, 8, pa1); ret::pk4(p1, 0, pa2); ret::pk4(p1, 8, pa3); \
            __builtin_amdgcn_sched_barrier(0); \
            const int vb = vb0 + ((t) & 1) * 16384; \
            attn::pv_one<0>(o[0], vb, pa0, pa1, pa2, pa3); attn::pv_one<1>(o[1], vb, pa0, pa1, pa2, pa3); \
        } \
        if ((t) + 1 < NT) NA_WRITE(KW, VW, ((t) + 1) & 1);     \
        __syncthreads(); } while (0)
    for (int t = 0; t < NT; t += 2) {
        NA_TILE(t, kB, vB, kA, vA);
        if (t + 1 < NT) NA_TILE(t + 1, kA, vA, kB, vB);
    }
#undef NA_TILE
#undef NA_LOAD
#undef NA_WRITE
    if (hi == 0) wsf[32 + r32] = l_reg; asm volatile("s_waitcnt lgkmcnt(0)" ::: "memory");
    bf16_t* Ow = ws_br(p) + (size_t)(CTXN + r * 64 + (wave & 1) * 32) * 2048 + h * 64;
#pragma unroll
    for (int q = 0; q < 16; ++q) { const int orow = attn::crow(q, hi); const float rl = __builtin_amdgcn_rcpf(wsf[32 + orow]);
#pragma unroll
        for (int d0 = 0; d0 < 2; ++d0) Ow[(size_t)orow * 2048 + d0 * 32 + r32] = (bf16_t)(attn::cvtpk(o[d0][q] * rl, 0.f) & 0xffffu); }
    __syncthreads();
}
#undef NKSWZ
}

namespace el {
typedef float f32x4 __attribute__((ext_vector_type(4)));
typedef unsigned u32x2 __attribute__((ext_vector_type(2)));
__device__ __forceinline__ float wsum(float v) { return rw::wave_sum(v); }
__device__ __forceinline__ unsigned pk(float lo, float hi) { unsigned r; asm volatile("v_cvt_pk_bf16_f32 %0, %1, %2" : "=v"(r) : "v"(lo), "v"(hi)); return r; }

__device__ __forceinline__ void mod_phase(const Params& p, char* lds) {
    int tid_ = threadIdx.x; asm volatile("" : "+v"(tid_));
    const int tid = tid_, ks = tid >> 6, jl = tid & 63;
    float* sc = (float*)lds; float* red = sc + 2048;
    for (int b = blockIdx.x; b < 2 * 48; b += gridDim.x) {
        const int l = b / 48, j = (b % 48) * 64 + jl;
        __syncthreads();
        for (int k = tid; k < 2048; k += NTHR) { const float x = k < 1024 ? p.c[k] : p.c_ctx[k - 1024]; sc[k] = x / (1.0f + __expf(-x)); }
        __syncthreads();
        const float* w = p.w_mod + (size_t)l * DM * 3072 + (size_t)(ks * 128) * 3072 + j; float a0 = 0.f, a1 = 0.f;
#pragma unroll 32
        for (int k = 0; k < 128; ++k) { const float wv = w[(size_t)k * 3072]; a0 += sc[ks * 128 + k] * wv; a1 += sc[1024 + ks * 128 + k] * wv; }
        red[ks * 64 + jl] = a0; red[512 + ks * 64 + jl] = a1;
        __syncthreads();
        if (tid < 128) { const int s = tid >> 6; float t = 0.f;
#pragma unroll
            for (int q = 0; q < 8; ++q) t += red[s * 512 + q * 64 + jl];
            ws_modv(p)[(l * 2 + s) * 3072 + j] = t + p.b_mod[l * 3072 + j]; }
    }
    __syncthreads();
}

template <int LAYER> __device__ __forceinline__ void modnorm_store(const Params& p, const f32x4 (&v)[4], int row, int lane) {
    const float* mv = ws_modv(p) + (LAYER * 2 + (row < CTXN ? 1 : 0)) * 3072; const float* g = p.g_pre + LAYER * DM;
    float ss = 0.f;
#pragma unroll
    for (int j = 0; j < 4; ++j) ss += (v[j][0] * v[j][0] + v[j][1] * v[j][1]) + (v[j][2] * v[j][2] + v[j][3] * v[j][3]);
    const float rstd = 1.0f / sqrtf(wsum(ss) * (1.0f / DM) + NORM_EPS);
    bf16_t* o = ws_xn(p) + (size_t)row * DM;
    f32x4 gg[4], sh[4], sc[4];
#pragma unroll
    for (int j = 0; j < 4; ++j) { const int c = lane * 4 + 256 * j; gg[j] = *(const f32x4*)(g + c); sh[j] = *(const f32x4*)(mv + c); sc[j] = *(const f32x4*)(mv + 1024 + c); }
#pragma unroll
    for (int j = 0; j < 4; ++j) { const int c = lane * 4 + 256 * j;
        const f32x4 y = v[j] * rstd * gg[j] * (sc[j] + 1.0f) + sh[j];
        u32x2 w; w.x = pk(y[0], y[1]); w.y = pk(y[2], y[3]); *(u32x2*)(o + c) = w; }
}
__device__ __forceinline__ void prenorm0_phase(const Params& p) {
    int tid_ = threadIdx.x; asm volatile("" : "+v"(tid_));
    const int lane = tid_ & 63, gw = (int)blockIdx.x * NWAVES + (tid_ >> 6), ngw = (int)gridDim.x * NWAVES;
    for (int row = gw; row < R; row += ngw) {
        const float* src = row < CTXN ? p.ctx + (size_t)row * DM : p.x + (size_t)(row - CTXN) * DM;
        f32x4 v[4];
#pragma unroll
        for (int j = 0; j < 4; ++j) v[j] = *(const f32x4*)(src + lane * 4 + 256 * j);
        modnorm_store<0>(p, v, row, lane);
    }
}
template <int LAYER> __device__ __forceinline__ void resid_phase(const Params& p) {
    int tid_ = threadIdx.x; asm volatile("" : "+v"(tid_));
    const int lane = tid_ & 63, gw = (int)blockIdx.x * NWAVES + (tid_ >> 6), ngw = (int)gridDim.x * NWAVES;
    for (int row = (LAYER == 0 ? 0 : CTXN) + gw; row < R; row += ngw) {
        const bool ctxsum = LAYER == 0 && row < CTXN;
        const float* y = ctxsum ? (const float*)(p.ws + WS_BIG + 72 * MiB) + (size_t)row * DM : ws_y(p) + (size_t)row * DM; const float* mv = ws_modv(p) + (LAYER * 2 + (row < CTXN ? 1 : 0)) * 3072 + 2048; const float* g = p.g_post + LAYER * DM;
        const float* src; float* dst;
        if (row < CTXN) { src = p.ctx + (size_t)row * DM; dst = ws_ctx1(p) + (size_t)row * DM; }
        else { src = (LAYER == 0 ? p.x : p.out) + (size_t)(row - CTXN) * DM; dst = p.out + (size_t)(row - CTXN) * DM; }
        f32x4 yv[4]; float ss = 0.f;
#pragma unroll
        for (int j = 0; j < 4; ++j) { yv[j] = *(const f32x4*)(y + lane * 4 + 256 * j);
            if (ctxsum) { _Pragma("unroll") for (int s = 1; s < 8; ++s) yv[j] += *(const f32x4*)(y + (size_t)s * CTXN * DM + lane * 4 + 256 * j); }
            ss += (yv[j][0] * yv[j][0] + yv[j][1] * yv[j][1]) + (yv[j][2] * yv[j][2] + yv[j][3] * yv[j][3]); }
        const float rstd = 1.0f / sqrtf(wsum(ss) * (1.0f / DM) + NORM_EPS);
        f32x4 xn[4], sv[4], mvv[4], gv[4];
#pragma unroll
        for (int j = 0; j < 4; ++j) { const int c = lane * 4 + 256 * j; sv[j] = *(const f32x4*)(src + c); mvv[j] = *(const f32x4*)(mv + c); gv[j] = *(const f32x4*)(g + c); }
#pragma unroll
        for (int j = 0; j < 4; ++j) { const int c = lane * 4 + 256 * j;
            xn[j] = sv[j] + mvv[j] * (yv[j] * rstd * gv[j]);
            *(f32x4*)(dst + c) = xn[j]; }
        if (LAYER == 0) modnorm_store<1>(p, xn, row, lane);
    }
}
__device__ __forceinline__ void ropenorm_phase(const Params& p) {
    int tid_ = threadIdx.x; asm volatile("" : "+v"(tid_));
    const int lane = tid_ & 63, gw = (int)blockIdx.x * NWAVES + (tid_ >> 6), ngw = (int)gridDim.x * NWAVES;
    const float* ct = ws_rope(p); const float* st = ct + N_ROPE;
    const float qn0 = p.q_norm[2 * lane], qn1 = p.q_norm[2 * lane + 1], kn0 = p.k_norm[2 * lane], kn1 = p.k_norm[2 * lane + 1];
    for (int row = gw; row < R; row += ngw) {
        const bool rot = row >= CTXN; const int t = row - CTXN; float cs = 1.f, sn = 0.f;
        if (rot) { const int pos = lane < 32 ? t / GW : t % GW, f = lane & 31; cs = ct[pos * 32 + f]; sn = st[pos * 32 + f]; }
        bf16_t* base = ws_big(p) + (size_t)row * P0W;
        unsigned u[18];
#pragma unroll
        for (int slot = 0; slot < 18; ++slot) {
            const int col = slot < 4 ? C_QA + slot * 128 : slot < 8 ? C_KA + (slot - 4) * 128 : slot < 16 ? C_QB + (slot - 8) * 128 : C_KB + (slot - 16) * 128;
            u[slot] = *((const unsigned*)(base + col) + lane); }
#pragma unroll
        for (int slot = 0; slot < 18; ++slot) {
            const int col = slot < 4 ? C_QA + slot * 128 : slot < 8 ? C_KA + (slot - 4) * 128 : slot < 16 ? C_QB + (slot - 8) * 128 : C_KB + (slot - 16) * 128;
            unsigned* ptr = (unsigned*)(base + col) + lane;
            float x1 = __uint_as_float(u[slot] << 16), x2 = __uint_as_float(u[slot] & 0xffff0000u);
            if (slot >= 4 && slot < 8) { x1 *= 0.08838834764831845f; x2 *= 0.08838834764831845f; }
            if (slot >= 8) { const float sc = 1.0f / sqrtf(wsum(x1 * x1 + x2 * x2) * (1.0f / 128.f) + NORM_EPS);
                x1 *= sc * (slot < 16 ? qn0 : kn0); x2 *= sc * (slot < 16 ? qn1 : kn1); }
            *ptr = pk(x1 * cs - x2 * sn, x1 * sn + x2 * cs);
        }
    }
}
}

constexpr int RING_BYTES = 131072, LDS_BYTES = 163840;
constexpr size_t WS_BAR = 256 * 1024;
constexpr size_t WS_SIDE = 255 * MiB;
constexpr size_t WS_YC = WS_BIG + 72 * MiB;
constexpr int LDS_BARW = LDS_BYTES - 64;
constexpr size_t WB_IN0 = WS_WB, WB_OUT0 = WB_IN0 + (size_t)EVEN_IN * DM * 2, WB_IN1 = WB_OUT0 + (size_t)DM * 2048 * 2, WB_OUT1 = WB_IN1 + (size_t)ODD_IN * DM * 2, WB_END = WB_OUT1 + (size_t)DM * 2048 * 2;
static_assert(WB_END <= WS_XN, "weight copies overflow their region");
static_assert(wy::WS_RING + wy::RING_TOTAL <= WB_IN1 && XCD_BAR_WORDS * 4 <= 16384 && wy::WS_WYF + (size_t)wy::WYF_WORDS * 4 <= WS_CTX1, "rwkv ring / flag words");

__device__ __forceinline__ unsigned pk2(float lo, float hi) { return (unsigned)f2bf(lo) | ((unsigned)f2bf(hi) << 16); }
__device__ __forceinline__ void transpose_item(const float* W, int K, int N, int ldw, bf16_t* WT, LAS float* scr, int item, int lane) {
    const int nblk = N / 32, kb = item / nblk, nb = item % nblk, k0 = 64 * kb, n0 = 32 * nb;
#pragma unroll
    for (int i = 0; i < 32; ++i) { const int kk = 2 * i + (lane >> 5); scr[kk * 33 + (lane & 31)] = W[(size_t)(k0 + kk) * ldw + n0 + (lane & 31)]; }
    asm volatile("s_waitcnt lgkmcnt(0)" ::: "memory");
    const int c = lane & 7;
#pragma unroll
    for (int j = 0; j < 4; ++j) { const int n = (lane >> 3) + 8 * j; const LAS float* s = scr + (8 * c) * 33 + n;
        v4u o; o.x = pk2(s[0 * 33], s[1 * 33]); o.y = pk2(s[2 * 33], s[3 * 33]); o.z = pk2(s[4 * 33], s[5 * 33]); o.w = pk2(s[6 * 33], s[7 * 33]);
        *(v4u*)(WT + (size_t)(n0 + n) * K + k0 + 8 * c) = o; }
    asm volatile("s_waitcnt lgkmcnt(0)" ::: "memory");
}
__device__ __forceinline__ void p0_weights(const Params& p, LAS unsigned char* lds) {
    const int lane = threadIdx.x & 63, wave = __builtin_amdgcn_readfirstlane(threadIdx.x >> 6);
    LAS float* scr = (LAS float*)(lds + wave * 16384);
    const int gw = blockIdx.x * NWAVES + wave, NGW = gridDim.x * NWAVES;
    constexpr int I_IN0 = (DM / 64) * (EVEN_IN / 32), I_OUT = (2048 / 64) * (DM / 32), I_IN1 = (DM / 64) * (ODD_IN / 32);
    for (int it = gw; it < I_IN0 + I_OUT + I_IN1 + I_OUT; it += NGW) {
        int r = it;
        if (r < I_IN0) { transpose_item(p.ev_w_in, DM, EVEN_IN, EVEN_IN, (bf16_t*)(p.ws + WB_IN0), scr, r, lane); continue; } r -= I_IN0;
        if (r < I_OUT) { transpose_item(p.ev_w_out, 2048, DM, DM, (bf16_t*)(p.ws + WB_OUT0), scr, r, lane); continue; } r -= I_OUT;
        if (r < I_IN1) { transpose_item(p.od_w_in, DM, ODD_IN, ODD_IN, (bf16_t*)(p.ws + WB_IN1), scr, r, lane); continue; } r -= I_IN1;
        transpose_item(p.od_w_out, 2048, DM, DM, (bf16_t*)(p.ws + WB_OUT1), scr, r, lane);
    }
}

template <class Epi> __device__ __forceinline__ void run_gemm(LAS unsigned char* lds, const bf16_t* A, const bf16_t* Bt, int M, int N, int K, const Epi& E, int rot = 0, int lda = 0, int ldb = 0) {
    const int G = (int)gridDim.x;
    pg8::Gemm g{A, Bt, M, N, K, lda, ldb}; pg8::StaticOrder S; S.init(M, N, G, ((int)blockIdx.x + rot) % G);
    pg8::gemm_phase<Epi, pg8::StaticOrder, true, true>(lds, g, S, E);
}
__device__ __forceinline__ int tail_rot(int units) { const int G = (int)gridDim.x; return (G - units % G) % G; }

#ifndef PROBE
#define PROBE 0
#endif
#define REP(bit) for (int rep_ = 0; rep_ < (((PROBE) >> (bit)) & 1) + 1; ++rep_)
__global__ void __launch_bounds__(NTHR, 2) mega(Params p) {
    extern __shared__ __attribute__((aligned(16))) unsigned char lds_raw[];
    cg::grid_group grid = cg::this_grid();
    LAS unsigned char* lds = (LAS unsigned char*)lds_raw;
    const long gsz = (long)gridDim.x * NTHR;
    if (threadIdx.x < 2) *(LAS unsigned*)(lds + LDS_BARW + 4 * threadIdx.x) = 0u;
    __syncthreads();
    const XcdBarrier xbar = xcd_barrier_post((unsigned*)(p.ws + WS_BAR), (volatile LAS unsigned*)(lds + LDS_BARW));
    const bf16_t* wt_in0 = (const bf16_t*)(p.ws + WB_IN0); const bf16_t* wt_out0 = (const bf16_t*)(p.ws + WB_OUT0);
    const bf16_t* wt_in1 = (const bf16_t*)(p.ws + WB_IN1); const bf16_t* wt_out1 = (const bf16_t*)(p.ws + WB_OUT1);
#define X(fn, n) { int t_ = threadIdx.x; asm volatile("" : "+v"(t_)); for (long g = (long)blockIdx.x * NTHR + t_; g < (long)(n); g += gsz) fn(p, g); }
#define SYNC xcd_barrier(xbar);
    if ((PROBE >> 13) & 1) { for (int i_ = 0; i_ < 20; ++i_) xcd_barrier(xbar); }
    REP(14) { el::mod_phase(p, (char*)lds_raw); X(ph_rope_table, N_ROPE) p0_weights(p, lds);
              if (p.out == nullptr) grid.sync();
              SYNC }
    REP(15) { el::prenorm0_phase(p); SYNC }
    REP(2) { run_gemm(lds, ws_xn(p), wt_in0, R, P0W, DM, pg8::EpiBf16<0>{ws_big(p), P0W, nullptr, 0, 0, 1.f});
             run_gemm(lds, ws_xn(p), wt_in0 + (size_t)C_GA * DM, CTXN, 2048, DM, pg8::EpiSiluBf16{(bf16_t*)(p.ws + WS_SIDE), 2048}, tail_rot((R / 256) * (P0W / 256)));
             SYNC }
    el::ropenorm_phase(p); SYNC
    REP(5) { for (int u = blockIdx.x; u < ret::NQ * 4; u += gridDim.x) { const int q = u < (ret::NQ - 2) * 4 ? 2 + u / 4 : (u - (ret::NQ - 2) * 4) / 4; ret::summaries_unit(p, q, u & 3, (char*)lds_raw); } SYNC }
    ret::state_scan(p); SYNC
#define CTX_ATTN_UNIT(head_) do { const int hd_ = (head_), kv_ = hd_ / 4; const bf16_t* P_ = ws_big(p); bf16_t* BR_ = ws_br(p); \
        attn::attn_dense_body<attn::bf16, false>(P_ + C_QB + hd_ * 128, P_ + C_KB + kv_ * 128, P_ + C_VB + kv_ * 128, BR_ + 1024 + hd_ * 128, CTXN, (char*)lds_raw); \
        __syncthreads(); \
        {     \
            int t_ = threadIdx.x; asm volatile("" : "+v"(t_)); const bf16_t* GC = (const bf16_t*)(p.ws + WS_SIDE); \
            const size_t o = (size_t)(t_ >> 1) * 2048 + 1024 + hd_ * 128 + (t_ & 1) * 64; \
            _Pragma("unroll") for (int i_ = 0; i_ < 8; ++i_) { v4u a = *(const v4u*)(BR_ + o + 8 * i_); const v4u b = *(const v4u*)(GC + o + 8 * i_); \
                _Pragma("unroll") for (int q_ = 0; q_ < 4; ++q_) a[q_] = attn::cvtpk(__uint_as_float(a[q_] << 16) * __uint_as_float(b[q_] << 16), __uint_as_float(a[q_] & 0xffff0000u) * __uint_as_float(b[q_] & 0xffff0000u)); \
                *(v4u*)(BR_ + o + 8 * i_) = a; } \
            __syncthreads(); } } while (0)
    const bool ctx_attn_early = gridDim.x >= 16;
    REP(6) { for (int u = blockIdx.x; u < ret::NQ * 4; u += gridDim.x) { const int q = u < (ret::NQ - 2) * 4 ? 2 + u / 4 : (u - (ret::NQ - 2) * 4) / 4; ret::output_unit(p, q, u & 3, (char*)lds_raw); }
             if (ctx_attn_early && (int)blockIdx.x >= (int)gridDim.x - 8) CTX_ATTN_UNIT((int)blockIdx.x - ((int)gridDim.x - 8));
             SYNC }
    REP(0) {
        const int G = (int)gridDim.x, vcu = (G % 8 == 0) ? ((int)blockIdx.x % 8) * (G / 8) + (int)blockIdx.x / 8 : (int)blockIdx.x;
        const int NLAT = (SEQ / 256) * 8, per = (NLAT + G - 1) / G;
        const bf16_t* P = ws_big(p); bf16_t* BR = ws_br(p);
        bool nomax; { int t_ = threadIdx.x; asm volatile("" : "+v"(t_)); const int l_ = t_ & 63; float gq = fmaxf(fabsf(p.q_norm[l_]), fabsf(p.q_norm[64 + l_])), gk = fmaxf(fabsf(p.k_norm[l_]), fabsf(p.k_norm[64 + l_]));
          for (int m_ = 32; m_ >= 1; m_ >>= 1) { gq = fmaxf(gq, __shfl_xor(gq, m_)); gk = fmaxf(gk, __shfl_xor(gk, m_)); }
          nomax = 11.3137085f * 1.4426950409f * 1.02f * gq * gk <= 40.0f; }
        for (int i = 0; i <= per; ++i) {
            int head, row0, seq;
            if (i < per) { const int unit = vcu * per + i; if (unit >= NLAT) continue; const int nqb = SEQ / 256, kv = unit / (4 * nqb), rem = unit % (4 * nqb); head = kv * 4 + rem / nqb; row0 = CTXN + (rem % nqb) * 256; seq = R; }
            else { if (ctx_attn_early || vcu >= 8) break; CTX_ATTN_UNIT(vcu); break; }
            const int kv = head / 4;
            if (nomax) attn::attn_dense_body<attn::bf16, true>(P + (size_t)row0 * P0W + C_QB + head * 128, P + C_KB + kv * 128, P + C_VB + kv * 128, BR + (size_t)row0 * 2048 + 1024 + head * 128, seq, (char*)lds_raw);
            else attn::attn_dense_body<attn::bf16, false>(P + (size_t)row0 * P0W + C_QB + head * 128, P + C_KB + kv * 128, P + C_VB + kv * 128, BR + (size_t)row0 * 2048 + 1024 + head * 128, seq, (char*)lds_raw);
            __syncthreads();
        }
        if (PROBE & 1) xcd_barrier(xbar);
    }
    SYNC
    run_gemm(lds, ws_xn(p) + (size_t)CTXN * DM, wt_in0 + (size_t)C_GA * DM, SEQ, 2048, DM, pg8::EpiGateMul{ws_br(p) + (size_t)CTXN * 2048, 2048});
    {
        pg8::Gemm gk{ws_br(p), wt_out0, 8 * 256, DM, 256, 2048, 2048, 256 * 2}; pg8::StaticOrder S; S.init(8 * 256, DM, (int)gridDim.x, (int)blockIdx.x);
        pg8::gemm_phase<pg8::EpiF32, pg8::StaticOrder, true, true>(lds, gk, S, pg8::EpiF32{(float*)(p.ws + WS_YC), DM}); }
    SYNC
    REP(4) { run_gemm(lds, ws_br(p) + (size_t)CTXN * 2048, wt_out0, SEQ, DM, 2048, pg8::EpiF32{ws_y(p) + (size_t)CTXN * DM, DM}); SYNC }
    REP(15) { el::resid_phase<0>(p); SYNC }
    REP(3) { run_gemm(lds, ws_xn(p), wt_in1 + (size_t)O_RW * DM, R, ZW, DM, pg8::EpiBf16Halo{ws_big(p), ZW, (bf16_t*)(p.ws + rw::WS_HALO)});
             run_gemm(lds, ws_xn(p), wt_in1 + (size_t)(O_NA + 1024) * DM, CTXN, 2048, DM, pg8::EpiBf16<0>{(bf16_t*)(p.ws + WS_SIDE), 2048, nullptr, 0, 0, 1.f}, tail_rot((R / 256) * (ZW / 256)));
             SYNC }
    rw::shift_inplace(p); wy::zero_words(p); SYNC
#ifndef PSKIP
#define PSKIP 0
#endif
    if ((PROBE >> 16) & 1) { wy::phase<1, PSKIP>(p, lds); SYNC wy::zero_words(p); SYNC }
    if ((PROBE >> 17) & 1) { wy::phase<2>(p, lds); SYNC wy::zero_words(p); SYNC }
    if ((PROBE >> 19) & 1) { wy::phase<4, 16>(p, lds); SYNC wy::zero_words(p); SYNC }
    if ((PROBE >> 18) & 1) { wy::phase<3>(p, lds); SYNC wy::zero_words(p); SYNC }
    if (gridDim.x >= 64) wy::phase<0>(p, lds);
    else { for (int b = blockIdx.x; b < 256; b += gridDim.x) rw::scan_block<0>(p, b, lds); }
    SYNC
    rw::finish_phase(p); SYNC
    REP(3) { run_gemm(lds, ws_xn(p) + (size_t)CTXN * DM, wt_in1 + (size_t)O_NA * DM, SEQ, NAW, DM, pg8::EpiBf16<0>{ws_big(p) + (size_t)CTXN * NAW, NAW, nullptr, 0, 0, 1.f}); SYNC }
    REP(7) { for (int u = blockIdx.x; u < (GROWS / 4) * 16; u += gridDim.x) na::na_unit(p, u >> 4, u & 15, (char*)lds_raw); SYNC }
    run_gemm(lds, ws_xn(p) + (size_t)CTXN * DM, wt_in1 + (size_t)O_GC * DM, SEQ, 2048, DM, pg8::EpiGateMul{ws_br(p) + (size_t)CTXN * 2048, 2048}); SYNC
    REP(4) { run_gemm(lds, ws_br(p) + (size_t)CTXN * 2048, wt_out1, SEQ, DM, 2048, pg8::EpiF32{ws_y(p) + (size_t)CTXN * DM, DM}); SYNC }
    el::resid_phase<1>(p);
#undef X
#undef SYNC
}

extern "C" void kernel_launch(void* const* d_in, const int* in_sizes, int n_in, void* d_out, int out_size, void* d_ws, size_t ws_size, hipStream_t stream) {
    static int grid_blocks = 0;
    if (!grid_blocks) {
        int dev = 0, cus = 0, per_cu = 0;
        (void)hipGetDevice(&dev); (void)hipDeviceGetAttribute(&cus, hipDeviceAttributeMultiprocessorCount, dev);
        (void)hipFuncSetAttribute((const void*)mega, hipFuncAttributeMaxDynamicSharedMemorySize, LDS_BYTES);
        (void)hipOccupancyMaxActiveBlocksPerMultiprocessor(&per_cu, mega, NTHR, LDS_BYTES);
        if (per_cu < 1) per_cu = 1;
        grid_blocks = cus * per_cu;
        if (ws_size < WS_END) fprintf(stderr, "kernel_launch: workspace too small: %zu < %zu\n", ws_size, (size_t)WS_END);
    }
    (void)hipMemsetAsync((char*)d_ws + WS_BAR, 0, XCD_BAR_WORDS * 4, stream);
    Params p = make_params(d_in, d_out, d_ws);
    void* args[] = {&p};
    hipError_t e = hipLaunchCooperativeKernel((void*)mega, dim3(grid_blocks), dim3(NTHR), args, LDS_BYTES, stream);
    if (e != hipSuccess) fprintf(stderr, "cooperative launch failed: %s (grid %d)\n", hipGetErrorString(e), grid_blocks);
}

#else
int main(int argc, char** argv) {
    const char* dir = argc > 1 ? argv[1] : "data";
    char path[512]; snprintf(path, 512, "%s/sizes.txt", dir); FILE* f = fopen(path, "r"); if (!f) { printf("no sizes\n"); return 1; }
    std::vector<long> sizes; long v; while (fscanf(f, "%ld", &v) == 1) sizes.push_back(v); fclose(f);
    if (sizes.size() != 31) { printf("bad n inputs %zu\n", sizes.size()); return 1; }
    snprintf(path, 512, "%s/inputs.bin", dir); f = fopen(path, "rb");
    std::vector<std::vector<float>> in(31); std::vector<void*> ptrs(31);
    for (int i = 0; i < 31; ++i) { in[i].resize(sizes[i]); if (fread(in[i].data(), 4, sizes[i], f) != (size_t)sizes[i]) { printf("short read\n"); return 1; } ptrs[i] = in[i].data(); }
    fclose(f);
    if (sizes[0] != (long)SEQ * DM) { printf("SEQ mismatch: build with -DSEQ_LEN=%ld\n", sizes[0] / DM); return 1; }
    std::vector<float> out((size_t)SEQ * DM, 0.f); std::vector<unsigned char> ws(WS_END, 0xAA);
    Params p = make_params(ptrs.data(), out.data(), ws.data());
    auto check = [&](const char* name, const float* got, size_t n) {
        snprintf(path, 512, "%s/%s", dir, name); FILE* g = fopen(path, "rb"); std::vector<float> ref(n); if (fread(ref.data(), 4, n, g) != n) printf("short ref\n"); fclose(g);
        double num = 0, den = 0, mx = 0; for (size_t i = 0; i < n; ++i) { const double d = (double)got[i] - ref[i]; num += d * d; den += (double)ref[i] * ref[i]; if (fabs(d) > mx) mx = fabs(d); }
        printf("%s: rvr=%.3e absmax=%.3e\n", name, num / den, mx); };
    static RwShared sh;
    int phase = 0;
#define X(fn, n) { printf("phase %d %s n=%ld\n", phase++, #fn, (long)(n)); fflush(stdout); _Pragma("omp parallel for schedule(dynamic, 64)") for (long g = 0; g < (long)(n); ++g) fn(p, g); }
#define SYNC
#define SCAN { printf("phase %d scan\n", phase++); fflush(stdout); _Pragma("omp parallel for schedule(dynamic, 1)") for (int b = 0; b < 32; ++b) { RwShared* s = new RwShared; rwkv_scan_block(p, b, *s); delete s; } }
    X(ph_mod, N_MOD) X(ph_rope_table, N_ROPE) X(ph_prenorm<0>, (long)R) X(ph_gemm_l0_qkv, (long)R * P0W) X(ph_ropenorm, N_ROPENORM) X(ph_ret_scan, N_RETSCAN)
    X(ph_ret_merge, N_RETMERGE) X(ph_gqa_attn, N_GQA) X(ph_gemm_l0_gate, (long)R * 2048) X(ph_gemm_l0_out, (long)R * DM) X(ph_resid<0>, (long)R)
    check("x0.bin", out.data(), out.size()); check("ctx0.bin", ws_ctx1(p), (size_t)CTXN * DM);
    X(ph_prenorm<1>, (long)R) X(ph_gemm_l1_rw, (long)R * ZW) SCAN X(ph_rwkv_finish, N_RWFIN) X(ph_gemm_l1_na, (long)R * NAW) X(ph_na, N_NA)
    X(ph_gemm_l1_gate, (long)SEQ * 2048) X(ph_gemm_l1_out, (long)SEQ * DM) X(ph_resid<1>, (long)SEQ)
    check("out.bin", out.data(), out.size());
    return 0;
}
#endif
```
